# Optimizing an MI355X kernel written in HIP

```python
import jax, jax.numpy as jnp
from jax import lax
import numpy as np

D_MODEL = 1024
BATCH = 8
SEQ = 8192
DEPTH = 1

HEAD_DIM = 64
MIX_WIDTH = D_MODEL
FOX_WIDTH = MIX_WIDTH // 2
SB_WIDTH = MIX_WIDTH - FOX_WIDTH
N_FOX_HEADS = FOX_WIDTH // HEAD_DIM
N_SB_HEADS = SB_WIDTH // HEAD_DIM
IN_PROJ_WIDTH = 3 * FOX_WIDTH + 3 * SB_WIDTH + N_FOX_HEADS
Q_BLOCK = 128
N_MEM = 256
N_XATTN_HEADS = 4
XATTN_HEAD_DIM = D_MODEL // N_XATTN_HEADS
N_GROUPS = 4
EXPERTS_PER_GROUP = 4
N_EXPERTS = N_GROUPS * EXPERTS_PER_GROUP
TOP_K_IN_GROUP = 2
D_FF_EXPERT = D_MODEL // 4
EPS = 1e-6

kernel_name = "hymba_fox_stickbreak_hmoe_layer"


def _rmsnorm(x, g):
    xf = x.astype(jnp.float32)
    y = xf * lax.rsqrt(jnp.mean(xf * xf, axis=-1, keepdims=True) + EPS)
    return (y * g.astype(jnp.float32)).astype(x.dtype)


def _heads(t, n_heads):
    b, s, _ = t.shape
    return t.reshape(b, s, n_heads, HEAD_DIM).transpose(0, 2, 1, 3)


def _query_blocks(t, n_heads):
    b, s, _ = t.shape
    return t.reshape(b, s // Q_BLOCK, Q_BLOCK, n_heads, HEAD_DIM).transpose(1, 0, 3, 2, 4)


def _merge_blocks(o):
    nb, b, h, qb, dh = o.shape
    return o.transpose(1, 0, 3, 2, 4).reshape(b, nb * qb, h * dh)


def _forgetting_attention(q, k, v, f_logit):
    b, s, _ = q.shape
    nb = s // Q_BLOCK
    c = jnp.cumsum(jax.nn.log_sigmoid(f_logit.astype(jnp.float32)), axis=1).transpose(0, 2, 1)
    c_blocks = c.reshape(b, N_FOX_HEADS, nb, Q_BLOCK).transpose(2, 0, 1, 3)
    qb = _query_blocks(q, N_FOX_HEADS)
    kh = _heads(k, N_FOX_HEADS)
    vh = _heads(v, N_FOX_HEADS)
    starts = jnp.arange(nb, dtype=jnp.int32) * Q_BLOCK
    kpos = jnp.arange(s, dtype=jnp.int32)
    scale = HEAD_DIM ** -0.5

    def one_block(args):
        q_blk, c_blk, start = args
        qpos = start + jnp.arange(Q_BLOCK, dtype=jnp.int32)
        logits = jnp.einsum('bhqd,bhkd->bhqk', q_blk, kh).astype(jnp.float32) * scale
        logits = logits + c_blk[..., None] - c[:, :, None, :]
        logits = jnp.where(kpos[None, :] <= qpos[:, None], logits, -jnp.inf)
        p = jax.nn.softmax(logits, axis=-1)
        return jnp.einsum('bhqk,bhkd->bhqd', p.astype(vh.dtype), vh)

    return _merge_blocks(lax.map(one_block, (qb, c_blocks, starts)))


def _stick_breaking_attention(q, k, v):
    b, s, _ = q.shape
    nb = s // Q_BLOCK
    qb = _query_blocks(q, N_SB_HEADS)
    kh = _heads(k, N_SB_HEADS)
    vh = _heads(v, N_SB_HEADS)
    starts = jnp.arange(nb, dtype=jnp.int32) * Q_BLOCK
    kpos = jnp.arange(s, dtype=jnp.int32)
    scale = HEAD_DIM ** -0.5

    def one_block(args):
        q_blk, start = args
        qpos = start + jnp.arange(Q_BLOCK, dtype=jnp.int32)
        mask = kpos[None, :] < qpos[:, None]
        z = jnp.einsum('bhqd,bhkd->bhqk', q_blk, kh).astype(jnp.float32) * scale
        log_one_minus = jnp.where(mask, jax.nn.log_sigmoid(-z), 0.0)
        tail = lax.cumsum(log_one_minus, axis=3, reverse=True) - log_one_minus
        weight = jnp.where(mask, jnp.exp(jax.nn.log_sigmoid(z) + tail), 0.0)
        return jnp.einsum('bhqk,bhkd->bhqd', weight.astype(vh.dtype), vh)

    return _merge_blocks(lax.map(one_block, (qb, starts)))


def _memory_cross_attention(hn, mn, w_xq, w_xkv, w_xo):
    b, s, d = hn.shape
    m = mn.shape[1]
    q = (hn @ w_xq).reshape(b, s, N_XATTN_HEADS, XATTN_HEAD_DIM)
    kv = mn @ w_xkv
    k = kv[..., :d].reshape(b, m, N_XATTN_HEADS, XATTN_HEAD_DIM)
    v = kv[..., d:].reshape(b, m, N_XATTN_HEADS, XATTN_HEAD_DIM)
    logits = jnp.einsum('bshd,bmhd->bhsm', q, k).astype(jnp.float32) * (XATTN_HEAD_DIM ** -0.5)
    p = jax.nn.softmax(logits, axis=-1)
    o = jnp.einsum('bhsm,bmhd->bshd', p.astype(v.dtype), v).reshape(b, s, d)
    return o @ w_xo


def _hierarchical_moe(u, w_rg, b_rg, w_re, b_re, w_gate, w_up, w_down):
    b, s, d = u.shape
    t = u.reshape(b * s, d)
    tf = t.astype(jnp.float32)
    p_group = jax.nn.softmax(tf @ w_rg.astype(jnp.float32) + b_rg.astype(jnp.float32), axis=-1)
    g_val, g_idx = lax.top_k(p_group, 1)
    g_val, g_idx = g_val[:, 0], g_idx[:, 0]
    e_logits = (tf @ w_re.astype(jnp.float32) + b_re.astype(jnp.float32)).reshape(-1, N_GROUPS, EXPERTS_PER_GROUP)
    in_group = jnp.take_along_axis(e_logits, g_idx[:, None, None], axis=1)[:, 0, :]
    e_val, e_idx = lax.top_k(in_group, TOP_K_IN_GROUP)
    weights = g_val[:, None] * jax.nn.softmax(e_val, axis=-1)
    expert_id = g_idx[:, None] * EXPERTS_PER_GROUP + e_idx
    gate = jnp.sum(jax.nn.one_hot(expert_id, N_EXPERTS, dtype=jnp.float32) * weights[..., None], axis=1)
    y = jnp.zeros((b * s, d), jnp.float32)
    for e in range(N_EXPERTS):
        hidden = jax.nn.silu(t @ w_gate[e]) * (t @ w_up[e])
        y = y + gate[:, e:e + 1] * (hidden @ w_down[e]).astype(jnp.float32)
    return y.astype(u.dtype).reshape(b, s, d)


def setup_inputs(seed: int = 0) -> dict:
    key = jax.random.key(seed)
    ks = jax.random.split(key, 24)
    f32 = jnp.float32
    nrm = lambda k, shape, scale: jax.random.normal(k, shape, f32) * scale
    gain = lambda k, shape: 1.0 + 0.02 * jax.random.normal(k, shape, f32)
    L = DEPTH
    return {
        "x": jax.random.normal(ks[0], (BATCH, SEQ, D_MODEL), f32),
        "mem": jax.random.normal(ks[1], (BATCH, N_MEM, D_MODEL), f32),
        "norm_mix": gain(ks[2], (L, D_MODEL)),
        "w_in": nrm(ks[3], (L, D_MODEL, IN_PROJ_WIDTH), D_MODEL ** -0.5),
        "b_forget": 3.0 + 0.5 * jax.random.normal(ks[4], (L, N_FOX_HEADS), f32),
        "norm_fox_out": gain(ks[5], (L, FOX_WIDTH)),
        "norm_sb_out": gain(ks[6], (L, SB_WIDTH)),
        "w_out": nrm(ks[7], (L, MIX_WIDTH, D_MODEL), MIX_WIDTH ** -0.5),
        "norm_xattn": gain(ks[8], (L, D_MODEL)),
        "norm_mem": gain(ks[9], (L, D_MODEL)),
        "w_xq": nrm(ks[10], (L, D_MODEL, D_MODEL), D_MODEL ** -0.5),
        "w_xkv": nrm(ks[11], (L, D_MODEL, 2 * D_MODEL), D_MODEL ** -0.5),
        "w_xo": nrm(ks[12], (L, D_MODEL, D_MODEL), D_MODEL ** -0.5),
        "norm_ffn": gain(ks[13], (L, D_MODEL)),
        "w_router_group": nrm(ks[14], (L, D_MODEL, N_GROUPS), D_MODEL ** -0.5),
        "b_router_group": nrm(ks[15], (L, N_GROUPS), 0.01),
        "w_router_expert": nrm(ks[16], (L, D_MODEL, N_EXPERTS), D_MODEL ** -0.5),
        "b_router_expert": nrm(ks[17], (L, N_EXPERTS), 0.01),
        "w_exp_gate": nrm(ks[18], (L, N_EXPERTS, D_MODEL, D_FF_EXPERT), D_MODEL ** -0.5),
        "w_exp_up": nrm(ks[19], (L, N_EXPERTS, D_MODEL, D_FF_EXPERT), D_MODEL ** -0.5),
        "w_exp_down": nrm(ks[20], (L, N_EXPERTS, D_FF_EXPERT, D_MODEL), D_FF_EXPERT ** -0.5),
        "norm_final": gain(ks[21], (D_MODEL,)),
    }


def reference(x, mem, norm_mix, w_in, b_forget, norm_fox_out, norm_sb_out, w_out,
              norm_xattn, norm_mem, w_xq, w_xkv, w_xo, norm_ffn,
              w_router_group, b_router_group, w_router_expert, b_router_expert,
              w_exp_gate, w_exp_up, w_exp_down, norm_final):
    h = x
    F, S_ = FOX_WIDTH, SB_WIDTH
    for l in range(DEPTH):
        u = _rmsnorm(h, norm_mix[l])
        proj = u @ w_in[l]
        q_a = proj[..., 0:F]
        k_a = proj[..., F:2 * F]
        v_a = proj[..., 2 * F:3 * F]
        o0 = 3 * F
        q_b = proj[..., o0:o0 + S_]
        k_b = proj[..., o0 + S_:o0 + 2 * S_]
        v_b = proj[..., o0 + 2 * S_:o0 + 3 * S_]
        f_logit = proj[..., o0 + 3 * S_:] + b_forget[l]
        o_a = _forgetting_attention(q_a, k_a, v_a, f_logit)
        o_b = _stick_breaking_attention(q_b, k_b, v_b)
        mixed = jnp.concatenate([_rmsnorm(o_a, norm_fox_out[l]), _rmsnorm(o_b, norm_sb_out[l])], axis=-1)
        h = h + (mixed @ w_out[l]).astype(h.dtype)
        h = h + _memory_cross_attention(_rmsnorm(h, norm_xattn[l]), _rmsnorm(mem, norm_mem[l]),
                                        w_xq[l], w_xkv[l], w_xo[l]).astype(h.dtype)
        h = h + _hierarchical_moe(_rmsnorm(h, norm_ffn[l]), w_router_group[l], b_router_group[l],
                                  w_router_expert[l], b_router_expert[l],
                                  w_exp_gate[l], w_exp_up[l], w_exp_down[l]).astype(h.dtype)
    return _rmsnorm(h, norm_final)
```

```cpp
#include <hip/hip_runtime.h>
#include <hip/hip_bf16.h>
#include <cstdio>
#include <cstdint>

#define LAS __attribute__((address_space(3)))
#define GAS __attribute__((address_space(1)))
typedef unsigned short bf16_t;
typedef short bf16x8 __attribute__((ext_vector_type(8)));
typedef short s16x4 __attribute__((ext_vector_type(4)));
typedef float f32x4 __attribute__((ext_vector_type(4)));
typedef float f32x2 __attribute__((ext_vector_type(2)));
typedef float f32x16 __attribute__((ext_vector_type(16)));
typedef unsigned u32x4 __attribute__((ext_vector_type(4)));
typedef unsigned u32x2 __attribute__((ext_vector_type(2)));
typedef __bf16 bf16x2_t __attribute__((ext_vector_type(2)));

constexpr int BATCH = 8, SEQ = 8192, DM = 1024, M = BATCH * SEQ;
constexpr int NH = 8, HD = 64, HW = NH * HD;
constexpr int NPROJ = 3 * HW * 2;
constexpr int WIN_LD = NPROJ + NH;
constexpr int NMEM = 256, XH = 4, XD = 256, MEMROWS = BATCH * NMEM;
constexpr int NEXP = 16, DFF = 256;
constexpr float EPS = 1e-6f;
constexpr float LOG2E = 1.4426950408889634f;
constexpr float C2 = 0.125f * LOG2E;
constexpr float XSC = 0.0625f * LOG2E;
constexpr float SB_EXIT = -173.0f;

constexpr size_t MiB = 1u << 20;
constexpr size_t WS_CTL = 0, CTL_ZERO_BYTES = 1 * MiB;
constexpr size_t WS_WIN = 1 * MiB;
constexpr size_t WS_WOUT = 7 * MiB;
constexpr size_t WS_WXQ = 9 * MiB;
constexpr size_t WS_WXKV = 11 * MiB;
constexpr size_t WS_WXO = 15 * MiB;
constexpr size_t WS_WGU = 17 * MiB;
constexpr size_t WS_WD = 33 * MiB;
constexpr size_t WS_RX = 41 * MiB;
constexpr size_t WS_RMEM = WS_RX + 256 * 1024;
constexpr size_t WS_LF = 42 * MiB;
constexpr size_t WS_C2 = 44 * MiB;
constexpr size_t WS_SSQ = 46 * MiB;
constexpr size_t WS_TOKSLOT = 50 * MiB;
constexpr size_t WS_TOKW = 51 * MiB;
constexpr size_t WS_LIST = 52 * MiB;
constexpr size_t WS_MEMB = 56 * MiB;
constexpr size_t WS_KVM = 60 * MiB;
constexpr size_t WS_GT = 68 * MiB;
constexpr size_t WS_HT = 84 * MiB;
constexpr size_t WS_XB = 128 * MiB;
constexpr size_t WS_QKV = 256 * MiB;
constexpr size_t WS_H1B = 256 * MiB, WS_U2B = 384 * MiB, WS_HID = 512 * MiB;
constexpr size_t WS_O = 640 * MiB;
constexpr size_t WS_Y = 704 * MiB;
constexpr size_t WS_END = 1024 * MiB;
constexpr size_t QKV_STRIDE = (size_t)M * HW;
constexpr int MAXTILES = M * 2 / 256 + NEXP;
static_assert(WS_Y + (size_t)MAXTILES * 256 * 1024 * 2 <= WS_END, "ws map");
static_assert(WS_HID + (size_t)MAXTILES * 256 * 256 * 2 <= WS_O, "ws map");
constexpr int CW_BAR = 4096;
constexpr int CW_CNT = 16384;

constexpr int RING_OFF = 0, RING_BYTES = 131072;
constexpr int EXTRA_OFF = 131072, EXTRA_BYTES = 16384;
constexpr int MISC_OFF = EXTRA_OFF + EXTRA_BYTES;
constexpr int LDS_BYTES = MISC_OFF + 1024;
constexpr int NWAVES = 8;
#ifndef PHASE_MASK
#define PHASE_MASK 0x7ff
#endif
#define PH(n) ((PHASE_MASK >> (n)) & 1)

__device__ __forceinline__ unsigned cvt_pk_bf16(float lo, float hi) { f32x2 v = {lo, hi}; bf16x2_t b = __builtin_convertvector(v, bf16x2_t); return __builtin_bit_cast(unsigned, b); }
__device__ __forceinline__ float bf16lo(unsigned u) { return __uint_as_float(u << 16); }
__device__ __forceinline__ float bf16hi(unsigned u) { return __uint_as_float(u & 0xffff0000u); }
__device__ __forceinline__ float wave_sum(float v) {
#pragma unroll
    for (int o = 1; o < 64; o <<= 1) v += __shfl_xor(v, o);
    return v;
}
#define LDS_WAIT() asm volatile("s_waitcnt lgkmcnt(0)" ::: "memory")
#define VM_WAIT() asm volatile("s_waitcnt vmcnt(0)" ::: "memory")

namespace pg8 {
constexpr int BM = 256, BK = 64, HALF = 128, HTB = HALF * BK * 2, STAGE_BYTES = 8 * HTB, NXCD = 8, WGM = 8;
__host__ __device__ __forceinline__ int lds_byte(int r, int c) { const int st = (r >> 4) * 2 + (c >> 5), rr = r & 15, cc = c & 31, ob = rr * 64 + cc * 2; return st * 1024 + (ob ^ (((ob >> 9) & 1) << 5)); }
__host__ __device__ __forceinline__ void stage_rc(int b, int& R, int& C) { const int st = b / 1024, sb = b % 1024, swz = sb ^ (((sb >> 9) & 1) << 5); R = (st >> 1) * 16 + swz / 64; C = (st & 1) * 32 + (swz % 64) / 2; }
__host__ __device__ __forceinline__ int perm32(int rho) { const int n = rho >> 4, i = rho & 15; return 8 * (i >> 2) + 4 * n + (i & 3); }

struct Unit { const char* a; const char* b; int orow, ocol, aux; const int* rows; int nvalid; };
struct Gemm { int lda, ldb, K; };

__device__ __forceinline__ bool tile_order(int i, int G, int c, int nM, int nN, int& pm, int& pn) {
    const int nwg = nM * nN; const long L = (long)i * G + c; if (L >= nwg) return false;
    int wgid = (int)L; { const int q = nwg / NXCD, r = nwg % NXCD, xcd = wgid % NXCD, off = wgid / NXCD; wgid = (xcd < r ? xcd * (q + 1) : r * (q + 1) + (xcd - r) * q) + off; }
    const int nig = WGM * nN, gid = wgid / nig, fm = gid * WGM, gsz = (nM - fm) < WGM ? (nM - fm) : WGM;
    pm = fm + ((wgid % nig) % gsz); pn = (wgid % nig) / gsz; return true;
}

template <class Epi, class Sched, bool ALIGN_EPI, bool GATHER>
__device__ __forceinline__ void gemm_phase(LAS unsigned char* lds, const Gemm g, const Sched& S, const Epi& E) {
    const int tid = threadIdx.x, wid = __builtin_amdgcn_readfirstlane(tid >> 6), lane = tid & 63, wr = wid >> 2, wc = wid & 3, fr = lane & 15, fq = lane >> 4;
    const int K = g.K, nt = K / BK;
    unsigned voffA[2], voffB[2]; int RA[2], CA[2];
#pragma unroll
    for (int i = 0; i < 2; ++i) { int R, C; stage_rc(tid * 16 + i * 8192, R, C); const int Rb = (R & ~31) + perm32(R & 31);
        RA[i] = R; CA[i] = C; voffA[i] = (unsigned)(R * g.lda + C) * 2u; voffB[i] = (unsigned)(Rb * g.ldb + C) * 2u; }
    const size_t kstep = (size_t)(BK * 2);
    const size_t hstepA = (size_t)HALF * g.lda * 2, hstepB = (size_t)HALF * g.ldb * 2;
    const unsigned ldsw = (unsigned)wid * 1024u;
    const int aoff = lds_byte(wr * 64 + fr, fq * 8), boff = lds_byte(wc * 32 + fr, fq * 8);
#define PG8_SA(b, h) (((b) * 2 + (h)) * HTB)
#define PG8_SB(b, h) ((4 + (b) * 2 + (h)) * HTB)
#define PG8_STAGE2(bufoff, gbase, v0, v1) do { \
        __builtin_amdgcn_global_load_lds((const unsigned*)((const char*)(gbase) + (v0)), (LAS unsigned*)(lds + (bufoff) + ldsw), 16, 0, 0); \
        __builtin_amdgcn_global_load_lds((const unsigned*)((const char*)(gbase) + (v1)), (LAS unsigned*)(lds + (bufoff) + ldsw + 8192), 16, 0, 0); } while (0)
#define PG8_STAGEB(bufoff, gbase) PG8_STAGE2(bufoff, gbase, voffB[0], voffB[1])
#define PG8_STAGEA(bufoff, kptr, h, NX) do { if constexpr (GATHER) { const unsigned v0_ = (NX) ? gvn[h][0] : gvc[h][0], v1_ = (NX) ? gvn[h][1] : gvc[h][1]; PG8_STAGE2(bufoff, kptr, v0_, v1_); } \
        else { PG8_STAGE2(bufoff, (kptr) + (h) * hstepA, voffA[0], voffA[1]); } } while (0)
#define PG8_LDA(dst, b, h) do { _Pragma("unroll") for (int m = 0; m < 4; ++m) _Pragma("unroll") for (int k = 0; k < 2; ++k) dst[m][k] = *(const LAS bf16x8*)(lds + PG8_SA(b, h) + aoff + m * 2048 + k * 1024); } while (0)
#define PG8_LDB(dst, b, h) do { _Pragma("unroll") for (int n = 0; n < 2; ++n) _Pragma("unroll") for (int k = 0; k < 2; ++k) dst[n][k] = *(const LAS bf16x8*)(lds + PG8_SB(b, h) + boff + n * 2048 + k * 1024); } while (0)
#define PG8_MMA(ai, bj, At, Bt) do { __builtin_amdgcn_s_setprio(1); _Pragma("unroll") for (int m = 0; m < 4; ++m) _Pragma("unroll") for (int n = 0; n < 2; ++n) _Pragma("unroll") for (int k = 0; k < 2; ++k) \
        acc[ai][bj][m][n] = __builtin_amdgcn_mfma_f32_16x16x32_bf16(Bt[n][k], At[m][k], acc[ai][bj][m][n], 0, 0, 0); __builtin_amdgcn_s_setprio(0); } while (0)
#define PG8_WAIT_V(n) asm volatile("s_waitcnt vmcnt(" #n ")" ::: "memory")
#define PG8_WAIT_L(n) asm volatile("s_waitcnt lgkmcnt(" #n ")" ::: "memory")
#define PG8_BAR __builtin_amdgcn_s_barrier()
#define PG8_SCHED __builtin_amdgcn_sched_barrier(0)
#define PG8_GATHER_OFFS(dst, u) do { _Pragma("unroll") for (int h_ = 0; h_ < 2; ++h_) _Pragma("unroll") for (int i_ = 0; i_ < 2; ++i_) { const int r_ = h_ * HALF + RA[i_]; \
        const int idx_ = (u).rows[r_ < (u).nvalid ? r_ : 0]; dst[h_][i_] = (unsigned)(idx_ * g.lda + CA[i_]) * 2u; } } while (0)
    Unit cur, nxt; int ui = 0;
    if (!S.next(0, cur)) return;
    unsigned gvc[2][2] = {{0u, 0u}, {0u, 0u}}, gvn[2][2] = {{0u, 0u}, {0u, 0u}};
    if constexpr (GATHER) { PG8_GATHER_OFFS(gvc, cur); }
    f32x4 acc[2][2][4][2];
#pragma unroll
    for (int a = 0; a < 2; ++a)
#pragma unroll
        for (int b = 0; b < 2; ++b)
#pragma unroll
            for (int m = 0; m < 4; ++m)
#pragma unroll
                for (int n = 0; n < 2; ++n) acc[a][b][m][n] = (f32x4){0.f, 0.f, 0.f, 0.f};
    bf16x8 At[4][2], B0[2][2], B1[2][2];
    const char* cA = cur.a; const char* cB = cur.b;
    PG8_STAGEB(PG8_SB(0, 0), cB); PG8_STAGEB(PG8_SB(0, 1), cB + hstepB); PG8_STAGEA(PG8_SA(0, 0), cA, 0, false); PG8_STAGEA(PG8_SA(0, 1), cA, 1, false);
    if (wr == 1) PG8_BAR;
    PG8_WAIT_V(2); PG8_BAR;
    PG8_STAGEB(PG8_SB(1, 0), cB + kstep); PG8_STAGEA(PG8_SA(1, 0), cA + kstep, 0, false); PG8_STAGEB(PG8_SB(1, 1), cB + hstepB + kstep);
    PG8_WAIT_V(6); PG8_BAR;
    for (;;) {
        const bool has_next = S.next(ui + 1, nxt);
        const char* nA = has_next ? nxt.a : cA; const char* nB = has_next ? nxt.b : cB;
        if constexpr (GATHER) { if (has_next) { PG8_GATHER_OFFS(gvn, nxt); } else { gvn[0][0] = gvc[0][0]; gvn[0][1] = gvc[0][1]; gvn[1][0] = gvc[1][0]; gvn[1][1] = gvc[1][1]; } }
#pragma unroll 1
        for (int t = 0; t < nt; t += 2) {
            const bool last = (t == nt - 2);
            const char* a1 = cA + (size_t)(t + 1) * kstep;
            const char* a2 = last ? nA : cA + (size_t)(t + 2) * kstep; const char* b2 = last ? nB : cB + (size_t)(t + 2) * kstep;
            const char* a3 = a2 + kstep; const char* b3 = b2 + kstep;
            PG8_LDB(B0, 0, 0); PG8_LDB(B1, 0, 1); PG8_SCHED; PG8_LDA(At, 0, 0); PG8_STAGEA(PG8_SA(1, 1), a1, 1, false);
            PG8_WAIT_V(8); PG8_WAIT_L(0); PG8_BAR; PG8_MMA(0, 0, At, B0); PG8_MMA(0, 1, At, B1); PG8_BAR; PG8_SCHED;
            PG8_LDA(At, 0, 1); PG8_STAGEB(PG8_SB(0, 0), b2); PG8_STAGEB(PG8_SB(0, 1), b2 + hstepB); PG8_STAGEA(PG8_SA(0, 0), a2, 0, last);
            PG8_WAIT_V(8); PG8_WAIT_L(0); PG8_BAR; PG8_MMA(1, 0, At, B0); PG8_MMA(1, 1, At, B1); PG8_BAR; PG8_SCHED;
            PG8_LDB(B0, 1, 0); PG8_LDB(B1, 1, 1); PG8_SCHED; PG8_LDA(At, 1, 0); PG8_STAGEA(PG8_SA(0, 1), a2, 1, last);
            PG8_WAIT_V(8); PG8_WAIT_L(0); PG8_BAR; PG8_MMA(0, 0, At, B0); PG8_MMA(0, 1, At, B1); PG8_BAR; PG8_SCHED;
            PG8_LDA(At, 1, 1); PG8_STAGEB(PG8_SB(1, 0), b3); PG8_STAGEB(PG8_SB(1, 1), b3 + hstepB); PG8_STAGEA(PG8_SA(1, 0), a3, 0, last);
            PG8_WAIT_V(8); PG8_WAIT_L(0); PG8_BAR; PG8_MMA(1, 0, At, B0); PG8_MMA(1, 1, At, B1); PG8_BAR; PG8_SCHED;
        }
        if constexpr (ALIGN_EPI) { if (wr == 0) PG8_BAR; }
        { int fr2 = fr, fq2 = fq; asm volatile("" : "+v"(fr2), "+v"(fq2));
          E(acc, cur, wr, wc, fr2, fq2); }
        if (!has_next) break;
#pragma unroll
        for (int a = 0; a < 2; ++a)
#pragma unroll
            for (int b = 0; b < 2; ++b)
#pragma unroll
                for (int m = 0; m < 4; ++m)
#pragma unroll
                    for (int n = 0; n < 2; ++n) acc[a][b][m][n] = (f32x4){0.f, 0.f, 0.f, 0.f};
        cur = nxt; cA = nA; cB = nB; ++ui;
        if constexpr (GATHER) { gvc[0][0] = gvn[0][0]; gvc[0][1] = gvn[0][1]; gvc[1][0] = gvn[1][0]; gvc[1][1] = gvn[1][1]; }
        if constexpr (ALIGN_EPI) { if (wr == 1) PG8_BAR; }
    }
    PG8_WAIT_V(0);
    if constexpr (!ALIGN_EPI) { if (wr == 0) PG8_BAR; }
    PG8_BAR;
#undef PG8_SA
#undef PG8_SB
#undef PG8_STAGE2
#undef PG8_STAGEA
#undef PG8_STAGEB
#undef PG8_LDA
#undef PG8_LDB
#undef PG8_MMA
#undef PG8_WAIT_V
#undef PG8_WAIT_L
#undef PG8_BAR
#undef PG8_SCHED
#undef PG8_GATHER_OFFS
}

#define EPI_ROW(u, ai, m) ((u).orow + (ai) * HALF + wr * 64 + (m) * 16 + fr)
#define EPI_COL(u, bj) ((u).ocol + (bj) * HALF + wc * 32 + 8 * fq)
struct EpiBf16 {
    bf16_t* O; int ldc; const float* rs; size_t stride; float sc0, sc3;
    __device__ __forceinline__ void operator()(const f32x4 (&acc)[2][2][4][2], const Unit& u, int wr, int wc, int fr, int fq) const {
        bf16_t* base = O + (size_t)u.aux * stride;
        const float sc = (u.aux == 0) ? sc0 : ((u.aux == 3) ? sc3 : 1.f);
#pragma unroll
        for (int ai = 0; ai < 2; ++ai)
#pragma unroll
            for (int m = 0; m < 4; ++m) { const int row = EPI_ROW(u, ai, m); const float s = (rs ? rs[row] : 1.f) * sc;
#pragma unroll
                for (int bj = 0; bj < 2; ++bj) { const f32x4 v0 = acc[ai][bj][m][0] * s, v1 = acc[ai][bj][m][1] * s;
                    u32x4 w; w.x = cvt_pk_bf16(v0[0], v0[1]); w.y = cvt_pk_bf16(v0[2], v0[3]); w.z = cvt_pk_bf16(v1[0], v1[1]); w.w = cvt_pk_bf16(v1[2], v1[3]);
                    *(u32x4*)(base + (size_t)row * ldc + EPI_COL(u, bj)) = w; } }
    }
};
struct EpiResid {
    const float* res; float* out; bf16_t* hb; float* ssq;
    __device__ __forceinline__ void operator()(const f32x4 (&acc)[2][2][4][2], const Unit& u, int wr, int wc, int fr, int fq) const {
#pragma unroll
        for (int ai = 0; ai < 2; ++ai)
#pragma unroll
            for (int m = 0; m < 4; ++m) { const int row = EPI_ROW(u, ai, m); float q = 0.f;
#pragma unroll
                for (int bj = 0; bj < 2; ++bj) { const size_t off = (size_t)row * DM + EPI_COL(u, bj);
                    const f32x4 r0 = *(const f32x4*)(res + off), r1 = *(const f32x4*)(res + off + 4);
                    const f32x4 v0 = acc[ai][bj][m][0] + r0, v1 = acc[ai][bj][m][1] + r1;
                    *(f32x4*)(out + off) = v0; *(f32x4*)(out + off + 4) = v1;
                    q += (v0[0] * v0[0] + v0[1] * v0[1]) + (v0[2] * v0[2] + v0[3] * v0[3]) + (v1[0] * v1[0] + v1[1] * v1[1]) + (v1[2] * v1[2] + v1[3] * v1[3]);
                    if (hb) { u32x4 w; w.x = cvt_pk_bf16(v0[0], v0[1]); w.y = cvt_pk_bf16(v0[2], v0[3]); w.z = cvt_pk_bf16(v1[0], v1[1]); w.w = cvt_pk_bf16(v1[2], v1[3]); *(u32x4*)(hb + off) = w; } }
                if (ssq) { q += __shfl_xor(q, 16); q += __shfl_xor(q, 32); if (fq == 0) ssq[(size_t)row * 16 + (u.ocol >> 8) * 4 + wc] = q; } }
    }
};
struct EpiSoftmax {
    bf16_t* P; const float* ssq; LAS float* red;
    __device__ __forceinline__ void operator()(f32x4 (&acc)[2][2][4][2], const Unit& u, int wr, int wc, int fr, int fq) const {
#pragma unroll
        for (int ai = 0; ai < 2; ++ai)
#pragma unroll
            for (int m = 0; m < 4; ++m) { const int row = EPI_ROW(u, ai, m); const f32x4* sp = (const f32x4*)(ssq + (size_t)row * 16);
                const f32x4 s0 = sp[0], s1 = sp[1], s2 = sp[2], s3 = sp[3];
                const float tot = ((s0[0] + s0[1]) + (s0[2] + s0[3])) + ((s1[0] + s1[1]) + (s1[2] + s1[3])) + ((s2[0] + s2[1]) + (s2[2] + s2[3])) + ((s3[0] + s3[1]) + (s3[2] + s3[3]));
                const float r1 = rsqrtf(tot * (1.0f / DM) + EPS) * XSC; float a = -3.0e38f;
#pragma unroll
                for (int bj = 0; bj < 2; ++bj)
#pragma unroll
                    for (int n = 0; n < 2; ++n) { f32x4 v = acc[ai][bj][m][n] * r1; acc[ai][bj][m][n] = v; a = fmaxf(a, fmaxf(fmaxf(v[0], v[1]), fmaxf(v[2], v[3]))); }
                a = fmaxf(a, __shfl_xor(a, 16)); a = fmaxf(a, __shfl_xor(a, 32));
                if (fq == 0) red[(ai * HALF + wr * 64 + m * 16 + fr) * 4 + wc] = a; asm volatile("" ::: "memory"); }
        LDS_WAIT(); __builtin_amdgcn_s_barrier(); asm volatile("" ::: "memory");
#pragma unroll
        for (int ai = 0; ai < 2; ++ai)
#pragma unroll
            for (int m = 0; m < 4; ++m) { const int rl = ai * HALF + wr * 64 + m * 16 + fr; const f32x4 mm = *(const LAS f32x4*)(red + rl * 4);
                const float a = fmaxf(fmaxf(mm[0], mm[1]), fmaxf(mm[2], mm[3])); float s = 0.f;
#pragma unroll
                for (int bj = 0; bj < 2; ++bj)
#pragma unroll
                    for (int n = 0; n < 2; ++n) { f32x4 v = acc[ai][bj][m][n];
                        v[0] = __builtin_amdgcn_exp2f(v[0] - a); v[1] = __builtin_amdgcn_exp2f(v[1] - a); v[2] = __builtin_amdgcn_exp2f(v[2] - a); v[3] = __builtin_amdgcn_exp2f(v[3] - a);
                        acc[ai][bj][m][n] = v; s += (v[0] + v[1]) + (v[2] + v[3]); }
                s += __shfl_xor(s, 16); s += __shfl_xor(s, 32);
                if (fq == 0) red[1024 + rl * 4 + wc] = s; }
        LDS_WAIT(); __builtin_amdgcn_s_barrier(); asm volatile("" ::: "memory");
#pragma unroll
        for (int ai = 0; ai < 2; ++ai)
#pragma unroll
            for (int m = 0; m < 4; ++m) { const int rl = ai * HALF + wr * 64 + m * 16 + fr; const int row = u.orow + rl; const f32x4 ss = *(const LAS f32x4*)(red + 1024 + rl * 4);
                const float inv = 1.0f / ((ss[0] + ss[1]) + (ss[2] + ss[3]));
#pragma unroll
                for (int bj = 0; bj < 2; ++bj) { const f32x4 v0 = acc[ai][bj][m][0] * inv, v1 = acc[ai][bj][m][1] * inv;
                    u32x4 w; w.x = cvt_pk_bf16(v0[0], v0[1]); w.y = cvt_pk_bf16(v0[2], v0[3]); w.z = cvt_pk_bf16(v1[0], v1[1]); w.w = cvt_pk_bf16(v1[2], v1[3]);
                    *(u32x4*)(P + (size_t)row * DM + EPI_COL(u, bj)) = w; } }
    }
};
struct EpiSwiglu {
    bf16_t* Hd;
    __device__ __forceinline__ void operator()(const f32x4 (&acc)[2][2][4][2], const Unit& u, int wr, int wc, int fr, int fq) const {
#pragma unroll
        for (int ai = 0; ai < 2; ++ai)
#pragma unroll
            for (int m = 0; m < 4; ++m) { const int row = EPI_ROW(u, ai, m); float h[8];
#pragma unroll
                for (int n = 0; n < 2; ++n)
#pragma unroll
                    for (int e = 0; e < 4; ++e) { const float gt = acc[ai][0][m][n][e], up = acc[ai][1][m][n][e];
                        h[n * 4 + e] = gt * __builtin_amdgcn_rcpf(1.0f + __builtin_amdgcn_exp2f(-gt * LOG2E)) * up; }
                u32x4 w; w.x = cvt_pk_bf16(h[0], h[1]); w.y = cvt_pk_bf16(h[2], h[3]); w.z = cvt_pk_bf16(h[4], h[5]); w.w = cvt_pk_bf16(h[6], h[7]);
                *(u32x4*)(Hd + (size_t)row * DFF + u.ocol + wc * 32 + 8 * fq) = w; }
    }
};
}

namespace att {
constexpr int QB = 256, KVBLK = 64, PITCH = HW;
constexpr int SLOTB = 8192, LDS_K = 0, LDS_V = 2 * SLOTB, LDS_WS = 4 * SLOTB, LDS_OST = LDS_WS + NWAVES * 256, LDS_FLAG = LDS_OST + NWAVES * 4096, LDS_END = LDS_FLAG + 64;
static_assert(LDS_END <= RING_BYTES, "attention LDS");
__device__ __forceinline__ int crow(int r, int hi) { return (r & 3) + 8 * (r >> 2) + 4 * hi; }
__device__ __forceinline__ void glds16(const void* gsrc, unsigned lds_dst) { unsigned keep;
    asm volatile("s_mov_b32 %0, m0\n\ts_mov_b32 m0, %2\n\ts_nop 0\n\tglobal_load_lds_dwordx4 %1, off\n\ts_mov_b32 m0, %0" : "=&s"(keep) : "v"(gsrc), "s"(lds_dst) : "memory"); }
#define ATT_WAIT_BAR0() asm volatile("s_waitcnt vmcnt(0) lgkmcnt(0)\n\ts_barrier" ::: "memory")
#define MFMA32(a, b, c) __builtin_amdgcn_mfma_f32_32x32x16_bf16(a, b, c, 0, 0, 0)
__device__ __forceinline__ void qkt(f32x16& p0, f32x16& p1, const LAS char* Kslot, const bf16x8* qr, const f32x16& cin, int r32, int hi) {
    const LAS char* kb = Kslot + hi * 1024 + r32 * 16;
#pragma unroll
    for (int d0 = 0; d0 < 4; ++d0) {
        const bf16x8 b0 = *(const LAS bf16x8*)(kb + d0 * 2048);
        const bf16x8 b1 = *(const LAS bf16x8*)(kb + d0 * 2048 + 512);
        if (d0 == 0) { p0 = MFMA32(b0, qr[0], cin); p1 = MFMA32(b1, qr[0], cin); }
        else { p0 = MFMA32(b0, qr[d0], p0); p1 = MFMA32(b1, qr[d0], p1); } }
}
__device__ __forceinline__ void pv(f32x16* o, int vb, bf16x8 pa0, bf16x8 pa1, bf16x8 pa2, bf16x8 pa3) {
#pragma unroll
    for (int d0 = 0; d0 < 2; ++d0) { s16x4 lo[4], hi[4];
#pragma unroll
        for (int ks = 0; ks < 4; ++ks) {
            asm volatile("ds_read_b64_tr_b16 %0,%1 offset:%c2" : "=&v"(lo[ks]) : "v"(vb), "i"(d0 * 4096 + ks * 1024) : "memory");
            asm volatile("ds_read_b64_tr_b16 %0,%1 offset:%c2" : "=&v"(hi[ks]) : "v"(vb), "i"(d0 * 4096 + ks * 1024 + 512) : "memory"); }
        asm volatile("s_waitcnt lgkmcnt(0)" ::: "memory"); __builtin_amdgcn_sched_barrier(0);
#define PK(k) (bf16x8){lo[k][0], lo[k][1], lo[k][2], lo[k][3], hi[k][0], hi[k][1], hi[k][2], hi[k][3]}
        o[d0] = MFMA32(pa0, PK(0), o[d0]); o[d0] = MFMA32(pa1, PK(1), o[d0]); o[d0] = MFMA32(pa2, PK(2), o[d0]); o[d0] = MFMA32(pa3, PK(3), o[d0]);
#undef PK
    }
}
__device__ __forceinline__ float swap_lo(float x) { auto rr = __builtin_amdgcn_permlane32_swap(__float_as_uint(x), __float_as_uint(x), false, false); return __uint_as_float(rr[0]); }
__device__ __forceinline__ float swap_hi(float x) { auto rr = __builtin_amdgcn_permlane32_swap(__float_as_uint(x), __float_as_uint(x), false, false); return __uint_as_float(rr[1]); }

template <int MODE> __device__ __forceinline__ void attn_unit(int b, int h, int qb, const bf16_t* Q, const bf16_t* K, const bf16_t* V, bf16_t* O, const float* cb, LAS char* shm) {
    const int tid = threadIdx.x, lane = tid & 63, r32 = lane & 31, hi = lane >> 5; const int wid = __builtin_amdgcn_readfirstlane(tid >> 6);
    const long rowbase = (long)b * SEQ; const int q0 = qb * QB;
    const bf16_t* Qw = Q + (rowbase + q0 + wid * 32) * PITCH + h * HD;
    const bf16_t* Kh = K + rowbase * PITCH + h * HD; const bf16_t* Vh = V + rowbase * PITCH + h * HD;
    const unsigned lds0 = (unsigned)(uintptr_t)shm;
    LAS float* wsf = (LAS float*)(shm + LDS_WS) + wid * 64;
    LAS unsigned* flags = (LAS unsigned*)(shm + LDS_FLAG);
    const bf16_t* ksrc = Kh + (long)lane * PITCH + wid * 8;
    const bf16_t* vsrc = Vh + (long)(16 * (wid & 3) + (lane >> 2)) * PITCH + (wid >> 2) * 32 + (lane & 3) * 8;
    const unsigned kdst = lds0 + LDS_K + wid * 1024, vdst = lds0 + LDS_V + wid * 1024;
#define DMA_KV(t, slot) do { glds16(ksrc + (long)(t) * KVBLK * PITCH, (unsigned)__builtin_amdgcn_readfirstlane(kdst + (slot))); glds16(vsrc + (long)(t) * KVBLK * PITCH, (unsigned)__builtin_amdgcn_readfirstlane(vdst + (slot))); } while (0)
    const int vb0 = (int)(lds0 + LDS_V) + ((lane >> 4) & 1) * 32 + (lane & 3) * 8 + (4 * hi + ((lane & 15) >> 2)) * 64;
    const int NT = (q0 + QB) / KVBLK;
    DMA_KV(NT - 1, 0);
    bf16x8 qr[4];
#pragma unroll
    for (int d0 = 0; d0 < 4; ++d0) qr[d0] = *(const bf16x8*)(Qw + (long)r32 * PITCH + d0 * 16 + hi * 8);
    f32x16 o[2]; o[0] = f32x16{}; o[1] = f32x16{};
    const int qrel = wid * 32 + r32;
    float m_run = -1.0e30f, l_run = 0.f, R = 0.f, ct = 0.f;
    if (MODE == 0) ct = cb[q0 + qrel];
    bf16x8 TD0, TD1, TONE;
#pragma unroll
    for (int j = 0; j < 8; ++j) { const int kvl = 8 * (j >> 2) + 4 * hi + (j & 3); TD0[j] = (kvl >= r32) ? (short)0x3F80 : (short)0; TD1[j] = (16 + kvl >= r32) ? (short)0x3F80 : (short)0; TONE[j] = (short)0x3F80; }
    f32x16 zero16 = f32x16{};
    for (int i = 0; i < NT; ++i) {
        const int t = NT - 1 - i, slot = (i & 1) * SLOTB;
        ATT_WAIT_BAR0();
        if (MODE == 1 && i > 0) {
            const LAS unsigned* fl = flags + ((i - 1) & 1) * 8; unsigned all = 1u;
#pragma unroll
            for (int w = 0; w < 8; ++w) all &= fl[w];
            if (__builtin_amdgcn_readfirstlane(all)) break;
        }
        if (t > 0) DMA_KV(t - 1, slot ^ SLOTB);
        const int jb = t - (NT - 4);
        const bool active = !(jb >= 0 && 2 * jb > wid);
        bool wave_done = false;
        if (MODE == 1) wave_done = __all(R < SB_EXIT);
        if (active && !(MODE == 1 && wave_done)) {
            f32x16 p0, p1;
            qkt(p0, p1, shm + LDS_K + slot, qr, zero16, r32, hi);
            if (MODE == 0) {
                const float* cbt = cb + t * KVBLK + 4 * hi;
#pragma unroll
                for (int g = 0; g < 4; ++g) { const f32x4 c0 = *(const f32x4*)(cbt + 8 * g), c1 = *(const f32x4*)(cbt + 32 + 8 * g);
#pragma unroll
                    for (int e = 0; e < 4; ++e) { p0[4 * g + e] += ct - c0[e]; p1[4 * g + e] += ct - c1[e]; } }
                if (jb >= 0) {
#pragma unroll
                    for (int r = 0; r < 16; ++r) { const int kv = 64 * jb + crow(r, hi); if (kv > qrel) p0[r] = -1.0e30f; if (kv + 32 > qrel) p1[r] = -1.0e30f; } }
                float a = fmaxf(p0[0], p1[0]);
#pragma unroll
                for (int r = 1; r < 16; ++r) a = fmaxf(a, fmaxf(p0[r], p1[r]));
                a = fmaxf(swap_lo(a), swap_hi(a));
                const float m_new = fmaxf(m_run, a), alpha = __builtin_amdgcn_exp2f(m_run - m_new); m_run = m_new;
                float s = 0.f;
#pragma unroll
                for (int r = 0; r < 16; ++r) { p0[r] = __builtin_amdgcn_exp2f(p0[r] - m_new); p1[r] = __builtin_amdgcn_exp2f(p1[r] - m_new); s += p0[r] + p1[r]; }
                l_run = l_run * alpha + s;
                if (hi == 0) wsf[r32] = alpha;
                LDS_WAIT();
#pragma unroll
                for (int r = 0; r < 16; ++r) { const float f = wsf[crow(r, hi)]; o[0][r] *= f; o[1][r] *= f; }
                LDS_WAIT();
            } else {
                if (jb >= 0) {
#pragma unroll
                    for (int r = 0; r < 16; ++r) { const int kv = 64 * jb + crow(r, hi); if (kv >= qrel) p0[r] = -1.0e30f; if (kv + 32 >= qrel) p1[r] = -1.0e30f; } }
                f32x16 l0, l1;
#pragma unroll
                for (int r = 0; r < 16; ++r) {
                    l0[r] = -(fmaxf(p0[r], 0.f) + __builtin_amdgcn_logf(1.0f + __builtin_amdgcn_exp2f(-fabsf(p0[r]))));
                    l1[r] = -(fmaxf(p1[r], 0.f) + __builtin_amdgcn_logf(1.0f + __builtin_amdgcn_exp2f(-fabsf(p1[r])))); }
                u32x4 lw0 = {cvt_pk_bf16(l0[0], l0[1]), cvt_pk_bf16(l0[2], l0[3]), cvt_pk_bf16(l0[4], l0[5]), cvt_pk_bf16(l0[6], l0[7])};
                u32x4 lw1 = {cvt_pk_bf16(l0[8], l0[9]), cvt_pk_bf16(l0[10], l0[11]), cvt_pk_bf16(l0[12], l0[13]), cvt_pk_bf16(l0[14], l0[15])};
                u32x4 lw2 = {cvt_pk_bf16(l1[0], l1[1]), cvt_pk_bf16(l1[2], l1[3]), cvt_pk_bf16(l1[4], l1[5]), cvt_pk_bf16(l1[6], l1[7])};
                u32x4 lw3 = {cvt_pk_bf16(l1[8], l1[9]), cvt_pk_bf16(l1[10], l1[11]), cvt_pk_bf16(l1[12], l1[13]), cvt_pk_bf16(l1[14], l1[15])};
                f32x16 rt;
#pragma unroll
                for (int r = 0; r < 16; ++r) rt[r] = R;
                f32x16 t0 = MFMA32(TD0, __builtin_bit_cast(bf16x8, lw0), rt); t0 = MFMA32(TD1, __builtin_bit_cast(bf16x8, lw1), t0);
                t0 = MFMA32(TONE, __builtin_bit_cast(bf16x8, lw2), t0); t0 = MFMA32(TONE, __builtin_bit_cast(bf16x8, lw3), t0);
                f32x16 t1 = MFMA32(TD0, __builtin_bit_cast(bf16x8, lw2), rt); t1 = MFMA32(TD1, __builtin_bit_cast(bf16x8, lw3), t1);
#pragma unroll
                for (int r = 0; r < 16; ++r) { p0[r] = __builtin_amdgcn_exp2f(p0[r] + t0[r]); p1[r] = __builtin_amdgcn_exp2f(p1[r] + t1[r]); }
                R = swap_lo(t0[0]);
            }
            u32x4 pw0 = {cvt_pk_bf16(p0[0], p0[1]), cvt_pk_bf16(p0[2], p0[3]), cvt_pk_bf16(p0[4], p0[5]), cvt_pk_bf16(p0[6], p0[7])};
            u32x4 pw1 = {cvt_pk_bf16(p0[8], p0[9]), cvt_pk_bf16(p0[10], p0[11]), cvt_pk_bf16(p0[12], p0[13]), cvt_pk_bf16(p0[14], p0[15])};
            u32x4 pw2 = {cvt_pk_bf16(p1[0], p1[1]), cvt_pk_bf16(p1[2], p1[3]), cvt_pk_bf16(p1[4], p1[5]), cvt_pk_bf16(p1[6], p1[7])};
            u32x4 pw3 = {cvt_pk_bf16(p1[8], p1[9]), cvt_pk_bf16(p1[10], p1[11]), cvt_pk_bf16(p1[12], p1[13]), cvt_pk_bf16(p1[14], p1[15])};
            pv(o, vb0 + slot, __builtin_bit_cast(bf16x8, pw0), __builtin_bit_cast(bf16x8, pw1), __builtin_bit_cast(bf16x8, pw2), __builtin_bit_cast(bf16x8, pw3));
        }
        if (MODE == 1) { const bool dn = __all(R < SB_EXIT); if (lane == 0) flags[(i & 1) * 8 + wid] = dn ? 1u : 0u; }
    }
    float linv = 1.f;
    if (MODE == 0) { const float lt = swap_lo(l_run) + swap_hi(l_run); linv = 1.0f / lt; }
    if (hi == 0) wsf[32 + r32] = linv;
    LDS_WAIT();
    bf16_t* Ow = O + (rowbase + q0 + wid * 32) * PITCH + h * HD;
    { LAS bf16_t* stg = (LAS bf16_t*)(shm + LDS_OST) + wid * 2048;
#pragma unroll
      for (int r = 0; r < 16; ++r) { const int orow = crow(r, hi); const float f = wsf[32 + orow];
#pragma unroll
        for (int d0 = 0; d0 < 2; ++d0) { const unsigned pk = cvt_pk_bf16(o[d0][r] * f, 0.f); stg[orow * 64 + d0 * 32 + r32] = (bf16_t)(pk & 0xffffu); } }
      LDS_WAIT();
#pragma unroll
      for (int i = 0; i < 4; ++i) { const int row = i * 8 + (lane >> 3), ch = lane & 7; const u32x4 v = *(const LAS u32x4*)(stg + row * 64 + ch * 8); *(u32x4*)(Ow + (long)row * PITCH + ch * 8) = v; } }
    asm volatile("s_waitcnt vmcnt(0) lgkmcnt(0)\n\ts_barrier" ::: "memory");
#undef DMA_KV
}
}

#define XB_TMO      128
#define XB_XCNT(j)  (256  + 64 * (j))
#define XB_XSUB(j)  (1280 + 64 * (j))
#define XB_XGEN(j)  (2304 + 64 * (j))
#define XB_TOP      3328
#define XB_TOPGEN   3392
#define XCD_BAR_WORDS 3456
#define XB_SPIN_CAP (1u << 18)
__device__ __forceinline__ unsigned xb_ld(unsigned* p)              { return __hip_atomic_load(p, __ATOMIC_RELAXED, __HIP_MEMORY_SCOPE_AGENT); }
__device__ __forceinline__ unsigned xb_add(unsigned* p, unsigned v) { return __hip_atomic_fetch_add(p, v, __ATOMIC_RELAXED, __HIP_MEMORY_SCOPE_AGENT); }
__device__ __forceinline__ unsigned xb_xcc_id() { return (unsigned)__builtin_amdgcn_s_getreg((3 << 11) | 20) & 0xFu; }
#define XB_SPIN(cond, bar) do { unsigned _sp = 0; while (cond) { __builtin_amdgcn_s_sleep(1); \
    if ((++_sp & 255u) == 0u) { if (xb_ld(&(bar)[XB_TMO])) break; if (_sp > XB_SPIN_CAP) { atomicAdd(&(bar)[XB_TMO], 1u); break; } } } } while (0)
struct XcdBarrier { unsigned* bar; unsigned x; volatile LAS unsigned* st; };
__device__ __forceinline__ XcdBarrier xcd_barrier_post(unsigned* bar, volatile LAS unsigned* st) {
    XcdBarrier b; b.bar = bar; b.x = xb_xcc_id(); b.st = st;
    if (threadIdx.x == 0) (void)xb_add(&bar[XB_XCNT(b.x)], 1u);
    return b;
}
__device__ __forceinline__ void xcd_barrier_complete(unsigned* bar, unsigned x, unsigned& nloc, unsigned& nx) {
    const unsigned G = gridDim.x * gridDim.y * gridDim.z;
    unsigned sum, cnt, mine, sp = 0u;
    for (;;) {
        sum = 0u; cnt = 0u; mine = 0u;
#pragma unroll
        for (unsigned j = 0; j < 16; ++j) { const unsigned c = xb_ld(&bar[XB_XCNT(j)]); sum += c; cnt += (c > 0u) ? 1u : 0u; mine = (j == x) ? c : mine; }
        if (sum == G) break;
        __builtin_amdgcn_s_sleep(1);
        if ((++sp & 255u) == 0u) { if (xb_ld(&bar[XB_TMO])) break; if (sp > XB_SPIN_CAP) { atomicAdd(&bar[XB_TMO], 1u); break; } }
    }
    nloc = mine > 0u ? mine : 1u; nx = cnt > 0u ? cnt : 1u;
}
__device__ __forceinline__ void xcd_barrier(const XcdBarrier& b) {
    asm volatile("s_waitcnt vmcnt(0)" ::: "memory");
    __syncthreads();
    if (threadIdx.x == 0) {
        unsigned* bar = b.bar;
        __builtin_amdgcn_s_waitcnt(0);
        unsigned nloc = b.st[0], nx = b.st[1];
        if (nloc == 0u) { xcd_barrier_complete(bar, b.x, nloc, nx); b.st[0] = nloc; b.st[1] = nx; }
        const unsigned old = xb_add(&bar[XB_XSUB(b.x)], 1u);
        const unsigned gen = old / nloc;
        if (old + 1u == (gen + 1u) * nloc) {
            __builtin_amdgcn_fence(__ATOMIC_RELEASE, "agent");
            asm volatile("s_waitcnt vmcnt(0)" ::: "memory");
            const unsigned og = xb_add(&bar[XB_TOP], 1u);
            const unsigned tg = og / nx;
            if (og + 1u == (tg + 1u) * nx) xb_add(&bar[XB_TOPGEN], 1u);
            else XB_SPIN(xb_ld(&bar[XB_TOPGEN]) == tg, bar);
            __builtin_amdgcn_fence(__ATOMIC_ACQUIRE, "agent");
            xb_add(&bar[XB_XGEN(b.x)], 1u);
            asm volatile("s_waitcnt vmcnt(0)" ::: "memory");
        } else {
            XB_SPIN(xb_ld(&bar[XB_XGEN(b.x)]) == gen, bar);
            __builtin_amdgcn_fence(__ATOMIC_ACQUIRE, "agent");
            asm volatile("s_waitcnt vmcnt(0)" ::: "memory");
        }
    }
    __syncthreads();
}

__device__ __forceinline__ const void* ldp(const volatile LAS unsigned* tab, int i) {
    const unsigned lo = __builtin_amdgcn_readfirstlane(tab[2 * i]), hi = __builtin_amdgcn_readfirstlane(tab[2 * i + 1]);
    return (const void*)(((unsigned long long)hi << 32) | lo);
}
struct Args {
    const float* x; const float* mem; const float* norm_mix; const float* w_in; const float* b_forget; const float* norm_fox; const float* norm_sb; const float* w_out;
    const float* norm_xattn; const float* norm_mem; const float* w_xq; const float* w_xkv; const float* w_xo; const float* norm_ffn;
    const float* w_rg; const float* b_rg; const float* w_re; const float* b_re; const float* w_gate; const float* w_up; const float* w_down; const float* norm_final;
    float* out; unsigned char* ws;
};

__device__ __forceinline__ void transpose_item(const float* W, int ldw, bf16_t* WT, int ldo, int k0, int n0, int dst_row0, const float* gain, LAS float* scr, int lane) {
#pragma unroll 8
    for (int i = 0; i < 32; ++i) { const int kk = 2 * i + (lane >> 5); float v = W[(size_t)(k0 + kk) * ldw + n0 + (lane & 31)]; if (gain) v *= gain[k0 + kk]; scr[kk * 33 + (lane & 31)] = v; }
    LDS_WAIT(); asm volatile("" ::: "memory");
    const int c = lane & 7;
#pragma unroll
    for (int j = 0; j < 4; ++j) { const int n = (lane >> 3) + 8 * j; const LAS float* s = scr + (8 * c) * 33 + n;
        u32x4 o; o.x = cvt_pk_bf16(s[0 * 33], s[1 * 33]); o.y = cvt_pk_bf16(s[2 * 33], s[3 * 33]); o.z = cvt_pk_bf16(s[4 * 33], s[5 * 33]); o.w = cvt_pk_bf16(s[6 * 33], s[7 * 33]);
        *(u32x4*)(WT + (size_t)(dst_row0 + n) * ldo + k0 + 8 * c) = o; }
    LDS_WAIT(); asm volatile("" ::: "memory");
}

struct SchedDense {
    const char* A; const char* Bt; int nM, nN, G, c; size_t a_tile, b_tile, b_batch; int split_tiles;
    __device__ __forceinline__ bool next(int i, pg8::Unit& u) const {
        int pm, pn; if (!pg8::tile_order(i, G, c, nM, nN, pm, pn)) return false;
        u.a = A + (size_t)pm * a_tile; u.b = Bt + (size_t)pn * b_tile + (size_t)(pm >> 5) * b_batch; u.orow = pm * 256;
        if (split_tiles) { u.aux = pn / split_tiles; u.ocol = (pn % split_tiles) * 256; } else { u.aux = 1; u.ocol = pn * 256; }
        u.rows = nullptr; u.nvalid = 256; return true;
    }
};
struct SchedGH {
    const char* KVm; const char* Wxq; const char* Wxo; int G, c;
    __device__ __forceinline__ bool next(int i, pg8::Unit& u) const {
        const int L = i * G + c; if (L >= 256) return false;
        const int kind = L >> 7, r = L & 127, bh = r >> 2, j = r & 3, b = bh >> 2, h = bh & 3;
        if (kind == 0) { u.a = KVm + ((size_t)(b * 256) * 2048 + h * 256) * 2; u.b = Wxq + ((size_t)(256 * j) * 1024 + h * 256) * 2; u.orow = b * 1024 + h * 256; u.ocol = 256 * j; u.aux = 1; }
        else { u.a = Wxo + ((size_t)(256 * j) * 1024 + h * 256) * 2; u.b = KVm + ((size_t)(b * 256) * 2048 + 1024 + h * 256) * 2; u.orow = b * 1024 + 256 * j; u.ocol = h * 256; u.aux = 2; }
        u.rows = nullptr; u.nvalid = 256; return true;
    }
};
template <int KIND> struct SchedGHk { SchedGH s; __device__ __forceinline__ bool next(int i, pg8::Unit& u) const { const int L = i * s.G + s.c; if (L >= 128) return false; SchedGH t = s; t.G = 1; t.c = 0; return t.next(128 * KIND + L, u); } };
struct EpiGH { bf16_t* GTp; bf16_t* HTp; __device__ __forceinline__ void operator()(const f32x4 (&acc)[2][2][4][2], const pg8::Unit& u, int wr, int wc, int fr, int fq) const {
    pg8::EpiBf16 e{u.aux == 1 ? GTp : HTp, DM, nullptr, 0, 1.f, 1.f}; pg8::Unit v = u; v.aux = 1; e(acc, v, wr, wc, fr, fq); } };
struct SchedMoe {
    const char* A; const char* W; const int* list; const LAS int* tbl; int G, c, NPN; size_t w_exp, w_tile, a_tile; int ocol_w;
    __device__ __forceinline__ bool next(int i, pg8::Unit& u) const {
        const int L = i * G + c; const int tl = L / NPN, pn = L % NPN;
        if (tl >= __builtin_amdgcn_readfirstlane(tbl[16])) return false;
        int e = 0;
#pragma unroll 1
        for (int x = 1; x < NEXP; ++x) { if (tl >= __builtin_amdgcn_readfirstlane(tbl[x])) e = x; }
        const int j = tl - __builtin_amdgcn_readfirstlane(tbl[e]), n = __builtin_amdgcn_readfirstlane(tbl[32 + e]) - 256 * j;
        u.a = A + (size_t)tl * a_tile; u.b = W + (size_t)e * w_exp + (size_t)pn * w_tile; u.orow = tl * 256; u.ocol = pn * ocol_w; u.aux = 1;
        u.rows = list + (size_t)e * M + 256 * j; u.nvalid = n < 256 ? n : 256; return true;
    }
};
__device__ __forceinline__ void moe_table(LAS int* tbl, const unsigned* ctl) {
    if (threadIdx.x == 0) { int base = 0; for (int e = 0; e < NEXP; ++e) { const int n = (int)ctl[CW_CNT + 64 * e]; tbl[e] = base; tbl[32 + e] = n; base += (n + 255) >> 8; } tbl[16] = base; }
    __syncthreads();
}

__global__ void __launch_bounds__(NWAVES * 64, 2) hymba_fwd(Args args) {
    extern __shared__ __attribute__((aligned(16))) unsigned char lds_raw[];
    LAS unsigned char* lds = (LAS unsigned char*)lds_raw;
    volatile LAS unsigned* MISC = (volatile LAS unsigned*)(lds + MISC_OFF);
    const int tid = threadIdx.x, lane = tid & 63, wave = __builtin_amdgcn_readfirstlane(tid >> 6);
    const int G = gridDim.x; const int bx = blockIdx.x; const int vcu = (G % 8 == 0) ? (bx % 8) * (G / 8) + bx / 8 : bx;
    volatile LAS unsigned* ATAB = (volatile LAS unsigned*)(lds + MISC_OFF + 512);
    for (int u = tid; u < 256; u += NWAVES * 64) ((LAS unsigned*)(lds + MISC_OFF))[u] = 0u;
    __syncthreads();
    if (tid == 0) { const float* const* ap = (const float* const*)&args;
#pragma unroll
        for (int i = 0; i < 24; ++i) { const unsigned long long v = (unsigned long long)ap[i]; ATAB[2 * i] = (unsigned)v; ATAB[2 * i + 1] = (unsigned)(v >> 32); } }
    __syncthreads();
#define ARGP(name) ((const float*)ldp(ATAB, (int)(offsetof(Args, name) / 8)))
#define PHASE_PTRS \
    unsigned char* const ws = (unsigned char*)ldp(ATAB, 23); float* const out = (float*)ldp(ATAB, 22); unsigned* const ctl = (unsigned*)(ws + WS_CTL); (void)out; (void)ctl; \
    bf16_t* const Win_t = (bf16_t*)(ws + WS_WIN); bf16_t* const Wout_t = (bf16_t*)(ws + WS_WOUT); bf16_t* const Wxq_n = (bf16_t*)(ws + WS_WXQ); bf16_t* const Wxkv_t = (bf16_t*)(ws + WS_WXKV); \
    bf16_t* const Wxo_t = (bf16_t*)(ws + WS_WXO); bf16_t* const Wgu_t = (bf16_t*)(ws + WS_WGU); bf16_t* const Wd_t = (bf16_t*)(ws + WS_WD); \
    float* const RX = (float*)(ws + WS_RX); float* const RMEM = (float*)(ws + WS_RMEM); float* const LF = (float*)(ws + WS_LF); float* const CC = (float*)(ws + WS_C2); float* const SSQ = (float*)(ws + WS_SSQ); \
    int* const TOKSLOT = (int*)(ws + WS_TOKSLOT); float* const TOKW = (float*)(ws + WS_TOKW); int* const LIST = (int*)(ws + WS_LIST); \
    bf16_t* const MEMB = (bf16_t*)(ws + WS_MEMB); bf16_t* const KVM = (bf16_t*)(ws + WS_KVM); bf16_t* const GT = (bf16_t*)(ws + WS_GT); bf16_t* const HT = (bf16_t*)(ws + WS_HT); \
    bf16_t* const XB = (bf16_t*)(ws + WS_XB); bf16_t* const QKV = (bf16_t*)(ws + WS_QKV); bf16_t* const H1B = (bf16_t*)(ws + WS_H1B); bf16_t* const U2B = (bf16_t*)(ws + WS_U2B); bf16_t* const HID = (bf16_t*)(ws + WS_HID); \
    bf16_t* const OAB = (bf16_t*)(ws + WS_O); bf16_t* const YB = (bf16_t*)(ws + WS_Y); \
    (void)Win_t; (void)Wout_t; (void)Wxq_n; (void)Wxkv_t; (void)Wxo_t; (void)Wgu_t; (void)Wd_t; (void)RX; (void)RMEM; (void)LF; (void)CC; (void)SSQ; (void)TOKSLOT; (void)TOKW; (void)LIST; \
    (void)MEMB; (void)KVM; (void)GT; (void)HT; (void)XB; (void)QKV; (void)H1B; (void)U2B; (void)HID; (void)OAB; (void)YB;
    XcdBarrier bar;
    { unsigned char* const ws0 = (unsigned char*)ldp(ATAB, 23); bar = xcd_barrier_post((unsigned*)(ws0 + WS_CTL) + CW_BAR, MISC + 8); }
    const int gw = vcu * NWAVES + wave, NGW = G * NWAVES;


    if (PH(0))
    {
        PHASE_PTRS
        LAS float* wfT = (LAS float*)(lds + RING_OFF);
        LAS float* scr = (LAS float*)(lds + RING_OFF + 32768 + wave * 8448);
        for (int idx = tid; idx < 8 * DM; idx += NWAVES * 64) { const int j = idx >> 10, k = idx & 1023; wfT[idx] = ARGP(w_in)[(size_t)k * WIN_LD + NPROJ + j] * ARGP(norm_mix)[k]; }
        constexpr int I_IN = 16 * 96, I_OUT = 16 * 32, I_XKV = 16 * 64, I_XO = 16 * 32, I_G = 16 * 16 * 8, I_U = I_G, I_D = 16 * 4 * 32, I_XQ = 1024;
        constexpr int NITEMS = I_IN + I_OUT + I_XKV + I_XO + I_G + I_U + I_D + I_XQ;
        for (int it = gw; it < NITEMS; it += NGW) {
            int r = it;
            if (r < I_IN) { const int kb = r / 96, nb = r % 96; transpose_item(ARGP(w_in), WIN_LD, Win_t, DM, 64 * kb, 32 * nb, 32 * nb, ARGP(norm_mix), scr, lane); continue; } r -= I_IN;
            if (r < I_OUT) { const int kb = r / 32, nb = r % 32; const float* gn = (64 * kb < HW) ? ARGP(norm_fox) : (ARGP(norm_sb) - HW); transpose_item(ARGP(w_out), DM, Wout_t, DM, 64 * kb, 32 * nb, 32 * nb, gn, scr, lane); continue; } r -= I_OUT;
            if (r < I_XKV) { const int kb = r / 64, nb = r % 64; transpose_item(ARGP(w_xkv), 2 * DM, Wxkv_t, DM, 64 * kb, 32 * nb, 32 * nb, ARGP(norm_mem), scr, lane); continue; } r -= I_XKV;
            if (r < I_XO) { const int kb = r / 32, nb = r % 32; transpose_item(ARGP(w_xo), DM, Wxo_t, DM, 64 * kb, 32 * nb, 32 * nb, nullptr, scr, lane); continue; } r -= I_XO;
            if (r < I_G + I_U) { const int up = r >= I_G; const int q = up ? r - I_G : r; const int e = q / 128, kb = (q % 128) / 8, nb = q % 8; const int n0 = 32 * nb;
                const float* W = (up ? ARGP(w_up) : ARGP(w_gate)) + (size_t)e * DM * DFF;
                transpose_item(W, DFF, Wgu_t + (size_t)e * 512 * DM, DM, 64 * kb, n0, 256 * (n0 / 128) + (n0 % 128) + (up ? 128 : 0), nullptr, scr, lane); continue; } r -= I_G + I_U;
            if (r < I_D) { const int e = r / 128, kb = (r % 128) / 32, nb = r % 32; transpose_item(ARGP(w_down) + (size_t)e * DFF * DM, DM, Wd_t + (size_t)e * DM * DFF, DFF, 64 * kb, 32 * nb, 32 * nb, nullptr, scr, lane); continue; } r -= I_D;
            { const int k = r; const float gk = ARGP(norm_xattn)[k]; const f32x4* src = (const f32x4*)(ARGP(w_xq) + (size_t)k * DM) + lane; u32x2* dst = (u32x2*)(Wxq_n + (size_t)k * DM) + lane;
#pragma unroll
              for (int j = 0; j < 4; ++j) { const f32x4 v = src[64 * j] * gk; u32x2 w; w.x = cvt_pk_bf16(v[0], v[1]); w.y = cvt_pk_bf16(v[2], v[3]); dst[64 * j] = w; } }
        }
        __syncthreads();
        for (int row = gw; row < M + MEMROWS; row += NGW) {
            const bool is_mem = row >= M; const int r = is_mem ? row - M : row;
            const f32x4* xr = (const f32x4*)((is_mem ? ARGP(mem) : ARGP(x)) + (size_t)r * DM) + lane;
            f32x4 v[4]; float s = 0.f;
#pragma unroll
            for (int j = 0; j < 4; ++j) { v[j] = xr[64 * j]; s += (v[j][0] * v[j][0] + v[j][1] * v[j][1]) + (v[j][2] * v[j][2] + v[j][3] * v[j][3]); }
            const float rinv = rsqrtf(wave_sum(s) * (1.0f / DM) + EPS);
            u32x2* o8 = (u32x2*)((is_mem ? MEMB : XB) + (size_t)r * DM) + lane;
#pragma unroll
            for (int j = 0; j < 4; ++j) { u32x2 w; w.x = cvt_pk_bf16(v[j][0], v[j][1]); w.y = cvt_pk_bf16(v[j][2], v[j][3]); o8[64 * j] = w; }
            if (is_mem) { if (lane == 0) RMEM[r] = rinv; continue; }
            float f[8];
#pragma unroll
            for (int jj = 0; jj < 8; ++jj) { float a = 0.f;
#pragma unroll
                for (int j = 0; j < 4; ++j) { const f32x4 w4 = *(const LAS f32x4*)(wfT + jj * DM + 256 * j + 4 * lane); a += (v[j][0] * w4[0] + v[j][1] * w4[1]) + (v[j][2] * w4[2] + v[j][3] * w4[3]); }
                f[jj] = wave_sum(a); }
            if (lane == 0) RX[r] = rinv;
            if (lane < 8) { float fl = 0.f;
#pragma unroll
                for (int jj = 0; jj < 8; ++jj) fl = (lane == jj) ? f[jj] : fl;
                fl = fl * rinv + ARGP(b_forget)[lane];
                const float ls = fminf(fl, 0.f) - log1pf(expf(-fabsf(fl)));
                LF[(size_t)r * 8 + lane] = ls * LOG2E; }
        }
    }
    xcd_barrier(bar);

    if (PH(1))
    if (vcu < BATCH) {
        PHASE_PTRS
        const int b = vcu, h = wave; float carry = 0.f;
        const float* src = LF + (size_t)b * SEQ * 8 + h; float* dst = CC + ((size_t)b * NH + h) * SEQ;
        for (int i0 = 0; i0 < SEQ; i0 += 256) {
            float v[4];
#pragma unroll
            for (int k = 0; k < 4; ++k) v[k] = src[(size_t)(i0 + 64 * k + lane) * 8];
#pragma unroll
            for (int k = 0; k < 4; ++k) { float x = v[k];
#pragma unroll
                for (int o = 1; o < 64; o <<= 1) { const float y = __shfl_up(x, o); if (lane >= o) x += y; }
                x += carry; dst[i0 + 64 * k + lane] = x; carry = __shfl(x, 63); }
        }
    }
    if (PH(1))
    {
        PHASE_PTRS
        pg8::Gemm g{DM, DM, DM};
        SchedDense S{(const char*)XB, (const char*)Win_t, M / 256, NPROJ / 256, G, bx, (size_t)256 * DM * 2, (size_t)256 * DM * 2, 0, 2};
        pg8::EpiBf16 E{QKV, HW, RX, QKV_STRIDE, C2, C2};
        pg8::gemm_phase<pg8::EpiBf16, SchedDense, true, false>(lds + RING_OFF, g, S, E);
        SchedDense S2{(const char*)MEMB, (const char*)Wxkv_t, MEMROWS / 256, 2 * DM / 256, G, bx, (size_t)256 * DM * 2, (size_t)256 * DM * 2, 0, 0};
        pg8::EpiBf16 E2{KVM, 2 * DM, RMEM, 0, 1.f, 1.f};
        pg8::gemm_phase<pg8::EpiBf16, SchedDense, true, false>(lds + RING_OFF, g, S2, E2);
    }
    xcd_barrier(bar);

    if (PH(2))
    {
        PHASE_PTRS
        const bf16_t* QA = QKV; const bf16_t* KA = QKV + QKV_STRIDE; const bf16_t* VA = QKV + 2 * QKV_STRIDE;
        const bf16_t* QBp = QKV + 3 * QKV_STRIDE; const bf16_t* KBp = QKV + 4 * QKV_STRIDE; const bf16_t* VBp = QKV + 5 * QKV_STRIDE;
        bf16_t* OA = OAB; bf16_t* OB = OAB + QKV_STRIDE;
        LAS char* shm = (LAS char*)(lds + RING_OFF);
        for (int i = 0; i < 8; ++i) { const int s = vcu & 7, bh = (vcu >> 3) + 32 * (i >> 2), k = i & 3; const int qb = (k == 0) ? s : (k == 1) ? 15 - s : (k == 2) ? 16 + s : 31 - s;
            att::attn_unit<0>(bh >> 3, bh & 7, qb, QA, KA, VA, OA, CC + (size_t)bh * SEQ, shm); }
        for (int i = 0; i < 8; ++i) { const int bh = vcu >> 2, qb = 8 * (vcu & 3) + i;
            att::attn_unit<1>(bh >> 3, bh & 7, qb, QBp, KBp, VBp, OB, nullptr, shm); }
    }
    xcd_barrier(bar);

    if (PH(3))
    {
        PHASE_PTRS
        const bf16_t* OA = OAB; const bf16_t* OB = OAB + QKV_STRIDE; bf16_t* MIX = XB;
        for (int row = gw; row < M; row += NGW) {
            const u32x4 a = *((const u32x4*)(OA + (size_t)row * HW) + lane), b = *((const u32x4*)(OB + (size_t)row * HW) + lane);
            float fa[8] = {bf16lo(a.x), bf16hi(a.x), bf16lo(a.y), bf16hi(a.y), bf16lo(a.z), bf16hi(a.z), bf16lo(a.w), bf16hi(a.w)};
            float fb[8] = {bf16lo(b.x), bf16hi(b.x), bf16lo(b.y), bf16hi(b.y), bf16lo(b.z), bf16hi(b.z), bf16lo(b.w), bf16hi(b.w)};
            float sa = 0.f, sb = 0.f;
#pragma unroll
            for (int j = 0; j < 8; ++j) { sa += fa[j] * fa[j]; sb += fb[j] * fb[j]; }
            const float ra = rsqrtf(wave_sum(sa) * (1.0f / HW) + EPS), rb = rsqrtf(wave_sum(sb) * (1.0f / HW) + EPS);
            u32x4 wa, wb;
            wa.x = cvt_pk_bf16(fa[0] * ra, fa[1] * ra); wa.y = cvt_pk_bf16(fa[2] * ra, fa[3] * ra); wa.z = cvt_pk_bf16(fa[4] * ra, fa[5] * ra); wa.w = cvt_pk_bf16(fa[6] * ra, fa[7] * ra);
            wb.x = cvt_pk_bf16(fb[0] * rb, fb[1] * rb); wb.y = cvt_pk_bf16(fb[2] * rb, fb[3] * rb); wb.z = cvt_pk_bf16(fb[4] * rb, fb[5] * rb); wb.w = cvt_pk_bf16(fb[6] * rb, fb[7] * rb);
            *((u32x4*)(MIX + (size_t)row * DM) + lane) = wa; *((u32x4*)(MIX + (size_t)row * DM + HW) + lane) = wb;
        }
        __syncthreads();
        pg8::Gemm g{0, 0, 256};
        SchedGH S{(const char*)KVM, (const char*)Wxq_n, (const char*)Wxo_t, G, bx};
        EpiGH E{GT, HT};
        g.lda = 2 * DM; g.ldb = DM; SchedGHk<0> S0{S}; pg8::gemm_phase<EpiGH, SchedGHk<0>, true, false>(lds + RING_OFF, g, S0, E);
        g.lda = DM; g.ldb = 2 * DM; SchedGHk<1> S1{S}; pg8::gemm_phase<EpiGH, SchedGHk<1>, true, false>(lds + RING_OFF, g, S1, E);
    }
    xcd_barrier(bar);

    if (PH(4))
    {
        PHASE_PTRS
        pg8::Gemm g{DM, DM, DM};
        SchedDense S{(const char*)XB, (const char*)Wout_t, M / 256, DM / 256, G, bx, (size_t)256 * DM * 2, (size_t)256 * DM * 2, 0, 0};
        pg8::EpiResid E{ARGP(x), out, H1B, SSQ};
        pg8::gemm_phase<pg8::EpiResid, SchedDense, true, false>(lds + RING_OFF, g, S, E);
    }
    xcd_barrier(bar);

    if (PH(5))
    {
        PHASE_PTRS
        pg8::Gemm g{DM, DM, DM};
        SchedDense S{(const char*)H1B, (const char*)GT, M / 256, DM / 256, G, bx, (size_t)256 * DM * 2, (size_t)256 * DM * 2, (size_t)DM * DM * 2, 0};
        pg8::EpiSoftmax E{XB, SSQ, (LAS float*)(lds + EXTRA_OFF)};
        pg8::gemm_phase<pg8::EpiSoftmax, SchedDense, true, false>(lds + RING_OFF, g, S, E);
    }
    xcd_barrier(bar);

    if (PH(6))
    {
        PHASE_PTRS
        pg8::Gemm g{DM, DM, DM};
        SchedDense S{(const char*)XB, (const char*)HT, M / 256, DM / 256, G, bx, (size_t)256 * DM * 2, (size_t)256 * DM * 2, (size_t)DM * DM * 2, 0};
        pg8::EpiResid E{out, out, nullptr, nullptr};
        pg8::gemm_phase<pg8::EpiResid, SchedDense, true, false>(lds + RING_OFF, g, S, E);
    }
    xcd_barrier(bar);

    if (PH(7))
    {
        PHASE_PTRS
        LAS float* wT = (LAS float*)(lds + RING_OFF);
        for (int idx = tid; idx < 20 * DM; idx += NWAVES * 64) { const int j = idx >> 10, k = idx & 1023; wT[idx] = (j < 4) ? ARGP(w_rg)[(size_t)k * 4 + j] : ARGP(w_re)[(size_t)k * 16 + (j - 4)]; }
        __syncthreads();
        for (int row = gw; row < M; row += NGW) {
            const f32x4* hr = (const f32x4*)(out + (size_t)row * DM) + lane; const f32x4* gp = (const f32x4*)ARGP(norm_ffn) + lane;
            f32x4 v[4]; float s = 0.f;
#pragma unroll
            for (int j = 0; j < 4; ++j) { v[j] = hr[64 * j]; s += (v[j][0] * v[j][0] + v[j][1] * v[j][1]) + (v[j][2] * v[j][2] + v[j][3] * v[j][3]); }
            const float rinv = rsqrtf(wave_sum(s) * (1.0f / DM) + EPS);
            u32x2* o8 = (u32x2*)(U2B + (size_t)row * DM) + lane;
#pragma unroll
            for (int j = 0; j < 4; ++j) { v[j] = v[j] * rinv * gp[64 * j]; u32x2 w; w.x = cvt_pk_bf16(v[j][0], v[j][1]); w.y = cvt_pk_bf16(v[j][2], v[j][3]); o8[64 * j] = w; }
            float lg[20];
#pragma unroll
            for (int jj = 0; jj < 20; ++jj) { float a = 0.f;
#pragma unroll
                for (int j = 0; j < 4; ++j) { const f32x4 w4 = *(const LAS f32x4*)(wT + jj * DM + 256 * j + 4 * lane); a += (v[j][0] * w4[0] + v[j][1] * w4[1]) + (v[j][2] * w4[2] + v[j][3] * w4[3]); }
                lg[jj] = wave_sum(a); asm volatile("" : "+v"(lg[jj]) :: "memory"); }
            float g0 = lg[0] + ARGP(b_rg)[0], g1 = lg[1] + ARGP(b_rg)[1], g2 = lg[2] + ARGP(b_rg)[2], g3 = lg[3] + ARGP(b_rg)[3];
            int gi = 0; float gm = g0; if (g1 > gm) { gm = g1; gi = 1; } if (g2 > gm) { gm = g2; gi = 2; } if (g3 > gm) { gm = g3; gi = 3; }
            const float gval = 1.0f / (expf(g0 - gm) + expf(g1 - gm) + expf(g2 - gm) + expf(g3 - gm));
            float el[4];
#pragma unroll
            for (int j = 0; j < 4; ++j) { const float e0 = lg[4 + j], e1 = lg[8 + j], e2 = lg[12 + j], e3 = lg[16 + j]; el[j] = ((gi == 0) ? e0 : (gi == 1) ? e1 : (gi == 2) ? e2 : e3) + ARGP(b_re)[gi * 4 + j]; }
            int i0 = 0; float m0 = el[0];
#pragma unroll
            for (int j = 1; j < 4; ++j) if (el[j] > m0) { m0 = el[j]; i0 = j; }
            int i1 = -1; float m1 = -3.0e38f;
#pragma unroll
            for (int j = 0; j < 4; ++j) if (j != i0 && el[j] > m1) { m1 = el[j]; i1 = j; }
            const float w0 = 1.0f / (1.0f + expf(m1 - m0)), w1 = 1.0f - w0;
            if (lane < 2) { const int e = gi * 4 + (lane == 0 ? i0 : i1); const float w = gval * (lane == 0 ? w0 : w1);
                const int pos = (int)__hip_atomic_fetch_add(ctl + CW_CNT + 64 * e, 1u, __ATOMIC_RELAXED, __HIP_MEMORY_SCOPE_AGENT);
                LIST[(size_t)e * M + pos] = row; TOKSLOT[(size_t)row * 2 + lane] = (e << 20) | pos; TOKW[(size_t)row * 2 + lane] = w; }
        }
    }
    xcd_barrier(bar);

    if (PH(8))
    {
        PHASE_PTRS
        pg8::Gemm g{DM, DM, DM};
        LAS int* tbl = (LAS int*)(lds + EXTRA_OFF + 8192); moe_table(tbl, ctl);
        SchedMoe S; S.A = (const char*)U2B; S.W = (const char*)Wgu_t; S.list = LIST; S.tbl = tbl; S.G = G; S.c = bx; S.NPN = 2; S.w_exp = (size_t)512 * DM * 2; S.w_tile = (size_t)256 * DM * 2; S.a_tile = 0; S.ocol_w = 128;
        pg8::EpiSwiglu E{HID};
        pg8::gemm_phase<pg8::EpiSwiglu, SchedMoe, true, true>(lds + RING_OFF, g, S, E);
    }
    xcd_barrier(bar);

    if (PH(9))
    {
        PHASE_PTRS
        pg8::Gemm g{DFF, DFF, DFF};
        LAS int* tbl = (LAS int*)(lds + EXTRA_OFF + 8192);
        SchedMoe S; S.A = (const char*)HID; S.W = (const char*)Wd_t; S.list = LIST; S.tbl = tbl; S.G = G; S.c = bx; S.NPN = 4; S.w_exp = (size_t)DM * DFF * 2; S.w_tile = (size_t)256 * DFF * 2; S.a_tile = (size_t)256 * DFF * 2; S.ocol_w = 256;
        pg8::EpiBf16 E{YB, DM, nullptr, 0, 1.f, 1.f};
        pg8::gemm_phase<pg8::EpiBf16, SchedMoe, true, false>(lds + RING_OFF, g, S, E);
    }
    xcd_barrier(bar);

    if (PH(10))
    {
        PHASE_PTRS
        const LAS int* tb = (const LAS int*)(lds + EXTRA_OFF + 8192);
        for (int row = gw; row < M; row += NGW) {
            const int s0 = TOKSLOT[(size_t)row * 2], s1 = TOKSLOT[(size_t)row * 2 + 1]; const float w0 = TOKW[(size_t)row * 2], w1 = TOKW[(size_t)row * 2 + 1];
            const int r0 = tb[s0 >> 20] * 256 + (s0 & 0xfffff), r1 = tb[s1 >> 20] * 256 + (s1 & 0xfffff);
            f32x4* hr = (f32x4*)(out + (size_t)row * DM) + lane; const u32x2* y0 = (const u32x2*)(YB + (size_t)r0 * DM) + lane; const u32x2* y1 = (const u32x2*)(YB + (size_t)r1 * DM) + lane;
            const f32x4* gp = (const f32x4*)ARGP(norm_final) + lane;
            f32x4 v[4]; float s = 0.f;
#pragma unroll
            for (int j = 0; j < 4; ++j) { const u32x2 a = y0[64 * j], b = y1[64 * j]; f32x4 h = hr[64 * j];
                h[0] += w0 * bf16lo(a.x) + w1 * bf16lo(b.x); h[1] += w0 * bf16hi(a.x) + w1 * bf16hi(b.x); h[2] += w0 * bf16lo(a.y) + w1 * bf16lo(b.y); h[3] += w0 * bf16hi(a.y) + w1 * bf16hi(b.y);
                v[j] = h; s += (h[0] * h[0] + h[1] * h[1]) + (h[2] * h[2] + h[3] * h[3]); }
            const float rinv = rsqrtf(wave_sum(s) * (1.0f / DM) + EPS);
#pragma unroll
            for (int j = 0; j < 4; ++j) hr[64 * j] = v[j] * rinv * gp[64 * j];
        }
    }
}

extern "C" void kernel_launch(void* const* d_in, const int* in_sizes, int n_in, void* d_out, int out_size, void* d_ws, size_t ws_size, hipStream_t stream) {
    static int grid = 0;
    if (grid == 0) {
        if (n_in != 22 || in_sizes[0] != M * DM || out_size != M * DM || ws_size < WS_END) { fprintf(stderr, "kernel_launch: unexpected shapes (n_in %d, in0 %d, out %d, ws %zu)\n", n_in, n_in > 0 ? in_sizes[0] : -1, out_size, ws_size); grid = -1; return; }
        int dev = 0, cus = 0, per_cu = 0;
        if (hipGetDevice(&dev) != hipSuccess || hipDeviceGetAttribute(&cus, hipDeviceAttributeMultiprocessorCount, dev) != hipSuccess) { grid = -1; return; }
        if (hipFuncSetAttribute((const void*)hymba_fwd, hipFuncAttributeMaxDynamicSharedMemorySize, LDS_BYTES) != hipSuccess) { fprintf(stderr, "kernel_launch: hipFuncSetAttribute failed\n"); grid = -1; return; }
        if (hipOccupancyMaxActiveBlocksPerMultiprocessor(&per_cu, (const void*)hymba_fwd, NWAVES * 64, LDS_BYTES) != hipSuccess || per_cu < 1) { fprintf(stderr, "kernel_launch: occupancy query reports %d\n", per_cu); }
        (void)hipGetLastError();
        grid = cus;
    }
    if (grid < 0) return;
    (void)hipMemsetAsync((char*)d_ws + WS_CTL, 0, CTL_ZERO_BYTES, stream);
    Args a{};
    const float** p = (const float**)&a;
    for (int i = 0; i < 22; ++i) p[i] = (const float*)d_in[i];
    a.out = (float*)d_out; a.ws = (unsigned char*)d_ws;
    hipLaunchKernelGGL(hymba_fwd, dim3(grid), dim3(NWAVES * 64), LDS_BYTES, stream, a);
}
```

```cpp
#include <hip/hip_runtime.h>
#include <hip/hip_bf16.h>
#include <cstdio>
#include <cstdint>

#define LAS __attribute__((address_space(3)))
#define GAS __attribute__((address_space(1)))
typedef unsigned short bf16_t;
typedef short bf16x8 __attribute__((ext_vector_type(8)));
typedef short s16x4 __attribute__((ext_vector_type(4)));
typedef float f32x4 __attribute__((ext_vector_type(4)));
typedef float f32x2 __attribute__((ext_vector_type(2)));
typedef float f32x16 __attribute__((ext_vector_type(16)));
typedef unsigned u32x4 __attribute__((ext_vector_type(4)));
typedef unsigned u32x2 __attribute__((ext_vector_type(2)));
typedef __bf16 bf16x2_t __attribute__((ext_vector_type(2)));

constexpr int BATCH = 8, SEQ = 8192, DM = 1024, M = BATCH * SEQ;
constexpr int NH = 8, HD = 64, HW = NH * HD;
constexpr int NPROJ = 3 * HW * 2;
constexpr int WIN_LD = NPROJ + NH;
constexpr int NMEM = 256, XH = 4, XD = 256, MEMROWS = BATCH * NMEM;
constexpr int NEXP = 16, DFF = 256;
constexpr float EPS = 1e-6f;
constexpr float LOG2E = 1.4426950408889634f;
constexpr float C2 = 0.125f * LOG2E;
constexpr float XSC = 0.0625f * LOG2E;
constexpr float SB_EXIT = -173.0f;

constexpr size_t MiB = 1u << 20;
constexpr size_t WS_CTL = 0, CTL_ZERO_BYTES = 1 * MiB;
constexpr size_t WS_WIN = 1 * MiB;
constexpr size_t WS_WOUT = 7 * MiB;
constexpr size_t WS_WXQ = 9 * MiB;
constexpr size_t WS_WXKV = 11 * MiB;
constexpr size_t WS_WXO = 15 * MiB;
constexpr size_t WS_WGU = 17 * MiB;
constexpr size_t WS_WD = 33 * MiB;
constexpr size_t WS_RX = 41 * MiB;
constexpr size_t WS_RMEM = WS_RX + 256 * 1024;
constexpr size_t WS_LF = 42 * MiB;
constexpr size_t WS_C2 = 44 * MiB;
constexpr size_t WS_SSQ = 46 * MiB;
constexpr size_t WS_TOKSLOT = 50 * MiB;
constexpr size_t WS_TOKW = 51 * MiB;
constexpr size_t WS_LIST = 52 * MiB;
constexpr size_t WS_MEMB = 56 * MiB;
constexpr size_t WS_KVM = 60 * MiB;
constexpr size_t WS_GT = 68 * MiB;
constexpr size_t WS_HT = 84 * MiB;
constexpr size_t WS_KX = 100 * MiB;
constexpr size_t WS_XB = 128 * MiB;
constexpr size_t WS_QKV = 256 * MiB;
constexpr size_t WS_H1B = 256 * MiB, WS_U2B = 384 * MiB, WS_HID = 512 * MiB;
constexpr size_t WS_O = 640 * MiB;
constexpr size_t WS_Y = 704 * MiB;
constexpr size_t WS_END = 1024 * MiB;
constexpr size_t QKV_STRIDE = (size_t)M * HW;
constexpr int MAXTILES = M * 2 / 256 + NEXP;
static_assert(WS_Y + (size_t)MAXTILES * 256 * 1024 * 2 <= WS_END, "ws map");
static_assert(WS_HID + (size_t)MAXTILES * 256 * 256 * 2 <= WS_O, "ws map");
constexpr int CW_BAR = 4096;
constexpr int CW_CNT = 16384;

constexpr int RING_OFF = 0, RING_BYTES = 131072;
constexpr int EXTRA_OFF = 131072, EXTRA_BYTES = 16384;
constexpr int MISC_OFF = EXTRA_OFF + EXTRA_BYTES;
constexpr int LDS_BYTES = MISC_OFF + 1024;
constexpr int NWAVES = 8;
#ifndef PHASE_MASK
#define PHASE_MASK 0x7ff
#endif
#define PH(n) ((PHASE_MASK >> (n)) & 1)
#ifndef FOX_V2
#define FOX_V2 1
#endif
#ifndef REP_MASK
#define REP_MASK 0
#endif
#define REPS(n) (1 + ((REP_MASK >> (n)) & 1))
#ifndef REP_FOX
#define REP_FOX 1
#endif
#ifndef REP_SB
#define REP_SB 1
#endif

__device__ __forceinline__ unsigned cvt_pk_bf16(float lo, float hi) { f32x2 v = {lo, hi}; bf16x2_t b = __builtin_convertvector(v, bf16x2_t); return __builtin_bit_cast(unsigned, b); }
__device__ __forceinline__ float bf16lo(unsigned u) { return __uint_as_float(u << 16); }
__device__ __forceinline__ float bf16hi(unsigned u) { return __uint_as_float(u & 0xffff0000u); }
__device__ __forceinline__ float wave_sum(float v) {
#pragma unroll
    for (int o = 1; o < 64; o <<= 1) v += __shfl_xor(v, o);
    return v;
}
#define LDS_WAIT() asm volatile("s_waitcnt lgkmcnt(0)" ::: "memory")
#define VM_WAIT() asm volatile("s_waitcnt vmcnt(0)" ::: "memory")

namespace pg8 {
constexpr int BM = 256, BK = 64, HALF = 128, HTB = HALF * BK * 2, STAGE_BYTES = 8 * HTB, NXCD = 8, WGM = 8;
__host__ __device__ __forceinline__ int lds_byte(int r, int c) { const int st = (r >> 4) * 2 + (c >> 5), rr = r & 15, cc = c & 31, ob = rr * 64 + cc * 2; return st * 1024 + (ob ^ (((ob >> 9) & 1) << 5)); }
__host__ __device__ __forceinline__ void stage_rc(int b, int& R, int& C) { const int st = b / 1024, sb = b % 1024, swz = sb ^ (((sb >> 9) & 1) << 5); R = (st >> 1) * 16 + swz / 64; C = (st & 1) * 32 + (swz % 64) / 2; }
__host__ __device__ __forceinline__ int perm32(int rho) { const int n = rho >> 4, i = rho & 15; return 8 * (i >> 2) + 4 * n + (i & 3); }

struct Unit { const char* a; const char* b; int orow, ocol, aux; const int* rows; int nvalid; };
struct Gemm { int lda, ldb, K; };

__device__ __forceinline__ bool tile_order(int i, int G, int c, int nM, int nN, int& pm, int& pn) {
    const int nwg = nM * nN; const long L = (long)i * G + c; if (L >= nwg) return false;
    int wgid = (int)L; { const int q = nwg / NXCD, r = nwg % NXCD, xcd = wgid % NXCD, off = wgid / NXCD; wgid = (xcd < r ? xcd * (q + 1) : r * (q + 1) + (xcd - r) * q) + off; }
    const int nig = WGM * nN, gid = wgid / nig, fm = gid * WGM, gsz = (nM - fm) < WGM ? (nM - fm) : WGM;
    pm = fm + ((wgid % nig) % gsz); pn = (wgid % nig) / gsz; return true;
}

template <class Epi, class Sched, bool ALIGN_EPI, bool GATHER>
__device__ __forceinline__ void gemm_phase(LAS unsigned char* lds, const Gemm g, const Sched& S, const Epi& E) {
    int tid = threadIdx.x; asm volatile("" : "+v"(tid));
    const int wid = __builtin_amdgcn_readfirstlane(tid >> 6), lane = tid & 63, wr = wid >> 2, wc = wid & 3, fr = lane & 15, fq = lane >> 4;
    const int K = g.K, nt = K / BK;
    unsigned voffA[2], voffB[2]; int RA[2], CA[2];
#pragma unroll
    for (int i = 0; i < 2; ++i) { int R, C; stage_rc(tid * 16 + i * 8192, R, C); const int Rb = (R & ~31) + perm32(R & 31);
        RA[i] = R; CA[i] = C; voffA[i] = (unsigned)(R * g.lda + C) * 2u; voffB[i] = (unsigned)(Rb * g.ldb + C) * 2u; }
    const size_t kstep = (size_t)(BK * 2);
    const size_t hstepA = (size_t)HALF * g.lda * 2, hstepB = (size_t)HALF * g.ldb * 2;
    const unsigned ldsw = (unsigned)wid * 1024u;
    const int aoff = lds_byte(wr * 64 + fr, fq * 8), boff = lds_byte(wc * 32 + fr, fq * 8);
#define PG8_SA(b, h) (((b) * 2 + (h)) * HTB)
#define PG8_SB(b, h) ((4 + (b) * 2 + (h)) * HTB)
#define PG8_STAGE2(bufoff, gbase, v0, v1) do { \
        __builtin_amdgcn_global_load_lds((const unsigned*)((const char*)(gbase) + (v0)), (LAS unsigned*)(lds + (bufoff) + ldsw), 16, 0, 0); \
        __builtin_amdgcn_global_load_lds((const unsigned*)((const char*)(gbase) + (v1)), (LAS unsigned*)(lds + (bufoff) + ldsw + 8192), 16, 0, 0); } while (0)
#define PG8_STAGEB(bufoff, gbase) PG8_STAGE2(bufoff, gbase, voffB[0], voffB[1])
#define PG8_STAGEA(bufoff, kptr, h, NX) do { if constexpr (GATHER) { const unsigned v0_ = (NX) ? gvn[h][0] : gvc[h][0], v1_ = (NX) ? gvn[h][1] : gvc[h][1]; PG8_STAGE2(bufoff, kptr, v0_, v1_); } \
        else { PG8_STAGE2(bufoff, (kptr) + (h) * hstepA, voffA[0], voffA[1]); } } while (0)
#define PG8_LDA(dst, b, h) do { _Pragma("unroll") for (int m = 0; m < 4; ++m) _Pragma("unroll") for (int k = 0; k < 2; ++k) dst[m][k] = *(const LAS bf16x8*)(lds + PG8_SA(b, h) + aoff + m * 2048 + k * 1024); } while (0)
#define PG8_LDB(dst, b, h) do { _Pragma("unroll") for (int n = 0; n < 2; ++n) _Pragma("unroll") for (int k = 0; k < 2; ++k) dst[n][k] = *(const LAS bf16x8*)(lds + PG8_SB(b, h) + boff + n * 2048 + k * 1024); } while (0)
#define PG8_MMA(ai, bj, At, Bt) do { __builtin_amdgcn_s_setprio(1); _Pragma("unroll") for (int m = 0; m < 4; ++m) _Pragma("unroll") for (int n = 0; n < 2; ++n) _Pragma("unroll") for (int k = 0; k < 2; ++k) \
        acc[ai][bj][m][n] = __builtin_amdgcn_mfma_f32_16x16x32_bf16(Bt[n][k], At[m][k], acc[ai][bj][m][n], 0, 0, 0); __builtin_amdgcn_s_setprio(0); } while (0)
#define PG8_WAIT_V(n) asm volatile("s_waitcnt vmcnt(" #n ")" ::: "memory")
#define PG8_WAIT_L(n) asm volatile("s_waitcnt lgkmcnt(" #n ")" ::: "memory")
#define PG8_BAR __builtin_amdgcn_s_barrier()
#define PG8_SCHED __builtin_amdgcn_sched_barrier(0)
#define PG8_GATHER_OFFS(dst, u) do { _Pragma("unroll") for (int h_ = 0; h_ < 2; ++h_) _Pragma("unroll") for (int i_ = 0; i_ < 2; ++i_) { const int r_ = h_ * HALF + RA[i_]; \
        const int idx_ = (u).rows[r_ < (u).nvalid ? r_ : 0]; dst[h_][i_] = (unsigned)(idx_ * g.lda + CA[i_]) * 2u; } } while (0)
    Unit cur, nxt; int ui = 0;
    if (!S.next(0, cur)) return;
    unsigned gvc[2][2] = {{0u, 0u}, {0u, 0u}}, gvn[2][2] = {{0u, 0u}, {0u, 0u}};
    if constexpr (GATHER) { PG8_GATHER_OFFS(gvc, cur); }
    f32x4 acc[2][2][4][2];
#pragma unroll
    for (int a = 0; a < 2; ++a)
#pragma unroll
        for (int b = 0; b < 2; ++b)
#pragma unroll
            for (int m = 0; m < 4; ++m)
#pragma unroll
                for (int n = 0; n < 2; ++n) acc[a][b][m][n] = (f32x4){0.f, 0.f, 0.f, 0.f};
    bf16x8 At[4][2], B0[2][2], B1[2][2];
    const char* cA = cur.a; const char* cB = cur.b;
    PG8_STAGEB(PG8_SB(0, 0), cB); PG8_STAGEB(PG8_SB(0, 1), cB + hstepB); PG8_STAGEA(PG8_SA(0, 0), cA, 0, false); PG8_STAGEA(PG8_SA(0, 1), cA, 1, false);
    if (wr == 1) PG8_BAR;
    PG8_WAIT_V(2); PG8_BAR;
    PG8_STAGEB(PG8_SB(1, 0), cB + kstep); PG8_STAGEA(PG8_SA(1, 0), cA + kstep, 0, false); PG8_STAGEB(PG8_SB(1, 1), cB + hstepB + kstep);
    PG8_WAIT_V(6); PG8_BAR;
    for (;;) {
        const bool has_next = S.next(ui + 1, nxt);
        const char* nA = has_next ? nxt.a : cA; const char* nB = has_next ? nxt.b : cB;
        if constexpr (GATHER) { if (has_next) { PG8_GATHER_OFFS(gvn, nxt); } else { gvn[0][0] = gvc[0][0]; gvn[0][1] = gvc[0][1]; gvn[1][0] = gvc[1][0]; gvn[1][1] = gvc[1][1]; } }
#pragma unroll 1
        for (int t = 0; t < nt; t += 2) {
            const bool last = (t == nt - 2);
            const char* a1 = cA + (size_t)(t + 1) * kstep;
            const char* a2 = last ? nA : cA + (size_t)(t + 2) * kstep; const char* b2 = last ? nB : cB + (size_t)(t + 2) * kstep;
            const char* a3 = a2 + kstep; const char* b3 = b2 + kstep;
            PG8_LDB(B0, 0, 0); PG8_LDB(B1, 0, 1); PG8_SCHED; PG8_LDA(At, 0, 0); PG8_STAGEA(PG8_SA(1, 1), a1, 1, false);
            PG8_WAIT_V(8); PG8_WAIT_L(0); PG8_BAR; PG8_MMA(0, 0, At, B0); PG8_MMA(0, 1, At, B1); PG8_BAR; PG8_SCHED;
            PG8_LDA(At, 0, 1); PG8_STAGEB(PG8_SB(0, 0), b2); PG8_STAGEB(PG8_SB(0, 1), b2 + hstepB); PG8_STAGEA(PG8_SA(0, 0), a2, 0, last);
            PG8_WAIT_V(8); PG8_WAIT_L(0); PG8_BAR; PG8_MMA(1, 0, At, B0); PG8_MMA(1, 1, At, B1); PG8_BAR; PG8_SCHED;
            PG8_LDB(B0, 1, 0); PG8_LDB(B1, 1, 1); PG8_SCHED; PG8_LDA(At, 1, 0); PG8_STAGEA(PG8_SA(0, 1), a2, 1, last);
            PG8_WAIT_V(8); PG8_WAIT_L(0); PG8_BAR; PG8_MMA(0, 0, At, B0); PG8_MMA(0, 1, At, B1); PG8_BAR; PG8_SCHED;
            PG8_LDA(At, 1, 1); PG8_STAGEB(PG8_SB(1, 0), b3); PG8_STAGEB(PG8_SB(1, 1), b3 + hstepB); PG8_STAGEA(PG8_SA(1, 0), a3, 0, last);
            PG8_WAIT_V(8); PG8_WAIT_L(0); PG8_BAR; PG8_MMA(1, 0, At, B0); PG8_MMA(1, 1, At, B1); PG8_BAR; PG8_SCHED;
        }
        if constexpr (ALIGN_EPI) { if (wr == 0) PG8_BAR; }
        { int fr2 = fr, fq2 = fq; asm volatile("" : "+v"(fr2), "+v"(fq2));
          E(acc, cur, wr, wc, fr2, fq2); }
        if (!has_next) break;
#pragma unroll
        for (int a = 0; a < 2; ++a)
#pragma unroll
            for (int b = 0; b < 2; ++b)
#pragma unroll
                for (int m = 0; m < 4; ++m)
#pragma unroll
                    for (int n = 0; n < 2; ++n) acc[a][b][m][n] = (f32x4){0.f, 0.f, 0.f, 0.f};
        cur = nxt; cA = nA; cB = nB; ++ui;
        if constexpr (GATHER) { gvc[0][0] = gvn[0][0]; gvc[0][1] = gvn[0][1]; gvc[1][0] = gvn[1][0]; gvc[1][1] = gvn[1][1]; }
        if constexpr (ALIGN_EPI) { if (wr == 1) PG8_BAR; }
    }
    PG8_WAIT_V(0);
    if constexpr (!ALIGN_EPI) { if (wr == 0) PG8_BAR; }
    PG8_BAR;
#undef PG8_SA
#undef PG8_SB
#undef PG8_STAGE2
#undef PG8_STAGEA
#undef PG8_STAGEB
#undef PG8_LDA
#undef PG8_LDB
#undef PG8_MMA
#undef PG8_WAIT_V
#undef PG8_WAIT_L
#undef PG8_BAR
#undef PG8_SCHED
#undef PG8_GATHER_OFFS
}

#define EPI_ROW(u, ai, m) ((u).orow + (ai) * HALF + wr * 64 + (m) * 16 + fr)
#define EPI_COL(u, bj) ((u).ocol + (bj) * HALF + wc * 32 + 8 * fq)
struct EpiBf16 {
    bf16_t* O; int ldc; const float* rs; size_t stride; float sc0, sc3;
    __device__ __forceinline__ void operator()(const f32x4 (&acc)[2][2][4][2], const Unit& u, int wr, int wc, int fr, int fq) const {
        bf16_t* base = O + (size_t)u.aux * stride;
        const float sc = (u.aux == 0) ? sc0 : ((u.aux == 3) ? sc3 : 1.f);
#pragma unroll
        for (int ai = 0; ai < 2; ++ai)
#pragma unroll
            for (int m = 0; m < 4; ++m) { const int row = EPI_ROW(u, ai, m); const float s = (rs ? rs[row] : 1.f) * sc;
#pragma unroll
                for (int bj = 0; bj < 2; ++bj) { const f32x4 v0 = acc[ai][bj][m][0] * s, v1 = acc[ai][bj][m][1] * s;
                    u32x4 w; w.x = cvt_pk_bf16(v0[0], v0[1]); w.y = cvt_pk_bf16(v0[2], v0[3]); w.z = cvt_pk_bf16(v1[0], v1[1]); w.w = cvt_pk_bf16(v1[2], v1[3]);
                    *(u32x4*)(base + (size_t)row * ldc + EPI_COL(u, bj)) = w; } }
    }
};
struct EpiResid {
    const float* res; float* out; bf16_t* hb; float* ssq;
    __device__ __forceinline__ void operator()(const f32x4 (&acc)[2][2][4][2], const Unit& u, int wr, int wc, int fr, int fq) const {
#pragma unroll
        for (int ai = 0; ai < 2; ++ai)
#pragma unroll
            for (int m = 0; m < 4; ++m) { const int row = EPI_ROW(u, ai, m); float q = 0.f;
#pragma unroll
                for (int bj = 0; bj < 2; ++bj) { const size_t off = (size_t)row * DM + EPI_COL(u, bj);
                    const f32x4 r0 = *(const f32x4*)(res + off), r1 = *(const f32x4*)(res + off + 4);
                    const f32x4 v0 = acc[ai][bj][m][0] + r0, v1 = acc[ai][bj][m][1] + r1;
                    *(f32x4*)(out + off) = v0; *(f32x4*)(out + off + 4) = v1;
                    q += (v0[0] * v0[0] + v0[1] * v0[1]) + (v0[2] * v0[2] + v0[3] * v0[3]) + (v1[0] * v1[0] + v1[1] * v1[1]) + (v1[2] * v1[2] + v1[3] * v1[3]);
                    if (hb) { u32x4 w; w.x = cvt_pk_bf16(v0[0], v0[1]); w.y = cvt_pk_bf16(v0[2], v0[3]); w.z = cvt_pk_bf16(v1[0], v1[1]); w.w = cvt_pk_bf16(v1[2], v1[3]); *(u32x4*)(hb + off) = w; } }
                if (ssq) { q += __shfl_xor(q, 16); q += __shfl_xor(q, 32); if (fq == 0) ssq[(size_t)row * 16 + (u.ocol >> 8) * 4 + wc] = q; } }
    }
};
struct EpiSoftmax {
    bf16_t* P; const float* ssq; LAS float* red;
    __device__ __forceinline__ void operator()(f32x4 (&acc)[2][2][4][2], const Unit& u, int wr, int wc, int fr, int fq) const {
#pragma unroll
        for (int ai = 0; ai < 2; ++ai)
#pragma unroll
            for (int m = 0; m < 4; ++m) { const int row = EPI_ROW(u, ai, m); const f32x4* sp = (const f32x4*)(ssq + (size_t)row * 16);
                const f32x4 s0 = sp[0], s1 = sp[1], s2 = sp[2], s3 = sp[3];
                const float tot = ((s0[0] + s0[1]) + (s0[2] + s0[3])) + ((s1[0] + s1[1]) + (s1[2] + s1[3])) + ((s2[0] + s2[1]) + (s2[2] + s2[3])) + ((s3[0] + s3[1]) + (s3[2] + s3[3]));
                const float r1 = rsqrtf(tot * (1.0f / DM) + EPS) * XSC; float a = -3.0e38f;
#pragma unroll
                for (int bj = 0; bj < 2; ++bj)
#pragma unroll
                    for (int n = 0; n < 2; ++n) { f32x4 v = acc[ai][bj][m][n] * r1; acc[ai][bj][m][n] = v; a = fmaxf(a, fmaxf(fmaxf(v[0], v[1]), fmaxf(v[2], v[3]))); }
                a = fmaxf(a, __shfl_xor(a, 16)); a = fmaxf(a, __shfl_xor(a, 32));
                if (fq == 0) red[(ai * HALF + wr * 64 + m * 16 + fr) * 4 + wc] = a; asm volatile("" ::: "memory"); }
        LDS_WAIT(); __builtin_amdgcn_s_barrier(); asm volatile("" ::: "memory");
#pragma unroll
        for (int ai = 0; ai < 2; ++ai)
#pragma unroll
            for (int m = 0; m < 4; ++m) { const int rl = ai * HALF + wr * 64 + m * 16 + fr; const f32x4 mm = *(const LAS f32x4*)(red + rl * 4);
                const float a = fmaxf(fmaxf(mm[0], mm[1]), fmaxf(mm[2], mm[3])); float s = 0.f;
#pragma unroll
                for (int bj = 0; bj < 2; ++bj)
#pragma unroll
                    for (int n = 0; n < 2; ++n) { f32x4 v = acc[ai][bj][m][n];
                        v[0] = __builtin_amdgcn_exp2f(v[0] - a); v[1] = __builtin_amdgcn_exp2f(v[1] - a); v[2] = __builtin_amdgcn_exp2f(v[2] - a); v[3] = __builtin_amdgcn_exp2f(v[3] - a);
                        acc[ai][bj][m][n] = v; s += (v[0] + v[1]) + (v[2] + v[3]); }
                s += __shfl_xor(s, 16); s += __shfl_xor(s, 32);
                if (fq == 0) red[1024 + rl * 4 + wc] = s; }
        LDS_WAIT(); __builtin_amdgcn_s_barrier(); asm volatile("" ::: "memory");
#pragma unroll
        for (int ai = 0; ai < 2; ++ai)
#pragma unroll
            for (int m = 0; m < 4; ++m) { const int rl = ai * HALF + wr * 64 + m * 16 + fr; const int row = u.orow + rl; const f32x4 ss = *(const LAS f32x4*)(red + 1024 + rl * 4);
                const float inv = 1.0f / ((ss[0] + ss[1]) + (ss[2] + ss[3]));
#pragma unroll
                for (int bj = 0; bj < 2; ++bj) { const f32x4 v0 = acc[ai][bj][m][0] * inv, v1 = acc[ai][bj][m][1] * inv;
                    u32x4 w; w.x = cvt_pk_bf16(v0[0], v0[1]); w.y = cvt_pk_bf16(v0[2], v0[3]); w.z = cvt_pk_bf16(v1[0], v1[1]); w.w = cvt_pk_bf16(v1[2], v1[3]);
                    *(u32x4*)(P + (size_t)row * DM + EPI_COL(u, bj)) = w; } }
    }
};
struct EpiSwiglu {
    bf16_t* Hd;
    __device__ __forceinline__ void operator()(const f32x4 (&acc)[2][2][4][2], const Unit& u, int wr, int wc, int fr, int fq) const {
#pragma unroll
        for (int ai = 0; ai < 2; ++ai)
#pragma unroll
            for (int m = 0; m < 4; ++m) { const int row = EPI_ROW(u, ai, m); float h[8];
#pragma unroll
                for (int n = 0; n < 2; ++n)
#pragma unroll
                    for (int e = 0; e < 4; ++e) { const float gt = acc[ai][0][m][n][e], up = acc[ai][1][m][n][e];
                        h[n * 4 + e] = gt * __builtin_amdgcn_rcpf(1.0f + __builtin_amdgcn_exp2f(-gt * LOG2E)) * up; }
                u32x4 w; w.x = cvt_pk_bf16(h[0], h[1]); w.y = cvt_pk_bf16(h[2], h[3]); w.z = cvt_pk_bf16(h[4], h[5]); w.w = cvt_pk_bf16(h[6], h[7]);
                *(u32x4*)(Hd + (size_t)row * DFF + u.ocol + wc * 32 + 8 * fq) = w; }
    }
};
}

namespace att {
constexpr int QB = 256, KVBLK = 64, PITCH = HW;
constexpr int SLOTB = 8192, LDS_K = 0, LDS_V = 2 * SLOTB, LDS_WS = 4 * SLOTB, LDS_OST = LDS_WS + NWAVES * 256, LDS_FLAG = LDS_OST + NWAVES * 4096, LDS_END = LDS_FLAG + 64;
static_assert(LDS_END <= RING_BYTES, "attention LDS");
__device__ __forceinline__ int crow(int r, int hi) { return (r & 3) + 8 * (r >> 2) + 4 * hi; }
__device__ __forceinline__ void glds16(const void* gsrc, unsigned lds_dst) { unsigned keep;
    asm volatile("s_mov_b32 %0, m0\n\ts_mov_b32 m0, %2\n\ts_nop 0\n\tglobal_load_lds_dwordx4 %1, off\n\ts_mov_b32 m0, %0" : "=&s"(keep) : "v"(gsrc), "s"(lds_dst) : "memory"); }
__device__ __forceinline__ void glds16s(const void* sbase, unsigned voff, unsigned lds_dst) { unsigned keep;
    asm volatile("s_mov_b32 %0, m0\n\ts_mov_b32 m0, %3\n\ts_nop 0\n\tglobal_load_lds_dwordx4 %1, %2\n\ts_mov_b32 m0, %0" : "=&s"(keep) : "v"(voff), "s"(sbase), "s"(lds_dst) : "memory"); }
#define ATT_WAIT_BAR0() asm volatile("s_waitcnt vmcnt(0) lgkmcnt(0)\n\ts_barrier" ::: "memory")
#define MFMA32(a, b, c) __builtin_amdgcn_mfma_f32_32x32x16_bf16(a, b, c, 0, 0, 0)
__device__ __forceinline__ void qkt(f32x16& p0, f32x16& p1, const LAS char* Kslot, const bf16x8* qr, const f32x16& cin, int r32, int hi) {
    const LAS char* kb = Kslot + hi * 1024 + r32 * 16;
#pragma unroll
    for (int d0 = 0; d0 < 4; ++d0) {
        const bf16x8 b0 = *(const LAS bf16x8*)(kb + d0 * 2048);
        const bf16x8 b1 = *(const LAS bf16x8*)(kb + d0 * 2048 + 512);
        if (d0 == 0) { p0 = MFMA32(b0, qr[0], cin); p1 = MFMA32(b1, qr[0], cin); }
        else { p0 = MFMA32(b0, qr[d0], p0); p1 = MFMA32(b1, qr[d0], p1); } }
}
__device__ __forceinline__ void pv(f32x16* o, int vb, bf16x8 pa0, bf16x8 pa1, bf16x8 pa2, bf16x8 pa3) {
#pragma unroll
    for (int d0 = 0; d0 < 2; ++d0) { s16x4 lo[4], hi[4];
#pragma unroll
        for (int ks = 0; ks < 4; ++ks) {
            asm volatile("ds_read_b64_tr_b16 %0,%1 offset:%c2" : "=&v"(lo[ks]) : "v"(vb), "i"(d0 * 4096 + ks * 1024) : "memory");
            asm volatile("ds_read_b64_tr_b16 %0,%1 offset:%c2" : "=&v"(hi[ks]) : "v"(vb), "i"(d0 * 4096 + ks * 1024 + 512) : "memory"); }
        asm volatile("s_waitcnt lgkmcnt(0)" ::: "memory"); __builtin_amdgcn_sched_barrier(0);
#define PK(k) (bf16x8){lo[k][0], lo[k][1], lo[k][2], lo[k][3], hi[k][0], hi[k][1], hi[k][2], hi[k][3]}
        o[d0] = MFMA32(pa0, PK(0), o[d0]); o[d0] = MFMA32(pa1, PK(1), o[d0]); o[d0] = MFMA32(pa2, PK(2), o[d0]); o[d0] = MFMA32(pa3, PK(3), o[d0]);
#undef PK
    }
}
__device__ __forceinline__ float swap_lo(float x) { auto rr = __builtin_amdgcn_permlane32_swap(__float_as_uint(x), __float_as_uint(x), false, false); return __uint_as_float(rr[0]); }
__device__ __forceinline__ float swap_hi(float x) { auto rr = __builtin_amdgcn_permlane32_swap(__float_as_uint(x), __float_as_uint(x), false, false); return __uint_as_float(rr[1]); }

template <int MODE> __device__ __forceinline__ void attn_unit(int b, int h, int qb, const bf16_t* Q, const bf16_t* K, const bf16_t* V, bf16_t* O, const float* cb, LAS char* shm) {
    int tid = threadIdx.x; asm volatile("" : "+v"(tid)); const int lane = tid & 63, r32 = lane & 31, hi = lane >> 5; const int wid = __builtin_amdgcn_readfirstlane(tid >> 6);
    const long rowbase = (long)b * SEQ; const int q0 = qb * QB;
    const bf16_t* Qw = Q + (rowbase + q0 + wid * 32) * PITCH + h * HD;
    const bf16_t* Kh = K + rowbase * PITCH + h * HD; const bf16_t* Vh = V + rowbase * PITCH + h * HD;
    const unsigned lds0 = (unsigned)(uintptr_t)shm;
    LAS float* wsf = (LAS float*)(shm + LDS_WS) + wid * 64;
    LAS unsigned* flags = (LAS unsigned*)(shm + LDS_FLAG);
    const bf16_t* ksrc = Kh + (long)lane * PITCH + wid * 8;
    const bf16_t* vsrc = Vh + (long)(16 * (wid & 3) + (lane >> 2)) * PITCH + (wid >> 2) * 32 + (lane & 3) * 8;
    const unsigned kdst = lds0 + LDS_K + wid * 1024, vdst = lds0 + LDS_V + wid * 1024;
#define DMA_KV(t, slot) do { glds16(ksrc + (long)(t) * KVBLK * PITCH, (unsigned)__builtin_amdgcn_readfirstlane(kdst + (slot))); glds16(vsrc + (long)(t) * KVBLK * PITCH, (unsigned)__builtin_amdgcn_readfirstlane(vdst + (slot))); } while (0)
    const int vb0 = (int)(lds0 + LDS_V) + ((lane >> 4) & 1) * 32 + (lane & 3) * 8 + (4 * hi + ((lane & 15) >> 2)) * 64;
    const int NT = (q0 + QB) / KVBLK;
    DMA_KV(NT - 1, 0);
    bf16x8 qr[4];
#pragma unroll
    for (int d0 = 0; d0 < 4; ++d0) qr[d0] = *(const bf16x8*)(Qw + (long)r32 * PITCH + d0 * 16 + hi * 8);
    f32x16 o[2]; o[0] = f32x16{}; o[1] = f32x16{};
    const int qrel = wid * 32 + r32;
    float m_run = -1.0e30f, l_run = 0.f, R = 0.f, ct = 0.f;
    if (MODE == 0) ct = cb[q0 + qrel];
    bf16x8 TD0, TD1, TONE;
#pragma unroll
    for (int j = 0; j < 8; ++j) { const int kvl = 8 * (j >> 2) + 4 * hi + (j & 3); TD0[j] = (kvl >= r32) ? (short)0x3F80 : (short)0; TD1[j] = (16 + kvl >= r32) ? (short)0x3F80 : (short)0; TONE[j] = (short)0x3F80; }
    f32x16 zero16 = f32x16{};
    for (int i = 0; i < NT; ++i) {
        const int t = NT - 1 - i, slot = (i & 1) * SLOTB;
        ATT_WAIT_BAR0();
        if (MODE == 1 && i > 0) {
            const LAS unsigned* fl = flags + ((i - 1) & 1) * 8; unsigned all = 1u;
#pragma unroll
            for (int w = 0; w < 8; ++w) all &= fl[w];
            if (__builtin_amdgcn_readfirstlane(all)) break;
        }
        if (t > 0) DMA_KV(t - 1, slot ^ SLOTB);
        const int jb = t - (NT - 4);
        const bool active = !(jb >= 0 && 2 * jb > wid);
        bool wave_done = false;
        if (MODE == 1) wave_done = __all(R < SB_EXIT);
        if (active && !(MODE == 1 && wave_done)) {
            f32x16 p0, p1;
            qkt(p0, p1, shm + LDS_K + slot, qr, zero16, r32, hi);
            if (MODE == 0) {
                const float* cbt = cb + t * KVBLK + 4 * hi;
#pragma unroll
                for (int g = 0; g < 4; ++g) { const f32x4 c0 = *(const f32x4*)(cbt + 8 * g), c1 = *(const f32x4*)(cbt + 32 + 8 * g);
#pragma unroll
                    for (int e = 0; e < 4; ++e) { p0[4 * g + e] += ct - c0[e]; p1[4 * g + e] += ct - c1[e]; } }
                if (jb >= 0) {
#pragma unroll
                    for (int r = 0; r < 16; ++r) { const int kv = 64 * jb + crow(r, hi); if (kv > qrel) p0[r] = -1.0e30f; if (kv + 32 > qrel) p1[r] = -1.0e30f; } }
                float a = fmaxf(p0[0], p1[0]);
#pragma unroll
                for (int r = 1; r < 16; ++r) a = fmaxf(a, fmaxf(p0[r], p1[r]));
                a = fmaxf(swap_lo(a), swap_hi(a));
                const float m_new = fmaxf(m_run, a), alpha = __builtin_amdgcn_exp2f(m_run - m_new); m_run = m_new;
                float s = 0.f;
#pragma unroll
                for (int r = 0; r < 16; ++r) { p0[r] = __builtin_amdgcn_exp2f(p0[r] - m_new); p1[r] = __builtin_amdgcn_exp2f(p1[r] - m_new); s += p0[r] + p1[r]; }
                l_run = l_run * alpha + s;
                if (hi == 0) wsf[r32] = alpha;
                LDS_WAIT();
#pragma unroll
                for (int r = 0; r < 16; ++r) { const float f = wsf[crow(r, hi)]; o[0][r] *= f; o[1][r] *= f; }
                LDS_WAIT();
            } else {
                if (jb >= 0) {
#pragma unroll
                    for (int r = 0; r < 16; ++r) { const int kv = 64 * jb + crow(r, hi); if (kv >= qrel) p0[r] = -1.0e30f; if (kv + 32 >= qrel) p1[r] = -1.0e30f; } }
                f32x16 l0, l1;
#pragma unroll
                for (int r = 0; r < 16; ++r) {
                    l0[r] = -(fmaxf(p0[r], 0.f) + __builtin_amdgcn_logf(1.0f + __builtin_amdgcn_exp2f(-fabsf(p0[r]))));
                    l1[r] = -(fmaxf(p1[r], 0.f) + __builtin_amdgcn_logf(1.0f + __builtin_amdgcn_exp2f(-fabsf(p1[r])))); }
                u32x4 lw0 = {cvt_pk_bf16(l0[0], l0[1]), cvt_pk_bf16(l0[2], l0[3]), cvt_pk_bf16(l0[4], l0[5]), cvt_pk_bf16(l0[6], l0[7])};
                u32x4 lw1 = {cvt_pk_bf16(l0[8], l0[9]), cvt_pk_bf16(l0[10], l0[11]), cvt_pk_bf16(l0[12], l0[13]), cvt_pk_bf16(l0[14], l0[15])};
                u32x4 lw2 = {cvt_pk_bf16(l1[0], l1[1]), cvt_pk_bf16(l1[2], l1[3]), cvt_pk_bf16(l1[4], l1[5]), cvt_pk_bf16(l1[6], l1[7])};
                u32x4 lw3 = {cvt_pk_bf16(l1[8], l1[9]), cvt_pk_bf16(l1[10], l1[11]), cvt_pk_bf16(l1[12], l1[13]), cvt_pk_bf16(l1[14], l1[15])};
                f32x16 rt;
#pragma unroll
                for (int r = 0; r < 16; ++r) rt[r] = R;
                f32x16 t0 = MFMA32(TD0, __builtin_bit_cast(bf16x8, lw0), rt); t0 = MFMA32(TD1, __builtin_bit_cast(bf16x8, lw1), t0);
                t0 = MFMA32(TONE, __builtin_bit_cast(bf16x8, lw2), t0); t0 = MFMA32(TONE, __builtin_bit_cast(bf16x8, lw3), t0);
                f32x16 t1 = MFMA32(TD0, __builtin_bit_cast(bf16x8, lw2), rt); t1 = MFMA32(TD1, __builtin_bit_cast(bf16x8, lw3), t1);
#pragma unroll
                for (int r = 0; r < 16; ++r) { p0[r] = __builtin_amdgcn_exp2f(p0[r] + t0[r]); p1[r] = __builtin_amdgcn_exp2f(p1[r] + t1[r]); }
                R = swap_lo(t0[0]);
            }
            u32x4 pw0 = {cvt_pk_bf16(p0[0], p0[1]), cvt_pk_bf16(p0[2], p0[3]), cvt_pk_bf16(p0[4], p0[5]), cvt_pk_bf16(p0[6], p0[7])};
            u32x4 pw1 = {cvt_pk_bf16(p0[8], p0[9]), cvt_pk_bf16(p0[10], p0[11]), cvt_pk_bf16(p0[12], p0[13]), cvt_pk_bf16(p0[14], p0[15])};
            u32x4 pw2 = {cvt_pk_bf16(p1[0], p1[1]), cvt_pk_bf16(p1[2], p1[3]), cvt_pk_bf16(p1[4], p1[5]), cvt_pk_bf16(p1[6], p1[7])};
            u32x4 pw3 = {cvt_pk_bf16(p1[8], p1[9]), cvt_pk_bf16(p1[10], p1[11]), cvt_pk_bf16(p1[12], p1[13]), cvt_pk_bf16(p1[14], p1[15])};
            pv(o, vb0 + slot, __builtin_bit_cast(bf16x8, pw0), __builtin_bit_cast(bf16x8, pw1), __builtin_bit_cast(bf16x8, pw2), __builtin_bit_cast(bf16x8, pw3));
        }
        if (MODE == 1) { const bool dn = __all(R < SB_EXIT); if (lane == 0) flags[(i & 1) * 8 + wid] = dn ? 1u : 0u; }
    }
    float linv = 1.f;
    if (MODE == 0) { const float lt = swap_lo(l_run) + swap_hi(l_run); linv = 1.0f / lt; }
    if (hi == 0) wsf[32 + r32] = linv;
    LDS_WAIT();
    bf16_t* Ow = O + (rowbase + q0 + wid * 32) * PITCH + h * HD;
    { LAS bf16_t* stg = (LAS bf16_t*)(shm + LDS_OST) + wid * 2048;
#pragma unroll
      for (int r = 0; r < 16; ++r) { const int orow = crow(r, hi); const float f = wsf[32 + orow];
#pragma unroll
        for (int d0 = 0; d0 < 2; ++d0) { const unsigned pk = cvt_pk_bf16(o[d0][r] * f, 0.f); stg[orow * 64 + d0 * 32 + r32] = (bf16_t)(pk & 0xffffu); } }
      LDS_WAIT();
#pragma unroll
      for (int i = 0; i < 4; ++i) { const int row = i * 8 + (lane >> 3), ch = lane & 7; const u32x4 v = *(const LAS u32x4*)(stg + row * 64 + ch * 8); *(u32x4*)(Ow + (long)row * PITCH + ch * 8) = v; } }
    asm volatile("s_waitcnt vmcnt(0) lgkmcnt(0)\n\ts_barrier" ::: "memory");
#undef DMA_KV
}
}


namespace fox {
constexpr int QB = 256, KVBLK = 64, PITCH = HW;
constexpr int NSLOT = 3, SLOTB = 9216;
constexpr int LDS_K = 0, LDS_V = NSLOT * SLOTB, LDS_WS = 2 * NSLOT * SLOTB, LDS_OST = LDS_WS + NWAVES * 256, LDS_END = LDS_OST + NWAVES * 4096;
static_assert(LDS_END <= RING_BYTES, "fox LDS");
constexpr float FLOOR = -256.0f;
using att::crow; using att::glds16; using att::glds16s;
typedef __attribute__((address_space(3))) const char* lds_cptr;
typedef short v4i16_t __attribute__((ext_vector_type(4)));
#define SBAR() __builtin_amdgcn_sched_barrier(0)
#define WAIT_BAR(N) asm volatile("s_waitcnt vmcnt(" #N ") lgkmcnt(0)\n\ts_barrier" ::: "memory")
__device__ __forceinline__ s16x4 vtr(lds_cptr p) { return __builtin_bit_cast(s16x4, __builtin_amdgcn_ds_read_tr16_b64_v4i16((__attribute__((address_space(3))) v4i16_t*)p)); }
__device__ __forceinline__ void kload2(bf16x8* kf, lds_cptr kp, int j) { kf[2 * j] = *(const LAS bf16x8*)(kp + j * 2048); kf[2 * j + 1] = *(const LAS bf16x8*)(kp + j * 2048 + 512); }
__device__ __forceinline__ void cmask(f32x16& p0, f32x16& p1, int jb, int qrel, int hi) {
    const float NEG = -INFINITY; const int kb = 64 * jb + 4 * hi;
#pragma unroll
    for (int r = 0; r < 16; ++r) { const int kv = kb + (r & 3) + 8 * (r >> 2); if (kv > qrel) p0[r] = NEG; if (kv + 32 > qrel) p1[r] = NEG; }
}
__device__ __forceinline__ void split3(float x, unsigned& hm, unsigned& lo) {
    const unsigned h = cvt_pk_bf16(x, 0.f) & 0xffffu; const float r1 = x - __uint_as_float(h << 16);
    const unsigned m = cvt_pk_bf16(r1, 0.f) & 0xffffu; const float r2 = r1 - __uint_as_float(m << 16);
    hm = h | (m << 16); lo = cvt_pk_bf16(r2, 0.f) & 0xffffu;
}
__device__ __forceinline__ bf16x8 qx_build(float a, int hi) {
    unsigned hm, lo; split3(a, hm, lo);
    u32x4 w; w.x = hm; w.y = lo | 0x3F800000u; w.z = 0x3F803F80u; w.w = 0u;
    if (hi) { w.x = 0u; w.y = 0u; w.z = 0u; }
    return __builtin_bit_cast(bf16x8, w);
}

template <int THRL> __device__ __forceinline__ void fox_unit(int bh, int qb, const bf16_t* Q, const bf16_t* K, const bf16_t* V, bf16_t* O, const float* cb, const bf16_t* KXh, LAS char* shm) {
    int tid = threadIdx.x; asm volatile("" : "+v"(tid)); const int lane = tid & 63, r32 = lane & 31, hi = lane >> 5; const int wid = __builtin_amdgcn_readfirstlane(tid >> 6);
    const int b = bh >> 3, h = bh & 7; const long rowbase = (long)b * SEQ; const int q0 = qb * QB;
    const bf16_t* Qw = Q + (rowbase + q0 + wid * 32) * PITCH + h * HD;
    const bf16_t* Kh = K + rowbase * PITCH + h * HD; const bf16_t* Vh = V + rowbase * PITCH + h * HD;
    const unsigned lds0 = (unsigned)(uintptr_t)shm;
    LAS float* wsf = (LAS float*)(shm + LDS_WS) + wid * 64;
    const int NT = (q0 + QB) / KVBLK;
    const unsigned koff = (unsigned)(lane * PITCH + wid * 8) * 2u, voff = (unsigned)((16 * (wid & 3) + (lane >> 2)) * PITCH + (wid >> 2) * 32 + (lane & 3) * 8) * 2u, xoff = (unsigned)lane * 16u;
    const unsigned kdst = lds0 + LDS_K + wid * 1024, vdst = lds0 + LDS_V + wid * 1024, xdst = lds0 + LDS_K + 8192;
    const bool xl = (lane >> 3) == wid;
#define DMA_K(p, slot) do { glds16s(Kh + (long)(NT - 1 - (p)) * KVBLK * PITCH, koff, (unsigned)__builtin_amdgcn_readfirstlane(kdst + (slot))); \
        if (xl) glds16s(KXh + (long)(NT - 1 - (p)) * KVBLK * 8, xoff, (unsigned)__builtin_amdgcn_readfirstlane(xdst + (slot))); } while (0)
#define DMA_V(p, slot) glds16s(Vh + (long)(NT - 1 - (p)) * KVBLK * PITCH, voff, (unsigned)__builtin_amdgcn_readfirstlane(vdst + (slot)))
    bf16x8 kf[10];
    const lds_cptr shm3 = (lds_cptr)shm; const lds_cptr kp0 = shm3 + LDS_K + hi * 1024 + r32 * 16; const lds_cptr kx0 = shm3 + LDS_K + 8192 + r32 * 16;
    const lds_cptr vp0 = shm3 + LDS_V + ((lane >> 4) & 1) * 32 + (lane & 3) * 8 + (4 * hi + ((lane & 15) >> 2)) * 64;
    DMA_K(0, 0); DMA_V(0, 0); DMA_K(1, SLOTB);
    bf16x8 qr[4];
#pragma unroll
    for (int d0 = 0; d0 < 4; ++d0) qr[d0] = *(const bf16x8*)(Qw + (long)r32 * PITCH + d0 * 16 + hi * 8);
    const int qrel = wid * 32 + r32;
    const float ct = cb[q0 + qrel];
    float mhat = 0.f, l_reg = 0.f; f32x16 o[2]; o[0] = f32x16{}; o[1] = f32x16{};
    bf16x8 qx = qx_build(ct, hi);
    const f32x16 z16 = f32x16{};
#define CMASK(P0, P1, p) do { const int jb_ = 3 - (p); if (jb_ >= 0) cmask(P0, P1, jb_, qrel, hi); } while (0)
    bool resc = false;
#define RESC() do { if (resc) { asm volatile("s_waitcnt lgkmcnt(0)" ::: "memory"); \
      _Pragma("unroll") for (int d_ = 0; d_ < 2; ++d_) _Pragma("unroll") for (int r = 0; r < 16; ++r) o[d_][r] *= wsf[crow(r, hi)]; } } while (0)
    f32x16 pA0, pA1, pB0, pB1;
    int sl_prev = 0, sl_cur = 0, sl_next = SLOTB;
#define ROT() do { sl_prev = sl_cur; sl_cur = sl_next; sl_next = (sl_next == (NSLOT - 1) * SLOTB) ? 0 : sl_next + SLOTB; } while (0)
    DMA_K(2, 2 * SLOTB);
    WAIT_BAR(5);
    { const LAS char* kb = (const LAS char*)shm + LDS_K + hi * 1024 + r32 * 16; const LAS char* kxb = (const LAS char*)shm + LDS_K + 8192 + r32 * 16;
      pA0 = MFMA32(*(const LAS bf16x8*)(kxb), qx, z16); pA1 = MFMA32(*(const LAS bf16x8*)(kxb + 512), qx, z16);
#pragma unroll
      for (int d0 = 0; d0 < 4; ++d0) { pA0 = MFMA32(*(const LAS bf16x8*)(kb + d0 * 2048), qr[d0], pA0); pA1 = MFMA32(*(const LAS bf16x8*)(kb + d0 * 2048 + 512), qr[d0], pA1); } }
    asm volatile("s_nop 15\n\ts_nop 7" : "+v"(pA0), "+v"(pA1)); CMASK(pA0, pA1, 0);
    { float a = fmaxf(pA0[0], pA1[0]);
#pragma unroll
      for (int r = 1; r < 16; ++r) a = fmaxf(a, fmaxf(pA0[r], pA1[r]));
      a = fmaxf(att::swap_lo(a), att::swap_hi(a));
      const float dl = fmaxf(a, FLOOR); mhat = dl;
#pragma unroll
      for (int r = 0; r < 16; ++r) { pA0[r] = __builtin_amdgcn_exp2f(pA0[r] - dl); pA1[r] = __builtin_amdgcn_exp2f(pA1[r] - dl); }
      qx = qx_build(ct - mhat, hi); asm volatile("" : "+v"(qx)); }
    WAIT_BAR(0);
    DMA_K(3, 0); DMA_V(1, SLOTB);
    ROT();
    kload2(kf, kp0 + sl_cur, 0); kload2(kf, kp0 + sl_cur, 1); kload2(kf, kp0 + sl_cur, 2); kload2(kf, kp0 + sl_cur, 3);
    kf[8] = *(const LAS bf16x8*)(kx0 + sl_cur); kf[9] = *(const LAS bf16x8*)(kx0 + sl_cur + 512);
    WAIT_BAR(3);
    s16x4 vlo[8], vhi[8]; u32x4 pw0, pw1, pw2, pw3;
#define PKW(P, B) cvt_pk_bf16(P[B], P[B + 1])
#define PAF(k) __builtin_bit_cast(bf16x8, pw##k)
#define VFR(i) (bf16x8){vlo[i][0], vlo[i][1], vlo[i][2], vlo[i][3], vhi[i][0], vhi[i][1], vhi[i][2], vhi[i][3]}
#define PIN(x) asm volatile("" : "+v"(x))
#define MX3(a, b, c) __builtin_fmaxf(__builtin_fmaxf((a), (b)), (c))
#define GAPA(MF, A0, A1, A2, A3, W0, W1, PW) do { MF; sacc += A0; sacc += A1; sacc += A2; sacc += A3; PIN(sacc); W0; W1; PIN(PW); SBAR(); } while (0)
#define EX(v) __builtin_amdgcn_exp2f(v)
#define GAPB(MF, X, B) do { MF; X[B] = EX(X[B]); X[B + 1] = EX(X[B + 1]); X[B + 2] = EX(X[B + 2]); X[B + 3] = EX(X[B + 3]); PIN(X); SBAR(); } while (0)
#define VRD(i) do { vlo[i] = vtr(vp_ + (((i) >> 2) * 4096 + ((i) & 3) * 1024)); vhi[i] = vtr(vp_ + (((i) >> 2) * 4096 + ((i) & 3) * 1024 + 512)); } while (0)
#define KRD(G, j) do { if (G) { kload2(kf, kp0 + sl_next, j); SBAR(); } } while (0)
#define KRDX(G) do { if (G) { kf[8] = *(const LAS bf16x8*)(kx0 + sl_next); kf[9] = *(const LAS bf16x8*)(kx0 + sl_next + 512); SBAR(); } } while (0)
#define STEP(C0, C1, P0, P1, t, GK, GV, GL) do { SBAR(); \
    const lds_cptr vp_ = vp0 + sl_prev; \
    C0 = MFMA32(kf[8], qx, z16); C1 = MFMA32(kf[9], qx, z16); SBAR(); \
    VRD(0); SBAR(); float sacc = (P0[0] + P0[1]); \
    GAPA(C0 = MFMA32(kf[0], qr[0], C0), P0[2], P0[3], P0[4], P0[5],     pw0[0] = PKW(P0, 0), pw0[1] = PKW(P0, 2), pw0); \
    VRD(4); SBAR(); GAPA(C1 = MFMA32(kf[1], qr[0], C1), P0[6], P0[7], P0[8], P0[9],     pw0[2] = PKW(P0, 4), pw0[3] = PKW(P0, 6), pw0); \
    VRD(1); SBAR(); GAPA(C0 = MFMA32(kf[2], qr[1], C0),   P0[10], P0[11], P0[12], P0[13], pw1[0] = PKW(P0, 8), pw1[1] = PKW(P0, 10), pw1); \
    VRD(5); SBAR(); GAPA(C1 = MFMA32(kf[3], qr[1], C1),   P0[14], P0[15], P1[0], P1[1],   pw1[2] = PKW(P0, 12), pw1[3] = PKW(P0, 14), pw1); \
    VRD(2); SBAR(); GAPA(C0 = MFMA32(kf[4], qr[2], C0),   P1[2], P1[3], P1[4], P1[5],     pw2[0] = PKW(P1, 0), pw2[1] = PKW(P1, 2), pw2); \
    VRD(6); SBAR(); GAPA(C1 = MFMA32(kf[5], qr[2], C1),   P1[6], P1[7], P1[8], P1[9],     pw2[2] = PKW(P1, 4), pw2[3] = PKW(P1, 6), pw2); \
    VRD(3); SBAR(); GAPA(C0 = MFMA32(kf[6], qr[3], C0),   P1[10], P1[11], P1[12], P1[13], pw3[0] = PKW(P1, 8), pw3[1] = PKW(P1, 10), pw3); \
    VRD(7); SBAR(); GAPA(C1 = MFMA32(kf[7], qr[3], C1),   P1[14], P1[15], 0.f, 0.f,       pw3[2] = PKW(P1, 12), pw3[3] = PKW(P1, 14), pw3); \
    l_reg += sacc; \
    if (GK) { DMA_K((t) + 3, sl_cur); } if (GV) { DMA_V((t) + 1, sl_next); } \
    CMASK(C0, C1, t); \
    { float a = MX3(C0[0], C0[1], C1[0]), b_ = MX3(C0[2], C0[3], C1[1]); a = MX3(a, C1[2], C1[3]); \
      _Pragma("unroll") for (int r = 4; r < 16; r += 4) { a = MX3(a, C0[r], C0[r + 1]); b_ = MX3(b_, C0[r + 2], C0[r + 3]); a = MX3(a, C1[r], C1[r + 1]); b_ = MX3(b_, C1[r + 2], C1[r + 3]); } \
      float rm = __builtin_fmaxf(a, b_); { auto rr = __builtin_amdgcn_permlane32_swap(__float_as_uint(rm), __float_as_uint(rm), false, false); rm = __builtin_fmaxf(__uint_as_float(rr[0]), __uint_as_float(rr[1])); } \
      resc = false; \
      if (__builtin_expect(__any(rm > (float)THRL), 0)) { const float dl = __builtin_fmaxf(rm, 0.f); mhat += dl; \
        _Pragma("unroll") for (int r = 0; r < 16; ++r) { C0[r] -= dl; C1[r] -= dl; } \
        qx = qx_build(ct - mhat, hi); asm volatile("" : "+v"(qx)); \
        const float f = __builtin_amdgcn_exp2f(-dl); l_reg *= f; if (hi == 0) wsf[r32] = f; resc = true; } } \
    SBAR(); \
    GAPB(o[0] = MFMA32(PAF(0), VFR(0), o[0]), C0, 0); \
    KRDX(GL); GAPB(o[1] = MFMA32(PAF(0), VFR(4), o[1]), C0, 4); \
    KRD(GL, 0); GAPB(o[0] = MFMA32(PAF(1), VFR(1), o[0]), C0, 8); \
    KRD(GL, 1); GAPB(o[1] = MFMA32(PAF(1), VFR(5), o[1]), C0, 12); \
    KRD(GL, 2); GAPB(o[0] = MFMA32(PAF(2), VFR(2), o[0]), C1, 0); \
    KRD(GL, 3); GAPB(o[1] = MFMA32(PAF(2), VFR(6), o[1]), C1, 4); \
    GAPB(o[0] = MFMA32(PAF(3), VFR(3), o[0]), C1, 8); \
    GAPB(o[1] = MFMA32(PAF(3), VFR(7), o[1]), C1, 12); \
    } while (0)
#define ENDW(tt) do { if ((tt) + 3 < NT) { WAIT_BAR(3); } else if ((tt) + 2 < NT) { WAIT_BAR(1); } else { WAIT_BAR(0); } } while (0)
    int t = 1;
    for (; t + 1 < NT && t < 5; t += 2) {
        STEP(pB0, pB1, pA0, pA1, t, (t + 3 < NT), (t + 1 < NT), (t + 1 < NT));       ENDW(t);     RESC(); ROT();
        STEP(pA0, pA1, pB0, pB1, t + 1, (t + 4 < NT), (t + 2 < NT), (t + 2 < NT));   ENDW(t + 1); RESC(); ROT();
    }
#undef CMASK
#define CMASK(P0, P1, p) do {} while (0)
    for (; t + 5 < NT; t += 2) {
        STEP(pB0, pB1, pA0, pA1, t, true, true, true);       WAIT_BAR(3); RESC(); ROT();
        STEP(pA0, pA1, pB0, pB1, t + 1, true, true, true);   WAIT_BAR(3); RESC(); ROT();
    }
    for (; t + 1 < NT; t += 2) {
        STEP(pB0, pB1, pA0, pA1, t, (t + 3 < NT), (t + 1 < NT), (t + 1 < NT));       ENDW(t);     RESC(); ROT();
        STEP(pA0, pA1, pB0, pB1, t + 1, (t + 4 < NT), (t + 2 < NT), (t + 2 < NT));   ENDW(t + 1); RESC(); ROT();
    }
#undef CMASK
#define CMASK(P0, P1, p) do { const int jb_ = 3 - (p); if (jb_ >= 0) cmask(P0, P1, jb_, qrel, hi); } while (0)
    STEP(pB0, pB1, pA0, pA1, NT - 1, false, false, false); RESC();
    { float sacc = pB0[0] + pB0[1];
#pragma unroll
      for (int r = 2; r < 16; ++r) sacc += pB0[r];
#pragma unroll
      for (int r = 0; r < 16; ++r) sacc += pB1[r];
      l_reg += sacc;
      pw0 = (u32x4){PKW(pB0, 0), PKW(pB0, 2), PKW(pB0, 4), PKW(pB0, 6)}; pw1 = (u32x4){PKW(pB0, 8), PKW(pB0, 10), PKW(pB0, 12), PKW(pB0, 14)};
      pw2 = (u32x4){PKW(pB1, 0), PKW(pB1, 2), PKW(pB1, 4), PKW(pB1, 6)}; pw3 = (u32x4){PKW(pB1, 8), PKW(pB1, 10), PKW(pB1, 12), PKW(pB1, 14)};
      SBAR(); att::pv(o, (int)(unsigned)(uintptr_t)(vp0 + sl_cur), PAF(0), PAF(1), PAF(2), PAF(3)); }
    l_reg = att::swap_lo(l_reg) + att::swap_hi(l_reg);
    if (hi == 0) wsf[32 + r32] = l_reg; asm volatile("s_waitcnt lgkmcnt(0)" ::: "memory");
    float rli[16];
#pragma unroll
    for (int r = 0; r < 16; ++r) rli[r] = __builtin_amdgcn_rcpf(wsf[32 + crow(r, hi)]);
    bf16_t* Ow = O + (rowbase + q0 + wid * 32) * PITCH + h * HD;
    { LAS bf16_t* stg = (LAS bf16_t*)(shm + LDS_OST) + wid * 2048;
#pragma unroll
      for (int r = 0; r < 16; ++r) { const int orow = crow(r, hi);
#pragma unroll
        for (int d0 = 0; d0 < 2; ++d0) stg[orow * 64 + d0 * 32 + r32] = (bf16_t)(cvt_pk_bf16(o[d0][r] * rli[r], 0.f) & 0xffffu); }
      asm volatile("s_waitcnt lgkmcnt(0)" ::: "memory");
#pragma unroll
      for (int i = 0; i < 4; ++i) { const int row = i * 8 + (lane >> 3), ch = lane & 7; const u32x4 v = *(const LAS u32x4*)(stg + row * 64 + ch * 8); *(u32x4*)(Ow + (long)row * PITCH + ch * 8) = v; } }
    asm volatile("s_waitcnt lgkmcnt(0)\n\ts_barrier" ::: "memory");
#undef DMA_K
#undef DMA_V
#undef CMASK
#undef RESC
#undef ROT
#undef PKW
#undef PAF
#undef VFR
#undef PIN
#undef MX3
#undef GAPA
#undef GAPB
#undef EX
#undef VRD
#undef KRD
#undef KRDX
#undef STEP
#undef ENDW
}
#undef SBAR
#undef WAIT_BAR
}

#define XB_TMO      128
#define XB_XCNT(j)  (256  + 64 * (j))
#define XB_XSUB(j)  (1280 + 64 * (j))
#define XB_XGEN(j)  (2304 + 64 * (j))
#define XB_TOP      3328
#define XB_TOPGEN   3392
#define XCD_BAR_WORDS 3456
#define XB_SPIN_CAP (1u << 18)
__device__ __forceinline__ unsigned xb_ld(unsigned* p)              { return __hip_atomic_load(p, __ATOMIC_RELAXED, __HIP_MEMORY_SCOPE_AGENT); }
__device__ __forceinline__ unsigned xb_add(unsigned* p, unsigned v) { return __hip_atomic_fetch_add(p, v, __ATOMIC_RELAXED, __HIP_MEMORY_SCOPE_AGENT); }
__device__ __forceinline__ unsigned xb_xcc_id() { return (unsigned)__builtin_amdgcn_s_getreg((3 << 11) | 20) & 0xFu; }
#define XB_SPIN(cond, bar) do { unsigned _sp = 0; while (cond) { __builtin_amdgcn_s_sleep(1); \
    if ((++_sp & 255u) == 0u) { if (xb_ld(&(bar)[XB_TMO])) break; if (_sp > XB_SPIN_CAP) { atomicAdd(&(bar)[XB_TMO], 1u); break; } } } } while (0)
struct XcdBarrier { unsigned* bar; unsigned x; volatile LAS unsigned* st; };
__device__ __forceinline__ XcdBarrier xcd_barrier_post(unsigned* bar, volatile LAS unsigned* st) {
    XcdBarrier b; b.bar = bar; b.x = xb_xcc_id(); b.st = st;
    if (threadIdx.x == 0) (void)xb_add(&bar[XB_XCNT(b.x)], 1u);
    return b;
}
__device__ __forceinline__ void xcd_barrier_complete(unsigned* bar, unsigned x, unsigned& nloc, unsigned& nx) {
    const unsigned G = gridDim.x * gridDim.y * gridDim.z;
    unsigned sum, cnt, mine, sp = 0u;
    for (;;) {
        sum = 0u; cnt = 0u; mine = 0u;
#pragma unroll
        for (unsigned j = 0; j < 16; ++j) { const unsigned c = xb_ld(&bar[XB_XCNT(j)]); sum += c; cnt += (c > 0u) ? 1u : 0u; mine = (j == x) ? c : mine; }
        if (sum == G) break;
        __builtin_amdgcn_s_sleep(1);
        if ((++sp & 255u) == 0u) { if (xb_ld(&bar[XB_TMO])) break; if (sp > XB_SPIN_CAP) { atomicAdd(&bar[XB_TMO], 1u); break; } }
    }
    nloc = mine > 0u ? mine : 1u; nx = cnt > 0u ? cnt : 1u;
}
__device__ __forceinline__ void xcd_barrier(const XcdBarrier& b) {
    asm volatile("s_waitcnt vmcnt(0)" ::: "memory");
    __syncthreads();
    if (threadIdx.x == 0) {
        unsigned* bar = b.bar;
        __builtin_amdgcn_s_waitcnt(0);
        unsigned nloc = b.st[0], nx = b.st[1];
        if (nloc == 0u) { xcd_barrier_complete(bar, b.x, nloc, nx); b.st[0] = nloc; b.st[1] = nx; }
        const unsigned old = xb_add(&bar[XB_XSUB(b.x)], 1u);
        const unsigned gen = old / nloc;
        if (old + 1u == (gen + 1u) * nloc) {
            __builtin_amdgcn_fence(__ATOMIC_RELEASE, "agent");
            asm volatile("s_waitcnt vmcnt(0)" ::: "memory");
            const unsigned og = xb_add(&bar[XB_TOP], 1u);
            const unsigned tg = og / nx;
            if (og + 1u == (tg + 1u) * nx) xb_add(&bar[XB_TOPGEN], 1u);
            else XB_SPIN(xb_ld(&bar[XB_TOPGEN]) == tg, bar);
            __builtin_amdgcn_fence(__ATOMIC_ACQUIRE, "agent");
            xb_add(&bar[XB_XGEN(b.x)], 1u);
            asm volatile("s_waitcnt vmcnt(0)" ::: "memory");
        } else {
            XB_SPIN(xb_ld(&bar[XB_XGEN(b.x)]) == gen, bar);
            __builtin_amdgcn_fence(__ATOMIC_ACQUIRE, "agent");
            asm volatile("s_waitcnt vmcnt(0)" ::: "memory");
        }
    }
    __syncthreads();
}

__device__ __forceinline__ const void* ldp(const volatile LAS unsigned* tab, int i) {
    const unsigned lo = __builtin_amdgcn_readfirstlane(tab[2 * i]), hi = __builtin_amdgcn_readfirstlane(tab[2 * i + 1]);
    return (const void*)(((unsigned long long)hi << 32) | lo);
}
struct Args {
    const float* x; const float* mem; const float* norm_mix; const float* w_in; const float* b_forget; const float* norm_fox; const float* norm_sb; const float* w_out;
    const float* norm_xattn; const float* norm_mem; const float* w_xq; const float* w_xkv; const float* w_xo; const float* norm_ffn;
    const float* w_rg; const float* b_rg; const float* w_re; const float* b_re; const float* w_gate; const float* w_up; const float* w_down; const float* norm_final;
    float* out; unsigned char* ws;
};

__device__ __forceinline__ void transpose_item(const float* W, int ldw, bf16_t* WT, int ldo, int k0, int n0, int dst_row0, const float* gain, LAS float* scr, int lane) {
#pragma unroll 8
    for (int i = 0; i < 32; ++i) { const int kk = 2 * i + (lane >> 5); float v = W[(size_t)(k0 + kk) * ldw + n0 + (lane & 31)]; if (gain) v *= gain[k0 + kk]; scr[kk * 33 + (lane & 31)] = v; }
    LDS_WAIT(); asm volatile("" ::: "memory");
    const int c = lane & 7;
#pragma unroll
    for (int j = 0; j < 4; ++j) { const int n = (lane >> 3) + 8 * j; const LAS float* s = scr + (8 * c) * 33 + n;
        u32x4 o; o.x = cvt_pk_bf16(s[0 * 33], s[1 * 33]); o.y = cvt_pk_bf16(s[2 * 33], s[3 * 33]); o.z = cvt_pk_bf16(s[4 * 33], s[5 * 33]); o.w = cvt_pk_bf16(s[6 * 33], s[7 * 33]);
        *(u32x4*)(WT + (size_t)(dst_row0 + n) * ldo + k0 + 8 * c) = o; }
    LDS_WAIT(); asm volatile("" ::: "memory");
}

struct SchedDense {
    const char* A; const char* Bt; int nM, nN, G, c; size_t a_tile, b_tile, b_batch; int split_tiles;
    __device__ __forceinline__ bool next(int i, pg8::Unit& u) const {
        int pm, pn; if (!pg8::tile_order(i, G, c, nM, nN, pm, pn)) return false;
        u.a = A + (size_t)pm * a_tile; u.b = Bt + (size_t)pn * b_tile + (size_t)(pm >> 5) * b_batch; u.orow = pm * 256;
        if (split_tiles) { u.aux = pn / split_tiles; u.ocol = (pn % split_tiles) * 256; } else { u.aux = 1; u.ocol = pn * 256; }
        u.rows = nullptr; u.nvalid = 256; return true;
    }
};
struct SchedGH {
    const char* KVm; const char* Wxq; const char* Wxo; int G, c;
    __device__ __forceinline__ bool next(int i, pg8::Unit& u) const {
        const int L = i * G + c; if (L >= 256) return false;
        const int kind = L >> 7, r = L & 127, bh = r >> 2, j = r & 3, b = bh >> 2, h = bh & 3;
        if (kind == 0) { u.a = KVm + ((size_t)(b * 256) * 2048 + h * 256) * 2; u.b = Wxq + ((size_t)(256 * j) * 1024 + h * 256) * 2; u.orow = b * 1024 + h * 256; u.ocol = 256 * j; u.aux = 1; }
        else { u.a = Wxo + ((size_t)(256 * j) * 1024 + h * 256) * 2; u.b = KVm + ((size_t)(b * 256) * 2048 + 1024 + h * 256) * 2; u.orow = b * 1024 + 256 * j; u.ocol = h * 256; u.aux = 2; }
        u.rows = nullptr; u.nvalid = 256; return true;
    }
};
template <int KIND> struct SchedGHk { SchedGH s; __device__ __forceinline__ bool next(int i, pg8::Unit& u) const { const int L = i * s.G + s.c; if (L >= 128) return false; SchedGH t = s; t.G = 1; t.c = 0; return t.next(128 * KIND + L, u); } };
struct EpiGH { bf16_t* GTp; bf16_t* HTp; __device__ __forceinline__ void operator()(const f32x4 (&acc)[2][2][4][2], const pg8::Unit& u, int wr, int wc, int fr, int fq) const {
    pg8::EpiBf16 e{u.aux == 1 ? GTp : HTp, DM, nullptr, 0, 1.f, 1.f}; pg8::Unit v = u; v.aux = 1; e(acc, v, wr, wc, fr, fq); } };
struct SchedMoe {
    const char* A; const char* W; const int* list; const LAS int* tbl; int G, c, NPN; size_t w_exp, w_tile, a_tile; int ocol_w;
    __device__ __forceinline__ bool next(int i, pg8::Unit& u) const {
        const int L = i * G + c; const int tl = L / NPN, pn = L % NPN;
        if (tl >= __builtin_amdgcn_readfirstlane(tbl[16])) return false;
        int e = 0;
#pragma unroll 1
        for (int x = 1; x < NEXP; ++x) { if (tl >= __builtin_amdgcn_readfirstlane(tbl[x])) e = x; }
        const int j = tl - __builtin_amdgcn_readfirstlane(tbl[e]), n = __builtin_amdgcn_readfirstlane(tbl[32 + e]) - 256 * j;
        u.a = A + (size_t)tl * a_tile; u.b = W + (size_t)e * w_exp + (size_t)pn * w_tile; u.orow = tl * 256; u.ocol = pn * ocol_w; u.aux = 1;
        u.rows = list + (size_t)e * M + 256 * j; u.nvalid = n < 256 ? n : 256; return true;
    }
};
__device__ __forceinline__ void moe_table(LAS int* tbl, const unsigned* ctl) {
    if (threadIdx.x == 0) { int base = 0; for (int e = 0; e < NEXP; ++e) { const int n = (int)ctl[CW_CNT + 64 * e]; tbl[e] = base; tbl[32 + e] = n; base += (n + 255) >> 8; } tbl[16] = base; }
    __syncthreads();
}

__global__ void __launch_bounds__(NWAVES * 64, 2) hymba_fwd(Args args) {
    extern __shared__ __attribute__((aligned(16))) unsigned char lds_raw[];
    LAS unsigned char* lds = (LAS unsigned char*)lds_raw;
    volatile LAS unsigned* MISC = (volatile LAS unsigned*)(lds + MISC_OFF);
    const int tid0 = threadIdx.x; const int wave = __builtin_amdgcn_readfirstlane(tid0 >> 6);
    const int G = gridDim.x; const int bx = blockIdx.x; const int vcu = (G % 8 == 0) ? (bx % 8) * (G / 8) + bx / 8 : bx;
    volatile LAS unsigned* ATAB = (volatile LAS unsigned*)(lds + MISC_OFF + 512);
    for (int u = tid0; u < 256; u += NWAVES * 64) ((LAS unsigned*)(lds + MISC_OFF))[u] = 0u;
    __syncthreads();
    if (tid0 == 0) { const float* const* ap = (const float* const*)&args;
#pragma unroll
        for (int i = 0; i < 24; ++i) { const unsigned long long v = (unsigned long long)ap[i]; ATAB[2 * i] = (unsigned)v; ATAB[2 * i + 1] = (unsigned)(v >> 32); } }
    __syncthreads();
#define ARGP(name) ((const float*)ldp(ATAB, (int)(offsetof(Args, name) / 8)))
#define PHASE_PTRS \
    int tid = threadIdx.x; asm volatile("" : "+v"(tid)); const int lane = tid & 63; (void)lane; \
    unsigned char* const ws = (unsigned char*)ldp(ATAB, 23); float* const out = (float*)ldp(ATAB, 22); unsigned* const ctl = (unsigned*)(ws + WS_CTL); (void)out; (void)ctl; \
    bf16_t* const Win_t = (bf16_t*)(ws + WS_WIN); bf16_t* const Wout_t = (bf16_t*)(ws + WS_WOUT); bf16_t* const Wxq_n = (bf16_t*)(ws + WS_WXQ); bf16_t* const Wxkv_t = (bf16_t*)(ws + WS_WXKV); \
    bf16_t* const Wxo_t = (bf16_t*)(ws + WS_WXO); bf16_t* const Wgu_t = (bf16_t*)(ws + WS_WGU); bf16_t* const Wd_t = (bf16_t*)(ws + WS_WD); \
    float* const RX = (float*)(ws + WS_RX); float* const RMEM = (float*)(ws + WS_RMEM); float* const LF = (float*)(ws + WS_LF); float* const CC = (float*)(ws + WS_C2); float* const SSQ = (float*)(ws + WS_SSQ); \
    int* const TOKSLOT = (int*)(ws + WS_TOKSLOT); float* const TOKW = (float*)(ws + WS_TOKW); int* const LIST = (int*)(ws + WS_LIST); \
    bf16_t* const MEMB = (bf16_t*)(ws + WS_MEMB); bf16_t* const KVM = (bf16_t*)(ws + WS_KVM); bf16_t* const GT = (bf16_t*)(ws + WS_GT); bf16_t* const HT = (bf16_t*)(ws + WS_HT); \
    bf16_t* const XB = (bf16_t*)(ws + WS_XB); bf16_t* const QKV = (bf16_t*)(ws + WS_QKV); bf16_t* const H1B = (bf16_t*)(ws + WS_H1B); bf16_t* const U2B = (bf16_t*)(ws + WS_U2B); bf16_t* const HID = (bf16_t*)(ws + WS_HID); \
    bf16_t* const OAB = (bf16_t*)(ws + WS_O); bf16_t* const YB = (bf16_t*)(ws + WS_Y); bf16_t* const KX = (bf16_t*)(ws + WS_KX); (void)KX; \
    (void)Win_t; (void)Wout_t; (void)Wxq_n; (void)Wxkv_t; (void)Wxo_t; (void)Wgu_t; (void)Wd_t; (void)RX; (void)RMEM; (void)LF; (void)CC; (void)SSQ; (void)TOKSLOT; (void)TOKW; (void)LIST; \
    (void)MEMB; (void)KVM; (void)GT; (void)HT; (void)XB; (void)QKV; (void)H1B; (void)U2B; (void)HID; (void)OAB; (void)YB;
    XcdBarrier bar;
    { unsigned char* const ws0 = (unsigned char*)ldp(ATAB, 23); bar = xcd_barrier_post((unsigned*)(ws0 + WS_CTL) + CW_BAR, MISC + 8); }
    const int gw = vcu * NWAVES + wave, NGW = G * NWAVES;


    if (PH(0))
    for (int rep_ = 0; rep_ < REPS(0); ++rep_)
    {
        PHASE_PTRS
        LAS float* wfT = (LAS float*)(lds + RING_OFF);
        LAS float* scr = (LAS float*)(lds + RING_OFF + 32768 + wave * 8448);
        for (int idx = tid; idx < 8 * DM; idx += NWAVES * 64) { const int j = idx >> 10, k = idx & 1023; wfT[idx] = ARGP(w_in)[(size_t)k * WIN_LD + NPROJ + j] * ARGP(norm_mix)[k]; }
        constexpr int I_IN = 16 * 96, I_OUT = 16 * 32, I_XKV = 16 * 64, I_XO = 16 * 32, I_G = 16 * 16 * 8, I_U = I_G, I_D = 16 * 4 * 32, I_XQ = 1024;
        constexpr int NITEMS = I_IN + I_OUT + I_XKV + I_XO + I_G + I_U + I_D + I_XQ;
        for (int it = gw; it < NITEMS; it += NGW) {
            int r = it;
            if (r < I_IN) { const int kb = r / 96, nb = r % 96; transpose_item(ARGP(w_in), WIN_LD, Win_t, DM, 64 * kb, 32 * nb, 32 * nb, ARGP(norm_mix), scr, lane); continue; } r -= I_IN;
            if (r < I_OUT) { const int kb = r / 32, nb = r % 32; const float* gn = (64 * kb < HW) ? ARGP(norm_fox) : (ARGP(norm_sb) - HW); transpose_item(ARGP(w_out), DM, Wout_t, DM, 64 * kb, 32 * nb, 32 * nb, gn, scr, lane); continue; } r -= I_OUT;
            if (r < I_XKV) { const int kb = r / 64, nb = r % 64; transpose_item(ARGP(w_xkv), 2 * DM, Wxkv_t, DM, 64 * kb, 32 * nb, 32 * nb, ARGP(norm_mem), scr, lane); continue; } r -= I_XKV;
            if (r < I_XO) { const int kb = r / 32, nb = r % 32; transpose_item(ARGP(w_xo), DM, Wxo_t, DM, 64 * kb, 32 * nb, 32 * nb, nullptr, scr, lane); continue; } r -= I_XO;
            if (r < I_G + I_U) { const int up = r >= I_G; const int q = up ? r - I_G : r; const int e = q / 128, kb = (q % 128) / 8, nb = q % 8; const int n0 = 32 * nb;
                const float* W = (up ? ARGP(w_up) : ARGP(w_gate)) + (size_t)e * DM * DFF;
                transpose_item(W, DFF, Wgu_t + (size_t)e * 512 * DM, DM, 64 * kb, n0, 256 * (n0 / 128) + (n0 % 128) + (up ? 128 : 0), nullptr, scr, lane); continue; } r -= I_G + I_U;
            if (r < I_D) { const int e = r / 128, kb = (r % 128) / 32, nb = r % 32; transpose_item(ARGP(w_down) + (size_t)e * DFF * DM, DM, Wd_t + (size_t)e * DM * DFF, DFF, 64 * kb, 32 * nb, 32 * nb, nullptr, scr, lane); continue; } r -= I_D;
            { const int k = r; const float gk = ARGP(norm_xattn)[k]; const f32x4* src = (const f32x4*)(ARGP(w_xq) + (size_t)k * DM) + lane; u32x2* dst = (u32x2*)(Wxq_n + (size_t)k * DM) + lane;
#pragma unroll
              for (int j = 0; j < 4; ++j) { const f32x4 v = src[64 * j] * gk; u32x2 w; w.x = cvt_pk_bf16(v[0], v[1]); w.y = cvt_pk_bf16(v[2], v[3]); dst[64 * j] = w; } }
        }
        __syncthreads();
        for (int row = gw; row < M + MEMROWS; row += NGW) {
            const bool is_mem = row >= M; const int r = is_mem ? row - M : row;
            const f32x4* xr = (const f32x4*)((is_mem ? ARGP(mem) : ARGP(x)) + (size_t)r * DM) + lane;
            f32x4 v[4]; float s = 0.f;
#pragma unroll
            for (int j = 0; j < 4; ++j) { v[j] = xr[64 * j]; s += (v[j][0] * v[j][0] + v[j][1] * v[j][1]) + (v[j][2] * v[j][2] + v[j][3] * v[j][3]); }
            const float rinv = rsqrtf(wave_sum(s) * (1.0f / DM) + EPS);
            u32x2* o8 = (u32x2*)((is_mem ? MEMB : XB) + (size_t)r * DM) + lane;
#pragma unroll
            for (int j = 0; j < 4; ++j) { u32x2 w; w.x = cvt_pk_bf16(v[j][0], v[j][1]); w.y = cvt_pk_bf16(v[j][2], v[j][3]); o8[64 * j] = w; }
            if (is_mem) { if (lane == 0) RMEM[r] = rinv; continue; }
            float f[8];
#pragma unroll
            for (int jj = 0; jj < 8; ++jj) { float a = 0.f;
#pragma unroll
                for (int j = 0; j < 4; ++j) { const f32x4 w4 = *(const LAS f32x4*)(wfT + jj * DM + 256 * j + 4 * lane); a += (v[j][0] * w4[0] + v[j][1] * w4[1]) + (v[j][2] * w4[2] + v[j][3] * w4[3]); }
                f[jj] = wave_sum(a); }
            if (lane == 0) RX[r] = rinv;
            if (lane < 8) { float fl = 0.f;
#pragma unroll
                for (int jj = 0; jj < 8; ++jj) fl = (lane == jj) ? f[jj] : fl;
                fl = fl * rinv + ARGP(b_forget)[lane];
                const float ls = fminf(fl, 0.f) - log1pf(expf(-fabsf(fl)));
                LF[(size_t)r * 8 + lane] = ls * LOG2E; }
        }
    }
    xcd_barrier(bar);

    if (PH(1))
    if (vcu < BATCH) {
        PHASE_PTRS
        const int b = vcu, h = wave; float carry = 0.f;
        const float* src = LF + (size_t)b * SEQ * 8 + h; float* dst = CC + ((size_t)b * NH + h) * SEQ;
        for (int i0 = 0; i0 < SEQ; i0 += 256) {
            float v[4];
#pragma unroll
            for (int k = 0; k < 4; ++k) v[k] = src[(size_t)(i0 + 64 * k + lane) * 8];
#pragma unroll
            for (int k = 0; k < 4; ++k) { float x = v[k];
#pragma unroll
                for (int o = 1; o < 64; o <<= 1) { const float y = __shfl_up(x, o); if (lane >= o) x += y; }
                x += carry; dst[i0 + 64 * k + lane] = x; carry = __shfl(x, 63);
                { unsigned hm, lo; fox::split3(-x, hm, lo); u32x4 w; w.x = 0x3F803F80u; w.y = 0x3F80u | (hm << 16); w.z = (hm >> 16) | (lo << 16); w.w = 0u;
                  *(u32x4*)(KX + (((size_t)b * NH + h) * SEQ + i0 + 64 * k + lane) * 8) = w; } }
        }
    }
    if (PH(1))
    for (int rep_ = 0; rep_ < REPS(1); ++rep_)
    {
        PHASE_PTRS
        pg8::Gemm g{DM, DM, DM};
        SchedDense S{(const char*)XB, (const char*)Win_t, M / 256, NPROJ / 256, G, bx, (size_t)256 * DM * 2, (size_t)256 * DM * 2, 0, 2};
        pg8::EpiBf16 E{QKV, HW, RX, QKV_STRIDE, C2, C2};
        pg8::gemm_phase<pg8::EpiBf16, SchedDense, true, false>(lds + RING_OFF, g, S, E);
        SchedDense S2{(const char*)MEMB, (const char*)Wxkv_t, MEMROWS / 256, 2 * DM / 256, G, bx, (size_t)256 * DM * 2, (size_t)256 * DM * 2, 0, 0};
        pg8::EpiBf16 E2{KVM, 2 * DM, RMEM, 0, 1.f, 1.f};
        pg8::gemm_phase<pg8::EpiBf16, SchedDense, true, false>(lds + RING_OFF, g, S2, E2);
    }
    xcd_barrier(bar);

    if (PH(2))
    {
        PHASE_PTRS
        const bf16_t* QA = QKV; const bf16_t* KA = QKV + QKV_STRIDE; const bf16_t* VA = QKV + 2 * QKV_STRIDE;
        const bf16_t* QBp = QKV + 3 * QKV_STRIDE; const bf16_t* KBp = QKV + 4 * QKV_STRIDE; const bf16_t* VBp = QKV + 5 * QKV_STRIDE;
        bf16_t* OA = OAB; bf16_t* OB = OAB + QKV_STRIDE;
        LAS char* shm = (LAS char*)(lds + RING_OFF);
        for (int rep = 0; rep < REP_FOX; ++rep)
        for (int i = 0; i < 8; ++i) { const int s = vcu & 7, bh = (vcu >> 3) + 32 * (i >> 2), k = i & 3; const int qb = (k == 0) ? s : (k == 1) ? 15 - s : (k == 2) ? 16 + s : 31 - s;
#if FOX_V2
            fox::fox_unit<8>(bh, qb, QA, KA, VA, OA, CC + (size_t)bh * SEQ, KX + (size_t)bh * SEQ * 8, shm); }
#else
            att::attn_unit<0>(bh >> 3, bh & 7, qb, QA, KA, VA, OA, CC + (size_t)bh * SEQ, shm); }
#endif
        for (int rep = 0; rep < REP_SB; ++rep)
        for (int i = 0; i < 8; ++i) { const int bh = vcu >> 2, qb = 8 * (vcu & 3) + i;
            att::attn_unit<1>(bh >> 3, bh & 7, qb, QBp, KBp, VBp, OB, nullptr, shm); }
    }
    xcd_barrier(bar);

    if (PH(3))
    for (int rep_ = 0; rep_ < REPS(3); ++rep_)
    {
        PHASE_PTRS
        const bf16_t* OA = OAB; const bf16_t* OB = OAB + QKV_STRIDE; bf16_t* MIX = XB;
        for (int row = gw; row < M; row += NGW) {
            const u32x4 a = *((const u32x4*)(OA + (size_t)row * HW) + lane), b = *((const u32x4*)(OB + (size_t)row * HW) + lane);
            float fa[8] = {bf16lo(a.x), bf16hi(a.x), bf16lo(a.y), bf16hi(a.y), bf16lo(a.z), bf16hi(a.z), bf16lo(a.w), bf16hi(a.w)};
            float fb[8] = {bf16lo(b.x), bf16hi(b.x), bf16lo(b.y), bf16hi(b.y), bf16lo(b.z), bf16hi(b.z), bf16lo(b.w), bf16hi(b.w)};
            float sa = 0.f, sb = 0.f;
#pragma unroll
            for (int j = 0; j < 8; ++j) { sa += fa[j] * fa[j]; sb += fb[j] * fb[j]; }
            const float ra = rsqrtf(wave_sum(sa) * (1.0f / HW) + EPS), rb = rsqrtf(wave_sum(sb) * (1.0f / HW) + EPS);
            u32x4 wa, wb;
            wa.x = cvt_pk_bf16(fa[0] * ra, fa[1] * ra); wa.y = cvt_pk_bf16(fa[2] * ra, fa[3] * ra); wa.z = cvt_pk_bf16(fa[4] * ra, fa[5] * ra); wa.w = cvt_pk_bf16(fa[6] * ra, fa[7] * ra);
            wb.x = cvt_pk_bf16(fb[0] * rb, fb[1] * rb); wb.y = cvt_pk_bf16(fb[2] * rb, fb[3] * rb); wb.z = cvt_pk_bf16(fb[4] * rb, fb[5] * rb); wb.w = cvt_pk_bf16(fb[6] * rb, fb[7] * rb);
            *((u32x4*)(MIX + (size_t)row * DM) + lane) = wa; *((u32x4*)(MIX + (size_t)row * DM + HW) + lane) = wb;
        }
        __syncthreads();
        pg8::Gemm g{0, 0, 256};
        SchedGH S{(const char*)KVM, (const char*)Wxq_n, (const char*)Wxo_t, G, bx};
        EpiGH E{GT, HT};
        g.lda = 2 * DM; g.ldb = DM; SchedGHk<0> S0{S}; pg8::gemm_phase<EpiGH, SchedGHk<0>, true, false>(lds + RING_OFF, g, S0, E);
        g.lda = DM; g.ldb = 2 * DM; SchedGHk<1> S1{S}; pg8::gemm_phase<EpiGH, SchedGHk<1>, true, false>(lds + RING_OFF, g, S1, E);
    }
    xcd_barrier(bar);

    if (PH(4))
    for (int rep_ = 0; rep_ < REPS(4); ++rep_)
    {
        PHASE_PTRS
        pg8::Gemm g{DM, DM, DM};
        SchedDense S{(const char*)XB, (const char*)Wout_t, M / 256, DM / 256, G, bx, (size_t)256 * DM * 2, (size_t)256 * DM * 2, 0, 0};
        pg8::EpiResid E{ARGP(x), out, H1B, SSQ};
        pg8::gemm_phase<pg8::EpiResid, SchedDense, true, false>(lds + RING_OFF, g, S, E);
    }
    xcd_barrier(bar);

    if (PH(5))
    for (int rep_ = 0; rep_ < REPS(5); ++rep_)
    {
        PHASE_PTRS
        pg8::Gemm g{DM, DM, DM};
        SchedDense S{(const char*)H1B, (const char*)GT, M / 256, DM / 256, G, bx, (size_t)256 * DM * 2, (size_t)256 * DM * 2, (size_t)DM * DM * 2, 0};
        pg8::EpiSoftmax E{XB, SSQ, (LAS float*)(lds + EXTRA_OFF)};
        pg8::gemm_phase<pg8::EpiSoftmax, SchedDense, true, false>(lds + RING_OFF, g, S, E);
    }
    xcd_barrier(bar);

    if (PH(6))
    {
        PHASE_PTRS
        pg8::Gemm g{DM, DM, DM};
        SchedDense S{(const char*)XB, (const char*)HT, M / 256, DM / 256, G, bx, (size_t)256 * DM * 2, (size_t)256 * DM * 2, (size_t)DM * DM * 2, 0};
        pg8::EpiResid E{out, out, nullptr, nullptr};
        pg8::gemm_phase<pg8::EpiResid, SchedDense, true, false>(lds + RING_OFF, g, S, E);
    }
    xcd_barrier(bar);

    if (PH(7))
    {
        PHASE_PTRS
        LAS float* wT = (LAS float*)(lds + RING_OFF);
        for (int idx = tid; idx < 20 * DM; idx += NWAVES * 64) { const int j = idx >> 10, k = idx & 1023; wT[idx] = (j < 4) ? ARGP(w_rg)[(size_t)k * 4 + j] : ARGP(w_re)[(size_t)k * 16 + (j - 4)]; }
        __syncthreads();
        for (int row = gw; row < M; row += NGW) {
            const f32x4* hr = (const f32x4*)(out + (size_t)row * DM) + lane; const f32x4* gp = (const f32x4*)ARGP(norm_ffn) + lane;
            f32x4 v[4]; float s = 0.f;
#pragma unroll
            for (int j = 0; j < 4; ++j) { v[j] = hr[64 * j]; s += (v[j][0] * v[j][0] + v[j][1] * v[j][1]) + (v[j][2] * v[j][2] + v[j][3] * v[j][3]); }
            const float rinv = rsqrtf(wave_sum(s) * (1.0f / DM) + EPS);
            u32x2* o8 = (u32x2*)(U2B + (size_t)row * DM) + lane;
#pragma unroll
            for (int j = 0; j < 4; ++j) { v[j] = v[j] * rinv * gp[64 * j]; u32x2 w; w.x = cvt_pk_bf16(v[j][0], v[j][1]); w.y = cvt_pk_bf16(v[j][2], v[j][3]); o8[64 * j] = w; }
            float lg[20];
#pragma unroll
            for (int jj = 0; jj < 20; ++jj) { float a = 0.f;
#pragma unroll
                for (int j = 0; j < 4; ++j) { const f32x4 w4 = *(const LAS f32x4*)(wT + jj * DM + 256 * j + 4 * lane); a += (v[j][0] * w4[0] + v[j][1] * w4[1]) + (v[j][2] * w4[2] + v[j][3] * w4[3]); }
                lg[jj] = wave_sum(a); asm volatile("" : "+v"(lg[jj]) :: "memory"); }
            float g0 = lg[0] + ARGP(b_rg)[0], g1 = lg[1] + ARGP(b_rg)[1], g2 = lg[2] + ARGP(b_rg)[2], g3 = lg[3] + ARGP(b_rg)[3];
            int gi = 0; float gm = g0; if (g1 > gm) { gm = g1; gi = 1; } if (g2 > gm) { gm = g2; gi = 2; } if (g3 > gm) { gm = g3; gi = 3; }
            const float gval = 1.0f / (expf(g0 - gm) + expf(g1 - gm) + expf(g2 - gm) + expf(g3 - gm));
            float el[4];
#pragma unroll
            for (int j = 0; j < 4; ++j) { const float e0 = lg[4 + j], e1 = lg[8 + j], e2 = lg[12 + j], e3 = lg[16 + j]; el[j] = ((gi == 0) ? e0 : (gi == 1) ? e1 : (gi == 2) ? e2 : e3) + ARGP(b_re)[gi * 4 + j]; }
            int i0 = 0; float m0 = el[0];
#pragma unroll
            for (int j = 1; j < 4; ++j) if (el[j] > m0) { m0 = el[j]; i0 = j; }
            int i1 = -1; float m1 = -3.0e38f;
#pragma unroll
            for (int j = 0; j < 4; ++j) if (j != i0 && el[j] > m1) { m1 = el[j]; i1 = j; }
            const float w0 = 1.0f / (1.0f + expf(m1 - m0)), w1 = 1.0f - w0;
            if (lane < 2) { const int e = gi * 4 + (lane == 0 ? i0 : i1); const float w = gval * (lane == 0 ? w0 : w1);
                const int pos = (int)__hip_atomic_fetch_add(ctl + CW_CNT + 64 * e, 1u, __ATOMIC_RELAXED, __HIP_MEMORY_SCOPE_AGENT);
                LIST[(size_t)e * M + pos] = row; TOKSLOT[(size_t)row * 2 + lane] = (e << 20) | pos; TOKW[(size_t)row * 2 + lane] = w; }
        }
    }
    xcd_barrier(bar);

    if (PH(8))
    for (int rep_ = 0; rep_ < REPS(8); ++rep_)
    {
        PHASE_PTRS
        pg8::Gemm g{DM, DM, DM};
        LAS int* tbl = (LAS int*)(lds + EXTRA_OFF + 8192); moe_table(tbl, ctl);
        SchedMoe S; S.A = (const char*)U2B; S.W = (const char*)Wgu_t; S.list = LIST; S.tbl = tbl; S.G = G; S.c = bx; S.NPN = 2; S.w_exp = (size_t)512 * DM * 2; S.w_tile = (size_t)256 * DM * 2; S.a_tile = 0; S.ocol_w = 128;
        pg8::EpiSwiglu E{HID};
        pg8::gemm_phase<pg8::EpiSwiglu, SchedMoe, true, true>(lds + RING_OFF, g, S, E);
    }
    xcd_barrier(bar);

    if (PH(9))
    for (int rep_ = 0; rep_ < REPS(9); ++rep_)
    {
        PHASE_PTRS
        pg8::Gemm g{DFF, DFF, DFF};
        LAS int* tbl = (LAS int*)(lds + EXTRA_OFF + 8192);
        SchedMoe S; S.A = (const char*)HID; S.W = (const char*)Wd_t; S.list = LIST; S.tbl = tbl; S.G = G; S.c = bx; S.NPN = 4; S.w_exp = (size_t)DM * DFF * 2; S.w_tile = (size_t)256 * DFF * 2; S.a_tile = (size_t)256 * DFF * 2; S.ocol_w = 256;
        pg8::EpiBf16 E{YB, DM, nullptr, 0, 1.f, 1.f};
        pg8::gemm_phase<pg8::EpiBf16, SchedMoe, true, false>(lds + RING_OFF, g, S, E);
    }
    xcd_barrier(bar);

    if (PH(10))
    {
        PHASE_PTRS
        const LAS int* tb = (const LAS int*)(lds + EXTRA_OFF + 8192);
        for (int row = gw; row < M; row += NGW) {
            const int s0 = TOKSLOT[(size_t)row * 2], s1 = TOKSLOT[(size_t)row * 2 + 1]; const float w0 = TOKW[(size_t)row * 2], w1 = TOKW[(size_t)row * 2 + 1];
            const int r0 = tb[s0 >> 20] * 256 + (s0 & 0xfffff), r1 = tb[s1 >> 20] * 256 + (s1 & 0xfffff);
            f32x4* hr = (f32x4*)(out + (size_t)row * DM) + lane; const u32x2* y0 = (const u32x2*)(YB + (size_t)r0 * DM) + lane; const u32x2* y1 = (const u32x2*)(YB + (size_t)r1 * DM) + lane;
            const f32x4* gp = (const f32x4*)ARGP(norm_final) + lane;
            f32x4 v[4]; float s = 0.f;
#pragma unroll
            for (int j = 0; j < 4; ++j) { const u32x2 a = y0[64 * j], b = y1[64 * j]; f32x4 h = hr[64 * j];
                h[0] += w0 * bf16lo(a.x) + w1 * bf16lo(b.x); h[1] += w0 * bf16hi(a.x) + w1 * bf16hi(b.x); h[2] += w0 * bf16lo(a.y) + w1 * bf16lo(b.y); h[3] += w0 * bf16hi(a.y) + w1 * bf16hi(b.y);
                v[j] = h; s += (h[0] * h[0] + h[1] * h[1]) + (h[2] * h[2] + h[3] * h[3]); }
            const float rinv = rsqrtf(wave_sum(s) * (1.0f / DM) + EPS);
#pragma unroll
            for (int j = 0; j < 4; ++j) hr[64 * j] = v[j] * rinv * gp[64 * j];
        }
    }
}

extern "C" void kernel_launch(void* const* d_in, const int* in_sizes, int n_in, void* d_out, int out_size, void* d_ws, size_t ws_size, hipStream_t stream) {
    static int grid = 0;
    if (grid == 0) {
        if (n_in != 22 || in_sizes[0] != M * DM || out_size != M * DM || ws_size < WS_END) { fprintf(stderr, "kernel_launch: unexpected shapes (n_in %d, in0 %d, out %d, ws %zu)\n", n_in, n_in > 0 ? in_sizes[0] : -1, out_size, ws_size); grid = -1; return; }
        int dev = 0, cus = 0, per_cu = 0;
        if (hipGetDevice(&dev) != hipSuccess || hipDeviceGetAttribute(&cus, hipDeviceAttributeMultiprocessorCount, dev) != hipSuccess) { grid = -1; return; }
        if (hipFuncSetAttribute((const void*)hymba_fwd, hipFuncAttributeMaxDynamicSharedMemorySize, LDS_BYTES) != hipSuccess) { fprintf(stderr, "kernel_launch: hipFuncSetAttribute failed\n"); grid = -1; return; }
        if (hipOccupancyMaxActiveBlocksPerMultiprocessor(&per_cu, (const void*)hymba_fwd, NWAVES * 64, LDS_BYTES) != hipSuccess || per_cu < 1) { fprintf(stderr, "kernel_launch: occupancy query reports %d\n", per_cu); }
        (void)hipGetLastError();
        grid = cus;
    }
    if (grid < 0) return;
    (void)hipMemsetAsync((char*)d_ws + WS_CTL, 0, CTL_ZERO_BYTES, stream);
    Args a{};
    const float** p = (const float**)&a;
    for (int i = 0; i < 22; ++i) p[i] = (const float*)d_in[i];
    a.out = (float*)d_out; a.ws = (unsigned char*)d_ws;
    hipLaunchKernelGGL(hymba_fwd, dim3(grid), dim3(NWAVES * 64), LDS_BYTES, stream, a);
}
```

```cpp
#include <hip/hip_runtime.h>
#include <hip/hip_bf16.h>
#include <cstdio>
#include <cstdint>

#define LAS __attribute__((address_space(3)))
#define GAS __attribute__((address_space(1)))
typedef unsigned short bf16_t;
typedef short bf16x8 __attribute__((ext_vector_type(8)));
typedef short s16x4 __attribute__((ext_vector_type(4)));
typedef float f32x4 __attribute__((ext_vector_type(4)));
typedef float f32x2 __attribute__((ext_vector_type(2)));
typedef float f32x16 __attribute__((ext_vector_type(16)));
typedef unsigned u32x4 __attribute__((ext_vector_type(4)));
typedef unsigned u32x2 __attribute__((ext_vector_type(2)));
typedef __bf16 bf16x2_t __attribute__((ext_vector_type(2)));

constexpr int BATCH = 8, SEQ = 8192, DM = 1024, M = BATCH * SEQ;
constexpr int NH = 8, HD = 64, HW = NH * HD;
constexpr int NPROJ = 3 * HW * 2;
constexpr int WIN_LD = NPROJ + NH;
constexpr int NMEM = 256, XH = 4, XD = 256, MEMROWS = BATCH * NMEM;
constexpr int NEXP = 16, DFF = 256;
constexpr float EPS = 1e-6f;
constexpr float LOG2E = 1.4426950408889634f;
constexpr float C2 = 0.125f * LOG2E;
constexpr float XSC = 0.0625f * LOG2E;
constexpr float SB_EXIT = -173.0f;

constexpr size_t MiB = 1u << 20;
constexpr size_t WS_CTL = 0, CTL_ZERO_BYTES = 1 * MiB;
constexpr size_t WS_WIN = 1 * MiB;
constexpr size_t WS_WOUT = 7 * MiB;
constexpr size_t WS_WXQ = 9 * MiB;
constexpr size_t WS_WXKV = 11 * MiB;
constexpr size_t WS_WXO = 15 * MiB;
constexpr size_t WS_WGU = 17 * MiB;
constexpr size_t WS_WD = 33 * MiB;
constexpr size_t WS_RX = 41 * MiB;
constexpr size_t WS_RMEM = WS_RX + 256 * 1024;
constexpr size_t WS_LF = 42 * MiB;
constexpr size_t WS_C2 = 44 * MiB;
constexpr size_t WS_SSQ = 46 * MiB;
constexpr size_t WS_TOKSLOT = 50 * MiB;
constexpr size_t WS_TOKW = 51 * MiB;
constexpr size_t WS_LIST = 52 * MiB;
constexpr size_t WS_MEMB = 56 * MiB;
constexpr size_t WS_KVM = 60 * MiB;
constexpr size_t WS_GT = 68 * MiB;
constexpr size_t WS_HT = 84 * MiB;
constexpr size_t WS_KX = 100 * MiB;
constexpr size_t WS_XB = 128 * MiB;
constexpr size_t WS_QKV = 256 * MiB;
constexpr size_t WS_H1B = 256 * MiB, WS_U2B = 384 * MiB, WS_HID = 512 * MiB;
constexpr size_t WS_O = 640 * MiB;
constexpr size_t WS_Y = 704 * MiB;
constexpr size_t WS_END = 1024 * MiB;
constexpr size_t QKV_STRIDE = (size_t)M * HW;
constexpr int MAXTILES = M * 2 / 256 + NEXP;
static_assert(WS_Y + (size_t)MAXTILES * 256 * 1024 * 2 <= WS_END, "ws map");
static_assert(WS_HID + (size_t)MAXTILES * 256 * 256 * 2 <= WS_O, "ws map");
constexpr int CW_BAR = 4096;
constexpr int CW_KN = 20480;
constexpr int CW_CNT = 16384;

constexpr int RING_OFF = 0, RING_BYTES = 131072;
constexpr int EXTRA_OFF = 131072, EXTRA_BYTES = 16384;
constexpr int MISC_OFF = EXTRA_OFF + EXTRA_BYTES;
constexpr int LDS_BYTES = MISC_OFF + 1024;
constexpr int NWAVES = 8;
#ifndef PHASE_MASK
#define PHASE_MASK 0x7ff
#endif
#define PH(n) ((PHASE_MASK >> (n)) & 1)
#ifndef FOX_V2
#define FOX_V2 1
#endif
#ifndef REP_MASK
#define REP_MASK 0
#endif
#define REPS(n) (1 + ((REP_MASK >> (n)) & 1))
#ifndef REP_FOX
#define REP_FOX 1
#endif
#ifndef REP_SB
#define REP_SB 1
#endif

__device__ __forceinline__ unsigned cvt_pk_bf16(float lo, float hi) { f32x2 v = {lo, hi}; bf16x2_t b = __builtin_convertvector(v, bf16x2_t); return __builtin_bit_cast(unsigned, b); }
__device__ __forceinline__ float bf16lo(unsigned u) { return __uint_as_float(u << 16); }
__device__ __forceinline__ float bf16hi(unsigned u) { return __uint_as_float(u & 0xffff0000u); }
__device__ __forceinline__ float wave_sum(float v) {
#pragma unroll
    for (int o = 1; o < 64; o <<= 1) v += __shfl_xor(v, o);
    return v;
}
#define LDS_WAIT() asm volatile("s_waitcnt lgkmcnt(0)" ::: "memory")
#define VM_WAIT() asm volatile("s_waitcnt vmcnt(0)" ::: "memory")

namespace pg8 {
constexpr int BM = 256, BK = 64, HALF = 128, HTB = HALF * BK * 2, STAGE_BYTES = 8 * HTB, NXCD = 8, WGM = 8;
__host__ __device__ __forceinline__ int lds_byte(int r, int c) { const int st = (r >> 4) * 2 + (c >> 5), rr = r & 15, cc = c & 31, ob = rr * 64 + cc * 2; return st * 1024 + (ob ^ (((ob >> 9) & 1) << 5)); }
__host__ __device__ __forceinline__ void stage_rc(int b, int& R, int& C) { const int st = b / 1024, sb = b % 1024, swz = sb ^ (((sb >> 9) & 1) << 5); R = (st >> 1) * 16 + swz / 64; C = (st & 1) * 32 + (swz % 64) / 2; }
__host__ __device__ __forceinline__ int perm32(int rho) { const int n = rho >> 4, i = rho & 15; return 8 * (i >> 2) + 4 * n + (i & 3); }

struct Unit { const char* a; const char* b; int orow, ocol, aux; const int* rows; int nvalid; };
struct Gemm { int lda, ldb, K; };

__device__ __forceinline__ bool tile_order(int i, int G, int c, int nM, int nN, int& pm, int& pn) {
    const int nwg = nM * nN; const long L = (long)i * G + c; if (L >= nwg) return false;
    int wgid = (int)L; { const int q = nwg / NXCD, r = nwg % NXCD, xcd = wgid % NXCD, off = wgid / NXCD; wgid = (xcd < r ? xcd * (q + 1) : r * (q + 1) + (xcd - r) * q) + off; }
    const int nig = WGM * nN, gid = wgid / nig, fm = gid * WGM, gsz = (nM - fm) < WGM ? (nM - fm) : WGM;
    pm = fm + ((wgid % nig) % gsz); pn = (wgid % nig) / gsz; return true;
}

template <class Epi, class Sched, bool ALIGN_EPI, bool GATHER>
__device__ __forceinline__ void gemm_phase(LAS unsigned char* lds, const Gemm g, const Sched& S, const Epi& E) {
    int tid = threadIdx.x; asm volatile("" : "+v"(tid));
    const int wid = __builtin_amdgcn_readfirstlane(tid >> 6), lane = tid & 63, wr = wid >> 2, wc = wid & 3, fr = lane & 15, fq = lane >> 4;
    const int K = g.K, nt = K / BK;
    unsigned voffA[2], voffB[2]; int RA[2], CA[2];
#pragma unroll
    for (int i = 0; i < 2; ++i) { int R, C; stage_rc(tid * 16 + i * 8192, R, C); const int Rb = (R & ~31) + perm32(R & 31);
        RA[i] = R; CA[i] = C; voffA[i] = (unsigned)(R * g.lda + C) * 2u; voffB[i] = (unsigned)(Rb * g.ldb + C) * 2u; }
    const size_t kstep = (size_t)(BK * 2);
    const size_t hstepA = (size_t)HALF * g.lda * 2, hstepB = (size_t)HALF * g.ldb * 2;
    const unsigned ldsw = (unsigned)wid * 1024u;
    const int aoff = lds_byte(wr * 64 + fr, fq * 8), boff = lds_byte(wc * 32 + fr, fq * 8);
#define PG8_SA(b, h) (((b) * 2 + (h)) * HTB)
#define PG8_SB(b, h) ((4 + (b) * 2 + (h)) * HTB)
#define PG8_STAGE2(bufoff, gbase, v0, v1) do { \
        __builtin_amdgcn_global_load_lds((const unsigned*)((const char*)(gbase) + (v0)), (LAS unsigned*)(lds + (bufoff) + ldsw), 16, 0, 0); \
        __builtin_amdgcn_global_load_lds((const unsigned*)((const char*)(gbase) + (v1)), (LAS unsigned*)(lds + (bufoff) + ldsw + 8192), 16, 0, 0); } while (0)
#define PG8_STAGEB(bufoff, gbase) PG8_STAGE2(bufoff, gbase, voffB[0], voffB[1])
#define PG8_STAGEA(bufoff, kptr, h, NX) do { if constexpr (GATHER) { const unsigned v0_ = (NX) ? gvn[h][0] : gvc[h][0], v1_ = (NX) ? gvn[h][1] : gvc[h][1]; PG8_STAGE2(bufoff, kptr, v0_, v1_); } \
        else { PG8_STAGE2(bufoff, (kptr) + (h) * hstepA, voffA[0], voffA[1]); } } while (0)
#define PG8_LDA(dst, b, h) do { _Pragma("unroll") for (int m = 0; m < 4; ++m) _Pragma("unroll") for (int k = 0; k < 2; ++k) dst[m][k] = *(const LAS bf16x8*)(lds + PG8_SA(b, h) + aoff + m * 2048 + k * 1024); } while (0)
#define PG8_LDB(dst, b, h) do { _Pragma("unroll") for (int n = 0; n < 2; ++n) _Pragma("unroll") for (int k = 0; k < 2; ++k) dst[n][k] = *(const LAS bf16x8*)(lds + PG8_SB(b, h) + boff + n * 2048 + k * 1024); } while (0)
#define PG8_MMA(ai, bj, At, Bt) do { __builtin_amdgcn_s_setprio(1); _Pragma("unroll") for (int m = 0; m < 4; ++m) _Pragma("unroll") for (int n = 0; n < 2; ++n) _Pragma("unroll") for (int k = 0; k < 2; ++k) \
        acc[ai][bj][m][n] = __builtin_amdgcn_mfma_f32_16x16x32_bf16(Bt[n][k], At[m][k], acc[ai][bj][m][n], 0, 0, 0); __builtin_amdgcn_s_setprio(0); } while (0)
#define PG8_WAIT_V(n) asm volatile("s_waitcnt vmcnt(" #n ")" ::: "memory")
#define PG8_WAIT_L(n) asm volatile("s_waitcnt lgkmcnt(" #n ")" ::: "memory")
#define PG8_BAR __builtin_amdgcn_s_barrier()
#define PG8_SCHED __builtin_amdgcn_sched_barrier(0)
#define PG8_GATHER_OFFS(dst, u) do { _Pragma("unroll") for (int h_ = 0; h_ < 2; ++h_) _Pragma("unroll") for (int i_ = 0; i_ < 2; ++i_) { const int r_ = h_ * HALF + RA[i_]; \
        const int idx_ = (u).rows[r_ < (u).nvalid ? r_ : 0]; dst[h_][i_] = (unsigned)(idx_ * g.lda + CA[i_]) * 2u; } } while (0)
    Unit cur, nxt; int ui = 0;
    if (!S.next(0, cur)) return;
    unsigned gvc[2][2] = {{0u, 0u}, {0u, 0u}}, gvn[2][2] = {{0u, 0u}, {0u, 0u}};
    if constexpr (GATHER) { PG8_GATHER_OFFS(gvc, cur); }
    f32x4 acc[2][2][4][2];
#pragma unroll
    for (int a = 0; a < 2; ++a)
#pragma unroll
        for (int b = 0; b < 2; ++b)
#pragma unroll
            for (int m = 0; m < 4; ++m)
#pragma unroll
                for (int n = 0; n < 2; ++n) acc[a][b][m][n] = (f32x4){0.f, 0.f, 0.f, 0.f};
    bf16x8 At[4][2], B0[2][2], B1[2][2];
    const char* cA = cur.a; const char* cB = cur.b;
    PG8_STAGEB(PG8_SB(0, 0), cB); PG8_STAGEB(PG8_SB(0, 1), cB + hstepB); PG8_STAGEA(PG8_SA(0, 0), cA, 0, false); PG8_STAGEA(PG8_SA(0, 1), cA, 1, false);
    if (wr == 1) PG8_BAR;
    PG8_WAIT_V(2); PG8_BAR;
    PG8_STAGEB(PG8_SB(1, 0), cB + kstep); PG8_STAGEA(PG8_SA(1, 0), cA + kstep, 0, false); PG8_STAGEB(PG8_SB(1, 1), cB + hstepB + kstep);
    PG8_WAIT_V(6); PG8_BAR;
    for (;;) {
        const bool has_next = S.next(ui + 1, nxt);
        const char* nA = has_next ? nxt.a : cA; const char* nB = has_next ? nxt.b : cB;
        if constexpr (GATHER) { if (has_next) { PG8_GATHER_OFFS(gvn, nxt); } else { gvn[0][0] = gvc[0][0]; gvn[0][1] = gvc[0][1]; gvn[1][0] = gvc[1][0]; gvn[1][1] = gvc[1][1]; } }
#pragma unroll 1
        for (int t = 0; t < nt; t += 2) {
            const bool last = (t == nt - 2);
            const char* a1 = cA + (size_t)(t + 1) * kstep;
            const char* a2 = last ? nA : cA + (size_t)(t + 2) * kstep; const char* b2 = last ? nB : cB + (size_t)(t + 2) * kstep;
            const char* a3 = a2 + kstep; const char* b3 = b2 + kstep;
            PG8_LDB(B0, 0, 0); PG8_LDB(B1, 0, 1); PG8_SCHED; PG8_LDA(At, 0, 0); PG8_STAGEA(PG8_SA(1, 1), a1, 1, false);
            PG8_WAIT_V(8); PG8_WAIT_L(0); PG8_BAR; PG8_MMA(0, 0, At, B0); PG8_MMA(0, 1, At, B1); PG8_BAR; PG8_SCHED;
            PG8_LDA(At, 0, 1); PG8_STAGEB(PG8_SB(0, 0), b2); PG8_STAGEB(PG8_SB(0, 1), b2 + hstepB); PG8_STAGEA(PG8_SA(0, 0), a2, 0, last);
            PG8_WAIT_V(8); PG8_WAIT_L(0); PG8_BAR; PG8_MMA(1, 0, At, B0); PG8_MMA(1, 1, At, B1); PG8_BAR; PG8_SCHED;
            PG8_LDB(B0, 1, 0); PG8_LDB(B1, 1, 1); PG8_SCHED; PG8_LDA(At, 1, 0); PG8_STAGEA(PG8_SA(0, 1), a2, 1, last);
            PG8_WAIT_V(8); PG8_WAIT_L(0); PG8_BAR; PG8_MMA(0, 0, At, B0); PG8_MMA(0, 1, At, B1); PG8_BAR; PG8_SCHED;
            PG8_LDA(At, 1, 1); PG8_STAGEB(PG8_SB(1, 0), b3); PG8_STAGEB(PG8_SB(1, 1), b3 + hstepB); PG8_STAGEA(PG8_SA(1, 0), a3, 0, last);
            PG8_WAIT_V(8); PG8_WAIT_L(0); PG8_BAR; PG8_MMA(1, 0, At, B0); PG8_MMA(1, 1, At, B1); PG8_BAR; PG8_SCHED;
        }
        if constexpr (ALIGN_EPI) { if (wr == 0) PG8_BAR; }
        { int fr2 = fr, fq2 = fq; asm volatile("" : "+v"(fr2), "+v"(fq2));
          E(acc, cur, wr, wc, fr2, fq2); }
        if (!has_next) break;
#pragma unroll
        for (int a = 0; a < 2; ++a)
#pragma unroll
            for (int b = 0; b < 2; ++b)
#pragma unroll
                for (int m = 0; m < 4; ++m)
#pragma unroll
                    for (int n = 0; n < 2; ++n) acc[a][b][m][n] = (f32x4){0.f, 0.f, 0.f, 0.f};
        cur = nxt; cA = nA; cB = nB; ++ui;
        if constexpr (GATHER) { gvc[0][0] = gvn[0][0]; gvc[0][1] = gvn[0][1]; gvc[1][0] = gvn[1][0]; gvc[1][1] = gvn[1][1]; }
        if constexpr (ALIGN_EPI) { if (wr == 1) PG8_BAR; }
    }
    PG8_WAIT_V(0);
    if constexpr (!ALIGN_EPI) { if (wr == 0) PG8_BAR; }
    PG8_BAR;
#undef PG8_SA
#undef PG8_SB
#undef PG8_STAGE2
#undef PG8_STAGEA
#undef PG8_STAGEB
#undef PG8_LDA
#undef PG8_LDB
#undef PG8_MMA
#undef PG8_WAIT_V
#undef PG8_WAIT_L
#undef PG8_BAR
#undef PG8_SCHED
#undef PG8_GATHER_OFFS
}

#define EPI_ROW(u, ai, m) ((u).orow + (ai) * HALF + wr * 64 + (m) * 16 + fr)
#define EPI_COL(u, bj) ((u).ocol + (bj) * HALF + wc * 32 + 8 * fq)
struct EpiBf16 {
    bf16_t* O; int ldc; const float* rs; size_t stride; float sc0, sc3;
    unsigned* kn;
    __device__ __forceinline__ void operator()(const f32x4 (&acc)[2][2][4][2], const Unit& u, int wr, int wc, int fr, int fq) const {
        bf16_t* base = O + (size_t)u.aux * stride;
        const float sc = (u.aux == 0) ? sc0 : ((u.aux == 3) ? sc3 : 1.f);
        float nmax[2] = {0.f, 0.f}; const bool dokn = kn && u.aux == 1;
#pragma unroll
        for (int ai = 0; ai < 2; ++ai)
#pragma unroll
            for (int m = 0; m < 4; ++m) { const int row = EPI_ROW(u, ai, m); const float s = (rs ? rs[row] : 1.f) * sc;
#pragma unroll
                for (int bj = 0; bj < 2; ++bj) { const f32x4 v0 = acc[ai][bj][m][0] * s, v1 = acc[ai][bj][m][1] * s;
                    u32x4 w; w.x = cvt_pk_bf16(v0[0], v0[1]); w.y = cvt_pk_bf16(v0[2], v0[3]); w.z = cvt_pk_bf16(v1[0], v1[1]); w.w = cvt_pk_bf16(v1[2], v1[3]);
                    *(u32x4*)(base + (size_t)row * ldc + EPI_COL(u, bj)) = w;
                    if (dokn) { float q = (v0[0] * v0[0] + v0[1] * v0[1]) + (v0[2] * v0[2] + v0[3] * v0[3]) + (v1[0] * v1[0] + v1[1] * v1[1]) + (v1[2] * v1[2] + v1[3] * v1[3]);
                        q += __shfl_xor(q, 16); q += __shfl_xor(q, 32); nmax[bj] = fmaxf(nmax[bj], q); } } }
        if (dokn) {
#pragma unroll
            for (int bj = 0; bj < 2; ++bj) { float q = nmax[bj]; q = fmaxf(q, __shfl_xor(q, 1)); q = fmaxf(q, __shfl_xor(q, 2)); q = fmaxf(q, __shfl_xor(q, 4)); q = fmaxf(q, __shfl_xor(q, 8));
                const int head = ((u.ocol + bj * HALF) >> 6) + (wc >> 1), bt = u.orow / SEQ;
                if ((fr | fq) == 0) atomicMax(kn + ((bt * NH + head) * 2 + (wc & 1)), __float_as_uint(q)); }
        }
    }
};
struct EpiResid {
    const float* res; float* out; bf16_t* hb; float* ssq;
    __device__ __forceinline__ void operator()(const f32x4 (&acc)[2][2][4][2], const Unit& u, int wr, int wc, int fr, int fq) const {
#pragma unroll
        for (int ai = 0; ai < 2; ++ai)
#pragma unroll
            for (int m = 0; m < 4; ++m) { const int row = EPI_ROW(u, ai, m); float q = 0.f;
#pragma unroll
                for (int bj = 0; bj < 2; ++bj) { const size_t off = (size_t)row * DM + EPI_COL(u, bj);
                    const f32x4 r0 = *(const f32x4*)(res + off), r1 = *(const f32x4*)(res + off + 4);
                    const f32x4 v0 = acc[ai][bj][m][0] + r0, v1 = acc[ai][bj][m][1] + r1;
                    *(f32x4*)(out + off) = v0; *(f32x4*)(out + off + 4) = v1;
                    q += (v0[0] * v0[0] + v0[1] * v0[1]) + (v0[2] * v0[2] + v0[3] * v0[3]) + (v1[0] * v1[0] + v1[1] * v1[1]) + (v1[2] * v1[2] + v1[3] * v1[3]);
                    if (hb) { u32x4 w; w.x = cvt_pk_bf16(v0[0], v0[1]); w.y = cvt_pk_bf16(v0[2], v0[3]); w.z = cvt_pk_bf16(v1[0], v1[1]); w.w = cvt_pk_bf16(v1[2], v1[3]); *(u32x4*)(hb + off) = w; } }
                if (ssq) { q += __shfl_xor(q, 16); q += __shfl_xor(q, 32); if (fq == 0) ssq[(size_t)row * 16 + (u.ocol >> 8) * 4 + wc] = q; } }
    }
};
struct EpiSoftmax {
    bf16_t* P; const float* ssq; LAS float* red;
    __device__ __forceinline__ void operator()(f32x4 (&acc)[2][2][4][2], const Unit& u, int wr, int wc, int fr, int fq) const {
#pragma unroll
        for (int ai = 0; ai < 2; ++ai)
#pragma unroll
            for (int m = 0; m < 4; ++m) { const int row = EPI_ROW(u, ai, m); const f32x4* sp = (const f32x4*)(ssq + (size_t)row * 16);
                const f32x4 s0 = sp[0], s1 = sp[1], s2 = sp[2], s3 = sp[3];
                const float tot = ((s0[0] + s0[1]) + (s0[2] + s0[3])) + ((s1[0] + s1[1]) + (s1[2] + s1[3])) + ((s2[0] + s2[1]) + (s2[2] + s2[3])) + ((s3[0] + s3[1]) + (s3[2] + s3[3]));
                const float r1 = rsqrtf(tot * (1.0f / DM) + EPS) * XSC; float a = -3.0e38f;
#pragma unroll
                for (int bj = 0; bj < 2; ++bj)
#pragma unroll
                    for (int n = 0; n < 2; ++n) { f32x4 v = acc[ai][bj][m][n] * r1; acc[ai][bj][m][n] = v; a = fmaxf(a, fmaxf(fmaxf(v[0], v[1]), fmaxf(v[2], v[3]))); }
                a = fmaxf(a, __shfl_xor(a, 16)); a = fmaxf(a, __shfl_xor(a, 32));
                if (fq == 0) red[(ai * HALF + wr * 64 + m * 16 + fr) * 4 + wc] = a; asm volatile("" ::: "memory"); }
        LDS_WAIT(); __builtin_amdgcn_s_barrier(); asm volatile("" ::: "memory");
#pragma unroll
        for (int ai = 0; ai < 2; ++ai)
#pragma unroll
            for (int m = 0; m < 4; ++m) { const int rl = ai * HALF + wr * 64 + m * 16 + fr; const f32x4 mm = *(const LAS f32x4*)(red + rl * 4);
                const float a = fmaxf(fmaxf(mm[0], mm[1]), fmaxf(mm[2], mm[3])); float s = 0.f;
#pragma unroll
                for (int bj = 0; bj < 2; ++bj)
#pragma unroll
                    for (int n = 0; n < 2; ++n) { f32x4 v = acc[ai][bj][m][n];
                        v[0] = __builtin_amdgcn_exp2f(v[0] - a); v[1] = __builtin_amdgcn_exp2f(v[1] - a); v[2] = __builtin_amdgcn_exp2f(v[2] - a); v[3] = __builtin_amdgcn_exp2f(v[3] - a);
                        acc[ai][bj][m][n] = v; s += (v[0] + v[1]) + (v[2] + v[3]); }
                s += __shfl_xor(s, 16); s += __shfl_xor(s, 32);
                if (fq == 0) red[1024 + rl * 4 + wc] = s; }
        LDS_WAIT(); __builtin_amdgcn_s_barrier(); asm volatile("" ::: "memory");
#pragma unroll
        for (int ai = 0; ai < 2; ++ai)
#pragma unroll
            for (int m = 0; m < 4; ++m) { const int rl = ai * HALF + wr * 64 + m * 16 + fr; const int row = u.orow + rl; const f32x4 ss = *(const LAS f32x4*)(red + 1024 + rl * 4);
                const float inv = 1.0f / ((ss[0] + ss[1]) + (ss[2] + ss[3]));
#pragma unroll
                for (int bj = 0; bj < 2; ++bj) { const f32x4 v0 = acc[ai][bj][m][0] * inv, v1 = acc[ai][bj][m][1] * inv;
                    u32x4 w; w.x = cvt_pk_bf16(v0[0], v0[1]); w.y = cvt_pk_bf16(v0[2], v0[3]); w.z = cvt_pk_bf16(v1[0], v1[1]); w.w = cvt_pk_bf16(v1[2], v1[3]);
                    *(u32x4*)(P + (size_t)row * DM + EPI_COL(u, bj)) = w; } }
    }
};
struct EpiSwiglu {
    bf16_t* Hd;
    __device__ __forceinline__ void operator()(const f32x4 (&acc)[2][2][4][2], const Unit& u, int wr, int wc, int fr, int fq) const {
#pragma unroll
        for (int ai = 0; ai < 2; ++ai)
#pragma unroll
            for (int m = 0; m < 4; ++m) { const int row = EPI_ROW(u, ai, m); float h[8];
#pragma unroll
                for (int n = 0; n < 2; ++n)
#pragma unroll
                    for (int e = 0; e < 4; ++e) { const float gt = acc[ai][0][m][n][e], up = acc[ai][1][m][n][e];
                        h[n * 4 + e] = gt * __builtin_amdgcn_rcpf(1.0f + __builtin_amdgcn_exp2f(-gt * LOG2E)) * up; }
                u32x4 w; w.x = cvt_pk_bf16(h[0], h[1]); w.y = cvt_pk_bf16(h[2], h[3]); w.z = cvt_pk_bf16(h[4], h[5]); w.w = cvt_pk_bf16(h[6], h[7]);
                *(u32x4*)(Hd + (size_t)row * DFF + u.ocol + wc * 32 + 8 * fq) = w; }
    }
};
}

namespace att {
constexpr int QB = 256, KVBLK = 64, PITCH = HW;
constexpr int SLOTB = 8192, LDS_K = 0, LDS_V = 2 * SLOTB, LDS_WS = 4 * SLOTB, LDS_OST = LDS_WS + NWAVES * 256, LDS_FLAG = LDS_OST + NWAVES * 4096, LDS_END = LDS_FLAG + 64;
static_assert(LDS_END <= RING_BYTES, "attention LDS");
__device__ __forceinline__ int crow(int r, int hi) { return (r & 3) + 8 * (r >> 2) + 4 * hi; }
__device__ __forceinline__ void glds16(const void* gsrc, unsigned lds_dst) { unsigned keep;
    asm volatile("s_mov_b32 %0, m0\n\ts_mov_b32 m0, %2\n\ts_nop 0\n\tglobal_load_lds_dwordx4 %1, off\n\ts_mov_b32 m0, %0" : "=&s"(keep) : "v"(gsrc), "s"(lds_dst) : "memory"); }
__device__ __forceinline__ void glds16s(const void* sbase, unsigned voff, unsigned lds_dst) { unsigned keep;
    asm volatile("s_mov_b32 %0, m0\n\ts_mov_b32 m0, %3\n\ts_nop 0\n\tglobal_load_lds_dwordx4 %1, %2\n\ts_mov_b32 m0, %0" : "=&s"(keep) : "v"(voff), "s"(sbase), "s"(lds_dst) : "memory"); }
#define ATT_WAIT_BAR0() asm volatile("s_waitcnt vmcnt(0) lgkmcnt(0)\n\ts_barrier" ::: "memory")
#define MFMA32(a, b, c) __builtin_amdgcn_mfma_f32_32x32x16_bf16(a, b, c, 0, 0, 0)
__device__ __forceinline__ void qkt(f32x16& p0, f32x16& p1, const LAS char* Kslot, const bf16x8* qr, const f32x16& cin, int r32, int hi) {
    const LAS char* kb = Kslot + hi * 1024 + r32 * 16;
#pragma unroll
    for (int d0 = 0; d0 < 4; ++d0) {
        const bf16x8 b0 = *(const LAS bf16x8*)(kb + d0 * 2048);
        const bf16x8 b1 = *(const LAS bf16x8*)(kb + d0 * 2048 + 512);
        if (d0 == 0) { p0 = MFMA32(b0, qr[0], cin); p1 = MFMA32(b1, qr[0], cin); }
        else { p0 = MFMA32(b0, qr[d0], p0); p1 = MFMA32(b1, qr[d0], p1); } }
}
__device__ __forceinline__ void pv(f32x16* o, int vb, bf16x8 pa0, bf16x8 pa1, bf16x8 pa2, bf16x8 pa3) {
#pragma unroll
    for (int d0 = 0; d0 < 2; ++d0) { s16x4 lo[4], hi[4];
#pragma unroll
        for (int ks = 0; ks < 4; ++ks) {
            asm volatile("ds_read_b64_tr_b16 %0,%1 offset:%c2" : "=&v"(lo[ks]) : "v"(vb), "i"(d0 * 4096 + ks * 1024) : "memory");
            asm volatile("ds_read_b64_tr_b16 %0,%1 offset:%c2" : "=&v"(hi[ks]) : "v"(vb), "i"(d0 * 4096 + ks * 1024 + 512) : "memory"); }
        asm volatile("s_waitcnt lgkmcnt(0)" ::: "memory"); __builtin_amdgcn_sched_barrier(0);
#define PK(k) (bf16x8){lo[k][0], lo[k][1], lo[k][2], lo[k][3], hi[k][0], hi[k][1], hi[k][2], hi[k][3]}
        o[d0] = MFMA32(pa0, PK(0), o[d0]); o[d0] = MFMA32(pa1, PK(1), o[d0]); o[d0] = MFMA32(pa2, PK(2), o[d0]); o[d0] = MFMA32(pa3, PK(3), o[d0]);
#undef PK
    }
}
__device__ __forceinline__ float swap_lo(float x) { auto rr = __builtin_amdgcn_permlane32_swap(__float_as_uint(x), __float_as_uint(x), false, false); return __uint_as_float(rr[0]); }
__device__ __forceinline__ float swap_hi(float x) { auto rr = __builtin_amdgcn_permlane32_swap(__float_as_uint(x), __float_as_uint(x), false, false); return __uint_as_float(rr[1]); }

template <int MODE> __device__ __forceinline__ void attn_unit(int b, int h, int qb, const bf16_t* Q, const bf16_t* K, const bf16_t* V, bf16_t* O, const float* cb, LAS char* shm) {
    int tid = threadIdx.x; asm volatile("" : "+v"(tid)); const int lane = tid & 63, r32 = lane & 31, hi = lane >> 5; const int wid = __builtin_amdgcn_readfirstlane(tid >> 6);
    const long rowbase = (long)b * SEQ; const int q0 = qb * QB;
    const bf16_t* Qw = Q + (rowbase + q0 + wid * 32) * PITCH + h * HD;
    const bf16_t* Kh = K + rowbase * PITCH + h * HD; const bf16_t* Vh = V + rowbase * PITCH + h * HD;
    const unsigned lds0 = (unsigned)(uintptr_t)shm;
    LAS float* wsf = (LAS float*)(shm + LDS_WS) + wid * 64;
    LAS unsigned* flags = (LAS unsigned*)(shm + LDS_FLAG);
    const bf16_t* ksrc = Kh + (long)lane * PITCH + wid * 8;
    const bf16_t* vsrc = Vh + (long)(16 * (wid & 3) + (lane >> 2)) * PITCH + (wid >> 2) * 32 + (lane & 3) * 8;
    const unsigned kdst = lds0 + LDS_K + wid * 1024, vdst = lds0 + LDS_V + wid * 1024;
#define DMA_KV(t, slot) do { glds16(ksrc + (long)(t) * KVBLK * PITCH, (unsigned)__builtin_amdgcn_readfirstlane(kdst + (slot))); glds16(vsrc + (long)(t) * KVBLK * PITCH, (unsigned)__builtin_amdgcn_readfirstlane(vdst + (slot))); } while (0)
    const int vb0 = (int)(lds0 + LDS_V) + ((lane >> 4) & 1) * 32 + (lane & 3) * 8 + (4 * hi + ((lane & 15) >> 2)) * 64;
    const int NT = (q0 + QB) / KVBLK;
    DMA_KV(NT - 1, 0);
    bf16x8 qr[4];
#pragma unroll
    for (int d0 = 0; d0 < 4; ++d0) qr[d0] = *(const bf16x8*)(Qw + (long)r32 * PITCH + d0 * 16 + hi * 8);
    f32x16 o[2]; o[0] = f32x16{}; o[1] = f32x16{};
    const int qrel = wid * 32 + r32;
    float m_run = -1.0e30f, l_run = 0.f, R = 0.f, ct = 0.f;
    if (MODE == 0) ct = cb[q0 + qrel];
    bf16x8 TD0, TD1, TONE;
#pragma unroll
    for (int j = 0; j < 8; ++j) { const int kvl = 8 * (j >> 2) + 4 * hi + (j & 3); TD0[j] = (kvl >= r32) ? (short)0x3F80 : (short)0; TD1[j] = (16 + kvl >= r32) ? (short)0x3F80 : (short)0; TONE[j] = (short)0x3F80; }
    f32x16 zero16 = f32x16{};
    for (int i = 0; i < NT; ++i) {
        const int t = NT - 1 - i, slot = (i & 1) * SLOTB;
        ATT_WAIT_BAR0();
        if (MODE == 1 && i > 0) {
            const LAS unsigned* fl = flags + ((i - 1) & 1) * 8; unsigned all = 1u;
#pragma unroll
            for (int w = 0; w < 8; ++w) all &= fl[w];
            if (__builtin_amdgcn_readfirstlane(all)) break;
        }
        if (t > 0) DMA_KV(t - 1, slot ^ SLOTB);
        const int jb = t - (NT - 4);
        const bool active = !(jb >= 0 && 2 * jb > wid);
        bool wave_done = false;
        if (MODE == 1) wave_done = __all(R < SB_EXIT);
        if (active && !(MODE == 1 && wave_done)) {
            f32x16 p0, p1;
            qkt(p0, p1, shm + LDS_K + slot, qr, zero16, r32, hi);
            if (MODE == 0) {
                const float* cbt = cb + t * KVBLK + 4 * hi;
#pragma unroll
                for (int g = 0; g < 4; ++g) { const f32x4 c0 = *(const f32x4*)(cbt + 8 * g), c1 = *(const f32x4*)(cbt + 32 + 8 * g);
#pragma unroll
                    for (int e = 0; e < 4; ++e) { p0[4 * g + e] += ct - c0[e]; p1[4 * g + e] += ct - c1[e]; } }
                if (jb >= 0) {
#pragma unroll
                    for (int r = 0; r < 16; ++r) { const int kv = 64 * jb + crow(r, hi); if (kv > qrel) p0[r] = -1.0e30f; if (kv + 32 > qrel) p1[r] = -1.0e30f; } }
                float a = fmaxf(p0[0], p1[0]);
#pragma unroll
                for (int r = 1; r < 16; ++r) a = fmaxf(a, fmaxf(p0[r], p1[r]));
                a = fmaxf(swap_lo(a), swap_hi(a));
                const float m_new = fmaxf(m_run, a), alpha = __builtin_amdgcn_exp2f(m_run - m_new); m_run = m_new;
                float s = 0.f;
#pragma unroll
                for (int r = 0; r < 16; ++r) { p0[r] = __builtin_amdgcn_exp2f(p0[r] - m_new); p1[r] = __builtin_amdgcn_exp2f(p1[r] - m_new); s += p0[r] + p1[r]; }
                l_run = l_run * alpha + s;
                if (hi == 0) wsf[r32] = alpha;
                LDS_WAIT();
#pragma unroll
                for (int r = 0; r < 16; ++r) { const float f = wsf[crow(r, hi)]; o[0][r] *= f; o[1][r] *= f; }
                LDS_WAIT();
            } else {
                if (jb >= 0) {
#pragma unroll
                    for (int r = 0; r < 16; ++r) { const int kv = 64 * jb + crow(r, hi); if (kv >= qrel) p0[r] = -1.0e30f; if (kv + 32 >= qrel) p1[r] = -1.0e30f; } }
                f32x16 l0, l1;
#pragma unroll
                for (int r = 0; r < 16; ++r) {
                    l0[r] = -(fmaxf(p0[r], 0.f) + __builtin_amdgcn_logf(1.0f + __builtin_amdgcn_exp2f(-fabsf(p0[r]))));
                    l1[r] = -(fmaxf(p1[r], 0.f) + __builtin_amdgcn_logf(1.0f + __builtin_amdgcn_exp2f(-fabsf(p1[r])))); }
                u32x4 lw0 = {cvt_pk_bf16(l0[0], l0[1]), cvt_pk_bf16(l0[2], l0[3]), cvt_pk_bf16(l0[4], l0[5]), cvt_pk_bf16(l0[6], l0[7])};
                u32x4 lw1 = {cvt_pk_bf16(l0[8], l0[9]), cvt_pk_bf16(l0[10], l0[11]), cvt_pk_bf16(l0[12], l0[13]), cvt_pk_bf16(l0[14], l0[15])};
                u32x4 lw2 = {cvt_pk_bf16(l1[0], l1[1]), cvt_pk_bf16(l1[2], l1[3]), cvt_pk_bf16(l1[4], l1[5]), cvt_pk_bf16(l1[6], l1[7])};
                u32x4 lw3 = {cvt_pk_bf16(l1[8], l1[9]), cvt_pk_bf16(l1[10], l1[11]), cvt_pk_bf16(l1[12], l1[13]), cvt_pk_bf16(l1[14], l1[15])};
                f32x16 rt;
#pragma unroll
                for (int r = 0; r < 16; ++r) rt[r] = R;
                f32x16 t0 = MFMA32(TD0, __builtin_bit_cast(bf16x8, lw0), rt); t0 = MFMA32(TD1, __builtin_bit_cast(bf16x8, lw1), t0);
                t0 = MFMA32(TONE, __builtin_bit_cast(bf16x8, lw2), t0); t0 = MFMA32(TONE, __builtin_bit_cast(bf16x8, lw3), t0);
                f32x16 t1 = MFMA32(TD0, __builtin_bit_cast(bf16x8, lw2), rt); t1 = MFMA32(TD1, __builtin_bit_cast(bf16x8, lw3), t1);
#pragma unroll
                for (int r = 0; r < 16; ++r) { p0[r] = __builtin_amdgcn_exp2f(p0[r] + t0[r]); p1[r] = __builtin_amdgcn_exp2f(p1[r] + t1[r]); }
                R = swap_lo(t0[0]);
            }
            u32x4 pw0 = {cvt_pk_bf16(p0[0], p0[1]), cvt_pk_bf16(p0[2], p0[3]), cvt_pk_bf16(p0[4], p0[5]), cvt_pk_bf16(p0[6], p0[7])};
            u32x4 pw1 = {cvt_pk_bf16(p0[8], p0[9]), cvt_pk_bf16(p0[10], p0[11]), cvt_pk_bf16(p0[12], p0[13]), cvt_pk_bf16(p0[14], p0[15])};
            u32x4 pw2 = {cvt_pk_bf16(p1[0], p1[1]), cvt_pk_bf16(p1[2], p1[3]), cvt_pk_bf16(p1[4], p1[5]), cvt_pk_bf16(p1[6], p1[7])};
            u32x4 pw3 = {cvt_pk_bf16(p1[8], p1[9]), cvt_pk_bf16(p1[10], p1[11]), cvt_pk_bf16(p1[12], p1[13]), cvt_pk_bf16(p1[14], p1[15])};
            pv(o, vb0 + slot, __builtin_bit_cast(bf16x8, pw0), __builtin_bit_cast(bf16x8, pw1), __builtin_bit_cast(bf16x8, pw2), __builtin_bit_cast(bf16x8, pw3));
        }
        if (MODE == 1) { const bool dn = __all(R < SB_EXIT); if (lane == 0) flags[(i & 1) * 8 + wid] = dn ? 1u : 0u; }
    }
    float linv = 1.f;
    if (MODE == 0) { const float lt = swap_lo(l_run) + swap_hi(l_run); linv = 1.0f / lt; }
    if (hi == 0) wsf[32 + r32] = linv;
    LDS_WAIT();
    bf16_t* Ow = O + (rowbase + q0 + wid * 32) * PITCH + h * HD;
    { LAS bf16_t* stg = (LAS bf16_t*)(shm + LDS_OST) + wid * 2048;
#pragma unroll
      for (int r = 0; r < 16; ++r) { const int orow = crow(r, hi); const float f = wsf[32 + orow];
#pragma unroll
        for (int d0 = 0; d0 < 2; ++d0) { const unsigned pk = cvt_pk_bf16(o[d0][r] * f, 0.f); stg[orow * 64 + d0 * 32 + r32] = (bf16_t)(pk & 0xffffu); } }
      LDS_WAIT();
#pragma unroll
      for (int i = 0; i < 4; ++i) { const int row = i * 8 + (lane >> 3), ch = lane & 7; const u32x4 v = *(const LAS u32x4*)(stg + row * 64 + ch * 8); *(u32x4*)(Ow + (long)row * PITCH + ch * 8) = v; } }
    asm volatile("s_waitcnt vmcnt(0) lgkmcnt(0)\n\ts_barrier" ::: "memory");
#undef DMA_KV
}
}


namespace fox {
constexpr int QB = 256, KVBLK = 64, PITCH = HW;
constexpr int NSLOT = 3, SLOTB = 9216;
constexpr int LDS_K = 0, LDS_V = NSLOT * SLOTB, LDS_WS = 2 * NSLOT * SLOTB, LDS_OST = LDS_WS + NWAVES * 256, LDS_CL = LDS_OST + NWAVES * 4096, LDS_VOTE = LDS_CL + 512, LDS_END = LDS_VOTE + 32;
static_assert(LDS_END <= RING_BYTES, "fox LDS");
constexpr float WIN_T = 64.0f;
constexpr float FLOOR = -256.0f;
using att::crow; using att::glds16; using att::glds16s;
typedef __attribute__((address_space(3))) const char* lds_cptr;
typedef short v4i16_t __attribute__((ext_vector_type(4)));
#define SBAR() __builtin_amdgcn_sched_barrier(0)
#define WAIT_BAR(N) asm volatile("s_waitcnt vmcnt(" #N ") lgkmcnt(0)\n\ts_barrier" ::: "memory")
__device__ __forceinline__ s16x4 vtr(lds_cptr p) { return __builtin_bit_cast(s16x4, __builtin_amdgcn_ds_read_tr16_b64_v4i16((__attribute__((address_space(3))) v4i16_t*)p)); }
__device__ __forceinline__ void kload2(bf16x8* kf, lds_cptr kp, int j) { kf[2 * j] = *(const LAS bf16x8*)(kp + j * 2048); kf[2 * j + 1] = *(const LAS bf16x8*)(kp + j * 2048 + 512); }
__device__ __forceinline__ void cmask(f32x16& p0, f32x16& p1, int jb, int qrel, int hi) {
    const float NEG = -INFINITY; const int kb = 64 * jb + 4 * hi;
#pragma unroll
    for (int r = 0; r < 16; ++r) { const int kv = kb + (r & 3) + 8 * (r >> 2); if (kv > qrel) p0[r] = NEG; if (kv + 32 > qrel) p1[r] = NEG; }
}
__device__ __forceinline__ void split3(float x, unsigned& hm, unsigned& lo) {
    const unsigned h = cvt_pk_bf16(x, 0.f) & 0xffffu; const float r1 = x - __uint_as_float(h << 16);
    const unsigned m = cvt_pk_bf16(r1, 0.f) & 0xffffu; const float r2 = r1 - __uint_as_float(m << 16);
    hm = h | (m << 16); lo = cvt_pk_bf16(r2, 0.f) & 0xffffu;
}
__device__ __forceinline__ bf16x8 qx_build(float a, int hi) {
    unsigned hm, lo; split3(a, hm, lo);
    u32x4 w; w.x = hm; w.y = lo | 0x3F800000u; w.z = 0x3F803F80u; w.w = 0u;
    if (hi) { w.x = 0u; w.y = 0u; w.z = 0u; }
    return __builtin_bit_cast(bf16x8, w);
}

template <int THRL> __device__ __forceinline__ void fox_unit(int bh, int qb, const bf16_t* Q, const bf16_t* K, const bf16_t* V, bf16_t* O, const float* cb, const bf16_t* KXh, float kmax, LAS char* shm) {
    int tid = threadIdx.x; asm volatile("" : "+v"(tid)); const int lane = tid & 63, r32 = lane & 31, hi = lane >> 5; const int wid = __builtin_amdgcn_readfirstlane(tid >> 6);
    const int b = bh >> 3, h = bh & 7; const long rowbase = (long)b * SEQ; const int q0 = qb * QB;
    const bf16_t* Qw = Q + (rowbase + q0 + wid * 32) * PITCH + h * HD;
    const bf16_t* Kh = K + rowbase * PITCH + h * HD; const bf16_t* Vh = V + rowbase * PITCH + h * HD;
    const unsigned lds0 = (unsigned)(uintptr_t)shm;
    LAS float* wsf = (LAS float*)(shm + LDS_WS) + wid * 64;
    const int NT = (q0 + QB) / KVBLK;
    int NTe = NT;
    LAS float* clt = (LAS float*)(shm + LDS_CL); LAS unsigned* votes = (LAS unsigned*)(shm + LDS_VOTE);
    const float clv = (tid < NT) ? cb[64 * tid + 63] : 0.f;
    const unsigned koff = (unsigned)(lane * PITCH + wid * 8) * 2u, voff = (unsigned)((16 * (wid & 3) + (lane >> 2)) * PITCH + (wid >> 2) * 32 + (lane & 3) * 8) * 2u, xoff = (unsigned)lane * 16u;
    const unsigned kdst = lds0 + LDS_K + wid * 1024, vdst = lds0 + LDS_V + wid * 1024, xdst = lds0 + LDS_K + 8192;
    const bool xl = (lane >> 3) == wid;
#define DMA_K(p, slot) do { glds16s(Kh + (long)(NT - 1 - (p)) * KVBLK * PITCH, koff, (unsigned)__builtin_amdgcn_readfirstlane(kdst + (slot))); \
        if (xl) glds16s(KXh + (long)(NT - 1 - (p)) * KVBLK * 8, xoff, (unsigned)__builtin_amdgcn_readfirstlane(xdst + (slot))); } while (0)
#define DMA_V(p, slot) glds16s(Vh + (long)(NT - 1 - (p)) * KVBLK * PITCH, voff, (unsigned)__builtin_amdgcn_readfirstlane(vdst + (slot)))
    bf16x8 kf[10];
    const lds_cptr shm3 = (lds_cptr)shm; const lds_cptr kp0 = shm3 + LDS_K + hi * 1024 + r32 * 16; const lds_cptr kx0 = shm3 + LDS_K + 8192 + r32 * 16;
    const lds_cptr vp0 = shm3 + LDS_V + ((lane >> 4) & 1) * 32 + (lane & 3) * 8 + (4 * hi + ((lane & 15) >> 2)) * 64;
    DMA_K(0, 0); DMA_V(0, 0); DMA_K(1, SLOTB);
    bf16x8 qr[4];
#pragma unroll
    for (int d0 = 0; d0 < 4; ++d0) qr[d0] = *(const bf16x8*)(Qw + (long)r32 * PITCH + d0 * 16 + hi * 8);
    const int qrel = wid * 32 + r32;
    const float ct = cb[q0 + qrel];
    float mhat = 0.f, l_reg = 0.f; f32x16 o[2]; o[0] = f32x16{}; o[1] = f32x16{};
    bf16x8 qx = qx_build(ct, hi);
    const f32x16 z16 = f32x16{};
#define CMASK(P0, P1, p) do { const int jb_ = 3 - (p); if (jb_ >= 0) cmask(P0, P1, jb_, qrel, hi); } while (0)
    bool resc = false;
#define RESC() do { if (resc) { asm volatile("s_waitcnt lgkmcnt(0)" ::: "memory"); \
      _Pragma("unroll") for (int d_ = 0; d_ < 2; ++d_) _Pragma("unroll") for (int r = 0; r < 16; ++r) o[d_][r] *= wsf[crow(r, hi)]; } } while (0)
    f32x16 pA0, pA1, pB0, pB1;
    int sl_prev = 0, sl_cur = 0, sl_next = SLOTB;
#define ROT() do { sl_prev = sl_cur; sl_cur = sl_next; sl_next = (sl_next == (NSLOT - 1) * SLOTB) ? 0 : sl_next + SLOTB; } while (0)
    DMA_K(2, 2 * SLOTB);
    WAIT_BAR(5);
    if (tid < NT) clt[tid] = clv;
    float qkb;
    { float q2 = 0.f;
#pragma unroll
      for (int d0 = 0; d0 < 4; ++d0)
#pragma unroll
          for (int j = 0; j < 8; ++j) { const float e = __uint_as_float(((unsigned)(unsigned short)qr[d0][j]) << 16); q2 += e * e; }
      q2 = att::swap_lo(q2) + att::swap_hi(q2); qkb = sqrtf(q2) * kmax + ct + WIN_T; }
    { const LAS char* kb = (const LAS char*)shm + LDS_K + hi * 1024 + r32 * 16; const LAS char* kxb = (const LAS char*)shm + LDS_K + 8192 + r32 * 16;
      pA0 = MFMA32(*(const LAS bf16x8*)(kxb), qx, z16); pA1 = MFMA32(*(const LAS bf16x8*)(kxb + 512), qx, z16);
#pragma unroll
      for (int d0 = 0; d0 < 4; ++d0) { pA0 = MFMA32(*(const LAS bf16x8*)(kb + d0 * 2048), qr[d0], pA0); pA1 = MFMA32(*(const LAS bf16x8*)(kb + d0 * 2048 + 512), qr[d0], pA1); } }
    asm volatile("s_nop 15\n\ts_nop 7" : "+v"(pA0), "+v"(pA1)); CMASK(pA0, pA1, 0);
    { float a = fmaxf(pA0[0], pA1[0]);
#pragma unroll
      for (int r = 1; r < 16; ++r) a = fmaxf(a, fmaxf(pA0[r], pA1[r]));
      a = fmaxf(att::swap_lo(a), att::swap_hi(a));
      const float dl = fmaxf(a, FLOOR); mhat = dl;
#pragma unroll
      for (int r = 0; r < 16; ++r) { pA0[r] = __builtin_amdgcn_exp2f(pA0[r] - dl); pA1[r] = __builtin_amdgcn_exp2f(pA1[r] - dl); }
      qx = qx_build(ct - mhat, hi); asm volatile("" : "+v"(qx)); }
    WAIT_BAR(0);
    DMA_K(3, 0); DMA_V(1, SLOTB);
    ROT();
    kload2(kf, kp0 + sl_cur, 0); kload2(kf, kp0 + sl_cur, 1); kload2(kf, kp0 + sl_cur, 2); kload2(kf, kp0 + sl_cur, 3);
    kf[8] = *(const LAS bf16x8*)(kx0 + sl_cur); kf[9] = *(const LAS bf16x8*)(kx0 + sl_cur + 512);
    WAIT_BAR(3);
    s16x4 vlo[8], vhi[8]; u32x4 pw0, pw1, pw2, pw3;
#define PKW(P, B) cvt_pk_bf16(P[B], P[B + 1])
#define PAF(k) __builtin_bit_cast(bf16x8, pw##k)
#define VFR(i) (bf16x8){vlo[i][0], vlo[i][1], vlo[i][2], vlo[i][3], vhi[i][0], vhi[i][1], vhi[i][2], vhi[i][3]}
#define PIN(x) asm volatile("" : "+v"(x))
#define MX3(a, b, c) __builtin_fmaxf(__builtin_fmaxf((a), (b)), (c))
#define GAPA(MF, A0, A1, A2, A3, W0, W1, PW) do { MF; sacc += A0; sacc += A1; sacc += A2; sacc += A3; PIN(sacc); W0; W1; PIN(PW); SBAR(); } while (0)
#define EX(v) __builtin_amdgcn_exp2f(v)
#define GAPB(MF, X, B) do { MF; X[B] = EX(X[B]); X[B + 1] = EX(X[B + 1]); X[B + 2] = EX(X[B + 2]); X[B + 3] = EX(X[B + 3]); PIN(X); SBAR(); } while (0)
#define VRD(i) do { vlo[i] = vtr(vp_ + (((i) >> 2) * 4096 + ((i) & 3) * 1024)); vhi[i] = vtr(vp_ + (((i) >> 2) * 4096 + ((i) & 3) * 1024 + 512)); } while (0)
#define KRD(G, j) do { if (G) { kload2(kf, kp0 + sl_next, j); SBAR(); } } while (0)
#define KRDX(G) do { if (G) { kf[8] = *(const LAS bf16x8*)(kx0 + sl_next); kf[9] = *(const LAS bf16x8*)(kx0 + sl_next + 512); SBAR(); } } while (0)
#define STEP(C0, C1, P0, P1, t, GK, GV, GL) do { SBAR(); \
    const lds_cptr vp_ = vp0 + sl_prev; \
    C0 = MFMA32(kf[8], qx, z16); C1 = MFMA32(kf[9], qx, z16); SBAR(); \
    VRD(0); SBAR(); float sacc = (P0[0] + P0[1]); \
    GAPA(C0 = MFMA32(kf[0], qr[0], C0), P0[2], P0[3], P0[4], P0[5],     pw0[0] = PKW(P0, 0), pw0[1] = PKW(P0, 2), pw0); \
    VRD(4); SBAR(); GAPA(C1 = MFMA32(kf[1], qr[0], C1), P0[6], P0[7], P0[8], P0[9],     pw0[2] = PKW(P0, 4), pw0[3] = PKW(P0, 6), pw0); \
    VRD(1); SBAR(); GAPA(C0 = MFMA32(kf[2], qr[1], C0),   P0[10], P0[11], P0[12], P0[13], pw1[0] = PKW(P0, 8), pw1[1] = PKW(P0, 10), pw1); \
    VRD(5); SBAR(); GAPA(C1 = MFMA32(kf[3], qr[1], C1),   P0[14], P0[15], P1[0], P1[1],   pw1[2] = PKW(P0, 12), pw1[3] = PKW(P0, 14), pw1); \
    VRD(2); SBAR(); GAPA(C0 = MFMA32(kf[4], qr[2], C0),   P1[2], P1[3], P1[4], P1[5],     pw2[0] = PKW(P1, 0), pw2[1] = PKW(P1, 2), pw2); \
    VRD(6); SBAR(); GAPA(C1 = MFMA32(kf[5], qr[2], C1),   P1[6], P1[7], P1[8], P1[9],     pw2[2] = PKW(P1, 4), pw2[3] = PKW(P1, 6), pw2); \
    VRD(3); SBAR(); GAPA(C0 = MFMA32(kf[6], qr[3], C0),   P1[10], P1[11], P1[12], P1[13], pw3[0] = PKW(P1, 8), pw3[1] = PKW(P1, 10), pw3); \
    VRD(7); SBAR(); GAPA(C1 = MFMA32(kf[7], qr[3], C1),   P1[14], P1[15], 0.f, 0.f,       pw3[2] = PKW(P1, 12), pw3[3] = PKW(P1, 14), pw3); \
    l_reg += sacc; \
    if (GK) { DMA_K((t) + 3, sl_cur); } if (GV) { DMA_V((t) + 1, sl_next); } \
    CMASK(C0, C1, t); \
    { float a = MX3(C0[0], C0[1], C1[0]), b_ = MX3(C0[2], C0[3], C1[1]); a = MX3(a, C1[2], C1[3]); \
      _Pragma("unroll") for (int r = 4; r < 16; r += 4) { a = MX3(a, C0[r], C0[r + 1]); b_ = MX3(b_, C0[r + 2], C0[r + 3]); a = MX3(a, C1[r], C1[r + 1]); b_ = MX3(b_, C1[r + 2], C1[r + 3]); } \
      float rm = __builtin_fmaxf(a, b_); { auto rr = __builtin_amdgcn_permlane32_swap(__float_as_uint(rm), __float_as_uint(rm), false, false); rm = __builtin_fmaxf(__uint_as_float(rr[0]), __uint_as_float(rr[1])); } \
      resc = false; \
      if (__builtin_expect(__any(rm > (float)THRL), 0)) { const float dl = __builtin_fmaxf(rm, 0.f); mhat += dl; \
        _Pragma("unroll") for (int r = 0; r < 16; ++r) { C0[r] -= dl; C1[r] -= dl; } \
        qx = qx_build(ct - mhat, hi); asm volatile("" : "+v"(qx)); \
        const float f = __builtin_amdgcn_exp2f(-dl); l_reg *= f; if (hi == 0) wsf[r32] = f; resc = true; } } \
    SBAR(); \
    GAPB(o[0] = MFMA32(PAF(0), VFR(0), o[0]), C0, 0); \
    KRDX(GL); GAPB(o[1] = MFMA32(PAF(0), VFR(4), o[1]), C0, 4); \
    KRD(GL, 0); GAPB(o[0] = MFMA32(PAF(1), VFR(1), o[0]), C0, 8); \
    KRD(GL, 1); GAPB(o[1] = MFMA32(PAF(1), VFR(5), o[1]), C0, 12); \
    KRD(GL, 2); GAPB(o[0] = MFMA32(PAF(2), VFR(2), o[0]), C1, 0); \
    KRD(GL, 3); GAPB(o[1] = MFMA32(PAF(2), VFR(6), o[1]), C1, 4); \
    GAPB(o[0] = MFMA32(PAF(3), VFR(3), o[0]), C1, 8); \
    GAPB(o[1] = MFMA32(PAF(3), VFR(7), o[1]), C1, 12); \
    } while (0)
#define ENDW(tt) do { if ((tt) + 3 < NTe) { WAIT_BAR(3); } else if ((tt) + 2 < NTe) { WAIT_BAR(1); } else { WAIT_BAR(0); } } while (0)
#define VOTE(t) do { const int ts_ = NT - (t) - 6; bool ok_ = false; if (ts_ >= 0) { ok_ = __all((qkb - mhat) < clt[ts_]); } if (lane == 0) votes[wid] = ok_ ? 1u : 0u; } while (0)
#define TALLY(t) do { const u32x4 va_ = *(const LAS u32x4*)votes, vb_ = *(const LAS u32x4*)(votes + 4); \
        if (__builtin_amdgcn_readfirstlane((va_.x & va_.y & va_.z & va_.w & vb_.x & vb_.y & vb_.z & vb_.w) != 0u)) { if ((t) + 5 < NTe) NTe = (t) + 5; } } while (0)
    int t = 1;
    for (; t + 1 < NTe && t < 5; t += 2) {
        STEP(pB0, pB1, pA0, pA1, t, (t + 3 < NTe), (t + 1 < NTe), (t + 1 < NTe));       VOTE(t); ENDW(t);     TALLY(t); RESC(); ROT();
        STEP(pA0, pA1, pB0, pB1, t + 1, (t + 4 < NTe), (t + 2 < NTe), (t + 2 < NTe));   ENDW(t + 1); RESC(); ROT();
    }
#undef CMASK
#define CMASK(P0, P1, p) do {} while (0)
    for (; t + 5 < NTe; t += 2) {
        STEP(pB0, pB1, pA0, pA1, t, true, true, true);       VOTE(t); WAIT_BAR(3); TALLY(t); RESC(); ROT();
        STEP(pA0, pA1, pB0, pB1, t + 1, (t + 4 < NTe), true, true);   ENDW(t + 1); RESC(); ROT();
    }
    for (; t + 1 < NTe; t += 2) {
        STEP(pB0, pB1, pA0, pA1, t, (t + 3 < NTe), (t + 1 < NTe), (t + 1 < NTe));       ENDW(t);     RESC(); ROT();
        STEP(pA0, pA1, pB0, pB1, t + 1, (t + 4 < NTe), (t + 2 < NTe), (t + 2 < NTe));   ENDW(t + 1); RESC(); ROT();
    }
#undef CMASK
#define CMASK(P0, P1, p) do { const int jb_ = 3 - (p); if (jb_ >= 0) cmask(P0, P1, jb_, qrel, hi); } while (0)
    STEP(pB0, pB1, pA0, pA1, NTe - 1, false, false, false); RESC();
    { float sacc = pB0[0] + pB0[1];
#pragma unroll
      for (int r = 2; r < 16; ++r) sacc += pB0[r];
#pragma unroll
      for (int r = 0; r < 16; ++r) sacc += pB1[r];
      l_reg += sacc;
      pw0 = (u32x4){PKW(pB0, 0), PKW(pB0, 2), PKW(pB0, 4), PKW(pB0, 6)}; pw1 = (u32x4){PKW(pB0, 8), PKW(pB0, 10), PKW(pB0, 12), PKW(pB0, 14)};
      pw2 = (u32x4){PKW(pB1, 0), PKW(pB1, 2), PKW(pB1, 4), PKW(pB1, 6)}; pw3 = (u32x4){PKW(pB1, 8), PKW(pB1, 10), PKW(pB1, 12), PKW(pB1, 14)};
      SBAR(); att::pv(o, (int)(unsigned)(uintptr_t)(vp0 + sl_cur), PAF(0), PAF(1), PAF(2), PAF(3)); }
    l_reg = att::swap_lo(l_reg) + att::swap_hi(l_reg);
    if (hi == 0) wsf[32 + r32] = l_reg; asm volatile("s_waitcnt lgkmcnt(0)" ::: "memory");
    float rli[16];
#pragma unroll
    for (int r = 0; r < 16; ++r) rli[r] = __builtin_amdgcn_rcpf(wsf[32 + crow(r, hi)]);
    bf16_t* Ow = O + (rowbase + q0 + wid * 32) * PITCH + h * HD;
    { LAS bf16_t* stg = (LAS bf16_t*)(shm + LDS_OST) + wid * 2048;
#pragma unroll
      for (int r = 0; r < 16; ++r) { const int orow = crow(r, hi);
#pragma unroll
        for (int d0 = 0; d0 < 2; ++d0) stg[orow * 64 + d0 * 32 + r32] = (bf16_t)(cvt_pk_bf16(o[d0][r] * rli[r], 0.f) & 0xffffu); }
      asm volatile("s_waitcnt lgkmcnt(0)" ::: "memory");
#pragma unroll
      for (int i = 0; i < 4; ++i) { const int row = i * 8 + (lane >> 3), ch = lane & 7; const u32x4 v = *(const LAS u32x4*)(stg + row * 64 + ch * 8); *(u32x4*)(Ow + (long)row * PITCH + ch * 8) = v; } }
    asm volatile("s_waitcnt lgkmcnt(0)\n\ts_barrier" ::: "memory");
#undef DMA_K
#undef DMA_V
#undef CMASK
#undef RESC
#undef ROT
#undef PKW
#undef PAF
#undef VFR
#undef PIN
#undef MX3
#undef GAPA
#undef GAPB
#undef EX
#undef VRD
#undef KRD
#undef KRDX
#undef STEP
#undef ENDW
#undef VOTE
#undef TALLY
}
#undef SBAR
#undef WAIT_BAR
}

#define XB_TMO      128
#define XB_XCNT(j)  (256  + 64 * (j))
#define XB_XSUB(j)  (1280 + 64 * (j))
#define XB_XGEN(j)  (2304 + 64 * (j))
#define XB_TOP      3328
#define XB_TOPGEN   3392
#define XCD_BAR_WORDS 3456
#define XB_SPIN_CAP (1u << 18)
__device__ __forceinline__ unsigned xb_ld(unsigned* p)              { return __hip_atomic_load(p, __ATOMIC_RELAXED, __HIP_MEMORY_SCOPE_AGENT); }
__device__ __forceinline__ unsigned xb_add(unsigned* p, unsigned v) { return __hip_atomic_fetch_add(p, v, __ATOMIC_RELAXED, __HIP_MEMORY_SCOPE_AGENT); }
__device__ __forceinline__ unsigned xb_xcc_id() { return (unsigned)__builtin_amdgcn_s_getreg((3 << 11) | 20) & 0xFu; }
#define XB_SPIN(cond, bar) do { unsigned _sp = 0; while (cond) { __builtin_amdgcn_s_sleep(1); \
    if ((++_sp & 255u) == 0u) { if (xb_ld(&(bar)[XB_TMO])) break; if (_sp > XB_SPIN_CAP) { atomicAdd(&(bar)[XB_TMO], 1u); break; } } } } while (0)
struct XcdBarrier { unsigned* bar; unsigned x; volatile LAS unsigned* st; };
__device__ __forceinline__ XcdBarrier xcd_barrier_post(unsigned* bar, volatile LAS unsigned* st) {
    XcdBarrier b; b.bar = bar; b.x = xb_xcc_id(); b.st = st;
    if (threadIdx.x == 0) (void)xb_add(&bar[XB_XCNT(b.x)], 1u);
    return b;
}
__device__ __forceinline__ void xcd_barrier_complete(unsigned* bar, unsigned x, unsigned& nloc, unsigned& nx) {
    const unsigned G = gridDim.x * gridDim.y * gridDim.z;
    unsigned sum, cnt, mine, sp = 0u;
    for (;;) {
        sum = 0u; cnt = 0u; mine = 0u;
#pragma unroll
        for (unsigned j = 0; j < 16; ++j) { const unsigned c = xb_ld(&bar[XB_XCNT(j)]); sum += c; cnt += (c > 0u) ? 1u : 0u; mine = (j == x) ? c : mine; }
        if (sum == G) break;
        __builtin_amdgcn_s_sleep(1);
        if ((++sp & 255u) == 0u) { if (xb_ld(&bar[XB_TMO])) break; if (sp > XB_SPIN_CAP) { atomicAdd(&bar[XB_TMO], 1u); break; } }
    }
    nloc = mine > 0u ? mine : 1u; nx = cnt > 0u ? cnt : 1u;
}
__device__ __forceinline__ void xcd_barrier(const XcdBarrier& b) {
    asm volatile("s_waitcnt vmcnt(0)" ::: "memory");
    __syncthreads();
    if (threadIdx.x == 0) {
        unsigned* bar = b.bar;
        __builtin_amdgcn_s_waitcnt(0);
        unsigned nloc = b.st[0], nx = b.st[1];
        if (nloc == 0u) { xcd_barrier_complete(bar, b.x, nloc, nx); b.st[0] = nloc; b.st[1] = nx; }
        const unsigned old = xb_add(&bar[XB_XSUB(b.x)], 1u);
        const unsigned gen = old / nloc;
        if (old + 1u == (gen + 1u) * nloc) {
            __builtin_amdgcn_fence(__ATOMIC_RELEASE, "agent");
            asm volatile("s_waitcnt vmcnt(0)" ::: "memory");
            const unsigned og = xb_add(&bar[XB_TOP], 1u);
            const unsigned tg = og / nx;
            if (og + 1u == (tg + 1u) * nx) xb_add(&bar[XB_TOPGEN], 1u);
            else XB_SPIN(xb_ld(&bar[XB_TOPGEN]) == tg, bar);
            __builtin_amdgcn_fence(__ATOMIC_ACQUIRE, "agent");
            xb_add(&bar[XB_XGEN(b.x)], 1u);
            asm volatile("s_waitcnt vmcnt(0)" ::: "memory");
        } else {
            XB_SPIN(xb_ld(&bar[XB_XGEN(b.x)]) == gen, bar);
            __builtin_amdgcn_fence(__ATOMIC_ACQUIRE, "agent");
            asm volatile("s_waitcnt vmcnt(0)" ::: "memory");
        }
    }
    __syncthreads();
}

__device__ __forceinline__ const void* ldp(const volatile LAS unsigned* tab, int i) {
    const unsigned lo = __builtin_amdgcn_readfirstlane(tab[2 * i]), hi = __builtin_amdgcn_readfirstlane(tab[2 * i + 1]);
    return (const void*)(((unsigned long long)hi << 32) | lo);
}
struct Args {
    const float* x; const float* mem; const float* norm_mix; const float* w_in; const float* b_forget; const float* norm_fox; const float* norm_sb; const float* w_out;
    const float* norm_xattn; const float* norm_mem; const float* w_xq; const float* w_xkv; const float* w_xo; const float* norm_ffn;
    const float* w_rg; const float* b_rg; const float* w_re; const float* b_re; const float* w_gate; const float* w_up; const float* w_down; const float* norm_final;
    float* out; unsigned char* ws;
};

__device__ __forceinline__ void transpose_item(const float* W, int ldw, bf16_t* WT, int ldo, int k0, int n0, int dst_row0, const float* gain, LAS float* scr, int lane) {
#pragma unroll 8
    for (int i = 0; i < 32; ++i) { const int kk = 2 * i + (lane >> 5); float v = W[(size_t)(k0 + kk) * ldw + n0 + (lane & 31)]; if (gain) v *= gain[k0 + kk]; scr[kk * 33 + (lane & 31)] = v; }
    LDS_WAIT(); asm volatile("" ::: "memory");
    const int c = lane & 7;
#pragma unroll
    for (int j = 0; j < 4; ++j) { const int n = (lane >> 3) + 8 * j; const LAS float* s = scr + (8 * c) * 33 + n;
        u32x4 o; o.x = cvt_pk_bf16(s[0 * 33], s[1 * 33]); o.y = cvt_pk_bf16(s[2 * 33], s[3 * 33]); o.z = cvt_pk_bf16(s[4 * 33], s[5 * 33]); o.w = cvt_pk_bf16(s[6 * 33], s[7 * 33]);
        *(u32x4*)(WT + (size_t)(dst_row0 + n) * ldo + k0 + 8 * c) = o; }
    LDS_WAIT(); asm volatile("" ::: "memory");
}

struct SchedDense {
    const char* A; const char* Bt; int nM, nN, G, c; size_t a_tile, b_tile, b_batch; int split_tiles;
    __device__ __forceinline__ bool next(int i, pg8::Unit& u) const {
        int pm, pn; if (!pg8::tile_order(i, G, c, nM, nN, pm, pn)) return false;
        u.a = A + (size_t)pm * a_tile; u.b = Bt + (size_t)pn * b_tile + (size_t)(pm >> 5) * b_batch; u.orow = pm * 256;
        if (split_tiles) { u.aux = pn / split_tiles; u.ocol = (pn % split_tiles) * 256; } else { u.aux = 1; u.ocol = pn * 256; }
        u.rows = nullptr; u.nvalid = 256; return true;
    }
};
struct SchedGH {
    const char* KVm; const char* Wxq; const char* Wxo; int G, c;
    __device__ __forceinline__ bool next(int i, pg8::Unit& u) const {
        const int L = i * G + c; if (L >= 256) return false;
        const int kind = L >> 7, r = L & 127, bh = r >> 2, j = r & 3, b = bh >> 2, h = bh & 3;
        if (kind == 0) { u.a = KVm + ((size_t)(b * 256) * 2048 + h * 256) * 2; u.b = Wxq + ((size_t)(256 * j) * 1024 + h * 256) * 2; u.orow = b * 1024 + h * 256; u.ocol = 256 * j; u.aux = 1; }
        else { u.a = Wxo + ((size_t)(256 * j) * 1024 + h * 256) * 2; u.b = KVm + ((size_t)(b * 256) * 2048 + 1024 + h * 256) * 2; u.orow = b * 1024 + 256 * j; u.ocol = h * 256; u.aux = 2; }
        u.rows = nullptr; u.nvalid = 256; return true;
    }
};
template <int KIND> struct SchedGHk { SchedGH s; __device__ __forceinline__ bool next(int i, pg8::Unit& u) const { const int L = i * s.G + s.c; if (L >= 128) return false; SchedGH t = s; t.G = 1; t.c = 0; return t.next(128 * KIND + L, u); } };
struct EpiGH { bf16_t* GTp; bf16_t* HTp; __device__ __forceinline__ void operator()(const f32x4 (&acc)[2][2][4][2], const pg8::Unit& u, int wr, int wc, int fr, int fq) const {
    pg8::EpiBf16 e{u.aux == 1 ? GTp : HTp, DM, nullptr, 0, 1.f, 1.f, nullptr}; pg8::Unit v = u; v.aux = 1; e(acc, v, wr, wc, fr, fq); } };
struct SchedMoe {
    const char* A; const char* W; const int* list; const LAS int* tbl; int G, c, NPN; size_t w_exp, w_tile, a_tile; int ocol_w;
    __device__ __forceinline__ bool next(int i, pg8::Unit& u) const {
        const int L = i * G + c; const int tl = L / NPN, pn = L % NPN;
        if (tl >= __builtin_amdgcn_readfirstlane(tbl[16])) return false;
        int e = 0;
#pragma unroll 1
        for (int x = 1; x < NEXP; ++x) { if (tl >= __builtin_amdgcn_readfirstlane(tbl[x])) e = x; }
        const int j = tl - __builtin_amdgcn_readfirstlane(tbl[e]), n = __builtin_amdgcn_readfirstlane(tbl[32 + e]) - 256 * j;
        u.a = A + (size_t)tl * a_tile; u.b = W + (size_t)e * w_exp + (size_t)pn * w_tile; u.orow = tl * 256; u.ocol = pn * ocol_w; u.aux = 1;
        u.rows = list + (size_t)e * M + 256 * j; u.nvalid = n < 256 ? n : 256; return true;
    }
};
__device__ __forceinline__ void moe_table(LAS int* tbl, const unsigned* ctl) {
    if (threadIdx.x == 0) { int base = 0; for (int e = 0; e < NEXP; ++e) { const int n = (int)ctl[CW_CNT + 64 * e]; tbl[e] = base; tbl[32 + e] = n; base += (n + 255) >> 8; } tbl[16] = base; }
    __syncthreads();
}

__global__ void __launch_bounds__(NWAVES * 64, 2) hymba_fwd(Args args) {
    extern __shared__ __attribute__((aligned(16))) unsigned char lds_raw[];
    LAS unsigned char* lds = (LAS unsigned char*)lds_raw;
    volatile LAS unsigned* MISC = (volatile LAS unsigned*)(lds + MISC_OFF);
    const int tid0 = threadIdx.x; const int wave = __builtin_amdgcn_readfirstlane(tid0 >> 6);
    const int G = gridDim.x; const int bx = blockIdx.x; const int vcu = (G % 8 == 0) ? (bx % 8) * (G / 8) + bx / 8 : bx;
    volatile LAS unsigned* ATAB = (volatile LAS unsigned*)(lds + MISC_OFF + 512);
    for (int u = tid0; u < 256; u += NWAVES * 64) ((LAS unsigned*)(lds + MISC_OFF))[u] = 0u;
    __syncthreads();
    if (tid0 == 0) { const float* const* ap = (const float* const*)&args;
#pragma unroll
        for (int i = 0; i < 24; ++i) { const unsigned long long v = (unsigned long long)ap[i]; ATAB[2 * i] = (unsigned)v; ATAB[2 * i + 1] = (unsigned)(v >> 32); } }
    __syncthreads();
#define ARGP(name) ((const float*)ldp(ATAB, (int)(offsetof(Args, name) / 8)))
#define PHASE_PTRS \
    int tid = threadIdx.x; asm volatile("" : "+v"(tid)); const int lane = tid & 63; (void)lane; \
    unsigned char* const ws = (unsigned char*)ldp(ATAB, 23); float* const out = (float*)ldp(ATAB, 22); unsigned* const ctl = (unsigned*)(ws + WS_CTL); (void)out; (void)ctl; \
    bf16_t* const Win_t = (bf16_t*)(ws + WS_WIN); bf16_t* const Wout_t = (bf16_t*)(ws + WS_WOUT); bf16_t* const Wxq_n = (bf16_t*)(ws + WS_WXQ); bf16_t* const Wxkv_t = (bf16_t*)(ws + WS_WXKV); \
    bf16_t* const Wxo_t = (bf16_t*)(ws + WS_WXO); bf16_t* const Wgu_t = (bf16_t*)(ws + WS_WGU); bf16_t* const Wd_t = (bf16_t*)(ws + WS_WD); \
    float* const RX = (float*)(ws + WS_RX); float* const RMEM = (float*)(ws + WS_RMEM); float* const LF = (float*)(ws + WS_LF); float* const CC = (float*)(ws + WS_C2); float* const SSQ = (float*)(ws + WS_SSQ); \
    int* const TOKSLOT = (int*)(ws + WS_TOKSLOT); float* const TOKW = (float*)(ws + WS_TOKW); int* const LIST = (int*)(ws + WS_LIST); \
    bf16_t* const MEMB = (bf16_t*)(ws + WS_MEMB); bf16_t* const KVM = (bf16_t*)(ws + WS_KVM); bf16_t* const GT = (bf16_t*)(ws + WS_GT); bf16_t* const HT = (bf16_t*)(ws + WS_HT); \
    bf16_t* const XB = (bf16_t*)(ws + WS_XB); bf16_t* const QKV = (bf16_t*)(ws + WS_QKV); bf16_t* const H1B = (bf16_t*)(ws + WS_H1B); bf16_t* const U2B = (bf16_t*)(ws + WS_U2B); bf16_t* const HID = (bf16_t*)(ws + WS_HID); \
    bf16_t* const OAB = (bf16_t*)(ws + WS_O); bf16_t* const YB = (bf16_t*)(ws + WS_Y); bf16_t* const KX = (bf16_t*)(ws + WS_KX); (void)KX; \
    (void)Win_t; (void)Wout_t; (void)Wxq_n; (void)Wxkv_t; (void)Wxo_t; (void)Wgu_t; (void)Wd_t; (void)RX; (void)RMEM; (void)LF; (void)CC; (void)SSQ; (void)TOKSLOT; (void)TOKW; (void)LIST; \
    (void)MEMB; (void)KVM; (void)GT; (void)HT; (void)XB; (void)QKV; (void)H1B; (void)U2B; (void)HID; (void)OAB; (void)YB;
    XcdBarrier bar;
    { unsigned char* const ws0 = (unsigned char*)ldp(ATAB, 23); bar = xcd_barrier_post((unsigned*)(ws0 + WS_CTL) + CW_BAR, MISC + 8); }
    const int gw = vcu * NWAVES + wave, NGW = G * NWAVES;


    if (PH(0))
    for (int rep_ = 0; rep_ < REPS(0); ++rep_)
    {
        PHASE_PTRS
        LAS float* wfT = (LAS float*)(lds + RING_OFF);
        LAS float* scr = (LAS float*)(lds + RING_OFF + 32768 + wave * 8448);
        for (int idx = tid; idx < 8 * DM; idx += NWAVES * 64) { const int j = idx >> 10, k = idx & 1023; wfT[idx] = ARGP(w_in)[(size_t)k * WIN_LD + NPROJ + j] * ARGP(norm_mix)[k]; }
        constexpr int I_IN = 16 * 96, I_OUT = 16 * 32, I_XKV = 16 * 64, I_XO = 16 * 32, I_G = 16 * 16 * 8, I_U = I_G, I_D = 16 * 4 * 32, I_XQ = 1024;
        constexpr int NITEMS = I_IN + I_OUT + I_XKV + I_XO + I_G + I_U + I_D + I_XQ;
        for (int it = gw; it < NITEMS; it += NGW) {
            int r = it;
            if (r < I_IN) { const int kb = r / 96, nb = r % 96; transpose_item(ARGP(w_in), WIN_LD, Win_t, DM, 64 * kb, 32 * nb, 32 * nb, ARGP(norm_mix), scr, lane); continue; } r -= I_IN;
            if (r < I_OUT) { const int kb = r / 32, nb = r % 32; const float* gn = (64 * kb < HW) ? ARGP(norm_fox) : (ARGP(norm_sb) - HW); transpose_item(ARGP(w_out), DM, Wout_t, DM, 64 * kb, 32 * nb, 32 * nb, gn, scr, lane); continue; } r -= I_OUT;
            if (r < I_XKV) { const int kb = r / 64, nb = r % 64; transpose_item(ARGP(w_xkv), 2 * DM, Wxkv_t, DM, 64 * kb, 32 * nb, 32 * nb, ARGP(norm_mem), scr, lane); continue; } r -= I_XKV;
            if (r < I_XO) { const int kb = r / 32, nb = r % 32; transpose_item(ARGP(w_xo), DM, Wxo_t, DM, 64 * kb, 32 * nb, 32 * nb, nullptr, scr, lane); continue; } r -= I_XO;
            if (r < I_G + I_U) { const int up = r >= I_G; const int q = up ? r - I_G : r; const int e = q / 128, kb = (q % 128) / 8, nb = q % 8; const int n0 = 32 * nb;
                const float* W = (up ? ARGP(w_up) : ARGP(w_gate)) + (size_t)e * DM * DFF;
                transpose_item(W, DFF, Wgu_t + (size_t)e * 512 * DM, DM, 64 * kb, n0, 256 * (n0 / 128) + (n0 % 128) + (up ? 128 : 0), nullptr, scr, lane); continue; } r -= I_G + I_U;
            if (r < I_D) { const int e = r / 128, kb = (r % 128) / 32, nb = r % 32; transpose_item(ARGP(w_down) + (size_t)e * DFF * DM, DM, Wd_t + (size_t)e * DM * DFF, DFF, 64 * kb, 32 * nb, 32 * nb, nullptr, scr, lane); continue; } r -= I_D;
            { const int k = r; const float gk = ARGP(norm_xattn)[k]; const f32x4* src = (const f32x4*)(ARGP(w_xq) + (size_t)k * DM) + lane; u32x2* dst = (u32x2*)(Wxq_n + (size_t)k * DM) + lane;
#pragma unroll
              for (int j = 0; j < 4; ++j) { const f32x4 v = src[64 * j] * gk; u32x2 w; w.x = cvt_pk_bf16(v[0], v[1]); w.y = cvt_pk_bf16(v[2], v[3]); dst[64 * j] = w; } }
        }
        __syncthreads();
        for (int row = gw; row < M + MEMROWS; row += NGW) {
            const bool is_mem = row >= M; const int r = is_mem ? row - M : row;
            const f32x4* xr = (const f32x4*)((is_mem ? ARGP(mem) : ARGP(x)) + (size_t)r * DM) + lane;
            f32x4 v[4]; float s = 0.f;
#pragma unroll
            for (int j = 0; j < 4; ++j) { v[j] = xr[64 * j]; s += (v[j][0] * v[j][0] + v[j][1] * v[j][1]) + (v[j][2] * v[j][2] + v[j][3] * v[j][3]); }
            const float rinv = rsqrtf(wave_sum(s) * (1.0f / DM) + EPS);
            u32x2* o8 = (u32x2*)((is_mem ? MEMB : XB) + (size_t)r * DM) + lane;
#pragma unroll
            for (int j = 0; j < 4; ++j) { u32x2 w; w.x = cvt_pk_bf16(v[j][0], v[j][1]); w.y = cvt_pk_bf16(v[j][2], v[j][3]); o8[64 * j] = w; }
            if (is_mem) { if (lane == 0) RMEM[r] = rinv; continue; }
            float f[8];
#pragma unroll
            for (int jj = 0; jj < 8; ++jj) { float a = 0.f;
#pragma unroll
                for (int j = 0; j < 4; ++j) { const f32x4 w4 = *(const LAS f32x4*)(wfT + jj * DM + 256 * j + 4 * lane); a += (v[j][0] * w4[0] + v[j][1] * w4[1]) + (v[j][2] * w4[2] + v[j][3] * w4[3]); }
                f[jj] = wave_sum(a); }
            if (lane == 0) RX[r] = rinv;
            if (lane < 8) { float fl = 0.f;
#pragma unroll
                for (int jj = 0; jj < 8; ++jj) fl = (lane == jj) ? f[jj] : fl;
                fl = fl * rinv + ARGP(b_forget)[lane];
                const float ls = fminf(fl, 0.f) - log1pf(expf(-fabsf(fl)));
                LF[(size_t)r * 8 + lane] = ls * LOG2E; }
        }
    }
    xcd_barrier(bar);

    if (PH(1))
    if (vcu < BATCH) {
        PHASE_PTRS
        const int b = vcu, h = wave; float carry = 0.f;
        const float* src = LF + (size_t)b * SEQ * 8 + h; float* dst = CC + ((size_t)b * NH + h) * SEQ;
        for (int i0 = 0; i0 < SEQ; i0 += 256) {
            float v[4];
#pragma unroll
            for (int k = 0; k < 4; ++k) v[k] = src[(size_t)(i0 + 64 * k + lane) * 8];
#pragma unroll
            for (int k = 0; k < 4; ++k) { float x = v[k];
#pragma unroll
                for (int o = 1; o < 64; o <<= 1) { const float y = __shfl_up(x, o); if (lane >= o) x += y; }
                x += carry; dst[i0 + 64 * k + lane] = x; carry = __shfl(x, 63);
                { unsigned hm, lo; fox::split3(-x, hm, lo); u32x4 w; w.x = 0x3F803F80u; w.y = 0x3F80u | (hm << 16); w.z = (hm >> 16) | (lo << 16); w.w = 0u;
                  *(u32x4*)(KX + (((size_t)b * NH + h) * SEQ + i0 + 64 * k + lane) * 8) = w; } }
        }
    }
    if (PH(1))
    for (int rep_ = 0; rep_ < REPS(1); ++rep_)
    {
        PHASE_PTRS
        pg8::Gemm g{DM, DM, DM};
        SchedDense S{(const char*)XB, (const char*)Win_t, M / 256, NPROJ / 256, G, bx, (size_t)256 * DM * 2, (size_t)256 * DM * 2, 0, 2};
        pg8::EpiBf16 E{QKV, HW, RX, QKV_STRIDE, C2, C2, ctl + CW_KN};
        pg8::gemm_phase<pg8::EpiBf16, SchedDense, true, false>(lds + RING_OFF, g, S, E);
        SchedDense S2{(const char*)MEMB, (const char*)Wxkv_t, MEMROWS / 256, 2 * DM / 256, G, bx, (size_t)256 * DM * 2, (size_t)256 * DM * 2, 0, 0};
        pg8::EpiBf16 E2{KVM, 2 * DM, RMEM, 0, 1.f, 1.f, nullptr};
        pg8::gemm_phase<pg8::EpiBf16, SchedDense, true, false>(lds + RING_OFF, g, S2, E2);
    }
    xcd_barrier(bar);

    if (PH(2))
    {
        PHASE_PTRS
        const bf16_t* QA = QKV; const bf16_t* KA = QKV + QKV_STRIDE; const bf16_t* VA = QKV + 2 * QKV_STRIDE;
        const bf16_t* QBp = QKV + 3 * QKV_STRIDE; const bf16_t* KBp = QKV + 4 * QKV_STRIDE; const bf16_t* VBp = QKV + 5 * QKV_STRIDE;
        bf16_t* OA = OAB; bf16_t* OB = OAB + QKV_STRIDE;
        LAS char* shm = (LAS char*)(lds + RING_OFF);
        for (int rep = 0; rep < REP_FOX; ++rep)
        for (int i = 0; i < 8; ++i) { const int bh = (vcu >> 5) * 8 + i, x = vcu & 31, qb = (i & 1) ? 31 - x : x;
            const float kmax = sqrtf(__uint_as_float(ctl[CW_KN + bh * 2]) + __uint_as_float(ctl[CW_KN + bh * 2 + 1])) * 1.01f;
#if FOX_V2
            fox::fox_unit<8>(bh, qb, QA, KA, VA, OA, CC + (size_t)bh * SEQ, KX + (size_t)bh * SEQ * 8, kmax, shm); }
#else
            att::attn_unit<0>(bh >> 3, bh & 7, qb, QA, KA, VA, OA, CC + (size_t)bh * SEQ, shm); }
#endif
        for (int rep = 0; rep < REP_SB; ++rep)
        for (int i = 0; i < 8; ++i) { const int bh = vcu >> 2, qb = 8 * (vcu & 3) + i;
            att::attn_unit<1>(bh >> 3, bh & 7, qb, QBp, KBp, VBp, OB, nullptr, shm); }
    }
    xcd_barrier(bar);

    if (PH(3))
    for (int rep_ = 0; rep_ < REPS(3); ++rep_)
    {
        PHASE_PTRS
        const bf16_t* OA = OAB; const bf16_t* OB = OAB + QKV_STRIDE; bf16_t* MIX = XB;
        for (int row = gw; row < M; row += NGW) {
            const u32x4 a = *((const u32x4*)(OA + (size_t)row * HW) + lane), b = *((const u32x4*)(OB + (size_t)row * HW) + lane);
            float fa[8] = {bf16lo(a.x), bf16hi(a.x), bf16lo(a.y), bf16hi(a.y), bf16lo(a.z), bf16hi(a.z), bf16lo(a.w), bf16hi(a.w)};
            float fb[8] = {bf16lo(b.x), bf16hi(b.x), bf16lo(b.y), bf16hi(b.y), bf16lo(b.z), bf16hi(b.z), bf16lo(b.w), bf16hi(b.w)};
            float sa = 0.f, sb = 0.f;
#pragma unroll
            for (int j = 0; j < 8; ++j) { sa += fa[j] * fa[j]; sb += fb[j] * fb[j]; }
            const float ra = rsqrtf(wave_sum(sa) * (1.0f / HW) + EPS), rb = rsqrtf(wave_sum(sb) * (1.0f / HW) + EPS);
            u32x4 wa, wb;
            wa.x = cvt_pk_bf16(fa[0] * ra, fa[1] * ra); wa.y = cvt_pk_bf16(fa[2] * ra, fa[3] * ra); wa.z = cvt_pk_bf16(fa[4] * ra, fa[5] * ra); wa.w = cvt_pk_bf16(fa[6] * ra, fa[7] * ra);
            wb.x = cvt_pk_bf16(fb[0] * rb, fb[1] * rb); wb.y = cvt_pk_bf16(fb[2] * rb, fb[3] * rb); wb.z = cvt_pk_bf16(fb[4] * rb, fb[5] * rb); wb.w = cvt_pk_bf16(fb[6] * rb, fb[7] * rb);
            *((u32x4*)(MIX + (size_t)row * DM) + lane) = wa; *((u32x4*)(MIX + (size_t)row * DM + HW) + lane) = wb;
        }
        __syncthreads();
        pg8::Gemm g{0, 0, 256};
        SchedGH S{(const char*)KVM, (const char*)Wxq_n, (const char*)Wxo_t, G, bx};
        EpiGH E{GT, HT};
        g.lda = 2 * DM; g.ldb = DM; SchedGHk<0> S0{S}; pg8::gemm_phase<EpiGH, SchedGHk<0>, true, false>(lds + RING_OFF, g, S0, E);
        g.lda = DM; g.ldb = 2 * DM; SchedGHk<1> S1{S}; pg8::gemm_phase<EpiGH, SchedGHk<1>, true, false>(lds + RING_OFF, g, S1, E);
    }
    xcd_barrier(bar);

    if (PH(4))
    for (int rep_ = 0; rep_ < REPS(4); ++rep_)
    {
        PHASE_PTRS
        pg8::Gemm g{DM, DM, DM};
        SchedDense S{(const char*)XB, (const char*)Wout_t, M / 256, DM / 256, G, bx, (size_t)256 * DM * 2, (size_t)256 * DM * 2, 0, 0};
        pg8::EpiResid E{ARGP(x), out, H1B, SSQ};
        pg8::gemm_phase<pg8::EpiResid, SchedDense, true, false>(lds + RING_OFF, g, S, E);
    }
    xcd_barrier(bar);

    if (PH(5))
    for (int rep_ = 0; rep_ < REPS(5); ++rep_)
    {
        PHASE_PTRS
        pg8::Gemm g{DM, DM, DM};
        SchedDense S{(const char*)H1B, (const char*)GT, M / 256, DM / 256, G, bx, (size_t)256 * DM * 2, (size_t)256 * DM * 2, (size_t)DM * DM * 2, 0};
        pg8::EpiSoftmax E{XB, SSQ, (LAS float*)(lds + EXTRA_OFF)};
        pg8::gemm_phase<pg8::EpiSoftmax, SchedDense, true, false>(lds + RING_OFF, g, S, E);
    }
    xcd_barrier(bar);

    if (PH(6))
    {
        PHASE_PTRS
        pg8::Gemm g{DM, DM, DM};
        SchedDense S{(const char*)XB, (const char*)HT, M / 256, DM / 256, G, bx, (size_t)256 * DM * 2, (size_t)256 * DM * 2, (size_t)DM * DM * 2, 0};
        pg8::EpiResid E{out, out, nullptr, nullptr};
        pg8::gemm_phase<pg8::EpiResid, SchedDense, true, false>(lds + RING_OFF, g, S, E);
    }
    xcd_barrier(bar);

    if (PH(7))
    {
        PHASE_PTRS
        LAS float* wT = (LAS float*)(lds + RING_OFF);
        for (int idx = tid; idx < 20 * DM; idx += NWAVES * 64) { const int j = idx >> 10, k = idx & 1023; wT[idx] = (j < 4) ? ARGP(w_rg)[(size_t)k * 4 + j] : ARGP(w_re)[(size_t)k * 16 + (j - 4)]; }
        __syncthreads();
        for (int row = gw; row < M; row += NGW) {
            const f32x4* hr = (const f32x4*)(out + (size_t)row * DM) + lane; const f32x4* gp = (const f32x4*)ARGP(norm_ffn) + lane;
            f32x4 v[4]; float s = 0.f;
#pragma unroll
            for (int j = 0; j < 4; ++j) { v[j] = hr[64 * j]; s += (v[j][0] * v[j][0] + v[j][1] * v[j][1]) + (v[j][2] * v[j][2] + v[j][3] * v[j][3]); }
            const float rinv = rsqrtf(wave_sum(s) * (1.0f / DM) + EPS);
            u32x2* o8 = (u32x2*)(U2B + (size_t)row * DM) + lane;
#pragma unroll
            for (int j = 0; j < 4; ++j) { v[j] = v[j] * rinv * gp[64 * j]; u32x2 w; w.x = cvt_pk_bf16(v[j][0], v[j][1]); w.y = cvt_pk_bf16(v[j][2], v[j][3]); o8[64 * j] = w; }
            float lg[20];
#pragma unroll
            for (int jj = 0; jj < 20; ++jj) { float a = 0.f;
#pragma unroll
                for (int j = 0; j < 4; ++j) { const f32x4 w4 = *(const LAS f32x4*)(wT + jj * DM + 256 * j + 4 * lane); a += (v[j][0] * w4[0] + v[j][1] * w4[1]) + (v[j][2] * w4[2] + v[j][3] * w4[3]); }
                lg[jj] = wave_sum(a); asm volatile("" : "+v"(lg[jj]) :: "memory"); }
            float g0 = lg[0] + ARGP(b_rg)[0], g1 = lg[1] + ARGP(b_rg)[1], g2 = lg[2] + ARGP(b_rg)[2], g3 = lg[3] + ARGP(b_rg)[3];
            int gi = 0; float gm = g0; if (g1 > gm) { gm = g1; gi = 1; } if (g2 > gm) { gm = g2; gi = 2; } if (g3 > gm) { gm = g3; gi = 3; }
            const float gval = 1.0f / (expf(g0 - gm) + expf(g1 - gm) + expf(g2 - gm) + expf(g3 - gm));
            float el[4];
#pragma unroll
            for (int j = 0; j < 4; ++j) { const float e0 = lg[4 + j], e1 = lg[8 + j], e2 = lg[12 + j], e3 = lg[16 + j]; el[j] = ((gi == 0) ? e0 : (gi == 1) ? e1 : (gi == 2) ? e2 : e3) + ARGP(b_re)[gi * 4 + j]; }
            int i0 = 0; float m0 = el[0];
#pragma unroll
            for (int j = 1; j < 4; ++j) if (el[j] > m0) { m0 = el[j]; i0 = j; }
            int i1 = -1; float m1 = -3.0e38f;
#pragma unroll
            for (int j = 0; j < 4; ++j) if (j != i0 && el[j] > m1) { m1 = el[j]; i1 = j; }
            const float w0 = 1.0f / (1.0f + expf(m1 - m0)), w1 = 1.0f - w0;
            if (lane < 2) { const int e = gi * 4 + (lane == 0 ? i0 : i1); const float w = gval * (lane == 0 ? w0 : w1);
                const int pos = (int)__hip_atomic_fetch_add(ctl + CW_CNT + 64 * e, 1u, __ATOMIC_RELAXED, __HIP_MEMORY_SCOPE_AGENT);
                LIST[(size_t)e * M + pos] = row; TOKSLOT[(size_t)row * 2 + lane] = (e << 20) | pos; TOKW[(size_t)row * 2 + lane] = w; }
        }
    }
    xcd_barrier(bar);

    if (PH(8))
    for (int rep_ = 0; rep_ < REPS(8); ++rep_)
    {
        PHASE_PTRS
        pg8::Gemm g{DM, DM, DM};
        LAS int* tbl = (LAS int*)(lds + EXTRA_OFF + 8192); moe_table(tbl, ctl);
        SchedMoe S; S.A = (const char*)U2B; S.W = (const char*)Wgu_t; S.list = LIST; S.tbl = tbl; S.G = G; S.c = bx; S.NPN = 2; S.w_exp = (size_t)512 * DM * 2; S.w_tile = (size_t)256 * DM * 2; S.a_tile = 0; S.ocol_w = 128;
        pg8::EpiSwiglu E{HID};
        pg8::gemm_phase<pg8::EpiSwiglu, SchedMoe, true, true>(lds + RING_OFF, g, S, E);
    }
    xcd_barrier(bar);

    if (PH(9))
    for (int rep_ = 0; rep_ < REPS(9); ++rep_)
    {
        PHASE_PTRS
        pg8::Gemm g{DFF, DFF, DFF};
        LAS int* tbl = (LAS int*)(lds + EXTRA_OFF + 8192);
        SchedMoe S; S.A = (const char*)HID; S.W = (const char*)Wd_t; S.list = LIST; S.tbl = tbl; S.G = G; S.c = bx; S.NPN = 4; S.w_exp = (size_t)DM * DFF * 2; S.w_tile = (size_t)256 * DFF * 2; S.a_tile = (size_t)256 * DFF * 2; S.ocol_w = 256;
        pg8::EpiBf16 E{YB, DM, nullptr, 0, 1.f, 1.f, nullptr};
        pg8::gemm_phase<pg8::EpiBf16, SchedMoe, true, false>(lds + RING_OFF, g, S, E);
    }
    xcd_barrier(bar);

    if (PH(10))
    {
        PHASE_PTRS
        const LAS int* tb = (const LAS int*)(lds + EXTRA_OFF + 8192);
        for (int row = gw; row < M; row += NGW) {
            const int s0 = TOKSLOT[(size_t)row * 2], s1 = TOKSLOT[(size_t)row * 2 + 1]; const float w0 = TOKW[(size_t)row * 2], w1 = TOKW[(size_t)row * 2 + 1];
            const int r0 = tb[s0 >> 20] * 256 + (s0 & 0xfffff), r1 = tb[s1 >> 20] * 256 + (s1 & 0xfffff);
            f32x4* hr = (f32x4*)(out + (size_t)row * DM) + lane; const u32x2* y0 = (const u32x2*)(YB + (size_t)r0 * DM) + lane; const u32x2* y1 = (const u32x2*)(YB + (size_t)r1 * DM) + lane;
            const f32x4* gp = (const f32x4*)ARGP(norm_final) + lane;
            f32x4 v[4]; float s = 0.f;
#pragma unroll
            for (int j = 0; j < 4; ++j) { const u32x2 a = y0[64 * j], b = y1[64 * j]; f32x4 h = hr[64 * j];
                h[0] += w0 * bf16lo(a.x) + w1 * bf16lo(b.x); h[1] += w0 * bf16hi(a.x) + w1 * bf16hi(b.x); h[2] += w0 * bf16lo(a.y) + w1 * bf16lo(b.y); h[3] += w0 * bf16hi(a.y) + w1 * bf16hi(b.y);
                v[j] = h; s += (h[0] * h[0] + h[1] * h[1]) + (h[2] * h[2] + h[3] * h[3]); }
            const float rinv = rsqrtf(wave_sum(s) * (1.0f / DM) + EPS);
#pragma unroll
            for (int j = 0; j < 4; ++j) hr[64 * j] = v[j] * rinv * gp[64 * j];
        }
    }
}

extern "C" void kernel_launch(void* const* d_in, const int* in_sizes, int n_in, void* d_out, int out_size, void* d_ws, size_t ws_size, hipStream_t stream) {
    static int grid = 0;
    if (grid == 0) {
        if (n_in != 22 || in_sizes[0] != M * DM || out_size != M * DM || ws_size < WS_END) { fprintf(stderr, "kernel_launch: unexpected shapes (n_in %d, in0 %d, out %d, ws %zu)\n", n_in, n_in > 0 ? in_sizes[0] : -1, out_size, ws_size); grid = -1; return; }
        int dev = 0, cus = 0, per_cu = 0;
        if (hipGetDevice(&dev) != hipSuccess || hipDeviceGetAttribute(&cus, hipDeviceAttributeMultiprocessorCount, dev) != hipSuccess) { grid = -1; return; }
        if (hipFuncSetAttribute((const void*)hymba_fwd, hipFuncAttributeMaxDynamicSharedMemorySize, LDS_BYTES) != hipSuccess) { fprintf(stderr, "kernel_launch: hipFuncSetAttribute failed\n"); grid = -1; return; }
        if (hipOccupancyMaxActiveBlocksPerMultiprocessor(&per_cu, (const void*)hymba_fwd, NWAVES * 64, LDS_BYTES) != hipSuccess || per_cu < 1) { fprintf(stderr, "kernel_launch: occupancy query reports %d\n", per_cu); }
        (void)hipGetLastError();
        grid = cus;
    }
    if (grid < 0) return;
    (void)hipMemsetAsync((char*)d_ws + WS_CTL, 0, CTL_ZERO_BYTES, stream);
    Args a{};
    const float** p = (const float**)&a;
    for (int i = 0; i < 22; ++i) p[i] = (const float*)d_in[i];
    a.out = (float*)d_out; a.ws = (unsigned char*)d_ws;
    hipLaunchKernelGGL(hymba_fwd, dim3(grid), dim3(NWAVES * 64), LDS_BYTES, stream, a);
}
```

```cpp
#include <hip/hip_runtime.h>
#include <hip/hip_bf16.h>
#include <cstdio>
#include <cstdint>

#define LAS __attribute__((address_space(3)))
#define GAS __attribute__((address_space(1)))
typedef unsigned short bf16_t;
typedef short bf16x8 __attribute__((ext_vector_type(8)));
typedef short s16x4 __attribute__((ext_vector_type(4)));
typedef float f32x4 __attribute__((ext_vector_type(4)));
typedef float f32x2 __attribute__((ext_vector_type(2)));
typedef float f32x16 __attribute__((ext_vector_type(16)));
typedef unsigned u32x4 __attribute__((ext_vector_type(4)));
typedef unsigned u32x2 __attribute__((ext_vector_type(2)));
typedef __bf16 bf16x2_t __attribute__((ext_vector_type(2)));

constexpr int BATCH = 8, SEQ = 8192, DM = 1024, M = BATCH * SEQ;
constexpr int NH = 8, HD = 64, HW = NH * HD;
constexpr int NPROJ = 3 * HW * 2;
constexpr int WIN_LD = NPROJ + NH;
constexpr int NMEM = 256, XH = 4, XD = 256, MEMROWS = BATCH * NMEM;
constexpr int NEXP = 16, DFF = 256;
constexpr float EPS = 1e-6f;
constexpr float LOG2E = 1.4426950408889634f;
constexpr float C2 = 0.125f * LOG2E;
constexpr float XSC = 0.0625f * LOG2E;
constexpr float SB_EXIT = -173.0f;

constexpr size_t MiB = 1u << 20;
constexpr size_t WS_CTL = 0, CTL_ZERO_BYTES = 1 * MiB;
constexpr size_t WS_WIN = 1 * MiB;
constexpr size_t WS_WOUT = 7 * MiB;
constexpr size_t WS_WXQ = 9 * MiB;
constexpr size_t WS_WXKV = 11 * MiB;
constexpr size_t WS_WXO = 15 * MiB;
constexpr size_t WS_WGU = 17 * MiB;
constexpr size_t WS_WD = 33 * MiB;
constexpr size_t WS_RX = 41 * MiB;
constexpr size_t WS_RMEM = WS_RX + 256 * 1024;
constexpr size_t WS_LF = 42 * MiB;
constexpr size_t WS_C2 = 44 * MiB;
constexpr size_t WS_SSQ = 46 * MiB;
constexpr size_t WS_TOKSLOT = 50 * MiB;
constexpr size_t WS_TOKW = 51 * MiB;
constexpr size_t WS_LIST = 52 * MiB;
constexpr size_t WS_MEMB = 56 * MiB;
constexpr size_t WS_KVM = 60 * MiB;
constexpr size_t WS_GT = 68 * MiB;
constexpr size_t WS_HT = 84 * MiB;
constexpr size_t WS_KX = 100 * MiB;
constexpr size_t WS_HS = 108 * MiB;
constexpr size_t WS_XB = 128 * MiB;
constexpr size_t WS_QKV = 256 * MiB;
constexpr size_t WS_H1B = 256 * MiB, WS_U2B = 384 * MiB, WS_HID = 512 * MiB;
constexpr size_t WS_O = 640 * MiB;
constexpr size_t WS_Y = 704 * MiB;
constexpr size_t WS_END = 1024 * MiB;
constexpr size_t QKV_STRIDE = (size_t)M * HW;
constexpr int MAXTILES = M * 2 / 256 + NEXP;
static_assert(WS_Y + (size_t)MAXTILES * 256 * 1024 * 2 <= WS_END, "ws map");
static_assert(WS_HID + (size_t)MAXTILES * 256 * 256 * 2 <= WS_O, "ws map");
constexpr int CW_BAR = 4096;
constexpr int CW_KN = 20480;
constexpr int CW_CNT = 16384;

constexpr int RING_OFF = 0, RING_BYTES = 131072;
constexpr int EXTRA_OFF = 131072, EXTRA_BYTES = 16384;
constexpr int MISC_OFF = EXTRA_OFF + EXTRA_BYTES;
constexpr int LDS_BYTES = MISC_OFF + 1024;
constexpr int NWAVES = 8;
#ifndef PHASE_MASK
#define PHASE_MASK 0x7ff
#endif
#define PH(n) ((PHASE_MASK >> (n)) & 1)
#ifndef FOX_V2
#define FOX_V2 1
#endif
#ifndef REP_MASK
#define REP_MASK 0
#endif
#define REPS(n) (1 + ((REP_MASK >> (n)) & 1))
#ifndef REP_FOX
#define REP_FOX 1
#endif
#ifndef REP_SB
#define REP_SB 1
#endif

__device__ __forceinline__ unsigned cvt_pk_bf16(float lo, float hi) { f32x2 v = {lo, hi}; bf16x2_t b = __builtin_convertvector(v, bf16x2_t); return __builtin_bit_cast(unsigned, b); }
__device__ __forceinline__ float bf16lo(unsigned u) { return __uint_as_float(u << 16); }
__device__ __forceinline__ float bf16hi(unsigned u) { return __uint_as_float(u & 0xffff0000u); }
__device__ __forceinline__ float wave_sum(float v) {
#pragma unroll
    for (int o = 1; o < 64; o <<= 1) v += __shfl_xor(v, o);
    return v;
}
#define LDS_WAIT() asm volatile("s_waitcnt lgkmcnt(0)" ::: "memory")
#define VM_WAIT() asm volatile("s_waitcnt vmcnt(0)" ::: "memory")

namespace pg8 {
constexpr int BM = 256, BK = 64, HALF = 128, HTB = HALF * BK * 2, STAGE_BYTES = 8 * HTB, NXCD = 8, WGM = 8;
__host__ __device__ __forceinline__ int lds_byte(int r, int c) { const int st = (r >> 4) * 2 + (c >> 5), rr = r & 15, cc = c & 31, ob = rr * 64 + cc * 2; return st * 1024 + (ob ^ (((ob >> 9) & 1) << 5)); }
__host__ __device__ __forceinline__ void stage_rc(int b, int& R, int& C) { const int st = b / 1024, sb = b % 1024, swz = sb ^ (((sb >> 9) & 1) << 5); R = (st >> 1) * 16 + swz / 64; C = (st & 1) * 32 + (swz % 64) / 2; }
__host__ __device__ __forceinline__ int perm32(int rho) { const int n = rho >> 4, i = rho & 15; return 8 * (i >> 2) + 4 * n + (i & 3); }

struct Unit { const char* a; const char* b; int orow, ocol, aux; const int* rows; int nvalid; };
struct Gemm { int lda, ldb, K; };

__device__ __forceinline__ bool tile_order(int i, int G, int c, int nM, int nN, int& pm, int& pn) {
    const int nwg = nM * nN; const long L = (long)i * G + c; if (L >= nwg) return false;
    int wgid = (int)L; { const int q = nwg / NXCD, r = nwg % NXCD, xcd = wgid % NXCD, off = wgid / NXCD; wgid = (xcd < r ? xcd * (q + 1) : r * (q + 1) + (xcd - r) * q) + off; }
    const int nig = WGM * nN, gid = wgid / nig, fm = gid * WGM, gsz = (nM - fm) < WGM ? (nM - fm) : WGM;
    pm = fm + ((wgid % nig) % gsz); pn = (wgid % nig) / gsz; return true;
}

template <class Epi, class Sched, bool ALIGN_EPI, bool GATHER>
__device__ __forceinline__ void gemm_phase(LAS unsigned char* lds, const Gemm g, const Sched& S, const Epi& E) {
    int tid = threadIdx.x; asm volatile("" : "+v"(tid));
    const int wid = __builtin_amdgcn_readfirstlane(tid >> 6), lane = tid & 63, wr = wid >> 2, wc = wid & 3, fr = lane & 15, fq = lane >> 4;
    const int K = g.K, nt = K / BK;
    unsigned voffA[2], voffB[2]; int RA[2], CA[2];
#pragma unroll
    for (int i = 0; i < 2; ++i) { int R, C; stage_rc(tid * 16 + i * 8192, R, C); const int Rb = (R & ~31) + perm32(R & 31);
        RA[i] = R; CA[i] = C; voffA[i] = (unsigned)(R * g.lda + C) * 2u; voffB[i] = (unsigned)(Rb * g.ldb + C) * 2u; }
    const size_t kstep = (size_t)(BK * 2);
    const size_t hstepA = (size_t)HALF * g.lda * 2, hstepB = (size_t)HALF * g.ldb * 2;
    const unsigned ldsw = (unsigned)wid * 1024u;
    const int aoff = lds_byte(wr * 64 + fr, fq * 8), boff = lds_byte(wc * 32 + fr, fq * 8);
#define PG8_SA(b, h) (((b) * 2 + (h)) * HTB)
#define PG8_SB(b, h) ((4 + (b) * 2 + (h)) * HTB)
#define PG8_STAGE2(bufoff, gbase, v0, v1) do { \
        __builtin_amdgcn_global_load_lds((const unsigned*)((const char*)(gbase) + (v0)), (LAS unsigned*)(lds + (bufoff) + ldsw), 16, 0, 0); \
        __builtin_amdgcn_global_load_lds((const unsigned*)((const char*)(gbase) + (v1)), (LAS unsigned*)(lds + (bufoff) + ldsw + 8192), 16, 0, 0); } while (0)
#define PG8_STAGEB(bufoff, gbase) PG8_STAGE2(bufoff, gbase, voffB[0], voffB[1])
#define PG8_STAGEA(bufoff, kptr, h, NX) do { if constexpr (GATHER) { const unsigned v0_ = (NX) ? gvn[h][0] : gvc[h][0], v1_ = (NX) ? gvn[h][1] : gvc[h][1]; PG8_STAGE2(bufoff, kptr, v0_, v1_); } \
        else { PG8_STAGE2(bufoff, (kptr) + (h) * hstepA, voffA[0], voffA[1]); } } while (0)
#define PG8_LDA(dst, b, h) do { _Pragma("unroll") for (int m = 0; m < 4; ++m) _Pragma("unroll") for (int k = 0; k < 2; ++k) dst[m][k] = *(const LAS bf16x8*)(lds + PG8_SA(b, h) + aoff + m * 2048 + k * 1024); } while (0)
#define PG8_LDB(dst, b, h) do { _Pragma("unroll") for (int n = 0; n < 2; ++n) _Pragma("unroll") for (int k = 0; k < 2; ++k) dst[n][k] = *(const LAS bf16x8*)(lds + PG8_SB(b, h) + boff + n * 2048 + k * 1024); } while (0)
#define PG8_MMA(ai, bj, At, Bt) do { __builtin_amdgcn_s_setprio(1); _Pragma("unroll") for (int m = 0; m < 4; ++m) _Pragma("unroll") for (int n = 0; n < 2; ++n) _Pragma("unroll") for (int k = 0; k < 2; ++k) \
        acc[ai][bj][m][n] = __builtin_amdgcn_mfma_f32_16x16x32_bf16(Bt[n][k], At[m][k], acc[ai][bj][m][n], 0, 0, 0); __builtin_amdgcn_s_setprio(0); } while (0)
#define PG8_WAIT_V(n) asm volatile("s_waitcnt vmcnt(" #n ")" ::: "memory")
#define PG8_WAIT_L(n) asm volatile("s_waitcnt lgkmcnt(" #n ")" ::: "memory")
#define PG8_BAR __builtin_amdgcn_s_barrier()
#define PG8_SCHED __builtin_amdgcn_sched_barrier(0)
#define PG8_GATHER_OFFS(dst, u) do { _Pragma("unroll") for (int h_ = 0; h_ < 2; ++h_) _Pragma("unroll") for (int i_ = 0; i_ < 2; ++i_) { const int r_ = h_ * HALF + RA[i_]; \
        const int idx_ = (u).rows[r_ < (u).nvalid ? r_ : 0]; dst[h_][i_] = (unsigned)(idx_ * g.lda + CA[i_]) * 2u; } } while (0)
    Unit cur, nxt; int ui = 0;
    if (!S.next(0, cur)) return;
    unsigned gvc[2][2] = {{0u, 0u}, {0u, 0u}}, gvn[2][2] = {{0u, 0u}, {0u, 0u}};
    if constexpr (GATHER) { PG8_GATHER_OFFS(gvc, cur); }
    f32x4 acc[2][2][4][2];
#pragma unroll
    for (int a = 0; a < 2; ++a)
#pragma unroll
        for (int b = 0; b < 2; ++b)
#pragma unroll
            for (int m = 0; m < 4; ++m)
#pragma unroll
                for (int n = 0; n < 2; ++n) acc[a][b][m][n] = (f32x4){0.f, 0.f, 0.f, 0.f};
    bf16x8 At[4][2], B0[2][2], B1[2][2];
    const char* cA = cur.a; const char* cB = cur.b;
    PG8_STAGEB(PG8_SB(0, 0), cB); PG8_STAGEB(PG8_SB(0, 1), cB + hstepB); PG8_STAGEA(PG8_SA(0, 0), cA, 0, false); PG8_STAGEA(PG8_SA(0, 1), cA, 1, false);
    if (wr == 1) PG8_BAR;
    PG8_WAIT_V(2); PG8_BAR;
    PG8_STAGEB(PG8_SB(1, 0), cB + kstep); PG8_STAGEA(PG8_SA(1, 0), cA + kstep, 0, false); PG8_STAGEB(PG8_SB(1, 1), cB + hstepB + kstep);
    PG8_WAIT_V(6); PG8_BAR;
    for (;;) {
        const bool has_next = S.next(ui + 1, nxt);
        const char* nA = has_next ? nxt.a : cA; const char* nB = has_next ? nxt.b : cB;
        if constexpr (GATHER) { if (has_next) { PG8_GATHER_OFFS(gvn, nxt); } else { gvn[0][0] = gvc[0][0]; gvn[0][1] = gvc[0][1]; gvn[1][0] = gvc[1][0]; gvn[1][1] = gvc[1][1]; } }
#pragma unroll 1
        for (int t = 0; t < nt; t += 2) {
            const bool last = (t == nt - 2);
            const char* a1 = cA + (size_t)(t + 1) * kstep;
            const char* a2 = last ? nA : cA + (size_t)(t + 2) * kstep; const char* b2 = last ? nB : cB + (size_t)(t + 2) * kstep;
            const char* a3 = a2 + kstep; const char* b3 = b2 + kstep;
            PG8_LDB(B0, 0, 0); PG8_LDB(B1, 0, 1); PG8_SCHED; PG8_LDA(At, 0, 0); PG8_STAGEA(PG8_SA(1, 1), a1, 1, false);
            PG8_WAIT_V(8); PG8_WAIT_L(0); PG8_BAR; PG8_MMA(0, 0, At, B0); PG8_MMA(0, 1, At, B1); PG8_BAR; PG8_SCHED;
            PG8_LDA(At, 0, 1); PG8_STAGEB(PG8_SB(0, 0), b2); PG8_STAGEB(PG8_SB(0, 1), b2 + hstepB); PG8_STAGEA(PG8_SA(0, 0), a2, 0, last);
            PG8_WAIT_V(8); PG8_WAIT_L(0); PG8_BAR; PG8_MMA(1, 0, At, B0); PG8_MMA(1, 1, At, B1); PG8_BAR; PG8_SCHED;
            PG8_LDB(B0, 1, 0); PG8_LDB(B1, 1, 1); PG8_SCHED; PG8_LDA(At, 1, 0); PG8_STAGEA(PG8_SA(0, 1), a2, 1, last);
            PG8_WAIT_V(8); PG8_WAIT_L(0); PG8_BAR; PG8_MMA(0, 0, At, B0); PG8_MMA(0, 1, At, B1); PG8_BAR; PG8_SCHED;
            PG8_LDA(At, 1, 1); PG8_STAGEB(PG8_SB(1, 0), b3); PG8_STAGEB(PG8_SB(1, 1), b3 + hstepB); PG8_STAGEA(PG8_SA(1, 0), a3, 0, last);
            PG8_WAIT_V(8); PG8_WAIT_L(0); PG8_BAR; PG8_MMA(1, 0, At, B0); PG8_MMA(1, 1, At, B1); PG8_BAR; PG8_SCHED;
            if constexpr (Epi::HAS_MID) { if (t == (nt >> 1) - 2) { int fr3 = fr, fq3 = fq; asm volatile("" : "+v"(fr3), "+v"(fq3)); E.mid(acc, cur, wr, wc, fr3, fq3); } }
        }
        if constexpr (ALIGN_EPI) { if (wr == 0) PG8_BAR; }
        { int fr2 = fr, fq2 = fq; asm volatile("" : "+v"(fr2), "+v"(fq2));
          E(acc, cur, wr, wc, fr2, fq2); }
        if (!has_next) break;
#pragma unroll
        for (int a = 0; a < 2; ++a)
#pragma unroll
            for (int b = 0; b < 2; ++b)
#pragma unroll
                for (int m = 0; m < 4; ++m)
#pragma unroll
                    for (int n = 0; n < 2; ++n) acc[a][b][m][n] = (f32x4){0.f, 0.f, 0.f, 0.f};
        cur = nxt; cA = nA; cB = nB; ++ui;
        if constexpr (GATHER) { gvc[0][0] = gvn[0][0]; gvc[0][1] = gvn[0][1]; gvc[1][0] = gvn[1][0]; gvc[1][1] = gvn[1][1]; }
        if constexpr (ALIGN_EPI) { if (wr == 1) PG8_BAR; }
    }
    PG8_WAIT_V(0);
    if constexpr (!ALIGN_EPI) { if (wr == 0) PG8_BAR; }
    PG8_BAR;
#undef PG8_SA
#undef PG8_SB
#undef PG8_STAGE2
#undef PG8_STAGEA
#undef PG8_STAGEB
#undef PG8_LDA
#undef PG8_LDB
#undef PG8_MMA
#undef PG8_WAIT_V
#undef PG8_WAIT_L
#undef PG8_BAR
#undef PG8_SCHED
#undef PG8_GATHER_OFFS
}

#define EPI_ROW(u, ai, m) ((u).orow + (ai) * HALF + wr * 64 + (m) * 16 + fr)
#define EPI_COL(u, bj) ((u).ocol + (bj) * HALF + wc * 32 + 8 * fq)
struct EpiBf16 {
    static constexpr bool HAS_MID = false;
    bf16_t* O; int ldc; const float* rs; size_t stride; float sc0, sc3;
    unsigned* kn;
    __device__ __forceinline__ void operator()(const f32x4 (&acc)[2][2][4][2], const Unit& u, int wr, int wc, int fr, int fq) const {
        bf16_t* base = O + (size_t)u.aux * stride;
        const float sc = (u.aux == 0) ? sc0 : ((u.aux == 3) ? sc3 : 1.f);
        float nmax[2] = {0.f, 0.f}; const bool dokn = kn && u.aux == 1;
#pragma unroll
        for (int ai = 0; ai < 2; ++ai)
#pragma unroll
            for (int m = 0; m < 4; ++m) { const int row = EPI_ROW(u, ai, m); const float s = (rs ? rs[row] : 1.f) * sc;
#pragma unroll
                for (int bj = 0; bj < 2; ++bj) { const f32x4 v0 = acc[ai][bj][m][0] * s, v1 = acc[ai][bj][m][1] * s;
                    u32x4 w; w.x = cvt_pk_bf16(v0[0], v0[1]); w.y = cvt_pk_bf16(v0[2], v0[3]); w.z = cvt_pk_bf16(v1[0], v1[1]); w.w = cvt_pk_bf16(v1[2], v1[3]);
                    *(u32x4*)(base + (size_t)row * ldc + EPI_COL(u, bj)) = w;
                    if (dokn) { float q = (v0[0] * v0[0] + v0[1] * v0[1]) + (v0[2] * v0[2] + v0[3] * v0[3]) + (v1[0] * v1[0] + v1[1] * v1[1]) + (v1[2] * v1[2] + v1[3] * v1[3]);
                        q += __shfl_xor(q, 16); q += __shfl_xor(q, 32); nmax[bj] = fmaxf(nmax[bj], q); } } }
        if (dokn) {
#pragma unroll
            for (int bj = 0; bj < 2; ++bj) { float q = nmax[bj]; q = fmaxf(q, __shfl_xor(q, 1)); q = fmaxf(q, __shfl_xor(q, 2)); q = fmaxf(q, __shfl_xor(q, 4)); q = fmaxf(q, __shfl_xor(q, 8));
                const int head = ((u.ocol + bj * HALF) >> 6) + (wc >> 1), bt = u.orow / SEQ;
                if ((fr | fq) == 0) atomicMax(kn + ((bt * NH + head) * 2 + (wc & 1)), __float_as_uint(q)); }
        }
    }
};
struct EpiResid {
    static constexpr bool HAS_MID = false;
    const float* res; float* out; bf16_t* hb; float* ssq;
    __device__ __forceinline__ void operator()(const f32x4 (&acc)[2][2][4][2], const Unit& u, int wr, int wc, int fr, int fq) const {
#pragma unroll
        for (int ai = 0; ai < 2; ++ai)
#pragma unroll
            for (int m = 0; m < 4; ++m) { const int row = EPI_ROW(u, ai, m); float q = 0.f;
#pragma unroll
                for (int bj = 0; bj < 2; ++bj) { const size_t off = (size_t)row * DM + EPI_COL(u, bj);
                    const f32x4 r0 = *(const f32x4*)(res + off), r1 = *(const f32x4*)(res + off + 4);
                    const f32x4 v0 = acc[ai][bj][m][0] + r0, v1 = acc[ai][bj][m][1] + r1;
                    *(f32x4*)(out + off) = v0; *(f32x4*)(out + off + 4) = v1;
                    q += (v0[0] * v0[0] + v0[1] * v0[1]) + (v0[2] * v0[2] + v0[3] * v0[3]) + (v1[0] * v1[0] + v1[1] * v1[1]) + (v1[2] * v1[2] + v1[3] * v1[3]);
                    if (hb) { u32x4 w; w.x = cvt_pk_bf16(v0[0], v0[1]); w.y = cvt_pk_bf16(v0[2], v0[3]); w.z = cvt_pk_bf16(v1[0], v1[1]); w.w = cvt_pk_bf16(v1[2], v1[3]); *(u32x4*)(hb + off) = w; } }
                if (ssq) { q += __shfl_xor(q, 16); q += __shfl_xor(q, 32); if (fq == 0) ssq[(size_t)row * 16 + (u.ocol >> 8) * 4 + wc] = q; } }
    }
};
struct EpiOutProj {
    static constexpr bool HAS_MID = true;
    const bf16_t* xb; bf16_t* hb; float* ssq; const float* hs;
    __device__ __forceinline__ void scales(int row, float& ra, float& rb) const {
        const f32x4* p = (const f32x4*)(hs + (size_t)row * 16); const f32x4 a0 = p[0], a1 = p[1], b0 = p[2], b1 = p[3];
        ra = rsqrtf((((a0[0] + a0[1]) + (a0[2] + a0[3])) + ((a1[0] + a1[1]) + (a1[2] + a1[3]))) * (1.0f / HW) + EPS);
        rb = rsqrtf((((b0[0] + b0[1]) + (b0[2] + b0[3])) + ((b1[0] + b1[1]) + (b1[2] + b1[3]))) * (1.0f / HW) + EPS);
    }
    __device__ __forceinline__ void mid(f32x4 (&acc)[2][2][4][2], const Unit& u, int wr, int wc, int fr, int fq) const {
#pragma unroll
        for (int ai = 0; ai < 2; ++ai)
#pragma unroll
            for (int m = 0; m < 4; ++m) { float ra, rb; scales(EPI_ROW(u, ai, m), ra, rb); const float f = ra / rb;
#pragma unroll
                for (int bj = 0; bj < 2; ++bj) { acc[ai][bj][m][0] *= f; acc[ai][bj][m][1] *= f; } }
    }
    __device__ __forceinline__ void operator()(const f32x4 (&acc)[2][2][4][2], const Unit& u, int wr, int wc, int fr, int fq) const {
#pragma unroll
        for (int ai = 0; ai < 2; ++ai)
#pragma unroll
            for (int m = 0; m < 4; ++m) { const int row = EPI_ROW(u, ai, m); float ra, rb; scales(row, ra, rb); float q = 0.f;
#pragma unroll
                for (int bj = 0; bj < 2; ++bj) { const size_t off = (size_t)row * DM + EPI_COL(u, bj);
                    const u32x4 xr = *(const u32x4*)(xb + off);
                    f32x4 v0 = acc[ai][bj][m][0] * rb, v1 = acc[ai][bj][m][1] * rb;
                    v0[0] += bf16lo(xr.x); v0[1] += bf16hi(xr.x); v0[2] += bf16lo(xr.y); v0[3] += bf16hi(xr.y); v1[0] += bf16lo(xr.z); v1[1] += bf16hi(xr.z); v1[2] += bf16lo(xr.w); v1[3] += bf16hi(xr.w);
                    q += (v0[0] * v0[0] + v0[1] * v0[1]) + (v0[2] * v0[2] + v0[3] * v0[3]) + (v1[0] * v1[0] + v1[1] * v1[1]) + (v1[2] * v1[2] + v1[3] * v1[3]);
                    u32x4 w; w.x = cvt_pk_bf16(v0[0], v0[1]); w.y = cvt_pk_bf16(v0[2], v0[3]); w.z = cvt_pk_bf16(v1[0], v1[1]); w.w = cvt_pk_bf16(v1[2], v1[3]); *(u32x4*)(hb + off) = w; }
                q += __shfl_xor(q, 16); q += __shfl_xor(q, 32); if (fq == 0) ssq[(size_t)row * 16 + (u.ocol >> 8) * 4 + wc] = q; }
    }
};
struct EpiResidBf16 {
    static constexpr bool HAS_MID = false;
    bf16_t* hb;
    __device__ __forceinline__ void operator()(const f32x4 (&acc)[2][2][4][2], const Unit& u, int wr, int wc, int fr, int fq) const {
#pragma unroll
        for (int ai = 0; ai < 2; ++ai)
#pragma unroll
            for (int m = 0; m < 4; ++m) { const int row = EPI_ROW(u, ai, m);
#pragma unroll
                for (int bj = 0; bj < 2; ++bj) { const size_t off = (size_t)row * DM + EPI_COL(u, bj);
                    const u32x4 xr = *(const u32x4*)(hb + off);
                    f32x4 v0 = acc[ai][bj][m][0], v1 = acc[ai][bj][m][1];
                    v0[0] += bf16lo(xr.x); v0[1] += bf16hi(xr.x); v0[2] += bf16lo(xr.y); v0[3] += bf16hi(xr.y); v1[0] += bf16lo(xr.z); v1[1] += bf16hi(xr.z); v1[2] += bf16lo(xr.w); v1[3] += bf16hi(xr.w);
                    u32x4 w; w.x = cvt_pk_bf16(v0[0], v0[1]); w.y = cvt_pk_bf16(v0[2], v0[3]); w.z = cvt_pk_bf16(v1[0], v1[1]); w.w = cvt_pk_bf16(v1[2], v1[3]); *(u32x4*)(hb + off) = w; } }
    }
};
struct EpiSoftmax {
    static constexpr bool HAS_MID = false;
    bf16_t* P; const float* ssq; LAS float* red;
    __device__ __forceinline__ void operator()(f32x4 (&acc)[2][2][4][2], const Unit& u, int wr, int wc, int fr, int fq) const {
#pragma unroll
        for (int ai = 0; ai < 2; ++ai)
#pragma unroll
            for (int m = 0; m < 4; ++m) { const int row = EPI_ROW(u, ai, m); const f32x4* sp = (const f32x4*)(ssq + (size_t)row * 16);
                const f32x4 s0 = sp[0], s1 = sp[1], s2 = sp[2], s3 = sp[3];
                const float tot = ((s0[0] + s0[1]) + (s0[2] + s0[3])) + ((s1[0] + s1[1]) + (s1[2] + s1[3])) + ((s2[0] + s2[1]) + (s2[2] + s2[3])) + ((s3[0] + s3[1]) + (s3[2] + s3[3]));
                const float r1 = rsqrtf(tot * (1.0f / DM) + EPS) * XSC; float a = -3.0e38f;
#pragma unroll
                for (int bj = 0; bj < 2; ++bj)
#pragma unroll
                    for (int n = 0; n < 2; ++n) { f32x4 v = acc[ai][bj][m][n] * r1; acc[ai][bj][m][n] = v; a = fmaxf(a, fmaxf(fmaxf(v[0], v[1]), fmaxf(v[2], v[3]))); }
                a = fmaxf(a, __shfl_xor(a, 16)); a = fmaxf(a, __shfl_xor(a, 32));
                if (fq == 0) red[(ai * HALF + wr * 64 + m * 16 + fr) * 4 + wc] = a; asm volatile("" ::: "memory"); }
        LDS_WAIT(); __builtin_amdgcn_s_barrier(); asm volatile("" ::: "memory");
#pragma unroll
        for (int ai = 0; ai < 2; ++ai)
#pragma unroll
            for (int m = 0; m < 4; ++m) { const int rl = ai * HALF + wr * 64 + m * 16 + fr; const f32x4 mm = *(const LAS f32x4*)(red + rl * 4);
                const float a = fmaxf(fmaxf(mm[0], mm[1]), fmaxf(mm[2], mm[3])); float s = 0.f;
#pragma unroll
                for (int bj = 0; bj < 2; ++bj)
#pragma unroll
                    for (int n = 0; n < 2; ++n) { f32x4 v = acc[ai][bj][m][n];
                        v[0] = __builtin_amdgcn_exp2f(v[0] - a); v[1] = __builtin_amdgcn_exp2f(v[1] - a); v[2] = __builtin_amdgcn_exp2f(v[2] - a); v[3] = __builtin_amdgcn_exp2f(v[3] - a);
                        acc[ai][bj][m][n] = v; s += (v[0] + v[1]) + (v[2] + v[3]); }
                s += __shfl_xor(s, 16); s += __shfl_xor(s, 32);
                if (fq == 0) red[1024 + rl * 4 + wc] = s; }
        LDS_WAIT(); __builtin_amdgcn_s_barrier(); asm volatile("" ::: "memory");
#pragma unroll
        for (int ai = 0; ai < 2; ++ai)
#pragma unroll
            for (int m = 0; m < 4; ++m) { const int rl = ai * HALF + wr * 64 + m * 16 + fr; const int row = u.orow + rl; const f32x4 ss = *(const LAS f32x4*)(red + 1024 + rl * 4);
                const float inv = 1.0f / ((ss[0] + ss[1]) + (ss[2] + ss[3]));
#pragma unroll
                for (int bj = 0; bj < 2; ++bj) { const f32x4 v0 = acc[ai][bj][m][0] * inv, v1 = acc[ai][bj][m][1] * inv;
                    u32x4 w; w.x = cvt_pk_bf16(v0[0], v0[1]); w.y = cvt_pk_bf16(v0[2], v0[3]); w.z = cvt_pk_bf16(v1[0], v1[1]); w.w = cvt_pk_bf16(v1[2], v1[3]);
                    *(u32x4*)(P + (size_t)row * DM + EPI_COL(u, bj)) = w; } }
    }
};
struct EpiSwiglu {
    static constexpr bool HAS_MID = false;
    bf16_t* Hd;
    __device__ __forceinline__ void operator()(const f32x4 (&acc)[2][2][4][2], const Unit& u, int wr, int wc, int fr, int fq) const {
#pragma unroll
        for (int ai = 0; ai < 2; ++ai)
#pragma unroll
            for (int m = 0; m < 4; ++m) { const int row = EPI_ROW(u, ai, m); float h[8];
#pragma unroll
                for (int n = 0; n < 2; ++n)
#pragma unroll
                    for (int e = 0; e < 4; ++e) { const float gt = acc[ai][0][m][n][e], up = acc[ai][1][m][n][e];
                        h[n * 4 + e] = gt * __builtin_amdgcn_rcpf(1.0f + __builtin_amdgcn_exp2f(-gt * LOG2E)) * up; }
                u32x4 w; w.x = cvt_pk_bf16(h[0], h[1]); w.y = cvt_pk_bf16(h[2], h[3]); w.z = cvt_pk_bf16(h[4], h[5]); w.w = cvt_pk_bf16(h[6], h[7]);
                *(u32x4*)(Hd + (size_t)row * DFF + u.ocol + wc * 32 + 8 * fq) = w; }
    }
};
}

namespace att {
constexpr int QB = 256, KVBLK = 64, PITCH = HW, OPITCH = DM;
constexpr int SLOTB = 8192, LDS_K = 0, LDS_V = 2 * SLOTB, LDS_WS = 4 * SLOTB, LDS_OST = LDS_WS + NWAVES * 256, LDS_FLAG = LDS_OST + NWAVES * 4096, LDS_END = LDS_FLAG + 64;
static_assert(LDS_END <= RING_BYTES, "attention LDS");
__device__ __forceinline__ int crow(int r, int hi) { return (r & 3) + 8 * (r >> 2) + 4 * hi; }
__device__ __forceinline__ void glds16(const void* gsrc, unsigned lds_dst) { unsigned keep;
    asm volatile("s_mov_b32 %0, m0\n\ts_mov_b32 m0, %2\n\ts_nop 0\n\tglobal_load_lds_dwordx4 %1, off\n\ts_mov_b32 m0, %0" : "=&s"(keep) : "v"(gsrc), "s"(lds_dst) : "memory"); }
__device__ __forceinline__ void glds16s(const void* sbase, unsigned voff, unsigned lds_dst) { unsigned keep;
    asm volatile("s_mov_b32 %0, m0\n\ts_mov_b32 m0, %3\n\ts_nop 0\n\tglobal_load_lds_dwordx4 %1, %2\n\ts_mov_b32 m0, %0" : "=&s"(keep) : "v"(voff), "s"(sbase), "s"(lds_dst) : "memory"); }
#define ATT_WAIT_BAR0() asm volatile("s_waitcnt vmcnt(0) lgkmcnt(0)\n\ts_barrier" ::: "memory")
#define MFMA32(a, b, c) __builtin_amdgcn_mfma_f32_32x32x16_bf16(a, b, c, 0, 0, 0)
__device__ __forceinline__ void store_row_ssq(u32x4 v, float* dst, int ch) {
    float q = (bf16lo(v.x) * bf16lo(v.x) + bf16hi(v.x) * bf16hi(v.x)) + (bf16lo(v.y) * bf16lo(v.y) + bf16hi(v.y) * bf16hi(v.y)) + (bf16lo(v.z) * bf16lo(v.z) + bf16hi(v.z) * bf16hi(v.z)) + (bf16lo(v.w) * bf16lo(v.w) + bf16hi(v.w) * bf16hi(v.w));
    q += __shfl_xor(q, 1); q += __shfl_xor(q, 2); q += __shfl_xor(q, 4);
    if (ch == 0) *dst = q;
}
__device__ __forceinline__ void qkt(f32x16& p0, f32x16& p1, const LAS char* Kslot, const bf16x8* qr, const f32x16& cin, int r32, int hi) {
    const LAS char* kb = Kslot + hi * 1024 + r32 * 16;
#pragma unroll
    for (int d0 = 0; d0 < 4; ++d0) {
        const bf16x8 b0 = *(const LAS bf16x8*)(kb + d0 * 2048);
        const bf16x8 b1 = *(const LAS bf16x8*)(kb + d0 * 2048 + 512);
        if (d0 == 0) { p0 = MFMA32(b0, qr[0], cin); p1 = MFMA32(b1, qr[0], cin); }
        else { p0 = MFMA32(b0, qr[d0], p0); p1 = MFMA32(b1, qr[d0], p1); } }
}
__device__ __forceinline__ void pv(f32x16* o, int vb, bf16x8 pa0, bf16x8 pa1, bf16x8 pa2, bf16x8 pa3) {
#pragma unroll
    for (int d0 = 0; d0 < 2; ++d0) { s16x4 lo[4], hi[4];
#pragma unroll
        for (int ks = 0; ks < 4; ++ks) {
            asm volatile("ds_read_b64_tr_b16 %0,%1 offset:%c2" : "=&v"(lo[ks]) : "v"(vb), "i"(d0 * 4096 + ks * 1024) : "memory");
            asm volatile("ds_read_b64_tr_b16 %0,%1 offset:%c2" : "=&v"(hi[ks]) : "v"(vb), "i"(d0 * 4096 + ks * 1024 + 512) : "memory"); }
        asm volatile("s_waitcnt lgkmcnt(0)" ::: "memory"); __builtin_amdgcn_sched_barrier(0);
#define PK(k) (bf16x8){lo[k][0], lo[k][1], lo[k][2], lo[k][3], hi[k][0], hi[k][1], hi[k][2], hi[k][3]}
        o[d0] = MFMA32(pa0, PK(0), o[d0]); o[d0] = MFMA32(pa1, PK(1), o[d0]); o[d0] = MFMA32(pa2, PK(2), o[d0]); o[d0] = MFMA32(pa3, PK(3), o[d0]);
#undef PK
    }
}
__device__ __forceinline__ float swap_lo(float x) { auto rr = __builtin_amdgcn_permlane32_swap(__float_as_uint(x), __float_as_uint(x), false, false); return __uint_as_float(rr[0]); }
__device__ __forceinline__ float swap_hi(float x) { auto rr = __builtin_amdgcn_permlane32_swap(__float_as_uint(x), __float_as_uint(x), false, false); return __uint_as_float(rr[1]); }

template <int MODE> __device__ __forceinline__ void attn_unit(int b, int h, int qb, const bf16_t* Q, const bf16_t* K, const bf16_t* V, bf16_t* O, float* hs, const float* cb, LAS char* shm) {
    int tid = threadIdx.x; asm volatile("" : "+v"(tid)); const int lane = tid & 63, r32 = lane & 31, hi = lane >> 5; const int wid = __builtin_amdgcn_readfirstlane(tid >> 6);
    const long rowbase = (long)b * SEQ; const int q0 = qb * QB;
    const bf16_t* Qw = Q + (rowbase + q0 + wid * 32) * PITCH + h * HD;
    const bf16_t* Kh = K + rowbase * PITCH + h * HD; const bf16_t* Vh = V + rowbase * PITCH + h * HD;
    const unsigned lds0 = (unsigned)(uintptr_t)shm;
    LAS float* wsf = (LAS float*)(shm + LDS_WS) + wid * 64;
    LAS unsigned* flags = (LAS unsigned*)(shm + LDS_FLAG);
    const bf16_t* ksrc = Kh + (long)lane * PITCH + wid * 8;
    const bf16_t* vsrc = Vh + (long)(16 * (wid & 3) + (lane >> 2)) * PITCH + (wid >> 2) * 32 + (lane & 3) * 8;
    const unsigned kdst = lds0 + LDS_K + wid * 1024, vdst = lds0 + LDS_V + wid * 1024;
#define DMA_KV(t, slot) do { glds16(ksrc + (long)(t) * KVBLK * PITCH, (unsigned)__builtin_amdgcn_readfirstlane(kdst + (slot))); glds16(vsrc + (long)(t) * KVBLK * PITCH, (unsigned)__builtin_amdgcn_readfirstlane(vdst + (slot))); } while (0)
    const int vb0 = (int)(lds0 + LDS_V) + ((lane >> 4) & 1) * 32 + (lane & 3) * 8 + (4 * hi + ((lane & 15) >> 2)) * 64;
    const int NT = (q0 + QB) / KVBLK;
    DMA_KV(NT - 1, 0);
    bf16x8 qr[4];
#pragma unroll
    for (int d0 = 0; d0 < 4; ++d0) qr[d0] = *(const bf16x8*)(Qw + (long)r32 * PITCH + d0 * 16 + hi * 8);
    f32x16 o[2]; o[0] = f32x16{}; o[1] = f32x16{};
    const int qrel = wid * 32 + r32;
    float m_run = -1.0e30f, l_run = 0.f, R = 0.f, ct = 0.f;
    if (MODE == 0) ct = cb[q0 + qrel];
    bf16x8 TD0, TD1, TONE;
#pragma unroll
    for (int j = 0; j < 8; ++j) { const int kvl = 8 * (j >> 2) + 4 * hi + (j & 3); TD0[j] = (kvl >= r32) ? (short)0x3F80 : (short)0; TD1[j] = (16 + kvl >= r32) ? (short)0x3F80 : (short)0; TONE[j] = (short)0x3F80; }
    f32x16 zero16 = f32x16{};
    for (int i = 0; i < NT; ++i) {
        const int t = NT - 1 - i, slot = (i & 1) * SLOTB;
        ATT_WAIT_BAR0();
        if (MODE == 1 && i > 0) {
            const LAS unsigned* fl = flags + ((i - 1) & 1) * 8; unsigned all = 1u;
#pragma unroll
            for (int w = 0; w < 8; ++w) all &= fl[w];
            if (__builtin_amdgcn_readfirstlane(all)) break;
        }
        if (t > 0) DMA_KV(t - 1, slot ^ SLOTB);
        const int jb = t - (NT - 4);
        const bool active = !(jb >= 0 && 2 * jb > wid);
        bool wave_done = false;
        if (MODE == 1) wave_done = __all(R < SB_EXIT);
        if (active && !(MODE == 1 && wave_done)) {
            f32x16 p0, p1;
            qkt(p0, p1, shm + LDS_K + slot, qr, zero16, r32, hi);
            if (MODE == 0) {
                const float* cbt = cb + t * KVBLK + 4 * hi;
#pragma unroll
                for (int g = 0; g < 4; ++g) { const f32x4 c0 = *(const f32x4*)(cbt + 8 * g), c1 = *(const f32x4*)(cbt + 32 + 8 * g);
#pragma unroll
                    for (int e = 0; e < 4; ++e) { p0[4 * g + e] += ct - c0[e]; p1[4 * g + e] += ct - c1[e]; } }
                if (jb >= 0) {
#pragma unroll
                    for (int r = 0; r < 16; ++r) { const int kv = 64 * jb + crow(r, hi); if (kv > qrel) p0[r] = -1.0e30f; if (kv + 32 > qrel) p1[r] = -1.0e30f; } }
                float a = fmaxf(p0[0], p1[0]);
#pragma unroll
                for (int r = 1; r < 16; ++r) a = fmaxf(a, fmaxf(p0[r], p1[r]));
                a = fmaxf(swap_lo(a), swap_hi(a));
                const float m_new = fmaxf(m_run, a), alpha = __builtin_amdgcn_exp2f(m_run - m_new); m_run = m_new;
                float s = 0.f;
#pragma unroll
                for (int r = 0; r < 16; ++r) { p0[r] = __builtin_amdgcn_exp2f(p0[r] - m_new); p1[r] = __builtin_amdgcn_exp2f(p1[r] - m_new); s += p0[r] + p1[r]; }
                l_run = l_run * alpha + s;
                if (hi == 0) wsf[r32] = alpha;
                LDS_WAIT();
#pragma unroll
                for (int r = 0; r < 16; ++r) { const float f = wsf[crow(r, hi)]; o[0][r] *= f; o[1][r] *= f; }
                LDS_WAIT();
            } else {
                if (jb >= 0) {
#pragma unroll
                    for (int r = 0; r < 16; ++r) { const int kv = 64 * jb + crow(r, hi); if (kv >= qrel) p0[r] = -1.0e30f; if (kv + 32 >= qrel) p1[r] = -1.0e30f; } }
                f32x16 l0, l1;
#pragma unroll
                for (int r = 0; r < 16; ++r) {
                    l0[r] = -(fmaxf(p0[r], 0.f) + __builtin_amdgcn_logf(1.0f + __builtin_amdgcn_exp2f(-fabsf(p0[r]))));
                    l1[r] = -(fmaxf(p1[r], 0.f) + __builtin_amdgcn_logf(1.0f + __builtin_amdgcn_exp2f(-fabsf(p1[r])))); }
                u32x4 lw0 = {cvt_pk_bf16(l0[0], l0[1]), cvt_pk_bf16(l0[2], l0[3]), cvt_pk_bf16(l0[4], l0[5]), cvt_pk_bf16(l0[6], l0[7])};
                u32x4 lw1 = {cvt_pk_bf16(l0[8], l0[9]), cvt_pk_bf16(l0[10], l0[11]), cvt_pk_bf16(l0[12], l0[13]), cvt_pk_bf16(l0[14], l0[15])};
                u32x4 lw2 = {cvt_pk_bf16(l1[0], l1[1]), cvt_pk_bf16(l1[2], l1[3]), cvt_pk_bf16(l1[4], l1[5]), cvt_pk_bf16(l1[6], l1[7])};
                u32x4 lw3 = {cvt_pk_bf16(l1[8], l1[9]), cvt_pk_bf16(l1[10], l1[11]), cvt_pk_bf16(l1[12], l1[13]), cvt_pk_bf16(l1[14], l1[15])};
                f32x16 rt;
#pragma unroll
                for (int r = 0; r < 16; ++r) rt[r] = R;
                f32x16 t0 = MFMA32(TD0, __builtin_bit_cast(bf16x8, lw0), rt); t0 = MFMA32(TD1, __builtin_bit_cast(bf16x8, lw1), t0);
                t0 = MFMA32(TONE, __builtin_bit_cast(bf16x8, lw2), t0); t0 = MFMA32(TONE, __builtin_bit_cast(bf16x8, lw3), t0);
                f32x16 t1 = MFMA32(TD0, __builtin_bit_cast(bf16x8, lw2), rt); t1 = MFMA32(TD1, __builtin_bit_cast(bf16x8, lw3), t1);
#pragma unroll
                for (int r = 0; r < 16; ++r) { p0[r] = __builtin_amdgcn_exp2f(p0[r] + t0[r]); p1[r] = __builtin_amdgcn_exp2f(p1[r] + t1[r]); }
                R = swap_lo(t0[0]);
            }
            u32x4 pw0 = {cvt_pk_bf16(p0[0], p0[1]), cvt_pk_bf16(p0[2], p0[3]), cvt_pk_bf16(p0[4], p0[5]), cvt_pk_bf16(p0[6], p0[7])};
            u32x4 pw1 = {cvt_pk_bf16(p0[8], p0[9]), cvt_pk_bf16(p0[10], p0[11]), cvt_pk_bf16(p0[12], p0[13]), cvt_pk_bf16(p0[14], p0[15])};
            u32x4 pw2 = {cvt_pk_bf16(p1[0], p1[1]), cvt_pk_bf16(p1[2], p1[3]), cvt_pk_bf16(p1[4], p1[5]), cvt_pk_bf16(p1[6], p1[7])};
            u32x4 pw3 = {cvt_pk_bf16(p1[8], p1[9]), cvt_pk_bf16(p1[10], p1[11]), cvt_pk_bf16(p1[12], p1[13]), cvt_pk_bf16(p1[14], p1[15])};
            pv(o, vb0 + slot, __builtin_bit_cast(bf16x8, pw0), __builtin_bit_cast(bf16x8, pw1), __builtin_bit_cast(bf16x8, pw2), __builtin_bit_cast(bf16x8, pw3));
        }
        if (MODE == 1) { const bool dn = __all(R < SB_EXIT); if (lane == 0) flags[(i & 1) * 8 + wid] = dn ? 1u : 0u; }
    }
    float linv = 1.f;
    if (MODE == 0) { const float lt = swap_lo(l_run) + swap_hi(l_run); linv = 1.0f / lt; }
    if (hi == 0) wsf[32 + r32] = linv;
    LDS_WAIT();
    bf16_t* Ow = O + (rowbase + q0 + wid * 32) * OPITCH + h * HD;
    { LAS bf16_t* stg = (LAS bf16_t*)(shm + LDS_OST) + wid * 2048;
#pragma unroll
      for (int r = 0; r < 16; ++r) { const int orow = crow(r, hi); const float f = wsf[32 + orow];
#pragma unroll
        for (int d0 = 0; d0 < 2; ++d0) { const unsigned pk = cvt_pk_bf16(o[d0][r] * f, 0.f); stg[orow * 64 + d0 * 32 + r32] = (bf16_t)(pk & 0xffffu); } }
      LDS_WAIT();
#pragma unroll
      for (int i = 0; i < 4; ++i) { const int row = i * 8 + (lane >> 3), ch = lane & 7; const u32x4 v = *(const LAS u32x4*)(stg + row * 64 + ch * 8); *(u32x4*)(Ow + (long)row * OPITCH + ch * 8) = v;
        store_row_ssq(v, hs + (rowbase + q0 + wid * 32 + row) * 16, ch); } }
    asm volatile("s_waitcnt vmcnt(0) lgkmcnt(0)\n\ts_barrier" ::: "memory");
#undef DMA_KV
}
}


namespace fox {
constexpr int QB = 256, KVBLK = 64, PITCH = HW, OPITCH = DM;
constexpr int NSLOT = 3, SLOTB = 9216;
constexpr int LDS_K = 0, LDS_V = NSLOT * SLOTB, LDS_WS = 2 * NSLOT * SLOTB, LDS_OST = LDS_WS + NWAVES * 256, LDS_CL = LDS_OST + NWAVES * 4096, LDS_VOTE = LDS_CL + 512, LDS_END = LDS_VOTE + 32;
static_assert(LDS_END <= RING_BYTES, "fox LDS");
constexpr float WIN_T = 64.0f;
constexpr float FLOOR = -256.0f;
using att::crow; using att::glds16; using att::glds16s;
typedef __attribute__((address_space(3))) const char* lds_cptr;
typedef short v4i16_t __attribute__((ext_vector_type(4)));
#define SBAR() __builtin_amdgcn_sched_barrier(0)
#define WAIT_BAR(N) asm volatile("s_waitcnt vmcnt(" #N ") lgkmcnt(0)\n\ts_barrier" ::: "memory")
__device__ __forceinline__ s16x4 vtr(lds_cptr p) { return __builtin_bit_cast(s16x4, __builtin_amdgcn_ds_read_tr16_b64_v4i16((__attribute__((address_space(3))) v4i16_t*)p)); }
__device__ __forceinline__ void kload2(bf16x8* kf, lds_cptr kp, int j) { kf[2 * j] = *(const LAS bf16x8*)(kp + j * 2048); kf[2 * j + 1] = *(const LAS bf16x8*)(kp + j * 2048 + 512); }
__device__ __forceinline__ void cmask(f32x16& p0, f32x16& p1, int jb, int qrel, int hi) {
    const float NEG = -INFINITY; const int kb = 64 * jb + 4 * hi;
#pragma unroll
    for (int r = 0; r < 16; ++r) { const int kv = kb + (r & 3) + 8 * (r >> 2); if (kv > qrel) p0[r] = NEG; if (kv + 32 > qrel) p1[r] = NEG; }
}
__device__ __forceinline__ void split3(float x, unsigned& hm, unsigned& lo) {
    const unsigned h = cvt_pk_bf16(x, 0.f) & 0xffffu; const float r1 = x - __uint_as_float(h << 16);
    const unsigned m = cvt_pk_bf16(r1, 0.f) & 0xffffu; const float r2 = r1 - __uint_as_float(m << 16);
    hm = h | (m << 16); lo = cvt_pk_bf16(r2, 0.f) & 0xffffu;
}
__device__ __forceinline__ bf16x8 qx_build(float a, int hi) {
    unsigned hm, lo; split3(a, hm, lo);
    u32x4 w; w.x = hm; w.y = lo | 0x3F800000u; w.z = 0x3F803F80u; w.w = 0u;
    if (hi) { w.x = 0u; w.y = 0u; w.z = 0u; }
    return __builtin_bit_cast(bf16x8, w);
}

template <int THRL> __device__ __forceinline__ void fox_unit(int bh, int qb, const bf16_t* Q, const bf16_t* K, const bf16_t* V, bf16_t* O, float* hs, const float* cb, const bf16_t* KXh, float kmax, LAS char* shm) {
    int tid = threadIdx.x; asm volatile("" : "+v"(tid)); const int lane = tid & 63, r32 = lane & 31, hi = lane >> 5; const int wid = __builtin_amdgcn_readfirstlane(tid >> 6);
    const int b = bh >> 3, h = bh & 7; const long rowbase = (long)b * SEQ; const int q0 = qb * QB;
    const bf16_t* Qw = Q + (rowbase + q0 + wid * 32) * PITCH + h * HD;
    const bf16_t* Kh = K + rowbase * PITCH + h * HD; const bf16_t* Vh = V + rowbase * PITCH + h * HD;
    const unsigned lds0 = (unsigned)(uintptr_t)shm;
    LAS float* wsf = (LAS float*)(shm + LDS_WS) + wid * 64;
    const int NT = (q0 + QB) / KVBLK;
    int NTe = NT;
    LAS float* clt = (LAS float*)(shm + LDS_CL); LAS unsigned* votes = (LAS unsigned*)(shm + LDS_VOTE);
    const float clv = (tid < NT) ? cb[64 * tid + 63] : 0.f;
    const unsigned koff = (unsigned)(lane * PITCH + wid * 8) * 2u, voff = (unsigned)((16 * (wid & 3) + (lane >> 2)) * PITCH + (wid >> 2) * 32 + (lane & 3) * 8) * 2u, xoff = (unsigned)lane * 16u;
    const unsigned kdst = lds0 + LDS_K + wid * 1024, vdst = lds0 + LDS_V + wid * 1024, xdst = lds0 + LDS_K + 8192;
    const bool xl = (lane >> 3) == wid;
#define DMA_K(p, slot) do { glds16s(Kh + (long)(NT - 1 - (p)) * KVBLK * PITCH, koff, (unsigned)__builtin_amdgcn_readfirstlane(kdst + (slot))); \
        if (xl) glds16s(KXh + (long)(NT - 1 - (p)) * KVBLK * 8, xoff, (unsigned)__builtin_amdgcn_readfirstlane(xdst + (slot))); } while (0)
#define DMA_V(p, slot) glds16s(Vh + (long)(NT - 1 - (p)) * KVBLK * PITCH, voff, (unsigned)__builtin_amdgcn_readfirstlane(vdst + (slot)))
    bf16x8 kf[10];
    const lds_cptr shm3 = (lds_cptr)shm; const lds_cptr kp0 = shm3 + LDS_K + hi * 1024 + r32 * 16; const lds_cptr kx0 = shm3 + LDS_K + 8192 + r32 * 16;
    const lds_cptr vp0 = shm3 + LDS_V + ((lane >> 4) & 1) * 32 + (lane & 3) * 8 + (4 * hi + ((lane & 15) >> 2)) * 64;
    DMA_K(0, 0); DMA_V(0, 0); DMA_K(1, SLOTB);
    bf16x8 qr[4];
#pragma unroll
    for (int d0 = 0; d0 < 4; ++d0) qr[d0] = *(const bf16x8*)(Qw + (long)r32 * PITCH + d0 * 16 + hi * 8);
    const int qrel = wid * 32 + r32;
    const float ct = cb[q0 + qrel];
    float mhat = 0.f, l_reg = 0.f; f32x16 o[2]; o[0] = f32x16{}; o[1] = f32x16{};
    bf16x8 qx = qx_build(ct, hi);
    const f32x16 z16 = f32x16{};
#define CMASK(P0, P1, p) do { const int jb_ = 3 - (p); if (jb_ >= 0) cmask(P0, P1, jb_, qrel, hi); } while (0)
    bool resc = false;
#define RESC() do { if (resc) { asm volatile("s_waitcnt lgkmcnt(0)" ::: "memory"); \
      _Pragma("unroll") for (int d_ = 0; d_ < 2; ++d_) _Pragma("unroll") for (int r = 0; r < 16; ++r) o[d_][r] *= wsf[crow(r, hi)]; } } while (0)
    f32x16 pA0, pA1, pB0, pB1;
    int sl_prev = 0, sl_cur = 0, sl_next = SLOTB;
#define ROT() do { sl_prev = sl_cur; sl_cur = sl_next; sl_next = (sl_next == (NSLOT - 1) * SLOTB) ? 0 : sl_next + SLOTB; } while (0)
    DMA_K(2, 2 * SLOTB);
    WAIT_BAR(5);
    if (tid < NT) clt[tid] = clv;
    float qkb;
    { float q2 = 0.f;
#pragma unroll
      for (int d0 = 0; d0 < 4; ++d0)
#pragma unroll
          for (int j = 0; j < 8; ++j) { const float e = __uint_as_float(((unsigned)(unsigned short)qr[d0][j]) << 16); q2 += e * e; }
      q2 = att::swap_lo(q2) + att::swap_hi(q2); qkb = sqrtf(q2) * kmax + ct + WIN_T; }
    { const LAS char* kb = (const LAS char*)shm + LDS_K + hi * 1024 + r32 * 16; const LAS char* kxb = (const LAS char*)shm + LDS_K + 8192 + r32 * 16;
      pA0 = MFMA32(*(const LAS bf16x8*)(kxb), qx, z16); pA1 = MFMA32(*(const LAS bf16x8*)(kxb + 512), qx, z16);
#pragma unroll
      for (int d0 = 0; d0 < 4; ++d0) { pA0 = MFMA32(*(const LAS bf16x8*)(kb + d0 * 2048), qr[d0], pA0); pA1 = MFMA32(*(const LAS bf16x8*)(kb + d0 * 2048 + 512), qr[d0], pA1); } }
    asm volatile("s_nop 15\n\ts_nop 7" : "+v"(pA0), "+v"(pA1)); CMASK(pA0, pA1, 0);
    { float a = fmaxf(pA0[0], pA1[0]);
#pragma unroll
      for (int r = 1; r < 16; ++r) a = fmaxf(a, fmaxf(pA0[r], pA1[r]));
      a = fmaxf(att::swap_lo(a), att::swap_hi(a));
      const float dl = fmaxf(a, FLOOR); mhat = dl;
#pragma unroll
      for (int r = 0; r < 16; ++r) { pA0[r] = __builtin_amdgcn_exp2f(pA0[r] - dl); pA1[r] = __builtin_amdgcn_exp2f(pA1[r] - dl); }
      qx = qx_build(ct - mhat, hi); asm volatile("" : "+v"(qx)); }
    WAIT_BAR(0);
    DMA_K(3, 0); DMA_V(1, SLOTB);
    ROT();
    kload2(kf, kp0 + sl_cur, 0); kload2(kf, kp0 + sl_cur, 1); kload2(kf, kp0 + sl_cur, 2); kload2(kf, kp0 + sl_cur, 3);
    kf[8] = *(const LAS bf16x8*)(kx0 + sl_cur); kf[9] = *(const LAS bf16x8*)(kx0 + sl_cur + 512);
    WAIT_BAR(3);
    s16x4 vlo[8], vhi[8]; u32x4 pw0, pw1, pw2, pw3;
#define PKW(P, B) cvt_pk_bf16(P[B], P[B + 1])
#define PAF(k) __builtin_bit_cast(bf16x8, pw##k)
#define VFR(i) (bf16x8){vlo[i][0], vlo[i][1], vlo[i][2], vlo[i][3], vhi[i][0], vhi[i][1], vhi[i][2], vhi[i][3]}
#define PIN(x) asm volatile("" : "+v"(x))
#define MX3(a, b, c) __builtin_fmaxf(__builtin_fmaxf((a), (b)), (c))
#define GAPA(MF, A0, A1, A2, A3, W0, W1, PW) do { MF; sacc += A0; sacc += A1; sacc += A2; sacc += A3; PIN(sacc); W0; W1; PIN(PW); SBAR(); } while (0)
#define EX(v) __builtin_amdgcn_exp2f(v)
#define GAPB(MF, X, B) do { MF; X[B] = EX(X[B]); X[B + 1] = EX(X[B + 1]); X[B + 2] = EX(X[B + 2]); X[B + 3] = EX(X[B + 3]); PIN(X); SBAR(); } while (0)
#define VRD(i) do { vlo[i] = vtr(vp_ + (((i) >> 2) * 4096 + ((i) & 3) * 1024)); vhi[i] = vtr(vp_ + (((i) >> 2) * 4096 + ((i) & 3) * 1024 + 512)); } while (0)
#define KRD(G, j) do { if (G) { kload2(kf, kp0 + sl_next, j); SBAR(); } } while (0)
#define KRDX(G) do { if (G) { kf[8] = *(const LAS bf16x8*)(kx0 + sl_next); kf[9] = *(const LAS bf16x8*)(kx0 + sl_next + 512); SBAR(); } } while (0)
#define STEP(C0, C1, P0, P1, t, GK, GV, GL) do { SBAR(); \
    const lds_cptr vp_ = vp0 + sl_prev; \
    C0 = MFMA32(kf[8], qx, z16); C1 = MFMA32(kf[9], qx, z16); SBAR(); \
    VRD(0); SBAR(); float sacc = (P0[0] + P0[1]); \
    GAPA(C0 = MFMA32(kf[0], qr[0], C0), P0[2], P0[3], P0[4], P0[5],     pw0[0] = PKW(P0, 0), pw0[1] = PKW(P0, 2), pw0); \
    VRD(4); SBAR(); GAPA(C1 = MFMA32(kf[1], qr[0], C1), P0[6], P0[7], P0[8], P0[9],     pw0[2] = PKW(P0, 4), pw0[3] = PKW(P0, 6), pw0); \
    VRD(1); SBAR(); GAPA(C0 = MFMA32(kf[2], qr[1], C0),   P0[10], P0[11], P0[12], P0[13], pw1[0] = PKW(P0, 8), pw1[1] = PKW(P0, 10), pw1); \
    VRD(5); SBAR(); GAPA(C1 = MFMA32(kf[3], qr[1], C1),   P0[14], P0[15], P1[0], P1[1],   pw1[2] = PKW(P0, 12), pw1[3] = PKW(P0, 14), pw1); \
    VRD(2); SBAR(); GAPA(C0 = MFMA32(kf[4], qr[2], C0),   P1[2], P1[3], P1[4], P1[5],     pw2[0] = PKW(P1, 0), pw2[1] = PKW(P1, 2), pw2); \
    VRD(6); SBAR(); GAPA(C1 = MFMA32(kf[5], qr[2], C1),   P1[6], P1[7], P1[8], P1[9],     pw2[2] = PKW(P1, 4), pw2[3] = PKW(P1, 6), pw2); \
    VRD(3); SBAR(); GAPA(C0 = MFMA32(kf[6], qr[3], C0),   P1[10], P1[11], P1[12], P1[13], pw3[0] = PKW(P1, 8), pw3[1] = PKW(P1, 10), pw3); \
    VRD(7); SBAR(); GAPA(C1 = MFMA32(kf[7], qr[3], C1),   P1[14], P1[15], 0.f, 0.f,       pw3[2] = PKW(P1, 12), pw3[3] = PKW(P1, 14), pw3); \
    l_reg += sacc; \
    if (GK) { DMA_K((t) + 3, sl_cur); } if (GV) { DMA_V((t) + 1, sl_next); } \
    CMASK(C0, C1, t); \
    { float a = MX3(C0[0], C0[1], C1[0]), b_ = MX3(C0[2], C0[3], C1[1]); a = MX3(a, C1[2], C1[3]); \
      _Pragma("unroll") for (int r = 4; r < 16; r += 4) { a = MX3(a, C0[r], C0[r + 1]); b_ = MX3(b_, C0[r + 2], C0[r + 3]); a = MX3(a, C1[r], C1[r + 1]); b_ = MX3(b_, C1[r + 2], C1[r + 3]); } \
      float rm = __builtin_fmaxf(a, b_); { auto rr = __builtin_amdgcn_permlane32_swap(__float_as_uint(rm), __float_as_uint(rm), false, false); rm = __builtin_fmaxf(__uint_as_float(rr[0]), __uint_as_float(rr[1])); } \
      resc = false; \
      if (__builtin_expect(__any(rm > (float)THRL), 0)) { const float dl = __builtin_fmaxf(rm, 0.f); mhat += dl; \
        _Pragma("unroll") for (int r = 0; r < 16; ++r) { C0[r] -= dl; C1[r] -= dl; } \
        qx = qx_build(ct - mhat, hi); asm volatile("" : "+v"(qx)); \
        const float f = __builtin_amdgcn_exp2f(-dl); l_reg *= f; if (hi == 0) wsf[r32] = f; resc = true; } } \
    SBAR(); \
    GAPB(o[0] = MFMA32(PAF(0), VFR(0), o[0]), C0, 0); \
    KRDX(GL); GAPB(o[1] = MFMA32(PAF(0), VFR(4), o[1]), C0, 4); \
    KRD(GL, 0); GAPB(o[0] = MFMA32(PAF(1), VFR(1), o[0]), C0, 8); \
    KRD(GL, 1); GAPB(o[1] = MFMA32(PAF(1), VFR(5), o[1]), C0, 12); \
    KRD(GL, 2); GAPB(o[0] = MFMA32(PAF(2), VFR(2), o[0]), C1, 0); \
    KRD(GL, 3); GAPB(o[1] = MFMA32(PAF(2), VFR(6), o[1]), C1, 4); \
    GAPB(o[0] = MFMA32(PAF(3), VFR(3), o[0]), C1, 8); \
    GAPB(o[1] = MFMA32(PAF(3), VFR(7), o[1]), C1, 12); \
    } while (0)
#define ENDW(tt) do { if ((tt) + 3 < NTe) { WAIT_BAR(3); } else if ((tt) + 2 < NTe) { WAIT_BAR(1); } else { WAIT_BAR(0); } } while (0)
#define VOTE(t) do { const int ts_ = NT - (t) - 6; bool ok_ = false; if (ts_ >= 0) { ok_ = __all((qkb - mhat) < clt[ts_]); } if (lane == 0) votes[wid] = ok_ ? 1u : 0u; } while (0)
#define TALLY(t) do { const u32x4 va_ = *(const LAS u32x4*)votes, vb_ = *(const LAS u32x4*)(votes + 4); \
        if (__builtin_amdgcn_readfirstlane((va_.x & va_.y & va_.z & va_.w & vb_.x & vb_.y & vb_.z & vb_.w) != 0u)) { if ((t) + 5 < NTe) NTe = (t) + 5; } } while (0)
    int t = 1;
    for (; t + 1 < NTe && t < 5; t += 2) {
        STEP(pB0, pB1, pA0, pA1, t, (t + 3 < NTe), (t + 1 < NTe), (t + 1 < NTe));       VOTE(t); ENDW(t);     TALLY(t); RESC(); ROT();
        STEP(pA0, pA1, pB0, pB1, t + 1, (t + 4 < NTe), (t + 2 < NTe), (t + 2 < NTe));   ENDW(t + 1); RESC(); ROT();
    }
#undef CMASK
#define CMASK(P0, P1, p) do {} while (0)
    for (; t + 5 < NTe; t += 2) {
        STEP(pB0, pB1, pA0, pA1, t, true, true, true);       VOTE(t); WAIT_BAR(3); TALLY(t); RESC(); ROT();
        STEP(pA0, pA1, pB0, pB1, t + 1, (t + 4 < NTe), true, true);   ENDW(t + 1); RESC(); ROT();
    }
    for (; t + 1 < NTe; t += 2) {
        STEP(pB0, pB1, pA0, pA1, t, (t + 3 < NTe), (t + 1 < NTe), (t + 1 < NTe));       ENDW(t);     RESC(); ROT();
        STEP(pA0, pA1, pB0, pB1, t + 1, (t + 4 < NTe), (t + 2 < NTe), (t + 2 < NTe));   ENDW(t + 1); RESC(); ROT();
    }
#undef CMASK
#define CMASK(P0, P1, p) do { const int jb_ = 3 - (p); if (jb_ >= 0) cmask(P0, P1, jb_, qrel, hi); } while (0)
    STEP(pB0, pB1, pA0, pA1, NTe - 1, false, false, false); RESC();
    { float sacc = pB0[0] + pB0[1];
#pragma unroll
      for (int r = 2; r < 16; ++r) sacc += pB0[r];
#pragma unroll
      for (int r = 0; r < 16; ++r) sacc += pB1[r];
      l_reg += sacc;
      pw0 = (u32x4){PKW(pB0, 0), PKW(pB0, 2), PKW(pB0, 4), PKW(pB0, 6)}; pw1 = (u32x4){PKW(pB0, 8), PKW(pB0, 10), PKW(pB0, 12), PKW(pB0, 14)};
      pw2 = (u32x4){PKW(pB1, 0), PKW(pB1, 2), PKW(pB1, 4), PKW(pB1, 6)}; pw3 = (u32x4){PKW(pB1, 8), PKW(pB1, 10), PKW(pB1, 12), PKW(pB1, 14)};
      SBAR(); att::pv(o, (int)(unsigned)(uintptr_t)(vp0 + sl_cur), PAF(0), PAF(1), PAF(2), PAF(3)); }
    l_reg = att::swap_lo(l_reg) + att::swap_hi(l_reg);
    if (hi == 0) wsf[32 + r32] = l_reg; asm volatile("s_waitcnt lgkmcnt(0)" ::: "memory");
    float rli[16];
#pragma unroll
    for (int r = 0; r < 16; ++r) rli[r] = __builtin_amdgcn_rcpf(wsf[32 + crow(r, hi)]);
    bf16_t* Ow = O + (rowbase + q0 + wid * 32) * OPITCH + h * HD;
    { LAS bf16_t* stg = (LAS bf16_t*)(shm + LDS_OST) + wid * 2048;
#pragma unroll
      for (int r = 0; r < 16; ++r) { const int orow = crow(r, hi);
#pragma unroll
        for (int d0 = 0; d0 < 2; ++d0) stg[orow * 64 + d0 * 32 + r32] = (bf16_t)(cvt_pk_bf16(o[d0][r] * rli[r], 0.f) & 0xffffu); }
      asm volatile("s_waitcnt lgkmcnt(0)" ::: "memory");
#pragma unroll
      for (int i = 0; i < 4; ++i) { const int row = i * 8 + (lane >> 3), ch = lane & 7; const u32x4 v = *(const LAS u32x4*)(stg + row * 64 + ch * 8); *(u32x4*)(Ow + (long)row * OPITCH + ch * 8) = v;
        att::store_row_ssq(v, hs + (rowbase + q0 + wid * 32 + row) * 16, ch); } }
    asm volatile("s_waitcnt lgkmcnt(0)\n\ts_barrier" ::: "memory");
#undef DMA_K
#undef DMA_V
#undef CMASK
#undef RESC
#undef ROT
#undef PKW
#undef PAF
#undef VFR
#undef PIN
#undef MX3
#undef GAPA
#undef GAPB
#undef EX
#undef VRD
#undef KRD
#undef KRDX
#undef STEP
#undef ENDW
#undef VOTE
#undef TALLY
}
#undef SBAR
#undef WAIT_BAR
}

#define XB_TMO      128
#define XB_XCNT(j)  (256  + 64 * (j))
#define XB_XSUB(j)  (1280 + 64 * (j))
#define XB_XGEN(j)  (2304 + 64 * (j))
#define XB_TOP      3328
#define XB_TOPGEN   3392
#define XCD_BAR_WORDS 3456
#define XB_SPIN_CAP (1u << 18)
__device__ __forceinline__ unsigned xb_ld(unsigned* p)              { return __hip_atomic_load(p, __ATOMIC_RELAXED, __HIP_MEMORY_SCOPE_AGENT); }
__device__ __forceinline__ unsigned xb_add(unsigned* p, unsigned v) { return __hip_atomic_fetch_add(p, v, __ATOMIC_RELAXED, __HIP_MEMORY_SCOPE_AGENT); }
__device__ __forceinline__ unsigned xb_xcc_id() { return (unsigned)__builtin_amdgcn_s_getreg((3 << 11) | 20) & 0xFu; }
#define XB_SPIN(cond, bar) do { unsigned _sp = 0; while (cond) { __builtin_amdgcn_s_sleep(1); \
    if ((++_sp & 255u) == 0u) { if (xb_ld(&(bar)[XB_TMO])) break; if (_sp > XB_SPIN_CAP) { atomicAdd(&(bar)[XB_TMO], 1u); break; } } } } while (0)
struct XcdBarrier { unsigned* bar; unsigned x; volatile LAS unsigned* st; };
__device__ __forceinline__ XcdBarrier xcd_barrier_post(unsigned* bar, volatile LAS unsigned* st) {
    XcdBarrier b; b.bar = bar; b.x = xb_xcc_id(); b.st = st;
    if (threadIdx.x == 0) (void)xb_add(&bar[XB_XCNT(b.x)], 1u);
    return b;
}
__device__ __forceinline__ void xcd_barrier_complete(unsigned* bar, unsigned x, unsigned& nloc, unsigned& nx) {
    const unsigned G = gridDim.x * gridDim.y * gridDim.z;
    unsigned sum, cnt, mine, sp = 0u;
    for (;;) {
        sum = 0u; cnt = 0u; mine = 0u;
#pragma unroll
        for (unsigned j = 0; j < 16; ++j) { const unsigned c = xb_ld(&bar[XB_XCNT(j)]); sum += c; cnt += (c > 0u) ? 1u : 0u; mine = (j == x) ? c : mine; }
        if (sum == G) break;
        __builtin_amdgcn_s_sleep(1);
        if ((++sp & 255u) == 0u) { if (xb_ld(&bar[XB_TMO])) break; if (sp > XB_SPIN_CAP) { atomicAdd(&bar[XB_TMO], 1u); break; } }
    }
    nloc = mine > 0u ? mine : 1u; nx = cnt > 0u ? cnt : 1u;
}
__device__ __forceinline__ void xcd_barrier(const XcdBarrier& b) {
    asm volatile("s_waitcnt vmcnt(0)" ::: "memory");
    __syncthreads();
    if (threadIdx.x == 0) {
        unsigned* bar = b.bar;
        __builtin_amdgcn_s_waitcnt(0);
        unsigned nloc = b.st[0], nx = b.st[1];
        if (nloc == 0u) { xcd_barrier_complete(bar, b.x, nloc, nx); b.st[0] = nloc; b.st[1] = nx; }
        const unsigned old = xb_add(&bar[XB_XSUB(b.x)], 1u);
        const unsigned gen = old / nloc;
        if (old + 1u == (gen + 1u) * nloc) {
            __builtin_amdgcn_fence(__ATOMIC_RELEASE, "agent");
            asm volatile("s_waitcnt vmcnt(0)" ::: "memory");
            const unsigned og = xb_add(&bar[XB_TOP], 1u);
            const unsigned tg = og / nx;
            if (og + 1u == (tg + 1u) * nx) xb_add(&bar[XB_TOPGEN], 1u);
            else XB_SPIN(xb_ld(&bar[XB_TOPGEN]) == tg, bar);
            __builtin_amdgcn_fence(__ATOMIC_ACQUIRE, "agent");
            xb_add(&bar[XB_XGEN(b.x)], 1u);
            asm volatile("s_waitcnt vmcnt(0)" ::: "memory");
        } else {
            XB_SPIN(xb_ld(&bar[XB_XGEN(b.x)]) == gen, bar);
            __builtin_amdgcn_fence(__ATOMIC_ACQUIRE, "agent");
            asm volatile("s_waitcnt vmcnt(0)" ::: "memory");
        }
    }
    __syncthreads();
}

__device__ __forceinline__ const void* ldp(const volatile LAS unsigned* tab, int i) {
    const unsigned lo = __builtin_amdgcn_readfirstlane(tab[2 * i]), hi = __builtin_amdgcn_readfirstlane(tab[2 * i + 1]);
    return (const void*)(((unsigned long long)hi << 32) | lo);
}
struct Args {
    const float* x; const float* mem; const float* norm_mix; const float* w_in; const float* b_forget; const float* norm_fox; const float* norm_sb; const float* w_out;
    const float* norm_xattn; const float* norm_mem; const float* w_xq; const float* w_xkv; const float* w_xo; const float* norm_ffn;
    const float* w_rg; const float* b_rg; const float* w_re; const float* b_re; const float* w_gate; const float* w_up; const float* w_down; const float* norm_final;
    float* out; unsigned char* ws;
};

__device__ __forceinline__ void transpose_item(const float* W, int ldw, bf16_t* WT, int ldo, int k0, int n0, int dst_row0, const float* gain, LAS float* scr, int lane) {
#pragma unroll 8
    for (int i = 0; i < 32; ++i) { const int kk = 2 * i + (lane >> 5); float v = W[(size_t)(k0 + kk) * ldw + n0 + (lane & 31)]; if (gain) v *= gain[k0 + kk]; scr[kk * 33 + (lane & 31)] = v; }
    LDS_WAIT(); asm volatile("" ::: "memory");
    const int c = lane & 7;
#pragma unroll
    for (int j = 0; j < 4; ++j) { const int n = (lane >> 3) + 8 * j; const LAS float* s = scr + (8 * c) * 33 + n;
        u32x4 o; o.x = cvt_pk_bf16(s[0 * 33], s[1 * 33]); o.y = cvt_pk_bf16(s[2 * 33], s[3 * 33]); o.z = cvt_pk_bf16(s[4 * 33], s[5 * 33]); o.w = cvt_pk_bf16(s[6 * 33], s[7 * 33]);
        *(u32x4*)(WT + (size_t)(dst_row0 + n) * ldo + k0 + 8 * c) = o; }
    LDS_WAIT(); asm volatile("" ::: "memory");
}

struct SchedDense {
    const char* A; const char* Bt; int nM, nN, G, c; size_t a_tile, b_tile, b_batch; int split_tiles;
    __device__ __forceinline__ bool next(int i, pg8::Unit& u) const {
        int pm, pn; if (!pg8::tile_order(i, G, c, nM, nN, pm, pn)) return false;
        u.a = A + (size_t)pm * a_tile; u.b = Bt + (size_t)pn * b_tile + (size_t)(pm >> 5) * b_batch; u.orow = pm * 256;
        if (split_tiles) { u.aux = pn / split_tiles; u.ocol = (pn % split_tiles) * 256; } else { u.aux = 1; u.ocol = pn * 256; }
        u.rows = nullptr; u.nvalid = 256; return true;
    }
};
struct SchedGH {
    const char* KVm; const char* Wxq; const char* Wxo; int G, c;
    __device__ __forceinline__ bool next(int i, pg8::Unit& u) const {
        const int L = i * G + c; if (L >= 256) return false;
        const int kind = L >> 7, r = L & 127, bh = r >> 2, j = r & 3, b = bh >> 2, h = bh & 3;
        if (kind == 0) { u.a = KVm + ((size_t)(b * 256) * 2048 + h * 256) * 2; u.b = Wxq + ((size_t)(256 * j) * 1024 + h * 256) * 2; u.orow = b * 1024 + h * 256; u.ocol = 256 * j; u.aux = 1; }
        else { u.a = Wxo + ((size_t)(256 * j) * 1024 + h * 256) * 2; u.b = KVm + ((size_t)(b * 256) * 2048 + 1024 + h * 256) * 2; u.orow = b * 1024 + 256 * j; u.ocol = h * 256; u.aux = 2; }
        u.rows = nullptr; u.nvalid = 256; return true;
    }
};
template <int KIND> struct SchedGHk { SchedGH s; __device__ __forceinline__ bool next(int i, pg8::Unit& u) const { const int L = i * s.G + s.c; if (L >= 128) return false; SchedGH t = s; t.G = 1; t.c = 0; return t.next(128 * KIND + L, u); } };
struct EpiGH { static constexpr bool HAS_MID = false; bf16_t* GTp; bf16_t* HTp; __device__ __forceinline__ void operator()(const f32x4 (&acc)[2][2][4][2], const pg8::Unit& u, int wr, int wc, int fr, int fq) const {
    pg8::EpiBf16 e{u.aux == 1 ? GTp : HTp, DM, nullptr, 0, 1.f, 1.f, nullptr}; pg8::Unit v = u; v.aux = 1; e(acc, v, wr, wc, fr, fq); } };
struct SchedMoe {
    const char* A; const char* W; const int* list; const LAS int* tbl; int G, c, NPN; size_t w_exp, w_tile, a_tile; int ocol_w;
    __device__ __forceinline__ bool next(int i, pg8::Unit& u) const {
        const int L = i * G + c; const int tl = L / NPN, pn = L % NPN;
        if (tl >= __builtin_amdgcn_readfirstlane(tbl[16])) return false;
        int e = 0;
#pragma unroll 1
        for (int x = 1; x < NEXP; ++x) { if (tl >= __builtin_amdgcn_readfirstlane(tbl[x])) e = x; }
        const int j = tl - __builtin_amdgcn_readfirstlane(tbl[e]), n = __builtin_amdgcn_readfirstlane(tbl[32 + e]) - 256 * j;
        u.a = A + (size_t)tl * a_tile; u.b = W + (size_t)e * w_exp + (size_t)pn * w_tile; u.orow = tl * 256; u.ocol = pn * ocol_w; u.aux = 1;
        u.rows = list + (size_t)e * M + 256 * j; u.nvalid = n < 256 ? n : 256; return true;
    }
};
__device__ __forceinline__ void moe_table(LAS int* tbl, const unsigned* ctl) {
    if (threadIdx.x == 0) { int base = 0; for (int e = 0; e < NEXP; ++e) { const int n = (int)ctl[CW_CNT + 64 * e]; tbl[e] = base; tbl[32 + e] = n; base += (n + 255) >> 8; } tbl[16] = base; }
    __syncthreads();
}

__global__ void __launch_bounds__(NWAVES * 64, 2) hymba_fwd(Args args) {
    extern __shared__ __attribute__((aligned(16))) unsigned char lds_raw[];
    LAS unsigned char* lds = (LAS unsigned char*)lds_raw;
    volatile LAS unsigned* MISC = (volatile LAS unsigned*)(lds + MISC_OFF);
    const int tid0 = threadIdx.x; const int wave = __builtin_amdgcn_readfirstlane(tid0 >> 6);
    const int G = gridDim.x; const int bx = blockIdx.x; const int vcu = (G % 8 == 0) ? (bx % 8) * (G / 8) + bx / 8 : bx;
    volatile LAS unsigned* ATAB = (volatile LAS unsigned*)(lds + MISC_OFF + 512);
    for (int u = tid0; u < 256; u += NWAVES * 64) ((LAS unsigned*)(lds + MISC_OFF))[u] = 0u;
    __syncthreads();
    if (tid0 == 0) { const float* const* ap = (const float* const*)&args;
#pragma unroll
        for (int i = 0; i < 24; ++i) { const unsigned long long v = (unsigned long long)ap[i]; ATAB[2 * i] = (unsigned)v; ATAB[2 * i + 1] = (unsigned)(v >> 32); } }
    __syncthreads();
#define ARGP(name) ((const float*)ldp(ATAB, (int)(offsetof(Args, name) / 8)))
#define PHASE_PTRS \
    int tid = threadIdx.x; asm volatile("" : "+v"(tid)); const int lane = tid & 63; (void)lane; \
    unsigned char* const ws = (unsigned char*)ldp(ATAB, 23); float* const out = (float*)ldp(ATAB, 22); unsigned* const ctl = (unsigned*)(ws + WS_CTL); (void)out; (void)ctl; \
    bf16_t* const Win_t = (bf16_t*)(ws + WS_WIN); bf16_t* const Wout_t = (bf16_t*)(ws + WS_WOUT); bf16_t* const Wxq_n = (bf16_t*)(ws + WS_WXQ); bf16_t* const Wxkv_t = (bf16_t*)(ws + WS_WXKV); \
    bf16_t* const Wxo_t = (bf16_t*)(ws + WS_WXO); bf16_t* const Wgu_t = (bf16_t*)(ws + WS_WGU); bf16_t* const Wd_t = (bf16_t*)(ws + WS_WD); \
    float* const RX = (float*)(ws + WS_RX); float* const RMEM = (float*)(ws + WS_RMEM); float* const LF = (float*)(ws + WS_LF); float* const CC = (float*)(ws + WS_C2); float* const SSQ = (float*)(ws + WS_SSQ); \
    int* const TOKSLOT = (int*)(ws + WS_TOKSLOT); float* const TOKW = (float*)(ws + WS_TOKW); int* const LIST = (int*)(ws + WS_LIST); \
    bf16_t* const MEMB = (bf16_t*)(ws + WS_MEMB); bf16_t* const KVM = (bf16_t*)(ws + WS_KVM); bf16_t* const GT = (bf16_t*)(ws + WS_GT); bf16_t* const HT = (bf16_t*)(ws + WS_HT); \
    bf16_t* const XB = (bf16_t*)(ws + WS_XB); bf16_t* const QKV = (bf16_t*)(ws + WS_QKV); bf16_t* const H1B = (bf16_t*)(ws + WS_H1B); bf16_t* const U2B = (bf16_t*)(ws + WS_U2B); bf16_t* const HID = (bf16_t*)(ws + WS_HID); \
    bf16_t* const OAB = (bf16_t*)(ws + WS_O); bf16_t* const YB = (bf16_t*)(ws + WS_Y); bf16_t* const KX = (bf16_t*)(ws + WS_KX); (void)KX; float* const HS = (float*)(ws + WS_HS); (void)HS; \
    (void)Win_t; (void)Wout_t; (void)Wxq_n; (void)Wxkv_t; (void)Wxo_t; (void)Wgu_t; (void)Wd_t; (void)RX; (void)RMEM; (void)LF; (void)CC; (void)SSQ; (void)TOKSLOT; (void)TOKW; (void)LIST; \
    (void)MEMB; (void)KVM; (void)GT; (void)HT; (void)XB; (void)QKV; (void)H1B; (void)U2B; (void)HID; (void)OAB; (void)YB;
    XcdBarrier bar;
    { unsigned char* const ws0 = (unsigned char*)ldp(ATAB, 23); bar = xcd_barrier_post((unsigned*)(ws0 + WS_CTL) + CW_BAR, MISC + 8); }
    const int gw = vcu * NWAVES + wave, NGW = G * NWAVES;


    if (PH(0))
    for (int rep_ = 0; rep_ < REPS(0); ++rep_)
    {
        PHASE_PTRS
        LAS float* wfT = (LAS float*)(lds + RING_OFF);
        LAS float* scr = (LAS float*)(lds + RING_OFF + 32768 + wave * 8448);
        for (int idx = tid; idx < 8 * DM; idx += NWAVES * 64) { const int j = idx >> 10, k = idx & 1023; wfT[idx] = ARGP(w_in)[(size_t)k * WIN_LD + NPROJ + j] * ARGP(norm_mix)[k]; }
        constexpr int I_IN = 16 * 96, I_OUT = 16 * 32, I_XKV = 16 * 64, I_XO = 16 * 32, I_G = 16 * 16 * 8, I_U = I_G, I_D = 16 * 4 * 32, I_XQ = 1024;
        constexpr int NITEMS = I_IN + I_OUT + I_XKV + I_XO + I_G + I_U + I_D + I_XQ;
        for (int it = gw; it < NITEMS; it += NGW) {
            int r = it;
            if (r < I_IN) { const int kb = r / 96, nb = r % 96; transpose_item(ARGP(w_in), WIN_LD, Win_t, DM, 64 * kb, 32 * nb, 32 * nb, ARGP(norm_mix), scr, lane); continue; } r -= I_IN;
            if (r < I_OUT) { const int kb = r / 32, nb = r % 32; const float* gn = (64 * kb < HW) ? ARGP(norm_fox) : (ARGP(norm_sb) - HW); transpose_item(ARGP(w_out), DM, Wout_t, DM, 64 * kb, 32 * nb, 32 * nb, gn, scr, lane); continue; } r -= I_OUT;
            if (r < I_XKV) { const int kb = r / 64, nb = r % 64; transpose_item(ARGP(w_xkv), 2 * DM, Wxkv_t, DM, 64 * kb, 32 * nb, 32 * nb, ARGP(norm_mem), scr, lane); continue; } r -= I_XKV;
            if (r < I_XO) { const int kb = r / 32, nb = r % 32; transpose_item(ARGP(w_xo), DM, Wxo_t, DM, 64 * kb, 32 * nb, 32 * nb, nullptr, scr, lane); continue; } r -= I_XO;
            if (r < I_G + I_U) { const int up = r >= I_G; const int q = up ? r - I_G : r; const int e = q / 128, kb = (q % 128) / 8, nb = q % 8; const int n0 = 32 * nb;
                const float* W = (up ? ARGP(w_up) : ARGP(w_gate)) + (size_t)e * DM * DFF;
                transpose_item(W, DFF, Wgu_t + (size_t)e * 512 * DM, DM, 64 * kb, n0, 256 * (n0 / 128) + (n0 % 128) + (up ? 128 : 0), nullptr, scr, lane); continue; } r -= I_G + I_U;
            if (r < I_D) { const int e = r / 128, kb = (r % 128) / 32, nb = r % 32; transpose_item(ARGP(w_down) + (size_t)e * DFF * DM, DM, Wd_t + (size_t)e * DM * DFF, DFF, 64 * kb, 32 * nb, 32 * nb, nullptr, scr, lane); continue; } r -= I_D;
            { const int k = r; const float gk = ARGP(norm_xattn)[k]; const f32x4* src = (const f32x4*)(ARGP(w_xq) + (size_t)k * DM) + lane; u32x2* dst = (u32x2*)(Wxq_n + (size_t)k * DM) + lane;
#pragma unroll
              for (int j = 0; j < 4; ++j) { const f32x4 v = src[64 * j] * gk; u32x2 w; w.x = cvt_pk_bf16(v[0], v[1]); w.y = cvt_pk_bf16(v[2], v[3]); dst[64 * j] = w; } }
        }
        __syncthreads();
        for (int row = gw; row < M + MEMROWS; row += NGW) {
            const bool is_mem = row >= M; const int r = is_mem ? row - M : row;
            const f32x4* xr = (const f32x4*)((is_mem ? ARGP(mem) : ARGP(x)) + (size_t)r * DM) + lane;
            f32x4 v[4]; float s = 0.f;
#pragma unroll
            for (int j = 0; j < 4; ++j) { v[j] = xr[64 * j]; s += (v[j][0] * v[j][0] + v[j][1] * v[j][1]) + (v[j][2] * v[j][2] + v[j][3] * v[j][3]); }
            const float rinv = rsqrtf(wave_sum(s) * (1.0f / DM) + EPS);
            u32x2* o8 = (u32x2*)((is_mem ? MEMB : XB) + (size_t)r * DM) + lane;
#pragma unroll
            for (int j = 0; j < 4; ++j) { u32x2 w; w.x = cvt_pk_bf16(v[j][0], v[j][1]); w.y = cvt_pk_bf16(v[j][2], v[j][3]); o8[64 * j] = w; }
            if (is_mem) { if (lane == 0) RMEM[r] = rinv; continue; }
            float f[8];
#pragma unroll
            for (int jj = 0; jj < 8; ++jj) { float a = 0.f;
#pragma unroll
                for (int j = 0; j < 4; ++j) { const f32x4 w4 = *(const LAS f32x4*)(wfT + jj * DM + 256 * j + 4 * lane); a += (v[j][0] * w4[0] + v[j][1] * w4[1]) + (v[j][2] * w4[2] + v[j][3] * w4[3]); }
                f[jj] = wave_sum(a); }
            if (lane == 0) RX[r] = rinv;
            if (lane < 8) { float fl = 0.f;
#pragma unroll
                for (int jj = 0; jj < 8; ++jj) fl = (lane == jj) ? f[jj] : fl;
                fl = fl * rinv + ARGP(b_forget)[lane];
                const float ls = fminf(fl, 0.f) - log1pf(expf(-fabsf(fl)));
                LF[(size_t)r * 8 + lane] = ls * LOG2E; }
        }
    }
    xcd_barrier(bar);

    if (PH(1))
    if (vcu < BATCH) {
        PHASE_PTRS
        const int b = vcu, h = wave; float carry = 0.f;
        const float* src = LF + (size_t)b * SEQ * 8 + h; float* dst = CC + ((size_t)b * NH + h) * SEQ;
        for (int i0 = 0; i0 < SEQ; i0 += 256) {
            float v[4];
#pragma unroll
            for (int k = 0; k < 4; ++k) v[k] = src[(size_t)(i0 + 64 * k + lane) * 8];
#pragma unroll
            for (int k = 0; k < 4; ++k) { float x = v[k];
#pragma unroll
                for (int o = 1; o < 64; o <<= 1) { const float y = __shfl_up(x, o); if (lane >= o) x += y; }
                x += carry; dst[i0 + 64 * k + lane] = x; carry = __shfl(x, 63);
                { unsigned hm, lo; fox::split3(-x, hm, lo); u32x4 w; w.x = 0x3F803F80u; w.y = 0x3F80u | (hm << 16); w.z = (hm >> 16) | (lo << 16); w.w = 0u;
                  *(u32x4*)(KX + (((size_t)b * NH + h) * SEQ + i0 + 64 * k + lane) * 8) = w; } }
        }
    }
    if (PH(1))
    for (int rep_ = 0; rep_ < REPS(1); ++rep_)
    {
        PHASE_PTRS
        pg8::Gemm g{DM, DM, DM};
        SchedDense S{(const char*)XB, (const char*)Win_t, M / 256, NPROJ / 256, G, bx, (size_t)256 * DM * 2, (size_t)256 * DM * 2, 0, 2};
        pg8::EpiBf16 E{QKV, HW, RX, QKV_STRIDE, C2, C2, ctl + CW_KN};
        pg8::gemm_phase<pg8::EpiBf16, SchedDense, true, false>(lds + RING_OFF, g, S, E);
        SchedDense S2{(const char*)MEMB, (const char*)Wxkv_t, MEMROWS / 256, 2 * DM / 256, G, bx, (size_t)256 * DM * 2, (size_t)256 * DM * 2, 0, 0};
        pg8::EpiBf16 E2{KVM, 2 * DM, RMEM, 0, 1.f, 1.f, nullptr};
        pg8::gemm_phase<pg8::EpiBf16, SchedDense, true, false>(lds + RING_OFF, g, S2, E2);
    }
    xcd_barrier(bar);

    if (PH(2))
    {
        PHASE_PTRS
        const bf16_t* QA = QKV; const bf16_t* KA = QKV + QKV_STRIDE; const bf16_t* VA = QKV + 2 * QKV_STRIDE;
        const bf16_t* QBp = QKV + 3 * QKV_STRIDE; const bf16_t* KBp = QKV + 4 * QKV_STRIDE; const bf16_t* VBp = QKV + 5 * QKV_STRIDE;
        bf16_t* OA = OAB; bf16_t* OB = OAB + HW;
        LAS char* shm = (LAS char*)(lds + RING_OFF);
        for (int rep = 0; rep < REP_FOX; ++rep)
        for (int i = 0; i < 8; ++i) { const int bh = (vcu >> 5) * 8 + i, x = vcu & 31, qb = (i & 1) ? 31 - x : x;
            const float kmax = sqrtf(__uint_as_float(ctl[CW_KN + bh * 2]) + __uint_as_float(ctl[CW_KN + bh * 2 + 1])) * 1.01f;
            fox::fox_unit<8>(bh, qb, QA, KA, VA, OA, HS + (bh & 7), CC + (size_t)bh * SEQ, KX + (size_t)bh * SEQ * 8, kmax, shm); }
        for (int rep = 0; rep < REP_SB; ++rep)
        for (int i = 0; i < 8; ++i) { const int bh = vcu >> 2, qb = 8 * (vcu & 3) + i;
            att::attn_unit<1>(bh >> 3, bh & 7, qb, QBp, KBp, VBp, OB, HS + 8 + (bh & 7), nullptr, shm); }
        VM_WAIT(); __syncthreads();
        pg8::Gemm g{0, 0, 256};
        SchedGH S{(const char*)KVM, (const char*)Wxq_n, (const char*)Wxo_t, G, bx};
        EpiGH E{GT, HT};
        g.lda = 2 * DM; g.ldb = DM; SchedGHk<0> S0{S}; pg8::gemm_phase<EpiGH, SchedGHk<0>, true, false>(lds + RING_OFF, g, S0, E);
        g.lda = DM; g.ldb = 2 * DM; SchedGHk<1> S1{S}; pg8::gemm_phase<EpiGH, SchedGHk<1>, true, false>(lds + RING_OFF, g, S1, E);
    }
    xcd_barrier(bar);

    if (PH(4))
    for (int rep_ = 0; rep_ < REPS(4); ++rep_)
    {
        PHASE_PTRS
        pg8::Gemm g{DM, DM, DM};
        SchedDense S{(const char*)OAB, (const char*)Wout_t, M / 256, DM / 256, G, bx, (size_t)256 * DM * 2, (size_t)256 * DM * 2, 0, 0};
        pg8::EpiOutProj E{XB, H1B, SSQ, HS};
        pg8::gemm_phase<pg8::EpiOutProj, SchedDense, true, false>(lds + RING_OFF, g, S, E);
    }
    xcd_barrier(bar);

    if (PH(5))
    for (int rep_ = 0; rep_ < REPS(5); ++rep_)
    {
        PHASE_PTRS
        pg8::Gemm g{DM, DM, DM};
        SchedDense S{(const char*)H1B, (const char*)GT, M / 256, DM / 256, G, bx, (size_t)256 * DM * 2, (size_t)256 * DM * 2, (size_t)DM * DM * 2, 0};
        pg8::EpiSoftmax E{XB, SSQ, (LAS float*)(lds + EXTRA_OFF)};
        pg8::gemm_phase<pg8::EpiSoftmax, SchedDense, true, false>(lds + RING_OFF, g, S, E);
    }
    xcd_barrier(bar);

    if (PH(6))
    {
        PHASE_PTRS
        pg8::Gemm g{DM, DM, DM};
        SchedDense S{(const char*)XB, (const char*)HT, M / 256, DM / 256, G, bx, (size_t)256 * DM * 2, (size_t)256 * DM * 2, (size_t)DM * DM * 2, 0};
        pg8::EpiResidBf16 E{H1B};
        pg8::gemm_phase<pg8::EpiResidBf16, SchedDense, true, false>(lds + RING_OFF, g, S, E);
    }
    xcd_barrier(bar);

    if (PH(7))
    {
        PHASE_PTRS
        LAS float* wT = (LAS float*)(lds + RING_OFF);
        for (int idx = tid; idx < 20 * DM; idx += NWAVES * 64) { const int j = idx >> 10, k = idx & 1023; wT[idx] = (j < 4) ? ARGP(w_rg)[(size_t)k * 4 + j] : ARGP(w_re)[(size_t)k * 16 + (j - 4)]; }
        __syncthreads();
        for (int row = gw; row < M; row += NGW) {
            const u32x2* hr = (const u32x2*)(H1B + (size_t)row * DM) + lane; const f32x4* gp = (const f32x4*)ARGP(norm_ffn) + lane;
            f32x4 v[4]; float s = 0.f;
#pragma unroll
            for (int j = 0; j < 4; ++j) { const u32x2 hh = hr[64 * j]; v[j] = (f32x4){bf16lo(hh.x), bf16hi(hh.x), bf16lo(hh.y), bf16hi(hh.y)}; s += (v[j][0] * v[j][0] + v[j][1] * v[j][1]) + (v[j][2] * v[j][2] + v[j][3] * v[j][3]); }
            const float rinv = rsqrtf(wave_sum(s) * (1.0f / DM) + EPS);
            u32x2* o8 = (u32x2*)(U2B + (size_t)row * DM) + lane;
#pragma unroll
            for (int j = 0; j < 4; ++j) { v[j] = v[j] * rinv * gp[64 * j]; u32x2 w; w.x = cvt_pk_bf16(v[j][0], v[j][1]); w.y = cvt_pk_bf16(v[j][2], v[j][3]); o8[64 * j] = w; }
            float lg[20];
#pragma unroll
            for (int jj = 0; jj < 20; ++jj) { float a = 0.f;
#pragma unroll
                for (int j = 0; j < 4; ++j) { const f32x4 w4 = *(const LAS f32x4*)(wT + jj * DM + 256 * j + 4 * lane); a += (v[j][0] * w4[0] + v[j][1] * w4[1]) + (v[j][2] * w4[2] + v[j][3] * w4[3]); }
                lg[jj] = wave_sum(a); asm volatile("" : "+v"(lg[jj]) :: "memory"); }
            float g0 = lg[0] + ARGP(b_rg)[0], g1 = lg[1] + ARGP(b_rg)[1], g2 = lg[2] + ARGP(b_rg)[2], g3 = lg[3] + ARGP(b_rg)[3];
            int gi = 0; float gm = g0; if (g1 > gm) { gm = g1; gi = 1; } if (g2 > gm) { gm = g2; gi = 2; } if (g3 > gm) { gm = g3; gi = 3; }
            const float gval = 1.0f / (expf(g0 - gm) + expf(g1 - gm) + expf(g2 - gm) + expf(g3 - gm));
            float el[4];
#pragma unroll
            for (int j = 0; j < 4; ++j) { const float e0 = lg[4 + j], e1 = lg[8 + j], e2 = lg[12 + j], e3 = lg[16 + j]; el[j] = ((gi == 0) ? e0 : (gi == 1) ? e1 : (gi == 2) ? e2 : e3) + ARGP(b_re)[gi * 4 + j]; }
            int i0 = 0; float m0 = el[0];
#pragma unroll
            for (int j = 1; j < 4; ++j) if (el[j] > m0) { m0 = el[j]; i0 = j; }
            int i1 = -1; float m1 = -3.0e38f;
#pragma unroll
            for (int j = 0; j < 4; ++j) if (j != i0 && el[j] > m1) { m1 = el[j]; i1 = j; }
            const float w0 = 1.0f / (1.0f + expf(m1 - m0)), w1 = 1.0f - w0;
            if (lane < 2) { const int e = gi * 4 + (lane == 0 ? i0 : i1); const float w = gval * (lane == 0 ? w0 : w1);
                const int pos = (int)__hip_atomic_fetch_add(ctl + CW_CNT + 64 * e, 1u, __ATOMIC_RELAXED, __HIP_MEMORY_SCOPE_AGENT);
                LIST[(size_t)e * M + pos] = row; TOKSLOT[(size_t)row * 2 + lane] = (e << 20) | pos; TOKW[(size_t)row * 2 + lane] = w; }
        }
    }
    xcd_barrier(bar);

    if (PH(8))
    for (int rep_ = 0; rep_ < REPS(8); ++rep_)
    {
        PHASE_PTRS
        pg8::Gemm g{DM, DM, DM};
        LAS int* tbl = (LAS int*)(lds + EXTRA_OFF + 8192); moe_table(tbl, ctl);
        SchedMoe S; S.A = (const char*)U2B; S.W = (const char*)Wgu_t; S.list = LIST; S.tbl = tbl; S.G = G; S.c = bx; S.NPN = 2; S.w_exp = (size_t)512 * DM * 2; S.w_tile = (size_t)256 * DM * 2; S.a_tile = 0; S.ocol_w = 128;
        pg8::EpiSwiglu E{HID};
        pg8::gemm_phase<pg8::EpiSwiglu, SchedMoe, true, true>(lds + RING_OFF, g, S, E);
    }
    xcd_barrier(bar);

    if (PH(9))
    for (int rep_ = 0; rep_ < REPS(9); ++rep_)
    {
        PHASE_PTRS
        pg8::Gemm g{DFF, DFF, DFF};
        LAS int* tbl = (LAS int*)(lds + EXTRA_OFF + 8192);
        SchedMoe S; S.A = (const char*)HID; S.W = (const char*)Wd_t; S.list = LIST; S.tbl = tbl; S.G = G; S.c = bx; S.NPN = 4; S.w_exp = (size_t)DM * DFF * 2; S.w_tile = (size_t)256 * DFF * 2; S.a_tile = (size_t)256 * DFF * 2; S.ocol_w = 256;
        pg8::EpiBf16 E{YB, DM, nullptr, 0, 1.f, 1.f, nullptr};
        pg8::gemm_phase<pg8::EpiBf16, SchedMoe, true, false>(lds + RING_OFF, g, S, E);
    }
    xcd_barrier(bar);

    if (PH(10))
    {
        PHASE_PTRS
        const LAS int* tb = (const LAS int*)(lds + EXTRA_OFF + 8192);
        for (int row = gw; row < M; row += NGW) {
            const int s0 = TOKSLOT[(size_t)row * 2], s1 = TOKSLOT[(size_t)row * 2 + 1]; const float w0 = TOKW[(size_t)row * 2], w1 = TOKW[(size_t)row * 2 + 1];
            const int r0 = tb[s0 >> 20] * 256 + (s0 & 0xfffff), r1 = tb[s1 >> 20] * 256 + (s1 & 0xfffff);
            f32x4* hr = (f32x4*)(out + (size_t)row * DM) + lane; const u32x2* h2r = (const u32x2*)(H1B + (size_t)row * DM) + lane; const u32x2* y0 = (const u32x2*)(YB + (size_t)r0 * DM) + lane; const u32x2* y1 = (const u32x2*)(YB + (size_t)r1 * DM) + lane;
            const f32x4* gp = (const f32x4*)ARGP(norm_final) + lane;
            f32x4 v[4]; float s = 0.f;
#pragma unroll
            for (int j = 0; j < 4; ++j) { const u32x2 a = y0[64 * j], b = y1[64 * j]; const u32x2 hh = h2r[64 * j]; f32x4 h = {bf16lo(hh.x), bf16hi(hh.x), bf16lo(hh.y), bf16hi(hh.y)};
                h[0] += w0 * bf16lo(a.x) + w1 * bf16lo(b.x); h[1] += w0 * bf16hi(a.x) + w1 * bf16hi(b.x); h[2] += w0 * bf16lo(a.y) + w1 * bf16lo(b.y); h[3] += w0 * bf16hi(a.y) + w1 * bf16hi(b.y);
                v[j] = h; s += (h[0] * h[0] + h[1] * h[1]) + (h[2] * h[2] + h[3] * h[3]); }
            const float rinv = rsqrtf(wave_sum(s) * (1.0f / DM) + EPS);
#pragma unroll
            for (int j = 0; j < 4; ++j) hr[64 * j] = v[j] * rinv * gp[64 * j];
        }
    }
}

extern "C" void kernel_launch(void* const* d_in, const int* in_sizes, int n_in, void* d_out, int out_size, void* d_ws, size_t ws_size, hipStream_t stream) {
    static int grid = 0;
    if (grid == 0) {
        if (n_in != 22 || in_sizes[0] != M * DM || out_size != M * DM || ws_size < WS_END) { fprintf(stderr, "kernel_launch: unexpected shapes (n_in %d, in0 %d, out %d, ws %zu)\n", n_in, n_in > 0 ? in_sizes[0] : -1, out_size, ws_size); grid = -1; return; }
        int dev = 0, cus = 0, per_cu = 0;
        if (hipGetDevice(&dev) != hipSuccess || hipDeviceGetAttribute(&cus, hipDeviceAttributeMultiprocessorCount, dev) != hipSuccess) { grid = -1; return; }
        if (hipFuncSetAttribute((const void*)hymba_fwd, hipFuncAttributeMaxDynamicSharedMemorySize, LDS_BYTES) != hipSuccess) { fprintf(stderr, "kernel_launch: hipFuncSetAttribute failed\n"); grid = -1; return; }
        if (hipOccupancyMaxActiveBlocksPerMultiprocessor(&per_cu, (const void*)hymba_fwd, NWAVES * 64, LDS_BYTES) != hipSuccess || per_cu < 1) { fprintf(stderr, "kernel_launch: occupancy query reports %d\n", per_cu); }
        (void)hipGetLastError();
        grid = cus;
    }
    if (grid < 0) return;
    (void)hipMemsetAsync((char*)d_ws + WS_CTL, 0, CTL_ZERO_BYTES, stream);
    Args a{};
    const float** p = (const float**)&a;
    for (int i = 0; i < 22; ++i) p[i] = (const float*)d_in[i];
    a.out = (float*)d_out; a.ws = (unsigned char*)d_ws;
    hipLaunchKernelGGL(hymba_fwd, dim3(grid), dim3(NWAVES * 64), LDS_BYTES, stream, a);
}
```

```cpp
#include <hip/hip_runtime.h>
#include <hip/hip_bf16.h>
#include <cstdio>
#include <cstdint>

#define LAS __attribute__((address_space(3)))
#define GAS __attribute__((address_space(1)))
typedef unsigned short bf16_t;
typedef short bf16x8 __attribute__((ext_vector_type(8)));
typedef short s16x4 __attribute__((ext_vector_type(4)));
typedef float f32x4 __attribute__((ext_vector_type(4)));
typedef float f32x2 __attribute__((ext_vector_type(2)));
typedef float f32x16 __attribute__((ext_vector_type(16)));
typedef unsigned u32x4 __attribute__((ext_vector_type(4)));
typedef unsigned u32x2 __attribute__((ext_vector_type(2)));
typedef __bf16 bf16x2_t __attribute__((ext_vector_type(2)));

constexpr int BATCH = 8, SEQ = 8192, DM = 1024, M = BATCH * SEQ;
constexpr int NH = 8, HD = 64, HW = NH * HD;
constexpr int NPROJ = 3 * HW * 2;
constexpr int WIN_LD = NPROJ + NH;
constexpr int NMEM = 256, XH = 4, XD = 256, MEMROWS = BATCH * NMEM;
constexpr int NEXP = 16, DFF = 256;
constexpr float EPS = 1e-6f;
constexpr float LOG2E = 1.4426950408889634f;
constexpr float C2 = 0.125f * LOG2E;
constexpr float XSC = 0.0625f * LOG2E;
constexpr float SB_EXIT = -64.0f;

constexpr size_t MiB = 1u << 20;
constexpr size_t WS_CTL = 0, CTL_ZERO_BYTES = 1 * MiB;
constexpr size_t WS_WIN = 1 * MiB;
constexpr size_t WS_WOUT = 7 * MiB;
constexpr size_t WS_WXQ = 9 * MiB;
constexpr size_t WS_WXKV = 11 * MiB;
constexpr size_t WS_WXO = 15 * MiB;
constexpr size_t WS_WGU = 17 * MiB;
constexpr size_t WS_WD = 33 * MiB;
constexpr size_t WS_RX = 41 * MiB;
constexpr size_t WS_RMEM = WS_RX + 256 * 1024;
constexpr size_t WS_LF = 42 * MiB;
constexpr size_t WS_C2 = 44 * MiB;
constexpr size_t WS_SSQ = 46 * MiB;
constexpr size_t WS_TOKSLOT = 50 * MiB;
constexpr size_t WS_TOKW = 51 * MiB;
constexpr size_t WS_LIST = 52 * MiB;
constexpr size_t WS_MEMB = 56 * MiB;
constexpr size_t WS_KVM = 60 * MiB;
constexpr size_t WS_GT = 68 * MiB;
constexpr size_t WS_HT = 84 * MiB;
constexpr size_t WS_KX = 100 * MiB;
constexpr size_t WS_HS = 108 * MiB;
constexpr size_t WS_XB = 128 * MiB;
constexpr size_t WS_QKV = 256 * MiB;
constexpr size_t WS_H1B = 256 * MiB, WS_U2B = 384 * MiB, WS_HID = 512 * MiB;
constexpr size_t WS_O = 640 * MiB;
constexpr size_t WS_Y = 704 * MiB;
constexpr size_t WS_END = 1024 * MiB;
constexpr size_t QKV_STRIDE = (size_t)M * HW;
constexpr int MAXTILES = M * 2 / 256 + NEXP;
static_assert(WS_Y + (size_t)MAXTILES * 256 * 1024 * 2 <= WS_END, "ws map");
static_assert(WS_HID + (size_t)MAXTILES * 256 * 256 * 2 <= WS_O, "ws map");
constexpr int CW_BAR = 4096;
constexpr int CW_KN = 20480;
constexpr int CW_CNT = 16384;

constexpr int RING_OFF = 0, RING_BYTES = 131072;
constexpr int EXTRA_OFF = 131072, EXTRA_BYTES = 16384;
constexpr int MISC_OFF = EXTRA_OFF + EXTRA_BYTES;
constexpr int LDS_BYTES = MISC_OFF + 1024;
constexpr int NWAVES = 8;
#ifndef PHASE_MASK
#define PHASE_MASK 0x7ff
#endif
#define PH(n) ((PHASE_MASK >> (n)) & 1)
#ifndef FOX_V2
#define FOX_V2 1
#endif
#ifndef REP_MASK
#define REP_MASK 0
#endif
#define REPS(n) (1 + ((REP_MASK >> (n)) & 1))
#ifndef REP_FOX
#define REP_FOX 1
#endif
#ifndef REP_SB
#define REP_SB 1
#endif

__device__ __forceinline__ unsigned cvt_pk_bf16(float lo, float hi) { f32x2 v = {lo, hi}; bf16x2_t b = __builtin_convertvector(v, bf16x2_t); return __builtin_bit_cast(unsigned, b); }
__device__ __forceinline__ float bf16lo(unsigned u) { return __uint_as_float(u << 16); }
__device__ __forceinline__ float bf16hi(unsigned u) { return __uint_as_float(u & 0xffff0000u); }
__device__ __forceinline__ float wave_sum(float v) {
#pragma unroll
    for (int o = 1; o < 64; o <<= 1) v += __shfl_xor(v, o);
    return v;
}
#define LDS_WAIT() asm volatile("s_waitcnt lgkmcnt(0)" ::: "memory")
#define VM_WAIT() asm volatile("s_waitcnt vmcnt(0)" ::: "memory")

namespace pg8 {
constexpr int BM = 256, BK = 64, HALF = 128, HTB = HALF * BK * 2, STAGE_BYTES = 8 * HTB, NXCD = 8, WGM = 8;
__host__ __device__ __forceinline__ int lds_byte(int r, int c) { const int st = (r >> 4) * 2 + (c >> 5), rr = r & 15, cc = c & 31, ob = rr * 64 + cc * 2; return st * 1024 + (ob ^ (((ob >> 9) & 1) << 5)); }
__host__ __device__ __forceinline__ void stage_rc(int b, int& R, int& C) { const int st = b / 1024, sb = b % 1024, swz = sb ^ (((sb >> 9) & 1) << 5); R = (st >> 1) * 16 + swz / 64; C = (st & 1) * 32 + (swz % 64) / 2; }
__host__ __device__ __forceinline__ int perm32(int rho) { const int n = rho >> 4, i = rho & 15; return 8 * (i >> 2) + 4 * n + (i & 3); }

struct Unit { const char* a; const char* b; int orow, ocol, aux; const int* rows; int nvalid; };
struct Gemm { int lda, ldb, K; };

__device__ __forceinline__ bool tile_order(int i, int G, int c, int nM, int nN, int& pm, int& pn) {
    const int nwg = nM * nN; const long L = (long)i * G + c; if (L >= nwg) return false;
    int wgid = (int)L; { const int q = nwg / NXCD, r = nwg % NXCD, xcd = wgid % NXCD, off = wgid / NXCD; wgid = (xcd < r ? xcd * (q + 1) : r * (q + 1) + (xcd - r) * q) + off; }
    const int nig = WGM * nN, gid = wgid / nig, fm = gid * WGM, gsz = (nM - fm) < WGM ? (nM - fm) : WGM;
    pm = fm + ((wgid % nig) % gsz); pn = (wgid % nig) / gsz; return true;
}

template <class Epi, class Sched, bool ALIGN_EPI, bool GATHER>
__device__ __forceinline__ void gemm_phase(LAS unsigned char* lds, const Gemm g, const Sched& S, const Epi& E) {
    int tid = threadIdx.x; asm volatile("" : "+v"(tid));
    const int wid = __builtin_amdgcn_readfirstlane(tid >> 6), lane = tid & 63, wr = wid >> 2, wc = wid & 3, fr = lane & 15, fq = lane >> 4;
    const int K = g.K, nt = K / BK;
    unsigned voffA[2], voffB[2]; int RA[2], CA[2];
#pragma unroll
    for (int i = 0; i < 2; ++i) { int R, C; stage_rc(tid * 16 + i * 8192, R, C); const int Rb = (R & ~31) + perm32(R & 31);
        RA[i] = R; CA[i] = C; voffA[i] = (unsigned)(R * g.lda + C) * 2u; voffB[i] = (unsigned)(Rb * g.ldb + C) * 2u; }
    const size_t kstep = (size_t)(BK * 2);
    const size_t hstepA = (size_t)HALF * g.lda * 2, hstepB = (size_t)HALF * g.ldb * 2;
    const unsigned ldsw = (unsigned)wid * 1024u;
    const int aoff = lds_byte(wr * 64 + fr, fq * 8), boff = lds_byte(wc * 32 + fr, fq * 8);
#define PG8_SA(b, h) (((b) * 2 + (h)) * HTB)
#define PG8_SB(b, h) ((4 + (b) * 2 + (h)) * HTB)
#define PG8_STAGE2(bufoff, gbase, v0, v1) do { \
        __builtin_amdgcn_global_load_lds((const unsigned*)((const char*)(gbase) + (v0)), (LAS unsigned*)(lds + (bufoff) + ldsw), 16, 0, 0); \
        __builtin_amdgcn_global_load_lds((const unsigned*)((const char*)(gbase) + (v1)), (LAS unsigned*)(lds + (bufoff) + ldsw + 8192), 16, 0, 0); } while (0)
#define PG8_STAGEB(bufoff, gbase) PG8_STAGE2(bufoff, gbase, voffB[0], voffB[1])
#define PG8_STAGEA(bufoff, kptr, h, NX) do { if constexpr (GATHER) { const unsigned v0_ = (NX) ? gvn[h][0] : gvc[h][0], v1_ = (NX) ? gvn[h][1] : gvc[h][1]; PG8_STAGE2(bufoff, kptr, v0_, v1_); } \
        else { PG8_STAGE2(bufoff, (kptr) + (h) * hstepA, voffA[0], voffA[1]); } } while (0)
#define PG8_LDA(dst, b, h) do { _Pragma("unroll") for (int m = 0; m < 4; ++m) _Pragma("unroll") for (int k = 0; k < 2; ++k) dst[m][k] = *(const LAS bf16x8*)(lds + PG8_SA(b, h) + aoff + m * 2048 + k * 1024); } while (0)
#define PG8_LDB(dst, b, h) do { _Pragma("unroll") for (int n = 0; n < 2; ++n) _Pragma("unroll") for (int k = 0; k < 2; ++k) dst[n][k] = *(const LAS bf16x8*)(lds + PG8_SB(b, h) + boff + n * 2048 + k * 1024); } while (0)
#define PG8_MMA(ai, bj, At, Bt) do { __builtin_amdgcn_s_setprio(1); _Pragma("unroll") for (int m = 0; m < 4; ++m) _Pragma("unroll") for (int n = 0; n < 2; ++n) _Pragma("unroll") for (int k = 0; k < 2; ++k) \
        acc[ai][bj][m][n] = __builtin_amdgcn_mfma_f32_16x16x32_bf16(Bt[n][k], At[m][k], acc[ai][bj][m][n], 0, 0, 0); __builtin_amdgcn_s_setprio(0); } while (0)
#define PG8_WAIT_V(n) asm volatile("s_waitcnt vmcnt(" #n ")" ::: "memory")
#define PG8_WAIT_L(n) asm volatile("s_waitcnt lgkmcnt(" #n ")" ::: "memory")
#define PG8_BAR __builtin_amdgcn_s_barrier()
#define PG8_SCHED __builtin_amdgcn_sched_barrier(0)
#define PG8_GATHER_OFFS(dst, u) do { _Pragma("unroll") for (int h_ = 0; h_ < 2; ++h_) _Pragma("unroll") for (int i_ = 0; i_ < 2; ++i_) { const int r_ = h_ * HALF + RA[i_]; \
        const int idx_ = (u).rows[r_ < (u).nvalid ? r_ : 0]; dst[h_][i_] = (unsigned)(idx_ * g.lda + CA[i_]) * 2u; } } while (0)
    Unit cur, nxt; int ui = 0;
    if (!S.next(0, cur)) return;
    unsigned gvc[2][2] = {{0u, 0u}, {0u, 0u}}, gvn[2][2] = {{0u, 0u}, {0u, 0u}};
    if constexpr (GATHER) { PG8_GATHER_OFFS(gvc, cur); }
    f32x4 acc[2][2][4][2];
#pragma unroll
    for (int a = 0; a < 2; ++a)
#pragma unroll
        for (int b = 0; b < 2; ++b)
#pragma unroll
            for (int m = 0; m < 4; ++m)
#pragma unroll
                for (int n = 0; n < 2; ++n) acc[a][b][m][n] = (f32x4){0.f, 0.f, 0.f, 0.f};
    bf16x8 At[4][2], B0[2][2], B1[2][2];
    const char* cA = cur.a; const char* cB = cur.b;
    PG8_STAGEB(PG8_SB(0, 0), cB); PG8_STAGEB(PG8_SB(0, 1), cB + hstepB); PG8_STAGEA(PG8_SA(0, 0), cA, 0, false); PG8_STAGEA(PG8_SA(0, 1), cA, 1, false);
    if (wr == 1) PG8_BAR;
    PG8_WAIT_V(2); PG8_BAR;
    PG8_STAGEB(PG8_SB(1, 0), cB + kstep); PG8_STAGEA(PG8_SA(1, 0), cA + kstep, 0, false); PG8_STAGEB(PG8_SB(1, 1), cB + hstepB + kstep);
    PG8_WAIT_V(6); PG8_BAR;
    for (;;) {
        const bool has_next = S.next(ui + 1, nxt);
        const char* nA = has_next ? nxt.a : cA; const char* nB = has_next ? nxt.b : cB;
        if constexpr (GATHER) { if (has_next) { PG8_GATHER_OFFS(gvn, nxt); } else { gvn[0][0] = gvc[0][0]; gvn[0][1] = gvc[0][1]; gvn[1][0] = gvc[1][0]; gvn[1][1] = gvc[1][1]; } }
#pragma unroll 1
        for (int t = 0; t < nt; t += 2) {
            const bool last = (t == nt - 2);
            const char* a1 = cA + (size_t)(t + 1) * kstep;
            const char* a2 = last ? nA : cA + (size_t)(t + 2) * kstep; const char* b2 = last ? nB : cB + (size_t)(t + 2) * kstep;
            const char* a3 = a2 + kstep; const char* b3 = b2 + kstep;
            PG8_LDB(B0, 0, 0); PG8_LDB(B1, 0, 1); PG8_SCHED; PG8_LDA(At, 0, 0); PG8_STAGEA(PG8_SA(1, 1), a1, 1, false);
            PG8_WAIT_V(8); PG8_WAIT_L(0); PG8_BAR; PG8_MMA(0, 0, At, B0); PG8_MMA(0, 1, At, B1); PG8_BAR; PG8_SCHED;
            PG8_LDA(At, 0, 1); PG8_STAGEB(PG8_SB(0, 0), b2); PG8_STAGEB(PG8_SB(0, 1), b2 + hstepB); PG8_STAGEA(PG8_SA(0, 0), a2, 0, last);
            PG8_WAIT_V(8); PG8_WAIT_L(0); PG8_BAR; PG8_MMA(1, 0, At, B0); PG8_MMA(1, 1, At, B1); PG8_BAR; PG8_SCHED;
            PG8_LDB(B0, 1, 0); PG8_LDB(B1, 1, 1); PG8_SCHED; PG8_LDA(At, 1, 0); PG8_STAGEA(PG8_SA(0, 1), a2, 1, last);
            PG8_WAIT_V(8); PG8_WAIT_L(0); PG8_BAR; PG8_MMA(0, 0, At, B0); PG8_MMA(0, 1, At, B1); PG8_BAR; PG8_SCHED;
            PG8_LDA(At, 1, 1); PG8_STAGEB(PG8_SB(1, 0), b3); PG8_STAGEB(PG8_SB(1, 1), b3 + hstepB); PG8_STAGEA(PG8_SA(1, 0), a3, 0, last);
            PG8_WAIT_V(8); PG8_WAIT_L(0); PG8_BAR; PG8_MMA(1, 0, At, B0); PG8_MMA(1, 1, At, B1); PG8_BAR; PG8_SCHED;
            if constexpr (Epi::HAS_MID) { if (t == (nt >> 1) - 2) { int fr3 = fr, fq3 = fq; asm volatile("" : "+v"(fr3), "+v"(fq3)); E.mid(acc, cur, wr, wc, fr3, fq3); } }
        }
        if constexpr (ALIGN_EPI) { if (wr == 0) PG8_BAR; }
        { int fr2 = fr, fq2 = fq; asm volatile("" : "+v"(fr2), "+v"(fq2));
          E(acc, cur, wr, wc, fr2, fq2); }
        if (!has_next) break;
#pragma unroll
        for (int a = 0; a < 2; ++a)
#pragma unroll
            for (int b = 0; b < 2; ++b)
#pragma unroll
                for (int m = 0; m < 4; ++m)
#pragma unroll
                    for (int n = 0; n < 2; ++n) acc[a][b][m][n] = (f32x4){0.f, 0.f, 0.f, 0.f};
        cur = nxt; cA = nA; cB = nB; ++ui;
        if constexpr (GATHER) { gvc[0][0] = gvn[0][0]; gvc[0][1] = gvn[0][1]; gvc[1][0] = gvn[1][0]; gvc[1][1] = gvn[1][1]; }
        if constexpr (ALIGN_EPI) { if (wr == 1) PG8_BAR; }
    }
    PG8_WAIT_V(0);
    if constexpr (!ALIGN_EPI) { if (wr == 0) PG8_BAR; }
    PG8_BAR;
#undef PG8_SA
#undef PG8_SB
#undef PG8_STAGE2
#undef PG8_STAGEA
#undef PG8_STAGEB
#undef PG8_LDA
#undef PG8_LDB
#undef PG8_MMA
#undef PG8_WAIT_V
#undef PG8_WAIT_L
#undef PG8_BAR
#undef PG8_SCHED
#undef PG8_GATHER_OFFS
}

#define EPI_ROW(u, ai, m) ((u).orow + (ai) * HALF + wr * 64 + (m) * 16 + fr)
#define EPI_COL(u, bj) ((u).ocol + (bj) * HALF + wc * 32 + 8 * fq)
struct EpiBf16 {
    static constexpr bool HAS_MID = false;
    bf16_t* O; int ldc; const float* rs; size_t stride; float sc0, sc3;
    unsigned* kn;
    __device__ __forceinline__ void operator()(const f32x4 (&acc)[2][2][4][2], const Unit& u, int wr, int wc, int fr, int fq) const {
        bf16_t* base = O + (size_t)u.aux * stride;
        const float sc = (u.aux == 0) ? sc0 : ((u.aux == 3) ? sc3 : 1.f);
        float nmax[2] = {0.f, 0.f}; const bool dokn = kn && u.aux == 1;
#pragma unroll
        for (int ai = 0; ai < 2; ++ai)
#pragma unroll
            for (int m = 0; m < 4; ++m) { const int row = EPI_ROW(u, ai, m); const float s = (rs ? rs[row] : 1.f) * sc;
#pragma unroll
                for (int bj = 0; bj < 2; ++bj) { const f32x4 v0 = acc[ai][bj][m][0] * s, v1 = acc[ai][bj][m][1] * s;
                    u32x4 w; w.x = cvt_pk_bf16(v0[0], v0[1]); w.y = cvt_pk_bf16(v0[2], v0[3]); w.z = cvt_pk_bf16(v1[0], v1[1]); w.w = cvt_pk_bf16(v1[2], v1[3]);
                    *(u32x4*)(base + (size_t)row * ldc + EPI_COL(u, bj)) = w;
                    if (dokn) { float q = (v0[0] * v0[0] + v0[1] * v0[1]) + (v0[2] * v0[2] + v0[3] * v0[3]) + (v1[0] * v1[0] + v1[1] * v1[1]) + (v1[2] * v1[2] + v1[3] * v1[3]);
                        q += __shfl_xor(q, 16); q += __shfl_xor(q, 32); nmax[bj] = fmaxf(nmax[bj], q); } } }
        if (dokn) {
#pragma unroll
            for (int bj = 0; bj < 2; ++bj) { float q = nmax[bj]; q = fmaxf(q, __shfl_xor(q, 1)); q = fmaxf(q, __shfl_xor(q, 2)); q = fmaxf(q, __shfl_xor(q, 4)); q = fmaxf(q, __shfl_xor(q, 8));
                const int head = ((u.ocol + bj * HALF) >> 6) + (wc >> 1), bt = u.orow / SEQ;
                if ((fr | fq) == 0) atomicMax(kn + ((bt * NH + head) * 2 + (wc & 1)), __float_as_uint(q)); }
        }
    }
};
struct EpiResid {
    static constexpr bool HAS_MID = false;
    const float* res; float* out; bf16_t* hb; float* ssq;
    __device__ __forceinline__ void operator()(const f32x4 (&acc)[2][2][4][2], const Unit& u, int wr, int wc, int fr, int fq) const {
#pragma unroll
        for (int ai = 0; ai < 2; ++ai)
#pragma unroll
            for (int m = 0; m < 4; ++m) { const int row = EPI_ROW(u, ai, m); float q = 0.f;
#pragma unroll
                for (int bj = 0; bj < 2; ++bj) { const size_t off = (size_t)row * DM + EPI_COL(u, bj);
                    const f32x4 r0 = *(const f32x4*)(res + off), r1 = *(const f32x4*)(res + off + 4);
                    const f32x4 v0 = acc[ai][bj][m][0] + r0, v1 = acc[ai][bj][m][1] + r1;
                    *(f32x4*)(out + off) = v0; *(f32x4*)(out + off + 4) = v1;
                    q += (v0[0] * v0[0] + v0[1] * v0[1]) + (v0[2] * v0[2] + v0[3] * v0[3]) + (v1[0] * v1[0] + v1[1] * v1[1]) + (v1[2] * v1[2] + v1[3] * v1[3]);
                    if (hb) { u32x4 w; w.x = cvt_pk_bf16(v0[0], v0[1]); w.y = cvt_pk_bf16(v0[2], v0[3]); w.z = cvt_pk_bf16(v1[0], v1[1]); w.w = cvt_pk_bf16(v1[2], v1[3]); *(u32x4*)(hb + off) = w; } }
                if (ssq) { q += __shfl_xor(q, 16); q += __shfl_xor(q, 32); if (fq == 0) ssq[(size_t)row * 16 + (u.ocol >> 8) * 4 + wc] = q; } }
    }
};
struct EpiOutProj {
    static constexpr bool HAS_MID = true;
    const bf16_t* xb; bf16_t* hb; float* ssq; const float* hs;
    __device__ __forceinline__ void scales(int row, float& ra, float& rb) const {
        const f32x4* p = (const f32x4*)(hs + (size_t)row * 16); const f32x4 a0 = p[0], a1 = p[1], b0 = p[2], b1 = p[3];
        ra = rsqrtf((((a0[0] + a0[1]) + (a0[2] + a0[3])) + ((a1[0] + a1[1]) + (a1[2] + a1[3]))) * (1.0f / HW) + EPS);
        rb = rsqrtf((((b0[0] + b0[1]) + (b0[2] + b0[3])) + ((b1[0] + b1[1]) + (b1[2] + b1[3]))) * (1.0f / HW) + EPS);
    }
    __device__ __forceinline__ void mid(f32x4 (&acc)[2][2][4][2], const Unit& u, int wr, int wc, int fr, int fq) const {
#pragma unroll
        for (int ai = 0; ai < 2; ++ai)
#pragma unroll
            for (int m = 0; m < 4; ++m) { float ra, rb; scales(EPI_ROW(u, ai, m), ra, rb); const float f = ra / rb;
#pragma unroll
                for (int bj = 0; bj < 2; ++bj) { acc[ai][bj][m][0] *= f; acc[ai][bj][m][1] *= f; } }
    }
    __device__ __forceinline__ void operator()(const f32x4 (&acc)[2][2][4][2], const Unit& u, int wr, int wc, int fr, int fq) const {
#pragma unroll
        for (int ai = 0; ai < 2; ++ai)
#pragma unroll
            for (int m = 0; m < 4; ++m) { const int row = EPI_ROW(u, ai, m); float ra, rb; scales(row, ra, rb); float q = 0.f;
#pragma unroll
                for (int bj = 0; bj < 2; ++bj) { const size_t off = (size_t)row * DM + EPI_COL(u, bj);
                    const u32x4 xr = *(const u32x4*)(xb + off);
                    f32x4 v0 = acc[ai][bj][m][0] * rb, v1 = acc[ai][bj][m][1] * rb;
                    v0[0] += bf16lo(xr.x); v0[1] += bf16hi(xr.x); v0[2] += bf16lo(xr.y); v0[3] += bf16hi(xr.y); v1[0] += bf16lo(xr.z); v1[1] += bf16hi(xr.z); v1[2] += bf16lo(xr.w); v1[3] += bf16hi(xr.w);
                    q += (v0[0] * v0[0] + v0[1] * v0[1]) + (v0[2] * v0[2] + v0[3] * v0[3]) + (v1[0] * v1[0] + v1[1] * v1[1]) + (v1[2] * v1[2] + v1[3] * v1[3]);
                    u32x4 w; w.x = cvt_pk_bf16(v0[0], v0[1]); w.y = cvt_pk_bf16(v0[2], v0[3]); w.z = cvt_pk_bf16(v1[0], v1[1]); w.w = cvt_pk_bf16(v1[2], v1[3]); *(u32x4*)(hb + off) = w; }
                q += __shfl_xor(q, 16); q += __shfl_xor(q, 32); if (fq == 0) ssq[(size_t)row * 16 + (u.ocol >> 8) * 4 + wc] = q; }
    }
};
struct EpiResidBf16 {
    static constexpr bool HAS_MID = false;
    bf16_t* hb;
    __device__ __forceinline__ void operator()(const f32x4 (&acc)[2][2][4][2], const Unit& u, int wr, int wc, int fr, int fq) const {
#pragma unroll
        for (int ai = 0; ai < 2; ++ai)
#pragma unroll
            for (int m = 0; m < 4; ++m) { const int row = EPI_ROW(u, ai, m);
#pragma unroll
                for (int bj = 0; bj < 2; ++bj) { const size_t off = (size_t)row * DM + EPI_COL(u, bj);
                    const u32x4 xr = *(const u32x4*)(hb + off);
                    f32x4 v0 = acc[ai][bj][m][0], v1 = acc[ai][bj][m][1];
                    v0[0] += bf16lo(xr.x); v0[1] += bf16hi(xr.x); v0[2] += bf16lo(xr.y); v0[3] += bf16hi(xr.y); v1[0] += bf16lo(xr.z); v1[1] += bf16hi(xr.z); v1[2] += bf16lo(xr.w); v1[3] += bf16hi(xr.w);
                    u32x4 w; w.x = cvt_pk_bf16(v0[0], v0[1]); w.y = cvt_pk_bf16(v0[2], v0[3]); w.z = cvt_pk_bf16(v1[0], v1[1]); w.w = cvt_pk_bf16(v1[2], v1[3]); *(u32x4*)(hb + off) = w; } }
    }
};
struct EpiSoftmax {
    static constexpr bool HAS_MID = false;
    bf16_t* P; const float* ssq; LAS float* red;
    __device__ __forceinline__ void operator()(f32x4 (&acc)[2][2][4][2], const Unit& u, int wr, int wc, int fr, int fq) const {
#pragma unroll
        for (int ai = 0; ai < 2; ++ai)
#pragma unroll
            for (int m = 0; m < 4; ++m) { const int row = EPI_ROW(u, ai, m); const f32x4* sp = (const f32x4*)(ssq + (size_t)row * 16);
                const f32x4 s0 = sp[0], s1 = sp[1], s2 = sp[2], s3 = sp[3];
                const float tot = ((s0[0] + s0[1]) + (s0[2] + s0[3])) + ((s1[0] + s1[1]) + (s1[2] + s1[3])) + ((s2[0] + s2[1]) + (s2[2] + s2[3])) + ((s3[0] + s3[1]) + (s3[2] + s3[3]));
                const float r1 = rsqrtf(tot * (1.0f / DM) + EPS) * XSC; float a = -3.0e38f;
#pragma unroll
                for (int bj = 0; bj < 2; ++bj)
#pragma unroll
                    for (int n = 0; n < 2; ++n) { f32x4 v = acc[ai][bj][m][n] * r1; acc[ai][bj][m][n] = v; a = fmaxf(a, fmaxf(fmaxf(v[0], v[1]), fmaxf(v[2], v[3]))); }
                a = fmaxf(a, __shfl_xor(a, 16)); a = fmaxf(a, __shfl_xor(a, 32));
                if (fq == 0) red[(ai * HALF + wr * 64 + m * 16 + fr) * 4 + wc] = a; asm volatile("" ::: "memory"); }
        LDS_WAIT(); __builtin_amdgcn_s_barrier(); asm volatile("" ::: "memory");
#pragma unroll
        for (int ai = 0; ai < 2; ++ai)
#pragma unroll
            for (int m = 0; m < 4; ++m) { const int rl = ai * HALF + wr * 64 + m * 16 + fr; const f32x4 mm = *(const LAS f32x4*)(red + rl * 4);
                const float a = fmaxf(fmaxf(mm[0], mm[1]), fmaxf(mm[2], mm[3])); float s = 0.f;
#pragma unroll
                for (int bj = 0; bj < 2; ++bj)
#pragma unroll
                    for (int n = 0; n < 2; ++n) { f32x4 v = acc[ai][bj][m][n];
                        v[0] = __builtin_amdgcn_exp2f(v[0] - a); v[1] = __builtin_amdgcn_exp2f(v[1] - a); v[2] = __builtin_amdgcn_exp2f(v[2] - a); v[3] = __builtin_amdgcn_exp2f(v[3] - a);
                        acc[ai][bj][m][n] = v; s += (v[0] + v[1]) + (v[2] + v[3]); }
                s += __shfl_xor(s, 16); s += __shfl_xor(s, 32);
                if (fq == 0) red[1024 + rl * 4 + wc] = s; }
        LDS_WAIT(); __builtin_amdgcn_s_barrier(); asm volatile("" ::: "memory");
#pragma unroll
        for (int ai = 0; ai < 2; ++ai)
#pragma unroll
            for (int m = 0; m < 4; ++m) { const int rl = ai * HALF + wr * 64 + m * 16 + fr; const int row = u.orow + rl; const f32x4 ss = *(const LAS f32x4*)(red + 1024 + rl * 4);
                const float inv = 1.0f / ((ss[0] + ss[1]) + (ss[2] + ss[3]));
#pragma unroll
                for (int bj = 0; bj < 2; ++bj) { const f32x4 v0 = acc[ai][bj][m][0] * inv, v1 = acc[ai][bj][m][1] * inv;
                    u32x4 w; w.x = cvt_pk_bf16(v0[0], v0[1]); w.y = cvt_pk_bf16(v0[2], v0[3]); w.z = cvt_pk_bf16(v1[0], v1[1]); w.w = cvt_pk_bf16(v1[2], v1[3]);
                    *(u32x4*)(P + (size_t)row * DM + EPI_COL(u, bj)) = w; } }
    }
};
struct EpiSwiglu {
    static constexpr bool HAS_MID = false;
    bf16_t* Hd;
    __device__ __forceinline__ void operator()(const f32x4 (&acc)[2][2][4][2], const Unit& u, int wr, int wc, int fr, int fq) const {
#pragma unroll
        for (int ai = 0; ai < 2; ++ai)
#pragma unroll
            for (int m = 0; m < 4; ++m) { const int row = EPI_ROW(u, ai, m); float h[8];
#pragma unroll
                for (int n = 0; n < 2; ++n)
#pragma unroll
                    for (int e = 0; e < 4; ++e) { const float gt = acc[ai][0][m][n][e], up = acc[ai][1][m][n][e];
                        h[n * 4 + e] = gt * __builtin_amdgcn_rcpf(1.0f + __builtin_amdgcn_exp2f(-gt * LOG2E)) * up; }
                u32x4 w; w.x = cvt_pk_bf16(h[0], h[1]); w.y = cvt_pk_bf16(h[2], h[3]); w.z = cvt_pk_bf16(h[4], h[5]); w.w = cvt_pk_bf16(h[6], h[7]);
                *(u32x4*)(Hd + (size_t)row * DFF + u.ocol + wc * 32 + 8 * fq) = w; }
    }
};
}

namespace att {
constexpr int QB = 256, KVBLK = 64, PITCH = HW, OPITCH = DM;
constexpr int SLOTB = 8192, LDS_K = 0, LDS_V = 2 * SLOTB, LDS_WS = 4 * SLOTB, LDS_OST = LDS_WS + NWAVES * 256, LDS_FLAG = LDS_OST + NWAVES * 4096, LDS_END = LDS_FLAG + 64;
static_assert(LDS_END <= RING_BYTES, "attention LDS");
__device__ __forceinline__ int crow(int r, int hi) { return (r & 3) + 8 * (r >> 2) + 4 * hi; }
__device__ __forceinline__ void glds16(const void* gsrc, unsigned lds_dst) { unsigned keep;
    asm volatile("s_mov_b32 %0, m0\n\ts_mov_b32 m0, %2\n\ts_nop 0\n\tglobal_load_lds_dwordx4 %1, off\n\ts_mov_b32 m0, %0" : "=&s"(keep) : "v"(gsrc), "s"(lds_dst) : "memory"); }
__device__ __forceinline__ void glds16s(const void* sbase, unsigned voff, unsigned lds_dst) { unsigned keep;
    asm volatile("s_mov_b32 %0, m0\n\ts_mov_b32 m0, %3\n\ts_nop 0\n\tglobal_load_lds_dwordx4 %1, %2\n\ts_mov_b32 m0, %0" : "=&s"(keep) : "v"(voff), "s"(sbase), "s"(lds_dst) : "memory"); }
#define ATT_WAIT_BAR0() asm volatile("s_waitcnt vmcnt(0) lgkmcnt(0)\n\ts_barrier" ::: "memory")
#define MFMA32(a, b, c) __builtin_amdgcn_mfma_f32_32x32x16_bf16(a, b, c, 0, 0, 0)
__device__ __forceinline__ void store_row_ssq(u32x4 v, float* dst, int ch) {
    float q = (bf16lo(v.x) * bf16lo(v.x) + bf16hi(v.x) * bf16hi(v.x)) + (bf16lo(v.y) * bf16lo(v.y) + bf16hi(v.y) * bf16hi(v.y)) + (bf16lo(v.z) * bf16lo(v.z) + bf16hi(v.z) * bf16hi(v.z)) + (bf16lo(v.w) * bf16lo(v.w) + bf16hi(v.w) * bf16hi(v.w));
    q += __shfl_xor(q, 1); q += __shfl_xor(q, 2); q += __shfl_xor(q, 4);
    if (ch == 0) *dst = q;
}
__device__ __forceinline__ void qkt(f32x16& p0, f32x16& p1, const LAS char* Kslot, const bf16x8* qr, const f32x16& cin, int r32, int hi) {
    const LAS char* kb = Kslot + hi * 1024 + r32 * 16;
#pragma unroll
    for (int d0 = 0; d0 < 4; ++d0) {
        const bf16x8 b0 = *(const LAS bf16x8*)(kb + d0 * 2048);
        const bf16x8 b1 = *(const LAS bf16x8*)(kb + d0 * 2048 + 512);
        if (d0 == 0) { p0 = MFMA32(b0, qr[0], cin); p1 = MFMA32(b1, qr[0], cin); }
        else { p0 = MFMA32(b0, qr[d0], p0); p1 = MFMA32(b1, qr[d0], p1); } }
}
__device__ __forceinline__ void pv(f32x16* o, int vb, bf16x8 pa0, bf16x8 pa1, bf16x8 pa2, bf16x8 pa3) {
#pragma unroll
    for (int d0 = 0; d0 < 2; ++d0) { s16x4 lo[4], hi[4];
#pragma unroll
        for (int ks = 0; ks < 4; ++ks) {
            asm volatile("ds_read_b64_tr_b16 %0,%1 offset:%c2" : "=&v"(lo[ks]) : "v"(vb), "i"(d0 * 4096 + ks * 1024) : "memory");
            asm volatile("ds_read_b64_tr_b16 %0,%1 offset:%c2" : "=&v"(hi[ks]) : "v"(vb), "i"(d0 * 4096 + ks * 1024 + 512) : "memory"); }
        asm volatile("s_waitcnt lgkmcnt(0)" ::: "memory"); __builtin_amdgcn_sched_barrier(0);
#define PK(k) (bf16x8){lo[k][0], lo[k][1], lo[k][2], lo[k][3], hi[k][0], hi[k][1], hi[k][2], hi[k][3]}
        o[d0] = MFMA32(pa0, PK(0), o[d0]); o[d0] = MFMA32(pa1, PK(1), o[d0]); o[d0] = MFMA32(pa2, PK(2), o[d0]); o[d0] = MFMA32(pa3, PK(3), o[d0]);
#undef PK
    }
}
__device__ __forceinline__ float swap_lo(float x) { auto rr = __builtin_amdgcn_permlane32_swap(__float_as_uint(x), __float_as_uint(x), false, false); return __uint_as_float(rr[0]); }
__device__ __forceinline__ float swap_hi(float x) { auto rr = __builtin_amdgcn_permlane32_swap(__float_as_uint(x), __float_as_uint(x), false, false); return __uint_as_float(rr[1]); }

template <int MODE> __device__ __forceinline__ void attn_unit(int b, int h, int qb, const bf16_t* Q, const bf16_t* K, const bf16_t* V, bf16_t* O, float* hs, const float* cb, LAS char* shm) {
    int tid = threadIdx.x; asm volatile("" : "+v"(tid)); const int lane = tid & 63, r32 = lane & 31, hi = lane >> 5; const int wid = __builtin_amdgcn_readfirstlane(tid >> 6);
    const long rowbase = (long)b * SEQ; const int q0 = qb * QB;
    const bf16_t* Qw = Q + (rowbase + q0 + wid * 32) * PITCH + h * HD;
    const bf16_t* Kh = K + rowbase * PITCH + h * HD; const bf16_t* Vh = V + rowbase * PITCH + h * HD;
    const unsigned lds0 = (unsigned)(uintptr_t)shm;
    LAS float* wsf = (LAS float*)(shm + LDS_WS) + wid * 64;
    LAS unsigned* flags = (LAS unsigned*)(shm + LDS_FLAG);
    const bf16_t* ksrc = Kh + (long)lane * PITCH + wid * 8;
    const bf16_t* vsrc = Vh + (long)(16 * (wid & 3) + (lane >> 2)) * PITCH + (wid >> 2) * 32 + (lane & 3) * 8;
    const unsigned kdst = lds0 + LDS_K + wid * 1024, vdst = lds0 + LDS_V + wid * 1024;
#define DMA_KV(t, slot) do { glds16(ksrc + (long)(t) * KVBLK * PITCH, (unsigned)__builtin_amdgcn_readfirstlane(kdst + (slot))); glds16(vsrc + (long)(t) * KVBLK * PITCH, (unsigned)__builtin_amdgcn_readfirstlane(vdst + (slot))); } while (0)
    const int vb0 = (int)(lds0 + LDS_V) + ((lane >> 4) & 1) * 32 + (lane & 3) * 8 + (4 * hi + ((lane & 15) >> 2)) * 64;
    const int NT = (q0 + QB) / KVBLK;
    DMA_KV(NT - 1, 0);
    bf16x8 qr[4];
#pragma unroll
    for (int d0 = 0; d0 < 4; ++d0) qr[d0] = *(const bf16x8*)(Qw + (long)r32 * PITCH + d0 * 16 + hi * 8);
    f32x16 o[2]; o[0] = f32x16{}; o[1] = f32x16{};
    const int qrel = wid * 32 + r32;
    float m_run = -1.0e30f, l_run = 0.f, R = 0.f, ct = 0.f;
    if (MODE == 0) ct = cb[q0 + qrel];
    bf16x8 TD0, TD1, TONE;
#pragma unroll
    for (int j = 0; j < 8; ++j) { const int kvl = 8 * (j >> 2) + 4 * hi + (j & 3); TD0[j] = (kvl >= r32) ? (short)0x3F80 : (short)0; TD1[j] = (16 + kvl >= r32) ? (short)0x3F80 : (short)0; TONE[j] = (short)0x3F80; }
    f32x16 zero16 = f32x16{};
    for (int i = 0; i < NT; ++i) {
        const int t = NT - 1 - i, slot = (i & 1) * SLOTB;
        ATT_WAIT_BAR0();
        if (MODE == 1 && i > 0) {
            const LAS unsigned* fl = flags + ((i - 1) & 1) * 8; unsigned all = 1u;
#pragma unroll
            for (int w = 0; w < 8; ++w) all &= fl[w];
            if (__builtin_amdgcn_readfirstlane(all)) break;
        }
        if (t > 0) DMA_KV(t - 1, slot ^ SLOTB);
        const int jb = t - (NT - 4);
        const bool active = !(jb >= 0 && 2 * jb > wid);
        bool wave_done = false;
        if (MODE == 1) wave_done = __all(R < SB_EXIT);
        if (active && !(MODE == 1 && wave_done)) {
            f32x16 p0, p1;
            qkt(p0, p1, shm + LDS_K + slot, qr, zero16, r32, hi);
            if (MODE == 0) {
                const float* cbt = cb + t * KVBLK + 4 * hi;
#pragma unroll
                for (int g = 0; g < 4; ++g) { const f32x4 c0 = *(const f32x4*)(cbt + 8 * g), c1 = *(const f32x4*)(cbt + 32 + 8 * g);
#pragma unroll
                    for (int e = 0; e < 4; ++e) { p0[4 * g + e] += ct - c0[e]; p1[4 * g + e] += ct - c1[e]; } }
                if (jb >= 0) {
#pragma unroll
                    for (int r = 0; r < 16; ++r) { const int kv = 64 * jb + crow(r, hi); if (kv > qrel) p0[r] = -1.0e30f; if (kv + 32 > qrel) p1[r] = -1.0e30f; } }
                float a = fmaxf(p0[0], p1[0]);
#pragma unroll
                for (int r = 1; r < 16; ++r) a = fmaxf(a, fmaxf(p0[r], p1[r]));
                a = fmaxf(swap_lo(a), swap_hi(a));
                const float m_new = fmaxf(m_run, a), alpha = __builtin_amdgcn_exp2f(m_run - m_new); m_run = m_new;
                float s = 0.f;
#pragma unroll
                for (int r = 0; r < 16; ++r) { p0[r] = __builtin_amdgcn_exp2f(p0[r] - m_new); p1[r] = __builtin_amdgcn_exp2f(p1[r] - m_new); s += p0[r] + p1[r]; }
                l_run = l_run * alpha + s;
                if (hi == 0) wsf[r32] = alpha;
                LDS_WAIT();
#pragma unroll
                for (int r = 0; r < 16; ++r) { const float f = wsf[crow(r, hi)]; o[0][r] *= f; o[1][r] *= f; }
                LDS_WAIT();
            } else {
                if (jb >= 0) {
#pragma unroll
                    for (int r = 0; r < 16; ++r) { const int kv = 64 * jb + crow(r, hi); if (kv >= qrel) p0[r] = -1.0e30f; if (kv + 32 >= qrel) p1[r] = -1.0e30f; } }
                f32x16 l0, l1;
#pragma unroll
                for (int r = 0; r < 16; ++r) {
                    l0[r] = -(fmaxf(p0[r], 0.f) + __builtin_amdgcn_logf(1.0f + __builtin_amdgcn_exp2f(-fabsf(p0[r]))));
                    l1[r] = -(fmaxf(p1[r], 0.f) + __builtin_amdgcn_logf(1.0f + __builtin_amdgcn_exp2f(-fabsf(p1[r])))); }
                u32x4 lw0 = {cvt_pk_bf16(l0[0], l0[1]), cvt_pk_bf16(l0[2], l0[3]), cvt_pk_bf16(l0[4], l0[5]), cvt_pk_bf16(l0[6], l0[7])};
                u32x4 lw1 = {cvt_pk_bf16(l0[8], l0[9]), cvt_pk_bf16(l0[10], l0[11]), cvt_pk_bf16(l0[12], l0[13]), cvt_pk_bf16(l0[14], l0[15])};
                u32x4 lw2 = {cvt_pk_bf16(l1[0], l1[1]), cvt_pk_bf16(l1[2], l1[3]), cvt_pk_bf16(l1[4], l1[5]), cvt_pk_bf16(l1[6], l1[7])};
                u32x4 lw3 = {cvt_pk_bf16(l1[8], l1[9]), cvt_pk_bf16(l1[10], l1[11]), cvt_pk_bf16(l1[12], l1[13]), cvt_pk_bf16(l1[14], l1[15])};
                f32x16 rt;
#pragma unroll
                for (int r = 0; r < 16; ++r) rt[r] = R;
                f32x16 t0 = MFMA32(TD0, __builtin_bit_cast(bf16x8, lw0), rt); t0 = MFMA32(TD1, __builtin_bit_cast(bf16x8, lw1), t0);
                t0 = MFMA32(TONE, __builtin_bit_cast(bf16x8, lw2), t0); t0 = MFMA32(TONE, __builtin_bit_cast(bf16x8, lw3), t0);
                f32x16 t1 = MFMA32(TD0, __builtin_bit_cast(bf16x8, lw2), rt); t1 = MFMA32(TD1, __builtin_bit_cast(bf16x8, lw3), t1);
#pragma unroll
                for (int r = 0; r < 16; ++r) { p0[r] = __builtin_amdgcn_exp2f(p0[r] + t0[r]); p1[r] = __builtin_amdgcn_exp2f(p1[r] + t1[r]); }
                R = swap_lo(t0[0]);
            }
            u32x4 pw0 = {cvt_pk_bf16(p0[0], p0[1]), cvt_pk_bf16(p0[2], p0[3]), cvt_pk_bf16(p0[4], p0[5]), cvt_pk_bf16(p0[6], p0[7])};
            u32x4 pw1 = {cvt_pk_bf16(p0[8], p0[9]), cvt_pk_bf16(p0[10], p0[11]), cvt_pk_bf16(p0[12], p0[13]), cvt_pk_bf16(p0[14], p0[15])};
            u32x4 pw2 = {cvt_pk_bf16(p1[0], p1[1]), cvt_pk_bf16(p1[2], p1[3]), cvt_pk_bf16(p1[4], p1[5]), cvt_pk_bf16(p1[6], p1[7])};
            u32x4 pw3 = {cvt_pk_bf16(p1[8], p1[9]), cvt_pk_bf16(p1[10], p1[11]), cvt_pk_bf16(p1[12], p1[13]), cvt_pk_bf16(p1[14], p1[15])};
            pv(o, vb0 + slot, __builtin_bit_cast(bf16x8, pw0), __builtin_bit_cast(bf16x8, pw1), __builtin_bit_cast(bf16x8, pw2), __builtin_bit_cast(bf16x8, pw3));
        }
        if (MODE == 1) { const bool dn = __all(R < SB_EXIT); if (lane == 0) flags[(i & 1) * 8 + wid] = dn ? 1u : 0u; }
    }
    float linv = 1.f;
    if (MODE == 0) { const float lt = swap_lo(l_run) + swap_hi(l_run); linv = 1.0f / lt; }
    if (hi == 0) wsf[32 + r32] = linv;
    LDS_WAIT();
    bf16_t* Ow = O + (rowbase + q0 + wid * 32) * OPITCH + h * HD;
    { LAS bf16_t* stg = (LAS bf16_t*)(shm + LDS_OST) + wid * 2048;
#pragma unroll
      for (int r = 0; r < 16; ++r) { const int orow = crow(r, hi); const float f = wsf[32 + orow];
#pragma unroll
        for (int d0 = 0; d0 < 2; ++d0) { const unsigned pk = cvt_pk_bf16(o[d0][r] * f, 0.f); stg[orow * 64 + d0 * 32 + r32] = (bf16_t)(pk & 0xffffu); } }
      LDS_WAIT();
#pragma unroll
      for (int i = 0; i < 4; ++i) { const int row = i * 8 + (lane >> 3), ch = lane & 7; const u32x4 v = *(const LAS u32x4*)(stg + row * 64 + ch * 8); *(u32x4*)(Ow + (long)row * OPITCH + ch * 8) = v;
        store_row_ssq(v, hs + (rowbase + q0 + wid * 32 + row) * 16, ch); } }
    asm volatile("s_waitcnt vmcnt(0) lgkmcnt(0)\n\ts_barrier" ::: "memory");
#undef DMA_KV
}
}


namespace fox {
constexpr int QB = 256, KVBLK = 64, PITCH = HW, OPITCH = DM;
constexpr int NSLOT = 3, SLOTB = 9216;
constexpr int LDS_K = 0, LDS_V = NSLOT * SLOTB, LDS_WS = 2 * NSLOT * SLOTB, LDS_OST = LDS_WS + NWAVES * 256, LDS_CL = LDS_OST + NWAVES * 4096, LDS_VOTE = LDS_CL + 512, LDS_END = LDS_VOTE + 32;
static_assert(LDS_END <= RING_BYTES, "fox LDS");
constexpr float WIN_T = 64.0f;
constexpr float FLOOR = -256.0f;
using att::crow; using att::glds16; using att::glds16s;
typedef __attribute__((address_space(3))) const char* lds_cptr;
typedef short v4i16_t __attribute__((ext_vector_type(4)));
#define SBAR() __builtin_amdgcn_sched_barrier(0)
#define WAIT_BAR(N) asm volatile("s_waitcnt vmcnt(" #N ") lgkmcnt(0)\n\ts_barrier" ::: "memory")
__device__ __forceinline__ s16x4 vtr(lds_cptr p) { return __builtin_bit_cast(s16x4, __builtin_amdgcn_ds_read_tr16_b64_v4i16((__attribute__((address_space(3))) v4i16_t*)p)); }
__device__ __forceinline__ void kload2(bf16x8* kf, lds_cptr kp, int j) { kf[2 * j] = *(const LAS bf16x8*)(kp + j * 2048); kf[2 * j + 1] = *(const LAS bf16x8*)(kp + j * 2048 + 512); }
__device__ __forceinline__ void cmask(f32x16& p0, f32x16& p1, int jb, int qrel, int hi) {
    const float NEG = -INFINITY; const int kb = 64 * jb + 4 * hi;
#pragma unroll
    for (int r = 0; r < 16; ++r) { const int kv = kb + (r & 3) + 8 * (r >> 2); if (kv > qrel) p0[r] = NEG; if (kv + 32 > qrel) p1[r] = NEG; }
}
__device__ __forceinline__ void split3(float x, unsigned& hm, unsigned& lo) {
    const unsigned h = cvt_pk_bf16(x, 0.f) & 0xffffu; const float r1 = x - __uint_as_float(h << 16);
    const unsigned m = cvt_pk_bf16(r1, 0.f) & 0xffffu; const float r2 = r1 - __uint_as_float(m << 16);
    hm = h | (m << 16); lo = cvt_pk_bf16(r2, 0.f) & 0xffffu;
}
__device__ __forceinline__ bf16x8 qx_build(float a, int hi) {
    unsigned hm, lo; split3(a, hm, lo);
    u32x4 w; w.x = hm; w.y = lo | 0x3F800000u; w.z = 0x3F803F80u; w.w = 0u;
    if (hi) { w.x = 0u; w.y = 0u; w.z = 0u; }
    return __builtin_bit_cast(bf16x8, w);
}

template <int THRL> __device__ __forceinline__ void fox_unit(int bh, int qb, const bf16_t* Q, const bf16_t* K, const bf16_t* V, bf16_t* O, float* hs, const float* cb, const bf16_t* KXh, float kmax, LAS char* shm) {
    int tid = threadIdx.x; asm volatile("" : "+v"(tid)); const int lane = tid & 63, r32 = lane & 31, hi = lane >> 5; const int wid = __builtin_amdgcn_readfirstlane(tid >> 6);
    const int b = bh >> 3, h = bh & 7; const long rowbase = (long)b * SEQ; const int q0 = qb * QB;
    const bf16_t* Qw = Q + (rowbase + q0 + wid * 32) * PITCH + h * HD;
    const bf16_t* Kh = K + rowbase * PITCH + h * HD; const bf16_t* Vh = V + rowbase * PITCH + h * HD;
    const unsigned lds0 = (unsigned)(uintptr_t)shm;
    LAS float* wsf = (LAS float*)(shm + LDS_WS) + wid * 64;
    const int NT = (q0 + QB) / KVBLK;
    int NTe = NT;
    LAS float* clt = (LAS float*)(shm + LDS_CL); LAS unsigned* votes = (LAS unsigned*)(shm + LDS_VOTE);
    const float clv = (tid < NT) ? cb[64 * tid + 63] : 0.f;
    const unsigned koff = (unsigned)(lane * PITCH + wid * 8) * 2u, voff = (unsigned)((16 * (wid & 3) + (lane >> 2)) * PITCH + (wid >> 2) * 32 + (lane & 3) * 8) * 2u, xoff = (unsigned)lane * 16u;
    const unsigned kdst = lds0 + LDS_K + wid * 1024, vdst = lds0 + LDS_V + wid * 1024, xdst = lds0 + LDS_K + 8192;
    const bool xl = (lane >> 3) == wid;
#define DMA_K(p, slot) do { glds16s(Kh + (long)(NT - 1 - (p)) * KVBLK * PITCH, koff, (unsigned)__builtin_amdgcn_readfirstlane(kdst + (slot))); \
        if (xl) glds16s(KXh + (long)(NT - 1 - (p)) * KVBLK * 8, xoff, (unsigned)__builtin_amdgcn_readfirstlane(xdst + (slot))); } while (0)
#define DMA_V(p, slot) glds16s(Vh + (long)(NT - 1 - (p)) * KVBLK * PITCH, voff, (unsigned)__builtin_amdgcn_readfirstlane(vdst + (slot)))
    bf16x8 kf[10];
    const lds_cptr shm3 = (lds_cptr)shm; const lds_cptr kp0 = shm3 + LDS_K + hi * 1024 + r32 * 16; const lds_cptr kx0 = shm3 + LDS_K + 8192 + r32 * 16;
    const lds_cptr vp0 = shm3 + LDS_V + ((lane >> 4) & 1) * 32 + (lane & 3) * 8 + (4 * hi + ((lane & 15) >> 2)) * 64;
    DMA_K(0, 0); DMA_V(0, 0); DMA_K(1, SLOTB);
    bf16x8 qr[4];
#pragma unroll
    for (int d0 = 0; d0 < 4; ++d0) qr[d0] = *(const bf16x8*)(Qw + (long)r32 * PITCH + d0 * 16 + hi * 8);
    const int qrel = wid * 32 + r32;
    const float ct = cb[q0 + qrel];
    float mhat = 0.f, l_reg = 0.f; f32x16 o[2]; o[0] = f32x16{}; o[1] = f32x16{};
    bf16x8 qx = qx_build(ct, hi);
    const f32x16 z16 = f32x16{};
#define CMASK(P0, P1, p) do { const int jb_ = 3 - (p); if (jb_ >= 0) cmask(P0, P1, jb_, qrel, hi); } while (0)
    bool resc = false;
#define RESC() do { if (resc) { asm volatile("s_waitcnt lgkmcnt(0)" ::: "memory"); \
      _Pragma("unroll") for (int d_ = 0; d_ < 2; ++d_) _Pragma("unroll") for (int r = 0; r < 16; ++r) o[d_][r] *= wsf[crow(r, hi)]; } } while (0)
    f32x16 pA0, pA1, pB0, pB1;
    int sl_prev = 0, sl_cur = 0, sl_next = SLOTB;
#define ROT() do { sl_prev = sl_cur; sl_cur = sl_next; sl_next = (sl_next == (NSLOT - 1) * SLOTB) ? 0 : sl_next + SLOTB; } while (0)
    DMA_K(2, 2 * SLOTB);
    WAIT_BAR(5);
    if (tid < NT) clt[tid] = clv;
    float qkb;
    { float q2 = 0.f;
#pragma unroll
      for (int d0 = 0; d0 < 4; ++d0)
#pragma unroll
          for (int j = 0; j < 8; ++j) { const float e = __uint_as_float(((unsigned)(unsigned short)qr[d0][j]) << 16); q2 += e * e; }
      q2 = att::swap_lo(q2) + att::swap_hi(q2); qkb = sqrtf(q2) * kmax + ct + WIN_T; }
    { const LAS char* kb = (const LAS char*)shm + LDS_K + hi * 1024 + r32 * 16; const LAS char* kxb = (const LAS char*)shm + LDS_K + 8192 + r32 * 16;
      pA0 = MFMA32(*(const LAS bf16x8*)(kxb), qx, z16); pA1 = MFMA32(*(const LAS bf16x8*)(kxb + 512), qx, z16);
#pragma unroll
      for (int d0 = 0; d0 < 4; ++d0) { pA0 = MFMA32(*(const LAS bf16x8*)(kb + d0 * 2048), qr[d0], pA0); pA1 = MFMA32(*(const LAS bf16x8*)(kb + d0 * 2048 + 512), qr[d0], pA1); } }
    asm volatile("s_nop 15\n\ts_nop 7" : "+v"(pA0), "+v"(pA1)); CMASK(pA0, pA1, 0);
    { float a = fmaxf(pA0[0], pA1[0]);
#pragma unroll
      for (int r = 1; r < 16; ++r) a = fmaxf(a, fmaxf(pA0[r], pA1[r]));
      a = fmaxf(att::swap_lo(a), att::swap_hi(a));
      const float dl = fmaxf(a, FLOOR); mhat = dl;
#pragma unroll
      for (int r = 0; r < 16; ++r) { pA0[r] = __builtin_amdgcn_exp2f(pA0[r] - dl); pA1[r] = __builtin_amdgcn_exp2f(pA1[r] - dl); }
      qx = qx_build(ct - mhat, hi); asm volatile("" : "+v"(qx)); }
    WAIT_BAR(0);
    DMA_K(3, 0); DMA_V(1, SLOTB);
    ROT();
    kload2(kf, kp0 + sl_cur, 0); kload2(kf, kp0 + sl_cur, 1); kload2(kf, kp0 + sl_cur, 2); kload2(kf, kp0 + sl_cur, 3);
    kf[8] = *(const LAS bf16x8*)(kx0 + sl_cur); kf[9] = *(const LAS bf16x8*)(kx0 + sl_cur + 512);
    WAIT_BAR(3);
    s16x4 vlo[8], vhi[8]; u32x4 pw0, pw1, pw2, pw3;
#define PKW(P, B) cvt_pk_bf16(P[B], P[B + 1])
#define PAF(k) __builtin_bit_cast(bf16x8, pw##k)
#define VFR(i) (bf16x8){vlo[i][0], vlo[i][1], vlo[i][2], vlo[i][3], vhi[i][0], vhi[i][1], vhi[i][2], vhi[i][3]}
#define PIN(x) asm volatile("" : "+v"(x))
#define MX3(a, b, c) __builtin_fmaxf(__builtin_fmaxf((a), (b)), (c))
#define GAPA(MF, A0, A1, A2, A3, W0, W1, PW) do { MF; sacc += A0; sacc += A1; sacc += A2; sacc += A3; PIN(sacc); W0; W1; PIN(PW); SBAR(); } while (0)
#define EX(v) __builtin_amdgcn_exp2f(v)
#define GAPB(MF, X, B) do { MF; X[B] = EX(X[B]); X[B + 1] = EX(X[B + 1]); X[B + 2] = EX(X[B + 2]); X[B + 3] = EX(X[B + 3]); PIN(X); SBAR(); } while (0)
#define VRD(i) do { vlo[i] = vtr(vp_ + (((i) >> 2) * 4096 + ((i) & 3) * 1024)); vhi[i] = vtr(vp_ + (((i) >> 2) * 4096 + ((i) & 3) * 1024 + 512)); } while (0)
#define KRD(G, j) do { if (G) { kload2(kf, kp0 + sl_next, j); SBAR(); } } while (0)
#define KRDX(G) do { if (G) { kf[8] = *(const LAS bf16x8*)(kx0 + sl_next); kf[9] = *(const LAS bf16x8*)(kx0 + sl_next + 512); SBAR(); } } while (0)
#define STEP(C0, C1, P0, P1, t, GK, GV, GL) do { SBAR(); \
    const lds_cptr vp_ = vp0 + sl_prev; \
    C0 = MFMA32(kf[8], qx, z16); C1 = MFMA32(kf[9], qx, z16); SBAR(); \
    VRD(0); SBAR(); float sacc = (P0[0] + P0[1]); \
    GAPA(C0 = MFMA32(kf[0], qr[0], C0), P0[2], P0[3], P0[4], P0[5],     pw0[0] = PKW(P0, 0), pw0[1] = PKW(P0, 2), pw0); \
    VRD(4); SBAR(); GAPA(C1 = MFMA32(kf[1], qr[0], C1), P0[6], P0[7], P0[8], P0[9],     pw0[2] = PKW(P0, 4), pw0[3] = PKW(P0, 6), pw0); \
    VRD(1); SBAR(); GAPA(C0 = MFMA32(kf[2], qr[1], C0),   P0[10], P0[11], P0[12], P0[13], pw1[0] = PKW(P0, 8), pw1[1] = PKW(P0, 10), pw1); \
    VRD(5); SBAR(); GAPA(C1 = MFMA32(kf[3], qr[1], C1),   P0[14], P0[15], P1[0], P1[1],   pw1[2] = PKW(P0, 12), pw1[3] = PKW(P0, 14), pw1); \
    VRD(2); SBAR(); GAPA(C0 = MFMA32(kf[4], qr[2], C0),   P1[2], P1[3], P1[4], P1[5],     pw2[0] = PKW(P1, 0), pw2[1] = PKW(P1, 2), pw2); \
    VRD(6); SBAR(); GAPA(C1 = MFMA32(kf[5], qr[2], C1),   P1[6], P1[7], P1[8], P1[9],     pw2[2] = PKW(P1, 4), pw2[3] = PKW(P1, 6), pw2); \
    VRD(3); SBAR(); GAPA(C0 = MFMA32(kf[6], qr[3], C0),   P1[10], P1[11], P1[12], P1[13], pw3[0] = PKW(P1, 8), pw3[1] = PKW(P1, 10), pw3); \
    VRD(7); SBAR(); GAPA(C1 = MFMA32(kf[7], qr[3], C1),   P1[14], P1[15], 0.f, 0.f,       pw3[2] = PKW(P1, 12), pw3[3] = PKW(P1, 14), pw3); \
    l_reg += sacc; \
    if (GK) { DMA_K((t) + 3, sl_cur); } if (GV) { DMA_V((t) + 1, sl_next); } \
    CMASK(C0, C1, t); \
    { float a = MX3(C0[0], C0[1], C1[0]), b_ = MX3(C0[2], C0[3], C1[1]); a = MX3(a, C1[2], C1[3]); \
      _Pragma("unroll") for (int r = 4; r < 16; r += 4) { a = MX3(a, C0[r], C0[r + 1]); b_ = MX3(b_, C0[r + 2], C0[r + 3]); a = MX3(a, C1[r], C1[r + 1]); b_ = MX3(b_, C1[r + 2], C1[r + 3]); } \
      float rm = __builtin_fmaxf(a, b_); { auto rr = __builtin_amdgcn_permlane32_swap(__float_as_uint(rm), __float_as_uint(rm), false, false); rm = __builtin_fmaxf(__uint_as_float(rr[0]), __uint_as_float(rr[1])); } \
      resc = false; \
      if (__builtin_expect(__any(rm > (float)THRL), 0)) { const float dl = __builtin_fmaxf(rm, 0.f); mhat += dl; \
        _Pragma("unroll") for (int r = 0; r < 16; ++r) { C0[r] -= dl; C1[r] -= dl; } \
        qx = qx_build(ct - mhat, hi); asm volatile("" : "+v"(qx)); \
        const float f = __builtin_amdgcn_exp2f(-dl); l_reg *= f; if (hi == 0) wsf[r32] = f; resc = true; } } \
    SBAR(); \
    GAPB(o[0] = MFMA32(PAF(0), VFR(0), o[0]), C0, 0); \
    KRDX(GL); GAPB(o[1] = MFMA32(PAF(0), VFR(4), o[1]), C0, 4); \
    KRD(GL, 0); GAPB(o[0] = MFMA32(PAF(1), VFR(1), o[0]), C0, 8); \
    KRD(GL, 1); GAPB(o[1] = MFMA32(PAF(1), VFR(5), o[1]), C0, 12); \
    KRD(GL, 2); GAPB(o[0] = MFMA32(PAF(2), VFR(2), o[0]), C1, 0); \
    KRD(GL, 3); GAPB(o[1] = MFMA32(PAF(2), VFR(6), o[1]), C1, 4); \
    GAPB(o[0] = MFMA32(PAF(3), VFR(3), o[0]), C1, 8); \
    GAPB(o[1] = MFMA32(PAF(3), VFR(7), o[1]), C1, 12); \
    } while (0)
#define ENDW(tt) do { if ((tt) + 3 < NTe) { WAIT_BAR(3); } else if ((tt) + 2 < NTe) { WAIT_BAR(1); } else { WAIT_BAR(0); } } while (0)
#define VOTE(u) do { const int ts_ = NT - (u) - 3; bool ok_ = false; if (ts_ >= 0) { ok_ = __all((qkb - mhat) < clt[ts_]); } if (lane == 0) votes[wid] = ok_ ? 1u : 0u; } while (0)
#define TALLY(u) do { const u32x4 va_ = *(const LAS u32x4*)votes, vb_ = *(const LAS u32x4*)(votes + 4); \
        if (__builtin_amdgcn_readfirstlane((va_.x & va_.y & va_.z & va_.w & vb_.x & vb_.y & vb_.z & vb_.w) != 0u)) { if ((u) + 2 < NTe) { NTe = (u) + 2; WAIT_BAR(0); } } } while (0)
    int t = 1;
    for (; t + 1 < NTe && t < 5; t += 2) {
        STEP(pB0, pB1, pA0, pA1, t, (t + 3 < NTe), (t + 1 < NTe), (t + 1 < NTe));       ENDW(t);     RESC(); ROT();
        STEP(pA0, pA1, pB0, pB1, t + 1, (t + 4 < NTe), (t + 2 < NTe), (t + 2 < NTe));   VOTE(t + 1); ENDW(t + 1); TALLY(t + 1); RESC(); ROT();
    }
#undef CMASK
#define CMASK(P0, P1, p) do {} while (0)
    for (; t + 5 < NTe; t += 2) {
        STEP(pB0, pB1, pA0, pA1, t, true, true, true);       WAIT_BAR(3); RESC(); ROT();
        STEP(pA0, pA1, pB0, pB1, t + 1, true, true, true);   VOTE(t + 1); WAIT_BAR(3); TALLY(t + 1); RESC(); ROT();
    }
    for (; t + 1 < NTe; t += 2) {
        STEP(pB0, pB1, pA0, pA1, t, (t + 3 < NTe), (t + 1 < NTe), (t + 1 < NTe));       ENDW(t);     RESC(); ROT();
        STEP(pA0, pA1, pB0, pB1, t + 1, (t + 4 < NTe), (t + 2 < NTe), (t + 2 < NTe));   ENDW(t + 1); RESC(); ROT();
    }
#undef CMASK
#define CMASK(P0, P1, p) do { const int jb_ = 3 - (p); if (jb_ >= 0) cmask(P0, P1, jb_, qrel, hi); } while (0)
    STEP(pB0, pB1, pA0, pA1, NTe - 1, false, false, false); RESC();
    { float sacc = pB0[0] + pB0[1];
#pragma unroll
      for (int r = 2; r < 16; ++r) sacc += pB0[r];
#pragma unroll
      for (int r = 0; r < 16; ++r) sacc += pB1[r];
      l_reg += sacc;
      pw0 = (u32x4){PKW(pB0, 0), PKW(pB0, 2), PKW(pB0, 4), PKW(pB0, 6)}; pw1 = (u32x4){PKW(pB0, 8), PKW(pB0, 10), PKW(pB0, 12), PKW(pB0, 14)};
      pw2 = (u32x4){PKW(pB1, 0), PKW(pB1, 2), PKW(pB1, 4), PKW(pB1, 6)}; pw3 = (u32x4){PKW(pB1, 8), PKW(pB1, 10), PKW(pB1, 12), PKW(pB1, 14)};
      SBAR(); att::pv(o, (int)(unsigned)(uintptr_t)(vp0 + sl_cur), PAF(0), PAF(1), PAF(2), PAF(3)); }
    l_reg = att::swap_lo(l_reg) + att::swap_hi(l_reg);
    if (hi == 0) wsf[32 + r32] = l_reg; asm volatile("s_waitcnt lgkmcnt(0)" ::: "memory");
    float rli[16];
#pragma unroll
    for (int r = 0; r < 16; ++r) rli[r] = __builtin_amdgcn_rcpf(wsf[32 + crow(r, hi)]);
    bf16_t* Ow = O + (rowbase + q0 + wid * 32) * OPITCH + h * HD;
    { LAS bf16_t* stg = (LAS bf16_t*)(shm + LDS_OST) + wid * 2048;
#pragma unroll
      for (int r = 0; r < 16; ++r) { const int orow = crow(r, hi);
#pragma unroll
        for (int d0 = 0; d0 < 2; ++d0) stg[orow * 64 + d0 * 32 + r32] = (bf16_t)(cvt_pk_bf16(o[d0][r] * rli[r], 0.f) & 0xffffu); }
      asm volatile("s_waitcnt lgkmcnt(0)" ::: "memory");
#pragma unroll
      for (int i = 0; i < 4; ++i) { const int row = i * 8 + (lane >> 3), ch = lane & 7; const u32x4 v = *(const LAS u32x4*)(stg + row * 64 + ch * 8); *(u32x4*)(Ow + (long)row * OPITCH + ch * 8) = v;
        att::store_row_ssq(v, hs + (rowbase + q0 + wid * 32 + row) * 16, ch); } }
    asm volatile("s_waitcnt lgkmcnt(0)\n\ts_barrier" ::: "memory");
#undef DMA_K
#undef DMA_V
#undef CMASK
#undef RESC
#undef ROT
#undef PKW
#undef PAF
#undef VFR
#undef PIN
#undef MX3
#undef GAPA
#undef GAPB
#undef EX
#undef VRD
#undef KRD
#undef KRDX
#undef STEP
#undef ENDW
#undef VOTE
#undef TALLY
}
#undef SBAR
#undef WAIT_BAR
}


namespace sbk {
constexpr int QB = 256, KVBLK = 64, PITCH = HW, OPITCH = DM, NBURST = 6, SLOTB = 8192;
constexpr int LDS_K = 0, LDS_V = NBURST * SLOTB, LDS_FLAG = 2 * NBURST * SLOTB, LDS_END = LDS_FLAG + 128;
static_assert(LDS_END <= RING_BYTES, "sb LDS");
using att::crow; using att::glds16s; using att::qkt; using att::pv; using att::swap_lo;
__device__ __forceinline__ void sb_tile(const LAS char* Kslot, int vb, const bf16x8* qr, bf16x8 TD0, bf16x8 TD1, bf16x8 TONE, int jb, int qrel, int r32, int hi, float& R, f32x16* o) {
    f32x16 p0, p1; const f32x16 z16 = f32x16{};
    qkt(p0, p1, Kslot, qr, z16, r32, hi);
    if (jb >= 0) {
#pragma unroll
        for (int r = 0; r < 16; ++r) { const int kv = 64 * jb + crow(r, hi); if (kv >= qrel) p0[r] = -1.0e30f; if (kv + 32 >= qrel) p1[r] = -1.0e30f; } }
    f32x16 l0, l1;
#pragma unroll
    for (int r = 0; r < 16; ++r) {
        l0[r] = -(fmaxf(p0[r], 0.f) + __builtin_amdgcn_logf(1.0f + __builtin_amdgcn_exp2f(-fabsf(p0[r]))));
        l1[r] = -(fmaxf(p1[r], 0.f) + __builtin_amdgcn_logf(1.0f + __builtin_amdgcn_exp2f(-fabsf(p1[r])))); }
    u32x4 lw0 = {cvt_pk_bf16(l0[0], l0[1]), cvt_pk_bf16(l0[2], l0[3]), cvt_pk_bf16(l0[4], l0[5]), cvt_pk_bf16(l0[6], l0[7])};
    u32x4 lw1 = {cvt_pk_bf16(l0[8], l0[9]), cvt_pk_bf16(l0[10], l0[11]), cvt_pk_bf16(l0[12], l0[13]), cvt_pk_bf16(l0[14], l0[15])};
    u32x4 lw2 = {cvt_pk_bf16(l1[0], l1[1]), cvt_pk_bf16(l1[2], l1[3]), cvt_pk_bf16(l1[4], l1[5]), cvt_pk_bf16(l1[6], l1[7])};
    u32x4 lw3 = {cvt_pk_bf16(l1[8], l1[9]), cvt_pk_bf16(l1[10], l1[11]), cvt_pk_bf16(l1[12], l1[13]), cvt_pk_bf16(l1[14], l1[15])};
    f32x16 rt;
#pragma unroll
    for (int r = 0; r < 16; ++r) rt[r] = R;
    f32x16 t0 = MFMA32(TD0, __builtin_bit_cast(bf16x8, lw0), rt); t0 = MFMA32(TD1, __builtin_bit_cast(bf16x8, lw1), t0);
    t0 = MFMA32(TONE, __builtin_bit_cast(bf16x8, lw2), t0); t0 = MFMA32(TONE, __builtin_bit_cast(bf16x8, lw3), t0);
    f32x16 t1 = MFMA32(TD0, __builtin_bit_cast(bf16x8, lw2), rt); t1 = MFMA32(TD1, __builtin_bit_cast(bf16x8, lw3), t1);
#pragma unroll
    for (int r = 0; r < 16; ++r) { p0[r] = __builtin_amdgcn_exp2f(p0[r] + t0[r]); p1[r] = __builtin_amdgcn_exp2f(p1[r] + t1[r]); }
    R = swap_lo(t0[0]);
    u32x4 pw0 = {cvt_pk_bf16(p0[0], p0[1]), cvt_pk_bf16(p0[2], p0[3]), cvt_pk_bf16(p0[4], p0[5]), cvt_pk_bf16(p0[6], p0[7])};
    u32x4 pw1 = {cvt_pk_bf16(p0[8], p0[9]), cvt_pk_bf16(p0[10], p0[11]), cvt_pk_bf16(p0[12], p0[13]), cvt_pk_bf16(p0[14], p0[15])};
    u32x4 pw2 = {cvt_pk_bf16(p1[0], p1[1]), cvt_pk_bf16(p1[2], p1[3]), cvt_pk_bf16(p1[4], p1[5]), cvt_pk_bf16(p1[6], p1[7])};
    u32x4 pw3 = {cvt_pk_bf16(p1[8], p1[9]), cvt_pk_bf16(p1[10], p1[11]), cvt_pk_bf16(p1[12], p1[13]), cvt_pk_bf16(p1[14], p1[15])};
    pv(o, vb, __builtin_bit_cast(bf16x8, pw0), __builtin_bit_cast(bf16x8, pw1), __builtin_bit_cast(bf16x8, pw2), __builtin_bit_cast(bf16x8, pw3));
}
#define SB_WAITBAR(N) asm volatile("s_waitcnt vmcnt(" #N ") lgkmcnt(0)\n\ts_barrier" ::: "memory")
__device__ __forceinline__ void sb_unit(int b, int h, int qb, const bf16_t* Q, const bf16_t* K, const bf16_t* V, bf16_t* O, float* hs, LAS char* shm) {
    int tid = threadIdx.x; asm volatile("" : "+v"(tid)); const int lane = tid & 63, r32 = lane & 31, hi = lane >> 5; const int wid = __builtin_amdgcn_readfirstlane(tid >> 6);
    const long rowbase = (long)b * SEQ; const int q0 = qb * QB;
    const bf16_t* Qw = Q + (rowbase + q0 + wid * 32) * PITCH + h * HD;
    const bf16_t* Kh = K + rowbase * PITCH + h * HD; const bf16_t* Vh = V + rowbase * PITCH + h * HD;
    const unsigned lds0 = (unsigned)(uintptr_t)shm;
    LAS unsigned* flags = (LAS unsigned*)(shm + LDS_FLAG);
    const unsigned koff = (unsigned)(lane * PITCH + wid * 8) * 2u, voff = (unsigned)((16 * (wid & 3) + (lane >> 2)) * PITCH + (wid >> 2) * 32 + (lane & 3) * 8) * 2u;
    const unsigned kdst = lds0 + LDS_K + wid * 1024, vdst = lds0 + LDS_V + wid * 1024;
#define SB_DMA(p, slot) do { glds16s(Kh + (long)(NT - 1 - (p)) * KVBLK * PITCH, koff, (unsigned)__builtin_amdgcn_readfirstlane(kdst + (slot) * SLOTB)); \
        glds16s(Vh + (long)(NT - 1 - (p)) * KVBLK * PITCH, voff, (unsigned)__builtin_amdgcn_readfirstlane(vdst + (slot) * SLOTB)); } while (0)
    const int vb0 = (int)(lds0 + LDS_V) + ((lane >> 4) & 1) * 32 + (lane & 3) * 8 + (4 * hi + ((lane & 15) >> 2)) * 64;
    const int NT = (q0 + QB) / KVBLK, NB = NT < NBURST ? NT : NBURST;
    for (int p = 0; p < NB; ++p) SB_DMA(p, p);
    bf16x8 qr[4];
#pragma unroll
    for (int d0 = 0; d0 < 4; ++d0) qr[d0] = *(const bf16x8*)(Qw + (long)r32 * PITCH + d0 * 16 + hi * 8);
    f32x16 o[2]; o[0] = f32x16{}; o[1] = f32x16{};
    const int qrel = wid * 32 + r32;
    float R = 0.f;
    bf16x8 TD0, TD1, TONE;
#pragma unroll
    for (int j = 0; j < 8; ++j) { const int kvl = 8 * (j >> 2) + 4 * hi + (j & 3); TD0[j] = (kvl >= r32) ? (short)0x3F80 : (short)0; TD1[j] = (16 + kvl >= r32) ? (short)0x3F80 : (short)0; TONE[j] = (short)0x3F80; }
    if (NB > 4) { SB_WAITBAR(4); } else { SB_WAITBAR(0); }
    bool mid_done = (NB <= 4);
    int p = 3 - (wid >> 1);
    for (; p < NB; ++p) {
        if (p >= 4 && !mid_done) { SB_WAITBAR(0); mid_done = true; }
        sb_tile(shm + LDS_K + p * SLOTB, vb0 + p * SLOTB, qr, TD0, TD1, TONE, 3 - p, qrel, r32, hi, R, o);
        if (__all(R < SB_EXIT)) { ++p; break; }
    }
    if (!mid_done) { SB_WAITBAR(0); }
    { const bool dn = __all(R < SB_EXIT) || (p >= NT); if (lane == 0) flags[wid] = dn ? 1u : 0u; }
    SB_WAITBAR(0);
    bool alldone;
    { const u32x4 fa = *(const LAS u32x4*)flags, fb = *(const LAS u32x4*)(flags + 4); alldone = __builtin_amdgcn_readfirstlane((fa.x & fa.y & fa.z & fa.w & fb.x & fb.y & fb.z & fb.w) != 0u); }
    if (!alldone && NB < NT) {
        SB_DMA(NB, 0);
        for (int i = 0; NB + i < NT; ++i) {
            const int pp = NB + i, sl = i & 1;
            SB_WAITBAR(0);
            if (i > 0) { const LAS unsigned* fl = flags + 8 + ((i - 1) & 1) * 8; const u32x4 fa = *(const LAS u32x4*)fl, fb = *(const LAS u32x4*)(fl + 4);
                if (__builtin_amdgcn_readfirstlane((fa.x & fa.y & fa.z & fa.w & fb.x & fb.y & fb.z & fb.w) != 0u)) break; }
            if (pp + 1 < NT) SB_DMA(pp + 1, sl ^ 1);
            if (!__all(R < SB_EXIT)) sb_tile(shm + LDS_K + sl * SLOTB, vb0 + sl * SLOTB, qr, TD0, TD1, TONE, -1, qrel, r32, hi, R, o);
            { const bool dn = __all(R < SB_EXIT); if (lane == 0) flags[8 + (i & 1) * 8 + wid] = dn ? 1u : 0u; }
        }
        SB_WAITBAR(0);
    }
    bf16_t* Ow = O + (rowbase + q0 + wid * 32) * OPITCH + h * HD;
    { LAS bf16_t* stg = (LAS bf16_t*)(shm + LDS_K) + wid * 2048;
#pragma unroll
      for (int r = 0; r < 16; ++r) { const int orow = crow(r, hi);
#pragma unroll
        for (int d0 = 0; d0 < 2; ++d0) stg[orow * 64 + d0 * 32 + r32] = (bf16_t)(cvt_pk_bf16(o[d0][r], 0.f) & 0xffffu); }
      LDS_WAIT();
#pragma unroll
      for (int i = 0; i < 4; ++i) { const int row = i * 8 + (lane >> 3), ch = lane & 7; const u32x4 v = *(const LAS u32x4*)(stg + row * 64 + ch * 8); *(u32x4*)(Ow + (long)row * OPITCH + ch * 8) = v;
        att::store_row_ssq(v, hs + (rowbase + q0 + wid * 32 + row) * 16, ch); } }
    asm volatile("s_waitcnt vmcnt(0) lgkmcnt(0)\n\ts_barrier" ::: "memory");
#undef SB_DMA
}
#undef SB_WAITBAR
}

#define XB_TMO      128
#define XB_XCNT(j)  (256  + 64 * (j))
#define XB_XSUB(j)  (1280 + 64 * (j))
#define XB_XGEN(j)  (2304 + 64 * (j))
#define XB_TOP      3328
#define XB_TOPGEN   3392
#define XCD_BAR_WORDS 3456
#define XB_SPIN_CAP (1u << 18)
__device__ __forceinline__ unsigned xb_ld(unsigned* p)              { return __hip_atomic_load(p, __ATOMIC_RELAXED, __HIP_MEMORY_SCOPE_AGENT); }
__device__ __forceinline__ unsigned xb_add(unsigned* p, unsigned v) { return __hip_atomic_fetch_add(p, v, __ATOMIC_RELAXED, __HIP_MEMORY_SCOPE_AGENT); }
__device__ __forceinline__ unsigned xb_xcc_id() { return (unsigned)__builtin_amdgcn_s_getreg((3 << 11) | 20) & 0xFu; }
#define XB_SPIN(cond, bar) do { unsigned _sp = 0; while (cond) { __builtin_amdgcn_s_sleep(1); \
    if ((++_sp & 255u) == 0u) { if (xb_ld(&(bar)[XB_TMO])) break; if (_sp > XB_SPIN_CAP) { atomicAdd(&(bar)[XB_TMO], 1u); break; } } } } while (0)
struct XcdBarrier { unsigned* bar; unsigned x; volatile LAS unsigned* st; };
__device__ __forceinline__ XcdBarrier xcd_barrier_post(unsigned* bar, volatile LAS unsigned* st) {
    XcdBarrier b; b.bar = bar; b.x = xb_xcc_id(); b.st = st;
    if (threadIdx.x == 0) (void)xb_add(&bar[XB_XCNT(b.x)], 1u);
    return b;
}
__device__ __forceinline__ void xcd_barrier_complete(unsigned* bar, unsigned x, unsigned& nloc, unsigned& nx) {
    const unsigned G = gridDim.x * gridDim.y * gridDim.z;
    unsigned sum, cnt, mine, sp = 0u;
    for (;;) {
        sum = 0u; cnt = 0u; mine = 0u;
#pragma unroll
        for (unsigned j = 0; j < 16; ++j) { const unsigned c = xb_ld(&bar[XB_XCNT(j)]); sum += c; cnt += (c > 0u) ? 1u : 0u; mine = (j == x) ? c : mine; }
        if (sum == G) break;
        __builtin_amdgcn_s_sleep(1);
        if ((++sp & 255u) == 0u) { if (xb_ld(&bar[XB_TMO])) break; if (sp > XB_SPIN_CAP) { atomicAdd(&bar[XB_TMO], 1u); break; } }
    }
    nloc = mine > 0u ? mine : 1u; nx = cnt > 0u ? cnt : 1u;
}
__device__ __forceinline__ void xcd_barrier(const XcdBarrier& b) {
    asm volatile("s_waitcnt vmcnt(0)" ::: "memory");
    __syncthreads();
    if (threadIdx.x == 0) {
        unsigned* bar = b.bar;
        __builtin_amdgcn_s_waitcnt(0);
        unsigned nloc = b.st[0], nx = b.st[1];
        if (nloc == 0u) { xcd_barrier_complete(bar, b.x, nloc, nx); b.st[0] = nloc; b.st[1] = nx; }
        const unsigned old = xb_add(&bar[XB_XSUB(b.x)], 1u);
        const unsigned gen = old / nloc;
        if (old + 1u == (gen + 1u) * nloc) {
            __builtin_amdgcn_fence(__ATOMIC_RELEASE, "agent");
            asm volatile("s_waitcnt vmcnt(0)" ::: "memory");
            const unsigned og = xb_add(&bar[XB_TOP], 1u);
            const unsigned tg = og / nx;
            if (og + 1u == (tg + 1u) * nx) xb_add(&bar[XB_TOPGEN], 1u);
            else XB_SPIN(xb_ld(&bar[XB_TOPGEN]) == tg, bar);
            __builtin_amdgcn_fence(__ATOMIC_ACQUIRE, "agent");
            xb_add(&bar[XB_XGEN(b.x)], 1u);
            asm volatile("s_waitcnt vmcnt(0)" ::: "memory");
        } else {
            XB_SPIN(xb_ld(&bar[XB_XGEN(b.x)]) == gen, bar);
            __builtin_amdgcn_fence(__ATOMIC_ACQUIRE, "agent");
            asm volatile("s_waitcnt vmcnt(0)" ::: "memory");
        }
    }
    __syncthreads();
}

__device__ __forceinline__ const void* ldp(const volatile LAS unsigned* tab, int i) {
    const unsigned lo = __builtin_amdgcn_readfirstlane(tab[2 * i]), hi = __builtin_amdgcn_readfirstlane(tab[2 * i + 1]);
    return (const void*)(((unsigned long long)hi << 32) | lo);
}
struct Args {
    const float* x; const float* mem; const float* norm_mix; const float* w_in; const float* b_forget; const float* norm_fox; const float* norm_sb; const float* w_out;
    const float* norm_xattn; const float* norm_mem; const float* w_xq; const float* w_xkv; const float* w_xo; const float* norm_ffn;
    const float* w_rg; const float* b_rg; const float* w_re; const float* b_re; const float* w_gate; const float* w_up; const float* w_down; const float* norm_final;
    float* out; unsigned char* ws;
};

__device__ __forceinline__ void transpose_item(const float* W, int ldw, bf16_t* WT, int ldo, int k0, int n0, int dst_row0, const float* gain, LAS float* scr, int lane) {
#pragma unroll 8
    for (int i = 0; i < 32; ++i) { const int kk = 2 * i + (lane >> 5); float v = W[(size_t)(k0 + kk) * ldw + n0 + (lane & 31)]; if (gain) v *= gain[k0 + kk]; scr[kk * 33 + (lane & 31)] = v; }
    LDS_WAIT(); asm volatile("" ::: "memory");
    const int c = lane & 7;
#pragma unroll
    for (int j = 0; j < 4; ++j) { const int n = (lane >> 3) + 8 * j; const LAS float* s = scr + (8 * c) * 33 + n;
        u32x4 o; o.x = cvt_pk_bf16(s[0 * 33], s[1 * 33]); o.y = cvt_pk_bf16(s[2 * 33], s[3 * 33]); o.z = cvt_pk_bf16(s[4 * 33], s[5 * 33]); o.w = cvt_pk_bf16(s[6 * 33], s[7 * 33]);
        *(u32x4*)(WT + (size_t)(dst_row0 + n) * ldo + k0 + 8 * c) = o; }
    LDS_WAIT(); asm volatile("" ::: "memory");
}

struct SchedDense {
    const char* A; const char* Bt; int nM, nN, G, c; size_t a_tile, b_tile, b_batch; int split_tiles;
    __device__ __forceinline__ bool next(int i, pg8::Unit& u) const {
        int pm, pn; if (!pg8::tile_order(i, G, c, nM, nN, pm, pn)) return false;
        u.a = A + (size_t)pm * a_tile; u.b = Bt + (size_t)pn * b_tile + (size_t)(pm >> 5) * b_batch; u.orow = pm * 256;
        if (split_tiles) { u.aux = pn / split_tiles; u.ocol = (pn % split_tiles) * 256; } else { u.aux = 1; u.ocol = pn * 256; }
        u.rows = nullptr; u.nvalid = 256; return true;
    }
};
struct SchedGH {
    const char* KVm; const char* Wxq; const char* Wxo; int G, c;
    __device__ __forceinline__ bool next(int i, pg8::Unit& u) const {
        const int L = i * G + c; if (L >= 256) return false;
        const int kind = L >> 7, r = L & 127, bh = r >> 2, j = r & 3, b = bh >> 2, h = bh & 3;
        if (kind == 0) { u.a = KVm + ((size_t)(b * 256) * 2048 + h * 256) * 2; u.b = Wxq + ((size_t)(256 * j) * 1024 + h * 256) * 2; u.orow = b * 1024 + h * 256; u.ocol = 256 * j; u.aux = 1; }
        else { u.a = Wxo + ((size_t)(256 * j) * 1024 + h * 256) * 2; u.b = KVm + ((size_t)(b * 256) * 2048 + 1024 + h * 256) * 2; u.orow = b * 1024 + 256 * j; u.ocol = h * 256; u.aux = 2; }
        u.rows = nullptr; u.nvalid = 256; return true;
    }
};
template <int KIND> struct SchedGHk { SchedGH s; __device__ __forceinline__ bool next(int i, pg8::Unit& u) const { const int L = i * s.G + s.c; if (L >= 128) return false; SchedGH t = s; t.G = 1; t.c = 0; return t.next(128 * KIND + L, u); } };
struct EpiGH { static constexpr bool HAS_MID = false; bf16_t* GTp; bf16_t* HTp; __device__ __forceinline__ void operator()(const f32x4 (&acc)[2][2][4][2], const pg8::Unit& u, int wr, int wc, int fr, int fq) const {
    pg8::EpiBf16 e{u.aux == 1 ? GTp : HTp, DM, nullptr, 0, 1.f, 1.f, nullptr}; pg8::Unit v = u; v.aux = 1; e(acc, v, wr, wc, fr, fq); } };
struct SchedMoe {
    const char* A; const char* W; const int* list; const LAS int* tbl; int G, c, NPN; size_t w_exp, w_tile, a_tile; int ocol_w;
    __device__ __forceinline__ bool next(int i, pg8::Unit& u) const {
        const int L = i * G + c; const int tl = L / NPN, pn = L % NPN;
        if (tl >= __builtin_amdgcn_readfirstlane(tbl[16])) return false;
        int e = 0;
#pragma unroll 1
        for (int x = 1; x < NEXP; ++x) { if (tl >= __builtin_amdgcn_readfirstlane(tbl[x])) e = x; }
        const int j = tl - __builtin_amdgcn_readfirstlane(tbl[e]), n = __builtin_amdgcn_readfirstlane(tbl[32 + e]) - 256 * j;
        u.a = A + (size_t)tl * a_tile; u.b = W + (size_t)e * w_exp + (size_t)pn * w_tile; u.orow = tl * 256; u.ocol = pn * ocol_w; u.aux = 1;
        u.rows = list + (size_t)e * M + 256 * j; u.nvalid = n < 256 ? n : 256; return true;
    }
};
__device__ __forceinline__ void moe_table(LAS int* tbl, const unsigned* ctl) {
    if (threadIdx.x == 0) { int base = 0; for (int e = 0; e < NEXP; ++e) { const int n = (int)ctl[CW_CNT + 64 * e]; tbl[e] = base; tbl[32 + e] = n; base += (n + 255) >> 8; } tbl[16] = base; }
    __syncthreads();
}

__global__ void __launch_bounds__(NWAVES * 64, 2) hymba_fwd(Args args) {
    extern __shared__ __attribute__((aligned(16))) unsigned char lds_raw[];
    LAS unsigned char* lds = (LAS unsigned char*)lds_raw;
    volatile LAS unsigned* MISC = (volatile LAS unsigned*)(lds + MISC_OFF);
    const int tid0 = threadIdx.x; const int wave = __builtin_amdgcn_readfirstlane(tid0 >> 6);
    const int G = gridDim.x; const int bx = blockIdx.x; const int vcu = (G % 8 == 0) ? (bx % 8) * (G / 8) + bx / 8 : bx;
    volatile LAS unsigned* ATAB = (volatile LAS unsigned*)(lds + MISC_OFF + 512);
    for (int u = tid0; u < 256; u += NWAVES * 64) ((LAS unsigned*)(lds + MISC_OFF))[u] = 0u;
    __syncthreads();
    if (tid0 == 0) { const float* const* ap = (const float* const*)&args;
#pragma unroll
        for (int i = 0; i < 24; ++i) { const unsigned long long v = (unsigned long long)ap[i]; ATAB[2 * i] = (unsigned)v; ATAB[2 * i + 1] = (unsigned)(v >> 32); } }
    __syncthreads();
#define ARGP(name) ((const float*)ldp(ATAB, (int)(offsetof(Args, name) / 8)))
#define PHASE_PTRS \
    int tid = threadIdx.x; asm volatile("" : "+v"(tid)); const int lane = tid & 63; (void)lane; \
    unsigned char* const ws = (unsigned char*)ldp(ATAB, 23); float* const out = (float*)ldp(ATAB, 22); unsigned* const ctl = (unsigned*)(ws + WS_CTL); (void)out; (void)ctl; \
    bf16_t* const Win_t = (bf16_t*)(ws + WS_WIN); bf16_t* const Wout_t = (bf16_t*)(ws + WS_WOUT); bf16_t* const Wxq_n = (bf16_t*)(ws + WS_WXQ); bf16_t* const Wxkv_t = (bf16_t*)(ws + WS_WXKV); \
    bf16_t* const Wxo_t = (bf16_t*)(ws + WS_WXO); bf16_t* const Wgu_t = (bf16_t*)(ws + WS_WGU); bf16_t* const Wd_t = (bf16_t*)(ws + WS_WD); \
    float* const RX = (float*)(ws + WS_RX); float* const RMEM = (float*)(ws + WS_RMEM); float* const LF = (float*)(ws + WS_LF); float* const CC = (float*)(ws + WS_C2); float* const SSQ = (float*)(ws + WS_SSQ); \
    int* const TOKSLOT = (int*)(ws + WS_TOKSLOT); float* const TOKW = (float*)(ws + WS_TOKW); int* const LIST = (int*)(ws + WS_LIST); \
    bf16_t* const MEMB = (bf16_t*)(ws + WS_MEMB); bf16_t* const KVM = (bf16_t*)(ws + WS_KVM); bf16_t* const GT = (bf16_t*)(ws + WS_GT); bf16_t* const HT = (bf16_t*)(ws + WS_HT); \
    bf16_t* const XB = (bf16_t*)(ws + WS_XB); bf16_t* const QKV = (bf16_t*)(ws + WS_QKV); bf16_t* const H1B = (bf16_t*)(ws + WS_H1B); bf16_t* const U2B = (bf16_t*)(ws + WS_U2B); bf16_t* const HID = (bf16_t*)(ws + WS_HID); \
    bf16_t* const OAB = (bf16_t*)(ws + WS_O); bf16_t* const YB = (bf16_t*)(ws + WS_Y); bf16_t* const KX = (bf16_t*)(ws + WS_KX); (void)KX; float* const HS = (float*)(ws + WS_HS); (void)HS; \
    (void)Win_t; (void)Wout_t; (void)Wxq_n; (void)Wxkv_t; (void)Wxo_t; (void)Wgu_t; (void)Wd_t; (void)RX; (void)RMEM; (void)LF; (void)CC; (void)SSQ; (void)TOKSLOT; (void)TOKW; (void)LIST; \
    (void)MEMB; (void)KVM; (void)GT; (void)HT; (void)XB; (void)QKV; (void)H1B; (void)U2B; (void)HID; (void)OAB; (void)YB;
    XcdBarrier bar;
    { unsigned char* const ws0 = (unsigned char*)ldp(ATAB, 23); bar = xcd_barrier_post((unsigned*)(ws0 + WS_CTL) + CW_BAR, MISC + 8); }
    const int gw = vcu * NWAVES + wave, NGW = G * NWAVES;


    if (PH(0))
    for (int rep_ = 0; rep_ < REPS(0); ++rep_)
    {
        PHASE_PTRS
        LAS float* wfT = (LAS float*)(lds + RING_OFF);
        LAS float* scr = (LAS float*)(lds + RING_OFF + 32768 + wave * 8448);
        for (int idx = tid; idx < 8 * DM; idx += NWAVES * 64) { const int j = idx >> 10, k = idx & 1023; wfT[idx] = ARGP(w_in)[(size_t)k * WIN_LD + NPROJ + j] * ARGP(norm_mix)[k]; }
        constexpr int I_IN = 16 * 96, I_OUT = 16 * 32, I_XKV = 16 * 64, I_XO = 16 * 32, I_G = 16 * 16 * 8, I_U = I_G, I_D = 16 * 4 * 32, I_XQ = 1024;
        constexpr int NITEMS = I_IN + I_OUT + I_XKV + I_XO + I_G + I_U + I_D + I_XQ;
        for (int it = gw; it < NITEMS; it += NGW) {
            int r = it;
            if (r < I_IN) { const int kb = r / 96, nb = r % 96; transpose_item(ARGP(w_in), WIN_LD, Win_t, DM, 64 * kb, 32 * nb, 32 * nb, ARGP(norm_mix), scr, lane); continue; } r -= I_IN;
            if (r < I_OUT) { const int kb = r / 32, nb = r % 32; const float* gn = (64 * kb < HW) ? ARGP(norm_fox) : (ARGP(norm_sb) - HW); transpose_item(ARGP(w_out), DM, Wout_t, DM, 64 * kb, 32 * nb, 32 * nb, gn, scr, lane); continue; } r -= I_OUT;
            if (r < I_XKV) { const int kb = r / 64, nb = r % 64; transpose_item(ARGP(w_xkv), 2 * DM, Wxkv_t, DM, 64 * kb, 32 * nb, 32 * nb, ARGP(norm_mem), scr, lane); continue; } r -= I_XKV;
            if (r < I_XO) { const int kb = r / 32, nb = r % 32; transpose_item(ARGP(w_xo), DM, Wxo_t, DM, 64 * kb, 32 * nb, 32 * nb, nullptr, scr, lane); continue; } r -= I_XO;
            if (r < I_G + I_U) { const int up = r >= I_G; const int q = up ? r - I_G : r; const int e = q / 128, kb = (q % 128) / 8, nb = q % 8; const int n0 = 32 * nb;
                const float* W = (up ? ARGP(w_up) : ARGP(w_gate)) + (size_t)e * DM * DFF;
                transpose_item(W, DFF, Wgu_t + (size_t)e * 512 * DM, DM, 64 * kb, n0, 256 * (n0 / 128) + (n0 % 128) + (up ? 128 : 0), nullptr, scr, lane); continue; } r -= I_G + I_U;
            if (r < I_D) { const int e = r / 128, kb = (r % 128) / 32, nb = r % 32; transpose_item(ARGP(w_down) + (size_t)e * DFF * DM, DM, Wd_t + (size_t)e * DM * DFF, DFF, 64 * kb, 32 * nb, 32 * nb, nullptr, scr, lane); continue; } r -= I_D;
            { const int k = r; const float gk = ARGP(norm_xattn)[k]; const f32x4* src = (const f32x4*)(ARGP(w_xq) + (size_t)k * DM) + lane; u32x2* dst = (u32x2*)(Wxq_n + (size_t)k * DM) + lane;
#pragma unroll
              for (int j = 0; j < 4; ++j) { const f32x4 v = src[64 * j] * gk; u32x2 w; w.x = cvt_pk_bf16(v[0], v[1]); w.y = cvt_pk_bf16(v[2], v[3]); dst[64 * j] = w; } }
        }
        __syncthreads();
        for (int row = gw; row < M + MEMROWS; row += NGW) {
            const bool is_mem = row >= M; const int r = is_mem ? row - M : row;
            const f32x4* xr = (const f32x4*)((is_mem ? ARGP(mem) : ARGP(x)) + (size_t)r * DM) + lane;
            f32x4 v[4]; float s = 0.f;
#pragma unroll
            for (int j = 0; j < 4; ++j) { v[j] = xr[64 * j]; s += (v[j][0] * v[j][0] + v[j][1] * v[j][1]) + (v[j][2] * v[j][2] + v[j][3] * v[j][3]); }
            const float rinv = rsqrtf(wave_sum(s) * (1.0f / DM) + EPS);
            u32x2* o8 = (u32x2*)((is_mem ? MEMB : XB) + (size_t)r * DM) + lane;
#pragma unroll
            for (int j = 0; j < 4; ++j) { u32x2 w; w.x = cvt_pk_bf16(v[j][0], v[j][1]); w.y = cvt_pk_bf16(v[j][2], v[j][3]); o8[64 * j] = w; }
            if (is_mem) { if (lane == 0) RMEM[r] = rinv; continue; }
            float f[8];
#pragma unroll
            for (int jj = 0; jj < 8; ++jj) { float a = 0.f;
#pragma unroll
                for (int j = 0; j < 4; ++j) { const f32x4 w4 = *(const LAS f32x4*)(wfT + jj * DM + 256 * j + 4 * lane); a += (v[j][0] * w4[0] + v[j][1] * w4[1]) + (v[j][2] * w4[2] + v[j][3] * w4[3]); }
                f[jj] = wave_sum(a); }
            if (lane == 0) RX[r] = rinv;
            if (lane < 8) { float fl = 0.f;
#pragma unroll
                for (int jj = 0; jj < 8; ++jj) fl = (lane == jj) ? f[jj] : fl;
                fl = fl * rinv + ARGP(b_forget)[lane];
                const float ls = fminf(fl, 0.f) - log1pf(expf(-fabsf(fl)));
                LF[(size_t)r * 8 + lane] = ls * LOG2E; }
        }
    }
    xcd_barrier(bar);

    if (PH(1))
    if (vcu < BATCH) {
        PHASE_PTRS
        const int b = vcu, h = wave; float carry = 0.f;
        const float* src = LF + (size_t)b * SEQ * 8 + h; float* dst = CC + ((size_t)b * NH + h) * SEQ;
        for (int i0 = 0; i0 < SEQ; i0 += 256) {
            float v[4];
#pragma unroll
            for (int k = 0; k < 4; ++k) v[k] = src[(size_t)(i0 + 64 * k + lane) * 8];
#pragma unroll
            for (int k = 0; k < 4; ++k) { float x = v[k];
#pragma unroll
                for (int o = 1; o < 64; o <<= 1) { const float y = __shfl_up(x, o); if (lane >= o) x += y; }
                x += carry; dst[i0 + 64 * k + lane] = x; carry = __shfl(x, 63);
                { unsigned hm, lo; fox::split3(-x, hm, lo); u32x4 w; w.x = 0x3F803F80u; w.y = 0x3F80u | (hm << 16); w.z = (hm >> 16) | (lo << 16); w.w = 0u;
                  *(u32x4*)(KX + (((size_t)b * NH + h) * SEQ + i0 + 64 * k + lane) * 8) = w; } }
        }
    }
    if (PH(1))
    for (int rep_ = 0; rep_ < REPS(1); ++rep_)
    {
        PHASE_PTRS
        pg8::Gemm g{DM, DM, DM};
        SchedDense S{(const char*)XB, (const char*)Win_t, M / 256, NPROJ / 256, G, bx, (size_t)256 * DM * 2, (size_t)256 * DM * 2, 0, 2};
        pg8::EpiBf16 E{QKV, HW, RX, QKV_STRIDE, C2, C2, ctl + CW_KN};
        pg8::gemm_phase<pg8::EpiBf16, SchedDense, true, false>(lds + RING_OFF, g, S, E);
        SchedDense S2{(const char*)MEMB, (const char*)Wxkv_t, MEMROWS / 256, 2 * DM / 256, G, bx, (size_t)256 * DM * 2, (size_t)256 * DM * 2, 0, 0};
        pg8::EpiBf16 E2{KVM, 2 * DM, RMEM, 0, 1.f, 1.f, nullptr};
        pg8::gemm_phase<pg8::EpiBf16, SchedDense, true, false>(lds + RING_OFF, g, S2, E2);
    }
    xcd_barrier(bar);

    if (PH(2))
    {
        PHASE_PTRS
        const bf16_t* QA = QKV; const bf16_t* KA = QKV + QKV_STRIDE; const bf16_t* VA = QKV + 2 * QKV_STRIDE;
        const bf16_t* QBp = QKV + 3 * QKV_STRIDE; const bf16_t* KBp = QKV + 4 * QKV_STRIDE; const bf16_t* VBp = QKV + 5 * QKV_STRIDE;
        bf16_t* OA = OAB; bf16_t* OB = OAB + HW;
        LAS char* shm = (LAS char*)(lds + RING_OFF);
        for (int rep = 0; rep < REP_FOX; ++rep)
        for (int i = 0; i < 8; ++i) { const int bh = (vcu >> 5) * 8 + i, x = vcu & 31, qb = (i & 1) ? 31 - x : x;
            const float kmax = sqrtf(__uint_as_float(ctl[CW_KN + bh * 2]) + __uint_as_float(ctl[CW_KN + bh * 2 + 1])) * 1.01f;
            fox::fox_unit<8>(bh, qb, QA, KA, VA, OA, HS + (bh & 7), CC + (size_t)bh * SEQ, KX + (size_t)bh * SEQ * 8, kmax, shm); }
        for (int rep = 0; rep < REP_SB; ++rep)
        for (int i = 0; i < 8; ++i) { const int bh = vcu >> 2, qb = 8 * (vcu & 3) + i;
            sbk::sb_unit(bh >> 3, bh & 7, qb, QBp, KBp, VBp, OB, HS + 8 + (bh & 7), shm); }
        VM_WAIT(); __syncthreads();
        pg8::Gemm g{0, 0, 256};
        SchedGH S{(const char*)KVM, (const char*)Wxq_n, (const char*)Wxo_t, G, bx};
        EpiGH E{GT, HT};
        g.lda = 2 * DM; g.ldb = DM; SchedGHk<0> S0{S}; pg8::gemm_phase<EpiGH, SchedGHk<0>, true, false>(lds + RING_OFF, g, S0, E);
        g.lda = DM; g.ldb = 2 * DM; SchedGHk<1> S1{S}; pg8::gemm_phase<EpiGH, SchedGHk<1>, true, false>(lds + RING_OFF, g, S1, E);
    }
    xcd_barrier(bar);

    if (PH(4))
    for (int rep_ = 0; rep_ < REPS(4); ++rep_)
    {
        PHASE_PTRS
        pg8::Gemm g{DM, DM, DM};
        SchedDense S{(const char*)OAB, (const char*)Wout_t, M / 256, DM / 256, G, bx, (size_t)256 * DM * 2, (size_t)256 * DM * 2, 0, 0};
        pg8::EpiOutProj E{XB, H1B, SSQ, HS};
        pg8::gemm_phase<pg8::EpiOutProj, SchedDense, true, false>(lds + RING_OFF, g, S, E);
    }
    xcd_barrier(bar);

    if (PH(5))
    for (int rep_ = 0; rep_ < REPS(5); ++rep_)
    {
        PHASE_PTRS
        pg8::Gemm g{DM, DM, DM};
        SchedDense S{(const char*)H1B, (const char*)GT, M / 256, DM / 256, G, bx, (size_t)256 * DM * 2, (size_t)256 * DM * 2, (size_t)DM * DM * 2, 0};
        pg8::EpiSoftmax E{XB, SSQ, (LAS float*)(lds + EXTRA_OFF)};
        pg8::gemm_phase<pg8::EpiSoftmax, SchedDense, true, false>(lds + RING_OFF, g, S, E);
    }
    xcd_barrier(bar);

    if (PH(6))
    {
        PHASE_PTRS
        pg8::Gemm g{DM, DM, DM};
        SchedDense S{(const char*)XB, (const char*)HT, M / 256, DM / 256, G, bx, (size_t)256 * DM * 2, (size_t)256 * DM * 2, (size_t)DM * DM * 2, 0};
        pg8::EpiResidBf16 E{H1B};
        pg8::gemm_phase<pg8::EpiResidBf16, SchedDense, true, false>(lds + RING_OFF, g, S, E);
    }
    xcd_barrier(bar);

    if (PH(7))
    {
        PHASE_PTRS
        LAS float* wT = (LAS float*)(lds + RING_OFF);
        for (int idx = tid; idx < 20 * DM; idx += NWAVES * 64) { const int j = idx >> 10, k = idx & 1023; wT[idx] = (j < 4) ? ARGP(w_rg)[(size_t)k * 4 + j] : ARGP(w_re)[(size_t)k * 16 + (j - 4)]; }
        __syncthreads();
        for (int row = gw; row < M; row += NGW) {
            const u32x2* hr = (const u32x2*)(H1B + (size_t)row * DM) + lane; const f32x4* gp = (const f32x4*)ARGP(norm_ffn) + lane;
            f32x4 v[4]; float s = 0.f;
#pragma unroll
            for (int j = 0; j < 4; ++j) { const u32x2 hh = hr[64 * j]; v[j] = (f32x4){bf16lo(hh.x), bf16hi(hh.x), bf16lo(hh.y), bf16hi(hh.y)}; s += (v[j][0] * v[j][0] + v[j][1] * v[j][1]) + (v[j][2] * v[j][2] + v[j][3] * v[j][3]); }
            const float rinv = rsqrtf(wave_sum(s) * (1.0f / DM) + EPS);
            u32x2* o8 = (u32x2*)(U2B + (size_t)row * DM) + lane;
#pragma unroll
            for (int j = 0; j < 4; ++j) { v[j] = v[j] * rinv * gp[64 * j]; u32x2 w; w.x = cvt_pk_bf16(v[j][0], v[j][1]); w.y = cvt_pk_bf16(v[j][2], v[j][3]); o8[64 * j] = w; }
            float lg[20];
#pragma unroll
            for (int jj = 0; jj < 20; ++jj) { float a = 0.f;
#pragma unroll
                for (int j = 0; j < 4; ++j) { const f32x4 w4 = *(const LAS f32x4*)(wT + jj * DM + 256 * j + 4 * lane); a += (v[j][0] * w4[0] + v[j][1] * w4[1]) + (v[j][2] * w4[2] + v[j][3] * w4[3]); }
                lg[jj] = wave_sum(a); asm volatile("" : "+v"(lg[jj]) :: "memory"); }
            float g0 = lg[0] + ARGP(b_rg)[0], g1 = lg[1] + ARGP(b_rg)[1], g2 = lg[2] + ARGP(b_rg)[2], g3 = lg[3] + ARGP(b_rg)[3];
            int gi = 0; float gm = g0; if (g1 > gm) { gm = g1; gi = 1; } if (g2 > gm) { gm = g2; gi = 2; } if (g3 > gm) { gm = g3; gi = 3; }
            const float gval = 1.0f / (expf(g0 - gm) + expf(g1 - gm) + expf(g2 - gm) + expf(g3 - gm));
            float el[4];
#pragma unroll
            for (int j = 0; j < 4; ++j) { const float e0 = lg[4 + j], e1 = lg[8 + j], e2 = lg[12 + j], e3 = lg[16 + j]; el[j] = ((gi == 0) ? e0 : (gi == 1) ? e1 : (gi == 2) ? e2 : e3) + ARGP(b_re)[gi * 4 + j]; }
            int i0 = 0; float m0 = el[0];
#pragma unroll
            for (int j = 1; j < 4; ++j) if (el[j] > m0) { m0 = el[j]; i0 = j; }
            int i1 = -1; float m1 = -3.0e38f;
#pragma unroll
            for (int j = 0; j < 4; ++j) if (j != i0 && el[j] > m1) { m1 = el[j]; i1 = j; }
            const float w0 = 1.0f / (1.0f + expf(m1 - m0)), w1 = 1.0f - w0;
            if (lane < 2) { const int e = gi * 4 + (lane == 0 ? i0 : i1); const float w = gval * (lane == 0 ? w0 : w1);
                const int pos = (int)__hip_atomic_fetch_add(ctl + CW_CNT + 64 * e, 1u, __ATOMIC_RELAXED, __HIP_MEMORY_SCOPE_AGENT);
                LIST[(size_t)e * M + pos] = row; TOKSLOT[(size_t)row * 2 + lane] = (e << 20) | pos; TOKW[(size_t)row * 2 + lane] = w; }
        }
    }
    xcd_barrier(bar);

    if (PH(8))
    for (int rep_ = 0; rep_ < REPS(8); ++rep_)
    {
        PHASE_PTRS
        pg8::Gemm g{DM, DM, DM};
        LAS int* tbl = (LAS int*)(lds + EXTRA_OFF + 8192); moe_table(tbl, ctl);
        SchedMoe S; S.A = (const char*)U2B; S.W = (const char*)Wgu_t; S.list = LIST; S.tbl = tbl; S.G = G; S.c = bx; S.NPN = 2; S.w_exp = (size_t)512 * DM * 2; S.w_tile = (size_t)256 * DM * 2; S.a_tile = 0; S.ocol_w = 128;
        pg8::EpiSwiglu E{HID};
        pg8::gemm_phase<pg8::EpiSwiglu, SchedMoe, true, true>(lds + RING_OFF, g, S, E);
    }
    xcd_barrier(bar);

    if (PH(9))
    for (int rep_ = 0; rep_ < REPS(9); ++rep_)
    {
        PHASE_PTRS
        pg8::Gemm g{DFF, DFF, DFF};
        LAS int* tbl = (LAS int*)(lds + EXTRA_OFF + 8192);
        SchedMoe S; S.A = (const char*)HID; S.W = (const char*)Wd_t; S.list = LIST; S.tbl = tbl; S.G = G; S.c = bx; S.NPN = 4; S.w_exp = (size_t)DM * DFF * 2; S.w_tile = (size_t)256 * DFF * 2; S.a_tile = (size_t)256 * DFF * 2; S.ocol_w = 256;
        pg8::EpiBf16 E{YB, DM, nullptr, 0, 1.f, 1.f, nullptr};
        pg8::gemm_phase<pg8::EpiBf16, SchedMoe, true, false>(lds + RING_OFF, g, S, E);
    }
    xcd_barrier(bar);

    if (PH(10))
    {
        PHASE_PTRS
        const LAS int* tb = (const LAS int*)(lds + EXTRA_OFF + 8192);
        for (int row = gw; row < M; row += NGW) {
            const int s0 = TOKSLOT[(size_t)row * 2], s1 = TOKSLOT[(size_t)row * 2 + 1]; const float w0 = TOKW[(size_t)row * 2], w1 = TOKW[(size_t)row * 2 + 1];
            const int r0 = tb[s0 >> 20] * 256 + (s0 & 0xfffff), r1 = tb[s1 >> 20] * 256 + (s1 & 0xfffff);
            f32x4* hr = (f32x4*)(out + (size_t)row * DM) + lane; const u32x2* h2r = (const u32x2*)(H1B + (size_t)row * DM) + lane; const u32x2* y0 = (const u32x2*)(YB + (size_t)r0 * DM) + lane; const u32x2* y1 = (const u32x2*)(YB + (size_t)r1 * DM) + lane;
            const f32x4* gp = (const f32x4*)ARGP(norm_final) + lane;
            f32x4 v[4]; float s = 0.f;
#pragma unroll
            for (int j = 0; j < 4; ++j) { const u32x2 a = y0[64 * j], b = y1[64 * j]; const u32x2 hh = h2r[64 * j]; f32x4 h = {bf16lo(hh.x), bf16hi(hh.x), bf16lo(hh.y), bf16hi(hh.y)};
                h[0] += w0 * bf16lo(a.x) + w1 * bf16lo(b.x); h[1] += w0 * bf16hi(a.x) + w1 * bf16hi(b.x); h[2] += w0 * bf16lo(a.y) + w1 * bf16lo(b.y); h[3] += w0 * bf16hi(a.y) + w1 * bf16hi(b.y);
                v[j] = h; s += (h[0] * h[0] + h[1] * h[1]) + (h[2] * h[2] + h[3] * h[3]); }
            const float rinv = rsqrtf(wave_sum(s) * (1.0f / DM) + EPS);
#pragma unroll
            for (int j = 0; j < 4; ++j) hr[64 * j] = v[j] * rinv * gp[64 * j];
        }
    }
}

extern "C" void kernel_launch(void* const* d_in, const int* in_sizes, int n_in, void* d_out, int out_size, void* d_ws, size_t ws_size, hipStream_t stream) {
    static int grid = 0;
    if (grid == 0) {
        if (n_in != 22 || in_sizes[0] != M * DM || out_size != M * DM || ws_size < WS_END) { fprintf(stderr, "kernel_launch: unexpected shapes (n_in %d, in0 %d, out %d, ws %zu)\n", n_in, n_in > 0 ? in_sizes[0] : -1, out_size, ws_size); grid = -1; return; }
        int dev = 0, cus = 0, per_cu = 0;
        if (hipGetDevice(&dev) != hipSuccess || hipDeviceGetAttribute(&cus, hipDeviceAttributeMultiprocessorCount, dev) != hipSuccess) { grid = -1; return; }
        if (hipFuncSetAttribute((const void*)hymba_fwd, hipFuncAttributeMaxDynamicSharedMemorySize, LDS_BYTES) != hipSuccess) { fprintf(stderr, "kernel_launch: hipFuncSetAttribute failed\n"); grid = -1; return; }
        if (hipOccupancyMaxActiveBlocksPerMultiprocessor(&per_cu, (const void*)hymba_fwd, NWAVES * 64, LDS_BYTES) != hipSuccess || per_cu < 1) { fprintf(stderr, "kernel_launch: occupancy query reports %d\n", per_cu); }
        (void)hipGetLastError();
        grid = cus;
    }
    if (grid < 0) return;
    (void)hipMemsetAsync((char*)d_ws + WS_CTL, 0, CTL_ZERO_BYTES, stream);
    Args a{};
    const float** p = (const float**)&a;
    for (int i = 0; i < 22; ++i) p[i] = (const float*)d_in[i];
    a.out = (float*)d_out; a.ws = (unsigned char*)d_ws;
    hipLaunchKernelGGL(hymba_fwd, dim3(grid), dim3(NWAVES * 64), LDS_BYTES, stream, a);
}
```

```cpp
#include <hip/hip_runtime.h>
#include <hip/hip_bf16.h>
#include <cstdio>
#include <cstdint>

#define LAS __attribute__((address_space(3)))
#define GAS __attribute__((address_space(1)))
typedef unsigned short bf16_t;
typedef short bf16x8 __attribute__((ext_vector_type(8)));
typedef short s16x4 __attribute__((ext_vector_type(4)));
typedef float f32x4 __attribute__((ext_vector_type(4)));
typedef float f32x2 __attribute__((ext_vector_type(2)));
typedef float f32x16 __attribute__((ext_vector_type(16)));
typedef unsigned u32x4 __attribute__((ext_vector_type(4)));
typedef unsigned u32x2 __attribute__((ext_vector_type(2)));
typedef __bf16 bf16x2_t __attribute__((ext_vector_type(2)));

constexpr int BATCH = 8, SEQ = 8192, DM = 1024, M = BATCH * SEQ;
constexpr int NH = 8, HD = 64, HW = NH * HD;
constexpr int NPROJ = 3 * HW * 2;
constexpr int WIN_LD = NPROJ + NH;
constexpr int NMEM = 256, XH = 4, XD = 256, MEMROWS = BATCH * NMEM;
constexpr int NEXP = 16, DFF = 256;
constexpr float EPS = 1e-6f;
constexpr float LOG2E = 1.4426950408889634f;
constexpr float C2 = 0.125f * LOG2E;
constexpr float XSC = 0.0625f * LOG2E;
constexpr float SB_EXIT = -64.0f;

constexpr size_t MiB = 1u << 20;
constexpr size_t WS_CTL = 0, CTL_ZERO_BYTES = 1 * MiB;
constexpr size_t WS_WIN = 1 * MiB;
constexpr size_t WS_WOUT = 7 * MiB;
constexpr size_t WS_WXQ = 9 * MiB;
constexpr size_t WS_WXKV = 11 * MiB;
constexpr size_t WS_WXO = 15 * MiB;
constexpr size_t WS_WGU = 17 * MiB;
constexpr size_t WS_WD = 33 * MiB;
constexpr size_t WS_RX = 41 * MiB;
constexpr size_t WS_RMEM = WS_RX + 256 * 1024;
constexpr size_t WS_LF = 42 * MiB;
constexpr size_t WS_C2 = 44 * MiB;
constexpr size_t WS_SSQ = 46 * MiB;
constexpr size_t WS_TOKSLOT = 50 * MiB;
constexpr size_t WS_TOKW = 51 * MiB;
constexpr size_t WS_LIST = 52 * MiB;
constexpr size_t WS_MEMB = 56 * MiB;
constexpr size_t WS_KVM = 60 * MiB;
constexpr size_t WS_GT = 68 * MiB;
constexpr size_t WS_HT = 84 * MiB;
constexpr size_t WS_KX = 100 * MiB;
constexpr size_t WS_HS = 108 * MiB;
constexpr size_t WS_XB = 128 * MiB;
constexpr size_t WS_QKV = 256 * MiB;
constexpr size_t WS_H1B = 256 * MiB, WS_U2B = 384 * MiB, WS_HID = 512 * MiB;
constexpr size_t WS_O = 640 * MiB;
constexpr size_t WS_Y = 704 * MiB;
constexpr size_t WS_END = 1024 * MiB;
constexpr size_t QKV_STRIDE = (size_t)M * HW;
constexpr int MAXTILES = M * 2 / 256 + NEXP;
static_assert(WS_Y + (size_t)MAXTILES * 256 * 1024 * 2 <= WS_END, "ws map");
static_assert(WS_HID + (size_t)MAXTILES * 256 * 256 * 2 <= WS_O, "ws map");
constexpr int CW_BAR = 4096;
constexpr int CW_KN = 20480;
constexpr int CW_CNT = 16384;

constexpr int RING_OFF = 0, RING_BYTES = 131072;
constexpr int EXTRA_OFF = 131072, EXTRA_BYTES = 16384;
constexpr int MISC_OFF = EXTRA_OFF + EXTRA_BYTES;
constexpr int LDS_BYTES = MISC_OFF + 1024;
constexpr int NWAVES = 8;
#ifndef PHASE_MASK
#define PHASE_MASK 0x7ff
#endif
#define PH(n) ((PHASE_MASK >> (n)) & 1)
#ifndef FOX_V2
#define FOX_V2 1
#endif
#ifndef REP_MASK
#define REP_MASK 0
#endif
#define REPS(n) (1 + ((REP_MASK >> (n)) & 1))
#ifndef REP_FOX
#define REP_FOX 1
#endif
#ifndef REP_SB
#define REP_SB 1
#endif

__device__ __forceinline__ unsigned cvt_pk_bf16(float lo, float hi) { f32x2 v = {lo, hi}; bf16x2_t b = __builtin_convertvector(v, bf16x2_t); return __builtin_bit_cast(unsigned, b); }
__device__ __forceinline__ float bf16lo(unsigned u) { return __uint_as_float(u << 16); }
__device__ __forceinline__ float bf16hi(unsigned u) { return __uint_as_float(u & 0xffff0000u); }
__device__ __forceinline__ float wave_sum(float v) {
#pragma unroll
    for (int o = 1; o < 64; o <<= 1) v += __shfl_xor(v, o);
    return v;
}
#define LDS_WAIT() asm volatile("s_waitcnt lgkmcnt(0)" ::: "memory")
#define VM_WAIT() asm volatile("s_waitcnt vmcnt(0)" ::: "memory")

namespace pg8 {
constexpr int BM = 256, BK = 64, HALF = 128, HTB = HALF * BK * 2, STAGE_BYTES = 8 * HTB, NXCD = 8, WGM = 8;
__host__ __device__ __forceinline__ int lds_byte(int r, int c) { const int st = (r >> 4) * 2 + (c >> 5), rr = r & 15, cc = c & 31, ob = rr * 64 + cc * 2; return st * 1024 + (ob ^ (((ob >> 9) & 1) << 5)); }
__host__ __device__ __forceinline__ void stage_rc(int b, int& R, int& C) { const int st = b / 1024, sb = b % 1024, swz = sb ^ (((sb >> 9) & 1) << 5); R = (st >> 1) * 16 + swz / 64; C = (st & 1) * 32 + (swz % 64) / 2; }
__host__ __device__ __forceinline__ int perm32(int rho) { const int n = rho >> 4, i = rho & 15; return 8 * (i >> 2) + 4 * n + (i & 3); }

struct Unit { const char* a; const char* b; int orow, ocol, aux; const int* rows; int nvalid; };
struct Gemm { int lda, ldb, K; };

__device__ __forceinline__ bool tile_order(int i, int G, int c, int nM, int nN, int& pm, int& pn) {
    const int nwg = nM * nN; const long L = (long)i * G + c; if (L >= nwg) return false;
    int wgid = (int)L; { const int q = nwg / NXCD, r = nwg % NXCD, xcd = wgid % NXCD, off = wgid / NXCD; wgid = (xcd < r ? xcd * (q + 1) : r * (q + 1) + (xcd - r) * q) + off; }
    const int nig = WGM * nN, gid = wgid / nig, fm = gid * WGM, gsz = (nM - fm) < WGM ? (nM - fm) : WGM;
    pm = fm + ((wgid % nig) % gsz); pn = (wgid % nig) / gsz; return true;
}

template <class Epi, class Sched, bool ALIGN_EPI, bool GATHER>
__device__ __forceinline__ void gemm_phase(LAS unsigned char* lds, const Gemm g, const Sched& S, const Epi& E) {
    int tid = threadIdx.x; asm volatile("" : "+v"(tid));
    const int wid = __builtin_amdgcn_readfirstlane(tid >> 6), lane = tid & 63, wr = wid >> 2, wc = wid & 3, fr = lane & 15, fq = lane >> 4;
    const int K = g.K, nt = K / BK;
    unsigned voffA[2], voffB[2]; int RA[2], CA[2];
#pragma unroll
    for (int i = 0; i < 2; ++i) { int R, C; stage_rc(tid * 16 + i * 8192, R, C); const int Rb = (R & ~31) + perm32(R & 31);
        RA[i] = R; CA[i] = C; voffA[i] = (unsigned)(R * g.lda + C) * 2u; voffB[i] = (unsigned)(Rb * g.ldb + C) * 2u; }
    const size_t kstep = (size_t)(BK * 2);
    const size_t hstepA = (size_t)HALF * g.lda * 2, hstepB = (size_t)HALF * g.ldb * 2;
    const unsigned ldsw = (unsigned)wid * 1024u;
    const int aoff = lds_byte(wr * 64 + fr, fq * 8), boff = lds_byte(wc * 32 + fr, fq * 8);
#define PG8_SA(b, h) (((b) * 2 + (h)) * HTB)
#define PG8_SB(b, h) ((4 + (b) * 2 + (h)) * HTB)
#define PG8_STAGE2(bufoff, gbase, v0, v1) do { \
        __builtin_amdgcn_global_load_lds((const unsigned*)((const char*)(gbase) + (v0)), (LAS unsigned*)(lds + (bufoff) + ldsw), 16, 0, 0); \
        __builtin_amdgcn_global_load_lds((const unsigned*)((const char*)(gbase) + (v1)), (LAS unsigned*)(lds + (bufoff) + ldsw + 8192), 16, 0, 0); } while (0)
#define PG8_STAGEB(bufoff, gbase) PG8_STAGE2(bufoff, gbase, voffB[0], voffB[1])
#define PG8_STAGEA(bufoff, kptr, h, NX) do { if constexpr (GATHER) { const unsigned v0_ = (NX) ? gvn[h][0] : gvc[h][0], v1_ = (NX) ? gvn[h][1] : gvc[h][1]; PG8_STAGE2(bufoff, kptr, v0_, v1_); } \
        else { PG8_STAGE2(bufoff, (kptr) + (h) * hstepA, voffA[0], voffA[1]); } } while (0)
#define PG8_LDA(dst, b, h) do { _Pragma("unroll") for (int m = 0; m < 4; ++m) _Pragma("unroll") for (int k = 0; k < 2; ++k) dst[m][k] = *(const LAS bf16x8*)(lds + PG8_SA(b, h) + aoff + m * 2048 + k * 1024); } while (0)
#define PG8_LDB(dst, b, h) do { _Pragma("unroll") for (int n = 0; n < 2; ++n) _Pragma("unroll") for (int k = 0; k < 2; ++k) dst[n][k] = *(const LAS bf16x8*)(lds + PG8_SB(b, h) + boff + n * 2048 + k * 1024); } while (0)
#define PG8_MMA(ai, bj, At, Bt) do { __builtin_amdgcn_s_setprio(1); _Pragma("unroll") for (int m = 0; m < 4; ++m) _Pragma("unroll") for (int n = 0; n < 2; ++n) _Pragma("unroll") for (int k = 0; k < 2; ++k) \
        acc[ai][bj][m][n] = __builtin_amdgcn_mfma_f32_16x16x32_bf16(Bt[n][k], At[m][k], acc[ai][bj][m][n], 0, 0, 0); __builtin_amdgcn_s_setprio(0); } while (0)
#define PG8_WAIT_V(n) asm volatile("s_waitcnt vmcnt(" #n ")" ::: "memory")
#define PG8_WAIT_L(n) asm volatile("s_waitcnt lgkmcnt(" #n ")" ::: "memory")
#define PG8_BAR __builtin_amdgcn_s_barrier()
#define PG8_SCHED __builtin_amdgcn_sched_barrier(0)
#define PG8_GATHER_OFFS(dst, u) do { _Pragma("unroll") for (int h_ = 0; h_ < 2; ++h_) _Pragma("unroll") for (int i_ = 0; i_ < 2; ++i_) { const int r_ = h_ * HALF + RA[i_]; \
        const int idx_ = (u).rows[r_ < (u).nvalid ? r_ : 0]; dst[h_][i_] = (unsigned)(idx_ * g.lda + CA[i_]) * 2u; } } while (0)
    Unit cur, nxt; int ui = 0;
    if (!S.next(0, cur)) return;
    unsigned gvc[2][2] = {{0u, 0u}, {0u, 0u}}, gvn[2][2] = {{0u, 0u}, {0u, 0u}};
    if constexpr (GATHER) { PG8_GATHER_OFFS(gvc, cur); }
    f32x4 acc[2][2][4][2];
#pragma unroll
    for (int a = 0; a < 2; ++a)
#pragma unroll
        for (int b = 0; b < 2; ++b)
#pragma unroll
            for (int m = 0; m < 4; ++m)
#pragma unroll
                for (int n = 0; n < 2; ++n) acc[a][b][m][n] = (f32x4){0.f, 0.f, 0.f, 0.f};
    bf16x8 At[4][2], B0[2][2], B1[2][2];
    const char* cA = cur.a; const char* cB = cur.b;
    PG8_STAGEB(PG8_SB(0, 0), cB); PG8_STAGEB(PG8_SB(0, 1), cB + hstepB); PG8_STAGEA(PG8_SA(0, 0), cA, 0, false); PG8_STAGEA(PG8_SA(0, 1), cA, 1, false);
    if (wr == 1) PG8_BAR;
    PG8_WAIT_V(2); PG8_BAR;
    PG8_STAGEB(PG8_SB(1, 0), cB + kstep); PG8_STAGEA(PG8_SA(1, 0), cA + kstep, 0, false); PG8_STAGEB(PG8_SB(1, 1), cB + hstepB + kstep);
    PG8_WAIT_V(6); PG8_BAR;
    for (;;) {
        const bool has_next = S.next(ui + 1, nxt);
        const char* nA = has_next ? nxt.a : cA; const char* nB = has_next ? nxt.b : cB;
        if constexpr (GATHER) { if (has_next) { PG8_GATHER_OFFS(gvn, nxt); } else { gvn[0][0] = gvc[0][0]; gvn[0][1] = gvc[0][1]; gvn[1][0] = gvc[1][0]; gvn[1][1] = gvc[1][1]; } }
#pragma unroll 1
        for (int t = 0; t < nt; t += 2) {
            const bool last = (t == nt - 2);
            const char* a1 = cA + (size_t)(t + 1) * kstep;
            const char* a2 = last ? nA : cA + (size_t)(t + 2) * kstep; const char* b2 = last ? nB : cB + (size_t)(t + 2) * kstep;
            const char* a3 = a2 + kstep; const char* b3 = b2 + kstep;
            PG8_LDB(B0, 0, 0); PG8_LDB(B1, 0, 1); PG8_SCHED; PG8_LDA(At, 0, 0); PG8_STAGEA(PG8_SA(1, 1), a1, 1, false);
            PG8_WAIT_V(8); PG8_WAIT_L(0); PG8_BAR; PG8_MMA(0, 0, At, B0); PG8_MMA(0, 1, At, B1); PG8_BAR; PG8_SCHED;
            PG8_LDA(At, 0, 1); PG8_STAGEB(PG8_SB(0, 0), b2); PG8_STAGEB(PG8_SB(0, 1), b2 + hstepB); PG8_STAGEA(PG8_SA(0, 0), a2, 0, last);
            PG8_WAIT_V(8); PG8_WAIT_L(0); PG8_BAR; PG8_MMA(1, 0, At, B0); PG8_MMA(1, 1, At, B1); PG8_BAR; PG8_SCHED;
            PG8_LDB(B0, 1, 0); PG8_LDB(B1, 1, 1); PG8_SCHED; PG8_LDA(At, 1, 0); PG8_STAGEA(PG8_SA(0, 1), a2, 1, last);
            PG8_WAIT_V(8); PG8_WAIT_L(0); PG8_BAR; PG8_MMA(0, 0, At, B0); PG8_MMA(0, 1, At, B1); PG8_BAR; PG8_SCHED;
            PG8_LDA(At, 1, 1); PG8_STAGEB(PG8_SB(1, 0), b3); PG8_STAGEB(PG8_SB(1, 1), b3 + hstepB); PG8_STAGEA(PG8_SA(1, 0), a3, 0, last);
            PG8_WAIT_V(8); PG8_WAIT_L(0); PG8_BAR; PG8_MMA(1, 0, At, B0); PG8_MMA(1, 1, At, B1); PG8_BAR; PG8_SCHED;
            if constexpr (Epi::HAS_MID) { if (t == (nt >> 1) - 2) { int fr3 = fr, fq3 = fq; asm volatile("" : "+v"(fr3), "+v"(fq3)); E.mid(acc, cur, wr, wc, fr3, fq3); } }
        }
        if constexpr (ALIGN_EPI) { if (wr == 0) PG8_BAR; }
        { int fr2 = fr, fq2 = fq; asm volatile("" : "+v"(fr2), "+v"(fq2));
          E(acc, cur, wr, wc, fr2, fq2); }
        if (!has_next) break;
#pragma unroll
        for (int a = 0; a < 2; ++a)
#pragma unroll
            for (int b = 0; b < 2; ++b)
#pragma unroll
                for (int m = 0; m < 4; ++m)
#pragma unroll
                    for (int n = 0; n < 2; ++n) acc[a][b][m][n] = (f32x4){0.f, 0.f, 0.f, 0.f};
        cur = nxt; cA = nA; cB = nB; ++ui;
        if constexpr (GATHER) { gvc[0][0] = gvn[0][0]; gvc[0][1] = gvn[0][1]; gvc[1][0] = gvn[1][0]; gvc[1][1] = gvn[1][1]; }
        if constexpr (ALIGN_EPI) { if (wr == 1) PG8_BAR; }
    }
    PG8_WAIT_V(0);
    if constexpr (!ALIGN_EPI) { if (wr == 0) PG8_BAR; }
    PG8_BAR;
#undef PG8_SA
#undef PG8_SB
#undef PG8_STAGE2
#undef PG8_STAGEA
#undef PG8_STAGEB
#undef PG8_LDA
#undef PG8_LDB
#undef PG8_MMA
#undef PG8_WAIT_V
#undef PG8_WAIT_L
#undef PG8_BAR
#undef PG8_SCHED
#undef PG8_GATHER_OFFS
}

#define EPI_ROW(u, ai, m) ((u).orow + (ai) * HALF + wr * 64 + (m) * 16 + fr)
#define EPI_COL(u, bj) ((u).ocol + (bj) * HALF + wc * 32 + 8 * fq)
struct EpiBf16 {
    static constexpr bool HAS_MID = false;
    bf16_t* O; int ldc; const float* rs; size_t stride; float sc0, sc3;
    unsigned* kn;
    __device__ __forceinline__ void operator()(const f32x4 (&acc)[2][2][4][2], const Unit& u, int wr, int wc, int fr, int fq) const {
        bf16_t* base = O + (size_t)u.aux * stride;
        const float sc = (u.aux == 0) ? sc0 : ((u.aux == 3) ? sc3 : 1.f);
        float nmax[2] = {0.f, 0.f}; const bool dokn = kn && u.aux == 1;
#pragma unroll
        for (int ai = 0; ai < 2; ++ai)
#pragma unroll
            for (int m = 0; m < 4; ++m) { const int row = EPI_ROW(u, ai, m); const float s = (rs ? rs[row] : 1.f) * sc;
#pragma unroll
                for (int bj = 0; bj < 2; ++bj) { const f32x4 v0 = acc[ai][bj][m][0] * s, v1 = acc[ai][bj][m][1] * s;
                    u32x4 w; w.x = cvt_pk_bf16(v0[0], v0[1]); w.y = cvt_pk_bf16(v0[2], v0[3]); w.z = cvt_pk_bf16(v1[0], v1[1]); w.w = cvt_pk_bf16(v1[2], v1[3]);
                    *(u32x4*)(base + (size_t)row * ldc + EPI_COL(u, bj)) = w;
                    if (dokn) { float q = (v0[0] * v0[0] + v0[1] * v0[1]) + (v0[2] * v0[2] + v0[3] * v0[3]) + (v1[0] * v1[0] + v1[1] * v1[1]) + (v1[2] * v1[2] + v1[3] * v1[3]);
                        q += __shfl_xor(q, 16); q += __shfl_xor(q, 32); nmax[bj] = fmaxf(nmax[bj], q); } } }
        if (dokn) {
#pragma unroll
            for (int bj = 0; bj < 2; ++bj) { float q = nmax[bj]; q = fmaxf(q, __shfl_xor(q, 1)); q = fmaxf(q, __shfl_xor(q, 2)); q = fmaxf(q, __shfl_xor(q, 4)); q = fmaxf(q, __shfl_xor(q, 8));
                const int head = ((u.ocol + bj * HALF) >> 6) + (wc >> 1), bt = u.orow / SEQ;
                if ((fr | fq) == 0) atomicMax(kn + ((bt * NH + head) * 2 + (wc & 1)), __float_as_uint(q)); }
        }
    }
};
struct EpiResid {
    static constexpr bool HAS_MID = false;
    const float* res; float* out; bf16_t* hb; float* ssq;
    __device__ __forceinline__ void operator()(const f32x4 (&acc)[2][2][4][2], const Unit& u, int wr, int wc, int fr, int fq) const {
#pragma unroll
        for (int ai = 0; ai < 2; ++ai)
#pragma unroll
            for (int m = 0; m < 4; ++m) { const int row = EPI_ROW(u, ai, m); float q = 0.f;
#pragma unroll
                for (int bj = 0; bj < 2; ++bj) { const size_t off = (size_t)row * DM + EPI_COL(u, bj);
                    const f32x4 r0 = *(const f32x4*)(res + off), r1 = *(const f32x4*)(res + off + 4);
                    const f32x4 v0 = acc[ai][bj][m][0] + r0, v1 = acc[ai][bj][m][1] + r1;
                    *(f32x4*)(out + off) = v0; *(f32x4*)(out + off + 4) = v1;
                    q += (v0[0] * v0[0] + v0[1] * v0[1]) + (v0[2] * v0[2] + v0[3] * v0[3]) + (v1[0] * v1[0] + v1[1] * v1[1]) + (v1[2] * v1[2] + v1[3] * v1[3]);
                    if (hb) { u32x4 w; w.x = cvt_pk_bf16(v0[0], v0[1]); w.y = cvt_pk_bf16(v0[2], v0[3]); w.z = cvt_pk_bf16(v1[0], v1[1]); w.w = cvt_pk_bf16(v1[2], v1[3]); *(u32x4*)(hb + off) = w; } }
                if (ssq) { q += __shfl_xor(q, 16); q += __shfl_xor(q, 32); if (fq == 0) ssq[(size_t)row * 16 + (u.ocol >> 8) * 4 + wc] = q; } }
    }
};
struct EpiOutProj {
    static constexpr bool HAS_MID = true;
    const bf16_t* xb; bf16_t* hb; float* ssq; const float* hs;
    __device__ __forceinline__ void scales(int row, float& ra, float& rb) const {
        const f32x4* p = (const f32x4*)(hs + (size_t)row * 16); const f32x4 a0 = p[0], a1 = p[1], b0 = p[2], b1 = p[3];
        ra = rsqrtf((((a0[0] + a0[1]) + (a0[2] + a0[3])) + ((a1[0] + a1[1]) + (a1[2] + a1[3]))) * (1.0f / HW) + EPS);
        rb = rsqrtf((((b0[0] + b0[1]) + (b0[2] + b0[3])) + ((b1[0] + b1[1]) + (b1[2] + b1[3]))) * (1.0f / HW) + EPS);
    }
    __device__ __forceinline__ void mid(f32x4 (&acc)[2][2][4][2], const Unit& u, int wr, int wc, int fr, int fq) const {
#pragma unroll
        for (int ai = 0; ai < 2; ++ai)
#pragma unroll
            for (int m = 0; m < 4; ++m) { float ra, rb; scales(EPI_ROW(u, ai, m), ra, rb); const float f = ra / rb;
#pragma unroll
                for (int bj = 0; bj < 2; ++bj) { acc[ai][bj][m][0] *= f; acc[ai][bj][m][1] *= f; } }
    }
    __device__ __forceinline__ void operator()(const f32x4 (&acc)[2][2][4][2], const Unit& u, int wr, int wc, int fr, int fq) const {
#pragma unroll
        for (int ai = 0; ai < 2; ++ai)
#pragma unroll
            for (int m = 0; m < 4; ++m) { const int row = EPI_ROW(u, ai, m); float ra, rb; scales(row, ra, rb); float q = 0.f;
#pragma unroll
                for (int bj = 0; bj < 2; ++bj) { const size_t off = (size_t)row * DM + EPI_COL(u, bj);
                    const u32x4 xr = *(const u32x4*)(xb + off);
                    f32x4 v0 = acc[ai][bj][m][0] * rb, v1 = acc[ai][bj][m][1] * rb;
                    v0[0] += bf16lo(xr.x); v0[1] += bf16hi(xr.x); v0[2] += bf16lo(xr.y); v0[3] += bf16hi(xr.y); v1[0] += bf16lo(xr.z); v1[1] += bf16hi(xr.z); v1[2] += bf16lo(xr.w); v1[3] += bf16hi(xr.w);
                    q += (v0[0] * v0[0] + v0[1] * v0[1]) + (v0[2] * v0[2] + v0[3] * v0[3]) + (v1[0] * v1[0] + v1[1] * v1[1]) + (v1[2] * v1[2] + v1[3] * v1[3]);
                    u32x4 w; w.x = cvt_pk_bf16(v0[0], v0[1]); w.y = cvt_pk_bf16(v0[2], v0[3]); w.z = cvt_pk_bf16(v1[0], v1[1]); w.w = cvt_pk_bf16(v1[2], v1[3]); *(u32x4*)(hb + off) = w; }
                q += __shfl_xor(q, 16); q += __shfl_xor(q, 32); if (fq == 0) ssq[(size_t)row * 16 + (u.ocol >> 8) * 4 + wc] = q; }
    }
};
struct EpiResidBf16 {
    static constexpr bool HAS_MID = false;
    bf16_t* hb;
    __device__ __forceinline__ void operator()(const f32x4 (&acc)[2][2][4][2], const Unit& u, int wr, int wc, int fr, int fq) const {
#pragma unroll
        for (int ai = 0; ai < 2; ++ai)
#pragma unroll
            for (int m = 0; m < 4; ++m) { const int row = EPI_ROW(u, ai, m);
#pragma unroll
                for (int bj = 0; bj < 2; ++bj) { const size_t off = (size_t)row * DM + EPI_COL(u, bj);
                    const u32x4 xr = *(const u32x4*)(hb + off);
                    f32x4 v0 = acc[ai][bj][m][0], v1 = acc[ai][bj][m][1];
                    v0[0] += bf16lo(xr.x); v0[1] += bf16hi(xr.x); v0[2] += bf16lo(xr.y); v0[3] += bf16hi(xr.y); v1[0] += bf16lo(xr.z); v1[1] += bf16hi(xr.z); v1[2] += bf16lo(xr.w); v1[3] += bf16hi(xr.w);
                    u32x4 w; w.x = cvt_pk_bf16(v0[0], v0[1]); w.y = cvt_pk_bf16(v0[2], v0[3]); w.z = cvt_pk_bf16(v1[0], v1[1]); w.w = cvt_pk_bf16(v1[2], v1[3]); *(u32x4*)(hb + off) = w; } }
    }
};
struct EpiSoftmax {
    static constexpr bool HAS_MID = false;
    bf16_t* P; const float* ssq; LAS float* red;
    __device__ __forceinline__ void operator()(f32x4 (&acc)[2][2][4][2], const Unit& u, int wr, int wc, int fr, int fq) const {
#pragma unroll
        for (int ai = 0; ai < 2; ++ai)
#pragma unroll
            for (int m = 0; m < 4; ++m) { const int row = EPI_ROW(u, ai, m); const f32x4* sp = (const f32x4*)(ssq + (size_t)row * 16);
                const f32x4 s0 = sp[0], s1 = sp[1], s2 = sp[2], s3 = sp[3];
                const float tot = ((s0[0] + s0[1]) + (s0[2] + s0[3])) + ((s1[0] + s1[1]) + (s1[2] + s1[3])) + ((s2[0] + s2[1]) + (s2[2] + s2[3])) + ((s3[0] + s3[1]) + (s3[2] + s3[3]));
                const float r1 = rsqrtf(tot * (1.0f / DM) + EPS) * XSC; float a = -3.0e38f;
#pragma unroll
                for (int bj = 0; bj < 2; ++bj)
#pragma unroll
                    for (int n = 0; n < 2; ++n) { f32x4 v = acc[ai][bj][m][n] * r1; acc[ai][bj][m][n] = v; a = fmaxf(a, fmaxf(fmaxf(v[0], v[1]), fmaxf(v[2], v[3]))); }
                a = fmaxf(a, __shfl_xor(a, 16)); a = fmaxf(a, __shfl_xor(a, 32));
                if (fq == 0) red[(ai * HALF + wr * 64 + m * 16 + fr) * 4 + wc] = a; asm volatile("" ::: "memory"); }
        LDS_WAIT(); __builtin_amdgcn_s_barrier(); asm volatile("" ::: "memory");
#pragma unroll
        for (int ai = 0; ai < 2; ++ai)
#pragma unroll
            for (int m = 0; m < 4; ++m) { const int rl = ai * HALF + wr * 64 + m * 16 + fr; const f32x4 mm = *(const LAS f32x4*)(red + rl * 4);
                const float a = fmaxf(fmaxf(mm[0], mm[1]), fmaxf(mm[2], mm[3])); float s = 0.f;
#pragma unroll
                for (int bj = 0; bj < 2; ++bj)
#pragma unroll
                    for (int n = 0; n < 2; ++n) { f32x4 v = acc[ai][bj][m][n];
                        v[0] = __builtin_amdgcn_exp2f(v[0] - a); v[1] = __builtin_amdgcn_exp2f(v[1] - a); v[2] = __builtin_amdgcn_exp2f(v[2] - a); v[3] = __builtin_amdgcn_exp2f(v[3] - a);
                        acc[ai][bj][m][n] = v; s += (v[0] + v[1]) + (v[2] + v[3]); }
                s += __shfl_xor(s, 16); s += __shfl_xor(s, 32);
                if (fq == 0) red[1024 + rl * 4 + wc] = s; }
        LDS_WAIT(); __builtin_amdgcn_s_barrier(); asm volatile("" ::: "memory");
#pragma unroll
        for (int ai = 0; ai < 2; ++ai)
#pragma unroll
            for (int m = 0; m < 4; ++m) { const int rl = ai * HALF + wr * 64 + m * 16 + fr; const int row = u.orow + rl; const f32x4 ss = *(const LAS f32x4*)(red + 1024 + rl * 4);
                const float inv = 1.0f / ((ss[0] + ss[1]) + (ss[2] + ss[3]));
#pragma unroll
                for (int bj = 0; bj < 2; ++bj) { const f32x4 v0 = acc[ai][bj][m][0] * inv, v1 = acc[ai][bj][m][1] * inv;
                    u32x4 w; w.x = cvt_pk_bf16(v0[0], v0[1]); w.y = cvt_pk_bf16(v0[2], v0[3]); w.z = cvt_pk_bf16(v1[0], v1[1]); w.w = cvt_pk_bf16(v1[2], v1[3]);
                    *(u32x4*)(P + (size_t)row * DM + EPI_COL(u, bj)) = w; } }
    }
};
struct EpiSwiglu {
    static constexpr bool HAS_MID = false;
    bf16_t* Hd;
    __device__ __forceinline__ void operator()(const f32x4 (&acc)[2][2][4][2], const Unit& u, int wr, int wc, int fr, int fq) const {
#pragma unroll
        for (int ai = 0; ai < 2; ++ai)
#pragma unroll
            for (int m = 0; m < 4; ++m) { const int row = EPI_ROW(u, ai, m); float h[8];
#pragma unroll
                for (int n = 0; n < 2; ++n)
#pragma unroll
                    for (int e = 0; e < 4; ++e) { const float gt = acc[ai][0][m][n][e], up = acc[ai][1][m][n][e];
                        h[n * 4 + e] = gt * __builtin_amdgcn_rcpf(1.0f + __builtin_amdgcn_exp2f(-gt * LOG2E)) * up; }
                u32x4 w; w.x = cvt_pk_bf16(h[0], h[1]); w.y = cvt_pk_bf16(h[2], h[3]); w.z = cvt_pk_bf16(h[4], h[5]); w.w = cvt_pk_bf16(h[6], h[7]);
                *(u32x4*)(Hd + (size_t)row * DFF + u.ocol + wc * 32 + 8 * fq) = w; }
    }
};
}

namespace att {
constexpr int QB = 256, KVBLK = 64, PITCH = HW, OPITCH = DM;
constexpr int SLOTB = 8192, LDS_K = 0, LDS_V = 2 * SLOTB, LDS_WS = 4 * SLOTB, LDS_OST = LDS_WS + NWAVES * 256, LDS_FLAG = LDS_OST + NWAVES * 4096, LDS_END = LDS_FLAG + 64;
static_assert(LDS_END <= RING_BYTES, "attention LDS");
__device__ __forceinline__ int crow(int r, int hi) { return (r & 3) + 8 * (r >> 2) + 4 * hi; }
__device__ __forceinline__ void glds16(const void* gsrc, unsigned lds_dst) { unsigned keep;
    asm volatile("s_mov_b32 %0, m0\n\ts_mov_b32 m0, %2\n\ts_nop 0\n\tglobal_load_lds_dwordx4 %1, off\n\ts_mov_b32 m0, %0" : "=&s"(keep) : "v"(gsrc), "s"(lds_dst) : "memory"); }
__device__ __forceinline__ void glds16s(const void* sbase, unsigned voff, unsigned lds_dst) { unsigned keep;
    asm volatile("s_mov_b32 %0, m0\n\ts_mov_b32 m0, %3\n\ts_nop 0\n\tglobal_load_lds_dwordx4 %1, %2\n\ts_mov_b32 m0, %0" : "=&s"(keep) : "v"(voff), "s"(sbase), "s"(lds_dst) : "memory"); }
#define ATT_WAIT_BAR0() asm volatile("s_waitcnt vmcnt(0) lgkmcnt(0)\n\ts_barrier" ::: "memory")
#define MFMA32(a, b, c) __builtin_amdgcn_mfma_f32_32x32x16_bf16(a, b, c, 0, 0, 0)
__device__ __forceinline__ void store_row_ssq(u32x4 v, float* dst, int ch) {
    float q = (bf16lo(v.x) * bf16lo(v.x) + bf16hi(v.x) * bf16hi(v.x)) + (bf16lo(v.y) * bf16lo(v.y) + bf16hi(v.y) * bf16hi(v.y)) + (bf16lo(v.z) * bf16lo(v.z) + bf16hi(v.z) * bf16hi(v.z)) + (bf16lo(v.w) * bf16lo(v.w) + bf16hi(v.w) * bf16hi(v.w));
    q += __shfl_xor(q, 1); q += __shfl_xor(q, 2); q += __shfl_xor(q, 4);
    if (ch == 0) *dst = q;
}
__device__ __forceinline__ void qkt(f32x16& p0, f32x16& p1, const LAS char* Kslot, const bf16x8* qr, const f32x16& cin, int r32, int hi) {
    const LAS char* kb = Kslot + hi * 1024 + r32 * 16;
#pragma unroll
    for (int d0 = 0; d0 < 4; ++d0) {
        const bf16x8 b0 = *(const LAS bf16x8*)(kb + d0 * 2048);
        const bf16x8 b1 = *(const LAS bf16x8*)(kb + d0 * 2048 + 512);
        if (d0 == 0) { p0 = MFMA32(b0, qr[0], cin); p1 = MFMA32(b1, qr[0], cin); }
        else { p0 = MFMA32(b0, qr[d0], p0); p1 = MFMA32(b1, qr[d0], p1); } }
}
__device__ __forceinline__ void pv(f32x16* o, int vb, bf16x8 pa0, bf16x8 pa1, bf16x8 pa2, bf16x8 pa3) {
#pragma unroll
    for (int d0 = 0; d0 < 2; ++d0) { s16x4 lo[4], hi[4];
#pragma unroll
        for (int ks = 0; ks < 4; ++ks) {
            asm volatile("ds_read_b64_tr_b16 %0,%1 offset:%c2" : "=&v"(lo[ks]) : "v"(vb), "i"(d0 * 4096 + ks * 1024) : "memory");
            asm volatile("ds_read_b64_tr_b16 %0,%1 offset:%c2" : "=&v"(hi[ks]) : "v"(vb), "i"(d0 * 4096 + ks * 1024 + 512) : "memory"); }
        asm volatile("s_waitcnt lgkmcnt(0)" ::: "memory"); __builtin_amdgcn_sched_barrier(0);
#define PK(k) (bf16x8){lo[k][0], lo[k][1], lo[k][2], lo[k][3], hi[k][0], hi[k][1], hi[k][2], hi[k][3]}
        o[d0] = MFMA32(pa0, PK(0), o[d0]); o[d0] = MFMA32(pa1, PK(1), o[d0]); o[d0] = MFMA32(pa2, PK(2), o[d0]); o[d0] = MFMA32(pa3, PK(3), o[d0]);
#undef PK
    }
}
__device__ __forceinline__ float swap_lo(float x) { auto rr = __builtin_amdgcn_permlane32_swap(__float_as_uint(x), __float_as_uint(x), false, false); return __uint_as_float(rr[0]); }
__device__ __forceinline__ float swap_hi(float x) { auto rr = __builtin_amdgcn_permlane32_swap(__float_as_uint(x), __float_as_uint(x), false, false); return __uint_as_float(rr[1]); }

template <int MODE> __device__ __forceinline__ void attn_unit(int b, int h, int qb, const bf16_t* Q, const bf16_t* K, const bf16_t* V, bf16_t* O, float* hs, const float* cb, LAS char* shm) {
    int tid = threadIdx.x; asm volatile("" : "+v"(tid)); const int lane = tid & 63, r32 = lane & 31, hi = lane >> 5; const int wid = __builtin_amdgcn_readfirstlane(tid >> 6);
    const long rowbase = (long)b * SEQ; const int q0 = qb * QB;
    const bf16_t* Qw = Q + (rowbase + q0 + wid * 32) * PITCH + h * HD;
    const bf16_t* Kh = K + rowbase * PITCH + h * HD; const bf16_t* Vh = V + rowbase * PITCH + h * HD;
    const unsigned lds0 = (unsigned)(uintptr_t)shm;
    LAS float* wsf = (LAS float*)(shm + LDS_WS) + wid * 64;
    LAS unsigned* flags = (LAS unsigned*)(shm + LDS_FLAG);
    const bf16_t* ksrc = Kh + (long)lane * PITCH + wid * 8;
    const bf16_t* vsrc = Vh + (long)(16 * (wid & 3) + (lane >> 2)) * PITCH + (wid >> 2) * 32 + (lane & 3) * 8;
    const unsigned kdst = lds0 + LDS_K + wid * 1024, vdst = lds0 + LDS_V + wid * 1024;
#define DMA_KV(t, slot) do { glds16(ksrc + (long)(t) * KVBLK * PITCH, (unsigned)__builtin_amdgcn_readfirstlane(kdst + (slot))); glds16(vsrc + (long)(t) * KVBLK * PITCH, (unsigned)__builtin_amdgcn_readfirstlane(vdst + (slot))); } while (0)
    const int vb0 = (int)(lds0 + LDS_V) + ((lane >> 4) & 1) * 32 + (lane & 3) * 8 + (4 * hi + ((lane & 15) >> 2)) * 64;
    const int NT = (q0 + QB) / KVBLK;
    DMA_KV(NT - 1, 0);
    bf16x8 qr[4];
#pragma unroll
    for (int d0 = 0; d0 < 4; ++d0) qr[d0] = *(const bf16x8*)(Qw + (long)r32 * PITCH + d0 * 16 + hi * 8);
    f32x16 o[2]; o[0] = f32x16{}; o[1] = f32x16{};
    const int qrel = wid * 32 + r32;
    float m_run = -1.0e30f, l_run = 0.f, R = 0.f, ct = 0.f;
    if (MODE == 0) ct = cb[q0 + qrel];
    bf16x8 TD0, TD1, TONE;
#pragma unroll
    for (int j = 0; j < 8; ++j) { const int kvl = 8 * (j >> 2) + 4 * hi + (j & 3); TD0[j] = (kvl >= r32) ? (short)0x3F80 : (short)0; TD1[j] = (16 + kvl >= r32) ? (short)0x3F80 : (short)0; TONE[j] = (short)0x3F80; }
    f32x16 zero16 = f32x16{};
    for (int i = 0; i < NT; ++i) {
        const int t = NT - 1 - i, slot = (i & 1) * SLOTB;
        ATT_WAIT_BAR0();
        if (MODE == 1 && i > 0) {
            const LAS unsigned* fl = flags + ((i - 1) & 1) * 8; unsigned all = 1u;
#pragma unroll
            for (int w = 0; w < 8; ++w) all &= fl[w];
            if (__builtin_amdgcn_readfirstlane(all)) break;
        }
        if (t > 0) DMA_KV(t - 1, slot ^ SLOTB);
        const int jb = t - (NT - 4);
        const bool active = !(jb >= 0 && 2 * jb > wid);
        bool wave_done = false;
        if (MODE == 1) wave_done = __all(R < SB_EXIT);
        if (active && !(MODE == 1 && wave_done)) {
            f32x16 p0, p1;
            qkt(p0, p1, shm + LDS_K + slot, qr, zero16, r32, hi);
            if (MODE == 0) {
                const float* cbt = cb + t * KVBLK + 4 * hi;
#pragma unroll
                for (int g = 0; g < 4; ++g) { const f32x4 c0 = *(const f32x4*)(cbt + 8 * g), c1 = *(const f32x4*)(cbt + 32 + 8 * g);
#pragma unroll
                    for (int e = 0; e < 4; ++e) { p0[4 * g + e] += ct - c0[e]; p1[4 * g + e] += ct - c1[e]; } }
                if (jb >= 0) {
#pragma unroll
                    for (int r = 0; r < 16; ++r) { const int kv = 64 * jb + crow(r, hi); if (kv > qrel) p0[r] = -1.0e30f; if (kv + 32 > qrel) p1[r] = -1.0e30f; } }
                float a = fmaxf(p0[0], p1[0]);
#pragma unroll
                for (int r = 1; r < 16; ++r) a = fmaxf(a, fmaxf(p0[r], p1[r]));
                a = fmaxf(swap_lo(a), swap_hi(a));
                const float m_new = fmaxf(m_run, a), alpha = __builtin_amdgcn_exp2f(m_run - m_new); m_run = m_new;
                float s = 0.f;
#pragma unroll
                for (int r = 0; r < 16; ++r) { p0[r] = __builtin_amdgcn_exp2f(p0[r] - m_new); p1[r] = __builtin_amdgcn_exp2f(p1[r] - m_new); s += p0[r] + p1[r]; }
                l_run = l_run * alpha + s;
                if (hi == 0) wsf[r32] = alpha;
                LDS_WAIT();
#pragma unroll
                for (int r = 0; r < 16; ++r) { const float f = wsf[crow(r, hi)]; o[0][r] *= f; o[1][r] *= f; }
                LDS_WAIT();
            } else {
                if (jb >= 0) {
#pragma unroll
                    for (int r = 0; r < 16; ++r) { const int kv = 64 * jb + crow(r, hi); if (kv >= qrel) p0[r] = -1.0e30f; if (kv + 32 >= qrel) p1[r] = -1.0e30f; } }
                f32x16 l0, l1;
#pragma unroll
                for (int r = 0; r < 16; ++r) {
                    l0[r] = -(fmaxf(p0[r], 0.f) + __builtin_amdgcn_logf(1.0f + __builtin_amdgcn_exp2f(-fabsf(p0[r]))));
                    l1[r] = -(fmaxf(p1[r], 0.f) + __builtin_amdgcn_logf(1.0f + __builtin_amdgcn_exp2f(-fabsf(p1[r])))); }
                u32x4 lw0 = {cvt_pk_bf16(l0[0], l0[1]), cvt_pk_bf16(l0[2], l0[3]), cvt_pk_bf16(l0[4], l0[5]), cvt_pk_bf16(l0[6], l0[7])};
                u32x4 lw1 = {cvt_pk_bf16(l0[8], l0[9]), cvt_pk_bf16(l0[10], l0[11]), cvt_pk_bf16(l0[12], l0[13]), cvt_pk_bf16(l0[14], l0[15])};
                u32x4 lw2 = {cvt_pk_bf16(l1[0], l1[1]), cvt_pk_bf16(l1[2], l1[3]), cvt_pk_bf16(l1[4], l1[5]), cvt_pk_bf16(l1[6], l1[7])};
                u32x4 lw3 = {cvt_pk_bf16(l1[8], l1[9]), cvt_pk_bf16(l1[10], l1[11]), cvt_pk_bf16(l1[12], l1[13]), cvt_pk_bf16(l1[14], l1[15])};
                f32x16 rt;
#pragma unroll
                for (int r = 0; r < 16; ++r) rt[r] = R;
                f32x16 t0 = MFMA32(TD0, __builtin_bit_cast(bf16x8, lw0), rt); t0 = MFMA32(TD1, __builtin_bit_cast(bf16x8, lw1), t0);
                t0 = MFMA32(TONE, __builtin_bit_cast(bf16x8, lw2), t0); t0 = MFMA32(TONE, __builtin_bit_cast(bf16x8, lw3), t0);
                f32x16 t1 = MFMA32(TD0, __builtin_bit_cast(bf16x8, lw2), rt); t1 = MFMA32(TD1, __builtin_bit_cast(bf16x8, lw3), t1);
#pragma unroll
                for (int r = 0; r < 16; ++r) { p0[r] = __builtin_amdgcn_exp2f(p0[r] + t0[r]); p1[r] = __builtin_amdgcn_exp2f(p1[r] + t1[r]); }
                R = swap_lo(t0[0]);
            }
            u32x4 pw0 = {cvt_pk_bf16(p0[0], p0[1]), cvt_pk_bf16(p0[2], p0[3]), cvt_pk_bf16(p0[4], p0[5]), cvt_pk_bf16(p0[6], p0[7])};
            u32x4 pw1 = {cvt_pk_bf16(p0[8], p0[9]), cvt_pk_bf16(p0[10], p0[11]), cvt_pk_bf16(p0[12], p0[13]), cvt_pk_bf16(p0[14], p0[15])};
            u32x4 pw2 = {cvt_pk_bf16(p1[0], p1[1]), cvt_pk_bf16(p1[2], p1[3]), cvt_pk_bf16(p1[4], p1[5]), cvt_pk_bf16(p1[6], p1[7])};
            u32x4 pw3 = {cvt_pk_bf16(p1[8], p1[9]), cvt_pk_bf16(p1[10], p1[11]), cvt_pk_bf16(p1[12], p1[13]), cvt_pk_bf16(p1[14], p1[15])};
            pv(o, vb0 + slot, __builtin_bit_cast(bf16x8, pw0), __builtin_bit_cast(bf16x8, pw1), __builtin_bit_cast(bf16x8, pw2), __builtin_bit_cast(bf16x8, pw3));
        }
        if (MODE == 1) { const bool dn = __all(R < SB_EXIT); if (lane == 0) flags[(i & 1) * 8 + wid] = dn ? 1u : 0u; }
    }
    float linv = 1.f;
    if (MODE == 0) { const float lt = swap_lo(l_run) + swap_hi(l_run); linv = 1.0f / lt; }
    if (hi == 0) wsf[32 + r32] = linv;
    LDS_WAIT();
    bf16_t* Ow = O + (rowbase + q0 + wid * 32) * OPITCH + h * HD;
    { LAS bf16_t* stg = (LAS bf16_t*)(shm + LDS_OST) + wid * 2048;
#pragma unroll
      for (int r = 0; r < 16; ++r) { const int orow = crow(r, hi); const float f = wsf[32 + orow];
#pragma unroll
        for (int d0 = 0; d0 < 2; ++d0) { const unsigned pk = cvt_pk_bf16(o[d0][r] * f, 0.f); stg[orow * 64 + d0 * 32 + r32] = (bf16_t)(pk & 0xffffu); } }
      LDS_WAIT();
#pragma unroll
      for (int i = 0; i < 4; ++i) { const int row = i * 8 + (lane >> 3), ch = lane & 7; const u32x4 v = *(const LAS u32x4*)(stg + row * 64 + ch * 8); *(u32x4*)(Ow + (long)row * OPITCH + ch * 8) = v;
        store_row_ssq(v, hs + (rowbase + q0 + wid * 32 + row) * 16, ch); } }
    asm volatile("s_waitcnt vmcnt(0) lgkmcnt(0)\n\ts_barrier" ::: "memory");
#undef DMA_KV
}
}


namespace fox {
constexpr int QB = 256, KVBLK = 64, PITCH = HW, OPITCH = DM;
constexpr int NSLOT = 3, SLOTB = 9216;
constexpr int LDS_K = 0, LDS_V = NSLOT * SLOTB, LDS_WS = 2 * NSLOT * SLOTB, LDS_OST = LDS_WS + NWAVES * 256, LDS_CL = LDS_OST + NWAVES * 4096, LDS_VOTE = LDS_CL + 512, LDS_END = LDS_VOTE + 32;
static_assert(LDS_END <= RING_BYTES, "fox LDS");
constexpr float WIN_T = 64.0f;
constexpr float FLOOR = -256.0f;
using att::crow; using att::glds16; using att::glds16s;
typedef __attribute__((address_space(3))) const char* lds_cptr;
typedef short v4i16_t __attribute__((ext_vector_type(4)));
#define SBAR() __builtin_amdgcn_sched_barrier(0)
#define WAIT_BAR(N) asm volatile("s_waitcnt vmcnt(" #N ") lgkmcnt(0)\n\ts_barrier" ::: "memory")
__device__ __forceinline__ s16x4 vtr(lds_cptr p) { return __builtin_bit_cast(s16x4, __builtin_amdgcn_ds_read_tr16_b64_v4i16((__attribute__((address_space(3))) v4i16_t*)p)); }
__device__ __forceinline__ void kload2(bf16x8* kf, lds_cptr kp, int j) { kf[2 * j] = *(const LAS bf16x8*)(kp + j * 2048); kf[2 * j + 1] = *(const LAS bf16x8*)(kp + j * 2048 + 512); }
__device__ __forceinline__ void cmask(f32x16& p0, f32x16& p1, int jb, int qrel, int hi) {
    const float NEG = -INFINITY; const int kb = 64 * jb + 4 * hi;
#pragma unroll
    for (int r = 0; r < 16; ++r) { const int kv = kb + (r & 3) + 8 * (r >> 2); if (kv > qrel) p0[r] = NEG; if (kv + 32 > qrel) p1[r] = NEG; }
}
__device__ __forceinline__ void split3(float x, unsigned& hm, unsigned& lo) {
    const unsigned h = cvt_pk_bf16(x, 0.f) & 0xffffu; const float r1 = x - __uint_as_float(h << 16);
    const unsigned m = cvt_pk_bf16(r1, 0.f) & 0xffffu; const float r2 = r1 - __uint_as_float(m << 16);
    hm = h | (m << 16); lo = cvt_pk_bf16(r2, 0.f) & 0xffffu;
}
__device__ __forceinline__ bf16x8 qx_build(float a, int hi) {
    unsigned hm, lo; split3(a, hm, lo);
    u32x4 w; w.x = hm; w.y = lo | 0x3F800000u; w.z = 0x3F803F80u; w.w = 0u;
    if (hi) { w.x = 0u; w.y = 0u; w.z = 0u; }
    return __builtin_bit_cast(bf16x8, w);
}

template <int THRL> __device__ __forceinline__ void fox_unit(int bh, int qb, const bf16_t* Q, const bf16_t* K, const bf16_t* V, bf16_t* O, float* hs, const float* cb, const bf16_t* KXh, float kmax, LAS char* shm) {
    int tid = threadIdx.x; asm volatile("" : "+v"(tid)); const int lane = tid & 63, r32 = lane & 31, hi = lane >> 5; const int wid = __builtin_amdgcn_readfirstlane(tid >> 6);
    const int b = bh >> 3, h = bh & 7; const long rowbase = (long)b * SEQ; const int q0 = qb * QB;
    const bf16_t* Qw = Q + (rowbase + q0 + wid * 32) * PITCH + h * HD;
    const bf16_t* Kh = K + rowbase * PITCH + h * HD; const bf16_t* Vh = V + rowbase * PITCH + h * HD;
    const unsigned lds0 = (unsigned)(uintptr_t)shm;
    LAS float* wsf = (LAS float*)(shm + LDS_WS) + wid * 64;
    const int NT = (q0 + QB) / KVBLK;
    int NTe = NT;
    LAS float* clt = (LAS float*)(shm + LDS_CL); LAS unsigned* votes = (LAS unsigned*)(shm + LDS_VOTE);
    const float clv = (tid < NT) ? cb[64 * tid + 63] : 0.f;
    const unsigned koff = (unsigned)(lane * PITCH + wid * 8) * 2u, voff = (unsigned)((16 * (wid & 3) + (lane >> 2)) * PITCH + (wid >> 2) * 32 + (lane & 3) * 8) * 2u, xoff = (unsigned)lane * 16u;
    const unsigned kdst = lds0 + LDS_K + wid * 1024, vdst = lds0 + LDS_V + wid * 1024, xdst = lds0 + LDS_K + 8192;
    const bool xl = (lane >> 3) == wid;
#define DMA_K(p, slot) do { glds16s(Kh + (long)(NT - 1 - (p)) * KVBLK * PITCH, koff, (unsigned)__builtin_amdgcn_readfirstlane(kdst + (slot))); \
        if (xl) glds16s(KXh + (long)(NT - 1 - (p)) * KVBLK * 8, xoff, (unsigned)__builtin_amdgcn_readfirstlane(xdst + (slot))); } while (0)
#define DMA_V(p, slot) glds16s(Vh + (long)(NT - 1 - (p)) * KVBLK * PITCH, voff, (unsigned)__builtin_amdgcn_readfirstlane(vdst + (slot)))
    bf16x8 kf[10];
    const lds_cptr shm3 = (lds_cptr)shm; const lds_cptr kp0 = shm3 + LDS_K + hi * 1024 + r32 * 16; const lds_cptr kx0 = shm3 + LDS_K + 8192 + r32 * 16;
    const lds_cptr vp0 = shm3 + LDS_V + ((lane >> 4) & 1) * 32 + (lane & 3) * 8 + (4 * hi + ((lane & 15) >> 2)) * 64;
    DMA_K(0, 0); DMA_V(0, 0); DMA_K(1, SLOTB);
    bf16x8 qr[4];
#pragma unroll
    for (int d0 = 0; d0 < 4; ++d0) qr[d0] = *(const bf16x8*)(Qw + (long)r32 * PITCH + d0 * 16 + hi * 8);
    const int qrel = wid * 32 + r32;
    const float ct = cb[q0 + qrel];
    float mhat = 0.f, l_reg = 0.f; f32x16 o[2]; o[0] = f32x16{}; o[1] = f32x16{};
    bf16x8 qx = qx_build(ct, hi);
    const f32x16 z16 = f32x16{};
#define CMASK(P0, P1, p) do { const int jb_ = 3 - (p); if (jb_ >= 0) cmask(P0, P1, jb_, qrel, hi); } while (0)
    bool resc = false;
#define RESC() do { if (resc) { asm volatile("s_waitcnt lgkmcnt(0)" ::: "memory"); \
      _Pragma("unroll") for (int d_ = 0; d_ < 2; ++d_) _Pragma("unroll") for (int r = 0; r < 16; ++r) o[d_][r] *= wsf[crow(r, hi)]; } } while (0)
    f32x16 pA0, pA1, pB0, pB1;
    int sl_prev = 0, sl_cur = 0, sl_next = SLOTB;
#define ROT() do { sl_prev = sl_cur; sl_cur = sl_next; sl_next = (sl_next == (NSLOT - 1) * SLOTB) ? 0 : sl_next + SLOTB; } while (0)
    DMA_K(2, 2 * SLOTB);
    WAIT_BAR(5);
    if (tid < NT) clt[tid] = clv;
    float qkb;
    { float q2 = 0.f;
#pragma unroll
      for (int d0 = 0; d0 < 4; ++d0)
#pragma unroll
          for (int j = 0; j < 8; ++j) { const float e = __uint_as_float(((unsigned)(unsigned short)qr[d0][j]) << 16); q2 += e * e; }
      q2 = att::swap_lo(q2) + att::swap_hi(q2); qkb = sqrtf(q2) * kmax + ct + WIN_T; }
    { const LAS char* kb = (const LAS char*)shm + LDS_K + hi * 1024 + r32 * 16; const LAS char* kxb = (const LAS char*)shm + LDS_K + 8192 + r32 * 16;
      pA0 = MFMA32(*(const LAS bf16x8*)(kxb), qx, z16); pA1 = MFMA32(*(const LAS bf16x8*)(kxb + 512), qx, z16);
#pragma unroll
      for (int d0 = 0; d0 < 4; ++d0) { pA0 = MFMA32(*(const LAS bf16x8*)(kb + d0 * 2048), qr[d0], pA0); pA1 = MFMA32(*(const LAS bf16x8*)(kb + d0 * 2048 + 512), qr[d0], pA1); } }
    asm volatile("s_nop 15\n\ts_nop 7" : "+v"(pA0), "+v"(pA1)); CMASK(pA0, pA1, 0);
    { float a = fmaxf(pA0[0], pA1[0]);
#pragma unroll
      for (int r = 1; r < 16; ++r) a = fmaxf(a, fmaxf(pA0[r], pA1[r]));
      a = fmaxf(att::swap_lo(a), att::swap_hi(a));
      const float dl = fmaxf(a, FLOOR); mhat = dl;
#pragma unroll
      for (int r = 0; r < 16; ++r) { pA0[r] = __builtin_amdgcn_exp2f(pA0[r] - dl); pA1[r] = __builtin_amdgcn_exp2f(pA1[r] - dl); }
      qx = qx_build(ct - mhat, hi); asm volatile("" : "+v"(qx)); }
    WAIT_BAR(0);
    DMA_K(3, 0); DMA_V(1, SLOTB);
    ROT();
    kload2(kf, kp0 + sl_cur, 0); kload2(kf, kp0 + sl_cur, 1); kload2(kf, kp0 + sl_cur, 2); kload2(kf, kp0 + sl_cur, 3);
    kf[8] = *(const LAS bf16x8*)(kx0 + sl_cur); kf[9] = *(const LAS bf16x8*)(kx0 + sl_cur + 512);
    WAIT_BAR(3);
    s16x4 vlo[8], vhi[8]; u32x4 pw0, pw1, pw2, pw3;
#define PKW(P, B) cvt_pk_bf16(P[B], P[B + 1])
#define PAF(k) __builtin_bit_cast(bf16x8, pw##k)
#define VFR(i) (bf16x8){vlo[i][0], vlo[i][1], vlo[i][2], vlo[i][3], vhi[i][0], vhi[i][1], vhi[i][2], vhi[i][3]}
#define PIN(x) asm volatile("" : "+v"(x))
#define MX3(a, b, c) __builtin_fmaxf(__builtin_fmaxf((a), (b)), (c))
#define GAPA(MF, A0, A1, A2, A3, W0, W1, PW) do { MF; sacc += A0; sacc += A1; sacc += A2; sacc += A3; PIN(sacc); W0; W1; PIN(PW); SBAR(); } while (0)
#define EX(v) __builtin_amdgcn_exp2f(v)
#define GAPB(MF, X, B) do { MF; X[B] = EX(X[B]); X[B + 1] = EX(X[B + 1]); X[B + 2] = EX(X[B + 2]); X[B + 3] = EX(X[B + 3]); PIN(X); SBAR(); } while (0)
#define VRD(i) do { vlo[i] = vtr(vp_ + (((i) >> 2) * 4096 + ((i) & 3) * 1024)); vhi[i] = vtr(vp_ + (((i) >> 2) * 4096 + ((i) & 3) * 1024 + 512)); } while (0)
#define KRD(G, j) do { if (G) { kload2(kf, kp0 + sl_next, j); SBAR(); } } while (0)
#define KRDX(G) do { if (G) { kf[8] = *(const LAS bf16x8*)(kx0 + sl_next); kf[9] = *(const LAS bf16x8*)(kx0 + sl_next + 512); SBAR(); } } while (0)
#define STEP(C0, C1, P0, P1, t, GK, GV, GL) do { SBAR(); \
    const lds_cptr vp_ = vp0 + sl_prev; \
    C0 = MFMA32(kf[8], qx, z16); C1 = MFMA32(kf[9], qx, z16); SBAR(); \
    VRD(0); SBAR(); float sacc = (P0[0] + P0[1]); \
    GAPA(C0 = MFMA32(kf[0], qr[0], C0), P0[2], P0[3], P0[4], P0[5],     pw0[0] = PKW(P0, 0), pw0[1] = PKW(P0, 2), pw0); \
    VRD(4); SBAR(); GAPA(C1 = MFMA32(kf[1], qr[0], C1), P0[6], P0[7], P0[8], P0[9],     pw0[2] = PKW(P0, 4), pw0[3] = PKW(P0, 6), pw0); \
    VRD(1); SBAR(); GAPA(C0 = MFMA32(kf[2], qr[1], C0),   P0[10], P0[11], P0[12], P0[13], pw1[0] = PKW(P0, 8), pw1[1] = PKW(P0, 10), pw1); \
    VRD(5); SBAR(); GAPA(C1 = MFMA32(kf[3], qr[1], C1),   P0[14], P0[15], P1[0], P1[1],   pw1[2] = PKW(P0, 12), pw1[3] = PKW(P0, 14), pw1); \
    VRD(2); SBAR(); GAPA(C0 = MFMA32(kf[4], qr[2], C0),   P1[2], P1[3], P1[4], P1[5],     pw2[0] = PKW(P1, 0), pw2[1] = PKW(P1, 2), pw2); \
    VRD(6); SBAR(); GAPA(C1 = MFMA32(kf[5], qr[2], C1),   P1[6], P1[7], P1[8], P1[9],     pw2[2] = PKW(P1, 4), pw2[3] = PKW(P1, 6), pw2); \
    VRD(3); SBAR(); GAPA(C0 = MFMA32(kf[6], qr[3], C0),   P1[10], P1[11], P1[12], P1[13], pw3[0] = PKW(P1, 8), pw3[1] = PKW(P1, 10), pw3); \
    VRD(7); SBAR(); GAPA(C1 = MFMA32(kf[7], qr[3], C1),   P1[14], P1[15], 0.f, 0.f,       pw3[2] = PKW(P1, 12), pw3[3] = PKW(P1, 14), pw3); \
    l_reg += sacc; \
    if (GK) { DMA_K((t) + 3, sl_cur); } if (GV) { DMA_V((t) + 1, sl_next); } \
    CMASK(C0, C1, t); \
    { float a = MX3(C0[0], C0[1], C1[0]), b_ = MX3(C0[2], C0[3], C1[1]); a = MX3(a, C1[2], C1[3]); \
      _Pragma("unroll") for (int r = 4; r < 16; r += 4) { a = MX3(a, C0[r], C0[r + 1]); b_ = MX3(b_, C0[r + 2], C0[r + 3]); a = MX3(a, C1[r], C1[r + 1]); b_ = MX3(b_, C1[r + 2], C1[r + 3]); } \
      float rm = __builtin_fmaxf(a, b_); { auto rr = __builtin_amdgcn_permlane32_swap(__float_as_uint(rm), __float_as_uint(rm), false, false); rm = __builtin_fmaxf(__uint_as_float(rr[0]), __uint_as_float(rr[1])); } \
      resc = false; \
      if (__builtin_expect(__any(rm > (float)THRL), 0)) { const float dl = __builtin_fmaxf(rm, 0.f); mhat += dl; \
        _Pragma("unroll") for (int r = 0; r < 16; ++r) { C0[r] -= dl; C1[r] -= dl; } \
        qx = qx_build(ct - mhat, hi); asm volatile("" : "+v"(qx)); \
        const float f = __builtin_amdgcn_exp2f(-dl); l_reg *= f; if (hi == 0) wsf[r32] = f; resc = true; } } \
    SBAR(); \
    GAPB(o[0] = MFMA32(PAF(0), VFR(0), o[0]), C0, 0); \
    KRDX(GL); GAPB(o[1] = MFMA32(PAF(0), VFR(4), o[1]), C0, 4); \
    KRD(GL, 0); GAPB(o[0] = MFMA32(PAF(1), VFR(1), o[0]), C0, 8); \
    KRD(GL, 1); GAPB(o[1] = MFMA32(PAF(1), VFR(5), o[1]), C0, 12); \
    KRD(GL, 2); GAPB(o[0] = MFMA32(PAF(2), VFR(2), o[0]), C1, 0); \
    KRD(GL, 3); GAPB(o[1] = MFMA32(PAF(2), VFR(6), o[1]), C1, 4); \
    GAPB(o[0] = MFMA32(PAF(3), VFR(3), o[0]), C1, 8); \
    GAPB(o[1] = MFMA32(PAF(3), VFR(7), o[1]), C1, 12); \
    } while (0)
#define ENDW(tt) do { if ((tt) + 3 < NTe) { WAIT_BAR(3); } else if ((tt) + 2 < NTe) { WAIT_BAR(1); } else { WAIT_BAR(0); } } while (0)
#define VOTE(u) do { const int ts_ = NT - (u) - 3; bool ok_ = false; if (ts_ >= 0) { ok_ = __all((qkb - mhat) < clt[ts_]); } if (lane == 0) votes[wid] = ok_ ? 1u : 0u; } while (0)
#define TALLY(u) do { const u32x4 va_ = *(const LAS u32x4*)votes, vb_ = *(const LAS u32x4*)(votes + 4); \
        if (__builtin_amdgcn_readfirstlane((va_.x & va_.y & va_.z & va_.w & vb_.x & vb_.y & vb_.z & vb_.w) != 0u)) { if ((u) + 2 < NTe) { NTe = (u) + 2; WAIT_BAR(0); } } } while (0)
    int t = 1;
    for (; t + 1 < NTe && t < 5; t += 2) {
        STEP(pB0, pB1, pA0, pA1, t, (t + 3 < NTe), (t + 1 < NTe), (t + 1 < NTe));       ENDW(t);     RESC(); ROT();
        STEP(pA0, pA1, pB0, pB1, t + 1, (t + 4 < NTe), (t + 2 < NTe), (t + 2 < NTe));   VOTE(t + 1); ENDW(t + 1); TALLY(t + 1); RESC(); ROT();
    }
#undef CMASK
#define CMASK(P0, P1, p) do {} while (0)
    for (; t + 5 < NTe; t += 2) {
        STEP(pB0, pB1, pA0, pA1, t, true, true, true);       WAIT_BAR(3); RESC(); ROT();
        STEP(pA0, pA1, pB0, pB1, t + 1, true, true, true);   VOTE(t + 1); WAIT_BAR(3); TALLY(t + 1); RESC(); ROT();
    }
    for (; t + 1 < NTe; t += 2) {
        STEP(pB0, pB1, pA0, pA1, t, (t + 3 < NTe), (t + 1 < NTe), (t + 1 < NTe));       ENDW(t);     RESC(); ROT();
        STEP(pA0, pA1, pB0, pB1, t + 1, (t + 4 < NTe), (t + 2 < NTe), (t + 2 < NTe));   ENDW(t + 1); RESC(); ROT();
    }
#undef CMASK
#define CMASK(P0, P1, p) do { const int jb_ = 3 - (p); if (jb_ >= 0) cmask(P0, P1, jb_, qrel, hi); } while (0)
    STEP(pB0, pB1, pA0, pA1, NTe - 1, false, false, false); RESC();
    { float sacc = pB0[0] + pB0[1];
#pragma unroll
      for (int r = 2; r < 16; ++r) sacc += pB0[r];
#pragma unroll
      for (int r = 0; r < 16; ++r) sacc += pB1[r];
      l_reg += sacc;
      pw0 = (u32x4){PKW(pB0, 0), PKW(pB0, 2), PKW(pB0, 4), PKW(pB0, 6)}; pw1 = (u32x4){PKW(pB0, 8), PKW(pB0, 10), PKW(pB0, 12), PKW(pB0, 14)};
      pw2 = (u32x4){PKW(pB1, 0), PKW(pB1, 2), PKW(pB1, 4), PKW(pB1, 6)}; pw3 = (u32x4){PKW(pB1, 8), PKW(pB1, 10), PKW(pB1, 12), PKW(pB1, 14)};
      SBAR(); att::pv(o, (int)(unsigned)(uintptr_t)(vp0 + sl_cur), PAF(0), PAF(1), PAF(2), PAF(3)); }
    l_reg = att::swap_lo(l_reg) + att::swap_hi(l_reg);
    if (hi == 0) wsf[32 + r32] = l_reg; asm volatile("s_waitcnt lgkmcnt(0)" ::: "memory");
    float rli[16];
#pragma unroll
    for (int r = 0; r < 16; ++r) rli[r] = __builtin_amdgcn_rcpf(wsf[32 + crow(r, hi)]);
    bf16_t* Ow = O + (rowbase + q0 + wid * 32) * OPITCH + h * HD;
    { LAS bf16_t* stg = (LAS bf16_t*)(shm + LDS_OST) + wid * 2048;
#pragma unroll
      for (int r = 0; r < 16; ++r) { const int orow = crow(r, hi);
#pragma unroll
        for (int d0 = 0; d0 < 2; ++d0) stg[orow * 64 + d0 * 32 + r32] = (bf16_t)(cvt_pk_bf16(o[d0][r] * rli[r], 0.f) & 0xffffu); }
      asm volatile("s_waitcnt lgkmcnt(0)" ::: "memory");
#pragma unroll
      for (int i = 0; i < 4; ++i) { const int row = i * 8 + (lane >> 3), ch = lane & 7; const u32x4 v = *(const LAS u32x4*)(stg + row * 64 + ch * 8); *(u32x4*)(Ow + (long)row * OPITCH + ch * 8) = v;
        att::store_row_ssq(v, hs + (rowbase + q0 + wid * 32 + row) * 16, ch); } }
    asm volatile("s_waitcnt lgkmcnt(0)\n\ts_barrier" ::: "memory");
#undef DMA_K
#undef DMA_V
#undef CMASK
#undef RESC
#undef ROT
#undef PKW
#undef PAF
#undef VFR
#undef PIN
#undef MX3
#undef GAPA
#undef GAPB
#undef EX
#undef VRD
#undef KRD
#undef KRDX
#undef STEP
#undef ENDW
#undef VOTE
#undef TALLY
}
#undef SBAR
#undef WAIT_BAR
}


namespace sbk {
constexpr int QB = 256, KVBLK = 64, PITCH = HW, OPITCH = DM, NBURST = 6, SLOTB = 8192;
constexpr int LDS_K = 0, LDS_V = NBURST * SLOTB, LDS_FLAG = 2 * NBURST * SLOTB, LDS_END = LDS_FLAG + 128;
static_assert(LDS_END <= RING_BYTES, "sb LDS");
using att::crow; using att::glds16s; using att::qkt; using att::pv; using att::swap_lo;
__device__ __forceinline__ void sb_tile(const LAS char* Kslot, int vb, const bf16x8* qr, bf16x8 TD0, bf16x8 TD1, bf16x8 TONE, int jb, int qrel, int r32, int hi, float& R, f32x16* o) {
    f32x16 p0, p1; const f32x16 z16 = f32x16{};
    qkt(p0, p1, Kslot, qr, z16, r32, hi);
    if (jb >= 0) {
#pragma unroll
        for (int r = 0; r < 16; ++r) { const int kv = 64 * jb + crow(r, hi); if (kv >= qrel) p0[r] = -1.0e30f; if (kv + 32 >= qrel) p1[r] = -1.0e30f; } }
    f32x16 l0, l1;
#pragma unroll
    for (int r = 0; r < 16; ++r) {
        l0[r] = -(fmaxf(p0[r], 0.f) + __builtin_amdgcn_logf(1.0f + __builtin_amdgcn_exp2f(-fabsf(p0[r]))));
        l1[r] = -(fmaxf(p1[r], 0.f) + __builtin_amdgcn_logf(1.0f + __builtin_amdgcn_exp2f(-fabsf(p1[r])))); }
    u32x4 lw0 = {cvt_pk_bf16(l0[0], l0[1]), cvt_pk_bf16(l0[2], l0[3]), cvt_pk_bf16(l0[4], l0[5]), cvt_pk_bf16(l0[6], l0[7])};
    u32x4 lw1 = {cvt_pk_bf16(l0[8], l0[9]), cvt_pk_bf16(l0[10], l0[11]), cvt_pk_bf16(l0[12], l0[13]), cvt_pk_bf16(l0[14], l0[15])};
    u32x4 lw2 = {cvt_pk_bf16(l1[0], l1[1]), cvt_pk_bf16(l1[2], l1[3]), cvt_pk_bf16(l1[4], l1[5]), cvt_pk_bf16(l1[6], l1[7])};
    u32x4 lw3 = {cvt_pk_bf16(l1[8], l1[9]), cvt_pk_bf16(l1[10], l1[11]), cvt_pk_bf16(l1[12], l1[13]), cvt_pk_bf16(l1[14], l1[15])};
    f32x16 rt;
#pragma unroll
    for (int r = 0; r < 16; ++r) rt[r] = R;
    f32x16 t0 = MFMA32(TD0, __builtin_bit_cast(bf16x8, lw0), rt); t0 = MFMA32(TD1, __builtin_bit_cast(bf16x8, lw1), t0);
    t0 = MFMA32(TONE, __builtin_bit_cast(bf16x8, lw2), t0); t0 = MFMA32(TONE, __builtin_bit_cast(bf16x8, lw3), t0);
    f32x16 t1 = MFMA32(TD0, __builtin_bit_cast(bf16x8, lw2), rt); t1 = MFMA32(TD1, __builtin_bit_cast(bf16x8, lw3), t1);
#pragma unroll
    for (int r = 0; r < 16; ++r) { p0[r] = __builtin_amdgcn_exp2f(p0[r] + t0[r]); p1[r] = __builtin_amdgcn_exp2f(p1[r] + t1[r]); }
    R = swap_lo(t0[0]);
    u32x4 pw0 = {cvt_pk_bf16(p0[0], p0[1]), cvt_pk_bf16(p0[2], p0[3]), cvt_pk_bf16(p0[4], p0[5]), cvt_pk_bf16(p0[6], p0[7])};
    u32x4 pw1 = {cvt_pk_bf16(p0[8], p0[9]), cvt_pk_bf16(p0[10], p0[11]), cvt_pk_bf16(p0[12], p0[13]), cvt_pk_bf16(p0[14], p0[15])};
    u32x4 pw2 = {cvt_pk_bf16(p1[0], p1[1]), cvt_pk_bf16(p1[2], p1[3]), cvt_pk_bf16(p1[4], p1[5]), cvt_pk_bf16(p1[6], p1[7])};
    u32x4 pw3 = {cvt_pk_bf16(p1[8], p1[9]), cvt_pk_bf16(p1[10], p1[11]), cvt_pk_bf16(p1[12], p1[13]), cvt_pk_bf16(p1[14], p1[15])};
    pv(o, vb, __builtin_bit_cast(bf16x8, pw0), __builtin_bit_cast(bf16x8, pw1), __builtin_bit_cast(bf16x8, pw2), __builtin_bit_cast(bf16x8, pw3));
}
#define SB_WAITBAR(N) asm volatile("s_waitcnt vmcnt(" #N ") lgkmcnt(0)\n\ts_barrier" ::: "memory")
__device__ __forceinline__ void sb_unit(int b, int h, int qb, const bf16_t* Q, const bf16_t* K, const bf16_t* V, bf16_t* O, float* hs, LAS char* shm) {
    int tid = threadIdx.x; asm volatile("" : "+v"(tid)); const int lane = tid & 63, r32 = lane & 31, hi = lane >> 5; const int wid = __builtin_amdgcn_readfirstlane(tid >> 6);
    const long rowbase = (long)b * SEQ; const int q0 = qb * QB;
    const bf16_t* Qw = Q + (rowbase + q0 + wid * 32) * PITCH + h * HD;
    const bf16_t* Kh = K + rowbase * PITCH + h * HD; const bf16_t* Vh = V + rowbase * PITCH + h * HD;
    const unsigned lds0 = (unsigned)(uintptr_t)shm;
    LAS unsigned* flags = (LAS unsigned*)(shm + LDS_FLAG);
    const unsigned koff = (unsigned)(lane * PITCH + wid * 8) * 2u, voff = (unsigned)((16 * (wid & 3) + (lane >> 2)) * PITCH + (wid >> 2) * 32 + (lane & 3) * 8) * 2u;
    const unsigned kdst = lds0 + LDS_K + wid * 1024, vdst = lds0 + LDS_V + wid * 1024;
#define SB_DMA(p, slot) do { glds16s(Kh + (long)(NT - 1 - (p)) * KVBLK * PITCH, koff, (unsigned)__builtin_amdgcn_readfirstlane(kdst + (slot) * SLOTB)); \
        glds16s(Vh + (long)(NT - 1 - (p)) * KVBLK * PITCH, voff, (unsigned)__builtin_amdgcn_readfirstlane(vdst + (slot) * SLOTB)); } while (0)
    const int vb0 = (int)(lds0 + LDS_V) + ((lane >> 4) & 1) * 32 + (lane & 3) * 8 + (4 * hi + ((lane & 15) >> 2)) * 64;
    const int NT = (q0 + QB) / KVBLK, NB = NT < NBURST ? NT : NBURST;
    for (int p = 0; p < NB; ++p) SB_DMA(p, p);
    bf16x8 qr[4];
#pragma unroll
    for (int d0 = 0; d0 < 4; ++d0) qr[d0] = *(const bf16x8*)(Qw + (long)r32 * PITCH + d0 * 16 + hi * 8);
    f32x16 o[2]; o[0] = f32x16{}; o[1] = f32x16{};
    const int qrel = wid * 32 + r32;
    float R = 0.f;
    bf16x8 TD0, TD1, TONE;
#pragma unroll
    for (int j = 0; j < 8; ++j) { const int kvl = 8 * (j >> 2) + 4 * hi + (j & 3); TD0[j] = (kvl >= r32) ? (short)0x3F80 : (short)0; TD1[j] = (16 + kvl >= r32) ? (short)0x3F80 : (short)0; TONE[j] = (short)0x3F80; }
    if (NB > 4) { SB_WAITBAR(4); } else { SB_WAITBAR(0); }
    bool mid_done = (NB <= 4);
    int p = 3 - (wid >> 1);
    for (; p < NB; ++p) {
        if (p >= 4 && !mid_done) { SB_WAITBAR(0); mid_done = true; }
        sb_tile(shm + LDS_K + p * SLOTB, vb0 + p * SLOTB, qr, TD0, TD1, TONE, 3 - p, qrel, r32, hi, R, o);
        if (__all(R < SB_EXIT)) { ++p; break; }
    }
    if (!mid_done) { SB_WAITBAR(0); }
    { const bool dn = __all(R < SB_EXIT) || (p >= NT); if (lane == 0) flags[wid] = dn ? 1u : 0u; }
    SB_WAITBAR(0);
    bool alldone;
    { const u32x4 fa = *(const LAS u32x4*)flags, fb = *(const LAS u32x4*)(flags + 4); alldone = __builtin_amdgcn_readfirstlane((fa.x & fa.y & fa.z & fa.w & fb.x & fb.y & fb.z & fb.w) != 0u); }
    if (!alldone && NB < NT) {
        SB_DMA(NB, 0);
        for (int i = 0; NB + i < NT; ++i) {
            const int pp = NB + i, sl = i & 1;
            SB_WAITBAR(0);
            if (i > 0) { const LAS unsigned* fl = flags + 8 + ((i - 1) & 1) * 8; const u32x4 fa = *(const LAS u32x4*)fl, fb = *(const LAS u32x4*)(fl + 4);
                if (__builtin_amdgcn_readfirstlane((fa.x & fa.y & fa.z & fa.w & fb.x & fb.y & fb.z & fb.w) != 0u)) break; }
            if (pp + 1 < NT) SB_DMA(pp + 1, sl ^ 1);
            if (!__all(R < SB_EXIT)) sb_tile(shm + LDS_K + sl * SLOTB, vb0 + sl * SLOTB, qr, TD0, TD1, TONE, -1, qrel, r32, hi, R, o);
            { const bool dn = __all(R < SB_EXIT); if (lane == 0) flags[8 + (i & 1) * 8 + wid] = dn ? 1u : 0u; }
        }
        SB_WAITBAR(0);
    }
    bf16_t* Ow = O + (rowbase + q0 + wid * 32) * OPITCH + h * HD;
    { LAS bf16_t* stg = (LAS bf16_t*)(shm + LDS_K) + wid * 2048;
#pragma unroll
      for (int r = 0; r < 16; ++r) { const int orow = crow(r, hi);
#pragma unroll
        for (int d0 = 0; d0 < 2; ++d0) stg[orow * 64 + d0 * 32 + r32] = (bf16_t)(cvt_pk_bf16(o[d0][r], 0.f) & 0xffffu); }
      LDS_WAIT();
#pragma unroll
      for (int i = 0; i < 4; ++i) { const int row = i * 8 + (lane >> 3), ch = lane & 7; const u32x4 v = *(const LAS u32x4*)(stg + row * 64 + ch * 8); *(u32x4*)(Ow + (long)row * OPITCH + ch * 8) = v;
        att::store_row_ssq(v, hs + (rowbase + q0 + wid * 32 + row) * 16, ch); } }
    asm volatile("s_waitcnt vmcnt(0) lgkmcnt(0)\n\ts_barrier" ::: "memory");
#undef SB_DMA
}
#undef SB_WAITBAR
}

#define XB_TMO      128
#define XB_XCNT(j)  (256  + 64 * (j))
#define XB_XSUB(j)  (1280 + 64 * (j))
#define XB_XGEN(j)  (2304 + 64 * (j))
#define XB_TOP      3328
#define XB_TOPGEN   3392
#define XCD_BAR_WORDS 3456
#define XB_SPIN_CAP (1u << 18)
__device__ __forceinline__ unsigned xb_ld(unsigned* p)              { return __hip_atomic_load(p, __ATOMIC_RELAXED, __HIP_MEMORY_SCOPE_AGENT); }
__device__ __forceinline__ unsigned xb_add(unsigned* p, unsigned v) { return __hip_atomic_fetch_add(p, v, __ATOMIC_RELAXED, __HIP_MEMORY_SCOPE_AGENT); }
__device__ __forceinline__ unsigned xb_xcc_id() { return (unsigned)__builtin_amdgcn_s_getreg((3 << 11) | 20) & 0xFu; }
#define XB_SPIN(cond, bar) do { unsigned _sp = 0; while (cond) { __builtin_amdgcn_s_sleep(1); \
    if ((++_sp & 255u) == 0u) { if (xb_ld(&(bar)[XB_TMO])) break; if (_sp > XB_SPIN_CAP) { atomicAdd(&(bar)[XB_TMO], 1u); break; } } } } while (0)
struct XcdBarrier { unsigned* bar; unsigned x; volatile LAS unsigned* st; };
__device__ __forceinline__ XcdBarrier xcd_barrier_post(unsigned* bar, volatile LAS unsigned* st) {
    XcdBarrier b; b.bar = bar; b.x = xb_xcc_id(); b.st = st;
    if (threadIdx.x == 0) (void)xb_add(&bar[XB_XCNT(b.x)], 1u);
    return b;
}
__device__ __forceinline__ void xcd_barrier_complete(unsigned* bar, unsigned x, unsigned& nloc, unsigned& nx) {
    const unsigned G = gridDim.x * gridDim.y * gridDim.z;
    unsigned sum, cnt, mine, sp = 0u;
    for (;;) {
        sum = 0u; cnt = 0u; mine = 0u;
#pragma unroll
        for (unsigned j = 0; j < 16; ++j) { const unsigned c = xb_ld(&bar[XB_XCNT(j)]); sum += c; cnt += (c > 0u) ? 1u : 0u; mine = (j == x) ? c : mine; }
        if (sum == G) break;
        __builtin_amdgcn_s_sleep(1);
        if ((++sp & 255u) == 0u) { if (xb_ld(&bar[XB_TMO])) break; if (sp > XB_SPIN_CAP) { atomicAdd(&bar[XB_TMO], 1u); break; } }
    }
    nloc = mine > 0u ? mine : 1u; nx = cnt > 0u ? cnt : 1u;
}
__device__ __forceinline__ void xcd_barrier(const XcdBarrier& b) {
    asm volatile("s_waitcnt vmcnt(0)" ::: "memory");
    __syncthreads();
    if (threadIdx.x == 0) {
        unsigned* bar = b.bar;
        __builtin_amdgcn_s_waitcnt(0);
        unsigned nloc = b.st[0], nx = b.st[1];
        if (nloc == 0u) { xcd_barrier_complete(bar, b.x, nloc, nx); b.st[0] = nloc; b.st[1] = nx; }
        const unsigned old = xb_add(&bar[XB_XSUB(b.x)], 1u);
        const unsigned gen = old / nloc;
        if (old + 1u == (gen + 1u) * nloc) {
            __builtin_amdgcn_fence(__ATOMIC_RELEASE, "agent");
            asm volatile("s_waitcnt vmcnt(0)" ::: "memory");
            const unsigned og = xb_add(&bar[XB_TOP], 1u);
            const unsigned tg = og / nx;
            if (og + 1u == (tg + 1u) * nx) xb_add(&bar[XB_TOPGEN], 1u);
            else XB_SPIN(xb_ld(&bar[XB_TOPGEN]) == tg, bar);
            __builtin_amdgcn_fence(__ATOMIC_ACQUIRE, "agent");
            xb_add(&bar[XB_XGEN(b.x)], 1u);
            asm volatile("s_waitcnt vmcnt(0)" ::: "memory");
        } else {
            XB_SPIN(xb_ld(&bar[XB_XGEN(b.x)]) == gen, bar);
            __builtin_amdgcn_fence(__ATOMIC_ACQUIRE, "agent");
            asm volatile("s_waitcnt vmcnt(0)" ::: "memory");
        }
    }
    __syncthreads();
}

__device__ __forceinline__ const void* ldp(const volatile LAS unsigned* tab, int i) {
    const unsigned lo = __builtin_amdgcn_readfirstlane(tab[2 * i]), hi = __builtin_amdgcn_readfirstlane(tab[2 * i + 1]);
    return (const void*)(((unsigned long long)hi << 32) | lo);
}
struct Args {
    const float* x; const float* mem; const float* norm_mix; const float* w_in; const float* b_forget; const float* norm_fox; const float* norm_sb; const float* w_out;
    const float* norm_xattn; const float* norm_mem; const float* w_xq; const float* w_xkv; const float* w_xo; const float* norm_ffn;
    const float* w_rg; const float* b_rg; const float* w_re; const float* b_re; const float* w_gate; const float* w_up; const float* w_down; const float* norm_final;
    float* out; unsigned char* ws;
};

__device__ __forceinline__ void transpose_item(const float* W, int ldw, bf16_t* WT, int ldo, int k0, int n0, int dst_row0, const float* gain, LAS float* scr, int lane) {
    float tv[32], tg[32];
#pragma unroll
    for (int i = 0; i < 32; ++i) { const int kk = 2 * i + (lane >> 5); tv[i] = W[(size_t)(k0 + kk) * ldw + n0 + (lane & 31)]; tg[i] = gain ? gain[k0 + kk] : 1.f; }
#pragma unroll
    for (int i = 0; i < 32; ++i) { const int kk = 2 * i + (lane >> 5); scr[kk * 33 + (lane & 31)] = tv[i] * tg[i]; }
    LDS_WAIT(); asm volatile("" ::: "memory");
    const int c = lane & 7;
#pragma unroll
    for (int j = 0; j < 4; ++j) { const int n = (lane >> 3) + 8 * j; const LAS float* s = scr + (8 * c) * 33 + n;
        u32x4 o; o.x = cvt_pk_bf16(s[0 * 33], s[1 * 33]); o.y = cvt_pk_bf16(s[2 * 33], s[3 * 33]); o.z = cvt_pk_bf16(s[4 * 33], s[5 * 33]); o.w = cvt_pk_bf16(s[6 * 33], s[7 * 33]);
        *(u32x4*)(WT + (size_t)(dst_row0 + n) * ldo + k0 + 8 * c) = o; }
    LDS_WAIT(); asm volatile("" ::: "memory");
}

struct SchedDense {
    const char* A; const char* Bt; int nM, nN, G, c; size_t a_tile, b_tile, b_batch; int split_tiles;
    __device__ __forceinline__ bool next(int i, pg8::Unit& u) const {
        int pm, pn; if (!pg8::tile_order(i, G, c, nM, nN, pm, pn)) return false;
        u.a = A + (size_t)pm * a_tile; u.b = Bt + (size_t)pn * b_tile + (size_t)(pm >> 5) * b_batch; u.orow = pm * 256;
        if (split_tiles) { u.aux = pn / split_tiles; u.ocol = (pn % split_tiles) * 256; } else { u.aux = 1; u.ocol = pn * 256; }
        u.rows = nullptr; u.nvalid = 256; return true;
    }
};
struct SchedGH {
    const char* KVm; const char* Wxq; const char* Wxo; int G, c;
    __device__ __forceinline__ bool next(int i, pg8::Unit& u) const {
        const int L = i * G + c; if (L >= 256) return false;
        const int kind = L >> 7, r = L & 127, bh = r >> 2, j = r & 3, b = bh >> 2, h = bh & 3;
        if (kind == 0) { u.a = KVm + ((size_t)(b * 256) * 2048 + h * 256) * 2; u.b = Wxq + ((size_t)(256 * j) * 1024 + h * 256) * 2; u.orow = b * 1024 + h * 256; u.ocol = 256 * j; u.aux = 1; }
        else { u.a = Wxo + ((size_t)(256 * j) * 1024 + h * 256) * 2; u.b = KVm + ((size_t)(b * 256) * 2048 + 1024 + h * 256) * 2; u.orow = b * 1024 + 256 * j; u.ocol = h * 256; u.aux = 2; }
        u.rows = nullptr; u.nvalid = 256; return true;
    }
};
template <int KIND> struct SchedGHk { SchedGH s; __device__ __forceinline__ bool next(int i, pg8::Unit& u) const { const int c2 = (s.G >= 256) ? s.c - 128 * KIND : s.c; if (c2 < 0) return false; const int L = i * s.G + c2; if (L >= 128) return false; SchedGH t = s; t.G = 1; t.c = 0; return t.next(128 * KIND + L, u); } };
struct EpiGH { static constexpr bool HAS_MID = false; bf16_t* GTp; bf16_t* HTp; __device__ __forceinline__ void operator()(const f32x4 (&acc)[2][2][4][2], const pg8::Unit& u, int wr, int wc, int fr, int fq) const {
    pg8::EpiBf16 e{u.aux == 1 ? GTp : HTp, DM, nullptr, 0, 1.f, 1.f, nullptr}; pg8::Unit v = u; v.aux = 1; e(acc, v, wr, wc, fr, fq); } };
struct SchedMoe {
    const char* A; const char* W; const int* list; const LAS int* tbl; int G, c, NPN; size_t w_exp, w_tile, a_tile; int ocol_w;
    __device__ __forceinline__ bool next(int i, pg8::Unit& u) const {
        const int L = i * G + c; const int tl = L / NPN, pn = L % NPN;
        if (tl >= __builtin_amdgcn_readfirstlane(tbl[16])) return false;
        int e = 0;
#pragma unroll 1
        for (int x = 1; x < NEXP; ++x) { if (tl >= __builtin_amdgcn_readfirstlane(tbl[x])) e = x; }
        const int j = tl - __builtin_amdgcn_readfirstlane(tbl[e]), n = __builtin_amdgcn_readfirstlane(tbl[32 + e]) - 256 * j;
        u.a = A + (size_t)tl * a_tile; u.b = W + (size_t)e * w_exp + (size_t)pn * w_tile; u.orow = tl * 256; u.ocol = pn * ocol_w; u.aux = 1;
        u.rows = list + (size_t)e * M + 256 * j; u.nvalid = n < 256 ? n : 256; return true;
    }
};
__device__ __forceinline__ void moe_table(LAS int* tbl, const unsigned* ctl) {
    if (threadIdx.x == 0) { int base = 0; for (int e = 0; e < NEXP; ++e) { const int n = (int)ctl[CW_CNT + 64 * e]; tbl[e] = base; tbl[32 + e] = n; base += (n + 255) >> 8; } tbl[16] = base; }
    __syncthreads();
}

__global__ void __launch_bounds__(NWAVES * 64, 2) hymba_fwd(Args args) {
    extern __shared__ __attribute__((aligned(16))) unsigned char lds_raw[];
    LAS unsigned char* lds = (LAS unsigned char*)lds_raw;
    volatile LAS unsigned* MISC = (volatile LAS unsigned*)(lds + MISC_OFF);
    const int tid0 = threadIdx.x; const int wave = __builtin_amdgcn_readfirstlane(tid0 >> 6);
    const int G = gridDim.x; const int bx = blockIdx.x; const int vcu = (G % 8 == 0) ? (bx % 8) * (G / 8) + bx / 8 : bx;
    volatile LAS unsigned* ATAB = (volatile LAS unsigned*)(lds + MISC_OFF + 512);
    for (int u = tid0; u < 256; u += NWAVES * 64) ((LAS unsigned*)(lds + MISC_OFF))[u] = 0u;
    __syncthreads();
    if (tid0 == 0) { const float* const* ap = (const float* const*)&args;
#pragma unroll
        for (int i = 0; i < 24; ++i) { const unsigned long long v = (unsigned long long)ap[i]; ATAB[2 * i] = (unsigned)v; ATAB[2 * i + 1] = (unsigned)(v >> 32); } }
    __syncthreads();
#define ARGP(name) ((const float*)ldp(ATAB, (int)(offsetof(Args, name) / 8)))
#define PHASE_PTRS \
    int tid = threadIdx.x; asm volatile("" : "+v"(tid)); const int lane = tid & 63; (void)lane; \
    unsigned char* const ws = (unsigned char*)ldp(ATAB, 23); float* const out = (float*)ldp(ATAB, 22); unsigned* const ctl = (unsigned*)(ws + WS_CTL); (void)out; (void)ctl; \
    bf16_t* const Win_t = (bf16_t*)(ws + WS_WIN); bf16_t* const Wout_t = (bf16_t*)(ws + WS_WOUT); bf16_t* const Wxq_n = (bf16_t*)(ws + WS_WXQ); bf16_t* const Wxkv_t = (bf16_t*)(ws + WS_WXKV); \
    bf16_t* const Wxo_t = (bf16_t*)(ws + WS_WXO); bf16_t* const Wgu_t = (bf16_t*)(ws + WS_WGU); bf16_t* const Wd_t = (bf16_t*)(ws + WS_WD); \
    float* const RX = (float*)(ws + WS_RX); float* const RMEM = (float*)(ws + WS_RMEM); float* const LF = (float*)(ws + WS_LF); float* const CC = (float*)(ws + WS_C2); float* const SSQ = (float*)(ws + WS_SSQ); \
    int* const TOKSLOT = (int*)(ws + WS_TOKSLOT); float* const TOKW = (float*)(ws + WS_TOKW); int* const LIST = (int*)(ws + WS_LIST); \
    bf16_t* const MEMB = (bf16_t*)(ws + WS_MEMB); bf16_t* const KVM = (bf16_t*)(ws + WS_KVM); bf16_t* const GT = (bf16_t*)(ws + WS_GT); bf16_t* const HT = (bf16_t*)(ws + WS_HT); \
    bf16_t* const XB = (bf16_t*)(ws + WS_XB); bf16_t* const QKV = (bf16_t*)(ws + WS_QKV); bf16_t* const H1B = (bf16_t*)(ws + WS_H1B); bf16_t* const U2B = (bf16_t*)(ws + WS_U2B); bf16_t* const HID = (bf16_t*)(ws + WS_HID); \
    bf16_t* const OAB = (bf16_t*)(ws + WS_O); bf16_t* const YB = (bf16_t*)(ws + WS_Y); bf16_t* const KX = (bf16_t*)(ws + WS_KX); (void)KX; float* const HS = (float*)(ws + WS_HS); (void)HS; \
    (void)Win_t; (void)Wout_t; (void)Wxq_n; (void)Wxkv_t; (void)Wxo_t; (void)Wgu_t; (void)Wd_t; (void)RX; (void)RMEM; (void)LF; (void)CC; (void)SSQ; (void)TOKSLOT; (void)TOKW; (void)LIST; \
    (void)MEMB; (void)KVM; (void)GT; (void)HT; (void)XB; (void)QKV; (void)H1B; (void)U2B; (void)HID; (void)OAB; (void)YB;
    XcdBarrier bar;
    { unsigned char* const ws0 = (unsigned char*)ldp(ATAB, 23); bar = xcd_barrier_post((unsigned*)(ws0 + WS_CTL) + CW_BAR, MISC + 8); }
    const int gw = vcu * NWAVES + wave, NGW = G * NWAVES;


    if (PH(0))
    for (int rep_ = 0; rep_ < REPS(0); ++rep_)
    {
        PHASE_PTRS
        LAS float* wfT = (LAS float*)(lds + RING_OFF);
        LAS float* scr = (LAS float*)(lds + RING_OFF + 32768 + wave * 8448);
        { const float* win = ARGP(w_in); const float* gmix = ARGP(norm_mix);
          f32x4 fa[2], fb[2]; float gk[2];
#pragma unroll
          for (int q = 0; q < 2; ++q) { const int k = tid + 512 * q; gk[q] = gmix[k]; fa[q] = *(const f32x4*)(win + (size_t)k * WIN_LD + NPROJ); fb[q] = *(const f32x4*)(win + (size_t)k * WIN_LD + NPROJ + 4); }
#pragma unroll
          for (int q = 0; q < 2; ++q) { const int k = tid + 512 * q;
#pragma unroll
              for (int j = 0; j < 4; ++j) { wfT[j * DM + k] = fa[q][j] * gk[q]; wfT[(4 + j) * DM + k] = fb[q][j] * gk[q]; } } }
        constexpr int I_IN = 16 * 96, I_OUT = 16 * 32, I_XKV = 16 * 64, I_XO = 16 * 32, I_G = 16 * 16 * 8, I_U = I_G, I_D = 16 * 4 * 32, I_XQ = 1024;
        constexpr int NITEMS = I_IN + I_OUT + I_XKV + I_XO + I_G + I_U + I_D + I_XQ;
        for (int it = gw; it < NITEMS; it += NGW) {
            int r = it;
            if (r < I_IN) { const int kb = r / 96, nb = r % 96; transpose_item(ARGP(w_in), WIN_LD, Win_t, DM, 64 * kb, 32 * nb, 32 * nb, ARGP(norm_mix), scr, lane); continue; } r -= I_IN;
            if (r < I_OUT) { const int kb = r / 32, nb = r % 32; const float* gn = (64 * kb < HW) ? ARGP(norm_fox) : (ARGP(norm_sb) - HW); transpose_item(ARGP(w_out), DM, Wout_t, DM, 64 * kb, 32 * nb, 32 * nb, gn, scr, lane); continue; } r -= I_OUT;
            if (r < I_XKV) { const int kb = r / 64, nb = r % 64; transpose_item(ARGP(w_xkv), 2 * DM, Wxkv_t, DM, 64 * kb, 32 * nb, 32 * nb, ARGP(norm_mem), scr, lane); continue; } r -= I_XKV;
            if (r < I_XO) { const int kb = r / 32, nb = r % 32; transpose_item(ARGP(w_xo), DM, Wxo_t, DM, 64 * kb, 32 * nb, 32 * nb, nullptr, scr, lane); continue; } r -= I_XO;
            if (r < I_G + I_U) { const int up = r >= I_G; const int q = up ? r - I_G : r; const int e = q / 128, kb = (q % 128) / 8, nb = q % 8; const int n0 = 32 * nb;
                const float* W = (up ? ARGP(w_up) : ARGP(w_gate)) + (size_t)e * DM * DFF;
                transpose_item(W, DFF, Wgu_t + (size_t)e * 512 * DM, DM, 64 * kb, n0, 256 * (n0 / 128) + (n0 % 128) + (up ? 128 : 0), nullptr, scr, lane); continue; } r -= I_G + I_U;
            if (r < I_D) { const int e = r / 128, kb = (r % 128) / 32, nb = r % 32; transpose_item(ARGP(w_down) + (size_t)e * DFF * DM, DM, Wd_t + (size_t)e * DM * DFF, DFF, 64 * kb, 32 * nb, 32 * nb, nullptr, scr, lane); continue; } r -= I_D;
            { const int k = r; const float gk = ARGP(norm_xattn)[k]; const f32x4* src = (const f32x4*)(ARGP(w_xq) + (size_t)k * DM) + lane; u32x2* dst = (u32x2*)(Wxq_n + (size_t)k * DM) + lane;
#pragma unroll
              for (int j = 0; j < 4; ++j) { const f32x4 v = src[64 * j] * gk; u32x2 w; w.x = cvt_pk_bf16(v[0], v[1]); w.y = cvt_pk_bf16(v[2], v[3]); dst[64 * j] = w; } }
        }
        __syncthreads();
        const float* xin = ARGP(x); const float* memin = ARGP(mem); const float* bfg = ARGP(b_forget);
        f32x4 vnx[4];
        { const int r0_ = gw; if (r0_ < M + MEMROWS) { const bool im_ = r0_ >= M; const f32x4* xr = (const f32x4*)((im_ ? memin : xin) + (size_t)(im_ ? r0_ - M : r0_) * DM) + lane;
#pragma unroll
            for (int j = 0; j < 4; ++j) vnx[j] = xr[64 * j]; } }
        for (int row = gw; row < M + MEMROWS; row += NGW) {
            const bool is_mem = row >= M; const int r = is_mem ? row - M : row;
            f32x4 v[4]; float s = 0.f;
#pragma unroll
            for (int j = 0; j < 4; ++j) v[j] = vnx[j];
            { const int nr_ = row + NGW; if (nr_ < M + MEMROWS) { const bool im_ = nr_ >= M; const f32x4* xr = (const f32x4*)((im_ ? memin : xin) + (size_t)(im_ ? nr_ - M : nr_) * DM) + lane;
#pragma unroll
                for (int j = 0; j < 4; ++j) vnx[j] = xr[64 * j]; } }
#pragma unroll
            for (int j = 0; j < 4; ++j) s += (v[j][0] * v[j][0] + v[j][1] * v[j][1]) + (v[j][2] * v[j][2] + v[j][3] * v[j][3]);
            const float rinv = rsqrtf(wave_sum(s) * (1.0f / DM) + EPS);
            u32x2* o8 = (u32x2*)((is_mem ? MEMB : XB) + (size_t)r * DM) + lane;
#pragma unroll
            for (int j = 0; j < 4; ++j) { u32x2 w; w.x = cvt_pk_bf16(v[j][0], v[j][1]); w.y = cvt_pk_bf16(v[j][2], v[j][3]); o8[64 * j] = w; }
            if (is_mem) { if (lane == 0) RMEM[r] = rinv; continue; }
            float f[8];
#pragma unroll
            for (int jj = 0; jj < 8; ++jj) { float a = 0.f;
#pragma unroll
                for (int j = 0; j < 4; ++j) { const f32x4 w4 = *(const LAS f32x4*)(wfT + jj * DM + 256 * j + 4 * lane); a += (v[j][0] * w4[0] + v[j][1] * w4[1]) + (v[j][2] * w4[2] + v[j][3] * w4[3]); }
                f[jj] = wave_sum(a); }
            if (lane == 0) RX[r] = rinv;
            if (lane < 8) { float fl = 0.f;
#pragma unroll
                for (int jj = 0; jj < 8; ++jj) fl = (lane == jj) ? f[jj] : fl;
                fl = fl * rinv + bfg[lane];
                const float ls = fminf(fl, 0.f) - log1pf(expf(-fabsf(fl)));
                LF[(size_t)r * 8 + lane] = ls * LOG2E; }
        }
    }
    xcd_barrier(bar);

    if (PH(1))
    if (vcu < 32) {
        PHASE_PTRS
        const int b = vcu >> 2, h = (vcu & 3) * 2 + (wave >> 2), seg = wave & 3, s0 = seg * 2048 + lane * 32;
        const float* src = LF + ((size_t)b * SEQ + s0) * 8 + h;
        float p[32];
#pragma unroll
        for (int j = 0; j < 32; ++j) p[j] = src[j * 8];
#pragma unroll
        for (int j = 1; j < 32; ++j) p[j] += p[j - 1];
        float inc = p[31];
#pragma unroll
        for (int o = 1; o < 64; o <<= 1) { const float y = __shfl_up(inc, o); if (lane >= o) inc += y; }
        LAS float* tot = (LAS float*)(lds + EXTRA_OFF);
        if (lane == 63) tot[wave] = inc;
        __syncthreads();
        float off = inc - p[31];
        for (int q = 0; q < 3; ++q) if (q < seg) off += tot[(wave & 4) + q];
        float* dst = CC + ((size_t)b * NH + h) * SEQ + s0; bf16_t* kx = KX + (((size_t)b * NH + h) * SEQ + s0) * 8;
#pragma unroll
        for (int j = 0; j < 32; ++j) { const float x = off + p[j]; dst[j] = x;
            unsigned hm, lo; fox::split3(-x, hm, lo); u32x4 w; w.x = 0x3F803F80u; w.y = 0x3F80u | (hm << 16); w.z = (hm >> 16) | (lo << 16); w.w = 0u;
            *(u32x4*)(kx + j * 8) = w; }
        VM_WAIT(); __syncthreads();
    }
    if (PH(1))
    for (int rep_ = 0; rep_ < REPS(1); ++rep_)
    {
        PHASE_PTRS
        pg8::Gemm g{DM, DM, DM};
        SchedDense S{(const char*)XB, (const char*)Win_t, M / 256, NPROJ / 256, G, bx, (size_t)256 * DM * 2, (size_t)256 * DM * 2, 0, 2};
        pg8::EpiBf16 E{QKV, HW, RX, QKV_STRIDE, C2, C2, ctl + CW_KN};
        pg8::gemm_phase<pg8::EpiBf16, SchedDense, true, false>(lds + RING_OFF, g, S, E);
    }
    xcd_barrier(bar);

    if (PH(2))
    {
        PHASE_PTRS
        const bf16_t* QA = QKV; const bf16_t* KA = QKV + QKV_STRIDE; const bf16_t* VA = QKV + 2 * QKV_STRIDE;
        const bf16_t* QBp = QKV + 3 * QKV_STRIDE; const bf16_t* KBp = QKV + 4 * QKV_STRIDE; const bf16_t* VBp = QKV + 5 * QKV_STRIDE;
        bf16_t* OA = OAB; bf16_t* OB = OAB + HW;
        LAS char* shm = (LAS char*)(lds + RING_OFF);
        for (int rep = 0; rep < REP_FOX; ++rep)
        for (int i = 0; i < 8; ++i) { const int bh = (vcu >> 5) * 8 + i, x = vcu & 31, qb = (i & 1) ? 31 - x : x;
            const float kmax = sqrtf(__uint_as_float(ctl[CW_KN + bh * 2]) + __uint_as_float(ctl[CW_KN + bh * 2 + 1])) * 1.01f;
            fox::fox_unit<8>(bh, qb, QA, KA, VA, OA, HS + (bh & 7), CC + (size_t)bh * SEQ, KX + (size_t)bh * SEQ * 8, kmax, shm); }
        for (int rep = 0; rep < REP_SB; ++rep)
        for (int i = 0; i < 8; ++i) { const int bh = vcu >> 2, qb = 8 * (vcu & 3) + i;
            sbk::sb_unit(bh >> 3, bh & 7, qb, QBp, KBp, VBp, OB, HS + 8 + (bh & 7), shm); }
        VM_WAIT(); __syncthreads();
        pg8::Gemm g{DM, DM, DM};
        SchedDense S2{(const char*)MEMB, (const char*)Wxkv_t, MEMROWS / 256, 2 * DM / 256, G, bx, (size_t)256 * DM * 2, (size_t)256 * DM * 2, 0, 0};
        pg8::EpiBf16 E2{KVM, 2 * DM, RMEM, 0, 1.f, 1.f, nullptr};
        pg8::gemm_phase<pg8::EpiBf16, SchedDense, true, false>(lds + RING_OFF, g, S2, E2);
    }
    xcd_barrier(bar);

    if (PH(4))
    for (int rep_ = 0; rep_ < REPS(4); ++rep_)
    {
        PHASE_PTRS
        pg8::Gemm g{DM, DM, DM};
        SchedDense S{(const char*)OAB, (const char*)Wout_t, M / 256, DM / 256, G, bx, (size_t)256 * DM * 2, (size_t)256 * DM * 2, 0, 0};
        pg8::EpiOutProj E{XB, H1B, SSQ, HS};
        pg8::gemm_phase<pg8::EpiOutProj, SchedDense, true, false>(lds + RING_OFF, g, S, E);
        pg8::Gemm g2{0, 0, 256};
        SchedGH SG{(const char*)KVM, (const char*)Wxq_n, (const char*)Wxo_t, G, bx};
        EpiGH EG{GT, HT};
        g2.lda = 2 * DM; g2.ldb = DM; SchedGHk<0> S0{SG}; pg8::gemm_phase<EpiGH, SchedGHk<0>, true, false>(lds + RING_OFF, g2, S0, EG);
        g2.lda = DM; g2.ldb = 2 * DM; SchedGHk<1> S1{SG}; pg8::gemm_phase<EpiGH, SchedGHk<1>, true, false>(lds + RING_OFF, g2, S1, EG);
    }
    xcd_barrier(bar);

    if (PH(5))
    for (int rep_ = 0; rep_ < REPS(5); ++rep_)
    {
        PHASE_PTRS
        pg8::Gemm g{DM, DM, DM};
        SchedDense S{(const char*)H1B, (const char*)GT, M / 256, DM / 256, G, bx, (size_t)256 * DM * 2, (size_t)256 * DM * 2, (size_t)DM * DM * 2, 0};
        pg8::EpiSoftmax E{XB, SSQ, (LAS float*)(lds + EXTRA_OFF)};
        pg8::gemm_phase<pg8::EpiSoftmax, SchedDense, true, false>(lds + RING_OFF, g, S, E);
    }
    xcd_barrier(bar);

    if (PH(6))
    {
        PHASE_PTRS
        pg8::Gemm g{DM, DM, DM};
        SchedDense S{(const char*)XB, (const char*)HT, M / 256, DM / 256, G, bx, (size_t)256 * DM * 2, (size_t)256 * DM * 2, (size_t)DM * DM * 2, 0};
        pg8::EpiResidBf16 E{H1B};
        pg8::gemm_phase<pg8::EpiResidBf16, SchedDense, true, false>(lds + RING_OFF, g, S, E);
    }
    xcd_barrier(bar);

    if (PH(7))
    {
        PHASE_PTRS
        LAS float* wT = (LAS float*)(lds + RING_OFF);
        { const f32x4* wg4 = (const f32x4*)ARGP(w_rg); const f32x4* we4 = (const f32x4*)ARGP(w_re);
          f32x4 ga[2], ea[2][4];
#pragma unroll
          for (int q = 0; q < 2; ++q) { const int k = tid + 512 * q; ga[q] = wg4[k];
#pragma unroll
              for (int c = 0; c < 4; ++c) ea[q][c] = we4[k * 4 + c]; }
#pragma unroll
          for (int q = 0; q < 2; ++q) { const int k = tid + 512 * q;
#pragma unroll
              for (int j = 0; j < 4; ++j) { wT[j * DM + k] = ga[q][j];
#pragma unroll
                  for (int c = 0; c < 4; ++c) wT[(4 + 4 * c + j) * DM + k] = ea[q][c][j]; } } }
        LAS int* dec_e = (LAS int*)(lds + RING_OFF + 81920); LAS float* dec_w = (LAS float*)(lds + RING_OFF + 81920 + 2048); LAS int* dec_r = (LAS int*)(lds + RING_OFF + 81920 + 4096);
        LAS int* hist = (LAS int*)(lds + RING_OFF + 81920 + 6144); LAS int* ebase = hist + 16;
        if (tid < 16) hist[tid] = 0;
        __syncthreads();
        const f32x4* gp = (const f32x4*)ARGP(norm_ffn) + lane;
        const float brg0 = ARGP(b_rg)[0], brg1 = ARGP(b_rg)[1], brg2 = ARGP(b_rg)[2], brg3 = ARGP(b_rg)[3]; const float* bre = ARGP(b_re);
        u32x2 hnx[4];
        if (gw < M) { const u32x2* hr = (const u32x2*)(H1B + (size_t)gw * DM) + lane;
#pragma unroll
            for (int j = 0; j < 4; ++j) hnx[j] = hr[64 * j]; }
        for (int row0 = gw; row0 < M; row0 += 32 * NGW) {
        for (int i = 0; i < 32; ++i) {
            const int row = row0 + i * NGW; if (row >= M) break;
            f32x4 v[4]; float s = 0.f;
#pragma unroll
            for (int j = 0; j < 4; ++j) { const u32x2 hh = hnx[j]; v[j] = (f32x4){bf16lo(hh.x), bf16hi(hh.x), bf16lo(hh.y), bf16hi(hh.y)}; s += (v[j][0] * v[j][0] + v[j][1] * v[j][1]) + (v[j][2] * v[j][2] + v[j][3] * v[j][3]); }
            if (row + NGW < M) { const u32x2* hr = (const u32x2*)(H1B + (size_t)(row + NGW) * DM) + lane;
#pragma unroll
                for (int j = 0; j < 4; ++j) hnx[j] = hr[64 * j]; }
            const float rinv = rsqrtf(wave_sum(s) * (1.0f / DM) + EPS);
            u32x2* o8 = (u32x2*)(U2B + (size_t)row * DM) + lane;
#pragma unroll
            for (int j = 0; j < 4; ++j) { v[j] = v[j] * rinv * gp[64 * j]; u32x2 w; w.x = cvt_pk_bf16(v[j][0], v[j][1]); w.y = cvt_pk_bf16(v[j][2], v[j][3]); o8[64 * j] = w; }
            float lg[20];
#pragma unroll
            for (int jj = 0; jj < 20; ++jj) { float a = 0.f;
#pragma unroll
                for (int j = 0; j < 4; ++j) { const f32x4 w4 = *(const LAS f32x4*)(wT + jj * DM + 256 * j + 4 * lane); a += (v[j][0] * w4[0] + v[j][1] * w4[1]) + (v[j][2] * w4[2] + v[j][3] * w4[3]); }
                lg[jj] = wave_sum(a); asm volatile("" : "+v"(lg[jj]) :: "memory"); }
            float g0 = lg[0] + brg0, g1 = lg[1] + brg1, g2 = lg[2] + brg2, g3 = lg[3] + brg3;
            int gi = 0; float gm = g0; if (g1 > gm) { gm = g1; gi = 1; } if (g2 > gm) { gm = g2; gi = 2; } if (g3 > gm) { gm = g3; gi = 3; }
            const float gval = 1.0f / (expf(g0 - gm) + expf(g1 - gm) + expf(g2 - gm) + expf(g3 - gm));
            float el[4];
#pragma unroll
            for (int j = 0; j < 4; ++j) { const float e0 = lg[4 + j], e1 = lg[8 + j], e2 = lg[12 + j], e3 = lg[16 + j]; el[j] = ((gi == 0) ? e0 : (gi == 1) ? e1 : (gi == 2) ? e2 : e3) + bre[gi * 4 + j]; }
            int i0 = 0; float m0 = el[0];
#pragma unroll
            for (int j = 1; j < 4; ++j) if (el[j] > m0) { m0 = el[j]; i0 = j; }
            int i1 = -1; float m1 = -3.0e38f;
#pragma unroll
            for (int j = 0; j < 4; ++j) if (j != i0 && el[j] > m1) { m1 = el[j]; i1 = j; }
            const float w0 = 1.0f / (1.0f + expf(m1 - m0)), w1 = 1.0f - w0;
            if (lane < 2) { const int e = gi * 4 + (lane == 0 ? i0 : i1); const float w = gval * (lane == 0 ? w0 : w1);
                const int idx = (wave * 32 + i) * 2 + lane; dec_e[idx] = e; dec_w[idx] = w; dec_r[idx] = __hip_atomic_fetch_add(hist + e, 1, __ATOMIC_RELAXED, __HIP_MEMORY_SCOPE_WORKGROUP); }
        }
        __syncthreads();
        if (tid < 16) { const int n = hist[tid]; ebase[tid] = n ? (int)__hip_atomic_fetch_add(ctl + CW_CNT + 64 * tid, (unsigned)n, __ATOMIC_RELAXED, __HIP_MEMORY_SCOPE_AGENT) : 0; }
        __syncthreads();
        { const int i = lane >> 1, row = row0 + i * NGW;
          if (row < M) { const int idx = wave * 64 + lane; const int e = dec_e[idx], pos = ebase[e] + dec_r[idx];
              LIST[(size_t)e * M + pos] = row; TOKSLOT[(size_t)row * 2 + (lane & 1)] = (e << 20) | pos; TOKW[(size_t)row * 2 + (lane & 1)] = dec_w[idx]; } }
        __syncthreads();
        if (tid < 16) hist[tid] = 0;
        __syncthreads();
        }
    }
    xcd_barrier(bar);

    if (PH(8))
    for (int rep_ = 0; rep_ < REPS(8); ++rep_)
    {
        PHASE_PTRS
        pg8::Gemm g{DM, DM, DM};
        LAS int* tbl = (LAS int*)(lds + EXTRA_OFF + 8192); moe_table(tbl, ctl);
        SchedMoe S; S.A = (const char*)U2B; S.W = (const char*)Wgu_t; S.list = LIST; S.tbl = tbl; S.G = G; S.c = bx; S.NPN = 2; S.w_exp = (size_t)512 * DM * 2; S.w_tile = (size_t)256 * DM * 2; S.a_tile = 0; S.ocol_w = 128;
        pg8::EpiSwiglu E{HID};
        pg8::gemm_phase<pg8::EpiSwiglu, SchedMoe, true, true>(lds + RING_OFF, g, S, E);
    }
    xcd_barrier(bar);

    if (PH(9))
    for (int rep_ = 0; rep_ < REPS(9); ++rep_)
    {
        PHASE_PTRS
        pg8::Gemm g{DFF, DFF, DFF};
        LAS int* tbl = (LAS int*)(lds + EXTRA_OFF + 8192);
        SchedMoe S; S.A = (const char*)HID; S.W = (const char*)Wd_t; S.list = LIST; S.tbl = tbl; S.G = G; S.c = bx; S.NPN = 4; S.w_exp = (size_t)DM * DFF * 2; S.w_tile = (size_t)256 * DFF * 2; S.a_tile = (size_t)256 * DFF * 2; S.ocol_w = 256;
        pg8::EpiBf16 E{YB, DM, nullptr, 0, 1.f, 1.f, nullptr};
        pg8::gemm_phase<pg8::EpiBf16, SchedMoe, true, false>(lds + RING_OFF, g, S, E);
    }
    xcd_barrier(bar);

    if (PH(10))
    {
        PHASE_PTRS
        const LAS int* tb = (const LAS int*)(lds + EXTRA_OFF + 8192);
        const f32x4* gp = (const f32x4*)ARGP(norm_final) + lane;
        int sl0 = 0, sl1 = 0; float sw0 = 0.f, sw1 = 0.f;
        u32x2 ya_n[4], yb_n[4], hh_n[4]; float w0_n = 0.f, w1_n = 0.f;
#define P10_SLOTS(rw) do { sl0 = TOKSLOT[(size_t)(rw) * 2]; sl1 = TOKSLOT[(size_t)(rw) * 2 + 1]; sw0 = TOKW[(size_t)(rw) * 2]; sw1 = TOKW[(size_t)(rw) * 2 + 1]; } while (0)
#define P10_DATA(rw) do { const int r0_ = tb[sl0 >> 20] * 256 + (sl0 & 0xfffff), r1_ = tb[sl1 >> 20] * 256 + (sl1 & 0xfffff); w0_n = sw0; w1_n = sw1; \
        const u32x2* y0_ = (const u32x2*)(YB + (size_t)r0_ * DM) + lane; const u32x2* y1_ = (const u32x2*)(YB + (size_t)r1_ * DM) + lane; const u32x2* h_ = (const u32x2*)(H1B + (size_t)(rw) * DM) + lane; \
        _Pragma("unroll") for (int j = 0; j < 4; ++j) { ya_n[j] = y0_[64 * j]; yb_n[j] = y1_[64 * j]; hh_n[j] = h_[64 * j]; } } while (0)
        if (gw < M) { P10_SLOTS(gw); P10_DATA(gw); if (gw + NGW < M) P10_SLOTS(gw + NGW); }
        for (int row = gw; row < M; row += NGW) {
            u32x2 ya[4], yb[4], hh[4]; const float w0 = w0_n, w1 = w1_n;
#pragma unroll
            for (int j = 0; j < 4; ++j) { ya[j] = ya_n[j]; yb[j] = yb_n[j]; hh[j] = hh_n[j]; }
            if (row + NGW < M) { P10_DATA(row + NGW); if (row + 2 * NGW < M) P10_SLOTS(row + 2 * NGW); }
            f32x4* hr = (f32x4*)(out + (size_t)row * DM) + lane;
            f32x4 v[4]; float s = 0.f;
#pragma unroll
            for (int j = 0; j < 4; ++j) { const u32x2 a = ya[j], b = yb[j]; const u32x2 hx = hh[j]; f32x4 h = {bf16lo(hx.x), bf16hi(hx.x), bf16lo(hx.y), bf16hi(hx.y)};
                h[0] += w0 * bf16lo(a.x) + w1 * bf16lo(b.x); h[1] += w0 * bf16hi(a.x) + w1 * bf16hi(b.x); h[2] += w0 * bf16lo(a.y) + w1 * bf16lo(b.y); h[3] += w0 * bf16hi(a.y) + w1 * bf16hi(b.y);
                v[j] = h; s += (h[0] * h[0] + h[1] * h[1]) + (h[2] * h[2] + h[3] * h[3]); }
            const float rinv = rsqrtf(wave_sum(s) * (1.0f / DM) + EPS);
#pragma unroll
            for (int j = 0; j < 4; ++j) hr[64 * j] = v[j] * rinv * gp[64 * j];
        }
#undef P10_SLOTS
#undef P10_DATA
    }
}

extern "C" void kernel_launch(void* const* d_in, const int* in_sizes, int n_in, void* d_out, int out_size, void* d_ws, size_t ws_size, hipStream_t stream) {
    static int grid = 0;
    if (grid == 0) {
        if (n_in != 22 || in_sizes[0] != M * DM || out_size != M * DM || ws_size < WS_END) { fprintf(stderr, "kernel_launch: unexpected shapes (n_in %d, in0 %d, out %d, ws %zu)\n", n_in, n_in > 0 ? in_sizes[0] : -1, out_size, ws_size); grid = -1; return; }
        int dev = 0, cus = 0, per_cu = 0;
        if (hipGetDevice(&dev) != hipSuccess || hipDeviceGetAttribute(&cus, hipDeviceAttributeMultiprocessorCount, dev) != hipSuccess) { grid = -1; return; }
        if (hipFuncSetAttribute((const void*)hymba_fwd, hipFuncAttributeMaxDynamicSharedMemorySize, LDS_BYTES) != hipSuccess) { fprintf(stderr, "kernel_launch: hipFuncSetAttribute failed\n"); grid = -1; return; }
        if (hipOccupancyMaxActiveBlocksPerMultiprocessor(&per_cu, (const void*)hymba_fwd, NWAVES * 64, LDS_BYTES) != hipSuccess || per_cu < 1) { fprintf(stderr, "kernel_launch: occupancy query reports %d\n", per_cu); }
        (void)hipGetLastError();
        grid = cus;
    }
    if (grid < 0) return;
    (void)hipMemsetAsync((char*)d_ws + WS_CTL, 0, CTL_ZERO_BYTES, stream);
    Args a{};
    const float** p = (const float**)&a;
    for (int i = 0; i < 22; ++i) p[i] = (const float*)d_in[i];
    a.out = (float*)d_out; a.ws = (unsigned char*)d_ws;
    hipLaunchKernelGGL(hymba_fwd, dim3(grid), dim3(NWAVES * 64), LDS_BYTES, stream, a);
}
```

```cpp
#include <hip/hip_runtime.h>
#include <hip/hip_bf16.h>
#include <cstdio>
#include <cstdint>

#define LAS __attribute__((address_space(3)))
#define GAS __attribute__((address_space(1)))
typedef unsigned short bf16_t;
typedef short bf16x8 __attribute__((ext_vector_type(8)));
typedef short s16x4 __attribute__((ext_vector_type(4)));
typedef float f32x4 __attribute__((ext_vector_type(4)));
typedef float f32x2 __attribute__((ext_vector_type(2)));
typedef float f32x16 __attribute__((ext_vector_type(16)));
typedef unsigned u32x4 __attribute__((ext_vector_type(4)));
typedef unsigned u32x2 __attribute__((ext_vector_type(2)));
typedef __bf16 bf16x2_t __attribute__((ext_vector_type(2)));

constexpr int BATCH = 8, SEQ = 8192, DM = 1024, M = BATCH * SEQ;
constexpr int NH = 8, HD = 64, HW = NH * HD;
constexpr int NPROJ = 3 * HW * 2;
constexpr int WIN_LD = NPROJ + NH;
constexpr int NMEM = 256, XH = 4, XD = 256, MEMROWS = BATCH * NMEM;
constexpr int NEXP = 16, DFF = 256;
constexpr float EPS = 1e-6f;
constexpr float LOG2E = 1.4426950408889634f;
constexpr float C2 = 0.125f * LOG2E;
constexpr float XSC = 0.0625f * LOG2E;
constexpr float SB_EXIT = -64.0f;

constexpr size_t MiB = 1u << 20;
constexpr size_t WS_CTL = 0, CTL_ZERO_BYTES = 1 * MiB;
constexpr size_t WS_WIN = 1 * MiB;
constexpr size_t WS_WOUT = 7 * MiB;
constexpr size_t WS_WXQ = 9 * MiB;
constexpr size_t WS_WXKV = 11 * MiB;
constexpr size_t WS_WXO = 15 * MiB;
constexpr size_t WS_WGU = 17 * MiB;
constexpr size_t WS_WD = 33 * MiB;
constexpr size_t WS_RX = 41 * MiB;
constexpr size_t WS_RMEM = WS_RX + 256 * 1024;
constexpr size_t WS_R2 = WS_RX + 512 * 1024;
constexpr size_t WS_LF = 42 * MiB;
constexpr size_t WS_C2 = 44 * MiB;
constexpr size_t WS_SSQ = 46 * MiB;
constexpr size_t WS_TOKSLOT = 50 * MiB;
constexpr size_t WS_TOKW = 51 * MiB;
constexpr size_t WS_LIST = 52 * MiB;
constexpr size_t WS_MEMB = 56 * MiB;
constexpr size_t WS_KVM = 60 * MiB;
constexpr size_t WS_GT = 68 * MiB;
constexpr size_t WS_HT = 84 * MiB;
constexpr size_t WS_KX = 100 * MiB;
constexpr size_t WS_HS = 108 * MiB;
constexpr size_t WS_XB = 128 * MiB;
constexpr size_t WS_QKV = 256 * MiB;
constexpr size_t WS_H1B = 256 * MiB, WS_U2B = 384 * MiB, WS_HID = 512 * MiB;
constexpr size_t WS_O = 640 * MiB;
constexpr size_t WS_Y = 704 * MiB;
constexpr size_t WS_END = 1024 * MiB;
constexpr size_t QKV_STRIDE = (size_t)M * HW;
constexpr int MAXTILES = M * 2 / 256 + NEXP;
static_assert(WS_Y + (size_t)MAXTILES * 256 * 1024 * 2 <= WS_END, "ws map");
static_assert(WS_HID + (size_t)MAXTILES * 256 * 256 * 2 <= WS_O, "ws map");
constexpr int CW_BAR = 4096;
constexpr int CW_KN = 20480;
constexpr int CW_CNT = 16384;

constexpr int RING_OFF = 0, RING_BYTES = 131072;
constexpr int EXTRA_OFF = 131072, EXTRA_BYTES = 16384;
constexpr int MISC_OFF = EXTRA_OFF + EXTRA_BYTES;
constexpr int LDS_BYTES = MISC_OFF + 1024;
constexpr int NWAVES = 8;
#ifndef PHASE_MASK
#define PHASE_MASK 0x7ff
#endif
#define PH(n) ((PHASE_MASK >> (n)) & 1)
#ifndef PROBE_LO
#define PROBE_LO -1
#endif
#ifndef PROBE_HI
#define PROBE_HI -1
#endif
#ifndef FOX_V2
#define FOX_V2 1
#endif
#ifndef REP_MASK
#define REP_MASK 0
#endif
#define REPS(n) (1 + ((REP_MASK >> (n)) & 1))
#ifndef REP_FOX
#define REP_FOX 1
#endif
#ifndef REP_SB
#define REP_SB 1
#endif

__device__ __forceinline__ unsigned cvt_pk_bf16(float lo, float hi) { f32x2 v = {lo, hi}; bf16x2_t b = __builtin_convertvector(v, bf16x2_t); return __builtin_bit_cast(unsigned, b); }
__device__ __forceinline__ float bf16lo(unsigned u) { return __uint_as_float(u << 16); }
__device__ __forceinline__ float bf16hi(unsigned u) { return __uint_as_float(u & 0xffff0000u); }
__device__ __forceinline__ float wave_sum(float v) {
#pragma unroll
    for (int o = 1; o < 64; o <<= 1) v += __shfl_xor(v, o);
    return v;
}
#define LDS_WAIT() asm volatile("s_waitcnt lgkmcnt(0)" ::: "memory")
#define VM_WAIT() asm volatile("s_waitcnt vmcnt(0)" ::: "memory")

namespace pg8 {
constexpr int BM = 256, BK = 64, HALF = 128, HTB = HALF * BK * 2, STAGE_BYTES = 8 * HTB, NXCD = 8, WGM = 8;
__host__ __device__ __forceinline__ int lds_byte(int r, int c) { const int st = (r >> 4) * 2 + (c >> 5), rr = r & 15, cc = c & 31, ob = rr * 64 + cc * 2; return st * 1024 + (ob ^ (((ob >> 9) & 1) << 5)); }
__host__ __device__ __forceinline__ void stage_rc(int b, int& R, int& C) { const int st = b / 1024, sb = b % 1024, swz = sb ^ (((sb >> 9) & 1) << 5); R = (st >> 1) * 16 + swz / 64; C = (st & 1) * 32 + (swz % 64) / 2; }
__host__ __device__ __forceinline__ int perm32(int rho) { const int n = rho >> 4, i = rho & 15; return 8 * (i >> 2) + 4 * n + (i & 3); }

struct Unit { const char* a; const char* b; int orow, ocol, aux; const int* rows; int nvalid; };
struct Gemm { int lda, ldb, K; };

__device__ __forceinline__ bool tile_order(int i, int G, int c, int nM, int nN, int& pm, int& pn) {
    const int nwg = nM * nN; const long L = (long)i * G + c; if (L >= nwg) return false;
    int wgid = (int)L; { const int q = nwg / NXCD, r = nwg % NXCD, xcd = wgid % NXCD, off = wgid / NXCD; wgid = (xcd < r ? xcd * (q + 1) : r * (q + 1) + (xcd - r) * q) + off; }
    const int nig = WGM * nN, gid = wgid / nig, fm = gid * WGM, gsz = (nM - fm) < WGM ? (nM - fm) : WGM;
    pm = fm + ((wgid % nig) % gsz); pn = (wgid % nig) / gsz; return true;
}

template <class Epi, class Sched, bool ALIGN_EPI, bool GATHER>
__device__ __forceinline__ void gemm_phase(LAS unsigned char* lds, const Gemm g, const Sched& S, const Epi& E) {
    int tid = threadIdx.x; asm volatile("" : "+v"(tid));
    const int wid = __builtin_amdgcn_readfirstlane(tid >> 6), lane = tid & 63, wr = wid >> 2, wc = wid & 3, fr = lane & 15, fq = lane >> 4;
    const int K = g.K, nt = K / BK;
    unsigned voffA[2], voffB[2]; int RA[2], CA[2];
#pragma unroll
    for (int i = 0; i < 2; ++i) { int R, C; stage_rc(tid * 16 + i * 8192, R, C); const int Rb = (R & ~31) + perm32(R & 31);
        RA[i] = R; CA[i] = C; voffA[i] = (unsigned)(R * g.lda + C) * 2u; voffB[i] = (unsigned)(Rb * g.ldb + C) * 2u; }
    const size_t kstep = (size_t)(BK * 2);
    const size_t hstepA = (size_t)HALF * g.lda * 2, hstepB = (size_t)HALF * g.ldb * 2;
    const unsigned ldsw = (unsigned)wid * 1024u;
    const int aoff = lds_byte(wr * 64 + fr, fq * 8), boff = lds_byte(wc * 32 + fr, fq * 8);
#define PG8_SA(b, h) (((b) * 2 + (h)) * HTB)
#define PG8_SB(b, h) ((4 + (b) * 2 + (h)) * HTB)
#define PG8_STAGE2(bufoff, gbase, v0, v1) do { \
        __builtin_amdgcn_global_load_lds((const unsigned*)((const char*)(gbase) + (v0)), (LAS unsigned*)(lds + (bufoff) + ldsw), 16, 0, 0); \
        __builtin_amdgcn_global_load_lds((const unsigned*)((const char*)(gbase) + (v1)), (LAS unsigned*)(lds + (bufoff) + ldsw + 8192), 16, 0, 0); } while (0)
#define PG8_STAGEB(bufoff, gbase) PG8_STAGE2(bufoff, gbase, voffB[0], voffB[1])
#define PG8_STAGEA(bufoff, kptr, h, NX) do { if constexpr (GATHER) { const unsigned v0_ = (NX) ? gvn[h][0] : gvc[h][0], v1_ = (NX) ? gvn[h][1] : gvc[h][1]; PG8_STAGE2(bufoff, kptr, v0_, v1_); } \
        else { PG8_STAGE2(bufoff, (kptr) + (h) * hstepA, voffA[0], voffA[1]); } } while (0)
#define PG8_LDA(dst, b, h) do { _Pragma("unroll") for (int m = 0; m < 4; ++m) _Pragma("unroll") for (int k = 0; k < 2; ++k) dst[m][k] = *(const LAS bf16x8*)(lds + PG8_SA(b, h) + aoff + m * 2048 + k * 1024); } while (0)
#define PG8_LDB(dst, b, h) do { _Pragma("unroll") for (int n = 0; n < 2; ++n) _Pragma("unroll") for (int k = 0; k < 2; ++k) dst[n][k] = *(const LAS bf16x8*)(lds + PG8_SB(b, h) + boff + n * 2048 + k * 1024); } while (0)
#define PG8_MMA(ai, bj, At, Bt) do { __builtin_amdgcn_s_setprio(1); _Pragma("unroll") for (int m = 0; m < 4; ++m) _Pragma("unroll") for (int n = 0; n < 2; ++n) _Pragma("unroll") for (int k = 0; k < 2; ++k) \
        acc[ai][bj][m][n] = __builtin_amdgcn_mfma_f32_16x16x32_bf16(Bt[n][k], At[m][k], acc[ai][bj][m][n], 0, 0, 0); __builtin_amdgcn_s_setprio(0); } while (0)
#define PG8_WAIT_V(n) asm volatile("s_waitcnt vmcnt(" #n ")" ::: "memory")
#define PG8_WAIT_L(n) asm volatile("s_waitcnt lgkmcnt(" #n ")" ::: "memory")
#define PG8_BAR __builtin_amdgcn_s_barrier()
#define PG8_SCHED __builtin_amdgcn_sched_barrier(0)
#define PG8_GATHER_OFFS(dst, u) do { _Pragma("unroll") for (int h_ = 0; h_ < 2; ++h_) _Pragma("unroll") for (int i_ = 0; i_ < 2; ++i_) { const int r_ = h_ * HALF + RA[i_]; \
        const int idx_ = (u).rows[r_ < (u).nvalid ? r_ : 0]; dst[h_][i_] = (unsigned)(idx_ * g.lda + CA[i_]) * 2u; } } while (0)
    Unit cur, nxt; int ui = 0;
    if (!S.next(0, cur)) return;
    unsigned gvc[2][2] = {{0u, 0u}, {0u, 0u}}, gvn[2][2] = {{0u, 0u}, {0u, 0u}};
    if constexpr (GATHER) { PG8_GATHER_OFFS(gvc, cur); }
    f32x4 acc[2][2][4][2];
#pragma unroll
    for (int a = 0; a < 2; ++a)
#pragma unroll
        for (int b = 0; b < 2; ++b)
#pragma unroll
            for (int m = 0; m < 4; ++m)
#pragma unroll
                for (int n = 0; n < 2; ++n) acc[a][b][m][n] = (f32x4){0.f, 0.f, 0.f, 0.f};
    bf16x8 At[4][2], B0[2][2], B1[2][2];
    const char* cA = cur.a; const char* cB = cur.b;
    PG8_STAGEB(PG8_SB(0, 0), cB); PG8_STAGEB(PG8_SB(0, 1), cB + hstepB); PG8_STAGEA(PG8_SA(0, 0), cA, 0, false); PG8_STAGEA(PG8_SA(0, 1), cA, 1, false);
    if (wr == 1) PG8_BAR;
    PG8_WAIT_V(2); PG8_BAR;
    PG8_STAGEB(PG8_SB(1, 0), cB + kstep); PG8_STAGEA(PG8_SA(1, 0), cA + kstep, 0, false); PG8_STAGEB(PG8_SB(1, 1), cB + hstepB + kstep);
    PG8_WAIT_V(6); PG8_BAR;
    for (;;) {
        const bool has_next = S.next(ui + 1, nxt);
        const char* nA = has_next ? nxt.a : cA; const char* nB = has_next ? nxt.b : cB;
        if constexpr (GATHER) { if (has_next) { PG8_GATHER_OFFS(gvn, nxt); } else { gvn[0][0] = gvc[0][0]; gvn[0][1] = gvc[0][1]; gvn[1][0] = gvc[1][0]; gvn[1][1] = gvc[1][1]; } }
#pragma unroll 1
        for (int t = 0; t < nt; t += 2) {
            const bool last = (t == nt - 2);
            const char* a1 = cA + (size_t)(t + 1) * kstep;
            const char* a2 = last ? nA : cA + (size_t)(t + 2) * kstep; const char* b2 = last ? nB : cB + (size_t)(t + 2) * kstep;
            const char* a3 = a2 + kstep; const char* b3 = b2 + kstep;
            PG8_LDB(B0, 0, 0); PG8_LDB(B1, 0, 1); PG8_SCHED; PG8_LDA(At, 0, 0); PG8_STAGEA(PG8_SA(1, 1), a1, 1, false);
            PG8_WAIT_V(8); PG8_WAIT_L(0); PG8_BAR; PG8_MMA(0, 0, At, B0); PG8_MMA(0, 1, At, B1); PG8_BAR; PG8_SCHED;
            PG8_LDA(At, 0, 1); PG8_STAGEB(PG8_SB(0, 0), b2); PG8_STAGEB(PG8_SB(0, 1), b2 + hstepB); PG8_STAGEA(PG8_SA(0, 0), a2, 0, last);
            PG8_WAIT_V(8); PG8_WAIT_L(0); PG8_BAR; PG8_MMA(1, 0, At, B0); PG8_MMA(1, 1, At, B1); PG8_BAR; PG8_SCHED;
            PG8_LDB(B0, 1, 0); PG8_LDB(B1, 1, 1); PG8_SCHED; PG8_LDA(At, 1, 0); PG8_STAGEA(PG8_SA(0, 1), a2, 1, last);
            PG8_WAIT_V(8); PG8_WAIT_L(0); PG8_BAR; PG8_MMA(0, 0, At, B0); PG8_MMA(0, 1, At, B1); PG8_BAR; PG8_SCHED;
            PG8_LDA(At, 1, 1); PG8_STAGEB(PG8_SB(1, 0), b3); PG8_STAGEB(PG8_SB(1, 1), b3 + hstepB); PG8_STAGEA(PG8_SA(1, 0), a3, 0, last);
            PG8_WAIT_V(8); PG8_WAIT_L(0); PG8_BAR; PG8_MMA(1, 0, At, B0); PG8_MMA(1, 1, At, B1); PG8_BAR; PG8_SCHED;
            if constexpr (Epi::HAS_MID) { if (t == (nt >> 1) - 2) { int fr3 = fr, fq3 = fq; asm volatile("" : "+v"(fr3), "+v"(fq3)); E.mid(acc, cur, wr, wc, fr3, fq3); } }
        }
        if constexpr (ALIGN_EPI) { if (wr == 0) PG8_BAR; }
        { int fr2 = fr, fq2 = fq; asm volatile("" : "+v"(fr2), "+v"(fq2));
          E(acc, cur, wr, wc, fr2, fq2); }
        if (!has_next) break;
#pragma unroll
        for (int a = 0; a < 2; ++a)
#pragma unroll
            for (int b = 0; b < 2; ++b)
#pragma unroll
                for (int m = 0; m < 4; ++m)
#pragma unroll
                    for (int n = 0; n < 2; ++n) acc[a][b][m][n] = (f32x4){0.f, 0.f, 0.f, 0.f};
        cur = nxt; cA = nA; cB = nB; ++ui;
        if constexpr (GATHER) { gvc[0][0] = gvn[0][0]; gvc[0][1] = gvn[0][1]; gvc[1][0] = gvn[1][0]; gvc[1][1] = gvn[1][1]; }
        if constexpr (ALIGN_EPI) { if (wr == 1) PG8_BAR; }
    }
    PG8_WAIT_V(0);
    if constexpr (!ALIGN_EPI) { if (wr == 0) PG8_BAR; }
    PG8_BAR;
#undef PG8_SA
#undef PG8_SB
#undef PG8_STAGE2
#undef PG8_STAGEA
#undef PG8_STAGEB
#undef PG8_LDA
#undef PG8_LDB
#undef PG8_MMA
#undef PG8_WAIT_V
#undef PG8_WAIT_L
#undef PG8_BAR
#undef PG8_SCHED
#undef PG8_GATHER_OFFS
}

#define EPI_ROW(u, ai, m) ((u).orow + (ai) * HALF + wr * 64 + (m) * 16 + fr)
#define EPI_COL(u, bj) ((u).ocol + (bj) * HALF + wc * 32 + 8 * fq)
struct EpiBf16 {
    static constexpr bool HAS_MID = false;
    bf16_t* O; int ldc; const float* rs; size_t stride; float sc0, sc3;
    unsigned* kn;
    __device__ __forceinline__ void operator()(const f32x4 (&acc)[2][2][4][2], const Unit& u, int wr, int wc, int fr, int fq) const {
        bf16_t* base = O + (size_t)u.aux * stride;
        const float sc = (u.aux == 0) ? sc0 : ((u.aux == 3) ? sc3 : 1.f);
        float nmax[2] = {0.f, 0.f}; const bool dokn = kn && u.aux == 1;
#pragma unroll
        for (int ai = 0; ai < 2; ++ai)
#pragma unroll
            for (int m = 0; m < 4; ++m) { const int row = EPI_ROW(u, ai, m); const float s = (rs ? rs[row] : 1.f) * sc;
#pragma unroll
                for (int bj = 0; bj < 2; ++bj) { const f32x4 v0 = acc[ai][bj][m][0] * s, v1 = acc[ai][bj][m][1] * s;
                    u32x4 w; w.x = cvt_pk_bf16(v0[0], v0[1]); w.y = cvt_pk_bf16(v0[2], v0[3]); w.z = cvt_pk_bf16(v1[0], v1[1]); w.w = cvt_pk_bf16(v1[2], v1[3]);
                    *(u32x4*)(base + (size_t)row * ldc + EPI_COL(u, bj)) = w;
                    if (dokn) { float q = (v0[0] * v0[0] + v0[1] * v0[1]) + (v0[2] * v0[2] + v0[3] * v0[3]) + (v1[0] * v1[0] + v1[1] * v1[1]) + (v1[2] * v1[2] + v1[3] * v1[3]);
                        q += __shfl_xor(q, 16); q += __shfl_xor(q, 32); nmax[bj] = fmaxf(nmax[bj], q); } } }
        if (dokn) {
#pragma unroll
            for (int bj = 0; bj < 2; ++bj) { float q = nmax[bj]; q = fmaxf(q, __shfl_xor(q, 1)); q = fmaxf(q, __shfl_xor(q, 2)); q = fmaxf(q, __shfl_xor(q, 4)); q = fmaxf(q, __shfl_xor(q, 8));
                const int head = ((u.ocol + bj * HALF) >> 6) + (wc >> 1), bt = u.orow / SEQ;
                if ((fr | fq) == 0) atomicMax(kn + ((bt * NH + head) * 2 + (wc & 1)), __float_as_uint(q)); }
        }
    }
};
struct EpiResid {
    static constexpr bool HAS_MID = false;
    const float* res; float* out; bf16_t* hb; float* ssq;
    __device__ __forceinline__ void operator()(const f32x4 (&acc)[2][2][4][2], const Unit& u, int wr, int wc, int fr, int fq) const {
#pragma unroll
        for (int ai = 0; ai < 2; ++ai)
#pragma unroll
            for (int m = 0; m < 4; ++m) { const int row = EPI_ROW(u, ai, m); float q = 0.f;
#pragma unroll
                for (int bj = 0; bj < 2; ++bj) { const size_t off = (size_t)row * DM + EPI_COL(u, bj);
                    const f32x4 r0 = *(const f32x4*)(res + off), r1 = *(const f32x4*)(res + off + 4);
                    const f32x4 v0 = acc[ai][bj][m][0] + r0, v1 = acc[ai][bj][m][1] + r1;
                    *(f32x4*)(out + off) = v0; *(f32x4*)(out + off + 4) = v1;
                    q += (v0[0] * v0[0] + v0[1] * v0[1]) + (v0[2] * v0[2] + v0[3] * v0[3]) + (v1[0] * v1[0] + v1[1] * v1[1]) + (v1[2] * v1[2] + v1[3] * v1[3]);
                    if (hb) { u32x4 w; w.x = cvt_pk_bf16(v0[0], v0[1]); w.y = cvt_pk_bf16(v0[2], v0[3]); w.z = cvt_pk_bf16(v1[0], v1[1]); w.w = cvt_pk_bf16(v1[2], v1[3]); *(u32x4*)(hb + off) = w; } }
                if (ssq) { q += __shfl_xor(q, 16); q += __shfl_xor(q, 32); if (fq == 0) ssq[(size_t)row * 16 + (u.ocol >> 8) * 4 + wc] = q; } }
    }
};
struct EpiOutProj {
    static constexpr bool HAS_MID = true;
    const bf16_t* xb; bf16_t* hb; float* ssq; const float* hs;
    __device__ __forceinline__ void scales(int row, float& ra, float& rb) const {
        const f32x4* p = (const f32x4*)(hs + (size_t)row * 16); const f32x4 a0 = p[0], a1 = p[1], b0 = p[2], b1 = p[3];
        ra = rsqrtf((((a0[0] + a0[1]) + (a0[2] + a0[3])) + ((a1[0] + a1[1]) + (a1[2] + a1[3]))) * (1.0f / HW) + EPS);
        rb = rsqrtf((((b0[0] + b0[1]) + (b0[2] + b0[3])) + ((b1[0] + b1[1]) + (b1[2] + b1[3]))) * (1.0f / HW) + EPS);
    }
    __device__ __forceinline__ void mid(f32x4 (&acc)[2][2][4][2], const Unit& u, int wr, int wc, int fr, int fq) const {
#pragma unroll
        for (int ai = 0; ai < 2; ++ai)
#pragma unroll
            for (int m = 0; m < 4; ++m) { float ra, rb; scales(EPI_ROW(u, ai, m), ra, rb); const float f = ra / rb;
#pragma unroll
                for (int bj = 0; bj < 2; ++bj) { acc[ai][bj][m][0] *= f; acc[ai][bj][m][1] *= f; } }
    }
    __device__ __forceinline__ void operator()(const f32x4 (&acc)[2][2][4][2], const Unit& u, int wr, int wc, int fr, int fq) const {
#pragma unroll
        for (int ai = 0; ai < 2; ++ai)
#pragma unroll
            for (int m = 0; m < 4; ++m) { const int row = EPI_ROW(u, ai, m); float ra, rb; scales(row, ra, rb); float q = 0.f;
#pragma unroll
                for (int bj = 0; bj < 2; ++bj) { const size_t off = (size_t)row * DM + EPI_COL(u, bj);
                    const u32x4 xr = *(const u32x4*)(xb + off);
                    f32x4 v0 = acc[ai][bj][m][0] * rb, v1 = acc[ai][bj][m][1] * rb;
                    v0[0] += bf16lo(xr.x); v0[1] += bf16hi(xr.x); v0[2] += bf16lo(xr.y); v0[3] += bf16hi(xr.y); v1[0] += bf16lo(xr.z); v1[1] += bf16hi(xr.z); v1[2] += bf16lo(xr.w); v1[3] += bf16hi(xr.w);
                    q += (v0[0] * v0[0] + v0[1] * v0[1]) + (v0[2] * v0[2] + v0[3] * v0[3]) + (v1[0] * v1[0] + v1[1] * v1[1]) + (v1[2] * v1[2] + v1[3] * v1[3]);
                    u32x4 w; w.x = cvt_pk_bf16(v0[0], v0[1]); w.y = cvt_pk_bf16(v0[2], v0[3]); w.z = cvt_pk_bf16(v1[0], v1[1]); w.w = cvt_pk_bf16(v1[2], v1[3]); *(u32x4*)(hb + off) = w; }
                q += __shfl_xor(q, 16); q += __shfl_xor(q, 32); if (fq == 0) ssq[(size_t)row * 16 + (u.ocol >> 8) * 4 + wc] = q; }
    }
};
struct EpiResidBf16 {
    static constexpr bool HAS_MID = false;
    bf16_t* hb;
    __device__ __forceinline__ void operator()(const f32x4 (&acc)[2][2][4][2], const Unit& u, int wr, int wc, int fr, int fq) const {
#pragma unroll
        for (int ai = 0; ai < 2; ++ai)
#pragma unroll
            for (int m = 0; m < 4; ++m) { const int row = EPI_ROW(u, ai, m);
#pragma unroll
                for (int bj = 0; bj < 2; ++bj) { const size_t off = (size_t)row * DM + EPI_COL(u, bj);
                    const u32x4 xr = *(const u32x4*)(hb + off);
                    f32x4 v0 = acc[ai][bj][m][0], v1 = acc[ai][bj][m][1];
                    v0[0] += bf16lo(xr.x); v0[1] += bf16hi(xr.x); v0[2] += bf16lo(xr.y); v0[3] += bf16hi(xr.y); v1[0] += bf16lo(xr.z); v1[1] += bf16hi(xr.z); v1[2] += bf16lo(xr.w); v1[3] += bf16hi(xr.w);
                    u32x4 w; w.x = cvt_pk_bf16(v0[0], v0[1]); w.y = cvt_pk_bf16(v0[2], v0[3]); w.z = cvt_pk_bf16(v1[0], v1[1]); w.w = cvt_pk_bf16(v1[2], v1[3]); *(u32x4*)(hb + off) = w; } }
    }
};
struct EpiSoftmax {
    static constexpr bool HAS_MID = false;
    bf16_t* P; const float* ssq; LAS float* red;
    __device__ __forceinline__ void operator()(f32x4 (&acc)[2][2][4][2], const Unit& u, int wr, int wc, int fr, int fq) const {
#pragma unroll
        for (int ai = 0; ai < 2; ++ai)
#pragma unroll
            for (int m = 0; m < 4; ++m) { const int row = EPI_ROW(u, ai, m); const f32x4* sp = (const f32x4*)(ssq + (size_t)row * 16);
                const f32x4 s0 = sp[0], s1 = sp[1], s2 = sp[2], s3 = sp[3];
                const float tot = ((s0[0] + s0[1]) + (s0[2] + s0[3])) + ((s1[0] + s1[1]) + (s1[2] + s1[3])) + ((s2[0] + s2[1]) + (s2[2] + s2[3])) + ((s3[0] + s3[1]) + (s3[2] + s3[3]));
                const float r1 = rsqrtf(tot * (1.0f / DM) + EPS) * XSC; float a = -3.0e38f;
#pragma unroll
                for (int bj = 0; bj < 2; ++bj)
#pragma unroll
                    for (int n = 0; n < 2; ++n) { f32x4 v = acc[ai][bj][m][n] * r1; acc[ai][bj][m][n] = v; a = fmaxf(a, fmaxf(fmaxf(v[0], v[1]), fmaxf(v[2], v[3]))); }
                a = fmaxf(a, __shfl_xor(a, 16)); a = fmaxf(a, __shfl_xor(a, 32));
                if (fq == 0) red[(ai * HALF + wr * 64 + m * 16 + fr) * 4 + wc] = a; asm volatile("" ::: "memory"); }
        LDS_WAIT(); __builtin_amdgcn_s_barrier(); asm volatile("" ::: "memory");
#pragma unroll
        for (int ai = 0; ai < 2; ++ai)
#pragma unroll
            for (int m = 0; m < 4; ++m) { const int rl = ai * HALF + wr * 64 + m * 16 + fr; const f32x4 mm = *(const LAS f32x4*)(red + rl * 4);
                const float a = fmaxf(fmaxf(mm[0], mm[1]), fmaxf(mm[2], mm[3])); float s = 0.f;
#pragma unroll
                for (int bj = 0; bj < 2; ++bj)
#pragma unroll
                    for (int n = 0; n < 2; ++n) { f32x4 v = acc[ai][bj][m][n];
                        v[0] = __builtin_amdgcn_exp2f(v[0] - a); v[1] = __builtin_amdgcn_exp2f(v[1] - a); v[2] = __builtin_amdgcn_exp2f(v[2] - a); v[3] = __builtin_amdgcn_exp2f(v[3] - a);
                        acc[ai][bj][m][n] = v; s += (v[0] + v[1]) + (v[2] + v[3]); }
                s += __shfl_xor(s, 16); s += __shfl_xor(s, 32);
                if (fq == 0) red[1024 + rl * 4 + wc] = s; }
        LDS_WAIT(); __builtin_amdgcn_s_barrier(); asm volatile("" ::: "memory");
#pragma unroll
        for (int ai = 0; ai < 2; ++ai)
#pragma unroll
            for (int m = 0; m < 4; ++m) { const int rl = ai * HALF + wr * 64 + m * 16 + fr; const int row = u.orow + rl; const f32x4 ss = *(const LAS f32x4*)(red + 1024 + rl * 4);
                const float inv = 1.0f / ((ss[0] + ss[1]) + (ss[2] + ss[3]));
#pragma unroll
                for (int bj = 0; bj < 2; ++bj) { const f32x4 v0 = acc[ai][bj][m][0] * inv, v1 = acc[ai][bj][m][1] * inv;
                    u32x4 w; w.x = cvt_pk_bf16(v0[0], v0[1]); w.y = cvt_pk_bf16(v0[2], v0[3]); w.z = cvt_pk_bf16(v1[0], v1[1]); w.w = cvt_pk_bf16(v1[2], v1[3]);
                    *(u32x4*)(P + (size_t)row * DM + EPI_COL(u, bj)) = w; } }
    }
};
struct EpiSwiglu {
    static constexpr bool HAS_MID = false;
    bf16_t* Hd; const float* r2;
    __device__ __forceinline__ void operator()(const f32x4 (&acc)[2][2][4][2], const Unit& u, int wr, int wc, int fr, int fq) const {
#pragma unroll
        for (int ai = 0; ai < 2; ++ai)
#pragma unroll
            for (int m = 0; m < 4; ++m) { const int rl = ai * HALF + wr * 64 + m * 16 + fr, row = u.orow + rl; const float rs = r2[u.rows[rl < u.nvalid ? rl : 0]]; float h[8];
#pragma unroll
                for (int n = 0; n < 2; ++n)
#pragma unroll
                    for (int e = 0; e < 4; ++e) { const float gt = acc[ai][0][m][n][e] * rs, up = acc[ai][1][m][n][e] * rs;
                        h[n * 4 + e] = gt * __builtin_amdgcn_rcpf(1.0f + __builtin_amdgcn_exp2f(-gt * LOG2E)) * up; }
                u32x4 w; w.x = cvt_pk_bf16(h[0], h[1]); w.y = cvt_pk_bf16(h[2], h[3]); w.z = cvt_pk_bf16(h[4], h[5]); w.w = cvt_pk_bf16(h[6], h[7]);
                *(u32x4*)(Hd + (size_t)row * DFF + u.ocol + wc * 32 + 8 * fq) = w; }
    }
};
}

namespace att {
constexpr int QB = 256, KVBLK = 64, PITCH = HW, OPITCH = DM;
constexpr int SLOTB = 8192, LDS_K = 0, LDS_V = 2 * SLOTB, LDS_WS = 4 * SLOTB, LDS_OST = LDS_WS + NWAVES * 256, LDS_FLAG = LDS_OST + NWAVES * 4096, LDS_END = LDS_FLAG + 64;
static_assert(LDS_END <= RING_BYTES, "attention LDS");
__device__ __forceinline__ int crow(int r, int hi) { return (r & 3) + 8 * (r >> 2) + 4 * hi; }
__device__ __forceinline__ void glds16(const void* gsrc, unsigned lds_dst) { unsigned keep;
    asm volatile("s_mov_b32 %0, m0\n\ts_mov_b32 m0, %2\n\ts_nop 0\n\tglobal_load_lds_dwordx4 %1, off\n\ts_mov_b32 m0, %0" : "=&s"(keep) : "v"(gsrc), "s"(lds_dst) : "memory"); }
__device__ __forceinline__ void glds16s(const void* sbase, unsigned voff, unsigned lds_dst) { unsigned keep;
    asm volatile("s_mov_b32 %0, m0\n\ts_mov_b32 m0, %3\n\ts_nop 0\n\tglobal_load_lds_dwordx4 %1, %2\n\ts_mov_b32 m0, %0" : "=&s"(keep) : "v"(voff), "s"(sbase), "s"(lds_dst) : "memory"); }
#define ATT_WAIT_BAR0() asm volatile("s_waitcnt vmcnt(0) lgkmcnt(0)\n\ts_barrier" ::: "memory")
#define MFMA32(a, b, c) __builtin_amdgcn_mfma_f32_32x32x16_bf16(a, b, c, 0, 0, 0)
__device__ __forceinline__ void store_row_ssq(u32x4 v, float* dst, int ch) {
    float q = (bf16lo(v.x) * bf16lo(v.x) + bf16hi(v.x) * bf16hi(v.x)) + (bf16lo(v.y) * bf16lo(v.y) + bf16hi(v.y) * bf16hi(v.y)) + (bf16lo(v.z) * bf16lo(v.z) + bf16hi(v.z) * bf16hi(v.z)) + (bf16lo(v.w) * bf16lo(v.w) + bf16hi(v.w) * bf16hi(v.w));
    q += __shfl_xor(q, 1); q += __shfl_xor(q, 2); q += __shfl_xor(q, 4);
    if (ch == 0) *dst = q;
}
__device__ __forceinline__ void qkt(f32x16& p0, f32x16& p1, const LAS char* Kslot, const bf16x8* qr, const f32x16& cin, int r32, int hi) {
    const LAS char* kb = Kslot + hi * 1024 + r32 * 16;
#pragma unroll
    for (int d0 = 0; d0 < 4; ++d0) {
        const bf16x8 b0 = *(const LAS bf16x8*)(kb + d0 * 2048);
        const bf16x8 b1 = *(const LAS bf16x8*)(kb + d0 * 2048 + 512);
        if (d0 == 0) { p0 = MFMA32(b0, qr[0], cin); p1 = MFMA32(b1, qr[0], cin); }
        else { p0 = MFMA32(b0, qr[d0], p0); p1 = MFMA32(b1, qr[d0], p1); } }
}
__device__ __forceinline__ void pv(f32x16* o, int vb, bf16x8 pa0, bf16x8 pa1, bf16x8 pa2, bf16x8 pa3) {
#pragma unroll
    for (int d0 = 0; d0 < 2; ++d0) { s16x4 lo[4], hi[4];
#pragma unroll
        for (int ks = 0; ks < 4; ++ks) {
            asm volatile("ds_read_b64_tr_b16 %0,%1 offset:%c2" : "=&v"(lo[ks]) : "v"(vb), "i"(d0 * 4096 + ks * 1024) : "memory");
            asm volatile("ds_read_b64_tr_b16 %0,%1 offset:%c2" : "=&v"(hi[ks]) : "v"(vb), "i"(d0 * 4096 + ks * 1024 + 512) : "memory"); }
        asm volatile("s_waitcnt lgkmcnt(0)" ::: "memory"); __builtin_amdgcn_sched_barrier(0);
#define PK(k) (bf16x8){lo[k][0], lo[k][1], lo[k][2], lo[k][3], hi[k][0], hi[k][1], hi[k][2], hi[k][3]}
        o[d0] = MFMA32(pa0, PK(0), o[d0]); o[d0] = MFMA32(pa1, PK(1), o[d0]); o[d0] = MFMA32(pa2, PK(2), o[d0]); o[d0] = MFMA32(pa3, PK(3), o[d0]);
#undef PK
    }
}
__device__ __forceinline__ float swap_lo(float x) { auto rr = __builtin_amdgcn_permlane32_swap(__float_as_uint(x), __float_as_uint(x), false, false); return __uint_as_float(rr[0]); }
__device__ __forceinline__ float swap_hi(float x) { auto rr = __builtin_amdgcn_permlane32_swap(__float_as_uint(x), __float_as_uint(x), false, false); return __uint_as_float(rr[1]); }

template <int MODE> __device__ __forceinline__ void attn_unit(int b, int h, int qb, const bf16_t* Q, const bf16_t* K, const bf16_t* V, bf16_t* O, float* hs, const float* cb, LAS char* shm) {
    int tid = threadIdx.x; asm volatile("" : "+v"(tid)); const int lane = tid & 63, r32 = lane & 31, hi = lane >> 5; const int wid = __builtin_amdgcn_readfirstlane(tid >> 6);
    const long rowbase = (long)b * SEQ; const int q0 = qb * QB;
    const bf16_t* Qw = Q + (rowbase + q0 + wid * 32) * PITCH + h * HD;
    const bf16_t* Kh = K + rowbase * PITCH + h * HD; const bf16_t* Vh = V + rowbase * PITCH + h * HD;
    const unsigned lds0 = (unsigned)(uintptr_t)shm;
    LAS float* wsf = (LAS float*)(shm + LDS_WS) + wid * 64;
    LAS unsigned* flags = (LAS unsigned*)(shm + LDS_FLAG);
    const bf16_t* ksrc = Kh + (long)lane * PITCH + wid * 8;
    const bf16_t* vsrc = Vh + (long)(16 * (wid & 3) + (lane >> 2)) * PITCH + (wid >> 2) * 32 + (lane & 3) * 8;
    const unsigned kdst = lds0 + LDS_K + wid * 1024, vdst = lds0 + LDS_V + wid * 1024;
#define DMA_KV(t, slot) do { glds16(ksrc + (long)(t) * KVBLK * PITCH, (unsigned)__builtin_amdgcn_readfirstlane(kdst + (slot))); glds16(vsrc + (long)(t) * KVBLK * PITCH, (unsigned)__builtin_amdgcn_readfirstlane(vdst + (slot))); } while (0)
    const int vb0 = (int)(lds0 + LDS_V) + ((lane >> 4) & 1) * 32 + (lane & 3) * 8 + (4 * hi + ((lane & 15) >> 2)) * 64;
    const int NT = (q0 + QB) / KVBLK;
    DMA_KV(NT - 1, 0);
    bf16x8 qr[4];
#pragma unroll
    for (int d0 = 0; d0 < 4; ++d0) qr[d0] = *(const bf16x8*)(Qw + (long)r32 * PITCH + d0 * 16 + hi * 8);
    f32x16 o[2]; o[0] = f32x16{}; o[1] = f32x16{};
    const int qrel = wid * 32 + r32;
    float m_run = -1.0e30f, l_run = 0.f, R = 0.f, ct = 0.f;
    if (MODE == 0) ct = cb[q0 + qrel];
    bf16x8 TD0, TD1, TONE;
#pragma unroll
    for (int j = 0; j < 8; ++j) { const int kvl = 8 * (j >> 2) + 4 * hi + (j & 3); TD0[j] = (kvl >= r32) ? (short)0x3F80 : (short)0; TD1[j] = (16 + kvl >= r32) ? (short)0x3F80 : (short)0; TONE[j] = (short)0x3F80; }
    f32x16 zero16 = f32x16{};
    for (int i = 0; i < NT; ++i) {
        const int t = NT - 1 - i, slot = (i & 1) * SLOTB;
        ATT_WAIT_BAR0();
        if (MODE == 1 && i > 0) {
            const LAS unsigned* fl = flags + ((i - 1) & 1) * 8; unsigned all = 1u;
#pragma unroll
            for (int w = 0; w < 8; ++w) all &= fl[w];
            if (__builtin_amdgcn_readfirstlane(all)) break;
        }
        if (t > 0) DMA_KV(t - 1, slot ^ SLOTB);
        const int jb = t - (NT - 4);
        const bool active = !(jb >= 0 && 2 * jb > wid);
        bool wave_done = false;
        if (MODE == 1) wave_done = __all(R < SB_EXIT);
        if (active && !(MODE == 1 && wave_done)) {
            f32x16 p0, p1;
            qkt(p0, p1, shm + LDS_K + slot, qr, zero16, r32, hi);
            if (MODE == 0) {
                const float* cbt = cb + t * KVBLK + 4 * hi;
#pragma unroll
                for (int g = 0; g < 4; ++g) { const f32x4 c0 = *(const f32x4*)(cbt + 8 * g), c1 = *(const f32x4*)(cbt + 32 + 8 * g);
#pragma unroll
                    for (int e = 0; e < 4; ++e) { p0[4 * g + e] += ct - c0[e]; p1[4 * g + e] += ct - c1[e]; } }
                if (jb >= 0) {
#pragma unroll
                    for (int r = 0; r < 16; ++r) { const int kv = 64 * jb + crow(r, hi); if (kv > qrel) p0[r] = -1.0e30f; if (kv + 32 > qrel) p1[r] = -1.0e30f; } }
                float a = fmaxf(p0[0], p1[0]);
#pragma unroll
                for (int r = 1; r < 16; ++r) a = fmaxf(a, fmaxf(p0[r], p1[r]));
                a = fmaxf(swap_lo(a), swap_hi(a));
                const float m_new = fmaxf(m_run, a), alpha = __builtin_amdgcn_exp2f(m_run - m_new); m_run = m_new;
                float s = 0.f;
#pragma unroll
                for (int r = 0; r < 16; ++r) { p0[r] = __builtin_amdgcn_exp2f(p0[r] - m_new); p1[r] = __builtin_amdgcn_exp2f(p1[r] - m_new); s += p0[r] + p1[r]; }
                l_run = l_run * alpha + s;
                if (hi == 0) wsf[r32] = alpha;
                LDS_WAIT();
#pragma unroll
                for (int r = 0; r < 16; ++r) { const float f = wsf[crow(r, hi)]; o[0][r] *= f; o[1][r] *= f; }
                LDS_WAIT();
            } else {
                if (jb >= 0) {
#pragma unroll
                    for (int r = 0; r < 16; ++r) { const int kv = 64 * jb + crow(r, hi); if (kv >= qrel) p0[r] = -1.0e30f; if (kv + 32 >= qrel) p1[r] = -1.0e30f; } }
                f32x16 l0, l1;
#pragma unroll
                for (int r = 0; r < 16; ++r) {
                    l0[r] = -(fmaxf(p0[r], 0.f) + __builtin_amdgcn_logf(1.0f + __builtin_amdgcn_exp2f(-fabsf(p0[r]))));
                    l1[r] = -(fmaxf(p1[r], 0.f) + __builtin_amdgcn_logf(1.0f + __builtin_amdgcn_exp2f(-fabsf(p1[r])))); }
                u32x4 lw0 = {cvt_pk_bf16(l0[0], l0[1]), cvt_pk_bf16(l0[2], l0[3]), cvt_pk_bf16(l0[4], l0[5]), cvt_pk_bf16(l0[6], l0[7])};
                u32x4 lw1 = {cvt_pk_bf16(l0[8], l0[9]), cvt_pk_bf16(l0[10], l0[11]), cvt_pk_bf16(l0[12], l0[13]), cvt_pk_bf16(l0[14], l0[15])};
                u32x4 lw2 = {cvt_pk_bf16(l1[0], l1[1]), cvt_pk_bf16(l1[2], l1[3]), cvt_pk_bf16(l1[4], l1[5]), cvt_pk_bf16(l1[6], l1[7])};
                u32x4 lw3 = {cvt_pk_bf16(l1[8], l1[9]), cvt_pk_bf16(l1[10], l1[11]), cvt_pk_bf16(l1[12], l1[13]), cvt_pk_bf16(l1[14], l1[15])};
                f32x16 rt;
#pragma unroll
                for (int r = 0; r < 16; ++r) rt[r] = R;
                f32x16 t0 = MFMA32(TD0, __builtin_bit_cast(bf16x8, lw0), rt); t0 = MFMA32(TD1, __builtin_bit_cast(bf16x8, lw1), t0);
                t0 = MFMA32(TONE, __builtin_bit_cast(bf16x8, lw2), t0); t0 = MFMA32(TONE, __builtin_bit_cast(bf16x8, lw3), t0);
                f32x16 t1 = MFMA32(TD0, __builtin_bit_cast(bf16x8, lw2), rt); t1 = MFMA32(TD1, __builtin_bit_cast(bf16x8, lw3), t1);
#pragma unroll
                for (int r = 0; r < 16; ++r) { p0[r] = __builtin_amdgcn_exp2f(p0[r] + t0[r]); p1[r] = __builtin_amdgcn_exp2f(p1[r] + t1[r]); }
                R = swap_lo(t0[0]);
            }
            u32x4 pw0 = {cvt_pk_bf16(p0[0], p0[1]), cvt_pk_bf16(p0[2], p0[3]), cvt_pk_bf16(p0[4], p0[5]), cvt_pk_bf16(p0[6], p0[7])};
            u32x4 pw1 = {cvt_pk_bf16(p0[8], p0[9]), cvt_pk_bf16(p0[10], p0[11]), cvt_pk_bf16(p0[12], p0[13]), cvt_pk_bf16(p0[14], p0[15])};
            u32x4 pw2 = {cvt_pk_bf16(p1[0], p1[1]), cvt_pk_bf16(p1[2], p1[3]), cvt_pk_bf16(p1[4], p1[5]), cvt_pk_bf16(p1[6], p1[7])};
            u32x4 pw3 = {cvt_pk_bf16(p1[8], p1[9]), cvt_pk_bf16(p1[10], p1[11]), cvt_pk_bf16(p1[12], p1[13]), cvt_pk_bf16(p1[14], p1[15])};
            pv(o, vb0 + slot, __builtin_bit_cast(bf16x8, pw0), __builtin_bit_cast(bf16x8, pw1), __builtin_bit_cast(bf16x8, pw2), __builtin_bit_cast(bf16x8, pw3));
        }
        if (MODE == 1) { const bool dn = __all(R < SB_EXIT); if (lane == 0) flags[(i & 1) * 8 + wid] = dn ? 1u : 0u; }
    }
    float linv = 1.f;
    if (MODE == 0) { const float lt = swap_lo(l_run) + swap_hi(l_run); linv = 1.0f / lt; }
    if (hi == 0) wsf[32 + r32] = linv;
    LDS_WAIT();
    bf16_t* Ow = O + (rowbase + q0 + wid * 32) * OPITCH + h * HD;
    { LAS bf16_t* stg = (LAS bf16_t*)(shm + LDS_OST) + wid * 2048;
#pragma unroll
      for (int r = 0; r < 16; ++r) { const int orow = crow(r, hi); const float f = wsf[32 + orow];
#pragma unroll
        for (int d0 = 0; d0 < 2; ++d0) { const unsigned pk = cvt_pk_bf16(o[d0][r] * f, 0.f); stg[orow * 64 + d0 * 32 + r32] = (bf16_t)(pk & 0xffffu); } }
      LDS_WAIT();
#pragma unroll
      for (int i = 0; i < 4; ++i) { const int row = i * 8 + (lane >> 3), ch = lane & 7; const u32x4 v = *(const LAS u32x4*)(stg + row * 64 + ch * 8); *(u32x4*)(Ow + (long)row * OPITCH + ch * 8) = v;
        store_row_ssq(v, hs + (rowbase + q0 + wid * 32 + row) * 16, ch); } }
    asm volatile("s_waitcnt vmcnt(0) lgkmcnt(0)\n\ts_barrier" ::: "memory");
#undef DMA_KV
}
}


namespace fox {
constexpr int QB = 256, KVBLK = 64, PITCH = HW, OPITCH = DM;
constexpr int NSLOT = 3, SLOTB = 9216;
constexpr int LDS_K = 0, LDS_V = NSLOT * SLOTB, LDS_WS = 2 * NSLOT * SLOTB, LDS_OST = LDS_WS + NWAVES * 256, LDS_CL = LDS_OST + NWAVES * 4096, LDS_VOTE = LDS_CL + 512, LDS_END = LDS_VOTE + 32;
static_assert(LDS_END <= RING_BYTES, "fox LDS");
constexpr float WIN_T = 64.0f;
constexpr float FLOOR = -256.0f;
using att::crow; using att::glds16; using att::glds16s;
typedef __attribute__((address_space(3))) const char* lds_cptr;
typedef short v4i16_t __attribute__((ext_vector_type(4)));
#define SBAR() __builtin_amdgcn_sched_barrier(0)
#define WAIT_BAR(N) asm volatile("s_waitcnt vmcnt(" #N ") lgkmcnt(0)\n\ts_barrier" ::: "memory")
__device__ __forceinline__ s16x4 vtr(lds_cptr p) { return __builtin_bit_cast(s16x4, __builtin_amdgcn_ds_read_tr16_b64_v4i16((__attribute__((address_space(3))) v4i16_t*)p)); }
__device__ __forceinline__ void kload2(bf16x8* kf, lds_cptr kp, int j) { kf[2 * j] = *(const LAS bf16x8*)(kp + j * 2048); kf[2 * j + 1] = *(const LAS bf16x8*)(kp + j * 2048 + 512); }
__device__ __forceinline__ void cmask(f32x16& p0, f32x16& p1, int jb, int qrel, int hi) {
    const float NEG = -INFINITY; const int kb = 64 * jb + 4 * hi;
#pragma unroll
    for (int r = 0; r < 16; ++r) { const int kv = kb + (r & 3) + 8 * (r >> 2); if (kv > qrel) p0[r] = NEG; if (kv + 32 > qrel) p1[r] = NEG; }
}
__device__ __forceinline__ void split3(float x, unsigned& hm, unsigned& lo) {
    const unsigned h = cvt_pk_bf16(x, 0.f) & 0xffffu; const float r1 = x - __uint_as_float(h << 16);
    const unsigned m = cvt_pk_bf16(r1, 0.f) & 0xffffu; const float r2 = r1 - __uint_as_float(m << 16);
    hm = h | (m << 16); lo = cvt_pk_bf16(r2, 0.f) & 0xffffu;
}
__device__ __forceinline__ bf16x8 qx_build(float a, int hi) {
    unsigned hm, lo; split3(a, hm, lo);
    u32x4 w; w.x = hm; w.y = lo | 0x3F800000u; w.z = 0x3F803F80u; w.w = 0u;
    if (hi) { w.x = 0u; w.y = 0u; w.z = 0u; }
    return __builtin_bit_cast(bf16x8, w);
}

template <int THRL> __device__ __forceinline__ void fox_unit(int bh, int qb, const bf16_t* Q, const bf16_t* K, const bf16_t* V, bf16_t* O, float* hs, const float* cb, const bf16_t* KXh, float kmax, LAS char* shm) {
    int tid = threadIdx.x; asm volatile("" : "+v"(tid)); const int lane = tid & 63, r32 = lane & 31, hi = lane >> 5; const int wid = __builtin_amdgcn_readfirstlane(tid >> 6);
    const int b = bh >> 3, h = bh & 7; const long rowbase = (long)b * SEQ; const int q0 = qb * QB;
    const bf16_t* Qw = Q + (rowbase + q0 + wid * 32) * PITCH + h * HD;
    const bf16_t* Kh = K + rowbase * PITCH + h * HD; const bf16_t* Vh = V + rowbase * PITCH + h * HD;
    const unsigned lds0 = (unsigned)(uintptr_t)shm;
    LAS float* wsf = (LAS float*)(shm + LDS_WS) + wid * 64;
    const int NT = (q0 + QB) / KVBLK;
    int NTe = NT;
    LAS float* clt = (LAS float*)(shm + LDS_CL); LAS unsigned* votes = (LAS unsigned*)(shm + LDS_VOTE);
    const float clv = (tid < NT) ? cb[64 * tid + 63] : 0.f;
    const unsigned koff = (unsigned)(lane * PITCH + wid * 8) * 2u, voff = (unsigned)((16 * (wid & 3) + (lane >> 2)) * PITCH + (wid >> 2) * 32 + (lane & 3) * 8) * 2u, xoff = (unsigned)lane * 16u;
    const unsigned kdst = lds0 + LDS_K + wid * 1024, vdst = lds0 + LDS_V + wid * 1024, xdst = lds0 + LDS_K + 8192;
    const bool xl = (lane >> 3) == wid;
#define DMA_K(p, slot) do { glds16s(Kh + (long)(NT - 1 - (p)) * KVBLK * PITCH, koff, (unsigned)__builtin_amdgcn_readfirstlane(kdst + (slot))); \
        if (xl) glds16s(KXh + (long)(NT - 1 - (p)) * KVBLK * 8, xoff, (unsigned)__builtin_amdgcn_readfirstlane(xdst + (slot))); } while (0)
#define DMA_V(p, slot) glds16s(Vh + (long)(NT - 1 - (p)) * KVBLK * PITCH, voff, (unsigned)__builtin_amdgcn_readfirstlane(vdst + (slot)))
    bf16x8 kf[10];
    const lds_cptr shm3 = (lds_cptr)shm; const lds_cptr kp0 = shm3 + LDS_K + hi * 1024 + r32 * 16; const lds_cptr kx0 = shm3 + LDS_K + 8192 + r32 * 16;
    const lds_cptr vp0 = shm3 + LDS_V + ((lane >> 4) & 1) * 32 + (lane & 3) * 8 + (4 * hi + ((lane & 15) >> 2)) * 64;
    DMA_K(0, 0); DMA_V(0, 0); DMA_K(1, SLOTB);
    bf16x8 qr[4];
#pragma unroll
    for (int d0 = 0; d0 < 4; ++d0) qr[d0] = *(const bf16x8*)(Qw + (long)r32 * PITCH + d0 * 16 + hi * 8);
    const int qrel = wid * 32 + r32;
    const float ct = cb[q0 + qrel];
    float mhat = 0.f, l_reg = 0.f; f32x16 o[2]; o[0] = f32x16{}; o[1] = f32x16{};
    bf16x8 qx = qx_build(ct, hi);
    const f32x16 z16 = f32x16{};
#define CMASK(P0, P1, p) do { const int jb_ = 3 - (p); if (jb_ >= 0) cmask(P0, P1, jb_, qrel, hi); } while (0)
    bool resc = false;
#define RESC() do { if (resc) { asm volatile("s_waitcnt lgkmcnt(0)" ::: "memory"); \
      _Pragma("unroll") for (int d_ = 0; d_ < 2; ++d_) _Pragma("unroll") for (int r = 0; r < 16; ++r) o[d_][r] *= wsf[crow(r, hi)]; } } while (0)
    f32x16 pA0, pA1, pB0, pB1;
    int sl_prev = 0, sl_cur = 0, sl_next = SLOTB;
#define ROT() do { sl_prev = sl_cur; sl_cur = sl_next; sl_next = (sl_next == (NSLOT - 1) * SLOTB) ? 0 : sl_next + SLOTB; } while (0)
    DMA_K(2, 2 * SLOTB);
    WAIT_BAR(5);
    if (tid < NT) clt[tid] = clv;
    float qkb;
    { float q2 = 0.f;
#pragma unroll
      for (int d0 = 0; d0 < 4; ++d0)
#pragma unroll
          for (int j = 0; j < 8; ++j) { const float e = __uint_as_float(((unsigned)(unsigned short)qr[d0][j]) << 16); q2 += e * e; }
      q2 = att::swap_lo(q2) + att::swap_hi(q2); qkb = sqrtf(q2) * kmax + ct + WIN_T; }
    { const LAS char* kb = (const LAS char*)shm + LDS_K + hi * 1024 + r32 * 16; const LAS char* kxb = (const LAS char*)shm + LDS_K + 8192 + r32 * 16;
      pA0 = MFMA32(*(const LAS bf16x8*)(kxb), qx, z16); pA1 = MFMA32(*(const LAS bf16x8*)(kxb + 512), qx, z16);
#pragma unroll
      for (int d0 = 0; d0 < 4; ++d0) { pA0 = MFMA32(*(const LAS bf16x8*)(kb + d0 * 2048), qr[d0], pA0); pA1 = MFMA32(*(const LAS bf16x8*)(kb + d0 * 2048 + 512), qr[d0], pA1); } }
    asm volatile("s_nop 15\n\ts_nop 7" : "+v"(pA0), "+v"(pA1)); CMASK(pA0, pA1, 0);
    { float a = fmaxf(pA0[0], pA1[0]);
#pragma unroll
      for (int r = 1; r < 16; ++r) a = fmaxf(a, fmaxf(pA0[r], pA1[r]));
      a = fmaxf(att::swap_lo(a), att::swap_hi(a));
      const float dl = fmaxf(a, FLOOR); mhat = dl;
#pragma unroll
      for (int r = 0; r < 16; ++r) { pA0[r] = __builtin_amdgcn_exp2f(pA0[r] - dl); pA1[r] = __builtin_amdgcn_exp2f(pA1[r] - dl); }
      qx = qx_build(ct - mhat, hi); asm volatile("" : "+v"(qx)); }
    WAIT_BAR(0);
    DMA_K(3, 0); DMA_V(1, SLOTB);
    ROT();
    kload2(kf, kp0 + sl_cur, 0); kload2(kf, kp0 + sl_cur, 1); kload2(kf, kp0 + sl_cur, 2); kload2(kf, kp0 + sl_cur, 3);
    kf[8] = *(const LAS bf16x8*)(kx0 + sl_cur); kf[9] = *(const LAS bf16x8*)(kx0 + sl_cur + 512);
    WAIT_BAR(3);
    s16x4 vlo[8], vhi[8]; u32x4 pw0, pw1, pw2, pw3;
#define PKW(P, B) cvt_pk_bf16(P[B], P[B + 1])
#define PAF(k) __builtin_bit_cast(bf16x8, pw##k)
#define VFR(i) (bf16x8){vlo[i][0], vlo[i][1], vlo[i][2], vlo[i][3], vhi[i][0], vhi[i][1], vhi[i][2], vhi[i][3]}
#define PIN(x) asm volatile("" : "+v"(x))
#define MX3(a, b, c) __builtin_fmaxf(__builtin_fmaxf((a), (b)), (c))
#define GAPA(MF, A0, A1, A2, A3, W0, W1, PW) do { MF; sacc += A0; sacc += A1; sacc += A2; sacc += A3; PIN(sacc); W0; W1; PIN(PW); SBAR(); } while (0)
#define EX(v) __builtin_amdgcn_exp2f(v)
#define GAPB(MF, X, B) do { MF; X[B] = EX(X[B]); X[B + 1] = EX(X[B + 1]); X[B + 2] = EX(X[B + 2]); X[B + 3] = EX(X[B + 3]); PIN(X); SBAR(); } while (0)
#define VRD(i) do { vlo[i] = vtr(vp_ + (((i) >> 2) * 4096 + ((i) & 3) * 1024)); vhi[i] = vtr(vp_ + (((i) >> 2) * 4096 + ((i) & 3) * 1024 + 512)); } while (0)
#define KRD(G, j) do { if (G) { kload2(kf, kp0 + sl_next, j); SBAR(); } } while (0)
#define KRDX(G) do { if (G) { kf[8] = *(const LAS bf16x8*)(kx0 + sl_next); kf[9] = *(const LAS bf16x8*)(kx0 + sl_next + 512); SBAR(); } } while (0)
#define STEP(C0, C1, P0, P1, t, GK, GV, GL) do { SBAR(); \
    const lds_cptr vp_ = vp0 + sl_prev; \
    C0 = MFMA32(kf[8], qx, z16); C1 = MFMA32(kf[9], qx, z16); SBAR(); \
    VRD(0); SBAR(); float sacc = (P0[0] + P0[1]); \
    GAPA(C0 = MFMA32(kf[0], qr[0], C0), P0[2], P0[3], P0[4], P0[5],     pw0[0] = PKW(P0, 0), pw0[1] = PKW(P0, 2), pw0); \
    VRD(4); SBAR(); GAPA(C1 = MFMA32(kf[1], qr[0], C1), P0[6], P0[7], P0[8], P0[9],     pw0[2] = PKW(P0, 4), pw0[3] = PKW(P0, 6), pw0); \
    VRD(1); SBAR(); GAPA(C0 = MFMA32(kf[2], qr[1], C0),   P0[10], P0[11], P0[12], P0[13], pw1[0] = PKW(P0, 8), pw1[1] = PKW(P0, 10), pw1); \
    VRD(5); SBAR(); GAPA(C1 = MFMA32(kf[3], qr[1], C1),   P0[14], P0[15], P1[0], P1[1],   pw1[2] = PKW(P0, 12), pw1[3] = PKW(P0, 14), pw1); \
    VRD(2); SBAR(); GAPA(C0 = MFMA32(kf[4], qr[2], C0),   P1[2], P1[3], P1[4], P1[5],     pw2[0] = PKW(P1, 0), pw2[1] = PKW(P1, 2), pw2); \
    VRD(6); SBAR(); GAPA(C1 = MFMA32(kf[5], qr[2], C1),   P1[6], P1[7], P1[8], P1[9],     pw2[2] = PKW(P1, 4), pw2[3] = PKW(P1, 6), pw2); \
    VRD(3); SBAR(); GAPA(C0 = MFMA32(kf[6], qr[3], C0),   P1[10], P1[11], P1[12], P1[13], pw3[0] = PKW(P1, 8), pw3[1] = PKW(P1, 10), pw3); \
    VRD(7); SBAR(); GAPA(C1 = MFMA32(kf[7], qr[3], C1),   P1[14], P1[15], 0.f, 0.f,       pw3[2] = PKW(P1, 12), pw3[3] = PKW(P1, 14), pw3); \
    l_reg += sacc; \
    if (GK) { DMA_K((t) + 3, sl_cur); } if (GV) { DMA_V((t) + 1, sl_next); } \
    CMASK(C0, C1, t); \
    { float a = MX3(C0[0], C0[1], C1[0]), b_ = MX3(C0[2], C0[3], C1[1]); a = MX3(a, C1[2], C1[3]); \
      _Pragma("unroll") for (int r = 4; r < 16; r += 4) { a = MX3(a, C0[r], C0[r + 1]); b_ = MX3(b_, C0[r + 2], C0[r + 3]); a = MX3(a, C1[r], C1[r + 1]); b_ = MX3(b_, C1[r + 2], C1[r + 3]); } \
      float rm = __builtin_fmaxf(a, b_); { auto rr = __builtin_amdgcn_permlane32_swap(__float_as_uint(rm), __float_as_uint(rm), false, false); rm = __builtin_fmaxf(__uint_as_float(rr[0]), __uint_as_float(rr[1])); } \
      resc = false; \
      if (__builtin_expect(__any(rm > (float)THRL), 0)) { const float dl = __builtin_fmaxf(rm, 0.f); mhat += dl; \
        _Pragma("unroll") for (int r = 0; r < 16; ++r) { C0[r] -= dl; C1[r] -= dl; } \
        qx = qx_build(ct - mhat, hi); asm volatile("" : "+v"(qx)); \
        const float f = __builtin_amdgcn_exp2f(-dl); l_reg *= f; if (hi == 0) wsf[r32] = f; resc = true; } } \
    SBAR(); \
    GAPB(o[0] = MFMA32(PAF(0), VFR(0), o[0]), C0, 0); \
    KRDX(GL); GAPB(o[1] = MFMA32(PAF(0), VFR(4), o[1]), C0, 4); \
    KRD(GL, 0); GAPB(o[0] = MFMA32(PAF(1), VFR(1), o[0]), C0, 8); \
    KRD(GL, 1); GAPB(o[1] = MFMA32(PAF(1), VFR(5), o[1]), C0, 12); \
    KRD(GL, 2); GAPB(o[0] = MFMA32(PAF(2), VFR(2), o[0]), C1, 0); \
    KRD(GL, 3); GAPB(o[1] = MFMA32(PAF(2), VFR(6), o[1]), C1, 4); \
    GAPB(o[0] = MFMA32(PAF(3), VFR(3), o[0]), C1, 8); \
    GAPB(o[1] = MFMA32(PAF(3), VFR(7), o[1]), C1, 12); \
    } while (0)
#define ENDW(tt) do { if ((tt) + 3 < NTe) { WAIT_BAR(3); } else if ((tt) + 2 < NTe) { WAIT_BAR(1); } else { WAIT_BAR(0); } } while (0)
#define VOTE(u) do { const int ts_ = NT - (u) - 3; bool ok_ = false; if (ts_ >= 0) { ok_ = __all((qkb - mhat) < clt[ts_]); } if (lane == 0) votes[wid] = ok_ ? 1u : 0u; } while (0)
#define TALLY(u) do { const u32x4 va_ = *(const LAS u32x4*)votes, vb_ = *(const LAS u32x4*)(votes + 4); \
        if (__builtin_amdgcn_readfirstlane((va_.x & va_.y & va_.z & va_.w & vb_.x & vb_.y & vb_.z & vb_.w) != 0u)) { if ((u) + 2 < NTe) { NTe = (u) + 2; WAIT_BAR(0); } } } while (0)
    int t = 1;
    for (; t + 1 < NTe && t < 5; t += 2) {
        STEP(pB0, pB1, pA0, pA1, t, (t + 3 < NTe), (t + 1 < NTe), (t + 1 < NTe));       ENDW(t);     RESC(); ROT();
        STEP(pA0, pA1, pB0, pB1, t + 1, (t + 4 < NTe), (t + 2 < NTe), (t + 2 < NTe));   VOTE(t + 1); ENDW(t + 1); TALLY(t + 1); RESC(); ROT();
    }
#undef CMASK
#define CMASK(P0, P1, p) do {} while (0)
    for (; t + 5 < NTe; t += 2) {
        STEP(pB0, pB1, pA0, pA1, t, true, true, true);       WAIT_BAR(3); RESC(); ROT();
        STEP(pA0, pA1, pB0, pB1, t + 1, true, true, true);   VOTE(t + 1); WAIT_BAR(3); TALLY(t + 1); RESC(); ROT();
    }
    for (; t + 1 < NTe; t += 2) {
        STEP(pB0, pB1, pA0, pA1, t, (t + 3 < NTe), (t + 1 < NTe), (t + 1 < NTe));       ENDW(t);     RESC(); ROT();
        STEP(pA0, pA1, pB0, pB1, t + 1, (t + 4 < NTe), (t + 2 < NTe), (t + 2 < NTe));   ENDW(t + 1); RESC(); ROT();
    }
#undef CMASK
#define CMASK(P0, P1, p) do { const int jb_ = 3 - (p); if (jb_ >= 0) cmask(P0, P1, jb_, qrel, hi); } while (0)
    STEP(pB0, pB1, pA0, pA1, NTe - 1, false, false, false); RESC();
    { float sacc = pB0[0] + pB0[1];
#pragma unroll
      for (int r = 2; r < 16; ++r) sacc += pB0[r];
#pragma unroll
      for (int r = 0; r < 16; ++r) sacc += pB1[r];
      l_reg += sacc;
      pw0 = (u32x4){PKW(pB0, 0), PKW(pB0, 2), PKW(pB0, 4), PKW(pB0, 6)}; pw1 = (u32x4){PKW(pB0, 8), PKW(pB0, 10), PKW(pB0, 12), PKW(pB0, 14)};
      pw2 = (u32x4){PKW(pB1, 0), PKW(pB1, 2), PKW(pB1, 4), PKW(pB1, 6)}; pw3 = (u32x4){PKW(pB1, 8), PKW(pB1, 10), PKW(pB1, 12), PKW(pB1, 14)};
      SBAR(); att::pv(o, (int)(unsigned)(uintptr_t)(vp0 + sl_cur), PAF(0), PAF(1), PAF(2), PAF(3)); }
    l_reg = att::swap_lo(l_reg) + att::swap_hi(l_reg);
    if (hi == 0) wsf[32 + r32] = l_reg; asm volatile("s_waitcnt lgkmcnt(0)" ::: "memory");
    float rli[16];
#pragma unroll
    for (int r = 0; r < 16; ++r) rli[r] = __builtin_amdgcn_rcpf(wsf[32 + crow(r, hi)]);
    bf16_t* Ow = O + (rowbase + q0 + wid * 32) * OPITCH + h * HD;
    { LAS bf16_t* stg = (LAS bf16_t*)(shm + LDS_OST) + wid * 2048;
#pragma unroll
      for (int r = 0; r < 16; ++r) { const int orow = crow(r, hi);
#pragma unroll
        for (int d0 = 0; d0 < 2; ++d0) stg[orow * 64 + d0 * 32 + r32] = (bf16_t)(cvt_pk_bf16(o[d0][r] * rli[r], 0.f) & 0xffffu); }
      asm volatile("s_waitcnt lgkmcnt(0)" ::: "memory");
#pragma unroll
      for (int i = 0; i < 4; ++i) { const int row = i * 8 + (lane >> 3), ch = lane & 7; const u32x4 v = *(const LAS u32x4*)(stg + row * 64 + ch * 8); *(u32x4*)(Ow + (long)row * OPITCH + ch * 8) = v;
        att::store_row_ssq(v, hs + (rowbase + q0 + wid * 32 + row) * 16, ch); } }
    asm volatile("s_waitcnt lgkmcnt(0)\n\ts_barrier" ::: "memory");
#undef DMA_K
#undef DMA_V
#undef CMASK
#undef RESC
#undef ROT
#undef PKW
#undef PAF
#undef VFR
#undef PIN
#undef MX3
#undef GAPA
#undef GAPB
#undef EX
#undef VRD
#undef KRD
#undef KRDX
#undef STEP
#undef ENDW
#undef VOTE
#undef TALLY
}
#undef SBAR
#undef WAIT_BAR
}


namespace sbk {
constexpr int QB = 256, KVBLK = 64, PITCH = HW, OPITCH = DM, NBURST = 6, SLOTB = 8192;
constexpr int LDS_K = 0, LDS_V = NBURST * SLOTB, LDS_FLAG = 2 * NBURST * SLOTB, LDS_END = LDS_FLAG + 128;
static_assert(LDS_END <= RING_BYTES, "sb LDS");
using att::crow; using att::glds16s; using att::qkt; using att::pv; using att::swap_lo;
__device__ __forceinline__ void sb_tile(const LAS char* Kslot, int vb, const bf16x8* qr, bf16x8 TD0, bf16x8 TD1, bf16x8 TONE, int jb, int qrel, int r32, int hi, float& R, f32x16* o) {
    f32x16 p0, p1; const f32x16 z16 = f32x16{};
    qkt(p0, p1, Kslot, qr, z16, r32, hi);
    if (jb >= 0) {
#pragma unroll
        for (int r = 0; r < 16; ++r) { const int kv = 64 * jb + crow(r, hi); if (kv >= qrel) p0[r] = -1.0e30f; if (kv + 32 >= qrel) p1[r] = -1.0e30f; } }
    f32x16 l0, l1;
#pragma unroll
    for (int r = 0; r < 16; ++r) {
        l0[r] = -(fmaxf(p0[r], 0.f) + __builtin_amdgcn_logf(1.0f + __builtin_amdgcn_exp2f(-fabsf(p0[r]))));
        l1[r] = -(fmaxf(p1[r], 0.f) + __builtin_amdgcn_logf(1.0f + __builtin_amdgcn_exp2f(-fabsf(p1[r])))); }
    u32x4 lw0 = {cvt_pk_bf16(l0[0], l0[1]), cvt_pk_bf16(l0[2], l0[3]), cvt_pk_bf16(l0[4], l0[5]), cvt_pk_bf16(l0[6], l0[7])};
    u32x4 lw1 = {cvt_pk_bf16(l0[8], l0[9]), cvt_pk_bf16(l0[10], l0[11]), cvt_pk_bf16(l0[12], l0[13]), cvt_pk_bf16(l0[14], l0[15])};
    u32x4 lw2 = {cvt_pk_bf16(l1[0], l1[1]), cvt_pk_bf16(l1[2], l1[3]), cvt_pk_bf16(l1[4], l1[5]), cvt_pk_bf16(l1[6], l1[7])};
    u32x4 lw3 = {cvt_pk_bf16(l1[8], l1[9]), cvt_pk_bf16(l1[10], l1[11]), cvt_pk_bf16(l1[12], l1[13]), cvt_pk_bf16(l1[14], l1[15])};
    f32x16 rt;
#pragma unroll
    for (int r = 0; r < 16; ++r) rt[r] = R;
    f32x16 t0 = MFMA32(TD0, __builtin_bit_cast(bf16x8, lw0), rt); t0 = MFMA32(TD1, __builtin_bit_cast(bf16x8, lw1), t0);
    t0 = MFMA32(TONE, __builtin_bit_cast(bf16x8, lw2), t0); t0 = MFMA32(TONE, __builtin_bit_cast(bf16x8, lw3), t0);
    f32x16 t1 = MFMA32(TD0, __builtin_bit_cast(bf16x8, lw2), rt); t1 = MFMA32(TD1, __builtin_bit_cast(bf16x8, lw3), t1);
#pragma unroll
    for (int r = 0; r < 16; ++r) { p0[r] = __builtin_amdgcn_exp2f(p0[r] + t0[r]); p1[r] = __builtin_amdgcn_exp2f(p1[r] + t1[r]); }
    R = swap_lo(t0[0]);
    u32x4 pw0 = {cvt_pk_bf16(p0[0], p0[1]), cvt_pk_bf16(p0[2], p0[3]), cvt_pk_bf16(p0[4], p0[5]), cvt_pk_bf16(p0[6], p0[7])};
    u32x4 pw1 = {cvt_pk_bf16(p0[8], p0[9]), cvt_pk_bf16(p0[10], p0[11]), cvt_pk_bf16(p0[12], p0[13]), cvt_pk_bf16(p0[14], p0[15])};
    u32x4 pw2 = {cvt_pk_bf16(p1[0], p1[1]), cvt_pk_bf16(p1[2], p1[3]), cvt_pk_bf16(p1[4], p1[5]), cvt_pk_bf16(p1[6], p1[7])};
    u32x4 pw3 = {cvt_pk_bf16(p1[8], p1[9]), cvt_pk_bf16(p1[10], p1[11]), cvt_pk_bf16(p1[12], p1[13]), cvt_pk_bf16(p1[14], p1[15])};
    pv(o, vb, __builtin_bit_cast(bf16x8, pw0), __builtin_bit_cast(bf16x8, pw1), __builtin_bit_cast(bf16x8, pw2), __builtin_bit_cast(bf16x8, pw3));
}
#define SB_WAITBAR(N) asm volatile("s_waitcnt vmcnt(" #N ") lgkmcnt(0)\n\ts_barrier" ::: "memory")
__device__ __forceinline__ void sb_unit(int b, int h, int qb, const bf16_t* Q, const bf16_t* K, const bf16_t* V, bf16_t* O, float* hs, LAS char* shm) {
    int tid = threadIdx.x; asm volatile("" : "+v"(tid)); const int lane = tid & 63, r32 = lane & 31, hi = lane >> 5; const int wid = __builtin_amdgcn_readfirstlane(tid >> 6);
    const long rowbase = (long)b * SEQ; const int q0 = qb * QB;
    const bf16_t* Qw = Q + (rowbase + q0 + wid * 32) * PITCH + h * HD;
    const bf16_t* Kh = K + rowbase * PITCH + h * HD; const bf16_t* Vh = V + rowbase * PITCH + h * HD;
    const unsigned lds0 = (unsigned)(uintptr_t)shm;
    LAS unsigned* flags = (LAS unsigned*)(shm + LDS_FLAG);
    const unsigned koff = (unsigned)(lane * PITCH + wid * 8) * 2u, voff = (unsigned)((16 * (wid & 3) + (lane >> 2)) * PITCH + (wid >> 2) * 32 + (lane & 3) * 8) * 2u;
    const unsigned kdst = lds0 + LDS_K + wid * 1024, vdst = lds0 + LDS_V + wid * 1024;
#define SB_DMA(p, slot) do { glds16s(Kh + (long)(NT - 1 - (p)) * KVBLK * PITCH, koff, (unsigned)__builtin_amdgcn_readfirstlane(kdst + (slot) * SLOTB)); \
        glds16s(Vh + (long)(NT - 1 - (p)) * KVBLK * PITCH, voff, (unsigned)__builtin_amdgcn_readfirstlane(vdst + (slot) * SLOTB)); } while (0)
    const int vb0 = (int)(lds0 + LDS_V) + ((lane >> 4) & 1) * 32 + (lane & 3) * 8 + (4 * hi + ((lane & 15) >> 2)) * 64;
    const int NT = (q0 + QB) / KVBLK, NB = NT < NBURST ? NT : NBURST;
    for (int p = 0; p < NB; ++p) SB_DMA(p, p);
    bf16x8 qr[4];
#pragma unroll
    for (int d0 = 0; d0 < 4; ++d0) qr[d0] = *(const bf16x8*)(Qw + (long)r32 * PITCH + d0 * 16 + hi * 8);
    f32x16 o[2]; o[0] = f32x16{}; o[1] = f32x16{};
    const int qrel = wid * 32 + r32;
    float R = 0.f;
    bf16x8 TD0, TD1, TONE;
#pragma unroll
    for (int j = 0; j < 8; ++j) { const int kvl = 8 * (j >> 2) + 4 * hi + (j & 3); TD0[j] = (kvl >= r32) ? (short)0x3F80 : (short)0; TD1[j] = (16 + kvl >= r32) ? (short)0x3F80 : (short)0; TONE[j] = (short)0x3F80; }
    if (NB > 4) { SB_WAITBAR(4); } else { SB_WAITBAR(0); }
    bool mid_done = (NB <= 4);
    int p = 3 - (wid >> 1);
    for (; p < NB; ++p) {
        if (p >= 4 && !mid_done) { SB_WAITBAR(0); mid_done = true; }
        sb_tile(shm + LDS_K + p * SLOTB, vb0 + p * SLOTB, qr, TD0, TD1, TONE, 3 - p, qrel, r32, hi, R, o);
        if (__all(R < SB_EXIT)) { ++p; break; }
    }
    if (!mid_done) { SB_WAITBAR(0); }
    { const bool dn = __all(R < SB_EXIT) || (p >= NT); if (lane == 0) flags[wid] = dn ? 1u : 0u; }
    SB_WAITBAR(0);
    bool alldone;
    { const u32x4 fa = *(const LAS u32x4*)flags, fb = *(const LAS u32x4*)(flags + 4); alldone = __builtin_amdgcn_readfirstlane((fa.x & fa.y & fa.z & fa.w & fb.x & fb.y & fb.z & fb.w) != 0u); }
    if (!alldone && NB < NT) {
        SB_DMA(NB, 0);
        for (int i = 0; NB + i < NT; ++i) {
            const int pp = NB + i, sl = i & 1;
            SB_WAITBAR(0);
            if (i > 0) { const LAS unsigned* fl = flags + 8 + ((i - 1) & 1) * 8; const u32x4 fa = *(const LAS u32x4*)fl, fb = *(const LAS u32x4*)(fl + 4);
                if (__builtin_amdgcn_readfirstlane((fa.x & fa.y & fa.z & fa.w & fb.x & fb.y & fb.z & fb.w) != 0u)) break; }
            if (pp + 1 < NT) SB_DMA(pp + 1, sl ^ 1);
            if (!__all(R < SB_EXIT)) sb_tile(shm + LDS_K + sl * SLOTB, vb0 + sl * SLOTB, qr, TD0, TD1, TONE, -1, qrel, r32, hi, R, o);
            { const bool dn = __all(R < SB_EXIT); if (lane == 0) flags[8 + (i & 1) * 8 + wid] = dn ? 1u : 0u; }
        }
        SB_WAITBAR(0);
    }
    bf16_t* Ow = O + (rowbase + q0 + wid * 32) * OPITCH + h * HD;
    { LAS bf16_t* stg = (LAS bf16_t*)(shm + LDS_K) + wid * 2048;
#pragma unroll
      for (int r = 0; r < 16; ++r) { const int orow = crow(r, hi);
#pragma unroll
        for (int d0 = 0; d0 < 2; ++d0) stg[orow * 64 + d0 * 32 + r32] = (bf16_t)(cvt_pk_bf16(o[d0][r], 0.f) & 0xffffu); }
      LDS_WAIT();
#pragma unroll
      for (int i = 0; i < 4; ++i) { const int row = i * 8 + (lane >> 3), ch = lane & 7; const u32x4 v = *(const LAS u32x4*)(stg + row * 64 + ch * 8); *(u32x4*)(Ow + (long)row * OPITCH + ch * 8) = v;
        att::store_row_ssq(v, hs + (rowbase + q0 + wid * 32 + row) * 16, ch); } }
    asm volatile("s_waitcnt vmcnt(0) lgkmcnt(0)\n\ts_barrier" ::: "memory");
#undef SB_DMA
}
#undef SB_WAITBAR
}

#define XB_TMO      128
#define XB_XCNT(j)  (256  + 64 * (j))
#define XB_XSUB(j)  (1280 + 64 * (j))
#define XB_XGEN(j)  (2304 + 64 * (j))
#define XB_TOP      3328
#define XB_TOPGEN   3392
#define XCD_BAR_WORDS 3456
#define XB_SPIN_CAP (1u << 18)
__device__ __forceinline__ unsigned xb_ld(unsigned* p)              { return __hip_atomic_load(p, __ATOMIC_RELAXED, __HIP_MEMORY_SCOPE_AGENT); }
__device__ __forceinline__ unsigned xb_add(unsigned* p, unsigned v) { return __hip_atomic_fetch_add(p, v, __ATOMIC_RELAXED, __HIP_MEMORY_SCOPE_AGENT); }
__device__ __forceinline__ unsigned xb_xcc_id() { return (unsigned)__builtin_amdgcn_s_getreg((3 << 11) | 20) & 0xFu; }
#define XB_SPIN(cond, bar) do { unsigned _sp = 0; while (cond) { __builtin_amdgcn_s_sleep(1); \
    if ((++_sp & 255u) == 0u) { if (xb_ld(&(bar)[XB_TMO])) break; if (_sp > XB_SPIN_CAP) { atomicAdd(&(bar)[XB_TMO], 1u); break; } } } } while (0)
struct XcdBarrier { unsigned* bar; unsigned x; volatile LAS unsigned* st; };
__device__ __forceinline__ XcdBarrier xcd_barrier_post(unsigned* bar, volatile LAS unsigned* st) {
    XcdBarrier b; b.bar = bar; b.x = xb_xcc_id(); b.st = st;
    if (threadIdx.x == 0) (void)xb_add(&bar[XB_XCNT(b.x)], 1u);
    return b;
}
__device__ __forceinline__ void xcd_barrier_complete(unsigned* bar, unsigned x, unsigned& nloc, unsigned& nx) {
    const unsigned G = gridDim.x * gridDim.y * gridDim.z;
    unsigned sum, cnt, mine, sp = 0u;
    for (;;) {
        sum = 0u; cnt = 0u; mine = 0u;
#pragma unroll
        for (unsigned j = 0; j < 16; ++j) { const unsigned c = xb_ld(&bar[XB_XCNT(j)]); sum += c; cnt += (c > 0u) ? 1u : 0u; mine = (j == x) ? c : mine; }
        if (sum == G) break;
        __builtin_amdgcn_s_sleep(1);
        if ((++sp & 255u) == 0u) { if (xb_ld(&bar[XB_TMO])) break; if (sp > XB_SPIN_CAP) { atomicAdd(&bar[XB_TMO], 1u); break; } }
    }
    nloc = mine > 0u ? mine : 1u; nx = cnt > 0u ? cnt : 1u;
}
__device__ __forceinline__ void xcd_barrier(const XcdBarrier& b) {
    asm volatile("s_waitcnt vmcnt(0)" ::: "memory");
    __syncthreads();
    if (threadIdx.x == 0) {
        unsigned* bar = b.bar;
        __builtin_amdgcn_s_waitcnt(0);
        unsigned nloc = b.st[0], nx = b.st[1];
        if (nloc == 0u) { xcd_barrier_complete(bar, b.x, nloc, nx); b.st[0] = nloc; b.st[1] = nx; }
        const unsigned old = xb_add(&bar[XB_XSUB(b.x)], 1u);
        const unsigned gen = old / nloc;
        if (old + 1u == (gen + 1u) * nloc) {
            __builtin_amdgcn_fence(__ATOMIC_RELEASE, "agent");
            asm volatile("s_waitcnt vmcnt(0)" ::: "memory");
            const unsigned og = xb_add(&bar[XB_TOP], 1u);
            const unsigned tg = og / nx;
            if (og + 1u == (tg + 1u) * nx) xb_add(&bar[XB_TOPGEN], 1u);
            else XB_SPIN(xb_ld(&bar[XB_TOPGEN]) == tg, bar);
            __builtin_amdgcn_fence(__ATOMIC_ACQUIRE, "agent");
            xb_add(&bar[XB_XGEN(b.x)], 1u);
            asm volatile("s_waitcnt vmcnt(0)" ::: "memory");
        } else {
            XB_SPIN(xb_ld(&bar[XB_XGEN(b.x)]) == gen, bar);
            __builtin_amdgcn_fence(__ATOMIC_ACQUIRE, "agent");
            asm volatile("s_waitcnt vmcnt(0)" ::: "memory");
        }
    }
    __syncthreads();
}

__device__ __forceinline__ const void* ldp(const volatile LAS unsigned* tab, int i) {
    const unsigned lo = __builtin_amdgcn_readfirstlane(tab[2 * i]), hi = __builtin_amdgcn_readfirstlane(tab[2 * i + 1]);
    return (const void*)(((unsigned long long)hi << 32) | lo);
}
struct Args {
    const float* x; const float* mem; const float* norm_mix; const float* w_in; const float* b_forget; const float* norm_fox; const float* norm_sb; const float* w_out;
    const float* norm_xattn; const float* norm_mem; const float* w_xq; const float* w_xkv; const float* w_xo; const float* norm_ffn;
    const float* w_rg; const float* b_rg; const float* w_re; const float* b_re; const float* w_gate; const float* w_up; const float* w_down; const float* norm_final;
    float* out; unsigned char* ws;
};

__device__ __forceinline__ void transpose_item(const float* W, int ldw, bf16_t* WT, int ldo, int k0, int n0, int dst_row0, const float* gain, LAS float* scr, int lane) {
    float tv[32], tg[32];
#pragma unroll
    for (int i = 0; i < 32; ++i) { const int kk = 2 * i + (lane >> 5); tv[i] = W[(size_t)(k0 + kk) * ldw + n0 + (lane & 31)]; tg[i] = gain ? gain[k0 + kk] : 1.f; }
#pragma unroll
    for (int i = 0; i < 32; ++i) { const int kk = 2 * i + (lane >> 5); scr[kk * 33 + (lane & 31)] = tv[i] * tg[i]; }
    LDS_WAIT(); asm volatile("" ::: "memory");
    const int c = lane & 7;
#pragma unroll
    for (int j = 0; j < 4; ++j) { const int n = (lane >> 3) + 8 * j; const LAS float* s = scr + (8 * c) * 33 + n;
        u32x4 o; o.x = cvt_pk_bf16(s[0 * 33], s[1 * 33]); o.y = cvt_pk_bf16(s[2 * 33], s[3 * 33]); o.z = cvt_pk_bf16(s[4 * 33], s[5 * 33]); o.w = cvt_pk_bf16(s[6 * 33], s[7 * 33]);
        *(u32x4*)(WT + (size_t)(dst_row0 + n) * ldo + k0 + 8 * c) = o; }
    LDS_WAIT(); asm volatile("" ::: "memory");
}

struct SchedDense {
    const char* A; const char* Bt; int nM, nN, G, c; size_t a_tile, b_tile, b_batch; int split_tiles;
    __device__ __forceinline__ bool next(int i, pg8::Unit& u) const {
        int pm, pn; if (!pg8::tile_order(i, G, c, nM, nN, pm, pn)) return false;
        u.a = A + (size_t)pm * a_tile; u.b = Bt + (size_t)pn * b_tile + (size_t)(pm >> 5) * b_batch; u.orow = pm * 256;
        if (split_tiles) { u.aux = pn / split_tiles; u.ocol = (pn % split_tiles) * 256; } else { u.aux = 1; u.ocol = pn * 256; }
        u.rows = nullptr; u.nvalid = 256; return true;
    }
};
struct SchedGH {
    const char* KVm; const char* Wxq; const char* Wxo; int G, c;
    __device__ __forceinline__ bool next(int i, pg8::Unit& u) const {
        const int L = i * G + c; if (L >= 256) return false;
        const int kind = L >> 7, r = L & 127, bh = r >> 2, j = r & 3, b = bh >> 2, h = bh & 3;
        if (kind == 0) { u.a = KVm + ((size_t)(b * 256) * 2048 + h * 256) * 2; u.b = Wxq + ((size_t)(256 * j) * 1024 + h * 256) * 2; u.orow = b * 1024 + h * 256; u.ocol = 256 * j; u.aux = 1; }
        else { u.a = Wxo + ((size_t)(256 * j) * 1024 + h * 256) * 2; u.b = KVm + ((size_t)(b * 256) * 2048 + 1024 + h * 256) * 2; u.orow = b * 1024 + 256 * j; u.ocol = h * 256; u.aux = 2; }
        u.rows = nullptr; u.nvalid = 256; return true;
    }
};
template <int KIND> struct SchedGHk { SchedGH s; __device__ __forceinline__ bool next(int i, pg8::Unit& u) const { const int c2 = (s.G >= 256) ? s.c - 128 * KIND : s.c; if (c2 < 0) return false; const int L = i * s.G + c2; if (L >= 128) return false; SchedGH t = s; t.G = 1; t.c = 0; return t.next(128 * KIND + L, u); } };
struct EpiGH { static constexpr bool HAS_MID = false; bf16_t* GTp; bf16_t* HTp; __device__ __forceinline__ void operator()(const f32x4 (&acc)[2][2][4][2], const pg8::Unit& u, int wr, int wc, int fr, int fq) const {
    pg8::EpiBf16 e{u.aux == 1 ? GTp : HTp, DM, nullptr, 0, 1.f, 1.f, nullptr}; pg8::Unit v = u; v.aux = 1; e(acc, v, wr, wc, fr, fq); } };
struct SchedMoe {
    const char* A; const char* W; const int* list; const LAS int* tbl; int G, c, NPN; size_t w_exp, w_tile, a_tile; int ocol_w;
    __device__ __forceinline__ bool next(int i, pg8::Unit& u) const {
        const int L = i * G + c; const int tl = L / NPN, pn = L % NPN;
        if (tl >= __builtin_amdgcn_readfirstlane(tbl[16])) return false;
        int e = 0;
#pragma unroll 1
        for (int x = 1; x < NEXP; ++x) { if (tl >= __builtin_amdgcn_readfirstlane(tbl[x])) e = x; }
        const int j = tl - __builtin_amdgcn_readfirstlane(tbl[e]), n = __builtin_amdgcn_readfirstlane(tbl[32 + e]) - 256 * j;
        u.a = A + (size_t)tl * a_tile; u.b = W + (size_t)e * w_exp + (size_t)pn * w_tile; u.orow = tl * 256; u.ocol = pn * ocol_w; u.aux = 1;
        u.rows = list + (size_t)e * M + 256 * j; u.nvalid = n < 256 ? n : 256; return true;
    }
};
__device__ __forceinline__ void moe_table(LAS int* tbl, const unsigned* ctl) {
    if (threadIdx.x == 0) { int base = 0; for (int e = 0; e < NEXP; ++e) { const int n = (int)ctl[CW_CNT + 64 * e]; tbl[e] = base; tbl[32 + e] = n; base += (n + 255) >> 8; } tbl[16] = base; }
    __syncthreads();
}

__global__ void __launch_bounds__(NWAVES * 64, 2) hymba_fwd(Args args) {
    extern __shared__ __attribute__((aligned(16))) unsigned char lds_raw[];
    LAS unsigned char* lds = (LAS unsigned char*)lds_raw;
    volatile LAS unsigned* MISC = (volatile LAS unsigned*)(lds + MISC_OFF);
    const int tid0 = threadIdx.x; const int wave = __builtin_amdgcn_readfirstlane(tid0 >> 6);
    const int G = gridDim.x; const int bx = blockIdx.x; const int vcu = (G % 8 == 0) ? (bx % 8) * (G / 8) + bx / 8 : bx;
    volatile LAS unsigned* ATAB = (volatile LAS unsigned*)(lds + MISC_OFF + 512);
    for (int u = tid0; u < 256; u += NWAVES * 64) ((LAS unsigned*)(lds + MISC_OFF))[u] = 0u;
    __syncthreads();
    if (tid0 == 0) { const float* const* ap = (const float* const*)&args;
#pragma unroll
        for (int i = 0; i < 24; ++i) { const unsigned long long v = (unsigned long long)ap[i]; ATAB[2 * i] = (unsigned)v; ATAB[2 * i + 1] = (unsigned)(v >> 32); } }
    __syncthreads();
#define ARGP(name) ((const float*)ldp(ATAB, (int)(offsetof(Args, name) / 8)))
#define PHASE_PTRS \
    int tid = threadIdx.x; asm volatile("" : "+v"(tid)); const int lane = tid & 63; (void)lane; \
    unsigned char* const ws = (unsigned char*)ldp(ATAB, 23); float* const out = (float*)ldp(ATAB, 22); unsigned* const ctl = (unsigned*)(ws + WS_CTL); (void)out; (void)ctl; \
    bf16_t* const Win_t = (bf16_t*)(ws + WS_WIN); bf16_t* const Wout_t = (bf16_t*)(ws + WS_WOUT); bf16_t* const Wxq_n = (bf16_t*)(ws + WS_WXQ); bf16_t* const Wxkv_t = (bf16_t*)(ws + WS_WXKV); \
    bf16_t* const Wxo_t = (bf16_t*)(ws + WS_WXO); bf16_t* const Wgu_t = (bf16_t*)(ws + WS_WGU); bf16_t* const Wd_t = (bf16_t*)(ws + WS_WD); \
    float* const RX = (float*)(ws + WS_RX); float* const RMEM = (float*)(ws + WS_RMEM); float* const LF = (float*)(ws + WS_LF); float* const CC = (float*)(ws + WS_C2); float* const SSQ = (float*)(ws + WS_SSQ); \
    int* const TOKSLOT = (int*)(ws + WS_TOKSLOT); float* const TOKW = (float*)(ws + WS_TOKW); int* const LIST = (int*)(ws + WS_LIST); \
    bf16_t* const MEMB = (bf16_t*)(ws + WS_MEMB); bf16_t* const KVM = (bf16_t*)(ws + WS_KVM); bf16_t* const GT = (bf16_t*)(ws + WS_GT); bf16_t* const HT = (bf16_t*)(ws + WS_HT); \
    bf16_t* const XB = (bf16_t*)(ws + WS_XB); bf16_t* const QKV = (bf16_t*)(ws + WS_QKV); bf16_t* const H1B = (bf16_t*)(ws + WS_H1B); bf16_t* const U2B = (bf16_t*)(ws + WS_U2B); bf16_t* const HID = (bf16_t*)(ws + WS_HID); \
    bf16_t* const OAB = (bf16_t*)(ws + WS_O); bf16_t* const YB = (bf16_t*)(ws + WS_Y); bf16_t* const KX = (bf16_t*)(ws + WS_KX); (void)KX; float* const HS = (float*)(ws + WS_HS); (void)HS; float* const R2 = (float*)(ws + WS_R2); (void)R2; \
    (void)Win_t; (void)Wout_t; (void)Wxq_n; (void)Wxkv_t; (void)Wxo_t; (void)Wgu_t; (void)Wd_t; (void)RX; (void)RMEM; (void)LF; (void)CC; (void)SSQ; (void)TOKSLOT; (void)TOKW; (void)LIST; \
    (void)MEMB; (void)KVM; (void)GT; (void)HT; (void)XB; (void)QKV; (void)H1B; (void)U2B; (void)HID; (void)OAB; (void)YB;
    XcdBarrier bar;
    { unsigned char* const ws0 = (unsigned char*)ldp(ATAB, 23); bar = xcd_barrier_post((unsigned*)(ws0 + WS_CTL) + CW_BAR, MISC + 8); }
    const int gw = vcu * NWAVES + wave, NGW = G * NWAVES;
    unsigned long long t_pa = 0, t_pb = 0; (void)t_pa; (void)t_pb;


    if (PROBE_LO == 0) t_pa = __builtin_amdgcn_s_memrealtime();
    if (PH(0))
    for (int rep_ = 0; rep_ < REPS(0); ++rep_)
    {
        PHASE_PTRS
        LAS float* wfT = (LAS float*)(lds + RING_OFF);
        LAS float* scr = (LAS float*)(lds + RING_OFF + 32768 + wave * 8448);
        { const float* win = ARGP(w_in); const float* gmix = ARGP(norm_mix);
          f32x4 fa[2], fb[2]; float gk[2];
#pragma unroll
          for (int q = 0; q < 2; ++q) { const int k = tid + 512 * q; gk[q] = gmix[k]; fa[q] = *(const f32x4*)(win + (size_t)k * WIN_LD + NPROJ); fb[q] = *(const f32x4*)(win + (size_t)k * WIN_LD + NPROJ + 4); }
#pragma unroll
          for (int q = 0; q < 2; ++q) { const int k = tid + 512 * q;
#pragma unroll
              for (int j = 0; j < 4; ++j) { wfT[j * DM + k] = fa[q][j] * gk[q]; wfT[(4 + j) * DM + k] = fb[q][j] * gk[q]; } } }
        constexpr int I_IN = 16 * 96, I_OUT = 16 * 32, I_XKV = 16 * 64, I_XO = 16 * 32, I_G = 16 * 16 * 8, I_U = I_G, I_D = 16 * 4 * 32, I_XQ = 1024;
        constexpr int NITEMS = I_IN + I_OUT + I_XKV + I_XO + I_G + I_U + I_D + I_XQ;
        for (int it = gw; it < NITEMS; it += NGW) {
            int r = it;
            if (r < I_IN) { const int kb = r / 96, nb = r % 96; transpose_item(ARGP(w_in), WIN_LD, Win_t, DM, 64 * kb, 32 * nb, 32 * nb, ARGP(norm_mix), scr, lane); continue; } r -= I_IN;
            if (r < I_OUT) { const int kb = r / 32, nb = r % 32; const float* gn = (64 * kb < HW) ? ARGP(norm_fox) : (ARGP(norm_sb) - HW); transpose_item(ARGP(w_out), DM, Wout_t, DM, 64 * kb, 32 * nb, 32 * nb, gn, scr, lane); continue; } r -= I_OUT;
            if (r < I_XKV) { const int kb = r / 64, nb = r % 64; transpose_item(ARGP(w_xkv), 2 * DM, Wxkv_t, DM, 64 * kb, 32 * nb, 32 * nb, ARGP(norm_mem), scr, lane); continue; } r -= I_XKV;
            if (r < I_XO) { const int kb = r / 32, nb = r % 32; transpose_item(ARGP(w_xo), DM, Wxo_t, DM, 64 * kb, 32 * nb, 32 * nb, nullptr, scr, lane); continue; } r -= I_XO;
            if (r < I_G + I_U) { const int up = r >= I_G; const int q = up ? r - I_G : r; const int e = q / 128, kb = (q % 128) / 8, nb = q % 8; const int n0 = 32 * nb;
                const float* W = (up ? ARGP(w_up) : ARGP(w_gate)) + (size_t)e * DM * DFF;
                transpose_item(W, DFF, Wgu_t + (size_t)e * 512 * DM, DM, 64 * kb, n0, 256 * (n0 / 128) + (n0 % 128) + (up ? 128 : 0), ARGP(norm_ffn), scr, lane); continue; } r -= I_G + I_U;
            if (r < I_D) { const int e = r / 128, kb = (r % 128) / 32, nb = r % 32; transpose_item(ARGP(w_down) + (size_t)e * DFF * DM, DM, Wd_t + (size_t)e * DM * DFF, DFF, 64 * kb, 32 * nb, 32 * nb, nullptr, scr, lane); continue; } r -= I_D;
            { const int k = r; const float gk = ARGP(norm_xattn)[k]; const f32x4* src = (const f32x4*)(ARGP(w_xq) + (size_t)k * DM) + lane; u32x2* dst = (u32x2*)(Wxq_n + (size_t)k * DM) + lane;
#pragma unroll
              for (int j = 0; j < 4; ++j) { const f32x4 v = src[64 * j] * gk; u32x2 w; w.x = cvt_pk_bf16(v[0], v[1]); w.y = cvt_pk_bf16(v[2], v[3]); dst[64 * j] = w; } }
        }
        __syncthreads();
        const float* xin = ARGP(x); const float* memin = ARGP(mem); const float* bfg = ARGP(b_forget);
        f32x4 vnx[4];
        { const int r0_ = gw; if (r0_ < M + MEMROWS) { const bool im_ = r0_ >= M; const f32x4* xr = (const f32x4*)((im_ ? memin : xin) + (size_t)(im_ ? r0_ - M : r0_) * DM) + lane;
#pragma unroll
            for (int j = 0; j < 4; ++j) vnx[j] = xr[64 * j]; } }
        for (int row = gw; row < M + MEMROWS; row += NGW) {
            const bool is_mem = row >= M; const int r = is_mem ? row - M : row;
            f32x4 v[4]; float s = 0.f;
#pragma unroll
            for (int j = 0; j < 4; ++j) v[j] = vnx[j];
            { const int nr_ = row + NGW; if (nr_ < M + MEMROWS) { const bool im_ = nr_ >= M; const f32x4* xr = (const f32x4*)((im_ ? memin : xin) + (size_t)(im_ ? nr_ - M : nr_) * DM) + lane;
#pragma unroll
                for (int j = 0; j < 4; ++j) vnx[j] = xr[64 * j]; } }
#pragma unroll
            for (int j = 0; j < 4; ++j) s += (v[j][0] * v[j][0] + v[j][1] * v[j][1]) + (v[j][2] * v[j][2] + v[j][3] * v[j][3]);
            const float rinv = rsqrtf(wave_sum(s) * (1.0f / DM) + EPS);
            u32x2* o8 = (u32x2*)((is_mem ? MEMB : XB) + (size_t)r * DM) + lane;
#pragma unroll
            for (int j = 0; j < 4; ++j) { u32x2 w; w.x = cvt_pk_bf16(v[j][0], v[j][1]); w.y = cvt_pk_bf16(v[j][2], v[j][3]); o8[64 * j] = w; }
            if (is_mem) { if (lane == 0) RMEM[r] = rinv; continue; }
            float f[8];
#pragma unroll
            for (int jj = 0; jj < 8; ++jj) { float a = 0.f;
#pragma unroll
                for (int j = 0; j < 4; ++j) { const f32x4 w4 = *(const LAS f32x4*)(wfT + jj * DM + 256 * j + 4 * lane); a += (v[j][0] * w4[0] + v[j][1] * w4[1]) + (v[j][2] * w4[2] + v[j][3] * w4[3]); }
                f[jj] = wave_sum(a); }
            if (lane == 0) RX[r] = rinv;
            if (lane < 8) { float fl = 0.f;
#pragma unroll
                for (int jj = 0; jj < 8; ++jj) fl = (lane == jj) ? f[jj] : fl;
                fl = fl * rinv + bfg[lane];
                const float ls = fminf(fl, 0.f) - log1pf(expf(-fabsf(fl)));
                LF[(size_t)r * 8 + lane] = ls * LOG2E; }
        }
    }
    xcd_barrier(bar);
    if (PROBE_HI == 0) t_pb = __builtin_amdgcn_s_memrealtime();

    if (PROBE_LO == 1) t_pa = __builtin_amdgcn_s_memrealtime();
    if (PH(1))
    if (vcu < 32) {
        PHASE_PTRS
        const int b = vcu >> 2, h = (vcu & 3) * 2 + (wave >> 2), seg = wave & 3, s0 = seg * 2048 + lane * 32;
        const float* src = LF + ((size_t)b * SEQ + s0) * 8 + h;
        float p[32];
#pragma unroll
        for (int j = 0; j < 32; ++j) p[j] = src[j * 8];
#pragma unroll
        for (int j = 1; j < 32; ++j) p[j] += p[j - 1];
        float inc = p[31];
#pragma unroll
        for (int o = 1; o < 64; o <<= 1) { const float y = __shfl_up(inc, o); if (lane >= o) inc += y; }
        LAS float* tot = (LAS float*)(lds + EXTRA_OFF);
        if (lane == 63) tot[wave] = inc;
        __syncthreads();
        float off = inc - p[31];
        for (int q = 0; q < 3; ++q) if (q < seg) off += tot[(wave & 4) + q];
        float* dst = CC + ((size_t)b * NH + h) * SEQ + s0; bf16_t* kx = KX + (((size_t)b * NH + h) * SEQ + s0) * 8;
#pragma unroll
        for (int j = 0; j < 32; ++j) { const float x = off + p[j]; dst[j] = x;
            unsigned hm, lo; fox::split3(-x, hm, lo); u32x4 w; w.x = 0x3F803F80u; w.y = 0x3F80u | (hm << 16); w.z = (hm >> 16) | (lo << 16); w.w = 0u;
            *(u32x4*)(kx + j * 8) = w; }
        VM_WAIT(); __syncthreads();
    }
    if (PH(1))
    for (int rep_ = 0; rep_ < REPS(1); ++rep_)
    {
        PHASE_PTRS
        pg8::Gemm g{DM, DM, DM};
        SchedDense S{(const char*)XB, (const char*)Win_t, M / 256, NPROJ / 256, G, bx, (size_t)256 * DM * 2, (size_t)256 * DM * 2, 0, 2};
        pg8::EpiBf16 E{QKV, HW, RX, QKV_STRIDE, C2, C2, ctl + CW_KN};
        pg8::gemm_phase<pg8::EpiBf16, SchedDense, true, false>(lds + RING_OFF, g, S, E);
    }
    xcd_barrier(bar);
    if (PROBE_HI == 1) t_pb = __builtin_amdgcn_s_memrealtime();

    if (PROBE_LO == 2) t_pa = __builtin_amdgcn_s_memrealtime();
    if (PH(2))
    {
        PHASE_PTRS
        const bf16_t* QA = QKV; const bf16_t* KA = QKV + QKV_STRIDE; const bf16_t* VA = QKV + 2 * QKV_STRIDE;
        const bf16_t* QBp = QKV + 3 * QKV_STRIDE; const bf16_t* KBp = QKV + 4 * QKV_STRIDE; const bf16_t* VBp = QKV + 5 * QKV_STRIDE;
        bf16_t* OA = OAB; bf16_t* OB = OAB + HW;
        LAS char* shm = (LAS char*)(lds + RING_OFF);
        for (int rep = 0; rep < REP_FOX; ++rep)
        for (int i = 0; i < 8; ++i) { const int bh = (vcu >> 5) * 8 + i, x = vcu & 31, qb = (i & 1) ? 31 - x : x;
            const float kmax = sqrtf(__uint_as_float(ctl[CW_KN + bh * 2]) + __uint_as_float(ctl[CW_KN + bh * 2 + 1])) * 1.01f;
            fox::fox_unit<8>(bh, qb, QA, KA, VA, OA, HS + (bh & 7), CC + (size_t)bh * SEQ, KX + (size_t)bh * SEQ * 8, kmax, shm); }
        for (int rep = 0; rep < REP_SB; ++rep)
        for (int i = 0; i < 8; ++i) { const int bh = vcu >> 2, qb = 8 * (vcu & 3) + i;
            sbk::sb_unit(bh >> 3, bh & 7, qb, QBp, KBp, VBp, OB, HS + 8 + (bh & 7), shm); }
        VM_WAIT(); __syncthreads();
        pg8::Gemm g{DM, DM, DM};
        SchedDense S2{(const char*)MEMB, (const char*)Wxkv_t, MEMROWS / 256, 2 * DM / 256, G, bx, (size_t)256 * DM * 2, (size_t)256 * DM * 2, 0, 0};
        pg8::EpiBf16 E2{KVM, 2 * DM, RMEM, 0, 1.f, 1.f, nullptr};
        pg8::gemm_phase<pg8::EpiBf16, SchedDense, true, false>(lds + RING_OFF, g, S2, E2);
    }
    xcd_barrier(bar);
    if (PROBE_HI == 2) t_pb = __builtin_amdgcn_s_memrealtime();

    if (PROBE_LO == 4) t_pa = __builtin_amdgcn_s_memrealtime();
    if (PH(4))
    for (int rep_ = 0; rep_ < REPS(4); ++rep_)
    {
        PHASE_PTRS
        pg8::Gemm g{DM, DM, DM};
        SchedDense S{(const char*)OAB, (const char*)Wout_t, M / 256, DM / 256, G, bx, (size_t)256 * DM * 2, (size_t)256 * DM * 2, 0, 0};
        pg8::EpiOutProj E{XB, H1B, SSQ, HS};
        pg8::gemm_phase<pg8::EpiOutProj, SchedDense, true, false>(lds + RING_OFF, g, S, E);
        pg8::Gemm g2{0, 0, 256};
        SchedGH SG{(const char*)KVM, (const char*)Wxq_n, (const char*)Wxo_t, G, bx};
        EpiGH EG{GT, HT};
        g2.lda = 2 * DM; g2.ldb = DM; SchedGHk<0> S0{SG}; pg8::gemm_phase<EpiGH, SchedGHk<0>, true, false>(lds + RING_OFF, g2, S0, EG);
        g2.lda = DM; g2.ldb = 2 * DM; SchedGHk<1> S1{SG}; pg8::gemm_phase<EpiGH, SchedGHk<1>, true, false>(lds + RING_OFF, g2, S1, EG);
    }
    xcd_barrier(bar);
    if (PROBE_HI == 4) t_pb = __builtin_amdgcn_s_memrealtime();

    if (PROBE_LO == 5) t_pa = __builtin_amdgcn_s_memrealtime();
    if (PH(5))
    for (int rep_ = 0; rep_ < REPS(5); ++rep_)
    {
        PHASE_PTRS
        pg8::Gemm g{DM, DM, DM};
        SchedDense S{(const char*)H1B, (const char*)GT, M / 256, DM / 256, G, bx, (size_t)256 * DM * 2, (size_t)256 * DM * 2, (size_t)DM * DM * 2, 0};
        pg8::EpiSoftmax E{XB, SSQ, (LAS float*)(lds + EXTRA_OFF)};
        pg8::gemm_phase<pg8::EpiSoftmax, SchedDense, true, false>(lds + RING_OFF, g, S, E);
    }
    xcd_barrier(bar);
    if (PROBE_HI == 5) t_pb = __builtin_amdgcn_s_memrealtime();

    if (PROBE_LO == 6) t_pa = __builtin_amdgcn_s_memrealtime();
    if (PH(6))
    {
        PHASE_PTRS
        pg8::Gemm g{DM, DM, DM};
        SchedDense S{(const char*)XB, (const char*)HT, M / 256, DM / 256, G, bx, (size_t)256 * DM * 2, (size_t)256 * DM * 2, (size_t)DM * DM * 2, 0};
        pg8::EpiResidBf16 E{H1B};
        pg8::gemm_phase<pg8::EpiResidBf16, SchedDense, true, false>(lds + RING_OFF, g, S, E);
    }
    xcd_barrier(bar);
    if (PROBE_HI == 6) t_pb = __builtin_amdgcn_s_memrealtime();

    if (PROBE_LO == 7) t_pa = __builtin_amdgcn_s_memrealtime();
    if (PH(7))
    {
        PHASE_PTRS
        LAS bf16_t* wBh = (LAS bf16_t*)(lds + RING_OFF); LAS bf16_t* wBl = wBh + 20 * DM;
        { const f32x4* wg4 = (const f32x4*)ARGP(w_rg); const f32x4* we4 = (const f32x4*)ARGP(w_re); const float* gf = ARGP(norm_ffn);
          f32x4 ga[2], ea[2][4]; float gk[2];
#pragma unroll
          for (int q = 0; q < 2; ++q) { const int k = tid + 512 * q; ga[q] = wg4[k]; gk[q] = gf[k];
#pragma unroll
              for (int c = 0; c < 4; ++c) ea[q][c] = we4[k * 4 + c]; }
#pragma unroll
          for (int q = 0; q < 2; ++q) { const int k = tid + 512 * q;
#pragma unroll
              for (int j = 0; j < 4; ++j) { { const float v = ga[q][j] * gk[q]; const unsigned hi_ = cvt_pk_bf16(v, 0.f) & 0xffffu; wBh[j * DM + k] = (bf16_t)hi_; wBl[j * DM + k] = (bf16_t)(cvt_pk_bf16(v - __uint_as_float(hi_ << 16), 0.f) & 0xffffu); }
#pragma unroll
                  for (int c = 0; c < 4; ++c) { const float v = ea[q][c][j] * gk[q]; const unsigned hi_ = cvt_pk_bf16(v, 0.f) & 0xffffu; const int col = 4 + 4 * c + j; wBh[col * DM + k] = (bf16_t)hi_; wBl[col * DM + k] = (bf16_t)(cvt_pk_bf16(v - __uint_as_float(hi_ << 16), 0.f) & 0xffffu); } } } }
        LAS int* dec_e = (LAS int*)(lds + RING_OFF + 81920); LAS float* dec_w = (LAS float*)(lds + RING_OFF + 81920 + 2048); LAS int* dec_r = (LAS int*)(lds + RING_OFF + 81920 + 4096);
        LAS int* hist = (LAS int*)(lds + RING_OFF + 81920 + 6144); LAS int* ebase = hist + 16;
        if (tid < 16) hist[tid] = 0;
        __syncthreads();
        const float brg0 = ARGP(b_rg)[0], brg1 = ARGP(b_rg)[1], brg2 = ARGP(b_rg)[2], brg3 = ARGP(b_rg)[3]; const float* bre = ARGP(b_re);
        const int tok = lane & 31, half = lane >> 5, jcol = tok < 20 ? tok : 19;
        for (int it = 0; it * NGW < M / 32; ++it) {
            const int T = gw + it * NGW; const bool act = T < M / 32; const int r0 = act ? 32 * T : 0;
            const bf16_t* rowp = H1B + (size_t)(r0 + tok) * DM + 512 * half;
            const LAS bf16_t* wph = wBh + jcol * DM + 512 * half; const LAS bf16_t* wpl = wBl + jcol * DM + 512 * half;
            f32x16 ah0 = f32x16{}, ah1 = f32x16{}, al0 = f32x16{}, al1 = f32x16{}; float ssq = 0.f;
#pragma unroll 4
            for (int sidx = 0; sidx < 64; sidx += 2) {
                const u32x4 a0 = *(const u32x4*)(rowp + 8 * sidx), a1 = *(const u32x4*)(rowp + 8 * sidx + 8);
                const bf16x8 wh0 = *(const LAS bf16x8*)(wph + 8 * sidx), wl0 = *(const LAS bf16x8*)(wpl + 8 * sidx), wh1 = *(const LAS bf16x8*)(wph + 8 * sidx + 8), wl1 = *(const LAS bf16x8*)(wpl + 8 * sidx + 8);
                ah0 = MFMA32(wh0, __builtin_bit_cast(bf16x8, a0), ah0); al0 = MFMA32(wl0, __builtin_bit_cast(bf16x8, a0), al0);
                ah1 = MFMA32(wh1, __builtin_bit_cast(bf16x8, a1), ah1); al1 = MFMA32(wl1, __builtin_bit_cast(bf16x8, a1), al1);
                ssq += (bf16lo(a0.x) * bf16lo(a0.x) + bf16hi(a0.x) * bf16hi(a0.x)) + (bf16lo(a0.y) * bf16lo(a0.y) + bf16hi(a0.y) * bf16hi(a0.y)) + (bf16lo(a0.z) * bf16lo(a0.z) + bf16hi(a0.z) * bf16hi(a0.z)) + (bf16lo(a0.w) * bf16lo(a0.w) + bf16hi(a0.w) * bf16hi(a0.w));
                ssq += (bf16lo(a1.x) * bf16lo(a1.x) + bf16hi(a1.x) * bf16hi(a1.x)) + (bf16lo(a1.y) * bf16lo(a1.y) + bf16hi(a1.y) * bf16hi(a1.y)) + (bf16lo(a1.z) * bf16lo(a1.z) + bf16hi(a1.z) * bf16hi(a1.z)) + (bf16lo(a1.w) * bf16lo(a1.w) + bf16hi(a1.w) * bf16hi(a1.w));
            }
            const float rinv = rsqrtf((att::swap_lo(ssq) + att::swap_hi(ssq)) * (1.0f / DM) + EPS);
            float lg[20];
#pragma unroll
            for (int r = 0; r < 12; ++r) { const float c = (ah0[r] + ah1[r]) + (al0[r] + al1[r]); auto rr = __builtin_amdgcn_permlane32_swap(__float_as_uint(c), __float_as_uint(c), false, false);
                const int jl = (r & 3) + 8 * (r >> 2); lg[jl] = __uint_as_float(rr[0]) * rinv; if (r < 8) lg[jl + 4] = __uint_as_float(rr[1]) * rinv; }
            float g0 = lg[0] + brg0, g1 = lg[1] + brg1, g2 = lg[2] + brg2, g3 = lg[3] + brg3;
            int gi = 0; float gm = g0; if (g1 > gm) { gm = g1; gi = 1; } if (g2 > gm) { gm = g2; gi = 2; } if (g3 > gm) { gm = g3; gi = 3; }
            const float gval = 1.0f / (expf(g0 - gm) + expf(g1 - gm) + expf(g2 - gm) + expf(g3 - gm));
            float el[4];
#pragma unroll
            for (int j = 0; j < 4; ++j) { const float e0 = lg[4 + j], e1 = lg[8 + j], e2 = lg[12 + j], e3 = lg[16 + j]; el[j] = ((gi == 0) ? e0 : (gi == 1) ? e1 : (gi == 2) ? e2 : e3) + bre[gi * 4 + j]; }
            int i0 = 0; float m0 = el[0];
#pragma unroll
            for (int j = 1; j < 4; ++j) if (el[j] > m0) { m0 = el[j]; i0 = j; }
            int i1 = -1; float m1 = -3.0e38f;
#pragma unroll
            for (int j = 0; j < 4; ++j) if (j != i0 && el[j] > m1) { m1 = el[j]; i1 = j; }
            const float w0 = 1.0f / (1.0f + expf(m1 - m0)), w1 = 1.0f - w0;
            if (act) { const int e = gi * 4 + (half == 0 ? i0 : i1); const float w = gval * (half == 0 ? w0 : w1);
                const int idx = (wave * 32 + tok) * 2 + half; dec_e[idx] = e; dec_w[idx] = w; dec_r[idx] = __hip_atomic_fetch_add(hist + e, 1, __ATOMIC_RELAXED, __HIP_MEMORY_SCOPE_WORKGROUP);
                if (half == 0) R2[r0 + tok] = rinv; }
            __syncthreads();
            if (tid < 16) { const int n = hist[tid]; ebase[tid] = n ? (int)__hip_atomic_fetch_add(ctl + CW_CNT + 64 * tid, (unsigned)n, __ATOMIC_RELAXED, __HIP_MEMORY_SCOPE_AGENT) : 0; }
            __syncthreads();
            if (act) { const int row = r0 + (lane >> 1), idx = wave * 64 + lane; const int e = dec_e[idx], pos = ebase[e] + dec_r[idx];
                LIST[(size_t)e * M + pos] = row; TOKSLOT[(size_t)row * 2 + (lane & 1)] = (e << 20) | pos; TOKW[(size_t)row * 2 + (lane & 1)] = dec_w[idx]; }
            __syncthreads();
            if (tid < 16) hist[tid] = 0;
            __syncthreads();
        }
    }
    xcd_barrier(bar);
    if (PROBE_HI == 7) t_pb = __builtin_amdgcn_s_memrealtime();

    if (PROBE_LO == 8) t_pa = __builtin_amdgcn_s_memrealtime();
    if (PH(8))
    for (int rep_ = 0; rep_ < REPS(8); ++rep_)
    {
        PHASE_PTRS
        pg8::Gemm g{DM, DM, DM};
        LAS int* tbl = (LAS int*)(lds + EXTRA_OFF + 8192); moe_table(tbl, ctl);
        SchedMoe S; S.A = (const char*)H1B; S.W = (const char*)Wgu_t; S.list = LIST; S.tbl = tbl; S.G = G; S.c = bx; S.NPN = 2; S.w_exp = (size_t)512 * DM * 2; S.w_tile = (size_t)256 * DM * 2; S.a_tile = 0; S.ocol_w = 128;
        pg8::EpiSwiglu E{HID, R2};
        pg8::gemm_phase<pg8::EpiSwiglu, SchedMoe, true, true>(lds + RING_OFF, g, S, E);
    }
    xcd_barrier(bar);
    if (PROBE_HI == 8) t_pb = __builtin_amdgcn_s_memrealtime();

    if (PROBE_LO == 9) t_pa = __builtin_amdgcn_s_memrealtime();
    if (PH(9))
    for (int rep_ = 0; rep_ < REPS(9); ++rep_)
    {
        PHASE_PTRS
        pg8::Gemm g{DFF, DFF, DFF};
        LAS int* tbl = (LAS int*)(lds + EXTRA_OFF + 8192);
        SchedMoe S; S.A = (const char*)HID; S.W = (const char*)Wd_t; S.list = LIST; S.tbl = tbl; S.G = G; S.c = bx; S.NPN = 4; S.w_exp = (size_t)DM * DFF * 2; S.w_tile = (size_t)256 * DFF * 2; S.a_tile = (size_t)256 * DFF * 2; S.ocol_w = 256;
        pg8::EpiBf16 E{YB, DM, nullptr, 0, 1.f, 1.f, nullptr};
        pg8::gemm_phase<pg8::EpiBf16, SchedMoe, true, false>(lds + RING_OFF, g, S, E);
    }
    xcd_barrier(bar);
    if (PROBE_HI == 9) t_pb = __builtin_amdgcn_s_memrealtime();

    if (PROBE_LO == 10) t_pa = __builtin_amdgcn_s_memrealtime();
    if (PH(10))
    {
        PHASE_PTRS
        const LAS int* tb = (const LAS int*)(lds + EXTRA_OFF + 8192);
        const f32x4* gp = (const f32x4*)ARGP(norm_final) + lane;
        int sl0 = 0, sl1 = 0; float sw0 = 0.f, sw1 = 0.f;
        u32x2 ya_n[4], yb_n[4], hh_n[4]; float w0_n = 0.f, w1_n = 0.f;
#define P10_SLOTS(rw) do { sl0 = TOKSLOT[(size_t)(rw) * 2]; sl1 = TOKSLOT[(size_t)(rw) * 2 + 1]; sw0 = TOKW[(size_t)(rw) * 2]; sw1 = TOKW[(size_t)(rw) * 2 + 1]; } while (0)
#define P10_DATA(rw) do { const int r0_ = tb[sl0 >> 20] * 256 + (sl0 & 0xfffff), r1_ = tb[sl1 >> 20] * 256 + (sl1 & 0xfffff); w0_n = sw0; w1_n = sw1; \
        const u32x2* y0_ = (const u32x2*)(YB + (size_t)r0_ * DM) + lane; const u32x2* y1_ = (const u32x2*)(YB + (size_t)r1_ * DM) + lane; const u32x2* h_ = (const u32x2*)(H1B + (size_t)(rw) * DM) + lane; \
        _Pragma("unroll") for (int j = 0; j < 4; ++j) { ya_n[j] = y0_[64 * j]; yb_n[j] = y1_[64 * j]; hh_n[j] = h_[64 * j]; } } while (0)
        if (gw < M) { P10_SLOTS(gw); P10_DATA(gw); if (gw + NGW < M) P10_SLOTS(gw + NGW); }
        for (int row = gw; row < M; row += NGW) {
            u32x2 ya[4], yb[4], hh[4]; const float w0 = w0_n, w1 = w1_n;
#pragma unroll
            for (int j = 0; j < 4; ++j) { ya[j] = ya_n[j]; yb[j] = yb_n[j]; hh[j] = hh_n[j]; }
            if (row + NGW < M) { P10_DATA(row + NGW); if (row + 2 * NGW < M) P10_SLOTS(row + 2 * NGW); }
            f32x4* hr = (f32x4*)(out + (size_t)row * DM) + lane;
            f32x4 v[4]; float s = 0.f;
#pragma unroll
            for (int j = 0; j < 4; ++j) { const u32x2 a = ya[j], b = yb[j]; const u32x2 hx = hh[j]; f32x4 h = {bf16lo(hx.x), bf16hi(hx.x), bf16lo(hx.y), bf16hi(hx.y)};
                h[0] += w0 * bf16lo(a.x) + w1 * bf16lo(b.x); h[1] += w0 * bf16hi(a.x) + w1 * bf16hi(b.x); h[2] += w0 * bf16lo(a.y) + w1 * bf16lo(b.y); h[3] += w0 * bf16hi(a.y) + w1 * bf16hi(b.y);
                v[j] = h; s += (h[0] * h[0] + h[1] * h[1]) + (h[2] * h[2] + h[3] * h[3]); }
            const float rinv = rsqrtf(wave_sum(s) * (1.0f / DM) + EPS);
#pragma unroll
            for (int j = 0; j < 4; ++j) hr[64 * j] = v[j] * rinv * gp[64 * j];
        }
#undef P10_SLOTS
#undef P10_DATA
    }
    if (PROBE_LO >= 0) {
        if (PROBE_HI == 10) t_pb = __builtin_amdgcn_s_memrealtime();
        if (blockIdx.x == 0 && threadIdx.x == 0) { const unsigned long long t0 = __builtin_amdgcn_s_memrealtime(), span = 2 * (t_pb - t_pa);
            while (__builtin_amdgcn_s_memrealtime() - t0 < span) __builtin_amdgcn_s_sleep(8); }
    }
}

extern "C" void kernel_launch(void* const* d_in, const int* in_sizes, int n_in, void* d_out, int out_size, void* d_ws, size_t ws_size, hipStream_t stream) {
    static int grid = 0;
    if (grid == 0) {
        if (n_in != 22 || in_sizes[0] != M * DM || out_size != M * DM || ws_size < WS_END) { fprintf(stderr, "kernel_launch: unexpected shapes (n_in %d, in0 %d, out %d, ws %zu)\n", n_in, n_in > 0 ? in_sizes[0] : -1, out_size, ws_size); grid = -1; return; }
        int dev = 0, cus = 0, per_cu = 0;
        if (hipGetDevice(&dev) != hipSuccess || hipDeviceGetAttribute(&cus, hipDeviceAttributeMultiprocessorCount, dev) != hipSuccess) { grid = -1; return; }
        if (hipFuncSetAttribute((const void*)hymba_fwd, hipFuncAttributeMaxDynamicSharedMemorySize, LDS_BYTES) != hipSuccess) { fprintf(stderr, "kernel_launch: hipFuncSetAttribute failed\n"); grid = -1; return; }
        if (hipOccupancyMaxActiveBlocksPerMultiprocessor(&per_cu, (const void*)hymba_fwd, NWAVES * 64, LDS_BYTES) != hipSuccess || per_cu < 1) { fprintf(stderr, "kernel_launch: occupancy query reports %d\n", per_cu); }
        (void)hipGetLastError();
        grid = cus;
    }
    if (grid < 0) return;
    (void)hipMemsetAsync((char*)d_ws + WS_CTL, 0, CTL_ZERO_BYTES, stream);
    Args a{};
    const float** p = (const float**)&a;
    for (int i = 0; i < 22; ++i) p[i] = (const float*)d_in[i];
    a.out = (float*)d_out; a.ws = (unsigned char*)d_ws;
    hipLaunchKernelGGL(hymba_fwd, dim3(grid), dim3(NWAVES * 64), LDS_BYTES, stream, a);
}
```

```cpp
#include <hip/hip_runtime.h>
#include <hip/hip_bf16.h>
#include <cstdio>
#include <cstdint>

#define LAS __attribute__((address_space(3)))
#define GAS __attribute__((address_space(1)))
typedef unsigned short bf16_t;
typedef short bf16x8 __attribute__((ext_vector_type(8)));
typedef short s16x4 __attribute__((ext_vector_type(4)));
typedef float f32x4 __attribute__((ext_vector_type(4)));
typedef float f32x2 __attribute__((ext_vector_type(2)));
typedef float f32x16 __attribute__((ext_vector_type(16)));
typedef unsigned u32x4 __attribute__((ext_vector_type(4)));
typedef unsigned u32x2 __attribute__((ext_vector_type(2)));
typedef __bf16 bf16x2_t __attribute__((ext_vector_type(2)));

constexpr int BATCH = 8, SEQ = 8192, DM = 1024, M = BATCH * SEQ;
constexpr int NH = 8, HD = 64, HW = NH * HD;
constexpr int NPROJ = 3 * HW * 2;
constexpr int WIN_LD = NPROJ + NH;
constexpr int NMEM = 256, XH = 4, XD = 256, MEMROWS = BATCH * NMEM;
constexpr int NEXP = 16, DFF = 256;
constexpr float EPS = 1e-6f;
constexpr float LOG2E = 1.4426950408889634f;
constexpr float C2 = 0.125f * LOG2E;
constexpr float XSC = 0.0625f * LOG2E;
constexpr float SB_EXIT = -48.0f;

constexpr size_t MiB = 1u << 20;
constexpr size_t WS_CTL = 0, CTL_ZERO_BYTES = 128 * 1024;
constexpr size_t WS_WIN = 1 * MiB;
constexpr size_t WS_WOUT = 7 * MiB;
constexpr size_t WS_WXQ = 9 * MiB;
constexpr size_t WS_WXKV = 11 * MiB;
constexpr size_t WS_WXO = 15 * MiB;
constexpr size_t WS_WGU = 17 * MiB;
constexpr size_t WS_WD = 33 * MiB;
constexpr size_t WS_RX = 41 * MiB;
constexpr size_t WS_RMEM = WS_RX + 256 * 1024;
constexpr size_t WS_R2 = WS_RX + 512 * 1024;
constexpr size_t WS_LF = 42 * MiB;
constexpr size_t WS_C2 = 44 * MiB;
constexpr size_t WS_SSQ = 46 * MiB;
constexpr size_t WS_TOKSLOT = 50 * MiB;
constexpr size_t WS_TOKW = 51 * MiB;
constexpr size_t WS_LIST = 52 * MiB;
constexpr size_t WS_MEMB = 56 * MiB;
constexpr size_t WS_KVM = 60 * MiB;
constexpr size_t WS_GT = 68 * MiB;
constexpr size_t WS_HT = 84 * MiB;
constexpr size_t WS_KX = 100 * MiB;
constexpr size_t WS_HS = 108 * MiB;
constexpr size_t WS_XB = 128 * MiB;
constexpr size_t WS_QKV = 256 * MiB;
constexpr size_t WS_H1B = 256 * MiB, WS_U2B = 384 * MiB, WS_HID = 512 * MiB;
constexpr size_t WS_O = 640 * MiB;
constexpr size_t WS_Y = 704 * MiB;
constexpr size_t WS_END = 1024 * MiB;
constexpr size_t QKV_STRIDE = (size_t)M * HW;
constexpr int MAXTILES = M * 2 / 256 + NEXP;
static_assert(WS_Y + (size_t)MAXTILES * 256 * 1024 * 2 <= WS_END, "ws map");
static_assert(WS_HID + (size_t)MAXTILES * 256 * 256 * 2 <= WS_O, "ws map");
constexpr int CW_BAR = 4096;
constexpr int CW_SBQ = 20736;
constexpr int CW_KN = 20480;
constexpr int CW_CNT = 16384;

constexpr int RING_OFF = 0, RING_BYTES = 131072;
constexpr int EXTRA_OFF = 131072, EXTRA_BYTES = 16384;
constexpr int MISC_OFF = EXTRA_OFF + EXTRA_BYTES;
constexpr int LDS_BYTES = MISC_OFF + 1024;
constexpr int NWAVES = 8;
#ifndef PHASE_MASK
#define PHASE_MASK 0x7ff
#endif
#define PH(n) ((PHASE_MASK >> (n)) & 1)
#ifndef PROBE_LO
#define PROBE_LO -1
#endif
#ifndef PROBE_HI
#define PROBE_HI -1
#endif
#ifndef FOX_V2
#define FOX_V2 1
#endif
#ifndef REP_MASK
#define REP_MASK 0
#endif
#define REPS(n) (1 + ((REP_MASK >> (n)) & 1))
#ifndef REP_FOX
#define REP_FOX 1
#endif
#ifndef REP_SB
#define REP_SB 1
#endif

__device__ __forceinline__ unsigned cvt_pk_bf16(float lo, float hi) { f32x2 v = {lo, hi}; bf16x2_t b = __builtin_convertvector(v, bf16x2_t); return __builtin_bit_cast(unsigned, b); }
__device__ __forceinline__ float bf16lo(unsigned u) { return __uint_as_float(u << 16); }
__device__ __forceinline__ float bf16hi(unsigned u) { return __uint_as_float(u & 0xffff0000u); }
__device__ __forceinline__ float wave_sum(float v) {
#pragma unroll
    for (int o = 1; o < 64; o <<= 1) v += __shfl_xor(v, o);
    return v;
}
#define LDS_WAIT() asm volatile("s_waitcnt lgkmcnt(0)" ::: "memory")
#define VM_WAIT() asm volatile("s_waitcnt vmcnt(0)" ::: "memory")

namespace pg8 {
constexpr int BM = 256, BK = 64, HALF = 128, HTB = HALF * BK * 2, STAGE_BYTES = 8 * HTB, NXCD = 8, WGM = 8;
__host__ __device__ __forceinline__ int lds_byte(int r, int c) { const int st = (r >> 4) * 2 + (c >> 5), rr = r & 15, cc = c & 31, ob = rr * 64 + cc * 2; return st * 1024 + (ob ^ (((ob >> 9) & 1) << 5)); }
__host__ __device__ __forceinline__ void stage_rc(int b, int& R, int& C) { const int st = b / 1024, sb = b % 1024, swz = sb ^ (((sb >> 9) & 1) << 5); R = (st >> 1) * 16 + swz / 64; C = (st & 1) * 32 + (swz % 64) / 2; }
__host__ __device__ __forceinline__ int perm32(int rho) { const int n = rho >> 4, i = rho & 15; return 8 * (i >> 2) + 4 * n + (i & 3); }

struct Unit { const char* a; const char* b; int orow, ocol, aux; const int* rows; int nvalid; };
struct Gemm { int lda, ldb, K; };

__device__ __forceinline__ bool tile_order(int i, int G, int c, int nM, int nN, int& pm, int& pn) {
    const int nwg = nM * nN; const long L = (long)i * G + c; if (L >= nwg) return false;
    int wgid = (int)L; { const int q = nwg / NXCD, r = nwg % NXCD, xcd = wgid % NXCD, off = wgid / NXCD; wgid = (xcd < r ? xcd * (q + 1) : r * (q + 1) + (xcd - r) * q) + off; }
    const int nig = WGM * nN, gid = wgid / nig, fm = gid * WGM, gsz = (nM - fm) < WGM ? (nM - fm) : WGM;
    pm = fm + ((wgid % nig) % gsz); pn = (wgid % nig) / gsz; return true;
}

template <class Epi, class Sched, bool ALIGN_EPI, bool GATHER>
__device__ __forceinline__ void gemm_phase(LAS unsigned char* lds, const Gemm g, const Sched& S, const Epi& E) {
    int tid = threadIdx.x; asm volatile("" : "+v"(tid));
    const int wid = __builtin_amdgcn_readfirstlane(tid >> 6), lane = tid & 63, wr = wid >> 2, wc = wid & 3, fr = lane & 15, fq = lane >> 4;
    const int K = g.K, nt = K / BK;
    unsigned voffA[2], voffB[2]; int RA[2], CA[2];
#pragma unroll
    for (int i = 0; i < 2; ++i) { int R, C; stage_rc(tid * 16 + i * 8192, R, C); const int Rb = (R & ~31) + perm32(R & 31);
        RA[i] = R; CA[i] = C; voffA[i] = (unsigned)(R * g.lda + C) * 2u; voffB[i] = (unsigned)(Rb * g.ldb + C) * 2u; }
    const size_t kstep = (size_t)(BK * 2);
    const size_t hstepA = (size_t)HALF * g.lda * 2, hstepB = (size_t)HALF * g.ldb * 2;
    const unsigned ldsw = (unsigned)wid * 1024u;
    const int aoff = lds_byte(wr * 64 + fr, fq * 8), boff = lds_byte(wc * 32 + fr, fq * 8);
#define PG8_SA(b, h) (((b) * 2 + (h)) * HTB)
#define PG8_SB(b, h) ((4 + (b) * 2 + (h)) * HTB)
#define PG8_STAGE2(bufoff, gbase, v0, v1) do { \
        __builtin_amdgcn_global_load_lds((const unsigned*)((const char*)(gbase) + (v0)), (LAS unsigned*)(lds + (bufoff) + ldsw), 16, 0, 0); \
        __builtin_amdgcn_global_load_lds((const unsigned*)((const char*)(gbase) + (v1)), (LAS unsigned*)(lds + (bufoff) + ldsw + 8192), 16, 0, 0); } while (0)
#define PG8_STAGEB(bufoff, gbase) PG8_STAGE2(bufoff, gbase, voffB[0], voffB[1])
#define PG8_STAGEA(bufoff, kptr, h, NX) do { if constexpr (GATHER) { const unsigned v0_ = (NX) ? gvn[h][0] : gvc[h][0], v1_ = (NX) ? gvn[h][1] : gvc[h][1]; PG8_STAGE2(bufoff, kptr, v0_, v1_); } \
        else { PG8_STAGE2(bufoff, (kptr) + (h) * hstepA, voffA[0], voffA[1]); } } while (0)
#define PG8_LDA(dst, b, h) do { _Pragma("unroll") for (int m = 0; m < 4; ++m) _Pragma("unroll") for (int k = 0; k < 2; ++k) dst[m][k] = *(const LAS bf16x8*)(lds + PG8_SA(b, h) + aoff + m * 2048 + k * 1024); } while (0)
#define PG8_LDB(dst, b, h) do { _Pragma("unroll") for (int n = 0; n < 2; ++n) _Pragma("unroll") for (int k = 0; k < 2; ++k) dst[n][k] = *(const LAS bf16x8*)(lds + PG8_SB(b, h) + boff + n * 2048 + k * 1024); } while (0)
#define PG8_MMA(ai, bj, At, Bt) do { __builtin_amdgcn_s_setprio(1); _Pragma("unroll") for (int m = 0; m < 4; ++m) _Pragma("unroll") for (int n = 0; n < 2; ++n) _Pragma("unroll") for (int k = 0; k < 2; ++k) \
        acc[ai][bj][m][n] = __builtin_amdgcn_mfma_f32_16x16x32_bf16(Bt[n][k], At[m][k], acc[ai][bj][m][n], 0, 0, 0); __builtin_amdgcn_s_setprio(0); } while (0)
#define PG8_WAIT_V(n) asm volatile("s_waitcnt vmcnt(" #n ")" ::: "memory")
#define PG8_WAIT_L(n) asm volatile("s_waitcnt lgkmcnt(" #n ")" ::: "memory")
#define PG8_BAR __builtin_amdgcn_s_barrier()
#define PG8_SCHED __builtin_amdgcn_sched_barrier(0)
#define PG8_GATHER_OFFS(dst, u) do { _Pragma("unroll") for (int h_ = 0; h_ < 2; ++h_) _Pragma("unroll") for (int i_ = 0; i_ < 2; ++i_) { const int r_ = h_ * HALF + RA[i_]; \
        const int idx_ = (u).rows[r_ < (u).nvalid ? r_ : 0]; dst[h_][i_] = (unsigned)(idx_ * g.lda + CA[i_]) * 2u; } } while (0)
    Unit cur, nxt; int ui = 0;
    if (!S.next(0, cur)) return;
    unsigned gvc[2][2] = {{0u, 0u}, {0u, 0u}}, gvn[2][2] = {{0u, 0u}, {0u, 0u}};
    if constexpr (GATHER) { PG8_GATHER_OFFS(gvc, cur); }
    f32x4 acc[2][2][4][2];
#pragma unroll
    for (int a = 0; a < 2; ++a)
#pragma unroll
        for (int b = 0; b < 2; ++b)
#pragma unroll
            for (int m = 0; m < 4; ++m)
#pragma unroll
                for (int n = 0; n < 2; ++n) acc[a][b][m][n] = (f32x4){0.f, 0.f, 0.f, 0.f};
    bf16x8 At[4][2], B0[2][2], B1[2][2];
    const char* cA = cur.a; const char* cB = cur.b;
    PG8_STAGEB(PG8_SB(0, 0), cB); PG8_STAGEB(PG8_SB(0, 1), cB + hstepB); PG8_STAGEA(PG8_SA(0, 0), cA, 0, false); PG8_STAGEA(PG8_SA(0, 1), cA, 1, false);
    if (wr == 1) PG8_BAR;
    PG8_WAIT_V(2); PG8_BAR;
    PG8_STAGEB(PG8_SB(1, 0), cB + kstep); PG8_STAGEA(PG8_SA(1, 0), cA + kstep, 0, false); PG8_STAGEB(PG8_SB(1, 1), cB + hstepB + kstep);
    PG8_WAIT_V(6); PG8_BAR;
    for (;;) {
        const bool has_next = S.next(ui + 1, nxt);
        const char* nA = has_next ? nxt.a : cA; const char* nB = has_next ? nxt.b : cB;
        if constexpr (GATHER) { if (has_next) { PG8_GATHER_OFFS(gvn, nxt); } else { gvn[0][0] = gvc[0][0]; gvn[0][1] = gvc[0][1]; gvn[1][0] = gvc[1][0]; gvn[1][1] = gvc[1][1]; } }
#pragma unroll 1
        for (int t = 0; t < nt; t += 2) {
            const bool last = (t == nt - 2);
            const char* a1 = cA + (size_t)(t + 1) * kstep;
            const char* a2 = last ? nA : cA + (size_t)(t + 2) * kstep; const char* b2 = last ? nB : cB + (size_t)(t + 2) * kstep;
            const char* a3 = a2 + kstep; const char* b3 = b2 + kstep;
            PG8_LDB(B0, 0, 0); PG8_LDB(B1, 0, 1); PG8_SCHED; PG8_LDA(At, 0, 0); PG8_STAGEA(PG8_SA(1, 1), a1, 1, false);
            PG8_WAIT_V(8); PG8_WAIT_L(0); PG8_BAR; PG8_MMA(0, 0, At, B0); PG8_MMA(0, 1, At, B1); PG8_BAR; PG8_SCHED;
            PG8_LDA(At, 0, 1); PG8_STAGEB(PG8_SB(0, 0), b2); PG8_STAGEB(PG8_SB(0, 1), b2 + hstepB); PG8_STAGEA(PG8_SA(0, 0), a2, 0, last);
            PG8_WAIT_V(8); PG8_WAIT_L(0); PG8_BAR; PG8_MMA(1, 0, At, B0); PG8_MMA(1, 1, At, B1); PG8_BAR; PG8_SCHED;
            PG8_LDB(B0, 1, 0); PG8_LDB(B1, 1, 1); PG8_SCHED; PG8_LDA(At, 1, 0); PG8_STAGEA(PG8_SA(0, 1), a2, 1, last);
            PG8_WAIT_V(8); PG8_WAIT_L(0); PG8_BAR; PG8_MMA(0, 0, At, B0); PG8_MMA(0, 1, At, B1); PG8_BAR; PG8_SCHED;
            PG8_LDA(At, 1, 1); PG8_STAGEB(PG8_SB(1, 0), b3); PG8_STAGEB(PG8_SB(1, 1), b3 + hstepB); PG8_STAGEA(PG8_SA(1, 0), a3, 0, last);
            PG8_WAIT_V(8); PG8_WAIT_L(0); PG8_BAR; PG8_MMA(1, 0, At, B0); PG8_MMA(1, 1, At, B1); PG8_BAR; PG8_SCHED;
            if constexpr (Epi::HAS_MID) { if (t == (nt >> 1) - 2) { int fr3 = fr, fq3 = fq; asm volatile("" : "+v"(fr3), "+v"(fq3)); E.mid(acc, cur, wr, wc, fr3, fq3); } }
        }
        if constexpr (ALIGN_EPI) { if (wr == 0) PG8_BAR; }
        { int fr2 = fr, fq2 = fq; asm volatile("" : "+v"(fr2), "+v"(fq2));
          E(acc, cur, wr, wc, fr2, fq2); }
        if (!has_next) break;
#pragma unroll
        for (int a = 0; a < 2; ++a)
#pragma unroll
            for (int b = 0; b < 2; ++b)
#pragma unroll
                for (int m = 0; m < 4; ++m)
#pragma unroll
                    for (int n = 0; n < 2; ++n) acc[a][b][m][n] = (f32x4){0.f, 0.f, 0.f, 0.f};
        cur = nxt; cA = nA; cB = nB; ++ui;
        if constexpr (GATHER) { gvc[0][0] = gvn[0][0]; gvc[0][1] = gvn[0][1]; gvc[1][0] = gvn[1][0]; gvc[1][1] = gvn[1][1]; }
        if constexpr (ALIGN_EPI) { if (wr == 1) PG8_BAR; }
    }
    PG8_WAIT_V(0);
    if constexpr (!ALIGN_EPI) { if (wr == 0) PG8_BAR; }
    PG8_BAR;
#undef PG8_SA
#undef PG8_SB
#undef PG8_STAGE2
#undef PG8_STAGEA
#undef PG8_STAGEB
#undef PG8_LDA
#undef PG8_LDB
#undef PG8_MMA
#undef PG8_WAIT_V
#undef PG8_WAIT_L
#undef PG8_BAR
#undef PG8_SCHED
#undef PG8_GATHER_OFFS
}

#define EPI_ROW(u, ai, m) ((u).orow + (ai) * HALF + wr * 64 + (m) * 16 + fr)
#define EPI_COL(u, bj) ((u).ocol + (bj) * HALF + wc * 32 + 8 * fq)
struct EpiBf16 {
    static constexpr bool HAS_MID = false;
    bf16_t* O; int ldc; const float* rs; size_t stride; float sc0, sc3;
    unsigned* kn;
    __device__ __forceinline__ void operator()(const f32x4 (&acc)[2][2][4][2], const Unit& u, int wr, int wc, int fr, int fq) const {
        bf16_t* base = O + (size_t)u.aux * stride;
        const float sc = (u.aux == 0) ? sc0 : ((u.aux == 3) ? sc3 : 1.f);
        float nmax[2] = {0.f, 0.f}; const bool dokn = kn && u.aux == 1;
#pragma unroll
        for (int ai = 0; ai < 2; ++ai)
#pragma unroll
            for (int m = 0; m < 4; ++m) { const int row = EPI_ROW(u, ai, m); const float s = (rs ? rs[row] : 1.f) * sc;
#pragma unroll
                for (int bj = 0; bj < 2; ++bj) { const f32x4 v0 = acc[ai][bj][m][0] * s, v1 = acc[ai][bj][m][1] * s;
                    u32x4 w; w.x = cvt_pk_bf16(v0[0], v0[1]); w.y = cvt_pk_bf16(v0[2], v0[3]); w.z = cvt_pk_bf16(v1[0], v1[1]); w.w = cvt_pk_bf16(v1[2], v1[3]);
                    *(u32x4*)(base + (size_t)row * ldc + EPI_COL(u, bj)) = w;
                    if (dokn) { float q = (v0[0] * v0[0] + v0[1] * v0[1]) + (v0[2] * v0[2] + v0[3] * v0[3]) + (v1[0] * v1[0] + v1[1] * v1[1]) + (v1[2] * v1[2] + v1[3] * v1[3]);
                        q += __shfl_xor(q, 16); q += __shfl_xor(q, 32); nmax[bj] = fmaxf(nmax[bj], q); } } }
        if (dokn) {
#pragma unroll
            for (int bj = 0; bj < 2; ++bj) { float q = nmax[bj]; q = fmaxf(q, __shfl_xor(q, 1)); q = fmaxf(q, __shfl_xor(q, 2)); q = fmaxf(q, __shfl_xor(q, 4)); q = fmaxf(q, __shfl_xor(q, 8));
                const int head = ((u.ocol + bj * HALF) >> 6) + (wc >> 1), bt = u.orow / SEQ;
                if ((fr | fq) == 0) atomicMax(kn + ((bt * NH + head) * 2 + (wc & 1)), __float_as_uint(q)); }
        }
    }
};
struct EpiResid {
    static constexpr bool HAS_MID = false;
    const float* res; float* out; bf16_t* hb; float* ssq;
    __device__ __forceinline__ void operator()(const f32x4 (&acc)[2][2][4][2], const Unit& u, int wr, int wc, int fr, int fq) const {
#pragma unroll
        for (int ai = 0; ai < 2; ++ai)
#pragma unroll
            for (int m = 0; m < 4; ++m) { const int row = EPI_ROW(u, ai, m); float q = 0.f;
#pragma unroll
                for (int bj = 0; bj < 2; ++bj) { const size_t off = (size_t)row * DM + EPI_COL(u, bj);
                    const f32x4 r0 = *(const f32x4*)(res + off), r1 = *(const f32x4*)(res + off + 4);
                    const f32x4 v0 = acc[ai][bj][m][0] + r0, v1 = acc[ai][bj][m][1] + r1;
                    *(f32x4*)(out + off) = v0; *(f32x4*)(out + off + 4) = v1;
                    q += (v0[0] * v0[0] + v0[1] * v0[1]) + (v0[2] * v0[2] + v0[3] * v0[3]) + (v1[0] * v1[0] + v1[1] * v1[1]) + (v1[2] * v1[2] + v1[3] * v1[3]);
                    if (hb) { u32x4 w; w.x = cvt_pk_bf16(v0[0], v0[1]); w.y = cvt_pk_bf16(v0[2], v0[3]); w.z = cvt_pk_bf16(v1[0], v1[1]); w.w = cvt_pk_bf16(v1[2], v1[3]); *(u32x4*)(hb + off) = w; } }
                if (ssq) { q += __shfl_xor(q, 16); q += __shfl_xor(q, 32); if (fq == 0) ssq[(size_t)row * 16 + (u.ocol >> 8) * 4 + wc] = q; } }
    }
};
struct EpiOutProj {
    static constexpr bool HAS_MID = true;
    const bf16_t* xb; bf16_t* hb; float* ssq; const float* hs;
    __device__ __forceinline__ void scales(int row, float& ra, float& rb) const {
        const f32x4* p = (const f32x4*)(hs + (size_t)row * 16); const f32x4 a0 = p[0], a1 = p[1], b0 = p[2], b1 = p[3];
        ra = rsqrtf((((a0[0] + a0[1]) + (a0[2] + a0[3])) + ((a1[0] + a1[1]) + (a1[2] + a1[3]))) * (1.0f / HW) + EPS);
        rb = rsqrtf((((b0[0] + b0[1]) + (b0[2] + b0[3])) + ((b1[0] + b1[1]) + (b1[2] + b1[3]))) * (1.0f / HW) + EPS);
    }
    __device__ __forceinline__ void mid(f32x4 (&acc)[2][2][4][2], const Unit& u, int wr, int wc, int fr, int fq) const {
#pragma unroll
        for (int ai = 0; ai < 2; ++ai)
#pragma unroll
            for (int m = 0; m < 4; ++m) { float ra, rb; scales(EPI_ROW(u, ai, m), ra, rb); const float f = ra / rb;
#pragma unroll
                for (int bj = 0; bj < 2; ++bj) { acc[ai][bj][m][0] *= f; acc[ai][bj][m][1] *= f; } }
    }
    __device__ __forceinline__ void operator()(const f32x4 (&acc)[2][2][4][2], const Unit& u, int wr, int wc, int fr, int fq) const {
#pragma unroll
        for (int ai = 0; ai < 2; ++ai)
#pragma unroll
            for (int m = 0; m < 4; ++m) { const int row = EPI_ROW(u, ai, m); float ra, rb; scales(row, ra, rb); float q = 0.f;
#pragma unroll
                for (int bj = 0; bj < 2; ++bj) { const size_t off = (size_t)row * DM + EPI_COL(u, bj);
                    const u32x4 xr = *(const u32x4*)(xb + off);
                    f32x4 v0 = acc[ai][bj][m][0] * rb, v1 = acc[ai][bj][m][1] * rb;
                    v0[0] += bf16lo(xr.x); v0[1] += bf16hi(xr.x); v0[2] += bf16lo(xr.y); v0[3] += bf16hi(xr.y); v1[0] += bf16lo(xr.z); v1[1] += bf16hi(xr.z); v1[2] += bf16lo(xr.w); v1[3] += bf16hi(xr.w);
                    q += (v0[0] * v0[0] + v0[1] * v0[1]) + (v0[2] * v0[2] + v0[3] * v0[3]) + (v1[0] * v1[0] + v1[1] * v1[1]) + (v1[2] * v1[2] + v1[3] * v1[3]);
                    u32x4 w; w.x = cvt_pk_bf16(v0[0], v0[1]); w.y = cvt_pk_bf16(v0[2], v0[3]); w.z = cvt_pk_bf16(v1[0], v1[1]); w.w = cvt_pk_bf16(v1[2], v1[3]); *(u32x4*)(hb + off) = w; }
                q += __shfl_xor(q, 16); q += __shfl_xor(q, 32); if (fq == 0) ssq[(size_t)row * 16 + (u.ocol >> 8) * 4 + wc] = q; }
    }
};
struct EpiResidBf16 {
    static constexpr bool HAS_MID = false;
    bf16_t* hb;
    __device__ __forceinline__ void operator()(const f32x4 (&acc)[2][2][4][2], const Unit& u, int wr, int wc, int fr, int fq) const {
#pragma unroll
        for (int ai = 0; ai < 2; ++ai)
#pragma unroll
            for (int m = 0; m < 4; ++m) { const int row = EPI_ROW(u, ai, m);
#pragma unroll
                for (int bj = 0; bj < 2; ++bj) { const size_t off = (size_t)row * DM + EPI_COL(u, bj);
                    const u32x4 xr = *(const u32x4*)(hb + off);
                    f32x4 v0 = acc[ai][bj][m][0], v1 = acc[ai][bj][m][1];
                    v0[0] += bf16lo(xr.x); v0[1] += bf16hi(xr.x); v0[2] += bf16lo(xr.y); v0[3] += bf16hi(xr.y); v1[0] += bf16lo(xr.z); v1[1] += bf16hi(xr.z); v1[2] += bf16lo(xr.w); v1[3] += bf16hi(xr.w);
                    u32x4 w; w.x = cvt_pk_bf16(v0[0], v0[1]); w.y = cvt_pk_bf16(v0[2], v0[3]); w.z = cvt_pk_bf16(v1[0], v1[1]); w.w = cvt_pk_bf16(v1[2], v1[3]); *(u32x4*)(hb + off) = w; } }
    }
};
struct EpiSoftmax {
    static constexpr bool HAS_MID = false;
    bf16_t* P; const float* ssq; LAS float* red;
    __device__ __forceinline__ void operator()(f32x4 (&acc)[2][2][4][2], const Unit& u, int wr, int wc, int fr, int fq) const {
#pragma unroll
        for (int ai = 0; ai < 2; ++ai)
#pragma unroll
            for (int m = 0; m < 4; ++m) { const int row = EPI_ROW(u, ai, m); const f32x4* sp = (const f32x4*)(ssq + (size_t)row * 16);
                const f32x4 s0 = sp[0], s1 = sp[1], s2 = sp[2], s3 = sp[3];
                const float tot = ((s0[0] + s0[1]) + (s0[2] + s0[3])) + ((s1[0] + s1[1]) + (s1[2] + s1[3])) + ((s2[0] + s2[1]) + (s2[2] + s2[3])) + ((s3[0] + s3[1]) + (s3[2] + s3[3]));
                const float r1 = rsqrtf(tot * (1.0f / DM) + EPS) * XSC; float a = -3.0e38f;
#pragma unroll
                for (int bj = 0; bj < 2; ++bj)
#pragma unroll
                    for (int n = 0; n < 2; ++n) { f32x4 v = acc[ai][bj][m][n] * r1; acc[ai][bj][m][n] = v; a = fmaxf(a, fmaxf(fmaxf(v[0], v[1]), fmaxf(v[2], v[3]))); }
                a = fmaxf(a, __shfl_xor(a, 16)); a = fmaxf(a, __shfl_xor(a, 32));
                if (fq == 0) red[(ai * HALF + wr * 64 + m * 16 + fr) * 4 + wc] = a; asm volatile("" ::: "memory"); }
        LDS_WAIT(); __builtin_amdgcn_s_barrier(); asm volatile("" ::: "memory");
#pragma unroll
        for (int ai = 0; ai < 2; ++ai)
#pragma unroll
            for (int m = 0; m < 4; ++m) { const int rl = ai * HALF + wr * 64 + m * 16 + fr; const f32x4 mm = *(const LAS f32x4*)(red + rl * 4);
                const float a = fmaxf(fmaxf(mm[0], mm[1]), fmaxf(mm[2], mm[3])); float s = 0.f;
#pragma unroll
                for (int bj = 0; bj < 2; ++bj)
#pragma unroll
                    for (int n = 0; n < 2; ++n) { f32x4 v = acc[ai][bj][m][n];
                        v[0] = __builtin_amdgcn_exp2f(v[0] - a); v[1] = __builtin_amdgcn_exp2f(v[1] - a); v[2] = __builtin_amdgcn_exp2f(v[2] - a); v[3] = __builtin_amdgcn_exp2f(v[3] - a);
                        acc[ai][bj][m][n] = v; s += (v[0] + v[1]) + (v[2] + v[3]); }
                s += __shfl_xor(s, 16); s += __shfl_xor(s, 32);
                if (fq == 0) red[1024 + rl * 4 + wc] = s; }
        LDS_WAIT(); __builtin_amdgcn_s_barrier(); asm volatile("" ::: "memory");
#pragma unroll
        for (int ai = 0; ai < 2; ++ai)
#pragma unroll
            for (int m = 0; m < 4; ++m) { const int rl = ai * HALF + wr * 64 + m * 16 + fr; const int row = u.orow + rl; const f32x4 ss = *(const LAS f32x4*)(red + 1024 + rl * 4);
                const float inv = 1.0f / ((ss[0] + ss[1]) + (ss[2] + ss[3]));
#pragma unroll
                for (int bj = 0; bj < 2; ++bj) { const f32x4 v0 = acc[ai][bj][m][0] * inv, v1 = acc[ai][bj][m][1] * inv;
                    u32x4 w; w.x = cvt_pk_bf16(v0[0], v0[1]); w.y = cvt_pk_bf16(v0[2], v0[3]); w.z = cvt_pk_bf16(v1[0], v1[1]); w.w = cvt_pk_bf16(v1[2], v1[3]);
                    *(u32x4*)(P + (size_t)row * DM + EPI_COL(u, bj)) = w; } }
    }
};
struct EpiSwiglu {
    static constexpr bool HAS_MID = false;
    bf16_t* Hd; const float* r2;
    __device__ __forceinline__ void operator()(const f32x4 (&acc)[2][2][4][2], const Unit& u, int wr, int wc, int fr, int fq) const {
#pragma unroll
        for (int ai = 0; ai < 2; ++ai)
#pragma unroll
            for (int m = 0; m < 4; ++m) { const int rl = ai * HALF + wr * 64 + m * 16 + fr, row = u.orow + rl; const float rs = r2[u.rows[rl < u.nvalid ? rl : 0]]; float h[8];
#pragma unroll
                for (int n = 0; n < 2; ++n)
#pragma unroll
                    for (int e = 0; e < 4; ++e) { const float gt = acc[ai][0][m][n][e] * rs, up = acc[ai][1][m][n][e] * rs;
                        h[n * 4 + e] = gt * __builtin_amdgcn_rcpf(1.0f + __builtin_amdgcn_exp2f(-gt * LOG2E)) * up; }
                u32x4 w; w.x = cvt_pk_bf16(h[0], h[1]); w.y = cvt_pk_bf16(h[2], h[3]); w.z = cvt_pk_bf16(h[4], h[5]); w.w = cvt_pk_bf16(h[6], h[7]);
                *(u32x4*)(Hd + (size_t)row * DFF + u.ocol + wc * 32 + 8 * fq) = w; }
    }
};
}

namespace att {
constexpr int QB = 256, KVBLK = 64, PITCH = HW, OPITCH = DM;
constexpr int SLOTB = 8192, LDS_K = 0, LDS_V = 2 * SLOTB, LDS_WS = 4 * SLOTB, LDS_OST = LDS_WS + NWAVES * 256, LDS_FLAG = LDS_OST + NWAVES * 4096, LDS_END = LDS_FLAG + 64;
static_assert(LDS_END <= RING_BYTES, "attention LDS");
__device__ __forceinline__ int crow(int r, int hi) { return (r & 3) + 8 * (r >> 2) + 4 * hi; }
__device__ __forceinline__ void glds16(const void* gsrc, unsigned lds_dst) { unsigned keep;
    asm volatile("s_mov_b32 %0, m0\n\ts_mov_b32 m0, %2\n\ts_nop 0\n\tglobal_load_lds_dwordx4 %1, off\n\ts_mov_b32 m0, %0" : "=&s"(keep) : "v"(gsrc), "s"(lds_dst) : "memory"); }
__device__ __forceinline__ void glds16s(const void* sbase, unsigned voff, unsigned lds_dst) { unsigned keep;
    asm volatile("s_mov_b32 %0, m0\n\ts_mov_b32 m0, %3\n\ts_nop 0\n\tglobal_load_lds_dwordx4 %1, %2\n\ts_mov_b32 m0, %0" : "=&s"(keep) : "v"(voff), "s"(sbase), "s"(lds_dst) : "memory"); }
#define ATT_WAIT_BAR0() asm volatile("s_waitcnt vmcnt(0) lgkmcnt(0)\n\ts_barrier" ::: "memory")
#define MFMA32(a, b, c) __builtin_amdgcn_mfma_f32_32x32x16_bf16(a, b, c, 0, 0, 0)
__device__ __forceinline__ void store_row_ssq(u32x4 v, float* dst, int ch) {
    float q = (bf16lo(v.x) * bf16lo(v.x) + bf16hi(v.x) * bf16hi(v.x)) + (bf16lo(v.y) * bf16lo(v.y) + bf16hi(v.y) * bf16hi(v.y)) + (bf16lo(v.z) * bf16lo(v.z) + bf16hi(v.z) * bf16hi(v.z)) + (bf16lo(v.w) * bf16lo(v.w) + bf16hi(v.w) * bf16hi(v.w));
    q += __shfl_xor(q, 1); q += __shfl_xor(q, 2); q += __shfl_xor(q, 4);
    if (ch == 0) *dst = q;
}
__device__ __forceinline__ void qkt(f32x16& p0, f32x16& p1, const LAS char* Kslot, const bf16x8* qr, const f32x16& cin, int r32, int hi) {
    const LAS char* kb = Kslot + hi * 1024 + r32 * 16;
#pragma unroll
    for (int d0 = 0; d0 < 4; ++d0) {
        const bf16x8 b0 = *(const LAS bf16x8*)(kb + d0 * 2048);
        const bf16x8 b1 = *(const LAS bf16x8*)(kb + d0 * 2048 + 512);
        if (d0 == 0) { p0 = MFMA32(b0, qr[0], cin); p1 = MFMA32(b1, qr[0], cin); }
        else { p0 = MFMA32(b0, qr[d0], p0); p1 = MFMA32(b1, qr[d0], p1); } }
}
__device__ __forceinline__ void pv(f32x16* o, int vb, bf16x8 pa0, bf16x8 pa1, bf16x8 pa2, bf16x8 pa3) {
#pragma unroll
    for (int d0 = 0; d0 < 2; ++d0) { s16x4 lo[4], hi[4];
#pragma unroll
        for (int ks = 0; ks < 4; ++ks) {
            asm volatile("ds_read_b64_tr_b16 %0,%1 offset:%c2" : "=&v"(lo[ks]) : "v"(vb), "i"(d0 * 4096 + ks * 1024) : "memory");
            asm volatile("ds_read_b64_tr_b16 %0,%1 offset:%c2" : "=&v"(hi[ks]) : "v"(vb), "i"(d0 * 4096 + ks * 1024 + 512) : "memory"); }
        asm volatile("s_waitcnt lgkmcnt(0)" ::: "memory"); __builtin_amdgcn_sched_barrier(0);
#define PK(k) (bf16x8){lo[k][0], lo[k][1], lo[k][2], lo[k][3], hi[k][0], hi[k][1], hi[k][2], hi[k][3]}
        o[d0] = MFMA32(pa0, PK(0), o[d0]); o[d0] = MFMA32(pa1, PK(1), o[d0]); o[d0] = MFMA32(pa2, PK(2), o[d0]); o[d0] = MFMA32(pa3, PK(3), o[d0]);
#undef PK
    }
}
__device__ __forceinline__ float swap_lo(float x) { auto rr = __builtin_amdgcn_permlane32_swap(__float_as_uint(x), __float_as_uint(x), false, false); return __uint_as_float(rr[0]); }
__device__ __forceinline__ float swap_hi(float x) { auto rr = __builtin_amdgcn_permlane32_swap(__float_as_uint(x), __float_as_uint(x), false, false); return __uint_as_float(rr[1]); }

template <int MODE> __device__ __forceinline__ void attn_unit(int b, int h, int qb, const bf16_t* Q, const bf16_t* K, const bf16_t* V, bf16_t* O, float* hs, const float* cb, LAS char* shm) {
    int tid = threadIdx.x; asm volatile("" : "+v"(tid)); const int lane = tid & 63, r32 = lane & 31, hi = lane >> 5; const int wid = __builtin_amdgcn_readfirstlane(tid >> 6);
    const long rowbase = (long)b * SEQ; const int q0 = qb * QB;
    const bf16_t* Qw = Q + (rowbase + q0 + wid * 32) * PITCH + h * HD;
    const bf16_t* Kh = K + rowbase * PITCH + h * HD; const bf16_t* Vh = V + rowbase * PITCH + h * HD;
    const unsigned lds0 = (unsigned)(uintptr_t)shm;
    LAS float* wsf = (LAS float*)(shm + LDS_WS) + wid * 64;
    LAS unsigned* flags = (LAS unsigned*)(shm + LDS_FLAG);
    const bf16_t* ksrc = Kh + (long)lane * PITCH + wid * 8;
    const bf16_t* vsrc = Vh + (long)(16 * (wid & 3) + (lane >> 2)) * PITCH + (wid >> 2) * 32 + (lane & 3) * 8;
    const unsigned kdst = lds0 + LDS_K + wid * 1024, vdst = lds0 + LDS_V + wid * 1024;
#define DMA_KV(t, slot) do { glds16(ksrc + (long)(t) * KVBLK * PITCH, (unsigned)__builtin_amdgcn_readfirstlane(kdst + (slot))); glds16(vsrc + (long)(t) * KVBLK * PITCH, (unsigned)__builtin_amdgcn_readfirstlane(vdst + (slot))); } while (0)
    const int vb0 = (int)(lds0 + LDS_V) + ((lane >> 4) & 1) * 32 + (lane & 3) * 8 + (4 * hi + ((lane & 15) >> 2)) * 64;
    const int NT = (q0 + QB) / KVBLK;
    DMA_KV(NT - 1, 0);
    bf16x8 qr[4];
#pragma unroll
    for (int d0 = 0; d0 < 4; ++d0) qr[d0] = *(const bf16x8*)(Qw + (long)r32 * PITCH + d0 * 16 + hi * 8);
    f32x16 o[2]; o[0] = f32x16{}; o[1] = f32x16{};
    const int qrel = wid * 32 + r32;
    float m_run = -1.0e30f, l_run = 0.f, R = 0.f, ct = 0.f;
    if (MODE == 0) ct = cb[q0 + qrel];
    bf16x8 TD0, TD1, TONE;
#pragma unroll
    for (int j = 0; j < 8; ++j) { const int kvl = 8 * (j >> 2) + 4 * hi + (j & 3); TD0[j] = (kvl >= r32) ? (short)0x3F80 : (short)0; TD1[j] = (16 + kvl >= r32) ? (short)0x3F80 : (short)0; TONE[j] = (short)0x3F80; }
    f32x16 zero16 = f32x16{};
    for (int i = 0; i < NT; ++i) {
        const int t = NT - 1 - i, slot = (i & 1) * SLOTB;
        ATT_WAIT_BAR0();
        if (MODE == 1 && i > 0) {
            const LAS unsigned* fl = flags + ((i - 1) & 1) * 8; unsigned all = 1u;
#pragma unroll
            for (int w = 0; w < 8; ++w) all &= fl[w];
            if (__builtin_amdgcn_readfirstlane(all)) break;
        }
        if (t > 0) DMA_KV(t - 1, slot ^ SLOTB);
        const int jb = t - (NT - 4);
        const bool active = !(jb >= 0 && 2 * jb > wid);
        bool wave_done = false;
        if (MODE == 1) wave_done = __all(R < SB_EXIT);
        if (active && !(MODE == 1 && wave_done)) {
            f32x16 p0, p1;
            qkt(p0, p1, shm + LDS_K + slot, qr, zero16, r32, hi);
            if (MODE == 0) {
                const float* cbt = cb + t * KVBLK + 4 * hi;
#pragma unroll
                for (int g = 0; g < 4; ++g) { const f32x4 c0 = *(const f32x4*)(cbt + 8 * g), c1 = *(const f32x4*)(cbt + 32 + 8 * g);
#pragma unroll
                    for (int e = 0; e < 4; ++e) { p0[4 * g + e] += ct - c0[e]; p1[4 * g + e] += ct - c1[e]; } }
                if (jb >= 0) {
#pragma unroll
                    for (int r = 0; r < 16; ++r) { const int kv = 64 * jb + crow(r, hi); if (kv > qrel) p0[r] = -1.0e30f; if (kv + 32 > qrel) p1[r] = -1.0e30f; } }
                float a = fmaxf(p0[0], p1[0]);
#pragma unroll
                for (int r = 1; r < 16; ++r) a = fmaxf(a, fmaxf(p0[r], p1[r]));
                a = fmaxf(swap_lo(a), swap_hi(a));
                const float m_new = fmaxf(m_run, a), alpha = __builtin_amdgcn_exp2f(m_run - m_new); m_run = m_new;
                float s = 0.f;
#pragma unroll
                for (int r = 0; r < 16; ++r) { p0[r] = __builtin_amdgcn_exp2f(p0[r] - m_new); p1[r] = __builtin_amdgcn_exp2f(p1[r] - m_new); s += p0[r] + p1[r]; }
                l_run = l_run * alpha + s;
                if (hi == 0) wsf[r32] = alpha;
                LDS_WAIT();
#pragma unroll
                for (int r = 0; r < 16; ++r) { const float f = wsf[crow(r, hi)]; o[0][r] *= f; o[1][r] *= f; }
                LDS_WAIT();
            } else {
                if (jb >= 0) {
#pragma unroll
                    for (int r = 0; r < 16; ++r) { const int kv = 64 * jb + crow(r, hi); if (kv >= qrel) p0[r] = -1.0e30f; if (kv + 32 >= qrel) p1[r] = -1.0e30f; } }
                f32x16 l0, l1;
#pragma unroll
                for (int r = 0; r < 16; ++r) {
                    l0[r] = -(fmaxf(p0[r], 0.f) + __builtin_amdgcn_logf(1.0f + __builtin_amdgcn_exp2f(-fabsf(p0[r]))));
                    l1[r] = -(fmaxf(p1[r], 0.f) + __builtin_amdgcn_logf(1.0f + __builtin_amdgcn_exp2f(-fabsf(p1[r])))); }
                u32x4 lw0 = {cvt_pk_bf16(l0[0], l0[1]), cvt_pk_bf16(l0[2], l0[3]), cvt_pk_bf16(l0[4], l0[5]), cvt_pk_bf16(l0[6], l0[7])};
                u32x4 lw1 = {cvt_pk_bf16(l0[8], l0[9]), cvt_pk_bf16(l0[10], l0[11]), cvt_pk_bf16(l0[12], l0[13]), cvt_pk_bf16(l0[14], l0[15])};
                u32x4 lw2 = {cvt_pk_bf16(l1[0], l1[1]), cvt_pk_bf16(l1[2], l1[3]), cvt_pk_bf16(l1[4], l1[5]), cvt_pk_bf16(l1[6], l1[7])};
                u32x4 lw3 = {cvt_pk_bf16(l1[8], l1[9]), cvt_pk_bf16(l1[10], l1[11]), cvt_pk_bf16(l1[12], l1[13]), cvt_pk_bf16(l1[14], l1[15])};
                f32x16 rt;
#pragma unroll
                for (int r = 0; r < 16; ++r) rt[r] = R;
                f32x16 t0 = MFMA32(TD0, __builtin_bit_cast(bf16x8, lw0), rt); t0 = MFMA32(TD1, __builtin_bit_cast(bf16x8, lw1), t0);
                t0 = MFMA32(TONE, __builtin_bit_cast(bf16x8, lw2), t0); t0 = MFMA32(TONE, __builtin_bit_cast(bf16x8, lw3), t0);
                f32x16 t1 = MFMA32(TD0, __builtin_bit_cast(bf16x8, lw2), rt); t1 = MFMA32(TD1, __builtin_bit_cast(bf16x8, lw3), t1);
#pragma unroll
                for (int r = 0; r < 16; ++r) { p0[r] = __builtin_amdgcn_exp2f(p0[r] + t0[r]); p1[r] = __builtin_amdgcn_exp2f(p1[r] + t1[r]); }
                R = swap_lo(t0[0]);
            }
            u32x4 pw0 = {cvt_pk_bf16(p0[0], p0[1]), cvt_pk_bf16(p0[2], p0[3]), cvt_pk_bf16(p0[4], p0[5]), cvt_pk_bf16(p0[6], p0[7])};
            u32x4 pw1 = {cvt_pk_bf16(p0[8], p0[9]), cvt_pk_bf16(p0[10], p0[11]), cvt_pk_bf16(p0[12], p0[13]), cvt_pk_bf16(p0[14], p0[15])};
            u32x4 pw2 = {cvt_pk_bf16(p1[0], p1[1]), cvt_pk_bf16(p1[2], p1[3]), cvt_pk_bf16(p1[4], p1[5]), cvt_pk_bf16(p1[6], p1[7])};
            u32x4 pw3 = {cvt_pk_bf16(p1[8], p1[9]), cvt_pk_bf16(p1[10], p1[11]), cvt_pk_bf16(p1[12], p1[13]), cvt_pk_bf16(p1[14], p1[15])};
            pv(o, vb0 + slot, __builtin_bit_cast(bf16x8, pw0), __builtin_bit_cast(bf16x8, pw1), __builtin_bit_cast(bf16x8, pw2), __builtin_bit_cast(bf16x8, pw3));
        }
        if (MODE == 1) { const bool dn = __all(R < SB_EXIT); if (lane == 0) flags[(i & 1) * 8 + wid] = dn ? 1u : 0u; }
    }
    float linv = 1.f;
    if (MODE == 0) { const float lt = swap_lo(l_run) + swap_hi(l_run); linv = 1.0f / lt; }
    if (hi == 0) wsf[32 + r32] = linv;
    LDS_WAIT();
    bf16_t* Ow = O + (rowbase + q0 + wid * 32) * OPITCH + h * HD;
    { LAS bf16_t* stg = (LAS bf16_t*)(shm + LDS_OST) + wid * 2048;
#pragma unroll
      for (int r = 0; r < 16; ++r) { const int orow = crow(r, hi); const float f = wsf[32 + orow];
#pragma unroll
        for (int d0 = 0; d0 < 2; ++d0) { const unsigned pk = cvt_pk_bf16(o[d0][r] * f, 0.f); stg[orow * 64 + d0 * 32 + r32] = (bf16_t)(pk & 0xffffu); } }
      LDS_WAIT();
#pragma unroll
      for (int i = 0; i < 4; ++i) { const int row = i * 8 + (lane >> 3), ch = lane & 7; const u32x4 v = *(const LAS u32x4*)(stg + row * 64 + ch * 8); *(u32x4*)(Ow + (long)row * OPITCH + ch * 8) = v;
        store_row_ssq(v, hs + (rowbase + q0 + wid * 32 + row) * 16, ch); } }
    asm volatile("s_waitcnt vmcnt(0) lgkmcnt(0)\n\ts_barrier" ::: "memory");
#undef DMA_KV
}
}


namespace fox {
constexpr int QB = 256, KVBLK = 64, PITCH = HW, OPITCH = DM;
constexpr int NSLOT = 3, SLOTB = 9216;
constexpr int LDS_K = 0, LDS_V = NSLOT * SLOTB, LDS_WS = 2 * NSLOT * SLOTB, LDS_OST = LDS_WS + NWAVES * 256, LDS_CL = LDS_OST + NWAVES * 4096, LDS_VOTE = LDS_CL + 512, LDS_END = LDS_VOTE + 32;
static_assert(LDS_END <= RING_BYTES, "fox LDS");
constexpr float WIN_T = 48.0f;
constexpr float FLOOR = -256.0f;
using att::crow; using att::glds16; using att::glds16s;
typedef __attribute__((address_space(3))) const char* lds_cptr;
typedef short v4i16_t __attribute__((ext_vector_type(4)));
#define SBAR() __builtin_amdgcn_sched_barrier(0)
#define WAIT_BAR(N) asm volatile("s_waitcnt vmcnt(" #N ") lgkmcnt(0)\n\ts_barrier" ::: "memory")
__device__ __forceinline__ s16x4 vtr(lds_cptr p) { return __builtin_bit_cast(s16x4, __builtin_amdgcn_ds_read_tr16_b64_v4i16((__attribute__((address_space(3))) v4i16_t*)p)); }
__device__ __forceinline__ void kload2(bf16x8* kf, lds_cptr kp, int j) { kf[2 * j] = *(const LAS bf16x8*)(kp + j * 2048); kf[2 * j + 1] = *(const LAS bf16x8*)(kp + j * 2048 + 512); }
__device__ __forceinline__ void cmask(f32x16& p0, f32x16& p1, int jb, int qrel, int hi) {
    const float NEG = -INFINITY; const int kb = 64 * jb + 4 * hi;
#pragma unroll
    for (int r = 0; r < 16; ++r) { const int kv = kb + (r & 3) + 8 * (r >> 2); if (kv > qrel) p0[r] = NEG; if (kv + 32 > qrel) p1[r] = NEG; }
}
__device__ __forceinline__ void split3(float x, unsigned& hm, unsigned& lo) {
    const unsigned h = cvt_pk_bf16(x, 0.f) & 0xffffu; const float r1 = x - __uint_as_float(h << 16);
    const unsigned m = cvt_pk_bf16(r1, 0.f) & 0xffffu; const float r2 = r1 - __uint_as_float(m << 16);
    hm = h | (m << 16); lo = cvt_pk_bf16(r2, 0.f) & 0xffffu;
}
__device__ __forceinline__ bf16x8 qx_build(float a, int hi) {
    unsigned hm, lo; split3(a, hm, lo);
    u32x4 w; w.x = hm; w.y = lo | 0x3F800000u; w.z = 0x3F803F80u; w.w = 0u;
    if (hi) { w.x = 0u; w.y = 0u; w.z = 0u; }
    return __builtin_bit_cast(bf16x8, w);
}

template <int THRL> __device__ __forceinline__ void fox_unit(int bh, int qb, const bf16_t* Q, const bf16_t* K, const bf16_t* V, bf16_t* O, float* hs, const float* cb, const bf16_t* KXh, float kmax, LAS char* shm) {
    int tid = threadIdx.x; asm volatile("" : "+v"(tid)); const int lane = tid & 63, r32 = lane & 31, hi = lane >> 5; const int wid = __builtin_amdgcn_readfirstlane(tid >> 6);
    const int b = bh >> 3, h = bh & 7; const long rowbase = (long)b * SEQ; const int q0 = qb * QB;
    const bf16_t* Qw = Q + (rowbase + q0 + wid * 32) * PITCH + h * HD;
    const bf16_t* Kh = K + rowbase * PITCH + h * HD; const bf16_t* Vh = V + rowbase * PITCH + h * HD;
    const unsigned lds0 = (unsigned)(uintptr_t)shm;
    LAS float* wsf = (LAS float*)(shm + LDS_WS) + wid * 64;
    const int NT = (q0 + QB) / KVBLK;
    int NTe = NT;
    LAS float* clt = (LAS float*)(shm + LDS_CL); LAS unsigned* votes = (LAS unsigned*)(shm + LDS_VOTE);
    const float clv = (tid < NT) ? cb[64 * tid + 63] : 0.f;
    const unsigned koff = (unsigned)(lane * PITCH + wid * 8) * 2u, voff = (unsigned)((16 * (wid & 3) + (lane >> 2)) * PITCH + (wid >> 2) * 32 + (lane & 3) * 8) * 2u, xoff = (unsigned)lane * 16u;
    const unsigned kdst = lds0 + LDS_K + wid * 1024, vdst = lds0 + LDS_V + wid * 1024, xdst = lds0 + LDS_K + 8192;
    const bool xl = (lane >> 3) == wid;
#define DMA_K(p, slot) do { glds16s(Kh + (long)(NT - 1 - (p)) * KVBLK * PITCH, koff, (unsigned)__builtin_amdgcn_readfirstlane(kdst + (slot))); \
        if (xl) glds16s(KXh + (long)(NT - 1 - (p)) * KVBLK * 8, xoff, (unsigned)__builtin_amdgcn_readfirstlane(xdst + (slot))); } while (0)
#define DMA_V(p, slot) glds16s(Vh + (long)(NT - 1 - (p)) * KVBLK * PITCH, voff, (unsigned)__builtin_amdgcn_readfirstlane(vdst + (slot)))
    bf16x8 kf[10];
    const lds_cptr shm3 = (lds_cptr)shm; const lds_cptr kp0 = shm3 + LDS_K + hi * 1024 + r32 * 16; const lds_cptr kx0 = shm3 + LDS_K + 8192 + r32 * 16;
    const lds_cptr vp0 = shm3 + LDS_V + ((lane >> 4) & 1) * 32 + (lane & 3) * 8 + (4 * hi + ((lane & 15) >> 2)) * 64;
    DMA_K(0, 0); DMA_V(0, 0); DMA_K(1, SLOTB);
    bf16x8 qr[4];
#pragma unroll
    for (int d0 = 0; d0 < 4; ++d0) qr[d0] = *(const bf16x8*)(Qw + (long)r32 * PITCH + d0 * 16 + hi * 8);
    const int qrel = wid * 32 + r32;
    const float ct = cb[q0 + qrel];
    float mhat = 0.f, l_reg = 0.f; f32x16 o[2]; o[0] = f32x16{}; o[1] = f32x16{};
    bf16x8 qx = qx_build(ct, hi);
    const f32x16 z16 = f32x16{};
#define CMASK(P0, P1, p) do { const int jb_ = 3 - (p); if (jb_ >= 0) cmask(P0, P1, jb_, qrel, hi); } while (0)
    bool resc = false;
#define RESC() do { if (resc) { asm volatile("s_waitcnt lgkmcnt(0)" ::: "memory"); \
      _Pragma("unroll") for (int d_ = 0; d_ < 2; ++d_) _Pragma("unroll") for (int r = 0; r < 16; ++r) o[d_][r] *= wsf[crow(r, hi)]; } } while (0)
    f32x16 pA0, pA1, pB0, pB1;
    int sl_prev = 0, sl_cur = 0, sl_next = SLOTB;
#define ROT() do { sl_prev = sl_cur; sl_cur = sl_next; sl_next = (sl_next == (NSLOT - 1) * SLOTB) ? 0 : sl_next + SLOTB; } while (0)
    DMA_K(2, 2 * SLOTB);
    WAIT_BAR(5);
    if (tid < NT) clt[tid] = clv;
    float qkb;
    { float q2 = 0.f;
#pragma unroll
      for (int d0 = 0; d0 < 4; ++d0)
#pragma unroll
          for (int j = 0; j < 8; ++j) { const float e = __uint_as_float(((unsigned)(unsigned short)qr[d0][j]) << 16); q2 += e * e; }
      q2 = att::swap_lo(q2) + att::swap_hi(q2); qkb = sqrtf(q2) * kmax + ct + WIN_T; }
    { const LAS char* kb = (const LAS char*)shm + LDS_K + hi * 1024 + r32 * 16; const LAS char* kxb = (const LAS char*)shm + LDS_K + 8192 + r32 * 16;
      pA0 = MFMA32(*(const LAS bf16x8*)(kxb), qx, z16); pA1 = MFMA32(*(const LAS bf16x8*)(kxb + 512), qx, z16);
#pragma unroll
      for (int d0 = 0; d0 < 4; ++d0) { pA0 = MFMA32(*(const LAS bf16x8*)(kb + d0 * 2048), qr[d0], pA0); pA1 = MFMA32(*(const LAS bf16x8*)(kb + d0 * 2048 + 512), qr[d0], pA1); } }
    asm volatile("s_nop 15\n\ts_nop 7" : "+v"(pA0), "+v"(pA1)); CMASK(pA0, pA1, 0);
    { float a = fmaxf(pA0[0], pA1[0]);
#pragma unroll
      for (int r = 1; r < 16; ++r) a = fmaxf(a, fmaxf(pA0[r], pA1[r]));
      a = fmaxf(att::swap_lo(a), att::swap_hi(a));
      const float dl = fmaxf(a, FLOOR); mhat = dl;
#pragma unroll
      for (int r = 0; r < 16; ++r) { pA0[r] = __builtin_amdgcn_exp2f(pA0[r] - dl); pA1[r] = __builtin_amdgcn_exp2f(pA1[r] - dl); }
      qx = qx_build(ct - mhat, hi); asm volatile("" : "+v"(qx)); }
    WAIT_BAR(0);
    DMA_K(3, 0); DMA_V(1, SLOTB);
    ROT();
    kload2(kf, kp0 + sl_cur, 0); kload2(kf, kp0 + sl_cur, 1); kload2(kf, kp0 + sl_cur, 2); kload2(kf, kp0 + sl_cur, 3);
    kf[8] = *(const LAS bf16x8*)(kx0 + sl_cur); kf[9] = *(const LAS bf16x8*)(kx0 + sl_cur + 512);
    WAIT_BAR(3);
    s16x4 vlo[8], vhi[8]; u32x4 pw0, pw1, pw2, pw3;
#define PKW(P, B) cvt_pk_bf16(P[B], P[B + 1])
#define PAF(k) __builtin_bit_cast(bf16x8, pw##k)
#define VFR(i) (bf16x8){vlo[i][0], vlo[i][1], vlo[i][2], vlo[i][3], vhi[i][0], vhi[i][1], vhi[i][2], vhi[i][3]}
#define PIN(x) asm volatile("" : "+v"(x))
#define MX3(a, b, c) __builtin_fmaxf(__builtin_fmaxf((a), (b)), (c))
#define GAPA(MF, A0, A1, A2, A3, W0, W1, PW) do { MF; sacc += A0; sacc += A1; sacc += A2; sacc += A3; PIN(sacc); W0; W1; PIN(PW); SBAR(); } while (0)
#define EX(v) __builtin_amdgcn_exp2f(v)
#define GAPB(MF, X, B) do { MF; X[B] = EX(X[B]); X[B + 1] = EX(X[B + 1]); X[B + 2] = EX(X[B + 2]); X[B + 3] = EX(X[B + 3]); PIN(X); SBAR(); } while (0)
#define VRD(i) do { vlo[i] = vtr(vp_ + (((i) >> 2) * 4096 + ((i) & 3) * 1024)); vhi[i] = vtr(vp_ + (((i) >> 2) * 4096 + ((i) & 3) * 1024 + 512)); } while (0)
#define KRD(G, j) do { if (G) { kload2(kf, kp0 + sl_next, j); SBAR(); } } while (0)
#define KRDX(G) do { if (G) { kf[8] = *(const LAS bf16x8*)(kx0 + sl_next); kf[9] = *(const LAS bf16x8*)(kx0 + sl_next + 512); SBAR(); } } while (0)
#define STEP(C0, C1, P0, P1, t, GK, GV, GL) do { SBAR(); \
    const lds_cptr vp_ = vp0 + sl_prev; \
    C0 = MFMA32(kf[8], qx, z16); C1 = MFMA32(kf[9], qx, z16); SBAR(); \
    VRD(0); SBAR(); float sacc = (P0[0] + P0[1]); \
    GAPA(C0 = MFMA32(kf[0], qr[0], C0), P0[2], P0[3], P0[4], P0[5],     pw0[0] = PKW(P0, 0), pw0[1] = PKW(P0, 2), pw0); \
    VRD(4); SBAR(); GAPA(C1 = MFMA32(kf[1], qr[0], C1), P0[6], P0[7], P0[8], P0[9],     pw0[2] = PKW(P0, 4), pw0[3] = PKW(P0, 6), pw0); \
    VRD(1); SBAR(); GAPA(C0 = MFMA32(kf[2], qr[1], C0),   P0[10], P0[11], P0[12], P0[13], pw1[0] = PKW(P0, 8), pw1[1] = PKW(P0, 10), pw1); \
    VRD(5); SBAR(); GAPA(C1 = MFMA32(kf[3], qr[1], C1),   P0[14], P0[15], P1[0], P1[1],   pw1[2] = PKW(P0, 12), pw1[3] = PKW(P0, 14), pw1); \
    VRD(2); SBAR(); GAPA(C0 = MFMA32(kf[4], qr[2], C0),   P1[2], P1[3], P1[4], P1[5],     pw2[0] = PKW(P1, 0), pw2[1] = PKW(P1, 2), pw2); \
    VRD(6); SBAR(); GAPA(C1 = MFMA32(kf[5], qr[2], C1),   P1[6], P1[7], P1[8], P1[9],     pw2[2] = PKW(P1, 4), pw2[3] = PKW(P1, 6), pw2); \
    VRD(3); SBAR(); GAPA(C0 = MFMA32(kf[6], qr[3], C0),   P1[10], P1[11], P1[12], P1[13], pw3[0] = PKW(P1, 8), pw3[1] = PKW(P1, 10), pw3); \
    VRD(7); SBAR(); GAPA(C1 = MFMA32(kf[7], qr[3], C1),   P1[14], P1[15], 0.f, 0.f,       pw3[2] = PKW(P1, 12), pw3[3] = PKW(P1, 14), pw3); \
    l_reg += sacc; \
    if (GK) { DMA_K((t) + 3, sl_cur); } if (GV) { DMA_V((t) + 1, sl_next); } \
    CMASK(C0, C1, t); \
    { float a = MX3(C0[0], C0[1], C1[0]), b_ = MX3(C0[2], C0[3], C1[1]); a = MX3(a, C1[2], C1[3]); \
      _Pragma("unroll") for (int r = 4; r < 16; r += 4) { a = MX3(a, C0[r], C0[r + 1]); b_ = MX3(b_, C0[r + 2], C0[r + 3]); a = MX3(a, C1[r], C1[r + 1]); b_ = MX3(b_, C1[r + 2], C1[r + 3]); } \
      float rm = __builtin_fmaxf(a, b_); { auto rr = __builtin_amdgcn_permlane32_swap(__float_as_uint(rm), __float_as_uint(rm), false, false); rm = __builtin_fmaxf(__uint_as_float(rr[0]), __uint_as_float(rr[1])); } \
      resc = false; \
      if (__builtin_expect(__any(rm > (float)THRL), 0)) { const float dl = __builtin_fmaxf(rm, 0.f); mhat += dl; \
        _Pragma("unroll") for (int r = 0; r < 16; ++r) { C0[r] -= dl; C1[r] -= dl; } \
        qx = qx_build(ct - mhat, hi); asm volatile("" : "+v"(qx)); \
        const float f = __builtin_amdgcn_exp2f(-dl); l_reg *= f; if (hi == 0) wsf[r32] = f; resc = true; } } \
    SBAR(); \
    GAPB(o[0] = MFMA32(PAF(0), VFR(0), o[0]), C0, 0); \
    KRDX(GL); GAPB(o[1] = MFMA32(PAF(0), VFR(4), o[1]), C0, 4); \
    KRD(GL, 0); GAPB(o[0] = MFMA32(PAF(1), VFR(1), o[0]), C0, 8); \
    KRD(GL, 1); GAPB(o[1] = MFMA32(PAF(1), VFR(5), o[1]), C0, 12); \
    KRD(GL, 2); GAPB(o[0] = MFMA32(PAF(2), VFR(2), o[0]), C1, 0); \
    KRD(GL, 3); GAPB(o[1] = MFMA32(PAF(2), VFR(6), o[1]), C1, 4); \
    GAPB(o[0] = MFMA32(PAF(3), VFR(3), o[0]), C1, 8); \
    GAPB(o[1] = MFMA32(PAF(3), VFR(7), o[1]), C1, 12); \
    } while (0)
#define ENDW(tt) do { if ((tt) + 3 < NTe) { WAIT_BAR(3); } else if ((tt) + 2 < NTe) { WAIT_BAR(1); } else { WAIT_BAR(0); } } while (0)
#define VOTE(u) do { const int ts_ = NT - (u) - 3; bool ok_ = false; if (ts_ >= 0) { ok_ = __all((qkb - mhat) < clt[ts_]); } if (lane == 0) votes[wid] = ok_ ? 1u : 0u; } while (0)
#define TALLY(u) do { const u32x4 va_ = *(const LAS u32x4*)votes, vb_ = *(const LAS u32x4*)(votes + 4); \
        if (__builtin_amdgcn_readfirstlane((va_.x & va_.y & va_.z & va_.w & vb_.x & vb_.y & vb_.z & vb_.w) != 0u)) { if ((u) + 2 < NTe) { NTe = (u) + 2; WAIT_BAR(0); } } } while (0)
    int t = 1;
    for (; t + 1 < NTe && t < 5; t += 2) {
        STEP(pB0, pB1, pA0, pA1, t, (t + 3 < NTe), (t + 1 < NTe), (t + 1 < NTe));       ENDW(t);     RESC(); ROT();
        STEP(pA0, pA1, pB0, pB1, t + 1, (t + 4 < NTe), (t + 2 < NTe), (t + 2 < NTe));   VOTE(t + 1); ENDW(t + 1); TALLY(t + 1); RESC(); ROT();
    }
#undef CMASK
#define CMASK(P0, P1, p) do {} while (0)
    for (; t + 5 < NTe; t += 2) {
        STEP(pB0, pB1, pA0, pA1, t, true, true, true);       WAIT_BAR(3); RESC(); ROT();
        STEP(pA0, pA1, pB0, pB1, t + 1, true, true, true);   VOTE(t + 1); WAIT_BAR(3); TALLY(t + 1); RESC(); ROT();
    }
    for (; t + 1 < NTe; t += 2) {
        STEP(pB0, pB1, pA0, pA1, t, (t + 3 < NTe), (t + 1 < NTe), (t + 1 < NTe));       ENDW(t);     RESC(); ROT();
        STEP(pA0, pA1, pB0, pB1, t + 1, (t + 4 < NTe), (t + 2 < NTe), (t + 2 < NTe));   ENDW(t + 1); RESC(); ROT();
    }
#undef CMASK
#define CMASK(P0, P1, p) do { const int jb_ = 3 - (p); if (jb_ >= 0) cmask(P0, P1, jb_, qrel, hi); } while (0)
    STEP(pB0, pB1, pA0, pA1, NTe - 1, false, false, false); RESC();
    { float sacc = pB0[0] + pB0[1];
#pragma unroll
      for (int r = 2; r < 16; ++r) sacc += pB0[r];
#pragma unroll
      for (int r = 0; r < 16; ++r) sacc += pB1[r];
      l_reg += sacc;
      pw0 = (u32x4){PKW(pB0, 0), PKW(pB0, 2), PKW(pB0, 4), PKW(pB0, 6)}; pw1 = (u32x4){PKW(pB0, 8), PKW(pB0, 10), PKW(pB0, 12), PKW(pB0, 14)};
      pw2 = (u32x4){PKW(pB1, 0), PKW(pB1, 2), PKW(pB1, 4), PKW(pB1, 6)}; pw3 = (u32x4){PKW(pB1, 8), PKW(pB1, 10), PKW(pB1, 12), PKW(pB1, 14)};
      SBAR(); att::pv(o, (int)(unsigned)(uintptr_t)(vp0 + sl_cur), PAF(0), PAF(1), PAF(2), PAF(3)); }
    l_reg = att::swap_lo(l_reg) + att::swap_hi(l_reg);
    if (hi == 0) wsf[32 + r32] = l_reg; asm volatile("s_waitcnt lgkmcnt(0)" ::: "memory");
    float rli[16];
#pragma unroll
    for (int r = 0; r < 16; ++r) rli[r] = __builtin_amdgcn_rcpf(wsf[32 + crow(r, hi)]);
    bf16_t* Ow = O + (rowbase + q0 + wid * 32) * OPITCH + h * HD;
    { LAS bf16_t* stg = (LAS bf16_t*)(shm + LDS_OST) + wid * 2048;
#pragma unroll
      for (int r = 0; r < 16; ++r) { const int orow = crow(r, hi);
#pragma unroll
        for (int d0 = 0; d0 < 2; ++d0) stg[orow * 64 + d0 * 32 + r32] = (bf16_t)(cvt_pk_bf16(o[d0][r] * rli[r], 0.f) & 0xffffu); }
      asm volatile("s_waitcnt lgkmcnt(0)" ::: "memory");
#pragma unroll
      for (int i = 0; i < 4; ++i) { const int row = i * 8 + (lane >> 3), ch = lane & 7; const u32x4 v = *(const LAS u32x4*)(stg + row * 64 + ch * 8); *(u32x4*)(Ow + (long)row * OPITCH + ch * 8) = v;
        att::store_row_ssq(v, hs + (rowbase + q0 + wid * 32 + row) * 16, ch); } }
    asm volatile("s_waitcnt lgkmcnt(0)\n\ts_barrier" ::: "memory");
#undef DMA_K
#undef DMA_V
#undef CMASK
#undef RESC
#undef ROT
#undef PKW
#undef PAF
#undef VFR
#undef PIN
#undef MX3
#undef GAPA
#undef GAPB
#undef EX
#undef VRD
#undef KRD
#undef KRDX
#undef STEP
#undef ENDW
#undef VOTE
#undef TALLY
}
#undef SBAR
#undef WAIT_BAR
}


namespace sbk {
constexpr int QB = 256, KVBLK = 64, PITCH = HW, OPITCH = DM, NBURST = 6, SLOTB = 8192;
constexpr int LDS_K = 0, LDS_V = NBURST * SLOTB, LDS_FLAG = 2 * NBURST * SLOTB, LDS_END = LDS_FLAG + 128;
static_assert(LDS_END <= RING_BYTES, "sb LDS");
using att::crow; using att::glds16s; using att::qkt; using att::pv; using att::swap_lo;
__device__ __forceinline__ void sb_tile(const LAS char* Kslot, int vb, const bf16x8* qr, bf16x8 TD0, bf16x8 TD1, bf16x8 TONE, int jb, int qrel, int r32, int hi, float& R, f32x16* o) {
    f32x16 p0, p1; const f32x16 z16 = f32x16{};
    qkt(p0, p1, Kslot, qr, z16, r32, hi);
    if (jb >= 0) {
#pragma unroll
        for (int r = 0; r < 16; ++r) { const int kv = 64 * jb + crow(r, hi); if (kv >= qrel) p0[r] = -1.0e30f; if (kv + 32 >= qrel) p1[r] = -1.0e30f; } }
    f32x16 l0, l1;
#pragma unroll
    for (int r = 0; r < 16; ++r) {
        l0[r] = -(fmaxf(p0[r], 0.f) + __builtin_amdgcn_logf(1.0f + __builtin_amdgcn_exp2f(-fabsf(p0[r]))));
        l1[r] = -(fmaxf(p1[r], 0.f) + __builtin_amdgcn_logf(1.0f + __builtin_amdgcn_exp2f(-fabsf(p1[r])))); }
    u32x4 lw0 = {cvt_pk_bf16(l0[0], l0[1]), cvt_pk_bf16(l0[2], l0[3]), cvt_pk_bf16(l0[4], l0[5]), cvt_pk_bf16(l0[6], l0[7])};
    u32x4 lw1 = {cvt_pk_bf16(l0[8], l0[9]), cvt_pk_bf16(l0[10], l0[11]), cvt_pk_bf16(l0[12], l0[13]), cvt_pk_bf16(l0[14], l0[15])};
    u32x4 lw2 = {cvt_pk_bf16(l1[0], l1[1]), cvt_pk_bf16(l1[2], l1[3]), cvt_pk_bf16(l1[4], l1[5]), cvt_pk_bf16(l1[6], l1[7])};
    u32x4 lw3 = {cvt_pk_bf16(l1[8], l1[9]), cvt_pk_bf16(l1[10], l1[11]), cvt_pk_bf16(l1[12], l1[13]), cvt_pk_bf16(l1[14], l1[15])};
    f32x16 rt;
#pragma unroll
    for (int r = 0; r < 16; ++r) rt[r] = R;
    f32x16 t0 = MFMA32(TD0, __builtin_bit_cast(bf16x8, lw0), rt); t0 = MFMA32(TD1, __builtin_bit_cast(bf16x8, lw1), t0);
    t0 = MFMA32(TONE, __builtin_bit_cast(bf16x8, lw2), t0); t0 = MFMA32(TONE, __builtin_bit_cast(bf16x8, lw3), t0);
    f32x16 t1 = MFMA32(TD0, __builtin_bit_cast(bf16x8, lw2), rt); t1 = MFMA32(TD1, __builtin_bit_cast(bf16x8, lw3), t1);
#pragma unroll
    for (int r = 0; r < 16; ++r) { p0[r] = __builtin_amdgcn_exp2f(p0[r] + t0[r]); p1[r] = __builtin_amdgcn_exp2f(p1[r] + t1[r]); }
    R = swap_lo(t0[0]);
    u32x4 pw0 = {cvt_pk_bf16(p0[0], p0[1]), cvt_pk_bf16(p0[2], p0[3]), cvt_pk_bf16(p0[4], p0[5]), cvt_pk_bf16(p0[6], p0[7])};
    u32x4 pw1 = {cvt_pk_bf16(p0[8], p0[9]), cvt_pk_bf16(p0[10], p0[11]), cvt_pk_bf16(p0[12], p0[13]), cvt_pk_bf16(p0[14], p0[15])};
    u32x4 pw2 = {cvt_pk_bf16(p1[0], p1[1]), cvt_pk_bf16(p1[2], p1[3]), cvt_pk_bf16(p1[4], p1[5]), cvt_pk_bf16(p1[6], p1[7])};
    u32x4 pw3 = {cvt_pk_bf16(p1[8], p1[9]), cvt_pk_bf16(p1[10], p1[11]), cvt_pk_bf16(p1[12], p1[13]), cvt_pk_bf16(p1[14], p1[15])};
    pv(o, vb, __builtin_bit_cast(bf16x8, pw0), __builtin_bit_cast(bf16x8, pw1), __builtin_bit_cast(bf16x8, pw2), __builtin_bit_cast(bf16x8, pw3));
}
#define SB_WAITBAR(N) asm volatile("s_waitcnt vmcnt(" #N ") lgkmcnt(0)\n\ts_barrier" ::: "memory")
__device__ __forceinline__ void sb_unit(int b, int h, int qb, const bf16_t* Q, const bf16_t* K, const bf16_t* V, bf16_t* O, float* hs, LAS char* shm) {
    int tid = threadIdx.x; asm volatile("" : "+v"(tid)); const int lane = tid & 63, r32 = lane & 31, hi = lane >> 5; const int wid = __builtin_amdgcn_readfirstlane(tid >> 6);
    const long rowbase = (long)b * SEQ; const int q0 = qb * QB;
    const bf16_t* Qw = Q + (rowbase + q0 + wid * 32) * PITCH + h * HD;
    const bf16_t* Kh = K + rowbase * PITCH + h * HD; const bf16_t* Vh = V + rowbase * PITCH + h * HD;
    const unsigned lds0 = (unsigned)(uintptr_t)shm;
    LAS unsigned* flags = (LAS unsigned*)(shm + LDS_FLAG);
    const unsigned koff = (unsigned)(lane * PITCH + wid * 8) * 2u, voff = (unsigned)((16 * (wid & 3) + (lane >> 2)) * PITCH + (wid >> 2) * 32 + (lane & 3) * 8) * 2u;
    const unsigned kdst = lds0 + LDS_K + wid * 1024, vdst = lds0 + LDS_V + wid * 1024;
#define SB_DMA(p, slot) do { glds16s(Kh + (long)(NT - 1 - (p)) * KVBLK * PITCH, koff, (unsigned)__builtin_amdgcn_readfirstlane(kdst + (slot) * SLOTB)); \
        glds16s(Vh + (long)(NT - 1 - (p)) * KVBLK * PITCH, voff, (unsigned)__builtin_amdgcn_readfirstlane(vdst + (slot) * SLOTB)); } while (0)
    const int vb0 = (int)(lds0 + LDS_V) + ((lane >> 4) & 1) * 32 + (lane & 3) * 8 + (4 * hi + ((lane & 15) >> 2)) * 64;
    const int NT = (q0 + QB) / KVBLK, NB = NT < NBURST ? NT : NBURST;
    for (int p = 0; p < NB; ++p) SB_DMA(p, p);
    bf16x8 qr[4];
#pragma unroll
    for (int d0 = 0; d0 < 4; ++d0) qr[d0] = *(const bf16x8*)(Qw + (long)r32 * PITCH + d0 * 16 + hi * 8);
    f32x16 o[2]; o[0] = f32x16{}; o[1] = f32x16{};
    const int qrel = wid * 32 + r32;
    float R = 0.f;
    bf16x8 TD0, TD1, TONE;
#pragma unroll
    for (int j = 0; j < 8; ++j) { const int kvl = 8 * (j >> 2) + 4 * hi + (j & 3); TD0[j] = (kvl >= r32) ? (short)0x3F80 : (short)0; TD1[j] = (16 + kvl >= r32) ? (short)0x3F80 : (short)0; TONE[j] = (short)0x3F80; }
    if (NB > 4) { SB_WAITBAR(4); } else { SB_WAITBAR(0); }
    bool mid_done = (NB <= 4);
    int p = 3 - (wid >> 1);
    for (; p < NB; ++p) {
        if (p >= 4 && !mid_done) { SB_WAITBAR(0); mid_done = true; }
        sb_tile(shm + LDS_K + p * SLOTB, vb0 + p * SLOTB, qr, TD0, TD1, TONE, 3 - p, qrel, r32, hi, R, o);
        if (__all(R < SB_EXIT)) { ++p; break; }
    }
    if (!mid_done) { SB_WAITBAR(0); }
    { const bool dn = __all(R < SB_EXIT) || (p >= NT); if (lane == 0) flags[wid] = dn ? 1u : 0u; }
    SB_WAITBAR(0);
    bool alldone;
    { const u32x4 fa = *(const LAS u32x4*)flags, fb = *(const LAS u32x4*)(flags + 4); alldone = __builtin_amdgcn_readfirstlane((fa.x & fa.y & fa.z & fa.w & fb.x & fb.y & fb.z & fb.w) != 0u); }
    if (!alldone && NB < NT) {
        SB_DMA(NB, 0);
        for (int i = 0; NB + i < NT; ++i) {
            const int pp = NB + i, sl = i & 1;
            SB_WAITBAR(0);
            if (i > 0) { const LAS unsigned* fl = flags + 8 + ((i - 1) & 1) * 8; const u32x4 fa = *(const LAS u32x4*)fl, fb = *(const LAS u32x4*)(fl + 4);
                if (__builtin_amdgcn_readfirstlane((fa.x & fa.y & fa.z & fa.w & fb.x & fb.y & fb.z & fb.w) != 0u)) break; }
            if (pp + 1 < NT) SB_DMA(pp + 1, sl ^ 1);
            if (!__all(R < SB_EXIT)) sb_tile(shm + LDS_K + sl * SLOTB, vb0 + sl * SLOTB, qr, TD0, TD1, TONE, -1, qrel, r32, hi, R, o);
            { const bool dn = __all(R < SB_EXIT); if (lane == 0) flags[8 + (i & 1) * 8 + wid] = dn ? 1u : 0u; }
        }
        SB_WAITBAR(0);
    }
    bf16_t* Ow = O + (rowbase + q0 + wid * 32) * OPITCH + h * HD;
    { LAS bf16_t* stg = (LAS bf16_t*)(shm + LDS_K) + wid * 2048;
#pragma unroll
      for (int r = 0; r < 16; ++r) { const int orow = crow(r, hi);
#pragma unroll
        for (int d0 = 0; d0 < 2; ++d0) stg[orow * 64 + d0 * 32 + r32] = (bf16_t)(cvt_pk_bf16(o[d0][r], 0.f) & 0xffffu); }
      LDS_WAIT();
#pragma unroll
      for (int i = 0; i < 4; ++i) { const int row = i * 8 + (lane >> 3), ch = lane & 7; const u32x4 v = *(const LAS u32x4*)(stg + row * 64 + ch * 8); *(u32x4*)(Ow + (long)row * OPITCH + ch * 8) = v;
        att::store_row_ssq(v, hs + (rowbase + q0 + wid * 32 + row) * 16, ch); } }
    asm volatile("s_waitcnt vmcnt(0) lgkmcnt(0)\n\ts_barrier" ::: "memory");
#undef SB_DMA
}
#undef SB_WAITBAR
}

#define XB_TMO      128
#define XB_XCNT(j)  (256  + 64 * (j))
#define XB_XSUB(j)  (1280 + 64 * (j))
#define XB_XGEN(j)  (2304 + 64 * (j))
#define XB_TOP      3328
#define XB_TOPGEN   3392
#define XCD_BAR_WORDS 3456
#define XB_SPIN_CAP (1u << 18)
__device__ __forceinline__ unsigned xb_ld(unsigned* p)              { return __hip_atomic_load(p, __ATOMIC_RELAXED, __HIP_MEMORY_SCOPE_AGENT); }
__device__ __forceinline__ unsigned xb_add(unsigned* p, unsigned v) { return __hip_atomic_fetch_add(p, v, __ATOMIC_RELAXED, __HIP_MEMORY_SCOPE_AGENT); }
__device__ __forceinline__ unsigned xb_xcc_id() { return (unsigned)__builtin_amdgcn_s_getreg((3 << 11) | 20) & 0xFu; }
#define XB_SPIN(cond, bar) do { unsigned _sp = 0; while (cond) { __builtin_amdgcn_s_sleep(1); \
    if ((++_sp & 255u) == 0u) { if (xb_ld(&(bar)[XB_TMO])) break; if (_sp > XB_SPIN_CAP) { atomicAdd(&(bar)[XB_TMO], 1u); break; } } } } while (0)
struct XcdBarrier { unsigned* bar; unsigned x; volatile LAS unsigned* st; };
__device__ __forceinline__ XcdBarrier xcd_barrier_post(unsigned* bar, volatile LAS unsigned* st) {
    XcdBarrier b; b.bar = bar; b.x = xb_xcc_id(); b.st = st;
    if (threadIdx.x == 0) (void)xb_add(&bar[XB_XCNT(b.x)], 1u);
    return b;
}
__device__ __forceinline__ void xcd_barrier_complete(unsigned* bar, unsigned x, unsigned& nloc, unsigned& nx) {
    const unsigned G = gridDim.x * gridDim.y * gridDim.z;
    unsigned sum, cnt, mine, sp = 0u;
    for (;;) {
        sum = 0u; cnt = 0u; mine = 0u;
#pragma unroll
        for (unsigned j = 0; j < 16; ++j) { const unsigned c = xb_ld(&bar[XB_XCNT(j)]); sum += c; cnt += (c > 0u) ? 1u : 0u; mine = (j == x) ? c : mine; }
        if (sum == G) break;
        __builtin_amdgcn_s_sleep(1);
        if ((++sp & 255u) == 0u) { if (xb_ld(&bar[XB_TMO])) break; if (sp > XB_SPIN_CAP) { atomicAdd(&bar[XB_TMO], 1u); break; } }
    }
    nloc = mine > 0u ? mine : 1u; nx = cnt > 0u ? cnt : 1u;
}
__device__ __forceinline__ void xcd_barrier(const XcdBarrier& b) {
    asm volatile("s_waitcnt vmcnt(0)" ::: "memory");
    __syncthreads();
    if (threadIdx.x == 0) {
        unsigned* bar = b.bar;
        __builtin_amdgcn_s_waitcnt(0);
        unsigned nloc = b.st[0], nx = b.st[1];
        if (nloc == 0u) { xcd_barrier_complete(bar, b.x, nloc, nx); b.st[0] = nloc; b.st[1] = nx; }
        const unsigned old = xb_add(&bar[XB_XSUB(b.x)], 1u);
        const unsigned gen = old / nloc;
        if (old + 1u == (gen + 1u) * nloc) {
            __builtin_amdgcn_fence(__ATOMIC_RELEASE, "agent");
            asm volatile("s_waitcnt vmcnt(0)" ::: "memory");
            const unsigned og = xb_add(&bar[XB_TOP], 1u);
            const unsigned tg = og / nx;
            if (og + 1u == (tg + 1u) * nx) xb_add(&bar[XB_TOPGEN], 1u);
            else XB_SPIN(xb_ld(&bar[XB_TOPGEN]) == tg, bar);
            __builtin_amdgcn_fence(__ATOMIC_ACQUIRE, "agent");
            xb_add(&bar[XB_XGEN(b.x)], 1u);
            asm volatile("s_waitcnt vmcnt(0)" ::: "memory");
        } else {
            XB_SPIN(xb_ld(&bar[XB_XGEN(b.x)]) == gen, bar);
            __builtin_amdgcn_fence(__ATOMIC_ACQUIRE, "agent");
            asm volatile("s_waitcnt vmcnt(0)" ::: "memory");
        }
    }
    __syncthreads();
}

__device__ __forceinline__ const void* ldp(const volatile LAS unsigned* tab, int i) {
    const unsigned lo = __builtin_amdgcn_readfirstlane(tab[2 * i]), hi = __builtin_amdgcn_readfirstlane(tab[2 * i + 1]);
    return (const void*)(((unsigned long long)hi << 32) | lo);
}
struct Args {
    const float* x; const float* mem; const float* norm_mix; const float* w_in; const float* b_forget; const float* norm_fox; const float* norm_sb; const float* w_out;
    const float* norm_xattn; const float* norm_mem; const float* w_xq; const float* w_xkv; const float* w_xo; const float* norm_ffn;
    const float* w_rg; const float* b_rg; const float* w_re; const float* b_re; const float* w_gate; const float* w_up; const float* w_down; const float* norm_final;
    float* out; unsigned char* ws;
};

__device__ __forceinline__ void transpose_item(const float* W, int ldw, bf16_t* WT, int ldo, int k0, int n0, int dst_row0, const float* gain, LAS float* scr, int lane) {
    float tv[32], tg[32];
#pragma unroll
    for (int i = 0; i < 32; ++i) { const int kk = 2 * i + (lane >> 5); tv[i] = W[(size_t)(k0 + kk) * ldw + n0 + (lane & 31)]; tg[i] = gain ? gain[k0 + kk] : 1.f; }
#pragma unroll
    for (int i = 0; i < 32; ++i) { const int kk = 2 * i + (lane >> 5); scr[kk * 33 + (lane & 31)] = tv[i] * tg[i]; }
    LDS_WAIT(); asm volatile("" ::: "memory");
    const int c = lane & 7;
#pragma unroll
    for (int j = 0; j < 4; ++j) { const int n = (lane >> 3) + 8 * j; const LAS float* s = scr + (8 * c) * 33 + n;
        u32x4 o; o.x = cvt_pk_bf16(s[0 * 33], s[1 * 33]); o.y = cvt_pk_bf16(s[2 * 33], s[3 * 33]); o.z = cvt_pk_bf16(s[4 * 33], s[5 * 33]); o.w = cvt_pk_bf16(s[6 * 33], s[7 * 33]);
        *(u32x4*)(WT + (size_t)(dst_row0 + n) * ldo + k0 + 8 * c) = o; }
    LDS_WAIT(); asm volatile("" ::: "memory");
}

struct SchedDense {
    const char* A; const char* Bt; int nM, nN, G, c; size_t a_tile, b_tile, b_batch; int split_tiles;
    __device__ __forceinline__ bool next(int i, pg8::Unit& u) const {
        int pm, pn; if (!pg8::tile_order(i, G, c, nM, nN, pm, pn)) return false;
        u.a = A + (size_t)pm * a_tile; u.b = Bt + (size_t)pn * b_tile + (size_t)(pm >> 5) * b_batch; u.orow = pm * 256;
        if (split_tiles) { u.aux = pn / split_tiles; u.ocol = (pn % split_tiles) * 256; } else { u.aux = 1; u.ocol = pn * 256; }
        u.rows = nullptr; u.nvalid = 256; return true;
    }
};
struct SchedGH {
    const char* KVm; const char* Wxq; const char* Wxo; int G, c;
    __device__ __forceinline__ bool next(int i, pg8::Unit& u) const {
        const int L = i * G + c; if (L >= 256) return false;
        const int kind = L >> 7, r = L & 127, bh = r >> 2, j = r & 3, b = bh >> 2, h = bh & 3;
        if (kind == 0) { u.a = KVm + ((size_t)(b * 256) * 2048 + h * 256) * 2; u.b = Wxq + ((size_t)(256 * j) * 1024 + h * 256) * 2; u.orow = b * 1024 + h * 256; u.ocol = 256 * j; u.aux = 1; }
        else { u.a = Wxo + ((size_t)(256 * j) * 1024 + h * 256) * 2; u.b = KVm + ((size_t)(b * 256) * 2048 + 1024 + h * 256) * 2; u.orow = b * 1024 + 256 * j; u.ocol = h * 256; u.aux = 2; }
        u.rows = nullptr; u.nvalid = 256; return true;
    }
};
template <int KIND> struct SchedGHk { SchedGH s; __device__ __forceinline__ bool next(int i, pg8::Unit& u) const { const int c2 = (s.G >= 256) ? s.c - 128 * KIND : s.c; if (c2 < 0) return false; const int L = i * s.G + c2; if (L >= 128) return false; SchedGH t = s; t.G = 1; t.c = 0; return t.next(128 * KIND + L, u); } };
struct EpiGH { static constexpr bool HAS_MID = false; bf16_t* GTp; bf16_t* HTp; __device__ __forceinline__ void operator()(const f32x4 (&acc)[2][2][4][2], const pg8::Unit& u, int wr, int wc, int fr, int fq) const {
    pg8::EpiBf16 e{u.aux == 1 ? GTp : HTp, DM, nullptr, 0, 1.f, 1.f, nullptr}; pg8::Unit v = u; v.aux = 1; e(acc, v, wr, wc, fr, fq); } };
struct SchedMoe {
    const char* A; const char* W; const int* list; const LAS int* tbl; int G, c, NPN; size_t w_exp, w_tile, a_tile; int ocol_w;
    __device__ __forceinline__ bool next(int i, pg8::Unit& u) const {
        const int L = i * G + c; const int tl = L / NPN, pn = L % NPN;
        if (tl >= __builtin_amdgcn_readfirstlane(tbl[16])) return false;
        int e = 0;
#pragma unroll 1
        for (int x = 1; x < NEXP; ++x) { if (tl >= __builtin_amdgcn_readfirstlane(tbl[x])) e = x; }
        const int j = tl - __builtin_amdgcn_readfirstlane(tbl[e]), n = __builtin_amdgcn_readfirstlane(tbl[32 + e]) - 256 * j;
        u.a = A + (size_t)tl * a_tile; u.b = W + (size_t)e * w_exp + (size_t)pn * w_tile; u.orow = tl * 256; u.ocol = pn * ocol_w; u.aux = 1;
        u.rows = list + (size_t)e * M + 256 * j; u.nvalid = n < 256 ? n : 256; return true;
    }
};
__device__ __forceinline__ void moe_table(LAS int* tbl, const unsigned* ctl) {
    if (threadIdx.x == 0) { int base = 0; for (int e = 0; e < NEXP; ++e) { const int n = (int)ctl[CW_CNT + 64 * e]; tbl[e] = base; tbl[32 + e] = n; base += (n + 255) >> 8; } tbl[16] = base; }
    __syncthreads();
}

__global__ void __launch_bounds__(NWAVES * 64, 2) hymba_fwd(Args args) {
    extern __shared__ __attribute__((aligned(16))) unsigned char lds_raw[];
    LAS unsigned char* lds = (LAS unsigned char*)lds_raw;
    volatile LAS unsigned* MISC = (volatile LAS unsigned*)(lds + MISC_OFF);
    const int tid0 = threadIdx.x; const int wave = __builtin_amdgcn_readfirstlane(tid0 >> 6);
    const int G = gridDim.x; const int bx = blockIdx.x; const int vcu = (G % 8 == 0) ? (bx % 8) * (G / 8) + bx / 8 : bx;
    volatile LAS unsigned* ATAB = (volatile LAS unsigned*)(lds + MISC_OFF + 512);
    for (int u = tid0; u < 256; u += NWAVES * 64) ((LAS unsigned*)(lds + MISC_OFF))[u] = 0u;
    __syncthreads();
    if (tid0 == 0) { const float* const* ap = (const float* const*)&args;
#pragma unroll
        for (int i = 0; i < 24; ++i) { const unsigned long long v = (unsigned long long)ap[i]; ATAB[2 * i] = (unsigned)v; ATAB[2 * i + 1] = (unsigned)(v >> 32); } }
    __syncthreads();
#define ARGP(name) ((const float*)ldp(ATAB, (int)(offsetof(Args, name) / 8)))
#define PHASE_PTRS \
    int tid = threadIdx.x; asm volatile("" : "+v"(tid)); const int lane = tid & 63; (void)lane; \
    unsigned char* const ws = (unsigned char*)ldp(ATAB, 23); float* const out = (float*)ldp(ATAB, 22); unsigned* const ctl = (unsigned*)(ws + WS_CTL); (void)out; (void)ctl; \
    bf16_t* const Win_t = (bf16_t*)(ws + WS_WIN); bf16_t* const Wout_t = (bf16_t*)(ws + WS_WOUT); bf16_t* const Wxq_n = (bf16_t*)(ws + WS_WXQ); bf16_t* const Wxkv_t = (bf16_t*)(ws + WS_WXKV); \
    bf16_t* const Wxo_t = (bf16_t*)(ws + WS_WXO); bf16_t* const Wgu_t = (bf16_t*)(ws + WS_WGU); bf16_t* const Wd_t = (bf16_t*)(ws + WS_WD); \
    float* const RX = (float*)(ws + WS_RX); float* const RMEM = (float*)(ws + WS_RMEM); float* const LF = (float*)(ws + WS_LF); float* const CC = (float*)(ws + WS_C2); float* const SSQ = (float*)(ws + WS_SSQ); \
    int* const TOKSLOT = (int*)(ws + WS_TOKSLOT); float* const TOKW = (float*)(ws + WS_TOKW); int* const LIST = (int*)(ws + WS_LIST); \
    bf16_t* const MEMB = (bf16_t*)(ws + WS_MEMB); bf16_t* const KVM = (bf16_t*)(ws + WS_KVM); bf16_t* const GT = (bf16_t*)(ws + WS_GT); bf16_t* const HT = (bf16_t*)(ws + WS_HT); \
    bf16_t* const XB = (bf16_t*)(ws + WS_XB); bf16_t* const QKV = (bf16_t*)(ws + WS_QKV); bf16_t* const H1B = (bf16_t*)(ws + WS_H1B); bf16_t* const U2B = (bf16_t*)(ws + WS_U2B); bf16_t* const HID = (bf16_t*)(ws + WS_HID); \
    bf16_t* const OAB = (bf16_t*)(ws + WS_O); bf16_t* const YB = (bf16_t*)(ws + WS_Y); bf16_t* const KX = (bf16_t*)(ws + WS_KX); (void)KX; float* const HS = (float*)(ws + WS_HS); (void)HS; float* const R2 = (float*)(ws + WS_R2); (void)R2; \
    (void)Win_t; (void)Wout_t; (void)Wxq_n; (void)Wxkv_t; (void)Wxo_t; (void)Wgu_t; (void)Wd_t; (void)RX; (void)RMEM; (void)LF; (void)CC; (void)SSQ; (void)TOKSLOT; (void)TOKW; (void)LIST; \
    (void)MEMB; (void)KVM; (void)GT; (void)HT; (void)XB; (void)QKV; (void)H1B; (void)U2B; (void)HID; (void)OAB; (void)YB;
    XcdBarrier bar;
    { unsigned char* const ws0 = (unsigned char*)ldp(ATAB, 23); bar = xcd_barrier_post((unsigned*)(ws0 + WS_CTL) + CW_BAR, MISC + 8); }
    const int gw = vcu * NWAVES + wave, NGW = G * NWAVES;
    unsigned long long t_pa = 0, t_pb = 0; (void)t_pa; (void)t_pb;


    if (PROBE_LO == 0) t_pa = __builtin_amdgcn_s_memrealtime();
    if (PH(0))
    for (int rep_ = 0; rep_ < REPS(0); ++rep_)
    {
        PHASE_PTRS
        LAS float* wfT = (LAS float*)(lds + RING_OFF);
        LAS float* scr = (LAS float*)(lds + RING_OFF + 32768 + wave * 8448);
        { const float* win = ARGP(w_in); const float* gmix = ARGP(norm_mix);
          f32x4 fa[2], fb[2]; float gk[2];
#pragma unroll
          for (int q = 0; q < 2; ++q) { const int k = tid + 512 * q; gk[q] = gmix[k]; fa[q] = *(const f32x4*)(win + (size_t)k * WIN_LD + NPROJ); fb[q] = *(const f32x4*)(win + (size_t)k * WIN_LD + NPROJ + 4); }
#pragma unroll
          for (int q = 0; q < 2; ++q) { const int k = tid + 512 * q;
#pragma unroll
              for (int j = 0; j < 4; ++j) { wfT[j * DM + k] = fa[q][j] * gk[q]; wfT[(4 + j) * DM + k] = fb[q][j] * gk[q]; } } }
        constexpr int I_IN = 16 * 96, I_OUT = 16 * 32, I_XKV = 16 * 64, I_XO = 16 * 32, I_G = 16 * 16 * 8, I_U = I_G, I_D = 16 * 4 * 32, I_XQ = 1024;
        constexpr int NITEMS = I_IN + I_OUT + I_XKV + I_XO + I_G + I_U + I_D + I_XQ;
        for (int it = gw; it < NITEMS; it += NGW) {
            int r = it;
            if (r < I_IN) { const int kb = r / 96, nb = r % 96; transpose_item(ARGP(w_in), WIN_LD, Win_t, DM, 64 * kb, 32 * nb, 32 * nb, ARGP(norm_mix), scr, lane); continue; } r -= I_IN;
            if (r < I_OUT) { const int kb = r / 32, nb = r % 32; const float* gn = (64 * kb < HW) ? ARGP(norm_fox) : (ARGP(norm_sb) - HW); transpose_item(ARGP(w_out), DM, Wout_t, DM, 64 * kb, 32 * nb, 32 * nb, gn, scr, lane); continue; } r -= I_OUT;
            if (r < I_XKV) { const int kb = r / 64, nb = r % 64; transpose_item(ARGP(w_xkv), 2 * DM, Wxkv_t, DM, 64 * kb, 32 * nb, 32 * nb, ARGP(norm_mem), scr, lane); continue; } r -= I_XKV;
            if (r < I_XO) { const int kb = r / 32, nb = r % 32; transpose_item(ARGP(w_xo), DM, Wxo_t, DM, 64 * kb, 32 * nb, 32 * nb, nullptr, scr, lane); continue; } r -= I_XO;
            if (r < I_G + I_U) { const int up = r >= I_G; const int q = up ? r - I_G : r; const int e = q / 128, kb = (q % 128) / 8, nb = q % 8; const int n0 = 32 * nb;
                const float* W = (up ? ARGP(w_up) : ARGP(w_gate)) + (size_t)e * DM * DFF;
                transpose_item(W, DFF, Wgu_t + (size_t)e * 512 * DM, DM, 64 * kb, n0, 256 * (n0 / 128) + (n0 % 128) + (up ? 128 : 0), ARGP(norm_ffn), scr, lane); continue; } r -= I_G + I_U;
            if (r < I_D) { const int e = r / 128, kb = (r % 128) / 32, nb = r % 32; transpose_item(ARGP(w_down) + (size_t)e * DFF * DM, DM, Wd_t + (size_t)e * DM * DFF, DFF, 64 * kb, 32 * nb, 32 * nb, nullptr, scr, lane); continue; } r -= I_D;
            { const int k = r; const float gk = ARGP(norm_xattn)[k]; const f32x4* src = (const f32x4*)(ARGP(w_xq) + (size_t)k * DM) + lane; u32x2* dst = (u32x2*)(Wxq_n + (size_t)k * DM) + lane;
#pragma unroll
              for (int j = 0; j < 4; ++j) { const f32x4 v = src[64 * j] * gk; u32x2 w; w.x = cvt_pk_bf16(v[0], v[1]); w.y = cvt_pk_bf16(v[2], v[3]); dst[64 * j] = w; } }
        }
        __syncthreads();
        const float* xin = ARGP(x); const float* memin = ARGP(mem); const float* bfg = ARGP(b_forget);
        f32x4 vnx[4];
        { const int r0_ = gw; if (r0_ < M + MEMROWS) { const bool im_ = r0_ >= M; const f32x4* xr = (const f32x4*)((im_ ? memin : xin) + (size_t)(im_ ? r0_ - M : r0_) * DM) + lane;
#pragma unroll
            for (int j = 0; j < 4; ++j) vnx[j] = xr[64 * j]; } }
        for (int row = gw; row < M + MEMROWS; row += NGW) {
            const bool is_mem = row >= M; const int r = is_mem ? row - M : row;
            f32x4 v[4]; float s = 0.f;
#pragma unroll
            for (int j = 0; j < 4; ++j) v[j] = vnx[j];
            { const int nr_ = row + NGW; if (nr_ < M + MEMROWS) { const bool im_ = nr_ >= M; const f32x4* xr = (const f32x4*)((im_ ? memin : xin) + (size_t)(im_ ? nr_ - M : nr_) * DM) + lane;
#pragma unroll
                for (int j = 0; j < 4; ++j) vnx[j] = xr[64 * j]; } }
#pragma unroll
            for (int j = 0; j < 4; ++j) s += (v[j][0] * v[j][0] + v[j][1] * v[j][1]) + (v[j][2] * v[j][2] + v[j][3] * v[j][3]);
            const float rinv = rsqrtf(wave_sum(s) * (1.0f / DM) + EPS);
            u32x2* o8 = (u32x2*)((is_mem ? MEMB : XB) + (size_t)r * DM) + lane;
#pragma unroll
            for (int j = 0; j < 4; ++j) { u32x2 w; w.x = cvt_pk_bf16(v[j][0], v[j][1]); w.y = cvt_pk_bf16(v[j][2], v[j][3]); o8[64 * j] = w; }
            if (is_mem) { if (lane == 0) RMEM[r] = rinv; continue; }
            float f[8];
#pragma unroll
            for (int jj = 0; jj < 8; ++jj) { float a = 0.f;
#pragma unroll
                for (int j = 0; j < 4; ++j) { const f32x4 w4 = *(const LAS f32x4*)(wfT + jj * DM + 256 * j + 4 * lane); a += (v[j][0] * w4[0] + v[j][1] * w4[1]) + (v[j][2] * w4[2] + v[j][3] * w4[3]); }
                f[jj] = wave_sum(a); }
            if (lane == 0) RX[r] = rinv;
            if (lane < 8) { float fl = 0.f;
#pragma unroll
                for (int jj = 0; jj < 8; ++jj) fl = (lane == jj) ? f[jj] : fl;
                fl = fl * rinv + bfg[lane];
                const float ls = fminf(fl, 0.f) - log1pf(expf(-fabsf(fl)));
                LF[(size_t)r * 8 + lane] = ls * LOG2E; }
        }
    }
    xcd_barrier(bar);
    if (PROBE_HI == 0) t_pb = __builtin_amdgcn_s_memrealtime();

    if (PROBE_LO == 1) t_pa = __builtin_amdgcn_s_memrealtime();
    if (PH(1))
    if (vcu < 32) {
        PHASE_PTRS
        const int b = vcu >> 2, h = (vcu & 3) * 2 + (wave >> 2), seg = wave & 3, s0 = seg * 2048 + lane * 32;
        const float* src = LF + ((size_t)b * SEQ + s0) * 8 + h;
        float p[32];
#pragma unroll
        for (int j = 0; j < 32; ++j) p[j] = src[j * 8];
#pragma unroll
        for (int j = 1; j < 32; ++j) p[j] += p[j - 1];
        float inc = p[31];
#pragma unroll
        for (int o = 1; o < 64; o <<= 1) { const float y = __shfl_up(inc, o); if (lane >= o) inc += y; }
        LAS float* tot = (LAS float*)(lds + EXTRA_OFF);
        if (lane == 63) tot[wave] = inc;
        __syncthreads();
        float off = inc - p[31];
        for (int q = 0; q < 3; ++q) if (q < seg) off += tot[(wave & 4) + q];
        float* dst = CC + ((size_t)b * NH + h) * SEQ + s0; bf16_t* kx = KX + (((size_t)b * NH + h) * SEQ + s0) * 8;
#pragma unroll
        for (int j = 0; j < 32; ++j) { const float x = off + p[j]; dst[j] = x;
            unsigned hm, lo; fox::split3(-x, hm, lo); u32x4 w; w.x = 0x3F803F80u; w.y = 0x3F80u | (hm << 16); w.z = (hm >> 16) | (lo << 16); w.w = 0u;
            *(u32x4*)(kx + j * 8) = w; }
        VM_WAIT(); __syncthreads();
    }
    if (PH(1))
    for (int rep_ = 0; rep_ < REPS(1); ++rep_)
    {
        PHASE_PTRS
        pg8::Gemm g{DM, DM, DM};
        SchedDense S{(const char*)XB, (const char*)Win_t, M / 256, NPROJ / 256, G, bx, (size_t)256 * DM * 2, (size_t)256 * DM * 2, 0, 2};
        pg8::EpiBf16 E{QKV, HW, RX, QKV_STRIDE, C2, C2, ctl + CW_KN};
        pg8::gemm_phase<pg8::EpiBf16, SchedDense, true, false>(lds + RING_OFF, g, S, E);
    }
    xcd_barrier(bar);
    if (PROBE_HI == 1) t_pb = __builtin_amdgcn_s_memrealtime();

    if (PROBE_LO == 2) t_pa = __builtin_amdgcn_s_memrealtime();
    if (PH(2))
    {
        PHASE_PTRS
        const bf16_t* QA = QKV; const bf16_t* KA = QKV + QKV_STRIDE; const bf16_t* VA = QKV + 2 * QKV_STRIDE;
        const bf16_t* QBp = QKV + 3 * QKV_STRIDE; const bf16_t* KBp = QKV + 4 * QKV_STRIDE; const bf16_t* VBp = QKV + 5 * QKV_STRIDE;
        bf16_t* OA = OAB; bf16_t* OB = OAB + HW;
        LAS char* shm = (LAS char*)(lds + RING_OFF);
        { pg8::Gemm g{DM, DM, DM};
          SchedDense S2{(const char*)MEMB, (const char*)Wxkv_t, MEMROWS / 256, 2 * DM / 256, G, bx, (size_t)256 * DM * 2, (size_t)256 * DM * 2, 0, 0};
          pg8::EpiBf16 E2{KVM, 2 * DM, RMEM, 0, 1.f, 1.f, nullptr};
          pg8::gemm_phase<pg8::EpiBf16, SchedDense, true, false>(lds + RING_OFF, g, S2, E2);
          VM_WAIT(); __syncthreads(); }
        for (int rep = 0; rep < REP_FOX; ++rep)
        for (int i = 0; i < 8; ++i) { const int bh = (vcu >> 5) * 8 + i, x = vcu & 31, qb = (i & 1) ? 31 - x : x;
            const float kmax = sqrtf(__uint_as_float(ctl[CW_KN + bh * 2]) + __uint_as_float(ctl[CW_KN + bh * 2 + 1])) * 1.01f;
            fox::fox_unit<8>(bh, qb, QA, KA, VA, OA, HS + (bh & 7), CC + (size_t)bh * SEQ, KX + (size_t)bh * SEQ * 8, kmax, shm); }
        { volatile LAS unsigned* qs = MISC + 16;
          unsigned nxt = 0u;
          if (tid == 0) qs[0] = __hip_atomic_fetch_add(ctl + CW_SBQ, 1u, __ATOMIC_RELAXED, __HIP_MEMORY_SCOPE_AGENT);
          __syncthreads();
          unsigned idx = qs[0];
          while (idx < (unsigned)(BATCH * NH * 32 * REP_SB)) {
              __syncthreads();
              if (tid == 0) nxt = __hip_atomic_fetch_add(ctl + CW_SBQ, 1u, __ATOMIC_RELAXED, __HIP_MEMORY_SCOPE_AGENT);
              const int un = (int)(idx % (unsigned)(BATCH * NH * 32)), bh = un >> 5, qb = un & 31;
              sbk::sb_unit(bh >> 3, bh & 7, qb, QBp, KBp, VBp, OB, HS + 8 + (bh & 7), shm);
              if (tid == 0) qs[0] = nxt;
              __syncthreads();
              idx = qs[0];
          } }
    }
    xcd_barrier(bar);
    if (PROBE_HI == 2) t_pb = __builtin_amdgcn_s_memrealtime();

    if (PROBE_LO == 4) t_pa = __builtin_amdgcn_s_memrealtime();
    if (PH(4))
    for (int rep_ = 0; rep_ < REPS(4); ++rep_)
    {
        PHASE_PTRS
        pg8::Gemm g{DM, DM, DM};
        SchedDense S{(const char*)OAB, (const char*)Wout_t, M / 256, DM / 256, G, bx, (size_t)256 * DM * 2, (size_t)256 * DM * 2, 0, 0};
        pg8::EpiOutProj E{XB, H1B, SSQ, HS};
        pg8::gemm_phase<pg8::EpiOutProj, SchedDense, true, false>(lds + RING_OFF, g, S, E);
        pg8::Gemm g2{0, 0, 256};
        SchedGH SG{(const char*)KVM, (const char*)Wxq_n, (const char*)Wxo_t, G, bx};
        EpiGH EG{GT, HT};
        g2.lda = 2 * DM; g2.ldb = DM; SchedGHk<0> S0{SG}; pg8::gemm_phase<EpiGH, SchedGHk<0>, true, false>(lds + RING_OFF, g2, S0, EG);
        g2.lda = DM; g2.ldb = 2 * DM; SchedGHk<1> S1{SG}; pg8::gemm_phase<EpiGH, SchedGHk<1>, true, false>(lds + RING_OFF, g2, S1, EG);
    }
    xcd_barrier(bar);
    if (PROBE_HI == 4) t_pb = __builtin_amdgcn_s_memrealtime();

    if (PROBE_LO == 5) t_pa = __builtin_amdgcn_s_memrealtime();
    if (PH(5))
    for (int rep_ = 0; rep_ < REPS(5); ++rep_)
    {
        PHASE_PTRS
        pg8::Gemm g{DM, DM, DM};
        SchedDense S{(const char*)H1B, (const char*)GT, M / 256, DM / 256, G, bx, (size_t)256 * DM * 2, (size_t)256 * DM * 2, (size_t)DM * DM * 2, 0};
        pg8::EpiSoftmax E{XB, SSQ, (LAS float*)(lds + EXTRA_OFF)};
        pg8::gemm_phase<pg8::EpiSoftmax, SchedDense, true, false>(lds + RING_OFF, g, S, E);
    }
    xcd_barrier(bar);
    if (PROBE_HI == 5) t_pb = __builtin_amdgcn_s_memrealtime();

    if (PROBE_LO == 6) t_pa = __builtin_amdgcn_s_memrealtime();
    if (PH(6))
    {
        PHASE_PTRS
        pg8::Gemm g{DM, DM, DM};
        SchedDense S{(const char*)XB, (const char*)HT, M / 256, DM / 256, G, bx, (size_t)256 * DM * 2, (size_t)256 * DM * 2, (size_t)DM * DM * 2, 0};
        pg8::EpiResidBf16 E{H1B};
        pg8::gemm_phase<pg8::EpiResidBf16, SchedDense, true, false>(lds + RING_OFF, g, S, E);
    }
    xcd_barrier(bar);
    if (PROBE_HI == 6) t_pb = __builtin_amdgcn_s_memrealtime();

    if (PROBE_LO == 7) t_pa = __builtin_amdgcn_s_memrealtime();
    if (PH(7))
    {
        PHASE_PTRS
        LAS bf16_t* wBh = (LAS bf16_t*)(lds + RING_OFF); LAS bf16_t* wBl = wBh + 20 * DM;
        { const f32x4* wg4 = (const f32x4*)ARGP(w_rg); const f32x4* we4 = (const f32x4*)ARGP(w_re); const float* gf = ARGP(norm_ffn);
          f32x4 ga[2], ea[2][4]; float gk[2];
#pragma unroll
          for (int q = 0; q < 2; ++q) { const int k = tid + 512 * q; ga[q] = wg4[k]; gk[q] = gf[k];
#pragma unroll
              for (int c = 0; c < 4; ++c) ea[q][c] = we4[k * 4 + c]; }
#pragma unroll
          for (int q = 0; q < 2; ++q) { const int k = tid + 512 * q;
#pragma unroll
              for (int j = 0; j < 4; ++j) { { const float v = ga[q][j] * gk[q]; const unsigned hi_ = cvt_pk_bf16(v, 0.f) & 0xffffu; wBh[j * DM + k] = (bf16_t)hi_; wBl[j * DM + k] = (bf16_t)(cvt_pk_bf16(v - __uint_as_float(hi_ << 16), 0.f) & 0xffffu); }
#pragma unroll
                  for (int c = 0; c < 4; ++c) { const float v = ea[q][c][j] * gk[q]; const unsigned hi_ = cvt_pk_bf16(v, 0.f) & 0xffffu; const int col = 4 + 4 * c + j; wBh[col * DM + k] = (bf16_t)hi_; wBl[col * DM + k] = (bf16_t)(cvt_pk_bf16(v - __uint_as_float(hi_ << 16), 0.f) & 0xffffu); } } } }
        LAS int* dec_e = (LAS int*)(lds + RING_OFF + 81920); LAS float* dec_w = (LAS float*)(lds + RING_OFF + 81920 + 2048); LAS int* dec_r = (LAS int*)(lds + RING_OFF + 81920 + 4096);
        LAS int* hist = (LAS int*)(lds + RING_OFF + 81920 + 6144); LAS int* ebase = hist + 16;
        if (tid < 16) hist[tid] = 0;
        __syncthreads();
        const float brg0 = ARGP(b_rg)[0], brg1 = ARGP(b_rg)[1], brg2 = ARGP(b_rg)[2], brg3 = ARGP(b_rg)[3]; const float* bre = ARGP(b_re);
        const int tok = lane & 31, half = lane >> 5, jcol = tok < 20 ? tok : 19;
        for (int it = 0; it * NGW < M / 32; ++it) {
            const int T = gw + it * NGW; const bool act = T < M / 32; const int r0 = act ? 32 * T : 0;
            const bf16_t* rowp = H1B + (size_t)(r0 + tok) * DM + 512 * half;
            const LAS bf16_t* wph = wBh + jcol * DM + 512 * half; const LAS bf16_t* wpl = wBl + jcol * DM + 512 * half;
            f32x16 ah0 = f32x16{}, ah1 = f32x16{}, al0 = f32x16{}, al1 = f32x16{}; float ssq = 0.f;
#pragma unroll 4
            for (int sidx = 0; sidx < 64; sidx += 2) {
                const u32x4 a0 = *(const u32x4*)(rowp + 8 * sidx), a1 = *(const u32x4*)(rowp + 8 * sidx + 8);
                const bf16x8 wh0 = *(const LAS bf16x8*)(wph + 8 * sidx), wl0 = *(const LAS bf16x8*)(wpl + 8 * sidx), wh1 = *(const LAS bf16x8*)(wph + 8 * sidx + 8), wl1 = *(const LAS bf16x8*)(wpl + 8 * sidx + 8);
                ah0 = MFMA32(wh0, __builtin_bit_cast(bf16x8, a0), ah0); al0 = MFMA32(wl0, __builtin_bit_cast(bf16x8, a0), al0);
                ah1 = MFMA32(wh1, __builtin_bit_cast(bf16x8, a1), ah1); al1 = MFMA32(wl1, __builtin_bit_cast(bf16x8, a1), al1);
                ssq += (bf16lo(a0.x) * bf16lo(a0.x) + bf16hi(a0.x) * bf16hi(a0.x)) + (bf16lo(a0.y) * bf16lo(a0.y) + bf16hi(a0.y) * bf16hi(a0.y)) + (bf16lo(a0.z) * bf16lo(a0.z) + bf16hi(a0.z) * bf16hi(a0.z)) + (bf16lo(a0.w) * bf16lo(a0.w) + bf16hi(a0.w) * bf16hi(a0.w));
                ssq += (bf16lo(a1.x) * bf16lo(a1.x) + bf16hi(a1.x) * bf16hi(a1.x)) + (bf16lo(a1.y) * bf16lo(a1.y) + bf16hi(a1.y) * bf16hi(a1.y)) + (bf16lo(a1.z) * bf16lo(a1.z) + bf16hi(a1.z) * bf16hi(a1.z)) + (bf16lo(a1.w) * bf16lo(a1.w) + bf16hi(a1.w) * bf16hi(a1.w));
            }
            const float rinv = rsqrtf((att::swap_lo(ssq) + att::swap_hi(ssq)) * (1.0f / DM) + EPS);
            float lg[20];
#pragma unroll
            for (int r = 0; r < 12; ++r) { const float c = (ah0[r] + ah1[r]) + (al0[r] + al1[r]); auto rr = __builtin_amdgcn_permlane32_swap(__float_as_uint(c), __float_as_uint(c), false, false);
                const int jl = (r & 3) + 8 * (r >> 2); lg[jl] = __uint_as_float(rr[0]) * rinv; if (r < 8) lg[jl + 4] = __uint_as_float(rr[1]) * rinv; }
            float g0 = lg[0] + brg0, g1 = lg[1] + brg1, g2 = lg[2] + brg2, g3 = lg[3] + brg3;
            int gi = 0; float gm = g0; if (g1 > gm) { gm = g1; gi = 1; } if (g2 > gm) { gm = g2; gi = 2; } if (g3 > gm) { gm = g3; gi = 3; }
            const float gval = 1.0f / (expf(g0 - gm) + expf(g1 - gm) + expf(g2 - gm) + expf(g3 - gm));
            float el[4];
#pragma unroll
            for (int j = 0; j < 4; ++j) { const float e0 = lg[4 + j], e1 = lg[8 + j], e2 = lg[12 + j], e3 = lg[16 + j]; el[j] = ((gi == 0) ? e0 : (gi == 1) ? e1 : (gi == 2) ? e2 : e3) + bre[gi * 4 + j]; }
            int i0 = 0; float m0 = el[0];
#pragma unroll
            for (int j = 1; j < 4; ++j) if (el[j] > m0) { m0 = el[j]; i0 = j; }
            int i1 = -1; float m1 = -3.0e38f;
#pragma unroll
            for (int j = 0; j < 4; ++j) if (j != i0 && el[j] > m1) { m1 = el[j]; i1 = j; }
            const float w0 = 1.0f / (1.0f + expf(m1 - m0)), w1 = 1.0f - w0;
            if (act) { const int e = gi * 4 + (half == 0 ? i0 : i1); const float w = gval * (half == 0 ? w0 : w1);
                const int idx = (wave * 32 + tok) * 2 + half; dec_e[idx] = e; dec_w[idx] = w; dec_r[idx] = __hip_atomic_fetch_add(hist + e, 1, __ATOMIC_RELAXED, __HIP_MEMORY_SCOPE_WORKGROUP);
                if (half == 0) R2[r0 + tok] = rinv; }
            __syncthreads();
            if (tid < 16) { const int n = hist[tid]; ebase[tid] = n ? (int)__hip_atomic_fetch_add(ctl + CW_CNT + 64 * tid, (unsigned)n, __ATOMIC_RELAXED, __HIP_MEMORY_SCOPE_AGENT) : 0; }
            __syncthreads();
            if (act) { const int row = r0 + (lane >> 1), idx = wave * 64 + lane; const int e = dec_e[idx], pos = ebase[e] + dec_r[idx];
                LIST[(size_t)e * M + pos] = row; TOKSLOT[(size_t)row * 2 + (lane & 1)] = (e << 20) | pos; TOKW[(size_t)row * 2 + (lane & 1)] = dec_w[idx]; }
            __syncthreads();
            if (tid < 16) hist[tid] = 0;
            __syncthreads();
        }
    }
    xcd_barrier(bar);
    if (PROBE_HI == 7) t_pb = __builtin_amdgcn_s_memrealtime();

    if (PROBE_LO == 8) t_pa = __builtin_amdgcn_s_memrealtime();
    if (PH(8))
    for (int rep_ = 0; rep_ < REPS(8); ++rep_)
    {
        PHASE_PTRS
        pg8::Gemm g{DM, DM, DM};
        LAS int* tbl = (LAS int*)(lds + EXTRA_OFF + 8192); moe_table(tbl, ctl);
        SchedMoe S; S.A = (const char*)H1B; S.W = (const char*)Wgu_t; S.list = LIST; S.tbl = tbl; S.G = G; S.c = bx; S.NPN = 2; S.w_exp = (size_t)512 * DM * 2; S.w_tile = (size_t)256 * DM * 2; S.a_tile = 0; S.ocol_w = 128;
        pg8::EpiSwiglu E{HID, R2};
        pg8::gemm_phase<pg8::EpiSwiglu, SchedMoe, true, true>(lds + RING_OFF, g, S, E);
    }
    xcd_barrier(bar);
    if (PROBE_HI == 8) t_pb = __builtin_amdgcn_s_memrealtime();

    if (PROBE_LO == 9) t_pa = __builtin_amdgcn_s_memrealtime();
    if (PH(9))
    for (int rep_ = 0; rep_ < REPS(9); ++rep_)
    {
        PHASE_PTRS
        pg8::Gemm g{DFF, DFF, DFF};
        LAS int* tbl = (LAS int*)(lds + EXTRA_OFF + 8192);
        SchedMoe S; S.A = (const char*)HID; S.W = (const char*)Wd_t; S.list = LIST; S.tbl = tbl; S.G = G; S.c = bx; S.NPN = 4; S.w_exp = (size_t)DM * DFF * 2; S.w_tile = (size_t)256 * DFF * 2; S.a_tile = (size_t)256 * DFF * 2; S.ocol_w = 256;
        pg8::EpiBf16 E{YB, DM, nullptr, 0, 1.f, 1.f, nullptr};
        pg8::gemm_phase<pg8::EpiBf16, SchedMoe, true, false>(lds + RING_OFF, g, S, E);
    }
    xcd_barrier(bar);
    if (PROBE_HI == 9) t_pb = __builtin_amdgcn_s_memrealtime();

    if (PROBE_LO == 10) t_pa = __builtin_amdgcn_s_memrealtime();
    if (PH(10))
    {
        PHASE_PTRS
        const LAS int* tb = (const LAS int*)(lds + EXTRA_OFF + 8192);
        const f32x4* gp = (const f32x4*)ARGP(norm_final) + lane;
        int sl0 = 0, sl1 = 0; float sw0 = 0.f, sw1 = 0.f;
        u32x2 ya_n[4], yb_n[4], hh_n[4]; float w0_n = 0.f, w1_n = 0.f;
#define P10_SLOTS(rw) do { sl0 = TOKSLOT[(size_t)(rw) * 2]; sl1 = TOKSLOT[(size_t)(rw) * 2 + 1]; sw0 = TOKW[(size_t)(rw) * 2]; sw1 = TOKW[(size_t)(rw) * 2 + 1]; } while (0)
#define P10_DATA(rw) do { const int r0_ = tb[sl0 >> 20] * 256 + (sl0 & 0xfffff), r1_ = tb[sl1 >> 20] * 256 + (sl1 & 0xfffff); w0_n = sw0; w1_n = sw1; \
        const u32x2* y0_ = (const u32x2*)(YB + (size_t)r0_ * DM) + lane; const u32x2* y1_ = (const u32x2*)(YB + (size_t)r1_ * DM) + lane; const u32x2* h_ = (const u32x2*)(H1B + (size_t)(rw) * DM) + lane; \
        _Pragma("unroll") for (int j = 0; j < 4; ++j) { ya_n[j] = y0_[64 * j]; yb_n[j] = y1_[64 * j]; hh_n[j] = h_[64 * j]; } } while (0)
        if (gw < M) { P10_SLOTS(gw); P10_DATA(gw); if (gw + NGW < M) P10_SLOTS(gw + NGW); }
        for (int row = gw; row < M; row += NGW) {
            u32x2 ya[4], yb[4], hh[4]; const float w0 = w0_n, w1 = w1_n;
#pragma unroll
            for (int j = 0; j < 4; ++j) { ya[j] = ya_n[j]; yb[j] = yb_n[j]; hh[j] = hh_n[j]; }
            if (row + NGW < M) { P10_DATA(row + NGW); if (row + 2 * NGW < M) P10_SLOTS(row + 2 * NGW); }
            f32x4* hr = (f32x4*)(out + (size_t)row * DM) + lane;
            f32x4 v[4]; float s = 0.f;
#pragma unroll
            for (int j = 0; j < 4; ++j) { const u32x2 a = ya[j], b = yb[j]; const u32x2 hx = hh[j]; f32x4 h = {bf16lo(hx.x), bf16hi(hx.x), bf16lo(hx.y), bf16hi(hx.y)};
                h[0] += w0 * bf16lo(a.x) + w1 * bf16lo(b.x); h[1] += w0 * bf16hi(a.x) + w1 * bf16hi(b.x); h[2] += w0 * bf16lo(a.y) + w1 * bf16lo(b.y); h[3] += w0 * bf16hi(a.y) + w1 * bf16hi(b.y);
                v[j] = h; s += (h[0] * h[0] + h[1] * h[1]) + (h[2] * h[2] + h[3] * h[3]); }
            const float rinv = rsqrtf(wave_sum(s) * (1.0f / DM) + EPS);
#pragma unroll
            for (int j = 0; j < 4; ++j) hr[64 * j] = v[j] * rinv * gp[64 * j];
        }
#undef P10_SLOTS
#undef P10_DATA
    }
    if (PROBE_LO >= 0) {
        if (PROBE_HI == 10) t_pb = __builtin_amdgcn_s_memrealtime();
        if (blockIdx.x == 0 && threadIdx.x == 0) { const unsigned long long t0 = __builtin_amdgcn_s_memrealtime(), span = 2 * (t_pb - t_pa);
            while (__builtin_amdgcn_s_memrealtime() - t0 < span) __builtin_amdgcn_s_sleep(8); }
    }
}

extern "C" void kernel_launch(void* const* d_in, const int* in_sizes, int n_in, void* d_out, int out_size, void* d_ws, size_t ws_size, hipStream_t stream) {
    static int grid = 0;
    if (grid == 0) {
        if (n_in != 22 || in_sizes[0] != M * DM || out_size != M * DM || ws_size < WS_END) { fprintf(stderr, "kernel_launch: unexpected shapes (n_in %d, in0 %d, out %d, ws %zu)\n", n_in, n_in > 0 ? in_sizes[0] : -1, out_size, ws_size); grid = -1; return; }
        int dev = 0, cus = 0, per_cu = 0;
        if (hipGetDevice(&dev) != hipSuccess || hipDeviceGetAttribute(&cus, hipDeviceAttributeMultiprocessorCount, dev) != hipSuccess) { grid = -1; return; }
        if (hipFuncSetAttribute((const void*)hymba_fwd, hipFuncAttributeMaxDynamicSharedMemorySize, LDS_BYTES) != hipSuccess) { fprintf(stderr, "kernel_launch: hipFuncSetAttribute failed\n"); grid = -1; return; }
        if (hipOccupancyMaxActiveBlocksPerMultiprocessor(&per_cu, (const void*)hymba_fwd, NWAVES * 64, LDS_BYTES) != hipSuccess || per_cu < 1) { fprintf(stderr, "kernel_launch: occupancy query reports %d\n", per_cu); }
        (void)hipGetLastError();
        grid = cus;
    }
    if (grid < 0) return;
    (void)hipMemsetAsync((char*)d_ws + WS_CTL, 0, CTL_ZERO_BYTES, stream);
    Args a{};
    const float** p = (const float**)&a;
    for (int i = 0; i < 22; ++i) p[i] = (const float*)d_in[i];
    a.out = (float*)d_out; a.ws = (unsigned char*)d_ws;
    hipLaunchKernelGGL(hymba_fwd, dim3(grid), dim3(NWAVES * 64), LDS_BYTES, stream, a);
}
```

```cpp
#include <hip/hip_runtime.h>
#include <hip/hip_bf16.h>
#include <cstdio>
#include <cstdint>

#define LAS __attribute__((address_space(3)))
#define GAS __attribute__((address_space(1)))
typedef unsigned short bf16_t;
typedef short bf16x8 __attribute__((ext_vector_type(8)));
typedef short s16x4 __attribute__((ext_vector_type(4)));
typedef float f32x4 __attribute__((ext_vector_type(4)));
typedef float f32x2 __attribute__((ext_vector_type(2)));
typedef float f32x16 __attribute__((ext_vector_type(16)));
typedef unsigned u32x4 __attribute__((ext_vector_type(4)));
typedef unsigned u32x2 __attribute__((ext_vector_type(2)));
typedef __bf16 bf16x2_t __attribute__((ext_vector_type(2)));

constexpr int BATCH = 8, SEQ = 8192, DM = 1024, M = BATCH * SEQ;
constexpr int NH = 8, HD = 64, HW = NH * HD;
constexpr int NPROJ = 3 * HW * 2;
constexpr int WIN_LD = NPROJ + NH;
constexpr int NMEM = 256, XH = 4, XD = 256, MEMROWS = BATCH * NMEM;
constexpr int NEXP = 16, DFF = 256;
constexpr float EPS = 1e-6f;
constexpr float LOG2E = 1.4426950408889634f;
constexpr float C2 = 0.125f * LOG2E;
constexpr float XSC = 0.0625f * LOG2E;
constexpr float SB_EXIT = -48.0f;

constexpr size_t MiB = 1u << 20;
constexpr size_t WS_CTL = 0, CTL_ZERO_BYTES = 128 * 1024;
constexpr size_t WS_WIN = 1 * MiB;
constexpr size_t WS_WOUT = 7 * MiB;
constexpr size_t WS_WXQ = 9 * MiB;
constexpr size_t WS_WXKV = 11 * MiB;
constexpr size_t WS_WXO = 15 * MiB;
constexpr size_t WS_WGU = 17 * MiB;
constexpr size_t WS_WD = 33 * MiB;
constexpr size_t WS_RX = 41 * MiB;
constexpr size_t WS_RMEM = WS_RX + 256 * 1024;
constexpr size_t WS_R2 = WS_RX + 512 * 1024;
constexpr size_t WS_LF = 42 * MiB;
constexpr size_t WS_C2 = 44 * MiB;
constexpr size_t WS_SSQ = 46 * MiB;
constexpr size_t WS_TOKSLOT = 50 * MiB;
constexpr size_t WS_TOKW = 51 * MiB;
constexpr size_t WS_LIST = 52 * MiB;
constexpr size_t WS_MEMB = 56 * MiB;
constexpr size_t WS_KVM = 60 * MiB;
constexpr size_t WS_GT = 68 * MiB;
constexpr size_t WS_HT = 84 * MiB;
constexpr size_t WS_KX = 100 * MiB;
constexpr size_t WS_HS = 108 * MiB;
constexpr size_t WS_XB = 128 * MiB;
constexpr size_t WS_QKV = 256 * MiB;
constexpr size_t WS_H1B = 256 * MiB, WS_U2B = 384 * MiB, WS_HID = 512 * MiB;
constexpr size_t WS_O = 640 * MiB;
constexpr size_t WS_Y = 704 * MiB;
constexpr size_t WS_END = 1024 * MiB;
constexpr size_t QKV_STRIDE = (size_t)M * HW;
constexpr int MAXTILES = M * 2 / 256 + NEXP;
static_assert(WS_Y + (size_t)MAXTILES * 256 * 1024 * 2 <= WS_END, "ws map");
static_assert(WS_HID + (size_t)MAXTILES * 256 * 256 * 2 <= WS_O, "ws map");
constexpr int CW_BAR = 4096;
constexpr int CW_SBQ = 20736;
constexpr int CW_KN = 20480;
constexpr int CW_CNT = 16384;

constexpr int RING_OFF = 0, RING_BYTES = 131072;
constexpr int EXTRA_OFF = 131072, EXTRA_BYTES = 16384;
constexpr int MISC_OFF = EXTRA_OFF + EXTRA_BYTES;
constexpr int LDS_BYTES = MISC_OFF + 1024;
constexpr int NWAVES = 8;
#ifndef PHASE_MASK
#define PHASE_MASK 0x7ff
#endif
#define PH(n) ((PHASE_MASK >> (n)) & 1)
#ifndef PROBE_LO
#define PROBE_LO -1
#endif
#ifndef PROBE_HI
#define PROBE_HI -1
#endif
#ifndef FOX_V2
#define FOX_V2 1
#endif
#ifndef REP_MASK
#define REP_MASK 0
#endif
#define REPS(n) (1 + ((REP_MASK >> (n)) & 1))
#ifndef REP_FOX
#define REP_FOX 1
#endif
#ifndef REP_SB
#define REP_SB 1
#endif

__device__ __forceinline__ unsigned cvt_pk_bf16(float lo, float hi) { f32x2 v = {lo, hi}; bf16x2_t b = __builtin_convertvector(v, bf16x2_t); return __builtin_bit_cast(unsigned, b); }
__device__ __forceinline__ float bf16lo(unsigned u) { return __uint_as_float(u << 16); }
__device__ __forceinline__ float bf16hi(unsigned u) { return __uint_as_float(u & 0xffff0000u); }
#define DPP_ADD(v, CTRL) v += __builtin_bit_cast(float, __builtin_amdgcn_update_dpp(0, __builtin_bit_cast(int, v), CTRL, 0xf, 0xf, true))
__device__ __forceinline__ float wave_sum(float v) {
    DPP_ADD(v, 0xB1); DPP_ADD(v, 0x4E); DPP_ADD(v, 0x141); DPP_ADD(v, 0x140);
    const int iv = __builtin_bit_cast(int, v);
    return (__builtin_bit_cast(float, __builtin_amdgcn_readlane(iv, 0)) + __builtin_bit_cast(float, __builtin_amdgcn_readlane(iv, 16))) +
           (__builtin_bit_cast(float, __builtin_amdgcn_readlane(iv, 32)) + __builtin_bit_cast(float, __builtin_amdgcn_readlane(iv, 48)));
}
#define LDS_WAIT() asm volatile("s_waitcnt lgkmcnt(0)" ::: "memory")
#define VM_WAIT() asm volatile("s_waitcnt vmcnt(0)" ::: "memory")

namespace pg8 {
constexpr int BM = 256, BK = 64, HALF = 128, HTB = HALF * BK * 2, STAGE_BYTES = 8 * HTB, NXCD = 8, WGM = 8;
__host__ __device__ __forceinline__ int lds_byte(int r, int c) { const int st = (r >> 4) * 2 + (c >> 5), rr = r & 15, cc = c & 31, ob = rr * 64 + cc * 2; return st * 1024 + (ob ^ (((ob >> 9) & 1) << 5)); }
__host__ __device__ __forceinline__ void stage_rc(int b, int& R, int& C) { const int st = b / 1024, sb = b % 1024, swz = sb ^ (((sb >> 9) & 1) << 5); R = (st >> 1) * 16 + swz / 64; C = (st & 1) * 32 + (swz % 64) / 2; }
__host__ __device__ __forceinline__ int perm32(int rho) { const int n = rho >> 4, i = rho & 15; return 8 * (i >> 2) + 4 * n + (i & 3); }

struct Unit { const char* a; const char* b; int orow, ocol, aux; const int* rows; int nvalid; };
struct Gemm { int lda, ldb, K; };

__device__ __forceinline__ bool tile_order(int i, int G, int c, int nM, int nN, int& pm, int& pn) {
    const int nwg = nM * nN; const long L = (long)i * G + c; if (L >= nwg) return false;
    int wgid = (int)L; { const int q = nwg / NXCD, r = nwg % NXCD, xcd = wgid % NXCD, off = wgid / NXCD; wgid = (xcd < r ? xcd * (q + 1) : r * (q + 1) + (xcd - r) * q) + off; }
    const int nig = WGM * nN, gid = wgid / nig, fm = gid * WGM, gsz = (nM - fm) < WGM ? (nM - fm) : WGM;
    pm = fm + ((wgid % nig) % gsz); pn = (wgid % nig) / gsz; return true;
}

template <class Epi, class Sched, bool ALIGN_EPI, bool GATHER>
__device__ __forceinline__ void gemm_phase(LAS unsigned char* lds, const Gemm g, const Sched& S, const Epi& E) {
    int tid = threadIdx.x; asm volatile("" : "+v"(tid));
    const int wid = __builtin_amdgcn_readfirstlane(tid >> 6), lane = tid & 63, wr = wid >> 2, wc = wid & 3, fr = lane & 15, fq = lane >> 4;
    const int K = g.K, nt = K / BK;
    unsigned voffA[2], voffB[2]; int RA[2], CA[2];
#pragma unroll
    for (int i = 0; i < 2; ++i) { int R, C; stage_rc(tid * 16 + i * 8192, R, C); const int Rb = (R & ~31) + perm32(R & 31);
        RA[i] = R; CA[i] = C; voffA[i] = (unsigned)(R * g.lda + C) * 2u; voffB[i] = (unsigned)(Rb * g.ldb + C) * 2u; }
    const size_t kstep = (size_t)(BK * 2);
    const size_t hstepA = (size_t)HALF * g.lda * 2, hstepB = (size_t)HALF * g.ldb * 2;
    const unsigned ldsw = (unsigned)wid * 1024u;
    const int aoff = lds_byte(wr * 64 + fr, fq * 8), boff = lds_byte(wc * 32 + fr, fq * 8);
#define PG8_SA(b, h) (((b) * 2 + (h)) * HTB)
#define PG8_SB(b, h) ((4 + (b) * 2 + (h)) * HTB)
#define PG8_STAGE2(bufoff, gbase, v0, v1) do { \
        __builtin_amdgcn_global_load_lds((const unsigned*)((const char*)(gbase) + (v0)), (LAS unsigned*)(lds + (bufoff) + ldsw), 16, 0, 0); \
        __builtin_amdgcn_global_load_lds((const unsigned*)((const char*)(gbase) + (v1)), (LAS unsigned*)(lds + (bufoff) + ldsw + 8192), 16, 0, 0); } while (0)
#define PG8_STAGEB(bufoff, gbase) PG8_STAGE2(bufoff, gbase, voffB[0], voffB[1])
#define PG8_STAGEA(bufoff, kptr, h, NX) do { if constexpr (GATHER) { const unsigned v0_ = (NX) ? gvn[h][0] : gvc[h][0], v1_ = (NX) ? gvn[h][1] : gvc[h][1]; PG8_STAGE2(bufoff, kptr, v0_, v1_); } \
        else { PG8_STAGE2(bufoff, (kptr) + (h) * hstepA, voffA[0], voffA[1]); } } while (0)
#define PG8_LDA(dst, b, h) do { _Pragma("unroll") for (int m = 0; m < 4; ++m) _Pragma("unroll") for (int k = 0; k < 2; ++k) dst[m][k] = *(const LAS bf16x8*)(lds + PG8_SA(b, h) + aoff + m * 2048 + k * 1024); } while (0)
#define PG8_LDB(dst, b, h) do { _Pragma("unroll") for (int n = 0; n < 2; ++n) _Pragma("unroll") for (int k = 0; k < 2; ++k) dst[n][k] = *(const LAS bf16x8*)(lds + PG8_SB(b, h) + boff + n * 2048 + k * 1024); } while (0)
#define PG8_MMA(ai, bj, At, Bt) do { __builtin_amdgcn_s_setprio(1); _Pragma("unroll") for (int m = 0; m < 4; ++m) _Pragma("unroll") for (int n = 0; n < 2; ++n) _Pragma("unroll") for (int k = 0; k < 2; ++k) \
        acc[ai][bj][m][n] = __builtin_amdgcn_mfma_f32_16x16x32_bf16(Bt[n][k], At[m][k], acc[ai][bj][m][n], 0, 0, 0); __builtin_amdgcn_s_setprio(0); } while (0)
#define PG8_WAIT_V(n) asm volatile("s_waitcnt vmcnt(" #n ")" ::: "memory")
#define PG8_WAIT_L(n) asm volatile("s_waitcnt lgkmcnt(" #n ")" ::: "memory")
#define PG8_BAR __builtin_amdgcn_s_barrier()
#define PG8_SCHED __builtin_amdgcn_sched_barrier(0)
#define PG8_GATHER_OFFS(dst, u) do { _Pragma("unroll") for (int h_ = 0; h_ < 2; ++h_) _Pragma("unroll") for (int i_ = 0; i_ < 2; ++i_) { const int r_ = h_ * HALF + RA[i_]; \
        const int idx_ = (u).rows[r_ < (u).nvalid ? r_ : 0]; dst[h_][i_] = (unsigned)(idx_ * g.lda + CA[i_]) * 2u; } } while (0)
    Unit cur, nxt; int ui = 0;
    if (!S.next(0, cur)) return;
    unsigned gvc[2][2] = {{0u, 0u}, {0u, 0u}}, gvn[2][2] = {{0u, 0u}, {0u, 0u}};
    if constexpr (GATHER) { PG8_GATHER_OFFS(gvc, cur); }
    f32x4 acc[2][2][4][2];
#pragma unroll
    for (int a = 0; a < 2; ++a)
#pragma unroll
        for (int b = 0; b < 2; ++b)
#pragma unroll
            for (int m = 0; m < 4; ++m)
#pragma unroll
                for (int n = 0; n < 2; ++n) acc[a][b][m][n] = (f32x4){0.f, 0.f, 0.f, 0.f};
    bf16x8 At[4][2], B0[2][2], B1[2][2];
    const char* cA = cur.a; const char* cB = cur.b;
    PG8_STAGEB(PG8_SB(0, 0), cB); PG8_STAGEB(PG8_SB(0, 1), cB + hstepB); PG8_STAGEA(PG8_SA(0, 0), cA, 0, false); PG8_STAGEA(PG8_SA(0, 1), cA, 1, false);
    if (wr == 1) PG8_BAR;
    PG8_WAIT_V(2); PG8_BAR;
    PG8_STAGEB(PG8_SB(1, 0), cB + kstep); PG8_STAGEA(PG8_SA(1, 0), cA + kstep, 0, false); PG8_STAGEB(PG8_SB(1, 1), cB + hstepB + kstep);
    PG8_WAIT_V(6); PG8_BAR;
    for (;;) {
        const bool has_next = S.next(ui + 1, nxt);
        const char* nA = has_next ? nxt.a : cA; const char* nB = has_next ? nxt.b : cB;
        if constexpr (GATHER) { if (has_next) { PG8_GATHER_OFFS(gvn, nxt); } else { gvn[0][0] = gvc[0][0]; gvn[0][1] = gvc[0][1]; gvn[1][0] = gvc[1][0]; gvn[1][1] = gvc[1][1]; } }
#pragma unroll 1
        for (int t = 0; t < nt; t += 2) {
            const bool last = (t == nt - 2);
            const char* a1 = cA + (size_t)(t + 1) * kstep;
            const char* a2 = last ? nA : cA + (size_t)(t + 2) * kstep; const char* b2 = last ? nB : cB + (size_t)(t + 2) * kstep;
            const char* a3 = a2 + kstep; const char* b3 = b2 + kstep;
            PG8_LDB(B0, 0, 0); PG8_LDB(B1, 0, 1); PG8_SCHED; PG8_LDA(At, 0, 0); PG8_STAGEA(PG8_SA(1, 1), a1, 1, false);
            PG8_WAIT_V(8); PG8_WAIT_L(0); PG8_BAR; PG8_MMA(0, 0, At, B0); PG8_MMA(0, 1, At, B1); PG8_BAR; PG8_SCHED;
            PG8_LDA(At, 0, 1); PG8_STAGEB(PG8_SB(0, 0), b2); PG8_STAGEB(PG8_SB(0, 1), b2 + hstepB); PG8_STAGEA(PG8_SA(0, 0), a2, 0, last);
            PG8_WAIT_V(8); PG8_WAIT_L(0); PG8_BAR; PG8_MMA(1, 0, At, B0); PG8_MMA(1, 1, At, B1); PG8_BAR; PG8_SCHED;
            PG8_LDB(B0, 1, 0); PG8_LDB(B1, 1, 1); PG8_SCHED; PG8_LDA(At, 1, 0); PG8_STAGEA(PG8_SA(0, 1), a2, 1, last);
            PG8_WAIT_V(8); PG8_WAIT_L(0); PG8_BAR; PG8_MMA(0, 0, At, B0); PG8_MMA(0, 1, At, B1); PG8_BAR; PG8_SCHED;
            PG8_LDA(At, 1, 1); PG8_STAGEB(PG8_SB(1, 0), b3); PG8_STAGEB(PG8_SB(1, 1), b3 + hstepB); PG8_STAGEA(PG8_SA(1, 0), a3, 0, last);
            PG8_WAIT_V(8); PG8_WAIT_L(0); PG8_BAR; PG8_MMA(1, 0, At, B0); PG8_MMA(1, 1, At, B1); PG8_BAR; PG8_SCHED;
            if constexpr (Epi::HAS_MID) { if (t == (nt >> 1) - 2) { int fr3 = fr, fq3 = fq; asm volatile("" : "+v"(fr3), "+v"(fq3)); E.mid(acc, cur, wr, wc, fr3, fq3); } }
        }
        if constexpr (ALIGN_EPI) { if (wr == 0) PG8_BAR; }
        { int fr2 = fr, fq2 = fq; asm volatile("" : "+v"(fr2), "+v"(fq2));
          E(acc, cur, wr, wc, fr2, fq2); }
        if (!has_next) break;
#pragma unroll
        for (int a = 0; a < 2; ++a)
#pragma unroll
            for (int b = 0; b < 2; ++b)
#pragma unroll
                for (int m = 0; m < 4; ++m)
#pragma unroll
                    for (int n = 0; n < 2; ++n) acc[a][b][m][n] = (f32x4){0.f, 0.f, 0.f, 0.f};
        cur = nxt; cA = nA; cB = nB; ++ui;
        if constexpr (GATHER) { gvc[0][0] = gvn[0][0]; gvc[0][1] = gvn[0][1]; gvc[1][0] = gvn[1][0]; gvc[1][1] = gvn[1][1]; }
        if constexpr (ALIGN_EPI) { if (wr == 1) PG8_BAR; }
    }
    PG8_WAIT_V(0);
    if constexpr (!ALIGN_EPI) { if (wr == 0) PG8_BAR; }
    PG8_BAR;
#undef PG8_SA
#undef PG8_SB
#undef PG8_STAGE2
#undef PG8_STAGEA
#undef PG8_STAGEB
#undef PG8_LDA
#undef PG8_LDB
#undef PG8_MMA
#undef PG8_WAIT_V
#undef PG8_WAIT_L
#undef PG8_BAR
#undef PG8_SCHED
#undef PG8_GATHER_OFFS
}

#define EPI_ROW(u, ai, m) ((u).orow + (ai) * HALF + wr * 64 + (m) * 16 + fr)
#define EPI_COL(u, bj) ((u).ocol + (bj) * HALF + wc * 32 + 8 * fq)
struct EpiBf16 {
    static constexpr bool HAS_MID = false;
    bf16_t* O; int ldc; const float* rs; size_t stride; float sc0, sc3;
    unsigned* kn;
    __device__ __forceinline__ void operator()(const f32x4 (&acc)[2][2][4][2], const Unit& u, int wr, int wc, int fr, int fq) const {
        bf16_t* base = O + (size_t)u.aux * stride;
        const float sc = (u.aux == 0) ? sc0 : ((u.aux == 3) ? sc3 : 1.f);
        float nmax[2] = {0.f, 0.f}; const bool dokn = kn && u.aux == 1;
#pragma unroll
        for (int ai = 0; ai < 2; ++ai)
#pragma unroll
            for (int m = 0; m < 4; ++m) { const int row = EPI_ROW(u, ai, m); const float s = (rs ? rs[row] : 1.f) * sc;
#pragma unroll
                for (int bj = 0; bj < 2; ++bj) { const f32x4 v0 = acc[ai][bj][m][0] * s, v1 = acc[ai][bj][m][1] * s;
                    u32x4 w; w.x = cvt_pk_bf16(v0[0], v0[1]); w.y = cvt_pk_bf16(v0[2], v0[3]); w.z = cvt_pk_bf16(v1[0], v1[1]); w.w = cvt_pk_bf16(v1[2], v1[3]);
                    *(u32x4*)(base + (size_t)row * ldc + EPI_COL(u, bj)) = w;
                    if (dokn) { float q = (v0[0] * v0[0] + v0[1] * v0[1]) + (v0[2] * v0[2] + v0[3] * v0[3]) + (v1[0] * v1[0] + v1[1] * v1[1]) + (v1[2] * v1[2] + v1[3] * v1[3]);
                        q += __shfl_xor(q, 16); q += __shfl_xor(q, 32); nmax[bj] = fmaxf(nmax[bj], q); } } }
        if (dokn) {
#pragma unroll
            for (int bj = 0; bj < 2; ++bj) { float q = nmax[bj]; q = fmaxf(q, __shfl_xor(q, 1)); q = fmaxf(q, __shfl_xor(q, 2)); q = fmaxf(q, __shfl_xor(q, 4)); q = fmaxf(q, __shfl_xor(q, 8));
                const int head = ((u.ocol + bj * HALF) >> 6) + (wc >> 1), bt = u.orow / SEQ;
                if ((fr | fq) == 0) atomicMax(kn + ((bt * NH + head) * 2 + (wc & 1)), __float_as_uint(q)); }
        }
    }
};
struct EpiResid {
    static constexpr bool HAS_MID = false;
    const float* res; float* out; bf16_t* hb; float* ssq;
    __device__ __forceinline__ void operator()(const f32x4 (&acc)[2][2][4][2], const Unit& u, int wr, int wc, int fr, int fq) const {
#pragma unroll
        for (int ai = 0; ai < 2; ++ai)
#pragma unroll
            for (int m = 0; m < 4; ++m) { const int row = EPI_ROW(u, ai, m); float q = 0.f;
#pragma unroll
                for (int bj = 0; bj < 2; ++bj) { const size_t off = (size_t)row * DM + EPI_COL(u, bj);
                    const f32x4 r0 = *(const f32x4*)(res + off), r1 = *(const f32x4*)(res + off + 4);
                    const f32x4 v0 = acc[ai][bj][m][0] + r0, v1 = acc[ai][bj][m][1] + r1;
                    *(f32x4*)(out + off) = v0; *(f32x4*)(out + off + 4) = v1;
                    q += (v0[0] * v0[0] + v0[1] * v0[1]) + (v0[2] * v0[2] + v0[3] * v0[3]) + (v1[0] * v1[0] + v1[1] * v1[1]) + (v1[2] * v1[2] + v1[3] * v1[3]);
                    if (hb) { u32x4 w; w.x = cvt_pk_bf16(v0[0], v0[1]); w.y = cvt_pk_bf16(v0[2], v0[3]); w.z = cvt_pk_bf16(v1[0], v1[1]); w.w = cvt_pk_bf16(v1[2], v1[3]); *(u32x4*)(hb + off) = w; } }
                if (ssq) { q += __shfl_xor(q, 16); q += __shfl_xor(q, 32); if (fq == 0) ssq[(size_t)row * 16 + (u.ocol >> 8) * 4 + wc] = q; } }
    }
};
struct EpiOutProj {
    static constexpr bool HAS_MID = true;
    const bf16_t* xb; bf16_t* hb; float* ssq; const float* hs;
    __device__ __forceinline__ void scales(int row, float& ra, float& rb) const {
        const f32x4* p = (const f32x4*)(hs + (size_t)row * 16); const f32x4 a0 = p[0], a1 = p[1], b0 = p[2], b1 = p[3];
        ra = rsqrtf((((a0[0] + a0[1]) + (a0[2] + a0[3])) + ((a1[0] + a1[1]) + (a1[2] + a1[3]))) * (1.0f / HW) + EPS);
        rb = rsqrtf((((b0[0] + b0[1]) + (b0[2] + b0[3])) + ((b1[0] + b1[1]) + (b1[2] + b1[3]))) * (1.0f / HW) + EPS);
    }
    __device__ __forceinline__ void mid(f32x4 (&acc)[2][2][4][2], const Unit& u, int wr, int wc, int fr, int fq) const {
#pragma unroll
        for (int ai = 0; ai < 2; ++ai)
#pragma unroll
            for (int m = 0; m < 4; ++m) { float ra, rb; scales(EPI_ROW(u, ai, m), ra, rb); const float f = ra / rb;
#pragma unroll
                for (int bj = 0; bj < 2; ++bj) { acc[ai][bj][m][0] *= f; acc[ai][bj][m][1] *= f; } }
    }
    __device__ __forceinline__ void operator()(const f32x4 (&acc)[2][2][4][2], const Unit& u, int wr, int wc, int fr, int fq) const {
#pragma unroll
        for (int ai = 0; ai < 2; ++ai)
#pragma unroll
            for (int m = 0; m < 4; ++m) { const int row = EPI_ROW(u, ai, m); float ra, rb; scales(row, ra, rb); float q = 0.f;
#pragma unroll
                for (int bj = 0; bj < 2; ++bj) { const size_t off = (size_t)row * DM + EPI_COL(u, bj);
                    const u32x4 xr = *(const u32x4*)(xb + off);
                    f32x4 v0 = acc[ai][bj][m][0] * rb, v1 = acc[ai][bj][m][1] * rb;
                    v0[0] += bf16lo(xr.x); v0[1] += bf16hi(xr.x); v0[2] += bf16lo(xr.y); v0[3] += bf16hi(xr.y); v1[0] += bf16lo(xr.z); v1[1] += bf16hi(xr.z); v1[2] += bf16lo(xr.w); v1[3] += bf16hi(xr.w);
                    q += (v0[0] * v0[0] + v0[1] * v0[1]) + (v0[2] * v0[2] + v0[3] * v0[3]) + (v1[0] * v1[0] + v1[1] * v1[1]) + (v1[2] * v1[2] + v1[3] * v1[3]);
                    u32x4 w; w.x = cvt_pk_bf16(v0[0], v0[1]); w.y = cvt_pk_bf16(v0[2], v0[3]); w.z = cvt_pk_bf16(v1[0], v1[1]); w.w = cvt_pk_bf16(v1[2], v1[3]); *(u32x4*)(hb + off) = w; }
                q += __shfl_xor(q, 16); q += __shfl_xor(q, 32); if (fq == 0) ssq[(size_t)row * 16 + (u.ocol >> 8) * 4 + wc] = q; }
    }
};
struct EpiResidBf16 {
    static constexpr bool HAS_MID = false;
    bf16_t* hb;
    __device__ __forceinline__ void operator()(const f32x4 (&acc)[2][2][4][2], const Unit& u, int wr, int wc, int fr, int fq) const {
#pragma unroll
        for (int ai = 0; ai < 2; ++ai)
#pragma unroll
            for (int m = 0; m < 4; ++m) { const int row = EPI_ROW(u, ai, m);
#pragma unroll
                for (int bj = 0; bj < 2; ++bj) { const size_t off = (size_t)row * DM + EPI_COL(u, bj);
                    const u32x4 xr = *(const u32x4*)(hb + off);
                    f32x4 v0 = acc[ai][bj][m][0], v1 = acc[ai][bj][m][1];
                    v0[0] += bf16lo(xr.x); v0[1] += bf16hi(xr.x); v0[2] += bf16lo(xr.y); v0[3] += bf16hi(xr.y); v1[0] += bf16lo(xr.z); v1[1] += bf16hi(xr.z); v1[2] += bf16lo(xr.w); v1[3] += bf16hi(xr.w);
                    u32x4 w; w.x = cvt_pk_bf16(v0[0], v0[1]); w.y = cvt_pk_bf16(v0[2], v0[3]); w.z = cvt_pk_bf16(v1[0], v1[1]); w.w = cvt_pk_bf16(v1[2], v1[3]); *(u32x4*)(hb + off) = w; } }
    }
};
struct EpiSoftmax {
    static constexpr bool HAS_MID = false;
    bf16_t* P; const float* ssq; LAS float* red;
    __device__ __forceinline__ void operator()(f32x4 (&acc)[2][2][4][2], const Unit& u, int wr, int wc, int fr, int fq) const {
#pragma unroll
        for (int ai = 0; ai < 2; ++ai)
#pragma unroll
            for (int m = 0; m < 4; ++m) { const int row = EPI_ROW(u, ai, m); const f32x4* sp = (const f32x4*)(ssq + (size_t)row * 16);
                const f32x4 s0 = sp[0], s1 = sp[1], s2 = sp[2], s3 = sp[3];
                const float tot = ((s0[0] + s0[1]) + (s0[2] + s0[3])) + ((s1[0] + s1[1]) + (s1[2] + s1[3])) + ((s2[0] + s2[1]) + (s2[2] + s2[3])) + ((s3[0] + s3[1]) + (s3[2] + s3[3]));
                const float r1 = rsqrtf(tot * (1.0f / DM) + EPS) * XSC; float a = -3.0e38f;
#pragma unroll
                for (int bj = 0; bj < 2; ++bj)
#pragma unroll
                    for (int n = 0; n < 2; ++n) { f32x4 v = acc[ai][bj][m][n] * r1; acc[ai][bj][m][n] = v; a = fmaxf(a, fmaxf(fmaxf(v[0], v[1]), fmaxf(v[2], v[3]))); }
                a = fmaxf(a, __shfl_xor(a, 16)); a = fmaxf(a, __shfl_xor(a, 32));
                if (fq == 0) red[(ai * HALF + wr * 64 + m * 16 + fr) * 4 + wc] = a; asm volatile("" ::: "memory"); }
        LDS_WAIT(); __builtin_amdgcn_s_barrier(); asm volatile("" ::: "memory");
#pragma unroll
        for (int ai = 0; ai < 2; ++ai)
#pragma unroll
            for (int m = 0; m < 4; ++m) { const int rl = ai * HALF + wr * 64 + m * 16 + fr; const f32x4 mm = *(const LAS f32x4*)(red + rl * 4);
                const float a = fmaxf(fmaxf(mm[0], mm[1]), fmaxf(mm[2], mm[3])); float s = 0.f;
#pragma unroll
                for (int bj = 0; bj < 2; ++bj)
#pragma unroll
                    for (int n = 0; n < 2; ++n) { f32x4 v = acc[ai][bj][m][n];
                        v[0] = __builtin_amdgcn_exp2f(v[0] - a); v[1] = __builtin_amdgcn_exp2f(v[1] - a); v[2] = __builtin_amdgcn_exp2f(v[2] - a); v[3] = __builtin_amdgcn_exp2f(v[3] - a);
                        acc[ai][bj][m][n] = v; s += (v[0] + v[1]) + (v[2] + v[3]); }
                s += __shfl_xor(s, 16); s += __shfl_xor(s, 32);
                if (fq == 0) red[1024 + rl * 4 + wc] = s; }
        LDS_WAIT(); __builtin_amdgcn_s_barrier(); asm volatile("" ::: "memory");
#pragma unroll
        for (int ai = 0; ai < 2; ++ai)
#pragma unroll
            for (int m = 0; m < 4; ++m) { const int rl = ai * HALF + wr * 64 + m * 16 + fr; const int row = u.orow + rl; const f32x4 ss = *(const LAS f32x4*)(red + 1024 + rl * 4);
                const float inv = 1.0f / ((ss[0] + ss[1]) + (ss[2] + ss[3]));
#pragma unroll
                for (int bj = 0; bj < 2; ++bj) { const f32x4 v0 = acc[ai][bj][m][0] * inv, v1 = acc[ai][bj][m][1] * inv;
                    u32x4 w; w.x = cvt_pk_bf16(v0[0], v0[1]); w.y = cvt_pk_bf16(v0[2], v0[3]); w.z = cvt_pk_bf16(v1[0], v1[1]); w.w = cvt_pk_bf16(v1[2], v1[3]);
                    *(u32x4*)(P + (size_t)row * DM + EPI_COL(u, bj)) = w; } }
    }
};
struct EpiSwiglu {
    static constexpr bool HAS_MID = false;
    bf16_t* Hd; const float* r2;
    __device__ __forceinline__ void operator()(const f32x4 (&acc)[2][2][4][2], const Unit& u, int wr, int wc, int fr, int fq) const {
#pragma unroll
        for (int ai = 0; ai < 2; ++ai)
#pragma unroll
            for (int m = 0; m < 4; ++m) { const int rl = ai * HALF + wr * 64 + m * 16 + fr, row = u.orow + rl; const float rs = r2[u.rows[rl < u.nvalid ? rl : 0]]; float h[8];
#pragma unroll
                for (int n = 0; n < 2; ++n)
#pragma unroll
                    for (int e = 0; e < 4; ++e) { const float gt = acc[ai][0][m][n][e] * rs, up = acc[ai][1][m][n][e] * rs;
                        h[n * 4 + e] = gt * __builtin_amdgcn_rcpf(1.0f + __builtin_amdgcn_exp2f(-gt * LOG2E)) * up; }
                u32x4 w; w.x = cvt_pk_bf16(h[0], h[1]); w.y = cvt_pk_bf16(h[2], h[3]); w.z = cvt_pk_bf16(h[4], h[5]); w.w = cvt_pk_bf16(h[6], h[7]);
                *(u32x4*)(Hd + (size_t)row * DFF + u.ocol + wc * 32 + 8 * fq) = w; }
    }
};
}

namespace att {
constexpr int QB = 256, KVBLK = 64, PITCH = HW, OPITCH = DM;
constexpr int SLOTB = 8192, LDS_K = 0, LDS_V = 2 * SLOTB, LDS_WS = 4 * SLOTB, LDS_OST = LDS_WS + NWAVES * 256, LDS_FLAG = LDS_OST + NWAVES * 4096, LDS_END = LDS_FLAG + 64;
static_assert(LDS_END <= RING_BYTES, "attention LDS");
__device__ __forceinline__ int crow(int r, int hi) { return (r & 3) + 8 * (r >> 2) + 4 * hi; }
__device__ __forceinline__ void glds16(const void* gsrc, unsigned lds_dst) { unsigned keep;
    asm volatile("s_mov_b32 %0, m0\n\ts_mov_b32 m0, %2\n\ts_nop 0\n\tglobal_load_lds_dwordx4 %1, off\n\ts_mov_b32 m0, %0" : "=&s"(keep) : "v"(gsrc), "s"(lds_dst) : "memory"); }
__device__ __forceinline__ void glds16s(const void* sbase, unsigned voff, unsigned lds_dst) { unsigned keep;
    asm volatile("s_mov_b32 %0, m0\n\ts_mov_b32 m0, %3\n\ts_nop 0\n\tglobal_load_lds_dwordx4 %1, %2\n\ts_mov_b32 m0, %0" : "=&s"(keep) : "v"(voff), "s"(sbase), "s"(lds_dst) : "memory"); }
#define ATT_WAIT_BAR0() asm volatile("s_waitcnt vmcnt(0) lgkmcnt(0)\n\ts_barrier" ::: "memory")
#define MFMA32(a, b, c) __builtin_amdgcn_mfma_f32_32x32x16_bf16(a, b, c, 0, 0, 0)
__device__ __forceinline__ void store_row_ssq(u32x4 v, float* dst, int ch) {
    float q = (bf16lo(v.x) * bf16lo(v.x) + bf16hi(v.x) * bf16hi(v.x)) + (bf16lo(v.y) * bf16lo(v.y) + bf16hi(v.y) * bf16hi(v.y)) + (bf16lo(v.z) * bf16lo(v.z) + bf16hi(v.z) * bf16hi(v.z)) + (bf16lo(v.w) * bf16lo(v.w) + bf16hi(v.w) * bf16hi(v.w));
    q += __shfl_xor(q, 1); q += __shfl_xor(q, 2); q += __shfl_xor(q, 4);
    if (ch == 0) *dst = q;
}
__device__ __forceinline__ void qkt(f32x16& p0, f32x16& p1, const LAS char* Kslot, const bf16x8* qr, const f32x16& cin, int r32, int hi) {
    const LAS char* kb = Kslot + hi * 1024 + r32 * 16;
#pragma unroll
    for (int d0 = 0; d0 < 4; ++d0) {
        const bf16x8 b0 = *(const LAS bf16x8*)(kb + d0 * 2048);
        const bf16x8 b1 = *(const LAS bf16x8*)(kb + d0 * 2048 + 512);
        if (d0 == 0) { p0 = MFMA32(b0, qr[0], cin); p1 = MFMA32(b1, qr[0], cin); }
        else { p0 = MFMA32(b0, qr[d0], p0); p1 = MFMA32(b1, qr[d0], p1); } }
}
__device__ __forceinline__ void pv(f32x16* o, int vb, bf16x8 pa0, bf16x8 pa1, bf16x8 pa2, bf16x8 pa3) {
#pragma unroll
    for (int d0 = 0; d0 < 2; ++d0) { s16x4 lo[4], hi[4];
#pragma unroll
        for (int ks = 0; ks < 4; ++ks) {
            asm volatile("ds_read_b64_tr_b16 %0,%1 offset:%c2" : "=&v"(lo[ks]) : "v"(vb), "i"(d0 * 4096 + ks * 1024) : "memory");
            asm volatile("ds_read_b64_tr_b16 %0,%1 offset:%c2" : "=&v"(hi[ks]) : "v"(vb), "i"(d0 * 4096 + ks * 1024 + 512) : "memory"); }
        asm volatile("s_waitcnt lgkmcnt(0)" ::: "memory"); __builtin_amdgcn_sched_barrier(0);
#define PK(k) (bf16x8){lo[k][0], lo[k][1], lo[k][2], lo[k][3], hi[k][0], hi[k][1], hi[k][2], hi[k][3]}
        o[d0] = MFMA32(pa0, PK(0), o[d0]); o[d0] = MFMA32(pa1, PK(1), o[d0]); o[d0] = MFMA32(pa2, PK(2), o[d0]); o[d0] = MFMA32(pa3, PK(3), o[d0]);
#undef PK
    }
}
__device__ __forceinline__ float swap_lo(float x) { auto rr = __builtin_amdgcn_permlane32_swap(__float_as_uint(x), __float_as_uint(x), false, false); return __uint_as_float(rr[0]); }
__device__ __forceinline__ float swap_hi(float x) { auto rr = __builtin_amdgcn_permlane32_swap(__float_as_uint(x), __float_as_uint(x), false, false); return __uint_as_float(rr[1]); }

template <int MODE> __device__ __forceinline__ void attn_unit(int b, int h, int qb, const bf16_t* Q, const bf16_t* K, const bf16_t* V, bf16_t* O, float* hs, const float* cb, LAS char* shm) {
    int tid = threadIdx.x; asm volatile("" : "+v"(tid)); const int lane = tid & 63, r32 = lane & 31, hi = lane >> 5; const int wid = __builtin_amdgcn_readfirstlane(tid >> 6);
    const long rowbase = (long)b * SEQ; const int q0 = qb * QB;
    const bf16_t* Qw = Q + (rowbase + q0 + wid * 32) * PITCH + h * HD;
    const bf16_t* Kh = K + rowbase * PITCH + h * HD; const bf16_t* Vh = V + rowbase * PITCH + h * HD;
    const unsigned lds0 = (unsigned)(uintptr_t)shm;
    LAS float* wsf = (LAS float*)(shm + LDS_WS) + wid * 64;
    LAS unsigned* flags = (LAS unsigned*)(shm + LDS_FLAG);
    const bf16_t* ksrc = Kh + (long)lane * PITCH + wid * 8;
    const bf16_t* vsrc = Vh + (long)(16 * (wid & 3) + (lane >> 2)) * PITCH + (wid >> 2) * 32 + (lane & 3) * 8;
    const unsigned kdst = lds0 + LDS_K + wid * 1024, vdst = lds0 + LDS_V + wid * 1024;
#define DMA_KV(t, slot) do { glds16(ksrc + (long)(t) * KVBLK * PITCH, (unsigned)__builtin_amdgcn_readfirstlane(kdst + (slot))); glds16(vsrc + (long)(t) * KVBLK * PITCH, (unsigned)__builtin_amdgcn_readfirstlane(vdst + (slot))); } while (0)
    const int vb0 = (int)(lds0 + LDS_V) + ((lane >> 4) & 1) * 32 + (lane & 3) * 8 + (4 * hi + ((lane & 15) >> 2)) * 64;
    const int NT = (q0 + QB) / KVBLK;
    DMA_KV(NT - 1, 0);
    bf16x8 qr[4];
#pragma unroll
    for (int d0 = 0; d0 < 4; ++d0) qr[d0] = *(const bf16x8*)(Qw + (long)r32 * PITCH + d0 * 16 + hi * 8);
    f32x16 o[2]; o[0] = f32x16{}; o[1] = f32x16{};
    const int qrel = wid * 32 + r32;
    float m_run = -1.0e30f, l_run = 0.f, R = 0.f, ct = 0.f;
    if (MODE == 0) ct = cb[q0 + qrel];
    bf16x8 TD0, TD1, TONE;
#pragma unroll
    for (int j = 0; j < 8; ++j) { const int kvl = 8 * (j >> 2) + 4 * hi + (j & 3); TD0[j] = (kvl >= r32) ? (short)0x3F80 : (short)0; TD1[j] = (16 + kvl >= r32) ? (short)0x3F80 : (short)0; TONE[j] = (short)0x3F80; }
    f32x16 zero16 = f32x16{};
    for (int i = 0; i < NT; ++i) {
        const int t = NT - 1 - i, slot = (i & 1) * SLOTB;
        ATT_WAIT_BAR0();
        if (MODE == 1 && i > 0) {
            const LAS unsigned* fl = flags + ((i - 1) & 1) * 8; unsigned all = 1u;
#pragma unroll
            for (int w = 0; w < 8; ++w) all &= fl[w];
            if (__builtin_amdgcn_readfirstlane(all)) break;
        }
        if (t > 0) DMA_KV(t - 1, slot ^ SLOTB);
        const int jb = t - (NT - 4);
        const bool active = !(jb >= 0 && 2 * jb > wid);
        bool wave_done = false;
        if (MODE == 1) wave_done = __all(R < SB_EXIT);
        if (active && !(MODE == 1 && wave_done)) {
            f32x16 p0, p1;
            qkt(p0, p1, shm + LDS_K + slot, qr, zero16, r32, hi);
            if (MODE == 0) {
                const float* cbt = cb + t * KVBLK + 4 * hi;
#pragma unroll
                for (int g = 0; g < 4; ++g) { const f32x4 c0 = *(const f32x4*)(cbt + 8 * g), c1 = *(const f32x4*)(cbt + 32 + 8 * g);
#pragma unroll
                    for (int e = 0; e < 4; ++e) { p0[4 * g + e] += ct - c0[e]; p1[4 * g + e] += ct - c1[e]; } }
                if (jb >= 0) {
#pragma unroll
                    for (int r = 0; r < 16; ++r) { const int kv = 64 * jb + crow(r, hi); if (kv > qrel) p0[r] = -1.0e30f; if (kv + 32 > qrel) p1[r] = -1.0e30f; } }
                float a = fmaxf(p0[0], p1[0]);
#pragma unroll
                for (int r = 1; r < 16; ++r) a = fmaxf(a, fmaxf(p0[r], p1[r]));
                a = fmaxf(swap_lo(a), swap_hi(a));
                const float m_new = fmaxf(m_run, a), alpha = __builtin_amdgcn_exp2f(m_run - m_new); m_run = m_new;
                float s = 0.f;
#pragma unroll
                for (int r = 0; r < 16; ++r) { p0[r] = __builtin_amdgcn_exp2f(p0[r] - m_new); p1[r] = __builtin_amdgcn_exp2f(p1[r] - m_new); s += p0[r] + p1[r]; }
                l_run = l_run * alpha + s;
                if (hi == 0) wsf[r32] = alpha;
                LDS_WAIT();
#pragma unroll
                for (int r = 0; r < 16; ++r) { const float f = wsf[crow(r, hi)]; o[0][r] *= f; o[1][r] *= f; }
                LDS_WAIT();
            } else {
                if (jb >= 0) {
#pragma unroll
                    for (int r = 0; r < 16; ++r) { const int kv = 64 * jb + crow(r, hi); if (kv >= qrel) p0[r] = -1.0e30f; if (kv + 32 >= qrel) p1[r] = -1.0e30f; } }
                f32x16 l0, l1;
#pragma unroll
                for (int r = 0; r < 16; ++r) {
                    l0[r] = -(fmaxf(p0[r], 0.f) + __builtin_amdgcn_logf(1.0f + __builtin_amdgcn_exp2f(-fabsf(p0[r]))));
                    l1[r] = -(fmaxf(p1[r], 0.f) + __builtin_amdgcn_logf(1.0f + __builtin_amdgcn_exp2f(-fabsf(p1[r])))); }
                u32x4 lw0 = {cvt_pk_bf16(l0[0], l0[1]), cvt_pk_bf16(l0[2], l0[3]), cvt_pk_bf16(l0[4], l0[5]), cvt_pk_bf16(l0[6], l0[7])};
                u32x4 lw1 = {cvt_pk_bf16(l0[8], l0[9]), cvt_pk_bf16(l0[10], l0[11]), cvt_pk_bf16(l0[12], l0[13]), cvt_pk_bf16(l0[14], l0[15])};
                u32x4 lw2 = {cvt_pk_bf16(l1[0], l1[1]), cvt_pk_bf16(l1[2], l1[3]), cvt_pk_bf16(l1[4], l1[5]), cvt_pk_bf16(l1[6], l1[7])};
                u32x4 lw3 = {cvt_pk_bf16(l1[8], l1[9]), cvt_pk_bf16(l1[10], l1[11]), cvt_pk_bf16(l1[12], l1[13]), cvt_pk_bf16(l1[14], l1[15])};
                f32x16 rt;
#pragma unroll
                for (int r = 0; r < 16; ++r) rt[r] = R;
                f32x16 t0 = MFMA32(TD0, __builtin_bit_cast(bf16x8, lw0), rt); t0 = MFMA32(TD1, __builtin_bit_cast(bf16x8, lw1), t0);
                t0 = MFMA32(TONE, __builtin_bit_cast(bf16x8, lw2), t0); t0 = MFMA32(TONE, __builtin_bit_cast(bf16x8, lw3), t0);
                f32x16 t1 = MFMA32(TD0, __builtin_bit_cast(bf16x8, lw2), rt); t1 = MFMA32(TD1, __builtin_bit_cast(bf16x8, lw3), t1);
#pragma unroll
                for (int r = 0; r < 16; ++r) { p0[r] = __builtin_amdgcn_exp2f(p0[r] + t0[r]); p1[r] = __builtin_amdgcn_exp2f(p1[r] + t1[r]); }
                R = swap_lo(t0[0]);
            }
            u32x4 pw0 = {cvt_pk_bf16(p0[0], p0[1]), cvt_pk_bf16(p0[2], p0[3]), cvt_pk_bf16(p0[4], p0[5]), cvt_pk_bf16(p0[6], p0[7])};
            u32x4 pw1 = {cvt_pk_bf16(p0[8], p0[9]), cvt_pk_bf16(p0[10], p0[11]), cvt_pk_bf16(p0[12], p0[13]), cvt_pk_bf16(p0[14], p0[15])};
            u32x4 pw2 = {cvt_pk_bf16(p1[0], p1[1]), cvt_pk_bf16(p1[2], p1[3]), cvt_pk_bf16(p1[4], p1[5]), cvt_pk_bf16(p1[6], p1[7])};
            u32x4 pw3 = {cvt_pk_bf16(p1[8], p1[9]), cvt_pk_bf16(p1[10], p1[11]), cvt_pk_bf16(p1[12], p1[13]), cvt_pk_bf16(p1[14], p1[15])};
            pv(o, vb0 + slot, __builtin_bit_cast(bf16x8, pw0), __builtin_bit_cast(bf16x8, pw1), __builtin_bit_cast(bf16x8, pw2), __builtin_bit_cast(bf16x8, pw3));
        }
        if (MODE == 1) { const bool dn = __all(R < SB_EXIT); if (lane == 0) flags[(i & 1) * 8 + wid] = dn ? 1u : 0u; }
    }
    float linv = 1.f;
    if (MODE == 0) { const float lt = swap_lo(l_run) + swap_hi(l_run); linv = 1.0f / lt; }
    if (hi == 0) wsf[32 + r32] = linv;
    LDS_WAIT();
    bf16_t* Ow = O + (rowbase + q0 + wid * 32) * OPITCH + h * HD;
    { LAS bf16_t* stg = (LAS bf16_t*)(shm + LDS_OST) + wid * 2048;
#pragma unroll
      for (int r = 0; r < 16; ++r) { const int orow = crow(r, hi); const float f = wsf[32 + orow];
#pragma unroll
        for (int d0 = 0; d0 < 2; ++d0) { const unsigned pk = cvt_pk_bf16(o[d0][r] * f, 0.f); stg[orow * 64 + d0 * 32 + r32] = (bf16_t)(pk & 0xffffu); } }
      LDS_WAIT();
#pragma unroll
      for (int i = 0; i < 4; ++i) { const int row = i * 8 + (lane >> 3), ch = lane & 7; const u32x4 v = *(const LAS u32x4*)(stg + row * 64 + ch * 8); *(u32x4*)(Ow + (long)row * OPITCH + ch * 8) = v;
        store_row_ssq(v, hs + (rowbase + q0 + wid * 32 + row) * 16, ch); } }
    asm volatile("s_waitcnt vmcnt(0) lgkmcnt(0)\n\ts_barrier" ::: "memory");
#undef DMA_KV
}
}


namespace fox {
constexpr int QB = 256, KVBLK = 64, PITCH = HW, OPITCH = DM;
constexpr int NSLOT = 3, SLOTB = 9216;
constexpr int LDS_K = 0, LDS_V = NSLOT * SLOTB, LDS_WS = 2 * NSLOT * SLOTB, LDS_OST = LDS_WS + NWAVES * 256, LDS_CL = LDS_OST + NWAVES * 4096, LDS_VOTE = LDS_CL + 512, LDS_END = LDS_VOTE + 32;
static_assert(LDS_END <= RING_BYTES, "fox LDS");
constexpr float WIN_T = 48.0f;
constexpr float FLOOR = -256.0f;
using att::crow; using att::glds16; using att::glds16s;
typedef __attribute__((address_space(3))) const char* lds_cptr;
typedef short v4i16_t __attribute__((ext_vector_type(4)));
#define SBAR() __builtin_amdgcn_sched_barrier(0)
#define WAIT_BAR(N) asm volatile("s_waitcnt vmcnt(" #N ") lgkmcnt(0)\n\ts_barrier" ::: "memory")
__device__ __forceinline__ s16x4 vtr(lds_cptr p) { return __builtin_bit_cast(s16x4, __builtin_amdgcn_ds_read_tr16_b64_v4i16((__attribute__((address_space(3))) v4i16_t*)p)); }
__device__ __forceinline__ void kload2(bf16x8* kf, lds_cptr kp, int j) { kf[2 * j] = *(const LAS bf16x8*)(kp + j * 2048); kf[2 * j + 1] = *(const LAS bf16x8*)(kp + j * 2048 + 512); }
__device__ __forceinline__ void cmask(f32x16& p0, f32x16& p1, int jb, int qrel, int hi) {
    const float NEG = -INFINITY; const int kb = 64 * jb + 4 * hi;
#pragma unroll
    for (int r = 0; r < 16; ++r) { const int kv = kb + (r & 3) + 8 * (r >> 2); if (kv > qrel) p0[r] = NEG; if (kv + 32 > qrel) p1[r] = NEG; }
}
__device__ __forceinline__ void split3(float x, unsigned& hm, unsigned& lo) {
    const unsigned h = cvt_pk_bf16(x, 0.f) & 0xffffu; const float r1 = x - __uint_as_float(h << 16);
    const unsigned m = cvt_pk_bf16(r1, 0.f) & 0xffffu; const float r2 = r1 - __uint_as_float(m << 16);
    hm = h | (m << 16); lo = cvt_pk_bf16(r2, 0.f) & 0xffffu;
}
__device__ __forceinline__ bf16x8 qx_build(float a, int hi) {
    unsigned hm, lo; split3(a, hm, lo);
    u32x4 w; w.x = hm; w.y = lo | 0x3F800000u; w.z = 0x3F803F80u; w.w = 0u;
    if (hi) { w.x = 0u; w.y = 0u; w.z = 0u; }
    return __builtin_bit_cast(bf16x8, w);
}

template <int THRL> __device__ __forceinline__ void fox_unit(int bh, int qb, const bf16_t* Q, const bf16_t* K, const bf16_t* V, bf16_t* O, float* hs, const float* cb, const bf16_t* KXh, float kmax, LAS char* shm) {
    int tid = threadIdx.x; asm volatile("" : "+v"(tid)); const int lane = tid & 63, r32 = lane & 31, hi = lane >> 5; const int wid = __builtin_amdgcn_readfirstlane(tid >> 6);
    const int b = bh >> 3, h = bh & 7; const long rowbase = (long)b * SEQ; const int q0 = qb * QB;
    const bf16_t* Qw = Q + (rowbase + q0 + wid * 32) * PITCH + h * HD;
    const bf16_t* Kh = K + rowbase * PITCH + h * HD; const bf16_t* Vh = V + rowbase * PITCH + h * HD;
    const unsigned lds0 = (unsigned)(uintptr_t)shm;
    LAS float* wsf = (LAS float*)(shm + LDS_WS) + wid * 64;
    const int NT = (q0 + QB) / KVBLK;
    int NTe = NT;
    LAS float* clt = (LAS float*)(shm + LDS_CL); LAS unsigned* votes = (LAS unsigned*)(shm + LDS_VOTE);
    const float clv = (tid < NT) ? cb[64 * tid + 63] : 0.f;
    const unsigned koff = (unsigned)(lane * PITCH + wid * 8) * 2u, voff = (unsigned)((16 * (wid & 3) + (lane >> 2)) * PITCH + (wid >> 2) * 32 + (lane & 3) * 8) * 2u, xoff = (unsigned)lane * 16u;
    const unsigned kdst = lds0 + LDS_K + wid * 1024, vdst = lds0 + LDS_V + wid * 1024, xdst = lds0 + LDS_K + 8192;
    const bool xl = (lane >> 3) == wid;
#define DMA_K(p, slot) do { glds16s(Kh + (long)(NT - 1 - (p)) * KVBLK * PITCH, koff, (unsigned)__builtin_amdgcn_readfirstlane(kdst + (slot))); \
        if (xl) glds16s(KXh + (long)(NT - 1 - (p)) * KVBLK * 8, xoff, (unsigned)__builtin_amdgcn_readfirstlane(xdst + (slot))); } while (0)
#define DMA_V(p, slot) glds16s(Vh + (long)(NT - 1 - (p)) * KVBLK * PITCH, voff, (unsigned)__builtin_amdgcn_readfirstlane(vdst + (slot)))
    bf16x8 kf[10];
    const lds_cptr shm3 = (lds_cptr)shm; const lds_cptr kp0 = shm3 + LDS_K + hi * 1024 + r32 * 16; const lds_cptr kx0 = shm3 + LDS_K + 8192 + r32 * 16;
    const lds_cptr vp0 = shm3 + LDS_V + ((lane >> 4) & 1) * 32 + (lane & 3) * 8 + (4 * hi + ((lane & 15) >> 2)) * 64;
    DMA_K(0, 0); DMA_V(0, 0); DMA_K(1, SLOTB);
    bf16x8 qr[4];
#pragma unroll
    for (int d0 = 0; d0 < 4; ++d0) qr[d0] = *(const bf16x8*)(Qw + (long)r32 * PITCH + d0 * 16 + hi * 8);
    const int qrel = wid * 32 + r32;
    const float ct = cb[q0 + qrel];
    float mhat = 0.f, l_reg = 0.f; f32x16 o[2]; o[0] = f32x16{}; o[1] = f32x16{};
    bf16x8 qx = qx_build(ct, hi);
    const f32x16 z16 = f32x16{};
#define CMASK(P0, P1, p) do { const int jb_ = 3 - (p); if (jb_ >= 0) cmask(P0, P1, jb_, qrel, hi); } while (0)
    bool resc = false;
#define RESC() do { if (resc) { asm volatile("s_waitcnt lgkmcnt(0)" ::: "memory"); \
      _Pragma("unroll") for (int d_ = 0; d_ < 2; ++d_) _Pragma("unroll") for (int r = 0; r < 16; ++r) o[d_][r] *= wsf[crow(r, hi)]; } } while (0)
    f32x16 pA0, pA1, pB0, pB1;
    int sl_prev = 0, sl_cur = 0, sl_next = SLOTB;
#define ROT() do { sl_prev = sl_cur; sl_cur = sl_next; sl_next = (sl_next == (NSLOT - 1) * SLOTB) ? 0 : sl_next + SLOTB; } while (0)
    DMA_K(2, 2 * SLOTB);
    WAIT_BAR(5);
    if (tid < NT) clt[tid] = clv;
    float qkb;
    { float q2 = 0.f;
#pragma unroll
      for (int d0 = 0; d0 < 4; ++d0)
#pragma unroll
          for (int j = 0; j < 8; ++j) { const float e = __uint_as_float(((unsigned)(unsigned short)qr[d0][j]) << 16); q2 += e * e; }
      q2 = att::swap_lo(q2) + att::swap_hi(q2); qkb = sqrtf(q2) * kmax + ct + WIN_T; }
    { const LAS char* kb = (const LAS char*)shm + LDS_K + hi * 1024 + r32 * 16; const LAS char* kxb = (const LAS char*)shm + LDS_K + 8192 + r32 * 16;
      pA0 = MFMA32(*(const LAS bf16x8*)(kxb), qx, z16); pA1 = MFMA32(*(const LAS bf16x8*)(kxb + 512), qx, z16);
#pragma unroll
      for (int d0 = 0; d0 < 4; ++d0) { pA0 = MFMA32(*(const LAS bf16x8*)(kb + d0 * 2048), qr[d0], pA0); pA1 = MFMA32(*(const LAS bf16x8*)(kb + d0 * 2048 + 512), qr[d0], pA1); } }
    asm volatile("s_nop 15\n\ts_nop 7" : "+v"(pA0), "+v"(pA1)); CMASK(pA0, pA1, 0);
    { float a = fmaxf(pA0[0], pA1[0]);
#pragma unroll
      for (int r = 1; r < 16; ++r) a = fmaxf(a, fmaxf(pA0[r], pA1[r]));
      a = fmaxf(att::swap_lo(a), att::swap_hi(a));
      const float dl = fmaxf(a, FLOOR); mhat = dl;
#pragma unroll
      for (int r = 0; r < 16; ++r) { pA0[r] = __builtin_amdgcn_exp2f(pA0[r] - dl); pA1[r] = __builtin_amdgcn_exp2f(pA1[r] - dl); }
      qx = qx_build(ct - mhat, hi); asm volatile("" : "+v"(qx)); }
    WAIT_BAR(0);
    DMA_K(3, 0); DMA_V(1, SLOTB);
    ROT();
    kload2(kf, kp0 + sl_cur, 0); kload2(kf, kp0 + sl_cur, 1); kload2(kf, kp0 + sl_cur, 2); kload2(kf, kp0 + sl_cur, 3);
    kf[8] = *(const LAS bf16x8*)(kx0 + sl_cur); kf[9] = *(const LAS bf16x8*)(kx0 + sl_cur + 512);
    WAIT_BAR(3);
    s16x4 vlo[8], vhi[8]; u32x4 pw0, pw1, pw2, pw3;
#define PKW(P, B) cvt_pk_bf16(P[B], P[B + 1])
#define PAF(k) __builtin_bit_cast(bf16x8, pw##k)
#define VFR(i) (bf16x8){vlo[i][0], vlo[i][1], vlo[i][2], vlo[i][3], vhi[i][0], vhi[i][1], vhi[i][2], vhi[i][3]}
#define PIN(x) asm volatile("" : "+v"(x))
#define MX3(a, b, c) __builtin_fmaxf(__builtin_fmaxf((a), (b)), (c))
#define GAPA(MF, A0, A1, A2, A3, W0, W1, PW) do { MF; sacc += A0; sacc += A1; sacc += A2; sacc += A3; PIN(sacc); W0; W1; PIN(PW); SBAR(); } while (0)
#define EX(v) __builtin_amdgcn_exp2f(v)
#define GAPB(MF, X, B) do { MF; X[B] = EX(X[B]); X[B + 1] = EX(X[B + 1]); X[B + 2] = EX(X[B + 2]); X[B + 3] = EX(X[B + 3]); PIN(X); SBAR(); } while (0)
#define VRD(i) do { vlo[i] = vtr(vp_ + (((i) >> 2) * 4096 + ((i) & 3) * 1024)); vhi[i] = vtr(vp_ + (((i) >> 2) * 4096 + ((i) & 3) * 1024 + 512)); } while (0)
#define KRD(G, j) do { if (G) { kload2(kf, kp0 + sl_next, j); SBAR(); } } while (0)
#define KRDX(G) do { if (G) { kf[8] = *(const LAS bf16x8*)(kx0 + sl_next); kf[9] = *(const LAS bf16x8*)(kx0 + sl_next + 512); SBAR(); } } while (0)
#define STEP(C0, C1, P0, P1, t, GK, GV, GL) do { SBAR(); \
    const lds_cptr vp_ = vp0 + sl_prev; \
    C0 = MFMA32(kf[8], qx, z16); C1 = MFMA32(kf[9], qx, z16); SBAR(); \
    VRD(0); SBAR(); float sacc = (P0[0] + P0[1]); \
    GAPA(C0 = MFMA32(kf[0], qr[0], C0), P0[2], P0[3], P0[4], P0[5],     pw0[0] = PKW(P0, 0), pw0[1] = PKW(P0, 2), pw0); \
    VRD(4); SBAR(); GAPA(C1 = MFMA32(kf[1], qr[0], C1), P0[6], P0[7], P0[8], P0[9],     pw0[2] = PKW(P0, 4), pw0[3] = PKW(P0, 6), pw0); \
    VRD(1); SBAR(); GAPA(C0 = MFMA32(kf[2], qr[1], C0),   P0[10], P0[11], P0[12], P0[13], pw1[0] = PKW(P0, 8), pw1[1] = PKW(P0, 10), pw1); \
    VRD(5); SBAR(); GAPA(C1 = MFMA32(kf[3], qr[1], C1),   P0[14], P0[15], P1[0], P1[1],   pw1[2] = PKW(P0, 12), pw1[3] = PKW(P0, 14), pw1); \
    VRD(2); SBAR(); GAPA(C0 = MFMA32(kf[4], qr[2], C0),   P1[2], P1[3], P1[4], P1[5],     pw2[0] = PKW(P1, 0), pw2[1] = PKW(P1, 2), pw2); \
    VRD(6); SBAR(); GAPA(C1 = MFMA32(kf[5], qr[2], C1),   P1[6], P1[7], P1[8], P1[9],     pw2[2] = PKW(P1, 4), pw2[3] = PKW(P1, 6), pw2); \
    VRD(3); SBAR(); GAPA(C0 = MFMA32(kf[6], qr[3], C0),   P1[10], P1[11], P1[12], P1[13], pw3[0] = PKW(P1, 8), pw3[1] = PKW(P1, 10), pw3); \
    VRD(7); SBAR(); GAPA(C1 = MFMA32(kf[7], qr[3], C1),   P1[14], P1[15], 0.f, 0.f,       pw3[2] = PKW(P1, 12), pw3[3] = PKW(P1, 14), pw3); \
    l_reg += sacc; \
    if (GK) { DMA_K((t) + 3, sl_cur); } if (GV) { DMA_V((t) + 1, sl_next); } \
    CMASK(C0, C1, t); \
    { float a = MX3(C0[0], C0[1], C1[0]), b_ = MX3(C0[2], C0[3], C1[1]); a = MX3(a, C1[2], C1[3]); \
      _Pragma("unroll") for (int r = 4; r < 16; r += 4) { a = MX3(a, C0[r], C0[r + 1]); b_ = MX3(b_, C0[r + 2], C0[r + 3]); a = MX3(a, C1[r], C1[r + 1]); b_ = MX3(b_, C1[r + 2], C1[r + 3]); } \
      float rm = __builtin_fmaxf(a, b_); { auto rr = __builtin_amdgcn_permlane32_swap(__float_as_uint(rm), __float_as_uint(rm), false, false); rm = __builtin_fmaxf(__uint_as_float(rr[0]), __uint_as_float(rr[1])); } \
      resc = false; \
      if (__builtin_expect(__any(rm > (float)THRL), 0)) { const float dl = __builtin_fmaxf(rm, 0.f); mhat += dl; \
        _Pragma("unroll") for (int r = 0; r < 16; ++r) { C0[r] -= dl; C1[r] -= dl; } \
        qx = qx_build(ct - mhat, hi); asm volatile("" : "+v"(qx)); \
        const float f = __builtin_amdgcn_exp2f(-dl); l_reg *= f; if (hi == 0) wsf[r32] = f; resc = true; } } \
    SBAR(); \
    GAPB(o[0] = MFMA32(PAF(0), VFR(0), o[0]), C0, 0); \
    KRDX(GL); GAPB(o[1] = MFMA32(PAF(0), VFR(4), o[1]), C0, 4); \
    KRD(GL, 0); GAPB(o[0] = MFMA32(PAF(1), VFR(1), o[0]), C0, 8); \
    KRD(GL, 1); GAPB(o[1] = MFMA32(PAF(1), VFR(5), o[1]), C0, 12); \
    KRD(GL, 2); GAPB(o[0] = MFMA32(PAF(2), VFR(2), o[0]), C1, 0); \
    KRD(GL, 3); GAPB(o[1] = MFMA32(PAF(2), VFR(6), o[1]), C1, 4); \
    GAPB(o[0] = MFMA32(PAF(3), VFR(3), o[0]), C1, 8); \
    GAPB(o[1] = MFMA32(PAF(3), VFR(7), o[1]), C1, 12); \
    } while (0)
#define ENDW(tt) do { if ((tt) + 3 < NTe) { WAIT_BAR(3); } else if ((tt) + 2 < NTe) { WAIT_BAR(1); } else { WAIT_BAR(0); } } while (0)
#define VOTE(u) do { const int ts_ = NT - (u) - 3; bool ok_ = false; if (ts_ >= 0) { ok_ = __all((qkb - mhat) < clt[ts_]); } if (lane == 0) votes[wid] = ok_ ? 1u : 0u; } while (0)
#define TALLY(u) do { const u32x4 va_ = *(const LAS u32x4*)votes, vb_ = *(const LAS u32x4*)(votes + 4); \
        if (__builtin_amdgcn_readfirstlane((va_.x & va_.y & va_.z & va_.w & vb_.x & vb_.y & vb_.z & vb_.w) != 0u)) { if ((u) + 2 < NTe) { NTe = (u) + 2; WAIT_BAR(0); } } } while (0)
    int t = 1;
    for (; t + 1 < NTe && t < 5; t += 2) {
        STEP(pB0, pB1, pA0, pA1, t, (t + 3 < NTe), (t + 1 < NTe), (t + 1 < NTe));       ENDW(t);     RESC(); ROT();
        STEP(pA0, pA1, pB0, pB1, t + 1, (t + 4 < NTe), (t + 2 < NTe), (t + 2 < NTe));   VOTE(t + 1); ENDW(t + 1); TALLY(t + 1); RESC(); ROT();
    }
#undef CMASK
#define CMASK(P0, P1, p) do {} while (0)
    for (; t + 5 < NTe; t += 2) {
        STEP(pB0, pB1, pA0, pA1, t, true, true, true);       WAIT_BAR(3); RESC(); ROT();
        STEP(pA0, pA1, pB0, pB1, t + 1, true, true, true);   VOTE(t + 1); WAIT_BAR(3); TALLY(t + 1); RESC(); ROT();
    }
    for (; t + 1 < NTe; t += 2) {
        STEP(pB0, pB1, pA0, pA1, t, (t + 3 < NTe), (t + 1 < NTe), (t + 1 < NTe));       ENDW(t);     RESC(); ROT();
        STEP(pA0, pA1, pB0, pB1, t + 1, (t + 4 < NTe), (t + 2 < NTe), (t + 2 < NTe));   ENDW(t + 1); RESC(); ROT();
    }
#undef CMASK
#define CMASK(P0, P1, p) do { const int jb_ = 3 - (p); if (jb_ >= 0) cmask(P0, P1, jb_, qrel, hi); } while (0)
    STEP(pB0, pB1, pA0, pA1, NTe - 1, false, false, false); RESC();
    { float sacc = pB0[0] + pB0[1];
#pragma unroll
      for (int r = 2; r < 16; ++r) sacc += pB0[r];
#pragma unroll
      for (int r = 0; r < 16; ++r) sacc += pB1[r];
      l_reg += sacc;
      pw0 = (u32x4){PKW(pB0, 0), PKW(pB0, 2), PKW(pB0, 4), PKW(pB0, 6)}; pw1 = (u32x4){PKW(pB0, 8), PKW(pB0, 10), PKW(pB0, 12), PKW(pB0, 14)};
      pw2 = (u32x4){PKW(pB1, 0), PKW(pB1, 2), PKW(pB1, 4), PKW(pB1, 6)}; pw3 = (u32x4){PKW(pB1, 8), PKW(pB1, 10), PKW(pB1, 12), PKW(pB1, 14)};
      SBAR(); att::pv(o, (int)(unsigned)(uintptr_t)(vp0 + sl_cur), PAF(0), PAF(1), PAF(2), PAF(3)); }
    l_reg = att::swap_lo(l_reg) + att::swap_hi(l_reg);
    if (hi == 0) wsf[32 + r32] = l_reg; asm volatile("s_waitcnt lgkmcnt(0)" ::: "memory");
    float rli[16];
#pragma unroll
    for (int r = 0; r < 16; ++r) rli[r] = __builtin_amdgcn_rcpf(wsf[32 + crow(r, hi)]);
    bf16_t* Ow = O + (rowbase + q0 + wid * 32) * OPITCH + h * HD;
    { LAS bf16_t* stg = (LAS bf16_t*)(shm + LDS_OST) + wid * 2048;
#pragma unroll
      for (int r = 0; r < 16; ++r) { const int orow = crow(r, hi);
#pragma unroll
        for (int d0 = 0; d0 < 2; ++d0) stg[orow * 64 + d0 * 32 + r32] = (bf16_t)(cvt_pk_bf16(o[d0][r] * rli[r], 0.f) & 0xffffu); }
      asm volatile("s_waitcnt lgkmcnt(0)" ::: "memory");
#pragma unroll
      for (int i = 0; i < 4; ++i) { const int row = i * 8 + (lane >> 3), ch = lane & 7; const u32x4 v = *(const LAS u32x4*)(stg + row * 64 + ch * 8); *(u32x4*)(Ow + (long)row * OPITCH + ch * 8) = v;
        att::store_row_ssq(v, hs + (rowbase + q0 + wid * 32 + row) * 16, ch); } }
    asm volatile("s_waitcnt lgkmcnt(0)\n\ts_barrier" ::: "memory");
#undef DMA_K
#undef DMA_V
#undef CMASK
#undef RESC
#undef ROT
#undef PKW
#undef PAF
#undef VFR
#undef PIN
#undef MX3
#undef GAPA
#undef GAPB
#undef EX
#undef VRD
#undef KRD
#undef KRDX
#undef STEP
#undef ENDW
#undef VOTE
#undef TALLY
}
#undef SBAR
#undef WAIT_BAR
}


namespace sbk {
constexpr int QB = 256, KVBLK = 64, PITCH = HW, OPITCH = DM, NBURST = 6, SLOTB = 8192;
constexpr int LDS_K = 0, LDS_V = NBURST * SLOTB, LDS_FLAG = 2 * NBURST * SLOTB, LDS_END = LDS_FLAG + 128;
static_assert(LDS_END <= RING_BYTES, "sb LDS");
using att::crow; using att::glds16s; using att::qkt; using att::pv; using att::swap_lo;
__device__ __forceinline__ void sb_tile(const LAS char* Kslot, int vb, const bf16x8* qr, bf16x8 TD0, bf16x8 TD1, bf16x8 TONE, int jb, int qrel, int r32, int hi, float& R, f32x16* o) {
    f32x16 p0, p1; const f32x16 z16 = f32x16{};
    qkt(p0, p1, Kslot, qr, z16, r32, hi);
    if (jb >= 0) {
#pragma unroll
        for (int r = 0; r < 16; ++r) { const int kv = 64 * jb + crow(r, hi); if (kv >= qrel) p0[r] = -1.0e30f; if (kv + 32 >= qrel) p1[r] = -1.0e30f; } }
    f32x16 l0, l1;
#pragma unroll
    for (int r = 0; r < 16; ++r) {
        l0[r] = -(fmaxf(p0[r], 0.f) + __builtin_amdgcn_logf(1.0f + __builtin_amdgcn_exp2f(-fabsf(p0[r]))));
        l1[r] = -(fmaxf(p1[r], 0.f) + __builtin_amdgcn_logf(1.0f + __builtin_amdgcn_exp2f(-fabsf(p1[r])))); }
    u32x4 lw0 = {cvt_pk_bf16(l0[0], l0[1]), cvt_pk_bf16(l0[2], l0[3]), cvt_pk_bf16(l0[4], l0[5]), cvt_pk_bf16(l0[6], l0[7])};
    u32x4 lw1 = {cvt_pk_bf16(l0[8], l0[9]), cvt_pk_bf16(l0[10], l0[11]), cvt_pk_bf16(l0[12], l0[13]), cvt_pk_bf16(l0[14], l0[15])};
    u32x4 lw2 = {cvt_pk_bf16(l1[0], l1[1]), cvt_pk_bf16(l1[2], l1[3]), cvt_pk_bf16(l1[4], l1[5]), cvt_pk_bf16(l1[6], l1[7])};
    u32x4 lw3 = {cvt_pk_bf16(l1[8], l1[9]), cvt_pk_bf16(l1[10], l1[11]), cvt_pk_bf16(l1[12], l1[13]), cvt_pk_bf16(l1[14], l1[15])};
    f32x16 rt;
#pragma unroll
    for (int r = 0; r < 16; ++r) rt[r] = R;
    f32x16 t0 = MFMA32(TD0, __builtin_bit_cast(bf16x8, lw0), rt); t0 = MFMA32(TD1, __builtin_bit_cast(bf16x8, lw1), t0);
    t0 = MFMA32(TONE, __builtin_bit_cast(bf16x8, lw2), t0); t0 = MFMA32(TONE, __builtin_bit_cast(bf16x8, lw3), t0);
    f32x16 t1 = MFMA32(TD0, __builtin_bit_cast(bf16x8, lw2), rt); t1 = MFMA32(TD1, __builtin_bit_cast(bf16x8, lw3), t1);
#pragma unroll
    for (int r = 0; r < 16; ++r) { p0[r] = __builtin_amdgcn_exp2f(p0[r] + t0[r]); p1[r] = __builtin_amdgcn_exp2f(p1[r] + t1[r]); }
    R = swap_lo(t0[0]);
    u32x4 pw0 = {cvt_pk_bf16(p0[0], p0[1]), cvt_pk_bf16(p0[2], p0[3]), cvt_pk_bf16(p0[4], p0[5]), cvt_pk_bf16(p0[6], p0[7])};
    u32x4 pw1 = {cvt_pk_bf16(p0[8], p0[9]), cvt_pk_bf16(p0[10], p0[11]), cvt_pk_bf16(p0[12], p0[13]), cvt_pk_bf16(p0[14], p0[15])};
    u32x4 pw2 = {cvt_pk_bf16(p1[0], p1[1]), cvt_pk_bf16(p1[2], p1[3]), cvt_pk_bf16(p1[4], p1[5]), cvt_pk_bf16(p1[6], p1[7])};
    u32x4 pw3 = {cvt_pk_bf16(p1[8], p1[9]), cvt_pk_bf16(p1[10], p1[11]), cvt_pk_bf16(p1[12], p1[13]), cvt_pk_bf16(p1[14], p1[15])};
    pv(o, vb, __builtin_bit_cast(bf16x8, pw0), __builtin_bit_cast(bf16x8, pw1), __builtin_bit_cast(bf16x8, pw2), __builtin_bit_cast(bf16x8, pw3));
}
#define SB_WAITBAR(N) asm volatile("s_waitcnt vmcnt(" #N ") lgkmcnt(0)\n\ts_barrier" ::: "memory")
__device__ __forceinline__ void sb_unit(int b, int h, int qb, const bf16_t* Q, const bf16_t* K, const bf16_t* V, bf16_t* O, float* hs, LAS char* shm) {
    int tid = threadIdx.x; asm volatile("" : "+v"(tid)); const int lane = tid & 63, r32 = lane & 31, hi = lane >> 5; const int wid = __builtin_amdgcn_readfirstlane(tid >> 6);
    const long rowbase = (long)b * SEQ; const int q0 = qb * QB;
    const bf16_t* Qw = Q + (rowbase + q0 + wid * 32) * PITCH + h * HD;
    const bf16_t* Kh = K + rowbase * PITCH + h * HD; const bf16_t* Vh = V + rowbase * PITCH + h * HD;
    const unsigned lds0 = (unsigned)(uintptr_t)shm;
    LAS unsigned* flags = (LAS unsigned*)(shm + LDS_FLAG);
    const unsigned koff = (unsigned)(lane * PITCH + wid * 8) * 2u, voff = (unsigned)((16 * (wid & 3) + (lane >> 2)) * PITCH + (wid >> 2) * 32 + (lane & 3) * 8) * 2u;
    const unsigned kdst = lds0 + LDS_K + wid * 1024, vdst = lds0 + LDS_V + wid * 1024;
#define SB_DMA(p, slot) do { glds16s(Kh + (long)(NT - 1 - (p)) * KVBLK * PITCH, koff, (unsigned)__builtin_amdgcn_readfirstlane(kdst + (slot) * SLOTB)); \
        glds16s(Vh + (long)(NT - 1 - (p)) * KVBLK * PITCH, voff, (unsigned)__builtin_amdgcn_readfirstlane(vdst + (slot) * SLOTB)); } while (0)
    const int vb0 = (int)(lds0 + LDS_V) + ((lane >> 4) & 1) * 32 + (lane & 3) * 8 + (4 * hi + ((lane & 15) >> 2)) * 64;
    const int NT = (q0 + QB) / KVBLK, NB = NT < NBURST ? NT : NBURST;
    for (int p = 0; p < NB; ++p) SB_DMA(p, p);
    bf16x8 qr[4];
#pragma unroll
    for (int d0 = 0; d0 < 4; ++d0) qr[d0] = *(const bf16x8*)(Qw + (long)r32 * PITCH + d0 * 16 + hi * 8);
    f32x16 o[2]; o[0] = f32x16{}; o[1] = f32x16{};
    const int qrel = wid * 32 + r32;
    float R = 0.f;
    bf16x8 TD0, TD1, TONE;
#pragma unroll
    for (int j = 0; j < 8; ++j) { const int kvl = 8 * (j >> 2) + 4 * hi + (j & 3); TD0[j] = (kvl >= r32) ? (short)0x3F80 : (short)0; TD1[j] = (16 + kvl >= r32) ? (short)0x3F80 : (short)0; TONE[j] = (short)0x3F80; }
    if (NB > 4) { SB_WAITBAR(4); } else { SB_WAITBAR(0); }
    bool mid_done = (NB <= 4);
    int p = 3 - (wid >> 1);
    for (; p < NB; ++p) {
        if (p >= 4 && !mid_done) { SB_WAITBAR(0); mid_done = true; }
        sb_tile(shm + LDS_K + p * SLOTB, vb0 + p * SLOTB, qr, TD0, TD1, TONE, 3 - p, qrel, r32, hi, R, o);
        if (__all(R < SB_EXIT)) { ++p; break; }
    }
    if (!mid_done) { SB_WAITBAR(0); }
    { const bool dn = __all(R < SB_EXIT) || (p >= NT); if (lane == 0) flags[wid] = dn ? 1u : 0u; }
    SB_WAITBAR(0);
    bool alldone;
    { const u32x4 fa = *(const LAS u32x4*)flags, fb = *(const LAS u32x4*)(flags + 4); alldone = __builtin_amdgcn_readfirstlane((fa.x & fa.y & fa.z & fa.w & fb.x & fb.y & fb.z & fb.w) != 0u); }
    if (!alldone && NB < NT) {
        SB_DMA(NB, 0);
        for (int i = 0; NB + i < NT; ++i) {
            const int pp = NB + i, sl = i & 1;
            SB_WAITBAR(0);
            if (i > 0) { const LAS unsigned* fl = flags + 8 + ((i - 1) & 1) * 8; const u32x4 fa = *(const LAS u32x4*)fl, fb = *(const LAS u32x4*)(fl + 4);
                if (__builtin_amdgcn_readfirstlane((fa.x & fa.y & fa.z & fa.w & fb.x & fb.y & fb.z & fb.w) != 0u)) break; }
            if (pp + 1 < NT) SB_DMA(pp + 1, sl ^ 1);
            if (!__all(R < SB_EXIT)) sb_tile(shm + LDS_K + sl * SLOTB, vb0 + sl * SLOTB, qr, TD0, TD1, TONE, -1, qrel, r32, hi, R, o);
            { const bool dn = __all(R < SB_EXIT); if (lane == 0) flags[8 + (i & 1) * 8 + wid] = dn ? 1u : 0u; }
        }
        SB_WAITBAR(0);
    }
    bf16_t* Ow = O + (rowbase + q0 + wid * 32) * OPITCH + h * HD;
    { LAS bf16_t* stg = (LAS bf16_t*)(shm + LDS_K) + wid * 2048;
#pragma unroll
      for (int r = 0; r < 16; ++r) { const int orow = crow(r, hi);
#pragma unroll
        for (int d0 = 0; d0 < 2; ++d0) stg[orow * 64 + d0 * 32 + r32] = (bf16_t)(cvt_pk_bf16(o[d0][r], 0.f) & 0xffffu); }
      LDS_WAIT();
#pragma unroll
      for (int i = 0; i < 4; ++i) { const int row = i * 8 + (lane >> 3), ch = lane & 7; const u32x4 v = *(const LAS u32x4*)(stg + row * 64 + ch * 8); *(u32x4*)(Ow + (long)row * OPITCH + ch * 8) = v;
        att::store_row_ssq(v, hs + (rowbase + q0 + wid * 32 + row) * 16, ch); } }
    asm volatile("s_waitcnt vmcnt(0) lgkmcnt(0)\n\ts_barrier" ::: "memory");
#undef SB_DMA
}
#undef SB_WAITBAR
}

#define XB_TMO      128
#define XB_XCNT(j)  (256  + 64 * (j))
#define XB_XSUB(j)  (1280 + 64 * (j))
#define XB_XGEN(j)  (2304 + 64 * (j))
#define XB_TOP      3328
#define XB_TOPGEN   3392
#define XCD_BAR_WORDS 3456
#define XB_SPIN_CAP (1u << 18)
__device__ __forceinline__ unsigned xb_ld(unsigned* p)              { return __hip_atomic_load(p, __ATOMIC_RELAXED, __HIP_MEMORY_SCOPE_AGENT); }
__device__ __forceinline__ unsigned xb_add(unsigned* p, unsigned v) { return __hip_atomic_fetch_add(p, v, __ATOMIC_RELAXED, __HIP_MEMORY_SCOPE_AGENT); }
__device__ __forceinline__ unsigned xb_xcc_id() { return (unsigned)__builtin_amdgcn_s_getreg((3 << 11) | 20) & 0xFu; }
#define XB_SPIN(cond, bar) do { unsigned _sp = 0; while (cond) { __builtin_amdgcn_s_sleep(1); \
    if ((++_sp & 255u) == 0u) { if (xb_ld(&(bar)[XB_TMO])) break; if (_sp > XB_SPIN_CAP) { atomicAdd(&(bar)[XB_TMO], 1u); break; } } } } while (0)
struct XcdBarrier { unsigned* bar; unsigned x; volatile LAS unsigned* st; };
__device__ __forceinline__ XcdBarrier xcd_barrier_post(unsigned* bar, volatile LAS unsigned* st) {
    XcdBarrier b; b.bar = bar; b.x = xb_xcc_id(); b.st = st;
    if (threadIdx.x == 0) (void)xb_add(&bar[XB_XCNT(b.x)], 1u);
    return b;
}
__device__ __forceinline__ void xcd_barrier_complete(unsigned* bar, unsigned x, unsigned& nloc, unsigned& nx) {
    const unsigned G = gridDim.x * gridDim.y * gridDim.z;
    unsigned sum, cnt, mine, sp = 0u;
    for (;;) {
        sum = 0u; cnt = 0u; mine = 0u;
#pragma unroll
        for (unsigned j = 0; j < 16; ++j) { const unsigned c = xb_ld(&bar[XB_XCNT(j)]); sum += c; cnt += (c > 0u) ? 1u : 0u; mine = (j == x) ? c : mine; }
        if (sum == G) break;
        __builtin_amdgcn_s_sleep(1);
        if ((++sp & 255u) == 0u) { if (xb_ld(&bar[XB_TMO])) break; if (sp > XB_SPIN_CAP) { atomicAdd(&bar[XB_TMO], 1u); break; } }
    }
    nloc = mine > 0u ? mine : 1u; nx = cnt > 0u ? cnt : 1u;
}
__device__ __forceinline__ void xcd_barrier(const XcdBarrier& b) {
    asm volatile("s_waitcnt vmcnt(0)" ::: "memory");
    __syncthreads();
    if (threadIdx.x == 0) {
        unsigned* bar = b.bar;
        __builtin_amdgcn_s_waitcnt(0);
        unsigned nloc = b.st[0], nx = b.st[1];
        if (nloc == 0u) { xcd_barrier_complete(bar, b.x, nloc, nx); b.st[0] = nloc; b.st[1] = nx; }
        const unsigned old = xb_add(&bar[XB_XSUB(b.x)], 1u);
        const unsigned gen = old / nloc;
        if (old + 1u == (gen + 1u) * nloc) {
            __builtin_amdgcn_fence(__ATOMIC_RELEASE, "agent");
            asm volatile("s_waitcnt vmcnt(0)" ::: "memory");
            const unsigned og = xb_add(&bar[XB_TOP], 1u);
            const unsigned tg = og / nx;
            if (og + 1u == (tg + 1u) * nx) xb_add(&bar[XB_TOPGEN], 1u);
            else XB_SPIN(xb_ld(&bar[XB_TOPGEN]) == tg, bar);
            __builtin_amdgcn_fence(__ATOMIC_ACQUIRE, "agent");
            xb_add(&bar[XB_XGEN(b.x)], 1u);
            asm volatile("s_waitcnt vmcnt(0)" ::: "memory");
        } else {
            XB_SPIN(xb_ld(&bar[XB_XGEN(b.x)]) == gen, bar);
            __builtin_amdgcn_fence(__ATOMIC_ACQUIRE, "agent");
            asm volatile("s_waitcnt vmcnt(0)" ::: "memory");
        }
    }
    __syncthreads();
}

__device__ __forceinline__ const void* ldp(const volatile LAS unsigned* tab, int i) {
    const unsigned lo = __builtin_amdgcn_readfirstlane(tab[2 * i]), hi = __builtin_amdgcn_readfirstlane(tab[2 * i + 1]);
    return (const void*)(((unsigned long long)hi << 32) | lo);
}
struct Args {
    const float* x; const float* mem; const float* norm_mix; const float* w_in; const float* b_forget; const float* norm_fox; const float* norm_sb; const float* w_out;
    const float* norm_xattn; const float* norm_mem; const float* w_xq; const float* w_xkv; const float* w_xo; const float* norm_ffn;
    const float* w_rg; const float* b_rg; const float* w_re; const float* b_re; const float* w_gate; const float* w_up; const float* w_down; const float* norm_final;
    float* out; unsigned char* ws;
};

__device__ __forceinline__ void transpose_item(const float* W, int ldw, bf16_t* WT, int ldo, int k0, int n0, int dst_row0, const float* gain, LAS float* scr, int lane) {
    float tv[32], tg[32];
#pragma unroll
    for (int i = 0; i < 32; ++i) { const int kk = 2 * i + (lane >> 5); tv[i] = W[(size_t)(k0 + kk) * ldw + n0 + (lane & 31)]; tg[i] = gain ? gain[k0 + kk] : 1.f; }
#pragma unroll
    for (int i = 0; i < 32; ++i) { const int kk = 2 * i + (lane >> 5); scr[kk * 33 + (lane & 31)] = tv[i] * tg[i]; }
    LDS_WAIT(); asm volatile("" ::: "memory");
    const int c = lane & 7;
#pragma unroll
    for (int j = 0; j < 4; ++j) { const int n = (lane >> 3) + 8 * j; const LAS float* s = scr + (8 * c) * 33 + n;
        u32x4 o; o.x = cvt_pk_bf16(s[0 * 33], s[1 * 33]); o.y = cvt_pk_bf16(s[2 * 33], s[3 * 33]); o.z = cvt_pk_bf16(s[4 * 33], s[5 * 33]); o.w = cvt_pk_bf16(s[6 * 33], s[7 * 33]);
        *(u32x4*)(WT + (size_t)(dst_row0 + n) * ldo + k0 + 8 * c) = o; }
    LDS_WAIT(); asm volatile("" ::: "memory");
}

struct SchedDense {
    const char* A; const char* Bt; int nM, nN, G, c; size_t a_tile, b_tile, b_batch; int split_tiles;
    __device__ __forceinline__ bool next(int i, pg8::Unit& u) const {
        int pm, pn; if (!pg8::tile_order(i, G, c, nM, nN, pm, pn)) return false;
        u.a = A + (size_t)pm * a_tile; u.b = Bt + (size_t)pn * b_tile + (size_t)(pm >> 5) * b_batch; u.orow = pm * 256;
        if (split_tiles) { u.aux = pn / split_tiles; u.ocol = (pn % split_tiles) * 256; } else { u.aux = 1; u.ocol = pn * 256; }
        u.rows = nullptr; u.nvalid = 256; return true;
    }
};
struct SchedGH {
    const char* KVm; const char* Wxq; const char* Wxo; int G, c;
    __device__ __forceinline__ bool next(int i, pg8::Unit& u) const {
        const int L = i * G + c; if (L >= 256) return false;
        const int kind = L >> 7, r = L & 127, bh = r >> 2, j = r & 3, b = bh >> 2, h = bh & 3;
        if (kind == 0) { u.a = KVm + ((size_t)(b * 256) * 2048 + h * 256) * 2; u.b = Wxq + ((size_t)(256 * j) * 1024 + h * 256) * 2; u.orow = b * 1024 + h * 256; u.ocol = 256 * j; u.aux = 1; }
        else { u.a = Wxo + ((size_t)(256 * j) * 1024 + h * 256) * 2; u.b = KVm + ((size_t)(b * 256) * 2048 + 1024 + h * 256) * 2; u.orow = b * 1024 + 256 * j; u.ocol = h * 256; u.aux = 2; }
        u.rows = nullptr; u.nvalid = 256; return true;
    }
};
template <int KIND> struct SchedGHk { SchedGH s; __device__ __forceinline__ bool next(int i, pg8::Unit& u) const { const int c2 = (s.G >= 256) ? s.c - 128 * KIND : s.c; if (c2 < 0) return false; const int L = i * s.G + c2; if (L >= 128) return false; SchedGH t = s; t.G = 1; t.c = 0; return t.next(128 * KIND + L, u); } };
struct EpiGH { static constexpr bool HAS_MID = false; bf16_t* GTp; bf16_t* HTp; __device__ __forceinline__ void operator()(const f32x4 (&acc)[2][2][4][2], const pg8::Unit& u, int wr, int wc, int fr, int fq) const {
    pg8::EpiBf16 e{u.aux == 1 ? GTp : HTp, DM, nullptr, 0, 1.f, 1.f, nullptr}; pg8::Unit v = u; v.aux = 1; e(acc, v, wr, wc, fr, fq); } };
struct SchedMoe {
    const char* A; const char* W; const int* list; const LAS int* tbl; int G, c, NPN; size_t w_exp, w_tile, a_tile; int ocol_w;
    __device__ __forceinline__ bool next(int i, pg8::Unit& u) const {
        const int L = i * G + c; const int tl = L / NPN, pn = L % NPN;
        if (tl >= __builtin_amdgcn_readfirstlane(tbl[16])) return false;
        int e = 0;
#pragma unroll 1
        for (int x = 1; x < NEXP; ++x) { if (tl >= __builtin_amdgcn_readfirstlane(tbl[x])) e = x; }
        const int j = tl - __builtin_amdgcn_readfirstlane(tbl[e]), n = __builtin_amdgcn_readfirstlane(tbl[32 + e]) - 256 * j;
        u.a = A + (size_t)tl * a_tile; u.b = W + (size_t)e * w_exp + (size_t)pn * w_tile; u.orow = tl * 256; u.ocol = pn * ocol_w; u.aux = 1;
        u.rows = list + (size_t)e * M + 256 * j; u.nvalid = n < 256 ? n : 256; return true;
    }
};
__device__ __forceinline__ void moe_table(LAS int* tbl, const unsigned* ctl) {
    if (threadIdx.x == 0) { int base = 0; for (int e = 0; e < NEXP; ++e) { const int n = (int)ctl[CW_CNT + 64 * e]; tbl[e] = base; tbl[32 + e] = n; base += (n + 255) >> 8; } tbl[16] = base; }
    __syncthreads();
}

__global__ void __launch_bounds__(NWAVES * 64, 2) hymba_fwd(Args args) {
    extern __shared__ __attribute__((aligned(16))) unsigned char lds_raw[];
    LAS unsigned char* lds = (LAS unsigned char*)lds_raw;
    volatile LAS unsigned* MISC = (volatile LAS unsigned*)(lds + MISC_OFF);
    const int tid0 = threadIdx.x; const int wave = __builtin_amdgcn_readfirstlane(tid0 >> 6);
    const int G = gridDim.x; const int bx = blockIdx.x; const int vcu = (G % 8 == 0) ? (bx % 8) * (G / 8) + bx / 8 : bx;
    volatile LAS unsigned* ATAB = (volatile LAS unsigned*)(lds + MISC_OFF + 512);
    for (int u = tid0; u < 256; u += NWAVES * 64) ((LAS unsigned*)(lds + MISC_OFF))[u] = 0u;
    __syncthreads();
    if (tid0 == 0) { const float* const* ap = (const float* const*)&args;
#pragma unroll
        for (int i = 0; i < 24; ++i) { const unsigned long long v = (unsigned long long)ap[i]; ATAB[2 * i] = (unsigned)v; ATAB[2 * i + 1] = (unsigned)(v >> 32); } }
    __syncthreads();
#define ARGP(name) ((const float*)ldp(ATAB, (int)(offsetof(Args, name) / 8)))
#define PHASE_PTRS \
    int tid = threadIdx.x; asm volatile("" : "+v"(tid)); const int lane = tid & 63; (void)lane; \
    unsigned char* const ws = (unsigned char*)ldp(ATAB, 23); float* const out = (float*)ldp(ATAB, 22); unsigned* const ctl = (unsigned*)(ws + WS_CTL); (void)out; (void)ctl; \
    bf16_t* const Win_t = (bf16_t*)(ws + WS_WIN); bf16_t* const Wout_t = (bf16_t*)(ws + WS_WOUT); bf16_t* const Wxq_n = (bf16_t*)(ws + WS_WXQ); bf16_t* const Wxkv_t = (bf16_t*)(ws + WS_WXKV); \
    bf16_t* const Wxo_t = (bf16_t*)(ws + WS_WXO); bf16_t* const Wgu_t = (bf16_t*)(ws + WS_WGU); bf16_t* const Wd_t = (bf16_t*)(ws + WS_WD); \
    float* const RX = (float*)(ws + WS_RX); float* const RMEM = (float*)(ws + WS_RMEM); float* const LF = (float*)(ws + WS_LF); float* const CC = (float*)(ws + WS_C2); float* const SSQ = (float*)(ws + WS_SSQ); \
    int* const TOKSLOT = (int*)(ws + WS_TOKSLOT); float* const TOKW = (float*)(ws + WS_TOKW); int* const LIST = (int*)(ws + WS_LIST); \
    bf16_t* const MEMB = (bf16_t*)(ws + WS_MEMB); bf16_t* const KVM = (bf16_t*)(ws + WS_KVM); bf16_t* const GT = (bf16_t*)(ws + WS_GT); bf16_t* const HT = (bf16_t*)(ws + WS_HT); \
    bf16_t* const XB = (bf16_t*)(ws + WS_XB); bf16_t* const QKV = (bf16_t*)(ws + WS_QKV); bf16_t* const H1B = (bf16_t*)(ws + WS_H1B); bf16_t* const U2B = (bf16_t*)(ws + WS_U2B); bf16_t* const HID = (bf16_t*)(ws + WS_HID); \
    bf16_t* const OAB = (bf16_t*)(ws + WS_O); bf16_t* const YB = (bf16_t*)(ws + WS_Y); bf16_t* const KX = (bf16_t*)(ws + WS_KX); (void)KX; float* const HS = (float*)(ws + WS_HS); (void)HS; float* const R2 = (float*)(ws + WS_R2); (void)R2; \
    (void)Win_t; (void)Wout_t; (void)Wxq_n; (void)Wxkv_t; (void)Wxo_t; (void)Wgu_t; (void)Wd_t; (void)RX; (void)RMEM; (void)LF; (void)CC; (void)SSQ; (void)TOKSLOT; (void)TOKW; (void)LIST; \
    (void)MEMB; (void)KVM; (void)GT; (void)HT; (void)XB; (void)QKV; (void)H1B; (void)U2B; (void)HID; (void)OAB; (void)YB;
    XcdBarrier bar;
    { unsigned char* const ws0 = (unsigned char*)ldp(ATAB, 23); bar = xcd_barrier_post((unsigned*)(ws0 + WS_CTL) + CW_BAR, MISC + 8); }
    const int gw = vcu * NWAVES + wave, NGW = G * NWAVES;
    unsigned long long t_pa = 0, t_pb = 0; (void)t_pa; (void)t_pb;


    if (PROBE_LO == 0) t_pa = __builtin_amdgcn_s_memrealtime();
    if (PH(0))
    for (int rep_ = 0; rep_ < REPS(0); ++rep_)
    {
        PHASE_PTRS
        LAS float* wfT = (LAS float*)(lds + RING_OFF);
        LAS float* scr = (LAS float*)(lds + RING_OFF + 32768 + wave * 8448);
        { const float* win = ARGP(w_in); const float* gmix = ARGP(norm_mix);
          f32x4 fa[2], fb[2]; float gk[2];
#pragma unroll
          for (int q = 0; q < 2; ++q) { const int k = tid + 512 * q; gk[q] = gmix[k]; fa[q] = *(const f32x4*)(win + (size_t)k * WIN_LD + NPROJ); fb[q] = *(const f32x4*)(win + (size_t)k * WIN_LD + NPROJ + 4); }
#pragma unroll
          for (int q = 0; q < 2; ++q) { const int k = tid + 512 * q;
#pragma unroll
              for (int j = 0; j < 4; ++j) { wfT[j * DM + k] = fa[q][j] * gk[q]; wfT[(4 + j) * DM + k] = fb[q][j] * gk[q]; } } }
        constexpr int I_IN = 16 * 96, I_OUT = 16 * 32, I_XKV = 16 * 64, I_XO = 16 * 32, I_G = 16 * 16 * 8, I_U = I_G, I_D = 16 * 4 * 32, I_XQ = 1024;
        constexpr int NITEMS = I_IN + I_OUT + I_XKV + I_XO + I_G + I_U + I_D + I_XQ;
        for (int it = gw; it < NITEMS; it += NGW) {
            int r = it;
            if (r < I_IN) { const int kb = r / 96, nb = r % 96; transpose_item(ARGP(w_in), WIN_LD, Win_t, DM, 64 * kb, 32 * nb, 32 * nb, ARGP(norm_mix), scr, lane); continue; } r -= I_IN;
            if (r < I_OUT) { const int kb = r / 32, nb = r % 32; const float* gn = (64 * kb < HW) ? ARGP(norm_fox) : (ARGP(norm_sb) - HW); transpose_item(ARGP(w_out), DM, Wout_t, DM, 64 * kb, 32 * nb, 32 * nb, gn, scr, lane); continue; } r -= I_OUT;
            if (r < I_XKV) { const int kb = r / 64, nb = r % 64; transpose_item(ARGP(w_xkv), 2 * DM, Wxkv_t, DM, 64 * kb, 32 * nb, 32 * nb, ARGP(norm_mem), scr, lane); continue; } r -= I_XKV;
            if (r < I_XO) { const int kb = r / 32, nb = r % 32; transpose_item(ARGP(w_xo), DM, Wxo_t, DM, 64 * kb, 32 * nb, 32 * nb, nullptr, scr, lane); continue; } r -= I_XO;
            if (r < I_G + I_U) { const int up = r >= I_G; const int q = up ? r - I_G : r; const int e = q / 128, kb = (q % 128) / 8, nb = q % 8; const int n0 = 32 * nb;
                const float* W = (up ? ARGP(w_up) : ARGP(w_gate)) + (size_t)e * DM * DFF;
                transpose_item(W, DFF, Wgu_t + (size_t)e * 512 * DM, DM, 64 * kb, n0, 256 * (n0 / 128) + (n0 % 128) + (up ? 128 : 0), ARGP(norm_ffn), scr, lane); continue; } r -= I_G + I_U;
            if (r < I_D) { const int e = r / 128, kb = (r % 128) / 32, nb = r % 32; transpose_item(ARGP(w_down) + (size_t)e * DFF * DM, DM, Wd_t + (size_t)e * DM * DFF, DFF, 64 * kb, 32 * nb, 32 * nb, nullptr, scr, lane); continue; } r -= I_D;
            { const int k = r; const float gk = ARGP(norm_xattn)[k]; const f32x4* src = (const f32x4*)(ARGP(w_xq) + (size_t)k * DM) + lane; u32x2* dst = (u32x2*)(Wxq_n + (size_t)k * DM) + lane;
#pragma unroll
              for (int j = 0; j < 4; ++j) { const f32x4 v = src[64 * j] * gk; u32x2 w; w.x = cvt_pk_bf16(v[0], v[1]); w.y = cvt_pk_bf16(v[2], v[3]); dst[64 * j] = w; } }
        }
        __syncthreads();
        const float* xin = ARGP(x); const float* memin = ARGP(mem); const float* bfg = ARGP(b_forget);
        f32x4 vnx[4];
        { const int r0_ = gw; if (r0_ < M + MEMROWS) { const bool im_ = r0_ >= M; const f32x4* xr = (const f32x4*)((im_ ? memin : xin) + (size_t)(im_ ? r0_ - M : r0_) * DM) + lane;
#pragma unroll
            for (int j = 0; j < 4; ++j) vnx[j] = xr[64 * j]; } }
        for (int row = gw; row < M + MEMROWS; row += NGW) {
            const bool is_mem = row >= M; const int r = is_mem ? row - M : row;
            f32x4 v[4]; float s = 0.f;
#pragma unroll
            for (int j = 0; j < 4; ++j) v[j] = vnx[j];
            { const int nr_ = row + NGW; if (nr_ < M + MEMROWS) { const bool im_ = nr_ >= M; const f32x4* xr = (const f32x4*)((im_ ? memin : xin) + (size_t)(im_ ? nr_ - M : nr_) * DM) + lane;
#pragma unroll
                for (int j = 0; j < 4; ++j) vnx[j] = xr[64 * j]; } }
#pragma unroll
            for (int j = 0; j < 4; ++j) s += (v[j][0] * v[j][0] + v[j][1] * v[j][1]) + (v[j][2] * v[j][2] + v[j][3] * v[j][3]);
            const float rinv = rsqrtf(wave_sum(s) * (1.0f / DM) + EPS);
            u32x2* o8 = (u32x2*)((is_mem ? MEMB : XB) + (size_t)r * DM) + lane;
#pragma unroll
            for (int j = 0; j < 4; ++j) { u32x2 w; w.x = cvt_pk_bf16(v[j][0], v[j][1]); w.y = cvt_pk_bf16(v[j][2], v[j][3]); o8[64 * j] = w; }
            if (is_mem) { if (lane == 0) RMEM[r] = rinv; continue; }
            float f[8];
#pragma unroll
            for (int jj = 0; jj < 8; ++jj) { float a = 0.f;
#pragma unroll
                for (int j = 0; j < 4; ++j) { const f32x4 w4 = *(const LAS f32x4*)(wfT + jj * DM + 256 * j + 4 * lane); a += (v[j][0] * w4[0] + v[j][1] * w4[1]) + (v[j][2] * w4[2] + v[j][3] * w4[3]); }
                f[jj] = wave_sum(a); }
            if (lane == 0) RX[r] = rinv;
            if (lane < 8) { float fl = 0.f;
#pragma unroll
                for (int jj = 0; jj < 8; ++jj) fl = (lane == jj) ? f[jj] : fl;
                fl = fl * rinv + bfg[lane];
                const float ls = fminf(fl, 0.f) - log1pf(expf(-fabsf(fl)));
                LF[(size_t)r * 8 + lane] = ls * LOG2E; }
        }
    }
    xcd_barrier(bar);
    if (PROBE_HI == 0) t_pb = __builtin_amdgcn_s_memrealtime();

    if (PROBE_LO == 1) t_pa = __builtin_amdgcn_s_memrealtime();
    if (PH(1))
    if (vcu < 32) {
        PHASE_PTRS
        const int b = vcu >> 2, h = (vcu & 3) * 2 + (wave >> 2), seg = wave & 3, s0 = seg * 2048 + lane * 32;
        const float* src = LF + ((size_t)b * SEQ + s0) * 8 + h;
        float p[32];
#pragma unroll
        for (int j = 0; j < 32; ++j) p[j] = src[j * 8];
#pragma unroll
        for (int j = 1; j < 32; ++j) p[j] += p[j - 1];
        float inc = p[31];
#pragma unroll
        for (int o = 1; o < 64; o <<= 1) { const float y = __shfl_up(inc, o); if (lane >= o) inc += y; }
        LAS float* tot = (LAS float*)(lds + EXTRA_OFF);
        if (lane == 63) tot[wave] = inc;
        __syncthreads();
        float off = inc - p[31];
        for (int q = 0; q < 3; ++q) if (q < seg) off += tot[(wave & 4) + q];
        float* dst = CC + ((size_t)b * NH + h) * SEQ + s0; bf16_t* kx = KX + (((size_t)b * NH + h) * SEQ + s0) * 8;
#pragma unroll
        for (int j = 0; j < 32; ++j) { const float x = off + p[j]; dst[j] = x;
            unsigned hm, lo; fox::split3(-x, hm, lo); u32x4 w; w.x = 0x3F803F80u; w.y = 0x3F80u | (hm << 16); w.z = (hm >> 16) | (lo << 16); w.w = 0u;
            *(u32x4*)(kx + j * 8) = w; }
        VM_WAIT(); __syncthreads();
    }
    if (PH(1))
    for (int rep_ = 0; rep_ < REPS(1); ++rep_)
    {
        PHASE_PTRS
        pg8::Gemm g{DM, DM, DM};
        SchedDense S{(const char*)XB, (const char*)Win_t, M / 256, NPROJ / 256, G, bx, (size_t)256 * DM * 2, (size_t)256 * DM * 2, 0, 2};
        pg8::EpiBf16 E{QKV, HW, RX, QKV_STRIDE, C2, C2, ctl + CW_KN};
        pg8::gemm_phase<pg8::EpiBf16, SchedDense, true, false>(lds + RING_OFF, g, S, E);
    }
    xcd_barrier(bar);
    if (PROBE_HI == 1) t_pb = __builtin_amdgcn_s_memrealtime();

    if (PROBE_LO == 2) t_pa = __builtin_amdgcn_s_memrealtime();
    if (PH(2))
    {
        PHASE_PTRS
        const bf16_t* QA = QKV; const bf16_t* KA = QKV + QKV_STRIDE; const bf16_t* VA = QKV + 2 * QKV_STRIDE;
        const bf16_t* QBp = QKV + 3 * QKV_STRIDE; const bf16_t* KBp = QKV + 4 * QKV_STRIDE; const bf16_t* VBp = QKV + 5 * QKV_STRIDE;
        bf16_t* OA = OAB; bf16_t* OB = OAB + HW;
        LAS char* shm = (LAS char*)(lds + RING_OFF);
        { pg8::Gemm g{DM, DM, DM};
          SchedDense S2{(const char*)MEMB, (const char*)Wxkv_t, MEMROWS / 256, 2 * DM / 256, G, bx, (size_t)256 * DM * 2, (size_t)256 * DM * 2, 0, 0};
          pg8::EpiBf16 E2{KVM, 2 * DM, RMEM, 0, 1.f, 1.f, nullptr};
          pg8::gemm_phase<pg8::EpiBf16, SchedDense, true, false>(lds + RING_OFF, g, S2, E2);
          VM_WAIT(); __syncthreads(); }
        for (int rep = 0; rep < REP_FOX; ++rep)
        for (int i = 0; i < 8; ++i) { const int bh = (vcu >> 5) * 8 + i, x = vcu & 31, qb = (i & 1) ? 31 - x : x;
            const float kmax = sqrtf(__uint_as_float(ctl[CW_KN + bh * 2]) + __uint_as_float(ctl[CW_KN + bh * 2 + 1])) * 1.01f;
            fox::fox_unit<8>(bh, qb, QA, KA, VA, OA, HS + (bh & 7), CC + (size_t)bh * SEQ, KX + (size_t)bh * SEQ * 8, kmax, shm); }
        { volatile LAS unsigned* qs = MISC + 16;
          unsigned nxt = 0u;
          if (tid == 0) qs[0] = __hip_atomic_fetch_add(ctl + CW_SBQ, 1u, __ATOMIC_RELAXED, __HIP_MEMORY_SCOPE_AGENT);
          __syncthreads();
          unsigned idx = qs[0];
          while (idx < (unsigned)(BATCH * NH * 32 * REP_SB)) {
              __syncthreads();
              if (tid == 0) nxt = __hip_atomic_fetch_add(ctl + CW_SBQ, 1u, __ATOMIC_RELAXED, __HIP_MEMORY_SCOPE_AGENT);
              const int un = (int)(idx % (unsigned)(BATCH * NH * 32)), bh = un >> 5, qb = un & 31;
              sbk::sb_unit(bh >> 3, bh & 7, qb, QBp, KBp, VBp, OB, HS + 8 + (bh & 7), shm);
              if (tid == 0) qs[0] = nxt;
              __syncthreads();
              idx = qs[0];
          } }
    }
    xcd_barrier(bar);
    if (PROBE_HI == 2) t_pb = __builtin_amdgcn_s_memrealtime();

    if (PROBE_LO == 4) t_pa = __builtin_amdgcn_s_memrealtime();
    if (PH(4))
    for (int rep_ = 0; rep_ < REPS(4); ++rep_)
    {
        PHASE_PTRS
        pg8::Gemm g{DM, DM, DM};
        SchedDense S{(const char*)OAB, (const char*)Wout_t, M / 256, DM / 256, G, bx, (size_t)256 * DM * 2, (size_t)256 * DM * 2, 0, 0};
        pg8::EpiOutProj E{XB, H1B, SSQ, HS};
        pg8::gemm_phase<pg8::EpiOutProj, SchedDense, true, false>(lds + RING_OFF, g, S, E);
        pg8::Gemm g2{0, 0, 256};
        SchedGH SG{(const char*)KVM, (const char*)Wxq_n, (const char*)Wxo_t, G, bx};
        EpiGH EG{GT, HT};
        g2.lda = 2 * DM; g2.ldb = DM; SchedGHk<0> S0{SG}; pg8::gemm_phase<EpiGH, SchedGHk<0>, true, false>(lds + RING_OFF, g2, S0, EG);
        g2.lda = DM; g2.ldb = 2 * DM; SchedGHk<1> S1{SG}; pg8::gemm_phase<EpiGH, SchedGHk<1>, true, false>(lds + RING_OFF, g2, S1, EG);
    }
    xcd_barrier(bar);
    if (PROBE_HI == 4) t_pb = __builtin_amdgcn_s_memrealtime();

    if (PROBE_LO == 5) t_pa = __builtin_amdgcn_s_memrealtime();
    if (PH(5))
    for (int rep_ = 0; rep_ < REPS(5); ++rep_)
    {
        PHASE_PTRS
        pg8::Gemm g{DM, DM, DM};
        SchedDense S{(const char*)H1B, (const char*)GT, M / 256, DM / 256, G, bx, (size_t)256 * DM * 2, (size_t)256 * DM * 2, (size_t)DM * DM * 2, 0};
        pg8::EpiSoftmax E{XB, SSQ, (LAS float*)(lds + EXTRA_OFF)};
        pg8::gemm_phase<pg8::EpiSoftmax, SchedDense, true, false>(lds + RING_OFF, g, S, E);
    }
    xcd_barrier(bar);
    if (PROBE_HI == 5) t_pb = __builtin_amdgcn_s_memrealtime();

    if (PROBE_LO == 6) t_pa = __builtin_amdgcn_s_memrealtime();
    if (PH(6))
    {
        PHASE_PTRS
        pg8::Gemm g{DM, DM, DM};
        SchedDense S{(const char*)XB, (const char*)HT, M / 256, DM / 256, G, bx, (size_t)256 * DM * 2, (size_t)256 * DM * 2, (size_t)DM * DM * 2, 0};
        pg8::EpiResidBf16 E{H1B};
        pg8::gemm_phase<pg8::EpiResidBf16, SchedDense, true, false>(lds + RING_OFF, g, S, E);
    }
    xcd_barrier(bar);
    if (PROBE_HI == 6) t_pb = __builtin_amdgcn_s_memrealtime();

    if (PROBE_LO == 7) t_pa = __builtin_amdgcn_s_memrealtime();
    if (PH(7))
    {
        PHASE_PTRS
        LAS bf16_t* wBh = (LAS bf16_t*)(lds + RING_OFF); LAS bf16_t* wBl = wBh + 20 * DM;
        { const f32x4* wg4 = (const f32x4*)ARGP(w_rg); const f32x4* we4 = (const f32x4*)ARGP(w_re); const float* gf = ARGP(norm_ffn);
          f32x4 ga[2], ea[2][4]; float gk[2];
#pragma unroll
          for (int q = 0; q < 2; ++q) { const int k = tid + 512 * q; ga[q] = wg4[k]; gk[q] = gf[k];
#pragma unroll
              for (int c = 0; c < 4; ++c) ea[q][c] = we4[k * 4 + c]; }
#pragma unroll
          for (int q = 0; q < 2; ++q) { const int k = tid + 512 * q;
#pragma unroll
              for (int j = 0; j < 4; ++j) { { const float v = ga[q][j] * gk[q]; const unsigned hi_ = cvt_pk_bf16(v, 0.f) & 0xffffu; wBh[j * DM + k] = (bf16_t)hi_; wBl[j * DM + k] = (bf16_t)(cvt_pk_bf16(v - __uint_as_float(hi_ << 16), 0.f) & 0xffffu); }
#pragma unroll
                  for (int c = 0; c < 4; ++c) { const float v = ea[q][c][j] * gk[q]; const unsigned hi_ = cvt_pk_bf16(v, 0.f) & 0xffffu; const int col = 4 + 4 * c + j; wBh[col * DM + k] = (bf16_t)hi_; wBl[col * DM + k] = (bf16_t)(cvt_pk_bf16(v - __uint_as_float(hi_ << 16), 0.f) & 0xffffu); } } } }
        LAS int* dec_e = (LAS int*)(lds + RING_OFF + 81920); LAS float* dec_w = (LAS float*)(lds + RING_OFF + 81920 + 2048); LAS int* dec_r = (LAS int*)(lds + RING_OFF + 81920 + 4096);
        LAS int* hist = (LAS int*)(lds + RING_OFF + 81920 + 6144); LAS int* ebase = hist + 16;
        if (tid < 16) hist[tid] = 0;
        __syncthreads();
        const float brg0 = ARGP(b_rg)[0], brg1 = ARGP(b_rg)[1], brg2 = ARGP(b_rg)[2], brg3 = ARGP(b_rg)[3]; const float* bre = ARGP(b_re);
        const int tok = lane & 31, half = lane >> 5, jcol = tok < 20 ? tok : 19;
        for (int it = 0; it * NGW < M / 32; ++it) {
            const int T = gw + it * NGW; const bool act = T < M / 32; const int r0 = act ? 32 * T : 0;
            const bf16_t* rowp = H1B + (size_t)(r0 + tok) * DM + 512 * half;
            const LAS bf16_t* wph = wBh + jcol * DM + 512 * half; const LAS bf16_t* wpl = wBl + jcol * DM + 512 * half;
            f32x16 ah0 = f32x16{}, ah1 = f32x16{}, al0 = f32x16{}, al1 = f32x16{}; float ssq = 0.f;
#pragma unroll 4
            for (int sidx = 0; sidx < 64; sidx += 2) {
                const u32x4 a0 = *(const u32x4*)(rowp + 8 * sidx), a1 = *(const u32x4*)(rowp + 8 * sidx + 8);
                const bf16x8 wh0 = *(const LAS bf16x8*)(wph + 8 * sidx), wl0 = *(const LAS bf16x8*)(wpl + 8 * sidx), wh1 = *(const LAS bf16x8*)(wph + 8 * sidx + 8), wl1 = *(const LAS bf16x8*)(wpl + 8 * sidx + 8);
                ah0 = MFMA32(wh0, __builtin_bit_cast(bf16x8, a0), ah0); al0 = MFMA32(wl0, __builtin_bit_cast(bf16x8, a0), al0);
                ah1 = MFMA32(wh1, __builtin_bit_cast(bf16x8, a1), ah1); al1 = MFMA32(wl1, __builtin_bit_cast(bf16x8, a1), al1);
                ssq += (bf16lo(a0.x) * bf16lo(a0.x) + bf16hi(a0.x) * bf16hi(a0.x)) + (bf16lo(a0.y) * bf16lo(a0.y) + bf16hi(a0.y) * bf16hi(a0.y)) + (bf16lo(a0.z) * bf16lo(a0.z) + bf16hi(a0.z) * bf16hi(a0.z)) + (bf16lo(a0.w) * bf16lo(a0.w) + bf16hi(a0.w) * bf16hi(a0.w));
                ssq += (bf16lo(a1.x) * bf16lo(a1.x) + bf16hi(a1.x) * bf16hi(a1.x)) + (bf16lo(a1.y) * bf16lo(a1.y) + bf16hi(a1.y) * bf16hi(a1.y)) + (bf16lo(a1.z) * bf16lo(a1.z) + bf16hi(a1.z) * bf16hi(a1.z)) + (bf16lo(a1.w) * bf16lo(a1.w) + bf16hi(a1.w) * bf16hi(a1.w));
            }
            const float rinv = rsqrtf((att::swap_lo(ssq) + att::swap_hi(ssq)) * (1.0f / DM) + EPS);
            float lg[20];
#pragma unroll
            for (int r = 0; r < 12; ++r) { const float c = (ah0[r] + ah1[r]) + (al0[r] + al1[r]); auto rr = __builtin_amdgcn_permlane32_swap(__float_as_uint(c), __float_as_uint(c), false, false);
                const int jl = (r & 3) + 8 * (r >> 2); lg[jl] = __uint_as_float(rr[0]) * rinv; if (r < 8) lg[jl + 4] = __uint_as_float(rr[1]) * rinv; }
            float g0 = lg[0] + brg0, g1 = lg[1] + brg1, g2 = lg[2] + brg2, g3 = lg[3] + brg3;
            int gi = 0; float gm = g0; if (g1 > gm) { gm = g1; gi = 1; } if (g2 > gm) { gm = g2; gi = 2; } if (g3 > gm) { gm = g3; gi = 3; }
            const float gval = 1.0f / (expf(g0 - gm) + expf(g1 - gm) + expf(g2 - gm) + expf(g3 - gm));
            float el[4];
#pragma unroll
            for (int j = 0; j < 4; ++j) { const float e0 = lg[4 + j], e1 = lg[8 + j], e2 = lg[12 + j], e3 = lg[16 + j]; el[j] = ((gi == 0) ? e0 : (gi == 1) ? e1 : (gi == 2) ? e2 : e3) + bre[gi * 4 + j]; }
            int i0 = 0; float m0 = el[0];
#pragma unroll
            for (int j = 1; j < 4; ++j) if (el[j] > m0) { m0 = el[j]; i0 = j; }
            int i1 = -1; float m1 = -3.0e38f;
#pragma unroll
            for (int j = 0; j < 4; ++j) if (j != i0 && el[j] > m1) { m1 = el[j]; i1 = j; }
            const float w0 = 1.0f / (1.0f + expf(m1 - m0)), w1 = 1.0f - w0;
            if (act) { const int e = gi * 4 + (half == 0 ? i0 : i1); const float w = gval * (half == 0 ? w0 : w1);
                const int idx = (wave * 32 + tok) * 2 + half; dec_e[idx] = e; dec_w[idx] = w; dec_r[idx] = __hip_atomic_fetch_add(hist + e, 1, __ATOMIC_RELAXED, __HIP_MEMORY_SCOPE_WORKGROUP);
                if (half == 0) R2[r0 + tok] = rinv; }
            __syncthreads();
            if (tid < 16) { const int n = hist[tid]; ebase[tid] = n ? (int)__hip_atomic_fetch_add(ctl + CW_CNT + 64 * tid, (unsigned)n, __ATOMIC_RELAXED, __HIP_MEMORY_SCOPE_AGENT) : 0; }
            __syncthreads();
            if (act) { const int row = r0 + (lane >> 1), idx = wave * 64 + lane; const int e = dec_e[idx], pos = ebase[e] + dec_r[idx];
                LIST[(size_t)e * M + pos] = row; TOKSLOT[(size_t)row * 2 + (lane & 1)] = (e << 20) | pos; TOKW[(size_t)row * 2 + (lane & 1)] = dec_w[idx]; }
            __syncthreads();
            if (tid < 16) hist[tid] = 0;
            __syncthreads();
        }
    }
    xcd_barrier(bar);
    if (PROBE_HI == 7) t_pb = __builtin_amdgcn_s_memrealtime();

    if (PROBE_LO == 8) t_pa = __builtin_amdgcn_s_memrealtime();
    if (PH(8))
    for (int rep_ = 0; rep_ < REPS(8); ++rep_)
    {
        PHASE_PTRS
        pg8::Gemm g{DM, DM, DM};
        LAS int* tbl = (LAS int*)(lds + EXTRA_OFF + 8192); moe_table(tbl, ctl);
        SchedMoe S; S.A = (const char*)H1B; S.W = (const char*)Wgu_t; S.list = LIST; S.tbl = tbl; S.G = G; S.c = bx; S.NPN = 2; S.w_exp = (size_t)512 * DM * 2; S.w_tile = (size_t)256 * DM * 2; S.a_tile = 0; S.ocol_w = 128;
        pg8::EpiSwiglu E{HID, R2};
        pg8::gemm_phase<pg8::EpiSwiglu, SchedMoe, true, true>(lds + RING_OFF, g, S, E);
    }
    xcd_barrier(bar);
    if (PROBE_HI == 8) t_pb = __builtin_amdgcn_s_memrealtime();

    if (PROBE_LO == 9) t_pa = __builtin_amdgcn_s_memrealtime();
    if (PH(9))
    for (int rep_ = 0; rep_ < REPS(9); ++rep_)
    {
        PHASE_PTRS
        pg8::Gemm g{DFF, DFF, DFF};
        LAS int* tbl = (LAS int*)(lds + EXTRA_OFF + 8192);
        SchedMoe S; S.A = (const char*)HID; S.W = (const char*)Wd_t; S.list = LIST; S.tbl = tbl; S.G = G; S.c = bx; S.NPN = 4; S.w_exp = (size_t)DM * DFF * 2; S.w_tile = (size_t)256 * DFF * 2; S.a_tile = (size_t)256 * DFF * 2; S.ocol_w = 256;
        pg8::EpiBf16 E{YB, DM, nullptr, 0, 1.f, 1.f, nullptr};
        pg8::gemm_phase<pg8::EpiBf16, SchedMoe, true, false>(lds + RING_OFF, g, S, E);
    }
    xcd_barrier(bar);
    if (PROBE_HI == 9) t_pb = __builtin_amdgcn_s_memrealtime();

    if (PROBE_LO == 10) t_pa = __builtin_amdgcn_s_memrealtime();
    if (PH(10))
    {
        PHASE_PTRS
        const LAS int* tb = (const LAS int*)(lds + EXTRA_OFF + 8192);
        const f32x4* gp = (const f32x4*)ARGP(norm_final) + lane;
        int sl0 = 0, sl1 = 0; float sw0 = 0.f, sw1 = 0.f;
        u32x2 ya_n[4], yb_n[4], hh_n[4]; float w0_n = 0.f, w1_n = 0.f;
#define P10_SLOTS(rw) do { sl0 = TOKSLOT[(size_t)(rw) * 2]; sl1 = TOKSLOT[(size_t)(rw) * 2 + 1]; sw0 = TOKW[(size_t)(rw) * 2]; sw1 = TOKW[(size_t)(rw) * 2 + 1]; } while (0)
#define P10_DATA(rw) do { const int r0_ = tb[sl0 >> 20] * 256 + (sl0 & 0xfffff), r1_ = tb[sl1 >> 20] * 256 + (sl1 & 0xfffff); w0_n = sw0; w1_n = sw1; \
        const u32x2* y0_ = (const u32x2*)(YB + (size_t)r0_ * DM) + lane; const u32x2* y1_ = (const u32x2*)(YB + (size_t)r1_ * DM) + lane; const u32x2* h_ = (const u32x2*)(H1B + (size_t)(rw) * DM) + lane; \
        _Pragma("unroll") for (int j = 0; j < 4; ++j) { ya_n[j] = y0_[64 * j]; yb_n[j] = y1_[64 * j]; hh_n[j] = h_[64 * j]; } } while (0)
        if (gw < M) { P10_SLOTS(gw); P10_DATA(gw); if (gw + NGW < M) P10_SLOTS(gw + NGW); }
        for (int row = gw; row < M; row += NGW) {
            u32x2 ya[4], yb[4], hh[4]; const float w0 = w0_n, w1 = w1_n;
#pragma unroll
            for (int j = 0; j < 4; ++j) { ya[j] = ya_n[j]; yb[j] = yb_n[j]; hh[j] = hh_n[j]; }
            if (row + NGW < M) { P10_DATA(row + NGW); if (row + 2 * NGW < M) P10_SLOTS(row + 2 * NGW); }
            f32x4* hr = (f32x4*)(out + (size_t)row * DM) + lane;
            f32x4 v[4]; float s = 0.f;
#pragma unroll
            for (int j = 0; j < 4; ++j) { const u32x2 a = ya[j], b = yb[j]; const u32x2 hx = hh[j]; f32x4 h = {bf16lo(hx.x), bf16hi(hx.x), bf16lo(hx.y), bf16hi(hx.y)};
                h[0] += w0 * bf16lo(a.x) + w1 * bf16lo(b.x); h[1] += w0 * bf16hi(a.x) + w1 * bf16hi(b.x); h[2] += w0 * bf16lo(a.y) + w1 * bf16lo(b.y); h[3] += w0 * bf16hi(a.y) + w1 * bf16hi(b.y);
                v[j] = h; s += (h[0] * h[0] + h[1] * h[1]) + (h[2] * h[2] + h[3] * h[3]); }
            const float rinv = rsqrtf(wave_sum(s) * (1.0f / DM) + EPS);
#pragma unroll
            for (int j = 0; j < 4; ++j) hr[64 * j] = v[j] * rinv * gp[64 * j];
        }
#undef P10_SLOTS
#undef P10_DATA
    }
    if (PROBE_LO >= 0) {
        if (PROBE_HI == 10) t_pb = __builtin_amdgcn_s_memrealtime();
        if (blockIdx.x == 0 && threadIdx.x == 0) { const unsigned long long t0 = __builtin_amdgcn_s_memrealtime(), span = 2 * (t_pb - t_pa);
            while (__builtin_amdgcn_s_memrealtime() - t0 < span) __builtin_amdgcn_s_sleep(8); }
    }
}

extern "C" void kernel_launch(void* const* d_in, const int* in_sizes, int n_in, void* d_out, int out_size, void* d_ws, size_t ws_size, hipStream_t stream) {
    static int grid = 0;
    if (grid == 0) {
        if (n_in != 22 || in_sizes[0] != M * DM || out_size != M * DM || ws_size < WS_END) { fprintf(stderr, "kernel_launch: unexpected shapes (n_in %d, in0 %d, out %d, ws %zu)\n", n_in, n_in > 0 ? in_sizes[0] : -1, out_size, ws_size); grid = -1; return; }
        int dev = 0, cus = 0, per_cu = 0;
        if (hipGetDevice(&dev) != hipSuccess || hipDeviceGetAttribute(&cus, hipDeviceAttributeMultiprocessorCount, dev) != hipSuccess) { grid = -1; return; }
        if (hipFuncSetAttribute((const void*)hymba_fwd, hipFuncAttributeMaxDynamicSharedMemorySize, LDS_BYTES) != hipSuccess) { fprintf(stderr, "kernel_launch: hipFuncSetAttribute failed\n"); grid = -1; return; }
        if (hipOccupancyMaxActiveBlocksPerMultiprocessor(&per_cu, (const void*)hymba_fwd, NWAVES * 64, LDS_BYTES) != hipSuccess || per_cu < 1) { fprintf(stderr, "kernel_launch: occupancy query reports %d\n", per_cu); }
        (void)hipGetLastError();
        grid = cus;
    }
    if (grid < 0) return;
    (void)hipMemsetAsync((char*)d_ws + WS_CTL, 0, CTL_ZERO_BYTES, stream);
    Args a{};
    const float** p = (const float**)&a;
    for (int i = 0; i < 22; ++i) p[i] = (const float*)d_in[i];
    a.out = (float*)d_out; a.ws = (unsigned char*)d_ws;
    hipLaunchKernelGGL(hymba_fwd, dim3(grid), dim3(NWAVES * 64), LDS_BYTES, stream, a);
}
```

```cpp
#include <hip/hip_runtime.h>
#include <hip/hip_bf16.h>
#include <cstdio>
#include <cstdint>

#define LAS __attribute__((address_space(3)))
#define GAS __attribute__((address_space(1)))
typedef unsigned short bf16_t;
typedef short bf16x8 __attribute__((ext_vector_type(8)));
typedef short s16x4 __attribute__((ext_vector_type(4)));
typedef float f32x4 __attribute__((ext_vector_type(4)));
typedef float f32x2 __attribute__((ext_vector_type(2)));
typedef float f32x16 __attribute__((ext_vector_type(16)));
typedef unsigned u32x4 __attribute__((ext_vector_type(4)));
typedef unsigned u32x2 __attribute__((ext_vector_type(2)));
typedef __bf16 bf16x2_t __attribute__((ext_vector_type(2)));

constexpr int BATCH = 8, SEQ = 8192, DM = 1024, M = BATCH * SEQ;
constexpr int NH = 8, HD = 64, HW = NH * HD;
constexpr int NPROJ = 3 * HW * 2;
constexpr int WIN_LD = NPROJ + NH;
constexpr int NMEM = 256, XH = 4, XD = 256, MEMROWS = BATCH * NMEM;
constexpr int NEXP = 16, DFF = 256;
constexpr float EPS = 1e-6f;
constexpr float LOG2E = 1.4426950408889634f;
constexpr float C2 = 0.125f * LOG2E;
constexpr float XSC = 0.0625f * LOG2E;
constexpr float SB_EXIT = -48.0f;

constexpr size_t MiB = 1u << 20;
constexpr size_t WS_CTL = 0, CTL_ZERO_BYTES = 128 * 1024;
constexpr size_t WS_WIN = 1 * MiB;
constexpr size_t WS_WOUT = 7 * MiB;
constexpr size_t WS_WXQ = 9 * MiB;
constexpr size_t WS_WXKV = 11 * MiB;
constexpr size_t WS_WXO = 15 * MiB;
constexpr size_t WS_WGU = 17 * MiB;
constexpr size_t WS_WD = 33 * MiB;
constexpr size_t WS_RX = 41 * MiB;
constexpr size_t WS_RMEM = WS_RX + 256 * 1024;
constexpr size_t WS_R2 = WS_RX + 512 * 1024;
constexpr size_t WS_LF = 42 * MiB;
constexpr size_t WS_C2 = 44 * MiB;
constexpr size_t WS_SSQ = 46 * MiB;
constexpr size_t WS_TOKSLOT = 50 * MiB;
constexpr size_t WS_TOKW = 51 * MiB;
constexpr size_t WS_LIST = 52 * MiB;
constexpr size_t WS_MEMB = 56 * MiB;
constexpr size_t WS_KVM = 60 * MiB;
constexpr size_t WS_GT = 68 * MiB;
constexpr size_t WS_HT = 84 * MiB;
constexpr size_t WS_KX = 100 * MiB;
constexpr size_t WS_HS = 108 * MiB;
constexpr size_t WS_XB = 128 * MiB;
constexpr size_t WS_QKV = 256 * MiB;
constexpr size_t WS_H1B = 256 * MiB, WS_U2B = 384 * MiB, WS_HID = 512 * MiB;
constexpr size_t WS_O = 640 * MiB;
constexpr size_t WS_Y = 704 * MiB;
constexpr size_t WS_END = 1024 * MiB;
constexpr size_t QKV_STRIDE = (size_t)M * HW;
constexpr int MAXTILES = M * 2 / 256 + NEXP;
static_assert(WS_Y + (size_t)MAXTILES * 256 * 1024 * 2 <= WS_END, "ws map");
static_assert(WS_HID + (size_t)MAXTILES * 256 * 256 * 2 <= WS_O, "ws map");
constexpr int CW_BAR = 4096;
constexpr int CW_SBQ = 20736;
constexpr int CW_KN = 20480;
constexpr int CW_CNT = 16384;

constexpr int RING_OFF = 0, RING_BYTES = 131072;
constexpr int EXTRA_OFF = 131072, EXTRA_BYTES = 16384;
constexpr int MISC_OFF = EXTRA_OFF + EXTRA_BYTES;
constexpr int LDS_BYTES = MISC_OFF + 1024;
constexpr int NWAVES = 8;
#ifndef PHASE_MASK
#define PHASE_MASK 0x7ff
#endif
#define PH(n) ((PHASE_MASK >> (n)) & 1)
#ifndef PROBE_LO
#define PROBE_LO -1
#endif
#ifndef PROBE_HI
#define PROBE_HI -1
#endif
#ifndef FOX_V2
#define FOX_V2 1
#endif
#ifndef REP_MASK
#define REP_MASK 0
#endif
#define REPS(n) (1 + ((REP_MASK >> (n)) & 1))
#ifndef REP_FOX
#define REP_FOX 1
#endif
#ifndef REP_SB
#define REP_SB 1
#endif

__device__ __forceinline__ unsigned cvt_pk_bf16(float lo, float hi) { f32x2 v = {lo, hi}; bf16x2_t b = __builtin_convertvector(v, bf16x2_t); return __builtin_bit_cast(unsigned, b); }
__device__ __forceinline__ float bf16lo(unsigned u) { return __uint_as_float(u << 16); }
__device__ __forceinline__ float bf16hi(unsigned u) { return __uint_as_float(u & 0xffff0000u); }
#define DPP_ADD(v, CTRL) v += __builtin_bit_cast(float, __builtin_amdgcn_update_dpp(0, __builtin_bit_cast(int, v), CTRL, 0xf, 0xf, true))
__device__ __forceinline__ float wave_sum(float v) {
    DPP_ADD(v, 0xB1); DPP_ADD(v, 0x4E); DPP_ADD(v, 0x141); DPP_ADD(v, 0x140);
    const int iv = __builtin_bit_cast(int, v);
    return (__builtin_bit_cast(float, __builtin_amdgcn_readlane(iv, 0)) + __builtin_bit_cast(float, __builtin_amdgcn_readlane(iv, 16))) +
           (__builtin_bit_cast(float, __builtin_amdgcn_readlane(iv, 32)) + __builtin_bit_cast(float, __builtin_amdgcn_readlane(iv, 48)));
}
#define LDS_WAIT() asm volatile("s_waitcnt lgkmcnt(0)" ::: "memory")
#define VM_WAIT() asm volatile("s_waitcnt vmcnt(0)" ::: "memory")

namespace pg8 {
constexpr int BM = 256, BK = 64, HALF = 128, HTB = HALF * BK * 2, STAGE_BYTES = 8 * HTB, NXCD = 8, WGM = 8;
__host__ __device__ __forceinline__ int lds_byte(int r, int c) { const int st = (r >> 4) * 2 + (c >> 5), rr = r & 15, cc = c & 31, ob = rr * 64 + cc * 2; return st * 1024 + (ob ^ (((ob >> 9) & 1) << 5)); }
__host__ __device__ __forceinline__ void stage_rc(int b, int& R, int& C) { const int st = b / 1024, sb = b % 1024, swz = sb ^ (((sb >> 9) & 1) << 5); R = (st >> 1) * 16 + swz / 64; C = (st & 1) * 32 + (swz % 64) / 2; }
__host__ __device__ __forceinline__ int perm32(int rho) { const int n = rho >> 4, i = rho & 15; return 8 * (i >> 2) + 4 * n + (i & 3); }

struct Unit { const char* a; const char* b; int orow, ocol, aux; const int* rows; int nvalid; int seq; };
struct Gemm { int lda, ldb, K; };

__device__ __forceinline__ bool tile_order(int i, int G, int c, int nM, int nN, int& pm, int& pn) {
    const int nwg = nM * nN; const long L = (long)i * G + c; if (L >= nwg) return false;
    int wgid = (int)L; { const int q = nwg / NXCD, r = nwg % NXCD, xcd = wgid % NXCD, off = wgid / NXCD; wgid = (xcd < r ? xcd * (q + 1) : r * (q + 1) + (xcd - r) * q) + off; }
    const int nig = WGM * nN, gid = wgid / nig, fm = gid * WGM, gsz = (nM - fm) < WGM ? (nM - fm) : WGM;
    pm = fm + ((wgid % nig) % gsz); pn = (wgid % nig) / gsz; return true;
}

template <class Epi, class Sched, bool ALIGN_EPI, bool GATHER>
__device__ __forceinline__ void gemm_phase(LAS unsigned char* lds, const Gemm g, const Sched& S, const Epi& E) {
    int tid = threadIdx.x; asm volatile("" : "+v"(tid));
    const int wid = __builtin_amdgcn_readfirstlane(tid >> 6), lane = tid & 63, wr = wid >> 2, wc = wid & 3, fr = lane & 15, fq = lane >> 4;
    const int K = g.K, nt = K / BK;
    unsigned voffA[2], voffB[2]; int RA[2], CA[2];
#pragma unroll
    for (int i = 0; i < 2; ++i) { int R, C; stage_rc(tid * 16 + i * 8192, R, C); const int Rb = (R & ~31) + perm32(R & 31);
        RA[i] = R; CA[i] = C; voffA[i] = (unsigned)(R * g.lda + C) * 2u; voffB[i] = (unsigned)(Rb * g.ldb + C) * 2u; }
    const size_t kstep = (size_t)(BK * 2);
    const size_t hstepA = (size_t)HALF * g.lda * 2, hstepB = (size_t)HALF * g.ldb * 2;
    const unsigned ldsw = (unsigned)wid * 1024u;
    const int aoff = lds_byte(wr * 64 + fr, fq * 8), boff = lds_byte(wc * 32 + fr, fq * 8);
#define PG8_SA(b, h) (((b) * 2 + (h)) * HTB)
#define PG8_SB(b, h) ((4 + (b) * 2 + (h)) * HTB)
#define PG8_STAGE2(bufoff, gbase, v0, v1) do { \
        __builtin_amdgcn_global_load_lds((const unsigned*)((const char*)(gbase) + (v0)), (LAS unsigned*)(lds + (bufoff) + ldsw), 16, 0, 0); \
        __builtin_amdgcn_global_load_lds((const unsigned*)((const char*)(gbase) + (v1)), (LAS unsigned*)(lds + (bufoff) + ldsw + 8192), 16, 0, 0); } while (0)
#define PG8_STAGEB(bufoff, gbase) PG8_STAGE2(bufoff, gbase, voffB[0], voffB[1])
#define PG8_STAGEA(bufoff, kptr, h, NX) do { if constexpr (GATHER) { const unsigned v0_ = (NX) ? gvn[h][0] : gvc[h][0], v1_ = (NX) ? gvn[h][1] : gvc[h][1]; PG8_STAGE2(bufoff, kptr, v0_, v1_); } \
        else { PG8_STAGE2(bufoff, (kptr) + (h) * hstepA, voffA[0], voffA[1]); } } while (0)
#define PG8_LDA(dst, b, h) do { _Pragma("unroll") for (int m = 0; m < 4; ++m) _Pragma("unroll") for (int k = 0; k < 2; ++k) dst[m][k] = *(const LAS bf16x8*)(lds + PG8_SA(b, h) + aoff + m * 2048 + k * 1024); } while (0)
#define PG8_LDB(dst, b, h) do { _Pragma("unroll") for (int n = 0; n < 2; ++n) _Pragma("unroll") for (int k = 0; k < 2; ++k) dst[n][k] = *(const LAS bf16x8*)(lds + PG8_SB(b, h) + boff + n * 2048 + k * 1024); } while (0)
#define PG8_MMA(ai, bj, At, Bt) do { __builtin_amdgcn_s_setprio(1); _Pragma("unroll") for (int m = 0; m < 4; ++m) _Pragma("unroll") for (int n = 0; n < 2; ++n) _Pragma("unroll") for (int k = 0; k < 2; ++k) \
        acc[ai][bj][m][n] = __builtin_amdgcn_mfma_f32_16x16x32_bf16(Bt[n][k], At[m][k], acc[ai][bj][m][n], 0, 0, 0); __builtin_amdgcn_s_setprio(0); } while (0)
#define PG8_WAIT_V(n) asm volatile("s_waitcnt vmcnt(" #n ")" ::: "memory")
#define PG8_WAIT_L(n) asm volatile("s_waitcnt lgkmcnt(" #n ")" ::: "memory")
#define PG8_BAR __builtin_amdgcn_s_barrier()
#define PG8_SCHED __builtin_amdgcn_sched_barrier(0)
#define PG8_GATHER_OFFS(dst, u) do { _Pragma("unroll") for (int h_ = 0; h_ < 2; ++h_) _Pragma("unroll") for (int i_ = 0; i_ < 2; ++i_) { const int r_ = h_ * HALF + RA[i_]; \
        const int idx_ = (u).rows[r_ < (u).nvalid ? r_ : 0]; dst[h_][i_] = (unsigned)(idx_ * g.lda + CA[i_]) * 2u; } } while (0)
    Unit cur, nxt; int ui = 0;
    if (!S.next(0, cur)) return;
    cur.seq = 0;
    unsigned gvc[2][2] = {{0u, 0u}, {0u, 0u}}, gvn[2][2] = {{0u, 0u}, {0u, 0u}};
    if constexpr (GATHER) { PG8_GATHER_OFFS(gvc, cur); }
    f32x4 acc[2][2][4][2];
#pragma unroll
    for (int a = 0; a < 2; ++a)
#pragma unroll
        for (int b = 0; b < 2; ++b)
#pragma unroll
            for (int m = 0; m < 4; ++m)
#pragma unroll
                for (int n = 0; n < 2; ++n) acc[a][b][m][n] = (f32x4){0.f, 0.f, 0.f, 0.f};
    bf16x8 At[4][2], B0[2][2], B1[2][2];
    const char* cA = cur.a; const char* cB = cur.b;
    PG8_STAGEB(PG8_SB(0, 0), cB); PG8_STAGEB(PG8_SB(0, 1), cB + hstepB); PG8_STAGEA(PG8_SA(0, 0), cA, 0, false); PG8_STAGEA(PG8_SA(0, 1), cA, 1, false);
    if (wr == 1) PG8_BAR;
    PG8_WAIT_V(2); PG8_BAR;
    PG8_STAGEB(PG8_SB(1, 0), cB + kstep); PG8_STAGEA(PG8_SA(1, 0), cA + kstep, 0, false); PG8_STAGEB(PG8_SB(1, 1), cB + hstepB + kstep);
    PG8_WAIT_V(6); PG8_BAR;
    for (;;) {
        const bool has_next = S.next(ui + 1, nxt); nxt.seq = ui + 1;
        const char* nA = has_next ? nxt.a : cA; const char* nB = has_next ? nxt.b : cB;
        if constexpr (GATHER) { if (has_next) { PG8_GATHER_OFFS(gvn, nxt); } else { gvn[0][0] = gvc[0][0]; gvn[0][1] = gvc[0][1]; gvn[1][0] = gvc[1][0]; gvn[1][1] = gvc[1][1]; } }
#pragma unroll 1
        for (int t = 0; t < nt; t += 2) {
            const bool last = (t == nt - 2);
            const char* a1 = cA + (size_t)(t + 1) * kstep;
            const char* a2 = last ? nA : cA + (size_t)(t + 2) * kstep; const char* b2 = last ? nB : cB + (size_t)(t + 2) * kstep;
            const char* a3 = a2 + kstep; const char* b3 = b2 + kstep;
            PG8_LDB(B0, 0, 0); PG8_LDB(B1, 0, 1); PG8_SCHED; PG8_LDA(At, 0, 0); PG8_STAGEA(PG8_SA(1, 1), a1, 1, false);
            PG8_WAIT_V(8); PG8_WAIT_L(0); PG8_BAR; PG8_MMA(0, 0, At, B0); PG8_MMA(0, 1, At, B1); PG8_BAR; PG8_SCHED;
            PG8_LDA(At, 0, 1); PG8_STAGEB(PG8_SB(0, 0), b2); PG8_STAGEB(PG8_SB(0, 1), b2 + hstepB); PG8_STAGEA(PG8_SA(0, 0), a2, 0, last);
            PG8_WAIT_V(8); PG8_WAIT_L(0); PG8_BAR; PG8_MMA(1, 0, At, B0); PG8_MMA(1, 1, At, B1); PG8_BAR; PG8_SCHED;
            PG8_LDB(B0, 1, 0); PG8_LDB(B1, 1, 1); PG8_SCHED; PG8_LDA(At, 1, 0); PG8_STAGEA(PG8_SA(0, 1), a2, 1, last);
            PG8_WAIT_V(8); PG8_WAIT_L(0); PG8_BAR; PG8_MMA(0, 0, At, B0); PG8_MMA(0, 1, At, B1); PG8_BAR; PG8_SCHED;
            PG8_LDA(At, 1, 1); PG8_STAGEB(PG8_SB(1, 0), b3); PG8_STAGEB(PG8_SB(1, 1), b3 + hstepB); PG8_STAGEA(PG8_SA(1, 0), a3, 0, last);
            PG8_WAIT_V(8); PG8_WAIT_L(0); PG8_BAR; PG8_MMA(1, 0, At, B0); PG8_MMA(1, 1, At, B1); PG8_BAR; PG8_SCHED;
            if constexpr (Epi::HAS_MID) { if (t == (nt >> 1) - 2) { int fr3 = fr, fq3 = fq; asm volatile("" : "+v"(fr3), "+v"(fq3)); E.mid(acc, cur, wr, wc, fr3, fq3); } }
        }
        if constexpr (ALIGN_EPI) { if (wr == 0) PG8_BAR; }
        { int fr2 = fr, fq2 = fq; asm volatile("" : "+v"(fr2), "+v"(fq2));
          E(acc, cur, wr, wc, fr2, fq2); }
        if (!has_next) break;
#pragma unroll
        for (int a = 0; a < 2; ++a)
#pragma unroll
            for (int b = 0; b < 2; ++b)
#pragma unroll
                for (int m = 0; m < 4; ++m)
#pragma unroll
                    for (int n = 0; n < 2; ++n) acc[a][b][m][n] = (f32x4){0.f, 0.f, 0.f, 0.f};
        cur = nxt; cA = nA; cB = nB; ++ui;
        if constexpr (GATHER) { gvc[0][0] = gvn[0][0]; gvc[0][1] = gvn[0][1]; gvc[1][0] = gvn[1][0]; gvc[1][1] = gvn[1][1]; }
        if constexpr (ALIGN_EPI) { if (wr == 1) PG8_BAR; }
    }
    PG8_WAIT_V(0);
    if constexpr (!ALIGN_EPI) { if (wr == 0) PG8_BAR; }
    PG8_BAR;
#undef PG8_SA
#undef PG8_SB
#undef PG8_STAGE2
#undef PG8_STAGEA
#undef PG8_STAGEB
#undef PG8_LDA
#undef PG8_LDB
#undef PG8_MMA
#undef PG8_WAIT_V
#undef PG8_WAIT_L
#undef PG8_BAR
#undef PG8_SCHED
#undef PG8_GATHER_OFFS
}

#define EPI_ROW(u, ai, m) ((u).orow + (ai) * HALF + wr * 64 + (m) * 16 + fr)
#define EPI_COL(u, bj) ((u).ocol + (bj) * HALF + wc * 32 + 8 * fq)
struct EpiBf16 {
    static constexpr bool HAS_MID = false;
    bf16_t* O; int ldc; const float* rs; size_t stride; float sc0, sc3;
    unsigned* kn;
    const LAS float* rst;
    __device__ __forceinline__ void operator()(const f32x4 (&acc)[2][2][4][2], const Unit& u, int wr, int wc, int fr, int fq) const {
        bf16_t* base = O + (size_t)u.aux * stride;
        const float sc = (u.aux == 0) ? sc0 : ((u.aux == 3) ? sc3 : 1.f);
        float nmax[2] = {0.f, 0.f}; const bool dokn = kn && u.aux == 1;
#pragma unroll
        for (int ai = 0; ai < 2; ++ai)
#pragma unroll
            for (int m = 0; m < 4; ++m) { const int row = EPI_ROW(u, ai, m); const float s = (rst ? rst[u.seq * 256 + ai * HALF + wr * 64 + m * 16 + fr] : (rs ? rs[row] : 1.f)) * sc;
#pragma unroll
                for (int bj = 0; bj < 2; ++bj) { const f32x4 v0 = acc[ai][bj][m][0] * s, v1 = acc[ai][bj][m][1] * s;
                    u32x4 w; w.x = cvt_pk_bf16(v0[0], v0[1]); w.y = cvt_pk_bf16(v0[2], v0[3]); w.z = cvt_pk_bf16(v1[0], v1[1]); w.w = cvt_pk_bf16(v1[2], v1[3]);
                    *(u32x4*)(base + (size_t)row * ldc + EPI_COL(u, bj)) = w;
                    if (dokn) { float q = (v0[0] * v0[0] + v0[1] * v0[1]) + (v0[2] * v0[2] + v0[3] * v0[3]) + (v1[0] * v1[0] + v1[1] * v1[1]) + (v1[2] * v1[2] + v1[3] * v1[3]);
                        q += __shfl_xor(q, 16); q += __shfl_xor(q, 32); nmax[bj] = fmaxf(nmax[bj], q); } } }
        if (dokn) {
#pragma unroll
            for (int bj = 0; bj < 2; ++bj) { float q = nmax[bj]; q = fmaxf(q, __shfl_xor(q, 1)); q = fmaxf(q, __shfl_xor(q, 2)); q = fmaxf(q, __shfl_xor(q, 4)); q = fmaxf(q, __shfl_xor(q, 8));
                const int head = ((u.ocol + bj * HALF) >> 6) + (wc >> 1), bt = u.orow / SEQ;
                if ((fr | fq) == 0) atomicMax(kn + ((bt * NH + head) * 2 + (wc & 1)), __float_as_uint(q)); }
        }
    }
};
struct EpiResid {
    static constexpr bool HAS_MID = false;
    const float* res; float* out; bf16_t* hb; float* ssq;
    __device__ __forceinline__ void operator()(const f32x4 (&acc)[2][2][4][2], const Unit& u, int wr, int wc, int fr, int fq) const {
#pragma unroll
        for (int ai = 0; ai < 2; ++ai)
#pragma unroll
            for (int m = 0; m < 4; ++m) { const int row = EPI_ROW(u, ai, m); float q = 0.f;
#pragma unroll
                for (int bj = 0; bj < 2; ++bj) { const size_t off = (size_t)row * DM + EPI_COL(u, bj);
                    const f32x4 r0 = *(const f32x4*)(res + off), r1 = *(const f32x4*)(res + off + 4);
                    const f32x4 v0 = acc[ai][bj][m][0] + r0, v1 = acc[ai][bj][m][1] + r1;
                    *(f32x4*)(out + off) = v0; *(f32x4*)(out + off + 4) = v1;
                    q += (v0[0] * v0[0] + v0[1] * v0[1]) + (v0[2] * v0[2] + v0[3] * v0[3]) + (v1[0] * v1[0] + v1[1] * v1[1]) + (v1[2] * v1[2] + v1[3] * v1[3]);
                    if (hb) { u32x4 w; w.x = cvt_pk_bf16(v0[0], v0[1]); w.y = cvt_pk_bf16(v0[2], v0[3]); w.z = cvt_pk_bf16(v1[0], v1[1]); w.w = cvt_pk_bf16(v1[2], v1[3]); *(u32x4*)(hb + off) = w; } }
                if (ssq) { q += __shfl_xor(q, 16); q += __shfl_xor(q, 32); if (fq == 0) ssq[(size_t)row * 16 + (u.ocol >> 8) * 4 + wc] = q; } }
    }
};
struct EpiOutProj {
    static constexpr bool HAS_MID = true;
    const bf16_t* xb; bf16_t* hb; float* ssq; const LAS f32x2* rab;
    __device__ __forceinline__ void mid(f32x4 (&acc)[2][2][4][2], const Unit& u, int wr, int wc, int fr, int fq) const {
#pragma unroll
        for (int ai = 0; ai < 2; ++ai)
#pragma unroll
            for (int m = 0; m < 4; ++m) { const float f = rab[u.seq * 256 + ai * HALF + wr * 64 + m * 16 + fr].x;
#pragma unroll
                for (int bj = 0; bj < 2; ++bj) { acc[ai][bj][m][0] *= f; acc[ai][bj][m][1] *= f; } }
    }
    __device__ __forceinline__ void operator()(const f32x4 (&acc)[2][2][4][2], const Unit& u, int wr, int wc, int fr, int fq) const {
#pragma unroll
        for (int ai = 0; ai < 2; ++ai)
#pragma unroll
            for (int m = 0; m < 4; ++m) { const int row = EPI_ROW(u, ai, m); const float rb = rab[u.seq * 256 + ai * HALF + wr * 64 + m * 16 + fr].y; float q = 0.f;
#pragma unroll
                for (int bj = 0; bj < 2; ++bj) { const size_t off = (size_t)row * DM + EPI_COL(u, bj);
                    const u32x4 xr = *(const u32x4*)(xb + off);
                    f32x4 v0 = acc[ai][bj][m][0] * rb, v1 = acc[ai][bj][m][1] * rb;
                    v0[0] += bf16lo(xr.x); v0[1] += bf16hi(xr.x); v0[2] += bf16lo(xr.y); v0[3] += bf16hi(xr.y); v1[0] += bf16lo(xr.z); v1[1] += bf16hi(xr.z); v1[2] += bf16lo(xr.w); v1[3] += bf16hi(xr.w);
                    q += (v0[0] * v0[0] + v0[1] * v0[1]) + (v0[2] * v0[2] + v0[3] * v0[3]) + (v1[0] * v1[0] + v1[1] * v1[1]) + (v1[2] * v1[2] + v1[3] * v1[3]);
                    u32x4 w; w.x = cvt_pk_bf16(v0[0], v0[1]); w.y = cvt_pk_bf16(v0[2], v0[3]); w.z = cvt_pk_bf16(v1[0], v1[1]); w.w = cvt_pk_bf16(v1[2], v1[3]); *(u32x4*)(hb + off) = w; }
                q += __shfl_xor(q, 16); q += __shfl_xor(q, 32); if (fq == 0) ssq[(size_t)row * 16 + (u.ocol >> 8) * 4 + wc] = q; }
    }
};
struct EpiResidBf16 {
    static constexpr bool HAS_MID = false;
    bf16_t* hb;
    __device__ __forceinline__ void operator()(const f32x4 (&acc)[2][2][4][2], const Unit& u, int wr, int wc, int fr, int fq) const {
#pragma unroll
        for (int ai = 0; ai < 2; ++ai)
#pragma unroll
            for (int m = 0; m < 4; ++m) { const int row = EPI_ROW(u, ai, m);
#pragma unroll
                for (int bj = 0; bj < 2; ++bj) { const size_t off = (size_t)row * DM + EPI_COL(u, bj);
                    const u32x4 xr = *(const u32x4*)(hb + off);
                    f32x4 v0 = acc[ai][bj][m][0], v1 = acc[ai][bj][m][1];
                    v0[0] += bf16lo(xr.x); v0[1] += bf16hi(xr.x); v0[2] += bf16lo(xr.y); v0[3] += bf16hi(xr.y); v1[0] += bf16lo(xr.z); v1[1] += bf16hi(xr.z); v1[2] += bf16lo(xr.w); v1[3] += bf16hi(xr.w);
                    u32x4 w; w.x = cvt_pk_bf16(v0[0], v0[1]); w.y = cvt_pk_bf16(v0[2], v0[3]); w.z = cvt_pk_bf16(v1[0], v1[1]); w.w = cvt_pk_bf16(v1[2], v1[3]); *(u32x4*)(hb + off) = w; } }
    }
};
struct EpiSoftmax {
    static constexpr bool HAS_MID = false;
    bf16_t* P; const LAS float* r1t; LAS float* red;
    __device__ __forceinline__ void operator()(f32x4 (&acc)[2][2][4][2], const Unit& u, int wr, int wc, int fr, int fq) const {
#pragma unroll
        for (int ai = 0; ai < 2; ++ai)
#pragma unroll
            for (int m = 0; m < 4; ++m) { const float r1 = r1t[u.seq * 256 + ai * HALF + wr * 64 + m * 16 + fr]; float a = -3.0e38f;
#pragma unroll
                for (int bj = 0; bj < 2; ++bj)
#pragma unroll
                    for (int n = 0; n < 2; ++n) { f32x4 v = acc[ai][bj][m][n] * r1; acc[ai][bj][m][n] = v; a = fmaxf(a, fmaxf(fmaxf(v[0], v[1]), fmaxf(v[2], v[3]))); }
                a = fmaxf(a, __shfl_xor(a, 16)); a = fmaxf(a, __shfl_xor(a, 32));
                if (fq == 0) red[(ai * HALF + wr * 64 + m * 16 + fr) * 4 + wc] = a; asm volatile("" ::: "memory"); }
        LDS_WAIT(); __builtin_amdgcn_s_barrier(); asm volatile("" ::: "memory");
#pragma unroll
        for (int ai = 0; ai < 2; ++ai)
#pragma unroll
            for (int m = 0; m < 4; ++m) { const int rl = ai * HALF + wr * 64 + m * 16 + fr; const f32x4 mm = *(const LAS f32x4*)(red + rl * 4);
                const float a = fmaxf(fmaxf(mm[0], mm[1]), fmaxf(mm[2], mm[3])); float s = 0.f;
#pragma unroll
                for (int bj = 0; bj < 2; ++bj)
#pragma unroll
                    for (int n = 0; n < 2; ++n) { f32x4 v = acc[ai][bj][m][n];
                        v[0] = __builtin_amdgcn_exp2f(v[0] - a); v[1] = __builtin_amdgcn_exp2f(v[1] - a); v[2] = __builtin_amdgcn_exp2f(v[2] - a); v[3] = __builtin_amdgcn_exp2f(v[3] - a);
                        acc[ai][bj][m][n] = v; s += (v[0] + v[1]) + (v[2] + v[3]); }
                s += __shfl_xor(s, 16); s += __shfl_xor(s, 32);
                if (fq == 0) red[1024 + rl * 4 + wc] = s; }
        LDS_WAIT(); __builtin_amdgcn_s_barrier(); asm volatile("" ::: "memory");
#pragma unroll
        for (int ai = 0; ai < 2; ++ai)
#pragma unroll
            for (int m = 0; m < 4; ++m) { const int rl = ai * HALF + wr * 64 + m * 16 + fr; const int row = u.orow + rl; const f32x4 ss = *(const LAS f32x4*)(red + 1024 + rl * 4);
                const float inv = 1.0f / ((ss[0] + ss[1]) + (ss[2] + ss[3]));
#pragma unroll
                for (int bj = 0; bj < 2; ++bj) { const f32x4 v0 = acc[ai][bj][m][0] * inv, v1 = acc[ai][bj][m][1] * inv;
                    u32x4 w; w.x = cvt_pk_bf16(v0[0], v0[1]); w.y = cvt_pk_bf16(v0[2], v0[3]); w.z = cvt_pk_bf16(v1[0], v1[1]); w.w = cvt_pk_bf16(v1[2], v1[3]);
                    *(u32x4*)(P + (size_t)row * DM + EPI_COL(u, bj)) = w; } }
    }
};
struct EpiSwiglu {
    static constexpr bool HAS_MID = false;
    bf16_t* Hd; const float* r2s; const int* listbase;
    __device__ __forceinline__ void operator()(const f32x4 (&acc)[2][2][4][2], const Unit& u, int wr, int wc, int fr, int fq) const {
#pragma unroll
        for (int ai = 0; ai < 2; ++ai)
#pragma unroll
            for (int m = 0; m < 4; ++m) { const int rl = ai * HALF + wr * 64 + m * 16 + fr, row = u.orow + rl; const float rs = r2s[(u.rows - listbase) + (rl < u.nvalid ? rl : 0)]; float h[8];
#pragma unroll
                for (int n = 0; n < 2; ++n)
#pragma unroll
                    for (int e = 0; e < 4; ++e) { const float gt = acc[ai][0][m][n][e] * rs, up = acc[ai][1][m][n][e] * rs;
                        h[n * 4 + e] = gt * __builtin_amdgcn_rcpf(1.0f + __builtin_amdgcn_exp2f(-gt * LOG2E)) * up; }
                u32x4 w; w.x = cvt_pk_bf16(h[0], h[1]); w.y = cvt_pk_bf16(h[2], h[3]); w.z = cvt_pk_bf16(h[4], h[5]); w.w = cvt_pk_bf16(h[6], h[7]);
                *(u32x4*)(Hd + (size_t)row * DFF + u.ocol + wc * 32 + 8 * fq) = w; }
    }
};
}

namespace att {
constexpr int QB = 256, KVBLK = 64, PITCH = HW, OPITCH = DM;
constexpr int SLOTB = 8192, LDS_K = 0, LDS_V = 2 * SLOTB, LDS_WS = 4 * SLOTB, LDS_OST = LDS_WS + NWAVES * 256, LDS_FLAG = LDS_OST + NWAVES * 4096, LDS_END = LDS_FLAG + 64;
static_assert(LDS_END <= RING_BYTES, "attention LDS");
__device__ __forceinline__ int crow(int r, int hi) { return (r & 3) + 8 * (r >> 2) + 4 * hi; }
__device__ __forceinline__ void glds16(const void* gsrc, unsigned lds_dst) { unsigned keep;
    asm volatile("s_mov_b32 %0, m0\n\ts_mov_b32 m0, %2\n\ts_nop 0\n\tglobal_load_lds_dwordx4 %1, off\n\ts_mov_b32 m0, %0" : "=&s"(keep) : "v"(gsrc), "s"(lds_dst) : "memory"); }
__device__ __forceinline__ void glds16s(const void* sbase, unsigned voff, unsigned lds_dst) { unsigned keep;
    asm volatile("s_mov_b32 %0, m0\n\ts_mov_b32 m0, %3\n\ts_nop 0\n\tglobal_load_lds_dwordx4 %1, %2\n\ts_mov_b32 m0, %0" : "=&s"(keep) : "v"(voff), "s"(sbase), "s"(lds_dst) : "memory"); }
#define ATT_WAIT_BAR0() asm volatile("s_waitcnt vmcnt(0) lgkmcnt(0)\n\ts_barrier" ::: "memory")
#define MFMA32(a, b, c) __builtin_amdgcn_mfma_f32_32x32x16_bf16(a, b, c, 0, 0, 0)
__device__ __forceinline__ void store_row_ssq(u32x4 v, float* dst, int ch) {
    float q = (bf16lo(v.x) * bf16lo(v.x) + bf16hi(v.x) * bf16hi(v.x)) + (bf16lo(v.y) * bf16lo(v.y) + bf16hi(v.y) * bf16hi(v.y)) + (bf16lo(v.z) * bf16lo(v.z) + bf16hi(v.z) * bf16hi(v.z)) + (bf16lo(v.w) * bf16lo(v.w) + bf16hi(v.w) * bf16hi(v.w));
    q += __shfl_xor(q, 1); q += __shfl_xor(q, 2); q += __shfl_xor(q, 4);
    if (ch == 0) *dst = q;
}
__device__ __forceinline__ void qkt(f32x16& p0, f32x16& p1, const LAS char* Kslot, const bf16x8* qr, const f32x16& cin, int r32, int hi) {
    const LAS char* kb = Kslot + hi * 1024 + r32 * 16;
#pragma unroll
    for (int d0 = 0; d0 < 4; ++d0) {
        const bf16x8 b0 = *(const LAS bf16x8*)(kb + d0 * 2048);
        const bf16x8 b1 = *(const LAS bf16x8*)(kb + d0 * 2048 + 512);
        if (d0 == 0) { p0 = MFMA32(b0, qr[0], cin); p1 = MFMA32(b1, qr[0], cin); }
        else { p0 = MFMA32(b0, qr[d0], p0); p1 = MFMA32(b1, qr[d0], p1); } }
}
__device__ __forceinline__ void pv(f32x16* o, int vb, bf16x8 pa0, bf16x8 pa1, bf16x8 pa2, bf16x8 pa3) {
#pragma unroll
    for (int d0 = 0; d0 < 2; ++d0) { s16x4 lo[4], hi[4];
#pragma unroll
        for (int ks = 0; ks < 4; ++ks) {
            asm volatile("ds_read_b64_tr_b16 %0,%1 offset:%c2" : "=&v"(lo[ks]) : "v"(vb), "i"(d0 * 4096 + ks * 1024) : "memory");
            asm volatile("ds_read_b64_tr_b16 %0,%1 offset:%c2" : "=&v"(hi[ks]) : "v"(vb), "i"(d0 * 4096 + ks * 1024 + 512) : "memory"); }
        asm volatile("s_waitcnt lgkmcnt(0)" ::: "memory"); __builtin_amdgcn_sched_barrier(0);
#define PK(k) (bf16x8){lo[k][0], lo[k][1], lo[k][2], lo[k][3], hi[k][0], hi[k][1], hi[k][2], hi[k][3]}
        o[d0] = MFMA32(pa0, PK(0), o[d0]); o[d0] = MFMA32(pa1, PK(1), o[d0]); o[d0] = MFMA32(pa2, PK(2), o[d0]); o[d0] = MFMA32(pa3, PK(3), o[d0]);
#undef PK
    }
}
__device__ __forceinline__ float swap_lo(float x) { auto rr = __builtin_amdgcn_permlane32_swap(__float_as_uint(x), __float_as_uint(x), false, false); return __uint_as_float(rr[0]); }
__device__ __forceinline__ float swap_hi(float x) { auto rr = __builtin_amdgcn_permlane32_swap(__float_as_uint(x), __float_as_uint(x), false, false); return __uint_as_float(rr[1]); }

template <int MODE> __device__ __forceinline__ void attn_unit(int b, int h, int qb, const bf16_t* Q, const bf16_t* K, const bf16_t* V, bf16_t* O, float* hs, const float* cb, LAS char* shm) {
    int tid = threadIdx.x; asm volatile("" : "+v"(tid)); const int lane = tid & 63, r32 = lane & 31, hi = lane >> 5; const int wid = __builtin_amdgcn_readfirstlane(tid >> 6);
    const long rowbase = (long)b * SEQ; const int q0 = qb * QB;
    const bf16_t* Qw = Q + (rowbase + q0 + wid * 32) * PITCH + h * HD;
    const bf16_t* Kh = K + rowbase * PITCH + h * HD; const bf16_t* Vh = V + rowbase * PITCH + h * HD;
    const unsigned lds0 = (unsigned)(uintptr_t)shm;
    LAS float* wsf = (LAS float*)(shm + LDS_WS) + wid * 64;
    LAS unsigned* flags = (LAS unsigned*)(shm + LDS_FLAG);
    const bf16_t* ksrc = Kh + (long)lane * PITCH + wid * 8;
    const bf16_t* vsrc = Vh + (long)(16 * (wid & 3) + (lane >> 2)) * PITCH + (wid >> 2) * 32 + (lane & 3) * 8;
    const unsigned kdst = lds0 + LDS_K + wid * 1024, vdst = lds0 + LDS_V + wid * 1024;
#define DMA_KV(t, slot) do { glds16(ksrc + (long)(t) * KVBLK * PITCH, (unsigned)__builtin_amdgcn_readfirstlane(kdst + (slot))); glds16(vsrc + (long)(t) * KVBLK * PITCH, (unsigned)__builtin_amdgcn_readfirstlane(vdst + (slot))); } while (0)
    const int vb0 = (int)(lds0 + LDS_V) + ((lane >> 4) & 1) * 32 + (lane & 3) * 8 + (4 * hi + ((lane & 15) >> 2)) * 64;
    const int NT = (q0 + QB) / KVBLK;
    DMA_KV(NT - 1, 0);
    bf16x8 qr[4];
#pragma unroll
    for (int d0 = 0; d0 < 4; ++d0) qr[d0] = *(const bf16x8*)(Qw + (long)r32 * PITCH + d0 * 16 + hi * 8);
    f32x16 o[2]; o[0] = f32x16{}; o[1] = f32x16{};
    const int qrel = wid * 32 + r32;
    float m_run = -1.0e30f, l_run = 0.f, R = 0.f, ct = 0.f;
    if (MODE == 0) ct = cb[q0 + qrel];
    bf16x8 TD0, TD1, TONE;
#pragma unroll
    for (int j = 0; j < 8; ++j) { const int kvl = 8 * (j >> 2) + 4 * hi + (j & 3); TD0[j] = (kvl >= r32) ? (short)0x3F80 : (short)0; TD1[j] = (16 + kvl >= r32) ? (short)0x3F80 : (short)0; TONE[j] = (short)0x3F80; }
    f32x16 zero16 = f32x16{};
    for (int i = 0; i < NT; ++i) {
        const int t = NT - 1 - i, slot = (i & 1) * SLOTB;
        ATT_WAIT_BAR0();
        if (MODE == 1 && i > 0) {
            const LAS unsigned* fl = flags + ((i - 1) & 1) * 8; unsigned all = 1u;
#pragma unroll
            for (int w = 0; w < 8; ++w) all &= fl[w];
            if (__builtin_amdgcn_readfirstlane(all)) break;
        }
        if (t > 0) DMA_KV(t - 1, slot ^ SLOTB);
        const int jb = t - (NT - 4);
        const bool active = !(jb >= 0 && 2 * jb > wid);
        bool wave_done = false;
        if (MODE == 1) wave_done = __all(R < SB_EXIT);
        if (active && !(MODE == 1 && wave_done)) {
            f32x16 p0, p1;
            qkt(p0, p1, shm + LDS_K + slot, qr, zero16, r32, hi);
            if (MODE == 0) {
                const float* cbt = cb + t * KVBLK + 4 * hi;
#pragma unroll
                for (int g = 0; g < 4; ++g) { const f32x4 c0 = *(const f32x4*)(cbt + 8 * g), c1 = *(const f32x4*)(cbt + 32 + 8 * g);
#pragma unroll
                    for (int e = 0; e < 4; ++e) { p0[4 * g + e] += ct - c0[e]; p1[4 * g + e] += ct - c1[e]; } }
                if (jb >= 0) {
#pragma unroll
                    for (int r = 0; r < 16; ++r) { const int kv = 64 * jb + crow(r, hi); if (kv > qrel) p0[r] = -1.0e30f; if (kv + 32 > qrel) p1[r] = -1.0e30f; } }
                float a = fmaxf(p0[0], p1[0]);
#pragma unroll
                for (int r = 1; r < 16; ++r) a = fmaxf(a, fmaxf(p0[r], p1[r]));
                a = fmaxf(swap_lo(a), swap_hi(a));
                const float m_new = fmaxf(m_run, a), alpha = __builtin_amdgcn_exp2f(m_run - m_new); m_run = m_new;
                float s = 0.f;
#pragma unroll
                for (int r = 0; r < 16; ++r) { p0[r] = __builtin_amdgcn_exp2f(p0[r] - m_new); p1[r] = __builtin_amdgcn_exp2f(p1[r] - m_new); s += p0[r] + p1[r]; }
                l_run = l_run * alpha + s;
                if (hi == 0) wsf[r32] = alpha;
                LDS_WAIT();
#pragma unroll
                for (int r = 0; r < 16; ++r) { const float f = wsf[crow(r, hi)]; o[0][r] *= f; o[1][r] *= f; }
                LDS_WAIT();
            } else {
                if (jb >= 0) {
#pragma unroll
                    for (int r = 0; r < 16; ++r) { const int kv = 64 * jb + crow(r, hi); if (kv >= qrel) p0[r] = -1.0e30f; if (kv + 32 >= qrel) p1[r] = -1.0e30f; } }
                f32x16 l0, l1;
#pragma unroll
                for (int r = 0; r < 16; ++r) {
                    l0[r] = -(fmaxf(p0[r], 0.f) + __builtin_amdgcn_logf(1.0f + __builtin_amdgcn_exp2f(-fabsf(p0[r]))));
                    l1[r] = -(fmaxf(p1[r], 0.f) + __builtin_amdgcn_logf(1.0f + __builtin_amdgcn_exp2f(-fabsf(p1[r])))); }
                u32x4 lw0 = {cvt_pk_bf16(l0[0], l0[1]), cvt_pk_bf16(l0[2], l0[3]), cvt_pk_bf16(l0[4], l0[5]), cvt_pk_bf16(l0[6], l0[7])};
                u32x4 lw1 = {cvt_pk_bf16(l0[8], l0[9]), cvt_pk_bf16(l0[10], l0[11]), cvt_pk_bf16(l0[12], l0[13]), cvt_pk_bf16(l0[14], l0[15])};
                u32x4 lw2 = {cvt_pk_bf16(l1[0], l1[1]), cvt_pk_bf16(l1[2], l1[3]), cvt_pk_bf16(l1[4], l1[5]), cvt_pk_bf16(l1[6], l1[7])};
                u32x4 lw3 = {cvt_pk_bf16(l1[8], l1[9]), cvt_pk_bf16(l1[10], l1[11]), cvt_pk_bf16(l1[12], l1[13]), cvt_pk_bf16(l1[14], l1[15])};
                f32x16 rt;
#pragma unroll
                for (int r = 0; r < 16; ++r) rt[r] = R;
                f32x16 t0 = MFMA32(TD0, __builtin_bit_cast(bf16x8, lw0), rt); t0 = MFMA32(TD1, __builtin_bit_cast(bf16x8, lw1), t0);
                t0 = MFMA32(TONE, __builtin_bit_cast(bf16x8, lw2), t0); t0 = MFMA32(TONE, __builtin_bit_cast(bf16x8, lw3), t0);
                f32x16 t1 = MFMA32(TD0, __builtin_bit_cast(bf16x8, lw2), rt); t1 = MFMA32(TD1, __builtin_bit_cast(bf16x8, lw3), t1);
#pragma unroll
                for (int r = 0; r < 16; ++r) { p0[r] = __builtin_amdgcn_exp2f(p0[r] + t0[r]); p1[r] = __builtin_amdgcn_exp2f(p1[r] + t1[r]); }
                R = swap_lo(t0[0]);
            }
            u32x4 pw0 = {cvt_pk_bf16(p0[0], p0[1]), cvt_pk_bf16(p0[2], p0[3]), cvt_pk_bf16(p0[4], p0[5]), cvt_pk_bf16(p0[6], p0[7])};
            u32x4 pw1 = {cvt_pk_bf16(p0[8], p0[9]), cvt_pk_bf16(p0[10], p0[11]), cvt_pk_bf16(p0[12], p0[13]), cvt_pk_bf16(p0[14], p0[15])};
            u32x4 pw2 = {cvt_pk_bf16(p1[0], p1[1]), cvt_pk_bf16(p1[2], p1[3]), cvt_pk_bf16(p1[4], p1[5]), cvt_pk_bf16(p1[6], p1[7])};
            u32x4 pw3 = {cvt_pk_bf16(p1[8], p1[9]), cvt_pk_bf16(p1[10], p1[11]), cvt_pk_bf16(p1[12], p1[13]), cvt_pk_bf16(p1[14], p1[15])};
            pv(o, vb0 + slot, __builtin_bit_cast(bf16x8, pw0), __builtin_bit_cast(bf16x8, pw1), __builtin_bit_cast(bf16x8, pw2), __builtin_bit_cast(bf16x8, pw3));
        }
        if (MODE == 1) { const bool dn = __all(R < SB_EXIT); if (lane == 0) flags[(i & 1) * 8 + wid] = dn ? 1u : 0u; }
    }
    float linv = 1.f;
    if (MODE == 0) { const float lt = swap_lo(l_run) + swap_hi(l_run); linv = 1.0f / lt; }
    if (hi == 0) wsf[32 + r32] = linv;
    LDS_WAIT();
    bf16_t* Ow = O + (rowbase + q0 + wid * 32) * OPITCH + h * HD;
    { LAS bf16_t* stg = (LAS bf16_t*)(shm + LDS_OST) + wid * 2048;
#pragma unroll
      for (int r = 0; r < 16; ++r) { const int orow = crow(r, hi); const float f = wsf[32 + orow];
#pragma unroll
        for (int d0 = 0; d0 < 2; ++d0) { const unsigned pk = cvt_pk_bf16(o[d0][r] * f, 0.f); stg[orow * 64 + d0 * 32 + r32] = (bf16_t)(pk & 0xffffu); } }
      LDS_WAIT();
#pragma unroll
      for (int i = 0; i < 4; ++i) { const int row = i * 8 + (lane >> 3), ch = lane & 7; const u32x4 v = *(const LAS u32x4*)(stg + row * 64 + ch * 8); *(u32x4*)(Ow + (long)row * OPITCH + ch * 8) = v;
        store_row_ssq(v, hs + (rowbase + q0 + wid * 32 + row) * 16, ch); } }
    asm volatile("s_waitcnt vmcnt(0) lgkmcnt(0)\n\ts_barrier" ::: "memory");
#undef DMA_KV
}
}


namespace fox {
constexpr int QB = 256, KVBLK = 64, PITCH = HW, OPITCH = DM;
constexpr int NSLOT = 3, SLOTB = 9216;
constexpr int LDS_K = 0, LDS_V = NSLOT * SLOTB, LDS_WS = 2 * NSLOT * SLOTB, LDS_OST = LDS_WS + NWAVES * 256, LDS_CL = LDS_OST + NWAVES * 4096, LDS_VOTE = LDS_CL + 512, LDS_END = LDS_VOTE + 32;
static_assert(LDS_END <= RING_BYTES, "fox LDS");
constexpr float WIN_T = 48.0f;
constexpr float FLOOR = -256.0f;
using att::crow; using att::glds16; using att::glds16s;
typedef __attribute__((address_space(3))) const char* lds_cptr;
typedef short v4i16_t __attribute__((ext_vector_type(4)));
#define SBAR() __builtin_amdgcn_sched_barrier(0)
#define WAIT_BAR(N) asm volatile("s_waitcnt vmcnt(" #N ") lgkmcnt(0)\n\ts_barrier" ::: "memory")
__device__ __forceinline__ s16x4 vtr(lds_cptr p) { return __builtin_bit_cast(s16x4, __builtin_amdgcn_ds_read_tr16_b64_v4i16((__attribute__((address_space(3))) v4i16_t*)p)); }
__device__ __forceinline__ void kload2(bf16x8* kf, lds_cptr kp, int j) { kf[2 * j] = *(const LAS bf16x8*)(kp + j * 2048); kf[2 * j + 1] = *(const LAS bf16x8*)(kp + j * 2048 + 512); }
__device__ __forceinline__ void cmask(f32x16& p0, f32x16& p1, int jb, int qrel, int hi) {
    const float NEG = -INFINITY; const int kb = 64 * jb + 4 * hi;
#pragma unroll
    for (int r = 0; r < 16; ++r) { const int kv = kb + (r & 3) + 8 * (r >> 2); if (kv > qrel) p0[r] = NEG; if (kv + 32 > qrel) p1[r] = NEG; }
}
__device__ __forceinline__ void split3(float x, unsigned& hm, unsigned& lo) {
    const unsigned h = cvt_pk_bf16(x, 0.f) & 0xffffu; const float r1 = x - __uint_as_float(h << 16);
    const unsigned m = cvt_pk_bf16(r1, 0.f) & 0xffffu; const float r2 = r1 - __uint_as_float(m << 16);
    hm = h | (m << 16); lo = cvt_pk_bf16(r2, 0.f) & 0xffffu;
}
__device__ __forceinline__ bf16x8 qx_build(float a, int hi) {
    unsigned hm, lo; split3(a, hm, lo);
    u32x4 w; w.x = hm; w.y = lo | 0x3F800000u; w.z = 0x3F803F80u; w.w = 0u;
    if (hi) { w.x = 0u; w.y = 0u; w.z = 0u; }
    return __builtin_bit_cast(bf16x8, w);
}

template <int THRL> __device__ __forceinline__ void fox_unit(int bh, int qb, const bf16_t* Q, const bf16_t* K, const bf16_t* V, bf16_t* O, float* hs, const float* cb, const bf16_t* KXh, float kmax, LAS char* shm) {
    int tid = threadIdx.x; asm volatile("" : "+v"(tid)); const int lane = tid & 63, r32 = lane & 31, hi = lane >> 5; const int wid = __builtin_amdgcn_readfirstlane(tid >> 6);
    const int b = bh >> 3, h = bh & 7; const long rowbase = (long)b * SEQ; const int q0 = qb * QB;
    const bf16_t* Qw = Q + (rowbase + q0 + wid * 32) * PITCH + h * HD;
    const bf16_t* Kh = K + rowbase * PITCH + h * HD; const bf16_t* Vh = V + rowbase * PITCH + h * HD;
    const unsigned lds0 = (unsigned)(uintptr_t)shm;
    LAS float* wsf = (LAS float*)(shm + LDS_WS) + wid * 64;
    const int NT = (q0 + QB) / KVBLK;
    int NTe = NT;
    LAS float* clt = (LAS float*)(shm + LDS_CL); LAS unsigned* votes = (LAS unsigned*)(shm + LDS_VOTE);
    const float clv = (tid < NT) ? cb[64 * tid + 63] : 0.f;
    const unsigned koff = (unsigned)(lane * PITCH + wid * 8) * 2u, voff = (unsigned)((16 * (wid & 3) + (lane >> 2)) * PITCH + (wid >> 2) * 32 + (lane & 3) * 8) * 2u, xoff = (unsigned)lane * 16u;
    const unsigned kdst = lds0 + LDS_K + wid * 1024, vdst = lds0 + LDS_V + wid * 1024, xdst = lds0 + LDS_K + 8192;
    const bool xl = (lane >> 3) == wid;
#define DMA_K(p, slot) do { glds16s(Kh + (long)(NT - 1 - (p)) * KVBLK * PITCH, koff, (unsigned)__builtin_amdgcn_readfirstlane(kdst + (slot))); \
        if (xl) glds16s(KXh + (long)(NT - 1 - (p)) * KVBLK * 8, xoff, (unsigned)__builtin_amdgcn_readfirstlane(xdst + (slot))); } while (0)
#define DMA_V(p, slot) glds16s(Vh + (long)(NT - 1 - (p)) * KVBLK * PITCH, voff, (unsigned)__builtin_amdgcn_readfirstlane(vdst + (slot)))
    bf16x8 kf[10];
    const lds_cptr shm3 = (lds_cptr)shm; const lds_cptr kp0 = shm3 + LDS_K + hi * 1024 + r32 * 16; const lds_cptr kx0 = shm3 + LDS_K + 8192 + r32 * 16;
    const lds_cptr vp0 = shm3 + LDS_V + ((lane >> 4) & 1) * 32 + (lane & 3) * 8 + (4 * hi + ((lane & 15) >> 2)) * 64;
    DMA_K(0, 0); DMA_V(0, 0); DMA_K(1, SLOTB);
    bf16x8 qr[4];
#pragma unroll
    for (int d0 = 0; d0 < 4; ++d0) qr[d0] = *(const bf16x8*)(Qw + (long)r32 * PITCH + d0 * 16 + hi * 8);
    const int qrel = wid * 32 + r32;
    const float ct = cb[q0 + qrel];
    float mhat = 0.f, l_reg = 0.f; f32x16 o[2]; o[0] = f32x16{}; o[1] = f32x16{};
    bf16x8 qx = qx_build(ct, hi);
    const f32x16 z16 = f32x16{};
#define CMASK(P0, P1, p) do { const int jb_ = 3 - (p); if (jb_ >= 0) cmask(P0, P1, jb_, qrel, hi); } while (0)
    bool resc = false;
#define RESC() do { if (resc) { asm volatile("s_waitcnt lgkmcnt(0)" ::: "memory"); \
      _Pragma("unroll") for (int d_ = 0; d_ < 2; ++d_) _Pragma("unroll") for (int r = 0; r < 16; ++r) o[d_][r] *= wsf[crow(r, hi)]; } } while (0)
    f32x16 pA0, pA1, pB0, pB1;
    int sl_prev = 0, sl_cur = 0, sl_next = SLOTB;
#define ROT() do { sl_prev = sl_cur; sl_cur = sl_next; sl_next = (sl_next == (NSLOT - 1) * SLOTB) ? 0 : sl_next + SLOTB; } while (0)
    DMA_K(2, 2 * SLOTB);
    WAIT_BAR(5);
    if (tid < NT) clt[tid] = clv;
    float qkb;
    { float q2 = 0.f;
#pragma unroll
      for (int d0 = 0; d0 < 4; ++d0)
#pragma unroll
          for (int j = 0; j < 8; ++j) { const float e = __uint_as_float(((unsigned)(unsigned short)qr[d0][j]) << 16); q2 += e * e; }
      q2 = att::swap_lo(q2) + att::swap_hi(q2); qkb = sqrtf(q2) * kmax + ct + WIN_T; }
    { const LAS char* kb = (const LAS char*)shm + LDS_K + hi * 1024 + r32 * 16; const LAS char* kxb = (const LAS char*)shm + LDS_K + 8192 + r32 * 16;
      pA0 = MFMA32(*(const LAS bf16x8*)(kxb), qx, z16); pA1 = MFMA32(*(const LAS bf16x8*)(kxb + 512), qx, z16);
#pragma unroll
      for (int d0 = 0; d0 < 4; ++d0) { pA0 = MFMA32(*(const LAS bf16x8*)(kb + d0 * 2048), qr[d0], pA0); pA1 = MFMA32(*(const LAS bf16x8*)(kb + d0 * 2048 + 512), qr[d0], pA1); } }
    asm volatile("s_nop 15\n\ts_nop 7" : "+v"(pA0), "+v"(pA1)); CMASK(pA0, pA1, 0);
    { float a = fmaxf(pA0[0], pA1[0]);
#pragma unroll
      for (int r = 1; r < 16; ++r) a = fmaxf(a, fmaxf(pA0[r], pA1[r]));
      a = fmaxf(att::swap_lo(a), att::swap_hi(a));
      const float dl = fmaxf(a, FLOOR); mhat = dl;
#pragma unroll
      for (int r = 0; r < 16; ++r) { pA0[r] = __builtin_amdgcn_exp2f(pA0[r] - dl); pA1[r] = __builtin_amdgcn_exp2f(pA1[r] - dl); }
      qx = qx_build(ct - mhat, hi); asm volatile("" : "+v"(qx)); }
    WAIT_BAR(0);
    DMA_K(3, 0); DMA_V(1, SLOTB);
    ROT();
    kload2(kf, kp0 + sl_cur, 0); kload2(kf, kp0 + sl_cur, 1); kload2(kf, kp0 + sl_cur, 2); kload2(kf, kp0 + sl_cur, 3);
    kf[8] = *(const LAS bf16x8*)(kx0 + sl_cur); kf[9] = *(const LAS bf16x8*)(kx0 + sl_cur + 512);
    WAIT_BAR(3);
    s16x4 vlo[8], vhi[8]; u32x4 pw0, pw1, pw2, pw3;
#define PKW(P, B) cvt_pk_bf16(P[B], P[B + 1])
#define PAF(k) __builtin_bit_cast(bf16x8, pw##k)
#define VFR(i) (bf16x8){vlo[i][0], vlo[i][1], vlo[i][2], vlo[i][3], vhi[i][0], vhi[i][1], vhi[i][2], vhi[i][3]}
#define PIN(x) asm volatile("" : "+v"(x))
#define MX3(a, b, c) __builtin_fmaxf(__builtin_fmaxf((a), (b)), (c))
#define GAPA(MF, A0, A1, A2, A3, W0, W1, PW) do { MF; sacc += A0; sacc += A1; sacc += A2; sacc += A3; PIN(sacc); W0; W1; PIN(PW); SBAR(); } while (0)
#define EX(v) __builtin_amdgcn_exp2f(v)
#define GAPB(MF, X, B) do { MF; X[B] = EX(X[B]); X[B + 1] = EX(X[B + 1]); X[B + 2] = EX(X[B + 2]); X[B + 3] = EX(X[B + 3]); PIN(X); SBAR(); } while (0)
#define VRD(i) do { vlo[i] = vtr(vp_ + (((i) >> 2) * 4096 + ((i) & 3) * 1024)); vhi[i] = vtr(vp_ + (((i) >> 2) * 4096 + ((i) & 3) * 1024 + 512)); } while (0)
#define KRD(G, j) do { if (G) { kload2(kf, kp0 + sl_next, j); SBAR(); } } while (0)
#define KRDX(G) do { if (G) { kf[8] = *(const LAS bf16x8*)(kx0 + sl_next); kf[9] = *(const LAS bf16x8*)(kx0 + sl_next + 512); SBAR(); } } while (0)
#define STEP(C0, C1, P0, P1, t, GK, GV, GL) do { SBAR(); \
    const lds_cptr vp_ = vp0 + sl_prev; \
    C0 = MFMA32(kf[8], qx, z16); C1 = MFMA32(kf[9], qx, z16); SBAR(); \
    VRD(0); SBAR(); float sacc = (P0[0] + P0[1]); \
    GAPA(C0 = MFMA32(kf[0], qr[0], C0), P0[2], P0[3], P0[4], P0[5],     pw0[0] = PKW(P0, 0), pw0[1] = PKW(P0, 2), pw0); \
    VRD(4); SBAR(); GAPA(C1 = MFMA32(kf[1], qr[0], C1), P0[6], P0[7], P0[8], P0[9],     pw0[2] = PKW(P0, 4), pw0[3] = PKW(P0, 6), pw0); \
    VRD(1); SBAR(); GAPA(C0 = MFMA32(kf[2], qr[1], C0),   P0[10], P0[11], P0[12], P0[13], pw1[0] = PKW(P0, 8), pw1[1] = PKW(P0, 10), pw1); \
    VRD(5); SBAR(); GAPA(C1 = MFMA32(kf[3], qr[1], C1),   P0[14], P0[15], P1[0], P1[1],   pw1[2] = PKW(P0, 12), pw1[3] = PKW(P0, 14), pw1); \
    VRD(2); SBAR(); GAPA(C0 = MFMA32(kf[4], qr[2], C0),   P1[2], P1[3], P1[4], P1[5],     pw2[0] = PKW(P1, 0), pw2[1] = PKW(P1, 2), pw2); \
    VRD(6); SBAR(); GAPA(C1 = MFMA32(kf[5], qr[2], C1),   P1[6], P1[7], P1[8], P1[9],     pw2[2] = PKW(P1, 4), pw2[3] = PKW(P1, 6), pw2); \
    VRD(3); SBAR(); GAPA(C0 = MFMA32(kf[6], qr[3], C0),   P1[10], P1[11], P1[12], P1[13], pw3[0] = PKW(P1, 8), pw3[1] = PKW(P1, 10), pw3); \
    VRD(7); SBAR(); GAPA(C1 = MFMA32(kf[7], qr[3], C1),   P1[14], P1[15], 0.f, 0.f,       pw3[2] = PKW(P1, 12), pw3[3] = PKW(P1, 14), pw3); \
    l_reg += sacc; \
    if (GK) { DMA_K((t) + 3, sl_cur); } if (GV) { DMA_V((t) + 1, sl_next); } \
    CMASK(C0, C1, t); \
    { float a = MX3(C0[0], C0[1], C1[0]), b_ = MX3(C0[2], C0[3], C1[1]); a = MX3(a, C1[2], C1[3]); \
      _Pragma("unroll") for (int r = 4; r < 16; r += 4) { a = MX3(a, C0[r], C0[r + 1]); b_ = MX3(b_, C0[r + 2], C0[r + 3]); a = MX3(a, C1[r], C1[r + 1]); b_ = MX3(b_, C1[r + 2], C1[r + 3]); } \
      float rm = __builtin_fmaxf(a, b_); { auto rr = __builtin_amdgcn_permlane32_swap(__float_as_uint(rm), __float_as_uint(rm), false, false); rm = __builtin_fmaxf(__uint_as_float(rr[0]), __uint_as_float(rr[1])); } \
      resc = false; \
      if (__builtin_expect(__any(rm > (float)THRL), 0)) { const float dl = __builtin_fmaxf(rm, 0.f); mhat += dl; \
        _Pragma("unroll") for (int r = 0; r < 16; ++r) { C0[r] -= dl; C1[r] -= dl; } \
        qx = qx_build(ct - mhat, hi); asm volatile("" : "+v"(qx)); \
        const float f = __builtin_amdgcn_exp2f(-dl); l_reg *= f; if (hi == 0) wsf[r32] = f; resc = true; } } \
    SBAR(); \
    GAPB(o[0] = MFMA32(PAF(0), VFR(0), o[0]), C0, 0); \
    KRDX(GL); GAPB(o[1] = MFMA32(PAF(0), VFR(4), o[1]), C0, 4); \
    KRD(GL, 0); GAPB(o[0] = MFMA32(PAF(1), VFR(1), o[0]), C0, 8); \
    KRD(GL, 1); GAPB(o[1] = MFMA32(PAF(1), VFR(5), o[1]), C0, 12); \
    KRD(GL, 2); GAPB(o[0] = MFMA32(PAF(2), VFR(2), o[0]), C1, 0); \
    KRD(GL, 3); GAPB(o[1] = MFMA32(PAF(2), VFR(6), o[1]), C1, 4); \
    GAPB(o[0] = MFMA32(PAF(3), VFR(3), o[0]), C1, 8); \
    GAPB(o[1] = MFMA32(PAF(3), VFR(7), o[1]), C1, 12); \
    } while (0)
#define ENDW(tt) do { if ((tt) + 3 < NTe) { WAIT_BAR(3); } else if ((tt) + 2 < NTe) { WAIT_BAR(1); } else { WAIT_BAR(0); } } while (0)
#define VOTE(u) do { const int ts_ = NT - (u) - 3; bool ok_ = false; if (ts_ >= 0) { ok_ = __all((qkb - mhat) < clt[ts_]); } if (lane == 0) votes[wid] = ok_ ? 1u : 0u; } while (0)
#define TALLY(u) do { const u32x4 va_ = *(const LAS u32x4*)votes, vb_ = *(const LAS u32x4*)(votes + 4); \
        if (__builtin_amdgcn_readfirstlane((va_.x & va_.y & va_.z & va_.w & vb_.x & vb_.y & vb_.z & vb_.w) != 0u)) { if ((u) + 2 < NTe) { NTe = (u) + 2; WAIT_BAR(0); } } } while (0)
    int t = 1;
    for (; t + 1 < NTe && t < 5; t += 2) {
        STEP(pB0, pB1, pA0, pA1, t, (t + 3 < NTe), (t + 1 < NTe), (t + 1 < NTe));       ENDW(t);     RESC(); ROT();
        STEP(pA0, pA1, pB0, pB1, t + 1, (t + 4 < NTe), (t + 2 < NTe), (t + 2 < NTe));   VOTE(t + 1); ENDW(t + 1); TALLY(t + 1); RESC(); ROT();
    }
#undef CMASK
#define CMASK(P0, P1, p) do {} while (0)
    for (; t + 5 < NTe; t += 2) {
        STEP(pB0, pB1, pA0, pA1, t, true, true, true);       WAIT_BAR(3); RESC(); ROT();
        STEP(pA0, pA1, pB0, pB1, t + 1, true, true, true);   VOTE(t + 1); WAIT_BAR(3); TALLY(t + 1); RESC(); ROT();
    }
    for (; t + 1 < NTe; t += 2) {
        STEP(pB0, pB1, pA0, pA1, t, (t + 3 < NTe), (t + 1 < NTe), (t + 1 < NTe));       ENDW(t);     RESC(); ROT();
        STEP(pA0, pA1, pB0, pB1, t + 1, (t + 4 < NTe), (t + 2 < NTe), (t + 2 < NTe));   ENDW(t + 1); RESC(); ROT();
    }
#undef CMASK
#define CMASK(P0, P1, p) do { const int jb_ = 3 - (p); if (jb_ >= 0) cmask(P0, P1, jb_, qrel, hi); } while (0)
    STEP(pB0, pB1, pA0, pA1, NTe - 1, false, false, false); RESC();
    { float sacc = pB0[0] + pB0[1];
#pragma unroll
      for (int r = 2; r < 16; ++r) sacc += pB0[r];
#pragma unroll
      for (int r = 0; r < 16; ++r) sacc += pB1[r];
      l_reg += sacc;
      pw0 = (u32x4){PKW(pB0, 0), PKW(pB0, 2), PKW(pB0, 4), PKW(pB0, 6)}; pw1 = (u32x4){PKW(pB0, 8), PKW(pB0, 10), PKW(pB0, 12), PKW(pB0, 14)};
      pw2 = (u32x4){PKW(pB1, 0), PKW(pB1, 2), PKW(pB1, 4), PKW(pB1, 6)}; pw3 = (u32x4){PKW(pB1, 8), PKW(pB1, 10), PKW(pB1, 12), PKW(pB1, 14)};
      SBAR(); att::pv(o, (int)(unsigned)(uintptr_t)(vp0 + sl_cur), PAF(0), PAF(1), PAF(2), PAF(3)); }
    l_reg = att::swap_lo(l_reg) + att::swap_hi(l_reg);
    if (hi == 0) wsf[32 + r32] = l_reg; asm volatile("s_waitcnt lgkmcnt(0)" ::: "memory");
    float rli[16];
#pragma unroll
    for (int r = 0; r < 16; ++r) rli[r] = __builtin_amdgcn_rcpf(wsf[32 + crow(r, hi)]);
    bf16_t* Ow = O + (rowbase + q0 + wid * 32) * OPITCH + h * HD;
    { LAS bf16_t* stg = (LAS bf16_t*)(shm + LDS_OST) + wid * 2048;
#pragma unroll
      for (int r = 0; r < 16; ++r) { const int orow = crow(r, hi);
#pragma unroll
        for (int d0 = 0; d0 < 2; ++d0) stg[orow * 64 + d0 * 32 + r32] = (bf16_t)(cvt_pk_bf16(o[d0][r] * rli[r], 0.f) & 0xffffu); }
      asm volatile("s_waitcnt lgkmcnt(0)" ::: "memory");
#pragma unroll
      for (int i = 0; i < 4; ++i) { const int row = i * 8 + (lane >> 3), ch = lane & 7; const u32x4 v = *(const LAS u32x4*)(stg + row * 64 + ch * 8); *(u32x4*)(Ow + (long)row * OPITCH + ch * 8) = v;
        att::store_row_ssq(v, hs + (rowbase + q0 + wid * 32 + row) * 16, ch); } }
    asm volatile("s_waitcnt lgkmcnt(0)\n\ts_barrier" ::: "memory");
#undef DMA_K
#undef DMA_V
#undef CMASK
#undef RESC
#undef ROT
#undef PKW
#undef PAF
#undef VFR
#undef PIN
#undef MX3
#undef GAPA
#undef GAPB
#undef EX
#undef VRD
#undef KRD
#undef KRDX
#undef STEP
#undef ENDW
#undef VOTE
#undef TALLY
}
#undef SBAR
#undef WAIT_BAR
}


namespace sbk {
constexpr int QB = 256, KVBLK = 64, PITCH = HW, OPITCH = DM, NBURST = 6, SLOTB = 8192;
constexpr int LDS_K = 0, LDS_V = NBURST * SLOTB, LDS_FLAG = 2 * NBURST * SLOTB, LDS_END = LDS_FLAG + 128;
static_assert(LDS_END <= RING_BYTES, "sb LDS");
using att::crow; using att::glds16s; using att::qkt; using att::pv; using att::swap_lo;
__device__ __forceinline__ void sb_tile(const LAS char* Kslot, int vb, const bf16x8* qr, bf16x8 TD0, bf16x8 TD1, bf16x8 TONE, int jb, int qrel, int r32, int hi, float& R, f32x16* o) {
    f32x16 p0, p1; const f32x16 z16 = f32x16{};
    qkt(p0, p1, Kslot, qr, z16, r32, hi);
    if (jb >= 0) {
#pragma unroll
        for (int r = 0; r < 16; ++r) { const int kv = 64 * jb + crow(r, hi); if (kv >= qrel) p0[r] = -1.0e30f; if (kv + 32 >= qrel) p1[r] = -1.0e30f; } }
    f32x16 l0, l1;
#pragma unroll
    for (int r = 0; r < 16; ++r) {
        l0[r] = -(fmaxf(p0[r], 0.f) + __builtin_amdgcn_logf(1.0f + __builtin_amdgcn_exp2f(-fabsf(p0[r]))));
        l1[r] = -(fmaxf(p1[r], 0.f) + __builtin_amdgcn_logf(1.0f + __builtin_amdgcn_exp2f(-fabsf(p1[r])))); }
    u32x4 lw0 = {cvt_pk_bf16(l0[0], l0[1]), cvt_pk_bf16(l0[2], l0[3]), cvt_pk_bf16(l0[4], l0[5]), cvt_pk_bf16(l0[6], l0[7])};
    u32x4 lw1 = {cvt_pk_bf16(l0[8], l0[9]), cvt_pk_bf16(l0[10], l0[11]), cvt_pk_bf16(l0[12], l0[13]), cvt_pk_bf16(l0[14], l0[15])};
    u32x4 lw2 = {cvt_pk_bf16(l1[0], l1[1]), cvt_pk_bf16(l1[2], l1[3]), cvt_pk_bf16(l1[4], l1[5]), cvt_pk_bf16(l1[6], l1[7])};
    u32x4 lw3 = {cvt_pk_bf16(l1[8], l1[9]), cvt_pk_bf16(l1[10], l1[11]), cvt_pk_bf16(l1[12], l1[13]), cvt_pk_bf16(l1[14], l1[15])};
    f32x16 rt;
#pragma unroll
    for (int r = 0; r < 16; ++r) rt[r] = R;
    f32x16 t0 = MFMA32(TD0, __builtin_bit_cast(bf16x8, lw0), rt); t0 = MFMA32(TD1, __builtin_bit_cast(bf16x8, lw1), t0);
    t0 = MFMA32(TONE, __builtin_bit_cast(bf16x8, lw2), t0); t0 = MFMA32(TONE, __builtin_bit_cast(bf16x8, lw3), t0);
    f32x16 t1 = MFMA32(TD0, __builtin_bit_cast(bf16x8, lw2), rt); t1 = MFMA32(TD1, __builtin_bit_cast(bf16x8, lw3), t1);
#pragma unroll
    for (int r = 0; r < 16; ++r) { p0[r] = __builtin_amdgcn_exp2f(p0[r] + t0[r]); p1[r] = __builtin_amdgcn_exp2f(p1[r] + t1[r]); }
    R = swap_lo(t0[0]);
    u32x4 pw0 = {cvt_pk_bf16(p0[0], p0[1]), cvt_pk_bf16(p0[2], p0[3]), cvt_pk_bf16(p0[4], p0[5]), cvt_pk_bf16(p0[6], p0[7])};
    u32x4 pw1 = {cvt_pk_bf16(p0[8], p0[9]), cvt_pk_bf16(p0[10], p0[11]), cvt_pk_bf16(p0[12], p0[13]), cvt_pk_bf16(p0[14], p0[15])};
    u32x4 pw2 = {cvt_pk_bf16(p1[0], p1[1]), cvt_pk_bf16(p1[2], p1[3]), cvt_pk_bf16(p1[4], p1[5]), cvt_pk_bf16(p1[6], p1[7])};
    u32x4 pw3 = {cvt_pk_bf16(p1[8], p1[9]), cvt_pk_bf16(p1[10], p1[11]), cvt_pk_bf16(p1[12], p1[13]), cvt_pk_bf16(p1[14], p1[15])};
    pv(o, vb, __builtin_bit_cast(bf16x8, pw0), __builtin_bit_cast(bf16x8, pw1), __builtin_bit_cast(bf16x8, pw2), __builtin_bit_cast(bf16x8, pw3));
}
#define SB_WAITBAR(N) asm volatile("s_waitcnt vmcnt(" #N ") lgkmcnt(0)\n\ts_barrier" ::: "memory")
__device__ __forceinline__ void sb_unit(int b, int h, int qb, const bf16_t* Q, const bf16_t* K, const bf16_t* V, bf16_t* O, float* hs, LAS char* shm) {
    int tid = threadIdx.x; asm volatile("" : "+v"(tid)); const int lane = tid & 63, r32 = lane & 31, hi = lane >> 5; const int wid = __builtin_amdgcn_readfirstlane(tid >> 6);
    const long rowbase = (long)b * SEQ; const int q0 = qb * QB;
    const bf16_t* Qw = Q + (rowbase + q0 + wid * 32) * PITCH + h * HD;
    const bf16_t* Kh = K + rowbase * PITCH + h * HD; const bf16_t* Vh = V + rowbase * PITCH + h * HD;
    const unsigned lds0 = (unsigned)(uintptr_t)shm;
    LAS unsigned* flags = (LAS unsigned*)(shm + LDS_FLAG);
    const unsigned koff = (unsigned)(lane * PITCH + wid * 8) * 2u, voff = (unsigned)((16 * (wid & 3) + (lane >> 2)) * PITCH + (wid >> 2) * 32 + (lane & 3) * 8) * 2u;
    const unsigned kdst = lds0 + LDS_K + wid * 1024, vdst = lds0 + LDS_V + wid * 1024;
#define SB_DMA(p, slot) do { glds16s(Kh + (long)(NT - 1 - (p)) * KVBLK * PITCH, koff, (unsigned)__builtin_amdgcn_readfirstlane(kdst + (slot) * SLOTB)); \
        glds16s(Vh + (long)(NT - 1 - (p)) * KVBLK * PITCH, voff, (unsigned)__builtin_amdgcn_readfirstlane(vdst + (slot) * SLOTB)); } while (0)
    const int vb0 = (int)(lds0 + LDS_V) + ((lane >> 4) & 1) * 32 + (lane & 3) * 8 + (4 * hi + ((lane & 15) >> 2)) * 64;
    const int NT = (q0 + QB) / KVBLK, NB = NT < NBURST ? NT : NBURST;
    for (int p = 0; p < NB; ++p) SB_DMA(p, p);
    bf16x8 qr[4];
#pragma unroll
    for (int d0 = 0; d0 < 4; ++d0) qr[d0] = *(const bf16x8*)(Qw + (long)r32 * PITCH + d0 * 16 + hi * 8);
    f32x16 o[2]; o[0] = f32x16{}; o[1] = f32x16{};
    const int qrel = wid * 32 + r32;
    float R = 0.f;
    bf16x8 TD0, TD1, TONE;
#pragma unroll
    for (int j = 0; j < 8; ++j) { const int kvl = 8 * (j >> 2) + 4 * hi + (j & 3); TD0[j] = (kvl >= r32) ? (short)0x3F80 : (short)0; TD1[j] = (16 + kvl >= r32) ? (short)0x3F80 : (short)0; TONE[j] = (short)0x3F80; }
    if (NB > 4) { SB_WAITBAR(4); } else { SB_WAITBAR(0); }
    bool mid_done = (NB <= 4);
    int p = 3 - (wid >> 1);
    for (; p < NB; ++p) {
        if (p >= 4 && !mid_done) { SB_WAITBAR(0); mid_done = true; }
        sb_tile(shm + LDS_K + p * SLOTB, vb0 + p * SLOTB, qr, TD0, TD1, TONE, 3 - p, qrel, r32, hi, R, o);
        if (__all(R < SB_EXIT)) { ++p; break; }
    }
    if (!mid_done) { SB_WAITBAR(0); }
    { const bool dn = __all(R < SB_EXIT) || (p >= NT); if (lane == 0) flags[wid] = dn ? 1u : 0u; }
    SB_WAITBAR(0);
    bool alldone;
    { const u32x4 fa = *(const LAS u32x4*)flags, fb = *(const LAS u32x4*)(flags + 4); alldone = __builtin_amdgcn_readfirstlane((fa.x & fa.y & fa.z & fa.w & fb.x & fb.y & fb.z & fb.w) != 0u); }
    if (!alldone && NB < NT) {
        SB_DMA(NB, 0);
        for (int i = 0; NB + i < NT; ++i) {
            const int pp = NB + i, sl = i & 1;
            SB_WAITBAR(0);
            if (i > 0) { const LAS unsigned* fl = flags + 8 + ((i - 1) & 1) * 8; const u32x4 fa = *(const LAS u32x4*)fl, fb = *(const LAS u32x4*)(fl + 4);
                if (__builtin_amdgcn_readfirstlane((fa.x & fa.y & fa.z & fa.w & fb.x & fb.y & fb.z & fb.w) != 0u)) break; }
            if (pp + 1 < NT) SB_DMA(pp + 1, sl ^ 1);
            if (!__all(R < SB_EXIT)) sb_tile(shm + LDS_K + sl * SLOTB, vb0 + sl * SLOTB, qr, TD0, TD1, TONE, -1, qrel, r32, hi, R, o);
            { const bool dn = __all(R < SB_EXIT); if (lane == 0) flags[8 + (i & 1) * 8 + wid] = dn ? 1u : 0u; }
        }
        SB_WAITBAR(0);
    }
    bf16_t* Ow = O + (rowbase + q0 + wid * 32) * OPITCH + h * HD;
    { LAS bf16_t* stg = (LAS bf16_t*)(shm + LDS_K) + wid * 2048;
#pragma unroll
      for (int r = 0; r < 16; ++r) { const int orow = crow(r, hi);
#pragma unroll
        for (int d0 = 0; d0 < 2; ++d0) stg[orow * 64 + d0 * 32 + r32] = (bf16_t)(cvt_pk_bf16(o[d0][r], 0.f) & 0xffffu); }
      LDS_WAIT();
#pragma unroll
      for (int i = 0; i < 4; ++i) { const int row = i * 8 + (lane >> 3), ch = lane & 7; const u32x4 v = *(const LAS u32x4*)(stg + row * 64 + ch * 8); *(u32x4*)(Ow + (long)row * OPITCH + ch * 8) = v;
        att::store_row_ssq(v, hs + (rowbase + q0 + wid * 32 + row) * 16, ch); } }
    asm volatile("s_waitcnt vmcnt(0) lgkmcnt(0)\n\ts_barrier" ::: "memory");
#undef SB_DMA
}
#undef SB_WAITBAR
}

#define XB_TMO      128
#define XB_XCNT(j)  (256  + 64 * (j))
#define XB_XSUB(j)  (1280 + 64 * (j))
#define XB_XGEN(j)  (2304 + 64 * (j))
#define XB_TOP      3328
#define XB_TOPGEN   3392
#define XCD_BAR_WORDS 3456
#define XB_SPIN_CAP (1u << 18)
__device__ __forceinline__ unsigned xb_ld(unsigned* p)              { return __hip_atomic_load(p, __ATOMIC_RELAXED, __HIP_MEMORY_SCOPE_AGENT); }
__device__ __forceinline__ unsigned xb_add(unsigned* p, unsigned v) { return __hip_atomic_fetch_add(p, v, __ATOMIC_RELAXED, __HIP_MEMORY_SCOPE_AGENT); }
__device__ __forceinline__ unsigned xb_xcc_id() { return (unsigned)__builtin_amdgcn_s_getreg((3 << 11) | 20) & 0xFu; }
#define XB_SPIN(cond, bar) do { unsigned _sp = 0; while (cond) { __builtin_amdgcn_s_sleep(1); \
    if ((++_sp & 255u) == 0u) { if (xb_ld(&(bar)[XB_TMO])) break; if (_sp > XB_SPIN_CAP) { atomicAdd(&(bar)[XB_TMO], 1u); break; } } } } while (0)
struct XcdBarrier { unsigned* bar; unsigned x; volatile LAS unsigned* st; };
__device__ __forceinline__ XcdBarrier xcd_barrier_post(unsigned* bar, volatile LAS unsigned* st) {
    XcdBarrier b; b.bar = bar; b.x = xb_xcc_id(); b.st = st;
    if (threadIdx.x == 0) (void)xb_add(&bar[XB_XCNT(b.x)], 1u);
    return b;
}
__device__ __forceinline__ void xcd_barrier_complete(unsigned* bar, unsigned x, unsigned& nloc, unsigned& nx) {
    const unsigned G = gridDim.x * gridDim.y * gridDim.z;
    unsigned sum, cnt, mine, sp = 0u;
    for (;;) {
        sum = 0u; cnt = 0u; mine = 0u;
#pragma unroll
        for (unsigned j = 0; j < 16; ++j) { const unsigned c = xb_ld(&bar[XB_XCNT(j)]); sum += c; cnt += (c > 0u) ? 1u : 0u; mine = (j == x) ? c : mine; }
        if (sum == G) break;
        __builtin_amdgcn_s_sleep(1);
        if ((++sp & 255u) == 0u) { if (xb_ld(&bar[XB_TMO])) break; if (sp > XB_SPIN_CAP) { atomicAdd(&bar[XB_TMO], 1u); break; } }
    }
    nloc = mine > 0u ? mine : 1u; nx = cnt > 0u ? cnt : 1u;
}
__device__ __forceinline__ void xcd_barrier(const XcdBarrier& b) {
    asm volatile("s_waitcnt vmcnt(0)" ::: "memory");
    __syncthreads();
    if (threadIdx.x == 0) {
        unsigned* bar = b.bar;
        __builtin_amdgcn_s_waitcnt(0);
        unsigned nloc = b.st[0], nx = b.st[1];
        if (nloc == 0u) { xcd_barrier_complete(bar, b.x, nloc, nx); b.st[0] = nloc; b.st[1] = nx; }
        const unsigned old = xb_add(&bar[XB_XSUB(b.x)], 1u);
        const unsigned gen = old / nloc;
        if (old + 1u == (gen + 1u) * nloc) {
            __builtin_amdgcn_fence(__ATOMIC_RELEASE, "agent");
            asm volatile("s_waitcnt vmcnt(0)" ::: "memory");
            const unsigned og = xb_add(&bar[XB_TOP], 1u);
            const unsigned tg = og / nx;
            if (og + 1u == (tg + 1u) * nx) xb_add(&bar[XB_TOPGEN], 1u);
            else XB_SPIN(xb_ld(&bar[XB_TOPGEN]) == tg, bar);
            __builtin_amdgcn_fence(__ATOMIC_ACQUIRE, "agent");
            xb_add(&bar[XB_XGEN(b.x)], 1u);
            asm volatile("s_waitcnt vmcnt(0)" ::: "memory");
        } else {
            XB_SPIN(xb_ld(&bar[XB_XGEN(b.x)]) == gen, bar);
            __builtin_amdgcn_fence(__ATOMIC_ACQUIRE, "agent");
            asm volatile("s_waitcnt vmcnt(0)" ::: "memory");
        }
    }
    __syncthreads();
}

__device__ __forceinline__ const void* ldp(const volatile LAS unsigned* tab, int i) {
    const unsigned lo = __builtin_amdgcn_readfirstlane(tab[2 * i]), hi = __builtin_amdgcn_readfirstlane(tab[2 * i + 1]);
    return (const void*)(((unsigned long long)hi << 32) | lo);
}
struct Args {
    const float* x; const float* mem; const float* norm_mix; const float* w_in; const float* b_forget; const float* norm_fox; const float* norm_sb; const float* w_out;
    const float* norm_xattn; const float* norm_mem; const float* w_xq; const float* w_xkv; const float* w_xo; const float* norm_ffn;
    const float* w_rg; const float* b_rg; const float* w_re; const float* b_re; const float* w_gate; const float* w_up; const float* w_down; const float* norm_final;
    float* out; unsigned char* ws;
};

__device__ __forceinline__ void transpose_item(const float* W, int ldw, bf16_t* WT, int ldo, int k0, int n0, int dst_row0, const float* gain, LAS float* scr, int lane) {
    float tv[32], tg[32];
#pragma unroll
    for (int i = 0; i < 32; ++i) { const int kk = 2 * i + (lane >> 5); tv[i] = W[(size_t)(k0 + kk) * ldw + n0 + (lane & 31)]; tg[i] = gain ? gain[k0 + kk] : 1.f; }
#pragma unroll
    for (int i = 0; i < 32; ++i) { const int kk = 2 * i + (lane >> 5); scr[kk * 33 + (lane & 31)] = tv[i] * tg[i]; }
    LDS_WAIT(); asm volatile("" ::: "memory");
    const int c = lane & 7;
#pragma unroll
    for (int j = 0; j < 4; ++j) { const int n = (lane >> 3) + 8 * j; const LAS float* s = scr + (8 * c) * 33 + n;
        u32x4 o; o.x = cvt_pk_bf16(s[0 * 33], s[1 * 33]); o.y = cvt_pk_bf16(s[2 * 33], s[3 * 33]); o.z = cvt_pk_bf16(s[4 * 33], s[5 * 33]); o.w = cvt_pk_bf16(s[6 * 33], s[7 * 33]);
        *(u32x4*)(WT + (size_t)(dst_row0 + n) * ldo + k0 + 8 * c) = o; }
    LDS_WAIT(); asm volatile("" ::: "memory");
}

struct SchedDense {
    const char* A; const char* Bt; int nM, nN, G, c; size_t a_tile, b_tile, b_batch; int split_tiles;
    __device__ __forceinline__ bool next(int i, pg8::Unit& u) const {
        int pm, pn; if (!pg8::tile_order(i, G, c, nM, nN, pm, pn)) return false;
        u.a = A + (size_t)pm * a_tile; u.b = Bt + (size_t)pn * b_tile + (size_t)(pm >> 5) * b_batch; u.orow = pm * 256;
        if (split_tiles) { u.aux = pn / split_tiles; u.ocol = (pn % split_tiles) * 256; } else { u.aux = 1; u.ocol = pn * 256; }
        u.rows = nullptr; u.nvalid = 256; return true;
    }
};
struct SchedGH {
    const char* KVm; const char* Wxq; const char* Wxo; int G, c;
    __device__ __forceinline__ bool next(int i, pg8::Unit& u) const {
        const int L = i * G + c; if (L >= 256) return false;
        const int kind = L >> 7, r = L & 127, bh = r >> 2, j = r & 3, b = bh >> 2, h = bh & 3;
        if (kind == 0) { u.a = KVm + ((size_t)(b * 256) * 2048 + h * 256) * 2; u.b = Wxq + ((size_t)(256 * j) * 1024 + h * 256) * 2; u.orow = b * 1024 + h * 256; u.ocol = 256 * j; u.aux = 1; }
        else { u.a = Wxo + ((size_t)(256 * j) * 1024 + h * 256) * 2; u.b = KVm + ((size_t)(b * 256) * 2048 + 1024 + h * 256) * 2; u.orow = b * 1024 + 256 * j; u.ocol = h * 256; u.aux = 2; }
        u.rows = nullptr; u.nvalid = 256; return true;
    }
};
template <int KIND> struct SchedGHk { SchedGH s; __device__ __forceinline__ bool next(int i, pg8::Unit& u) const { const int c2 = (s.G >= 256) ? s.c - 128 * KIND : s.c; if (c2 < 0) return false; const int L = i * s.G + c2; if (L >= 128) return false; SchedGH t = s; t.G = 1; t.c = 0; return t.next(128 * KIND + L, u); } };
struct EpiGH { static constexpr bool HAS_MID = false; bf16_t* GTp; bf16_t* HTp; __device__ __forceinline__ void operator()(const f32x4 (&acc)[2][2][4][2], const pg8::Unit& u, int wr, int wc, int fr, int fq) const {
    pg8::EpiBf16 e{u.aux == 1 ? GTp : HTp, DM, nullptr, 0, 1.f, 1.f, nullptr, nullptr}; pg8::Unit v = u; v.aux = 1; e(acc, v, wr, wc, fr, fq); } };
struct SchedMoe {
    const char* A; const char* W; const int* list; const LAS int* tbl; int G, c, NPN; size_t w_exp, w_tile, a_tile; int ocol_w;
    __device__ __forceinline__ bool next(int i, pg8::Unit& u) const {
        const int L = i * G + c; const int tl = L / NPN, pn = L % NPN;
        if (tl >= __builtin_amdgcn_readfirstlane(tbl[16])) return false;
        int e = 0;
#pragma unroll 1
        for (int x = 1; x < NEXP; ++x) { if (tl >= __builtin_amdgcn_readfirstlane(tbl[x])) e = x; }
        const int j = tl - __builtin_amdgcn_readfirstlane(tbl[e]), n = __builtin_amdgcn_readfirstlane(tbl[32 + e]) - 256 * j;
        u.a = A + (size_t)tl * a_tile; u.b = W + (size_t)e * w_exp + (size_t)pn * w_tile; u.orow = tl * 256; u.ocol = pn * ocol_w; u.aux = 1;
        u.rows = list + (size_t)e * M + 256 * j; u.nvalid = n < 256 ? n : 256; return true;
    }
};
__device__ __forceinline__ void moe_table(LAS int* tbl, const unsigned* ctl) {
    if (threadIdx.x == 0) { int base = 0; for (int e = 0; e < NEXP; ++e) { const int n = (int)ctl[CW_CNT + 64 * e]; tbl[e] = base; tbl[32 + e] = n; base += (n + 255) >> 8; } tbl[16] = base; }
    __syncthreads();
}

__global__ void __launch_bounds__(NWAVES * 64, 2) hymba_fwd(Args args) {
    extern __shared__ __attribute__((aligned(16))) unsigned char lds_raw[];
    LAS unsigned char* lds = (LAS unsigned char*)lds_raw;
    volatile LAS unsigned* MISC = (volatile LAS unsigned*)(lds + MISC_OFF);
    const int tid0 = threadIdx.x; const int wave = __builtin_amdgcn_readfirstlane(tid0 >> 6);
    const int G = gridDim.x; const int bx = blockIdx.x; const int vcu = (G % 8 == 0) ? (bx % 8) * (G / 8) + bx / 8 : bx;
    volatile LAS unsigned* ATAB = (volatile LAS unsigned*)(lds + MISC_OFF + 512);
    for (int u = tid0; u < 256; u += NWAVES * 64) ((LAS unsigned*)(lds + MISC_OFF))[u] = 0u;
    __syncthreads();
    if (tid0 == 0) { const float* const* ap = (const float* const*)&args;
#pragma unroll
        for (int i = 0; i < 24; ++i) { const unsigned long long v = (unsigned long long)ap[i]; ATAB[2 * i] = (unsigned)v; ATAB[2 * i + 1] = (unsigned)(v >> 32); } }
    __syncthreads();
#define ARGP(name) ((const float*)ldp(ATAB, (int)(offsetof(Args, name) / 8)))
#define PHASE_PTRS \
    int tid = threadIdx.x; asm volatile("" : "+v"(tid)); const int lane = tid & 63; (void)lane; \
    unsigned char* const ws = (unsigned char*)ldp(ATAB, 23); float* const out = (float*)ldp(ATAB, 22); unsigned* const ctl = (unsigned*)(ws + WS_CTL); (void)out; (void)ctl; \
    bf16_t* const Win_t = (bf16_t*)(ws + WS_WIN); bf16_t* const Wout_t = (bf16_t*)(ws + WS_WOUT); bf16_t* const Wxq_n = (bf16_t*)(ws + WS_WXQ); bf16_t* const Wxkv_t = (bf16_t*)(ws + WS_WXKV); \
    bf16_t* const Wxo_t = (bf16_t*)(ws + WS_WXO); bf16_t* const Wgu_t = (bf16_t*)(ws + WS_WGU); bf16_t* const Wd_t = (bf16_t*)(ws + WS_WD); \
    float* const RX = (float*)(ws + WS_RX); float* const RMEM = (float*)(ws + WS_RMEM); float* const LF = (float*)(ws + WS_LF); float* const CC = (float*)(ws + WS_C2); float* const SSQ = (float*)(ws + WS_SSQ); \
    int* const TOKSLOT = (int*)(ws + WS_TOKSLOT); float* const TOKW = (float*)(ws + WS_TOKW); int* const LIST = (int*)(ws + WS_LIST); \
    bf16_t* const MEMB = (bf16_t*)(ws + WS_MEMB); bf16_t* const KVM = (bf16_t*)(ws + WS_KVM); bf16_t* const GT = (bf16_t*)(ws + WS_GT); bf16_t* const HT = (bf16_t*)(ws + WS_HT); \
    bf16_t* const XB = (bf16_t*)(ws + WS_XB); bf16_t* const QKV = (bf16_t*)(ws + WS_QKV); bf16_t* const H1B = (bf16_t*)(ws + WS_H1B); bf16_t* const U2B = (bf16_t*)(ws + WS_U2B); bf16_t* const HID = (bf16_t*)(ws + WS_HID); \
    bf16_t* const OAB = (bf16_t*)(ws + WS_O); bf16_t* const YB = (bf16_t*)(ws + WS_Y); bf16_t* const KX = (bf16_t*)(ws + WS_KX); (void)KX; float* const HS = (float*)(ws + WS_HS); (void)HS; float* const R2S = (float*)(ws + WS_SSQ); (void)R2S; \
    (void)Win_t; (void)Wout_t; (void)Wxq_n; (void)Wxkv_t; (void)Wxo_t; (void)Wgu_t; (void)Wd_t; (void)RX; (void)RMEM; (void)LF; (void)CC; (void)SSQ; (void)TOKSLOT; (void)TOKW; (void)LIST; \
    (void)MEMB; (void)KVM; (void)GT; (void)HT; (void)XB; (void)QKV; (void)H1B; (void)U2B; (void)HID; (void)OAB; (void)YB;
    XcdBarrier bar;
    { unsigned char* const ws0 = (unsigned char*)ldp(ATAB, 23); bar = xcd_barrier_post((unsigned*)(ws0 + WS_CTL) + CW_BAR, MISC + 8); }
    const int gw = vcu * NWAVES + wave, NGW = G * NWAVES;
    unsigned long long t_pa = 0, t_pb = 0; (void)t_pa; (void)t_pb;


    if (PROBE_LO == 0) t_pa = __builtin_amdgcn_s_memrealtime();
    if (PH(0))
    for (int rep_ = 0; rep_ < REPS(0); ++rep_)
    {
        PHASE_PTRS
        LAS float* wfT = (LAS float*)(lds + RING_OFF);
        LAS float* scr = (LAS float*)(lds + RING_OFF + 32768 + wave * 8448);
        { const float* win = ARGP(w_in); const float* gmix = ARGP(norm_mix);
          f32x4 fa[2], fb[2]; float gk[2];
#pragma unroll
          for (int q = 0; q < 2; ++q) { const int k = tid + 512 * q; gk[q] = gmix[k]; fa[q] = *(const f32x4*)(win + (size_t)k * WIN_LD + NPROJ); fb[q] = *(const f32x4*)(win + (size_t)k * WIN_LD + NPROJ + 4); }
#pragma unroll
          for (int q = 0; q < 2; ++q) { const int k = tid + 512 * q;
#pragma unroll
              for (int j = 0; j < 4; ++j) { wfT[j * DM + k] = fa[q][j] * gk[q]; wfT[(4 + j) * DM + k] = fb[q][j] * gk[q]; } } }
        constexpr int I_IN = 16 * 96, I_OUT = 16 * 32, I_XKV = 16 * 64, I_XO = 16 * 32, I_G = 16 * 16 * 8, I_U = I_G, I_D = 16 * 4 * 32, I_XQ = 1024;
        constexpr int NITEMS = I_IN + I_OUT + I_XKV + I_XO + I_G + I_U + I_D + I_XQ;
        for (int it = gw; it < NITEMS; it += NGW) {
            int r = it;
            if (r < I_IN) { const int kb = r / 96, nb = r % 96; transpose_item(ARGP(w_in), WIN_LD, Win_t, DM, 64 * kb, 32 * nb, 32 * nb, ARGP(norm_mix), scr, lane); continue; } r -= I_IN;
            if (r < I_OUT) { const int kb = r / 32, nb = r % 32; const float* gn = (64 * kb < HW) ? ARGP(norm_fox) : (ARGP(norm_sb) - HW); transpose_item(ARGP(w_out), DM, Wout_t, DM, 64 * kb, 32 * nb, 32 * nb, gn, scr, lane); continue; } r -= I_OUT;
            if (r < I_XKV) { const int kb = r / 64, nb = r % 64; transpose_item(ARGP(w_xkv), 2 * DM, Wxkv_t, DM, 64 * kb, 32 * nb, 32 * nb, ARGP(norm_mem), scr, lane); continue; } r -= I_XKV;
            if (r < I_XO) { const int kb = r / 32, nb = r % 32; transpose_item(ARGP(w_xo), DM, Wxo_t, DM, 64 * kb, 32 * nb, 32 * nb, nullptr, scr, lane); continue; } r -= I_XO;
            if (r < I_G + I_U) { const int up = r >= I_G; const int q = up ? r - I_G : r; const int e = q / 128, kb = (q % 128) / 8, nb = q % 8; const int n0 = 32 * nb;
                const float* W = (up ? ARGP(w_up) : ARGP(w_gate)) + (size_t)e * DM * DFF;
                transpose_item(W, DFF, Wgu_t + (size_t)e * 512 * DM, DM, 64 * kb, n0, 256 * (n0 / 128) + (n0 % 128) + (up ? 128 : 0), ARGP(norm_ffn), scr, lane); continue; } r -= I_G + I_U;
            if (r < I_D) { const int e = r / 128, kb = (r % 128) / 32, nb = r % 32; transpose_item(ARGP(w_down) + (size_t)e * DFF * DM, DM, Wd_t + (size_t)e * DM * DFF, DFF, 64 * kb, 32 * nb, 32 * nb, nullptr, scr, lane); continue; } r -= I_D;
            { const int k = r; const float gk = ARGP(norm_xattn)[k]; const f32x4* src = (const f32x4*)(ARGP(w_xq) + (size_t)k * DM) + lane; u32x2* dst = (u32x2*)(Wxq_n + (size_t)k * DM) + lane;
#pragma unroll
              for (int j = 0; j < 4; ++j) { const f32x4 v = src[64 * j] * gk; u32x2 w; w.x = cvt_pk_bf16(v[0], v[1]); w.y = cvt_pk_bf16(v[2], v[3]); dst[64 * j] = w; } }
        }
        __syncthreads();
        const float* xin = ARGP(x); const float* memin = ARGP(mem); const float* bfg = ARGP(b_forget);
        f32x4 vnx[4];
        { const int r0_ = gw; if (r0_ < M + MEMROWS) { const bool im_ = r0_ >= M; const f32x4* xr = (const f32x4*)((im_ ? memin : xin) + (size_t)(im_ ? r0_ - M : r0_) * DM) + lane;
#pragma unroll
            for (int j = 0; j < 4; ++j) vnx[j] = xr[64 * j]; } }
        for (int row = gw; row < M + MEMROWS; row += NGW) {
            const bool is_mem = row >= M; const int r = is_mem ? row - M : row;
            f32x4 v[4]; float s = 0.f;
#pragma unroll
            for (int j = 0; j < 4; ++j) v[j] = vnx[j];
            { const int nr_ = row + NGW; if (nr_ < M + MEMROWS) { const bool im_ = nr_ >= M; const f32x4* xr = (const f32x4*)((im_ ? memin : xin) + (size_t)(im_ ? nr_ - M : nr_) * DM) + lane;
#pragma unroll
                for (int j = 0; j < 4; ++j) vnx[j] = xr[64 * j]; } }
#pragma unroll
            for (int j = 0; j < 4; ++j) s += (v[j][0] * v[j][0] + v[j][1] * v[j][1]) + (v[j][2] * v[j][2] + v[j][3] * v[j][3]);
            const float rinv = rsqrtf(wave_sum(s) * (1.0f / DM) + EPS);
            u32x2* o8 = (u32x2*)((is_mem ? MEMB : XB) + (size_t)r * DM) + lane;
#pragma unroll
            for (int j = 0; j < 4; ++j) { u32x2 w; w.x = cvt_pk_bf16(v[j][0], v[j][1]); w.y = cvt_pk_bf16(v[j][2], v[j][3]); o8[64 * j] = w; }
            if (is_mem) { if (lane == 0) RMEM[r] = rinv; continue; }
            float f[8];
#pragma unroll
            for (int jj = 0; jj < 8; ++jj) { float a = 0.f;
#pragma unroll
                for (int j = 0; j < 4; ++j) { const f32x4 w4 = *(const LAS f32x4*)(wfT + jj * DM + 256 * j + 4 * lane); a += (v[j][0] * w4[0] + v[j][1] * w4[1]) + (v[j][2] * w4[2] + v[j][3] * w4[3]); }
                f[jj] = wave_sum(a); }
            if (lane == 0) RX[r] = rinv;
            if (lane < 8) { float fl = 0.f;
#pragma unroll
                for (int jj = 0; jj < 8; ++jj) fl = (lane == jj) ? f[jj] : fl;
                fl = fl * rinv + bfg[lane];
                const float ls = fminf(fl, 0.f) - log1pf(expf(-fabsf(fl)));
                LF[(size_t)r * 8 + lane] = ls * LOG2E; }
        }
    }
    xcd_barrier(bar);
    if (PROBE_HI == 0) t_pb = __builtin_amdgcn_s_memrealtime();

    if (PROBE_LO == 1) t_pa = __builtin_amdgcn_s_memrealtime();
    if (PH(1))
    if (vcu < 32) {
        PHASE_PTRS
        const int b = vcu >> 2, h = (vcu & 3) * 2 + (wave >> 2), seg = wave & 3, s0 = seg * 2048 + lane * 32;
        const float* src = LF + ((size_t)b * SEQ + s0) * 8 + h;
        float p[32];
#pragma unroll
        for (int j = 0; j < 32; ++j) p[j] = src[j * 8];
#pragma unroll
        for (int j = 1; j < 32; ++j) p[j] += p[j - 1];
        float inc = p[31];
#pragma unroll
        for (int o = 1; o < 64; o <<= 1) { const float y = __shfl_up(inc, o); if (lane >= o) inc += y; }
        LAS float* tot = (LAS float*)(lds + EXTRA_OFF);
        if (lane == 63) tot[wave] = inc;
        __syncthreads();
        float off = inc - p[31];
        for (int q = 0; q < 3; ++q) if (q < seg) off += tot[(wave & 4) + q];
        float* dst = CC + ((size_t)b * NH + h) * SEQ + s0; bf16_t* kx = KX + (((size_t)b * NH + h) * SEQ + s0) * 8;
#pragma unroll
        for (int j = 0; j < 32; ++j) { const float x = off + p[j]; dst[j] = x;
            unsigned hm, lo; fox::split3(-x, hm, lo); u32x4 w; w.x = 0x3F803F80u; w.y = 0x3F80u | (hm << 16); w.z = (hm >> 16) | (lo << 16); w.w = 0u;
            *(u32x4*)(kx + j * 8) = w; }
        VM_WAIT(); __syncthreads();
    }
    if (PH(1))
    for (int rep_ = 0; rep_ < REPS(1); ++rep_)
    {
        PHASE_PTRS
        pg8::Gemm g{DM, DM, DM};
        SchedDense S{(const char*)XB, (const char*)Win_t, M / 256, NPROJ / 256, G, bx, (size_t)256 * DM * 2, (size_t)256 * DM * 2, 0, 2};
        LAS float* rst = (LAS float*)(lds + EXTRA_OFF);
        for (int i = 0; i < 16; ++i) { int pm, pn; if (!pg8::tile_order(i, G, bx, M / 256, NPROJ / 256, pm, pn)) break; if (tid < 256) rst[i * 256 + tid] = RX[pm * 256 + tid]; }
        VM_WAIT(); __syncthreads();
        pg8::EpiBf16 E{QKV, HW, RX, QKV_STRIDE, C2, C2, ctl + CW_KN, rst};
        pg8::gemm_phase<pg8::EpiBf16, SchedDense, true, false>(lds + RING_OFF, g, S, E);
    }
    xcd_barrier(bar);
    if (PROBE_HI == 1) t_pb = __builtin_amdgcn_s_memrealtime();

    if (PROBE_LO == 2) t_pa = __builtin_amdgcn_s_memrealtime();
    if (PH(2))
    {
        PHASE_PTRS
        const bf16_t* QA = QKV; const bf16_t* KA = QKV + QKV_STRIDE; const bf16_t* VA = QKV + 2 * QKV_STRIDE;
        const bf16_t* QBp = QKV + 3 * QKV_STRIDE; const bf16_t* KBp = QKV + 4 * QKV_STRIDE; const bf16_t* VBp = QKV + 5 * QKV_STRIDE;
        bf16_t* OA = OAB; bf16_t* OB = OAB + HW;
        LAS char* shm = (LAS char*)(lds + RING_OFF);
        { pg8::Gemm g{DM, DM, DM};
          SchedDense S2{(const char*)MEMB, (const char*)Wxkv_t, MEMROWS / 256, 2 * DM / 256, G, bx, (size_t)256 * DM * 2, (size_t)256 * DM * 2, 0, 0};
          pg8::EpiBf16 E2{KVM, 2 * DM, RMEM, 0, 1.f, 1.f, nullptr, nullptr};
          pg8::gemm_phase<pg8::EpiBf16, SchedDense, true, false>(lds + RING_OFF, g, S2, E2);
          VM_WAIT(); __syncthreads(); }
        for (int rep = 0; rep < REP_FOX; ++rep)
        for (int i = 0; i < 8; ++i) { const int bh = (vcu >> 5) * 8 + i, x = vcu & 31, qb = (i & 1) ? 31 - x : x;
            const float kmax = sqrtf(__uint_as_float(ctl[CW_KN + bh * 2]) + __uint_as_float(ctl[CW_KN + bh * 2 + 1])) * 1.01f;
            fox::fox_unit<8>(bh, qb, QA, KA, VA, OA, HS + (bh & 7), CC + (size_t)bh * SEQ, KX + (size_t)bh * SEQ * 8, kmax, shm); }
        { volatile LAS unsigned* qs = MISC + 16;
          unsigned nxt = 0u;
          if (tid == 0) qs[0] = __hip_atomic_fetch_add(ctl + CW_SBQ, 1u, __ATOMIC_RELAXED, __HIP_MEMORY_SCOPE_AGENT);
          __syncthreads();
          unsigned idx = qs[0];
          while (idx < (unsigned)(BATCH * NH * 32 * REP_SB)) {
              __syncthreads();
              if (tid == 0) nxt = __hip_atomic_fetch_add(ctl + CW_SBQ, 1u, __ATOMIC_RELAXED, __HIP_MEMORY_SCOPE_AGENT);
              const int un = (int)(idx % (unsigned)(BATCH * NH * 32)), bh = un >> 5, qb = un & 31;
              sbk::sb_unit(bh >> 3, bh & 7, qb, QBp, KBp, VBp, OB, HS + 8 + (bh & 7), shm);
              if (tid == 0) qs[0] = nxt;
              __syncthreads();
              idx = qs[0];
          } }
    }
    xcd_barrier(bar);
    if (PROBE_HI == 2) t_pb = __builtin_amdgcn_s_memrealtime();

    if (PROBE_LO == 4) t_pa = __builtin_amdgcn_s_memrealtime();
    if (PH(4))
    for (int rep_ = 0; rep_ < REPS(4); ++rep_)
    {
        PHASE_PTRS
        pg8::Gemm g{DM, DM, DM};
        SchedDense S{(const char*)OAB, (const char*)Wout_t, M / 256, DM / 256, G, bx, (size_t)256 * DM * 2, (size_t)256 * DM * 2, 0, 0};
        LAS f32x2* rab = (LAS f32x2*)(lds + EXTRA_OFF);
        for (int i = 0; i < 8; ++i) { int pm, pn; if (!pg8::tile_order(i, G, bx, M / 256, DM / 256, pm, pn)) break;
            if (tid < 256) { const f32x4* p = (const f32x4*)(HS + (size_t)(pm * 256 + tid) * 16); const f32x4 a0 = p[0], a1 = p[1], b0 = p[2], b1 = p[3];
                const float ra = rsqrtf((((a0[0] + a0[1]) + (a0[2] + a0[3])) + ((a1[0] + a1[1]) + (a1[2] + a1[3]))) * (1.0f / HW) + EPS);
                const float rb = rsqrtf((((b0[0] + b0[1]) + (b0[2] + b0[3])) + ((b1[0] + b1[1]) + (b1[2] + b1[3]))) * (1.0f / HW) + EPS);
                rab[i * 256 + tid] = (f32x2){ra / rb, rb}; } }
        VM_WAIT(); __syncthreads();
        pg8::EpiOutProj E{XB, H1B, SSQ, rab};
        pg8::gemm_phase<pg8::EpiOutProj, SchedDense, true, false>(lds + RING_OFF, g, S, E);
        pg8::Gemm g2{0, 0, 256};
        SchedGH SG{(const char*)KVM, (const char*)Wxq_n, (const char*)Wxo_t, G, bx};
        EpiGH EG{GT, HT};
        g2.lda = 2 * DM; g2.ldb = DM; SchedGHk<0> S0{SG}; pg8::gemm_phase<EpiGH, SchedGHk<0>, true, false>(lds + RING_OFF, g2, S0, EG);
        g2.lda = DM; g2.ldb = 2 * DM; SchedGHk<1> S1{SG}; pg8::gemm_phase<EpiGH, SchedGHk<1>, true, false>(lds + RING_OFF, g2, S1, EG);
    }
    xcd_barrier(bar);
    if (PROBE_HI == 4) t_pb = __builtin_amdgcn_s_memrealtime();

    if (PROBE_LO == 5) t_pa = __builtin_amdgcn_s_memrealtime();
    if (PH(5))
    for (int rep_ = 0; rep_ < REPS(5); ++rep_)
    {
        PHASE_PTRS
        pg8::Gemm g{DM, DM, DM};
        SchedDense S{(const char*)H1B, (const char*)GT, M / 256, DM / 256, G, bx, (size_t)256 * DM * 2, (size_t)256 * DM * 2, (size_t)DM * DM * 2, 0};
        LAS float* r1t = (LAS float*)(lds + EXTRA_OFF + 8192);
        for (int i = 0; i < 8; ++i) { int pm, pn; if (!pg8::tile_order(i, G, bx, M / 256, DM / 256, pm, pn)) break;
            if (tid < 256) { const f32x4* sp = (const f32x4*)(SSQ + (size_t)(pm * 256 + tid) * 16); const f32x4 s0 = sp[0], s1 = sp[1], s2 = sp[2], s3 = sp[3];
                const float tot = ((s0[0] + s0[1]) + (s0[2] + s0[3])) + ((s1[0] + s1[1]) + (s1[2] + s1[3])) + ((s2[0] + s2[1]) + (s2[2] + s2[3])) + ((s3[0] + s3[1]) + (s3[2] + s3[3]));
                r1t[i * 256 + tid] = rsqrtf(tot * (1.0f / DM) + EPS) * XSC; } }
        VM_WAIT(); __syncthreads();
        pg8::EpiSoftmax E{XB, r1t, (LAS float*)(lds + EXTRA_OFF)};
        pg8::gemm_phase<pg8::EpiSoftmax, SchedDense, true, false>(lds + RING_OFF, g, S, E);
    }
    xcd_barrier(bar);
    if (PROBE_HI == 5) t_pb = __builtin_amdgcn_s_memrealtime();

    if (PROBE_LO == 6) t_pa = __builtin_amdgcn_s_memrealtime();
    if (PH(6))
    {
        PHASE_PTRS
        pg8::Gemm g{DM, DM, DM};
        SchedDense S{(const char*)XB, (const char*)HT, M / 256, DM / 256, G, bx, (size_t)256 * DM * 2, (size_t)256 * DM * 2, (size_t)DM * DM * 2, 0};
        pg8::EpiResidBf16 E{H1B};
        pg8::gemm_phase<pg8::EpiResidBf16, SchedDense, true, false>(lds + RING_OFF, g, S, E);
    }
    xcd_barrier(bar);
    if (PROBE_HI == 6) t_pb = __builtin_amdgcn_s_memrealtime();

    if (PROBE_LO == 7) t_pa = __builtin_amdgcn_s_memrealtime();
    if (PH(7))
    {
        PHASE_PTRS
        LAS bf16_t* wBh = (LAS bf16_t*)(lds + RING_OFF); LAS bf16_t* wBl = wBh + 20 * DM;
        { const f32x4* wg4 = (const f32x4*)ARGP(w_rg); const f32x4* we4 = (const f32x4*)ARGP(w_re); const float* gf = ARGP(norm_ffn);
          f32x4 ga[2], ea[2][4]; float gk[2];
#pragma unroll
          for (int q = 0; q < 2; ++q) { const int k = tid + 512 * q; ga[q] = wg4[k]; gk[q] = gf[k];
#pragma unroll
              for (int c = 0; c < 4; ++c) ea[q][c] = we4[k * 4 + c]; }
#pragma unroll
          for (int q = 0; q < 2; ++q) { const int k = tid + 512 * q;
#pragma unroll
              for (int j = 0; j < 4; ++j) { { const float v = ga[q][j] * gk[q]; const unsigned hi_ = cvt_pk_bf16(v, 0.f) & 0xffffu; wBh[j * DM + k] = (bf16_t)hi_; wBl[j * DM + k] = (bf16_t)(cvt_pk_bf16(v - __uint_as_float(hi_ << 16), 0.f) & 0xffffu); }
#pragma unroll
                  for (int c = 0; c < 4; ++c) { const float v = ea[q][c][j] * gk[q]; const unsigned hi_ = cvt_pk_bf16(v, 0.f) & 0xffffu; const int col = 4 + 4 * c + j; wBh[col * DM + k] = (bf16_t)hi_; wBl[col * DM + k] = (bf16_t)(cvt_pk_bf16(v - __uint_as_float(hi_ << 16), 0.f) & 0xffffu); } } } }
        LAS int* dec_e = (LAS int*)(lds + RING_OFF + 81920); LAS float* dec_w = (LAS float*)(lds + RING_OFF + 81920 + 2048); LAS int* dec_r = (LAS int*)(lds + RING_OFF + 81920 + 4096);
        LAS int* hist = (LAS int*)(lds + RING_OFF + 81920 + 6144); LAS int* ebase = hist + 16; LAS float* dec_v = (LAS float*)(lds + RING_OFF + 81920 + 8192);
        if (tid < 16) hist[tid] = 0;
        __syncthreads();
        const float brg0 = ARGP(b_rg)[0], brg1 = ARGP(b_rg)[1], brg2 = ARGP(b_rg)[2], brg3 = ARGP(b_rg)[3]; const float* bre = ARGP(b_re);
        const int tok = lane & 31, half = lane >> 5, jcol = tok < 20 ? tok : 19;
        for (int it = 0; it * NGW < M / 32; ++it) {
            const int T = gw + it * NGW; const bool act = T < M / 32; const int r0 = act ? 32 * T : 0;
            const bf16_t* rowp = H1B + (size_t)(r0 + tok) * DM + 512 * half;
            const LAS bf16_t* wph = wBh + jcol * DM + 512 * half; const LAS bf16_t* wpl = wBl + jcol * DM + 512 * half;
            f32x16 ah0 = f32x16{}, ah1 = f32x16{}, al0 = f32x16{}, al1 = f32x16{}; float ssq = 0.f;
#pragma unroll 4
            for (int sidx = 0; sidx < 64; sidx += 2) {
                const u32x4 a0 = *(const u32x4*)(rowp + 8 * sidx), a1 = *(const u32x4*)(rowp + 8 * sidx + 8);
                const bf16x8 wh0 = *(const LAS bf16x8*)(wph + 8 * sidx), wl0 = *(const LAS bf16x8*)(wpl + 8 * sidx), wh1 = *(const LAS bf16x8*)(wph + 8 * sidx + 8), wl1 = *(const LAS bf16x8*)(wpl + 8 * sidx + 8);
                ah0 = MFMA32(wh0, __builtin_bit_cast(bf16x8, a0), ah0); al0 = MFMA32(wl0, __builtin_bit_cast(bf16x8, a0), al0);
                ah1 = MFMA32(wh1, __builtin_bit_cast(bf16x8, a1), ah1); al1 = MFMA32(wl1, __builtin_bit_cast(bf16x8, a1), al1);
                ssq += (bf16lo(a0.x) * bf16lo(a0.x) + bf16hi(a0.x) * bf16hi(a0.x)) + (bf16lo(a0.y) * bf16lo(a0.y) + bf16hi(a0.y) * bf16hi(a0.y)) + (bf16lo(a0.z) * bf16lo(a0.z) + bf16hi(a0.z) * bf16hi(a0.z)) + (bf16lo(a0.w) * bf16lo(a0.w) + bf16hi(a0.w) * bf16hi(a0.w));
                ssq += (bf16lo(a1.x) * bf16lo(a1.x) + bf16hi(a1.x) * bf16hi(a1.x)) + (bf16lo(a1.y) * bf16lo(a1.y) + bf16hi(a1.y) * bf16hi(a1.y)) + (bf16lo(a1.z) * bf16lo(a1.z) + bf16hi(a1.z) * bf16hi(a1.z)) + (bf16lo(a1.w) * bf16lo(a1.w) + bf16hi(a1.w) * bf16hi(a1.w));
            }
            const float rinv = rsqrtf((att::swap_lo(ssq) + att::swap_hi(ssq)) * (1.0f / DM) + EPS);
            float lg[20];
#pragma unroll
            for (int r = 0; r < 12; ++r) { const float c = (ah0[r] + ah1[r]) + (al0[r] + al1[r]); auto rr = __builtin_amdgcn_permlane32_swap(__float_as_uint(c), __float_as_uint(c), false, false);
                const int jl = (r & 3) + 8 * (r >> 2); lg[jl] = __uint_as_float(rr[0]) * rinv; if (r < 8) lg[jl + 4] = __uint_as_float(rr[1]) * rinv; }
            float g0 = lg[0] + brg0, g1 = lg[1] + brg1, g2 = lg[2] + brg2, g3 = lg[3] + brg3;
            int gi = 0; float gm = g0; if (g1 > gm) { gm = g1; gi = 1; } if (g2 > gm) { gm = g2; gi = 2; } if (g3 > gm) { gm = g3; gi = 3; }
            const float gval = 1.0f / (expf(g0 - gm) + expf(g1 - gm) + expf(g2 - gm) + expf(g3 - gm));
            float el[4];
#pragma unroll
            for (int j = 0; j < 4; ++j) { const float e0 = lg[4 + j], e1 = lg[8 + j], e2 = lg[12 + j], e3 = lg[16 + j]; el[j] = ((gi == 0) ? e0 : (gi == 1) ? e1 : (gi == 2) ? e2 : e3) + bre[gi * 4 + j]; }
            int i0 = 0; float m0 = el[0];
#pragma unroll
            for (int j = 1; j < 4; ++j) if (el[j] > m0) { m0 = el[j]; i0 = j; }
            int i1 = -1; float m1 = -3.0e38f;
#pragma unroll
            for (int j = 0; j < 4; ++j) if (j != i0 && el[j] > m1) { m1 = el[j]; i1 = j; }
            const float w0 = 1.0f / (1.0f + expf(m1 - m0)), w1 = 1.0f - w0;
            if (act) { const int e = gi * 4 + (half == 0 ? i0 : i1); const float w = gval * (half == 0 ? w0 : w1);
                const int idx = (wave * 32 + tok) * 2 + half; dec_e[idx] = e; dec_w[idx] = w; dec_v[idx] = rinv; dec_r[idx] = __hip_atomic_fetch_add(hist + e, 1, __ATOMIC_RELAXED, __HIP_MEMORY_SCOPE_WORKGROUP); }
            __syncthreads();
            if (tid < 16) { const int n = hist[tid]; ebase[tid] = n ? (int)__hip_atomic_fetch_add(ctl + CW_CNT + 64 * tid, (unsigned)n, __ATOMIC_RELAXED, __HIP_MEMORY_SCOPE_AGENT) : 0; }
            __syncthreads();
            if (act) { const int row = r0 + (lane >> 1), idx = wave * 64 + lane; const int e = dec_e[idx], pos = ebase[e] + dec_r[idx];
                LIST[(size_t)e * M + pos] = row; R2S[(size_t)e * M + pos] = dec_v[idx]; TOKSLOT[(size_t)row * 2 + (lane & 1)] = (e << 20) | pos; TOKW[(size_t)row * 2 + (lane & 1)] = dec_w[idx]; }
            __syncthreads();
            if (tid < 16) hist[tid] = 0;
            __syncthreads();
        }
    }
    xcd_barrier(bar);
    if (PROBE_HI == 7) t_pb = __builtin_amdgcn_s_memrealtime();

    if (PROBE_LO == 8) t_pa = __builtin_amdgcn_s_memrealtime();
    if (PH(8))
    for (int rep_ = 0; rep_ < REPS(8); ++rep_)
    {
        PHASE_PTRS
        pg8::Gemm g{DM, DM, DM};
        LAS int* tbl = (LAS int*)(lds + EXTRA_OFF + 8192); moe_table(tbl, ctl);
        SchedMoe S; S.A = (const char*)H1B; S.W = (const char*)Wgu_t; S.list = LIST; S.tbl = tbl; S.G = G; S.c = bx; S.NPN = 2; S.w_exp = (size_t)512 * DM * 2; S.w_tile = (size_t)256 * DM * 2; S.a_tile = 0; S.ocol_w = 128;
        pg8::EpiSwiglu E{HID, R2S, LIST};
        pg8::gemm_phase<pg8::EpiSwiglu, SchedMoe, true, true>(lds + RING_OFF, g, S, E);
    }
    xcd_barrier(bar);
    if (PROBE_HI == 8) t_pb = __builtin_amdgcn_s_memrealtime();

    if (PROBE_LO == 9) t_pa = __builtin_amdgcn_s_memrealtime();
    if (PH(9))
    for (int rep_ = 0; rep_ < REPS(9); ++rep_)
    {
        PHASE_PTRS
        pg8::Gemm g{DFF, DFF, DFF};
        LAS int* tbl = (LAS int*)(lds + EXTRA_OFF + 8192);
        SchedMoe S; S.A = (const char*)HID; S.W = (const char*)Wd_t; S.list = LIST; S.tbl = tbl; S.G = G; S.c = bx; S.NPN = 4; S.w_exp = (size_t)DM * DFF * 2; S.w_tile = (size_t)256 * DFF * 2; S.a_tile = (size_t)256 * DFF * 2; S.ocol_w = 256;
        pg8::EpiBf16 E{YB, DM, nullptr, 0, 1.f, 1.f, nullptr, nullptr};
        pg8::gemm_phase<pg8::EpiBf16, SchedMoe, true, false>(lds + RING_OFF, g, S, E);
    }
    xcd_barrier(bar);
    if (PROBE_HI == 9) t_pb = __builtin_amdgcn_s_memrealtime();

    if (PROBE_LO == 10) t_pa = __builtin_amdgcn_s_memrealtime();
    if (PH(10))
    {
        PHASE_PTRS
        const LAS int* tb = (const LAS int*)(lds + EXTRA_OFF + 8192);
        const f32x4* gp = (const f32x4*)ARGP(norm_final) + lane;
        int sl0 = 0, sl1 = 0; float sw0 = 0.f, sw1 = 0.f;
        u32x2 ya_n[4], yb_n[4], hh_n[4]; float w0_n = 0.f, w1_n = 0.f;
#define P10_SLOTS(rw) do { sl0 = TOKSLOT[(size_t)(rw) * 2]; sl1 = TOKSLOT[(size_t)(rw) * 2 + 1]; sw0 = TOKW[(size_t)(rw) * 2]; sw1 = TOKW[(size_t)(rw) * 2 + 1]; } while (0)
#define P10_DATA(rw) do { const int r0_ = tb[sl0 >> 20] * 256 + (sl0 & 0xfffff), r1_ = tb[sl1 >> 20] * 256 + (sl1 & 0xfffff); w0_n = sw0; w1_n = sw1; \
        const u32x2* y0_ = (const u32x2*)(YB + (size_t)r0_ * DM) + lane; const u32x2* y1_ = (const u32x2*)(YB + (size_t)r1_ * DM) + lane; const u32x2* h_ = (const u32x2*)(H1B + (size_t)(rw) * DM) + lane; \
        _Pragma("unroll") for (int j = 0; j < 4; ++j) { ya_n[j] = y0_[64 * j]; yb_n[j] = y1_[64 * j]; hh_n[j] = h_[64 * j]; } } while (0)
        if (gw < M) { P10_SLOTS(gw); P10_DATA(gw); if (gw + NGW < M) P10_SLOTS(gw + NGW); }
        for (int row = gw; row < M; row += NGW) {
            u32x2 ya[4], yb[4], hh[4]; const float w0 = w0_n, w1 = w1_n;
#pragma unroll
            for (int j = 0; j < 4; ++j) { ya[j] = ya_n[j]; yb[j] = yb_n[j]; hh[j] = hh_n[j]; }
            if (row + NGW < M) { P10_DATA(row + NGW); if (row + 2 * NGW < M) P10_SLOTS(row + 2 * NGW); }
            f32x4* hr = (f32x4*)(out + (size_t)row * DM) + lane;
            f32x4 v[4]; float s = 0.f;
#pragma unroll
            for (int j = 0; j < 4; ++j) { const u32x2 a = ya[j], b = yb[j]; const u32x2 hx = hh[j]; f32x4 h = {bf16lo(hx.x), bf16hi(hx.x), bf16lo(hx.y), bf16hi(hx.y)};
                h[0] += w0 * bf16lo(a.x) + w1 * bf16lo(b.x); h[1] += w0 * bf16hi(a.x) + w1 * bf16hi(b.x); h[2] += w0 * bf16lo(a.y) + w1 * bf16lo(b.y); h[3] += w0 * bf16hi(a.y) + w1 * bf16hi(b.y);
                v[j] = h; s += (h[0] * h[0] + h[1] * h[1]) + (h[2] * h[2] + h[3] * h[3]); }
            const float rinv = rsqrtf(wave_sum(s) * (1.0f / DM) + EPS);
#pragma unroll
            for (int j = 0; j < 4; ++j) hr[64 * j] = v[j] * rinv * gp[64 * j];
        }
#undef P10_SLOTS
#undef P10_DATA
    }
    if (PROBE_LO >= 0) {
        if (PROBE_HI == 10) t_pb = __builtin_amdgcn_s_memrealtime();
        if (blockIdx.x == 0 && threadIdx.x == 0) { const unsigned long long t0 = __builtin_amdgcn_s_memrealtime(), span = 2 * (t_pb - t_pa);
            while (__builtin_amdgcn_s_memrealtime() - t0 < span) __builtin_amdgcn_s_sleep(8); }
    }
}

extern "C" void kernel_launch(void* const* d_in, const int* in_sizes, int n_in, void* d_out, int out_size, void* d_ws, size_t ws_size, hipStream_t stream) {
    static int grid = 0;
    if (grid == 0) {
        if (n_in != 22 || in_sizes[0] != M * DM || out_size != M * DM || ws_size < WS_END) { fprintf(stderr, "kernel_launch: unexpected shapes (n_in %d, in0 %d, out %d, ws %zu)\n", n_in, n_in > 0 ? in_sizes[0] : -1, out_size, ws_size); grid = -1; return; }
        int dev = 0, cus = 0, per_cu = 0;
        if (hipGetDevice(&dev) != hipSuccess || hipDeviceGetAttribute(&cus, hipDeviceAttributeMultiprocessorCount, dev) != hipSuccess) { grid = -1; return; }
        if (hipFuncSetAttribute((const void*)hymba_fwd, hipFuncAttributeMaxDynamicSharedMemorySize, LDS_BYTES) != hipSuccess) { fprintf(stderr, "kernel_launch: hipFuncSetAttribute failed\n"); grid = -1; return; }
        if (hipOccupancyMaxActiveBlocksPerMultiprocessor(&per_cu, (const void*)hymba_fwd, NWAVES * 64, LDS_BYTES) != hipSuccess || per_cu < 1) { fprintf(stderr, "kernel_launch: occupancy query reports %d\n", per_cu); }
        (void)hipGetLastError();
        grid = cus;
    }
    if (grid < 0) return;
    (void)hipMemsetAsync((char*)d_ws + WS_CTL, 0, CTL_ZERO_BYTES, stream);
    Args a{};
    const float** p = (const float**)&a;
    for (int i = 0; i < 22; ++i) p[i] = (const float*)d_in[i];
    a.out = (float*)d_out; a.ws = (unsigned char*)d_ws;
    hipLaunchKernelGGL(hymba_fwd, dim3(grid), dim3(NWAVES * 64), LDS_BYTES, stream, a);
}
```

```cpp
#include <hip/hip_runtime.h>
#include <hip/hip_bf16.h>
#include <cstdio>
#include <cstdint>

#define LAS __attribute__((address_space(3)))
#define GAS __attribute__((address_space(1)))
typedef unsigned short bf16_t;
typedef short bf16x8 __attribute__((ext_vector_type(8)));
typedef short s16x4 __attribute__((ext_vector_type(4)));
typedef float f32x4 __attribute__((ext_vector_type(4)));
typedef float f32x2 __attribute__((ext_vector_type(2)));
typedef float f32x16 __attribute__((ext_vector_type(16)));
typedef unsigned u32x4 __attribute__((ext_vector_type(4)));
typedef unsigned u32x2 __attribute__((ext_vector_type(2)));
typedef __bf16 bf16x2_t __attribute__((ext_vector_type(2)));

constexpr int BATCH = 8, SEQ = 8192, DM = 1024, M = BATCH * SEQ;
constexpr int NH = 8, HD = 64, HW = NH * HD;
constexpr int NPROJ = 3 * HW * 2;
constexpr int WIN_LD = NPROJ + NH;
constexpr int NMEM = 256, XH = 4, XD = 256, MEMROWS = BATCH * NMEM;
constexpr int NEXP = 16, DFF = 256;
constexpr float EPS = 1e-6f;
constexpr float LOG2E = 1.4426950408889634f;
constexpr float C2 = 0.125f * LOG2E;
constexpr float XSC = 0.0625f * LOG2E;
constexpr float SB_EXIT = -48.0f;

constexpr size_t MiB = 1u << 20;
constexpr size_t WS_CTL = 0, CTL_ZERO_BYTES = 128 * 1024;
constexpr size_t WS_WIN = 1 * MiB;
constexpr size_t WS_WOUT = 7 * MiB;
constexpr size_t WS_WXQ = 9 * MiB;
constexpr size_t WS_WXKV = 11 * MiB;
constexpr size_t WS_WXO = 15 * MiB;
constexpr size_t WS_WGU = 17 * MiB;
constexpr size_t WS_WD = 33 * MiB;
constexpr size_t WS_RX = 41 * MiB;
constexpr size_t WS_RMEM = WS_RX + 256 * 1024;
constexpr size_t WS_R2 = WS_RX + 512 * 1024;
constexpr size_t WS_LF = 42 * MiB;
constexpr size_t WS_C2 = 44 * MiB;
constexpr size_t WS_SSQ = 46 * MiB;
constexpr size_t WS_TOKSLOT = 50 * MiB;
constexpr size_t WS_TOKW = 51 * MiB;
constexpr size_t WS_LIST = 52 * MiB;
constexpr size_t WS_MEMB = 56 * MiB;
constexpr size_t WS_KVM = 60 * MiB;
constexpr size_t WS_GT = 68 * MiB;
constexpr size_t WS_HT = 84 * MiB;
constexpr size_t WS_KX = 100 * MiB;
constexpr size_t WS_HS = 108 * MiB;
constexpr size_t WS_XB = 128 * MiB;
constexpr size_t WS_QKV = 256 * MiB;
constexpr size_t WS_H1B = 256 * MiB, WS_U2B = 384 * MiB, WS_HID = 512 * MiB;
constexpr size_t WS_O = 640 * MiB;
constexpr size_t WS_Y = 704 * MiB;
constexpr size_t WS_END = 1024 * MiB;
constexpr size_t QKV_STRIDE = (size_t)M * HW;
constexpr int MAXTILES = M * 2 / 256 + NEXP;
static_assert(WS_Y + (size_t)MAXTILES * 256 * 1024 * 2 <= WS_END, "ws map");
static_assert(WS_HID + (size_t)MAXTILES * 256 * 256 * 2 <= WS_O, "ws map");
constexpr int CW_BAR = 4096;
constexpr int CW_SBQ = 20736;
constexpr int CW_KN = 20480;
constexpr int CW_CNT = 16384;

constexpr int RING_OFF = 0, RING_BYTES = 131072;
constexpr int EXTRA_OFF = 131072, EXTRA_BYTES = 16384;
constexpr int MISC_OFF = EXTRA_OFF + EXTRA_BYTES;
constexpr int LDS_BYTES = MISC_OFF + 1024;
constexpr int NWAVES = 8;
#ifndef PHASE_MASK
#define PHASE_MASK 0x7ff
#endif
#define PH(n) ((PHASE_MASK >> (n)) & 1)
#ifndef PROBE_LO
#define PROBE_LO -1
#endif
#ifndef PROBE_HI
#define PROBE_HI -1
#endif
#ifndef FOX_V2
#define FOX_V2 1
#endif
#ifndef REP_MASK
#define REP_MASK 0
#endif
#define REPS(n) (1 + ((REP_MASK >> (n)) & 1))
#ifndef REP_FOX
#define REP_FOX 1
#endif
#ifndef REP_SB
#define REP_SB 1
#endif

__device__ __forceinline__ unsigned cvt_pk_bf16(float lo, float hi) { f32x2 v = {lo, hi}; bf16x2_t b = __builtin_convertvector(v, bf16x2_t); return __builtin_bit_cast(unsigned, b); }
__device__ __forceinline__ float bf16lo(unsigned u) { return __uint_as_float(u << 16); }
__device__ __forceinline__ float bf16hi(unsigned u) { return __uint_as_float(u & 0xffff0000u); }
#define DPP_ADD(v, CTRL) v += __builtin_bit_cast(float, __builtin_amdgcn_update_dpp(0, __builtin_bit_cast(int, v), CTRL, 0xf, 0xf, true))
__device__ __forceinline__ float wave_sum(float v) {
    DPP_ADD(v, 0xB1); DPP_ADD(v, 0x4E); DPP_ADD(v, 0x141); DPP_ADD(v, 0x140);
    const int iv = __builtin_bit_cast(int, v);
    return (__builtin_bit_cast(float, __builtin_amdgcn_readlane(iv, 0)) + __builtin_bit_cast(float, __builtin_amdgcn_readlane(iv, 16))) +
           (__builtin_bit_cast(float, __builtin_amdgcn_readlane(iv, 32)) + __builtin_bit_cast(float, __builtin_amdgcn_readlane(iv, 48)));
}
#define LDS_WAIT() asm volatile("s_waitcnt lgkmcnt(0)" ::: "memory")
#define VM_WAIT() asm volatile("s_waitcnt vmcnt(0)" ::: "memory")

namespace pg8 {
constexpr int BM = 256, BK = 64, HALF = 128, HTB = HALF * BK * 2, STAGE_BYTES = 8 * HTB, NXCD = 8, WGM = 8;
__host__ __device__ __forceinline__ int lds_byte(int r, int c) { const int st = (r >> 4) * 2 + (c >> 5), rr = r & 15, cc = c & 31, ob = rr * 64 + cc * 2; return st * 1024 + (ob ^ (((ob >> 9) & 1) << 5)); }
__host__ __device__ __forceinline__ void stage_rc(int b, int& R, int& C) { const int st = b / 1024, sb = b % 1024, swz = sb ^ (((sb >> 9) & 1) << 5); R = (st >> 1) * 16 + swz / 64; C = (st & 1) * 32 + (swz % 64) / 2; }
__host__ __device__ __forceinline__ int perm32(int rho) { const int n = rho >> 4, i = rho & 15; return 8 * (i >> 2) + 4 * n + (i & 3); }

struct Unit { const char* a; const char* b; int orow, ocol, aux; const int* rows; int nvalid; int seq; };
struct Gemm { int lda, ldb, K; };

__device__ __forceinline__ bool tile_order(int i, int G, int c, int nM, int nN, int& pm, int& pn) {
    const int nwg = nM * nN; const long L = (long)i * G + c; if (L >= nwg) return false;
    int wgid = (int)L; { const int q = nwg / NXCD, r = nwg % NXCD, xcd = wgid % NXCD, off = wgid / NXCD; wgid = (xcd < r ? xcd * (q + 1) : r * (q + 1) + (xcd - r) * q) + off; }
    const int nig = WGM * nN, gid = wgid / nig, fm = gid * WGM, gsz = (nM - fm) < WGM ? (nM - fm) : WGM;
    pm = fm + ((wgid % nig) % gsz); pn = (wgid % nig) / gsz; return true;
}

template <class Epi, class Sched, bool ALIGN_EPI, bool GATHER>
__device__ __forceinline__ void gemm_phase(LAS unsigned char* lds, const Gemm g, const Sched& S, const Epi& E) {
    int tid = threadIdx.x; asm volatile("" : "+v"(tid));
    const int wid = __builtin_amdgcn_readfirstlane(tid >> 6), lane = tid & 63, wr = wid >> 2, wc = wid & 3, fr = lane & 15, fq = lane >> 4;
    const int K = g.K, nt = K / BK;
    unsigned voffA[2], voffB[2]; int RA[2], CA[2];
#pragma unroll
    for (int i = 0; i < 2; ++i) { int R, C; stage_rc(tid * 16 + i * 8192, R, C); const int Rb = (R & ~31) + perm32(R & 31);
        RA[i] = R; CA[i] = C; voffA[i] = (unsigned)(R * g.lda + C) * 2u; voffB[i] = (unsigned)(Rb * g.ldb + C) * 2u; }
    const size_t kstep = (size_t)(BK * 2);
    const size_t hstepA = (size_t)HALF * g.lda * 2, hstepB = (size_t)HALF * g.ldb * 2;
    const unsigned ldsw = (unsigned)wid * 1024u;
    const int aoff = lds_byte(wr * 64 + fr, fq * 8), boff = lds_byte(wc * 32 + fr, fq * 8);
#define PG8_SA(b, h) (((b) * 2 + (h)) * HTB)
#define PG8_SB(b, h) ((4 + (b) * 2 + (h)) * HTB)
#define PG8_STAGE2(bufoff, gbase, v0, v1) do { \
        __builtin_amdgcn_global_load_lds((const unsigned*)((const char*)(gbase) + (v0)), (LAS unsigned*)(lds + (bufoff) + ldsw), 16, 0, 0); \
        __builtin_amdgcn_global_load_lds((const unsigned*)((const char*)(gbase) + (v1)), (LAS unsigned*)(lds + (bufoff) + ldsw + 8192), 16, 0, 0); } while (0)
#define PG8_STAGEB(bufoff, gbase) PG8_STAGE2(bufoff, gbase, voffB[0], voffB[1])
#define PG8_STAGEA(bufoff, kptr, h, NX) do { if constexpr (GATHER) { const unsigned v0_ = (NX) ? gvn[h][0] : gvc[h][0], v1_ = (NX) ? gvn[h][1] : gvc[h][1]; PG8_STAGE2(bufoff, kptr, v0_, v1_); } \
        else { PG8_STAGE2(bufoff, (kptr) + (h) * hstepA, voffA[0], voffA[1]); } } while (0)
#define PG8_LDA(dst, b, h) do { _Pragma("unroll") for (int m = 0; m < 4; ++m) _Pragma("unroll") for (int k = 0; k < 2; ++k) dst[m][k] = *(const LAS bf16x8*)(lds + PG8_SA(b, h) + aoff + m * 2048 + k * 1024); } while (0)
#define PG8_LDB(dst, b, h) do { _Pragma("unroll") for (int n = 0; n < 2; ++n) _Pragma("unroll") for (int k = 0; k < 2; ++k) dst[n][k] = *(const LAS bf16x8*)(lds + PG8_SB(b, h) + boff + n * 2048 + k * 1024); } while (0)
#define PG8_MMA(ai, bj, At, Bt) do { __builtin_amdgcn_s_setprio(1); _Pragma("unroll") for (int m = 0; m < 4; ++m) _Pragma("unroll") for (int n = 0; n < 2; ++n) _Pragma("unroll") for (int k = 0; k < 2; ++k) \
        acc[ai][bj][m][n] = __builtin_amdgcn_mfma_f32_16x16x32_bf16(Bt[n][k], At[m][k], acc[ai][bj][m][n], 0, 0, 0); __builtin_amdgcn_s_setprio(0); } while (0)
#define PG8_WAIT_V(n) asm volatile("s_waitcnt vmcnt(" #n ")" ::: "memory")
#define PG8_WAIT_L(n) asm volatile("s_waitcnt lgkmcnt(" #n ")" ::: "memory")
#define PG8_BAR __builtin_amdgcn_s_barrier()
#define PG8_SCHED __builtin_amdgcn_sched_barrier(0)
#define PG8_GATHER_OFFS(dst, u) do { _Pragma("unroll") for (int h_ = 0; h_ < 2; ++h_) _Pragma("unroll") for (int i_ = 0; i_ < 2; ++i_) { const int r_ = h_ * HALF + RA[i_]; \
        const int idx_ = (u).rows[r_ < (u).nvalid ? r_ : 0]; dst[h_][i_] = (unsigned)(idx_ * g.lda + CA[i_]) * 2u; } } while (0)
    Unit cur, nxt; int ui = 0;
    if (!S.next(0, cur)) return;
    cur.seq = 0;
    unsigned gvc[2][2] = {{0u, 0u}, {0u, 0u}}, gvn[2][2] = {{0u, 0u}, {0u, 0u}};
    if constexpr (GATHER) { PG8_GATHER_OFFS(gvc, cur); }
    f32x4 acc[2][2][4][2];
#pragma unroll
    for (int a = 0; a < 2; ++a)
#pragma unroll
        for (int b = 0; b < 2; ++b)
#pragma unroll
            for (int m = 0; m < 4; ++m)
#pragma unroll
                for (int n = 0; n < 2; ++n) acc[a][b][m][n] = (f32x4){0.f, 0.f, 0.f, 0.f};
    bf16x8 At[4][2], B0[2][2], B1[2][2];
    const char* cA = cur.a; const char* cB = cur.b;
    PG8_STAGEB(PG8_SB(0, 0), cB); PG8_STAGEB(PG8_SB(0, 1), cB + hstepB); PG8_STAGEA(PG8_SA(0, 0), cA, 0, false); PG8_STAGEA(PG8_SA(0, 1), cA, 1, false);
    if (wr == 1) PG8_BAR;
    PG8_WAIT_V(2); PG8_BAR;
    PG8_STAGEB(PG8_SB(1, 0), cB + kstep); PG8_STAGEA(PG8_SA(1, 0), cA + kstep, 0, false); PG8_STAGEB(PG8_SB(1, 1), cB + hstepB + kstep);
    PG8_WAIT_V(6); PG8_BAR;
    for (;;) {
        const bool has_next = S.next(ui + 1, nxt); nxt.seq = ui + 1;
        const char* nA = has_next ? nxt.a : cA; const char* nB = has_next ? nxt.b : cB;
        if constexpr (GATHER) { if (has_next) { PG8_GATHER_OFFS(gvn, nxt); } else { gvn[0][0] = gvc[0][0]; gvn[0][1] = gvc[0][1]; gvn[1][0] = gvc[1][0]; gvn[1][1] = gvc[1][1]; } }
#pragma unroll 1
        for (int t = 0; t < nt; t += 2) {
            const bool last = (t == nt - 2);
            const char* a1 = cA + (size_t)(t + 1) * kstep;
            const char* a2 = last ? nA : cA + (size_t)(t + 2) * kstep; const char* b2 = last ? nB : cB + (size_t)(t + 2) * kstep;
            const char* a3 = a2 + kstep; const char* b3 = b2 + kstep;
            PG8_LDB(B0, 0, 0); PG8_LDB(B1, 0, 1); PG8_SCHED; PG8_LDA(At, 0, 0); PG8_STAGEA(PG8_SA(1, 1), a1, 1, false);
            PG8_WAIT_V(8); PG8_WAIT_L(0); PG8_BAR; PG8_MMA(0, 0, At, B0); PG8_MMA(0, 1, At, B1); PG8_BAR; PG8_SCHED;
            PG8_LDA(At, 0, 1); PG8_STAGEB(PG8_SB(0, 0), b2); PG8_STAGEB(PG8_SB(0, 1), b2 + hstepB); PG8_STAGEA(PG8_SA(0, 0), a2, 0, last);
            PG8_WAIT_V(8); PG8_WAIT_L(0); PG8_BAR; PG8_MMA(1, 0, At, B0); PG8_MMA(1, 1, At, B1); PG8_BAR; PG8_SCHED;
            PG8_LDB(B0, 1, 0); PG8_LDB(B1, 1, 1); PG8_SCHED; PG8_LDA(At, 1, 0); PG8_STAGEA(PG8_SA(0, 1), a2, 1, last);
            PG8_WAIT_V(8); PG8_WAIT_L(0); PG8_BAR; PG8_MMA(0, 0, At, B0); PG8_MMA(0, 1, At, B1); PG8_BAR; PG8_SCHED;
            PG8_LDA(At, 1, 1); PG8_STAGEB(PG8_SB(1, 0), b3); PG8_STAGEB(PG8_SB(1, 1), b3 + hstepB); PG8_STAGEA(PG8_SA(1, 0), a3, 0, last);
            PG8_WAIT_V(8); PG8_WAIT_L(0); PG8_BAR; PG8_MMA(1, 0, At, B0); PG8_MMA(1, 1, At, B1); PG8_BAR; PG8_SCHED;
            if constexpr (Epi::HAS_MID) { if (t == (nt >> 1) - 2) { int fr3 = fr, fq3 = fq; asm volatile("" : "+v"(fr3), "+v"(fq3)); E.mid(acc, cur, wr, wc, fr3, fq3); } }
        }
        if constexpr (ALIGN_EPI) { if (wr == 0) PG8_BAR; }
        { int fr2 = fr, fq2 = fq; asm volatile("" : "+v"(fr2), "+v"(fq2));
          E(acc, cur, wr, wc, fr2, fq2); }
        if (!has_next) break;
#pragma unroll
        for (int a = 0; a < 2; ++a)
#pragma unroll
            for (int b = 0; b < 2; ++b)
#pragma unroll
                for (int m = 0; m < 4; ++m)
#pragma unroll
                    for (int n = 0; n < 2; ++n) acc[a][b][m][n] = (f32x4){0.f, 0.f, 0.f, 0.f};
        cur = nxt; cA = nA; cB = nB; ++ui;
        if constexpr (GATHER) { gvc[0][0] = gvn[0][0]; gvc[0][1] = gvn[0][1]; gvc[1][0] = gvn[1][0]; gvc[1][1] = gvn[1][1]; }
        if constexpr (ALIGN_EPI) { if (wr == 1) PG8_BAR; }
    }
    PG8_WAIT_V(0);
    if constexpr (!ALIGN_EPI) { if (wr == 0) PG8_BAR; }
    PG8_BAR;
#undef PG8_SA
#undef PG8_SB
#undef PG8_STAGE2
#undef PG8_STAGEA
#undef PG8_STAGEB
#undef PG8_LDA
#undef PG8_LDB
#undef PG8_MMA
#undef PG8_WAIT_V
#undef PG8_WAIT_L
#undef PG8_BAR
#undef PG8_SCHED
#undef PG8_GATHER_OFFS
}

#define EPI_ROW(u, ai, m) ((u).orow + (ai) * HALF + wr * 64 + (m) * 16 + fr)
#define EPI_COL(u, bj) ((u).ocol + (bj) * HALF + wc * 32 + 8 * fq)
struct EpiBf16 {
    static constexpr bool HAS_MID = false;
    bf16_t* O; int ldc; const float* rs; size_t stride; float sc0, sc3;
    unsigned* kn;
    const LAS float* rst;
    __device__ __forceinline__ void operator()(const f32x4 (&acc)[2][2][4][2], const Unit& u, int wr, int wc, int fr, int fq) const {
        bf16_t* base = O + (size_t)u.aux * stride;
        const float sc = (u.aux == 0) ? sc0 : ((u.aux == 3) ? sc3 : 1.f);
        float nmax[2] = {0.f, 0.f}; const bool dokn = kn && u.aux == 1;
#pragma unroll
        for (int ai = 0; ai < 2; ++ai)
#pragma unroll
            for (int m = 0; m < 4; ++m) { const int row = EPI_ROW(u, ai, m); const float s = (rst ? rst[u.seq * 256 + ai * HALF + wr * 64 + m * 16 + fr] : (rs ? rs[row] : 1.f)) * sc;
#pragma unroll
                for (int bj = 0; bj < 2; ++bj) { const f32x4 v0 = acc[ai][bj][m][0] * s, v1 = acc[ai][bj][m][1] * s;
                    u32x4 w; w.x = cvt_pk_bf16(v0[0], v0[1]); w.y = cvt_pk_bf16(v0[2], v0[3]); w.z = cvt_pk_bf16(v1[0], v1[1]); w.w = cvt_pk_bf16(v1[2], v1[3]);
                    *(u32x4*)(base + (size_t)row * ldc + EPI_COL(u, bj)) = w;
                    if (dokn) { float q = (v0[0] * v0[0] + v0[1] * v0[1]) + (v0[2] * v0[2] + v0[3] * v0[3]) + (v1[0] * v1[0] + v1[1] * v1[1]) + (v1[2] * v1[2] + v1[3] * v1[3]);
                        q += __shfl_xor(q, 16); q += __shfl_xor(q, 32); nmax[bj] = fmaxf(nmax[bj], q); } } }
        if (dokn) {
#pragma unroll
            for (int bj = 0; bj < 2; ++bj) { float q = nmax[bj]; q = fmaxf(q, __shfl_xor(q, 1)); q = fmaxf(q, __shfl_xor(q, 2)); q = fmaxf(q, __shfl_xor(q, 4)); q = fmaxf(q, __shfl_xor(q, 8));
                const int head = ((u.ocol + bj * HALF) >> 6) + (wc >> 1), bt = u.orow / SEQ;
                if ((fr | fq) == 0) atomicMax(kn + ((bt * NH + head) * 2 + (wc & 1)), __float_as_uint(q)); }
        }
    }
};
struct EpiResid {
    static constexpr bool HAS_MID = false;
    const float* res; float* out; bf16_t* hb; float* ssq;
    __device__ __forceinline__ void operator()(const f32x4 (&acc)[2][2][4][2], const Unit& u, int wr, int wc, int fr, int fq) const {
#pragma unroll
        for (int ai = 0; ai < 2; ++ai)
#pragma unroll
            for (int m = 0; m < 4; ++m) { const int row = EPI_ROW(u, ai, m); float q = 0.f;
#pragma unroll
                for (int bj = 0; bj < 2; ++bj) { const size_t off = (size_t)row * DM + EPI_COL(u, bj);
                    const f32x4 r0 = *(const f32x4*)(res + off), r1 = *(const f32x4*)(res + off + 4);
                    const f32x4 v0 = acc[ai][bj][m][0] + r0, v1 = acc[ai][bj][m][1] + r1;
                    *(f32x4*)(out + off) = v0; *(f32x4*)(out + off + 4) = v1;
                    q += (v0[0] * v0[0] + v0[1] * v0[1]) + (v0[2] * v0[2] + v0[3] * v0[3]) + (v1[0] * v1[0] + v1[1] * v1[1]) + (v1[2] * v1[2] + v1[3] * v1[3]);
                    if (hb) { u32x4 w; w.x = cvt_pk_bf16(v0[0], v0[1]); w.y = cvt_pk_bf16(v0[2], v0[3]); w.z = cvt_pk_bf16(v1[0], v1[1]); w.w = cvt_pk_bf16(v1[2], v1[3]); *(u32x4*)(hb + off) = w; } }
                if (ssq) { q += __shfl_xor(q, 16); q += __shfl_xor(q, 32); if (fq == 0) ssq[(size_t)row * 16 + (u.ocol >> 8) * 4 + wc] = q; } }
    }
};
struct EpiOutProj {
    static constexpr bool HAS_MID = true;
    const bf16_t* xb; bf16_t* hb; float* ssq; const LAS f32x2* rab;
    __device__ __forceinline__ void mid(f32x4 (&acc)[2][2][4][2], const Unit& u, int wr, int wc, int fr, int fq) const {
#pragma unroll
        for (int ai = 0; ai < 2; ++ai)
#pragma unroll
            for (int m = 0; m < 4; ++m) { const float f = rab[u.seq * 256 + ai * HALF + wr * 64 + m * 16 + fr].x;
#pragma unroll
                for (int bj = 0; bj < 2; ++bj) { acc[ai][bj][m][0] *= f; acc[ai][bj][m][1] *= f; } }
    }
    __device__ __forceinline__ void operator()(const f32x4 (&acc)[2][2][4][2], const Unit& u, int wr, int wc, int fr, int fq) const {
#pragma unroll
        for (int ai = 0; ai < 2; ++ai)
#pragma unroll
            for (int m = 0; m < 4; ++m) { const int row = EPI_ROW(u, ai, m); const float rb = rab[u.seq * 256 + ai * HALF + wr * 64 + m * 16 + fr].y; float q = 0.f;
#pragma unroll
                for (int bj = 0; bj < 2; ++bj) { const size_t off = (size_t)row * DM + EPI_COL(u, bj);
                    const u32x4 xr = *(const u32x4*)(xb + off);
                    f32x4 v0 = acc[ai][bj][m][0] * rb, v1 = acc[ai][bj][m][1] * rb;
                    v0[0] += bf16lo(xr.x); v0[1] += bf16hi(xr.x); v0[2] += bf16lo(xr.y); v0[3] += bf16hi(xr.y); v1[0] += bf16lo(xr.z); v1[1] += bf16hi(xr.z); v1[2] += bf16lo(xr.w); v1[3] += bf16hi(xr.w);
                    q += (v0[0] * v0[0] + v0[1] * v0[1]) + (v0[2] * v0[2] + v0[3] * v0[3]) + (v1[0] * v1[0] + v1[1] * v1[1]) + (v1[2] * v1[2] + v1[3] * v1[3]);
                    u32x4 w; w.x = cvt_pk_bf16(v0[0], v0[1]); w.y = cvt_pk_bf16(v0[2], v0[3]); w.z = cvt_pk_bf16(v1[0], v1[1]); w.w = cvt_pk_bf16(v1[2], v1[3]); *(u32x4*)(hb + off) = w; }
                q += __shfl_xor(q, 16); q += __shfl_xor(q, 32); if (fq == 0) ssq[(size_t)row * 16 + (u.ocol >> 8) * 4 + wc] = q; }
    }
};
struct EpiResidBf16 {
    static constexpr bool HAS_MID = false;
    bf16_t* hb;
    __device__ __forceinline__ void operator()(const f32x4 (&acc)[2][2][4][2], const Unit& u, int wr, int wc, int fr, int fq) const {
#pragma unroll
        for (int ai = 0; ai < 2; ++ai)
#pragma unroll
            for (int m = 0; m < 4; ++m) { const int row = EPI_ROW(u, ai, m);
#pragma unroll
                for (int bj = 0; bj < 2; ++bj) { const size_t off = (size_t)row * DM + EPI_COL(u, bj);
                    const u32x4 xr = *(const u32x4*)(hb + off);
                    f32x4 v0 = acc[ai][bj][m][0], v1 = acc[ai][bj][m][1];
                    v0[0] += bf16lo(xr.x); v0[1] += bf16hi(xr.x); v0[2] += bf16lo(xr.y); v0[3] += bf16hi(xr.y); v1[0] += bf16lo(xr.z); v1[1] += bf16hi(xr.z); v1[2] += bf16lo(xr.w); v1[3] += bf16hi(xr.w);
                    u32x4 w; w.x = cvt_pk_bf16(v0[0], v0[1]); w.y = cvt_pk_bf16(v0[2], v0[3]); w.z = cvt_pk_bf16(v1[0], v1[1]); w.w = cvt_pk_bf16(v1[2], v1[3]); *(u32x4*)(hb + off) = w; } }
    }
};
struct EpiSoftmax {
    static constexpr bool HAS_MID = false;
    bf16_t* P; const LAS float* r1t; LAS float* red;
    __device__ __forceinline__ void operator()(f32x4 (&acc)[2][2][4][2], const Unit& u, int wr, int wc, int fr, int fq) const {
#pragma unroll
        for (int ai = 0; ai < 2; ++ai)
#pragma unroll
            for (int m = 0; m < 4; ++m) { const float r1 = r1t[u.seq * 256 + ai * HALF + wr * 64 + m * 16 + fr]; float a = -3.0e38f;
#pragma unroll
                for (int bj = 0; bj < 2; ++bj)
#pragma unroll
                    for (int n = 0; n < 2; ++n) { f32x4 v = acc[ai][bj][m][n] * r1; acc[ai][bj][m][n] = v; a = fmaxf(a, fmaxf(fmaxf(v[0], v[1]), fmaxf(v[2], v[3]))); }
                a = fmaxf(a, __shfl_xor(a, 16)); a = fmaxf(a, __shfl_xor(a, 32));
                if (fq == 0) red[(ai * HALF + wr * 64 + m * 16 + fr) * 4 + wc] = a; asm volatile("" ::: "memory"); }
        LDS_WAIT(); __builtin_amdgcn_s_barrier(); asm volatile("" ::: "memory");
#pragma unroll
        for (int ai = 0; ai < 2; ++ai)
#pragma unroll
            for (int m = 0; m < 4; ++m) { const int rl = ai * HALF + wr * 64 + m * 16 + fr; const f32x4 mm = *(const LAS f32x4*)(red + rl * 4);
                const float a = fmaxf(fmaxf(mm[0], mm[1]), fmaxf(mm[2], mm[3])); float s = 0.f;
#pragma unroll
                for (int bj = 0; bj < 2; ++bj)
#pragma unroll
                    for (int n = 0; n < 2; ++n) { f32x4 v = acc[ai][bj][m][n];
                        v[0] = __builtin_amdgcn_exp2f(v[0] - a); v[1] = __builtin_amdgcn_exp2f(v[1] - a); v[2] = __builtin_amdgcn_exp2f(v[2] - a); v[3] = __builtin_amdgcn_exp2f(v[3] - a);
                        acc[ai][bj][m][n] = v; s += (v[0] + v[1]) + (v[2] + v[3]); }
                s += __shfl_xor(s, 16); s += __shfl_xor(s, 32);
                if (fq == 0) red[1024 + rl * 4 + wc] = s; }
        LDS_WAIT(); __builtin_amdgcn_s_barrier(); asm volatile("" ::: "memory");
#pragma unroll
        for (int ai = 0; ai < 2; ++ai)
#pragma unroll
            for (int m = 0; m < 4; ++m) { const int rl = ai * HALF + wr * 64 + m * 16 + fr; const int row = u.orow + rl; const f32x4 ss = *(const LAS f32x4*)(red + 1024 + rl * 4);
                const float inv = 1.0f / ((ss[0] + ss[1]) + (ss[2] + ss[3]));
#pragma unroll
                for (int bj = 0; bj < 2; ++bj) { const f32x4 v0 = acc[ai][bj][m][0] * inv, v1 = acc[ai][bj][m][1] * inv;
                    u32x4 w; w.x = cvt_pk_bf16(v0[0], v0[1]); w.y = cvt_pk_bf16(v0[2], v0[3]); w.z = cvt_pk_bf16(v1[0], v1[1]); w.w = cvt_pk_bf16(v1[2], v1[3]);
                    *(u32x4*)(P + (size_t)row * DM + EPI_COL(u, bj)) = w; } }
    }
};
struct EpiSwiglu {
    static constexpr bool HAS_MID = false;
    bf16_t* Hd; const float* r2s; const int* listbase;
    __device__ __forceinline__ void operator()(const f32x4 (&acc)[2][2][4][2], const Unit& u, int wr, int wc, int fr, int fq) const {
#pragma unroll
        for (int ai = 0; ai < 2; ++ai)
#pragma unroll
            for (int m = 0; m < 4; ++m) { const int rl = ai * HALF + wr * 64 + m * 16 + fr, row = u.orow + rl; const float rs = r2s[(u.rows - listbase) + (rl < u.nvalid ? rl : 0)]; float h[8];
#pragma unroll
                for (int n = 0; n < 2; ++n)
#pragma unroll
                    for (int e = 0; e < 4; ++e) { const float gt = acc[ai][0][m][n][e] * rs, up = acc[ai][1][m][n][e] * rs;
                        h[n * 4 + e] = gt * __builtin_amdgcn_rcpf(1.0f + __builtin_amdgcn_exp2f(-gt * LOG2E)) * up; }
                u32x4 w; w.x = cvt_pk_bf16(h[0], h[1]); w.y = cvt_pk_bf16(h[2], h[3]); w.z = cvt_pk_bf16(h[4], h[5]); w.w = cvt_pk_bf16(h[6], h[7]);
                *(u32x4*)(Hd + (size_t)row * DFF + u.ocol + wc * 32 + 8 * fq) = w; }
    }
};
}

namespace att {
constexpr int QB = 256, KVBLK = 64, PITCH = HW, OPITCH = DM;
constexpr int SLOTB = 8192, LDS_K = 0, LDS_V = 2 * SLOTB, LDS_WS = 4 * SLOTB, LDS_OST = LDS_WS + NWAVES * 256, LDS_FLAG = LDS_OST + NWAVES * 4096, LDS_END = LDS_FLAG + 64;
static_assert(LDS_END <= RING_BYTES, "attention LDS");
__device__ __forceinline__ int crow(int r, int hi) { return (r & 3) + 8 * (r >> 2) + 4 * hi; }
__device__ __forceinline__ void glds16(const void* gsrc, unsigned lds_dst) { unsigned keep;
    asm volatile("s_mov_b32 %0, m0\n\ts_mov_b32 m0, %2\n\ts_nop 0\n\tglobal_load_lds_dwordx4 %1, off\n\ts_mov_b32 m0, %0" : "=&s"(keep) : "v"(gsrc), "s"(lds_dst) : "memory"); }
__device__ __forceinline__ void glds16s(const void* sbase, unsigned voff, unsigned lds_dst) { unsigned keep;
    asm volatile("s_mov_b32 %0, m0\n\ts_mov_b32 m0, %3\n\ts_nop 0\n\tglobal_load_lds_dwordx4 %1, %2\n\ts_mov_b32 m0, %0" : "=&s"(keep) : "v"(voff), "s"(sbase), "s"(lds_dst) : "memory"); }
#define ATT_WAIT_BAR0() asm volatile("s_waitcnt vmcnt(0) lgkmcnt(0)\n\ts_barrier" ::: "memory")
#define MFMA32(a, b, c) __builtin_amdgcn_mfma_f32_32x32x16_bf16(a, b, c, 0, 0, 0)
__device__ __forceinline__ void store_row_ssq(u32x4 v, float* dst, int ch) {
    float q = (bf16lo(v.x) * bf16lo(v.x) + bf16hi(v.x) * bf16hi(v.x)) + (bf16lo(v.y) * bf16lo(v.y) + bf16hi(v.y) * bf16hi(v.y)) + (bf16lo(v.z) * bf16lo(v.z) + bf16hi(v.z) * bf16hi(v.z)) + (bf16lo(v.w) * bf16lo(v.w) + bf16hi(v.w) * bf16hi(v.w));
    q += __shfl_xor(q, 1); q += __shfl_xor(q, 2); q += __shfl_xor(q, 4);
    if (ch == 0) *dst = q;
}
__device__ __forceinline__ void qkt(f32x16& p0, f32x16& p1, const LAS char* Kslot, const bf16x8* qr, const f32x16& cin, int r32, int hi) {
    const LAS char* kb = Kslot + hi * 1024 + r32 * 16;
#pragma unroll
    for (int d0 = 0; d0 < 4; ++d0) {
        const bf16x8 b0 = *(const LAS bf16x8*)(kb + d0 * 2048);
        const bf16x8 b1 = *(const LAS bf16x8*)(kb + d0 * 2048 + 512);
        if (d0 == 0) { p0 = MFMA32(b0, qr[0], cin); p1 = MFMA32(b1, qr[0], cin); }
        else { p0 = MFMA32(b0, qr[d0], p0); p1 = MFMA32(b1, qr[d0], p1); } }
}
__device__ __forceinline__ void pv(f32x16* o, int vb, bf16x8 pa0, bf16x8 pa1, bf16x8 pa2, bf16x8 pa3) {
#pragma unroll
    for (int d0 = 0; d0 < 2; ++d0) { s16x4 lo[4], hi[4];
#pragma unroll
        for (int ks = 0; ks < 4; ++ks) {
            asm volatile("ds_read_b64_tr_b16 %0,%1 offset:%c2" : "=&v"(lo[ks]) : "v"(vb), "i"(d0 * 4096 + ks * 1024) : "memory");
            asm volatile("ds_read_b64_tr_b16 %0,%1 offset:%c2" : "=&v"(hi[ks]) : "v"(vb), "i"(d0 * 4096 + ks * 1024 + 512) : "memory"); }
        asm volatile("s_waitcnt lgkmcnt(0)" ::: "memory"); __builtin_amdgcn_sched_barrier(0);
#define PK(k) (bf16x8){lo[k][0], lo[k][1], lo[k][2], lo[k][3], hi[k][0], hi[k][1], hi[k][2], hi[k][3]}
        o[d0] = MFMA32(pa0, PK(0), o[d0]); o[d0] = MFMA32(pa1, PK(1), o[d0]); o[d0] = MFMA32(pa2, PK(2), o[d0]); o[d0] = MFMA32(pa3, PK(3), o[d0]);
#undef PK
    }
}
__device__ __forceinline__ float swap_lo(float x) { auto rr = __builtin_amdgcn_permlane32_swap(__float_as_uint(x), __float_as_uint(x), false, false); return __uint_as_float(rr[0]); }
__device__ __forceinline__ float swap_hi(float x) { auto rr = __builtin_amdgcn_permlane32_swap(__float_as_uint(x), __float_as_uint(x), false, false); return __uint_as_float(rr[1]); }

template <int MODE> __device__ __forceinline__ void attn_unit(int b, int h, int qb, const bf16_t* Q, const bf16_t* K, const bf16_t* V, bf16_t* O, float* hs, const float* cb, LAS char* shm) {
    int tid = threadIdx.x; asm volatile("" : "+v"(tid)); const int lane = tid & 63, r32 = lane & 31, hi = lane >> 5; const int wid = __builtin_amdgcn_readfirstlane(tid >> 6);
    const long rowbase = (long)b * SEQ; const int q0 = qb * QB;
    const bf16_t* Qw = Q + (rowbase + q0 + wid * 32) * PITCH + h * HD;
    const bf16_t* Kh = K + rowbase * PITCH + h * HD; const bf16_t* Vh = V + rowbase * PITCH + h * HD;
    const unsigned lds0 = (unsigned)(uintptr_t)shm;
    LAS float* wsf = (LAS float*)(shm + LDS_WS) + wid * 64;
    LAS unsigned* flags = (LAS unsigned*)(shm + LDS_FLAG);
    const bf16_t* ksrc = Kh + (long)lane * PITCH + wid * 8;
    const bf16_t* vsrc = Vh + (long)(16 * (wid & 3) + (lane >> 2)) * PITCH + (wid >> 2) * 32 + (lane & 3) * 8;
    const unsigned kdst = lds0 + LDS_K + wid * 1024, vdst = lds0 + LDS_V + wid * 1024;
#define DMA_KV(t, slot) do { glds16(ksrc + (long)(t) * KVBLK * PITCH, (unsigned)__builtin_amdgcn_readfirstlane(kdst + (slot))); glds16(vsrc + (long)(t) * KVBLK * PITCH, (unsigned)__builtin_amdgcn_readfirstlane(vdst + (slot))); } while (0)
    const int vb0 = (int)(lds0 + LDS_V) + ((lane >> 4) & 1) * 32 + (lane & 3) * 8 + (4 * hi + ((lane & 15) >> 2)) * 64;
    const int NT = (q0 + QB) / KVBLK;
    DMA_KV(NT - 1, 0);
    bf16x8 qr[4];
#pragma unroll
    for (int d0 = 0; d0 < 4; ++d0) qr[d0] = *(const bf16x8*)(Qw + (long)r32 * PITCH + d0 * 16 + hi * 8);
    f32x16 o[2]; o[0] = f32x16{}; o[1] = f32x16{};
    const int qrel = wid * 32 + r32;
    float m_run = -1.0e30f, l_run = 0.f, R = 0.f, ct = 0.f;
    if (MODE == 0) ct = cb[q0 + qrel];
    bf16x8 TD0, TD1, TONE;
#pragma unroll
    for (int j = 0; j < 8; ++j) { const int kvl = 8 * (j >> 2) + 4 * hi + (j & 3); TD0[j] = (kvl >= r32) ? (short)0x3F80 : (short)0; TD1[j] = (16 + kvl >= r32) ? (short)0x3F80 : (short)0; TONE[j] = (short)0x3F80; }
    f32x16 zero16 = f32x16{};
    for (int i = 0; i < NT; ++i) {
        const int t = NT - 1 - i, slot = (i & 1) * SLOTB;
        ATT_WAIT_BAR0();
        if (MODE == 1 && i > 0) {
            const LAS unsigned* fl = flags + ((i - 1) & 1) * 8; unsigned all = 1u;
#pragma unroll
            for (int w = 0; w < 8; ++w) all &= fl[w];
            if (__builtin_amdgcn_readfirstlane(all)) break;
        }
        if (t > 0) DMA_KV(t - 1, slot ^ SLOTB);
        const int jb = t - (NT - 4);
        const bool active = !(jb >= 0 && 2 * jb > wid);
        bool wave_done = false;
        if (MODE == 1) wave_done = __all(R < SB_EXIT);
        if (active && !(MODE == 1 && wave_done)) {
            f32x16 p0, p1;
            qkt(p0, p1, shm + LDS_K + slot, qr, zero16, r32, hi);
            if (MODE == 0) {
                const float* cbt = cb + t * KVBLK + 4 * hi;
#pragma unroll
                for (int g = 0; g < 4; ++g) { const f32x4 c0 = *(const f32x4*)(cbt + 8 * g), c1 = *(const f32x4*)(cbt + 32 + 8 * g);
#pragma unroll
                    for (int e = 0; e < 4; ++e) { p0[4 * g + e] += ct - c0[e]; p1[4 * g + e] += ct - c1[e]; } }
                if (jb >= 0) {
#pragma unroll
                    for (int r = 0; r < 16; ++r) { const int kv = 64 * jb + crow(r, hi); if (kv > qrel) p0[r] = -1.0e30f; if (kv + 32 > qrel) p1[r] = -1.0e30f; } }
                float a = fmaxf(p0[0], p1[0]);
#pragma unroll
                for (int r = 1; r < 16; ++r) a = fmaxf(a, fmaxf(p0[r], p1[r]));
                a = fmaxf(swap_lo(a), swap_hi(a));
                const float m_new = fmaxf(m_run, a), alpha = __builtin_amdgcn_exp2f(m_run - m_new); m_run = m_new;
                float s = 0.f;
#pragma unroll
                for (int r = 0; r < 16; ++r) { p0[r] = __builtin_amdgcn_exp2f(p0[r] - m_new); p1[r] = __builtin_amdgcn_exp2f(p1[r] - m_new); s += p0[r] + p1[r]; }
                l_run = l_run * alpha + s;
                if (hi == 0) wsf[r32] = alpha;
                LDS_WAIT();
#pragma unroll
                for (int r = 0; r < 16; ++r) { const float f = wsf[crow(r, hi)]; o[0][r] *= f; o[1][r] *= f; }
                LDS_WAIT();
            } else {
                if (jb >= 0) {
#pragma unroll
                    for (int r = 0; r < 16; ++r) { const int kv = 64 * jb + crow(r, hi); if (kv >= qrel) p0[r] = -1.0e30f; if (kv + 32 >= qrel) p1[r] = -1.0e30f; } }
                f32x16 l0, l1;
#pragma unroll
                for (int r = 0; r < 16; ++r) {
                    l0[r] = -(fmaxf(p0[r], 0.f) + __builtin_amdgcn_logf(1.0f + __builtin_amdgcn_exp2f(-fabsf(p0[r]))));
                    l1[r] = -(fmaxf(p1[r], 0.f) + __builtin_amdgcn_logf(1.0f + __builtin_amdgcn_exp2f(-fabsf(p1[r])))); }
                u32x4 lw0 = {cvt_pk_bf16(l0[0], l0[1]), cvt_pk_bf16(l0[2], l0[3]), cvt_pk_bf16(l0[4], l0[5]), cvt_pk_bf16(l0[6], l0[7])};
                u32x4 lw1 = {cvt_pk_bf16(l0[8], l0[9]), cvt_pk_bf16(l0[10], l0[11]), cvt_pk_bf16(l0[12], l0[13]), cvt_pk_bf16(l0[14], l0[15])};
                u32x4 lw2 = {cvt_pk_bf16(l1[0], l1[1]), cvt_pk_bf16(l1[2], l1[3]), cvt_pk_bf16(l1[4], l1[5]), cvt_pk_bf16(l1[6], l1[7])};
                u32x4 lw3 = {cvt_pk_bf16(l1[8], l1[9]), cvt_pk_bf16(l1[10], l1[11]), cvt_pk_bf16(l1[12], l1[13]), cvt_pk_bf16(l1[14], l1[15])};
                f32x16 rt;
#pragma unroll
                for (int r = 0; r < 16; ++r) rt[r] = R;
                f32x16 t0 = MFMA32(TD0, __builtin_bit_cast(bf16x8, lw0), rt); t0 = MFMA32(TD1, __builtin_bit_cast(bf16x8, lw1), t0);
                t0 = MFMA32(TONE, __builtin_bit_cast(bf16x8, lw2), t0); t0 = MFMA32(TONE, __builtin_bit_cast(bf16x8, lw3), t0);
                f32x16 t1 = MFMA32(TD0, __builtin_bit_cast(bf16x8, lw2), rt); t1 = MFMA32(TD1, __builtin_bit_cast(bf16x8, lw3), t1);
#pragma unroll
                for (int r = 0; r < 16; ++r) { p0[r] = __builtin_amdgcn_exp2f(p0[r] + t0[r]); p1[r] = __builtin_amdgcn_exp2f(p1[r] + t1[r]); }
                R = swap_lo(t0[0]);
            }
            u32x4 pw0 = {cvt_pk_bf16(p0[0], p0[1]), cvt_pk_bf16(p0[2], p0[3]), cvt_pk_bf16(p0[4], p0[5]), cvt_pk_bf16(p0[6], p0[7])};
            u32x4 pw1 = {cvt_pk_bf16(p0[8], p0[9]), cvt_pk_bf16(p0[10], p0[11]), cvt_pk_bf16(p0[12], p0[13]), cvt_pk_bf16(p0[14], p0[15])};
            u32x4 pw2 = {cvt_pk_bf16(p1[0], p1[1]), cvt_pk_bf16(p1[2], p1[3]), cvt_pk_bf16(p1[4], p1[5]), cvt_pk_bf16(p1[6], p1[7])};
            u32x4 pw3 = {cvt_pk_bf16(p1[8], p1[9]), cvt_pk_bf16(p1[10], p1[11]), cvt_pk_bf16(p1[12], p1[13]), cvt_pk_bf16(p1[14], p1[15])};
            pv(o, vb0 + slot, __builtin_bit_cast(bf16x8, pw0), __builtin_bit_cast(bf16x8, pw1), __builtin_bit_cast(bf16x8, pw2), __builtin_bit_cast(bf16x8, pw3));
        }
        if (MODE == 1) { const bool dn = __all(R < SB_EXIT); if (lane == 0) flags[(i & 1) * 8 + wid] = dn ? 1u : 0u; }
    }
    float linv = 1.f;
    if (MODE == 0) { const float lt = swap_lo(l_run) + swap_hi(l_run); linv = 1.0f / lt; }
    if (hi == 0) wsf[32 + r32] = linv;
    LDS_WAIT();
    bf16_t* Ow = O + (rowbase + q0 + wid * 32) * OPITCH + h * HD;
    { LAS bf16_t* stg = (LAS bf16_t*)(shm + LDS_OST) + wid * 2048;
#pragma unroll
      for (int r = 0; r < 16; ++r) { const int orow = crow(r, hi); const float f = wsf[32 + orow];
#pragma unroll
        for (int d0 = 0; d0 < 2; ++d0) { const unsigned pk = cvt_pk_bf16(o[d0][r] * f, 0.f); stg[orow * 64 + d0 * 32 + r32] = (bf16_t)(pk & 0xffffu); } }
      LDS_WAIT();
#pragma unroll
      for (int i = 0; i < 4; ++i) { const int row = i * 8 + (lane >> 3), ch = lane & 7; const u32x4 v = *(const LAS u32x4*)(stg + row * 64 + ch * 8); *(u32x4*)(Ow + (long)row * OPITCH + ch * 8) = v;
        store_row_ssq(v, hs + (rowbase + q0 + wid * 32 + row) * 16, ch); } }
    asm volatile("s_waitcnt vmcnt(0) lgkmcnt(0)\n\ts_barrier" ::: "memory");
#undef DMA_KV
}
}


namespace fox {
constexpr int QB = 256, KVBLK = 64, PITCH = HW, OPITCH = DM;
constexpr int NSLOT = 3, SLOTB = 9216;
constexpr int LDS_K = 0, LDS_V = NSLOT * SLOTB, LDS_WS = 2 * NSLOT * SLOTB, LDS_OST = LDS_WS + NWAVES * 256, LDS_CL = LDS_OST + NWAVES * 4096, LDS_VOTE = LDS_CL + 512, LDS_END = LDS_VOTE + 32;
static_assert(LDS_END <= RING_BYTES, "fox LDS");
constexpr float WIN_T = 48.0f;
constexpr float FLOOR = -256.0f;
using att::crow; using att::glds16; using att::glds16s;
typedef __attribute__((address_space(3))) const char* lds_cptr;
typedef short v4i16_t __attribute__((ext_vector_type(4)));
#define SBAR() __builtin_amdgcn_sched_barrier(0)
#define WAIT_BAR(N) asm volatile("s_waitcnt vmcnt(" #N ") lgkmcnt(0)\n\ts_barrier" ::: "memory")
__device__ __forceinline__ s16x4 vtr(lds_cptr p) { return __builtin_bit_cast(s16x4, __builtin_amdgcn_ds_read_tr16_b64_v4i16((__attribute__((address_space(3))) v4i16_t*)p)); }
__device__ __forceinline__ void kload2(bf16x8* kf, lds_cptr kp, int j) { kf[2 * j] = *(const LAS bf16x8*)(kp + j * 2048); kf[2 * j + 1] = *(const LAS bf16x8*)(kp + j * 2048 + 512); }
__device__ __forceinline__ void cmask(f32x16& p0, f32x16& p1, int jb, int qrel, int hi) {
    const float NEG = -INFINITY; const int kb = 64 * jb + 4 * hi;
#pragma unroll
    for (int r = 0; r < 16; ++r) { const int kv = kb + (r & 3) + 8 * (r >> 2); if (kv > qrel) p0[r] = NEG; if (kv + 32 > qrel) p1[r] = NEG; }
}
__device__ __forceinline__ void split3(float x, unsigned& hm, unsigned& lo) {
    const unsigned h = cvt_pk_bf16(x, 0.f) & 0xffffu; const float r1 = x - __uint_as_float(h << 16);
    const unsigned m = cvt_pk_bf16(r1, 0.f) & 0xffffu; const float r2 = r1 - __uint_as_float(m << 16);
    hm = h | (m << 16); lo = cvt_pk_bf16(r2, 0.f) & 0xffffu;
}
__device__ __forceinline__ bf16x8 qx_build(float a, int hi) {
    unsigned hm, lo; split3(a, hm, lo);
    u32x4 w; w.x = hm; w.y = lo | 0x3F800000u; w.z = 0x3F803F80u; w.w = 0u;
    if (hi) { w.x = 0u; w.y = 0u; w.z = 0u; }
    return __builtin_bit_cast(bf16x8, w);
}

template <int THRL> __device__ __forceinline__ void fox_unit(int bh, int qb, const bf16_t* Q, const bf16_t* K, const bf16_t* V, bf16_t* O, float* hs, const float* cb, const bf16_t* KXh, float kmax, LAS char* shm) {
    int tid = threadIdx.x; asm volatile("" : "+v"(tid)); const int lane = tid & 63, r32 = lane & 31, hi = lane >> 5; const int wid = __builtin_amdgcn_readfirstlane(tid >> 6);
    const int b = bh >> 3, h = bh & 7; const long rowbase = (long)b * SEQ; const int q0 = qb * QB;
    const bf16_t* Qw = Q + (rowbase + q0 + wid * 32) * PITCH + h * HD;
    const bf16_t* Kh = K + rowbase * PITCH + h * HD; const bf16_t* Vh = V + rowbase * PITCH + h * HD;
    const unsigned lds0 = (unsigned)(uintptr_t)shm;
    LAS float* wsf = (LAS float*)(shm + LDS_WS) + wid * 64;
    const int NT = (q0 + QB) / KVBLK;
    int NTe = NT;
    LAS float* clt = (LAS float*)(shm + LDS_CL); LAS unsigned* votes = (LAS unsigned*)(shm + LDS_VOTE);
    const float clv = (tid < NT) ? cb[64 * tid + 63] : 0.f;
    const unsigned koff = (unsigned)(lane * PITCH + wid * 8) * 2u, voff = (unsigned)((16 * (wid & 3) + (lane >> 2)) * PITCH + (wid >> 2) * 32 + (lane & 3) * 8) * 2u, xoff = (unsigned)lane * 16u;
    const unsigned kdst = lds0 + LDS_K + wid * 1024, vdst = lds0 + LDS_V + wid * 1024, xdst = lds0 + LDS_K + 8192;
    const bool xl = (lane >> 3) == wid;
#define DMA_K(p, slot) do { glds16s(Kh + (long)(NT - 1 - (p)) * KVBLK * PITCH, koff, (unsigned)__builtin_amdgcn_readfirstlane(kdst + (slot))); \
        if (xl) glds16s(KXh + (long)(NT - 1 - (p)) * KVBLK * 8, xoff, (unsigned)__builtin_amdgcn_readfirstlane(xdst + (slot))); } while (0)
#define DMA_V(p, slot) glds16s(Vh + (long)(NT - 1 - (p)) * KVBLK * PITCH, voff, (unsigned)__builtin_amdgcn_readfirstlane(vdst + (slot)))
    bf16x8 kf[10];
    const lds_cptr shm3 = (lds_cptr)shm; const lds_cptr kp0 = shm3 + LDS_K + hi * 1024 + r32 * 16; const lds_cptr kx0 = shm3 + LDS_K + 8192 + r32 * 16;
    const lds_cptr vp0 = shm3 + LDS_V + ((lane >> 4) & 1) * 32 + (lane & 3) * 8 + (4 * hi + ((lane & 15) >> 2)) * 64;
    DMA_K(0, 0); DMA_V(0, 0); DMA_K(1, SLOTB);
    bf16x8 qr[4];
#pragma unroll
    for (int d0 = 0; d0 < 4; ++d0) qr[d0] = *(const bf16x8*)(Qw + (long)r32 * PITCH + d0 * 16 + hi * 8);
    const int qrel = wid * 32 + r32;
    const float ct = cb[q0 + qrel];
    float mhat = 0.f, l_reg = 0.f; f32x16 o[2]; o[0] = f32x16{}; o[1] = f32x16{};
    bf16x8 qx = qx_build(ct, hi);
    const f32x16 z16 = f32x16{};
#define CMASK(P0, P1, p) do { const int jb_ = 3 - (p); if (jb_ >= 0) cmask(P0, P1, jb_, qrel, hi); } while (0)
    bool resc = false;
#define RESC() do { if (resc) { asm volatile("s_waitcnt lgkmcnt(0)" ::: "memory"); \
      _Pragma("unroll") for (int d_ = 0; d_ < 2; ++d_) _Pragma("unroll") for (int r = 0; r < 16; ++r) o[d_][r] *= wsf[crow(r, hi)]; } } while (0)
    f32x16 pA0, pA1, pB0, pB1;
    int sl_prev = 0, sl_cur = 0, sl_next = SLOTB;
#define ROT() do { sl_prev = sl_cur; sl_cur = sl_next; sl_next = (sl_next == (NSLOT - 1) * SLOTB) ? 0 : sl_next + SLOTB; } while (0)
    DMA_K(2, 2 * SLOTB);
    WAIT_BAR(5);
    if (tid < NT) clt[tid] = clv;
    float qkb;
    { float q2 = 0.f;
#pragma unroll
      for (int d0 = 0; d0 < 4; ++d0)
#pragma unroll
          for (int j = 0; j < 8; ++j) { const float e = __uint_as_float(((unsigned)(unsigned short)qr[d0][j]) << 16); q2 += e * e; }
      q2 = att::swap_lo(q2) + att::swap_hi(q2); qkb = sqrtf(q2) * kmax + ct + WIN_T; }
    { const LAS char* kb = (const LAS char*)shm + LDS_K + hi * 1024 + r32 * 16; const LAS char* kxb = (const LAS char*)shm + LDS_K + 8192 + r32 * 16;
      pA0 = MFMA32(*(const LAS bf16x8*)(kxb), qx, z16); pA1 = MFMA32(*(const LAS bf16x8*)(kxb + 512), qx, z16);
#pragma unroll
      for (int d0 = 0; d0 < 4; ++d0) { pA0 = MFMA32(*(const LAS bf16x8*)(kb + d0 * 2048), qr[d0], pA0); pA1 = MFMA32(*(const LAS bf16x8*)(kb + d0 * 2048 + 512), qr[d0], pA1); } }
    asm volatile("s_nop 15\n\ts_nop 7" : "+v"(pA0), "+v"(pA1)); CMASK(pA0, pA1, 0);
    { float a = fmaxf(pA0[0], pA1[0]);
#pragma unroll
      for (int r = 1; r < 16; ++r) a = fmaxf(a, fmaxf(pA0[r], pA1[r]));
      a = fmaxf(att::swap_lo(a), att::swap_hi(a));
      const float dl = fmaxf(a, FLOOR); mhat = dl;
#pragma unroll
      for (int r = 0; r < 16; ++r) { pA0[r] = __builtin_amdgcn_exp2f(pA0[r] - dl); pA1[r] = __builtin_amdgcn_exp2f(pA1[r] - dl); }
      qx = qx_build(ct - mhat, hi); asm volatile("" : "+v"(qx)); }
    WAIT_BAR(0);
    DMA_K(3, 0); DMA_V(1, SLOTB);
    ROT();
    kload2(kf, kp0 + sl_cur, 0); kload2(kf, kp0 + sl_cur, 1); kload2(kf, kp0 + sl_cur, 2); kload2(kf, kp0 + sl_cur, 3);
    kf[8] = *(const LAS bf16x8*)(kx0 + sl_cur); kf[9] = *(const LAS bf16x8*)(kx0 + sl_cur + 512);
    WAIT_BAR(3);
    s16x4 vlo[8], vhi[8]; u32x4 pw0, pw1, pw2, pw3;
#define PKW(P, B) cvt_pk_bf16(P[B], P[B + 1])
#define PAF(k) __builtin_bit_cast(bf16x8, pw##k)
#define VFR(i) (bf16x8){vlo[i][0], vlo[i][1], vlo[i][2], vlo[i][3], vhi[i][0], vhi[i][1], vhi[i][2], vhi[i][3]}
#define PIN(x) asm volatile("" : "+v"(x))
#define MX3(a, b, c) __builtin_fmaxf(__builtin_fmaxf((a), (b)), (c))
#define GAPA(MF, A0, A1, A2, A3, W0, W1, PW) do { MF; sacc += A0; sacc += A1; sacc += A2; sacc += A3; PIN(sacc); W0; W1; PIN(PW); SBAR(); } while (0)
#define EX(v) __builtin_amdgcn_exp2f(v)
#define GAPB(MF, X, B) do { MF; X[B] = EX(X[B]); X[B + 1] = EX(X[B + 1]); X[B + 2] = EX(X[B + 2]); X[B + 3] = EX(X[B + 3]); PIN(X); SBAR(); } while (0)
#define VRD(i) do { vlo[i] = vtr(vp_ + (((i) >> 2) * 4096 + ((i) & 3) * 1024)); vhi[i] = vtr(vp_ + (((i) >> 2) * 4096 + ((i) & 3) * 1024 + 512)); } while (0)
#define KRD(G, j) do { if (G) { kload2(kf, kp0 + sl_next, j); SBAR(); } } while (0)
#define KRDX(G) do { if (G) { kf[8] = *(const LAS bf16x8*)(kx0 + sl_next); kf[9] = *(const LAS bf16x8*)(kx0 + sl_next + 512); SBAR(); } } while (0)
#define STEP(C0, C1, P0, P1, t, GK, GV, GL) do { SBAR(); \
    const lds_cptr vp_ = vp0 + sl_prev; \
    C0 = MFMA32(kf[8], qx, z16); C1 = MFMA32(kf[9], qx, z16); SBAR(); \
    VRD(0); SBAR(); float sacc = (P0[0] + P0[1]); \
    GAPA(C0 = MFMA32(kf[0], qr[0], C0), P0[2], P0[3], P0[4], P0[5],     pw0[0] = PKW(P0, 0), pw0[1] = PKW(P0, 2), pw0); \
    VRD(4); SBAR(); GAPA(C1 = MFMA32(kf[1], qr[0], C1), P0[6], P0[7], P0[8], P0[9],     pw0[2] = PKW(P0, 4), pw0[3] = PKW(P0, 6), pw0); \
    VRD(1); SBAR(); GAPA(C0 = MFMA32(kf[2], qr[1], C0),   P0[10], P0[11], P0[12], P0[13], pw1[0] = PKW(P0, 8), pw1[1] = PKW(P0, 10), pw1); \
    VRD(5); SBAR(); GAPA(C1 = MFMA32(kf[3], qr[1], C1),   P0[14], P0[15], P1[0], P1[1],   pw1[2] = PKW(P0, 12), pw1[3] = PKW(P0, 14), pw1); \
    VRD(2); SBAR(); GAPA(C0 = MFMA32(kf[4], qr[2], C0),   P1[2], P1[3], P1[4], P1[5],     pw2[0] = PKW(P1, 0), pw2[1] = PKW(P1, 2), pw2); \
    VRD(6); SBAR(); GAPA(C1 = MFMA32(kf[5], qr[2], C1),   P1[6], P1[7], P1[8], P1[9],     pw2[2] = PKW(P1, 4), pw2[3] = PKW(P1, 6), pw2); \
    VRD(3); SBAR(); GAPA(C0 = MFMA32(kf[6], qr[3], C0),   P1[10], P1[11], P1[12], P1[13], pw3[0] = PKW(P1, 8), pw3[1] = PKW(P1, 10), pw3); \
    VRD(7); SBAR(); GAPA(C1 = MFMA32(kf[7], qr[3], C1),   P1[14], P1[15], 0.f, 0.f,       pw3[2] = PKW(P1, 12), pw3[3] = PKW(P1, 14), pw3); \
    l_reg += sacc; \
    if (GK) { DMA_K((t) + 3, sl_cur); } if (GV) { DMA_V((t) + 1, sl_next); } \
    CMASK(C0, C1, t); \
    { float a = MX3(C0[0], C0[1], C1[0]), b_ = MX3(C0[2], C0[3], C1[1]); a = MX3(a, C1[2], C1[3]); \
      _Pragma("unroll") for (int r = 4; r < 16; r += 4) { a = MX3(a, C0[r], C0[r + 1]); b_ = MX3(b_, C0[r + 2], C0[r + 3]); a = MX3(a, C1[r], C1[r + 1]); b_ = MX3(b_, C1[r + 2], C1[r + 3]); } \
      float rm = __builtin_fmaxf(a, b_); { auto rr = __builtin_amdgcn_permlane32_swap(__float_as_uint(rm), __float_as_uint(rm), false, false); rm = __builtin_fmaxf(__uint_as_float(rr[0]), __uint_as_float(rr[1])); } \
      resc = false; \
      if (__builtin_expect(__any(rm > (float)THRL), 0)) { const float dl = __builtin_fmaxf(rm, 0.f); mhat += dl; \
        _Pragma("unroll") for (int r = 0; r < 16; ++r) { C0[r] -= dl; C1[r] -= dl; } \
        qx = qx_build(ct - mhat, hi); asm volatile("" : "+v"(qx)); \
        const float f = __builtin_amdgcn_exp2f(-dl); l_reg *= f; if (hi == 0) wsf[r32] = f; resc = true; } } \
    SBAR(); \
    GAPB(o[0] = MFMA32(PAF(0), VFR(0), o[0]), C0, 0); \
    KRDX(GL); GAPB(o[1] = MFMA32(PAF(0), VFR(4), o[1]), C0, 4); \
    KRD(GL, 0); GAPB(o[0] = MFMA32(PAF(1), VFR(1), o[0]), C0, 8); \
    KRD(GL, 1); GAPB(o[1] = MFMA32(PAF(1), VFR(5), o[1]), C0, 12); \
    KRD(GL, 2); GAPB(o[0] = MFMA32(PAF(2), VFR(2), o[0]), C1, 0); \
    KRD(GL, 3); GAPB(o[1] = MFMA32(PAF(2), VFR(6), o[1]), C1, 4); \
    GAPB(o[0] = MFMA32(PAF(3), VFR(3), o[0]), C1, 8); \
    GAPB(o[1] = MFMA32(PAF(3), VFR(7), o[1]), C1, 12); \
    } while (0)
#define ENDW(tt) do { if ((tt) + 3 < NTe) { WAIT_BAR(3); } else if ((tt) + 2 < NTe) { WAIT_BAR(1); } else { WAIT_BAR(0); } } while (0)
#define VOTE(u) do { const int ts_ = NT - (u) - 3; bool ok_ = false; if (ts_ >= 0) { ok_ = __all((qkb - mhat) < clt[ts_]); } if (lane == 0) votes[wid] = ok_ ? 1u : 0u; } while (0)
#define TALLY(u) do { const u32x4 va_ = *(const LAS u32x4*)votes, vb_ = *(const LAS u32x4*)(votes + 4); \
        if (__builtin_amdgcn_readfirstlane((va_.x & va_.y & va_.z & va_.w & vb_.x & vb_.y & vb_.z & vb_.w) != 0u)) { if ((u) + 2 < NTe) { NTe = (u) + 2; WAIT_BAR(0); } } } while (0)
    int t = 1;
    for (; t + 1 < NTe && t < 5; t += 2) {
        STEP(pB0, pB1, pA0, pA1, t, (t + 3 < NTe), (t + 1 < NTe), (t + 1 < NTe));       ENDW(t);     RESC(); ROT();
        STEP(pA0, pA1, pB0, pB1, t + 1, (t + 4 < NTe), (t + 2 < NTe), (t + 2 < NTe));   VOTE(t + 1); ENDW(t + 1); TALLY(t + 1); RESC(); ROT();
    }
#undef CMASK
#define CMASK(P0, P1, p) do {} while (0)
    for (; t + 5 < NTe; t += 2) {
        STEP(pB0, pB1, pA0, pA1, t, true, true, true);       WAIT_BAR(3); RESC(); ROT();
        STEP(pA0, pA1, pB0, pB1, t + 1, true, true, true);   VOTE(t + 1); WAIT_BAR(3); TALLY(t + 1); RESC(); ROT();
    }
    for (; t + 1 < NTe; t += 2) {
        STEP(pB0, pB1, pA0, pA1, t, (t + 3 < NTe), (t + 1 < NTe), (t + 1 < NTe));       ENDW(t);     RESC(); ROT();
        STEP(pA0, pA1, pB0, pB1, t + 1, (t + 4 < NTe), (t + 2 < NTe), (t + 2 < NTe));   ENDW(t + 1); RESC(); ROT();
    }
#undef CMASK
#define CMASK(P0, P1, p) do { const int jb_ = 3 - (p); if (jb_ >= 0) cmask(P0, P1, jb_, qrel, hi); } while (0)
    STEP(pB0, pB1, pA0, pA1, NTe - 1, false, false, false); RESC();
    { float sacc = pB0[0] + pB0[1];
#pragma unroll
      for (int r = 2; r < 16; ++r) sacc += pB0[r];
#pragma unroll
      for (int r = 0; r < 16; ++r) sacc += pB1[r];
      l_reg += sacc;
      pw0 = (u32x4){PKW(pB0, 0), PKW(pB0, 2), PKW(pB0, 4), PKW(pB0, 6)}; pw1 = (u32x4){PKW(pB0, 8), PKW(pB0, 10), PKW(pB0, 12), PKW(pB0, 14)};
      pw2 = (u32x4){PKW(pB1, 0), PKW(pB1, 2), PKW(pB1, 4), PKW(pB1, 6)}; pw3 = (u32x4){PKW(pB1, 8), PKW(pB1, 10), PKW(pB1, 12), PKW(pB1, 14)};
      SBAR(); att::pv(o, (int)(unsigned)(uintptr_t)(vp0 + sl_cur), PAF(0), PAF(1), PAF(2), PAF(3)); }
    l_reg = att::swap_lo(l_reg) + att::swap_hi(l_reg);
    if (hi == 0) wsf[32 + r32] = l_reg; asm volatile("s_waitcnt lgkmcnt(0)" ::: "memory");
    float rli[16];
#pragma unroll
    for (int r = 0; r < 16; ++r) rli[r] = __builtin_amdgcn_rcpf(wsf[32 + crow(r, hi)]);
    bf16_t* Ow = O + (rowbase + q0 + wid * 32) * OPITCH + h * HD;
    { LAS bf16_t* stg = (LAS bf16_t*)(shm + LDS_OST) + wid * 2048;
#pragma unroll
      for (int r = 0; r < 16; ++r) { const int orow = crow(r, hi);
#pragma unroll
        for (int d0 = 0; d0 < 2; ++d0) stg[orow * 64 + d0 * 32 + r32] = (bf16_t)(cvt_pk_bf16(o[d0][r] * rli[r], 0.f) & 0xffffu); }
      asm volatile("s_waitcnt lgkmcnt(0)" ::: "memory");
#pragma unroll
      for (int i = 0; i < 4; ++i) { const int row = i * 8 + (lane >> 3), ch = lane & 7; const u32x4 v = *(const LAS u32x4*)(stg + row * 64 + ch * 8); *(u32x4*)(Ow + (long)row * OPITCH + ch * 8) = v;
        att::store_row_ssq(v, hs + (rowbase + q0 + wid * 32 + row) * 16, ch); } }
    asm volatile("s_waitcnt lgkmcnt(0)\n\ts_barrier" ::: "memory");
#undef DMA_K
#undef DMA_V
#undef CMASK
#undef RESC
#undef ROT
#undef PKW
#undef PAF
#undef VFR
#undef PIN
#undef MX3
#undef GAPA
#undef GAPB
#undef EX
#undef VRD
#undef KRD
#undef KRDX
#undef STEP
#undef ENDW
#undef VOTE
#undef TALLY
}
#undef SBAR
#undef WAIT_BAR
}


namespace sbk {
constexpr int QB = 256, KVBLK = 64, PITCH = HW, OPITCH = DM, NBURST = 6, SLOTB = 8192;
constexpr int LDS_K = 0, LDS_V = NBURST * SLOTB, LDS_FLAG = 2 * NBURST * SLOTB, LDS_END = LDS_FLAG + 128;
static_assert(LDS_END <= RING_BYTES, "sb LDS");
using att::crow; using att::glds16s; using att::qkt; using att::pv; using att::swap_lo;
__device__ __forceinline__ void sb_tile(const LAS char* Kslot, int vb, const bf16x8* qr, bf16x8 TD0, bf16x8 TD1, bf16x8 TONE, int jb, int qrel, int r32, int hi, float& R, f32x16* o) {
    f32x16 p0, p1; const f32x16 z16 = f32x16{};
    qkt(p0, p1, Kslot, qr, z16, r32, hi);
    if (jb >= 0) {
#pragma unroll
        for (int r = 0; r < 16; ++r) { const int kv = 64 * jb + crow(r, hi); if (kv >= qrel) p0[r] = -1.0e30f; if (kv + 32 >= qrel) p1[r] = -1.0e30f; } }
    f32x16 l0, l1;
#pragma unroll
    for (int r = 0; r < 16; ++r) {
        l0[r] = -(fmaxf(p0[r], 0.f) + __builtin_amdgcn_logf(1.0f + __builtin_amdgcn_exp2f(-fabsf(p0[r]))));
        l1[r] = -(fmaxf(p1[r], 0.f) + __builtin_amdgcn_logf(1.0f + __builtin_amdgcn_exp2f(-fabsf(p1[r])))); }
    u32x4 lw0 = {cvt_pk_bf16(l0[0], l0[1]), cvt_pk_bf16(l0[2], l0[3]), cvt_pk_bf16(l0[4], l0[5]), cvt_pk_bf16(l0[6], l0[7])};
    u32x4 lw1 = {cvt_pk_bf16(l0[8], l0[9]), cvt_pk_bf16(l0[10], l0[11]), cvt_pk_bf16(l0[12], l0[13]), cvt_pk_bf16(l0[14], l0[15])};
    u32x4 lw2 = {cvt_pk_bf16(l1[0], l1[1]), cvt_pk_bf16(l1[2], l1[3]), cvt_pk_bf16(l1[4], l1[5]), cvt_pk_bf16(l1[6], l1[7])};
    u32x4 lw3 = {cvt_pk_bf16(l1[8], l1[9]), cvt_pk_bf16(l1[10], l1[11]), cvt_pk_bf16(l1[12], l1[13]), cvt_pk_bf16(l1[14], l1[15])};
    f32x16 rt;
#pragma unroll
    for (int r = 0; r < 16; ++r) rt[r] = R;
    f32x16 t0 = MFMA32(TD0, __builtin_bit_cast(bf16x8, lw0), rt); t0 = MFMA32(TD1, __builtin_bit_cast(bf16x8, lw1), t0);
    t0 = MFMA32(TONE, __builtin_bit_cast(bf16x8, lw2), t0); t0 = MFMA32(TONE, __builtin_bit_cast(bf16x8, lw3), t0);
    f32x16 t1 = MFMA32(TD0, __builtin_bit_cast(bf16x8, lw2), rt); t1 = MFMA32(TD1, __builtin_bit_cast(bf16x8, lw3), t1);
#pragma unroll
    for (int r = 0; r < 16; ++r) { p0[r] = __builtin_amdgcn_exp2f(p0[r] + t0[r]); p1[r] = __builtin_amdgcn_exp2f(p1[r] + t1[r]); }
    R = swap_lo(t0[0]);
    u32x4 pw0 = {cvt_pk_bf16(p0[0], p0[1]), cvt_pk_bf16(p0[2], p0[3]), cvt_pk_bf16(p0[4], p0[5]), cvt_pk_bf16(p0[6], p0[7])};
    u32x4 pw1 = {cvt_pk_bf16(p0[8], p0[9]), cvt_pk_bf16(p0[10], p0[11]), cvt_pk_bf16(p0[12], p0[13]), cvt_pk_bf16(p0[14], p0[15])};
    u32x4 pw2 = {cvt_pk_bf16(p1[0], p1[1]), cvt_pk_bf16(p1[2], p1[3]), cvt_pk_bf16(p1[4], p1[5]), cvt_pk_bf16(p1[6], p1[7])};
    u32x4 pw3 = {cvt_pk_bf16(p1[8], p1[9]), cvt_pk_bf16(p1[10], p1[11]), cvt_pk_bf16(p1[12], p1[13]), cvt_pk_bf16(p1[14], p1[15])};
    pv(o, vb, __builtin_bit_cast(bf16x8, pw0), __builtin_bit_cast(bf16x8, pw1), __builtin_bit_cast(bf16x8, pw2), __builtin_bit_cast(bf16x8, pw3));
}
#define SB_WAITBAR(N) asm volatile("s_waitcnt vmcnt(" #N ") lgkmcnt(0)\n\ts_barrier" ::: "memory")
__device__ __forceinline__ void sb_unit(int b, int h, int qb, const bf16_t* Q, const bf16_t* K, const bf16_t* V, bf16_t* O, float* hs, LAS char* shm) {
    int tid = threadIdx.x; asm volatile("" : "+v"(tid)); const int lane = tid & 63, r32 = lane & 31, hi = lane >> 5; const int wid = __builtin_amdgcn_readfirstlane(tid >> 6);
    const long rowbase = (long)b * SEQ; const int q0 = qb * QB;
    const bf16_t* Qw = Q + (rowbase + q0 + wid * 32) * PITCH + h * HD;
    const bf16_t* Kh = K + rowbase * PITCH + h * HD; const bf16_t* Vh = V + rowbase * PITCH + h * HD;
    const unsigned lds0 = (unsigned)(uintptr_t)shm;
    LAS unsigned* flags = (LAS unsigned*)(shm + LDS_FLAG);
    const unsigned koff = (unsigned)(lane * PITCH + wid * 8) * 2u, voff = (unsigned)((16 * (wid & 3) + (lane >> 2)) * PITCH + (wid >> 2) * 32 + (lane & 3) * 8) * 2u;
    const unsigned kdst = lds0 + LDS_K + wid * 1024, vdst = lds0 + LDS_V + wid * 1024;
#define SB_DMA(p, slot) do { glds16s(Kh + (long)(NT - 1 - (p)) * KVBLK * PITCH, koff, (unsigned)__builtin_amdgcn_readfirstlane(kdst + (slot) * SLOTB)); \
        glds16s(Vh + (long)(NT - 1 - (p)) * KVBLK * PITCH, voff, (unsigned)__builtin_amdgcn_readfirstlane(vdst + (slot) * SLOTB)); } while (0)
    const int vb0 = (int)(lds0 + LDS_V) + ((lane >> 4) & 1) * 32 + (lane & 3) * 8 + (4 * hi + ((lane & 15) >> 2)) * 64;
    const int NT = (q0 + QB) / KVBLK, NB = NT < NBURST ? NT : NBURST;
    for (int p = 0; p < NB; ++p) SB_DMA(p, p);
    bf16x8 qr[4];
#pragma unroll
    for (int d0 = 0; d0 < 4; ++d0) qr[d0] = *(const bf16x8*)(Qw + (long)r32 * PITCH + d0 * 16 + hi * 8);
    f32x16 o[2]; o[0] = f32x16{}; o[1] = f32x16{};
    const int qrel = wid * 32 + r32;
    float R = 0.f;
    bf16x8 TD0, TD1, TONE;
#pragma unroll
    for (int j = 0; j < 8; ++j) { const int kvl = 8 * (j >> 2) + 4 * hi + (j & 3); TD0[j] = (kvl >= r32) ? (short)0x3F80 : (short)0; TD1[j] = (16 + kvl >= r32) ? (short)0x3F80 : (short)0; TONE[j] = (short)0x3F80; }
    if (NB > 4) { SB_WAITBAR(4); } else { SB_WAITBAR(0); }
    bool mid_done = (NB <= 4);
    int p = 3 - (wid >> 1);
    for (; p < NB; ++p) {
        if (p >= 4 && !mid_done) { SB_WAITBAR(0); mid_done = true; }
        sb_tile(shm + LDS_K + p * SLOTB, vb0 + p * SLOTB, qr, TD0, TD1, TONE, 3 - p, qrel, r32, hi, R, o);
        if (__all(R < SB_EXIT)) { ++p; break; }
    }
    if (!mid_done) { SB_WAITBAR(0); }
    { const bool dn = __all(R < SB_EXIT) || (p >= NT); if (lane == 0) flags[wid] = dn ? 1u : 0u; }
    SB_WAITBAR(0);
    bool alldone;
    { const u32x4 fa = *(const LAS u32x4*)flags, fb = *(const LAS u32x4*)(flags + 4); alldone = __builtin_amdgcn_readfirstlane((fa.x & fa.y & fa.z & fa.w & fb.x & fb.y & fb.z & fb.w) != 0u); }
    if (!alldone && NB < NT) {
        SB_DMA(NB, 0);
        for (int i = 0; NB + i < NT; ++i) {
            const int pp = NB + i, sl = i & 1;
            SB_WAITBAR(0);
            if (i > 0) { const LAS unsigned* fl = flags + 8 + ((i - 1) & 1) * 8; const u32x4 fa = *(const LAS u32x4*)fl, fb = *(const LAS u32x4*)(fl + 4);
                if (__builtin_amdgcn_readfirstlane((fa.x & fa.y & fa.z & fa.w & fb.x & fb.y & fb.z & fb.w) != 0u)) break; }
            if (pp + 1 < NT) SB_DMA(pp + 1, sl ^ 1);
            if (!__all(R < SB_EXIT)) sb_tile(shm + LDS_K + sl * SLOTB, vb0 + sl * SLOTB, qr, TD0, TD1, TONE, -1, qrel, r32, hi, R, o);
            { const bool dn = __all(R < SB_EXIT); if (lane == 0) flags[8 + (i & 1) * 8 + wid] = dn ? 1u : 0u; }
        }
        SB_WAITBAR(0);
    }
    bf16_t* Ow = O + (rowbase + q0 + wid * 32) * OPITCH + h * HD;
    { LAS bf16_t* stg = (LAS bf16_t*)(shm + LDS_K) + wid * 2048;
#pragma unroll
      for (int r = 0; r < 16; ++r) { const int orow = crow(r, hi);
#pragma unroll
        for (int d0 = 0; d0 < 2; ++d0) stg[orow * 64 + d0 * 32 + r32] = (bf16_t)(cvt_pk_bf16(o[d0][r], 0.f) & 0xffffu); }
      LDS_WAIT();
#pragma unroll
      for (int i = 0; i < 4; ++i) { const int row = i * 8 + (lane >> 3), ch = lane & 7; const u32x4 v = *(const LAS u32x4*)(stg + row * 64 + ch * 8); *(u32x4*)(Ow + (long)row * OPITCH + ch * 8) = v;
        att::store_row_ssq(v, hs + (rowbase + q0 + wid * 32 + row) * 16, ch); } }
    asm volatile("s_waitcnt vmcnt(0) lgkmcnt(0)\n\ts_barrier" ::: "memory");
#undef SB_DMA
}
#undef SB_WAITBAR
}

#define XB_TMO      128
#define XB_XCNT(j)  (256  + 64 * (j))
#define XB_XSUB(j)  (1280 + 64 * (j))
#define XB_XGEN(j)  (2304 + 64 * (j))
#define XB_TOP      3328
#define XB_TOPGEN   3392
#define XCD_BAR_WORDS 3456
#define XB_SPIN_CAP (1u << 18)
__device__ __forceinline__ unsigned xb_ld(unsigned* p)              { return __hip_atomic_load(p, __ATOMIC_RELAXED, __HIP_MEMORY_SCOPE_AGENT); }
__device__ __forceinline__ unsigned xb_add(unsigned* p, unsigned v) { return __hip_atomic_fetch_add(p, v, __ATOMIC_RELAXED, __HIP_MEMORY_SCOPE_AGENT); }
__device__ __forceinline__ unsigned xb_xcc_id() { return (unsigned)__builtin_amdgcn_s_getreg((3 << 11) | 20) & 0xFu; }
#define XB_SPIN(cond, bar) do { unsigned _sp = 0; while (cond) { __builtin_amdgcn_s_sleep(1); \
    if ((++_sp & 255u) == 0u) { if (xb_ld(&(bar)[XB_TMO])) break; if (_sp > XB_SPIN_CAP) { atomicAdd(&(bar)[XB_TMO], 1u); break; } } } } while (0)
struct XcdBarrier { unsigned* bar; unsigned x; volatile LAS unsigned* st; };
__device__ __forceinline__ XcdBarrier xcd_barrier_post(unsigned* bar, volatile LAS unsigned* st) {
    XcdBarrier b; b.bar = bar; b.x = xb_xcc_id(); b.st = st;
    if (threadIdx.x == 0) (void)xb_add(&bar[XB_XCNT(b.x)], 1u);
    return b;
}
__device__ __forceinline__ void xcd_barrier_complete(unsigned* bar, unsigned x, unsigned& nloc, unsigned& nx) {
    const unsigned G = gridDim.x * gridDim.y * gridDim.z;
    unsigned sum, cnt, mine, sp = 0u;
    for (;;) {
        sum = 0u; cnt = 0u; mine = 0u;
#pragma unroll
        for (unsigned j = 0; j < 16; ++j) { const unsigned c = xb_ld(&bar[XB_XCNT(j)]); sum += c; cnt += (c > 0u) ? 1u : 0u; mine = (j == x) ? c : mine; }
        if (sum == G) break;
        __builtin_amdgcn_s_sleep(1);
        if ((++sp & 255u) == 0u) { if (xb_ld(&bar[XB_TMO])) break; if (sp > XB_SPIN_CAP) { atomicAdd(&bar[XB_TMO], 1u); break; } }
    }
    nloc = mine > 0u ? mine : 1u; nx = cnt > 0u ? cnt : 1u;
}
__device__ __forceinline__ void xcd_barrier(const XcdBarrier& b) {
    asm volatile("s_waitcnt vmcnt(0)" ::: "memory");
    __syncthreads();
    if (threadIdx.x == 0) {
        unsigned* bar = b.bar;
        __builtin_amdgcn_s_waitcnt(0);
        unsigned nloc = b.st[0], nx = b.st[1];
        if (nloc == 0u) { xcd_barrier_complete(bar, b.x, nloc, nx); b.st[0] = nloc; b.st[1] = nx; }
        const unsigned old = xb_add(&bar[XB_XSUB(b.x)], 1u);
        const unsigned gen = old / nloc;
        if (old + 1u == (gen + 1u) * nloc) {
            __builtin_amdgcn_fence(__ATOMIC_RELEASE, "agent");
            asm volatile("s_waitcnt vmcnt(0)" ::: "memory");
            const unsigned og = xb_add(&bar[XB_TOP], 1u);
            const unsigned tg = og / nx;
            if (og + 1u == (tg + 1u) * nx) xb_add(&bar[XB_TOPGEN], 1u);
            else XB_SPIN(xb_ld(&bar[XB_TOPGEN]) == tg, bar);
            __builtin_amdgcn_fence(__ATOMIC_ACQUIRE, "agent");
            xb_add(&bar[XB_XGEN(b.x)], 1u);
            asm volatile("s_waitcnt vmcnt(0)" ::: "memory");
        } else {
            XB_SPIN(xb_ld(&bar[XB_XGEN(b.x)]) == gen, bar);
            __builtin_amdgcn_fence(__ATOMIC_ACQUIRE, "agent");
            asm volatile("s_waitcnt vmcnt(0)" ::: "memory");
        }
    }
    __syncthreads();
}

__device__ __forceinline__ const void* ldp(const volatile LAS unsigned* tab, int i) {
    const unsigned lo = __builtin_amdgcn_readfirstlane(tab[2 * i]), hi = __builtin_amdgcn_readfirstlane(tab[2 * i + 1]);
    return (const void*)(const GAS void*)(((unsigned long long)hi << 32) | lo);
}
struct Args {
    const float* x; const float* mem; const float* norm_mix; const float* w_in; const float* b_forget; const float* norm_fox; const float* norm_sb; const float* w_out;
    const float* norm_xattn; const float* norm_mem; const float* w_xq; const float* w_xkv; const float* w_xo; const float* norm_ffn;
    const float* w_rg; const float* b_rg; const float* w_re; const float* b_re; const float* w_gate; const float* w_up; const float* w_down; const float* norm_final;
    float* out; unsigned char* ws;
};

__device__ __forceinline__ void transpose_item(const float* W, int ldw, bf16_t* WT, int ldo, int k0, int n0, int dst_row0, const float* gain, LAS float* scr, int lane) {
    float tv[32], tg[32];
#pragma unroll
    for (int i = 0; i < 32; ++i) { const int kk = 2 * i + (lane >> 5); tv[i] = W[(size_t)(k0 + kk) * ldw + n0 + (lane & 31)]; tg[i] = gain ? gain[k0 + kk] : 1.f; }
#pragma unroll
    for (int i = 0; i < 32; ++i) { const int kk = 2 * i + (lane >> 5); scr[kk * 33 + (lane & 31)] = tv[i] * tg[i]; }
    LDS_WAIT(); asm volatile("" ::: "memory");
    const int c = lane & 7;
#pragma unroll
    for (int j = 0; j < 4; ++j) { const int n = (lane >> 3) + 8 * j; const LAS float* s = scr + (8 * c) * 33 + n;
        u32x4 o; o.x = cvt_pk_bf16(s[0 * 33], s[1 * 33]); o.y = cvt_pk_bf16(s[2 * 33], s[3 * 33]); o.z = cvt_pk_bf16(s[4 * 33], s[5 * 33]); o.w = cvt_pk_bf16(s[6 * 33], s[7 * 33]);
        *(u32x4*)(WT + (size_t)(dst_row0 + n) * ldo + k0 + 8 * c) = o; }
    LDS_WAIT(); asm volatile("" ::: "memory");
}

struct SchedDense {
    const char* A; const char* Bt; int nM, nN, G, c; size_t a_tile, b_tile, b_batch; int split_tiles;
    __device__ __forceinline__ bool next(int i, pg8::Unit& u) const {
        int pm, pn; if (!pg8::tile_order(i, G, c, nM, nN, pm, pn)) return false;
        u.a = A + (size_t)pm * a_tile; u.b = Bt + (size_t)pn * b_tile + (size_t)(pm >> 5) * b_batch; u.orow = pm * 256;
        if (split_tiles) { u.aux = pn / split_tiles; u.ocol = (pn % split_tiles) * 256; } else { u.aux = 1; u.ocol = pn * 256; }
        u.rows = nullptr; u.nvalid = 256; return true;
    }
};
struct SchedGH {
    const char* KVm; const char* Wxq; const char* Wxo; int G, c;
    __device__ __forceinline__ bool next(int i, pg8::Unit& u) const {
        const int L = i * G + c; if (L >= 256) return false;
        const int kind = L >> 7, r = L & 127, bh = r >> 2, j = r & 3, b = bh >> 2, h = bh & 3;
        if (kind == 0) { u.a = KVm + ((size_t)(b * 256) * 2048 + h * 256) * 2; u.b = Wxq + ((size_t)(256 * j) * 1024 + h * 256) * 2; u.orow = b * 1024 + h * 256; u.ocol = 256 * j; u.aux = 1; }
        else { u.a = Wxo + ((size_t)(256 * j) * 1024 + h * 256) * 2; u.b = KVm + ((size_t)(b * 256) * 2048 + 1024 + h * 256) * 2; u.orow = b * 1024 + 256 * j; u.ocol = h * 256; u.aux = 2; }
        u.rows = nullptr; u.nvalid = 256; return true;
    }
};
template <int KIND> struct SchedGHk { SchedGH s; __device__ __forceinline__ bool next(int i, pg8::Unit& u) const { const int c2 = (s.G >= 256) ? s.c - 128 * KIND : s.c; if (c2 < 0) return false; const int L = i * s.G + c2; if (L >= 128) return false; SchedGH t = s; t.G = 1; t.c = 0; return t.next(128 * KIND + L, u); } };
struct EpiGH { static constexpr bool HAS_MID = false; bf16_t* GTp; bf16_t* HTp; __device__ __forceinline__ void operator()(const f32x4 (&acc)[2][2][4][2], const pg8::Unit& u, int wr, int wc, int fr, int fq) const {
    pg8::EpiBf16 e{u.aux == 1 ? GTp : HTp, DM, nullptr, 0, 1.f, 1.f, nullptr, nullptr}; pg8::Unit v = u; v.aux = 1; e(acc, v, wr, wc, fr, fq); } };
struct SchedMoe {
    const char* A; const char* W; const int* list; const LAS int* tbl; int G, c, NPN; size_t w_exp, w_tile, a_tile; int ocol_w;
    __device__ __forceinline__ bool next(int i, pg8::Unit& u) const {
        const int L = i * G + c; const int tl = L / NPN, pn = L % NPN;
        if (tl >= __builtin_amdgcn_readfirstlane(tbl[16])) return false;
        int e = 0;
#pragma unroll 1
        for (int x = 1; x < NEXP; ++x) { if (tl >= __builtin_amdgcn_readfirstlane(tbl[x])) e = x; }
        const int j = tl - __builtin_amdgcn_readfirstlane(tbl[e]), n = __builtin_amdgcn_readfirstlane(tbl[32 + e]) - 256 * j;
        u.a = A + (size_t)tl * a_tile; u.b = W + (size_t)e * w_exp + (size_t)pn * w_tile; u.orow = tl * 256; u.ocol = pn * ocol_w; u.aux = 1;
        u.rows = list + (size_t)e * M + 256 * j; u.nvalid = n < 256 ? n : 256; return true;
    }
};
__device__ __forceinline__ void moe_table(LAS int* tbl, const unsigned* ctl) {
    if (threadIdx.x == 0) { int base = 0; for (int e = 0; e < NEXP; ++e) { const int n = (int)ctl[CW_CNT + 64 * e]; tbl[e] = base; tbl[32 + e] = n; base += (n + 255) >> 8; } tbl[16] = base; }
    __syncthreads();
}

__global__ void __launch_bounds__(NWAVES * 64, 2) hymba_fwd(Args args) {
    extern __shared__ __attribute__((aligned(16))) unsigned char lds_raw[];
    LAS unsigned char* lds = (LAS unsigned char*)lds_raw;
    volatile LAS unsigned* MISC = (volatile LAS unsigned*)(lds + MISC_OFF);
    const int tid0 = threadIdx.x; const int wave = __builtin_amdgcn_readfirstlane(tid0 >> 6);
    const int G = gridDim.x; const int bx = blockIdx.x; const int vcu = (G % 8 == 0) ? (bx % 8) * (G / 8) + bx / 8 : bx;
    volatile LAS unsigned* ATAB = (volatile LAS unsigned*)(lds + MISC_OFF + 512);
    for (int u = tid0; u < 256; u += NWAVES * 64) ((LAS unsigned*)(lds + MISC_OFF))[u] = 0u;
    __syncthreads();
    if (tid0 == 0) { const float* const* ap = (const float* const*)&args;
#pragma unroll
        for (int i = 0; i < 24; ++i) { const unsigned long long v = (unsigned long long)ap[i]; ATAB[2 * i] = (unsigned)v; ATAB[2 * i + 1] = (unsigned)(v >> 32); } }
    __syncthreads();
#define ARGP(name) ((const float*)ldp(ATAB, (int)(offsetof(Args, name) / 8)))
#define PHASE_PTRS \
    int tid = threadIdx.x; asm volatile("" : "+v"(tid)); const int lane = tid & 63; (void)lane; \
    unsigned char* const ws = (unsigned char*)ldp(ATAB, 23); float* const out = (float*)ldp(ATAB, 22); unsigned* const ctl = (unsigned*)(ws + WS_CTL); (void)out; (void)ctl; \
    bf16_t* const Win_t = (bf16_t*)(ws + WS_WIN); bf16_t* const Wout_t = (bf16_t*)(ws + WS_WOUT); bf16_t* const Wxq_n = (bf16_t*)(ws + WS_WXQ); bf16_t* const Wxkv_t = (bf16_t*)(ws + WS_WXKV); \
    bf16_t* const Wxo_t = (bf16_t*)(ws + WS_WXO); bf16_t* const Wgu_t = (bf16_t*)(ws + WS_WGU); bf16_t* const Wd_t = (bf16_t*)(ws + WS_WD); \
    float* const RX = (float*)(ws + WS_RX); float* const RMEM = (float*)(ws + WS_RMEM); float* const LF = (float*)(ws + WS_LF); float* const CC = (float*)(ws + WS_C2); float* const SSQ = (float*)(ws + WS_SSQ); \
    int* const TOKSLOT = (int*)(ws + WS_TOKSLOT); float* const TOKW = (float*)(ws + WS_TOKW); int* const LIST = (int*)(ws + WS_LIST); \
    bf16_t* const MEMB = (bf16_t*)(ws + WS_MEMB); bf16_t* const KVM = (bf16_t*)(ws + WS_KVM); bf16_t* const GT = (bf16_t*)(ws + WS_GT); bf16_t* const HT = (bf16_t*)(ws + WS_HT); \
    bf16_t* const XB = (bf16_t*)(ws + WS_XB); bf16_t* const QKV = (bf16_t*)(ws + WS_QKV); bf16_t* const H1B = (bf16_t*)(ws + WS_H1B); bf16_t* const U2B = (bf16_t*)(ws + WS_U2B); bf16_t* const HID = (bf16_t*)(ws + WS_HID); \
    bf16_t* const OAB = (bf16_t*)(ws + WS_O); bf16_t* const YB = (bf16_t*)(ws + WS_Y); bf16_t* const KX = (bf16_t*)(ws + WS_KX); (void)KX; float* const HS = (float*)(ws + WS_HS); (void)HS; float* const R2S = (float*)(ws + WS_SSQ); (void)R2S; \
    (void)Win_t; (void)Wout_t; (void)Wxq_n; (void)Wxkv_t; (void)Wxo_t; (void)Wgu_t; (void)Wd_t; (void)RX; (void)RMEM; (void)LF; (void)CC; (void)SSQ; (void)TOKSLOT; (void)TOKW; (void)LIST; \
    (void)MEMB; (void)KVM; (void)GT; (void)HT; (void)XB; (void)QKV; (void)H1B; (void)U2B; (void)HID; (void)OAB; (void)YB;
    XcdBarrier bar;
    { unsigned char* const ws0 = (unsigned char*)ldp(ATAB, 23); bar = xcd_barrier_post((unsigned*)(ws0 + WS_CTL) + CW_BAR, MISC + 8); }
    const int gw = vcu * NWAVES + wave, NGW = G * NWAVES;
    unsigned long long t_pa = 0, t_pb = 0; (void)t_pa; (void)t_pb;


    if (PROBE_LO == 0) t_pa = __builtin_amdgcn_s_memrealtime();
    if (PH(0))
    for (int rep_ = 0; rep_ < REPS(0); ++rep_)
    {
        PHASE_PTRS
        LAS float* wfT = (LAS float*)(lds + RING_OFF);
        LAS float* scr = (LAS float*)(lds + RING_OFF + 32768 + wave * 8448);
        { const float* win = ARGP(w_in); const float* gmix = ARGP(norm_mix);
          f32x4 fa[2], fb[2]; float gk[2];
#pragma unroll
          for (int q = 0; q < 2; ++q) { const int k = tid + 512 * q; gk[q] = gmix[k]; fa[q] = *(const f32x4*)(win + (size_t)k * WIN_LD + NPROJ); fb[q] = *(const f32x4*)(win + (size_t)k * WIN_LD + NPROJ + 4); }
#pragma unroll
          for (int q = 0; q < 2; ++q) { const int k = tid + 512 * q;
#pragma unroll
              for (int j = 0; j < 4; ++j) { wfT[j * DM + k] = fa[q][j] * gk[q]; wfT[(4 + j) * DM + k] = fb[q][j] * gk[q]; } } }
        constexpr int I_IN = 16 * 96, I_OUT = 16 * 32, I_XKV = 16 * 64, I_XO = 16 * 32, I_G = 16 * 16 * 8, I_U = I_G, I_D = 16 * 4 * 32, I_XQ = 1024;
        constexpr int NITEMS = I_IN + I_OUT + I_XKV + I_XO + I_G + I_U + I_D + I_XQ;
        for (int it = gw; it < NITEMS; it += NGW) {
            int r = it;
            if (r < I_IN) { const int kb = r / 96, nb = r % 96; transpose_item(ARGP(w_in), WIN_LD, Win_t, DM, 64 * kb, 32 * nb, 32 * nb, ARGP(norm_mix), scr, lane); continue; } r -= I_IN;
            if (r < I_OUT) { const int kb = r / 32, nb = r % 32; const float* gn = (64 * kb < HW) ? ARGP(norm_fox) : (ARGP(norm_sb) - HW); transpose_item(ARGP(w_out), DM, Wout_t, DM, 64 * kb, 32 * nb, 32 * nb, gn, scr, lane); continue; } r -= I_OUT;
            if (r < I_XKV) { const int kb = r / 64, nb = r % 64; transpose_item(ARGP(w_xkv), 2 * DM, Wxkv_t, DM, 64 * kb, 32 * nb, 32 * nb, ARGP(norm_mem), scr, lane); continue; } r -= I_XKV;
            if (r < I_XO) { const int kb = r / 32, nb = r % 32; transpose_item(ARGP(w_xo), DM, Wxo_t, DM, 64 * kb, 32 * nb, 32 * nb, nullptr, scr, lane); continue; } r -= I_XO;
            if (r < I_G + I_U) { const int up = r >= I_G; const int q = up ? r - I_G : r; const int e = q / 128, kb = (q % 128) / 8, nb = q % 8; const int n0 = 32 * nb;
                const float* W = (up ? ARGP(w_up) : ARGP(w_gate)) + (size_t)e * DM * DFF;
                transpose_item(W, DFF, Wgu_t + (size_t)e * 512 * DM, DM, 64 * kb, n0, 256 * (n0 / 128) + (n0 % 128) + (up ? 128 : 0), ARGP(norm_ffn), scr, lane); continue; } r -= I_G + I_U;
            if (r < I_D) { const int e = r / 128, kb = (r % 128) / 32, nb = r % 32; transpose_item(ARGP(w_down) + (size_t)e * DFF * DM, DM, Wd_t + (size_t)e * DM * DFF, DFF, 64 * kb, 32 * nb, 32 * nb, nullptr, scr, lane); continue; } r -= I_D;
            { const int k = r; const float gk = ARGP(norm_xattn)[k]; const f32x4* src = (const f32x4*)(ARGP(w_xq) + (size_t)k * DM) + lane; u32x2* dst = (u32x2*)(Wxq_n + (size_t)k * DM) + lane;
#pragma unroll
              for (int j = 0; j < 4; ++j) { const f32x4 v = src[64 * j] * gk; u32x2 w; w.x = cvt_pk_bf16(v[0], v[1]); w.y = cvt_pk_bf16(v[2], v[3]); dst[64 * j] = w; } }
        }
        __syncthreads();
        const float* xin = ARGP(x); const float* memin = ARGP(mem); const float* bfg = ARGP(b_forget);
        constexpr int TOT = M + MEMROWS;
#define P0_LOAD(vv, rw) do { if ((rw) < TOT) { const bool im_ = (rw) >= M; const f32x4* xr_ = (const f32x4*)((im_ ? memin : xin) + (size_t)(im_ ? (rw) - M : (rw)) * DM) + lane; \
        _Pragma("unroll") for (int j = 0; j < 4; ++j) vv[j] = __builtin_nontemporal_load(xr_ + 64 * j); } } while (0)
#define P0_ROW(vv, rw) do { const int row_ = (rw); const bool is_mem = row_ >= M; const int r = is_mem ? row_ - M : row_; float s = 0.f; \
        _Pragma("unroll") for (int j = 0; j < 4; ++j) s += (vv[j][0] * vv[j][0] + vv[j][1] * vv[j][1]) + (vv[j][2] * vv[j][2] + vv[j][3] * vv[j][3]); \
        const float rinv = rsqrtf(wave_sum(s) * (1.0f / DM) + EPS); \
        u32x2* o8 = (u32x2*)((is_mem ? MEMB : XB) + (size_t)r * DM) + lane; \
        _Pragma("unroll") for (int j = 0; j < 4; ++j) { u32x2 w; w.x = cvt_pk_bf16(vv[j][0], vv[j][1]); w.y = cvt_pk_bf16(vv[j][2], vv[j][3]); o8[64 * j] = w; } \
        if (is_mem) { if (lane == 0) RMEM[r] = rinv; } \
        else { float f[8]; \
            _Pragma("unroll") for (int jj = 0; jj < 8; ++jj) { float a = 0.f; \
                _Pragma("unroll") for (int j = 0; j < 4; ++j) { const f32x4 w4 = *(const LAS f32x4*)(wfT + jj * DM + 256 * j + 4 * lane); a += (vv[j][0] * w4[0] + vv[j][1] * w4[1]) + (vv[j][2] * w4[2] + vv[j][3] * w4[3]); } \
                f[jj] = wave_sum(a); } \
            if (lane == 0) RX[r] = rinv; \
            if (lane < 8) { float fl = 0.f; \
                _Pragma("unroll") for (int jj = 0; jj < 8; ++jj) fl = (lane == jj) ? f[jj] : fl; \
                fl = fl * rinv + bfg[lane]; \
                const float ls = fminf(fl, 0.f) - log1pf(expf(-fabsf(fl))); \
                LF[(size_t)r * 8 + lane] = ls * LOG2E; } } } while (0)
        f32x4 va[4], vb[4], vc[4];
        P0_LOAD(va, gw); P0_LOAD(vb, gw + NGW);
        for (int row = gw; row < TOT; row += 3 * NGW) {
            P0_LOAD(vc, row + 2 * NGW); P0_ROW(va, row);
            if (row + NGW < TOT) { P0_LOAD(va, row + 3 * NGW); P0_ROW(vb, row + NGW); }
            if (row + 2 * NGW < TOT) { P0_LOAD(vb, row + 4 * NGW); P0_ROW(vc, row + 2 * NGW); }
        }
#undef P0_LOAD
#undef P0_ROW
    }
    xcd_barrier(bar);
    if (PROBE_HI == 0) t_pb = __builtin_amdgcn_s_memrealtime();

    if (PROBE_LO == 1) t_pa = __builtin_amdgcn_s_memrealtime();
    if (PH(1))
    if (vcu < 32) {
        PHASE_PTRS
        const int b = vcu >> 2, h = (vcu & 3) * 2 + (wave >> 2), seg = wave & 3, s0 = seg * 2048 + lane * 32;
        const float* src = LF + ((size_t)b * SEQ + s0) * 8 + h;
        float p[32];
#pragma unroll
        for (int j = 0; j < 32; ++j) p[j] = src[j * 8];
#pragma unroll
        for (int j = 1; j < 32; ++j) p[j] += p[j - 1];
        float inc = p[31];
#pragma unroll
        for (int o = 1; o < 64; o <<= 1) { const float y = __shfl_up(inc, o); if (lane >= o) inc += y; }
        LAS float* tot = (LAS float*)(lds + EXTRA_OFF);
        if (lane == 63) tot[wave] = inc;
        __syncthreads();
        float off = inc - p[31];
        for (int q = 0; q < 3; ++q) if (q < seg) off += tot[(wave & 4) + q];
        float* dst = CC + ((size_t)b * NH + h) * SEQ + s0; bf16_t* kx = KX + (((size_t)b * NH + h) * SEQ + s0) * 8;
#pragma unroll
        for (int j = 0; j < 32; ++j) { const float x = off + p[j]; dst[j] = x;
            unsigned hm, lo; fox::split3(-x, hm, lo); u32x4 w; w.x = 0x3F803F80u; w.y = 0x3F80u | (hm << 16); w.z = (hm >> 16) | (lo << 16); w.w = 0u;
            *(u32x4*)(kx + j * 8) = w; }
        VM_WAIT(); __syncthreads();
    }
    if (PH(1))
    for (int rep_ = 0; rep_ < REPS(1); ++rep_)
    {
        PHASE_PTRS
        pg8::Gemm g{DM, DM, DM};
        SchedDense S{(const char*)XB, (const char*)Win_t, M / 256, NPROJ / 256, G, bx, (size_t)256 * DM * 2, (size_t)256 * DM * 2, 0, 2};
        LAS float* rst = (LAS float*)(lds + EXTRA_OFF);
        for (int i = 0; i < 16; ++i) { int pm, pn; if (!pg8::tile_order(i, G, bx, M / 256, NPROJ / 256, pm, pn)) break; if (tid < 256) rst[i * 256 + tid] = RX[pm * 256 + tid]; }
        VM_WAIT(); __syncthreads();
        pg8::EpiBf16 E{QKV, HW, RX, QKV_STRIDE, C2, C2, ctl + CW_KN, rst};
        pg8::gemm_phase<pg8::EpiBf16, SchedDense, true, false>(lds + RING_OFF, g, S, E);
    }
    xcd_barrier(bar);
    if (PROBE_HI == 1) t_pb = __builtin_amdgcn_s_memrealtime();

    if (PROBE_LO == 2) t_pa = __builtin_amdgcn_s_memrealtime();
    if (PH(2))
    {
        PHASE_PTRS
        const bf16_t* QA = QKV; const bf16_t* KA = QKV + QKV_STRIDE; const bf16_t* VA = QKV + 2 * QKV_STRIDE;
        const bf16_t* QBp = QKV + 3 * QKV_STRIDE; const bf16_t* KBp = QKV + 4 * QKV_STRIDE; const bf16_t* VBp = QKV + 5 * QKV_STRIDE;
        bf16_t* OA = OAB; bf16_t* OB = OAB + HW;
        LAS char* shm = (LAS char*)(lds + RING_OFF);
        { pg8::Gemm g{DM, DM, DM};
          SchedDense S2{(const char*)MEMB, (const char*)Wxkv_t, MEMROWS / 256, 2 * DM / 256, G, bx, (size_t)256 * DM * 2, (size_t)256 * DM * 2, 0, 0};
          pg8::EpiBf16 E2{KVM, 2 * DM, RMEM, 0, 1.f, 1.f, nullptr, nullptr};
          pg8::gemm_phase<pg8::EpiBf16, SchedDense, true, false>(lds + RING_OFF, g, S2, E2);
          VM_WAIT(); __syncthreads(); }
        for (int rep = 0; rep < REP_FOX; ++rep)
        for (int i = 0; i < 8; ++i) { const int bh = (vcu >> 5) * 8 + i, x = vcu & 31, qb = (i & 1) ? 31 - x : x;
            const float kmax = sqrtf(__uint_as_float(ctl[CW_KN + bh * 2]) + __uint_as_float(ctl[CW_KN + bh * 2 + 1])) * 1.01f;
            fox::fox_unit<8>(bh, qb, QA, KA, VA, OA, HS + (bh & 7), CC + (size_t)bh * SEQ, KX + (size_t)bh * SEQ * 8, kmax, shm); }
        { volatile LAS unsigned* qs = MISC + 16;
          unsigned nxt = 0u;
          if (tid == 0) qs[0] = __hip_atomic_fetch_add(ctl + CW_SBQ, 1u, __ATOMIC_RELAXED, __HIP_MEMORY_SCOPE_AGENT);
          __syncthreads();
          unsigned idx = qs[0];
          while (idx < (unsigned)(BATCH * NH * 32 * REP_SB)) {
              __syncthreads();
              if (tid == 0) nxt = __hip_atomic_fetch_add(ctl + CW_SBQ, 1u, __ATOMIC_RELAXED, __HIP_MEMORY_SCOPE_AGENT);
              const int un = (int)(idx % (unsigned)(BATCH * NH * 32)), bh = un >> 5, qb = un & 31;
              sbk::sb_unit(bh >> 3, bh & 7, qb, QBp, KBp, VBp, OB, HS + 8 + (bh & 7), shm);
              if (tid == 0) qs[0] = nxt;
              __syncthreads();
              idx = qs[0];
          } }
    }
    xcd_barrier(bar);
    if (PROBE_HI == 2) t_pb = __builtin_amdgcn_s_memrealtime();

    if (PROBE_LO == 4) t_pa = __builtin_amdgcn_s_memrealtime();
    if (PH(4))
    for (int rep_ = 0; rep_ < REPS(4); ++rep_)
    {
        PHASE_PTRS
        pg8::Gemm g{DM, DM, DM};
        SchedDense S{(const char*)OAB, (const char*)Wout_t, M / 256, DM / 256, G, bx, (size_t)256 * DM * 2, (size_t)256 * DM * 2, 0, 0};
        LAS f32x2* rab = (LAS f32x2*)(lds + EXTRA_OFF);
        for (int i = 0; i < 8; ++i) { int pm, pn; if (!pg8::tile_order(i, G, bx, M / 256, DM / 256, pm, pn)) break;
            if (tid < 256) { const f32x4* p = (const f32x4*)(HS + (size_t)(pm * 256 + tid) * 16); const f32x4 a0 = p[0], a1 = p[1], b0 = p[2], b1 = p[3];
                const float ra = rsqrtf((((a0[0] + a0[1]) + (a0[2] + a0[3])) + ((a1[0] + a1[1]) + (a1[2] + a1[3]))) * (1.0f / HW) + EPS);
                const float rb = rsqrtf((((b0[0] + b0[1]) + (b0[2] + b0[3])) + ((b1[0] + b1[1]) + (b1[2] + b1[3]))) * (1.0f / HW) + EPS);
                rab[i * 256 + tid] = (f32x2){ra / rb, rb}; } }
        VM_WAIT(); __syncthreads();
        pg8::EpiOutProj E{XB, H1B, SSQ, rab};
        pg8::gemm_phase<pg8::EpiOutProj, SchedDense, true, false>(lds + RING_OFF, g, S, E);
        pg8::Gemm g2{0, 0, 256};
        SchedGH SG{(const char*)KVM, (const char*)Wxq_n, (const char*)Wxo_t, G, bx};
        EpiGH EG{GT, HT};
        g2.lda = 2 * DM; g2.ldb = DM; SchedGHk<0> S0{SG}; pg8::gemm_phase<EpiGH, SchedGHk<0>, true, false>(lds + RING_OFF, g2, S0, EG);
        g2.lda = DM; g2.ldb = 2 * DM; SchedGHk<1> S1{SG}; pg8::gemm_phase<EpiGH, SchedGHk<1>, true, false>(lds + RING_OFF, g2, S1, EG);
    }
    xcd_barrier(bar);
    if (PROBE_HI == 4) t_pb = __builtin_amdgcn_s_memrealtime();

    if (PROBE_LO == 5) t_pa = __builtin_amdgcn_s_memrealtime();
    if (PH(5))
    for (int rep_ = 0; rep_ < REPS(5); ++rep_)
    {
        PHASE_PTRS
        pg8::Gemm g{DM, DM, DM};
        SchedDense S{(const char*)H1B, (const char*)GT, M / 256, DM / 256, G, bx, (size_t)256 * DM * 2, (size_t)256 * DM * 2, (size_t)DM * DM * 2, 0};
        LAS float* r1t = (LAS float*)(lds + EXTRA_OFF + 8192);
        for (int i = 0; i < 8; ++i) { int pm, pn; if (!pg8::tile_order(i, G, bx, M / 256, DM / 256, pm, pn)) break;
            if (tid < 256) { const f32x4* sp = (const f32x4*)(SSQ + (size_t)(pm * 256 + tid) * 16); const f32x4 s0 = sp[0], s1 = sp[1], s2 = sp[2], s3 = sp[3];
                const float tot = ((s0[0] + s0[1]) + (s0[2] + s0[3])) + ((s1[0] + s1[1]) + (s1[2] + s1[3])) + ((s2[0] + s2[1]) + (s2[2] + s2[3])) + ((s3[0] + s3[1]) + (s3[2] + s3[3]));
                r1t[i * 256 + tid] = rsqrtf(tot * (1.0f / DM) + EPS) * XSC; } }
        VM_WAIT(); __syncthreads();
        pg8::EpiSoftmax E{XB, r1t, (LAS float*)(lds + EXTRA_OFF)};
        pg8::gemm_phase<pg8::EpiSoftmax, SchedDense, true, false>(lds + RING_OFF, g, S, E);
    }
    xcd_barrier(bar);
    if (PROBE_HI == 5) t_pb = __builtin_amdgcn_s_memrealtime();

    if (PROBE_LO == 6) t_pa = __builtin_amdgcn_s_memrealtime();
    if (PH(6))
    {
        PHASE_PTRS
        pg8::Gemm g{DM, DM, DM};
        SchedDense S{(const char*)XB, (const char*)HT, M / 256, DM / 256, G, bx, (size_t)256 * DM * 2, (size_t)256 * DM * 2, (size_t)DM * DM * 2, 0};
        pg8::EpiResidBf16 E{H1B};
        pg8::gemm_phase<pg8::EpiResidBf16, SchedDense, true, false>(lds + RING_OFF, g, S, E);
    }
    xcd_barrier(bar);
    if (PROBE_HI == 6) t_pb = __builtin_amdgcn_s_memrealtime();

    if (PROBE_LO == 7) t_pa = __builtin_amdgcn_s_memrealtime();
    if (PH(7))
    {
        PHASE_PTRS
        LAS bf16_t* wBh = (LAS bf16_t*)(lds + RING_OFF); LAS bf16_t* wBl = wBh + 20 * DM;
        { const f32x4* wg4 = (const f32x4*)ARGP(w_rg); const f32x4* we4 = (const f32x4*)ARGP(w_re); const float* gf = ARGP(norm_ffn);
          f32x4 ga[2], ea[2][4]; float gk[2];
#pragma unroll
          for (int q = 0; q < 2; ++q) { const int k = tid + 512 * q; ga[q] = wg4[k]; gk[q] = gf[k];
#pragma unroll
              for (int c = 0; c < 4; ++c) ea[q][c] = we4[k * 4 + c]; }
#pragma unroll
          for (int q = 0; q < 2; ++q) { const int k = tid + 512 * q;
#pragma unroll
              for (int j = 0; j < 4; ++j) { { const float v = ga[q][j] * gk[q]; const unsigned hi_ = cvt_pk_bf16(v, 0.f) & 0xffffu; wBh[j * DM + k] = (bf16_t)hi_; wBl[j * DM + k] = (bf16_t)(cvt_pk_bf16(v - __uint_as_float(hi_ << 16), 0.f) & 0xffffu); }
#pragma unroll
                  for (int c = 0; c < 4; ++c) { const float v = ea[q][c][j] * gk[q]; const unsigned hi_ = cvt_pk_bf16(v, 0.f) & 0xffffu; const int col = 4 + 4 * c + j; wBh[col * DM + k] = (bf16_t)hi_; wBl[col * DM + k] = (bf16_t)(cvt_pk_bf16(v - __uint_as_float(hi_ << 16), 0.f) & 0xffffu); } } } }
        LAS int* dec_e = (LAS int*)(lds + RING_OFF + 81920); LAS float* dec_w = (LAS float*)(lds + RING_OFF + 81920 + 2048); LAS int* dec_r = (LAS int*)(lds + RING_OFF + 81920 + 4096);
        LAS int* hist = (LAS int*)(lds + RING_OFF + 81920 + 6144); LAS int* ebase = hist + 16; LAS float* dec_v = (LAS float*)(lds + RING_OFF + 81920 + 8192);
        if (tid < 16) hist[tid] = 0;
        __syncthreads();
        const float brg0 = ARGP(b_rg)[0], brg1 = ARGP(b_rg)[1], brg2 = ARGP(b_rg)[2], brg3 = ARGP(b_rg)[3]; const float* bre = ARGP(b_re);
        const int tok = lane & 31, half = lane >> 5, jcol = tok < 20 ? tok : 19;
        for (int it = 0; it * NGW < M / 32; ++it) {
            const int T = gw + it * NGW; const bool act = T < M / 32; const int r0 = act ? 32 * T : 0;
            const bf16_t* rowp = H1B + (size_t)(r0 + tok) * DM + 512 * half;
            const LAS bf16_t* wph = wBh + jcol * DM + 512 * half; const LAS bf16_t* wpl = wBl + jcol * DM + 512 * half;
            f32x16 ah0 = f32x16{}, ah1 = f32x16{}, al0 = f32x16{}, al1 = f32x16{}; float ssq = 0.f;
#pragma unroll 4
            for (int sidx = 0; sidx < 64; sidx += 2) {
                const u32x4 a0 = *(const u32x4*)(rowp + 8 * sidx), a1 = *(const u32x4*)(rowp + 8 * sidx + 8);
                const bf16x8 wh0 = *(const LAS bf16x8*)(wph + 8 * sidx), wl0 = *(const LAS bf16x8*)(wpl + 8 * sidx), wh1 = *(const LAS bf16x8*)(wph + 8 * sidx + 8), wl1 = *(const LAS bf16x8*)(wpl + 8 * sidx + 8);
                ah0 = MFMA32(wh0, __builtin_bit_cast(bf16x8, a0), ah0); al0 = MFMA32(wl0, __builtin_bit_cast(bf16x8, a0), al0);
                ah1 = MFMA32(wh1, __builtin_bit_cast(bf16x8, a1), ah1); al1 = MFMA32(wl1, __builtin_bit_cast(bf16x8, a1), al1);
                ssq += (bf16lo(a0.x) * bf16lo(a0.x) + bf16hi(a0.x) * bf16hi(a0.x)) + (bf16lo(a0.y) * bf16lo(a0.y) + bf16hi(a0.y) * bf16hi(a0.y)) + (bf16lo(a0.z) * bf16lo(a0.z) + bf16hi(a0.z) * bf16hi(a0.z)) + (bf16lo(a0.w) * bf16lo(a0.w) + bf16hi(a0.w) * bf16hi(a0.w));
                ssq += (bf16lo(a1.x) * bf16lo(a1.x) + bf16hi(a1.x) * bf16hi(a1.x)) + (bf16lo(a1.y) * bf16lo(a1.y) + bf16hi(a1.y) * bf16hi(a1.y)) + (bf16lo(a1.z) * bf16lo(a1.z) + bf16hi(a1.z) * bf16hi(a1.z)) + (bf16lo(a1.w) * bf16lo(a1.w) + bf16hi(a1.w) * bf16hi(a1.w));
            }
            const float rinv = rsqrtf((att::swap_lo(ssq) + att::swap_hi(ssq)) * (1.0f / DM) + EPS);
            float lg[20];
#pragma unroll
            for (int r = 0; r < 12; ++r) { const float c = (ah0[r] + ah1[r]) + (al0[r] + al1[r]); auto rr = __builtin_amdgcn_permlane32_swap(__float_as_uint(c), __float_as_uint(c), false, false);
                const int jl = (r & 3) + 8 * (r >> 2); lg[jl] = __uint_as_float(rr[0]) * rinv; if (r < 8) lg[jl + 4] = __uint_as_float(rr[1]) * rinv; }
            float g0 = lg[0] + brg0, g1 = lg[1] + brg1, g2 = lg[2] + brg2, g3 = lg[3] + brg3;
            int gi = 0; float gm = g0; if (g1 > gm) { gm = g1; gi = 1; } if (g2 > gm) { gm = g2; gi = 2; } if (g3 > gm) { gm = g3; gi = 3; }
            const float gval = 1.0f / (expf(g0 - gm) + expf(g1 - gm) + expf(g2 - gm) + expf(g3 - gm));
            float el[4];
#pragma unroll
            for (int j = 0; j < 4; ++j) { const float e0 = lg[4 + j], e1 = lg[8 + j], e2 = lg[12 + j], e3 = lg[16 + j]; el[j] = ((gi == 0) ? e0 : (gi == 1) ? e1 : (gi == 2) ? e2 : e3) + bre[gi * 4 + j]; }
            int i0 = 0; float m0 = el[0];
#pragma unroll
            for (int j = 1; j < 4; ++j) if (el[j] > m0) { m0 = el[j]; i0 = j; }
            int i1 = -1; float m1 = -3.0e38f;
#pragma unroll
            for (int j = 0; j < 4; ++j) if (j != i0 && el[j] > m1) { m1 = el[j]; i1 = j; }
            const float w0 = 1.0f / (1.0f + expf(m1 - m0)), w1 = 1.0f - w0;
            if (act) { const int e = gi * 4 + (half == 0 ? i0 : i1); const float w = gval * (half == 0 ? w0 : w1);
                const int idx = (wave * 32 + tok) * 2 + half; dec_e[idx] = e; dec_w[idx] = w; dec_v[idx] = rinv; dec_r[idx] = __hip_atomic_fetch_add(hist + e, 1, __ATOMIC_RELAXED, __HIP_MEMORY_SCOPE_WORKGROUP); }
            __syncthreads();
            if (tid < 16) { const int n = hist[tid]; ebase[tid] = n ? (int)__hip_atomic_fetch_add(ctl + CW_CNT + 64 * tid, (unsigned)n, __ATOMIC_RELAXED, __HIP_MEMORY_SCOPE_AGENT) : 0; }
            __syncthreads();
            if (act) { const int row = r0 + (lane >> 1), idx = wave * 64 + lane; const int e = dec_e[idx], pos = ebase[e] + dec_r[idx];
                LIST[(size_t)e * M + pos] = row; R2S[(size_t)e * M + pos] = dec_v[idx]; TOKSLOT[(size_t)row * 2 + (lane & 1)] = (e << 20) | pos; TOKW[(size_t)row * 2 + (lane & 1)] = dec_w[idx]; }
            __syncthreads();
            if (tid < 16) hist[tid] = 0;
            __syncthreads();
        }
    }
    xcd_barrier(bar);
    if (PROBE_HI == 7) t_pb = __builtin_amdgcn_s_memrealtime();

    if (PROBE_LO == 8) t_pa = __builtin_amdgcn_s_memrealtime();
    if (PH(8))
    for (int rep_ = 0; rep_ < REPS(8); ++rep_)
    {
        PHASE_PTRS
        pg8::Gemm g{DM, DM, DM};
        LAS int* tbl = (LAS int*)(lds + EXTRA_OFF + 8192); moe_table(tbl, ctl);
        SchedMoe S; S.A = (const char*)H1B; S.W = (const char*)Wgu_t; S.list = LIST; S.tbl = tbl; S.G = G; S.c = bx; S.NPN = 2; S.w_exp = (size_t)512 * DM * 2; S.w_tile = (size_t)256 * DM * 2; S.a_tile = 0; S.ocol_w = 128;
        pg8::EpiSwiglu E{HID, R2S, LIST};
        pg8::gemm_phase<pg8::EpiSwiglu, SchedMoe, true, true>(lds + RING_OFF, g, S, E);
    }
    xcd_barrier(bar);
    if (PROBE_HI == 8) t_pb = __builtin_amdgcn_s_memrealtime();

    if (PROBE_LO == 9) t_pa = __builtin_amdgcn_s_memrealtime();
    if (PH(9))
    for (int rep_ = 0; rep_ < REPS(9); ++rep_)
    {
        PHASE_PTRS
        pg8::Gemm g{DFF, DFF, DFF};
        LAS int* tbl = (LAS int*)(lds + EXTRA_OFF + 8192);
        SchedMoe S; S.A = (const char*)HID; S.W = (const char*)Wd_t; S.list = LIST; S.tbl = tbl; S.G = G; S.c = bx; S.NPN = 4; S.w_exp = (size_t)DM * DFF * 2; S.w_tile = (size_t)256 * DFF * 2; S.a_tile = (size_t)256 * DFF * 2; S.ocol_w = 256;
        pg8::EpiBf16 E{YB, DM, nullptr, 0, 1.f, 1.f, nullptr, nullptr};
        pg8::gemm_phase<pg8::EpiBf16, SchedMoe, true, false>(lds + RING_OFF, g, S, E);
    }
    xcd_barrier(bar);
    if (PROBE_HI == 9) t_pb = __builtin_amdgcn_s_memrealtime();

    if (PROBE_LO == 10) t_pa = __builtin_amdgcn_s_memrealtime();
    if (PH(10))
    {
        PHASE_PTRS
        const LAS int* tb = (const LAS int*)(lds + EXTRA_OFF + 8192);
        const f32x4* gp = (const f32x4*)ARGP(norm_final) + lane;
        int sl0 = 0, sl1 = 0; float sw0 = 0.f, sw1 = 0.f;
        u32x2 ya_n[4], yb_n[4], hh_n[4]; float w0_n = 0.f, w1_n = 0.f;
#define P10_SLOTS(rw) do { sl0 = TOKSLOT[(size_t)(rw) * 2]; sl1 = TOKSLOT[(size_t)(rw) * 2 + 1]; sw0 = TOKW[(size_t)(rw) * 2]; sw1 = TOKW[(size_t)(rw) * 2 + 1]; } while (0)
#define P10_DATA(rw) do { const int r0_ = tb[sl0 >> 20] * 256 + (sl0 & 0xfffff), r1_ = tb[sl1 >> 20] * 256 + (sl1 & 0xfffff); w0_n = sw0; w1_n = sw1; \
        const u32x2* y0_ = (const u32x2*)(YB + (size_t)r0_ * DM) + lane; const u32x2* y1_ = (const u32x2*)(YB + (size_t)r1_ * DM) + lane; const u32x2* h_ = (const u32x2*)(H1B + (size_t)(rw) * DM) + lane; \
        _Pragma("unroll") for (int j = 0; j < 4; ++j) { ya_n[j] = y0_[64 * j]; yb_n[j] = y1_[64 * j]; hh_n[j] = h_[64 * j]; } } while (0)
        if (gw < M) { P10_SLOTS(gw); P10_DATA(gw); if (gw + NGW < M) P10_SLOTS(gw + NGW); }
        for (int row = gw; row < M; row += NGW) {
            u32x2 ya[4], yb[4], hh[4]; const float w0 = w0_n, w1 = w1_n;
#pragma unroll
            for (int j = 0; j < 4; ++j) { ya[j] = ya_n[j]; yb[j] = yb_n[j]; hh[j] = hh_n[j]; }
            if (row + NGW < M) { P10_DATA(row + NGW); if (row + 2 * NGW < M) P10_SLOTS(row + 2 * NGW); }
            f32x4* hr = (f32x4*)(out + (size_t)row * DM) + lane;
            f32x4 v[4]; float s = 0.f;
#pragma unroll
            for (int j = 0; j < 4; ++j) { const u32x2 a = ya[j], b = yb[j]; const u32x2 hx = hh[j]; f32x4 h = {bf16lo(hx.x), bf16hi(hx.x), bf16lo(hx.y), bf16hi(hx.y)};
                h[0] += w0 * bf16lo(a.x) + w1 * bf16lo(b.x); h[1] += w0 * bf16hi(a.x) + w1 * bf16hi(b.x); h[2] += w0 * bf16lo(a.y) + w1 * bf16lo(b.y); h[3] += w0 * bf16hi(a.y) + w1 * bf16hi(b.y);
                v[j] = h; s += (h[0] * h[0] + h[1] * h[1]) + (h[2] * h[2] + h[3] * h[3]); }
            const float rinv = rsqrtf(wave_sum(s) * (1.0f / DM) + EPS);
#pragma unroll
            for (int j = 0; j < 4; ++j) __builtin_nontemporal_store(v[j] * rinv * gp[64 * j], hr + 64 * j);
        }
#undef P10_SLOTS
#undef P10_DATA
    }
    if (PROBE_LO >= 0) {
        if (PROBE_HI == 10) t_pb = __builtin_amdgcn_s_memrealtime();
        if (blockIdx.x == 0 && threadIdx.x == 0) { const unsigned long long t0 = __builtin_amdgcn_s_memrealtime(), span = 2 * (t_pb - t_pa);
            while (__builtin_amdgcn_s_memrealtime() - t0 < span) __builtin_amdgcn_s_sleep(8); }
    }
}

extern "C" void kernel_launch(void* const* d_in, const int* in_sizes, int n_in, void* d_out, int out_size, void* d_ws, size_t ws_size, hipStream_t stream) {
    static int grid = 0;
    if (grid == 0) {
        if (n_in != 22 || in_sizes[0] != M * DM || out_size != M * DM || ws_size < WS_END) { fprintf(stderr, "kernel_launch: unexpected shapes (n_in %d, in0 %d, out %d, ws %zu)\n", n_in, n_in > 0 ? in_sizes[0] : -1, out_size, ws_size); grid = -1; return; }
        int dev = 0, cus = 0, per_cu = 0;
        if (hipGetDevice(&dev) != hipSuccess || hipDeviceGetAttribute(&cus, hipDeviceAttributeMultiprocessorCount, dev) != hipSuccess) { grid = -1; return; }
        if (hipFuncSetAttribute((const void*)hymba_fwd, hipFuncAttributeMaxDynamicSharedMemorySize, LDS_BYTES) != hipSuccess) { fprintf(stderr, "kernel_launch: hipFuncSetAttribute failed\n"); grid = -1; return; }
        if (hipOccupancyMaxActiveBlocksPerMultiprocessor(&per_cu, (const void*)hymba_fwd, NWAVES * 64, LDS_BYTES) != hipSuccess || per_cu < 1) { fprintf(stderr, "kernel_launch: occupancy query reports %d\n", per_cu); }
        (void)hipGetLastError();
        grid = cus;
    }
    if (grid < 0) return;
    (void)hipMemsetAsync((char*)d_ws + WS_CTL, 0, CTL_ZERO_BYTES, stream);
    Args a{};
    const float** p = (const float**)&a;
    for (int i = 0; i < 22; ++i) p[i] = (const float*)d_in[i];
    a.out = (float*)d_out; a.ws = (unsigned char*)d_ws;
    hipLaunchKernelGGL(hymba_fwd, dim3(grid), dim3(NWAVES * 64), LDS_BYTES, stream, a);
}
```

```cpp
#include <hip/hip_runtime.h>
#include <hip/hip_bf16.h>
#include <cstdio>
#include <cstdint>

#define LAS __attribute__((address_space(3)))
#define GAS __attribute__((address_space(1)))
typedef unsigned short bf16_t;
typedef short bf16x8 __attribute__((ext_vector_type(8)));
typedef short s16x4 __attribute__((ext_vector_type(4)));
typedef float f32x4 __attribute__((ext_vector_type(4)));
typedef float f32x2 __attribute__((ext_vector_type(2)));
typedef float f32x16 __attribute__((ext_vector_type(16)));
typedef unsigned u32x4 __attribute__((ext_vector_type(4)));
typedef unsigned u32x2 __attribute__((ext_vector_type(2)));
typedef __bf16 bf16x2_t __attribute__((ext_vector_type(2)));

constexpr int BATCH = 8, SEQ = 8192, DM = 1024, M = BATCH * SEQ;
constexpr int NH = 8, HD = 64, HW = NH * HD;
constexpr int NPROJ = 3 * HW * 2;
constexpr int WIN_LD = NPROJ + NH;
constexpr int NMEM = 256, XH = 4, XD = 256, MEMROWS = BATCH * NMEM;
constexpr int NEXP = 16, DFF = 256;
constexpr float EPS = 1e-6f;
constexpr float LOG2E = 1.4426950408889634f;
constexpr float C2 = 0.125f * LOG2E;
constexpr float XSC = 0.0625f * LOG2E;
constexpr float P_SCALE = 128.0f;
constexpr float WGU_SCALE = 32.0f;
constexpr float WD_SCALE = 16.0f;
constexpr float SB_EXIT = -48.0f;

constexpr size_t MiB = 1u << 20;
constexpr size_t WS_CTL = 0, CTL_ZERO_BYTES = 128 * 1024;
constexpr size_t WS_WIN = 1 * MiB;
constexpr size_t WS_WOUT = 7 * MiB;
constexpr size_t WS_WXQ = 9 * MiB;
constexpr size_t WS_WXKV = 11 * MiB;
constexpr size_t WS_WXO = 15 * MiB;
constexpr size_t WS_WGU = 17 * MiB;
constexpr size_t WS_WD = 33 * MiB;
constexpr size_t WS_RX = 41 * MiB;
constexpr size_t WS_RMEM = WS_RX + 256 * 1024;
constexpr size_t WS_R2 = WS_RX + 512 * 1024;
constexpr size_t WS_LF = 42 * MiB;
constexpr size_t WS_C2 = 44 * MiB;
constexpr size_t WS_SSQ = 46 * MiB;
constexpr size_t WS_TOKSLOT = 50 * MiB;
constexpr size_t WS_TOKW = 51 * MiB;
constexpr size_t WS_LIST = 52 * MiB;
constexpr size_t WS_MEMB = 56 * MiB;
constexpr size_t WS_KVM = 60 * MiB;
constexpr size_t WS_GT = 68 * MiB;
constexpr size_t WS_HT = 84 * MiB;
constexpr size_t WS_KX = 100 * MiB;
constexpr size_t WS_HS = 108 * MiB;
constexpr size_t WS_XB = 128 * MiB;
constexpr size_t WS_QKV = 256 * MiB;
constexpr size_t WS_H1B = 256 * MiB, WS_U2B = 384 * MiB, WS_HID = 512 * MiB;
constexpr size_t WS_H1F8 = 384 * MiB, WS_H2F8 = 448 * MiB;
constexpr size_t WS_O = 640 * MiB;
constexpr size_t WS_Y = 704 * MiB;
constexpr size_t WS_END = 1024 * MiB;
constexpr size_t QKV_STRIDE = (size_t)M * HW;
constexpr int MAXTILES = M * 2 / 256 + NEXP;
static_assert(WS_Y + (size_t)MAXTILES * 256 * 1024 * 2 <= WS_END, "ws map");
static_assert(WS_HID + (size_t)MAXTILES * 256 * 256 * 2 <= WS_O, "ws map");
constexpr int CW_BAR = 4096;
constexpr int CW_SBQ = 20736;
constexpr int CW_KN = 20480;
constexpr int CW_CNT = 16384;

constexpr int RING_OFF = 0, RING_BYTES = 131072;
constexpr int EXTRA_OFF = 131072, EXTRA_BYTES = 16384;
constexpr int MISC_OFF = EXTRA_OFF + EXTRA_BYTES;
constexpr int LDS_BYTES = MISC_OFF + 1024;
constexpr int NWAVES = 8;
#ifndef PHASE_MASK
#define PHASE_MASK 0x7ff
#endif
#define PH(n) ((PHASE_MASK >> (n)) & 1)
#ifndef PROBE_LO
#define PROBE_LO -1
#endif
#ifndef PROBE_HI
#define PROBE_HI -1
#endif
#ifndef FOX_V2
#define FOX_V2 1
#endif
#ifndef REP_MASK
#define REP_MASK 0
#endif
#define REPS(n) (1 + ((REP_MASK >> (n)) & 1))
#ifndef REP_FOX
#define REP_FOX 1
#endif
#ifndef REP_SB
#define REP_SB 1
#endif

__device__ __forceinline__ unsigned cvt_pk_bf16(float lo, float hi) { f32x2 v = {lo, hi}; bf16x2_t b = __builtin_convertvector(v, bf16x2_t); return __builtin_bit_cast(unsigned, b); }
__device__ __forceinline__ unsigned cvt4_fp8(float a, float b, float c, float d) { int w = 0; w = __builtin_amdgcn_cvt_pk_fp8_f32(a, b, w, false); w = __builtin_amdgcn_cvt_pk_fp8_f32(c, d, w, true); return (unsigned)w; }
__device__ __forceinline__ float bf16lo(unsigned u) { return __uint_as_float(u << 16); }
__device__ __forceinline__ float bf16hi(unsigned u) { return __uint_as_float(u & 0xffff0000u); }
#define DPP_ADD(v, CTRL) v += __builtin_bit_cast(float, __builtin_amdgcn_update_dpp(0, __builtin_bit_cast(int, v), CTRL, 0xf, 0xf, true))
__device__ __forceinline__ float wave_sum(float v) {
    DPP_ADD(v, 0xB1); DPP_ADD(v, 0x4E); DPP_ADD(v, 0x141); DPP_ADD(v, 0x140);
    const int iv = __builtin_bit_cast(int, v);
    return (__builtin_bit_cast(float, __builtin_amdgcn_readlane(iv, 0)) + __builtin_bit_cast(float, __builtin_amdgcn_readlane(iv, 16))) +
           (__builtin_bit_cast(float, __builtin_amdgcn_readlane(iv, 32)) + __builtin_bit_cast(float, __builtin_amdgcn_readlane(iv, 48)));
}
#define LDS_WAIT() asm volatile("s_waitcnt lgkmcnt(0)" ::: "memory")
#define VM_WAIT() asm volatile("s_waitcnt vmcnt(0)" ::: "memory")

namespace pg8 {
constexpr int BM = 256, BK = 64, HALF = 128, HTB = HALF * BK * 2, STAGE_BYTES = 8 * HTB, NXCD = 8, WGM = 8;
__host__ __device__ __forceinline__ int lds_byte(int r, int c) { const int st = (r >> 4) * 2 + (c >> 5), rr = r & 15, cc = c & 31, ob = rr * 64 + cc * 2; return st * 1024 + (ob ^ (((ob >> 9) & 1) << 5)); }
__host__ __device__ __forceinline__ void stage_rc(int b, int& R, int& C) { const int st = b / 1024, sb = b % 1024, swz = sb ^ (((sb >> 9) & 1) << 5); R = (st >> 1) * 16 + swz / 64; C = (st & 1) * 32 + (swz % 64) / 2; }
__host__ __device__ __forceinline__ int perm32(int rho) { const int n = rho >> 4, i = rho & 15; return 8 * (i >> 2) + 4 * n + (i & 3); }

struct Unit { const char* a; const char* b; int orow, ocol, aux; const int* rows; int nvalid; int seq; };
struct Gemm { int lda, ldb, K; };

__device__ __forceinline__ bool tile_order(int i, int G, int c, int nM, int nN, int& pm, int& pn) {
    const int nwg = nM * nN; const long L = (long)i * G + c; if (L >= nwg) return false;
    int wgid = (int)L; { const int q = nwg / NXCD, r = nwg % NXCD, xcd = wgid % NXCD, off = wgid / NXCD; wgid = (xcd < r ? xcd * (q + 1) : r * (q + 1) + (xcd - r) * q) + off; }
    const int nig = WGM * nN, gid = wgid / nig, fm = gid * WGM, gsz = (nM - fm) < WGM ? (nM - fm) : WGM;
    pm = fm + ((wgid % nig) % gsz); pn = (wgid % nig) / gsz; return true;
}

typedef int v8i32 __attribute__((ext_vector_type(8)));
template <class Epi, class Sched, bool ALIGN_EPI, bool GATHER, bool FP8 = false>
__device__ __forceinline__ void gemm_phase(LAS unsigned char* lds, const Gemm g, const Sched& S, const Epi& E) {
    int tid = threadIdx.x; asm volatile("" : "+v"(tid));
    const int wid = __builtin_amdgcn_readfirstlane(tid >> 6), lane = tid & 63, wr = wid >> 2, wc = wid & 3, fr = lane & 15, fq = lane >> 4;
    constexpr int ESZ = FP8 ? 1 : 2;
    const int K = g.K, nt = K / (FP8 ? 2 * BK : BK);
    unsigned voffA[2], voffB[2]; int RA[2], CA[2];
#pragma unroll
    for (int i = 0; i < 2; ++i) { int R, C; stage_rc(tid * 16 + i * 8192, R, C); const int Rb = (R & ~31) + perm32(R & 31);
        RA[i] = R; CA[i] = C; voffA[i] = (unsigned)(R * g.lda * ESZ + C * 2); voffB[i] = (unsigned)(Rb * g.ldb * ESZ + C * 2); }
    const size_t kstep = (size_t)(BK * 2);
    const size_t hstepA = (size_t)HALF * g.lda * ESZ, hstepB = (size_t)HALF * g.ldb * ESZ;
    const unsigned ldsw = (unsigned)wid * 1024u;
    const int aoff = lds_byte(wr * 64 + fr, FP8 ? fq * 16 : fq * 8), boff = lds_byte(wc * 32 + fr, FP8 ? fq * 16 : fq * 8);
    constexpr int KOFF = FP8 ? 16 : 1024;
#define PG8_SA(b, h) (((b) * 2 + (h)) * HTB)
#define PG8_SB(b, h) ((4 + (b) * 2 + (h)) * HTB)
#define PG8_STAGE2(bufoff, gbase, v0, v1) do { \
        __builtin_amdgcn_global_load_lds((const unsigned*)((const char*)(gbase) + (v0)), (LAS unsigned*)(lds + (bufoff) + ldsw), 16, 0, 0); \
        __builtin_amdgcn_global_load_lds((const unsigned*)((const char*)(gbase) + (v1)), (LAS unsigned*)(lds + (bufoff) + ldsw + 8192), 16, 0, 0); } while (0)
#define PG8_STAGEB(bufoff, gbase) PG8_STAGE2(bufoff, gbase, voffB[0], voffB[1])
#define PG8_STAGEA(bufoff, kptr, h, NX) do { if constexpr (GATHER) { const unsigned v0_ = (NX) ? gvn[h][0] : gvc[h][0], v1_ = (NX) ? gvn[h][1] : gvc[h][1]; PG8_STAGE2(bufoff, kptr, v0_, v1_); } \
        else { PG8_STAGE2(bufoff, (kptr) + (h) * hstepA, voffA[0], voffA[1]); } } while (0)
#define PG8_LDA(dst, b, h) do { _Pragma("unroll") for (int m = 0; m < 4; ++m) _Pragma("unroll") for (int k = 0; k < 2; ++k) dst[m][k] = *(const LAS bf16x8*)(lds + PG8_SA(b, h) + aoff + m * 2048 + k * KOFF); } while (0)
#define PG8_LDB(dst, b, h) do { _Pragma("unroll") for (int n = 0; n < 2; ++n) _Pragma("unroll") for (int k = 0; k < 2; ++k) dst[n][k] = *(const LAS bf16x8*)(lds + PG8_SB(b, h) + boff + n * 2048 + k * KOFF); } while (0)
#define PG8_CAT(x) __builtin_shufflevector(__builtin_bit_cast(f32x4, (x)[0]), __builtin_bit_cast(f32x4, (x)[1]), 0, 1, 2, 3, 4, 5, 6, 7)
#define PG8_MMA(ai, bj, At, Bt) do { __builtin_amdgcn_s_setprio(1); _Pragma("unroll") for (int m = 0; m < 4; ++m) _Pragma("unroll") for (int n = 0; n < 2; ++n) { \
        if constexpr (FP8) { acc[ai][bj][m][n] = __builtin_amdgcn_mfma_scale_f32_16x16x128_f8f6f4(__builtin_bit_cast(v8i32, PG8_CAT(Bt[n])), __builtin_bit_cast(v8i32, PG8_CAT(At[m])), acc[ai][bj][m][n], 0, 0, 0, 0x7F7F7F7F, 0, 0x7F7F7F7F); } \
        else { _Pragma("unroll") for (int k = 0; k < 2; ++k) acc[ai][bj][m][n] = __builtin_amdgcn_mfma_f32_16x16x32_bf16(Bt[n][k], At[m][k], acc[ai][bj][m][n], 0, 0, 0); } } \
        _Pragma("unroll") for (int m = 0; m < 4; ++m) _Pragma("unroll") for (int n = 0; n < 2; ++n) asm volatile("" : "+v"(acc[ai][bj][m][n]));     \
        __builtin_amdgcn_s_setprio(0); } while (0)
#define PG8_WAIT_V(n) asm volatile("s_waitcnt vmcnt(" #n ")" ::: "memory")
#define PG8_WAIT_L(n) asm volatile("s_waitcnt lgkmcnt(" #n ")" ::: "memory")
#define PG8_BAR __builtin_amdgcn_s_barrier()
#define PG8_SCHED __builtin_amdgcn_sched_barrier(0)
#define PG8_GATHER_OFFS(dst, u) do { _Pragma("unroll") for (int h_ = 0; h_ < 2; ++h_) _Pragma("unroll") for (int i_ = 0; i_ < 2; ++i_) { const int r_ = h_ * HALF + RA[i_]; \
        const int idx_ = (u).rows[r_ < (u).nvalid ? r_ : 0]; dst[h_][i_] = (unsigned)(idx_ * g.lda * ESZ + CA[i_] * 2); } } while (0)
    Unit cur, nxt; int ui = 0;
    if (!S.next(0, cur)) return;
    cur.seq = 0;
    unsigned gvc[2][2] = {{0u, 0u}, {0u, 0u}}, gvn[2][2] = {{0u, 0u}, {0u, 0u}};
    if constexpr (GATHER) { PG8_GATHER_OFFS(gvc, cur); }
    f32x4 acc[2][2][4][2];
#pragma unroll
    for (int a = 0; a < 2; ++a)
#pragma unroll
        for (int b = 0; b < 2; ++b)
#pragma unroll
            for (int m = 0; m < 4; ++m)
#pragma unroll
                for (int n = 0; n < 2; ++n) acc[a][b][m][n] = (f32x4){0.f, 0.f, 0.f, 0.f};
    bf16x8 At[4][2], B0[2][2], B1[2][2];
    const char* cA = cur.a; const char* cB = cur.b;
    PG8_STAGEB(PG8_SB(0, 0), cB); PG8_STAGEB(PG8_SB(0, 1), cB + hstepB); PG8_STAGEA(PG8_SA(0, 0), cA, 0, false); PG8_STAGEA(PG8_SA(0, 1), cA, 1, false);
    if (wr == 1) PG8_BAR;
    PG8_WAIT_V(2); PG8_BAR;
    PG8_STAGEB(PG8_SB(1, 0), cB + kstep); PG8_STAGEA(PG8_SA(1, 0), cA + kstep, 0, false); PG8_STAGEB(PG8_SB(1, 1), cB + hstepB + kstep);
    PG8_WAIT_V(6); PG8_BAR;
    for (;;) {
        const bool has_next = S.next(ui + 1, nxt); nxt.seq = ui + 1;
        const char* nA = has_next ? nxt.a : cA; const char* nB = has_next ? nxt.b : cB;
        if constexpr (GATHER) { if (has_next) { PG8_GATHER_OFFS(gvn, nxt); } else { gvn[0][0] = gvc[0][0]; gvn[0][1] = gvc[0][1]; gvn[1][0] = gvc[1][0]; gvn[1][1] = gvc[1][1]; } }
#pragma unroll 1
        for (int t = 0; t < nt; t += 2) {
            const bool last = (t == nt - 2);
            const char* a1 = cA + (size_t)(t + 1) * kstep;
            const char* a2 = last ? nA : cA + (size_t)(t + 2) * kstep; const char* b2 = last ? nB : cB + (size_t)(t + 2) * kstep;
            const char* a3 = a2 + kstep; const char* b3 = b2 + kstep;
            PG8_LDB(B0, 0, 0); PG8_LDB(B1, 0, 1); PG8_SCHED; PG8_LDA(At, 0, 0); PG8_STAGEA(PG8_SA(1, 1), a1, 1, false);
            PG8_WAIT_V(8); PG8_WAIT_L(0); PG8_BAR; PG8_MMA(0, 0, At, B0); PG8_MMA(0, 1, At, B1); PG8_BAR; PG8_SCHED;
            PG8_LDA(At, 0, 1); PG8_STAGEB(PG8_SB(0, 0), b2); PG8_STAGEB(PG8_SB(0, 1), b2 + hstepB); PG8_STAGEA(PG8_SA(0, 0), a2, 0, last);
            PG8_WAIT_V(8); PG8_WAIT_L(0); PG8_BAR; PG8_MMA(1, 0, At, B0); PG8_MMA(1, 1, At, B1); PG8_BAR; PG8_SCHED;
            PG8_LDB(B0, 1, 0); PG8_LDB(B1, 1, 1); PG8_SCHED; PG8_LDA(At, 1, 0); PG8_STAGEA(PG8_SA(0, 1), a2, 1, last);
            PG8_WAIT_V(8); PG8_WAIT_L(0); PG8_BAR; PG8_MMA(0, 0, At, B0); PG8_MMA(0, 1, At, B1); PG8_BAR; PG8_SCHED;
            PG8_LDA(At, 1, 1); PG8_STAGEB(PG8_SB(1, 0), b3); PG8_STAGEB(PG8_SB(1, 1), b3 + hstepB); PG8_STAGEA(PG8_SA(1, 0), a3, 0, last);
            PG8_WAIT_V(8); PG8_WAIT_L(0); PG8_BAR; PG8_MMA(1, 0, At, B0); PG8_MMA(1, 1, At, B1); PG8_BAR; PG8_SCHED;
            if constexpr (Epi::HAS_MID) { if (t == (nt >> 1) - 2) { int fr3 = fr, fq3 = fq; asm volatile("" : "+v"(fr3), "+v"(fq3)); E.mid(acc, cur, wr, wc, fr3, fq3); } }
        }
        if constexpr (ALIGN_EPI) { if (wr == 0) PG8_BAR; }
        { int fr2 = fr, fq2 = fq; asm volatile("" : "+v"(fr2), "+v"(fq2));
          E(acc, cur, wr, wc, fr2, fq2); }
        if (!has_next) break;
#pragma unroll
        for (int a = 0; a < 2; ++a)
#pragma unroll
            for (int b = 0; b < 2; ++b)
#pragma unroll
                for (int m = 0; m < 4; ++m)
#pragma unroll
                    for (int n = 0; n < 2; ++n) acc[a][b][m][n] = (f32x4){0.f, 0.f, 0.f, 0.f};
        cur = nxt; cA = nA; cB = nB; ++ui;
        if constexpr (GATHER) { gvc[0][0] = gvn[0][0]; gvc[0][1] = gvn[0][1]; gvc[1][0] = gvn[1][0]; gvc[1][1] = gvn[1][1]; }
        if constexpr (ALIGN_EPI) { if (wr == 1) PG8_BAR; }
    }
    PG8_WAIT_V(0);
    if constexpr (!ALIGN_EPI) { if (wr == 0) PG8_BAR; }
    PG8_BAR;
#undef PG8_SA
#undef PG8_SB
#undef PG8_STAGE2
#undef PG8_STAGEA
#undef PG8_STAGEB
#undef PG8_LDA
#undef PG8_LDB
#undef PG8_MMA
#undef PG8_CAT
#undef PG8_WAIT_V
#undef PG8_WAIT_L
#undef PG8_BAR
#undef PG8_SCHED
#undef PG8_GATHER_OFFS
}

#define EPI_ROW(u, ai, m) ((u).orow + (ai) * HALF + wr * 64 + (m) * 16 + fr)
#define EPI_COL(u, bj) ((u).ocol + (bj) * HALF + wc * 32 + 8 * fq)
struct EpiBf16 {
    static constexpr bool HAS_MID = false;
    bf16_t* O; int ldc; const float* rs; size_t stride; float sc0, sc3;
    unsigned* kn;
    const LAS float* rst;
    float mul;
    __device__ __forceinline__ void operator()(const f32x4 (&acc)[2][2][4][2], const Unit& u, int wr, int wc, int fr, int fq) const {
        bf16_t* base = O + (size_t)u.aux * stride;
        const float sc = ((u.aux == 0) ? sc0 : ((u.aux == 3) ? sc3 : 1.f)) * mul;
        float nmax[2] = {0.f, 0.f}; const bool dokn = kn && u.aux == 1;
#pragma unroll
        for (int ai = 0; ai < 2; ++ai)
#pragma unroll
            for (int m = 0; m < 4; ++m) { const int row = EPI_ROW(u, ai, m); const float s = (rst ? rst[u.seq * 256 + ai * HALF + wr * 64 + m * 16 + fr] : (rs ? rs[row] : 1.f)) * sc;
#pragma unroll
                for (int bj = 0; bj < 2; ++bj) { const f32x4 v0 = acc[ai][bj][m][0] * s, v1 = acc[ai][bj][m][1] * s;
                    u32x4 w; w.x = cvt_pk_bf16(v0[0], v0[1]); w.y = cvt_pk_bf16(v0[2], v0[3]); w.z = cvt_pk_bf16(v1[0], v1[1]); w.w = cvt_pk_bf16(v1[2], v1[3]);
                    *(u32x4*)(base + (size_t)row * ldc + EPI_COL(u, bj)) = w;
                    if (dokn) { float q = (v0[0] * v0[0] + v0[1] * v0[1]) + (v0[2] * v0[2] + v0[3] * v0[3]) + (v1[0] * v1[0] + v1[1] * v1[1]) + (v1[2] * v1[2] + v1[3] * v1[3]);
                        q += __shfl_xor(q, 16); q += __shfl_xor(q, 32); nmax[bj] = fmaxf(nmax[bj], q); } } }
        if (dokn) {
#pragma unroll
            for (int bj = 0; bj < 2; ++bj) { float q = nmax[bj]; q = fmaxf(q, __shfl_xor(q, 1)); q = fmaxf(q, __shfl_xor(q, 2)); q = fmaxf(q, __shfl_xor(q, 4)); q = fmaxf(q, __shfl_xor(q, 8));
                const int head = ((u.ocol + bj * HALF) >> 6) + (wc >> 1), bt = u.orow / SEQ;
                if ((fr | fq) == 0) atomicMax(kn + ((bt * NH + head) * 2 + (wc & 1)), __float_as_uint(q)); }
        }
    }
};
struct EpiResid {
    static constexpr bool HAS_MID = false;
    const float* res; float* out; bf16_t* hb; float* ssq;
    __device__ __forceinline__ void operator()(const f32x4 (&acc)[2][2][4][2], const Unit& u, int wr, int wc, int fr, int fq) const {
#pragma unroll
        for (int ai = 0; ai < 2; ++ai)
#pragma unroll
            for (int m = 0; m < 4; ++m) { const int row = EPI_ROW(u, ai, m); float q = 0.f;
#pragma unroll
                for (int bj = 0; bj < 2; ++bj) { const size_t off = (size_t)row * DM + EPI_COL(u, bj);
                    const f32x4 r0 = *(const f32x4*)(res + off), r1 = *(const f32x4*)(res + off + 4);
                    const f32x4 v0 = acc[ai][bj][m][0] + r0, v1 = acc[ai][bj][m][1] + r1;
                    *(f32x4*)(out + off) = v0; *(f32x4*)(out + off + 4) = v1;
                    q += (v0[0] * v0[0] + v0[1] * v0[1]) + (v0[2] * v0[2] + v0[3] * v0[3]) + (v1[0] * v1[0] + v1[1] * v1[1]) + (v1[2] * v1[2] + v1[3] * v1[3]);
                    if (hb) { u32x4 w; w.x = cvt_pk_bf16(v0[0], v0[1]); w.y = cvt_pk_bf16(v0[2], v0[3]); w.z = cvt_pk_bf16(v1[0], v1[1]); w.w = cvt_pk_bf16(v1[2], v1[3]); *(u32x4*)(hb + off) = w; } }
                if (ssq) { q += __shfl_xor(q, 16); q += __shfl_xor(q, 32); if (fq == 0) ssq[(size_t)row * 16 + (u.ocol >> 8) * 4 + wc] = q; } }
    }
};
struct EpiOutProj {
    static constexpr bool HAS_MID = true;
    const bf16_t* xb; bf16_t* hb; unsigned char* h8; float* ssq; const LAS f32x2* rab;
    __device__ __forceinline__ void mid(f32x4 (&acc)[2][2][4][2], const Unit& u, int wr, int wc, int fr, int fq) const {
#pragma unroll
        for (int ai = 0; ai < 2; ++ai)
#pragma unroll
            for (int m = 0; m < 4; ++m) { const float f = rab[u.seq * 256 + ai * HALF + wr * 64 + m * 16 + fr].x;
#pragma unroll
                for (int bj = 0; bj < 2; ++bj) { acc[ai][bj][m][0] *= f; acc[ai][bj][m][1] *= f; } }
    }
    __device__ __forceinline__ void operator()(const f32x4 (&acc)[2][2][4][2], const Unit& u, int wr, int wc, int fr, int fq) const {
#pragma unroll
        for (int ai = 0; ai < 2; ++ai)
#pragma unroll
            for (int m = 0; m < 4; ++m) { const int row = EPI_ROW(u, ai, m); const float rb = rab[u.seq * 256 + ai * HALF + wr * 64 + m * 16 + fr].y; float q = 0.f;
#pragma unroll
                for (int bj = 0; bj < 2; ++bj) { const size_t off = (size_t)row * DM + EPI_COL(u, bj);
                    const u32x4 xr = *(const u32x4*)(xb + off);
                    f32x4 v0 = acc[ai][bj][m][0] * rb, v1 = acc[ai][bj][m][1] * rb;
                    v0[0] += bf16lo(xr.x); v0[1] += bf16hi(xr.x); v0[2] += bf16lo(xr.y); v0[3] += bf16hi(xr.y); v1[0] += bf16lo(xr.z); v1[1] += bf16hi(xr.z); v1[2] += bf16lo(xr.w); v1[3] += bf16hi(xr.w);
                    q += (v0[0] * v0[0] + v0[1] * v0[1]) + (v0[2] * v0[2] + v0[3] * v0[3]) + (v1[0] * v1[0] + v1[1] * v1[1]) + (v1[2] * v1[2] + v1[3] * v1[3]);
                    u32x4 w; w.x = cvt_pk_bf16(v0[0], v0[1]); w.y = cvt_pk_bf16(v0[2], v0[3]); w.z = cvt_pk_bf16(v1[0], v1[1]); w.w = cvt_pk_bf16(v1[2], v1[3]); *(u32x4*)(hb + off) = w;
                    { u32x2 w8; w8.x = cvt4_fp8(v0[0], v0[1], v0[2], v0[3]); w8.y = cvt4_fp8(v1[0], v1[1], v1[2], v1[3]); *(u32x2*)(h8 + off) = w8; } }
                q += __shfl_xor(q, 16); q += __shfl_xor(q, 32); if (fq == 0) ssq[(size_t)row * 16 + (u.ocol >> 8) * 4 + wc] = q; }
    }
};
struct EpiResidBf16 {
    static constexpr bool HAS_MID = false;
    bf16_t* hb; unsigned char* h8; float mul;
    __device__ __forceinline__ void operator()(const f32x4 (&acc)[2][2][4][2], const Unit& u, int wr, int wc, int fr, int fq) const {
#pragma unroll
        for (int ai = 0; ai < 2; ++ai)
#pragma unroll
            for (int m = 0; m < 4; ++m) { const int row = EPI_ROW(u, ai, m);
#pragma unroll
                for (int bj = 0; bj < 2; ++bj) { const size_t off = (size_t)row * DM + EPI_COL(u, bj);
                    const u32x4 xr = *(const u32x4*)(hb + off);
                    f32x4 v0 = acc[ai][bj][m][0] * mul, v1 = acc[ai][bj][m][1] * mul;
                    v0[0] += bf16lo(xr.x); v0[1] += bf16hi(xr.x); v0[2] += bf16lo(xr.y); v0[3] += bf16hi(xr.y); v1[0] += bf16lo(xr.z); v1[1] += bf16hi(xr.z); v1[2] += bf16lo(xr.w); v1[3] += bf16hi(xr.w);
                    u32x4 w; w.x = cvt_pk_bf16(v0[0], v0[1]); w.y = cvt_pk_bf16(v0[2], v0[3]); w.z = cvt_pk_bf16(v1[0], v1[1]); w.w = cvt_pk_bf16(v1[2], v1[3]); *(u32x4*)(hb + off) = w;
                    if (h8) { u32x2 w8; w8.x = cvt4_fp8(v0[0], v0[1], v0[2], v0[3]); w8.y = cvt4_fp8(v1[0], v1[1], v1[2], v1[3]); *(u32x2*)(h8 + off) = w8; } } }
    }
};
struct EpiSoftmax {
    static constexpr bool HAS_MID = false;
    bf16_t* P; const LAS float* r1t; LAS float* red;
    __device__ __forceinline__ void operator()(f32x4 (&acc)[2][2][4][2], const Unit& u, int wr, int wc, int fr, int fq) const {
#pragma unroll
        for (int ai = 0; ai < 2; ++ai)
#pragma unroll
            for (int m = 0; m < 4; ++m) { const float r1 = r1t[u.seq * 256 + ai * HALF + wr * 64 + m * 16 + fr]; float a = -3.0e38f;
#pragma unroll
                for (int bj = 0; bj < 2; ++bj)
#pragma unroll
                    for (int n = 0; n < 2; ++n) { f32x4 v = acc[ai][bj][m][n] * r1; acc[ai][bj][m][n] = v; a = fmaxf(a, fmaxf(fmaxf(v[0], v[1]), fmaxf(v[2], v[3]))); }
                a = fmaxf(a, __shfl_xor(a, 16)); a = fmaxf(a, __shfl_xor(a, 32));
                if (fq == 0) red[(ai * HALF + wr * 64 + m * 16 + fr) * 4 + wc] = a; asm volatile("" ::: "memory"); }
        LDS_WAIT(); __builtin_amdgcn_s_barrier(); asm volatile("" ::: "memory");
#pragma unroll
        for (int ai = 0; ai < 2; ++ai)
#pragma unroll
            for (int m = 0; m < 4; ++m) { const int rl = ai * HALF + wr * 64 + m * 16 + fr; const f32x4 mm = *(const LAS f32x4*)(red + rl * 4);
                const float a = fmaxf(fmaxf(mm[0], mm[1]), fmaxf(mm[2], mm[3])); float s = 0.f;
#pragma unroll
                for (int bj = 0; bj < 2; ++bj)
#pragma unroll
                    for (int n = 0; n < 2; ++n) { f32x4 v = acc[ai][bj][m][n];
                        v[0] = __builtin_amdgcn_exp2f(v[0] - a); v[1] = __builtin_amdgcn_exp2f(v[1] - a); v[2] = __builtin_amdgcn_exp2f(v[2] - a); v[3] = __builtin_amdgcn_exp2f(v[3] - a);
                        acc[ai][bj][m][n] = v; s += (v[0] + v[1]) + (v[2] + v[3]); }
                s += __shfl_xor(s, 16); s += __shfl_xor(s, 32);
                if (fq == 0) red[1024 + rl * 4 + wc] = s; }
        LDS_WAIT(); __builtin_amdgcn_s_barrier(); asm volatile("" ::: "memory");
#pragma unroll
        for (int ai = 0; ai < 2; ++ai)
#pragma unroll
            for (int m = 0; m < 4; ++m) { const int rl = ai * HALF + wr * 64 + m * 16 + fr; const int row = u.orow + rl; const f32x4 ss = *(const LAS f32x4*)(red + 1024 + rl * 4);
                const float inv = P_SCALE / ((ss[0] + ss[1]) + (ss[2] + ss[3]));
#pragma unroll
                for (int bj = 0; bj < 2; ++bj) { const f32x4 v0 = acc[ai][bj][m][0] * inv, v1 = acc[ai][bj][m][1] * inv;
                    u32x2 w8; w8.x = cvt4_fp8(v0[0], v0[1], v0[2], v0[3]); w8.y = cvt4_fp8(v1[0], v1[1], v1[2], v1[3]);
                    *(u32x2*)((unsigned char*)P + (size_t)row * DM + EPI_COL(u, bj)) = w8; } }
    }
};
struct EpiSwiglu {
    static constexpr bool HAS_MID = false;
    bf16_t* Hd; const float* r2s; const int* listbase;
    __device__ __forceinline__ void operator()(const f32x4 (&acc)[2][2][4][2], const Unit& u, int wr, int wc, int fr, int fq) const {
#pragma unroll
        for (int ai = 0; ai < 2; ++ai)
#pragma unroll
            for (int m = 0; m < 4; ++m) { const int rl = ai * HALF + wr * 64 + m * 16 + fr, row = u.orow + rl; const float rs = r2s[(u.rows - listbase) + (rl < u.nvalid ? rl : 0)] * (1.0f / WGU_SCALE); float h[8];
#pragma unroll
                for (int n = 0; n < 2; ++n)
#pragma unroll
                    for (int e = 0; e < 4; ++e) { const float gt = acc[ai][0][m][n][e] * rs, up = acc[ai][1][m][n][e] * rs;
                        h[n * 4 + e] = gt * __builtin_amdgcn_rcpf(1.0f + __builtin_amdgcn_exp2f(-gt * LOG2E)) * up; }
                u32x2 w; w.x = cvt4_fp8(h[0], h[1], h[2], h[3]); w.y = cvt4_fp8(h[4], h[5], h[6], h[7]);
                *(u32x2*)((unsigned char*)Hd + (size_t)row * DFF + u.ocol + wc * 32 + 8 * fq) = w; }
    }
};
}

namespace att {
constexpr int QB = 256, KVBLK = 64, PITCH = HW, OPITCH = DM;
constexpr int SLOTB = 8192, LDS_K = 0, LDS_V = 2 * SLOTB, LDS_WS = 4 * SLOTB, LDS_OST = LDS_WS + NWAVES * 256, LDS_FLAG = LDS_OST + NWAVES * 4096, LDS_END = LDS_FLAG + 64;
static_assert(LDS_END <= RING_BYTES, "attention LDS");
__device__ __forceinline__ int crow(int r, int hi) { return (r & 3) + 8 * (r >> 2) + 4 * hi; }
__device__ __forceinline__ void glds16(const void* gsrc, unsigned lds_dst) { unsigned keep;
    asm volatile("s_mov_b32 %0, m0\n\ts_mov_b32 m0, %2\n\ts_nop 0\n\tglobal_load_lds_dwordx4 %1, off\n\ts_mov_b32 m0, %0" : "=&s"(keep) : "v"(gsrc), "s"(lds_dst) : "memory"); }
__device__ __forceinline__ void glds16s(const void* sbase, unsigned voff, unsigned lds_dst) { unsigned keep;
    asm volatile("s_mov_b32 %0, m0\n\ts_mov_b32 m0, %3\n\ts_nop 0\n\tglobal_load_lds_dwordx4 %1, %2\n\ts_mov_b32 m0, %0" : "=&s"(keep) : "v"(voff), "s"(sbase), "s"(lds_dst) : "memory"); }
#define ATT_WAIT_BAR0() asm volatile("s_waitcnt vmcnt(0) lgkmcnt(0)\n\ts_barrier" ::: "memory")
#define MFMA32(a, b, c) __builtin_amdgcn_mfma_f32_32x32x16_bf16(a, b, c, 0, 0, 0)
__device__ __forceinline__ void store_row_ssq(u32x4 v, float* dst, int ch) {
    float q = (bf16lo(v.x) * bf16lo(v.x) + bf16hi(v.x) * bf16hi(v.x)) + (bf16lo(v.y) * bf16lo(v.y) + bf16hi(v.y) * bf16hi(v.y)) + (bf16lo(v.z) * bf16lo(v.z) + bf16hi(v.z) * bf16hi(v.z)) + (bf16lo(v.w) * bf16lo(v.w) + bf16hi(v.w) * bf16hi(v.w));
    q += __shfl_xor(q, 1); q += __shfl_xor(q, 2); q += __shfl_xor(q, 4);
    if (ch == 0) *dst = q;
}
__device__ __forceinline__ void qkt(f32x16& p0, f32x16& p1, const LAS char* Kslot, const bf16x8* qr, const f32x16& cin, int r32, int hi) {
    const LAS char* kb = Kslot + hi * 1024 + r32 * 16;
#pragma unroll
    for (int d0 = 0; d0 < 4; ++d0) {
        const bf16x8 b0 = *(const LAS bf16x8*)(kb + d0 * 2048);
        const bf16x8 b1 = *(const LAS bf16x8*)(kb + d0 * 2048 + 512);
        if (d0 == 0) { p0 = MFMA32(b0, qr[0], cin); p1 = MFMA32(b1, qr[0], cin); }
        else { p0 = MFMA32(b0, qr[d0], p0); p1 = MFMA32(b1, qr[d0], p1); } }
}
__device__ __forceinline__ void pv(f32x16* o, int vb, bf16x8 pa0, bf16x8 pa1, bf16x8 pa2, bf16x8 pa3) {
#pragma unroll
    for (int d0 = 0; d0 < 2; ++d0) { s16x4 lo[4], hi[4];
#pragma unroll
        for (int ks = 0; ks < 4; ++ks) {
            asm volatile("ds_read_b64_tr_b16 %0,%1 offset:%c2" : "=&v"(lo[ks]) : "v"(vb), "i"(d0 * 4096 + ks * 1024) : "memory");
            asm volatile("ds_read_b64_tr_b16 %0,%1 offset:%c2" : "=&v"(hi[ks]) : "v"(vb), "i"(d0 * 4096 + ks * 1024 + 512) : "memory"); }
        asm volatile("s_waitcnt lgkmcnt(0)" ::: "memory"); __builtin_amdgcn_sched_barrier(0);
#define PK(k) (bf16x8){lo[k][0], lo[k][1], lo[k][2], lo[k][3], hi[k][0], hi[k][1], hi[k][2], hi[k][3]}
        o[d0] = MFMA32(pa0, PK(0), o[d0]); o[d0] = MFMA32(pa1, PK(1), o[d0]); o[d0] = MFMA32(pa2, PK(2), o[d0]); o[d0] = MFMA32(pa3, PK(3), o[d0]);
#undef PK
    }
}
__device__ __forceinline__ float swap_lo(float x) { auto rr = __builtin_amdgcn_permlane32_swap(__float_as_uint(x), __float_as_uint(x), false, false); return __uint_as_float(rr[0]); }
__device__ __forceinline__ float swap_hi(float x) { auto rr = __builtin_amdgcn_permlane32_swap(__float_as_uint(x), __float_as_uint(x), false, false); return __uint_as_float(rr[1]); }

template <int MODE> __device__ __forceinline__ void attn_unit(int b, int h, int qb, const bf16_t* Q, const bf16_t* K, const bf16_t* V, bf16_t* O, float* hs, const float* cb, LAS char* shm) {
    int tid = threadIdx.x; asm volatile("" : "+v"(tid)); const int lane = tid & 63, r32 = lane & 31, hi = lane >> 5; const int wid = __builtin_amdgcn_readfirstlane(tid >> 6);
    const long rowbase = (long)b * SEQ; const int q0 = qb * QB;
    const bf16_t* Qw = Q + (rowbase + q0 + wid * 32) * PITCH + h * HD;
    const bf16_t* Kh = K + rowbase * PITCH + h * HD; const bf16_t* Vh = V + rowbase * PITCH + h * HD;
    const unsigned lds0 = (unsigned)(uintptr_t)shm;
    LAS float* wsf = (LAS float*)(shm + LDS_WS) + wid * 64;
    LAS unsigned* flags = (LAS unsigned*)(shm + LDS_FLAG);
    const bf16_t* ksrc = Kh + (long)lane * PITCH + wid * 8;
    const bf16_t* vsrc = Vh + (long)(16 * (wid & 3) + (lane >> 2)) * PITCH + (wid >> 2) * 32 + (lane & 3) * 8;
    const unsigned kdst = lds0 + LDS_K + wid * 1024, vdst = lds0 + LDS_V + wid * 1024;
#define DMA_KV(t, slot) do { glds16(ksrc + (long)(t) * KVBLK * PITCH, (unsigned)__builtin_amdgcn_readfirstlane(kdst + (slot))); glds16(vsrc + (long)(t) * KVBLK * PITCH, (unsigned)__builtin_amdgcn_readfirstlane(vdst + (slot))); } while (0)
    const int vb0 = (int)(lds0 + LDS_V) + ((lane >> 4) & 1) * 32 + (lane & 3) * 8 + (4 * hi + ((lane & 15) >> 2)) * 64;
    const int NT = (q0 + QB) / KVBLK;
    DMA_KV(NT - 1, 0);
    bf16x8 qr[4];
#pragma unroll
    for (int d0 = 0; d0 < 4; ++d0) qr[d0] = *(const bf16x8*)(Qw + (long)r32 * PITCH + d0 * 16 + hi * 8);
    f32x16 o[2]; o[0] = f32x16{}; o[1] = f32x16{};
    const int qrel = wid * 32 + r32;
    float m_run = -1.0e30f, l_run = 0.f, R = 0.f, ct = 0.f;
    if (MODE == 0) ct = cb[q0 + qrel];
    bf16x8 TD0, TD1, TONE;
#pragma unroll
    for (int j = 0; j < 8; ++j) { const int kvl = 8 * (j >> 2) + 4 * hi + (j & 3); TD0[j] = (kvl >= r32) ? (short)0x3F80 : (short)0; TD1[j] = (16 + kvl >= r32) ? (short)0x3F80 : (short)0; TONE[j] = (short)0x3F80; }
    f32x16 zero16 = f32x16{};
    for (int i = 0; i < NT; ++i) {
        const int t = NT - 1 - i, slot = (i & 1) * SLOTB;
        ATT_WAIT_BAR0();
        if (MODE == 1 && i > 0) {
            const LAS unsigned* fl = flags + ((i - 1) & 1) * 8; unsigned all = 1u;
#pragma unroll
            for (int w = 0; w < 8; ++w) all &= fl[w];
            if (__builtin_amdgcn_readfirstlane(all)) break;
        }
        if (t > 0) DMA_KV(t - 1, slot ^ SLOTB);
        const int jb = t - (NT - 4);
        const bool active = !(jb >= 0 && 2 * jb > wid);
        bool wave_done = false;
        if (MODE == 1) wave_done = __all(R < SB_EXIT);
        if (active && !(MODE == 1 && wave_done)) {
            f32x16 p0, p1;
            qkt(p0, p1, shm + LDS_K + slot, qr, zero16, r32, hi);
            if (MODE == 0) {
                const float* cbt = cb + t * KVBLK + 4 * hi;
#pragma unroll
                for (int g = 0; g < 4; ++g) { const f32x4 c0 = *(const f32x4*)(cbt + 8 * g), c1 = *(const f32x4*)(cbt + 32 + 8 * g);
#pragma unroll
                    for (int e = 0; e < 4; ++e) { p0[4 * g + e] += ct - c0[e]; p1[4 * g + e] += ct - c1[e]; } }
                if (jb >= 0) {
#pragma unroll
                    for (int r = 0; r < 16; ++r) { const int kv = 64 * jb + crow(r, hi); if (kv > qrel) p0[r] = -1.0e30f; if (kv + 32 > qrel) p1[r] = -1.0e30f; } }
                float a = fmaxf(p0[0], p1[0]);
#pragma unroll
                for (int r = 1; r < 16; ++r) a = fmaxf(a, fmaxf(p0[r], p1[r]));
                a = fmaxf(swap_lo(a), swap_hi(a));
                const float m_new = fmaxf(m_run, a), alpha = __builtin_amdgcn_exp2f(m_run - m_new); m_run = m_new;
                float s = 0.f;
#pragma unroll
                for (int r = 0; r < 16; ++r) { p0[r] = __builtin_amdgcn_exp2f(p0[r] - m_new); p1[r] = __builtin_amdgcn_exp2f(p1[r] - m_new); s += p0[r] + p1[r]; }
                l_run = l_run * alpha + s;
                if (hi == 0) wsf[r32] = alpha;
                LDS_WAIT();
#pragma unroll
                for (int r = 0; r < 16; ++r) { const float f = wsf[crow(r, hi)]; o[0][r] *= f; o[1][r] *= f; }
                LDS_WAIT();
            } else {
                if (jb >= 0) {
#pragma unroll
                    for (int r = 0; r < 16; ++r) { const int kv = 64 * jb + crow(r, hi); if (kv >= qrel) p0[r] = -1.0e30f; if (kv + 32 >= qrel) p1[r] = -1.0e30f; } }
                f32x16 l0, l1;
#pragma unroll
                for (int r = 0; r < 16; ++r) {
                    l0[r] = -(fmaxf(p0[r], 0.f) + __builtin_amdgcn_logf(1.0f + __builtin_amdgcn_exp2f(-fabsf(p0[r]))));
                    l1[r] = -(fmaxf(p1[r], 0.f) + __builtin_amdgcn_logf(1.0f + __builtin_amdgcn_exp2f(-fabsf(p1[r])))); }
                u32x4 lw0 = {cvt_pk_bf16(l0[0], l0[1]), cvt_pk_bf16(l0[2], l0[3]), cvt_pk_bf16(l0[4], l0[5]), cvt_pk_bf16(l0[6], l0[7])};
                u32x4 lw1 = {cvt_pk_bf16(l0[8], l0[9]), cvt_pk_bf16(l0[10], l0[11]), cvt_pk_bf16(l0[12], l0[13]), cvt_pk_bf16(l0[14], l0[15])};
                u32x4 lw2 = {cvt_pk_bf16(l1[0], l1[1]), cvt_pk_bf16(l1[2], l1[3]), cvt_pk_bf16(l1[4], l1[5]), cvt_pk_bf16(l1[6], l1[7])};
                u32x4 lw3 = {cvt_pk_bf16(l1[8], l1[9]), cvt_pk_bf16(l1[10], l1[11]), cvt_pk_bf16(l1[12], l1[13]), cvt_pk_bf16(l1[14], l1[15])};
                f32x16 rt;
#pragma unroll
                for (int r = 0; r < 16; ++r) rt[r] = R;
                f32x16 t0 = MFMA32(TD0, __builtin_bit_cast(bf16x8, lw0), rt); t0 = MFMA32(TD1, __builtin_bit_cast(bf16x8, lw1), t0);
                t0 = MFMA32(TONE, __builtin_bit_cast(bf16x8, lw2), t0); t0 = MFMA32(TONE, __builtin_bit_cast(bf16x8, lw3), t0);
                f32x16 t1 = MFMA32(TD0, __builtin_bit_cast(bf16x8, lw2), rt); t1 = MFMA32(TD1, __builtin_bit_cast(bf16x8, lw3), t1);
#pragma unroll
                for (int r = 0; r < 16; ++r) { p0[r] = __builtin_amdgcn_exp2f(p0[r] + t0[r]); p1[r] = __builtin_amdgcn_exp2f(p1[r] + t1[r]); }
                R = swap_lo(t0[0]);
            }
            u32x4 pw0 = {cvt_pk_bf16(p0[0], p0[1]), cvt_pk_bf16(p0[2], p0[3]), cvt_pk_bf16(p0[4], p0[5]), cvt_pk_bf16(p0[6], p0[7])};
            u32x4 pw1 = {cvt_pk_bf16(p0[8], p0[9]), cvt_pk_bf16(p0[10], p0[11]), cvt_pk_bf16(p0[12], p0[13]), cvt_pk_bf16(p0[14], p0[15])};
            u32x4 pw2 = {cvt_pk_bf16(p1[0], p1[1]), cvt_pk_bf16(p1[2], p1[3]), cvt_pk_bf16(p1[4], p1[5]), cvt_pk_bf16(p1[6], p1[7])};
            u32x4 pw3 = {cvt_pk_bf16(p1[8], p1[9]), cvt_pk_bf16(p1[10], p1[11]), cvt_pk_bf16(p1[12], p1[13]), cvt_pk_bf16(p1[14], p1[15])};
            pv(o, vb0 + slot, __builtin_bit_cast(bf16x8, pw0), __builtin_bit_cast(bf16x8, pw1), __builtin_bit_cast(bf16x8, pw2), __builtin_bit_cast(bf16x8, pw3));
        }
        if (MODE == 1) { const bool dn = __all(R < SB_EXIT); if (lane == 0) flags[(i & 1) * 8 + wid] = dn ? 1u : 0u; }
    }
    float linv = 1.f;
    if (MODE == 0) { const float lt = swap_lo(l_run) + swap_hi(l_run); linv = 1.0f / lt; }
    if (hi == 0) wsf[32 + r32] = linv;
    LDS_WAIT();
    bf16_t* Ow = O + (rowbase + q0 + wid * 32) * OPITCH + h * HD;
    { LAS bf16_t* stg = (LAS bf16_t*)(shm + LDS_OST) + wid * 2048;
#pragma unroll
      for (int r = 0; r < 16; ++r) { const int orow = crow(r, hi); const float f = wsf[32 + orow];
#pragma unroll
        for (int d0 = 0; d0 < 2; ++d0) { const unsigned pk = cvt_pk_bf16(o[d0][r] * f, 0.f); stg[orow * 64 + d0 * 32 + r32] = (bf16_t)(pk & 0xffffu); } }
      LDS_WAIT();
#pragma unroll
      for (int i = 0; i < 4; ++i) { const int row = i * 8 + (lane >> 3), ch = lane & 7; const u32x4 v = *(const LAS u32x4*)(stg + row * 64 + ch * 8); *(u32x4*)(Ow + (long)row * OPITCH + ch * 8) = v;
        store_row_ssq(v, hs + (rowbase + q0 + wid * 32 + row) * 16, ch); } }
    asm volatile("s_waitcnt vmcnt(0) lgkmcnt(0)\n\ts_barrier" ::: "memory");
#undef DMA_KV
}
}


namespace fox {
constexpr int QB = 256, KVBLK = 64, PITCH = HW, OPITCH = DM;
constexpr int NSLOT = 3, SLOTB = 9216;
constexpr int LDS_K = 0, LDS_V = NSLOT * SLOTB, LDS_WS = 2 * NSLOT * SLOTB, LDS_OST = LDS_WS + NWAVES * 256, LDS_CL = LDS_OST + NWAVES * 4096, LDS_VOTE = LDS_CL + 512, LDS_END = LDS_VOTE + 32;
static_assert(LDS_END <= RING_BYTES, "fox LDS");
constexpr float WIN_T = 48.0f;
constexpr float FLOOR = -256.0f;
using att::crow; using att::glds16; using att::glds16s;
typedef __attribute__((address_space(3))) const char* lds_cptr;
typedef short v4i16_t __attribute__((ext_vector_type(4)));
#define SBAR() __builtin_amdgcn_sched_barrier(0)
#define WAIT_BAR(N) asm volatile("s_waitcnt vmcnt(" #N ") lgkmcnt(0)\n\ts_barrier" ::: "memory")
__device__ __forceinline__ s16x4 vtr(lds_cptr p) { return __builtin_bit_cast(s16x4, __builtin_amdgcn_ds_read_tr16_b64_v4i16((__attribute__((address_space(3))) v4i16_t*)p)); }
__device__ __forceinline__ void kload2(bf16x8* kf, lds_cptr kp, int j) { kf[2 * j] = *(const LAS bf16x8*)(kp + j * 2048); kf[2 * j + 1] = *(const LAS bf16x8*)(kp + j * 2048 + 512); }
__device__ __forceinline__ void cmask(f32x16& p0, f32x16& p1, int jb, int qrel, int hi) {
    const float NEG = -INFINITY; const int kb = 64 * jb + 4 * hi;
#pragma unroll
    for (int r = 0; r < 16; ++r) { const int kv = kb + (r & 3) + 8 * (r >> 2); if (kv > qrel) p0[r] = NEG; if (kv + 32 > qrel) p1[r] = NEG; }
}
__device__ __forceinline__ void split3(float x, unsigned& hm, unsigned& lo) {
    const unsigned h = cvt_pk_bf16(x, 0.f) & 0xffffu; const float r1 = x - __uint_as_float(h << 16);
    const unsigned m = cvt_pk_bf16(r1, 0.f) & 0xffffu; const float r2 = r1 - __uint_as_float(m << 16);
    hm = h | (m << 16); lo = cvt_pk_bf16(r2, 0.f) & 0xffffu;
}
__device__ __forceinline__ bf16x8 qx_build(float a, int hi) {
    unsigned hm, lo; split3(a, hm, lo);
    u32x4 w; w.x = hm; w.y = lo | 0x3F800000u; w.z = 0x3F803F80u; w.w = 0u;
    if (hi) { w.x = 0u; w.y = 0u; w.z = 0u; }
    return __builtin_bit_cast(bf16x8, w);
}

template <int THRL> __device__ __forceinline__ void fox_unit(int bh, int qb, const bf16_t* Q, const bf16_t* K, const bf16_t* V, bf16_t* O, float* hs, const float* cb, const bf16_t* KXh, float kmax, LAS char* shm) {
    int tid = threadIdx.x; asm volatile("" : "+v"(tid)); const int lane = tid & 63, r32 = lane & 31, hi = lane >> 5; const int wid = __builtin_amdgcn_readfirstlane(tid >> 6);
    const int b = bh >> 3, h = bh & 7; const long rowbase = (long)b * SEQ; const int q0 = qb * QB;
    const bf16_t* Qw = Q + (rowbase + q0 + wid * 32) * PITCH + h * HD;
    const bf16_t* Kh = K + rowbase * PITCH + h * HD; const bf16_t* Vh = V + rowbase * PITCH + h * HD;
    const unsigned lds0 = (unsigned)(uintptr_t)shm;
    LAS float* wsf = (LAS float*)(shm + LDS_WS) + wid * 64;
    const int NT = (q0 + QB) / KVBLK;
    int NTe = NT;
    LAS float* clt = (LAS float*)(shm + LDS_CL); LAS unsigned* votes = (LAS unsigned*)(shm + LDS_VOTE);
    const float clv = (tid < NT) ? cb[64 * tid + 63] : 0.f;
    const unsigned koff = (unsigned)(lane * PITCH + wid * 8) * 2u, voff = (unsigned)((16 * (wid & 3) + (lane >> 2)) * PITCH + (wid >> 2) * 32 + (lane & 3) * 8) * 2u, xoff = (unsigned)lane * 16u;
    const unsigned kdst = lds0 + LDS_K + wid * 1024, vdst = lds0 + LDS_V + wid * 1024, xdst = lds0 + LDS_K + 8192;
    const bool xl = (lane >> 3) == wid;
#define DMA_K(p, slot) do { glds16s(Kh + (long)(NT - 1 - (p)) * KVBLK * PITCH, koff, (unsigned)__builtin_amdgcn_readfirstlane(kdst + (slot))); \
        if (xl) glds16s(KXh + (long)(NT - 1 - (p)) * KVBLK * 8, xoff, (unsigned)__builtin_amdgcn_readfirstlane(xdst + (slot))); } while (0)
#define DMA_V(p, slot) glds16s(Vh + (long)(NT - 1 - (p)) * KVBLK * PITCH, voff, (unsigned)__builtin_amdgcn_readfirstlane(vdst + (slot)))
    bf16x8 kf[10];
    const lds_cptr shm3 = (lds_cptr)shm; const lds_cptr kp0 = shm3 + LDS_K + hi * 1024 + r32 * 16; const lds_cptr kx0 = shm3 + LDS_K + 8192 + r32 * 16;
    const lds_cptr vp0 = shm3 + LDS_V + ((lane >> 4) & 1) * 32 + (lane & 3) * 8 + (4 * hi + ((lane & 15) >> 2)) * 64;
    DMA_K(0, 0); DMA_V(0, 0); DMA_K(1, SLOTB);
    bf16x8 qr[4];
#pragma unroll
    for (int d0 = 0; d0 < 4; ++d0) qr[d0] = *(const bf16x8*)(Qw + (long)r32 * PITCH + d0 * 16 + hi * 8);
    const int qrel = wid * 32 + r32;
    const float ct = cb[q0 + qrel];
    float mhat = 0.f, l_reg = 0.f; f32x16 o[2]; o[0] = f32x16{}; o[1] = f32x16{};
    bf16x8 qx = qx_build(ct, hi);
    const f32x16 z16 = f32x16{};
#define CMASK(P0, P1, p) do { const int jb_ = 3 - (p); if (jb_ >= 0) cmask(P0, P1, jb_, qrel, hi); } while (0)
    bool resc = false;
#define RESC() do { if (resc) { asm volatile("s_waitcnt lgkmcnt(0)" ::: "memory"); \
      _Pragma("unroll") for (int d_ = 0; d_ < 2; ++d_) _Pragma("unroll") for (int r = 0; r < 16; ++r) o[d_][r] *= wsf[crow(r, hi)]; } } while (0)
    f32x16 pA0, pA1, pB0, pB1;
    int sl_prev = 0, sl_cur = 0, sl_next = SLOTB;
#define ROT() do { sl_prev = sl_cur; sl_cur = sl_next; sl_next = (sl_next == (NSLOT - 1) * SLOTB) ? 0 : sl_next + SLOTB; } while (0)
    DMA_K(2, 2 * SLOTB);
    WAIT_BAR(5);
    if (tid < NT) clt[tid] = clv;
    float qkb;
    { float q2 = 0.f;
#pragma unroll
      for (int d0 = 0; d0 < 4; ++d0)
#pragma unroll
          for (int j = 0; j < 8; ++j) { const float e = __uint_as_float(((unsigned)(unsigned short)qr[d0][j]) << 16); q2 += e * e; }
      q2 = att::swap_lo(q2) + att::swap_hi(q2); qkb = sqrtf(q2) * kmax + ct + WIN_T; }
    { const LAS char* kb = (const LAS char*)shm + LDS_K + hi * 1024 + r32 * 16; const LAS char* kxb = (const LAS char*)shm + LDS_K + 8192 + r32 * 16;
      pA0 = MFMA32(*(const LAS bf16x8*)(kxb), qx, z16); pA1 = MFMA32(*(const LAS bf16x8*)(kxb + 512), qx, z16);
#pragma unroll
      for (int d0 = 0; d0 < 4; ++d0) { pA0 = MFMA32(*(const LAS bf16x8*)(kb + d0 * 2048), qr[d0], pA0); pA1 = MFMA32(*(const LAS bf16x8*)(kb + d0 * 2048 + 512), qr[d0], pA1); } }
    asm volatile("s_nop 15\n\ts_nop 7" : "+v"(pA0), "+v"(pA1)); CMASK(pA0, pA1, 0);
    { float a = fmaxf(pA0[0], pA1[0]);
#pragma unroll
      for (int r = 1; r < 16; ++r) a = fmaxf(a, fmaxf(pA0[r], pA1[r]));
      a = fmaxf(att::swap_lo(a), att::swap_hi(a));
      const float dl = fmaxf(a, FLOOR); mhat = dl;
#pragma unroll
      for (int r = 0; r < 16; ++r) { pA0[r] = __builtin_amdgcn_exp2f(pA0[r] - dl); pA1[r] = __builtin_amdgcn_exp2f(pA1[r] - dl); }
      qx = qx_build(ct - mhat, hi); asm volatile("" : "+v"(qx)); }
    WAIT_BAR(0);
    DMA_K(3, 0); DMA_V(1, SLOTB);
    ROT();
    kload2(kf, kp0 + sl_cur, 0); kload2(kf, kp0 + sl_cur, 1); kload2(kf, kp0 + sl_cur, 2); kload2(kf, kp0 + sl_cur, 3);
    kf[8] = *(const LAS bf16x8*)(kx0 + sl_cur); kf[9] = *(const LAS bf16x8*)(kx0 + sl_cur + 512);
    WAIT_BAR(3);
    s16x4 vlo[8], vhi[8]; u32x4 pw0, pw1, pw2, pw3;
#define PKW(P, B) cvt_pk_bf16(P[B], P[B + 1])
#define PAF(k) __builtin_bit_cast(bf16x8, pw##k)
#define VFR(i) (bf16x8){vlo[i][0], vlo[i][1], vlo[i][2], vlo[i][3], vhi[i][0], vhi[i][1], vhi[i][2], vhi[i][3]}
#define PIN(x) asm volatile("" : "+v"(x))
#define MX3(a, b, c) __builtin_fmaxf(__builtin_fmaxf((a), (b)), (c))
#define GAPA(MF, A0, A1, A2, A3, W0, W1, PW) do { MF; sacc += A0; sacc += A1; sacc += A2; sacc += A3; PIN(sacc); W0; W1; PIN(PW); SBAR(); } while (0)
#define EX(v) __builtin_amdgcn_exp2f(v)
#define GAPB(MF, X, B) do { MF; X[B] = EX(X[B]); X[B + 1] = EX(X[B + 1]); X[B + 2] = EX(X[B + 2]); X[B + 3] = EX(X[B + 3]); PIN(X); SBAR(); } while (0)
#define VRD(i) do { vlo[i] = vtr(vp_ + (((i) >> 2) * 4096 + ((i) & 3) * 1024)); vhi[i] = vtr(vp_ + (((i) >> 2) * 4096 + ((i) & 3) * 1024 + 512)); } while (0)
#define KRD(G, j) do { if (G) { kload2(kf, kp0 + sl_next, j); SBAR(); } } while (0)
#define KRDX(G) do { if (G) { kf[8] = *(const LAS bf16x8*)(kx0 + sl_next); kf[9] = *(const LAS bf16x8*)(kx0 + sl_next + 512); SBAR(); } } while (0)
#define STEP(C0, C1, P0, P1, t, GK, GV, GL) do { SBAR(); \
    const lds_cptr vp_ = vp0 + sl_prev; \
    C0 = MFMA32(kf[8], qx, z16); C1 = MFMA32(kf[9], qx, z16); SBAR(); \
    VRD(0); SBAR(); float sacc = (P0[0] + P0[1]); \
    GAPA(C0 = MFMA32(kf[0], qr[0], C0), P0[2], P0[3], P0[4], P0[5],     pw0[0] = PKW(P0, 0), pw0[1] = PKW(P0, 2), pw0); \
    VRD(4); SBAR(); GAPA(C1 = MFMA32(kf[1], qr[0], C1), P0[6], P0[7], P0[8], P0[9],     pw0[2] = PKW(P0, 4), pw0[3] = PKW(P0, 6), pw0); \
    VRD(1); SBAR(); GAPA(C0 = MFMA32(kf[2], qr[1], C0),   P0[10], P0[11], P0[12], P0[13], pw1[0] = PKW(P0, 8), pw1[1] = PKW(P0, 10), pw1); \
    VRD(5); SBAR(); GAPA(C1 = MFMA32(kf[3], qr[1], C1),   P0[14], P0[15], P1[0], P1[1],   pw1[2] = PKW(P0, 12), pw1[3] = PKW(P0, 14), pw1); \
    VRD(2); SBAR(); GAPA(C0 = MFMA32(kf[4], qr[2], C0),   P1[2], P1[3], P1[4], P1[5],     pw2[0] = PKW(P1, 0), pw2[1] = PKW(P1, 2), pw2); \
    VRD(6); SBAR(); GAPA(C1 = MFMA32(kf[5], qr[2], C1),   P1[6], P1[7], P1[8], P1[9],     pw2[2] = PKW(P1, 4), pw2[3] = PKW(P1, 6), pw2); \
    VRD(3); SBAR(); GAPA(C0 = MFMA32(kf[6], qr[3], C0),   P1[10], P1[11], P1[12], P1[13], pw3[0] = PKW(P1, 8), pw3[1] = PKW(P1, 10), pw3); \
    VRD(7); SBAR(); GAPA(C1 = MFMA32(kf[7], qr[3], C1),   P1[14], P1[15], 0.f, 0.f,       pw3[2] = PKW(P1, 12), pw3[3] = PKW(P1, 14), pw3); \
    l_reg += sacc; \
    if (GK) { DMA_K((t) + 3, sl_cur); } if (GV) { DMA_V((t) + 1, sl_next); } \
    CMASK(C0, C1, t); \
    { float a = MX3(C0[0], C0[1], C1[0]), b_ = MX3(C0[2], C0[3], C1[1]); a = MX3(a, C1[2], C1[3]); \
      _Pragma("unroll") for (int r = 4; r < 16; r += 4) { a = MX3(a, C0[r], C0[r + 1]); b_ = MX3(b_, C0[r + 2], C0[r + 3]); a = MX3(a, C1[r], C1[r + 1]); b_ = MX3(b_, C1[r + 2], C1[r + 3]); } \
      float rm = __builtin_fmaxf(a, b_); { auto rr = __builtin_amdgcn_permlane32_swap(__float_as_uint(rm), __float_as_uint(rm), false, false); rm = __builtin_fmaxf(__uint_as_float(rr[0]), __uint_as_float(rr[1])); } \
      resc = false; \
      if (__builtin_expect(__any(rm > (float)THRL), 0)) { const float dl = __builtin_fmaxf(rm, 0.f); mhat += dl; \
        _Pragma("unroll") for (int r = 0; r < 16; ++r) { C0[r] -= dl; C1[r] -= dl; } \
        qx = qx_build(ct - mhat, hi); asm volatile("" : "+v"(qx)); \
        const float f = __builtin_amdgcn_exp2f(-dl); l_reg *= f; if (hi == 0) wsf[r32] = f; resc = true; } } \
    SBAR(); \
    GAPB(o[0] = MFMA32(PAF(0), VFR(0), o[0]), C0, 0); \
    KRDX(GL); GAPB(o[1] = MFMA32(PAF(0), VFR(4), o[1]), C0, 4); \
    KRD(GL, 0); GAPB(o[0] = MFMA32(PAF(1), VFR(1), o[0]), C0, 8); \
    KRD(GL, 1); GAPB(o[1] = MFMA32(PAF(1), VFR(5), o[1]), C0, 12); \
    KRD(GL, 2); GAPB(o[0] = MFMA32(PAF(2), VFR(2), o[0]), C1, 0); \
    KRD(GL, 3); GAPB(o[1] = MFMA32(PAF(2), VFR(6), o[1]), C1, 4); \
    GAPB(o[0] = MFMA32(PAF(3), VFR(3), o[0]), C1, 8); \
    GAPB(o[1] = MFMA32(PAF(3), VFR(7), o[1]), C1, 12); \
    } while (0)
#define ENDW(tt) do { if ((tt) + 3 < NTe) { WAIT_BAR(3); } else if ((tt) + 2 < NTe) { WAIT_BAR(1); } else { WAIT_BAR(0); } } while (0)
#define VOTE(u) do { const int ts_ = NT - (u) - 3; bool ok_ = false; if (ts_ >= 0) { ok_ = __all((qkb - mhat) < clt[ts_]); } if (lane == 0) votes[wid] = ok_ ? 1u : 0u; } while (0)
#define TALLY(u) do { const u32x4 va_ = *(const LAS u32x4*)votes, vb_ = *(const LAS u32x4*)(votes + 4); \
        if (__builtin_amdgcn_readfirstlane((va_.x & va_.y & va_.z & va_.w & vb_.x & vb_.y & vb_.z & vb_.w) != 0u)) { if ((u) + 2 < NTe) { NTe = (u) + 2; WAIT_BAR(0); } } } while (0)
    int t = 1;
    for (; t + 1 < NTe && t < 5; t += 2) {
        STEP(pB0, pB1, pA0, pA1, t, (t + 3 < NTe), (t + 1 < NTe), (t + 1 < NTe));       ENDW(t);     RESC(); ROT();
        STEP(pA0, pA1, pB0, pB1, t + 1, (t + 4 < NTe), (t + 2 < NTe), (t + 2 < NTe));   VOTE(t + 1); ENDW(t + 1); TALLY(t + 1); RESC(); ROT();
    }
#undef CMASK
#define CMASK(P0, P1, p) do {} while (0)
    for (; t + 5 < NTe; t += 2) {
        STEP(pB0, pB1, pA0, pA1, t, true, true, true);       WAIT_BAR(3); RESC(); ROT();
        STEP(pA0, pA1, pB0, pB1, t + 1, true, true, true);   VOTE(t + 1); WAIT_BAR(3); TALLY(t + 1); RESC(); ROT();
    }
    for (; t + 1 < NTe; t += 2) {
        STEP(pB0, pB1, pA0, pA1, t, (t + 3 < NTe), (t + 1 < NTe), (t + 1 < NTe));       ENDW(t);     RESC(); ROT();
        STEP(pA0, pA1, pB0, pB1, t + 1, (t + 4 < NTe), (t + 2 < NTe), (t + 2 < NTe));   ENDW(t + 1); RESC(); ROT();
    }
#undef CMASK
#define CMASK(P0, P1, p) do { const int jb_ = 3 - (p); if (jb_ >= 0) cmask(P0, P1, jb_, qrel, hi); } while (0)
    STEP(pB0, pB1, pA0, pA1, NTe - 1, false, false, false); RESC();
    { float sacc = pB0[0] + pB0[1];
#pragma unroll
      for (int r = 2; r < 16; ++r) sacc += pB0[r];
#pragma unroll
      for (int r = 0; r < 16; ++r) sacc += pB1[r];
      l_reg += sacc;
      pw0 = (u32x4){PKW(pB0, 0), PKW(pB0, 2), PKW(pB0, 4), PKW(pB0, 6)}; pw1 = (u32x4){PKW(pB0, 8), PKW(pB0, 10), PKW(pB0, 12), PKW(pB0, 14)};
      pw2 = (u32x4){PKW(pB1, 0), PKW(pB1, 2), PKW(pB1, 4), PKW(pB1, 6)}; pw3 = (u32x4){PKW(pB1, 8), PKW(pB1, 10), PKW(pB1, 12), PKW(pB1, 14)};
      SBAR(); att::pv(o, (int)(unsigned)(uintptr_t)(vp0 + sl_cur), PAF(0), PAF(1), PAF(2), PAF(3)); }
    l_reg = att::swap_lo(l_reg) + att::swap_hi(l_reg);
    if (hi == 0) wsf[32 + r32] = l_reg; asm volatile("s_waitcnt lgkmcnt(0)" ::: "memory");
    float rli[16];
#pragma unroll
    for (int r = 0; r < 16; ++r) rli[r] = __builtin_amdgcn_rcpf(wsf[32 + crow(r, hi)]);
    bf16_t* Ow = O + (rowbase + q0 + wid * 32) * OPITCH + h * HD;
    { LAS bf16_t* stg = (LAS bf16_t*)(shm + LDS_OST) + wid * 2048;
#pragma unroll
      for (int r = 0; r < 16; ++r) { const int orow = crow(r, hi);
#pragma unroll
        for (int d0 = 0; d0 < 2; ++d0) stg[orow * 64 + d0 * 32 + r32] = (bf16_t)(cvt_pk_bf16(o[d0][r] * rli[r], 0.f) & 0xffffu); }
      asm volatile("s_waitcnt lgkmcnt(0)" ::: "memory");
#pragma unroll
      for (int i = 0; i < 4; ++i) { const int row = i * 8 + (lane >> 3), ch = lane & 7; const u32x4 v = *(const LAS u32x4*)(stg + row * 64 + ch * 8); *(u32x4*)(Ow + (long)row * OPITCH + ch * 8) = v;
        att::store_row_ssq(v, hs + (rowbase + q0 + wid * 32 + row) * 16, ch); } }
    asm volatile("s_waitcnt lgkmcnt(0)\n\ts_barrier" ::: "memory");
#undef DMA_K
#undef DMA_V
#undef CMASK
#undef RESC
#undef ROT
#undef PKW
#undef PAF
#undef VFR
#undef PIN
#undef MX3
#undef GAPA
#undef GAPB
#undef EX
#undef VRD
#undef KRD
#undef KRDX
#undef STEP
#undef ENDW
#undef VOTE
#undef TALLY
}
#undef SBAR
#undef WAIT_BAR
}


namespace sbk {
constexpr int QB = 256, KVBLK = 64, PITCH = HW, OPITCH = DM, NBURST = 6, SLOTB = 8192;
constexpr int LDS_K = 0, LDS_V = NBURST * SLOTB, LDS_FLAG = 2 * NBURST * SLOTB, LDS_END = LDS_FLAG + 128;
static_assert(LDS_END <= RING_BYTES, "sb LDS");
using att::crow; using att::glds16s; using att::qkt; using att::pv; using att::swap_lo;
__device__ __forceinline__ void sb_tile(const LAS char* Kslot, int vb, const bf16x8* qr, bf16x8 TD0, bf16x8 TD1, bf16x8 TONE, int jb, int qrel, int r32, int hi, float& R, f32x16* o) {
    f32x16 p0, p1; const f32x16 z16 = f32x16{};
    qkt(p0, p1, Kslot, qr, z16, r32, hi);
    if (jb >= 0) {
#pragma unroll
        for (int r = 0; r < 16; ++r) { const int kv = 64 * jb + crow(r, hi); if (kv >= qrel) p0[r] = -1.0e30f; if (kv + 32 >= qrel) p1[r] = -1.0e30f; } }
    f32x16 l0, l1;
#pragma unroll
    for (int r = 0; r < 16; ++r) {
        l0[r] = -(fmaxf(p0[r], 0.f) + __builtin_amdgcn_logf(1.0f + __builtin_amdgcn_exp2f(-fabsf(p0[r]))));
        l1[r] = -(fmaxf(p1[r], 0.f) + __builtin_amdgcn_logf(1.0f + __builtin_amdgcn_exp2f(-fabsf(p1[r])))); }
    u32x4 lw0 = {cvt_pk_bf16(l0[0], l0[1]), cvt_pk_bf16(l0[2], l0[3]), cvt_pk_bf16(l0[4], l0[5]), cvt_pk_bf16(l0[6], l0[7])};
    u32x4 lw1 = {cvt_pk_bf16(l0[8], l0[9]), cvt_pk_bf16(l0[10], l0[11]), cvt_pk_bf16(l0[12], l0[13]), cvt_pk_bf16(l0[14], l0[15])};
    u32x4 lw2 = {cvt_pk_bf16(l1[0], l1[1]), cvt_pk_bf16(l1[2], l1[3]), cvt_pk_bf16(l1[4], l1[5]), cvt_pk_bf16(l1[6], l1[7])};
    u32x4 lw3 = {cvt_pk_bf16(l1[8], l1[9]), cvt_pk_bf16(l1[10], l1[11]), cvt_pk_bf16(l1[12], l1[13]), cvt_pk_bf16(l1[14], l1[15])};
    f32x16 rt;
#pragma unroll
    for (int r = 0; r < 16; ++r) rt[r] = R;
    f32x16 t0 = MFMA32(TD0, __builtin_bit_cast(bf16x8, lw0), rt); t0 = MFMA32(TD1, __builtin_bit_cast(bf16x8, lw1), t0);
    t0 = MFMA32(TONE, __builtin_bit_cast(bf16x8, lw2), t0); t0 = MFMA32(TONE, __builtin_bit_cast(bf16x8, lw3), t0);
    f32x16 t1 = MFMA32(TD0, __builtin_bit_cast(bf16x8, lw2), rt); t1 = MFMA32(TD1, __builtin_bit_cast(bf16x8, lw3), t1);
#pragma unroll
    for (int r = 0; r < 16; ++r) { p0[r] = __builtin_amdgcn_exp2f(p0[r] + t0[r]); p1[r] = __builtin_amdgcn_exp2f(p1[r] + t1[r]); }
    R = swap_lo(t0[0]);
    u32x4 pw0 = {cvt_pk_bf16(p0[0], p0[1]), cvt_pk_bf16(p0[2], p0[3]), cvt_pk_bf16(p0[4], p0[5]), cvt_pk_bf16(p0[6], p0[7])};
    u32x4 pw1 = {cvt_pk_bf16(p0[8], p0[9]), cvt_pk_bf16(p0[10], p0[11]), cvt_pk_bf16(p0[12], p0[13]), cvt_pk_bf16(p0[14], p0[15])};
    u32x4 pw2 = {cvt_pk_bf16(p1[0], p1[1]), cvt_pk_bf16(p1[2], p1[3]), cvt_pk_bf16(p1[4], p1[5]), cvt_pk_bf16(p1[6], p1[7])};
    u32x4 pw3 = {cvt_pk_bf16(p1[8], p1[9]), cvt_pk_bf16(p1[10], p1[11]), cvt_pk_bf16(p1[12], p1[13]), cvt_pk_bf16(p1[14], p1[15])};
    pv(o, vb, __builtin_bit_cast(bf16x8, pw0), __builtin_bit_cast(bf16x8, pw1), __builtin_bit_cast(bf16x8, pw2), __builtin_bit_cast(bf16x8, pw3));
}
#define SB_WAITBAR(N) asm volatile("s_waitcnt vmcnt(" #N ") lgkmcnt(0)\n\ts_barrier" ::: "memory")
__device__ __forceinline__ void sb_unit(int b, int h, int qb, const bf16_t* Q, const bf16_t* K, const bf16_t* V, bf16_t* O, float* hs, LAS char* shm) {
    int tid = threadIdx.x; asm volatile("" : "+v"(tid)); const int lane = tid & 63, r32 = lane & 31, hi = lane >> 5; const int wid = __builtin_amdgcn_readfirstlane(tid >> 6);
    const long rowbase = (long)b * SEQ; const int q0 = qb * QB;
    const bf16_t* Qw = Q + (rowbase + q0 + wid * 32) * PITCH + h * HD;
    const bf16_t* Kh = K + rowbase * PITCH + h * HD; const bf16_t* Vh = V + rowbase * PITCH + h * HD;
    const unsigned lds0 = (unsigned)(uintptr_t)shm;
    LAS unsigned* flags = (LAS unsigned*)(shm + LDS_FLAG);
    const unsigned koff = (unsigned)(lane * PITCH + wid * 8) * 2u, voff = (unsigned)((16 * (wid & 3) + (lane >> 2)) * PITCH + (wid >> 2) * 32 + (lane & 3) * 8) * 2u;
    const unsigned kdst = lds0 + LDS_K + wid * 1024, vdst = lds0 + LDS_V + wid * 1024;
#define SB_DMA(p, slot) do { glds16s(Kh + (long)(NT - 1 - (p)) * KVBLK * PITCH, koff, (unsigned)__builtin_amdgcn_readfirstlane(kdst + (slot) * SLOTB)); \
        glds16s(Vh + (long)(NT - 1 - (p)) * KVBLK * PITCH, voff, (unsigned)__builtin_amdgcn_readfirstlane(vdst + (slot) * SLOTB)); } while (0)
    const int vb0 = (int)(lds0 + LDS_V) + ((lane >> 4) & 1) * 32 + (lane & 3) * 8 + (4 * hi + ((lane & 15) >> 2)) * 64;
    const int NT = (q0 + QB) / KVBLK, NB = NT < NBURST ? NT : NBURST;
    for (int p = 0; p < NB; ++p) SB_DMA(p, p);
    bf16x8 qr[4];
#pragma unroll
    for (int d0 = 0; d0 < 4; ++d0) qr[d0] = *(const bf16x8*)(Qw + (long)r32 * PITCH + d0 * 16 + hi * 8);
    f32x16 o[2]; o[0] = f32x16{}; o[1] = f32x16{};
    const int qrel = wid * 32 + r32;
    float R = 0.f;
    bf16x8 TD0, TD1, TONE;
#pragma unroll
    for (int j = 0; j < 8; ++j) { const int kvl = 8 * (j >> 2) + 4 * hi + (j & 3); TD0[j] = (kvl >= r32) ? (short)0x3F80 : (short)0; TD1[j] = (16 + kvl >= r32) ? (short)0x3F80 : (short)0; TONE[j] = (short)0x3F80; }
    if (NB > 4) { SB_WAITBAR(4); } else { SB_WAITBAR(0); }
    bool mid_done = (NB <= 4);
    int p = 3 - (wid >> 1);
    for (; p < NB; ++p) {
        if (p >= 4 && !mid_done) { SB_WAITBAR(0); mid_done = true; }
        sb_tile(shm + LDS_K + p * SLOTB, vb0 + p * SLOTB, qr, TD0, TD1, TONE, 3 - p, qrel, r32, hi, R, o);
        if (__all(R < SB_EXIT)) { ++p; break; }
    }
    if (!mid_done) { SB_WAITBAR(0); }
    { const bool dn = __all(R < SB_EXIT) || (p >= NT); if (lane == 0) flags[wid] = dn ? 1u : 0u; }
    SB_WAITBAR(0);
    bool alldone;
    { const u32x4 fa = *(const LAS u32x4*)flags, fb = *(const LAS u32x4*)(flags + 4); alldone = __builtin_amdgcn_readfirstlane((fa.x & fa.y & fa.z & fa.w & fb.x & fb.y & fb.z & fb.w) != 0u); }
    if (!alldone && NB < NT) {
        SB_DMA(NB, 0);
        for (int i = 0; NB + i < NT; ++i) {
            const int pp = NB + i, sl = i & 1;
            SB_WAITBAR(0);
            if (i > 0) { const LAS unsigned* fl = flags + 8 + ((i - 1) & 1) * 8; const u32x4 fa = *(const LAS u32x4*)fl, fb = *(const LAS u32x4*)(fl + 4);
                if (__builtin_amdgcn_readfirstlane((fa.x & fa.y & fa.z & fa.w & fb.x & fb.y & fb.z & fb.w) != 0u)) break; }
            if (pp + 1 < NT) SB_DMA(pp + 1, sl ^ 1);
            if (!__all(R < SB_EXIT)) sb_tile(shm + LDS_K + sl * SLOTB, vb0 + sl * SLOTB, qr, TD0, TD1, TONE, -1, qrel, r32, hi, R, o);
            { const bool dn = __all(R < SB_EXIT); if (lane == 0) flags[8 + (i & 1) * 8 + wid] = dn ? 1u : 0u; }
        }
        SB_WAITBAR(0);
    }
    bf16_t* Ow = O + (rowbase + q0 + wid * 32) * OPITCH + h * HD;
    { LAS bf16_t* stg = (LAS bf16_t*)(shm + LDS_K) + wid * 2048;
#pragma unroll
      for (int r = 0; r < 16; ++r) { const int orow = crow(r, hi);
#pragma unroll
        for (int d0 = 0; d0 < 2; ++d0) stg[orow * 64 + d0 * 32 + r32] = (bf16_t)(cvt_pk_bf16(o[d0][r], 0.f) & 0xffffu); }
      LDS_WAIT();
#pragma unroll
      for (int i = 0; i < 4; ++i) { const int row = i * 8 + (lane >> 3), ch = lane & 7; const u32x4 v = *(const LAS u32x4*)(stg + row * 64 + ch * 8); *(u32x4*)(Ow + (long)row * OPITCH + ch * 8) = v;
        att::store_row_ssq(v, hs + (rowbase + q0 + wid * 32 + row) * 16, ch); } }
    asm volatile("s_waitcnt vmcnt(0) lgkmcnt(0)\n\ts_barrier" ::: "memory");
#undef SB_DMA
}
#undef SB_WAITBAR
}

#define XB_TMO      128
#define XB_XCNT(j)  (256  + 64 * (j))
#define XB_XSUB(j)  (1280 + 64 * (j))
#define XB_XGEN(j)  (2304 + 64 * (j))
#define XB_TOP      3328
#define XB_TOPGEN   3392
#define XCD_BAR_WORDS 3456
#define XB_SPIN_CAP (1u << 18)
__device__ __forceinline__ unsigned xb_ld(unsigned* p)              { return __hip_atomic_load(p, __ATOMIC_RELAXED, __HIP_MEMORY_SCOPE_AGENT); }
__device__ __forceinline__ unsigned xb_add(unsigned* p, unsigned v) { return __hip_atomic_fetch_add(p, v, __ATOMIC_RELAXED, __HIP_MEMORY_SCOPE_AGENT); }
__device__ __forceinline__ unsigned xb_xcc_id() { return (unsigned)__builtin_amdgcn_s_getreg((3 << 11) | 20) & 0xFu; }
#define XB_SPIN(cond, bar) do { unsigned _sp = 0; while (cond) { __builtin_amdgcn_s_sleep(1); \
    if ((++_sp & 255u) == 0u) { if (xb_ld(&(bar)[XB_TMO])) break; if (_sp > XB_SPIN_CAP) { atomicAdd(&(bar)[XB_TMO], 1u); break; } } } } while (0)
struct XcdBarrier { unsigned* bar; unsigned x; volatile LAS unsigned* st; };
__device__ __forceinline__ XcdBarrier xcd_barrier_post(unsigned* bar, volatile LAS unsigned* st) {
    XcdBarrier b; b.bar = bar; b.x = xb_xcc_id(); b.st = st;
    if (threadIdx.x == 0) (void)xb_add(&bar[XB_XCNT(b.x)], 1u);
    return b;
}
__device__ __forceinline__ void xcd_barrier_complete(unsigned* bar, unsigned x, unsigned& nloc, unsigned& nx) {
    const unsigned G = gridDim.x * gridDim.y * gridDim.z;
    unsigned sum, cnt, mine, sp = 0u;
    for (;;) {
        sum = 0u; cnt = 0u; mine = 0u;
#pragma unroll
        for (unsigned j = 0; j < 16; ++j) { const unsigned c = xb_ld(&bar[XB_XCNT(j)]); sum += c; cnt += (c > 0u) ? 1u : 0u; mine = (j == x) ? c : mine; }
        if (sum == G) break;
        __builtin_amdgcn_s_sleep(1);
        if ((++sp & 255u) == 0u) { if (xb_ld(&bar[XB_TMO])) break; if (sp > XB_SPIN_CAP) { atomicAdd(&bar[XB_TMO], 1u); break; } }
    }
    nloc = mine > 0u ? mine : 1u; nx = cnt > 0u ? cnt : 1u;
}
__device__ __forceinline__ void xcd_barrier(const XcdBarrier& b) {
    asm volatile("s_waitcnt vmcnt(0)" ::: "memory");
    __syncthreads();
    if (threadIdx.x == 0) {
        unsigned* bar = b.bar;
        __builtin_amdgcn_s_waitcnt(0);
        unsigned nloc = b.st[0], nx = b.st[1];
        if (nloc == 0u) { xcd_barrier_complete(bar, b.x, nloc, nx); b.st[0] = nloc; b.st[1] = nx; }
        const unsigned old = xb_add(&bar[XB_XSUB(b.x)], 1u);
        const unsigned gen = old / nloc;
        if (old + 1u == (gen + 1u) * nloc) {
            __builtin_amdgcn_fence(__ATOMIC_RELEASE, "agent");
            asm volatile("s_waitcnt vmcnt(0)" ::: "memory");
            const unsigned og = xb_add(&bar[XB_TOP], 1u);
            const unsigned tg = og / nx;
            if (og + 1u == (tg + 1u) * nx) xb_add(&bar[XB_TOPGEN], 1u);
            else XB_SPIN(xb_ld(&bar[XB_TOPGEN]) == tg, bar);
            __builtin_amdgcn_fence(__ATOMIC_ACQUIRE, "agent");
            xb_add(&bar[XB_XGEN(b.x)], 1u);
            asm volatile("s_waitcnt vmcnt(0)" ::: "memory");
        } else {
            XB_SPIN(xb_ld(&bar[XB_XGEN(b.x)]) == gen, bar);
            __builtin_amdgcn_fence(__ATOMIC_ACQUIRE, "agent");
            asm volatile("s_waitcnt vmcnt(0)" ::: "memory");
        }
    }
    __syncthreads();
}

__device__ __forceinline__ const void* ldp(const volatile LAS unsigned* tab, int i) {
    const unsigned lo = __builtin_amdgcn_readfirstlane(tab[2 * i]), hi = __builtin_amdgcn_readfirstlane(tab[2 * i + 1]);
    return (const void*)(const GAS void*)(((unsigned long long)hi << 32) | lo);
}
struct Args {
    const float* x; const float* mem; const float* norm_mix; const float* w_in; const float* b_forget; const float* norm_fox; const float* norm_sb; const float* w_out;
    const float* norm_xattn; const float* norm_mem; const float* w_xq; const float* w_xkv; const float* w_xo; const float* norm_ffn;
    const float* w_rg; const float* b_rg; const float* w_re; const float* b_re; const float* w_gate; const float* w_up; const float* w_down; const float* norm_final;
    float* out; unsigned char* ws;
};

__device__ __forceinline__ void transpose_item(const float* W, int ldw, bf16_t* WT, int ldo, int k0, int n0, int dst_row0, const float* gain, LAS float* scr, int lane) {
    float tv[32], tg[32];
#pragma unroll
    for (int i = 0; i < 32; ++i) { const int kk = 2 * i + (lane >> 5); tv[i] = W[(size_t)(k0 + kk) * ldw + n0 + (lane & 31)]; tg[i] = gain ? gain[k0 + kk] : 1.f; }
#pragma unroll
    for (int i = 0; i < 32; ++i) { const int kk = 2 * i + (lane >> 5); scr[kk * 33 + (lane & 31)] = tv[i] * tg[i]; }
    LDS_WAIT(); asm volatile("" ::: "memory");
    const int c = lane & 7;
#pragma unroll
    for (int j = 0; j < 4; ++j) { const int n = (lane >> 3) + 8 * j; const LAS float* s = scr + (8 * c) * 33 + n;
        u32x4 o; o.x = cvt_pk_bf16(s[0 * 33], s[1 * 33]); o.y = cvt_pk_bf16(s[2 * 33], s[3 * 33]); o.z = cvt_pk_bf16(s[4 * 33], s[5 * 33]); o.w = cvt_pk_bf16(s[6 * 33], s[7 * 33]);
        *(u32x4*)(WT + (size_t)(dst_row0 + n) * ldo + k0 + 8 * c) = o; }
    LDS_WAIT(); asm volatile("" ::: "memory");
}

__device__ __forceinline__ void transpose_item8(const float* W, int ldw, unsigned char* WT, int ldo, int k0, int n0, int dst_row0, const float* gain, float scale, LAS float* scr, int lane) {
    float tv[32], tg[32];
#pragma unroll
    for (int i = 0; i < 32; ++i) { const int kk = 2 * i + (lane >> 5); tv[i] = W[(size_t)(k0 + kk) * ldw + n0 + (lane & 31)]; tg[i] = gain ? gain[k0 + kk] : 1.f; }
#pragma unroll
    for (int i = 0; i < 32; ++i) { const int kk = 2 * i + (lane >> 5); scr[kk * 33 + (lane & 31)] = tv[i] * tg[i] * scale; }
    LDS_WAIT(); asm volatile("" ::: "memory");
    const int c = lane & 7;
#pragma unroll
    for (int j = 0; j < 4; ++j) { const int n = (lane >> 3) + 8 * j; const LAS float* s = scr + (8 * c) * 33 + n;
        u32x2 o; o.x = cvt4_fp8(s[0 * 33], s[1 * 33], s[2 * 33], s[3 * 33]); o.y = cvt4_fp8(s[4 * 33], s[5 * 33], s[6 * 33], s[7 * 33]);
        *(u32x2*)(WT + (size_t)(dst_row0 + n) * ldo + k0 + 8 * c) = o; }
    LDS_WAIT(); asm volatile("" ::: "memory");
}

struct SchedDense {
    const char* A; const char* Bt; int nM, nN, G, c; size_t a_tile, b_tile, b_batch; int split_tiles;
    __device__ __forceinline__ bool next(int i, pg8::Unit& u) const {
        int pm, pn; if (!pg8::tile_order(i, G, c, nM, nN, pm, pn)) return false;
        u.a = A + (size_t)pm * a_tile; u.b = Bt + (size_t)pn * b_tile + (size_t)(pm >> 5) * b_batch; u.orow = pm * 256;
        if (split_tiles) { u.aux = pn / split_tiles; u.ocol = (pn % split_tiles) * 256; } else { u.aux = 1; u.ocol = pn * 256; }
        u.rows = nullptr; u.nvalid = 256; return true;
    }
};
struct SchedGH {
    const char* KVm; const char* Wxq; const char* Wxo; int G, c;
    __device__ __forceinline__ bool next(int i, pg8::Unit& u) const {
        const int L = i * G + c; if (L >= 256) return false;
        const int kind = L >> 7, r = L & 127, bh = r >> 2, j = r & 3, b = bh >> 2, h = bh & 3;
        if (kind == 0) { u.a = KVm + ((size_t)(b * 256) * 2048 + h * 256) * 2; u.b = Wxq + ((size_t)(256 * j) * 1024 + h * 256) * 2; u.orow = b * 1024 + h * 256; u.ocol = 256 * j; u.aux = 1; }
        else { u.a = Wxo + ((size_t)(256 * j) * 1024 + h * 256) * 2; u.b = KVm + ((size_t)(b * 256) * 2048 + 1024 + h * 256) * 2; u.orow = b * 1024 + 256 * j; u.ocol = h * 256; u.aux = 2; }
        u.rows = nullptr; u.nvalid = 256; return true;
    }
};
template <int KIND> struct SchedGHk { SchedGH s; __device__ __forceinline__ bool next(int i, pg8::Unit& u) const { const int c2 = (s.G >= 256) ? s.c - 128 * KIND : s.c; if (c2 < 0) return false; const int L = i * s.G + c2; if (L >= 128) return false; SchedGH t = s; t.G = 1; t.c = 0; return t.next(128 * KIND + L, u); } };
struct EpiGH { static constexpr bool HAS_MID = false; unsigned char* GTp; unsigned char* HTp;
    __device__ __forceinline__ void operator()(const f32x4 (&acc)[2][2][4][2], const pg8::Unit& u, int wr, int wc, int fr, int fq) const {
        unsigned char* base = u.aux == 1 ? GTp : HTp;
#pragma unroll
        for (int ai = 0; ai < 2; ++ai)
#pragma unroll
            for (int m = 0; m < 4; ++m) { const int row = u.orow + ai * pg8::HALF + wr * 64 + m * 16 + fr;
#pragma unroll
                for (int bj = 0; bj < 2; ++bj) { const f32x4 v0 = acc[ai][bj][m][0], v1 = acc[ai][bj][m][1];
                    u32x2 w8; w8.x = cvt4_fp8(v0[0], v0[1], v0[2], v0[3]); w8.y = cvt4_fp8(v1[0], v1[1], v1[2], v1[3]);
                    *(u32x2*)(base + (size_t)row * DM + u.ocol + bj * pg8::HALF + wc * 32 + 8 * fq) = w8; } }
    } };
struct SchedMoe {
    const char* A; const char* W; const int* list; const LAS int* tbl; int G, c, NPN; size_t w_exp, w_tile, a_tile; int ocol_w;
    __device__ __forceinline__ bool next(int i, pg8::Unit& u) const {
        const int L = i * G + c; const int tl = L / NPN, pn = L % NPN;
        if (tl >= __builtin_amdgcn_readfirstlane(tbl[16])) return false;
        int e = 0;
#pragma unroll 1
        for (int x = 1; x < NEXP; ++x) { if (tl >= __builtin_amdgcn_readfirstlane(tbl[x])) e = x; }
        const int j = tl - __builtin_amdgcn_readfirstlane(tbl[e]), n = __builtin_amdgcn_readfirstlane(tbl[32 + e]) - 256 * j;
        u.a = A + (size_t)tl * a_tile; u.b = W + (size_t)e * w_exp + (size_t)pn * w_tile; u.orow = tl * 256; u.ocol = pn * ocol_w; u.aux = 1;
        u.rows = list + (size_t)e * M + 256 * j; u.nvalid = n < 256 ? n : 256; return true;
    }
};
__device__ __forceinline__ void moe_table(LAS int* tbl, const unsigned* ctl) {
    if (threadIdx.x == 0) { int base = 0; for (int e = 0; e < NEXP; ++e) { const int n = (int)ctl[CW_CNT + 64 * e]; tbl[e] = base; tbl[32 + e] = n; base += (n + 255) >> 8; } tbl[16] = base; }
    __syncthreads();
}

__global__ void __launch_bounds__(NWAVES * 64, 2) hymba_fwd(Args args) {
    extern __shared__ __attribute__((aligned(16))) unsigned char lds_raw[];
    LAS unsigned char* lds = (LAS unsigned char*)lds_raw;
    volatile LAS unsigned* MISC = (volatile LAS unsigned*)(lds + MISC_OFF);
    const int tid0 = threadIdx.x; const int wave = __builtin_amdgcn_readfirstlane(tid0 >> 6);
    const int G = gridDim.x; const int bx = blockIdx.x; const int vcu = (G % 8 == 0) ? (bx % 8) * (G / 8) + bx / 8 : bx;
    volatile LAS unsigned* ATAB = (volatile LAS unsigned*)(lds + MISC_OFF + 512);
    for (int u = tid0; u < 256; u += NWAVES * 64) ((LAS unsigned*)(lds + MISC_OFF))[u] = 0u;
    __syncthreads();
    if (tid0 == 0) { const float* const* ap = (const float* const*)&args;
#pragma unroll
        for (int i = 0; i < 24; ++i) { const unsigned long long v = (unsigned long long)ap[i]; ATAB[2 * i] = (unsigned)v; ATAB[2 * i + 1] = (unsigned)(v >> 32); } }
    __syncthreads();
#define ARGP(name) ((const float*)ldp(ATAB, (int)(offsetof(Args, name) / 8)))
#define PHASE_PTRS \
    int tid = threadIdx.x; asm volatile("" : "+v"(tid)); const int lane = tid & 63; (void)lane; \
    unsigned char* const ws = (unsigned char*)ldp(ATAB, 23); float* const out = (float*)ldp(ATAB, 22); unsigned* const ctl = (unsigned*)(ws + WS_CTL); (void)out; (void)ctl; \
    bf16_t* const Win_t = (bf16_t*)(ws + WS_WIN); bf16_t* const Wout_t = (bf16_t*)(ws + WS_WOUT); bf16_t* const Wxq_n = (bf16_t*)(ws + WS_WXQ); bf16_t* const Wxkv_t = (bf16_t*)(ws + WS_WXKV); \
    bf16_t* const Wxo_t = (bf16_t*)(ws + WS_WXO); bf16_t* const Wgu_t = (bf16_t*)(ws + WS_WGU); bf16_t* const Wd_t = (bf16_t*)(ws + WS_WD); \
    float* const RX = (float*)(ws + WS_RX); float* const RMEM = (float*)(ws + WS_RMEM); float* const LF = (float*)(ws + WS_LF); float* const CC = (float*)(ws + WS_C2); float* const SSQ = (float*)(ws + WS_SSQ); \
    int* const TOKSLOT = (int*)(ws + WS_TOKSLOT); float* const TOKW = (float*)(ws + WS_TOKW); int* const LIST = (int*)(ws + WS_LIST); \
    bf16_t* const MEMB = (bf16_t*)(ws + WS_MEMB); bf16_t* const KVM = (bf16_t*)(ws + WS_KVM); bf16_t* const GT = (bf16_t*)(ws + WS_GT); bf16_t* const HT = (bf16_t*)(ws + WS_HT); \
    bf16_t* const XB = (bf16_t*)(ws + WS_XB); bf16_t* const QKV = (bf16_t*)(ws + WS_QKV); bf16_t* const H1B = (bf16_t*)(ws + WS_H1B); bf16_t* const U2B = (bf16_t*)(ws + WS_U2B); bf16_t* const HID = (bf16_t*)(ws + WS_HID); \
    bf16_t* const OAB = (bf16_t*)(ws + WS_O); bf16_t* const YB = (bf16_t*)(ws + WS_Y); bf16_t* const KX = (bf16_t*)(ws + WS_KX); (void)KX; float* const HS = (float*)(ws + WS_HS); (void)HS; float* const R2S = (float*)(ws + WS_SSQ); (void)R2S; unsigned char* const H1F8 = ws + WS_H1F8; (void)H1F8; unsigned char* const H2F8 = ws + WS_H2F8; (void)H2F8; \
    (void)Win_t; (void)Wout_t; (void)Wxq_n; (void)Wxkv_t; (void)Wxo_t; (void)Wgu_t; (void)Wd_t; (void)RX; (void)RMEM; (void)LF; (void)CC; (void)SSQ; (void)TOKSLOT; (void)TOKW; (void)LIST; \
    (void)MEMB; (void)KVM; (void)GT; (void)HT; (void)XB; (void)QKV; (void)H1B; (void)U2B; (void)HID; (void)OAB; (void)YB;
    XcdBarrier bar;
    { unsigned char* const ws0 = (unsigned char*)ldp(ATAB, 23); bar = xcd_barrier_post((unsigned*)(ws0 + WS_CTL) + CW_BAR, MISC + 8); }
    const int gw = vcu * NWAVES + wave, NGW = G * NWAVES;
    unsigned long long t_pa = 0, t_pb = 0; (void)t_pa; (void)t_pb;


    if (PROBE_LO == 0) t_pa = __builtin_amdgcn_s_memrealtime();
    if (PH(0))
    for (int rep_ = 0; rep_ < REPS(0); ++rep_)
    {
        PHASE_PTRS
        LAS float* wfT = (LAS float*)(lds + RING_OFF);
        LAS float* scr = (LAS float*)(lds + RING_OFF + 32768 + wave * 8448);
        { const float* win = ARGP(w_in); const float* gmix = ARGP(norm_mix);
          f32x4 fa[2], fb[2]; float gk[2];
#pragma unroll
          for (int q = 0; q < 2; ++q) { const int k = tid + 512 * q; gk[q] = gmix[k]; fa[q] = *(const f32x4*)(win + (size_t)k * WIN_LD + NPROJ); fb[q] = *(const f32x4*)(win + (size_t)k * WIN_LD + NPROJ + 4); }
#pragma unroll
          for (int q = 0; q < 2; ++q) { const int k = tid + 512 * q;
#pragma unroll
              for (int j = 0; j < 4; ++j) { wfT[j * DM + k] = fa[q][j] * gk[q]; wfT[(4 + j) * DM + k] = fb[q][j] * gk[q]; } } }
        constexpr int I_IN = 16 * 96, I_OUT = 16 * 32, I_XKV = 16 * 64, I_XO = 16 * 32, I_G = 16 * 16 * 8, I_U = I_G, I_D = 16 * 4 * 32, I_XQ = 1024;
        constexpr int NITEMS = I_IN + I_OUT + I_XKV + I_XO + I_G + I_U + I_D + I_XQ;
        for (int it = gw; it < NITEMS; it += NGW) {
            int r = it;
            if (r < I_IN) { const int kb = r / 96, nb = r % 96; transpose_item(ARGP(w_in), WIN_LD, Win_t, DM, 64 * kb, 32 * nb, 32 * nb, ARGP(norm_mix), scr, lane); continue; } r -= I_IN;
            if (r < I_OUT) { const int kb = r / 32, nb = r % 32; const float* gn = (64 * kb < HW) ? ARGP(norm_fox) : (ARGP(norm_sb) - HW); transpose_item(ARGP(w_out), DM, Wout_t, DM, 64 * kb, 32 * nb, 32 * nb, gn, scr, lane); continue; } r -= I_OUT;
            if (r < I_XKV) { const int kb = r / 64, nb = r % 64; transpose_item(ARGP(w_xkv), 2 * DM, Wxkv_t, DM, 64 * kb, 32 * nb, 32 * nb, ARGP(norm_mem), scr, lane); continue; } r -= I_XKV;
            if (r < I_XO) { const int kb = r / 32, nb = r % 32; transpose_item(ARGP(w_xo), DM, Wxo_t, DM, 64 * kb, 32 * nb, 32 * nb, nullptr, scr, lane); continue; } r -= I_XO;
            if (r < I_G + I_U) { const int up = r >= I_G; const int q = up ? r - I_G : r; const int e = q / 128, kb = (q % 128) / 8, nb = q % 8; const int n0 = 32 * nb;
                const float* W = (up ? ARGP(w_up) : ARGP(w_gate)) + (size_t)e * DM * DFF;
                transpose_item8(W, DFF, (unsigned char*)Wgu_t + (size_t)e * 512 * DM, DM, 64 * kb, n0, 256 * (n0 / 128) + (n0 % 128) + (up ? 128 : 0), ARGP(norm_ffn), WGU_SCALE, scr, lane); continue; } r -= I_G + I_U;
            if (r < I_D) { const int e = r / 128, kb = (r % 128) / 32, nb = r % 32; transpose_item8(ARGP(w_down) + (size_t)e * DFF * DM, DM, (unsigned char*)Wd_t + (size_t)e * DM * DFF, DFF, 64 * kb, 32 * nb, 32 * nb, nullptr, WD_SCALE, scr, lane); continue; } r -= I_D;
            { const int k = r; const float gk = ARGP(norm_xattn)[k]; const f32x4* src = (const f32x4*)(ARGP(w_xq) + (size_t)k * DM) + lane; u32x2* dst = (u32x2*)(Wxq_n + (size_t)k * DM) + lane;
#pragma unroll
              for (int j = 0; j < 4; ++j) { const f32x4 v = src[64 * j] * gk; u32x2 w; w.x = cvt_pk_bf16(v[0], v[1]); w.y = cvt_pk_bf16(v[2], v[3]); dst[64 * j] = w; } }
        }
        __syncthreads();
        const float* xin = ARGP(x); const float* memin = ARGP(mem); const float* bfg = ARGP(b_forget);
        constexpr int TOT = M + MEMROWS;
#define P0_LOAD(vv, rw) do { if ((rw) < TOT) { const bool im_ = (rw) >= M; const f32x4* xr_ = (const f32x4*)((im_ ? memin : xin) + (size_t)(im_ ? (rw) - M : (rw)) * DM) + lane; \
        _Pragma("unroll") for (int j = 0; j < 4; ++j) vv[j] = __builtin_nontemporal_load(xr_ + 64 * j); } } while (0)
#define P0_ROW(vv, rw) do { const int row_ = (rw); const bool is_mem = row_ >= M; const int r = is_mem ? row_ - M : row_; float s = 0.f; \
        _Pragma("unroll") for (int j = 0; j < 4; ++j) s += (vv[j][0] * vv[j][0] + vv[j][1] * vv[j][1]) + (vv[j][2] * vv[j][2] + vv[j][3] * vv[j][3]); \
        const float rinv = rsqrtf(wave_sum(s) * (1.0f / DM) + EPS); \
        u32x2* o8 = (u32x2*)((is_mem ? MEMB : XB) + (size_t)r * DM) + lane; \
        _Pragma("unroll") for (int j = 0; j < 4; ++j) { u32x2 w; w.x = cvt_pk_bf16(vv[j][0], vv[j][1]); w.y = cvt_pk_bf16(vv[j][2], vv[j][3]); o8[64 * j] = w; } \
        if (is_mem) { if (lane == 0) RMEM[r] = rinv; } \
        else { float f[8]; \
            _Pragma("unroll") for (int jj = 0; jj < 8; ++jj) { float a = 0.f; \
                _Pragma("unroll") for (int j = 0; j < 4; ++j) { const f32x4 w4 = *(const LAS f32x4*)(wfT + jj * DM + 256 * j + 4 * lane); a += (vv[j][0] * w4[0] + vv[j][1] * w4[1]) + (vv[j][2] * w4[2] + vv[j][3] * w4[3]); } \
                f[jj] = wave_sum(a); } \
            if (lane == 0) RX[r] = rinv; \
            if (lane < 8) { float fl = 0.f; \
                _Pragma("unroll") for (int jj = 0; jj < 8; ++jj) fl = (lane == jj) ? f[jj] : fl; \
                fl = fl * rinv + bfg[lane]; \
                const float ls = fminf(fl, 0.f) - log1pf(expf(-fabsf(fl))); \
                LF[(size_t)r * 8 + lane] = ls * LOG2E; } } } while (0)
        f32x4 va[4], vb[4], vc[4];
        P0_LOAD(va, gw); P0_LOAD(vb, gw + NGW);
        for (int row = gw; row < TOT; row += 3 * NGW) {
            P0_LOAD(vc, row + 2 * NGW); P0_ROW(va, row);
            if (row + NGW < TOT) { P0_LOAD(va, row + 3 * NGW); P0_ROW(vb, row + NGW); }
            if (row + 2 * NGW < TOT) { P0_LOAD(vb, row + 4 * NGW); P0_ROW(vc, row + 2 * NGW); }
        }
#undef P0_LOAD
#undef P0_ROW
    }
    xcd_barrier(bar);
    if (PROBE_HI == 0) t_pb = __builtin_amdgcn_s_memrealtime();

    if (PROBE_LO == 1) t_pa = __builtin_amdgcn_s_memrealtime();
    if (PH(1))
    if (vcu < 32) {
        PHASE_PTRS
        const int b = vcu >> 2, h = (vcu & 3) * 2 + (wave >> 2), seg = wave & 3, s0 = seg * 2048 + lane * 32;
        const float* src = LF + ((size_t)b * SEQ + s0) * 8 + h;
        float p[32];
#pragma unroll
        for (int j = 0; j < 32; ++j) p[j] = src[j * 8];
#pragma unroll
        for (int j = 1; j < 32; ++j) p[j] += p[j - 1];
        float inc = p[31];
#pragma unroll
        for (int o = 1; o < 64; o <<= 1) { const float y = __shfl_up(inc, o); if (lane >= o) inc += y; }
        LAS float* tot = (LAS float*)(lds + EXTRA_OFF);
        if (lane == 63) tot[wave] = inc;
        __syncthreads();
        float off = inc - p[31];
        for (int q = 0; q < 3; ++q) if (q < seg) off += tot[(wave & 4) + q];
        float* dst = CC + ((size_t)b * NH + h) * SEQ + s0; bf16_t* kx = KX + (((size_t)b * NH + h) * SEQ + s0) * 8;
#pragma unroll
        for (int j = 0; j < 32; ++j) { const float x = off + p[j]; dst[j] = x;
            unsigned hm, lo; fox::split3(-x, hm, lo); u32x4 w; w.x = 0x3F803F80u; w.y = 0x3F80u | (hm << 16); w.z = (hm >> 16) | (lo << 16); w.w = 0u;
            *(u32x4*)(kx + j * 8) = w; }
        VM_WAIT(); __syncthreads();
    }
    if (PH(1))
    for (int rep_ = 0; rep_ < REPS(1); ++rep_)
    {
        PHASE_PTRS
        pg8::Gemm g{DM, DM, DM};
        SchedDense S{(const char*)XB, (const char*)Win_t, M / 256, NPROJ / 256, G, bx, (size_t)256 * DM * 2, (size_t)256 * DM * 2, 0, 2};
        LAS float* rst = (LAS float*)(lds + EXTRA_OFF);
        for (int i = 0; i < 16; ++i) { int pm, pn; if (!pg8::tile_order(i, G, bx, M / 256, NPROJ / 256, pm, pn)) break; if (tid < 256) rst[i * 256 + tid] = RX[pm * 256 + tid]; }
        VM_WAIT(); __syncthreads();
        pg8::EpiBf16 E{QKV, HW, RX, QKV_STRIDE, C2, C2, ctl + CW_KN, rst, 1.f};
        pg8::gemm_phase<pg8::EpiBf16, SchedDense, true, false>(lds + RING_OFF, g, S, E);
    }
    xcd_barrier(bar);
    if (PROBE_HI == 1) t_pb = __builtin_amdgcn_s_memrealtime();

    if (PROBE_LO == 2) t_pa = __builtin_amdgcn_s_memrealtime();
    if (PH(2))
    {
        PHASE_PTRS
        const bf16_t* QA = QKV; const bf16_t* KA = QKV + QKV_STRIDE; const bf16_t* VA = QKV + 2 * QKV_STRIDE;
        const bf16_t* QBp = QKV + 3 * QKV_STRIDE; const bf16_t* KBp = QKV + 4 * QKV_STRIDE; const bf16_t* VBp = QKV + 5 * QKV_STRIDE;
        bf16_t* OA = OAB; bf16_t* OB = OAB + HW;
        LAS char* shm = (LAS char*)(lds + RING_OFF);
        { pg8::Gemm g{DM, DM, DM};
          SchedDense S2{(const char*)MEMB, (const char*)Wxkv_t, MEMROWS / 256, 2 * DM / 256, G, bx, (size_t)256 * DM * 2, (size_t)256 * DM * 2, 0, 0};
          pg8::EpiBf16 E2{KVM, 2 * DM, RMEM, 0, 1.f, 1.f, nullptr, nullptr, 1.f};
          pg8::gemm_phase<pg8::EpiBf16, SchedDense, true, false>(lds + RING_OFF, g, S2, E2);
          VM_WAIT(); __syncthreads(); }
        for (int rep = 0; rep < REP_FOX; ++rep)
        for (int i = 0; i < 8; ++i) { const int bh = (vcu >> 5) * 8 + i, x = vcu & 31, qb = (i & 1) ? 31 - x : x;
            const float kmax = sqrtf(__uint_as_float(ctl[CW_KN + bh * 2]) + __uint_as_float(ctl[CW_KN + bh * 2 + 1])) * 1.01f;
            fox::fox_unit<8>(bh, qb, QA, KA, VA, OA, HS + (bh & 7), CC + (size_t)bh * SEQ, KX + (size_t)bh * SEQ * 8, kmax, shm); }
        { volatile LAS unsigned* qs = MISC + 16;
          unsigned nxt = 0u;
          if (tid == 0) qs[0] = __hip_atomic_fetch_add(ctl + CW_SBQ, 1u, __ATOMIC_RELAXED, __HIP_MEMORY_SCOPE_AGENT);
          __syncthreads();
          unsigned idx = qs[0];
          while (idx < (unsigned)(BATCH * NH * 32 * REP_SB)) {
              __syncthreads();
              if (tid == 0) nxt = __hip_atomic_fetch_add(ctl + CW_SBQ, 1u, __ATOMIC_RELAXED, __HIP_MEMORY_SCOPE_AGENT);
              const int un = (int)(idx % (unsigned)(BATCH * NH * 32)), bh = un >> 5, qb = un & 31;
              sbk::sb_unit(bh >> 3, bh & 7, qb, QBp, KBp, VBp, OB, HS + 8 + (bh & 7), shm);
              if (tid == 0) qs[0] = nxt;
              __syncthreads();
              idx = qs[0];
          } }
    }
    xcd_barrier(bar);
    if (PROBE_HI == 2) t_pb = __builtin_amdgcn_s_memrealtime();

    if (PROBE_LO == 4) t_pa = __builtin_amdgcn_s_memrealtime();
    if (PH(4))
    for (int rep_ = 0; rep_ < REPS(4); ++rep_)
    {
        PHASE_PTRS
        pg8::Gemm g{DM, DM, DM};
        SchedDense S{(const char*)OAB, (const char*)Wout_t, M / 256, DM / 256, G, bx, (size_t)256 * DM * 2, (size_t)256 * DM * 2, 0, 0};
        LAS f32x2* rab = (LAS f32x2*)(lds + EXTRA_OFF);
        for (int i = 0; i < 8; ++i) { int pm, pn; if (!pg8::tile_order(i, G, bx, M / 256, DM / 256, pm, pn)) break;
            if (tid < 256) { const f32x4* p = (const f32x4*)(HS + (size_t)(pm * 256 + tid) * 16); const f32x4 a0 = p[0], a1 = p[1], b0 = p[2], b1 = p[3];
                const float ra = rsqrtf((((a0[0] + a0[1]) + (a0[2] + a0[3])) + ((a1[0] + a1[1]) + (a1[2] + a1[3]))) * (1.0f / HW) + EPS);
                const float rb = rsqrtf((((b0[0] + b0[1]) + (b0[2] + b0[3])) + ((b1[0] + b1[1]) + (b1[2] + b1[3]))) * (1.0f / HW) + EPS);
                rab[i * 256 + tid] = (f32x2){ra / rb, rb}; } }
        VM_WAIT(); __syncthreads();
        pg8::EpiOutProj E{XB, H1B, H1F8, SSQ, rab};
        pg8::gemm_phase<pg8::EpiOutProj, SchedDense, true, false>(lds + RING_OFF, g, S, E);
        pg8::Gemm g2{0, 0, 256};
        SchedGH SG{(const char*)KVM, (const char*)Wxq_n, (const char*)Wxo_t, G, bx};
        EpiGH EG{(unsigned char*)GT, (unsigned char*)HT};
        g2.lda = 2 * DM; g2.ldb = DM; SchedGHk<0> S0{SG}; pg8::gemm_phase<EpiGH, SchedGHk<0>, true, false>(lds + RING_OFF, g2, S0, EG);
        g2.lda = DM; g2.ldb = 2 * DM; SchedGHk<1> S1{SG}; pg8::gemm_phase<EpiGH, SchedGHk<1>, true, false>(lds + RING_OFF, g2, S1, EG);
    }
    xcd_barrier(bar);
    if (PROBE_HI == 4) t_pb = __builtin_amdgcn_s_memrealtime();

    if (PROBE_LO == 5) t_pa = __builtin_amdgcn_s_memrealtime();
    if (PH(5))
    for (int rep_ = 0; rep_ < REPS(5); ++rep_)
    {
        PHASE_PTRS
        pg8::Gemm g{DM, DM, DM};
        SchedDense S{(const char*)H1F8, (const char*)GT, M / 256, DM / 256, G, bx, (size_t)256 * DM, (size_t)256 * DM, (size_t)DM * DM, 0};
        LAS float* r1t = (LAS float*)(lds + EXTRA_OFF + 8192);
        for (int i = 0; i < 8; ++i) { int pm, pn; if (!pg8::tile_order(i, G, bx, M / 256, DM / 256, pm, pn)) break;
            if (tid < 256) { const f32x4* sp = (const f32x4*)(SSQ + (size_t)(pm * 256 + tid) * 16); const f32x4 s0 = sp[0], s1 = sp[1], s2 = sp[2], s3 = sp[3];
                const float tot = ((s0[0] + s0[1]) + (s0[2] + s0[3])) + ((s1[0] + s1[1]) + (s1[2] + s1[3])) + ((s2[0] + s2[1]) + (s2[2] + s2[3])) + ((s3[0] + s3[1]) + (s3[2] + s3[3]));
                r1t[i * 256 + tid] = rsqrtf(tot * (1.0f / DM) + EPS) * XSC; } }
        VM_WAIT(); __syncthreads();
        pg8::EpiSoftmax E{XB, r1t, (LAS float*)(lds + EXTRA_OFF)};
        pg8::gemm_phase<pg8::EpiSoftmax, SchedDense, true, false, true>(lds + RING_OFF, g, S, E);
    }
    xcd_barrier(bar);
    if (PROBE_HI == 5) t_pb = __builtin_amdgcn_s_memrealtime();

    if (PROBE_LO == 6) t_pa = __builtin_amdgcn_s_memrealtime();
    if (PH(6))
    {
        PHASE_PTRS
        pg8::Gemm g{DM, DM, DM};
        SchedDense S{(const char*)XB, (const char*)HT, M / 256, DM / 256, G, bx, (size_t)256 * DM, (size_t)256 * DM, (size_t)DM * DM, 0};
        pg8::EpiResidBf16 E{H1B, H2F8, 1.0f / P_SCALE};
        pg8::gemm_phase<pg8::EpiResidBf16, SchedDense, true, false, true>(lds + RING_OFF, g, S, E);
    }
    xcd_barrier(bar);
    if (PROBE_HI == 6) t_pb = __builtin_amdgcn_s_memrealtime();

    if (PROBE_LO == 7) t_pa = __builtin_amdgcn_s_memrealtime();
    if (PH(7))
    {
        PHASE_PTRS
        LAS bf16_t* wBh = (LAS bf16_t*)(lds + RING_OFF); LAS bf16_t* wBl = wBh + 20 * DM;
        { const f32x4* wg4 = (const f32x4*)ARGP(w_rg); const f32x4* we4 = (const f32x4*)ARGP(w_re); const float* gf = ARGP(norm_ffn);
          f32x4 ga[2], ea[2][4]; float gk[2];
#pragma unroll
          for (int q = 0; q < 2; ++q) { const int k = tid + 512 * q; ga[q] = wg4[k]; gk[q] = gf[k];
#pragma unroll
              for (int c = 0; c < 4; ++c) ea[q][c] = we4[k * 4 + c]; }
#pragma unroll
          for (int q = 0; q < 2; ++q) { const int k = tid + 512 * q;
#pragma unroll
              for (int j = 0; j < 4; ++j) { { const float v = ga[q][j] * gk[q]; const unsigned hi_ = cvt_pk_bf16(v, 0.f) & 0xffffu; wBh[j * DM + k] = (bf16_t)hi_; wBl[j * DM + k] = (bf16_t)(cvt_pk_bf16(v - __uint_as_float(hi_ << 16), 0.f) & 0xffffu); }
#pragma unroll
                  for (int c = 0; c < 4; ++c) { const float v = ea[q][c][j] * gk[q]; const unsigned hi_ = cvt_pk_bf16(v, 0.f) & 0xffffu; const int col = 4 + 4 * c + j; wBh[col * DM + k] = (bf16_t)hi_; wBl[col * DM + k] = (bf16_t)(cvt_pk_bf16(v - __uint_as_float(hi_ << 16), 0.f) & 0xffffu); } } } }
        LAS int* dec_e = (LAS int*)(lds + RING_OFF + 81920); LAS float* dec_w = (LAS float*)(lds + RING_OFF + 81920 + 2048); LAS int* dec_r = (LAS int*)(lds + RING_OFF + 81920 + 4096);
        LAS int* hist = (LAS int*)(lds + RING_OFF + 81920 + 6144); LAS int* ebase = hist + 16; LAS float* dec_v = (LAS float*)(lds + RING_OFF + 81920 + 8192);
        if (tid < 16) hist[tid] = 0;
        __syncthreads();
        const float brg0 = ARGP(b_rg)[0], brg1 = ARGP(b_rg)[1], brg2 = ARGP(b_rg)[2], brg3 = ARGP(b_rg)[3]; const float* bre = ARGP(b_re);
        const int tok = lane & 31, half = lane >> 5, jcol = tok < 20 ? tok : 19;
        for (int it = 0; it * NGW < M / 32; ++it) {
            const int T = gw + it * NGW; const bool act = T < M / 32; const int r0 = act ? 32 * T : 0;
            const bf16_t* rowp = H1B + (size_t)(r0 + tok) * DM + 512 * half;
            const LAS bf16_t* wph = wBh + jcol * DM + 512 * half; const LAS bf16_t* wpl = wBl + jcol * DM + 512 * half;
            f32x16 ah0 = f32x16{}, ah1 = f32x16{}, al0 = f32x16{}, al1 = f32x16{}; float ssq = 0.f;
#pragma unroll 4
            for (int sidx = 0; sidx < 64; sidx += 2) {
                const u32x4 a0 = *(const u32x4*)(rowp + 8 * sidx), a1 = *(const u32x4*)(rowp + 8 * sidx + 8);
                const bf16x8 wh0 = *(const LAS bf16x8*)(wph + 8 * sidx), wl0 = *(const LAS bf16x8*)(wpl + 8 * sidx), wh1 = *(const LAS bf16x8*)(wph + 8 * sidx + 8), wl1 = *(const LAS bf16x8*)(wpl + 8 * sidx + 8);
                ah0 = MFMA32(wh0, __builtin_bit_cast(bf16x8, a0), ah0); al0 = MFMA32(wl0, __builtin_bit_cast(bf16x8, a0), al0);
                ah1 = MFMA32(wh1, __builtin_bit_cast(bf16x8, a1), ah1); al1 = MFMA32(wl1, __builtin_bit_cast(bf16x8, a1), al1);
                ssq += (bf16lo(a0.x) * bf16lo(a0.x) + bf16hi(a0.x) * bf16hi(a0.x)) + (bf16lo(a0.y) * bf16lo(a0.y) + bf16hi(a0.y) * bf16hi(a0.y)) + (bf16lo(a0.z) * bf16lo(a0.z) + bf16hi(a0.z) * bf16hi(a0.z)) + (bf16lo(a0.w) * bf16lo(a0.w) + bf16hi(a0.w) * bf16hi(a0.w));
                ssq += (bf16lo(a1.x) * bf16lo(a1.x) + bf16hi(a1.x) * bf16hi(a1.x)) + (bf16lo(a1.y) * bf16lo(a1.y) + bf16hi(a1.y) * bf16hi(a1.y)) + (bf16lo(a1.z) * bf16lo(a1.z) + bf16hi(a1.z) * bf16hi(a1.z)) + (bf16lo(a1.w) * bf16lo(a1.w) + bf16hi(a1.w) * bf16hi(a1.w));
            }
            const float rinv = rsqrtf((att::swap_lo(ssq) + att::swap_hi(ssq)) * (1.0f / DM) + EPS);
            float lg[20];
#pragma unroll
            for (int r = 0; r < 12; ++r) { const float c = (ah0[r] + ah1[r]) + (al0[r] + al1[r]); auto rr = __builtin_amdgcn_permlane32_swap(__float_as_uint(c), __float_as_uint(c), false, false);
                const int jl = (r & 3) + 8 * (r >> 2); lg[jl] = __uint_as_float(rr[0]) * rinv; if (r < 8) lg[jl + 4] = __uint_as_float(rr[1]) * rinv; }
            float g0 = lg[0] + brg0, g1 = lg[1] + brg1, g2 = lg[2] + brg2, g3 = lg[3] + brg3;
            int gi = 0; float gm = g0; if (g1 > gm) { gm = g1; gi = 1; } if (g2 > gm) { gm = g2; gi = 2; } if (g3 > gm) { gm = g3; gi = 3; }
            const float gval = 1.0f / (expf(g0 - gm) + expf(g1 - gm) + expf(g2 - gm) + expf(g3 - gm));
            float el[4];
#pragma unroll
            for (int j = 0; j < 4; ++j) { const float e0 = lg[4 + j], e1 = lg[8 + j], e2 = lg[12 + j], e3 = lg[16 + j]; el[j] = ((gi == 0) ? e0 : (gi == 1) ? e1 : (gi == 2) ? e2 : e3) + bre[gi * 4 + j]; }
            int i0 = 0; float m0 = el[0];
#pragma unroll
            for (int j = 1; j < 4; ++j) if (el[j] > m0) { m0 = el[j]; i0 = j; }
            int i1 = -1; float m1 = -3.0e38f;
#pragma unroll
            for (int j = 0; j < 4; ++j) if (j != i0 && el[j] > m1) { m1 = el[j]; i1 = j; }
            const float w0 = 1.0f / (1.0f + expf(m1 - m0)), w1 = 1.0f - w0;
            if (act) { const int e = gi * 4 + (half == 0 ? i0 : i1); const float w = gval * (half == 0 ? w0 : w1);
                const int idx = (wave * 32 + tok) * 2 + half; dec_e[idx] = e; dec_w[idx] = w; dec_v[idx] = rinv; dec_r[idx] = __hip_atomic_fetch_add(hist + e, 1, __ATOMIC_RELAXED, __HIP_MEMORY_SCOPE_WORKGROUP); }
            __syncthreads();
            if (tid < 16) { const int n = hist[tid]; ebase[tid] = n ? (int)__hip_atomic_fetch_add(ctl + CW_CNT + 64 * tid, (unsigned)n, __ATOMIC_RELAXED, __HIP_MEMORY_SCOPE_AGENT) : 0; }
            __syncthreads();
            if (act) { const int row = r0 + (lane >> 1), idx = wave * 64 + lane; const int e = dec_e[idx], pos = ebase[e] + dec_r[idx];
                LIST[(size_t)e * M + pos] = row; R2S[(size_t)e * M + pos] = dec_v[idx]; TOKSLOT[(size_t)row * 2 + (lane & 1)] = (e << 20) | pos; TOKW[(size_t)row * 2 + (lane & 1)] = dec_w[idx]; }
            __syncthreads();
            if (tid < 16) hist[tid] = 0;
            __syncthreads();
        }
    }
    xcd_barrier(bar);
    if (PROBE_HI == 7) t_pb = __builtin_amdgcn_s_memrealtime();

    if (PROBE_LO == 8) t_pa = __builtin_amdgcn_s_memrealtime();
    if (PH(8))
    for (int rep_ = 0; rep_ < REPS(8); ++rep_)
    {
        PHASE_PTRS
        pg8::Gemm g{DM, DM, DM};
        LAS int* tbl = (LAS int*)(lds + EXTRA_OFF + 8192); moe_table(tbl, ctl);
        SchedMoe S; S.A = (const char*)H2F8; S.W = (const char*)Wgu_t; S.list = LIST; S.tbl = tbl; S.G = G; S.c = bx; S.NPN = 2; S.w_exp = (size_t)512 * DM; S.w_tile = (size_t)256 * DM; S.a_tile = 0; S.ocol_w = 128;
        pg8::EpiSwiglu E{HID, R2S, LIST};
        pg8::gemm_phase<pg8::EpiSwiglu, SchedMoe, true, true, true>(lds + RING_OFF, g, S, E);
    }
    xcd_barrier(bar);
    if (PROBE_HI == 8) t_pb = __builtin_amdgcn_s_memrealtime();

    if (PROBE_LO == 9) t_pa = __builtin_amdgcn_s_memrealtime();
    if (PH(9))
    for (int rep_ = 0; rep_ < REPS(9); ++rep_)
    {
        PHASE_PTRS
        pg8::Gemm g{DFF, DFF, DFF};
        LAS int* tbl = (LAS int*)(lds + EXTRA_OFF + 8192);
        SchedMoe S; S.A = (const char*)HID; S.W = (const char*)Wd_t; S.list = LIST; S.tbl = tbl; S.G = G; S.c = bx; S.NPN = 4; S.w_exp = (size_t)DM * DFF; S.w_tile = (size_t)256 * DFF; S.a_tile = (size_t)256 * DFF; S.ocol_w = 256;
        pg8::EpiBf16 E{YB, DM, nullptr, 0, 1.f, 1.f, nullptr, nullptr, 1.0f / WD_SCALE};
        pg8::gemm_phase<pg8::EpiBf16, SchedMoe, true, false, true>(lds + RING_OFF, g, S, E);
    }
    xcd_barrier(bar);
    if (PROBE_HI == 9) t_pb = __builtin_amdgcn_s_memrealtime();

    if (PROBE_LO == 10) t_pa = __builtin_amdgcn_s_memrealtime();
    if (PH(10))
    {
        PHASE_PTRS
        const LAS int* tb = (const LAS int*)(lds + EXTRA_OFF + 8192);
        const f32x4* gp = (const f32x4*)ARGP(norm_final) + lane;
        int sl0 = 0, sl1 = 0; float sw0 = 0.f, sw1 = 0.f;
        u32x2 ya_n[4], yb_n[4], hh_n[4]; float w0_n = 0.f, w1_n = 0.f;
#define P10_SLOTS(rw) do { sl0 = TOKSLOT[(size_t)(rw) * 2]; sl1 = TOKSLOT[(size_t)(rw) * 2 + 1]; sw0 = TOKW[(size_t)(rw) * 2]; sw1 = TOKW[(size_t)(rw) * 2 + 1]; } while (0)
#define P10_DATA(rw) do { const int r0_ = tb[sl0 >> 20] * 256 + (sl0 & 0xfffff), r1_ = tb[sl1 >> 20] * 256 + (sl1 & 0xfffff); w0_n = sw0; w1_n = sw1; \
        const u32x2* y0_ = (const u32x2*)(YB + (size_t)r0_ * DM) + lane; const u32x2* y1_ = (const u32x2*)(YB + (size_t)r1_ * DM) + lane; const u32x2* h_ = (const u32x2*)(H1B + (size_t)(rw) * DM) + lane; \
        _Pragma("unroll") for (int j = 0; j < 4; ++j) { ya_n[j] = y0_[64 * j]; yb_n[j] = y1_[64 * j]; hh_n[j] = h_[64 * j]; } } while (0)
        if (gw < M) { P10_SLOTS(gw); P10_DATA(gw); if (gw + NGW < M) P10_SLOTS(gw + NGW); }
        for (int row = gw; row < M; row += NGW) {
            u32x2 ya[4], yb[4], hh[4]; const float w0 = w0_n, w1 = w1_n;
#pragma unroll
            for (int j = 0; j < 4; ++j) { ya[j] = ya_n[j]; yb[j] = yb_n[j]; hh[j] = hh_n[j]; }
            if (row + NGW < M) { P10_DATA(row + NGW); if (row + 2 * NGW < M) P10_SLOTS(row + 2 * NGW); }
            f32x4* hr = (f32x4*)(out + (size_t)row * DM) + lane;
            f32x4 v[4]; float s = 0.f;
#pragma unroll
            for (int j = 0; j < 4; ++j) { const u32x2 a = ya[j], b = yb[j]; const u32x2 hx = hh[j]; f32x4 h = {bf16lo(hx.x), bf16hi(hx.x), bf16lo(hx.y), bf16hi(hx.y)};
                h[0] += w0 * bf16lo(a.x) + w1 * bf16lo(b.x); h[1] += w0 * bf16hi(a.x) + w1 * bf16hi(b.x); h[2] += w0 * bf16lo(a.y) + w1 * bf16lo(b.y); h[3] += w0 * bf16hi(a.y) + w1 * bf16hi(b.y);
                v[j] = h; s += (h[0] * h[0] + h[1] * h[1]) + (h[2] * h[2] + h[3] * h[3]); }
            const float rinv = rsqrtf(wave_sum(s) * (1.0f / DM) + EPS);
#pragma unroll
            for (int j = 0; j < 4; ++j) __builtin_nontemporal_store(v[j] * rinv * gp[64 * j], hr + 64 * j);
        }
#undef P10_SLOTS
#undef P10_DATA
    }
    if (PROBE_LO >= 0) {
        if (PROBE_HI == 10) t_pb = __builtin_amdgcn_s_memrealtime();
        if (blockIdx.x == 0 && threadIdx.x == 0) { const unsigned long long t0 = __builtin_amdgcn_s_memrealtime(), span = 2 * (t_pb - t_pa);
            while (__builtin_amdgcn_s_memrealtime() - t0 < span) __builtin_amdgcn_s_sleep(8); }
    }
}

extern "C" void kernel_launch(void* const* d_in, const int* in_sizes, int n_in, void* d_out, int out_size, void* d_ws, size_t ws_size, hipStream_t stream) {
    static int grid = 0;
    if (grid == 0) {
        if (n_in != 22 || in_sizes[0] != M * DM || out_size != M * DM || ws_size < WS_END) { fprintf(stderr, "kernel_launch: unexpected shapes (n_in %d, in0 %d, out %d, ws %zu)\n", n_in, n_in > 0 ? in_sizes[0] : -1, out_size, ws_size); grid = -1; return; }
        int dev = 0, cus = 0, per_cu = 0;
        if (hipGetDevice(&dev) != hipSuccess || hipDeviceGetAttribute(&cus, hipDeviceAttributeMultiprocessorCount, dev) != hipSuccess) { grid = -1; return; }
        if (hipFuncSetAttribute((const void*)hymba_fwd, hipFuncAttributeMaxDynamicSharedMemorySize, LDS_BYTES) != hipSuccess) { fprintf(stderr, "kernel_launch: hipFuncSetAttribute failed\n"); grid = -1; return; }
        if (hipOccupancyMaxActiveBlocksPerMultiprocessor(&per_cu, (const void*)hymba_fwd, NWAVES * 64, LDS_BYTES) != hipSuccess || per_cu < 1) { fprintf(stderr, "kernel_launch: occupancy query reports %d\n", per_cu); }
        (void)hipGetLastError();
        grid = cus;
    }
    if (grid < 0) return;
    (void)hipMemsetAsync((char*)d_ws + WS_CTL, 0, CTL_ZERO_BYTES, stream);
    Args a{};
    const float** p = (const float**)&a;
    for (int i = 0; i < 22; ++i) p[i] = (const float*)d_in[i];
    a.out = (float*)d_out; a.ws = (unsigned char*)d_ws;
    hipLaunchKernelGGL(hymba_fwd, dim3(grid), dim3(NWAVES * 64), LDS_BYTES, stream, a);
}
```

```cpp
#include <hip/hip_runtime.h>
#include <hip/hip_bf16.h>
#include <cstdio>
#include <cstdint>

#define LAS __attribute__((address_space(3)))
#define GAS __attribute__((address_space(1)))
typedef unsigned short bf16_t;
typedef short bf16x8 __attribute__((ext_vector_type(8)));
typedef short s16x4 __attribute__((ext_vector_type(4)));
typedef float f32x4 __attribute__((ext_vector_type(4)));
typedef float f32x2 __attribute__((ext_vector_type(2)));
typedef float f32x16 __attribute__((ext_vector_type(16)));
typedef unsigned u32x4 __attribute__((ext_vector_type(4)));
typedef unsigned u32x2 __attribute__((ext_vector_type(2)));
typedef __bf16 bf16x2_t __attribute__((ext_vector_type(2)));

constexpr int BATCH = 8, SEQ = 8192, DM = 1024, M = BATCH * SEQ;
constexpr int NH = 8, HD = 64, HW = NH * HD;
constexpr int NPROJ = 3 * HW * 2;
constexpr int WIN_LD = NPROJ + NH;
constexpr int NMEM = 256, XH = 4, XD = 256, MEMROWS = BATCH * NMEM;
constexpr int NEXP = 16, DFF = 256;
constexpr float EPS = 1e-6f;
constexpr float LOG2E = 1.4426950408889634f;
constexpr float C2 = 0.125f * LOG2E;
constexpr float XSC = 0.0625f * LOG2E;
constexpr float P_SCALE = 128.0f;
constexpr float WGU_SCALE = 32.0f;
constexpr float WD_SCALE = 16.0f;
constexpr float SB_EXIT = -48.0f;

constexpr size_t MiB = 1u << 20;
constexpr size_t WS_CTL = 0, CTL_ZERO_BYTES = 128 * 1024;
constexpr size_t WS_WIN = 1 * MiB;
constexpr size_t WS_WOUT = 7 * MiB;
constexpr size_t WS_WXQ = 9 * MiB;
constexpr size_t WS_WXKV = 11 * MiB;
constexpr size_t WS_WXO = 15 * MiB;
constexpr size_t WS_WGU = 17 * MiB;
constexpr size_t WS_WD = 33 * MiB;
constexpr size_t WS_RX = 41 * MiB;
constexpr size_t WS_RMEM = WS_RX + 256 * 1024;
constexpr size_t WS_R2 = WS_RX + 512 * 1024;
constexpr size_t WS_LF = 42 * MiB;
constexpr size_t WS_C2 = 44 * MiB;
constexpr size_t WS_SSQ = 46 * MiB;
constexpr size_t WS_TOKSLOT = 50 * MiB;
constexpr size_t WS_TOKW = 51 * MiB;
constexpr size_t WS_LIST = 52 * MiB;
constexpr size_t WS_MEMB = 56 * MiB;
constexpr size_t WS_KVM = 60 * MiB;
constexpr size_t WS_GT = 68 * MiB;
constexpr size_t WS_HT = 84 * MiB;
constexpr size_t WS_KX = 100 * MiB;
constexpr size_t WS_HS = 108 * MiB;
constexpr size_t WS_XB = 128 * MiB;
constexpr size_t WS_QKV = 256 * MiB;
constexpr size_t WS_H1B = 256 * MiB, WS_U2B = 384 * MiB, WS_HID = 512 * MiB;
constexpr size_t WS_H1F8 = 384 * MiB, WS_H2F8 = 448 * MiB;
constexpr size_t WS_O = 640 * MiB;
constexpr size_t WS_Y = 704 * MiB;
constexpr size_t WS_END = 1024 * MiB;
constexpr size_t QKV_STRIDE = (size_t)M * HW;
constexpr int MAXTILES = M * 2 / 256 + NEXP;
static_assert(WS_Y + (size_t)MAXTILES * 256 * 1024 * 2 <= WS_END, "ws map");
static_assert(WS_HID + (size_t)MAXTILES * 256 * 256 * 2 <= WS_O, "ws map");
constexpr int CW_BAR = 4096;
constexpr int CW_SBQ = 20736;
constexpr int CW_KN = 20480;
constexpr int CW_CNT = 16384;

constexpr int RING_OFF = 0, RING_BYTES = 131072;
constexpr int EXTRA_OFF = 131072, EXTRA_BYTES = 16384;
constexpr int MISC_OFF = EXTRA_OFF + EXTRA_BYTES;
constexpr int LDS_BYTES = MISC_OFF + 1024;
constexpr int NWAVES = 8;
#ifndef PHASE_MASK
#define PHASE_MASK 0x7ff
#endif
#define PH(n) ((PHASE_MASK >> (n)) & 1)
#ifndef PROBE_LO
#define PROBE_LO -1
#endif
#ifndef PROBE_HI
#define PROBE_HI -1
#endif
#ifndef FOX_V2
#define FOX_V2 1
#endif
#ifndef REP_MASK
#define REP_MASK 0
#endif
#define REPS(n) (1 + ((REP_MASK >> (n)) & 1))
#ifndef REP_FOX
#define REP_FOX 1
#endif
#ifndef REP_SB
#define REP_SB 1
#endif

__device__ __forceinline__ unsigned cvt_pk_bf16(float lo, float hi) { f32x2 v = {lo, hi}; bf16x2_t b = __builtin_convertvector(v, bf16x2_t); return __builtin_bit_cast(unsigned, b); }
__device__ __forceinline__ unsigned cvt4_fp8(float a, float b, float c, float d) { int w = 0; w = __builtin_amdgcn_cvt_pk_fp8_f32(a, b, w, false); w = __builtin_amdgcn_cvt_pk_fp8_f32(c, d, w, true); return (unsigned)w; }
__device__ __forceinline__ float bf16lo(unsigned u) { return __uint_as_float(u << 16); }
__device__ __forceinline__ float bf16hi(unsigned u) { return __uint_as_float(u & 0xffff0000u); }
#define DPP_ADD(v, CTRL) v += __builtin_bit_cast(float, __builtin_amdgcn_update_dpp(0, __builtin_bit_cast(int, v), CTRL, 0xf, 0xf, true))
__device__ __forceinline__ float wave_sum(float v) {
    DPP_ADD(v, 0xB1); DPP_ADD(v, 0x4E); DPP_ADD(v, 0x141); DPP_ADD(v, 0x140);
    const int iv = __builtin_bit_cast(int, v);
    return (__builtin_bit_cast(float, __builtin_amdgcn_readlane(iv, 0)) + __builtin_bit_cast(float, __builtin_amdgcn_readlane(iv, 16))) +
           (__builtin_bit_cast(float, __builtin_amdgcn_readlane(iv, 32)) + __builtin_bit_cast(float, __builtin_amdgcn_readlane(iv, 48)));
}
#define LDS_WAIT() asm volatile("s_waitcnt lgkmcnt(0)" ::: "memory")
#define VM_WAIT() asm volatile("s_waitcnt vmcnt(0)" ::: "memory")

namespace pg8 {
constexpr int BM = 256, BK = 64, HALF = 128, HTB = HALF * BK * 2, STAGE_BYTES = 8 * HTB, NXCD = 8, WGM = 8;
__host__ __device__ __forceinline__ int lds_byte(int r, int c) { const int st = (r >> 4) * 2 + (c >> 5), rr = r & 15, cc = c & 31, ob = rr * 64 + cc * 2; return st * 1024 + (ob ^ (((ob >> 9) & 1) << 5)); }
__host__ __device__ __forceinline__ void stage_rc(int b, int& R, int& C) { const int st = b / 1024, sb = b % 1024, swz = sb ^ (((sb >> 9) & 1) << 5); R = (st >> 1) * 16 + swz / 64; C = (st & 1) * 32 + (swz % 64) / 2; }
__host__ __device__ __forceinline__ int perm32(int rho) { const int n = rho >> 4, i = rho & 15; return 8 * (i >> 2) + 4 * n + (i & 3); }

struct Unit { const char* a; const char* b; int orow, ocol, aux; const int* rows; int nvalid; int seq; };
struct Gemm { int lda, ldb, K; };

__device__ __forceinline__ bool tile_order(int i, int G, int c, int nM, int nN, int& pm, int& pn) {
    const int nwg = nM * nN; const long L = (long)i * G + c; if (L >= nwg) return false;
    int wgid = (int)L; { const int q = nwg / NXCD, r = nwg % NXCD, xcd = wgid % NXCD, off = wgid / NXCD; wgid = (xcd < r ? xcd * (q + 1) : r * (q + 1) + (xcd - r) * q) + off; }
    const int nig = WGM * nN, gid = wgid / nig, fm = gid * WGM, gsz = (nM - fm) < WGM ? (nM - fm) : WGM;
    pm = fm + ((wgid % nig) % gsz); pn = (wgid % nig) / gsz; return true;
}

typedef int v8i32 __attribute__((ext_vector_type(8)));
template <class Epi, class Sched, bool ALIGN_EPI, bool GATHER, bool FP8 = false>
__device__ __forceinline__ void gemm_phase(LAS unsigned char* lds, const Gemm g, const Sched& S, const Epi& E) {
    int tid = threadIdx.x; asm volatile("" : "+v"(tid));
    const int wid = __builtin_amdgcn_readfirstlane(tid >> 6), lane = tid & 63, wr = wid >> 2, wc = wid & 3, fr = lane & 15, fq = lane >> 4;
    constexpr int ESZ = FP8 ? 1 : 2;
    const int K = g.K, nt = K / (FP8 ? 2 * BK : BK);
    unsigned voffA[2], voffB[2]; int RA[2], CA[2];
#pragma unroll
    for (int i = 0; i < 2; ++i) { int R, C; stage_rc(tid * 16 + i * 8192, R, C); const int Rb = (R & ~31) + perm32(R & 31);
        RA[i] = R; CA[i] = C; voffA[i] = (unsigned)(R * g.lda * ESZ + C * 2); voffB[i] = (unsigned)(Rb * g.ldb * ESZ + C * 2); }
    const size_t kstep = (size_t)(BK * 2);
    const size_t hstepA = (size_t)HALF * g.lda * ESZ, hstepB = (size_t)HALF * g.ldb * ESZ;
    const unsigned ldsw = (unsigned)wid * 1024u;
    const int aoff = lds_byte(wr * 64 + fr, FP8 ? fq * 16 : fq * 8), boff = lds_byte(wc * 32 + fr, FP8 ? fq * 16 : fq * 8);
    constexpr int KOFF = FP8 ? 16 : 1024;
#define PG8_SA(b, h) (((b) * 2 + (h)) * HTB)
#define PG8_SB(b, h) ((4 + (b) * 2 + (h)) * HTB)
#define PG8_STAGE2(bufoff, gbase, v0, v1) do { \
        __builtin_amdgcn_global_load_lds((const unsigned*)((const char*)(gbase) + (v0)), (LAS unsigned*)(lds + (bufoff) + ldsw), 16, 0, 0); \
        __builtin_amdgcn_global_load_lds((const unsigned*)((const char*)(gbase) + (v1)), (LAS unsigned*)(lds + (bufoff) + ldsw + 8192), 16, 0, 0); } while (0)
#define PG8_STAGEB(bufoff, gbase) PG8_STAGE2(bufoff, gbase, voffB[0], voffB[1])
#define PG8_STAGEA(bufoff, kptr, h, NX) do { if constexpr (GATHER) { const unsigned v0_ = (NX) ? gvn[h][0] : gvc[h][0], v1_ = (NX) ? gvn[h][1] : gvc[h][1]; PG8_STAGE2(bufoff, kptr, v0_, v1_); } \
        else { PG8_STAGE2(bufoff, (kptr) + (h) * hstepA, voffA[0], voffA[1]); } } while (0)
#define PG8_LDA(dst, b, h) do { _Pragma("unroll") for (int m = 0; m < 4; ++m) _Pragma("unroll") for (int k = 0; k < 2; ++k) dst[m][k] = *(const LAS bf16x8*)(lds + PG8_SA(b, h) + aoff + m * 2048 + k * KOFF); } while (0)
#define PG8_LDB(dst, b, h) do { _Pragma("unroll") for (int n = 0; n < 2; ++n) _Pragma("unroll") for (int k = 0; k < 2; ++k) dst[n][k] = *(const LAS bf16x8*)(lds + PG8_SB(b, h) + boff + n * 2048 + k * KOFF); } while (0)
#define PG8_CAT(x) __builtin_shufflevector(__builtin_bit_cast(f32x4, (x)[0]), __builtin_bit_cast(f32x4, (x)[1]), 0, 1, 2, 3, 4, 5, 6, 7)
#define PG8_MMA(ai, bj, At, Bt) do { __builtin_amdgcn_s_setprio(1); _Pragma("unroll") for (int m = 0; m < 4; ++m) _Pragma("unroll") for (int n = 0; n < 2; ++n) { \
        if constexpr (FP8) { acc[ai][bj][m][n] = __builtin_amdgcn_mfma_scale_f32_16x16x128_f8f6f4(__builtin_bit_cast(v8i32, PG8_CAT(Bt[n])), __builtin_bit_cast(v8i32, PG8_CAT(At[m])), acc[ai][bj][m][n], 0, 0, 0, 0x7F7F7F7F, 0, 0x7F7F7F7F); } \
        else { _Pragma("unroll") for (int k = 0; k < 2; ++k) acc[ai][bj][m][n] = __builtin_amdgcn_mfma_f32_16x16x32_bf16(Bt[n][k], At[m][k], acc[ai][bj][m][n], 0, 0, 0); } } \
        _Pragma("unroll") for (int m = 0; m < 4; ++m) _Pragma("unroll") for (int n = 0; n < 2; ++n) asm volatile("" : "+v"(acc[ai][bj][m][n]));     \
        __builtin_amdgcn_s_setprio(0); } while (0)
#define PG8_WAIT_V(n) asm volatile("s_waitcnt vmcnt(" #n ")" ::: "memory")
#define PG8_WAIT_L(n) asm volatile("s_waitcnt lgkmcnt(" #n ")" ::: "memory")
#define PG8_BAR __builtin_amdgcn_s_barrier()
#define PG8_SCHED __builtin_amdgcn_sched_barrier(0)
#define PG8_GATHER_OFFS(dst, u) do { _Pragma("unroll") for (int h_ = 0; h_ < 2; ++h_) _Pragma("unroll") for (int i_ = 0; i_ < 2; ++i_) { const int r_ = h_ * HALF + RA[i_]; \
        const int idx_ = (u).rows[r_ < (u).nvalid ? r_ : 0]; dst[h_][i_] = (unsigned)(idx_ * g.lda * ESZ + CA[i_] * 2); } } while (0)
    Unit cur, nxt; int ui = 0;
    if (!S.next(0, cur)) return;
    cur.seq = 0;
    unsigned gvc[2][2] = {{0u, 0u}, {0u, 0u}}, gvn[2][2] = {{0u, 0u}, {0u, 0u}};
    if constexpr (GATHER) { PG8_GATHER_OFFS(gvc, cur); }
    f32x4 acc[2][2][4][2];
#pragma unroll
    for (int a = 0; a < 2; ++a)
#pragma unroll
        for (int b = 0; b < 2; ++b)
#pragma unroll
            for (int m = 0; m < 4; ++m)
#pragma unroll
                for (int n = 0; n < 2; ++n) acc[a][b][m][n] = (f32x4){0.f, 0.f, 0.f, 0.f};
    bf16x8 At[4][2], B0[2][2], B1[2][2];
    const char* cA = cur.a; const char* cB = cur.b;
    PG8_STAGEB(PG8_SB(0, 0), cB); PG8_STAGEB(PG8_SB(0, 1), cB + hstepB); PG8_STAGEA(PG8_SA(0, 0), cA, 0, false); PG8_STAGEA(PG8_SA(0, 1), cA, 1, false);
    if (wr == 1) PG8_BAR;
    PG8_WAIT_V(2); PG8_BAR;
    PG8_STAGEB(PG8_SB(1, 0), cB + kstep); PG8_STAGEA(PG8_SA(1, 0), cA + kstep, 0, false); PG8_STAGEB(PG8_SB(1, 1), cB + hstepB + kstep);
    PG8_WAIT_V(6); PG8_BAR;
    for (;;) {
        const bool has_next = S.next(ui + 1, nxt); nxt.seq = ui + 1;
        const char* nA = has_next ? nxt.a : cA; const char* nB = has_next ? nxt.b : cB;
        if constexpr (GATHER) { if (has_next) { PG8_GATHER_OFFS(gvn, nxt); } else { gvn[0][0] = gvc[0][0]; gvn[0][1] = gvc[0][1]; gvn[1][0] = gvc[1][0]; gvn[1][1] = gvc[1][1]; } }
#pragma unroll 1
        for (int t = 0; t < nt; t += 2) {
            const bool last = (t == nt - 2);
            const char* a1 = cA + (size_t)(t + 1) * kstep;
            const char* a2 = last ? nA : cA + (size_t)(t + 2) * kstep; const char* b2 = last ? nB : cB + (size_t)(t + 2) * kstep;
            const char* a3 = a2 + kstep; const char* b3 = b2 + kstep;
            PG8_LDB(B0, 0, 0); PG8_LDB(B1, 0, 1); PG8_SCHED; PG8_LDA(At, 0, 0); PG8_STAGEA(PG8_SA(1, 1), a1, 1, false);
            PG8_WAIT_V(8); PG8_WAIT_L(0); PG8_BAR; PG8_MMA(0, 0, At, B0); PG8_MMA(0, 1, At, B1); PG8_BAR; PG8_SCHED;
            PG8_LDA(At, 0, 1); PG8_STAGEB(PG8_SB(0, 0), b2); PG8_STAGEB(PG8_SB(0, 1), b2 + hstepB); PG8_STAGEA(PG8_SA(0, 0), a2, 0, last);
            PG8_WAIT_V(8); PG8_WAIT_L(0); PG8_BAR; PG8_MMA(1, 0, At, B0); PG8_MMA(1, 1, At, B1); PG8_BAR; PG8_SCHED;
            PG8_LDB(B0, 1, 0); PG8_LDB(B1, 1, 1); PG8_SCHED; PG8_LDA(At, 1, 0); PG8_STAGEA(PG8_SA(0, 1), a2, 1, last);
            PG8_WAIT_V(8); PG8_WAIT_L(0); PG8_BAR; PG8_MMA(0, 0, At, B0); PG8_MMA(0, 1, At, B1); PG8_BAR; PG8_SCHED;
            PG8_LDA(At, 1, 1); PG8_STAGEB(PG8_SB(1, 0), b3); PG8_STAGEB(PG8_SB(1, 1), b3 + hstepB); PG8_STAGEA(PG8_SA(1, 0), a3, 0, last);
            PG8_WAIT_V(8); PG8_WAIT_L(0); PG8_BAR; PG8_MMA(1, 0, At, B0); PG8_MMA(1, 1, At, B1); PG8_BAR; PG8_SCHED;
            if constexpr (Epi::HAS_MID) { if (t == (nt >> 1) - 2) { int fr3 = fr, fq3 = fq; asm volatile("" : "+v"(fr3), "+v"(fq3)); E.mid(acc, cur, wr, wc, fr3, fq3); } }
        }
        if constexpr (ALIGN_EPI) { if (wr == 0) PG8_BAR; }
        { int fr2 = fr, fq2 = fq; asm volatile("" : "+v"(fr2), "+v"(fq2));
          E(acc, cur, wr, wc, fr2, fq2); }
        if (!has_next) break;
#pragma unroll
        for (int a = 0; a < 2; ++a)
#pragma unroll
            for (int b = 0; b < 2; ++b)
#pragma unroll
                for (int m = 0; m < 4; ++m)
#pragma unroll
                    for (int n = 0; n < 2; ++n) acc[a][b][m][n] = (f32x4){0.f, 0.f, 0.f, 0.f};
        cur = nxt; cA = nA; cB = nB; ++ui;
        if constexpr (GATHER) { gvc[0][0] = gvn[0][0]; gvc[0][1] = gvn[0][1]; gvc[1][0] = gvn[1][0]; gvc[1][1] = gvn[1][1]; }
        if constexpr (ALIGN_EPI) { if (wr == 1) PG8_BAR; }
    }
    PG8_WAIT_V(0);
    if constexpr (!ALIGN_EPI) { if (wr == 0) PG8_BAR; }
    PG8_BAR;
#undef PG8_SA
#undef PG8_SB
#undef PG8_STAGE2
#undef PG8_STAGEA
#undef PG8_STAGEB
#undef PG8_LDA
#undef PG8_LDB
#undef PG8_MMA
#undef PG8_CAT
#undef PG8_WAIT_V
#undef PG8_WAIT_L
#undef PG8_BAR
#undef PG8_SCHED
#undef PG8_GATHER_OFFS
}

#define EPI_ROW(u, ai, m) ((u).orow + (ai) * HALF + wr * 64 + (m) * 16 + fr)
#define EPI_COL(u, bj) ((u).ocol + (bj) * HALF + wc * 32 + 8 * fq)
struct EpiBf16 {
    static constexpr bool HAS_MID = false;
    bf16_t* O; int ldc; const float* rs; size_t stride; float sc0, sc3;
    unsigned* kn;
    const LAS float* rst;
    float mul;
    bool out8;
    __device__ __forceinline__ void operator()(const f32x4 (&acc)[2][2][4][2], const Unit& u, int wr, int wc, int fr, int fq) const {
        bf16_t* base = O + (size_t)u.aux * stride;
        const float sc = ((u.aux == 0) ? sc0 : ((u.aux == 3) ? sc3 : 1.f)) * mul;
        float nmax[2] = {0.f, 0.f}; const bool dokn = kn && u.aux == 1;
#pragma unroll
        for (int ai = 0; ai < 2; ++ai)
#pragma unroll
            for (int m = 0; m < 4; ++m) { const int row = EPI_ROW(u, ai, m); const float s = (rst ? rst[u.seq * 256 + ai * HALF + wr * 64 + m * 16 + fr] : (rs ? rs[row] : 1.f)) * sc;
#pragma unroll
                for (int bj = 0; bj < 2; ++bj) { const f32x4 v0 = acc[ai][bj][m][0] * s, v1 = acc[ai][bj][m][1] * s;
                    if (out8) { u32x2 w8; w8.x = cvt4_fp8(v0[0], v0[1], v0[2], v0[3]); w8.y = cvt4_fp8(v1[0], v1[1], v1[2], v1[3]); *(u32x2*)((unsigned char*)base + (size_t)row * ldc + EPI_COL(u, bj)) = w8; }
                    else { u32x4 w; w.x = cvt_pk_bf16(v0[0], v0[1]); w.y = cvt_pk_bf16(v0[2], v0[3]); w.z = cvt_pk_bf16(v1[0], v1[1]); w.w = cvt_pk_bf16(v1[2], v1[3]);
                    *(u32x4*)(base + (size_t)row * ldc + EPI_COL(u, bj)) = w; }
                    if (dokn) { float q = (v0[0] * v0[0] + v0[1] * v0[1]) + (v0[2] * v0[2] + v0[3] * v0[3]) + (v1[0] * v1[0] + v1[1] * v1[1]) + (v1[2] * v1[2] + v1[3] * v1[3]);
                        q += __shfl_xor(q, 16); q += __shfl_xor(q, 32); nmax[bj] = fmaxf(nmax[bj], q); } } }
        if (dokn) {
#pragma unroll
            for (int bj = 0; bj < 2; ++bj) { float q = nmax[bj]; q = fmaxf(q, __shfl_xor(q, 1)); q = fmaxf(q, __shfl_xor(q, 2)); q = fmaxf(q, __shfl_xor(q, 4)); q = fmaxf(q, __shfl_xor(q, 8));
                const int head = ((u.ocol + bj * HALF) >> 6) + (wc >> 1), bt = u.orow / SEQ;
                if ((fr | fq) == 0) atomicMax(kn + ((bt * NH + head) * 2 + (wc & 1)), __float_as_uint(q)); }
        }
    }
};
struct EpiResid {
    static constexpr bool HAS_MID = false;
    const float* res; float* out; bf16_t* hb; float* ssq;
    __device__ __forceinline__ void operator()(const f32x4 (&acc)[2][2][4][2], const Unit& u, int wr, int wc, int fr, int fq) const {
#pragma unroll
        for (int ai = 0; ai < 2; ++ai)
#pragma unroll
            for (int m = 0; m < 4; ++m) { const int row = EPI_ROW(u, ai, m); float q = 0.f;
#pragma unroll
                for (int bj = 0; bj < 2; ++bj) { const size_t off = (size_t)row * DM + EPI_COL(u, bj);
                    const f32x4 r0 = *(const f32x4*)(res + off), r1 = *(const f32x4*)(res + off + 4);
                    const f32x4 v0 = acc[ai][bj][m][0] + r0, v1 = acc[ai][bj][m][1] + r1;
                    *(f32x4*)(out + off) = v0; *(f32x4*)(out + off + 4) = v1;
                    q += (v0[0] * v0[0] + v0[1] * v0[1]) + (v0[2] * v0[2] + v0[3] * v0[3]) + (v1[0] * v1[0] + v1[1] * v1[1]) + (v1[2] * v1[2] + v1[3] * v1[3]);
                    if (hb) { u32x4 w; w.x = cvt_pk_bf16(v0[0], v0[1]); w.y = cvt_pk_bf16(v0[2], v0[3]); w.z = cvt_pk_bf16(v1[0], v1[1]); w.w = cvt_pk_bf16(v1[2], v1[3]); *(u32x4*)(hb + off) = w; } }
                if (ssq) { q += __shfl_xor(q, 16); q += __shfl_xor(q, 32); if (fq == 0) ssq[(size_t)row * 16 + (u.ocol >> 8) * 4 + wc] = q; } }
    }
};
struct EpiOutProj {
    static constexpr bool HAS_MID = true;
    const bf16_t* xb; bf16_t* hb; unsigned char* h8; float* ssq; const LAS f32x2* rab;
    __device__ __forceinline__ void mid(f32x4 (&acc)[2][2][4][2], const Unit& u, int wr, int wc, int fr, int fq) const {
#pragma unroll
        for (int ai = 0; ai < 2; ++ai)
#pragma unroll
            for (int m = 0; m < 4; ++m) { const float f = rab[u.seq * 256 + ai * HALF + wr * 64 + m * 16 + fr].x;
#pragma unroll
                for (int bj = 0; bj < 2; ++bj) { acc[ai][bj][m][0] *= f; acc[ai][bj][m][1] *= f; } }
    }
    __device__ __forceinline__ void operator()(const f32x4 (&acc)[2][2][4][2], const Unit& u, int wr, int wc, int fr, int fq) const {
#pragma unroll
        for (int ai = 0; ai < 2; ++ai)
#pragma unroll
            for (int m = 0; m < 4; ++m) { const int row = EPI_ROW(u, ai, m); const float rb = rab[u.seq * 256 + ai * HALF + wr * 64 + m * 16 + fr].y; float q = 0.f;
#pragma unroll
                for (int bj = 0; bj < 2; ++bj) { const size_t off = (size_t)row * DM + EPI_COL(u, bj);
                    const u32x4 xr = *(const u32x4*)(xb + off);
                    f32x4 v0 = acc[ai][bj][m][0] * rb, v1 = acc[ai][bj][m][1] * rb;
                    v0[0] += bf16lo(xr.x); v0[1] += bf16hi(xr.x); v0[2] += bf16lo(xr.y); v0[3] += bf16hi(xr.y); v1[0] += bf16lo(xr.z); v1[1] += bf16hi(xr.z); v1[2] += bf16lo(xr.w); v1[3] += bf16hi(xr.w);
                    q += (v0[0] * v0[0] + v0[1] * v0[1]) + (v0[2] * v0[2] + v0[3] * v0[3]) + (v1[0] * v1[0] + v1[1] * v1[1]) + (v1[2] * v1[2] + v1[3] * v1[3]);
                    u32x4 w; w.x = cvt_pk_bf16(v0[0], v0[1]); w.y = cvt_pk_bf16(v0[2], v0[3]); w.z = cvt_pk_bf16(v1[0], v1[1]); w.w = cvt_pk_bf16(v1[2], v1[3]); *(u32x4*)(hb + off) = w;
                    { u32x2 w8; w8.x = cvt4_fp8(v0[0], v0[1], v0[2], v0[3]); w8.y = cvt4_fp8(v1[0], v1[1], v1[2], v1[3]); *(u32x2*)(h8 + off) = w8; } }
                q += __shfl_xor(q, 16); q += __shfl_xor(q, 32); if (fq == 0) ssq[(size_t)row * 16 + (u.ocol >> 8) * 4 + wc] = q; }
    }
};
struct EpiResidBf16 {
    static constexpr bool HAS_MID = false;
    bf16_t* hb; unsigned char* h8; float mul;
    __device__ __forceinline__ void operator()(const f32x4 (&acc)[2][2][4][2], const Unit& u, int wr, int wc, int fr, int fq) const {
#pragma unroll
        for (int ai = 0; ai < 2; ++ai)
#pragma unroll
            for (int m = 0; m < 4; ++m) { const int row = EPI_ROW(u, ai, m);
#pragma unroll
                for (int bj = 0; bj < 2; ++bj) { const size_t off = (size_t)row * DM + EPI_COL(u, bj);
                    const u32x4 xr = *(const u32x4*)(hb + off);
                    f32x4 v0 = acc[ai][bj][m][0] * mul, v1 = acc[ai][bj][m][1] * mul;
                    v0[0] += bf16lo(xr.x); v0[1] += bf16hi(xr.x); v0[2] += bf16lo(xr.y); v0[3] += bf16hi(xr.y); v1[0] += bf16lo(xr.z); v1[1] += bf16hi(xr.z); v1[2] += bf16lo(xr.w); v1[3] += bf16hi(xr.w);
                    u32x4 w; w.x = cvt_pk_bf16(v0[0], v0[1]); w.y = cvt_pk_bf16(v0[2], v0[3]); w.z = cvt_pk_bf16(v1[0], v1[1]); w.w = cvt_pk_bf16(v1[2], v1[3]); *(u32x4*)(hb + off) = w;
                    if (h8) { u32x2 w8; w8.x = cvt4_fp8(v0[0], v0[1], v0[2], v0[3]); w8.y = cvt4_fp8(v1[0], v1[1], v1[2], v1[3]); *(u32x2*)(h8 + off) = w8; } } }
    }
};
struct EpiSoftmax {
    static constexpr bool HAS_MID = false;
    bf16_t* P; const LAS float* r1t; LAS float* red;
    __device__ __forceinline__ void operator()(f32x4 (&acc)[2][2][4][2], const Unit& u, int wr, int wc, int fr, int fq) const {
#pragma unroll
        for (int ai = 0; ai < 2; ++ai)
#pragma unroll
            for (int m = 0; m < 4; ++m) { const float r1 = r1t[u.seq * 256 + ai * HALF + wr * 64 + m * 16 + fr]; float a = -3.0e38f;
#pragma unroll
                for (int bj = 0; bj < 2; ++bj)
#pragma unroll
                    for (int n = 0; n < 2; ++n) { f32x4 v = acc[ai][bj][m][n] * r1; acc[ai][bj][m][n] = v; a = fmaxf(a, fmaxf(fmaxf(v[0], v[1]), fmaxf(v[2], v[3]))); }
                a = fmaxf(a, __shfl_xor(a, 16)); a = fmaxf(a, __shfl_xor(a, 32));
                if (fq == 0) red[(ai * HALF + wr * 64 + m * 16 + fr) * 4 + wc] = a; asm volatile("" ::: "memory"); }
        LDS_WAIT(); __builtin_amdgcn_s_barrier(); asm volatile("" ::: "memory");
#pragma unroll
        for (int ai = 0; ai < 2; ++ai)
#pragma unroll
            for (int m = 0; m < 4; ++m) { const int rl = ai * HALF + wr * 64 + m * 16 + fr; const f32x4 mm = *(const LAS f32x4*)(red + rl * 4);
                const float a = fmaxf(fmaxf(mm[0], mm[1]), fmaxf(mm[2], mm[3])); float s = 0.f;
#pragma unroll
                for (int bj = 0; bj < 2; ++bj)
#pragma unroll
                    for (int n = 0; n < 2; ++n) { f32x4 v = acc[ai][bj][m][n];
                        v[0] = __builtin_amdgcn_exp2f(v[0] - a); v[1] = __builtin_amdgcn_exp2f(v[1] - a); v[2] = __builtin_amdgcn_exp2f(v[2] - a); v[3] = __builtin_amdgcn_exp2f(v[3] - a);
                        acc[ai][bj][m][n] = v; s += (v[0] + v[1]) + (v[2] + v[3]); }
                s += __shfl_xor(s, 16); s += __shfl_xor(s, 32);
                if (fq == 0) red[1024 + rl * 4 + wc] = s; }
        LDS_WAIT(); __builtin_amdgcn_s_barrier(); asm volatile("" ::: "memory");
#pragma unroll
        for (int ai = 0; ai < 2; ++ai)
#pragma unroll
            for (int m = 0; m < 4; ++m) { const int rl = ai * HALF + wr * 64 + m * 16 + fr; const int row = u.orow + rl; const f32x4 ss = *(const LAS f32x4*)(red + 1024 + rl * 4);
                const float inv = P_SCALE / ((ss[0] + ss[1]) + (ss[2] + ss[3]));
#pragma unroll
                for (int bj = 0; bj < 2; ++bj) { const f32x4 v0 = acc[ai][bj][m][0] * inv, v1 = acc[ai][bj][m][1] * inv;
                    u32x2 w8; w8.x = cvt4_fp8(v0[0], v0[1], v0[2], v0[3]); w8.y = cvt4_fp8(v1[0], v1[1], v1[2], v1[3]);
                    *(u32x2*)((unsigned char*)P + (size_t)row * DM + EPI_COL(u, bj)) = w8; } }
    }
};
struct EpiSwiglu {
    static constexpr bool HAS_MID = false;
    bf16_t* Hd; const float* r2s; const int* listbase;
    __device__ __forceinline__ void operator()(const f32x4 (&acc)[2][2][4][2], const Unit& u, int wr, int wc, int fr, int fq) const {
#pragma unroll
        for (int ai = 0; ai < 2; ++ai)
#pragma unroll
            for (int m = 0; m < 4; ++m) { const int rl = ai * HALF + wr * 64 + m * 16 + fr, row = u.orow + rl; const float rs = r2s[(u.rows - listbase) + (rl < u.nvalid ? rl : 0)] * (1.0f / WGU_SCALE); float h[8];
#pragma unroll
                for (int n = 0; n < 2; ++n)
#pragma unroll
                    for (int e = 0; e < 4; ++e) { const float gt = acc[ai][0][m][n][e] * rs, up = acc[ai][1][m][n][e] * rs;
                        h[n * 4 + e] = gt * __builtin_amdgcn_rcpf(1.0f + __builtin_amdgcn_exp2f(-gt * LOG2E)) * up; }
                u32x2 w; w.x = cvt4_fp8(h[0], h[1], h[2], h[3]); w.y = cvt4_fp8(h[4], h[5], h[6], h[7]);
                *(u32x2*)((unsigned char*)Hd + (size_t)row * DFF + u.ocol + wc * 32 + 8 * fq) = w; }
    }
};
}

namespace att {
constexpr int QB = 256, KVBLK = 64, PITCH = HW, OPITCH = DM;
constexpr int SLOTB = 8192, LDS_K = 0, LDS_V = 2 * SLOTB, LDS_WS = 4 * SLOTB, LDS_OST = LDS_WS + NWAVES * 256, LDS_FLAG = LDS_OST + NWAVES * 4096, LDS_END = LDS_FLAG + 64;
static_assert(LDS_END <= RING_BYTES, "attention LDS");
__device__ __forceinline__ int crow(int r, int hi) { return (r & 3) + 8 * (r >> 2) + 4 * hi; }
__device__ __forceinline__ void glds16(const void* gsrc, unsigned lds_dst) { unsigned keep;
    asm volatile("s_mov_b32 %0, m0\n\ts_mov_b32 m0, %2\n\ts_nop 0\n\tglobal_load_lds_dwordx4 %1, off\n\ts_mov_b32 m0, %0" : "=&s"(keep) : "v"(gsrc), "s"(lds_dst) : "memory"); }
__device__ __forceinline__ void glds16s(const void* sbase, unsigned voff, unsigned lds_dst) { unsigned keep;
    asm volatile("s_mov_b32 %0, m0\n\ts_mov_b32 m0, %3\n\ts_nop 0\n\tglobal_load_lds_dwordx4 %1, %2\n\ts_mov_b32 m0, %0" : "=&s"(keep) : "v"(voff), "s"(sbase), "s"(lds_dst) : "memory"); }
#define ATT_WAIT_BAR0() asm volatile("s_waitcnt vmcnt(0) lgkmcnt(0)\n\ts_barrier" ::: "memory")
#define MFMA32(a, b, c) __builtin_amdgcn_mfma_f32_32x32x16_bf16(a, b, c, 0, 0, 0)
__device__ __forceinline__ void store_row_ssq(u32x4 v, float* dst, int ch) {
    float q = (bf16lo(v.x) * bf16lo(v.x) + bf16hi(v.x) * bf16hi(v.x)) + (bf16lo(v.y) * bf16lo(v.y) + bf16hi(v.y) * bf16hi(v.y)) + (bf16lo(v.z) * bf16lo(v.z) + bf16hi(v.z) * bf16hi(v.z)) + (bf16lo(v.w) * bf16lo(v.w) + bf16hi(v.w) * bf16hi(v.w));
    q += __shfl_xor(q, 1); q += __shfl_xor(q, 2); q += __shfl_xor(q, 4);
    if (ch == 0) *dst = q;
}
__device__ __forceinline__ void qkt(f32x16& p0, f32x16& p1, const LAS char* Kslot, const bf16x8* qr, const f32x16& cin, int r32, int hi) {
    const LAS char* kb = Kslot + hi * 1024 + r32 * 16;
#pragma unroll
    for (int d0 = 0; d0 < 4; ++d0) {
        const bf16x8 b0 = *(const LAS bf16x8*)(kb + d0 * 2048);
        const bf16x8 b1 = *(const LAS bf16x8*)(kb + d0 * 2048 + 512);
        if (d0 == 0) { p0 = MFMA32(b0, qr[0], cin); p1 = MFMA32(b1, qr[0], cin); }
        else { p0 = MFMA32(b0, qr[d0], p0); p1 = MFMA32(b1, qr[d0], p1); } }
}
__device__ __forceinline__ void pv(f32x16* o, int vb, bf16x8 pa0, bf16x8 pa1, bf16x8 pa2, bf16x8 pa3) {
#pragma unroll
    for (int d0 = 0; d0 < 2; ++d0) { s16x4 lo[4], hi[4];
#pragma unroll
        for (int ks = 0; ks < 4; ++ks) {
            asm volatile("ds_read_b64_tr_b16 %0,%1 offset:%c2" : "=&v"(lo[ks]) : "v"(vb), "i"(d0 * 4096 + ks * 1024) : "memory");
            asm volatile("ds_read_b64_tr_b16 %0,%1 offset:%c2" : "=&v"(hi[ks]) : "v"(vb), "i"(d0 * 4096 + ks * 1024 + 512) : "memory"); }
        asm volatile("s_waitcnt lgkmcnt(0)" ::: "memory"); __builtin_amdgcn_sched_barrier(0);
#define PK(k) (bf16x8){lo[k][0], lo[k][1], lo[k][2], lo[k][3], hi[k][0], hi[k][1], hi[k][2], hi[k][3]}
        o[d0] = MFMA32(pa0, PK(0), o[d0]); o[d0] = MFMA32(pa1, PK(1), o[d0]); o[d0] = MFMA32(pa2, PK(2), o[d0]); o[d0] = MFMA32(pa3, PK(3), o[d0]);
#undef PK
    }
}
__device__ __forceinline__ float swap_lo(float x) { auto rr = __builtin_amdgcn_permlane32_swap(__float_as_uint(x), __float_as_uint(x), false, false); return __uint_as_float(rr[0]); }
__device__ __forceinline__ float swap_hi(float x) { auto rr = __builtin_amdgcn_permlane32_swap(__float_as_uint(x), __float_as_uint(x), false, false); return __uint_as_float(rr[1]); }

template <int MODE> __device__ __forceinline__ void attn_unit(int b, int h, int qb, const bf16_t* Q, const bf16_t* K, const bf16_t* V, bf16_t* O, float* hs, const float* cb, LAS char* shm) {
    int tid = threadIdx.x; asm volatile("" : "+v"(tid)); const int lane = tid & 63, r32 = lane & 31, hi = lane >> 5; const int wid = __builtin_amdgcn_readfirstlane(tid >> 6);
    const long rowbase = (long)b * SEQ; const int q0 = qb * QB;
    const bf16_t* Qw = Q + (rowbase + q0 + wid * 32) * PITCH + h * HD;
    const bf16_t* Kh = K + rowbase * PITCH + h * HD; const bf16_t* Vh = V + rowbase * PITCH + h * HD;
    const unsigned lds0 = (unsigned)(uintptr_t)shm;
    LAS float* wsf = (LAS float*)(shm + LDS_WS) + wid * 64;
    LAS unsigned* flags = (LAS unsigned*)(shm + LDS_FLAG);
    const bf16_t* ksrc = Kh + (long)lane * PITCH + wid * 8;
    const bf16_t* vsrc = Vh + (long)(16 * (wid & 3) + (lane >> 2)) * PITCH + (wid >> 2) * 32 + (lane & 3) * 8;
    const unsigned kdst = lds0 + LDS_K + wid * 1024, vdst = lds0 + LDS_V + wid * 1024;
#define DMA_KV(t, slot) do { glds16(ksrc + (long)(t) * KVBLK * PITCH, (unsigned)__builtin_amdgcn_readfirstlane(kdst + (slot))); glds16(vsrc + (long)(t) * KVBLK * PITCH, (unsigned)__builtin_amdgcn_readfirstlane(vdst + (slot))); } while (0)
    const int vb0 = (int)(lds0 + LDS_V) + ((lane >> 4) & 1) * 32 + (lane & 3) * 8 + (4 * hi + ((lane & 15) >> 2)) * 64;
    const int NT = (q0 + QB) / KVBLK;
    DMA_KV(NT - 1, 0);
    bf16x8 qr[4];
#pragma unroll
    for (int d0 = 0; d0 < 4; ++d0) qr[d0] = *(const bf16x8*)(Qw + (long)r32 * PITCH + d0 * 16 + hi * 8);
    f32x16 o[2]; o[0] = f32x16{}; o[1] = f32x16{};
    const int qrel = wid * 32 + r32;
    float m_run = -1.0e30f, l_run = 0.f, R = 0.f, ct = 0.f;
    if (MODE == 0) ct = cb[q0 + qrel];
    bf16x8 TD0, TD1, TONE;
#pragma unroll
    for (int j = 0; j < 8; ++j) { const int kvl = 8 * (j >> 2) + 4 * hi + (j & 3); TD0[j] = (kvl >= r32) ? (short)0x3F80 : (short)0; TD1[j] = (16 + kvl >= r32) ? (short)0x3F80 : (short)0; TONE[j] = (short)0x3F80; }
    f32x16 zero16 = f32x16{};
    for (int i = 0; i < NT; ++i) {
        const int t = NT - 1 - i, slot = (i & 1) * SLOTB;
        ATT_WAIT_BAR0();
        if (MODE == 1 && i > 0) {
            const LAS unsigned* fl = flags + ((i - 1) & 1) * 8; unsigned all = 1u;
#pragma unroll
            for (int w = 0; w < 8; ++w) all &= fl[w];
            if (__builtin_amdgcn_readfirstlane(all)) break;
        }
        if (t > 0) DMA_KV(t - 1, slot ^ SLOTB);
        const int jb = t - (NT - 4);
        const bool active = !(jb >= 0 && 2 * jb > wid);
        bool wave_done = false;
        if (MODE == 1) wave_done = __all(R < SB_EXIT);
        if (active && !(MODE == 1 && wave_done)) {
            f32x16 p0, p1;
            qkt(p0, p1, shm + LDS_K + slot, qr, zero16, r32, hi);
            if (MODE == 0) {
                const float* cbt = cb + t * KVBLK + 4 * hi;
#pragma unroll
                for (int g = 0; g < 4; ++g) { const f32x4 c0 = *(const f32x4*)(cbt + 8 * g), c1 = *(const f32x4*)(cbt + 32 + 8 * g);
#pragma unroll
                    for (int e = 0; e < 4; ++e) { p0[4 * g + e] += ct - c0[e]; p1[4 * g + e] += ct - c1[e]; } }
                if (jb >= 0) {
#pragma unroll
                    for (int r = 0; r < 16; ++r) { const int kv = 64 * jb + crow(r, hi); if (kv > qrel) p0[r] = -1.0e30f; if (kv + 32 > qrel) p1[r] = -1.0e30f; } }
                float a = fmaxf(p0[0], p1[0]);
#pragma unroll
                for (int r = 1; r < 16; ++r) a = fmaxf(a, fmaxf(p0[r], p1[r]));
                a = fmaxf(swap_lo(a), swap_hi(a));
                const float m_new = fmaxf(m_run, a), alpha = __builtin_amdgcn_exp2f(m_run - m_new); m_run = m_new;
                float s = 0.f;
#pragma unroll
                for (int r = 0; r < 16; ++r) { p0[r] = __builtin_amdgcn_exp2f(p0[r] - m_new); p1[r] = __builtin_amdgcn_exp2f(p1[r] - m_new); s += p0[r] + p1[r]; }
                l_run = l_run * alpha + s;
                if (hi == 0) wsf[r32] = alpha;
                LDS_WAIT();
#pragma unroll
                for (int r = 0; r < 16; ++r) { const float f = wsf[crow(r, hi)]; o[0][r] *= f; o[1][r] *= f; }
                LDS_WAIT();
            } else {
                if (jb >= 0) {
#pragma unroll
                    for (int r = 0; r < 16; ++r) { const int kv = 64 * jb + crow(r, hi); if (kv >= qrel) p0[r] = -1.0e30f; if (kv + 32 >= qrel) p1[r] = -1.0e30f; } }
                f32x16 l0, l1;
#pragma unroll
                for (int r = 0; r < 16; ++r) {
                    l0[r] = -(fmaxf(p0[r], 0.f) + __builtin_amdgcn_logf(1.0f + __builtin_amdgcn_exp2f(-fabsf(p0[r]))));
                    l1[r] = -(fmaxf(p1[r], 0.f) + __builtin_amdgcn_logf(1.0f + __builtin_amdgcn_exp2f(-fabsf(p1[r])))); }
                u32x4 lw0 = {cvt_pk_bf16(l0[0], l0[1]), cvt_pk_bf16(l0[2], l0[3]), cvt_pk_bf16(l0[4], l0[5]), cvt_pk_bf16(l0[6], l0[7])};
                u32x4 lw1 = {cvt_pk_bf16(l0[8], l0[9]), cvt_pk_bf16(l0[10], l0[11]), cvt_pk_bf16(l0[12], l0[13]), cvt_pk_bf16(l0[14], l0[15])};
                u32x4 lw2 = {cvt_pk_bf16(l1[0], l1[1]), cvt_pk_bf16(l1[2], l1[3]), cvt_pk_bf16(l1[4], l1[5]), cvt_pk_bf16(l1[6], l1[7])};
                u32x4 lw3 = {cvt_pk_bf16(l1[8], l1[9]), cvt_pk_bf16(l1[10], l1[11]), cvt_pk_bf16(l1[12], l1[13]), cvt_pk_bf16(l1[14], l1[15])};
                f32x16 rt;
#pragma unroll
                for (int r = 0; r < 16; ++r) rt[r] = R;
                f32x16 t0 = MFMA32(TD0, __builtin_bit_cast(bf16x8, lw0), rt); t0 = MFMA32(TD1, __builtin_bit_cast(bf16x8, lw1), t0);
                t0 = MFMA32(TONE, __builtin_bit_cast(bf16x8, lw2), t0); t0 = MFMA32(TONE, __builtin_bit_cast(bf16x8, lw3), t0);
                f32x16 t1 = MFMA32(TD0, __builtin_bit_cast(bf16x8, lw2), rt); t1 = MFMA32(TD1, __builtin_bit_cast(bf16x8, lw3), t1);
#pragma unroll
                for (int r = 0; r < 16; ++r) { p0[r] = __builtin_amdgcn_exp2f(p0[r] + t0[r]); p1[r] = __builtin_amdgcn_exp2f(p1[r] + t1[r]); }
                R = swap_lo(t0[0]);
            }
            u32x4 pw0 = {cvt_pk_bf16(p0[0], p0[1]), cvt_pk_bf16(p0[2], p0[3]), cvt_pk_bf16(p0[4], p0[5]), cvt_pk_bf16(p0[6], p0[7])};
            u32x4 pw1 = {cvt_pk_bf16(p0[8], p0[9]), cvt_pk_bf16(p0[10], p0[11]), cvt_pk_bf16(p0[12], p0[13]), cvt_pk_bf16(p0[14], p0[15])};
            u32x4 pw2 = {cvt_pk_bf16(p1[0], p1[1]), cvt_pk_bf16(p1[2], p1[3]), cvt_pk_bf16(p1[4], p1[5]), cvt_pk_bf16(p1[6], p1[7])};
            u32x4 pw3 = {cvt_pk_bf16(p1[8], p1[9]), cvt_pk_bf16(p1[10], p1[11]), cvt_pk_bf16(p1[12], p1[13]), cvt_pk_bf16(p1[14], p1[15])};
            pv(o, vb0 + slot, __builtin_bit_cast(bf16x8, pw0), __builtin_bit_cast(bf16x8, pw1), __builtin_bit_cast(bf16x8, pw2), __builtin_bit_cast(bf16x8, pw3));
        }
        if (MODE == 1) { const bool dn = __all(R < SB_EXIT); if (lane == 0) flags[(i & 1) * 8 + wid] = dn ? 1u : 0u; }
    }
    float linv = 1.f;
    if (MODE == 0) { const float lt = swap_lo(l_run) + swap_hi(l_run); linv = 1.0f / lt; }
    if (hi == 0) wsf[32 + r32] = linv;
    LDS_WAIT();
    bf16_t* Ow = O + (rowbase + q0 + wid * 32) * OPITCH + h * HD;
    { LAS bf16_t* stg = (LAS bf16_t*)(shm + LDS_OST) + wid * 2048;
#pragma unroll
      for (int r = 0; r < 16; ++r) { const int orow = crow(r, hi); const float f = wsf[32 + orow];
#pragma unroll
        for (int d0 = 0; d0 < 2; ++d0) { const unsigned pk = cvt_pk_bf16(o[d0][r] * f, 0.f); stg[orow * 64 + d0 * 32 + r32] = (bf16_t)(pk & 0xffffu); } }
      LDS_WAIT();
#pragma unroll
      for (int i = 0; i < 4; ++i) { const int row = i * 8 + (lane >> 3), ch = lane & 7; const u32x4 v = *(const LAS u32x4*)(stg + row * 64 + ch * 8); *(u32x4*)(Ow + (long)row * OPITCH + ch * 8) = v;
        store_row_ssq(v, hs + (rowbase + q0 + wid * 32 + row) * 16, ch); } }
    asm volatile("s_waitcnt vmcnt(0) lgkmcnt(0)\n\ts_barrier" ::: "memory");
#undef DMA_KV
}
}


namespace fox {
constexpr int QB = 256, KVBLK = 64, PITCH = HW, OPITCH = DM;
constexpr int NSLOT = 3, SLOTB = 9216;
constexpr int LDS_K = 0, LDS_V = NSLOT * SLOTB, LDS_WS = 2 * NSLOT * SLOTB, LDS_OST = LDS_WS + NWAVES * 256, LDS_CL = LDS_OST + NWAVES * 4096, LDS_VOTE = LDS_CL + 512, LDS_END = LDS_VOTE + 32;
static_assert(LDS_END <= RING_BYTES, "fox LDS");
constexpr float WIN_T = 48.0f;
constexpr float FLOOR = -256.0f;
using att::crow; using att::glds16; using att::glds16s;
typedef __attribute__((address_space(3))) const char* lds_cptr;
typedef short v4i16_t __attribute__((ext_vector_type(4)));
#define SBAR() __builtin_amdgcn_sched_barrier(0)
#define WAIT_BAR(N) asm volatile("s_waitcnt vmcnt(" #N ") lgkmcnt(0)\n\ts_barrier" ::: "memory")
__device__ __forceinline__ s16x4 vtr(lds_cptr p) { return __builtin_bit_cast(s16x4, __builtin_amdgcn_ds_read_tr16_b64_v4i16((__attribute__((address_space(3))) v4i16_t*)p)); }
__device__ __forceinline__ void kload2(bf16x8* kf, lds_cptr kp, int j) { kf[2 * j] = *(const LAS bf16x8*)(kp + j * 2048); kf[2 * j + 1] = *(const LAS bf16x8*)(kp + j * 2048 + 512); }
__device__ __forceinline__ void cmask(f32x16& p0, f32x16& p1, int jb, int qrel, int hi) {
    const float NEG = -INFINITY; const int kb = 64 * jb + 4 * hi;
#pragma unroll
    for (int r = 0; r < 16; ++r) { const int kv = kb + (r & 3) + 8 * (r >> 2); if (kv > qrel) p0[r] = NEG; if (kv + 32 > qrel) p1[r] = NEG; }
}
__device__ __forceinline__ void split3(float x, unsigned& hm, unsigned& lo) {
    const unsigned h = cvt_pk_bf16(x, 0.f) & 0xffffu; const float r1 = x - __uint_as_float(h << 16);
    const unsigned m = cvt_pk_bf16(r1, 0.f) & 0xffffu; const float r2 = r1 - __uint_as_float(m << 16);
    hm = h | (m << 16); lo = cvt_pk_bf16(r2, 0.f) & 0xffffu;
}
__device__ __forceinline__ bf16x8 qx_build(float a, int hi) {
    unsigned hm, lo; split3(a, hm, lo);
    u32x4 w; w.x = hm; w.y = lo | 0x3F800000u; w.z = 0x3F803F80u; w.w = 0u;
    if (hi) { w.x = 0u; w.y = 0u; w.z = 0u; }
    return __builtin_bit_cast(bf16x8, w);
}

template <int THRL> __device__ __forceinline__ void fox_unit(int bh, int qb, const bf16_t* Q, const bf16_t* K, const bf16_t* V, bf16_t* O, float* hs, const float* cb, const bf16_t* KXh, float kmax, LAS char* shm) {
    int tid = threadIdx.x; asm volatile("" : "+v"(tid)); const int lane = tid & 63, r32 = lane & 31, hi = lane >> 5; const int wid = __builtin_amdgcn_readfirstlane(tid >> 6);
    const int b = bh >> 3, h = bh & 7; const long rowbase = (long)b * SEQ; const int q0 = qb * QB;
    const bf16_t* Qw = Q + (rowbase + q0 + wid * 32) * PITCH + h * HD;
    const bf16_t* Kh = K + rowbase * PITCH + h * HD; const bf16_t* Vh = V + rowbase * PITCH + h * HD;
    const unsigned lds0 = (unsigned)(uintptr_t)shm;
    LAS float* wsf = (LAS float*)(shm + LDS_WS) + wid * 64;
    const int NT = (q0 + QB) / KVBLK;
    int NTe = NT;
    LAS float* clt = (LAS float*)(shm + LDS_CL); LAS unsigned* votes = (LAS unsigned*)(shm + LDS_VOTE);
    const float clv = (tid < NT) ? cb[64 * tid + 63] : 0.f;
    const unsigned koff = (unsigned)(lane * PITCH + wid * 8) * 2u, voff = (unsigned)((16 * (wid & 3) + (lane >> 2)) * PITCH + (wid >> 2) * 32 + (lane & 3) * 8) * 2u, xoff = (unsigned)lane * 16u;
    const unsigned kdst = lds0 + LDS_K + wid * 1024, vdst = lds0 + LDS_V + wid * 1024, xdst = lds0 + LDS_K + 8192;
    const bool xl = (lane >> 3) == wid;
#define DMA_K(p, slot) do { glds16s(Kh + (long)(NT - 1 - (p)) * KVBLK * PITCH, koff, (unsigned)__builtin_amdgcn_readfirstlane(kdst + (slot))); \
        if (xl) glds16s(KXh + (long)(NT - 1 - (p)) * KVBLK * 8, xoff, (unsigned)__builtin_amdgcn_readfirstlane(xdst + (slot))); } while (0)
#define DMA_V(p, slot) glds16s(Vh + (long)(NT - 1 - (p)) * KVBLK * PITCH, voff, (unsigned)__builtin_amdgcn_readfirstlane(vdst + (slot)))
    bf16x8 kf[10];
    const lds_cptr shm3 = (lds_cptr)shm; const lds_cptr kp0 = shm3 + LDS_K + hi * 1024 + r32 * 16; const lds_cptr kx0 = shm3 + LDS_K + 8192 + r32 * 16;
    const lds_cptr vp0 = shm3 + LDS_V + ((lane >> 4) & 1) * 32 + (lane & 3) * 8 + (4 * hi + ((lane & 15) >> 2)) * 64;
    DMA_K(0, 0); DMA_V(0, 0); DMA_K(1, SLOTB);
    bf16x8 qr[4];
#pragma unroll
    for (int d0 = 0; d0 < 4; ++d0) qr[d0] = *(const bf16x8*)(Qw + (long)r32 * PITCH + d0 * 16 + hi * 8);
    const int qrel = wid * 32 + r32;
    const float ct = cb[q0 + qrel];
    float mhat = 0.f, l_reg = 0.f; f32x16 o[2]; o[0] = f32x16{}; o[1] = f32x16{};
    bf16x8 qx = qx_build(ct, hi);
    const f32x16 z16 = f32x16{};
#define CMASK(P0, P1, p) do { const int jb_ = 3 - (p); if (jb_ >= 0) cmask(P0, P1, jb_, qrel, hi); } while (0)
    bool resc = false;
#define RESC() do { if (resc) { asm volatile("s_waitcnt lgkmcnt(0)" ::: "memory"); \
      _Pragma("unroll") for (int d_ = 0; d_ < 2; ++d_) _Pragma("unroll") for (int r = 0; r < 16; ++r) o[d_][r] *= wsf[crow(r, hi)]; } } while (0)
    f32x16 pA0, pA1, pB0, pB1;
    int sl_prev = 0, sl_cur = 0, sl_next = SLOTB;
#define ROT() do { sl_prev = sl_cur; sl_cur = sl_next; sl_next = (sl_next == (NSLOT - 1) * SLOTB) ? 0 : sl_next + SLOTB; } while (0)
    DMA_K(2, 2 * SLOTB);
    WAIT_BAR(5);
    if (tid < NT) clt[tid] = clv;
    float qkb;
    { float q2 = 0.f;
#pragma unroll
      for (int d0 = 0; d0 < 4; ++d0)
#pragma unroll
          for (int j = 0; j < 8; ++j) { const float e = __uint_as_float(((unsigned)(unsigned short)qr[d0][j]) << 16); q2 += e * e; }
      q2 = att::swap_lo(q2) + att::swap_hi(q2); qkb = sqrtf(q2) * kmax + ct + WIN_T; }
    { const LAS char* kb = (const LAS char*)shm + LDS_K + hi * 1024 + r32 * 16; const LAS char* kxb = (const LAS char*)shm + LDS_K + 8192 + r32 * 16;
      pA0 = MFMA32(*(const LAS bf16x8*)(kxb), qx, z16); pA1 = MFMA32(*(const LAS bf16x8*)(kxb + 512), qx, z16);
#pragma unroll
      for (int d0 = 0; d0 < 4; ++d0) { pA0 = MFMA32(*(const LAS bf16x8*)(kb + d0 * 2048), qr[d0], pA0); pA1 = MFMA32(*(const LAS bf16x8*)(kb + d0 * 2048 + 512), qr[d0], pA1); } }
    asm volatile("s_nop 15\n\ts_nop 7" : "+v"(pA0), "+v"(pA1)); CMASK(pA0, pA1, 0);
    { float a = fmaxf(pA0[0], pA1[0]);
#pragma unroll
      for (int r = 1; r < 16; ++r) a = fmaxf(a, fmaxf(pA0[r], pA1[r]));
      a = fmaxf(att::swap_lo(a), att::swap_hi(a));
      const float dl = fmaxf(a, FLOOR); mhat = dl;
#pragma unroll
      for (int r = 0; r < 16; ++r) { pA0[r] = __builtin_amdgcn_exp2f(pA0[r] - dl); pA1[r] = __builtin_amdgcn_exp2f(pA1[r] - dl); }
      qx = qx_build(ct - mhat, hi); asm volatile("" : "+v"(qx)); }
    WAIT_BAR(0);
    DMA_K(3, 0); DMA_V(1, SLOTB);
    ROT();
    kload2(kf, kp0 + sl_cur, 0); kload2(kf, kp0 + sl_cur, 1); kload2(kf, kp0 + sl_cur, 2); kload2(kf, kp0 + sl_cur, 3);
    kf[8] = *(const LAS bf16x8*)(kx0 + sl_cur); kf[9] = *(const LAS bf16x8*)(kx0 + sl_cur + 512);
    WAIT_BAR(3);
    s16x4 vlo[8], vhi[8]; u32x4 pw0, pw1, pw2, pw3;
#define PKW(P, B) cvt_pk_bf16(P[B], P[B + 1])
#define PAF(k) __builtin_bit_cast(bf16x8, pw##k)
#define VFR(i) (bf16x8){vlo[i][0], vlo[i][1], vlo[i][2], vlo[i][3], vhi[i][0], vhi[i][1], vhi[i][2], vhi[i][3]}
#define PIN(x) asm volatile("" : "+v"(x))
#define MX3(a, b, c) __builtin_fmaxf(__builtin_fmaxf((a), (b)), (c))
#define GAPA(MF, A0, A1, A2, A3, W0, W1, PW) do { MF; sacc += A0; sacc += A1; sacc += A2; sacc += A3; PIN(sacc); W0; W1; PIN(PW); SBAR(); } while (0)
#define EX(v) __builtin_amdgcn_exp2f(v)
#define GAPB(MF, X, B) do { MF; X[B] = EX(X[B]); X[B + 1] = EX(X[B + 1]); X[B + 2] = EX(X[B + 2]); X[B + 3] = EX(X[B + 3]); PIN(X); SBAR(); } while (0)
#define VRD(i) do { vlo[i] = vtr(vp_ + (((i) >> 2) * 4096 + ((i) & 3) * 1024)); vhi[i] = vtr(vp_ + (((i) >> 2) * 4096 + ((i) & 3) * 1024 + 512)); } while (0)
#define KRD(G, j) do { if (G) { kload2(kf, kp0 + sl_next, j); SBAR(); } } while (0)
#define KRDX(G) do { if (G) { kf[8] = *(const LAS bf16x8*)(kx0 + sl_next); kf[9] = *(const LAS bf16x8*)(kx0 + sl_next + 512); SBAR(); } } while (0)
#define STEP(C0, C1, P0, P1, t, GK, GV, GL) do { SBAR(); \
    const lds_cptr vp_ = vp0 + sl_prev; \
    C0 = MFMA32(kf[8], qx, z16); C1 = MFMA32(kf[9], qx, z16); SBAR(); \
    VRD(0); SBAR(); float sacc = (P0[0] + P0[1]); \
    GAPA(C0 = MFMA32(kf[0], qr[0], C0), P0[2], P0[3], P0[4], P0[5],     pw0[0] = PKW(P0, 0), pw0[1] = PKW(P0, 2), pw0); \
    VRD(4); SBAR(); GAPA(C1 = MFMA32(kf[1], qr[0], C1), P0[6], P0[7], P0[8], P0[9],     pw0[2] = PKW(P0, 4), pw0[3] = PKW(P0, 6), pw0); \
    VRD(1); SBAR(); GAPA(C0 = MFMA32(kf[2], qr[1], C0),   P0[10], P0[11], P0[12], P0[13], pw1[0] = PKW(P0, 8), pw1[1] = PKW(P0, 10), pw1); \
    VRD(5); SBAR(); GAPA(C1 = MFMA32(kf[3], qr[1], C1),   P0[14], P0[15], P1[0], P1[1],   pw1[2] = PKW(P0, 12), pw1[3] = PKW(P0, 14), pw1); \
    VRD(2); SBAR(); GAPA(C0 = MFMA32(kf[4], qr[2], C0),   P1[2], P1[3], P1[4], P1[5],     pw2[0] = PKW(P1, 0), pw2[1] = PKW(P1, 2), pw2); \
    VRD(6); SBAR(); GAPA(C1 = MFMA32(kf[5], qr[2], C1),   P1[6], P1[7], P1[8], P1[9],     pw2[2] = PKW(P1, 4), pw2[3] = PKW(P1, 6), pw2); \
    VRD(3); SBAR(); GAPA(C0 = MFMA32(kf[6], qr[3], C0),   P1[10], P1[11], P1[12], P1[13], pw3[0] = PKW(P1, 8), pw3[1] = PKW(P1, 10), pw3); \
    VRD(7); SBAR(); GAPA(C1 = MFMA32(kf[7], qr[3], C1),   P1[14], P1[15], 0.f, 0.f,       pw3[2] = PKW(P1, 12), pw3[3] = PKW(P1, 14), pw3); \
    l_reg += sacc; \
    if (GK) { DMA_K((t) + 3, sl_cur); } if (GV) { DMA_V((t) + 1, sl_next); } \
    CMASK(C0, C1, t); \
    { float a = MX3(C0[0], C0[1], C1[0]), b_ = MX3(C0[2], C0[3], C1[1]); a = MX3(a, C1[2], C1[3]); \
      _Pragma("unroll") for (int r = 4; r < 16; r += 4) { a = MX3(a, C0[r], C0[r + 1]); b_ = MX3(b_, C0[r + 2], C0[r + 3]); a = MX3(a, C1[r], C1[r + 1]); b_ = MX3(b_, C1[r + 2], C1[r + 3]); } \
      float rm = __builtin_fmaxf(a, b_); { auto rr = __builtin_amdgcn_permlane32_swap(__float_as_uint(rm), __float_as_uint(rm), false, false); rm = __builtin_fmaxf(__uint_as_float(rr[0]), __uint_as_float(rr[1])); } \
      resc = false; \
      if (__builtin_expect(__any(rm > (float)THRL), 0)) { const float dl = __builtin_fmaxf(rm, 0.f); mhat += dl; \
        _Pragma("unroll") for (int r = 0; r < 16; ++r) { C0[r] -= dl; C1[r] -= dl; } \
        qx = qx_build(ct - mhat, hi); asm volatile("" : "+v"(qx)); \
        const float f = __builtin_amdgcn_exp2f(-dl); l_reg *= f; if (hi == 0) wsf[r32] = f; resc = true; } } \
    SBAR(); \
    GAPB(o[0] = MFMA32(PAF(0), VFR(0), o[0]), C0, 0); \
    KRDX(GL); GAPB(o[1] = MFMA32(PAF(0), VFR(4), o[1]), C0, 4); \
    KRD(GL, 0); GAPB(o[0] = MFMA32(PAF(1), VFR(1), o[0]), C0, 8); \
    KRD(GL, 1); GAPB(o[1] = MFMA32(PAF(1), VFR(5), o[1]), C0, 12); \
    KRD(GL, 2); GAPB(o[0] = MFMA32(PAF(2), VFR(2), o[0]), C1, 0); \
    KRD(GL, 3); GAPB(o[1] = MFMA32(PAF(2), VFR(6), o[1]), C1, 4); \
    GAPB(o[0] = MFMA32(PAF(3), VFR(3), o[0]), C1, 8); \
    GAPB(o[1] = MFMA32(PAF(3), VFR(7), o[1]), C1, 12); \
    } while (0)
#define ENDW(tt) do { if ((tt) + 3 < NTe) { WAIT_BAR(3); } else if ((tt) + 2 < NTe) { WAIT_BAR(1); } else { WAIT_BAR(0); } } while (0)
#define VOTE(u) do { const int ts_ = NT - (u) - 3; bool ok_ = false; if (ts_ >= 0) { ok_ = __all((qkb - mhat) < clt[ts_]); } if (lane == 0) votes[wid] = ok_ ? 1u : 0u; } while (0)
#define TALLY(u) do { const u32x4 va_ = *(const LAS u32x4*)votes, vb_ = *(const LAS u32x4*)(votes + 4); \
        if (__builtin_amdgcn_readfirstlane((va_.x & va_.y & va_.z & va_.w & vb_.x & vb_.y & vb_.z & vb_.w) != 0u)) { if ((u) + 2 < NTe) { NTe = (u) + 2; WAIT_BAR(0); } } } while (0)
    int t = 1;
    for (; t + 1 < NTe && t < 5; t += 2) {
        STEP(pB0, pB1, pA0, pA1, t, (t + 3 < NTe), (t + 1 < NTe), (t + 1 < NTe));       ENDW(t);     RESC(); ROT();
        STEP(pA0, pA1, pB0, pB1, t + 1, (t + 4 < NTe), (t + 2 < NTe), (t + 2 < NTe));   VOTE(t + 1); ENDW(t + 1); TALLY(t + 1); RESC(); ROT();
    }
#undef CMASK
#define CMASK(P0, P1, p) do {} while (0)
    for (; t + 5 < NTe; t += 2) {
        STEP(pB0, pB1, pA0, pA1, t, true, true, true);       WAIT_BAR(3); RESC(); ROT();
        STEP(pA0, pA1, pB0, pB1, t + 1, true, true, true);   VOTE(t + 1); WAIT_BAR(3); TALLY(t + 1); RESC(); ROT();
    }
    for (; t + 1 < NTe; t += 2) {
        STEP(pB0, pB1, pA0, pA1, t, (t + 3 < NTe), (t + 1 < NTe), (t + 1 < NTe));       ENDW(t);     RESC(); ROT();
        STEP(pA0, pA1, pB0, pB1, t + 1, (t + 4 < NTe), (t + 2 < NTe), (t + 2 < NTe));   ENDW(t + 1); RESC(); ROT();
    }
#undef CMASK
#define CMASK(P0, P1, p) do { const int jb_ = 3 - (p); if (jb_ >= 0) cmask(P0, P1, jb_, qrel, hi); } while (0)
    STEP(pB0, pB1, pA0, pA1, NTe - 1, false, false, false); RESC();
    { float sacc = pB0[0] + pB0[1];
#pragma unroll
      for (int r = 2; r < 16; ++r) sacc += pB0[r];
#pragma unroll
      for (int r = 0; r < 16; ++r) sacc += pB1[r];
      l_reg += sacc;
      pw0 = (u32x4){PKW(pB0, 0), PKW(pB0, 2), PKW(pB0, 4), PKW(pB0, 6)}; pw1 = (u32x4){PKW(pB0, 8), PKW(pB0, 10), PKW(pB0, 12), PKW(pB0, 14)};
      pw2 = (u32x4){PKW(pB1, 0), PKW(pB1, 2), PKW(pB1, 4), PKW(pB1, 6)}; pw3 = (u32x4){PKW(pB1, 8), PKW(pB1, 10), PKW(pB1, 12), PKW(pB1, 14)};
      SBAR(); att::pv(o, (int)(unsigned)(uintptr_t)(vp0 + sl_cur), PAF(0), PAF(1), PAF(2), PAF(3)); }
    l_reg = att::swap_lo(l_reg) + att::swap_hi(l_reg);
    if (hi == 0) wsf[32 + r32] = l_reg; asm volatile("s_waitcnt lgkmcnt(0)" ::: "memory");
    float rli[16];
#pragma unroll
    for (int r = 0; r < 16; ++r) rli[r] = __builtin_amdgcn_rcpf(wsf[32 + crow(r, hi)]);
    bf16_t* Ow = O + (rowbase + q0 + wid * 32) * OPITCH + h * HD;
    { LAS bf16_t* stg = (LAS bf16_t*)(shm + LDS_OST) + wid * 2048;
#pragma unroll
      for (int r = 0; r < 16; ++r) { const int orow = crow(r, hi);
#pragma unroll
        for (int d0 = 0; d0 < 2; ++d0) stg[orow * 64 + d0 * 32 + r32] = (bf16_t)(cvt_pk_bf16(o[d0][r] * rli[r], 0.f) & 0xffffu); }
      asm volatile("s_waitcnt lgkmcnt(0)" ::: "memory");
#pragma unroll
      for (int i = 0; i < 4; ++i) { const int row = i * 8 + (lane >> 3), ch = lane & 7; const u32x4 v = *(const LAS u32x4*)(stg + row * 64 + ch * 8); *(u32x4*)(Ow + (long)row * OPITCH + ch * 8) = v;
        att::store_row_ssq(v, hs + (rowbase + q0 + wid * 32 + row) * 16, ch); } }
    asm volatile("s_waitcnt lgkmcnt(0)\n\ts_barrier" ::: "memory");
#undef DMA_K
#undef DMA_V
#undef CMASK
#undef RESC
#undef ROT
#undef PKW
#undef PAF
#undef VFR
#undef PIN
#undef MX3
#undef GAPA
#undef GAPB
#undef EX
#undef VRD
#undef KRD
#undef KRDX
#undef STEP
#undef ENDW
#undef VOTE
#undef TALLY
}
#undef SBAR
#undef WAIT_BAR
}


namespace sbk {
constexpr int QB = 256, KVBLK = 64, PITCH = HW, OPITCH = DM, NBURST = 6, SLOTB = 8192;
constexpr int LDS_K = 0, LDS_V = NBURST * SLOTB, LDS_FLAG = 2 * NBURST * SLOTB, LDS_END = LDS_FLAG + 128;
static_assert(LDS_END <= RING_BYTES, "sb LDS");
using att::crow; using att::glds16s; using att::qkt; using att::pv; using att::swap_lo;
__device__ __forceinline__ void sb_tile(const LAS char* Kslot, int vb, const bf16x8* qr, bf16x8 TD0, bf16x8 TD1, bf16x8 TONE, int jb, int qrel, int r32, int hi, float& R, f32x16* o) {
    f32x16 p0, p1; const f32x16 z16 = f32x16{};
    qkt(p0, p1, Kslot, qr, z16, r32, hi);
    if (jb >= 0) {
#pragma unroll
        for (int r = 0; r < 16; ++r) { const int kv = 64 * jb + crow(r, hi); if (kv >= qrel) p0[r] = -1.0e30f; if (kv + 32 >= qrel) p1[r] = -1.0e30f; } }
    f32x16 l0, l1;
#pragma unroll
    for (int r = 0; r < 16; ++r) {
        l0[r] = -(fmaxf(p0[r], 0.f) + __builtin_amdgcn_logf(1.0f + __builtin_amdgcn_exp2f(-fabsf(p0[r]))));
        l1[r] = -(fmaxf(p1[r], 0.f) + __builtin_amdgcn_logf(1.0f + __builtin_amdgcn_exp2f(-fabsf(p1[r])))); }
    u32x4 lw0 = {cvt_pk_bf16(l0[0], l0[1]), cvt_pk_bf16(l0[2], l0[3]), cvt_pk_bf16(l0[4], l0[5]), cvt_pk_bf16(l0[6], l0[7])};
    u32x4 lw1 = {cvt_pk_bf16(l0[8], l0[9]), cvt_pk_bf16(l0[10], l0[11]), cvt_pk_bf16(l0[12], l0[13]), cvt_pk_bf16(l0[14], l0[15])};
    u32x4 lw2 = {cvt_pk_bf16(l1[0], l1[1]), cvt_pk_bf16(l1[2], l1[3]), cvt_pk_bf16(l1[4], l1[5]), cvt_pk_bf16(l1[6], l1[7])};
    u32x4 lw3 = {cvt_pk_bf16(l1[8], l1[9]), cvt_pk_bf16(l1[10], l1[11]), cvt_pk_bf16(l1[12], l1[13]), cvt_pk_bf16(l1[14], l1[15])};
    f32x16 rt;
#pragma unroll
    for (int r = 0; r < 16; ++r) rt[r] = R;
    f32x16 t0 = MFMA32(TD0, __builtin_bit_cast(bf16x8, lw0), rt); t0 = MFMA32(TD1, __builtin_bit_cast(bf16x8, lw1), t0);
    t0 = MFMA32(TONE, __builtin_bit_cast(bf16x8, lw2), t0); t0 = MFMA32(TONE, __builtin_bit_cast(bf16x8, lw3), t0);
    f32x16 t1 = MFMA32(TD0, __builtin_bit_cast(bf16x8, lw2), rt); t1 = MFMA32(TD1, __builtin_bit_cast(bf16x8, lw3), t1);
#pragma unroll
    for (int r = 0; r < 16; ++r) { p0[r] = __builtin_amdgcn_exp2f(p0[r] + t0[r]); p1[r] = __builtin_amdgcn_exp2f(p1[r] + t1[r]); }
    R = swap_lo(t0[0]);
    u32x4 pw0 = {cvt_pk_bf16(p0[0], p0[1]), cvt_pk_bf16(p0[2], p0[3]), cvt_pk_bf16(p0[4], p0[5]), cvt_pk_bf16(p0[6], p0[7])};
    u32x4 pw1 = {cvt_pk_bf16(p0[8], p0[9]), cvt_pk_bf16(p0[10], p0[11]), cvt_pk_bf16(p0[12], p0[13]), cvt_pk_bf16(p0[14], p0[15])};
    u32x4 pw2 = {cvt_pk_bf16(p1[0], p1[1]), cvt_pk_bf16(p1[2], p1[3]), cvt_pk_bf16(p1[4], p1[5]), cvt_pk_bf16(p1[6], p1[7])};
    u32x4 pw3 = {cvt_pk_bf16(p1[8], p1[9]), cvt_pk_bf16(p1[10], p1[11]), cvt_pk_bf16(p1[12], p1[13]), cvt_pk_bf16(p1[14], p1[15])};
    pv(o, vb, __builtin_bit_cast(bf16x8, pw0), __builtin_bit_cast(bf16x8, pw1), __builtin_bit_cast(bf16x8, pw2), __builtin_bit_cast(bf16x8, pw3));
}
#define SB_WAITBAR(N) asm volatile("s_waitcnt vmcnt(" #N ") lgkmcnt(0)\n\ts_barrier" ::: "memory")
__device__ __forceinline__ void sb_unit(int b, int h, int qb, const bf16_t* Q, const bf16_t* K, const bf16_t* V, bf16_t* O, float* hs, LAS char* shm) {
    int tid = threadIdx.x; asm volatile("" : "+v"(tid)); const int lane = tid & 63, r32 = lane & 31, hi = lane >> 5; const int wid = __builtin_amdgcn_readfirstlane(tid >> 6);
    const long rowbase = (long)b * SEQ; const int q0 = qb * QB;
    const bf16_t* Qw = Q + (rowbase + q0 + wid * 32) * PITCH + h * HD;
    const bf16_t* Kh = K + rowbase * PITCH + h * HD; const bf16_t* Vh = V + rowbase * PITCH + h * HD;
    const unsigned lds0 = (unsigned)(uintptr_t)shm;
    LAS unsigned* flags = (LAS unsigned*)(shm + LDS_FLAG);
    const unsigned koff = (unsigned)(lane * PITCH + wid * 8) * 2u, voff = (unsigned)((16 * (wid & 3) + (lane >> 2)) * PITCH + (wid >> 2) * 32 + (lane & 3) * 8) * 2u;
    const unsigned kdst = lds0 + LDS_K + wid * 1024, vdst = lds0 + LDS_V + wid * 1024;
#define SB_DMA(p, slot) do { glds16s(Kh + (long)(NT - 1 - (p)) * KVBLK * PITCH, koff, (unsigned)__builtin_amdgcn_readfirstlane(kdst + (slot) * SLOTB)); \
        glds16s(Vh + (long)(NT - 1 - (p)) * KVBLK * PITCH, voff, (unsigned)__builtin_amdgcn_readfirstlane(vdst + (slot) * SLOTB)); } while (0)
    const int vb0 = (int)(lds0 + LDS_V) + ((lane >> 4) & 1) * 32 + (lane & 3) * 8 + (4 * hi + ((lane & 15) >> 2)) * 64;
    const int NT = (q0 + QB) / KVBLK, NB = NT < NBURST ? NT : NBURST;
    for (int p = 0; p < NB; ++p) SB_DMA(p, p);
    bf16x8 qr[4];
#pragma unroll
    for (int d0 = 0; d0 < 4; ++d0) qr[d0] = *(const bf16x8*)(Qw + (long)r32 * PITCH + d0 * 16 + hi * 8);
    f32x16 o[2]; o[0] = f32x16{}; o[1] = f32x16{};
    const int qrel = wid * 32 + r32;
    float R = 0.f;
    bf16x8 TD0, TD1, TONE;
#pragma unroll
    for (int j = 0; j < 8; ++j) { const int kvl = 8 * (j >> 2) + 4 * hi + (j & 3); TD0[j] = (kvl >= r32) ? (short)0x3F80 : (short)0; TD1[j] = (16 + kvl >= r32) ? (short)0x3F80 : (short)0; TONE[j] = (short)0x3F80; }
    if (NB > 4) { SB_WAITBAR(4); } else { SB_WAITBAR(0); }
    bool mid_done = (NB <= 4);
    int p = 3 - (wid >> 1);
    for (; p < NB; ++p) {
        if (p >= 4 && !mid_done) { SB_WAITBAR(0); mid_done = true; }
        sb_tile(shm + LDS_K + p * SLOTB, vb0 + p * SLOTB, qr, TD0, TD1, TONE, 3 - p, qrel, r32, hi, R, o);
        if (__all(R < SB_EXIT)) { ++p; break; }
    }
    if (!mid_done) { SB_WAITBAR(0); }
    { const bool dn = __all(R < SB_EXIT) || (p >= NT); if (lane == 0) flags[wid] = dn ? 1u : 0u; }
    SB_WAITBAR(0);
    bool alldone;
    { const u32x4 fa = *(const LAS u32x4*)flags, fb = *(const LAS u32x4*)(flags + 4); alldone = __builtin_amdgcn_readfirstlane((fa.x & fa.y & fa.z & fa.w & fb.x & fb.y & fb.z & fb.w) != 0u); }
    if (!alldone && NB < NT) {
        SB_DMA(NB, 0);
        for (int i = 0; NB + i < NT; ++i) {
            const int pp = NB + i, sl = i & 1;
            SB_WAITBAR(0);
            if (i > 0) { const LAS unsigned* fl = flags + 8 + ((i - 1) & 1) * 8; const u32x4 fa = *(const LAS u32x4*)fl, fb = *(const LAS u32x4*)(fl + 4);
                if (__builtin_amdgcn_readfirstlane((fa.x & fa.y & fa.z & fa.w & fb.x & fb.y & fb.z & fb.w) != 0u)) break; }
            if (pp + 1 < NT) SB_DMA(pp + 1, sl ^ 1);
            if (!__all(R < SB_EXIT)) sb_tile(shm + LDS_K + sl * SLOTB, vb0 + sl * SLOTB, qr, TD0, TD1, TONE, -1, qrel, r32, hi, R, o);
            { const bool dn = __all(R < SB_EXIT); if (lane == 0) flags[8 + (i & 1) * 8 + wid] = dn ? 1u : 0u; }
        }
        SB_WAITBAR(0);
    }
    bf16_t* Ow = O + (rowbase + q0 + wid * 32) * OPITCH + h * HD;
    { LAS bf16_t* stg = (LAS bf16_t*)(shm + LDS_K) + wid * 2048;
#pragma unroll
      for (int r = 0; r < 16; ++r) { const int orow = crow(r, hi);
#pragma unroll
        for (int d0 = 0; d0 < 2; ++d0) stg[orow * 64 + d0 * 32 + r32] = (bf16_t)(cvt_pk_bf16(o[d0][r], 0.f) & 0xffffu); }
      LDS_WAIT();
#pragma unroll
      for (int i = 0; i < 4; ++i) { const int row = i * 8 + (lane >> 3), ch = lane & 7; const u32x4 v = *(const LAS u32x4*)(stg + row * 64 + ch * 8); *(u32x4*)(Ow + (long)row * OPITCH + ch * 8) = v;
        att::store_row_ssq(v, hs + (rowbase + q0 + wid * 32 + row) * 16, ch); } }
    asm volatile("s_waitcnt vmcnt(0) lgkmcnt(0)\n\ts_barrier" ::: "memory");
#undef SB_DMA
}
#undef SB_WAITBAR
}

#define XB_TMO      128
#define XB_XCNT(j)  (256  + 64 * (j))
#define XB_XSUB(j)  (1280 + 64 * (j))
#define XB_XGEN(j)  (2304 + 64 * (j))
#define XB_TOP      3328
#define XB_TOPGEN   3392
#define XCD_BAR_WORDS 3456
#define XB_SPIN_CAP (1u << 18)
__device__ __forceinline__ unsigned xb_ld(unsigned* p)              { return __hip_atomic_load(p, __ATOMIC_RELAXED, __HIP_MEMORY_SCOPE_AGENT); }
__device__ __forceinline__ unsigned xb_add(unsigned* p, unsigned v) { return __hip_atomic_fetch_add(p, v, __ATOMIC_RELAXED, __HIP_MEMORY_SCOPE_AGENT); }
__device__ __forceinline__ unsigned xb_xcc_id() { return (unsigned)__builtin_amdgcn_s_getreg((3 << 11) | 20) & 0xFu; }
#define XB_SPIN(cond, bar) do { unsigned _sp = 0; while (cond) { __builtin_amdgcn_s_sleep(1); \
    if ((++_sp & 255u) == 0u) { if (xb_ld(&(bar)[XB_TMO])) break; if (_sp > XB_SPIN_CAP) { atomicAdd(&(bar)[XB_TMO], 1u); break; } } } } while (0)
struct XcdBarrier { unsigned* bar; unsigned x; volatile LAS unsigned* st; };
__device__ __forceinline__ XcdBarrier xcd_barrier_post(unsigned* bar, volatile LAS unsigned* st) {
    XcdBarrier b; b.bar = bar; b.x = xb_xcc_id(); b.st = st;
    if (threadIdx.x == 0) (void)xb_add(&bar[XB_XCNT(b.x)], 1u);
    return b;
}
__device__ __forceinline__ void xcd_barrier_complete(unsigned* bar, unsigned x, unsigned& nloc, unsigned& nx) {
    const unsigned G = gridDim.x * gridDim.y * gridDim.z;
    unsigned sum, cnt, mine, sp = 0u;
    for (;;) {
        sum = 0u; cnt = 0u; mine = 0u;
#pragma unroll
        for (unsigned j = 0; j < 16; ++j) { const unsigned c = xb_ld(&bar[XB_XCNT(j)]); sum += c; cnt += (c > 0u) ? 1u : 0u; mine = (j == x) ? c : mine; }
        if (sum == G) break;
        __builtin_amdgcn_s_sleep(1);
        if ((++sp & 255u) == 0u) { if (xb_ld(&bar[XB_TMO])) break; if (sp > XB_SPIN_CAP) { atomicAdd(&bar[XB_TMO], 1u); break; } }
    }
    nloc = mine > 0u ? mine : 1u; nx = cnt > 0u ? cnt : 1u;
}
__device__ __forceinline__ void xcd_barrier(const XcdBarrier& b) {
    asm volatile("s_waitcnt vmcnt(0)" ::: "memory");
    __syncthreads();
    if (threadIdx.x == 0) {
        unsigned* bar = b.bar;
        __builtin_amdgcn_s_waitcnt(0);
        unsigned nloc = b.st[0], nx = b.st[1];
        if (nloc == 0u) { xcd_barrier_complete(bar, b.x, nloc, nx); b.st[0] = nloc; b.st[1] = nx; }
        const unsigned old = xb_add(&bar[XB_XSUB(b.x)], 1u);
        const unsigned gen = old / nloc;
        if (old + 1u == (gen + 1u) * nloc) {
            __builtin_amdgcn_fence(__ATOMIC_RELEASE, "agent");
            asm volatile("s_waitcnt vmcnt(0)" ::: "memory");
            const unsigned og = xb_add(&bar[XB_TOP], 1u);
            const unsigned tg = og / nx;
            if (og + 1u == (tg + 1u) * nx) xb_add(&bar[XB_TOPGEN], 1u);
            else XB_SPIN(xb_ld(&bar[XB_TOPGEN]) == tg, bar);
            __builtin_amdgcn_fence(__ATOMIC_ACQUIRE, "agent");
            xb_add(&bar[XB_XGEN(b.x)], 1u);
            asm volatile("s_waitcnt vmcnt(0)" ::: "memory");
        } else {
            XB_SPIN(xb_ld(&bar[XB_XGEN(b.x)]) == gen, bar);
            __builtin_amdgcn_fence(__ATOMIC_ACQUIRE, "agent");
            asm volatile("s_waitcnt vmcnt(0)" ::: "memory");
        }
    }
    __syncthreads();
}

__device__ __forceinline__ const void* ldp(const volatile LAS unsigned* tab, int i) {
    const unsigned lo = __builtin_amdgcn_readfirstlane(tab[2 * i]), hi = __builtin_amdgcn_readfirstlane(tab[2 * i + 1]);
    return (const void*)(const GAS void*)(((unsigned long long)hi << 32) | lo);
}
struct Args {
    const float* x; const float* mem; const float* norm_mix; const float* w_in; const float* b_forget; const float* norm_fox; const float* norm_sb; const float* w_out;
    const float* norm_xattn; const float* norm_mem; const float* w_xq; const float* w_xkv; const float* w_xo; const float* norm_ffn;
    const float* w_rg; const float* b_rg; const float* w_re; const float* b_re; const float* w_gate; const float* w_up; const float* w_down; const float* norm_final;
    float* out; unsigned char* ws;
};

__device__ __forceinline__ void transpose_item(const float* W, int ldw, bf16_t* WT, int ldo, int k0, int n0, int dst_row0, const float* gain, LAS float* scr, int lane) {
    float tv[32], tg[32];
#pragma unroll
    for (int i = 0; i < 32; ++i) { const int kk = 2 * i + (lane >> 5); tv[i] = W[(size_t)(k0 + kk) * ldw + n0 + (lane & 31)]; tg[i] = gain ? gain[k0 + kk] : 1.f; }
#pragma unroll
    for (int i = 0; i < 32; ++i) { const int kk = 2 * i + (lane >> 5); scr[kk * 33 + (lane & 31)] = tv[i] * tg[i]; }
    LDS_WAIT(); asm volatile("" ::: "memory");
    const int c = lane & 7;
#pragma unroll
    for (int j = 0; j < 4; ++j) { const int n = (lane >> 3) + 8 * j; const LAS float* s = scr + (8 * c) * 33 + n;
        u32x4 o; o.x = cvt_pk_bf16(s[0 * 33], s[1 * 33]); o.y = cvt_pk_bf16(s[2 * 33], s[3 * 33]); o.z = cvt_pk_bf16(s[4 * 33], s[5 * 33]); o.w = cvt_pk_bf16(s[6 * 33], s[7 * 33]);
        *(u32x4*)(WT + (size_t)(dst_row0 + n) * ldo + k0 + 8 * c) = o; }
    LDS_WAIT(); asm volatile("" ::: "memory");
}

__device__ __forceinline__ void transpose_item8(const float* W, int ldw, unsigned char* WT, int ldo, int k0, int n0, int dst_row0, const float* gain, float scale, LAS float* scr, int lane) {
    float tv[32], tg[32];
#pragma unroll
    for (int i = 0; i < 32; ++i) { const int kk = 2 * i + (lane >> 5); tv[i] = W[(size_t)(k0 + kk) * ldw + n0 + (lane & 31)]; tg[i] = gain ? gain[k0 + kk] : 1.f; }
#pragma unroll
    for (int i = 0; i < 32; ++i) { const int kk = 2 * i + (lane >> 5); scr[kk * 33 + (lane & 31)] = tv[i] * tg[i] * scale; }
    LDS_WAIT(); asm volatile("" ::: "memory");
    const int c = lane & 7;
#pragma unroll
    for (int j = 0; j < 4; ++j) { const int n = (lane >> 3) + 8 * j; const LAS float* s = scr + (8 * c) * 33 + n;
        u32x2 o; o.x = cvt4_fp8(s[0 * 33], s[1 * 33], s[2 * 33], s[3 * 33]); o.y = cvt4_fp8(s[4 * 33], s[5 * 33], s[6 * 33], s[7 * 33]);
        *(u32x2*)(WT + (size_t)(dst_row0 + n) * ldo + k0 + 8 * c) = o; }
    LDS_WAIT(); asm volatile("" ::: "memory");
}

struct SchedDense {
    const char* A; const char* Bt; int nM, nN, G, c; size_t a_tile, b_tile, b_batch; int split_tiles;
    __device__ __forceinline__ bool next(int i, pg8::Unit& u) const {
        int pm, pn; if (!pg8::tile_order(i, G, c, nM, nN, pm, pn)) return false;
        u.a = A + (size_t)pm * a_tile; u.b = Bt + (size_t)pn * b_tile + (size_t)(pm >> 5) * b_batch; u.orow = pm * 256;
        if (split_tiles) { u.aux = pn / split_tiles; u.ocol = (pn % split_tiles) * 256; } else { u.aux = 1; u.ocol = pn * 256; }
        u.rows = nullptr; u.nvalid = 256; return true;
    }
};
struct SchedGH {
    const char* KVm; const char* Wxq; const char* Wxo; int G, c;
    __device__ __forceinline__ bool next(int i, pg8::Unit& u) const {
        const int L = i * G + c; if (L >= 256) return false;
        const int kind = L >> 7, r = L & 127, bh = r >> 2, j = r & 3, b = bh >> 2, h = bh & 3;
        if (kind == 0) { u.a = KVm + ((size_t)(b * 256) * 2048 + h * 256) * 2; u.b = Wxq + ((size_t)(256 * j) * 1024 + h * 256) * 2; u.orow = b * 1024 + h * 256; u.ocol = 256 * j; u.aux = 1; }
        else { u.a = Wxo + ((size_t)(256 * j) * 1024 + h * 256) * 2; u.b = KVm + ((size_t)(b * 256) * 2048 + 1024 + h * 256) * 2; u.orow = b * 1024 + 256 * j; u.ocol = h * 256; u.aux = 2; }
        u.rows = nullptr; u.nvalid = 256; return true;
    }
};
template <int KIND> struct SchedGHk { SchedGH s; __device__ __forceinline__ bool next(int i, pg8::Unit& u) const { const int c2 = (s.G >= 256) ? s.c - 128 * KIND : s.c; if (c2 < 0) return false; const int L = i * s.G + c2; if (L >= 128) return false; SchedGH t = s; t.G = 1; t.c = 0; return t.next(128 * KIND + L, u); } };
struct EpiGH { static constexpr bool HAS_MID = false; unsigned char* GTp; unsigned char* HTp;
    __device__ __forceinline__ void operator()(const f32x4 (&acc)[2][2][4][2], const pg8::Unit& u, int wr, int wc, int fr, int fq) const {
        unsigned char* base = u.aux == 1 ? GTp : HTp;
#pragma unroll
        for (int ai = 0; ai < 2; ++ai)
#pragma unroll
            for (int m = 0; m < 4; ++m) { const int row = u.orow + ai * pg8::HALF + wr * 64 + m * 16 + fr;
#pragma unroll
                for (int bj = 0; bj < 2; ++bj) { const f32x4 v0 = acc[ai][bj][m][0], v1 = acc[ai][bj][m][1];
                    u32x2 w8; w8.x = cvt4_fp8(v0[0], v0[1], v0[2], v0[3]); w8.y = cvt4_fp8(v1[0], v1[1], v1[2], v1[3]);
                    *(u32x2*)(base + (size_t)row * DM + u.ocol + bj * pg8::HALF + wc * 32 + 8 * fq) = w8; } }
    } };
struct SchedMoe {
    const char* A; const char* W; const int* list; const LAS int* tbl; int G, c, NPN; size_t w_exp, w_tile, a_tile; int ocol_w;
    __device__ __forceinline__ bool next(int i, pg8::Unit& u) const {
        const int L = i * G + c; const int tl = L / NPN, pn = L % NPN;
        if (tl >= __builtin_amdgcn_readfirstlane(tbl[16])) return false;
        int e = 0;
#pragma unroll 1
        for (int x = 1; x < NEXP; ++x) { if (tl >= __builtin_amdgcn_readfirstlane(tbl[x])) e = x; }
        const int j = tl - __builtin_amdgcn_readfirstlane(tbl[e]), n = __builtin_amdgcn_readfirstlane(tbl[32 + e]) - 256 * j;
        u.a = A + (size_t)tl * a_tile; u.b = W + (size_t)e * w_exp + (size_t)pn * w_tile; u.orow = tl * 256; u.ocol = pn * ocol_w; u.aux = 1;
        u.rows = list + (size_t)e * M + 256 * j; u.nvalid = n < 256 ? n : 256; return true;
    }
};
__device__ __forceinline__ void moe_table(LAS int* tbl, const unsigned* ctl) {
    if (threadIdx.x == 0) { int base = 0; for (int e = 0; e < NEXP; ++e) { const int n = (int)ctl[CW_CNT + 64 * e]; tbl[e] = base; tbl[32 + e] = n; base += (n + 255) >> 8; } tbl[16] = base; }
    __syncthreads();
}

__global__ void __launch_bounds__(NWAVES * 64, 2) hymba_fwd(Args args) {
    extern __shared__ __attribute__((aligned(16))) unsigned char lds_raw[];
    LAS unsigned char* lds = (LAS unsigned char*)lds_raw;
    volatile LAS unsigned* MISC = (volatile LAS unsigned*)(lds + MISC_OFF);
    const int tid0 = threadIdx.x; const int wave = __builtin_amdgcn_readfirstlane(tid0 >> 6);
    const int G = gridDim.x; const int bx = blockIdx.x; const int vcu = (G % 8 == 0) ? (bx % 8) * (G / 8) + bx / 8 : bx;
    volatile LAS unsigned* ATAB = (volatile LAS unsigned*)(lds + MISC_OFF + 512);
    for (int u = tid0; u < 256; u += NWAVES * 64) ((LAS unsigned*)(lds + MISC_OFF))[u] = 0u;
    __syncthreads();
    if (tid0 == 0) { const float* const* ap = (const float* const*)&args;
#pragma unroll
        for (int i = 0; i < 24; ++i) { const unsigned long long v = (unsigned long long)ap[i]; ATAB[2 * i] = (unsigned)v; ATAB[2 * i + 1] = (unsigned)(v >> 32); } }
    __syncthreads();
#define ARGP(name) ((const float*)ldp(ATAB, (int)(offsetof(Args, name) / 8)))
#define PHASE_PTRS \
    int tid = threadIdx.x; asm volatile("" : "+v"(tid)); const int lane = tid & 63; (void)lane; \
    unsigned char* const ws = (unsigned char*)ldp(ATAB, 23); float* const out = (float*)ldp(ATAB, 22); unsigned* const ctl = (unsigned*)(ws + WS_CTL); (void)out; (void)ctl; \
    bf16_t* const Win_t = (bf16_t*)(ws + WS_WIN); bf16_t* const Wout_t = (bf16_t*)(ws + WS_WOUT); bf16_t* const Wxq_n = (bf16_t*)(ws + WS_WXQ); bf16_t* const Wxkv_t = (bf16_t*)(ws + WS_WXKV); \
    bf16_t* const Wxo_t = (bf16_t*)(ws + WS_WXO); bf16_t* const Wgu_t = (bf16_t*)(ws + WS_WGU); bf16_t* const Wd_t = (bf16_t*)(ws + WS_WD); \
    float* const RX = (float*)(ws + WS_RX); float* const RMEM = (float*)(ws + WS_RMEM); float* const LF = (float*)(ws + WS_LF); float* const CC = (float*)(ws + WS_C2); float* const SSQ = (float*)(ws + WS_SSQ); \
    int* const TOKSLOT = (int*)(ws + WS_TOKSLOT); float* const TOKW = (float*)(ws + WS_TOKW); int* const LIST = (int*)(ws + WS_LIST); \
    bf16_t* const MEMB = (bf16_t*)(ws + WS_MEMB); bf16_t* const KVM = (bf16_t*)(ws + WS_KVM); bf16_t* const GT = (bf16_t*)(ws + WS_GT); bf16_t* const HT = (bf16_t*)(ws + WS_HT); \
    bf16_t* const XB = (bf16_t*)(ws + WS_XB); bf16_t* const QKV = (bf16_t*)(ws + WS_QKV); bf16_t* const H1B = (bf16_t*)(ws + WS_H1B); bf16_t* const U2B = (bf16_t*)(ws + WS_U2B); bf16_t* const HID = (bf16_t*)(ws + WS_HID); \
    bf16_t* const OAB = (bf16_t*)(ws + WS_O); bf16_t* const YB = (bf16_t*)(ws + WS_Y); bf16_t* const KX = (bf16_t*)(ws + WS_KX); (void)KX; float* const HS = (float*)(ws + WS_HS); (void)HS; float* const R2S = (float*)(ws + WS_SSQ); (void)R2S; unsigned char* const H1F8 = ws + WS_H1F8; (void)H1F8; unsigned char* const H2F8 = ws + WS_H2F8; (void)H2F8; \
    (void)Win_t; (void)Wout_t; (void)Wxq_n; (void)Wxkv_t; (void)Wxo_t; (void)Wgu_t; (void)Wd_t; (void)RX; (void)RMEM; (void)LF; (void)CC; (void)SSQ; (void)TOKSLOT; (void)TOKW; (void)LIST; \
    (void)MEMB; (void)KVM; (void)GT; (void)HT; (void)XB; (void)QKV; (void)H1B; (void)U2B; (void)HID; (void)OAB; (void)YB;
    XcdBarrier bar;
    { unsigned char* const ws0 = (unsigned char*)ldp(ATAB, 23); bar = xcd_barrier_post((unsigned*)(ws0 + WS_CTL) + CW_BAR, MISC + 8); }
    const int gw = vcu * NWAVES + wave, NGW = G * NWAVES;
    unsigned long long t_pa = 0, t_pb = 0; (void)t_pa; (void)t_pb;


    if (PROBE_LO == 0) t_pa = __builtin_amdgcn_s_memrealtime();
    if (PH(0))
    for (int rep_ = 0; rep_ < REPS(0); ++rep_)
    {
        PHASE_PTRS
        LAS float* wfT = (LAS float*)(lds + RING_OFF);
        LAS float* scr = (LAS float*)(lds + RING_OFF + 32768 + wave * 8448);
        { const float* win = ARGP(w_in); const float* gmix = ARGP(norm_mix);
          f32x4 fa[2], fb[2]; float gk[2];
#pragma unroll
          for (int q = 0; q < 2; ++q) { const int k = tid + 512 * q; gk[q] = gmix[k]; fa[q] = *(const f32x4*)(win + (size_t)k * WIN_LD + NPROJ); fb[q] = *(const f32x4*)(win + (size_t)k * WIN_LD + NPROJ + 4); }
#pragma unroll
          for (int q = 0; q < 2; ++q) { const int k = tid + 512 * q;
#pragma unroll
              for (int j = 0; j < 4; ++j) { wfT[j * DM + k] = fa[q][j] * gk[q]; wfT[(4 + j) * DM + k] = fb[q][j] * gk[q]; } } }
        constexpr int I_IN = 16 * 96, I_OUT = 16 * 32, I_XKV = 16 * 64, I_XO = 16 * 32, I_G = 16 * 16 * 8, I_U = I_G, I_D = 16 * 4 * 32, I_XQ = 1024;
        constexpr int NITEMS = I_IN + I_OUT + I_XKV + I_XO + I_G + I_U + I_D + I_XQ;
        for (int it = gw; it < NITEMS; it += NGW) {
            int r = it;
            if (r < I_IN) { const int kb = r / 96, nb = r % 96; transpose_item(ARGP(w_in), WIN_LD, Win_t, DM, 64 * kb, 32 * nb, 32 * nb, ARGP(norm_mix), scr, lane); continue; } r -= I_IN;
            if (r < I_OUT) { const int kb = r / 32, nb = r % 32; const float* gn = (64 * kb < HW) ? ARGP(norm_fox) : (ARGP(norm_sb) - HW); transpose_item(ARGP(w_out), DM, Wout_t, DM, 64 * kb, 32 * nb, 32 * nb, gn, scr, lane); continue; } r -= I_OUT;
            if (r < I_XKV) { const int kb = r / 64, nb = r % 64; transpose_item(ARGP(w_xkv), 2 * DM, Wxkv_t, DM, 64 * kb, 32 * nb, 32 * nb, ARGP(norm_mem), scr, lane); continue; } r -= I_XKV;
            if (r < I_XO) { const int kb = r / 32, nb = r % 32; transpose_item(ARGP(w_xo), DM, Wxo_t, DM, 64 * kb, 32 * nb, 32 * nb, nullptr, scr, lane); continue; } r -= I_XO;
            if (r < I_G + I_U) { const int up = r >= I_G; const int q = up ? r - I_G : r; const int e = q / 128, kb = (q % 128) / 8, nb = q % 8; const int n0 = 32 * nb;
                const float* W = (up ? ARGP(w_up) : ARGP(w_gate)) + (size_t)e * DM * DFF;
                transpose_item8(W, DFF, (unsigned char*)Wgu_t + (size_t)e * 512 * DM, DM, 64 * kb, n0, 256 * (n0 / 128) + (n0 % 128) + (up ? 128 : 0), ARGP(norm_ffn), WGU_SCALE, scr, lane); continue; } r -= I_G + I_U;
            if (r < I_D) { const int e = r / 128, kb = (r % 128) / 32, nb = r % 32; transpose_item8(ARGP(w_down) + (size_t)e * DFF * DM, DM, (unsigned char*)Wd_t + (size_t)e * DM * DFF, DFF, 64 * kb, 32 * nb, 32 * nb, nullptr, WD_SCALE, scr, lane); continue; } r -= I_D;
            { const int k = r; const float gk = ARGP(norm_xattn)[k]; const f32x4* src = (const f32x4*)(ARGP(w_xq) + (size_t)k * DM) + lane; u32x2* dst = (u32x2*)(Wxq_n + (size_t)k * DM) + lane;
#pragma unroll
              for (int j = 0; j < 4; ++j) { const f32x4 v = src[64 * j] * gk; u32x2 w; w.x = cvt_pk_bf16(v[0], v[1]); w.y = cvt_pk_bf16(v[2], v[3]); dst[64 * j] = w; } }
        }
        __syncthreads();
        const float* xin = ARGP(x); const float* memin = ARGP(mem); const float* bfg = ARGP(b_forget);
        constexpr int TOT = M + MEMROWS;
#define P0_LOAD(vv, rw) do { if ((rw) < TOT) { const bool im_ = (rw) >= M; const f32x4* xr_ = (const f32x4*)((im_ ? memin : xin) + (size_t)(im_ ? (rw) - M : (rw)) * DM) + lane; \
        _Pragma("unroll") for (int j = 0; j < 4; ++j) vv[j] = __builtin_nontemporal_load(xr_ + 64 * j); } } while (0)
#define P0_ROW(vv, rw) do { const int row_ = (rw); const bool is_mem = row_ >= M; const int r = is_mem ? row_ - M : row_; float s = 0.f; \
        _Pragma("unroll") for (int j = 0; j < 4; ++j) s += (vv[j][0] * vv[j][0] + vv[j][1] * vv[j][1]) + (vv[j][2] * vv[j][2] + vv[j][3] * vv[j][3]); \
        const float rinv = rsqrtf(wave_sum(s) * (1.0f / DM) + EPS); \
        u32x2* o8 = (u32x2*)((is_mem ? MEMB : XB) + (size_t)r * DM) + lane; \
        _Pragma("unroll") for (int j = 0; j < 4; ++j) { u32x2 w; w.x = cvt_pk_bf16(vv[j][0], vv[j][1]); w.y = cvt_pk_bf16(vv[j][2], vv[j][3]); o8[64 * j] = w; } \
        if (is_mem) { if (lane == 0) RMEM[r] = rinv; } \
        else { float f[8]; \
            _Pragma("unroll") for (int jj = 0; jj < 8; ++jj) { float a = 0.f; \
                _Pragma("unroll") for (int j = 0; j < 4; ++j) { const f32x4 w4 = *(const LAS f32x4*)(wfT + jj * DM + 256 * j + 4 * lane); a += (vv[j][0] * w4[0] + vv[j][1] * w4[1]) + (vv[j][2] * w4[2] + vv[j][3] * w4[3]); } \
                f[jj] = wave_sum(a); } \
            if (lane == 0) RX[r] = rinv; \
            if (lane < 8) { float fl = 0.f; \
                _Pragma("unroll") for (int jj = 0; jj < 8; ++jj) fl = (lane == jj) ? f[jj] : fl; \
                fl = fl * rinv + bfg[lane]; \
                const float ls = fminf(fl, 0.f) - log1pf(expf(-fabsf(fl))); \
                LF[(size_t)r * 8 + lane] = ls * LOG2E; } } } while (0)
        f32x4 va[4], vb[4], vc[4];
        P0_LOAD(va, gw); P0_LOAD(vb, gw + NGW);
        for (int row = gw; row < TOT; row += 3 * NGW) {
            P0_LOAD(vc, row + 2 * NGW); P0_ROW(va, row);
            if (row + NGW < TOT) { P0_LOAD(va, row + 3 * NGW); P0_ROW(vb, row + NGW); }
            if (row + 2 * NGW < TOT) { P0_LOAD(vb, row + 4 * NGW); P0_ROW(vc, row + 2 * NGW); }
        }
#undef P0_LOAD
#undef P0_ROW
    }
    xcd_barrier(bar);
    if (PROBE_HI == 0) t_pb = __builtin_amdgcn_s_memrealtime();

    if (PROBE_LO == 1) t_pa = __builtin_amdgcn_s_memrealtime();
    if (PH(1))
    if (vcu < 32) {
        PHASE_PTRS
        const int b = vcu >> 2, h = (vcu & 3) * 2 + (wave >> 2), seg = wave & 3, s0 = seg * 2048 + lane * 32;
        const float* src = LF + ((size_t)b * SEQ + s0) * 8 + h;
        float p[32];
#pragma unroll
        for (int j = 0; j < 32; ++j) p[j] = src[j * 8];
#pragma unroll
        for (int j = 1; j < 32; ++j) p[j] += p[j - 1];
        float inc = p[31];
#pragma unroll
        for (int o = 1; o < 64; o <<= 1) { const float y = __shfl_up(inc, o); if (lane >= o) inc += y; }
        LAS float* tot = (LAS float*)(lds + EXTRA_OFF);
        if (lane == 63) tot[wave] = inc;
        __syncthreads();
        float off = inc - p[31];
        for (int q = 0; q < 3; ++q) if (q < seg) off += tot[(wave & 4) + q];
        float* dst = CC + ((size_t)b * NH + h) * SEQ + s0; bf16_t* kx = KX + (((size_t)b * NH + h) * SEQ + s0) * 8;
#pragma unroll
        for (int j = 0; j < 32; ++j) { const float x = off + p[j]; dst[j] = x;
            unsigned hm, lo; fox::split3(-x, hm, lo); u32x4 w; w.x = 0x3F803F80u; w.y = 0x3F80u | (hm << 16); w.z = (hm >> 16) | (lo << 16); w.w = 0u;
            *(u32x4*)(kx + j * 8) = w; }
        VM_WAIT(); __syncthreads();
    }
    if (PH(1))
    for (int rep_ = 0; rep_ < REPS(1); ++rep_)
    {
        PHASE_PTRS
        pg8::Gemm g{DM, DM, DM};
        SchedDense S{(const char*)XB, (const char*)Win_t, M / 256, NPROJ / 256, G, bx, (size_t)256 * DM * 2, (size_t)256 * DM * 2, 0, 2};
        LAS float* rst = (LAS float*)(lds + EXTRA_OFF);
        for (int i = 0; i < 16; ++i) { int pm, pn; if (!pg8::tile_order(i, G, bx, M / 256, NPROJ / 256, pm, pn)) break; if (tid < 256) rst[i * 256 + tid] = RX[pm * 256 + tid]; }
        VM_WAIT(); __syncthreads();
        pg8::EpiBf16 E{QKV, HW, RX, QKV_STRIDE, C2, C2, ctl + CW_KN, rst, 1.f, false};
        pg8::gemm_phase<pg8::EpiBf16, SchedDense, true, false>(lds + RING_OFF, g, S, E);
    }
    xcd_barrier(bar);
    if (PROBE_HI == 1) t_pb = __builtin_amdgcn_s_memrealtime();

    if (PROBE_LO == 2) t_pa = __builtin_amdgcn_s_memrealtime();
    if (PH(2))
    {
        PHASE_PTRS
        const bf16_t* QA = QKV; const bf16_t* KA = QKV + QKV_STRIDE; const bf16_t* VA = QKV + 2 * QKV_STRIDE;
        const bf16_t* QBp = QKV + 3 * QKV_STRIDE; const bf16_t* KBp = QKV + 4 * QKV_STRIDE; const bf16_t* VBp = QKV + 5 * QKV_STRIDE;
        bf16_t* OA = OAB; bf16_t* OB = OAB + HW;
        LAS char* shm = (LAS char*)(lds + RING_OFF);
        { pg8::Gemm g{DM, DM, DM};
          SchedDense S2{(const char*)MEMB, (const char*)Wxkv_t, MEMROWS / 256, 2 * DM / 256, G, bx, (size_t)256 * DM * 2, (size_t)256 * DM * 2, 0, 0};
          pg8::EpiBf16 E2{KVM, 2 * DM, RMEM, 0, 1.f, 1.f, nullptr, nullptr, 1.f, false};
          pg8::gemm_phase<pg8::EpiBf16, SchedDense, true, false>(lds + RING_OFF, g, S2, E2);
          VM_WAIT(); __syncthreads(); }
        for (int rep = 0; rep < REP_FOX; ++rep)
        for (int i = 0; i < 8; ++i) { const int bh = (vcu >> 5) * 8 + i, x = vcu & 31, qb = (i & 1) ? 31 - x : x;
            const float kmax = sqrtf(__uint_as_float(ctl[CW_KN + bh * 2]) + __uint_as_float(ctl[CW_KN + bh * 2 + 1])) * 1.01f;
            fox::fox_unit<8>(bh, qb, QA, KA, VA, OA, HS + (bh & 7), CC + (size_t)bh * SEQ, KX + (size_t)bh * SEQ * 8, kmax, shm); }
        { volatile LAS unsigned* qs = MISC + 16;
          unsigned nxt = 0u;
          if (tid == 0) qs[0] = __hip_atomic_fetch_add(ctl + CW_SBQ, 1u, __ATOMIC_RELAXED, __HIP_MEMORY_SCOPE_AGENT);
          __syncthreads();
          unsigned idx = qs[0];
          while (idx < (unsigned)(BATCH * NH * 32 * REP_SB)) {
              __syncthreads();
              if (tid == 0) nxt = __hip_atomic_fetch_add(ctl + CW_SBQ, 1u, __ATOMIC_RELAXED, __HIP_MEMORY_SCOPE_AGENT);
              const int un = (int)(idx % (unsigned)(BATCH * NH * 32)), bh = un >> 5, qb = un & 31;
              sbk::sb_unit(bh >> 3, bh & 7, qb, QBp, KBp, VBp, OB, HS + 8 + (bh & 7), shm);
              if (tid == 0) qs[0] = nxt;
              __syncthreads();
              idx = qs[0];
          } }
    }
    xcd_barrier(bar);
    if (PROBE_HI == 2) t_pb = __builtin_amdgcn_s_memrealtime();

    if (PROBE_LO == 4) t_pa = __builtin_amdgcn_s_memrealtime();
    if (PH(4))
    for (int rep_ = 0; rep_ < REPS(4); ++rep_)
    {
        PHASE_PTRS
        pg8::Gemm g{DM, DM, DM};
        SchedDense S{(const char*)OAB, (const char*)Wout_t, M / 256, DM / 256, G, bx, (size_t)256 * DM * 2, (size_t)256 * DM * 2, 0, 0};
        LAS f32x2* rab = (LAS f32x2*)(lds + EXTRA_OFF);
        for (int i = 0; i < 8; ++i) { int pm, pn; if (!pg8::tile_order(i, G, bx, M / 256, DM / 256, pm, pn)) break;
            if (tid < 256) { const f32x4* p = (const f32x4*)(HS + (size_t)(pm * 256 + tid) * 16); const f32x4 a0 = p[0], a1 = p[1], b0 = p[2], b1 = p[3];
                const float ra = rsqrtf((((a0[0] + a0[1]) + (a0[2] + a0[3])) + ((a1[0] + a1[1]) + (a1[2] + a1[3]))) * (1.0f / HW) + EPS);
                const float rb = rsqrtf((((b0[0] + b0[1]) + (b0[2] + b0[3])) + ((b1[0] + b1[1]) + (b1[2] + b1[3]))) * (1.0f / HW) + EPS);
                rab[i * 256 + tid] = (f32x2){ra / rb, rb}; } }
        VM_WAIT(); __syncthreads();
        pg8::EpiOutProj E{XB, H1B, H1F8, SSQ, rab};
        pg8::gemm_phase<pg8::EpiOutProj, SchedDense, true, false>(lds + RING_OFF, g, S, E);
        pg8::Gemm g2{0, 0, 256};
        SchedGH SG{(const char*)KVM, (const char*)Wxq_n, (const char*)Wxo_t, G, bx};
        EpiGH EG{(unsigned char*)GT, (unsigned char*)HT};
        g2.lda = 2 * DM; g2.ldb = DM; SchedGHk<0> S0{SG}; pg8::gemm_phase<EpiGH, SchedGHk<0>, true, false>(lds + RING_OFF, g2, S0, EG);
        g2.lda = DM; g2.ldb = 2 * DM; SchedGHk<1> S1{SG}; pg8::gemm_phase<EpiGH, SchedGHk<1>, true, false>(lds + RING_OFF, g2, S1, EG);
    }
    xcd_barrier(bar);
    if (PROBE_HI == 4) t_pb = __builtin_amdgcn_s_memrealtime();

    if (PROBE_LO == 5) t_pa = __builtin_amdgcn_s_memrealtime();
    if (PH(5))
    for (int rep_ = 0; rep_ < REPS(5); ++rep_)
    {
        PHASE_PTRS
        pg8::Gemm g{DM, DM, DM};
        SchedDense S{(const char*)H1F8, (const char*)GT, M / 256, DM / 256, G, bx, (size_t)256 * DM, (size_t)256 * DM, (size_t)DM * DM, 0};
        LAS float* r1t = (LAS float*)(lds + EXTRA_OFF + 8192);
        for (int i = 0; i < 8; ++i) { int pm, pn; if (!pg8::tile_order(i, G, bx, M / 256, DM / 256, pm, pn)) break;
            if (tid < 256) { const f32x4* sp = (const f32x4*)(SSQ + (size_t)(pm * 256 + tid) * 16); const f32x4 s0 = sp[0], s1 = sp[1], s2 = sp[2], s3 = sp[3];
                const float tot = ((s0[0] + s0[1]) + (s0[2] + s0[3])) + ((s1[0] + s1[1]) + (s1[2] + s1[3])) + ((s2[0] + s2[1]) + (s2[2] + s2[3])) + ((s3[0] + s3[1]) + (s3[2] + s3[3]));
                r1t[i * 256 + tid] = rsqrtf(tot * (1.0f / DM) + EPS) * XSC; } }
        VM_WAIT(); __syncthreads();
        pg8::EpiSoftmax E{XB, r1t, (LAS float*)(lds + EXTRA_OFF)};
        pg8::gemm_phase<pg8::EpiSoftmax, SchedDense, true, false, true>(lds + RING_OFF, g, S, E);
    }
    xcd_barrier(bar);
    if (PROBE_HI == 5) t_pb = __builtin_amdgcn_s_memrealtime();

    if (PROBE_LO == 6) t_pa = __builtin_amdgcn_s_memrealtime();
    if (PH(6))
    {
        PHASE_PTRS
        pg8::Gemm g{DM, DM, DM};
        SchedDense S{(const char*)XB, (const char*)HT, M / 256, DM / 256, G, bx, (size_t)256 * DM, (size_t)256 * DM, (size_t)DM * DM, 0};
        pg8::EpiResidBf16 E{H1B, H2F8, 1.0f / P_SCALE};
        pg8::gemm_phase<pg8::EpiResidBf16, SchedDense, true, false, true>(lds + RING_OFF, g, S, E);
    }
    xcd_barrier(bar);
    if (PROBE_HI == 6) t_pb = __builtin_amdgcn_s_memrealtime();

    if (PROBE_LO == 7) t_pa = __builtin_amdgcn_s_memrealtime();
    if (PH(7))
    {
        PHASE_PTRS
        LAS bf16_t* wBh = (LAS bf16_t*)(lds + RING_OFF); LAS bf16_t* wBl = wBh + 20 * DM;
        { const f32x4* wg4 = (const f32x4*)ARGP(w_rg); const f32x4* we4 = (const f32x4*)ARGP(w_re); const float* gf = ARGP(norm_ffn);
          f32x4 ga[2], ea[2][4]; float gk[2];
#pragma unroll
          for (int q = 0; q < 2; ++q) { const int k = tid + 512 * q; ga[q] = wg4[k]; gk[q] = gf[k];
#pragma unroll
              for (int c = 0; c < 4; ++c) ea[q][c] = we4[k * 4 + c]; }
#pragma unroll
          for (int q = 0; q < 2; ++q) { const int k = tid + 512 * q;
#pragma unroll
              for (int j = 0; j < 4; ++j) { { const float v = ga[q][j] * gk[q]; const unsigned hi_ = cvt_pk_bf16(v, 0.f) & 0xffffu; wBh[j * DM + k] = (bf16_t)hi_; wBl[j * DM + k] = (bf16_t)(cvt_pk_bf16(v - __uint_as_float(hi_ << 16), 0.f) & 0xffffu); }
#pragma unroll
                  for (int c = 0; c < 4; ++c) { const float v = ea[q][c][j] * gk[q]; const unsigned hi_ = cvt_pk_bf16(v, 0.f) & 0xffffu; const int col = 4 + 4 * c + j; wBh[col * DM + k] = (bf16_t)hi_; wBl[col * DM + k] = (bf16_t)(cvt_pk_bf16(v - __uint_as_float(hi_ << 16), 0.f) & 0xffffu); } } } }
        LAS int* dec_e = (LAS int*)(lds + RING_OFF + 81920); LAS float* dec_w = (LAS float*)(lds + RING_OFF + 81920 + 2048); LAS int* dec_r = (LAS int*)(lds + RING_OFF + 81920 + 4096);
        LAS int* hist = (LAS int*)(lds + RING_OFF + 81920 + 6144); LAS int* ebase = hist + 16; LAS float* dec_v = (LAS float*)(lds + RING_OFF + 81920 + 8192);
        if (tid < 16) hist[tid] = 0;
        __syncthreads();
        const float brg0 = ARGP(b_rg)[0], brg1 = ARGP(b_rg)[1], brg2 = ARGP(b_rg)[2], brg3 = ARGP(b_rg)[3]; const float* bre = ARGP(b_re);
        const int tok = lane & 31, half = lane >> 5, jcol = tok < 20 ? tok : 19;
        for (int it = 0; it * NGW < M / 32; ++it) {
            const int T = gw + it * NGW; const bool act = T < M / 32; const int r0 = act ? 32 * T : 0;
            const bf16_t* rowp = H1B + (size_t)(r0 + tok) * DM + 512 * half;
            const LAS bf16_t* wph = wBh + jcol * DM + 512 * half; const LAS bf16_t* wpl = wBl + jcol * DM + 512 * half;
            f32x16 ah0 = f32x16{}, ah1 = f32x16{}, al0 = f32x16{}, al1 = f32x16{}; float ssq = 0.f;
#pragma unroll 4
            for (int sidx = 0; sidx < 64; sidx += 2) {
                const u32x4 a0 = *(const u32x4*)(rowp + 8 * sidx), a1 = *(const u32x4*)(rowp + 8 * sidx + 8);
                const bf16x8 wh0 = *(const LAS bf16x8*)(wph + 8 * sidx), wl0 = *(const LAS bf16x8*)(wpl + 8 * sidx), wh1 = *(const LAS bf16x8*)(wph + 8 * sidx + 8), wl1 = *(const LAS bf16x8*)(wpl + 8 * sidx + 8);
                ah0 = MFMA32(wh0, __builtin_bit_cast(bf16x8, a0), ah0); al0 = MFMA32(wl0, __builtin_bit_cast(bf16x8, a0), al0);
                ah1 = MFMA32(wh1, __builtin_bit_cast(bf16x8, a1), ah1); al1 = MFMA32(wl1, __builtin_bit_cast(bf16x8, a1), al1);
                ssq += (bf16lo(a0.x) * bf16lo(a0.x) + bf16hi(a0.x) * bf16hi(a0.x)) + (bf16lo(a0.y) * bf16lo(a0.y) + bf16hi(a0.y) * bf16hi(a0.y)) + (bf16lo(a0.z) * bf16lo(a0.z) + bf16hi(a0.z) * bf16hi(a0.z)) + (bf16lo(a0.w) * bf16lo(a0.w) + bf16hi(a0.w) * bf16hi(a0.w));
                ssq += (bf16lo(a1.x) * bf16lo(a1.x) + bf16hi(a1.x) * bf16hi(a1.x)) + (bf16lo(a1.y) * bf16lo(a1.y) + bf16hi(a1.y) * bf16hi(a1.y)) + (bf16lo(a1.z) * bf16lo(a1.z) + bf16hi(a1.z) * bf16hi(a1.z)) + (bf16lo(a1.w) * bf16lo(a1.w) + bf16hi(a1.w) * bf16hi(a1.w));
            }
            const float rinv = rsqrtf((att::swap_lo(ssq) + att::swap_hi(ssq)) * (1.0f / DM) + EPS);
            float lg[20];
#pragma unroll
            for (int r = 0; r < 12; ++r) { const float c = (ah0[r] + ah1[r]) + (al0[r] + al1[r]); auto rr = __builtin_amdgcn_permlane32_swap(__float_as_uint(c), __float_as_uint(c), false, false);
                const int jl = (r & 3) + 8 * (r >> 2); lg[jl] = __uint_as_float(rr[0]) * rinv; if (r < 8) lg[jl + 4] = __uint_as_float(rr[1]) * rinv; }
            float g0 = lg[0] + brg0, g1 = lg[1] + brg1, g2 = lg[2] + brg2, g3 = lg[3] + brg3;
            int gi = 0; float gm = g0; if (g1 > gm) { gm = g1; gi = 1; } if (g2 > gm) { gm = g2; gi = 2; } if (g3 > gm) { gm = g3; gi = 3; }
            const float gval = 1.0f / (expf(g0 - gm) + expf(g1 - gm) + expf(g2 - gm) + expf(g3 - gm));
            float el[4];
#pragma unroll
            for (int j = 0; j < 4; ++j) { const float e0 = lg[4 + j], e1 = lg[8 + j], e2 = lg[12 + j], e3 = lg[16 + j]; el[j] = ((gi == 0) ? e0 : (gi == 1) ? e1 : (gi == 2) ? e2 : e3) + bre[gi * 4 + j]; }
            int i0 = 0; float m0 = el[0];
#pragma unroll
            for (int j = 1; j < 4; ++j) if (el[j] > m0) { m0 = el[j]; i0 = j; }
            int i1 = -1; float m1 = -3.0e38f;
#pragma unroll
            for (int j = 0; j < 4; ++j) if (j != i0 && el[j] > m1) { m1 = el[j]; i1 = j; }
            const float w0 = 1.0f / (1.0f + expf(m1 - m0)), w1 = 1.0f - w0;
            if (act) { const int e = gi * 4 + (half == 0 ? i0 : i1); const float w = gval * (half == 0 ? w0 : w1);
                const int idx = (wave * 32 + tok) * 2 + half; dec_e[idx] = e; dec_w[idx] = w; dec_v[idx] = rinv; dec_r[idx] = __hip_atomic_fetch_add(hist + e, 1, __ATOMIC_RELAXED, __HIP_MEMORY_SCOPE_WORKGROUP); }
            __syncthreads();
            if (tid < 16) { const int n = hist[tid]; ebase[tid] = n ? (int)__hip_atomic_fetch_add(ctl + CW_CNT + 64 * tid, (unsigned)n, __ATOMIC_RELAXED, __HIP_MEMORY_SCOPE_AGENT) : 0; }
            __syncthreads();
            if (act) { const int row = r0 + (lane >> 1), idx = wave * 64 + lane; const int e = dec_e[idx], pos = ebase[e] + dec_r[idx];
                LIST[(size_t)e * M + pos] = row; R2S[(size_t)e * M + pos] = dec_v[idx]; TOKSLOT[(size_t)row * 2 + (lane & 1)] = (e << 20) | pos; TOKW[(size_t)row * 2 + (lane & 1)] = dec_w[idx]; }
            __syncthreads();
            if (tid < 16) hist[tid] = 0;
            __syncthreads();
        }
    }
    xcd_barrier(bar);
    if (PROBE_HI == 7) t_pb = __builtin_amdgcn_s_memrealtime();

    if (PROBE_LO == 8) t_pa = __builtin_amdgcn_s_memrealtime();
    if (PH(8))
    for (int rep_ = 0; rep_ < REPS(8); ++rep_)
    {
        PHASE_PTRS
        pg8::Gemm g{DM, DM, DM};
        LAS int* tbl = (LAS int*)(lds + EXTRA_OFF + 8192); moe_table(tbl, ctl);
        SchedMoe S; S.A = (const char*)H2F8; S.W = (const char*)Wgu_t; S.list = LIST; S.tbl = tbl; S.G = G; S.c = bx; S.NPN = 2; S.w_exp = (size_t)512 * DM; S.w_tile = (size_t)256 * DM; S.a_tile = 0; S.ocol_w = 128;
        pg8::EpiSwiglu E{HID, R2S, LIST};
        pg8::gemm_phase<pg8::EpiSwiglu, SchedMoe, true, true, true>(lds + RING_OFF, g, S, E);
    }
    xcd_barrier(bar);
    if (PROBE_HI == 8) t_pb = __builtin_amdgcn_s_memrealtime();

    if (PROBE_LO == 9) t_pa = __builtin_amdgcn_s_memrealtime();
    if (PH(9))
    for (int rep_ = 0; rep_ < REPS(9); ++rep_)
    {
        PHASE_PTRS
        pg8::Gemm g{DFF, DFF, DFF};
        LAS int* tbl = (LAS int*)(lds + EXTRA_OFF + 8192);
        SchedMoe S; S.A = (const char*)HID; S.W = (const char*)Wd_t; S.list = LIST; S.tbl = tbl; S.G = G; S.c = bx; S.NPN = 4; S.w_exp = (size_t)DM * DFF; S.w_tile = (size_t)256 * DFF; S.a_tile = (size_t)256 * DFF; S.ocol_w = 256;
        pg8::EpiBf16 E{YB, DM, nullptr, 0, 1.f, 1.f, nullptr, nullptr, 1.0f / WD_SCALE, true};
        pg8::gemm_phase<pg8::EpiBf16, SchedMoe, true, false, true>(lds + RING_OFF, g, S, E);
    }
    xcd_barrier(bar);
    if (PROBE_HI == 9) t_pb = __builtin_amdgcn_s_memrealtime();

    if (PROBE_LO == 10) t_pa = __builtin_amdgcn_s_memrealtime();
    if (PH(10))
    {
        PHASE_PTRS
        const LAS int* tb = (const LAS int*)(lds + EXTRA_OFF + 8192);
        const f32x4* gp = (const f32x4*)ARGP(norm_final) + lane;
        int sl0 = 0, sl1 = 0; float sw0 = 0.f, sw1 = 0.f;
        unsigned ya_n[4], yb_n[4]; u32x2 hh_n[4]; float w0_n = 0.f, w1_n = 0.f;
#define P10_SLOTS(rw) do { sl0 = TOKSLOT[(size_t)(rw) * 2]; sl1 = TOKSLOT[(size_t)(rw) * 2 + 1]; sw0 = TOKW[(size_t)(rw) * 2]; sw1 = TOKW[(size_t)(rw) * 2 + 1]; } while (0)
#define P10_DATA(rw) do { const int r0_ = tb[sl0 >> 20] * 256 + (sl0 & 0xfffff), r1_ = tb[sl1 >> 20] * 256 + (sl1 & 0xfffff); w0_n = sw0; w1_n = sw1; \
        const unsigned* y0_ = (const unsigned*)((const unsigned char*)YB + (size_t)r0_ * DM) + lane; const unsigned* y1_ = (const unsigned*)((const unsigned char*)YB + (size_t)r1_ * DM) + lane; const u32x2* h_ = (const u32x2*)(H1B + (size_t)(rw) * DM) + lane; \
        _Pragma("unroll") for (int j = 0; j < 4; ++j) { ya_n[j] = y0_[64 * j]; yb_n[j] = y1_[64 * j]; hh_n[j] = h_[64 * j]; } } while (0)
        if (gw < M) { P10_SLOTS(gw); P10_DATA(gw); if (gw + NGW < M) P10_SLOTS(gw + NGW); }
        for (int row = gw; row < M; row += NGW) {
            unsigned ya[4], yb[4]; u32x2 hh[4]; const float w0 = w0_n, w1 = w1_n;
#pragma unroll
            for (int j = 0; j < 4; ++j) { ya[j] = ya_n[j]; yb[j] = yb_n[j]; hh[j] = hh_n[j]; }
            if (row + NGW < M) { P10_DATA(row + NGW); if (row + 2 * NGW < M) P10_SLOTS(row + 2 * NGW); }
            f32x4* hr = (f32x4*)(out + (size_t)row * DM) + lane;
            f32x4 v[4]; float s = 0.f;
#pragma unroll
            for (int j = 0; j < 4; ++j) { const u32x2 hx = hh[j]; f32x4 h = {bf16lo(hx.x), bf16hi(hx.x), bf16lo(hx.y), bf16hi(hx.y)};
                const f32x2 a01 = __builtin_amdgcn_cvt_pk_f32_fp8((int)ya[j], false), a23 = __builtin_amdgcn_cvt_pk_f32_fp8((int)ya[j], true), b01 = __builtin_amdgcn_cvt_pk_f32_fp8((int)yb[j], false), b23 = __builtin_amdgcn_cvt_pk_f32_fp8((int)yb[j], true);
                h[0] += w0 * a01[0] + w1 * b01[0]; h[1] += w0 * a01[1] + w1 * b01[1]; h[2] += w0 * a23[0] + w1 * b23[0]; h[3] += w0 * a23[1] + w1 * b23[1];
                v[j] = h; s += (h[0] * h[0] + h[1] * h[1]) + (h[2] * h[2] + h[3] * h[3]); }
            const float rinv = rsqrtf(wave_sum(s) * (1.0f / DM) + EPS);
#pragma unroll
            for (int j = 0; j < 4; ++j) __builtin_nontemporal_store(v[j] * rinv * gp[64 * j], hr + 64 * j);
        }
#undef P10_SLOTS
#undef P10_DATA
    }
    if (PROBE_LO >= 0) {
        if (PROBE_HI == 10) t_pb = __builtin_amdgcn_s_memrealtime();
        if (blockIdx.x == 0 && threadIdx.x == 0) { const unsigned long long t0 = __builtin_amdgcn_s_memrealtime(), span = 2 * (t_pb - t_pa);
            while (__builtin_amdgcn_s_memrealtime() - t0 < span) __builtin_amdgcn_s_sleep(8); }
    }
}

extern "C" void kernel_launch(void* const* d_in, const int* in_sizes, int n_in, void* d_out, int out_size, void* d_ws, size_t ws_size, hipStream_t stream) {
    static int grid = 0;
    if (grid == 0) {
        if (n_in != 22 || in_sizes[0] != M * DM || out_size != M * DM || ws_size < WS_END) { fprintf(stderr, "kernel_launch: unexpected shapes (n_in %d, in0 %d, out %d, ws %zu)\n", n_in, n_in > 0 ? in_sizes[0] : -1, out_size, ws_size); grid = -1; return; }
        int dev = 0, cus = 0, per_cu = 0;
        if (hipGetDevice(&dev) != hipSuccess || hipDeviceGetAttribute(&cus, hipDeviceAttributeMultiprocessorCount, dev) != hipSuccess) { grid = -1; return; }
        if (hipFuncSetAttribute((const void*)hymba_fwd, hipFuncAttributeMaxDynamicSharedMemorySize, LDS_BYTES) != hipSuccess) { fprintf(stderr, "kernel_launch: hipFuncSetAttribute failed\n"); grid = -1; return; }
        if (hipOccupancyMaxActiveBlocksPerMultiprocessor(&per_cu, (const void*)hymba_fwd, NWAVES * 64, LDS_BYTES) != hipSuccess || per_cu < 1) { fprintf(stderr, "kernel_launch: occupancy query reports %d\n", per_cu); }
        (void)hipGetLastError();
        grid = cus;
    }
    if (grid < 0) return;
    (void)hipMemsetAsync((char*)d_ws + WS_CTL, 0, CTL_ZERO_BYTES, stream);
    Args a{};
    const float** p = (const float**)&a;
    for (int i = 0; i < 22; ++i) p[i] = (const float*)d_in[i];
    a.out = (float*)d_out; a.ws = (unsigned char*)d_ws;
    hipLaunchKernelGGL(hymba_fwd, dim3(grid), dim3(NWAVES * 64), LDS_BYTES, stream, a);
}
```

```cpp
#include <hip/hip_runtime.h>
#include <hip/hip_bf16.h>
#include <cstdio>
#include <cstdint>

#define LAS __attribute__((address_space(3)))
#define GAS __attribute__((address_space(1)))
typedef unsigned short bf16_t;
typedef short bf16x8 __attribute__((ext_vector_type(8)));
typedef short s16x4 __attribute__((ext_vector_type(4)));
typedef float f32x4 __attribute__((ext_vector_type(4)));
typedef float f32x2 __attribute__((ext_vector_type(2)));
typedef float f32x16 __attribute__((ext_vector_type(16)));
typedef unsigned u32x4 __attribute__((ext_vector_type(4)));
typedef unsigned u32x2 __attribute__((ext_vector_type(2)));
typedef __bf16 bf16x2_t __attribute__((ext_vector_type(2)));

constexpr int BATCH = 8, SEQ = 8192, DM = 1024, M = BATCH * SEQ;
constexpr int NH = 8, HD = 64, HW = NH * HD;
constexpr int NPROJ = 3 * HW * 2;
constexpr int WIN_LD = NPROJ + NH;
constexpr int NMEM = 256, XH = 4, XD = 256, MEMROWS = BATCH * NMEM;
constexpr int NEXP = 16, DFF = 256;
constexpr float EPS = 1e-6f;
constexpr float LOG2E = 1.4426950408889634f;
constexpr float C2 = 0.125f * LOG2E;
constexpr float XSC = 0.0625f * LOG2E;
constexpr float P_SCALE = 128.0f;
constexpr float WGU_SCALE = 32.0f;
constexpr float WD_SCALE = 16.0f;
constexpr float SB_EXIT = -48.0f;

constexpr size_t MiB = 1u << 20;
constexpr size_t WS_CTL = 0, CTL_ZERO_BYTES = 128 * 1024;
constexpr size_t WS_WIN = 1 * MiB;
constexpr size_t WS_WOUT = 7 * MiB;
constexpr size_t WS_WXQ = 9 * MiB;
constexpr size_t WS_WXKV = 11 * MiB;
constexpr size_t WS_WXO = 15 * MiB;
constexpr size_t WS_WGU = 17 * MiB;
constexpr size_t WS_WD = 33 * MiB;
constexpr size_t WS_RX = 41 * MiB;
constexpr size_t WS_RMEM = WS_RX + 256 * 1024;
constexpr size_t WS_R2 = WS_RX + 512 * 1024;
constexpr size_t WS_LF = 42 * MiB;
constexpr size_t WS_C2 = 44 * MiB;
constexpr size_t WS_SSQ = 46 * MiB;
constexpr size_t WS_TOKSLOT = 50 * MiB;
constexpr size_t WS_TOKW = 51 * MiB;
constexpr size_t WS_LIST = 52 * MiB;
constexpr size_t WS_MEMB = 56 * MiB;
constexpr size_t WS_KVM = 60 * MiB;
constexpr size_t WS_GT = 68 * MiB;
constexpr size_t WS_HT = 84 * MiB;
constexpr size_t WS_KX = 100 * MiB;
constexpr size_t WS_HS = 108 * MiB;
constexpr size_t WS_XB = 128 * MiB;
constexpr size_t WS_QKV = 256 * MiB;
constexpr size_t WS_H1B = 256 * MiB, WS_U2B = 384 * MiB, WS_HID = 512 * MiB;
constexpr size_t WS_H1F8 = 384 * MiB, WS_H2F8 = 448 * MiB;
constexpr size_t WS_O = 640 * MiB;
constexpr size_t WS_Y = 704 * MiB;
constexpr size_t WS_END = 1024 * MiB;
constexpr size_t QKV_STRIDE = (size_t)M * HW;
constexpr int MAXTILES = M * 2 / 256 + NEXP;
static_assert(WS_Y + (size_t)MAXTILES * 256 * 1024 * 2 <= WS_END, "ws map");
static_assert(WS_HID + (size_t)MAXTILES * 256 * 256 * 2 <= WS_O, "ws map");
constexpr int CW_BAR = 4096;
constexpr int CW_SBQ = 20736;
constexpr int CW_KN = 20480;
constexpr int CW_CNT = 16384;

constexpr int RING_OFF = 0, RING_BYTES = 131072;
constexpr int EXTRA_OFF = 131072, EXTRA_BYTES = 16384;
constexpr int MISC_OFF = EXTRA_OFF + EXTRA_BYTES;
constexpr int LDS_BYTES = MISC_OFF + 1024;
constexpr int NWAVES = 8;
#ifndef PHASE_MASK
#define PHASE_MASK 0x7ff
#endif
#define PH(n) ((PHASE_MASK >> (n)) & 1)
#ifndef PROBE_LO
#define PROBE_LO -1
#endif
#ifndef PROBE_HI
#define PROBE_HI -1
#endif
#ifndef FOX_V2
#define FOX_V2 1
#endif
#ifndef REP_MASK
#define REP_MASK 0
#endif
#define REPS(n) (1 + ((REP_MASK >> (n)) & 1))
#ifndef REP_FOX
#define REP_FOX 1
#endif
#ifndef REP_SB
#define REP_SB 1
#endif

__device__ __forceinline__ unsigned cvt_pk_bf16(float lo, float hi) { f32x2 v = {lo, hi}; bf16x2_t b = __builtin_convertvector(v, bf16x2_t); return __builtin_bit_cast(unsigned, b); }
__device__ __forceinline__ unsigned cvt4_fp8(float a, float b, float c, float d) { int w = 0; w = __builtin_amdgcn_cvt_pk_fp8_f32(a, b, w, false); w = __builtin_amdgcn_cvt_pk_fp8_f32(c, d, w, true); return (unsigned)w; }
__device__ __forceinline__ float bf16lo(unsigned u) { return __uint_as_float(u << 16); }
__device__ __forceinline__ float bf16hi(unsigned u) { return __uint_as_float(u & 0xffff0000u); }
#define DPP_ADD(v, CTRL) v += __builtin_bit_cast(float, __builtin_amdgcn_update_dpp(0, __builtin_bit_cast(int, v), CTRL, 0xf, 0xf, true))
__device__ __forceinline__ float wave_sum(float v) {
    DPP_ADD(v, 0xB1); DPP_ADD(v, 0x4E); DPP_ADD(v, 0x141); DPP_ADD(v, 0x140);
    const int iv = __builtin_bit_cast(int, v);
    return (__builtin_bit_cast(float, __builtin_amdgcn_readlane(iv, 0)) + __builtin_bit_cast(float, __builtin_amdgcn_readlane(iv, 16))) +
           (__builtin_bit_cast(float, __builtin_amdgcn_readlane(iv, 32)) + __builtin_bit_cast(float, __builtin_amdgcn_readlane(iv, 48)));
}
#define LDS_WAIT() asm volatile("s_waitcnt lgkmcnt(0)" ::: "memory")
#define VM_WAIT() asm volatile("s_waitcnt vmcnt(0)" ::: "memory")

namespace pg8 {
constexpr int BM = 256, BK = 64, HALF = 128, HTB = HALF * BK * 2, STAGE_BYTES = 8 * HTB, NXCD = 8, WGM = 8;
__host__ __device__ __forceinline__ int lds_byte(int r, int c) { const int st = (r >> 4) * 2 + (c >> 5), rr = r & 15, cc = c & 31, ob = rr * 64 + cc * 2; return st * 1024 + (ob ^ (((ob >> 9) & 1) << 5)); }
__host__ __device__ __forceinline__ void stage_rc(int b, int& R, int& C) { const int st = b / 1024, sb = b % 1024, swz = sb ^ (((sb >> 9) & 1) << 5); R = (st >> 1) * 16 + swz / 64; C = (st & 1) * 32 + (swz % 64) / 2; }
__host__ __device__ __forceinline__ int perm32(int rho) { const int n = rho >> 4, i = rho & 15; return 8 * (i >> 2) + 4 * n + (i & 3); }

struct Unit { const char* a; const char* b; int orow, ocol, aux; const int* rows; int nvalid; int seq; };
struct Gemm { int lda, ldb, K; };

__device__ __forceinline__ bool tile_order(int i, int G, int c, int nM, int nN, int& pm, int& pn) {
    const int nwg = nM * nN; const long L = (long)i * G + c; if (L >= nwg) return false;
    int wgid = (int)L; { const int q = nwg / NXCD, r = nwg % NXCD, xcd = wgid % NXCD, off = wgid / NXCD; wgid = (xcd < r ? xcd * (q + 1) : r * (q + 1) + (xcd - r) * q) + off; }
    const int nig = WGM * nN, gid = wgid / nig, fm = gid * WGM, gsz = (nM - fm) < WGM ? (nM - fm) : WGM;
    pm = fm + ((wgid % nig) % gsz); pn = (wgid % nig) / gsz; return true;
}

typedef int v8i32 __attribute__((ext_vector_type(8)));
template <class Epi, class Sched, bool ALIGN_EPI, bool GATHER, bool FP8 = false>
__device__ __forceinline__ void gemm_phase(LAS unsigned char* lds, const Gemm g, const Sched& S, const Epi& E) {
    int tid = threadIdx.x; asm volatile("" : "+v"(tid));
    const int wid = __builtin_amdgcn_readfirstlane(tid >> 6), lane = tid & 63, wr = wid >> 2, wc = wid & 3, fr = lane & 15, fq = lane >> 4;
    constexpr int ESZ = FP8 ? 1 : 2;
    const int K = g.K, nt = K / (FP8 ? 2 * BK : BK);
    unsigned voffA[2], voffB[2]; int RA[2], CA[2];
#pragma unroll
    for (int i = 0; i < 2; ++i) { int R, C; stage_rc(tid * 16 + i * 8192, R, C); const int Rb = (R & ~31) + perm32(R & 31);
        RA[i] = R; CA[i] = C; voffA[i] = (unsigned)(R * g.lda * ESZ + C * 2); voffB[i] = (unsigned)(Rb * g.ldb * ESZ + C * 2); }
    const size_t kstep = (size_t)(BK * 2);
    const size_t hstepA = (size_t)HALF * g.lda * ESZ, hstepB = (size_t)HALF * g.ldb * ESZ;
    const unsigned ldsw = (unsigned)wid * 1024u;
    const int aoff = lds_byte(wr * 64 + fr, FP8 ? fq * 16 : fq * 8), boff = lds_byte(wc * 32 + fr, FP8 ? fq * 16 : fq * 8);
    constexpr int KOFF = FP8 ? 16 : 1024;
#define PG8_SA(b, h) (((b) * 2 + (h)) * HTB)
#define PG8_SB(b, h) ((4 + (b) * 2 + (h)) * HTB)
#define PG8_STAGE2(bufoff, gbase, v0, v1) do { \
        __builtin_amdgcn_global_load_lds((const unsigned*)((const char*)(gbase) + (v0)), (LAS unsigned*)(lds + (bufoff) + ldsw), 16, 0, 0); \
        __builtin_amdgcn_global_load_lds((const unsigned*)((const char*)(gbase) + (v1)), (LAS unsigned*)(lds + (bufoff) + ldsw + 8192), 16, 0, 0); } while (0)
#define PG8_STAGEB(bufoff, gbase) PG8_STAGE2(bufoff, gbase, voffB[0], voffB[1])
#define PG8_STAGEA(bufoff, kptr, h, NX) do { if constexpr (GATHER) { const unsigned v0_ = (NX) ? gvn[h][0] : gvc[h][0], v1_ = (NX) ? gvn[h][1] : gvc[h][1]; PG8_STAGE2(bufoff, kptr, v0_, v1_); } \
        else { PG8_STAGE2(bufoff, (kptr) + (h) * hstepA, voffA[0], voffA[1]); } } while (0)
#define PG8_LDA(dst, b, h) do { _Pragma("unroll") for (int m = 0; m < 4; ++m) _Pragma("unroll") for (int k = 0; k < 2; ++k) dst[m][k] = *(const LAS bf16x8*)(lds + PG8_SA(b, h) + aoff + m * 2048 + k * KOFF); } while (0)
#define PG8_LDB(dst, b, h) do { _Pragma("unroll") for (int n = 0; n < 2; ++n) _Pragma("unroll") for (int k = 0; k < 2; ++k) dst[n][k] = *(const LAS bf16x8*)(lds + PG8_SB(b, h) + boff + n * 2048 + k * KOFF); } while (0)
#define PG8_CAT(x) __builtin_shufflevector(__builtin_bit_cast(f32x4, (x)[0]), __builtin_bit_cast(f32x4, (x)[1]), 0, 1, 2, 3, 4, 5, 6, 7)
#define PG8_MMA(ai, bj, At, Bt) do { __builtin_amdgcn_s_setprio(1); _Pragma("unroll") for (int m = 0; m < 4; ++m) _Pragma("unroll") for (int n = 0; n < 2; ++n) { \
        if constexpr (FP8) { acc[ai][bj][m][n] = __builtin_amdgcn_mfma_scale_f32_16x16x128_f8f6f4(__builtin_bit_cast(v8i32, PG8_CAT(Bt[n])), __builtin_bit_cast(v8i32, PG8_CAT(At[m])), acc[ai][bj][m][n], 0, 0, 0, 0x7F7F7F7F, 0, 0x7F7F7F7F); } \
        else { _Pragma("unroll") for (int k = 0; k < 2; ++k) acc[ai][bj][m][n] = __builtin_amdgcn_mfma_f32_16x16x32_bf16(Bt[n][k], At[m][k], acc[ai][bj][m][n], 0, 0, 0); } } \
        _Pragma("unroll") for (int m = 0; m < 4; ++m) _Pragma("unroll") for (int n = 0; n < 2; ++n) asm volatile("" : "+v"(acc[ai][bj][m][n]));     \
        __builtin_amdgcn_s_setprio(0); } while (0)
#define PG8_WAIT_V(n) asm volatile("s_waitcnt vmcnt(" #n ")" ::: "memory")
#define PG8_WAIT_L(n) asm volatile("s_waitcnt lgkmcnt(" #n ")" ::: "memory")
#define PG8_BAR __builtin_amdgcn_s_barrier()
#define PG8_SCHED __builtin_amdgcn_sched_barrier(0)
#define PG8_GATHER_OFFS(dst, u) do { _Pragma("unroll") for (int h_ = 0; h_ < 2; ++h_) _Pragma("unroll") for (int i_ = 0; i_ < 2; ++i_) { const int r_ = h_ * HALF + RA[i_]; \
        const int idx_ = (u).rows[r_ < (u).nvalid ? r_ : 0]; dst[h_][i_] = (unsigned)(idx_ * g.lda * ESZ + CA[i_] * 2); } } while (0)
    Unit cur, nxt; int ui = 0;
    if (!S.next(0, cur)) return;
    cur.seq = 0;
    unsigned gvc[2][2] = {{0u, 0u}, {0u, 0u}}, gvn[2][2] = {{0u, 0u}, {0u, 0u}};
    if constexpr (GATHER) { PG8_GATHER_OFFS(gvc, cur); }
    f32x4 acc[2][2][4][2];
#pragma unroll
    for (int a = 0; a < 2; ++a)
#pragma unroll
        for (int b = 0; b < 2; ++b)
#pragma unroll
            for (int m = 0; m < 4; ++m)
#pragma unroll
                for (int n = 0; n < 2; ++n) acc[a][b][m][n] = (f32x4){0.f, 0.f, 0.f, 0.f};
    bf16x8 At[4][2], B0[2][2], B1[2][2];
    const char* cA = cur.a; const char* cB = cur.b;
    PG8_STAGEB(PG8_SB(0, 0), cB); PG8_STAGEB(PG8_SB(0, 1), cB + hstepB); PG8_STAGEA(PG8_SA(0, 0), cA, 0, false); PG8_STAGEA(PG8_SA(0, 1), cA, 1, false);
    if (wr == 1) PG8_BAR;
    PG8_WAIT_V(2); PG8_BAR;
    PG8_STAGEB(PG8_SB(1, 0), cB + kstep); PG8_STAGEA(PG8_SA(1, 0), cA + kstep, 0, false); PG8_STAGEB(PG8_SB(1, 1), cB + hstepB + kstep);
    PG8_WAIT_V(6); PG8_BAR;
    for (;;) {
        const bool has_next = S.next(ui + 1, nxt); nxt.seq = ui + 1;
        const char* nA = has_next ? nxt.a : cA; const char* nB = has_next ? nxt.b : cB;
        if constexpr (GATHER) { if (has_next) { PG8_GATHER_OFFS(gvn, nxt); } else { gvn[0][0] = gvc[0][0]; gvn[0][1] = gvc[0][1]; gvn[1][0] = gvc[1][0]; gvn[1][1] = gvc[1][1]; } }
#pragma unroll 1
        for (int t = 0; t < nt; t += 2) {
            const bool last = (t == nt - 2);
            const char* a1 = cA + (size_t)(t + 1) * kstep;
            const char* a2 = last ? nA : cA + (size_t)(t + 2) * kstep; const char* b2 = last ? nB : cB + (size_t)(t + 2) * kstep;
            const char* a3 = a2 + kstep; const char* b3 = b2 + kstep;
            PG8_LDB(B0, 0, 0); PG8_LDB(B1, 0, 1); PG8_SCHED; PG8_LDA(At, 0, 0); PG8_STAGEA(PG8_SA(1, 1), a1, 1, false);
            PG8_WAIT_V(8); PG8_WAIT_L(0); PG8_BAR; PG8_MMA(0, 0, At, B0); PG8_MMA(0, 1, At, B1); PG8_BAR; PG8_SCHED;
            PG8_LDA(At, 0, 1); PG8_STAGEB(PG8_SB(0, 0), b2); PG8_STAGEB(PG8_SB(0, 1), b2 + hstepB); PG8_STAGEA(PG8_SA(0, 0), a2, 0, last);
            PG8_WAIT_V(8); PG8_WAIT_L(0); PG8_BAR; PG8_MMA(1, 0, At, B0); PG8_MMA(1, 1, At, B1); PG8_BAR; PG8_SCHED;
            PG8_LDB(B0, 1, 0); PG8_LDB(B1, 1, 1); PG8_SCHED; PG8_LDA(At, 1, 0); PG8_STAGEA(PG8_SA(0, 1), a2, 1, last);
            PG8_WAIT_V(8); PG8_WAIT_L(0); PG8_BAR; PG8_MMA(0, 0, At, B0); PG8_MMA(0, 1, At, B1); PG8_BAR; PG8_SCHED;
            PG8_LDA(At, 1, 1); PG8_STAGEB(PG8_SB(1, 0), b3); PG8_STAGEB(PG8_SB(1, 1), b3 + hstepB); PG8_STAGEA(PG8_SA(1, 0), a3, 0, last);
            PG8_WAIT_V(8); PG8_WAIT_L(0); PG8_BAR; PG8_MMA(1, 0, At, B0); PG8_MMA(1, 1, At, B1); PG8_BAR; PG8_SCHED;
            if constexpr (Epi::HAS_MID) { if (t == (nt >> 1) - 2) { int fr3 = fr, fq3 = fq; asm volatile("" : "+v"(fr3), "+v"(fq3)); E.mid(acc, cur, wr, wc, fr3, fq3); } }
        }
        if constexpr (ALIGN_EPI) { if (wr == 0) PG8_BAR; }
        { int fr2 = fr, fq2 = fq; asm volatile("" : "+v"(fr2), "+v"(fq2));
          E(acc, cur, wr, wc, fr2, fq2); }
        if (!has_next) break;
#pragma unroll
        for (int a = 0; a < 2; ++a)
#pragma unroll
            for (int b = 0; b < 2; ++b)
#pragma unroll
                for (int m = 0; m < 4; ++m)
#pragma unroll
                    for (int n = 0; n < 2; ++n) acc[a][b][m][n] = (f32x4){0.f, 0.f, 0.f, 0.f};
        cur = nxt; cA = nA; cB = nB; ++ui;
        if constexpr (GATHER) { gvc[0][0] = gvn[0][0]; gvc[0][1] = gvn[0][1]; gvc[1][0] = gvn[1][0]; gvc[1][1] = gvn[1][1]; }
        if constexpr (ALIGN_EPI) { if (wr == 1) PG8_BAR; }
    }
    PG8_WAIT_V(0);
    if constexpr (!ALIGN_EPI) { if (wr == 0) PG8_BAR; }
    PG8_BAR;
#undef PG8_SA
#undef PG8_SB
#undef PG8_STAGE2
#undef PG8_STAGEA
#undef PG8_STAGEB
#undef PG8_LDA
#undef PG8_LDB
#undef PG8_MMA
#undef PG8_CAT
#undef PG8_WAIT_V
#undef PG8_WAIT_L
#undef PG8_BAR
#undef PG8_SCHED
#undef PG8_GATHER_OFFS
}

#define EPI_ROW(u, ai, m) ((u).orow + (ai) * HALF + wr * 64 + (m) * 16 + fr)
#define EPI_COL(u, bj) ((u).ocol + (bj) * HALF + wc * 32 + 8 * fq)
struct EpiBf16 {
    static constexpr bool HAS_MID = false;
    bf16_t* O; int ldc; const float* rs; size_t stride; float sc0, sc3;
    unsigned* kn;
    const LAS float* rst;
    float mul;
    bool out8;
    __device__ __forceinline__ void operator()(const f32x4 (&acc)[2][2][4][2], const Unit& u, int wr, int wc, int fr, int fq) const {
        bf16_t* base = O + (size_t)u.aux * stride;
        const float sc = ((u.aux == 0) ? sc0 : ((u.aux == 3) ? sc3 : 1.f)) * mul;
        float nmax[2] = {0.f, 0.f}; const bool dokn = kn && u.aux == 1;
#pragma unroll
        for (int ai = 0; ai < 2; ++ai)
#pragma unroll
            for (int m = 0; m < 4; ++m) { const int row = EPI_ROW(u, ai, m); const float s = (rst ? rst[u.seq * 256 + ai * HALF + wr * 64 + m * 16 + fr] : (rs ? rs[row] : 1.f)) * sc;
#pragma unroll
                for (int bj = 0; bj < 2; ++bj) { const f32x4 v0 = acc[ai][bj][m][0] * s, v1 = acc[ai][bj][m][1] * s;
                    if (out8) { u32x2 w8; w8.x = cvt4_fp8(v0[0], v0[1], v0[2], v0[3]); w8.y = cvt4_fp8(v1[0], v1[1], v1[2], v1[3]); *(u32x2*)((unsigned char*)base + (size_t)row * ldc + EPI_COL(u, bj)) = w8; }
                    else { u32x4 w; w.x = cvt_pk_bf16(v0[0], v0[1]); w.y = cvt_pk_bf16(v0[2], v0[3]); w.z = cvt_pk_bf16(v1[0], v1[1]); w.w = cvt_pk_bf16(v1[2], v1[3]);
                    *(u32x4*)(base + (size_t)row * ldc + EPI_COL(u, bj)) = w; }
                    if (dokn) { float q = (v0[0] * v0[0] + v0[1] * v0[1]) + (v0[2] * v0[2] + v0[3] * v0[3]) + (v1[0] * v1[0] + v1[1] * v1[1]) + (v1[2] * v1[2] + v1[3] * v1[3]);
                        q += __shfl_xor(q, 16); q += __shfl_xor(q, 32); nmax[bj] = fmaxf(nmax[bj], q); } } }
        if (dokn) {
#pragma unroll
            for (int bj = 0; bj < 2; ++bj) { float q = nmax[bj]; q = fmaxf(q, __shfl_xor(q, 1)); q = fmaxf(q, __shfl_xor(q, 2)); q = fmaxf(q, __shfl_xor(q, 4)); q = fmaxf(q, __shfl_xor(q, 8));
                const int head = ((u.ocol + bj * HALF) >> 6) + (wc >> 1), bt = u.orow / SEQ;
                if ((fr | fq) == 0) atomicMax(kn + ((bt * NH + head) * 2 + (wc & 1)), __float_as_uint(q)); }
        }
    }
};
struct EpiResid {
    static constexpr bool HAS_MID = false;
    const float* res; float* out; bf16_t* hb; float* ssq;
    __device__ __forceinline__ void operator()(const f32x4 (&acc)[2][2][4][2], const Unit& u, int wr, int wc, int fr, int fq) const {
#pragma unroll
        for (int ai = 0; ai < 2; ++ai)
#pragma unroll
            for (int m = 0; m < 4; ++m) { const int row = EPI_ROW(u, ai, m); float q = 0.f;
#pragma unroll
                for (int bj = 0; bj < 2; ++bj) { const size_t off = (size_t)row * DM + EPI_COL(u, bj);
                    const f32x4 r0 = *(const f32x4*)(res + off), r1 = *(const f32x4*)(res + off + 4);
                    const f32x4 v0 = acc[ai][bj][m][0] + r0, v1 = acc[ai][bj][m][1] + r1;
                    *(f32x4*)(out + off) = v0; *(f32x4*)(out + off + 4) = v1;
                    q += (v0[0] * v0[0] + v0[1] * v0[1]) + (v0[2] * v0[2] + v0[3] * v0[3]) + (v1[0] * v1[0] + v1[1] * v1[1]) + (v1[2] * v1[2] + v1[3] * v1[3]);
                    if (hb) { u32x4 w; w.x = cvt_pk_bf16(v0[0], v0[1]); w.y = cvt_pk_bf16(v0[2], v0[3]); w.z = cvt_pk_bf16(v1[0], v1[1]); w.w = cvt_pk_bf16(v1[2], v1[3]); *(u32x4*)(hb + off) = w; } }
                if (ssq) { q += __shfl_xor(q, 16); q += __shfl_xor(q, 32); if (fq == 0) ssq[(size_t)row * 16 + (u.ocol >> 8) * 4 + wc] = q; } }
    }
};
struct EpiOutProj {
    static constexpr bool HAS_MID = true;
    const bf16_t* xb; bf16_t* hb; unsigned char* h8; float* ssq; const LAS f32x2* rab;
    __device__ __forceinline__ void mid(f32x4 (&acc)[2][2][4][2], const Unit& u, int wr, int wc, int fr, int fq) const {
#pragma unroll
        for (int ai = 0; ai < 2; ++ai)
#pragma unroll
            for (int m = 0; m < 4; ++m) { const float f = rab[u.seq * 256 + ai * HALF + wr * 64 + m * 16 + fr].x;
#pragma unroll
                for (int bj = 0; bj < 2; ++bj) { acc[ai][bj][m][0] *= f; acc[ai][bj][m][1] *= f; } }
    }
    __device__ __forceinline__ void operator()(const f32x4 (&acc)[2][2][4][2], const Unit& u, int wr, int wc, int fr, int fq) const {
        u32x4 xres[2][4][2];
#pragma unroll
        for (int ai = 0; ai < 2; ++ai)
#pragma unroll
            for (int m = 0; m < 4; ++m)
#pragma unroll
                for (int bj = 0; bj < 2; ++bj) xres[ai][m][bj] = *(const u32x4*)(xb + (size_t)EPI_ROW(u, ai, m) * DM + EPI_COL(u, bj));
        asm volatile("" ::: "memory");
#pragma unroll
        for (int ai = 0; ai < 2; ++ai)
#pragma unroll
            for (int m = 0; m < 4; ++m) { const int row = EPI_ROW(u, ai, m); const float rb = rab[u.seq * 256 + ai * HALF + wr * 64 + m * 16 + fr].y; float q = 0.f;
#pragma unroll
                for (int bj = 0; bj < 2; ++bj) { const size_t off = (size_t)row * DM + EPI_COL(u, bj);
                    const u32x4 xr = xres[ai][m][bj];
                    f32x4 v0 = acc[ai][bj][m][0] * rb, v1 = acc[ai][bj][m][1] * rb;
                    v0[0] += bf16lo(xr.x); v0[1] += bf16hi(xr.x); v0[2] += bf16lo(xr.y); v0[3] += bf16hi(xr.y); v1[0] += bf16lo(xr.z); v1[1] += bf16hi(xr.z); v1[2] += bf16lo(xr.w); v1[3] += bf16hi(xr.w);
                    q += (v0[0] * v0[0] + v0[1] * v0[1]) + (v0[2] * v0[2] + v0[3] * v0[3]) + (v1[0] * v1[0] + v1[1] * v1[1]) + (v1[2] * v1[2] + v1[3] * v1[3]);
                    u32x4 w; w.x = cvt_pk_bf16(v0[0], v0[1]); w.y = cvt_pk_bf16(v0[2], v0[3]); w.z = cvt_pk_bf16(v1[0], v1[1]); w.w = cvt_pk_bf16(v1[2], v1[3]); *(u32x4*)(hb + off) = w;
                    { u32x2 w8; w8.x = cvt4_fp8(v0[0], v0[1], v0[2], v0[3]); w8.y = cvt4_fp8(v1[0], v1[1], v1[2], v1[3]); *(u32x2*)(h8 + off) = w8; } }
                q += __shfl_xor(q, 16); q += __shfl_xor(q, 32); if (fq == 0) ssq[(size_t)row * 16 + (u.ocol >> 8) * 4 + wc] = q; }
    }
};
struct EpiResidBf16 {
    static constexpr bool HAS_MID = false;
    bf16_t* hb; unsigned char* h8; float mul;
    __device__ __forceinline__ void operator()(const f32x4 (&acc)[2][2][4][2], const Unit& u, int wr, int wc, int fr, int fq) const {
#pragma unroll
        for (int ai = 0; ai < 2; ++ai) {
        u32x4 xres[4][2];
#pragma unroll
            for (int m = 0; m < 4; ++m)
#pragma unroll
                for (int bj = 0; bj < 2; ++bj) xres[m][bj] = *(const u32x4*)(hb + (size_t)EPI_ROW(u, ai, m) * DM + EPI_COL(u, bj));
        asm volatile("" ::: "memory");
#pragma unroll
            for (int m = 0; m < 4; ++m) { const int row = EPI_ROW(u, ai, m);
#pragma unroll
                for (int bj = 0; bj < 2; ++bj) { const size_t off = (size_t)row * DM + EPI_COL(u, bj);
                    const u32x4 xr = xres[m][bj];
                    f32x4 v0 = acc[ai][bj][m][0] * mul, v1 = acc[ai][bj][m][1] * mul;
                    v0[0] += bf16lo(xr.x); v0[1] += bf16hi(xr.x); v0[2] += bf16lo(xr.y); v0[3] += bf16hi(xr.y); v1[0] += bf16lo(xr.z); v1[1] += bf16hi(xr.z); v1[2] += bf16lo(xr.w); v1[3] += bf16hi(xr.w);
                    u32x4 w; w.x = cvt_pk_bf16(v0[0], v0[1]); w.y = cvt_pk_bf16(v0[2], v0[3]); w.z = cvt_pk_bf16(v1[0], v1[1]); w.w = cvt_pk_bf16(v1[2], v1[3]); *(u32x4*)(hb + off) = w;
                    if (h8) { u32x2 w8; w8.x = cvt4_fp8(v0[0], v0[1], v0[2], v0[3]); w8.y = cvt4_fp8(v1[0], v1[1], v1[2], v1[3]); *(u32x2*)(h8 + off) = w8; } } }
        asm volatile("" ::: "memory"); }
    }
};
struct EpiSoftmax {
    static constexpr bool HAS_MID = false;
    bf16_t* P; const LAS float* r1t; LAS float* red;
    __device__ __forceinline__ void operator()(f32x4 (&acc)[2][2][4][2], const Unit& u, int wr, int wc, int fr, int fq) const {
#pragma unroll
        for (int ai = 0; ai < 2; ++ai)
#pragma unroll
            for (int m = 0; m < 4; ++m) { const float r1 = r1t[u.seq * 256 + ai * HALF + wr * 64 + m * 16 + fr]; float a = -3.0e38f;
#pragma unroll
                for (int bj = 0; bj < 2; ++bj)
#pragma unroll
                    for (int n = 0; n < 2; ++n) { f32x4 v = acc[ai][bj][m][n] * r1; acc[ai][bj][m][n] = v; a = fmaxf(a, fmaxf(fmaxf(v[0], v[1]), fmaxf(v[2], v[3]))); }
                a = fmaxf(a, __shfl_xor(a, 16)); a = fmaxf(a, __shfl_xor(a, 32));
                if (fq == 0) red[(ai * HALF + wr * 64 + m * 16 + fr) * 4 + wc] = a; asm volatile("" ::: "memory"); }
        LDS_WAIT(); __builtin_amdgcn_s_barrier(); asm volatile("" ::: "memory");
#pragma unroll
        for (int ai = 0; ai < 2; ++ai)
#pragma unroll
            for (int m = 0; m < 4; ++m) { const int rl = ai * HALF + wr * 64 + m * 16 + fr; const f32x4 mm = *(const LAS f32x4*)(red + rl * 4);
                const float a = fmaxf(fmaxf(mm[0], mm[1]), fmaxf(mm[2], mm[3])); float s = 0.f;
#pragma unroll
                for (int bj = 0; bj < 2; ++bj)
#pragma unroll
                    for (int n = 0; n < 2; ++n) { f32x4 v = acc[ai][bj][m][n];
                        v[0] = __builtin_amdgcn_exp2f(v[0] - a); v[1] = __builtin_amdgcn_exp2f(v[1] - a); v[2] = __builtin_amdgcn_exp2f(v[2] - a); v[3] = __builtin_amdgcn_exp2f(v[3] - a);
                        acc[ai][bj][m][n] = v; s += (v[0] + v[1]) + (v[2] + v[3]); }
                s += __shfl_xor(s, 16); s += __shfl_xor(s, 32);
                if (fq == 0) red[1024 + rl * 4 + wc] = s; }
        LDS_WAIT(); __builtin_amdgcn_s_barrier(); asm volatile("" ::: "memory");
#pragma unroll
        for (int ai = 0; ai < 2; ++ai)
#pragma unroll
            for (int m = 0; m < 4; ++m) { const int rl = ai * HALF + wr * 64 + m * 16 + fr; const int row = u.orow + rl; const f32x4 ss = *(const LAS f32x4*)(red + 1024 + rl * 4);
                const float inv = P_SCALE / ((ss[0] + ss[1]) + (ss[2] + ss[3]));
#pragma unroll
                for (int bj = 0; bj < 2; ++bj) { const f32x4 v0 = acc[ai][bj][m][0] * inv, v1 = acc[ai][bj][m][1] * inv;
                    u32x2 w8; w8.x = cvt4_fp8(v0[0], v0[1], v0[2], v0[3]); w8.y = cvt4_fp8(v1[0], v1[1], v1[2], v1[3]);
                    *(u32x2*)((unsigned char*)P + (size_t)row * DM + EPI_COL(u, bj)) = w8; } }
    }
};
struct EpiSwiglu {
    static constexpr bool HAS_MID = false;
    bf16_t* Hd; const float* r2s; const int* listbase;
    __device__ __forceinline__ void operator()(const f32x4 (&acc)[2][2][4][2], const Unit& u, int wr, int wc, int fr, int fq) const {
#pragma unroll
        for (int ai = 0; ai < 2; ++ai)
#pragma unroll
            for (int m = 0; m < 4; ++m) { const int rl = ai * HALF + wr * 64 + m * 16 + fr, row = u.orow + rl; const float rs = r2s[(u.rows - listbase) + (rl < u.nvalid ? rl : 0)] * (1.0f / WGU_SCALE); float h[8];
#pragma unroll
                for (int n = 0; n < 2; ++n)
#pragma unroll
                    for (int e = 0; e < 4; ++e) { const float gt = acc[ai][0][m][n][e] * rs, up = acc[ai][1][m][n][e] * rs;
                        h[n * 4 + e] = gt * __builtin_amdgcn_rcpf(1.0f + __builtin_amdgcn_exp2f(-gt * LOG2E)) * up; }
                u32x2 w; w.x = cvt4_fp8(h[0], h[1], h[2], h[3]); w.y = cvt4_fp8(h[4], h[5], h[6], h[7]);
                *(u32x2*)((unsigned char*)Hd + (size_t)row * DFF + u.ocol + wc * 32 + 8 * fq) = w; }
    }
};
}

namespace att {
constexpr int QB = 256, KVBLK = 64, PITCH = HW, OPITCH = DM;
constexpr int SLOTB = 8192, LDS_K = 0, LDS_V = 2 * SLOTB, LDS_WS = 4 * SLOTB, LDS_OST = LDS_WS + NWAVES * 256, LDS_FLAG = LDS_OST + NWAVES * 4096, LDS_END = LDS_FLAG + 64;
static_assert(LDS_END <= RING_BYTES, "attention LDS");
__device__ __forceinline__ int crow(int r, int hi) { return (r & 3) + 8 * (r >> 2) + 4 * hi; }
__device__ __forceinline__ void glds16(const void* gsrc, unsigned lds_dst) { unsigned keep;
    asm volatile("s_mov_b32 %0, m0\n\ts_mov_b32 m0, %2\n\ts_nop 0\n\tglobal_load_lds_dwordx4 %1, off\n\ts_mov_b32 m0, %0" : "=&s"(keep) : "v"(gsrc), "s"(lds_dst) : "memory"); }
__device__ __forceinline__ void glds16s(const void* sbase, unsigned voff, unsigned lds_dst) { unsigned keep;
    asm volatile("s_mov_b32 %0, m0\n\ts_mov_b32 m0, %3\n\ts_nop 0\n\tglobal_load_lds_dwordx4 %1, %2\n\ts_mov_b32 m0, %0" : "=&s"(keep) : "v"(voff), "s"(sbase), "s"(lds_dst) : "memory"); }
#define ATT_WAIT_BAR0() asm volatile("s_waitcnt vmcnt(0) lgkmcnt(0)\n\ts_barrier" ::: "memory")
#define MFMA32(a, b, c) __builtin_amdgcn_mfma_f32_32x32x16_bf16(a, b, c, 0, 0, 0)
__device__ __forceinline__ void store_row_ssq(u32x4 v, float* dst, int ch) {
    float q = (bf16lo(v.x) * bf16lo(v.x) + bf16hi(v.x) * bf16hi(v.x)) + (bf16lo(v.y) * bf16lo(v.y) + bf16hi(v.y) * bf16hi(v.y)) + (bf16lo(v.z) * bf16lo(v.z) + bf16hi(v.z) * bf16hi(v.z)) + (bf16lo(v.w) * bf16lo(v.w) + bf16hi(v.w) * bf16hi(v.w));
    q += __shfl_xor(q, 1); q += __shfl_xor(q, 2); q += __shfl_xor(q, 4);
    if (ch == 0) *dst = q;
}
__device__ __forceinline__ void qkt(f32x16& p0, f32x16& p1, const LAS char* Kslot, const bf16x8* qr, const f32x16& cin, int r32, int hi) {
    const LAS char* kb = Kslot + hi * 1024 + r32 * 16;
#pragma unroll
    for (int d0 = 0; d0 < 4; ++d0) {
        const bf16x8 b0 = *(const LAS bf16x8*)(kb + d0 * 2048);
        const bf16x8 b1 = *(const LAS bf16x8*)(kb + d0 * 2048 + 512);
        if (d0 == 0) { p0 = MFMA32(b0, qr[0], cin); p1 = MFMA32(b1, qr[0], cin); }
        else { p0 = MFMA32(b0, qr[d0], p0); p1 = MFMA32(b1, qr[d0], p1); } }
}
__device__ __forceinline__ void pv(f32x16* o, int vb, bf16x8 pa0, bf16x8 pa1, bf16x8 pa2, bf16x8 pa3) {
#pragma unroll
    for (int d0 = 0; d0 < 2; ++d0) { s16x4 lo[4], hi[4];
#pragma unroll
        for (int ks = 0; ks < 4; ++ks) {
            asm volatile("ds_read_b64_tr_b16 %0,%1 offset:%c2" : "=&v"(lo[ks]) : "v"(vb), "i"(d0 * 4096 + ks * 1024) : "memory");
            asm volatile("ds_read_b64_tr_b16 %0,%1 offset:%c2" : "=&v"(hi[ks]) : "v"(vb), "i"(d0 * 4096 + ks * 1024 + 512) : "memory"); }
        asm volatile("s_waitcnt lgkmcnt(0)" ::: "memory"); __builtin_amdgcn_sched_barrier(0);
#define PK(k) (bf16x8){lo[k][0], lo[k][1], lo[k][2], lo[k][3], hi[k][0], hi[k][1], hi[k][2], hi[k][3]}
        o[d0] = MFMA32(pa0, PK(0), o[d0]); o[d0] = MFMA32(pa1, PK(1), o[d0]); o[d0] = MFMA32(pa2, PK(2), o[d0]); o[d0] = MFMA32(pa3, PK(3), o[d0]);
#undef PK
    }
}
__device__ __forceinline__ float swap_lo(float x) { auto rr = __builtin_amdgcn_permlane32_swap(__float_as_uint(x), __float_as_uint(x), false, false); return __uint_as_float(rr[0]); }
__device__ __forceinline__ float swap_hi(float x) { auto rr = __builtin_amdgcn_permlane32_swap(__float_as_uint(x), __float_as_uint(x), false, false); return __uint_as_float(rr[1]); }

template <int MODE> __device__ __forceinline__ void attn_unit(int b, int h, int qb, const bf16_t* Q, const bf16_t* K, const bf16_t* V, bf16_t* O, float* hs, const float* cb, LAS char* shm) {
    int tid = threadIdx.x; asm volatile("" : "+v"(tid)); const int lane = tid & 63, r32 = lane & 31, hi = lane >> 5; const int wid = __builtin_amdgcn_readfirstlane(tid >> 6);
    const long rowbase = (long)b * SEQ; const int q0 = qb * QB;
    const bf16_t* Qw = Q + (rowbase + q0 + wid * 32) * PITCH + h * HD;
    const bf16_t* Kh = K + rowbase * PITCH + h * HD; const bf16_t* Vh = V + rowbase * PITCH + h * HD;
    const unsigned lds0 = (unsigned)(uintptr_t)shm;
    LAS float* wsf = (LAS float*)(shm + LDS_WS) + wid * 64;
    LAS unsigned* flags = (LAS unsigned*)(shm + LDS_FLAG);
    const bf16_t* ksrc = Kh + (long)lane * PITCH + wid * 8;
    const bf16_t* vsrc = Vh + (long)(16 * (wid & 3) + (lane >> 2)) * PITCH + (wid >> 2) * 32 + (lane & 3) * 8;
    const unsigned kdst = lds0 + LDS_K + wid * 1024, vdst = lds0 + LDS_V + wid * 1024;
#define DMA_KV(t, slot) do { glds16(ksrc + (long)(t) * KVBLK * PITCH, (unsigned)__builtin_amdgcn_readfirstlane(kdst + (slot))); glds16(vsrc + (long)(t) * KVBLK * PITCH, (unsigned)__builtin_amdgcn_readfirstlane(vdst + (slot))); } while (0)
    const int vb0 = (int)(lds0 + LDS_V) + ((lane >> 4) & 1) * 32 + (lane & 3) * 8 + (4 * hi + ((lane & 15) >> 2)) * 64;
    const int NT = (q0 + QB) / KVBLK;
    DMA_KV(NT - 1, 0);
    bf16x8 qr[4];
#pragma unroll
    for (int d0 = 0; d0 < 4; ++d0) qr[d0] = *(const bf16x8*)(Qw + (long)r32 * PITCH + d0 * 16 + hi * 8);
    f32x16 o[2]; o[0] = f32x16{}; o[1] = f32x16{};
    const int qrel = wid * 32 + r32;
    float m_run = -1.0e30f, l_run = 0.f, R = 0.f, ct = 0.f;
    if (MODE == 0) ct = cb[q0 + qrel];
    bf16x8 TD0, TD1, TONE;
#pragma unroll
    for (int j = 0; j < 8; ++j) { const int kvl = 8 * (j >> 2) + 4 * hi + (j & 3); TD0[j] = (kvl >= r32) ? (short)0x3F80 : (short)0; TD1[j] = (16 + kvl >= r32) ? (short)0x3F80 : (short)0; TONE[j] = (short)0x3F80; }
    f32x16 zero16 = f32x16{};
    for (int i = 0; i < NT; ++i) {
        const int t = NT - 1 - i, slot = (i & 1) * SLOTB;
        ATT_WAIT_BAR0();
        if (MODE == 1 && i > 0) {
            const LAS unsigned* fl = flags + ((i - 1) & 1) * 8; unsigned all = 1u;
#pragma unroll
            for (int w = 0; w < 8; ++w) all &= fl[w];
            if (__builtin_amdgcn_readfirstlane(all)) break;
        }
        if (t > 0) DMA_KV(t - 1, slot ^ SLOTB);
        const int jb = t - (NT - 4);
        const bool active = !(jb >= 0 && 2 * jb > wid);
        bool wave_done = false;
        if (MODE == 1) wave_done = __all(R < SB_EXIT);
        if (active && !(MODE == 1 && wave_done)) {
            f32x16 p0, p1;
            qkt(p0, p1, shm + LDS_K + slot, qr, zero16, r32, hi);
            if (MODE == 0) {
                const float* cbt = cb + t * KVBLK + 4 * hi;
#pragma unroll
                for (int g = 0; g < 4; ++g) { const f32x4 c0 = *(const f32x4*)(cbt + 8 * g), c1 = *(const f32x4*)(cbt + 32 + 8 * g);
#pragma unroll
                    for (int e = 0; e < 4; ++e) { p0[4 * g + e] += ct - c0[e]; p1[4 * g + e] += ct - c1[e]; } }
                if (jb >= 0) {
#pragma unroll
                    for (int r = 0; r < 16; ++r) { const int kv = 64 * jb + crow(r, hi); if (kv > qrel) p0[r] = -1.0e30f; if (kv + 32 > qrel) p1[r] = -1.0e30f; } }
                float a = fmaxf(p0[0], p1[0]);
#pragma unroll
                for (int r = 1; r < 16; ++r) a = fmaxf(a, fmaxf(p0[r], p1[r]));
                a = fmaxf(swap_lo(a), swap_hi(a));
                const float m_new = fmaxf(m_run, a), alpha = __builtin_amdgcn_exp2f(m_run - m_new); m_run = m_new;
                float s = 0.f;
#pragma unroll
                for (int r = 0; r < 16; ++r) { p0[r] = __builtin_amdgcn_exp2f(p0[r] - m_new); p1[r] = __builtin_amdgcn_exp2f(p1[r] - m_new); s += p0[r] + p1[r]; }
                l_run = l_run * alpha + s;
                if (hi == 0) wsf[r32] = alpha;
                LDS_WAIT();
#pragma unroll
                for (int r = 0; r < 16; ++r) { const float f = wsf[crow(r, hi)]; o[0][r] *= f; o[1][r] *= f; }
                LDS_WAIT();
            } else {
                if (jb >= 0) {
#pragma unroll
                    for (int r = 0; r < 16; ++r) { const int kv = 64 * jb + crow(r, hi); if (kv >= qrel) p0[r] = -1.0e30f; if (kv + 32 >= qrel) p1[r] = -1.0e30f; } }
                f32x16 l0, l1;
#pragma unroll
                for (int r = 0; r < 16; ++r) {
                    l0[r] = -(fmaxf(p0[r], 0.f) + __builtin_amdgcn_logf(1.0f + __builtin_amdgcn_exp2f(-fabsf(p0[r]))));
                    l1[r] = -(fmaxf(p1[r], 0.f) + __builtin_amdgcn_logf(1.0f + __builtin_amdgcn_exp2f(-fabsf(p1[r])))); }
                u32x4 lw0 = {cvt_pk_bf16(l0[0], l0[1]), cvt_pk_bf16(l0[2], l0[3]), cvt_pk_bf16(l0[4], l0[5]), cvt_pk_bf16(l0[6], l0[7])};
                u32x4 lw1 = {cvt_pk_bf16(l0[8], l0[9]), cvt_pk_bf16(l0[10], l0[11]), cvt_pk_bf16(l0[12], l0[13]), cvt_pk_bf16(l0[14], l0[15])};
                u32x4 lw2 = {cvt_pk_bf16(l1[0], l1[1]), cvt_pk_bf16(l1[2], l1[3]), cvt_pk_bf16(l1[4], l1[5]), cvt_pk_bf16(l1[6], l1[7])};
                u32x4 lw3 = {cvt_pk_bf16(l1[8], l1[9]), cvt_pk_bf16(l1[10], l1[11]), cvt_pk_bf16(l1[12], l1[13]), cvt_pk_bf16(l1[14], l1[15])};
                f32x16 rt;
#pragma unroll
                for (int r = 0; r < 16; ++r) rt[r] = R;
                f32x16 t0 = MFMA32(TD0, __builtin_bit_cast(bf16x8, lw0), rt); t0 = MFMA32(TD1, __builtin_bit_cast(bf16x8, lw1), t0);
                t0 = MFMA32(TONE, __builtin_bit_cast(bf16x8, lw2), t0); t0 = MFMA32(TONE, __builtin_bit_cast(bf16x8, lw3), t0);
                f32x16 t1 = MFMA32(TD0, __builtin_bit_cast(bf16x8, lw2), rt); t1 = MFMA32(TD1, __builtin_bit_cast(bf16x8, lw3), t1);
#pragma unroll
                for (int r = 0; r < 16; ++r) { p0[r] = __builtin_amdgcn_exp2f(p0[r] + t0[r]); p1[r] = __builtin_amdgcn_exp2f(p1[r] + t1[r]); }
                R = swap_lo(t0[0]);
            }
            u32x4 pw0 = {cvt_pk_bf16(p0[0], p0[1]), cvt_pk_bf16(p0[2], p0[3]), cvt_pk_bf16(p0[4], p0[5]), cvt_pk_bf16(p0[6], p0[7])};
            u32x4 pw1 = {cvt_pk_bf16(p0[8], p0[9]), cvt_pk_bf16(p0[10], p0[11]), cvt_pk_bf16(p0[12], p0[13]), cvt_pk_bf16(p0[14], p0[15])};
            u32x4 pw2 = {cvt_pk_bf16(p1[0], p1[1]), cvt_pk_bf16(p1[2], p1[3]), cvt_pk_bf16(p1[4], p1[5]), cvt_pk_bf16(p1[6], p1[7])};
            u32x4 pw3 = {cvt_pk_bf16(p1[8], p1[9]), cvt_pk_bf16(p1[10], p1[11]), cvt_pk_bf16(p1[12], p1[13]), cvt_pk_bf16(p1[14], p1[15])};
            pv(o, vb0 + slot, __builtin_bit_cast(bf16x8, pw0), __builtin_bit_cast(bf16x8, pw1), __builtin_bit_cast(bf16x8, pw2), __builtin_bit_cast(bf16x8, pw3));
        }
        if (MODE == 1) { const bool dn = __all(R < SB_EXIT); if (lane == 0) flags[(i & 1) * 8 + wid] = dn ? 1u : 0u; }
    }
    float linv = 1.f;
    if (MODE == 0) { const float lt = swap_lo(l_run) + swap_hi(l_run); linv = 1.0f / lt; }
    if (hi == 0) wsf[32 + r32] = linv;
    LDS_WAIT();
    bf16_t* Ow = O + (rowbase + q0 + wid * 32) * OPITCH + h * HD;
    { LAS bf16_t* stg = (LAS bf16_t*)(shm + LDS_OST) + wid * 2048;
#pragma unroll
      for (int r = 0; r < 16; ++r) { const int orow = crow(r, hi); const float f = wsf[32 + orow];
#pragma unroll
        for (int d0 = 0; d0 < 2; ++d0) { const unsigned pk = cvt_pk_bf16(o[d0][r] * f, 0.f); stg[orow * 64 + d0 * 32 + r32] = (bf16_t)(pk & 0xffffu); } }
      LDS_WAIT();
#pragma unroll
      for (int i = 0; i < 4; ++i) { const int row = i * 8 + (lane >> 3), ch = lane & 7; const u32x4 v = *(const LAS u32x4*)(stg + row * 64 + ch * 8); *(u32x4*)(Ow + (long)row * OPITCH + ch * 8) = v;
        store_row_ssq(v, hs + (rowbase + q0 + wid * 32 + row) * 16, ch); } }
    asm volatile("s_waitcnt vmcnt(0) lgkmcnt(0)\n\ts_barrier" ::: "memory");
#undef DMA_KV
}
}


namespace fox {
constexpr int QB = 256, KVBLK = 64, PITCH = HW, OPITCH = DM;
constexpr int NSLOT = 3, SLOTB = 9216;
constexpr int LDS_K = 0, LDS_V = NSLOT * SLOTB, LDS_WS = 2 * NSLOT * SLOTB, LDS_OST = LDS_WS + NWAVES * 256, LDS_CL = LDS_OST + NWAVES * 4096, LDS_VOTE = LDS_CL + 512, LDS_END = LDS_VOTE + 32;
static_assert(LDS_END <= RING_BYTES, "fox LDS");
constexpr float WIN_T = 48.0f;
constexpr float FLOOR = -256.0f;
using att::crow; using att::glds16; using att::glds16s;
typedef __attribute__((address_space(3))) const char* lds_cptr;
typedef short v4i16_t __attribute__((ext_vector_type(4)));
#define SBAR() __builtin_amdgcn_sched_barrier(0)
#define WAIT_BAR(N) asm volatile("s_waitcnt vmcnt(" #N ") lgkmcnt(0)\n\ts_barrier" ::: "memory")
__device__ __forceinline__ s16x4 vtr(lds_cptr p) { return __builtin_bit_cast(s16x4, __builtin_amdgcn_ds_read_tr16_b64_v4i16((__attribute__((address_space(3))) v4i16_t*)p)); }
__device__ __forceinline__ void kload2(bf16x8* kf, lds_cptr kp, int j) { kf[2 * j] = *(const LAS bf16x8*)(kp + j * 2048); kf[2 * j + 1] = *(const LAS bf16x8*)(kp + j * 2048 + 512); }
__device__ __forceinline__ void cmask(f32x16& p0, f32x16& p1, int jb, int qrel, int hi) {
    const float NEG = -INFINITY; const int kb = 64 * jb + 4 * hi;
#pragma unroll
    for (int r = 0; r < 16; ++r) { const int kv = kb + (r & 3) + 8 * (r >> 2); if (kv > qrel) p0[r] = NEG; if (kv + 32 > qrel) p1[r] = NEG; }
}
__device__ __forceinline__ void split3(float x, unsigned& hm, unsigned& lo) {
    const unsigned h = cvt_pk_bf16(x, 0.f) & 0xffffu; const float r1 = x - __uint_as_float(h << 16);
    const unsigned m = cvt_pk_bf16(r1, 0.f) & 0xffffu; const float r2 = r1 - __uint_as_float(m << 16);
    hm = h | (m << 16); lo = cvt_pk_bf16(r2, 0.f) & 0xffffu;
}
__device__ __forceinline__ bf16x8 qx_build(float a, int hi) {
    unsigned hm, lo; split3(a, hm, lo);
    u32x4 w; w.x = hm; w.y = lo | 0x3F800000u; w.z = 0x3F803F80u; w.w = 0u;
    if (hi) { w.x = 0u; w.y = 0u; w.z = 0u; }
    return __builtin_bit_cast(bf16x8, w);
}

template <int THRL> __device__ __forceinline__ void fox_unit(int bh, int qb, const bf16_t* Q, const bf16_t* K, const bf16_t* V, bf16_t* O, float* hs, const float* cb, const bf16_t* KXh, float kmax, LAS char* shm) {
    int tid = threadIdx.x; asm volatile("" : "+v"(tid)); const int lane = tid & 63, r32 = lane & 31, hi = lane >> 5; const int wid = __builtin_amdgcn_readfirstlane(tid >> 6);
    const int b = bh >> 3, h = bh & 7; const long rowbase = (long)b * SEQ; const int q0 = qb * QB;
    const bf16_t* Qw = Q + (rowbase + q0 + wid * 32) * PITCH + h * HD;
    const bf16_t* Kh = K + rowbase * PITCH + h * HD; const bf16_t* Vh = V + rowbase * PITCH + h * HD;
    const unsigned lds0 = (unsigned)(uintptr_t)shm;
    LAS float* wsf = (LAS float*)(shm + LDS_WS) + wid * 64;
    const int NT = (q0 + QB) / KVBLK;
    int NTe = NT;
    LAS float* clt = (LAS float*)(shm + LDS_CL); LAS unsigned* votes = (LAS unsigned*)(shm + LDS_VOTE);
    const float clv = (tid < NT) ? cb[64 * tid + 63] : 0.f;
    const unsigned koff = (unsigned)(lane * PITCH + wid * 8) * 2u, voff = (unsigned)((16 * (wid & 3) + (lane >> 2)) * PITCH + (wid >> 2) * 32 + (lane & 3) * 8) * 2u, xoff = (unsigned)lane * 16u;
    const unsigned kdst = lds0 + LDS_K + wid * 1024, vdst = lds0 + LDS_V + wid * 1024, xdst = lds0 + LDS_K + 8192;
    const bool xl = (lane >> 3) == wid;
#define DMA_K(p, slot) do { glds16s(Kh + (long)(NT - 1 - (p)) * KVBLK * PITCH, koff, (unsigned)__builtin_amdgcn_readfirstlane(kdst + (slot))); \
        if (xl) glds16s(KXh + (long)(NT - 1 - (p)) * KVBLK * 8, xoff, (unsigned)__builtin_amdgcn_readfirstlane(xdst + (slot))); } while (0)
#define DMA_V(p, slot) glds16s(Vh + (long)(NT - 1 - (p)) * KVBLK * PITCH, voff, (unsigned)__builtin_amdgcn_readfirstlane(vdst + (slot)))
    bf16x8 kf[10];
    const lds_cptr shm3 = (lds_cptr)shm; const lds_cptr kp0 = shm3 + LDS_K + hi * 1024 + r32 * 16; const lds_cptr kx0 = shm3 + LDS_K + 8192 + r32 * 16;
    const lds_cptr vp0 = shm3 + LDS_V + ((lane >> 4) & 1) * 32 + (lane & 3) * 8 + (4 * hi + ((lane & 15) >> 2)) * 64;
    DMA_K(0, 0); DMA_V(0, 0); DMA_K(1, SLOTB);
    bf16x8 qr[4];
#pragma unroll
    for (int d0 = 0; d0 < 4; ++d0) qr[d0] = *(const bf16x8*)(Qw + (long)r32 * PITCH + d0 * 16 + hi * 8);
    const int qrel = wid * 32 + r32;
    const float ct = cb[q0 + qrel];
    float mhat = 0.f, l_reg = 0.f; f32x16 o[2]; o[0] = f32x16{}; o[1] = f32x16{};
    bf16x8 qx = qx_build(ct, hi);
    const f32x16 z16 = f32x16{};
#define CMASK(P0, P1, p) do { const int jb_ = 3 - (p); if (jb_ >= 0) cmask(P0, P1, jb_, qrel, hi); } while (0)
    bool resc = false;
#define RESC() do { if (resc) { asm volatile("s_waitcnt lgkmcnt(0)" ::: "memory"); \
      _Pragma("unroll") for (int d_ = 0; d_ < 2; ++d_) _Pragma("unroll") for (int r = 0; r < 16; ++r) o[d_][r] *= wsf[crow(r, hi)]; } } while (0)
    f32x16 pA0, pA1, pB0, pB1;
    int sl_prev = 0, sl_cur = 0, sl_next = SLOTB;
#define ROT() do { sl_prev = sl_cur; sl_cur = sl_next; sl_next = (sl_next == (NSLOT - 1) * SLOTB) ? 0 : sl_next + SLOTB; } while (0)
    DMA_K(2, 2 * SLOTB);
    WAIT_BAR(5);
    if (tid < NT) clt[tid] = clv;
    float qkb;
    { float q2 = 0.f;
#pragma unroll
      for (int d0 = 0; d0 < 4; ++d0)
#pragma unroll
          for (int j = 0; j < 8; ++j) { const float e = __uint_as_float(((unsigned)(unsigned short)qr[d0][j]) << 16); q2 += e * e; }
      q2 = att::swap_lo(q2) + att::swap_hi(q2); qkb = sqrtf(q2) * kmax + ct + WIN_T; }
    { const LAS char* kb = (const LAS char*)shm + LDS_K + hi * 1024 + r32 * 16; const LAS char* kxb = (const LAS char*)shm + LDS_K + 8192 + r32 * 16;
      pA0 = MFMA32(*(const LAS bf16x8*)(kxb), qx, z16); pA1 = MFMA32(*(const LAS bf16x8*)(kxb + 512), qx, z16);
#pragma unroll
      for (int d0 = 0; d0 < 4; ++d0) { pA0 = MFMA32(*(const LAS bf16x8*)(kb + d0 * 2048), qr[d0], pA0); pA1 = MFMA32(*(const LAS bf16x8*)(kb + d0 * 2048 + 512), qr[d0], pA1); } }
    asm volatile("s_nop 15\n\ts_nop 7" : "+v"(pA0), "+v"(pA1)); CMASK(pA0, pA1, 0);
    { float a = fmaxf(pA0[0], pA1[0]);
#pragma unroll
      for (int r = 1; r < 16; ++r) a = fmaxf(a, fmaxf(pA0[r], pA1[r]));
      a = fmaxf(att::swap_lo(a), att::swap_hi(a));
      const float dl = fmaxf(a, FLOOR); mhat = dl;
#pragma unroll
      for (int r = 0; r < 16; ++r) { pA0[r] = __builtin_amdgcn_exp2f(pA0[r] - dl); pA1[r] = __builtin_amdgcn_exp2f(pA1[r] - dl); }
      qx = qx_build(ct - mhat, hi); asm volatile("" : "+v"(qx)); }
    WAIT_BAR(0);
    DMA_K(3, 0); DMA_V(1, SLOTB);
    ROT();
    kload2(kf, kp0 + sl_cur, 0); kload2(kf, kp0 + sl_cur, 1); kload2(kf, kp0 + sl_cur, 2); kload2(kf, kp0 + sl_cur, 3);
    kf[8] = *(const LAS bf16x8*)(kx0 + sl_cur); kf[9] = *(const LAS bf16x8*)(kx0 + sl_cur + 512);
    WAIT_BAR(3);
    s16x4 vlo[8], vhi[8]; u32x4 pw0, pw1, pw2, pw3;
#define PKW(P, B) cvt_pk_bf16(P[B], P[B + 1])
#define PAF(k) __builtin_bit_cast(bf16x8, pw##k)
#define VFR(i) (bf16x8){vlo[i][0], vlo[i][1], vlo[i][2], vlo[i][3], vhi[i][0], vhi[i][1], vhi[i][2], vhi[i][3]}
#define PIN(x) asm volatile("" : "+v"(x))
#define MX3(a, b, c) __builtin_fmaxf(__builtin_fmaxf((a), (b)), (c))
#define GAPA(MF, A0, A1, A2, A3, W0, W1, PW) do { MF; sacc += A0; sacc += A1; sacc += A2; sacc += A3; PIN(sacc); W0; W1; PIN(PW); SBAR(); } while (0)
#define EX(v) __builtin_amdgcn_exp2f(v)
#define GAPB(MF, X, B) do { MF; X[B] = EX(X[B]); X[B + 1] = EX(X[B + 1]); X[B + 2] = EX(X[B + 2]); X[B + 3] = EX(X[B + 3]); PIN(X); SBAR(); } while (0)
#define VRD(i) do { vlo[i] = vtr(vp_ + (((i) >> 2) * 4096 + ((i) & 3) * 1024)); vhi[i] = vtr(vp_ + (((i) >> 2) * 4096 + ((i) & 3) * 1024 + 512)); } while (0)
#define KRD(G, j) do { if (G) { kload2(kf, kp0 + sl_next, j); SBAR(); } } while (0)
#define KRDX(G) do { if (G) { kf[8] = *(const LAS bf16x8*)(kx0 + sl_next); kf[9] = *(const LAS bf16x8*)(kx0 + sl_next + 512); SBAR(); } } while (0)
#define STEP(C0, C1, P0, P1, t, GK, GV, GL) do { SBAR(); \
    const lds_cptr vp_ = vp0 + sl_prev; \
    C0 = MFMA32(kf[8], qx, z16); C1 = MFMA32(kf[9], qx, z16); SBAR(); \
    VRD(0); SBAR(); float sacc = (P0[0] + P0[1]); \
    GAPA(C0 = MFMA32(kf[0], qr[0], C0), P0[2], P0[3], P0[4], P0[5],     pw0[0] = PKW(P0, 0), pw0[1] = PKW(P0, 2), pw0); \
    VRD(4); SBAR(); GAPA(C1 = MFMA32(kf[1], qr[0], C1), P0[6], P0[7], P0[8], P0[9],     pw0[2] = PKW(P0, 4), pw0[3] = PKW(P0, 6), pw0); \
    VRD(1); SBAR(); GAPA(C0 = MFMA32(kf[2], qr[1], C0),   P0[10], P0[11], P0[12], P0[13], pw1[0] = PKW(P0, 8), pw1[1] = PKW(P0, 10), pw1); \
    VRD(5); SBAR(); GAPA(C1 = MFMA32(kf[3], qr[1], C1),   P0[14], P0[15], P1[0], P1[1],   pw1[2] = PKW(P0, 12), pw1[3] = PKW(P0, 14), pw1); \
    VRD(2); SBAR(); GAPA(C0 = MFMA32(kf[4], qr[2], C0),   P1[2], P1[3], P1[4], P1[5],     pw2[0] = PKW(P1, 0), pw2[1] = PKW(P1, 2), pw2); \
    VRD(6); SBAR(); GAPA(C1 = MFMA32(kf[5], qr[2], C1),   P1[6], P1[7], P1[8], P1[9],     pw2[2] = PKW(P1, 4), pw2[3] = PKW(P1, 6), pw2); \
    VRD(3); SBAR(); GAPA(C0 = MFMA32(kf[6], qr[3], C0),   P1[10], P1[11], P1[12], P1[13], pw3[0] = PKW(P1, 8), pw3[1] = PKW(P1, 10), pw3); \
    VRD(7); SBAR(); GAPA(C1 = MFMA32(kf[7], qr[3], C1),   P1[14], P1[15], 0.f, 0.f,       pw3[2] = PKW(P1, 12), pw3[3] = PKW(P1, 14), pw3); \
    l_reg += sacc; \
    if (GK) { DMA_K((t) + 3, sl_cur); } if (GV) { DMA_V((t) + 1, sl_next); } \
    CMASK(C0, C1, t); \
    { float a = MX3(C0[0], C0[1], C1[0]), b_ = MX3(C0[2], C0[3], C1[1]); a = MX3(a, C1[2], C1[3]); \
      _Pragma("unroll") for (int r = 4; r < 16; r += 4) { a = MX3(a, C0[r], C0[r + 1]); b_ = MX3(b_, C0[r + 2], C0[r + 3]); a = MX3(a, C1[r], C1[r + 1]); b_ = MX3(b_, C1[r + 2], C1[r + 3]); } \
      float rm = __builtin_fmaxf(a, b_); { auto rr = __builtin_amdgcn_permlane32_swap(__float_as_uint(rm), __float_as_uint(rm), false, false); rm = __builtin_fmaxf(__uint_as_float(rr[0]), __uint_as_float(rr[1])); } \
      resc = false; \
      if (__builtin_expect(__any(rm > (float)THRL), 0)) { const float dl = __builtin_fmaxf(rm, 0.f); mhat += dl; \
        _Pragma("unroll") for (int r = 0; r < 16; ++r) { C0[r] -= dl; C1[r] -= dl; } \
        qx = qx_build(ct - mhat, hi); asm volatile("" : "+v"(qx)); \
        const float f = __builtin_amdgcn_exp2f(-dl); l_reg *= f; if (hi == 0) wsf[r32] = f; resc = true; } } \
    SBAR(); \
    GAPB(o[0] = MFMA32(PAF(0), VFR(0), o[0]), C0, 0); \
    KRDX(GL); GAPB(o[1] = MFMA32(PAF(0), VFR(4), o[1]), C0, 4); \
    KRD(GL, 0); GAPB(o[0] = MFMA32(PAF(1), VFR(1), o[0]), C0, 8); \
    KRD(GL, 1); GAPB(o[1] = MFMA32(PAF(1), VFR(5), o[1]), C0, 12); \
    KRD(GL, 2); GAPB(o[0] = MFMA32(PAF(2), VFR(2), o[0]), C1, 0); \
    KRD(GL, 3); GAPB(o[1] = MFMA32(PAF(2), VFR(6), o[1]), C1, 4); \
    GAPB(o[0] = MFMA32(PAF(3), VFR(3), o[0]), C1, 8); \
    GAPB(o[1] = MFMA32(PAF(3), VFR(7), o[1]), C1, 12); \
    } while (0)
#define ENDW(tt) do { if ((tt) + 3 < NTe) { WAIT_BAR(3); } else if ((tt) + 2 < NTe) { WAIT_BAR(1); } else { WAIT_BAR(0); } } while (0)
#define VOTE(u) do { const int ts_ = NT - (u) - 3; bool ok_ = false; if (ts_ >= 0) { ok_ = __all((qkb - mhat) < clt[ts_]); } if (lane == 0) votes[wid] = ok_ ? 1u : 0u; } while (0)
#define TALLY(u) do { const u32x4 va_ = *(const LAS u32x4*)votes, vb_ = *(const LAS u32x4*)(votes + 4); \
        if (__builtin_amdgcn_readfirstlane((va_.x & va_.y & va_.z & va_.w & vb_.x & vb_.y & vb_.z & vb_.w) != 0u)) { if ((u) + 2 < NTe) { NTe = (u) + 2; WAIT_BAR(0); } } } while (0)
    int t = 1;
    for (; t + 1 < NTe && t < 5; t += 2) {
        STEP(pB0, pB1, pA0, pA1, t, (t + 3 < NTe), (t + 1 < NTe), (t + 1 < NTe));       ENDW(t);     RESC(); ROT();
        STEP(pA0, pA1, pB0, pB1, t + 1, (t + 4 < NTe), (t + 2 < NTe), (t + 2 < NTe));   VOTE(t + 1); ENDW(t + 1); TALLY(t + 1); RESC(); ROT();
    }
#undef CMASK
#define CMASK(P0, P1, p) do {} while (0)
    for (; t + 5 < NTe; t += 2) {
        STEP(pB0, pB1, pA0, pA1, t, true, true, true);       WAIT_BAR(3); RESC(); ROT();
        STEP(pA0, pA1, pB0, pB1, t + 1, true, true, true);   VOTE(t + 1); WAIT_BAR(3); TALLY(t + 1); RESC(); ROT();
    }
    for (; t + 1 < NTe; t += 2) {
        STEP(pB0, pB1, pA0, pA1, t, (t + 3 < NTe), (t + 1 < NTe), (t + 1 < NTe));       ENDW(t);     RESC(); ROT();
        STEP(pA0, pA1, pB0, pB1, t + 1, (t + 4 < NTe), (t + 2 < NTe), (t + 2 < NTe));   ENDW(t + 1); RESC(); ROT();
    }
#undef CMASK
#define CMASK(P0, P1, p) do { const int jb_ = 3 - (p); if (jb_ >= 0) cmask(P0, P1, jb_, qrel, hi); } while (0)
    STEP(pB0, pB1, pA0, pA1, NTe - 1, false, false, false); RESC();
    { float sacc = pB0[0] + pB0[1];
#pragma unroll
      for (int r = 2; r < 16; ++r) sacc += pB0[r];
#pragma unroll
      for (int r = 0; r < 16; ++r) sacc += pB1[r];
      l_reg += sacc;
      pw0 = (u32x4){PKW(pB0, 0), PKW(pB0, 2), PKW(pB0, 4), PKW(pB0, 6)}; pw1 = (u32x4){PKW(pB0, 8), PKW(pB0, 10), PKW(pB0, 12), PKW(pB0, 14)};
      pw2 = (u32x4){PKW(pB1, 0), PKW(pB1, 2), PKW(pB1, 4), PKW(pB1, 6)}; pw3 = (u32x4){PKW(pB1, 8), PKW(pB1, 10), PKW(pB1, 12), PKW(pB1, 14)};
      SBAR(); att::pv(o, (int)(unsigned)(uintptr_t)(vp0 + sl_cur), PAF(0), PAF(1), PAF(2), PAF(3)); }
    l_reg = att::swap_lo(l_reg) + att::swap_hi(l_reg);
    if (hi == 0) wsf[32 + r32] = l_reg; asm volatile("s_waitcnt lgkmcnt(0)" ::: "memory");
    float rli[16];
#pragma unroll
    for (int r = 0; r < 16; ++r) rli[r] = __builtin_amdgcn_rcpf(wsf[32 + crow(r, hi)]);
    bf16_t* Ow = O + (rowbase + q0 + wid * 32) * OPITCH + h * HD;
    { LAS bf16_t* stg = (LAS bf16_t*)(shm + LDS_OST) + wid * 2048;
#pragma unroll
      for (int r = 0; r < 16; ++r) { const int orow = crow(r, hi);
#pragma unroll
        for (int d0 = 0; d0 < 2; ++d0) stg[orow * 64 + d0 * 32 + r32] = (bf16_t)(cvt_pk_bf16(o[d0][r] * rli[r], 0.f) & 0xffffu); }
      asm volatile("s_waitcnt lgkmcnt(0)" ::: "memory");
#pragma unroll
      for (int i = 0; i < 4; ++i) { const int row = i * 8 + (lane >> 3), ch = lane & 7; const u32x4 v = *(const LAS u32x4*)(stg + row * 64 + ch * 8); *(u32x4*)(Ow + (long)row * OPITCH + ch * 8) = v;
        att::store_row_ssq(v, hs + (rowbase + q0 + wid * 32 + row) * 16, ch); } }
    asm volatile("s_waitcnt lgkmcnt(0)\n\ts_barrier" ::: "memory");
#undef DMA_K
#undef DMA_V
#undef CMASK
#undef RESC
#undef ROT
#undef PKW
#undef PAF
#undef VFR
#undef PIN
#undef MX3
#undef GAPA
#undef GAPB
#undef EX
#undef VRD
#undef KRD
#undef KRDX
#undef STEP
#undef ENDW
#undef VOTE
#undef TALLY
}
#undef SBAR
#undef WAIT_BAR
}


namespace sbk {
constexpr int QB = 256, KVBLK = 64, PITCH = HW, OPITCH = DM, NBURST = 6, SLOTB = 8192;
constexpr int LDS_K = 0, LDS_V = NBURST * SLOTB, LDS_FLAG = 2 * NBURST * SLOTB, LDS_END = LDS_FLAG + 128;
static_assert(LDS_END <= RING_BYTES, "sb LDS");
using att::crow; using att::glds16s; using att::qkt; using att::pv; using att::swap_lo;
__device__ __forceinline__ void sb_tile(const LAS char* Kslot, int vb, const bf16x8* qr, bf16x8 TD0, bf16x8 TD1, bf16x8 TONE, int jb, int qrel, int r32, int hi, float& R, f32x16* o) {
    f32x16 p0, p1; const f32x16 z16 = f32x16{};
    qkt(p0, p1, Kslot, qr, z16, r32, hi);
    if (jb >= 0) {
#pragma unroll
        for (int r = 0; r < 16; ++r) { const int kv = 64 * jb + crow(r, hi); if (kv >= qrel) p0[r] = -1.0e30f; if (kv + 32 >= qrel) p1[r] = -1.0e30f; } }
    f32x16 l0, l1;
#pragma unroll
    for (int r = 0; r < 16; ++r) {
        l0[r] = -(fmaxf(p0[r], 0.f) + __builtin_amdgcn_logf(1.0f + __builtin_amdgcn_exp2f(-fabsf(p0[r]))));
        l1[r] = -(fmaxf(p1[r], 0.f) + __builtin_amdgcn_logf(1.0f + __builtin_amdgcn_exp2f(-fabsf(p1[r])))); }
    u32x4 lw0 = {cvt_pk_bf16(l0[0], l0[1]), cvt_pk_bf16(l0[2], l0[3]), cvt_pk_bf16(l0[4], l0[5]), cvt_pk_bf16(l0[6], l0[7])};
    u32x4 lw1 = {cvt_pk_bf16(l0[8], l0[9]), cvt_pk_bf16(l0[10], l0[11]), cvt_pk_bf16(l0[12], l0[13]), cvt_pk_bf16(l0[14], l0[15])};
    u32x4 lw2 = {cvt_pk_bf16(l1[0], l1[1]), cvt_pk_bf16(l1[2], l1[3]), cvt_pk_bf16(l1[4], l1[5]), cvt_pk_bf16(l1[6], l1[7])};
    u32x4 lw3 = {cvt_pk_bf16(l1[8], l1[9]), cvt_pk_bf16(l1[10], l1[11]), cvt_pk_bf16(l1[12], l1[13]), cvt_pk_bf16(l1[14], l1[15])};
    f32x16 rt;
#pragma unroll
    for (int r = 0; r < 16; ++r) rt[r] = R;
    f32x16 t0 = MFMA32(TD0, __builtin_bit_cast(bf16x8, lw0), rt); t0 = MFMA32(TD1, __builtin_bit_cast(bf16x8, lw1), t0);
    t0 = MFMA32(TONE, __builtin_bit_cast(bf16x8, lw2), t0); t0 = MFMA32(TONE, __builtin_bit_cast(bf16x8, lw3), t0);
    f32x16 t1 = MFMA32(TD0, __builtin_bit_cast(bf16x8, lw2), rt); t1 = MFMA32(TD1, __builtin_bit_cast(bf16x8, lw3), t1);
#pragma unroll
    for (int r = 0; r < 16; ++r) { p0[r] = __builtin_amdgcn_exp2f(p0[r] + t0[r]); p1[r] = __builtin_amdgcn_exp2f(p1[r] + t1[r]); }
    R = swap_lo(t0[0]);
    u32x4 pw0 = {cvt_pk_bf16(p0[0], p0[1]), cvt_pk_bf16(p0[2], p0[3]), cvt_pk_bf16(p0[4], p0[5]), cvt_pk_bf16(p0[6], p0[7])};
    u32x4 pw1 = {cvt_pk_bf16(p0[8], p0[9]), cvt_pk_bf16(p0[10], p0[11]), cvt_pk_bf16(p0[12], p0[13]), cvt_pk_bf16(p0[14], p0[15])};
    u32x4 pw2 = {cvt_pk_bf16(p1[0], p1[1]), cvt_pk_bf16(p1[2], p1[3]), cvt_pk_bf16(p1[4], p1[5]), cvt_pk_bf16(p1[6], p1[7])};
    u32x4 pw3 = {cvt_pk_bf16(p1[8], p1[9]), cvt_pk_bf16(p1[10], p1[11]), cvt_pk_bf16(p1[12], p1[13]), cvt_pk_bf16(p1[14], p1[15])};
    pv(o, vb, __builtin_bit_cast(bf16x8, pw0), __builtin_bit_cast(bf16x8, pw1), __builtin_bit_cast(bf16x8, pw2), __builtin_bit_cast(bf16x8, pw3));
}
#define SB_WAITBAR(N) asm volatile("s_waitcnt vmcnt(" #N ") lgkmcnt(0)\n\ts_barrier" ::: "memory")
__device__ __forceinline__ void sb_unit(int b, int h, int qb, const bf16_t* Q, const bf16_t* K, const bf16_t* V, bf16_t* O, float* hs, LAS char* shm) {
    int tid = threadIdx.x; asm volatile("" : "+v"(tid)); const int lane = tid & 63, r32 = lane & 31, hi = lane >> 5; const int wid = __builtin_amdgcn_readfirstlane(tid >> 6);
    const long rowbase = (long)b * SEQ; const int q0 = qb * QB;
    const bf16_t* Qw = Q + (rowbase + q0 + wid * 32) * PITCH + h * HD;
    const bf16_t* Kh = K + rowbase * PITCH + h * HD; const bf16_t* Vh = V + rowbase * PITCH + h * HD;
    const unsigned lds0 = (unsigned)(uintptr_t)shm;
    LAS unsigned* flags = (LAS unsigned*)(shm + LDS_FLAG);
    const unsigned koff = (unsigned)(lane * PITCH + wid * 8) * 2u, voff = (unsigned)((16 * (wid & 3) + (lane >> 2)) * PITCH + (wid >> 2) * 32 + (lane & 3) * 8) * 2u;
    const unsigned kdst = lds0 + LDS_K + wid * 1024, vdst = lds0 + LDS_V + wid * 1024;
#define SB_DMA(p, slot) do { glds16s(Kh + (long)(NT - 1 - (p)) * KVBLK * PITCH, koff, (unsigned)__builtin_amdgcn_readfirstlane(kdst + (slot) * SLOTB)); \
        glds16s(Vh + (long)(NT - 1 - (p)) * KVBLK * PITCH, voff, (unsigned)__builtin_amdgcn_readfirstlane(vdst + (slot) * SLOTB)); } while (0)
    const int vb0 = (int)(lds0 + LDS_V) + ((lane >> 4) & 1) * 32 + (lane & 3) * 8 + (4 * hi + ((lane & 15) >> 2)) * 64;
    const int NT = (q0 + QB) / KVBLK, NB = NT < NBURST ? NT : NBURST;
    for (int p = 0; p < NB; ++p) SB_DMA(p, p);
    bf16x8 qr[4];
#pragma unroll
    for (int d0 = 0; d0 < 4; ++d0) qr[d0] = *(const bf16x8*)(Qw + (long)r32 * PITCH + d0 * 16 + hi * 8);
    f32x16 o[2]; o[0] = f32x16{}; o[1] = f32x16{};
    const int qrel = wid * 32 + r32;
    float R = 0.f;
    bf16x8 TD0, TD1, TONE;
#pragma unroll
    for (int j = 0; j < 8; ++j) { const int kvl = 8 * (j >> 2) + 4 * hi + (j & 3); TD0[j] = (kvl >= r32) ? (short)0x3F80 : (short)0; TD1[j] = (16 + kvl >= r32) ? (short)0x3F80 : (short)0; TONE[j] = (short)0x3F80; }
    if (NB > 4) { SB_WAITBAR(4); } else { SB_WAITBAR(0); }
    bool mid_done = (NB <= 4);
    int p = 3 - (wid >> 1);
    for (; p < NB; ++p) {
        if (p >= 4 && !mid_done) { SB_WAITBAR(0); mid_done = true; }
        sb_tile(shm + LDS_K + p * SLOTB, vb0 + p * SLOTB, qr, TD0, TD1, TONE, 3 - p, qrel, r32, hi, R, o);
        if (__all(R < SB_EXIT)) { ++p; break; }
    }
    if (!mid_done) { SB_WAITBAR(0); }
    { const bool dn = __all(R < SB_EXIT) || (p >= NT); if (lane == 0) flags[wid] = dn ? 1u : 0u; }
    SB_WAITBAR(0);
    bool alldone;
    { const u32x4 fa = *(const LAS u32x4*)flags, fb = *(const LAS u32x4*)(flags + 4); alldone = __builtin_amdgcn_readfirstlane((fa.x & fa.y & fa.z & fa.w & fb.x & fb.y & fb.z & fb.w) != 0u); }
    if (!alldone && NB < NT) {
        SB_DMA(NB, 0);
        for (int i = 0; NB + i < NT; ++i) {
            const int pp = NB + i, sl = i & 1;
            SB_WAITBAR(0);
            if (i > 0) { const LAS unsigned* fl = flags + 8 + ((i - 1) & 1) * 8; const u32x4 fa = *(const LAS u32x4*)fl, fb = *(const LAS u32x4*)(fl + 4);
                if (__builtin_amdgcn_readfirstlane((fa.x & fa.y & fa.z & fa.w & fb.x & fb.y & fb.z & fb.w) != 0u)) break; }
            if (pp + 1 < NT) SB_DMA(pp + 1, sl ^ 1);
            if (!__all(R < SB_EXIT)) sb_tile(shm + LDS_K + sl * SLOTB, vb0 + sl * SLOTB, qr, TD0, TD1, TONE, -1, qrel, r32, hi, R, o);
            { const bool dn = __all(R < SB_EXIT); if (lane == 0) flags[8 + (i & 1) * 8 + wid] = dn ? 1u : 0u; }
        }
        SB_WAITBAR(0);
    }
    bf16_t* Ow = O + (rowbase + q0 + wid * 32) * OPITCH + h * HD;
    { LAS bf16_t* stg = (LAS bf16_t*)(shm + LDS_K) + wid * 2048;
#pragma unroll
      for (int r = 0; r < 16; ++r) { const int orow = crow(r, hi);
#pragma unroll
        for (int d0 = 0; d0 < 2; ++d0) stg[orow * 64 + d0 * 32 + r32] = (bf16_t)(cvt_pk_bf16(o[d0][r], 0.f) & 0xffffu); }
      LDS_WAIT();
#pragma unroll
      for (int i = 0; i < 4; ++i) { const int row = i * 8 + (lane >> 3), ch = lane & 7; const u32x4 v = *(const LAS u32x4*)(stg + row * 64 + ch * 8); *(u32x4*)(Ow + (long)row * OPITCH + ch * 8) = v;
        att::store_row_ssq(v, hs + (rowbase + q0 + wid * 32 + row) * 16, ch); } }
    asm volatile("s_waitcnt vmcnt(0) lgkmcnt(0)\n\ts_barrier" ::: "memory");
#undef SB_DMA
}
#undef SB_WAITBAR
}

#define XB_TMO      128
#define XB_XCNT(j)  (256  + 64 * (j))
#define XB_XSUB(j)  (1280 + 64 * (j))
#define XB_XGEN(j)  (2304 + 64 * (j))
#define XB_TOP      3328
#define XB_TOPGEN   3392
#define XCD_BAR_WORDS 3456
#define XB_SPIN_CAP (1u << 18)
__device__ __forceinline__ unsigned xb_ld(unsigned* p)              { return __hip_atomic_load(p, __ATOMIC_RELAXED, __HIP_MEMORY_SCOPE_AGENT); }
__device__ __forceinline__ unsigned xb_add(unsigned* p, unsigned v) { return __hip_atomic_fetch_add(p, v, __ATOMIC_RELAXED, __HIP_MEMORY_SCOPE_AGENT); }
__device__ __forceinline__ unsigned xb_xcc_id() { return (unsigned)__builtin_amdgcn_s_getreg((3 << 11) | 20) & 0xFu; }
#define XB_SPIN(cond, bar) do { unsigned _sp = 0; while (cond) { __builtin_amdgcn_s_sleep(1); \
    if ((++_sp & 255u) == 0u) { if (xb_ld(&(bar)[XB_TMO])) break; if (_sp > XB_SPIN_CAP) { atomicAdd(&(bar)[XB_TMO], 1u); break; } } } } while (0)
struct XcdBarrier { unsigned* bar; unsigned x; volatile LAS unsigned* st; };
__device__ __forceinline__ XcdBarrier xcd_barrier_post(unsigned* bar, volatile LAS unsigned* st) {
    XcdBarrier b; b.bar = bar; b.x = xb_xcc_id(); b.st = st;
    if (threadIdx.x == 0) (void)xb_add(&bar[XB_XCNT(b.x)], 1u);
    return b;
}
__device__ __forceinline__ void xcd_barrier_complete(unsigned* bar, unsigned x, unsigned& nloc, unsigned& nx) {
    const unsigned G = gridDim.x * gridDim.y * gridDim.z;
    unsigned sum, cnt, mine, sp = 0u;
    for (;;) {
        sum = 0u; cnt = 0u; mine = 0u;
#pragma unroll
        for (unsigned j = 0; j < 16; ++j) { const unsigned c = xb_ld(&bar[XB_XCNT(j)]); sum += c; cnt += (c > 0u) ? 1u : 0u; mine = (j == x) ? c : mine; }
        if (sum == G) break;
        __builtin_amdgcn_s_sleep(1);
        if ((++sp & 255u) == 0u) { if (xb_ld(&bar[XB_TMO])) break; if (sp > XB_SPIN_CAP) { atomicAdd(&bar[XB_TMO], 1u); break; } }
    }
    nloc = mine > 0u ? mine : 1u; nx = cnt > 0u ? cnt : 1u;
}
__device__ __forceinline__ void xcd_barrier(const XcdBarrier& b) {
    asm volatile("s_waitcnt vmcnt(0)" ::: "memory");
    __syncthreads();
    if (threadIdx.x == 0) {
        unsigned* bar = b.bar;
        __builtin_amdgcn_s_waitcnt(0);
        unsigned nloc = b.st[0], nx = b.st[1];
        if (nloc == 0u) { xcd_barrier_complete(bar, b.x, nloc, nx); b.st[0] = nloc; b.st[1] = nx; }
        const unsigned old = xb_add(&bar[XB_XSUB(b.x)], 1u);
        const unsigned gen = old / nloc;
        if (old + 1u == (gen + 1u) * nloc) {
            __builtin_amdgcn_fence(__ATOMIC_RELEASE, "agent");
            asm volatile("s_waitcnt vmcnt(0)" ::: "memory");
            const unsigned og = xb_add(&bar[XB_TOP], 1u);
            const unsigned tg = og / nx;
            if (og + 1u == (tg + 1u) * nx) xb_add(&bar[XB_TOPGEN], 1u);
            else XB_SPIN(xb_ld(&bar[XB_TOPGEN]) == tg, bar);
            __builtin_amdgcn_fence(__ATOMIC_ACQUIRE, "agent");
            xb_add(&bar[XB_XGEN(b.x)], 1u);
            asm volatile("s_waitcnt vmcnt(0)" ::: "memory");
        } else {
            XB_SPIN(xb_ld(&bar[XB_XGEN(b.x)]) == gen, bar);
            __builtin_amdgcn_fence(__ATOMIC_ACQUIRE, "agent");
            asm volatile("s_waitcnt vmcnt(0)" ::: "memory");
        }
    }
    __syncthreads();
}

__device__ __forceinline__ const void* ldp(const volatile LAS unsigned* tab, int i) {
    const unsigned lo = __builtin_amdgcn_readfirstlane(tab[2 * i]), hi = __builtin_amdgcn_readfirstlane(tab[2 * i + 1]);
    return (const void*)(const GAS void*)(((unsigned long long)hi << 32) | lo);
}
struct Args {
    const float* x; const float* mem; const float* norm_mix; const float* w_in; const float* b_forget; const float* norm_fox; const float* norm_sb; const float* w_out;
    const float* norm_xattn; const float* norm_mem; const float* w_xq; const float* w_xkv; const float* w_xo; const float* norm_ffn;
    const float* w_rg; const float* b_rg; const float* w_re; const float* b_re; const float* w_gate; const float* w_up; const float* w_down; const float* norm_final;
    float* out; unsigned char* ws;
};

__device__ __forceinline__ void transpose_item(const float* W, int ldw, bf16_t* WT, int ldo, int k0, int n0, int dst_row0, const float* gain, LAS float* scr, int lane) {
    float tv[32], tg[32];
#pragma unroll
    for (int i = 0; i < 32; ++i) { const int kk = 2 * i + (lane >> 5); tv[i] = W[(size_t)(k0 + kk) * ldw + n0 + (lane & 31)]; tg[i] = gain ? gain[k0 + kk] : 1.f; }
#pragma unroll
    for (int i = 0; i < 32; ++i) { const int kk = 2 * i + (lane >> 5); scr[kk * 33 + (lane & 31)] = tv[i] * tg[i]; }
    LDS_WAIT(); asm volatile("" ::: "memory");
    const int c = lane & 7;
#pragma unroll
    for (int j = 0; j < 4; ++j) { const int n = (lane >> 3) + 8 * j; const LAS float* s = scr + (8 * c) * 33 + n;
        u32x4 o; o.x = cvt_pk_bf16(s[0 * 33], s[1 * 33]); o.y = cvt_pk_bf16(s[2 * 33], s[3 * 33]); o.z = cvt_pk_bf16(s[4 * 33], s[5 * 33]); o.w = cvt_pk_bf16(s[6 * 33], s[7 * 33]);
        *(u32x4*)(WT + (size_t)(dst_row0 + n) * ldo + k0 + 8 * c) = o; }
    LDS_WAIT(); asm volatile("" ::: "memory");
}

__device__ __forceinline__ void transpose_item8(const float* W, int ldw, unsigned char* WT, int ldo, int k0, int n0, int dst_row0, const float* gain, float scale, LAS float* scr, int lane) {
    float tv[32], tg[32];
#pragma unroll
    for (int i = 0; i < 32; ++i) { const int kk = 2 * i + (lane >> 5); tv[i] = W[(size_t)(k0 + kk) * ldw + n0 + (lane & 31)]; tg[i] = gain ? gain[k0 + kk] : 1.f; }
#pragma unroll
    for (int i = 0; i < 32; ++i) { const int kk = 2 * i + (lane >> 5); scr[kk * 33 + (lane & 31)] = tv[i] * tg[i] * scale; }
    LDS_WAIT(); asm volatile("" ::: "memory");
    const int c = lane & 7;
#pragma unroll
    for (int j = 0; j < 4; ++j) { const int n = (lane >> 3) + 8 * j; const LAS float* s = scr + (8 * c) * 33 + n;
        u32x2 o; o.x = cvt4_fp8(s[0 * 33], s[1 * 33], s[2 * 33], s[3 * 33]); o.y = cvt4_fp8(s[4 * 33], s[5 * 33], s[6 * 33], s[7 * 33]);
        *(u32x2*)(WT + (size_t)(dst_row0 + n) * ldo + k0 + 8 * c) = o; }
    LDS_WAIT(); asm volatile("" ::: "memory");
}

struct SchedDense {
    const char* A; const char* Bt; int nM, nN, G, c; size_t a_tile, b_tile, b_batch; int split_tiles;
    __device__ __forceinline__ bool next(int i, pg8::Unit& u) const {
        int pm, pn; if (!pg8::tile_order(i, G, c, nM, nN, pm, pn)) return false;
        u.a = A + (size_t)pm * a_tile; u.b = Bt + (size_t)pn * b_tile + (size_t)(pm >> 5) * b_batch; u.orow = pm * 256;
        if (split_tiles) { u.aux = pn / split_tiles; u.ocol = (pn % split_tiles) * 256; } else { u.aux = 1; u.ocol = pn * 256; }
        u.rows = nullptr; u.nvalid = 256; return true;
    }
};
struct SchedGH {
    const char* KVm; const char* Wxq; const char* Wxo; int G, c;
    __device__ __forceinline__ bool next(int i, pg8::Unit& u) const {
        const int L = i * G + c; if (L >= 256) return false;
        const int kind = L >> 7, r = L & 127, bh = r >> 2, j = r & 3, b = bh >> 2, h = bh & 3;
        if (kind == 0) { u.a = KVm + ((size_t)(b * 256) * 2048 + h * 256) * 2; u.b = Wxq + ((size_t)(256 * j) * 1024 + h * 256) * 2; u.orow = b * 1024 + h * 256; u.ocol = 256 * j; u.aux = 1; }
        else { u.a = Wxo + ((size_t)(256 * j) * 1024 + h * 256) * 2; u.b = KVm + ((size_t)(b * 256) * 2048 + 1024 + h * 256) * 2; u.orow = b * 1024 + 256 * j; u.ocol = h * 256; u.aux = 2; }
        u.rows = nullptr; u.nvalid = 256; return true;
    }
};
template <int KIND> struct SchedGHk { SchedGH s; __device__ __forceinline__ bool next(int i, pg8::Unit& u) const { const int c2 = (s.G >= 256) ? s.c - 128 * KIND : s.c; if (c2 < 0) return false; const int L = i * s.G + c2; if (L >= 128) return false; SchedGH t = s; t.G = 1; t.c = 0; return t.next(128 * KIND + L, u); } };
struct EpiGH { static constexpr bool HAS_MID = false; unsigned char* GTp; unsigned char* HTp;
    __device__ __forceinline__ void operator()(const f32x4 (&acc)[2][2][4][2], const pg8::Unit& u, int wr, int wc, int fr, int fq) const {
        unsigned char* base = u.aux == 1 ? GTp : HTp;
#pragma unroll
        for (int ai = 0; ai < 2; ++ai)
#pragma unroll
            for (int m = 0; m < 4; ++m) { const int row = u.orow + ai * pg8::HALF + wr * 64 + m * 16 + fr;
#pragma unroll
                for (int bj = 0; bj < 2; ++bj) { const f32x4 v0 = acc[ai][bj][m][0], v1 = acc[ai][bj][m][1];
                    u32x2 w8; w8.x = cvt4_fp8(v0[0], v0[1], v0[2], v0[3]); w8.y = cvt4_fp8(v1[0], v1[1], v1[2], v1[3]);
                    *(u32x2*)(base + (size_t)row * DM + u.ocol + bj * pg8::HALF + wc * 32 + 8 * fq) = w8; } }
    } };
struct SchedMoe {
    const char* A; const char* W; const int* list; const LAS int* tbl; int G, c, NPN; size_t w_exp, w_tile, a_tile; int ocol_w;
    __device__ __forceinline__ bool next(int i, pg8::Unit& u) const {
        const int L = i * G + c; const int tl = L / NPN, pn = L % NPN;
        if (tl >= __builtin_amdgcn_readfirstlane(tbl[16])) return false;
        int e = 0;
#pragma unroll 1
        for (int x = 1; x < NEXP; ++x) { if (tl >= __builtin_amdgcn_readfirstlane(tbl[x])) e = x; }
        const int j = tl - __builtin_amdgcn_readfirstlane(tbl[e]), n = __builtin_amdgcn_readfirstlane(tbl[32 + e]) - 256 * j;
        u.a = A + (size_t)tl * a_tile; u.b = W + (size_t)e * w_exp + (size_t)pn * w_tile; u.orow = tl * 256; u.ocol = pn * ocol_w; u.aux = 1;
        u.rows = list + (size_t)e * M + 256 * j; u.nvalid = n < 256 ? n : 256; return true;
    }
};
__device__ __forceinline__ void moe_table(LAS int* tbl, const unsigned* ctl) {
    if (threadIdx.x == 0) { int base = 0; for (int e = 0; e < NEXP; ++e) { const int n = (int)ctl[CW_CNT + 64 * e]; tbl[e] = base; tbl[32 + e] = n; base += (n + 255) >> 8; } tbl[16] = base; }
    __syncthreads();
}

__global__ void __launch_bounds__(NWAVES * 64, 2) hymba_fwd(Args args) {
    extern __shared__ __attribute__((aligned(16))) unsigned char lds_raw[];
    LAS unsigned char* lds = (LAS unsigned char*)lds_raw;
    volatile LAS unsigned* MISC = (volatile LAS unsigned*)(lds + MISC_OFF);
    const int tid0 = threadIdx.x; const int wave = __builtin_amdgcn_readfirstlane(tid0 >> 6);
    const int G = gridDim.x; const int bx = blockIdx.x; const int vcu = (G % 8 == 0) ? (bx % 8) * (G / 8) + bx / 8 : bx;
    volatile LAS unsigned* ATAB = (volatile LAS unsigned*)(lds + MISC_OFF + 512);
    for (int u = tid0; u < 256; u += NWAVES * 64) ((LAS unsigned*)(lds + MISC_OFF))[u] = 0u;
    __syncthreads();
    if (tid0 == 0) { const float* const* ap = (const float* const*)&args;
#pragma unroll
        for (int i = 0; i < 24; ++i) { const unsigned long long v = (unsigned long long)ap[i]; ATAB[2 * i] = (unsigned)v; ATAB[2 * i + 1] = (unsigned)(v >> 32); } }
    __syncthreads();
#define ARGP(name) ((const float*)ldp(ATAB, (int)(offsetof(Args, name) / 8)))
#define PHASE_PTRS \
    int tid = threadIdx.x; asm volatile("" : "+v"(tid)); const int lane = tid & 63; (void)lane; \
    unsigned char* const ws = (unsigned char*)ldp(ATAB, 23); float* const out = (float*)ldp(ATAB, 22); unsigned* const ctl = (unsigned*)(ws + WS_CTL); (void)out; (void)ctl; \
    bf16_t* const Win_t = (bf16_t*)(ws + WS_WIN); bf16_t* const Wout_t = (bf16_t*)(ws + WS_WOUT); bf16_t* const Wxq_n = (bf16_t*)(ws + WS_WXQ); bf16_t* const Wxkv_t = (bf16_t*)(ws + WS_WXKV); \
    bf16_t* const Wxo_t = (bf16_t*)(ws + WS_WXO); bf16_t* const Wgu_t = (bf16_t*)(ws + WS_WGU); bf16_t* const Wd_t = (bf16_t*)(ws + WS_WD); \
    float* const RX = (float*)(ws + WS_RX); float* const RMEM = (float*)(ws + WS_RMEM); float* const LF = (float*)(ws + WS_LF); float* const CC = (float*)(ws + WS_C2); float* const SSQ = (float*)(ws + WS_SSQ); \
    int* const TOKSLOT = (int*)(ws + WS_TOKSLOT); float* const TOKW = (float*)(ws + WS_TOKW); int* const LIST = (int*)(ws + WS_LIST); \
    bf16_t* const MEMB = (bf16_t*)(ws + WS_MEMB); bf16_t* const KVM = (bf16_t*)(ws + WS_KVM); bf16_t* const GT = (bf16_t*)(ws + WS_GT); bf16_t* const HT = (bf16_t*)(ws + WS_HT); \
    bf16_t* const XB = (bf16_t*)(ws + WS_XB); bf16_t* const QKV = (bf16_t*)(ws + WS_QKV); bf16_t* const H1B = (bf16_t*)(ws + WS_H1B); bf16_t* const U2B = (bf16_t*)(ws + WS_U2B); bf16_t* const HID = (bf16_t*)(ws + WS_HID); \
    bf16_t* const OAB = (bf16_t*)(ws + WS_O); bf16_t* const YB = (bf16_t*)(ws + WS_Y); bf16_t* const KX = (bf16_t*)(ws + WS_KX); (void)KX; float* const HS = (float*)(ws + WS_HS); (void)HS; float* const R2S = (float*)(ws + WS_SSQ); (void)R2S; unsigned char* const H1F8 = ws + WS_H1F8; (void)H1F8; unsigned char* const H2F8 = ws + WS_H2F8; (void)H2F8; \
    (void)Win_t; (void)Wout_t; (void)Wxq_n; (void)Wxkv_t; (void)Wxo_t; (void)Wgu_t; (void)Wd_t; (void)RX; (void)RMEM; (void)LF; (void)CC; (void)SSQ; (void)TOKSLOT; (void)TOKW; (void)LIST; \
    (void)MEMB; (void)KVM; (void)GT; (void)HT; (void)XB; (void)QKV; (void)H1B; (void)U2B; (void)HID; (void)OAB; (void)YB;
    XcdBarrier bar;
    { unsigned char* const ws0 = (unsigned char*)ldp(ATAB, 23); bar = xcd_barrier_post((unsigned*)(ws0 + WS_CTL) + CW_BAR, MISC + 8); }
    const int gw = vcu * NWAVES + wave, NGW = G * NWAVES;
    unsigned long long t_pa = 0, t_pb = 0; (void)t_pa; (void)t_pb;


    if (PROBE_LO == 0) t_pa = __builtin_amdgcn_s_memrealtime();
    if (PH(0))
    for (int rep_ = 0; rep_ < REPS(0); ++rep_)
    {
        PHASE_PTRS
        LAS float* wfT = (LAS float*)(lds + RING_OFF);
        LAS float* scr = (LAS float*)(lds + RING_OFF + 32768 + wave * 8448);
        { const float* win = ARGP(w_in); const float* gmix = ARGP(norm_mix);
          f32x4 fa[2], fb[2]; float gk[2];
#pragma unroll
          for (int q = 0; q < 2; ++q) { const int k = tid + 512 * q; gk[q] = gmix[k]; fa[q] = *(const f32x4*)(win + (size_t)k * WIN_LD + NPROJ); fb[q] = *(const f32x4*)(win + (size_t)k * WIN_LD + NPROJ + 4); }
#pragma unroll
          for (int q = 0; q < 2; ++q) { const int k = tid + 512 * q;
#pragma unroll
              for (int j = 0; j < 4; ++j) { wfT[j * DM + k] = fa[q][j] * gk[q]; wfT[(4 + j) * DM + k] = fb[q][j] * gk[q]; } } }
        constexpr int I_IN = 16 * 96, I_OUT = 16 * 32, I_XKV = 16 * 64, I_XO = 16 * 32, I_G = 16 * 16 * 8, I_U = I_G, I_D = 16 * 4 * 32, I_XQ = 1024;
        constexpr int NITEMS = I_IN + I_OUT + I_XKV + I_XO + I_G + I_U + I_D + I_XQ;
        for (int it = gw; it < NITEMS; it += NGW) {
            int r = it;
            if (r < I_IN) { const int kb = r / 96, nb = r % 96; transpose_item(ARGP(w_in), WIN_LD, Win_t, DM, 64 * kb, 32 * nb, 32 * nb, ARGP(norm_mix), scr, lane); continue; } r -= I_IN;
            if (r < I_OUT) { const int kb = r / 32, nb = r % 32; const float* gn = (64 * kb < HW) ? ARGP(norm_fox) : (ARGP(norm_sb) - HW); transpose_item(ARGP(w_out), DM, Wout_t, DM, 64 * kb, 32 * nb, 32 * nb, gn, scr, lane); continue; } r -= I_OUT;
            if (r < I_XKV) { const int kb = r / 64, nb = r % 64; transpose_item(ARGP(w_xkv), 2 * DM, Wxkv_t, DM, 64 * kb, 32 * nb, 32 * nb, ARGP(norm_mem), scr, lane); continue; } r -= I_XKV;
            if (r < I_XO) { const int kb = r / 32, nb = r % 32; transpose_item(ARGP(w_xo), DM, Wxo_t, DM, 64 * kb, 32 * nb, 32 * nb, nullptr, scr, lane); continue; } r -= I_XO;
            if (r < I_G + I_U) { const int up = r >= I_G; const int q = up ? r - I_G : r; const int e = q / 128, kb = (q % 128) / 8, nb = q % 8; const int n0 = 32 * nb;
                const float* W = (up ? ARGP(w_up) : ARGP(w_gate)) + (size_t)e * DM * DFF;
                transpose_item8(W, DFF, (unsigned char*)Wgu_t + (size_t)e * 512 * DM, DM, 64 * kb, n0, 256 * (n0 / 128) + (n0 % 128) + (up ? 128 : 0), ARGP(norm_ffn), WGU_SCALE, scr, lane); continue; } r -= I_G + I_U;
            if (r < I_D) { const int e = r / 128, kb = (r % 128) / 32, nb = r % 32; transpose_item8(ARGP(w_down) + (size_t)e * DFF * DM, DM, (unsigned char*)Wd_t + (size_t)e * DM * DFF, DFF, 64 * kb, 32 * nb, 32 * nb, nullptr, WD_SCALE, scr, lane); continue; } r -= I_D;
            { const int k = r; const float gk = ARGP(norm_xattn)[k]; const f32x4* src = (const f32x4*)(ARGP(w_xq) + (size_t)k * DM) + lane; u32x2* dst = (u32x2*)(Wxq_n + (size_t)k * DM) + lane;
#pragma unroll
              for (int j = 0; j < 4; ++j) { const f32x4 v = src[64 * j] * gk; u32x2 w; w.x = cvt_pk_bf16(v[0], v[1]); w.y = cvt_pk_bf16(v[2], v[3]); dst[64 * j] = w; } }
        }
        __syncthreads();
        const float* xin = ARGP(x); const float* memin = ARGP(mem); const float* bfg = ARGP(b_forget);
        constexpr int TOT = M + MEMROWS;
#define P0_LOAD(vv, rw) do { if ((rw) < TOT) { const bool im_ = (rw) >= M; const f32x4* xr_ = (const f32x4*)((im_ ? memin : xin) + (size_t)(im_ ? (rw) - M : (rw)) * DM) + lane; \
        _Pragma("unroll") for (int j = 0; j < 4; ++j) vv[j] = __builtin_nontemporal_load(xr_ + 64 * j); } } while (0)
#define P0_ROW(vv, rw) do { const int row_ = (rw); const bool is_mem = row_ >= M; const int r = is_mem ? row_ - M : row_; float s = 0.f; \
        _Pragma("unroll") for (int j = 0; j < 4; ++j) s += (vv[j][0] * vv[j][0] + vv[j][1] * vv[j][1]) + (vv[j][2] * vv[j][2] + vv[j][3] * vv[j][3]); \
        const float rinv = rsqrtf(wave_sum(s) * (1.0f / DM) + EPS); \
        u32x2* o8 = (u32x2*)((is_mem ? MEMB : XB) + (size_t)r * DM) + lane; \
        _Pragma("unroll") for (int j = 0; j < 4; ++j) { u32x2 w; w.x = cvt_pk_bf16(vv[j][0], vv[j][1]); w.y = cvt_pk_bf16(vv[j][2], vv[j][3]); o8[64 * j] = w; } \
        if (is_mem) { if (lane == 0) RMEM[r] = rinv; } \
        else { float f[8]; \
            _Pragma("unroll") for (int jj = 0; jj < 8; ++jj) { float a = 0.f; \
                _Pragma("unroll") for (int j = 0; j < 4; ++j) { const f32x4 w4 = *(const LAS f32x4*)(wfT + jj * DM + 256 * j + 4 * lane); a += (vv[j][0] * w4[0] + vv[j][1] * w4[1]) + (vv[j][2] * w4[2] + vv[j][3] * w4[3]); } \
                f[jj] = wave_sum(a); } \
            if (lane == 0) RX[r] = rinv; \
            if (lane < 8) { float fl = 0.f; \
                _Pragma("unroll") for (int jj = 0; jj < 8; ++jj) fl = (lane == jj) ? f[jj] : fl; \
                fl = fl * rinv + bfg[lane]; \
                const float ls = fminf(fl, 0.f) - log1pf(expf(-fabsf(fl))); \
                LF[(size_t)r * 8 + lane] = ls * LOG2E; } } } while (0)
        f32x4 va[4], vb[4], vc[4];
        P0_LOAD(va, gw); P0_LOAD(vb, gw + NGW);
        for (int row = gw; row < TOT; row += 3 * NGW) {
            P0_LOAD(vc, row + 2 * NGW); P0_ROW(va, row);
            if (row + NGW < TOT) { P0_LOAD(va, row + 3 * NGW); P0_ROW(vb, row + NGW); }
            if (row + 2 * NGW < TOT) { P0_LOAD(vb, row + 4 * NGW); P0_ROW(vc, row + 2 * NGW); }
        }
#undef P0_LOAD
#undef P0_ROW
    }
    xcd_barrier(bar);
    if (PROBE_HI == 0) t_pb = __builtin_amdgcn_s_memrealtime();

    if (PROBE_LO == 1) t_pa = __builtin_amdgcn_s_memrealtime();
    if (PH(1))
    if (vcu < 32) {
        PHASE_PTRS
        const int b = vcu >> 2, h = (vcu & 3) * 2 + (wave >> 2), seg = wave & 3, s0 = seg * 2048 + lane * 32;
        const float* src = LF + ((size_t)b * SEQ + s0) * 8 + h;
        float p[32];
#pragma unroll
        for (int j = 0; j < 32; ++j) p[j] = src[j * 8];
#pragma unroll
        for (int j = 1; j < 32; ++j) p[j] += p[j - 1];
        float inc = p[31];
#pragma unroll
        for (int o = 1; o < 64; o <<= 1) { const float y = __shfl_up(inc, o); if (lane >= o) inc += y; }
        LAS float* tot = (LAS float*)(lds + EXTRA_OFF);
        if (lane == 63) tot[wave] = inc;
        __syncthreads();
        float off = inc - p[31];
        for (int q = 0; q < 3; ++q) if (q < seg) off += tot[(wave & 4) + q];
        float* dst = CC + ((size_t)b * NH + h) * SEQ + s0; bf16_t* kx = KX + (((size_t)b * NH + h) * SEQ + s0) * 8;
#pragma unroll
        for (int j = 0; j < 32; ++j) { const float x = off + p[j]; dst[j] = x;
            unsigned hm, lo; fox::split3(-x, hm, lo); u32x4 w; w.x = 0x3F803F80u; w.y = 0x3F80u | (hm << 16); w.z = (hm >> 16) | (lo << 16); w.w = 0u;
            *(u32x4*)(kx + j * 8) = w; }
        VM_WAIT(); __syncthreads();
    }
    if (PH(1))
    for (int rep_ = 0; rep_ < REPS(1); ++rep_)
    {
        PHASE_PTRS
        pg8::Gemm g{DM, DM, DM};
        SchedDense S{(const char*)XB, (const char*)Win_t, M / 256, NPROJ / 256, G, bx, (size_t)256 * DM * 2, (size_t)256 * DM * 2, 0, 2};
        LAS float* rst = (LAS float*)(lds + EXTRA_OFF);
#pragma unroll
        for (int q = 0; q < 8; ++q) { const int idx = tid + 512 * q, i = idx >> 8, r = idx & 255; int pm, pn; if (pg8::tile_order(i, G, bx, M / 256, NPROJ / 256, pm, pn)) rst[idx] = RX[pm * 256 + r]; }
        VM_WAIT(); __syncthreads();
        pg8::EpiBf16 E{QKV, HW, RX, QKV_STRIDE, C2, C2, ctl + CW_KN, rst, 1.f, false};
        pg8::gemm_phase<pg8::EpiBf16, SchedDense, true, false>(lds + RING_OFF, g, S, E);
    }
    xcd_barrier(bar);
    if (PROBE_HI == 1) t_pb = __builtin_amdgcn_s_memrealtime();

    if (PROBE_LO == 2) t_pa = __builtin_amdgcn_s_memrealtime();
    if (PH(2))
    {
        PHASE_PTRS
        const bf16_t* QA = QKV; const bf16_t* KA = QKV + QKV_STRIDE; const bf16_t* VA = QKV + 2 * QKV_STRIDE;
        const bf16_t* QBp = QKV + 3 * QKV_STRIDE; const bf16_t* KBp = QKV + 4 * QKV_STRIDE; const bf16_t* VBp = QKV + 5 * QKV_STRIDE;
        bf16_t* OA = OAB; bf16_t* OB = OAB + HW;
        LAS char* shm = (LAS char*)(lds + RING_OFF);
        { pg8::Gemm g{DM, DM, DM};
          SchedDense S2{(const char*)MEMB, (const char*)Wxkv_t, MEMROWS / 256, 2 * DM / 256, G, bx, (size_t)256 * DM * 2, (size_t)256 * DM * 2, 0, 0};
          pg8::EpiBf16 E2{KVM, 2 * DM, RMEM, 0, 1.f, 1.f, nullptr, nullptr, 1.f, false};
          pg8::gemm_phase<pg8::EpiBf16, SchedDense, true, false>(lds + RING_OFF, g, S2, E2);
          VM_WAIT(); __syncthreads(); }
        for (int rep = 0; rep < REP_FOX; ++rep)
        for (int i = 0; i < 8; ++i) { const int bh = (vcu >> 5) * 8 + i, x = vcu & 31, qb = (i & 1) ? 31 - x : x;
            const float kmax = sqrtf(__uint_as_float(ctl[CW_KN + bh * 2]) + __uint_as_float(ctl[CW_KN + bh * 2 + 1])) * 1.01f;
            fox::fox_unit<8>(bh, qb, QA, KA, VA, OA, HS + (bh & 7), CC + (size_t)bh * SEQ, KX + (size_t)bh * SEQ * 8, kmax, shm); }
        { volatile LAS unsigned* qs = MISC + 16;
          unsigned nxt = 0u;
          if (tid == 0) qs[0] = __hip_atomic_fetch_add(ctl + CW_SBQ, 1u, __ATOMIC_RELAXED, __HIP_MEMORY_SCOPE_AGENT);
          __syncthreads();
          unsigned idx = qs[0];
          while (idx < (unsigned)(BATCH * NH * 32 * REP_SB)) {
              __syncthreads();
              if (tid == 0) nxt = __hip_atomic_fetch_add(ctl + CW_SBQ, 1u, __ATOMIC_RELAXED, __HIP_MEMORY_SCOPE_AGENT);
              const int un = (int)(idx % (unsigned)(BATCH * NH * 32)), bh = un >> 5, qb = un & 31;
              sbk::sb_unit(bh >> 3, bh & 7, qb, QBp, KBp, VBp, OB, HS + 8 + (bh & 7), shm);
              if (tid == 0) qs[0] = nxt;
              __syncthreads();
              idx = qs[0];
          } }
    }
    xcd_barrier(bar);
    if (PROBE_HI == 2) t_pb = __builtin_amdgcn_s_memrealtime();

    if (PROBE_LO == 4) t_pa = __builtin_amdgcn_s_memrealtime();
    if (PH(4))
    for (int rep_ = 0; rep_ < REPS(4); ++rep_)
    {
        PHASE_PTRS
        pg8::Gemm g{DM, DM, DM};
        SchedDense S{(const char*)OAB, (const char*)Wout_t, M / 256, DM / 256, G, bx, (size_t)256 * DM * 2, (size_t)256 * DM * 2, 0, 0};
        LAS f32x2* rab = (LAS f32x2*)(lds + EXTRA_OFF);
#pragma unroll
        for (int q = 0; q < 4; ++q) { const int idx = tid + 512 * q, i = idx >> 8, r = idx & 255; int pm, pn;
            if (pg8::tile_order(i, G, bx, M / 256, DM / 256, pm, pn)) { const f32x4* p = (const f32x4*)(HS + (size_t)(pm * 256 + r) * 16); const f32x4 a0 = p[0], a1 = p[1], b0 = p[2], b1 = p[3];
                const float ra = rsqrtf((((a0[0] + a0[1]) + (a0[2] + a0[3])) + ((a1[0] + a1[1]) + (a1[2] + a1[3]))) * (1.0f / HW) + EPS);
                const float rb = rsqrtf((((b0[0] + b0[1]) + (b0[2] + b0[3])) + ((b1[0] + b1[1]) + (b1[2] + b1[3]))) * (1.0f / HW) + EPS);
                rab[idx] = (f32x2){ra / rb, rb}; } }
        VM_WAIT(); __syncthreads();
        pg8::EpiOutProj E{XB, H1B, H1F8, SSQ, rab};
        pg8::gemm_phase<pg8::EpiOutProj, SchedDense, true, false>(lds + RING_OFF, g, S, E);
        pg8::Gemm g2{0, 0, 256};
        SchedGH SG{(const char*)KVM, (const char*)Wxq_n, (const char*)Wxo_t, G, bx};
        EpiGH EG{(unsigned char*)GT, (unsigned char*)HT};
        g2.lda = 2 * DM; g2.ldb = DM; SchedGHk<0> S0{SG}; pg8::gemm_phase<EpiGH, SchedGHk<0>, true, false>(lds + RING_OFF, g2, S0, EG);
        g2.lda = DM; g2.ldb = 2 * DM; SchedGHk<1> S1{SG}; pg8::gemm_phase<EpiGH, SchedGHk<1>, true, false>(lds + RING_OFF, g2, S1, EG);
    }
    xcd_barrier(bar);
    if (PROBE_HI == 4) t_pb = __builtin_amdgcn_s_memrealtime();

    if (PROBE_LO == 5) t_pa = __builtin_amdgcn_s_memrealtime();
    if (PH(5))
    for (int rep_ = 0; rep_ < REPS(5); ++rep_)
    {
        PHASE_PTRS
        pg8::Gemm g{DM, DM, DM};
        SchedDense S{(const char*)H1F8, (const char*)GT, M / 256, DM / 256, G, bx, (size_t)256 * DM, (size_t)256 * DM, (size_t)DM * DM, 0};
        LAS float* r1t = (LAS float*)(lds + EXTRA_OFF + 8192);
#pragma unroll
        for (int q = 0; q < 4; ++q) { const int idx = tid + 512 * q, i = idx >> 8, r = idx & 255; int pm, pn;
            if (pg8::tile_order(i, G, bx, M / 256, DM / 256, pm, pn)) { const f32x4* sp = (const f32x4*)(SSQ + (size_t)(pm * 256 + r) * 16); const f32x4 s0 = sp[0], s1 = sp[1], s2 = sp[2], s3 = sp[3];
                const float tot = ((s0[0] + s0[1]) + (s0[2] + s0[3])) + ((s1[0] + s1[1]) + (s1[2] + s1[3])) + ((s2[0] + s2[1]) + (s2[2] + s2[3])) + ((s3[0] + s3[1]) + (s3[2] + s3[3]));
                r1t[idx] = rsqrtf(tot * (1.0f / DM) + EPS) * XSC; } }
        VM_WAIT(); __syncthreads();
        pg8::EpiSoftmax E{XB, r1t, (LAS float*)(lds + EXTRA_OFF)};
        pg8::gemm_phase<pg8::EpiSoftmax, SchedDense, true, false, true>(lds + RING_OFF, g, S, E);
    }
    xcd_barrier(bar);
    if (PROBE_HI == 5) t_pb = __builtin_amdgcn_s_memrealtime();

    if (PROBE_LO == 6) t_pa = __builtin_amdgcn_s_memrealtime();
    if (PH(6))
    {
        PHASE_PTRS
        pg8::Gemm g{DM, DM, DM};
        SchedDense S{(const char*)XB, (const char*)HT, M / 256, DM / 256, G, bx, (size_t)256 * DM, (size_t)256 * DM, (size_t)DM * DM, 0};
        pg8::EpiResidBf16 E{H1B, H2F8, 1.0f / P_SCALE};
        pg8::gemm_phase<pg8::EpiResidBf16, SchedDense, true, false, true>(lds + RING_OFF, g, S, E);
    }
    xcd_barrier(bar);
    if (PROBE_HI == 6) t_pb = __builtin_amdgcn_s_memrealtime();

    if (PROBE_LO == 7) t_pa = __builtin_amdgcn_s_memrealtime();
    if (PH(7))
    {
        PHASE_PTRS
        LAS bf16_t* wBh = (LAS bf16_t*)(lds + RING_OFF); LAS bf16_t* wBl = wBh + 20 * DM;
        { const f32x4* wg4 = (const f32x4*)ARGP(w_rg); const f32x4* we4 = (const f32x4*)ARGP(w_re); const float* gf = ARGP(norm_ffn);
          f32x4 ga[2], ea[2][4]; float gk[2];
#pragma unroll
          for (int q = 0; q < 2; ++q) { const int k = tid + 512 * q; ga[q] = wg4[k]; gk[q] = gf[k];
#pragma unroll
              for (int c = 0; c < 4; ++c) ea[q][c] = we4[k * 4 + c]; }
#pragma unroll
          for (int q = 0; q < 2; ++q) { const int k = tid + 512 * q;
#pragma unroll
              for (int j = 0; j < 4; ++j) { { const float v = ga[q][j] * gk[q]; const unsigned hi_ = cvt_pk_bf16(v, 0.f) & 0xffffu; wBh[j * DM + k] = (bf16_t)hi_; wBl[j * DM + k] = (bf16_t)(cvt_pk_bf16(v - __uint_as_float(hi_ << 16), 0.f) & 0xffffu); }
#pragma unroll
                  for (int c = 0; c < 4; ++c) { const float v = ea[q][c][j] * gk[q]; const unsigned hi_ = cvt_pk_bf16(v, 0.f) & 0xffffu; const int col = 4 + 4 * c + j; wBh[col * DM + k] = (bf16_t)hi_; wBl[col * DM + k] = (bf16_t)(cvt_pk_bf16(v - __uint_as_float(hi_ << 16), 0.f) & 0xffffu); } } } }
        LAS int* dec_e = (LAS int*)(lds + RING_OFF + 81920); LAS float* dec_w = (LAS float*)(lds + RING_OFF + 81920 + 2048); LAS int* dec_r = (LAS int*)(lds + RING_OFF + 81920 + 4096);
        LAS int* hist = (LAS int*)(lds + RING_OFF + 81920 + 6144); LAS int* ebase = hist + 16; LAS float* dec_v = (LAS float*)(lds + RING_OFF + 81920 + 8192);
        if (tid < 16) hist[tid] = 0;
        __syncthreads();
        const float brg0 = ARGP(b_rg)[0], brg1 = ARGP(b_rg)[1], brg2 = ARGP(b_rg)[2], brg3 = ARGP(b_rg)[3]; const float* bre = ARGP(b_re);
        const int tok = lane & 31, half = lane >> 5, jcol = tok < 20 ? tok : 19;
        for (int it = 0; it * NGW < M / 32; ++it) {
            const int T = gw + it * NGW; const bool act = T < M / 32; const int r0 = act ? 32 * T : 0;
            const bf16_t* rowp = H1B + (size_t)(r0 + tok) * DM + 512 * half;
            const LAS bf16_t* wph = wBh + jcol * DM + 512 * half; const LAS bf16_t* wpl = wBl + jcol * DM + 512 * half;
            f32x16 ah0 = f32x16{}, ah1 = f32x16{}, al0 = f32x16{}, al1 = f32x16{}; float ssq = 0.f;
#pragma unroll 4
            for (int sidx = 0; sidx < 64; sidx += 2) {
                const u32x4 a0 = *(const u32x4*)(rowp + 8 * sidx), a1 = *(const u32x4*)(rowp + 8 * sidx + 8);
                const bf16x8 wh0 = *(const LAS bf16x8*)(wph + 8 * sidx), wl0 = *(const LAS bf16x8*)(wpl + 8 * sidx), wh1 = *(const LAS bf16x8*)(wph + 8 * sidx + 8), wl1 = *(const LAS bf16x8*)(wpl + 8 * sidx + 8);
                ah0 = MFMA32(wh0, __builtin_bit_cast(bf16x8, a0), ah0); al0 = MFMA32(wl0, __builtin_bit_cast(bf16x8, a0), al0);
                ah1 = MFMA32(wh1, __builtin_bit_cast(bf16x8, a1), ah1); al1 = MFMA32(wl1, __builtin_bit_cast(bf16x8, a1), al1);
                ssq += (bf16lo(a0.x) * bf16lo(a0.x) + bf16hi(a0.x) * bf16hi(a0.x)) + (bf16lo(a0.y) * bf16lo(a0.y) + bf16hi(a0.y) * bf16hi(a0.y)) + (bf16lo(a0.z) * bf16lo(a0.z) + bf16hi(a0.z) * bf16hi(a0.z)) + (bf16lo(a0.w) * bf16lo(a0.w) + bf16hi(a0.w) * bf16hi(a0.w));
                ssq += (bf16lo(a1.x) * bf16lo(a1.x) + bf16hi(a1.x) * bf16hi(a1.x)) + (bf16lo(a1.y) * bf16lo(a1.y) + bf16hi(a1.y) * bf16hi(a1.y)) + (bf16lo(a1.z) * bf16lo(a1.z) + bf16hi(a1.z) * bf16hi(a1.z)) + (bf16lo(a1.w) * bf16lo(a1.w) + bf16hi(a1.w) * bf16hi(a1.w));
            }
            const float rinv = rsqrtf((att::swap_lo(ssq) + att::swap_hi(ssq)) * (1.0f / DM) + EPS);
            float lg[20];
#pragma unroll
            for (int r = 0; r < 12; ++r) { const float c = (ah0[r] + ah1[r]) + (al0[r] + al1[r]); auto rr = __builtin_amdgcn_permlane32_swap(__float_as_uint(c), __float_as_uint(c), false, false);
                const int jl = (r & 3) + 8 * (r >> 2); lg[jl] = __uint_as_float(rr[0]) * rinv; if (r < 8) lg[jl + 4] = __uint_as_float(rr[1]) * rinv; }
            float g0 = lg[0] + brg0, g1 = lg[1] + brg1, g2 = lg[2] + brg2, g3 = lg[3] + brg3;
            int gi = 0; float gm = g0; if (g1 > gm) { gm = g1; gi = 1; } if (g2 > gm) { gm = g2; gi = 2; } if (g3 > gm) { gm = g3; gi = 3; }
            const float gval = 1.0f / (expf(g0 - gm) + expf(g1 - gm) + expf(g2 - gm) + expf(g3 - gm));
            float el[4];
#pragma unroll
            for (int j = 0; j < 4; ++j) { const float e0 = lg[4 + j], e1 = lg[8 + j], e2 = lg[12 + j], e3 = lg[16 + j]; el[j] = ((gi == 0) ? e0 : (gi == 1) ? e1 : (gi == 2) ? e2 : e3) + bre[gi * 4 + j]; }
            int i0 = 0; float m0 = el[0];
#pragma unroll
            for (int j = 1; j < 4; ++j) if (el[j] > m0) { m0 = el[j]; i0 = j; }
            int i1 = -1; float m1 = -3.0e38f;
#pragma unroll
            for (int j = 0; j < 4; ++j) if (j != i0 && el[j] > m1) { m1 = el[j]; i1 = j; }
            const float w0 = 1.0f / (1.0f + expf(m1 - m0)), w1 = 1.0f - w0;
            if (act) { const int e = gi * 4 + (half == 0 ? i0 : i1); const float w = gval * (half == 0 ? w0 : w1);
                const int idx = (wave * 32 + tok) * 2 + half; dec_e[idx] = e; dec_w[idx] = w; dec_v[idx] = rinv; dec_r[idx] = __hip_atomic_fetch_add(hist + e, 1, __ATOMIC_RELAXED, __HIP_MEMORY_SCOPE_WORKGROUP); }
            __syncthreads();
            if (tid < 16) { const int n = hist[tid]; ebase[tid] = n ? (int)__hip_atomic_fetch_add(ctl + CW_CNT + 64 * tid, (unsigned)n, __ATOMIC_RELAXED, __HIP_MEMORY_SCOPE_AGENT) : 0; }
            __syncthreads();
            if (act) { const int row = r0 + (lane >> 1), idx = wave * 64 + lane; const int e = dec_e[idx], pos = ebase[e] + dec_r[idx];
                LIST[(size_t)e * M + pos] = row; R2S[(size_t)e * M + pos] = dec_v[idx]; TOKSLOT[(size_t)row * 2 + (lane & 1)] = (e << 20) | pos; TOKW[(size_t)row * 2 + (lane & 1)] = dec_w[idx]; }
            __syncthreads();
            if (tid < 16) hist[tid] = 0;
            __syncthreads();
        }
    }
    xcd_barrier(bar);
    if (PROBE_HI == 7) t_pb = __builtin_amdgcn_s_memrealtime();

    if (PROBE_LO == 8) t_pa = __builtin_amdgcn_s_memrealtime();
    if (PH(8))
    for (int rep_ = 0; rep_ < REPS(8); ++rep_)
    {
        PHASE_PTRS
        pg8::Gemm g{DM, DM, DM};
        LAS int* tbl = (LAS int*)(lds + EXTRA_OFF + 8192); moe_table(tbl, ctl);
        SchedMoe S; S.A = (const char*)H2F8; S.W = (const char*)Wgu_t; S.list = LIST; S.tbl = tbl; S.G = G; S.c = bx; S.NPN = 2; S.w_exp = (size_t)512 * DM; S.w_tile = (size_t)256 * DM; S.a_tile = 0; S.ocol_w = 128;
        pg8::EpiSwiglu E{HID, R2S, LIST};
        pg8::gemm_phase<pg8::EpiSwiglu, SchedMoe, true, true, true>(lds + RING_OFF, g, S, E);
    }
    xcd_barrier(bar);
    if (PROBE_HI == 8) t_pb = __builtin_amdgcn_s_memrealtime();

    if (PROBE_LO == 9) t_pa = __builtin_amdgcn_s_memrealtime();
    if (PH(9))
    for (int rep_ = 0; rep_ < REPS(9); ++rep_)
    {
        PHASE_PTRS
        pg8::Gemm g{DFF, DFF, DFF};
        LAS int* tbl = (LAS int*)(lds + EXTRA_OFF + 8192);
        SchedMoe S; S.A = (const char*)HID; S.W = (const char*)Wd_t; S.list = LIST; S.tbl = tbl; S.G = G; S.c = bx; S.NPN = 4; S.w_exp = (size_t)DM * DFF; S.w_tile = (size_t)256 * DFF; S.a_tile = (size_t)256 * DFF; S.ocol_w = 256;
        pg8::EpiBf16 E{YB, DM, nullptr, 0, 1.f, 1.f, nullptr, nullptr, 1.0f / WD_SCALE, true};
        pg8::gemm_phase<pg8::EpiBf16, SchedMoe, true, false, true>(lds + RING_OFF, g, S, E);
    }
    xcd_barrier(bar);
    if (PROBE_HI == 9) t_pb = __builtin_amdgcn_s_memrealtime();

    if (PROBE_LO == 10) t_pa = __builtin_amdgcn_s_memrealtime();
    if (PH(10))
    {
        PHASE_PTRS
        const LAS int* tb = (const LAS int*)(lds + EXTRA_OFF + 8192);
        const f32x4* gp = (const f32x4*)ARGP(norm_final) + lane;
        int sl0 = 0, sl1 = 0; float sw0 = 0.f, sw1 = 0.f;
        unsigned ya_n[4], yb_n[4]; u32x2 hh_n[4]; float w0_n = 0.f, w1_n = 0.f;
#define P10_SLOTS(rw) do { sl0 = TOKSLOT[(size_t)(rw) * 2]; sl1 = TOKSLOT[(size_t)(rw) * 2 + 1]; sw0 = TOKW[(size_t)(rw) * 2]; sw1 = TOKW[(size_t)(rw) * 2 + 1]; } while (0)
#define P10_DATA(rw) do { const int r0_ = tb[sl0 >> 20] * 256 + (sl0 & 0xfffff), r1_ = tb[sl1 >> 20] * 256 + (sl1 & 0xfffff); w0_n = sw0; w1_n = sw1; \
        const unsigned* y0_ = (const unsigned*)((const unsigned char*)YB + (size_t)r0_ * DM) + lane; const unsigned* y1_ = (const unsigned*)((const unsigned char*)YB + (size_t)r1_ * DM) + lane; const u32x2* h_ = (const u32x2*)(H1B + (size_t)(rw) * DM) + lane; \
        _Pragma("unroll") for (int j = 0; j < 4; ++j) { ya_n[j] = y0_[64 * j]; yb_n[j] = y1_[64 * j]; hh_n[j] = h_[64 * j]; } } while (0)
        if (gw < M) { P10_SLOTS(gw); P10_DATA(gw); if (gw + NGW < M) P10_SLOTS(gw + NGW); }
        for (int row = gw; row < M; row += NGW) {
            unsigned ya[4], yb[4]; u32x2 hh[4]; const float w0 = w0_n, w1 = w1_n;
#pragma unroll
            for (int j = 0; j < 4; ++j) { ya[j] = ya_n[j]; yb[j] = yb_n[j]; hh[j] = hh_n[j]; }
            if (row + NGW < M) { P10_DATA(row + NGW); if (row + 2 * NGW < M) P10_SLOTS(row + 2 * NGW); }
            f32x4* hr = (f32x4*)(out + (size_t)row * DM) + lane;
            f32x4 v[4]; float s = 0.f;
#pragma unroll
            for (int j = 0; j < 4; ++j) { const u32x2 hx = hh[j]; f32x4 h = {bf16lo(hx.x), bf16hi(hx.x), bf16lo(hx.y), bf16hi(hx.y)};
                const f32x2 a01 = __builtin_amdgcn_cvt_pk_f32_fp8((int)ya[j], false), a23 = __builtin_amdgcn_cvt_pk_f32_fp8((int)ya[j], true), b01 = __builtin_amdgcn_cvt_pk_f32_fp8((int)yb[j], false), b23 = __builtin_amdgcn_cvt_pk_f32_fp8((int)yb[j], true);
                h[0] += w0 * a01[0] + w1 * b01[0]; h[1] += w0 * a01[1] + w1 * b01[1]; h[2] += w0 * a23[0] + w1 * b23[0]; h[3] += w0 * a23[1] + w1 * b23[1];
                v[j] = h; s += (h[0] * h[0] + h[1] * h[1]) + (h[2] * h[2] + h[3] * h[3]); }
            const float rinv = rsqrtf(wave_sum(s) * (1.0f / DM) + EPS);
#pragma unroll
            for (int j = 0; j < 4; ++j) __builtin_nontemporal_store(v[j] * rinv * gp[64 * j], hr + 64 * j);
        }
#undef P10_SLOTS
#undef P10_DATA
    }
    if (PROBE_LO >= 0) {
        if (PROBE_HI == 10) t_pb = __builtin_amdgcn_s_memrealtime();
        if (blockIdx.x == 0 && threadIdx.x == 0) { const unsigned long long t0 = __builtin_amdgcn_s_memrealtime(), span = 2 * (t_pb - t_pa);
            while (__builtin_amdgcn_s_memrealtime() - t0 < span) __builtin_amdgcn_s_sleep(8); }
    }
}

extern "C" void kernel_launch(void* const* d_in, const int* in_sizes, int n_in, void* d_out, int out_size, void* d_ws, size_t ws_size, hipStream_t stream) {
    static int grid = 0;
    if (grid == 0) {
        if (n_in != 22 || in_sizes[0] != M * DM || out_size != M * DM || ws_size < WS_END) { fprintf(stderr, "kernel_launch: unexpected shapes (n_in %d, in0 %d, out %d, ws %zu)\n", n_in, n_in > 0 ? in_sizes[0] : -1, out_size, ws_size); grid = -1; return; }
        int dev = 0, cus = 0, per_cu = 0;
        if (hipGetDevice(&dev) != hipSuccess || hipDeviceGetAttribute(&cus, hipDeviceAttributeMultiprocessorCount, dev) != hipSuccess) { grid = -1; return; }
        if (hipFuncSetAttribute((const void*)hymba_fwd, hipFuncAttributeMaxDynamicSharedMemorySize, LDS_BYTES) != hipSuccess) { fprintf(stderr, "kernel_launch: hipFuncSetAttribute failed\n"); grid = -1; return; }
        if (hipOccupancyMaxActiveBlocksPerMultiprocessor(&per_cu, (const void*)hymba_fwd, NWAVES * 64, LDS_BYTES) != hipSuccess || per_cu < 1) { fprintf(stderr, "kernel_launch: occupancy query reports %d\n", per_cu); }
        (void)hipGetLastError();
        grid = cus;
    }
    if (grid < 0) return;
    (void)hipMemsetAsync((char*)d_ws + WS_CTL, 0, CTL_ZERO_BYTES, stream);
    Args a{};
    const float** p = (const float**)&a;
    for (int i = 0; i < 22; ++i) p[i] = (const float*)d_in[i];
    a.out = (float*)d_out; a.ws = (unsigned char*)d_ws;
    hipLaunchKernelGGL(hymba_fwd, dim3(grid), dim3(NWAVES * 64), LDS_BYTES, stream, a);
}
```

```cpp
#include <hip/hip_runtime.h>
#include <hip/hip_bf16.h>
#include <cstdio>
#include <cstdint>

#define LAS __attribute__((address_space(3)))
#define GAS __attribute__((address_space(1)))
typedef unsigned short bf16_t;
typedef short bf16x8 __attribute__((ext_vector_type(8)));
typedef short s16x4 __attribute__((ext_vector_type(4)));
typedef float f32x4 __attribute__((ext_vector_type(4)));
typedef float f32x2 __attribute__((ext_vector_type(2)));
typedef float f32x16 __attribute__((ext_vector_type(16)));
typedef unsigned u32x4 __attribute__((ext_vector_type(4)));
typedef unsigned u32x2 __attribute__((ext_vector_type(2)));
typedef __bf16 bf16x2_t __attribute__((ext_vector_type(2)));

constexpr int BATCH = 8, SEQ = 8192, DM = 1024, M = BATCH * SEQ;
constexpr int NH = 8, HD = 64, HW = NH * HD;
constexpr int NPROJ = 3 * HW * 2;
constexpr int WIN_LD = NPROJ + NH;
constexpr int NMEM = 256, XH = 4, XD = 256, MEMROWS = BATCH * NMEM;
constexpr int NEXP = 16, DFF = 256;
constexpr float EPS = 1e-6f;
constexpr float LOG2E = 1.4426950408889634f;
constexpr float C2 = 0.125f * LOG2E;
constexpr float XSC = 0.0625f * LOG2E;
constexpr float P_SCALE = 128.0f;
constexpr float WGU_SCALE = 32.0f;
constexpr float WD_SCALE = 16.0f;
constexpr float SB_EXIT = -48.0f;

constexpr size_t MiB = 1u << 20;
constexpr size_t WS_CTL = 0, CTL_ZERO_BYTES = 128 * 1024;
constexpr size_t WS_WIN = 1 * MiB;
constexpr size_t WS_WOUT = 7 * MiB;
constexpr size_t WS_WXQ = 9 * MiB;
constexpr size_t WS_WXKV = 11 * MiB;
constexpr size_t WS_WXO = 15 * MiB;
constexpr size_t WS_WGU = 17 * MiB;
constexpr size_t WS_WD = 33 * MiB;
constexpr size_t WS_RX = 41 * MiB;
constexpr size_t WS_RMEM = WS_RX + 256 * 1024;
constexpr size_t WS_R2 = WS_RX + 512 * 1024;
constexpr size_t WS_LF = 42 * MiB;
constexpr size_t WS_C2 = 44 * MiB;
constexpr size_t WS_SSQ = 46 * MiB;
constexpr size_t WS_TOKSLOT = 50 * MiB;
constexpr size_t WS_TOKW = 51 * MiB;
constexpr size_t WS_LIST = 52 * MiB;
constexpr size_t WS_MEMB = 56 * MiB;
constexpr size_t WS_KVM = 60 * MiB;
constexpr size_t WS_GT = 68 * MiB;
constexpr size_t WS_HT = 84 * MiB;
constexpr size_t WS_KX = 100 * MiB;
constexpr size_t WS_HS = 108 * MiB;
constexpr size_t WS_XB = 128 * MiB;
constexpr size_t WS_QKV = 256 * MiB;
constexpr size_t WS_H1B = 256 * MiB, WS_U2B = 384 * MiB, WS_HID = 512 * MiB;
constexpr size_t WS_H1F8 = 384 * MiB, WS_H2F8 = 448 * MiB;
constexpr size_t WS_O = 640 * MiB;
constexpr size_t WS_Y = 704 * MiB;
constexpr size_t WS_END = 1024 * MiB;
constexpr size_t QKV_STRIDE = (size_t)M * HW;
constexpr int MAXTILES = M * 2 / 256 + NEXP;
static_assert(WS_Y + (size_t)MAXTILES * 256 * 1024 * 2 <= WS_END, "ws map");
static_assert(WS_HID + (size_t)MAXTILES * 256 * 256 * 2 <= WS_O, "ws map");
constexpr int CW_BAR = 4096;
constexpr int CW_SBQ = 20736;
constexpr int CW_KN = 20480;
constexpr int CW_CNT = 16384;

constexpr int RING_OFF = 0, RING_BYTES = 131072;
constexpr int EXTRA_OFF = 131072, EXTRA_BYTES = 16384;
constexpr int MISC_OFF = EXTRA_OFF + EXTRA_BYTES;
constexpr int LDS_BYTES = MISC_OFF + 1024;
constexpr int NWAVES = 8;
#ifndef PHASE_MASK
#define PHASE_MASK 0x7ff
#endif
#define PH(n) ((PHASE_MASK >> (n)) & 1)
#ifndef PROBE_LO
#define PROBE_LO -1
#endif
#ifndef PROBE_HI
#define PROBE_HI -1
#endif
#ifndef FOX_V2
#define FOX_V2 1
#endif
#ifndef REP_MASK
#define REP_MASK 0
#endif
#define REPS(n) (1 + ((REP_MASK >> (n)) & 1))
#ifndef REP_FOX
#define REP_FOX 1
#endif
#ifndef REP_SB
#define REP_SB 1
#endif

__device__ __forceinline__ unsigned cvt_pk_bf16(float lo, float hi) { f32x2 v = {lo, hi}; bf16x2_t b = __builtin_convertvector(v, bf16x2_t); return __builtin_bit_cast(unsigned, b); }
__device__ __forceinline__ unsigned cvt4_fp8(float a, float b, float c, float d) { int w = 0; w = __builtin_amdgcn_cvt_pk_fp8_f32(a, b, w, false); w = __builtin_amdgcn_cvt_pk_fp8_f32(c, d, w, true); return (unsigned)w; }
__device__ __forceinline__ float bf16lo(unsigned u) { return __uint_as_float(u << 16); }
__device__ __forceinline__ float bf16hi(unsigned u) { return __uint_as_float(u & 0xffff0000u); }
#define DPP_ADD(v, CTRL) v += __builtin_bit_cast(float, __builtin_amdgcn_update_dpp(0, __builtin_bit_cast(int, v), CTRL, 0xf, 0xf, true))
__device__ __forceinline__ float wave_sum(float v) {
    DPP_ADD(v, 0xB1); DPP_ADD(v, 0x4E); DPP_ADD(v, 0x141); DPP_ADD(v, 0x140);
    const int iv = __builtin_bit_cast(int, v);
    return (__builtin_bit_cast(float, __builtin_amdgcn_readlane(iv, 0)) + __builtin_bit_cast(float, __builtin_amdgcn_readlane(iv, 16))) +
           (__builtin_bit_cast(float, __builtin_amdgcn_readlane(iv, 32)) + __builtin_bit_cast(float, __builtin_amdgcn_readlane(iv, 48)));
}
#define LDS_WAIT() asm volatile("s_waitcnt lgkmcnt(0)" ::: "memory")
#define VM_WAIT() asm volatile("s_waitcnt vmcnt(0)" ::: "memory")

namespace pg8 {
constexpr int BM = 256, BK = 64, HALF = 128, HTB = HALF * BK * 2, STAGE_BYTES = 8 * HTB, NXCD = 8, WGM = 8;
__host__ __device__ __forceinline__ int lds_byte(int r, int c) { const int st = (r >> 4) * 2 + (c >> 5), rr = r & 15, cc = c & 31, ob = rr * 64 + cc * 2; return st * 1024 + (ob ^ (((ob >> 9) & 1) << 5)); }
__host__ __device__ __forceinline__ void stage_rc(int b, int& R, int& C) { const int st = b / 1024, sb = b % 1024, swz = sb ^ (((sb >> 9) & 1) << 5); R = (st >> 1) * 16 + swz / 64; C = (st & 1) * 32 + (swz % 64) / 2; }
__host__ __device__ __forceinline__ int perm32(int rho) { const int n = rho >> 4, i = rho & 15; return 8 * (i >> 2) + 4 * n + (i & 3); }

struct Unit { const char* a; const char* b; int orow, ocol, aux; const int* rows; int nvalid; int seq; };
struct Gemm { int lda, ldb, K; };

__device__ __forceinline__ bool tile_order(int i, int G, int c, int nM, int nN, int& pm, int& pn) {
    const int nwg = nM * nN; const long L = (long)i * G + c; if (L >= nwg) return false;
    int wgid = (int)L; { const int q = nwg / NXCD, r = nwg % NXCD, xcd = wgid % NXCD, off = wgid / NXCD; wgid = (xcd < r ? xcd * (q + 1) : r * (q + 1) + (xcd - r) * q) + off; }
    const int nig = WGM * nN, gid = wgid / nig, fm = gid * WGM, gsz = (nM - fm) < WGM ? (nM - fm) : WGM;
    pm = fm + ((wgid % nig) % gsz); pn = (wgid % nig) / gsz; return true;
}

typedef int v8i32 __attribute__((ext_vector_type(8)));
template <class Epi, class Sched, bool ALIGN_EPI, bool GATHER, bool FP8 = false>
__device__ __forceinline__ void gemm_phase(LAS unsigned char* lds, const Gemm g, const Sched& S, const Epi& E) {
    int tid = threadIdx.x; asm volatile("" : "+v"(tid));
    const int wid = __builtin_amdgcn_readfirstlane(tid >> 6), lane = tid & 63, wr = wid >> 2, wc = wid & 3, fr = lane & 15, fq = lane >> 4;
    constexpr int ESZ = FP8 ? 1 : 2;
    const int K = g.K, nt = K / (FP8 ? 2 * BK : BK);
    unsigned voffA[2], voffB[2]; int RA[2], CA[2];
#pragma unroll
    for (int i = 0; i < 2; ++i) { int R, C; stage_rc(tid * 16 + i * 8192, R, C); const int Rb = (R & ~31) + perm32(R & 31);
        RA[i] = R; CA[i] = C; voffA[i] = (unsigned)(R * g.lda * ESZ + C * 2); voffB[i] = (unsigned)(Rb * g.ldb * ESZ + C * 2); }
    const size_t kstep = (size_t)(BK * 2);
    const size_t hstepA = (size_t)HALF * g.lda * ESZ, hstepB = (size_t)HALF * g.ldb * ESZ;
    const unsigned ldsw = (unsigned)wid * 1024u;
    const int aoff = lds_byte(wr * 64 + fr, FP8 ? fq * 16 : fq * 8), boff = lds_byte(wc * 32 + fr, FP8 ? fq * 16 : fq * 8);
    constexpr int KOFF = FP8 ? 16 : 1024;
#define PG8_SA(b, h) (((b) * 2 + (h)) * HTB)
#define PG8_SB(b, h) ((4 + (b) * 2 + (h)) * HTB)
#define PG8_STAGE2(bufoff, gbase, v0, v1) do { \
        __builtin_amdgcn_global_load_lds((const unsigned*)((const char*)(gbase) + (v0)), (LAS unsigned*)(lds + (bufoff) + ldsw), 16, 0, 0); \
        __builtin_amdgcn_global_load_lds((const unsigned*)((const char*)(gbase) + (v1)), (LAS unsigned*)(lds + (bufoff) + ldsw + 8192), 16, 0, 0); } while (0)
#define PG8_STAGEB(bufoff, gbase) PG8_STAGE2(bufoff, gbase, voffB[0], voffB[1])
#define PG8_STAGEA(bufoff, kptr, h, NX) do { if constexpr (GATHER) { const unsigned v0_ = (NX) ? gvn[h][0] : gvc[h][0], v1_ = (NX) ? gvn[h][1] : gvc[h][1]; PG8_STAGE2(bufoff, kptr, v0_, v1_); } \
        else { PG8_STAGE2(bufoff, (kptr) + (h) * hstepA, voffA[0], voffA[1]); } } while (0)
#define PG8_LDA(dst, b, h) do { _Pragma("unroll") for (int m = 0; m < 4; ++m) _Pragma("unroll") for (int k = 0; k < 2; ++k) dst[m][k] = *(const LAS bf16x8*)(lds + PG8_SA(b, h) + aoff + m * 2048 + k * KOFF); } while (0)
#define PG8_LDB(dst, b, h) do { _Pragma("unroll") for (int n = 0; n < 2; ++n) _Pragma("unroll") for (int k = 0; k < 2; ++k) dst[n][k] = *(const LAS bf16x8*)(lds + PG8_SB(b, h) + boff + n * 2048 + k * KOFF); } while (0)
#define PG8_CAT(x) __builtin_shufflevector(__builtin_bit_cast(f32x4, (x)[0]), __builtin_bit_cast(f32x4, (x)[1]), 0, 1, 2, 3, 4, 5, 6, 7)
#define PG8_MMA(ai, bj, At, Bt) do { __builtin_amdgcn_s_setprio(1); _Pragma("unroll") for (int m = 0; m < 4; ++m) _Pragma("unroll") for (int n = 0; n < 2; ++n) { \
        if constexpr (FP8) { acc[ai][bj][m][n] = __builtin_amdgcn_mfma_scale_f32_16x16x128_f8f6f4(__builtin_bit_cast(v8i32, PG8_CAT(Bt[n])), __builtin_bit_cast(v8i32, PG8_CAT(At[m])), acc[ai][bj][m][n], 0, 0, 0, 0x7F7F7F7F, 0, 0x7F7F7F7F); } \
        else { _Pragma("unroll") for (int k = 0; k < 2; ++k) acc[ai][bj][m][n] = __builtin_amdgcn_mfma_f32_16x16x32_bf16(Bt[n][k], At[m][k], acc[ai][bj][m][n], 0, 0, 0); } } \
        _Pragma("unroll") for (int m = 0; m < 4; ++m) _Pragma("unroll") for (int n = 0; n < 2; ++n) asm volatile("" : "+v"(acc[ai][bj][m][n]));     \
        __builtin_amdgcn_s_setprio(0); } while (0)
#define PG8_WAIT_V(n) asm volatile("s_waitcnt vmcnt(" #n ")" ::: "memory")
#define PG8_WAIT_L(n) asm volatile("s_waitcnt lgkmcnt(" #n ")" ::: "memory")
#define PG8_BAR __builtin_amdgcn_s_barrier()
#define PG8_SCHED __builtin_amdgcn_sched_barrier(0)
#define PG8_GATHER_OFFS(dst, u) do { _Pragma("unroll") for (int h_ = 0; h_ < 2; ++h_) _Pragma("unroll") for (int i_ = 0; i_ < 2; ++i_) { const int r_ = h_ * HALF + RA[i_]; \
        const int idx_ = (u).rows[r_ < (u).nvalid ? r_ : 0]; dst[h_][i_] = (unsigned)(idx_ * g.lda * ESZ + CA[i_] * 2); } } while (0)
    Unit cur, nxt; int ui = 0;
    if (!S.next(0, cur)) return;
    cur.seq = 0;
    unsigned gvc[2][2] = {{0u, 0u}, {0u, 0u}}, gvn[2][2] = {{0u, 0u}, {0u, 0u}};
    if constexpr (GATHER) { PG8_GATHER_OFFS(gvc, cur); }
    f32x4 acc[2][2][4][2];
#pragma unroll
    for (int a = 0; a < 2; ++a)
#pragma unroll
        for (int b = 0; b < 2; ++b)
#pragma unroll
            for (int m = 0; m < 4; ++m)
#pragma unroll
                for (int n = 0; n < 2; ++n) acc[a][b][m][n] = (f32x4){0.f, 0.f, 0.f, 0.f};
    bf16x8 At[4][2], B0[2][2], B1[2][2];
    const char* cA = cur.a; const char* cB = cur.b;
    PG8_STAGEB(PG8_SB(0, 0), cB); PG8_STAGEB(PG8_SB(0, 1), cB + hstepB); PG8_STAGEA(PG8_SA(0, 0), cA, 0, false); PG8_STAGEA(PG8_SA(0, 1), cA, 1, false);
    if (wr == 1) PG8_BAR;
    PG8_WAIT_V(2); PG8_BAR;
    PG8_STAGEB(PG8_SB(1, 0), cB + kstep); PG8_STAGEA(PG8_SA(1, 0), cA + kstep, 0, false); PG8_STAGEB(PG8_SB(1, 1), cB + hstepB + kstep);
    PG8_WAIT_V(6); PG8_BAR;
    for (;;) {
        const bool has_next = S.next(ui + 1, nxt); nxt.seq = ui + 1;
        const char* nA = has_next ? nxt.a : cA; const char* nB = has_next ? nxt.b : cB;
        if constexpr (GATHER) { if (has_next) { PG8_GATHER_OFFS(gvn, nxt); } else { gvn[0][0] = gvc[0][0]; gvn[0][1] = gvc[0][1]; gvn[1][0] = gvc[1][0]; gvn[1][1] = gvc[1][1]; } }
#pragma unroll 1
        for (int t = 0; t < nt; t += 2) {
            const bool last = (t == nt - 2);
            const char* a1 = cA + (size_t)(t + 1) * kstep;
            const char* a2 = last ? nA : cA + (size_t)(t + 2) * kstep; const char* b2 = last ? nB : cB + (size_t)(t + 2) * kstep;
            const char* a3 = a2 + kstep; const char* b3 = b2 + kstep;
            PG8_LDB(B0, 0, 0); PG8_LDB(B1, 0, 1); PG8_SCHED; PG8_LDA(At, 0, 0); PG8_STAGEA(PG8_SA(1, 1), a1, 1, false);
            PG8_WAIT_V(8); PG8_WAIT_L(0); PG8_BAR; PG8_MMA(0, 0, At, B0); PG8_MMA(0, 1, At, B1); PG8_BAR; PG8_SCHED;
            PG8_LDA(At, 0, 1); PG8_STAGEB(PG8_SB(0, 0), b2); PG8_STAGEB(PG8_SB(0, 1), b2 + hstepB); PG8_STAGEA(PG8_SA(0, 0), a2, 0, last);
            PG8_WAIT_V(8); PG8_WAIT_L(0); PG8_BAR; PG8_MMA(1, 0, At, B0); PG8_MMA(1, 1, At, B1); PG8_BAR; PG8_SCHED;
            PG8_LDB(B0, 1, 0); PG8_LDB(B1, 1, 1); PG8_SCHED; PG8_LDA(At, 1, 0); PG8_STAGEA(PG8_SA(0, 1), a2, 1, last);
            PG8_WAIT_V(8); PG8_WAIT_L(0); PG8_BAR; PG8_MMA(0, 0, At, B0); PG8_MMA(0, 1, At, B1); PG8_BAR; PG8_SCHED;
            PG8_LDA(At, 1, 1); PG8_STAGEB(PG8_SB(1, 0), b3); PG8_STAGEB(PG8_SB(1, 1), b3 + hstepB); PG8_STAGEA(PG8_SA(1, 0), a3, 0, last);
            PG8_WAIT_V(8); PG8_WAIT_L(0); PG8_BAR; PG8_MMA(1, 0, At, B0); PG8_MMA(1, 1, At, B1); PG8_BAR; PG8_SCHED;
            if constexpr (Epi::HAS_MID) { if (t == (nt >> 1) - 2) { int fr3 = fr, fq3 = fq; asm volatile("" : "+v"(fr3), "+v"(fq3)); E.mid(acc, cur, wr, wc, fr3, fq3); } }
        }
        if constexpr (ALIGN_EPI) { if (wr == 0) PG8_BAR; }
        { int fr2 = fr, fq2 = fq; asm volatile("" : "+v"(fr2), "+v"(fq2));
          E(acc, cur, wr, wc, fr2, fq2); }
        if (!has_next) break;
#pragma unroll
        for (int a = 0; a < 2; ++a)
#pragma unroll
            for (int b = 0; b < 2; ++b)
#pragma unroll
                for (int m = 0; m < 4; ++m)
#pragma unroll
                    for (int n = 0; n < 2; ++n) acc[a][b][m][n] = (f32x4){0.f, 0.f, 0.f, 0.f};
        cur = nxt; cA = nA; cB = nB; ++ui;
        if constexpr (GATHER) { gvc[0][0] = gvn[0][0]; gvc[0][1] = gvn[0][1]; gvc[1][0] = gvn[1][0]; gvc[1][1] = gvn[1][1]; }
        if constexpr (ALIGN_EPI) { if (wr == 1) PG8_BAR; }
    }
    PG8_WAIT_V(0);
    if constexpr (!ALIGN_EPI) { if (wr == 0) PG8_BAR; }
    PG8_BAR;
#undef PG8_SA
#undef PG8_SB
#undef PG8_STAGE2
#undef PG8_STAGEA
#undef PG8_STAGEB
#undef PG8_LDA
#undef PG8_LDB
#undef PG8_MMA
#undef PG8_CAT
#undef PG8_WAIT_V
#undef PG8_WAIT_L
#undef PG8_BAR
#undef PG8_SCHED
#undef PG8_GATHER_OFFS
}

#define EPI_ROW(u, ai, m) ((u).orow + (ai) * HALF + wr * 64 + (m) * 16 + fr)
#define EPI_COL(u, bj) ((u).ocol + (bj) * HALF + wc * 32 + 8 * fq)
struct EpiBf16 {
    static constexpr bool HAS_MID = false;
    bf16_t* O; int ldc; const float* rs; size_t stride; float sc0, sc3;
    unsigned* kn;
    const LAS float* rst;
    float mul;
    bool out8;
    __device__ __forceinline__ void operator()(const f32x4 (&acc)[2][2][4][2], const Unit& u, int wr, int wc, int fr, int fq) const {
        bf16_t* base = O + (size_t)u.aux * stride;
        const float sc = ((u.aux == 0) ? sc0 : ((u.aux == 3) ? sc3 : 1.f)) * mul;
        float nmax[2] = {0.f, 0.f}; const bool dokn = kn && u.aux == 1;
#pragma unroll
        for (int ai = 0; ai < 2; ++ai)
#pragma unroll
            for (int m = 0; m < 4; ++m) { const int row = EPI_ROW(u, ai, m); const float s = (rst ? rst[u.seq * 256 + ai * HALF + wr * 64 + m * 16 + fr] : (rs ? rs[row] : 1.f)) * sc;
#pragma unroll
                for (int bj = 0; bj < 2; ++bj) { const f32x4 v0 = acc[ai][bj][m][0] * s, v1 = acc[ai][bj][m][1] * s;
                    if (out8) { u32x2 w8; w8.x = cvt4_fp8(v0[0], v0[1], v0[2], v0[3]); w8.y = cvt4_fp8(v1[0], v1[1], v1[2], v1[3]); *(u32x2*)((unsigned char*)base + (size_t)row * ldc + EPI_COL(u, bj)) = w8; }
                    else { u32x4 w; w.x = cvt_pk_bf16(v0[0], v0[1]); w.y = cvt_pk_bf16(v0[2], v0[3]); w.z = cvt_pk_bf16(v1[0], v1[1]); w.w = cvt_pk_bf16(v1[2], v1[3]);
                    *(u32x4*)(base + (size_t)row * ldc + EPI_COL(u, bj)) = w; }
                    if (dokn) { float q = (v0[0] * v0[0] + v0[1] * v0[1]) + (v0[2] * v0[2] + v0[3] * v0[3]) + (v1[0] * v1[0] + v1[1] * v1[1]) + (v1[2] * v1[2] + v1[3] * v1[3]);
                        q += __shfl_xor(q, 16); q += __shfl_xor(q, 32); nmax[bj] = fmaxf(nmax[bj], q); } } }
        if (dokn) {
#pragma unroll
            for (int bj = 0; bj < 2; ++bj) { float q = nmax[bj]; q = fmaxf(q, __shfl_xor(q, 1)); q = fmaxf(q, __shfl_xor(q, 2)); q = fmaxf(q, __shfl_xor(q, 4)); q = fmaxf(q, __shfl_xor(q, 8));
                const int head = ((u.ocol + bj * HALF) >> 6) + (wc >> 1), bt = u.orow / SEQ;
                if ((fr | fq) == 0) atomicMax(kn + ((bt * NH + head) * 2 + (wc & 1)), __float_as_uint(q)); }
        }
    }
};
struct EpiResid {
    static constexpr bool HAS_MID = false;
    const float* res; float* out; bf16_t* hb; float* ssq;
    __device__ __forceinline__ void operator()(const f32x4 (&acc)[2][2][4][2], const Unit& u, int wr, int wc, int fr, int fq) const {
#pragma unroll
        for (int ai = 0; ai < 2; ++ai)
#pragma unroll
            for (int m = 0; m < 4; ++m) { const int row = EPI_ROW(u, ai, m); float q = 0.f;
#pragma unroll
                for (int bj = 0; bj < 2; ++bj) { const size_t off = (size_t)row * DM + EPI_COL(u, bj);
                    const f32x4 r0 = *(const f32x4*)(res + off), r1 = *(const f32x4*)(res + off + 4);
                    const f32x4 v0 = acc[ai][bj][m][0] + r0, v1 = acc[ai][bj][m][1] + r1;
                    *(f32x4*)(out + off) = v0; *(f32x4*)(out + off + 4) = v1;
                    q += (v0[0] * v0[0] + v0[1] * v0[1]) + (v0[2] * v0[2] + v0[3] * v0[3]) + (v1[0] * v1[0] + v1[1] * v1[1]) + (v1[2] * v1[2] + v1[3] * v1[3]);
                    if (hb) { u32x4 w; w.x = cvt_pk_bf16(v0[0], v0[1]); w.y = cvt_pk_bf16(v0[2], v0[3]); w.z = cvt_pk_bf16(v1[0], v1[1]); w.w = cvt_pk_bf16(v1[2], v1[3]); *(u32x4*)(hb + off) = w; } }
                if (ssq) { q += __shfl_xor(q, 16); q += __shfl_xor(q, 32); if (fq == 0) ssq[(size_t)row * 16 + (u.ocol >> 8) * 4 + wc] = q; } }
    }
};
struct EpiOutProj {
    static constexpr bool HAS_MID = true;
    const bf16_t* xb; bf16_t* hb; unsigned char* h8; float* ssq; const LAS f32x2* rab;
    __device__ __forceinline__ void mid(f32x4 (&acc)[2][2][4][2], const Unit& u, int wr, int wc, int fr, int fq) const {
#pragma unroll
        for (int ai = 0; ai < 2; ++ai)
#pragma unroll
            for (int m = 0; m < 4; ++m) { const float f = rab[u.seq * 256 + ai * HALF + wr * 64 + m * 16 + fr].x;
#pragma unroll
                for (int bj = 0; bj < 2; ++bj) { acc[ai][bj][m][0] *= f; acc[ai][bj][m][1] *= f; } }
    }
    __device__ __forceinline__ void operator()(const f32x4 (&acc)[2][2][4][2], const Unit& u, int wr, int wc, int fr, int fq) const {
        u32x4 xres[2][4][2];
#pragma unroll
        for (int ai = 0; ai < 2; ++ai)
#pragma unroll
            for (int m = 0; m < 4; ++m)
#pragma unroll
                for (int bj = 0; bj < 2; ++bj) xres[ai][m][bj] = *(const u32x4*)(xb + (size_t)EPI_ROW(u, ai, m) * DM + EPI_COL(u, bj));
        asm volatile("" ::: "memory");
#pragma unroll
        for (int ai = 0; ai < 2; ++ai)
#pragma unroll
            for (int m = 0; m < 4; ++m) { const int row = EPI_ROW(u, ai, m); const float rb = rab[u.seq * 256 + ai * HALF + wr * 64 + m * 16 + fr].y; float q = 0.f;
#pragma unroll
                for (int bj = 0; bj < 2; ++bj) { const size_t off = (size_t)row * DM + EPI_COL(u, bj);
                    const u32x4 xr = xres[ai][m][bj];
                    f32x4 v0 = acc[ai][bj][m][0] * rb, v1 = acc[ai][bj][m][1] * rb;
                    v0[0] += bf16lo(xr.x); v0[1] += bf16hi(xr.x); v0[2] += bf16lo(xr.y); v0[3] += bf16hi(xr.y); v1[0] += bf16lo(xr.z); v1[1] += bf16hi(xr.z); v1[2] += bf16lo(xr.w); v1[3] += bf16hi(xr.w);
                    q += (v0[0] * v0[0] + v0[1] * v0[1]) + (v0[2] * v0[2] + v0[3] * v0[3]) + (v1[0] * v1[0] + v1[1] * v1[1]) + (v1[2] * v1[2] + v1[3] * v1[3]);
                    u32x4 w; w.x = cvt_pk_bf16(v0[0], v0[1]); w.y = cvt_pk_bf16(v0[2], v0[3]); w.z = cvt_pk_bf16(v1[0], v1[1]); w.w = cvt_pk_bf16(v1[2], v1[3]); *(u32x4*)(hb + off) = w;
                    { u32x2 w8; w8.x = cvt4_fp8(v0[0], v0[1], v0[2], v0[3]); w8.y = cvt4_fp8(v1[0], v1[1], v1[2], v1[3]); *(u32x2*)(h8 + off) = w8; } }
                q += __shfl_xor(q, 16); q += __shfl_xor(q, 32); if (fq == 0) ssq[(size_t)row * 16 + (u.ocol >> 8) * 4 + wc] = q; }
    }
};
struct EpiResidBf16 {
    static constexpr bool HAS_MID = false;
    bf16_t* hb; unsigned char* h8; float mul;
    __device__ __forceinline__ void operator()(const f32x4 (&acc)[2][2][4][2], const Unit& u, int wr, int wc, int fr, int fq) const {
#pragma unroll
        for (int ai = 0; ai < 2; ++ai) {
        u32x4 xres[4][2];
#pragma unroll
            for (int m = 0; m < 4; ++m)
#pragma unroll
                for (int bj = 0; bj < 2; ++bj) xres[m][bj] = *(const u32x4*)(hb + (size_t)EPI_ROW(u, ai, m) * DM + EPI_COL(u, bj));
        asm volatile("" ::: "memory");
#pragma unroll
            for (int m = 0; m < 4; ++m) { const int row = EPI_ROW(u, ai, m);
#pragma unroll
                for (int bj = 0; bj < 2; ++bj) { const size_t off = (size_t)row * DM + EPI_COL(u, bj);
                    const u32x4 xr = xres[m][bj];
                    f32x4 v0 = acc[ai][bj][m][0] * mul, v1 = acc[ai][bj][m][1] * mul;
                    v0[0] += bf16lo(xr.x); v0[1] += bf16hi(xr.x); v0[2] += bf16lo(xr.y); v0[3] += bf16hi(xr.y); v1[0] += bf16lo(xr.z); v1[1] += bf16hi(xr.z); v1[2] += bf16lo(xr.w); v1[3] += bf16hi(xr.w);
                    u32x4 w; w.x = cvt_pk_bf16(v0[0], v0[1]); w.y = cvt_pk_bf16(v0[2], v0[3]); w.z = cvt_pk_bf16(v1[0], v1[1]); w.w = cvt_pk_bf16(v1[2], v1[3]); *(u32x4*)(hb + off) = w;
                    if (h8) { u32x2 w8; w8.x = cvt4_fp8(v0[0], v0[1], v0[2], v0[3]); w8.y = cvt4_fp8(v1[0], v1[1], v1[2], v1[3]); *(u32x2*)(h8 + off) = w8; } } }
        asm volatile("" ::: "memory"); }
    }
};
struct EpiSoftmax {
    static constexpr bool HAS_MID = false;
    bf16_t* P; const LAS float* r1t; LAS float* red;
    __device__ __forceinline__ void operator()(f32x4 (&acc)[2][2][4][2], const Unit& u, int wr, int wc, int fr, int fq) const {
#pragma unroll
        for (int ai = 0; ai < 2; ++ai)
#pragma unroll
            for (int m = 0; m < 4; ++m) { const float r1 = r1t[u.seq * 256 + ai * HALF + wr * 64 + m * 16 + fr]; float a = -3.0e38f;
#pragma unroll
                for (int bj = 0; bj < 2; ++bj)
#pragma unroll
                    for (int n = 0; n < 2; ++n) { f32x4 v = acc[ai][bj][m][n] * r1; acc[ai][bj][m][n] = v; a = fmaxf(a, fmaxf(fmaxf(v[0], v[1]), fmaxf(v[2], v[3]))); }
                a = fmaxf(a, __shfl_xor(a, 16)); a = fmaxf(a, __shfl_xor(a, 32));
                if (fq == 0) red[(ai * HALF + wr * 64 + m * 16 + fr) * 4 + wc] = a; asm volatile("" ::: "memory"); }
        LDS_WAIT(); __builtin_amdgcn_s_barrier(); asm volatile("" ::: "memory");
#pragma unroll
        for (int ai = 0; ai < 2; ++ai)
#pragma unroll
            for (int m = 0; m < 4; ++m) { const int rl = ai * HALF + wr * 64 + m * 16 + fr; const f32x4 mm = *(const LAS f32x4*)(red + rl * 4);
                const float a = fmaxf(fmaxf(mm[0], mm[1]), fmaxf(mm[2], mm[3])); float s = 0.f;
#pragma unroll
                for (int bj = 0; bj < 2; ++bj)
#pragma unroll
                    for (int n = 0; n < 2; ++n) { f32x4 v = acc[ai][bj][m][n];
                        v[0] = __builtin_amdgcn_exp2f(v[0] - a); v[1] = __builtin_amdgcn_exp2f(v[1] - a); v[2] = __builtin_amdgcn_exp2f(v[2] - a); v[3] = __builtin_amdgcn_exp2f(v[3] - a);
                        acc[ai][bj][m][n] = v; s += (v[0] + v[1]) + (v[2] + v[3]); }
                s += __shfl_xor(s, 16); s += __shfl_xor(s, 32);
                if (fq == 0) red[1024 + rl * 4 + wc] = s; }
        LDS_WAIT(); __builtin_amdgcn_s_barrier(); asm volatile("" ::: "memory");
#pragma unroll
        for (int ai = 0; ai < 2; ++ai)
#pragma unroll
            for (int m = 0; m < 4; ++m) { const int rl = ai * HALF + wr * 64 + m * 16 + fr; const int row = u.orow + rl; const f32x4 ss = *(const LAS f32x4*)(red + 1024 + rl * 4);
                const float inv = P_SCALE / ((ss[0] + ss[1]) + (ss[2] + ss[3]));
#pragma unroll
                for (int bj = 0; bj < 2; ++bj) { const f32x4 v0 = acc[ai][bj][m][0] * inv, v1 = acc[ai][bj][m][1] * inv;
                    u32x2 w8; w8.x = cvt4_fp8(v0[0], v0[1], v0[2], v0[3]); w8.y = cvt4_fp8(v1[0], v1[1], v1[2], v1[3]);
                    *(u32x2*)((unsigned char*)P + (size_t)row * DM + EPI_COL(u, bj)) = w8; } }
    }
};
struct EpiSwiglu {
    static constexpr bool HAS_MID = false;
    bf16_t* Hd; const float* r2s; const int* listbase;
    __device__ __forceinline__ void operator()(const f32x4 (&acc)[2][2][4][2], const Unit& u, int wr, int wc, int fr, int fq) const {
#pragma unroll
        for (int ai = 0; ai < 2; ++ai)
#pragma unroll
            for (int m = 0; m < 4; ++m) { const int rl = ai * HALF + wr * 64 + m * 16 + fr, row = u.orow + rl; const float rs = r2s[(u.rows - listbase) + (rl < u.nvalid ? rl : 0)] * (1.0f / WGU_SCALE); float h[8];
#pragma unroll
                for (int n = 0; n < 2; ++n)
#pragma unroll
                    for (int e = 0; e < 4; ++e) { const float gt = acc[ai][0][m][n][e] * rs, up = acc[ai][1][m][n][e] * rs;
                        h[n * 4 + e] = gt * __builtin_amdgcn_rcpf(1.0f + __builtin_amdgcn_exp2f(-gt * LOG2E)) * up; }
                u32x2 w; w.x = cvt4_fp8(h[0], h[1], h[2], h[3]); w.y = cvt4_fp8(h[4], h[5], h[6], h[7]);
                *(u32x2*)((unsigned char*)Hd + (size_t)row * DFF + u.ocol + wc * 32 + 8 * fq) = w; }
    }
};
}

namespace att {
constexpr int QB = 256, KVBLK = 64, PITCH = HW, OPITCH = DM;
constexpr int SLOTB = 8192, LDS_K = 0, LDS_V = 2 * SLOTB, LDS_WS = 4 * SLOTB, LDS_OST = LDS_WS + NWAVES * 256, LDS_FLAG = LDS_OST + NWAVES * 4096, LDS_END = LDS_FLAG + 64;
static_assert(LDS_END <= RING_BYTES, "attention LDS");
__device__ __forceinline__ int crow(int r, int hi) { return (r & 3) + 8 * (r >> 2) + 4 * hi; }
__device__ __forceinline__ void glds16(const void* gsrc, unsigned lds_dst) { unsigned keep;
    asm volatile("s_mov_b32 %0, m0\n\ts_mov_b32 m0, %2\n\ts_nop 0\n\tglobal_load_lds_dwordx4 %1, off\n\ts_mov_b32 m0, %0" : "=&s"(keep) : "v"(gsrc), "s"(lds_dst) : "memory"); }
__device__ __forceinline__ void glds16s(const void* sbase, unsigned voff, unsigned lds_dst) { unsigned keep;
    asm volatile("s_mov_b32 %0, m0\n\ts_mov_b32 m0, %3\n\ts_nop 0\n\tglobal_load_lds_dwordx4 %1, %2\n\ts_mov_b32 m0, %0" : "=&s"(keep) : "v"(voff), "s"(sbase), "s"(lds_dst) : "memory"); }
#define ATT_WAIT_BAR0() asm volatile("s_waitcnt vmcnt(0) lgkmcnt(0)\n\ts_barrier" ::: "memory")
#define MFMA32(a, b, c) __builtin_amdgcn_mfma_f32_32x32x16_bf16(a, b, c, 0, 0, 0)
__device__ __forceinline__ void store_row_ssq(u32x4 v, float* dst, int ch) {
    float q = (bf16lo(v.x) * bf16lo(v.x) + bf16hi(v.x) * bf16hi(v.x)) + (bf16lo(v.y) * bf16lo(v.y) + bf16hi(v.y) * bf16hi(v.y)) + (bf16lo(v.z) * bf16lo(v.z) + bf16hi(v.z) * bf16hi(v.z)) + (bf16lo(v.w) * bf16lo(v.w) + bf16hi(v.w) * bf16hi(v.w));
    q += __shfl_xor(q, 1); q += __shfl_xor(q, 2); q += __shfl_xor(q, 4);
    if (ch == 0) *dst = q;
}
__device__ __forceinline__ void qkt(f32x16& p0, f32x16& p1, const LAS char* Kslot, const bf16x8* qr, const f32x16& cin, int r32, int hi) {
    const LAS char* kb = Kslot + hi * 1024 + r32 * 16;
#pragma unroll
    for (int d0 = 0; d0 < 4; ++d0) {
        const bf16x8 b0 = *(const LAS bf16x8*)(kb + d0 * 2048);
        const bf16x8 b1 = *(const LAS bf16x8*)(kb + d0 * 2048 + 512);
        if (d0 == 0) { p0 = MFMA32(b0, qr[0], cin); p1 = MFMA32(b1, qr[0], cin); }
        else { p0 = MFMA32(b0, qr[d0], p0); p1 = MFMA32(b1, qr[d0], p1); } }
}
__device__ __forceinline__ void pv(f32x16* o, int vb, bf16x8 pa0, bf16x8 pa1, bf16x8 pa2, bf16x8 pa3) {
#pragma unroll
    for (int d0 = 0; d0 < 2; ++d0) { s16x4 lo[4], hi[4];
#pragma unroll
        for (int ks = 0; ks < 4; ++ks) {
            asm volatile("ds_read_b64_tr_b16 %0,%1 offset:%c2" : "=&v"(lo[ks]) : "v"(vb), "i"(d0 * 4096 + ks * 1024) : "memory");
            asm volatile("ds_read_b64_tr_b16 %0,%1 offset:%c2" : "=&v"(hi[ks]) : "v"(vb), "i"(d0 * 4096 + ks * 1024 + 512) : "memory"); }
        asm volatile("s_waitcnt lgkmcnt(0)" ::: "memory"); __builtin_amdgcn_sched_barrier(0);
#define PK(k) (bf16x8){lo[k][0], lo[k][1], lo[k][2], lo[k][3], hi[k][0], hi[k][1], hi[k][2], hi[k][3]}
        o[d0] = MFMA32(pa0, PK(0), o[d0]); o[d0] = MFMA32(pa1, PK(1), o[d0]); o[d0] = MFMA32(pa2, PK(2), o[d0]); o[d0] = MFMA32(pa3, PK(3), o[d0]);
#undef PK
    }
}
__device__ __forceinline__ float swap_lo(float x) { auto rr = __builtin_amdgcn_permlane32_swap(__float_as_uint(x), __float_as_uint(x), false, false); return __uint_as_float(rr[0]); }
__device__ __forceinline__ float swap_hi(float x) { auto rr = __builtin_amdgcn_permlane32_swap(__float_as_uint(x), __float_as_uint(x), false, false); return __uint_as_float(rr[1]); }

template <int MODE> __device__ __forceinline__ void attn_unit(int b, int h, int qb, const bf16_t* Q, const bf16_t* K, const bf16_t* V, bf16_t* O, float* hs, const float* cb, LAS char* shm) {
    int tid = threadIdx.x; asm volatile("" : "+v"(tid)); const int lane = tid & 63, r32 = lane & 31, hi = lane >> 5; const int wid = __builtin_amdgcn_readfirstlane(tid >> 6);
    const long rowbase = (long)b * SEQ; const int q0 = qb * QB;
    const bf16_t* Qw = Q + (rowbase + q0 + wid * 32) * PITCH + h * HD;
    const bf16_t* Kh = K + rowbase * PITCH + h * HD; const bf16_t* Vh = V + rowbase * PITCH + h * HD;
    const unsigned lds0 = (unsigned)(uintptr_t)shm;
    LAS float* wsf = (LAS float*)(shm + LDS_WS) + wid * 64;
    LAS unsigned* flags = (LAS unsigned*)(shm + LDS_FLAG);
    const bf16_t* ksrc = Kh + (long)lane * PITCH + wid * 8;
    const bf16_t* vsrc = Vh + (long)(16 * (wid & 3) + (lane >> 2)) * PITCH + (wid >> 2) * 32 + (lane & 3) * 8;
    const unsigned kdst = lds0 + LDS_K + wid * 1024, vdst = lds0 + LDS_V + wid * 1024;
#define DMA_KV(t, slot) do { glds16(ksrc + (long)(t) * KVBLK * PITCH, (unsigned)__builtin_amdgcn_readfirstlane(kdst + (slot))); glds16(vsrc + (long)(t) * KVBLK * PITCH, (unsigned)__builtin_amdgcn_readfirstlane(vdst + (slot))); } while (0)
    const int vb0 = (int)(lds0 + LDS_V) + ((lane >> 4) & 1) * 32 + (lane & 3) * 8 + (4 * hi + ((lane & 15) >> 2)) * 64;
    const int NT = (q0 + QB) / KVBLK;
    DMA_KV(NT - 1, 0);
    bf16x8 qr[4];
#pragma unroll
    for (int d0 = 0; d0 < 4; ++d0) qr[d0] = *(const bf16x8*)(Qw + (long)r32 * PITCH + d0 * 16 + hi * 8);
    f32x16 o[2]; o[0] = f32x16{}; o[1] = f32x16{};
    const int qrel = wid * 32 + r32;
    float m_run = -1.0e30f, l_run = 0.f, R = 0.f, ct = 0.f;
    if (MODE == 0) ct = cb[q0 + qrel];
    bf16x8 TD0, TD1, TONE;
#pragma unroll
    for (int j = 0; j < 8; ++j) { const int kvl = 8 * (j >> 2) + 4 * hi + (j & 3); TD0[j] = (kvl >= r32) ? (short)0x3F80 : (short)0; TD1[j] = (16 + kvl >= r32) ? (short)0x3F80 : (short)0; TONE[j] = (short)0x3F80; }
    f32x16 zero16 = f32x16{};
    for (int i = 0; i < NT; ++i) {
        const int t = NT - 1 - i, slot = (i & 1) * SLOTB;
        ATT_WAIT_BAR0();
        if (MODE == 1 && i > 0) {
            const LAS unsigned* fl = flags + ((i - 1) & 1) * 8; unsigned all = 1u;
#pragma unroll
            for (int w = 0; w < 8; ++w) all &= fl[w];
            if (__builtin_amdgcn_readfirstlane(all)) break;
        }
        if (t > 0) DMA_KV(t - 1, slot ^ SLOTB);
        const int jb = t - (NT - 4);
        const bool active = !(jb >= 0 && 2 * jb > wid);
        bool wave_done = false;
        if (MODE == 1) wave_done = __all(R < SB_EXIT);
        if (active && !(MODE == 1 && wave_done)) {
            f32x16 p0, p1;
            qkt(p0, p1, shm + LDS_K + slot, qr, zero16, r32, hi);
            if (MODE == 0) {
                const float* cbt = cb + t * KVBLK + 4 * hi;
#pragma unroll
                for (int g = 0; g < 4; ++g) { const f32x4 c0 = *(const f32x4*)(cbt + 8 * g), c1 = *(const f32x4*)(cbt + 32 + 8 * g);
#pragma unroll
                    for (int e = 0; e < 4; ++e) { p0[4 * g + e] += ct - c0[e]; p1[4 * g + e] += ct - c1[e]; } }
                if (jb >= 0) {
#pragma unroll
                    for (int r = 0; r < 16; ++r) { const int kv = 64 * jb + crow(r, hi); if (kv > qrel) p0[r] = -1.0e30f; if (kv + 32 > qrel) p1[r] = -1.0e30f; } }
                float a = fmaxf(p0[0], p1[0]);
#pragma unroll
                for (int r = 1; r < 16; ++r) a = fmaxf(a, fmaxf(p0[r], p1[r]));
                a = fmaxf(swap_lo(a), swap_hi(a));
                const float m_new = fmaxf(m_run, a), alpha = __builtin_amdgcn_exp2f(m_run - m_new); m_run = m_new;
                float s = 0.f;
#pragma unroll
                for (int r = 0; r < 16; ++r) { p0[r] = __builtin_amdgcn_exp2f(p0[r] - m_new); p1[r] = __builtin_amdgcn_exp2f(p1[r] - m_new); s += p0[r] + p1[r]; }
                l_run = l_run * alpha + s;
                if (hi == 0) wsf[r32] = alpha;
                LDS_WAIT();
#pragma unroll
                for (int r = 0; r < 16; ++r) { const float f = wsf[crow(r, hi)]; o[0][r] *= f; o[1][r] *= f; }
                LDS_WAIT();
            } else {
                if (jb >= 0) {
#pragma unroll
                    for (int r = 0; r < 16; ++r) { const int kv = 64 * jb + crow(r, hi); if (kv >= qrel) p0[r] = -1.0e30f; if (kv + 32 >= qrel) p1[r] = -1.0e30f; } }
                f32x16 l0, l1;
#pragma unroll
                for (int r = 0; r < 16; ++r) {
                    l0[r] = -(fmaxf(p0[r], 0.f) + __builtin_amdgcn_logf(1.0f + __builtin_amdgcn_exp2f(-fabsf(p0[r]))));
                    l1[r] = -(fmaxf(p1[r], 0.f) + __builtin_amdgcn_logf(1.0f + __builtin_amdgcn_exp2f(-fabsf(p1[r])))); }
                u32x4 lw0 = {cvt_pk_bf16(l0[0], l0[1]), cvt_pk_bf16(l0[2], l0[3]), cvt_pk_bf16(l0[4], l0[5]), cvt_pk_bf16(l0[6], l0[7])};
                u32x4 lw1 = {cvt_pk_bf16(l0[8], l0[9]), cvt_pk_bf16(l0[10], l0[11]), cvt_pk_bf16(l0[12], l0[13]), cvt_pk_bf16(l0[14], l0[15])};
                u32x4 lw2 = {cvt_pk_bf16(l1[0], l1[1]), cvt_pk_bf16(l1[2], l1[3]), cvt_pk_bf16(l1[4], l1[5]), cvt_pk_bf16(l1[6], l1[7])};
                u32x4 lw3 = {cvt_pk_bf16(l1[8], l1[9]), cvt_pk_bf16(l1[10], l1[11]), cvt_pk_bf16(l1[12], l1[13]), cvt_pk_bf16(l1[14], l1[15])};
                f32x16 rt;
#pragma unroll
                for (int r = 0; r < 16; ++r) rt[r] = R;
                f32x16 t0 = MFMA32(TD0, __builtin_bit_cast(bf16x8, lw0), rt); t0 = MFMA32(TD1, __builtin_bit_cast(bf16x8, lw1), t0);
                t0 = MFMA32(TONE, __builtin_bit_cast(bf16x8, lw2), t0); t0 = MFMA32(TONE, __builtin_bit_cast(bf16x8, lw3), t0);
                f32x16 t1 = MFMA32(TD0, __builtin_bit_cast(bf16x8, lw2), rt); t1 = MFMA32(TD1, __builtin_bit_cast(bf16x8, lw3), t1);
#pragma unroll
                for (int r = 0; r < 16; ++r) { p0[r] = __builtin_amdgcn_exp2f(p0[r] + t0[r]); p1[r] = __builtin_amdgcn_exp2f(p1[r] + t1[r]); }
                R = swap_lo(t0[0]);
            }
            u32x4 pw0 = {cvt_pk_bf16(p0[0], p0[1]), cvt_pk_bf16(p0[2], p0[3]), cvt_pk_bf16(p0[4], p0[5]), cvt_pk_bf16(p0[6], p0[7])};
            u32x4 pw1 = {cvt_pk_bf16(p0[8], p0[9]), cvt_pk_bf16(p0[10], p0[11]), cvt_pk_bf16(p0[12], p0[13]), cvt_pk_bf16(p0[14], p0[15])};
            u32x4 pw2 = {cvt_pk_bf16(p1[0], p1[1]), cvt_pk_bf16(p1[2], p1[3]), cvt_pk_bf16(p1[4], p1[5]), cvt_pk_bf16(p1[6], p1[7])};
            u32x4 pw3 = {cvt_pk_bf16(p1[8], p1[9]), cvt_pk_bf16(p1[10], p1[11]), cvt_pk_bf16(p1[12], p1[13]), cvt_pk_bf16(p1[14], p1[15])};
            pv(o, vb0 + slot, __builtin_bit_cast(bf16x8, pw0), __builtin_bit_cast(bf16x8, pw1), __builtin_bit_cast(bf16x8, pw2), __builtin_bit_cast(bf16x8, pw3));
        }
        if (MODE == 1) { const bool dn = __all(R < SB_EXIT); if (lane == 0) flags[(i & 1) * 8 + wid] = dn ? 1u : 0u; }
    }
    float linv = 1.f;
    if (MODE == 0) { const float lt = swap_lo(l_run) + swap_hi(l_run); linv = 1.0f / lt; }
    if (hi == 0) wsf[32 + r32] = linv;
    LDS_WAIT();
    bf16_t* Ow = O + (rowbase + q0 + wid * 32) * OPITCH + h * HD;
    { LAS bf16_t* stg = (LAS bf16_t*)(shm + LDS_OST) + wid * 2048;
#pragma unroll
      for (int r = 0; r < 16; ++r) { const int orow = crow(r, hi); const float f = wsf[32 + orow];
#pragma unroll
        for (int d0 = 0; d0 < 2; ++d0) { const unsigned pk = cvt_pk_bf16(o[d0][r] * f, 0.f); stg[orow * 64 + d0 * 32 + r32] = (bf16_t)(pk & 0xffffu); } }
      LDS_WAIT();
#pragma unroll
      for (int i = 0; i < 4; ++i) { const int row = i * 8 + (lane >> 3), ch = lane & 7; const u32x4 v = *(const LAS u32x4*)(stg + row * 64 + ch * 8); *(u32x4*)(Ow + (long)row * OPITCH + ch * 8) = v;
        store_row_ssq(v, hs + (rowbase + q0 + wid * 32 + row) * 16, ch); } }
    asm volatile("s_waitcnt vmcnt(0) lgkmcnt(0)\n\ts_barrier" ::: "memory");
#undef DMA_KV
}
}


namespace fox {
constexpr int QB = 256, KVBLK = 64, PITCH = HW, OPITCH = DM;
constexpr int NSLOT = 3, SLOTB = 9216;
constexpr int LDS_K = 0, LDS_V = NSLOT * SLOTB, LDS_WS = 2 * NSLOT * SLOTB, LDS_OST = LDS_WS + NWAVES * 256, LDS_CL = LDS_OST + NWAVES * 4096, LDS_VOTE = LDS_CL + 512, LDS_END = LDS_VOTE + 32;
static_assert(LDS_END <= RING_BYTES, "fox LDS");
constexpr float WIN_T = 48.0f;
constexpr float FLOOR = -256.0f;
using att::crow; using att::glds16; using att::glds16s;
typedef __attribute__((address_space(3))) const char* lds_cptr;
typedef short v4i16_t __attribute__((ext_vector_type(4)));
#define SBAR() __builtin_amdgcn_sched_barrier(0)
#define WAIT_BAR(N) asm volatile("s_waitcnt vmcnt(" #N ") lgkmcnt(0)\n\ts_barrier" ::: "memory")
__device__ __forceinline__ s16x4 vtr(lds_cptr p) { return __builtin_bit_cast(s16x4, __builtin_amdgcn_ds_read_tr16_b64_v4i16((__attribute__((address_space(3))) v4i16_t*)p)); }
__device__ __forceinline__ void kload2(bf16x8* kf, lds_cptr kp, int j) { kf[2 * j] = *(const LAS bf16x8*)(kp + j * 2048); kf[2 * j + 1] = *(const LAS bf16x8*)(kp + j * 2048 + 512); }
__device__ __forceinline__ void cmask(f32x16& p0, f32x16& p1, int jb, int qrel, int hi) {
    const float NEG = -INFINITY; const int kb = 64 * jb + 4 * hi;
#pragma unroll
    for (int r = 0; r < 16; ++r) { const int kv = kb + (r & 3) + 8 * (r >> 2); if (kv > qrel) p0[r] = NEG; if (kv + 32 > qrel) p1[r] = NEG; }
}
__device__ __forceinline__ void split3(float x, unsigned& hm, unsigned& lo) {
    const unsigned h = cvt_pk_bf16(x, 0.f) & 0xffffu; const float r1 = x - __uint_as_float(h << 16);
    const unsigned m = cvt_pk_bf16(r1, 0.f) & 0xffffu; const float r2 = r1 - __uint_as_float(m << 16);
    hm = h | (m << 16); lo = cvt_pk_bf16(r2, 0.f) & 0xffffu;
}
__device__ __forceinline__ bf16x8 qx_build(float a, int hi) {
    unsigned hm, lo; split3(a, hm, lo);
    u32x4 w; w.x = hm; w.y = lo | 0x3F800000u; w.z = 0x3F803F80u; w.w = 0u;
    if (hi) { w.x = 0u; w.y = 0u; w.z = 0u; }
    return __builtin_bit_cast(bf16x8, w);
}

template <int THRL> __device__ __forceinline__ void fox_unit(int bh, int qb, const bf16_t* Q, const bf16_t* K, const bf16_t* V, bf16_t* O, float* hs, const float* cb, const bf16_t* KXall, float kmax, LAS char* shm, bool pre, int nbh, int nqb) {
    const bf16_t* KXh = KXall + (size_t)bh * SEQ * 8;
    int tid = threadIdx.x; asm volatile("" : "+v"(tid)); const int lane = tid & 63, r32 = lane & 31, hi = lane >> 5; const int wid = __builtin_amdgcn_readfirstlane(tid >> 6);
    const int b = bh >> 3, h = bh & 7; const long rowbase = (long)b * SEQ; const int q0 = qb * QB;
    const bf16_t* Qw = Q + (rowbase + q0 + wid * 32) * PITCH + h * HD;
    const bf16_t* Kh = K + rowbase * PITCH + h * HD; const bf16_t* Vh = V + rowbase * PITCH + h * HD;
    const unsigned lds0 = (unsigned)(uintptr_t)shm;
    LAS float* wsf = (LAS float*)(shm + LDS_WS) + wid * 64;
    const int NT = (q0 + QB) / KVBLK;
    int NTe = NT;
    LAS float* clt = (LAS float*)(shm + LDS_CL); LAS unsigned* votes = (LAS unsigned*)(shm + LDS_VOTE);
    const float clv = (tid < NT) ? cb[64 * tid + 63] : 0.f;
    const unsigned koff = (unsigned)(lane * PITCH + wid * 8) * 2u, voff = (unsigned)((16 * (wid & 3) + (lane >> 2)) * PITCH + (wid >> 2) * 32 + (lane & 3) * 8) * 2u, xoff = (unsigned)lane * 16u;
    const unsigned kdst = lds0 + LDS_K + wid * 1024, vdst = lds0 + LDS_V + wid * 1024, xdst = lds0 + LDS_K + 8192;
    const bool xl = (lane >> 3) == wid;
#define DMA_KX(Kb, KXb, NTv, p, slot) do { glds16s((Kb) + (long)((NTv) - 1 - (p)) * KVBLK * PITCH, koff, (unsigned)__builtin_amdgcn_readfirstlane(kdst + (slot))); \
        if (xl) glds16s((KXb) + (long)((NTv) - 1 - (p)) * KVBLK * 8, xoff, (unsigned)__builtin_amdgcn_readfirstlane(xdst + (slot))); } while (0)
#define DMA_VX(Vb, NTv, p, slot) glds16s((Vb) + (long)((NTv) - 1 - (p)) * KVBLK * PITCH, voff, (unsigned)__builtin_amdgcn_readfirstlane(vdst + (slot)))
#define DMA_K(p, slot) DMA_KX(Kh, KXh, NT, p, slot)
#define DMA_V(p, slot) DMA_VX(Vh, NT, p, slot)
    bf16x8 kf[10];
    const lds_cptr shm3 = (lds_cptr)shm; const lds_cptr kp0 = shm3 + LDS_K + hi * 1024 + r32 * 16; const lds_cptr kx0 = shm3 + LDS_K + 8192 + r32 * 16;
    const lds_cptr vp0 = shm3 + LDS_V + ((lane >> 4) & 1) * 32 + (lane & 3) * 8 + (4 * hi + ((lane & 15) >> 2)) * 64;
    if (!pre) { DMA_K(0, 0); DMA_V(0, 0); DMA_K(1, SLOTB); }
    bf16x8 qr[4];
#pragma unroll
    for (int d0 = 0; d0 < 4; ++d0) qr[d0] = *(const bf16x8*)(Qw + (long)r32 * PITCH + d0 * 16 + hi * 8);
    const int qrel = wid * 32 + r32;
    const float ct = cb[q0 + qrel];
    float mhat = 0.f, l_reg = 0.f; f32x16 o[2]; o[0] = f32x16{}; o[1] = f32x16{};
    bf16x8 qx = qx_build(ct, hi);
    const f32x16 z16 = f32x16{};
#define CMASK(P0, P1, p) do { const int jb_ = 3 - (p); if (jb_ >= 0) cmask(P0, P1, jb_, qrel, hi); } while (0)
    bool resc = false;
#define RESC() do { if (resc) { asm volatile("s_waitcnt lgkmcnt(0)" ::: "memory"); \
      _Pragma("unroll") for (int d_ = 0; d_ < 2; ++d_) _Pragma("unroll") for (int r = 0; r < 16; ++r) o[d_][r] *= wsf[crow(r, hi)]; } } while (0)
    f32x16 pA0, pA1, pB0, pB1;
    int sl_prev = 0, sl_cur = 0, sl_next = SLOTB;
#define ROT() do { sl_prev = sl_cur; sl_cur = sl_next; sl_next = (sl_next == (NSLOT - 1) * SLOTB) ? 0 : sl_next + SLOTB; } while (0)
    if (!pre) { DMA_K(2, 2 * SLOTB); }
    if (pre) { WAIT_BAR(0); } else WAIT_BAR(5);
    if (tid < NT) clt[tid] = clv;
    float qkb;
    { float q2 = 0.f;
#pragma unroll
      for (int d0 = 0; d0 < 4; ++d0)
#pragma unroll
          for (int j = 0; j < 8; ++j) { const float e = __uint_as_float(((unsigned)(unsigned short)qr[d0][j]) << 16); q2 += e * e; }
      q2 = att::swap_lo(q2) + att::swap_hi(q2); qkb = sqrtf(q2) * kmax + ct + WIN_T; }
    { const LAS char* kb = (const LAS char*)shm + LDS_K + hi * 1024 + r32 * 16; const LAS char* kxb = (const LAS char*)shm + LDS_K + 8192 + r32 * 16;
      pA0 = MFMA32(*(const LAS bf16x8*)(kxb), qx, z16); pA1 = MFMA32(*(const LAS bf16x8*)(kxb + 512), qx, z16);
#pragma unroll
      for (int d0 = 0; d0 < 4; ++d0) { pA0 = MFMA32(*(const LAS bf16x8*)(kb + d0 * 2048), qr[d0], pA0); pA1 = MFMA32(*(const LAS bf16x8*)(kb + d0 * 2048 + 512), qr[d0], pA1); } }
    asm volatile("s_nop 15\n\ts_nop 7" : "+v"(pA0), "+v"(pA1)); CMASK(pA0, pA1, 0);
    { float a = fmaxf(pA0[0], pA1[0]);
#pragma unroll
      for (int r = 1; r < 16; ++r) a = fmaxf(a, fmaxf(pA0[r], pA1[r]));
      a = fmaxf(att::swap_lo(a), att::swap_hi(a));
      const float dl = fmaxf(a, FLOOR); mhat = dl;
#pragma unroll
      for (int r = 0; r < 16; ++r) { pA0[r] = __builtin_amdgcn_exp2f(pA0[r] - dl); pA1[r] = __builtin_amdgcn_exp2f(pA1[r] - dl); }
      qx = qx_build(ct - mhat, hi); asm volatile("" : "+v"(qx)); }
    WAIT_BAR(0);
    DMA_K(3, 0); DMA_V(1, SLOTB);
    ROT();
    kload2(kf, kp0 + sl_cur, 0); kload2(kf, kp0 + sl_cur, 1); kload2(kf, kp0 + sl_cur, 2); kload2(kf, kp0 + sl_cur, 3);
    kf[8] = *(const LAS bf16x8*)(kx0 + sl_cur); kf[9] = *(const LAS bf16x8*)(kx0 + sl_cur + 512);
    WAIT_BAR(3);
    s16x4 vlo[8], vhi[8]; u32x4 pw0, pw1, pw2, pw3;
#define PKW(P, B) cvt_pk_bf16(P[B], P[B + 1])
#define PAF(k) __builtin_bit_cast(bf16x8, pw##k)
#define VFR(i) (bf16x8){vlo[i][0], vlo[i][1], vlo[i][2], vlo[i][3], vhi[i][0], vhi[i][1], vhi[i][2], vhi[i][3]}
#define PIN(x) asm volatile("" : "+v"(x))
#define MX3(a, b, c) __builtin_fmaxf(__builtin_fmaxf((a), (b)), (c))
#define GAPA(MF, A0, A1, A2, A3, W0, W1, PW) do { MF; sacc += A0; sacc += A1; sacc += A2; sacc += A3; PIN(sacc); W0; W1; PIN(PW); SBAR(); } while (0)
#define EX(v) __builtin_amdgcn_exp2f(v)
#define GAPB(MF, X, B) do { MF; X[B] = EX(X[B]); X[B + 1] = EX(X[B + 1]); X[B + 2] = EX(X[B + 2]); X[B + 3] = EX(X[B + 3]); PIN(X); SBAR(); } while (0)
#define VRD(i) do { vlo[i] = vtr(vp_ + (((i) >> 2) * 4096 + ((i) & 3) * 1024)); vhi[i] = vtr(vp_ + (((i) >> 2) * 4096 + ((i) & 3) * 1024 + 512)); } while (0)
#define KRD(G, j) do { if (G) { kload2(kf, kp0 + sl_next, j); SBAR(); } } while (0)
#define KRDX(G) do { if (G) { kf[8] = *(const LAS bf16x8*)(kx0 + sl_next); kf[9] = *(const LAS bf16x8*)(kx0 + sl_next + 512); SBAR(); } } while (0)
#define STEP(C0, C1, P0, P1, t, GK, GV, GL) do { SBAR(); \
    const lds_cptr vp_ = vp0 + sl_prev; \
    C0 = MFMA32(kf[8], qx, z16); C1 = MFMA32(kf[9], qx, z16); SBAR(); \
    VRD(0); SBAR(); float sacc = (P0[0] + P0[1]); \
    GAPA(C0 = MFMA32(kf[0], qr[0], C0), P0[2], P0[3], P0[4], P0[5],     pw0[0] = PKW(P0, 0), pw0[1] = PKW(P0, 2), pw0); \
    VRD(4); SBAR(); GAPA(C1 = MFMA32(kf[1], qr[0], C1), P0[6], P0[7], P0[8], P0[9],     pw0[2] = PKW(P0, 4), pw0[3] = PKW(P0, 6), pw0); \
    VRD(1); SBAR(); GAPA(C0 = MFMA32(kf[2], qr[1], C0),   P0[10], P0[11], P0[12], P0[13], pw1[0] = PKW(P0, 8), pw1[1] = PKW(P0, 10), pw1); \
    VRD(5); SBAR(); GAPA(C1 = MFMA32(kf[3], qr[1], C1),   P0[14], P0[15], P1[0], P1[1],   pw1[2] = PKW(P0, 12), pw1[3] = PKW(P0, 14), pw1); \
    VRD(2); SBAR(); GAPA(C0 = MFMA32(kf[4], qr[2], C0),   P1[2], P1[3], P1[4], P1[5],     pw2[0] = PKW(P1, 0), pw2[1] = PKW(P1, 2), pw2); \
    VRD(6); SBAR(); GAPA(C1 = MFMA32(kf[5], qr[2], C1),   P1[6], P1[7], P1[8], P1[9],     pw2[2] = PKW(P1, 4), pw2[3] = PKW(P1, 6), pw2); \
    VRD(3); SBAR(); GAPA(C0 = MFMA32(kf[6], qr[3], C0),   P1[10], P1[11], P1[12], P1[13], pw3[0] = PKW(P1, 8), pw3[1] = PKW(P1, 10), pw3); \
    VRD(7); SBAR(); GAPA(C1 = MFMA32(kf[7], qr[3], C1),   P1[14], P1[15], 0.f, 0.f,       pw3[2] = PKW(P1, 12), pw3[3] = PKW(P1, 14), pw3); \
    l_reg += sacc; \
    if (GK) { DMA_K((t) + 3, sl_cur); } if (GV) { DMA_V((t) + 1, sl_next); } \
    CMASK(C0, C1, t); \
    { float a = MX3(C0[0], C0[1], C1[0]), b_ = MX3(C0[2], C0[3], C1[1]); a = MX3(a, C1[2], C1[3]); \
      _Pragma("unroll") for (int r = 4; r < 16; r += 4) { a = MX3(a, C0[r], C0[r + 1]); b_ = MX3(b_, C0[r + 2], C0[r + 3]); a = MX3(a, C1[r], C1[r + 1]); b_ = MX3(b_, C1[r + 2], C1[r + 3]); } \
      float rm = __builtin_fmaxf(a, b_); { auto rr = __builtin_amdgcn_permlane32_swap(__float_as_uint(rm), __float_as_uint(rm), false, false); rm = __builtin_fmaxf(__uint_as_float(rr[0]), __uint_as_float(rr[1])); } \
      resc = false; \
      if (__builtin_expect(__any(rm > (float)THRL), 0)) { const float dl = __builtin_fmaxf(rm, 0.f); mhat += dl; \
        _Pragma("unroll") for (int r = 0; r < 16; ++r) { C0[r] -= dl; C1[r] -= dl; } \
        qx = qx_build(ct - mhat, hi); asm volatile("" : "+v"(qx)); \
        const float f = __builtin_amdgcn_exp2f(-dl); l_reg *= f; if (hi == 0) wsf[r32] = f; resc = true; } } \
    SBAR(); \
    GAPB(o[0] = MFMA32(PAF(0), VFR(0), o[0]), C0, 0); \
    KRDX(GL); GAPB(o[1] = MFMA32(PAF(0), VFR(4), o[1]), C0, 4); \
    KRD(GL, 0); GAPB(o[0] = MFMA32(PAF(1), VFR(1), o[0]), C0, 8); \
    KRD(GL, 1); GAPB(o[1] = MFMA32(PAF(1), VFR(5), o[1]), C0, 12); \
    KRD(GL, 2); GAPB(o[0] = MFMA32(PAF(2), VFR(2), o[0]), C1, 0); \
    KRD(GL, 3); GAPB(o[1] = MFMA32(PAF(2), VFR(6), o[1]), C1, 4); \
    GAPB(o[0] = MFMA32(PAF(3), VFR(3), o[0]), C1, 8); \
    GAPB(o[1] = MFMA32(PAF(3), VFR(7), o[1]), C1, 12); \
    } while (0)
#define ENDW(tt) do { if ((tt) + 3 < NTe) { WAIT_BAR(3); } else if ((tt) + 2 < NTe) { WAIT_BAR(1); } else { WAIT_BAR(0); } } while (0)
#define VOTE(u) do { const int ts_ = NT - (u) - 3; bool ok_ = false; if (ts_ >= 0) { ok_ = __all((qkb - mhat) < clt[ts_]); } if (lane == 0) votes[wid] = ok_ ? 1u : 0u; } while (0)
#define TALLY(u) do { const u32x4 va_ = *(const LAS u32x4*)votes, vb_ = *(const LAS u32x4*)(votes + 4); \
        if (__builtin_amdgcn_readfirstlane((va_.x & va_.y & va_.z & va_.w & vb_.x & vb_.y & vb_.z & vb_.w) != 0u)) { if ((u) + 2 < NTe) { NTe = (u) + 2; WAIT_BAR(0); } } } while (0)
    int t = 1;
    for (; t + 1 < NTe && t < 5; t += 2) {
        STEP(pB0, pB1, pA0, pA1, t, (t + 3 < NTe), (t + 1 < NTe), (t + 1 < NTe));       ENDW(t);     RESC(); ROT();
        STEP(pA0, pA1, pB0, pB1, t + 1, (t + 4 < NTe), (t + 2 < NTe), (t + 2 < NTe));   VOTE(t + 1); ENDW(t + 1); TALLY(t + 1); RESC(); ROT();
    }
#undef CMASK
#define CMASK(P0, P1, p) do {} while (0)
    for (; t + 5 < NTe; t += 2) {
        STEP(pB0, pB1, pA0, pA1, t, true, true, true);       WAIT_BAR(3); RESC(); ROT();
        STEP(pA0, pA1, pB0, pB1, t + 1, true, true, true);   VOTE(t + 1); WAIT_BAR(3); TALLY(t + 1); RESC(); ROT();
    }
    for (; t + 1 < NTe; t += 2) {
        STEP(pB0, pB1, pA0, pA1, t, (t + 3 < NTe), (t + 1 < NTe), (t + 1 < NTe));       ENDW(t);     RESC(); ROT();
        STEP(pA0, pA1, pB0, pB1, t + 1, (t + 4 < NTe), (t + 2 < NTe), (t + 2 < NTe));   ENDW(t + 1); RESC(); ROT();
    }
#undef CMASK
#define CMASK(P0, P1, p) do { const int jb_ = 3 - (p); if (jb_ >= 0) cmask(P0, P1, jb_, qrel, hi); } while (0)
    STEP(pB0, pB1, pA0, pA1, NTe - 1, false, false, false); RESC();
    { float sacc = pB0[0] + pB0[1];
#pragma unroll
      for (int r = 2; r < 16; ++r) sacc += pB0[r];
#pragma unroll
      for (int r = 0; r < 16; ++r) sacc += pB1[r];
      l_reg += sacc;
      pw0 = (u32x4){PKW(pB0, 0), PKW(pB0, 2), PKW(pB0, 4), PKW(pB0, 6)}; pw1 = (u32x4){PKW(pB0, 8), PKW(pB0, 10), PKW(pB0, 12), PKW(pB0, 14)};
      pw2 = (u32x4){PKW(pB1, 0), PKW(pB1, 2), PKW(pB1, 4), PKW(pB1, 6)}; pw3 = (u32x4){PKW(pB1, 8), PKW(pB1, 10), PKW(pB1, 12), PKW(pB1, 14)};
      SBAR(); att::pv(o, (int)(unsigned)(uintptr_t)(vp0 + sl_cur), PAF(0), PAF(1), PAF(2), PAF(3)); }
    if (nbh >= 0) { asm volatile("s_waitcnt lgkmcnt(0)\n\ts_barrier" ::: "memory");
        const int NTn = (nqb * QB + QB) / KVBLK; const bf16_t* Kn = K + (long)(nbh >> 3) * SEQ * PITCH + (nbh & 7) * HD; const bf16_t* Vn = V + (long)(nbh >> 3) * SEQ * PITCH + (nbh & 7) * HD; const bf16_t* KXn = KXall + (size_t)nbh * SEQ * 8;
        DMA_KX(Kn, KXn, NTn, 0, 0); DMA_VX(Vn, NTn, 0, 0); DMA_KX(Kn, KXn, NTn, 1, SLOTB); DMA_KX(Kn, KXn, NTn, 2, 2 * SLOTB); }
    l_reg = att::swap_lo(l_reg) + att::swap_hi(l_reg);
    if (hi == 0) wsf[32 + r32] = l_reg; asm volatile("s_waitcnt lgkmcnt(0)" ::: "memory");
    float rli[16];
#pragma unroll
    for (int r = 0; r < 16; ++r) rli[r] = __builtin_amdgcn_rcpf(wsf[32 + crow(r, hi)]);
    bf16_t* Ow = O + (rowbase + q0 + wid * 32) * OPITCH + h * HD;
    { LAS bf16_t* stg = (LAS bf16_t*)(shm + LDS_OST) + wid * 2048;
#pragma unroll
      for (int r = 0; r < 16; ++r) { const int orow = crow(r, hi);
#pragma unroll
        for (int d0 = 0; d0 < 2; ++d0) stg[orow * 64 + d0 * 32 + r32] = (bf16_t)(cvt_pk_bf16(o[d0][r] * rli[r], 0.f) & 0xffffu); }
      asm volatile("s_waitcnt lgkmcnt(0)" ::: "memory");
#pragma unroll
      for (int i = 0; i < 4; ++i) { const int row = i * 8 + (lane >> 3), ch = lane & 7; const u32x4 v = *(const LAS u32x4*)(stg + row * 64 + ch * 8); *(u32x4*)(Ow + (long)row * OPITCH + ch * 8) = v;
        att::store_row_ssq(v, hs + (rowbase + q0 + wid * 32 + row) * 16, ch); } }
    asm volatile("s_waitcnt lgkmcnt(0)\n\ts_barrier" ::: "memory");
#undef DMA_K
#undef DMA_V
#undef DMA_KX
#undef DMA_VX
#undef CMASK
#undef RESC
#undef ROT
#undef PKW
#undef PAF
#undef VFR
#undef PIN
#undef MX3
#undef GAPA
#undef GAPB
#undef EX
#undef VRD
#undef KRD
#undef KRDX
#undef STEP
#undef ENDW
#undef VOTE
#undef TALLY
}
#undef SBAR
#undef WAIT_BAR
}


namespace sbk {
constexpr int QB = 256, KVBLK = 64, PITCH = HW, OPITCH = DM, NBURST = 6, SLOTB = 8192;
constexpr int LDS_K = 0, LDS_V = NBURST * SLOTB, LDS_FLAG = 2 * NBURST * SLOTB, LDS_END = LDS_FLAG + 128;
static_assert(LDS_END <= RING_BYTES, "sb LDS");
using att::crow; using att::glds16s; using att::qkt; using att::pv; using att::swap_lo;
__device__ __forceinline__ void sb_tile(const LAS char* Kslot, int vb, const bf16x8* qr, bf16x8 TD0, bf16x8 TD1, bf16x8 TONE, int jb, int qrel, int r32, int hi, float& R, f32x16* o) {
    f32x16 p0, p1; const f32x16 z16 = f32x16{};
    qkt(p0, p1, Kslot, qr, z16, r32, hi);
    if (jb >= 0) {
#pragma unroll
        for (int r = 0; r < 16; ++r) { const int kv = 64 * jb + crow(r, hi); if (kv >= qrel) p0[r] = -1.0e30f; if (kv + 32 >= qrel) p1[r] = -1.0e30f; } }
    f32x16 l0, l1;
#pragma unroll
    for (int r = 0; r < 16; ++r) {
        l0[r] = -(fmaxf(p0[r], 0.f) + __builtin_amdgcn_logf(1.0f + __builtin_amdgcn_exp2f(-fabsf(p0[r]))));
        l1[r] = -(fmaxf(p1[r], 0.f) + __builtin_amdgcn_logf(1.0f + __builtin_amdgcn_exp2f(-fabsf(p1[r])))); }
    u32x4 lw0 = {cvt_pk_bf16(l0[0], l0[1]), cvt_pk_bf16(l0[2], l0[3]), cvt_pk_bf16(l0[4], l0[5]), cvt_pk_bf16(l0[6], l0[7])};
    u32x4 lw1 = {cvt_pk_bf16(l0[8], l0[9]), cvt_pk_bf16(l0[10], l0[11]), cvt_pk_bf16(l0[12], l0[13]), cvt_pk_bf16(l0[14], l0[15])};
    u32x4 lw2 = {cvt_pk_bf16(l1[0], l1[1]), cvt_pk_bf16(l1[2], l1[3]), cvt_pk_bf16(l1[4], l1[5]), cvt_pk_bf16(l1[6], l1[7])};
    u32x4 lw3 = {cvt_pk_bf16(l1[8], l1[9]), cvt_pk_bf16(l1[10], l1[11]), cvt_pk_bf16(l1[12], l1[13]), cvt_pk_bf16(l1[14], l1[15])};
    f32x16 rt;
#pragma unroll
    for (int r = 0; r < 16; ++r) rt[r] = R;
    f32x16 t0 = MFMA32(TD0, __builtin_bit_cast(bf16x8, lw0), rt); t0 = MFMA32(TD1, __builtin_bit_cast(bf16x8, lw1), t0);
    t0 = MFMA32(TONE, __builtin_bit_cast(bf16x8, lw2), t0); t0 = MFMA32(TONE, __builtin_bit_cast(bf16x8, lw3), t0);
    f32x16 t1 = MFMA32(TD0, __builtin_bit_cast(bf16x8, lw2), rt); t1 = MFMA32(TD1, __builtin_bit_cast(bf16x8, lw3), t1);
#pragma unroll
    for (int r = 0; r < 16; ++r) { p0[r] = __builtin_amdgcn_exp2f(p0[r] + t0[r]); p1[r] = __builtin_amdgcn_exp2f(p1[r] + t1[r]); }
    R = swap_lo(t0[0]);
    u32x4 pw0 = {cvt_pk_bf16(p0[0], p0[1]), cvt_pk_bf16(p0[2], p0[3]), cvt_pk_bf16(p0[4], p0[5]), cvt_pk_bf16(p0[6], p0[7])};
    u32x4 pw1 = {cvt_pk_bf16(p0[8], p0[9]), cvt_pk_bf16(p0[10], p0[11]), cvt_pk_bf16(p0[12], p0[13]), cvt_pk_bf16(p0[14], p0[15])};
    u32x4 pw2 = {cvt_pk_bf16(p1[0], p1[1]), cvt_pk_bf16(p1[2], p1[3]), cvt_pk_bf16(p1[4], p1[5]), cvt_pk_bf16(p1[6], p1[7])};
    u32x4 pw3 = {cvt_pk_bf16(p1[8], p1[9]), cvt_pk_bf16(p1[10], p1[11]), cvt_pk_bf16(p1[12], p1[13]), cvt_pk_bf16(p1[14], p1[15])};
    pv(o, vb, __builtin_bit_cast(bf16x8, pw0), __builtin_bit_cast(bf16x8, pw1), __builtin_bit_cast(bf16x8, pw2), __builtin_bit_cast(bf16x8, pw3));
}
#define SB_WAITBAR(N) asm volatile("s_waitcnt vmcnt(" #N ") lgkmcnt(0)\n\ts_barrier" ::: "memory")
__device__ __forceinline__ void sb_unit(int b, int h, int qb, const bf16_t* Q, const bf16_t* K, const bf16_t* V, bf16_t* O, float* hs, LAS char* shm) {
    int tid = threadIdx.x; asm volatile("" : "+v"(tid)); const int lane = tid & 63, r32 = lane & 31, hi = lane >> 5; const int wid = __builtin_amdgcn_readfirstlane(tid >> 6);
    const long rowbase = (long)b * SEQ; const int q0 = qb * QB;
    const bf16_t* Qw = Q + (rowbase + q0 + wid * 32) * PITCH + h * HD;
    const bf16_t* Kh = K + rowbase * PITCH + h * HD; const bf16_t* Vh = V + rowbase * PITCH + h * HD;
    const unsigned lds0 = (unsigned)(uintptr_t)shm;
    LAS unsigned* flags = (LAS unsigned*)(shm + LDS_FLAG);
    const unsigned koff = (unsigned)(lane * PITCH + wid * 8) * 2u, voff = (unsigned)((16 * (wid & 3) + (lane >> 2)) * PITCH + (wid >> 2) * 32 + (lane & 3) * 8) * 2u;
    const unsigned kdst = lds0 + LDS_K + wid * 1024, vdst = lds0 + LDS_V + wid * 1024;
#define SB_DMA(p, slot) do { glds16s(Kh + (long)(NT - 1 - (p)) * KVBLK * PITCH, koff, (unsigned)__builtin_amdgcn_readfirstlane(kdst + (slot) * SLOTB)); \
        glds16s(Vh + (long)(NT - 1 - (p)) * KVBLK * PITCH, voff, (unsigned)__builtin_amdgcn_readfirstlane(vdst + (slot) * SLOTB)); } while (0)
    const int vb0 = (int)(lds0 + LDS_V) + ((lane >> 4) & 1) * 32 + (lane & 3) * 8 + (4 * hi + ((lane & 15) >> 2)) * 64;
    const int NT = (q0 + QB) / KVBLK, NB = NT < NBURST ? NT : NBURST;
    for (int p = 0; p < NB; ++p) SB_DMA(p, p);
    bf16x8 qr[4];
#pragma unroll
    for (int d0 = 0; d0 < 4; ++d0) qr[d0] = *(const bf16x8*)(Qw + (long)r32 * PITCH + d0 * 16 + hi * 8);
    f32x16 o[2]; o[0] = f32x16{}; o[1] = f32x16{};
    const int qrel = wid * 32 + r32;
    float R = 0.f;
    bf16x8 TD0, TD1, TONE;
#pragma unroll
    for (int j = 0; j < 8; ++j) { const int kvl = 8 * (j >> 2) + 4 * hi + (j & 3); TD0[j] = (kvl >= r32) ? (short)0x3F80 : (short)0; TD1[j] = (16 + kvl >= r32) ? (short)0x3F80 : (short)0; TONE[j] = (short)0x3F80; }
    if (NB > 4) { SB_WAITBAR(4); } else { SB_WAITBAR(0); }
    bool mid_done = (NB <= 4);
    int p = 3 - (wid >> 1);
    for (; p < NB; ++p) {
        if (p >= 4 && !mid_done) { SB_WAITBAR(0); mid_done = true; }
        sb_tile(shm + LDS_K + p * SLOTB, vb0 + p * SLOTB, qr, TD0, TD1, TONE, 3 - p, qrel, r32, hi, R, o);
        if (__all(R < SB_EXIT)) { ++p; break; }
    }
    if (!mid_done) { SB_WAITBAR(0); }
    { const bool dn = __all(R < SB_EXIT) || (p >= NT); if (lane == 0) flags[wid] = dn ? 1u : 0u; }
    SB_WAITBAR(0);
    bool alldone;
    { const u32x4 fa = *(const LAS u32x4*)flags, fb = *(const LAS u32x4*)(flags + 4); alldone = __builtin_amdgcn_readfirstlane((fa.x & fa.y & fa.z & fa.w & fb.x & fb.y & fb.z & fb.w) != 0u); }
    if (!alldone && NB < NT) {
        SB_DMA(NB, 0);
        for (int i = 0; NB + i < NT; ++i) {
            const int pp = NB + i, sl = i & 1;
            SB_WAITBAR(0);
            if (i > 0) { const LAS unsigned* fl = flags + 8 + ((i - 1) & 1) * 8; const u32x4 fa = *(const LAS u32x4*)fl, fb = *(const LAS u32x4*)(fl + 4);
                if (__builtin_amdgcn_readfirstlane((fa.x & fa.y & fa.z & fa.w & fb.x & fb.y & fb.z & fb.w) != 0u)) break; }
            if (pp + 1 < NT) SB_DMA(pp + 1, sl ^ 1);
            if (!__all(R < SB_EXIT)) sb_tile(shm + LDS_K + sl * SLOTB, vb0 + sl * SLOTB, qr, TD0, TD1, TONE, -1, qrel, r32, hi, R, o);
            { const bool dn = __all(R < SB_EXIT); if (lane == 0) flags[8 + (i & 1) * 8 + wid] = dn ? 1u : 0u; }
        }
        SB_WAITBAR(0);
    }
    bf16_t* Ow = O + (rowbase + q0 + wid * 32) * OPITCH + h * HD;
    { LAS bf16_t* stg = (LAS bf16_t*)(shm + LDS_K) + wid * 2048;
#pragma unroll
      for (int r = 0; r < 16; ++r) { const int orow = crow(r, hi);
#pragma unroll
        for (int d0 = 0; d0 < 2; ++d0) stg[orow * 64 + d0 * 32 + r32] = (bf16_t)(cvt_pk_bf16(o[d0][r], 0.f) & 0xffffu); }
      LDS_WAIT();
#pragma unroll
      for (int i = 0; i < 4; ++i) { const int row = i * 8 + (lane >> 3), ch = lane & 7; const u32x4 v = *(const LAS u32x4*)(stg + row * 64 + ch * 8); *(u32x4*)(Ow + (long)row * OPITCH + ch * 8) = v;
        att::store_row_ssq(v, hs + (rowbase + q0 + wid * 32 + row) * 16, ch); } }
    asm volatile("s_waitcnt vmcnt(0) lgkmcnt(0)\n\ts_barrier" ::: "memory");
#undef SB_DMA
}
#undef SB_WAITBAR
}

#define XB_TMO      128
#define XB_XCNT(j)  (256  + 64 * (j))
#define XB_XSUB(j)  (1280 + 64 * (j))
#define XB_XGEN(j)  (2304 + 64 * (j))
#define XB_TOP      3328
#define XB_TOPGEN   3392
#define XCD_BAR_WORDS 3456
#define XB_SPIN_CAP (1u << 18)
__device__ __forceinline__ unsigned xb_ld(unsigned* p)              { return __hip_atomic_load(p, __ATOMIC_RELAXED, __HIP_MEMORY_SCOPE_AGENT); }
__device__ __forceinline__ unsigned xb_add(unsigned* p, unsigned v) { return __hip_atomic_fetch_add(p, v, __ATOMIC_RELAXED, __HIP_MEMORY_SCOPE_AGENT); }
__device__ __forceinline__ unsigned xb_xcc_id() { return (unsigned)__builtin_amdgcn_s_getreg((3 << 11) | 20) & 0xFu; }
#define XB_SPIN(cond, bar) do { unsigned _sp = 0; while (cond) { __builtin_amdgcn_s_sleep(1); \
    if ((++_sp & 255u) == 0u) { if (xb_ld(&(bar)[XB_TMO])) break; if (_sp > XB_SPIN_CAP) { atomicAdd(&(bar)[XB_TMO], 1u); break; } } } } while (0)
struct XcdBarrier { unsigned* bar; unsigned x; volatile LAS unsigned* st; };
__device__ __forceinline__ XcdBarrier xcd_barrier_post(unsigned* bar, volatile LAS unsigned* st) {
    XcdBarrier b; b.bar = bar; b.x = xb_xcc_id(); b.st = st;
    if (threadIdx.x == 0) (void)xb_add(&bar[XB_XCNT(b.x)], 1u);
    return b;
}
__device__ __forceinline__ void xcd_barrier_complete(unsigned* bar, unsigned x, unsigned& nloc, unsigned& nx) {
    const unsigned G = gridDim.x * gridDim.y * gridDim.z;
    unsigned sum, cnt, mine, sp = 0u;
    for (;;) {
        sum = 0u; cnt = 0u; mine = 0u;
#pragma unroll
        for (unsigned j = 0; j < 16; ++j) { const unsigned c = xb_ld(&bar[XB_XCNT(j)]); sum += c; cnt += (c > 0u) ? 1u : 0u; mine = (j == x) ? c : mine; }
        if (sum == G) break;
        __builtin_amdgcn_s_sleep(1);
        if ((++sp & 255u) == 0u) { if (xb_ld(&bar[XB_TMO])) break; if (sp > XB_SPIN_CAP) { atomicAdd(&bar[XB_TMO], 1u); break; } }
    }
    nloc = mine > 0u ? mine : 1u; nx = cnt > 0u ? cnt : 1u;
}
__device__ __forceinline__ void xcd_barrier(const XcdBarrier& b) {
    asm volatile("s_waitcnt vmcnt(0)" ::: "memory");
    __syncthreads();
    if (threadIdx.x == 0) {
        unsigned* bar = b.bar;
        __builtin_amdgcn_s_waitcnt(0);
        unsigned nloc = b.st[0], nx = b.st[1];
        if (nloc == 0u) { xcd_barrier_complete(bar, b.x, nloc, nx); b.st[0] = nloc; b.st[1] = nx; }
        const unsigned old = xb_add(&bar[XB_XSUB(b.x)], 1u);
        const unsigned gen = old / nloc;
        if (old + 1u == (gen + 1u) * nloc) {
            __builtin_amdgcn_fence(__ATOMIC_RELEASE, "agent");
            asm volatile("s_waitcnt vmcnt(0)" ::: "memory");
            const unsigned og = xb_add(&bar[XB_TOP], 1u);
            const unsigned tg = og / nx;
            if (og + 1u == (tg + 1u) * nx) xb_add(&bar[XB_TOPGEN], 1u);
            else XB_SPIN(xb_ld(&bar[XB_TOPGEN]) == tg, bar);
            __builtin_amdgcn_fence(__ATOMIC_ACQUIRE, "agent");
            xb_add(&bar[XB_XGEN(b.x)], 1u);
            asm volatile("s_waitcnt vmcnt(0)" ::: "memory");
        } else {
            XB_SPIN(xb_ld(&bar[XB_XGEN(b.x)]) == gen, bar);
            __builtin_amdgcn_fence(__ATOMIC_ACQUIRE, "agent");
            asm volatile("s_waitcnt vmcnt(0)" ::: "memory");
        }
    }
    __syncthreads();
}

__device__ __forceinline__ const void* ldp(const volatile LAS unsigned* tab, int i) {
    const unsigned lo = __builtin_amdgcn_readfirstlane(tab[2 * i]), hi = __builtin_amdgcn_readfirstlane(tab[2 * i + 1]);
    return (const void*)(const GAS void*)(((unsigned long long)hi << 32) | lo);
}
struct Args {
    const float* x; const float* mem; const float* norm_mix; const float* w_in; const float* b_forget; const float* norm_fox; const float* norm_sb; const float* w_out;
    const float* norm_xattn; const float* norm_mem; const float* w_xq; const float* w_xkv; const float* w_xo; const float* norm_ffn;
    const float* w_rg; const float* b_rg; const float* w_re; const float* b_re; const float* w_gate; const float* w_up; const float* w_down; const float* norm_final;
    float* out; unsigned char* ws;
};

__device__ __forceinline__ void transpose_item(const float* W, int ldw, bf16_t* WT, int ldo, int k0, int n0, int dst_row0, const float* gain, LAS float* scr, int lane) {
    float tv[32], tg[32];
#pragma unroll
    for (int i = 0; i < 32; ++i) { const int kk = 2 * i + (lane >> 5); tv[i] = W[(size_t)(k0 + kk) * ldw + n0 + (lane & 31)]; tg[i] = gain ? gain[k0 + kk] : 1.f; }
#pragma unroll
    for (int i = 0; i < 32; ++i) { const int kk = 2 * i + (lane >> 5); scr[kk * 33 + (lane & 31)] = tv[i] * tg[i]; }
    LDS_WAIT(); asm volatile("" ::: "memory");
    const int c = lane & 7;
#pragma unroll
    for (int j = 0; j < 4; ++j) { const int n = (lane >> 3) + 8 * j; const LAS float* s = scr + (8 * c) * 33 + n;
        u32x4 o; o.x = cvt_pk_bf16(s[0 * 33], s[1 * 33]); o.y = cvt_pk_bf16(s[2 * 33], s[3 * 33]); o.z = cvt_pk_bf16(s[4 * 33], s[5 * 33]); o.w = cvt_pk_bf16(s[6 * 33], s[7 * 33]);
        *(u32x4*)(WT + (size_t)(dst_row0 + n) * ldo + k0 + 8 * c) = o; }
    LDS_WAIT(); asm volatile("" ::: "memory");
}

__device__ __forceinline__ void transpose_item8(const float* W, int ldw, unsigned char* WT, int ldo, int k0, int n0, int dst_row0, const float* gain, float scale, LAS float* scr, int lane) {
    float tv[32], tg[32];
#pragma unroll
    for (int i = 0; i < 32; ++i) { const int kk = 2 * i + (lane >> 5); tv[i] = W[(size_t)(k0 + kk) * ldw + n0 + (lane & 31)]; tg[i] = gain ? gain[k0 + kk] : 1.f; }
#pragma unroll
    for (int i = 0; i < 32; ++i) { const int kk = 2 * i + (lane >> 5); scr[kk * 33 + (lane & 31)] = tv[i] * tg[i] * scale; }
    LDS_WAIT(); asm volatile("" ::: "memory");
    const int c = lane & 7;
#pragma unroll
    for (int j = 0; j < 4; ++j) { const int n = (lane >> 3) + 8 * j; const LAS float* s = scr + (8 * c) * 33 + n;
        u32x2 o; o.x = cvt4_fp8(s[0 * 33], s[1 * 33], s[2 * 33], s[3 * 33]); o.y = cvt4_fp8(s[4 * 33], s[5 * 33], s[6 * 33], s[7 * 33]);
        *(u32x2*)(WT + (size_t)(dst_row0 + n) * ldo + k0 + 8 * c) = o; }
    LDS_WAIT(); asm volatile("" ::: "memory");
}

struct SchedDense {
    const char* A; const char* Bt; int nM, nN, G, c; size_t a_tile, b_tile, b_batch; int split_tiles;
    __device__ __forceinline__ bool next(int i, pg8::Unit& u) const {
        int pm, pn; if (!pg8::tile_order(i, G, c, nM, nN, pm, pn)) return false;
        u.a = A + (size_t)pm * a_tile; u.b = Bt + (size_t)pn * b_tile + (size_t)(pm >> 5) * b_batch; u.orow = pm * 256;
        if (split_tiles) { u.aux = pn / split_tiles; u.ocol = (pn % split_tiles) * 256; } else { u.aux = 1; u.ocol = pn * 256; }
        u.rows = nullptr; u.nvalid = 256; return true;
    }
};
struct SchedGH {
    const char* KVm; const char* Wxq; const char* Wxo; int G, c;
    __device__ __forceinline__ bool next(int i, pg8::Unit& u) const {
        const int L = i * G + c; if (L >= 256) return false;
        const int kind = L >> 7, r = L & 127, bh = r >> 2, j = r & 3, b = bh >> 2, h = bh & 3;
        if (kind == 0) { u.a = KVm + ((size_t)(b * 256) * 2048 + h * 256) * 2; u.b = Wxq + ((size_t)(256 * j) * 1024 + h * 256) * 2; u.orow = b * 1024 + h * 256; u.ocol = 256 * j; u.aux = 1; }
        else { u.a = Wxo + ((size_t)(256 * j) * 1024 + h * 256) * 2; u.b = KVm + ((size_t)(b * 256) * 2048 + 1024 + h * 256) * 2; u.orow = b * 1024 + 256 * j; u.ocol = h * 256; u.aux = 2; }
        u.rows = nullptr; u.nvalid = 256; return true;
    }
};
template <int KIND> struct SchedGHk { SchedGH s; __device__ __forceinline__ bool next(int i, pg8::Unit& u) const { const int c2 = (s.G >= 256) ? s.c - 128 * KIND : s.c; if (c2 < 0) return false; const int L = i * s.G + c2; if (L >= 128) return false; SchedGH t = s; t.G = 1; t.c = 0; return t.next(128 * KIND + L, u); } };
struct EpiGH { static constexpr bool HAS_MID = false; unsigned char* GTp; unsigned char* HTp;
    __device__ __forceinline__ void operator()(const f32x4 (&acc)[2][2][4][2], const pg8::Unit& u, int wr, int wc, int fr, int fq) const {
        unsigned char* base = u.aux == 1 ? GTp : HTp;
#pragma unroll
        for (int ai = 0; ai < 2; ++ai)
#pragma unroll
            for (int m = 0; m < 4; ++m) { const int row = u.orow + ai * pg8::HALF + wr * 64 + m * 16 + fr;
#pragma unroll
                for (int bj = 0; bj < 2; ++bj) { const f32x4 v0 = acc[ai][bj][m][0], v1 = acc[ai][bj][m][1];
                    u32x2 w8; w8.x = cvt4_fp8(v0[0], v0[1], v0[2], v0[3]); w8.y = cvt4_fp8(v1[0], v1[1], v1[2], v1[3]);
                    *(u32x2*)(base + (size_t)row * DM + u.ocol + bj * pg8::HALF + wc * 32 + 8 * fq) = w8; } }
    } };
struct SchedMoe {
    const char* A; const char* W; const int* list; const LAS int* tbl; int G, c, NPN; size_t w_exp, w_tile, a_tile; int ocol_w;
    __device__ __forceinline__ bool next(int i, pg8::Unit& u) const {
        const int L = i * G + c; const int tl = L / NPN, pn = L % NPN;
        if (tl >= __builtin_amdgcn_readfirstlane(tbl[16])) return false;
        int e = 0;
#pragma unroll 1
        for (int x = 1; x < NEXP; ++x) { if (tl >= __builtin_amdgcn_readfirstlane(tbl[x])) e = x; }
        const int j = tl - __builtin_amdgcn_readfirstlane(tbl[e]), n = __builtin_amdgcn_readfirstlane(tbl[32 + e]) - 256 * j;
        u.a = A + (size_t)tl * a_tile; u.b = W + (size_t)e * w_exp + (size_t)pn * w_tile; u.orow = tl * 256; u.ocol = pn * ocol_w; u.aux = 1;
        u.rows = list + (size_t)e * M + 256 * j; u.nvalid = n < 256 ? n : 256; return true;
    }
};
__device__ __forceinline__ void moe_table(LAS int* tbl, const unsigned* ctl) {
    if (threadIdx.x == 0) { int base = 0; for (int e = 0; e < NEXP; ++e) { const int n = (int)ctl[CW_CNT + 64 * e]; tbl[e] = base; tbl[32 + e] = n; base += (n + 255) >> 8; } tbl[16] = base; }
    __syncthreads();
}

__global__ void __launch_bounds__(NWAVES * 64, 2) hymba_fwd(Args args) {
    extern __shared__ __attribute__((aligned(16))) unsigned char lds_raw[];
    LAS unsigned char* lds = (LAS unsigned char*)lds_raw;
    volatile LAS unsigned* MISC = (volatile LAS unsigned*)(lds + MISC_OFF);
    const int tid0 = threadIdx.x; const int wave = __builtin_amdgcn_readfirstlane(tid0 >> 6);
    const int G = gridDim.x; const int bx = blockIdx.x; const int vcu = (G % 8 == 0) ? (bx % 8) * (G / 8) + bx / 8 : bx;
    volatile LAS unsigned* ATAB = (volatile LAS unsigned*)(lds + MISC_OFF + 512);
    for (int u = tid0; u < 256; u += NWAVES * 64) ((LAS unsigned*)(lds + MISC_OFF))[u] = 0u;
    __syncthreads();
    if (tid0 == 0) { const float* const* ap = (const float* const*)&args;
#pragma unroll
        for (int i = 0; i < 24; ++i) { const unsigned long long v = (unsigned long long)ap[i]; ATAB[2 * i] = (unsigned)v; ATAB[2 * i + 1] = (unsigned)(v >> 32); } }
    __syncthreads();
#define ARGP(name) ((const float*)ldp(ATAB, (int)(offsetof(Args, name) / 8)))
#define PHASE_PTRS \
    int tid = threadIdx.x; asm volatile("" : "+v"(tid)); const int lane = tid & 63; (void)lane; \
    unsigned char* const ws = (unsigned char*)ldp(ATAB, 23); float* const out = (float*)ldp(ATAB, 22); unsigned* const ctl = (unsigned*)(ws + WS_CTL); (void)out; (void)ctl; \
    bf16_t* const Win_t = (bf16_t*)(ws + WS_WIN); bf16_t* const Wout_t = (bf16_t*)(ws + WS_WOUT); bf16_t* const Wxq_n = (bf16_t*)(ws + WS_WXQ); bf16_t* const Wxkv_t = (bf16_t*)(ws + WS_WXKV); \
    bf16_t* const Wxo_t = (bf16_t*)(ws + WS_WXO); bf16_t* const Wgu_t = (bf16_t*)(ws + WS_WGU); bf16_t* const Wd_t = (bf16_t*)(ws + WS_WD); \
    float* const RX = (float*)(ws + WS_RX); float* const RMEM = (float*)(ws + WS_RMEM); float* const LF = (float*)(ws + WS_LF); float* const CC = (float*)(ws + WS_C2); float* const SSQ = (float*)(ws + WS_SSQ); \
    int* const TOKSLOT = (int*)(ws + WS_TOKSLOT); float* const TOKW = (float*)(ws + WS_TOKW); int* const LIST = (int*)(ws + WS_LIST); \
    bf16_t* const MEMB = (bf16_t*)(ws + WS_MEMB); bf16_t* const KVM = (bf16_t*)(ws + WS_KVM); bf16_t* const GT = (bf16_t*)(ws + WS_GT); bf16_t* const HT = (bf16_t*)(ws + WS_HT); \
    bf16_t* const XB = (bf16_t*)(ws + WS_XB); bf16_t* const QKV = (bf16_t*)(ws + WS_QKV); bf16_t* const H1B = (bf16_t*)(ws + WS_H1B); bf16_t* const U2B = (bf16_t*)(ws + WS_U2B); bf16_t* const HID = (bf16_t*)(ws + WS_HID); \
    bf16_t* const OAB = (bf16_t*)(ws + WS_O); bf16_t* const YB = (bf16_t*)(ws + WS_Y); bf16_t* const KX = (bf16_t*)(ws + WS_KX); (void)KX; float* const HS = (float*)(ws + WS_HS); (void)HS; float* const R2S = (float*)(ws + WS_SSQ); (void)R2S; unsigned char* const H1F8 = ws + WS_H1F8; (void)H1F8; unsigned char* const H2F8 = ws + WS_H2F8; (void)H2F8; \
    (void)Win_t; (void)Wout_t; (void)Wxq_n; (void)Wxkv_t; (void)Wxo_t; (void)Wgu_t; (void)Wd_t; (void)RX; (void)RMEM; (void)LF; (void)CC; (void)SSQ; (void)TOKSLOT; (void)TOKW; (void)LIST; \
    (void)MEMB; (void)KVM; (void)GT; (void)HT; (void)XB; (void)QKV; (void)H1B; (void)U2B; (void)HID; (void)OAB; (void)YB;
    XcdBarrier bar;
    { unsigned char* const ws0 = (unsigned char*)ldp(ATAB, 23); bar = xcd_barrier_post((unsigned*)(ws0 + WS_CTL) + CW_BAR, MISC + 8); }
    const int gw = vcu * NWAVES + wave, NGW = G * NWAVES;
    unsigned long long t_pa = 0, t_pb = 0; (void)t_pa; (void)t_pb;


    if (PROBE_LO == 0) t_pa = __builtin_amdgcn_s_memrealtime();
    if (PH(0))
    for (int rep_ = 0; rep_ < REPS(0); ++rep_)
    {
        PHASE_PTRS
        LAS float* wfT = (LAS float*)(lds + RING_OFF);
        LAS float* scr = (LAS float*)(lds + RING_OFF + 32768 + wave * 8448);
        { const float* win = ARGP(w_in); const float* gmix = ARGP(norm_mix);
          f32x4 fa[2], fb[2]; float gk[2];
#pragma unroll
          for (int q = 0; q < 2; ++q) { const int k = tid + 512 * q; gk[q] = gmix[k]; fa[q] = *(const f32x4*)(win + (size_t)k * WIN_LD + NPROJ); fb[q] = *(const f32x4*)(win + (size_t)k * WIN_LD + NPROJ + 4); }
#pragma unroll
          for (int q = 0; q < 2; ++q) { const int k = tid + 512 * q;
#pragma unroll
              for (int j = 0; j < 4; ++j) { wfT[j * DM + k] = fa[q][j] * gk[q]; wfT[(4 + j) * DM + k] = fb[q][j] * gk[q]; } } }
        constexpr int I_IN = 16 * 96, I_OUT = 16 * 32, I_XKV = 16 * 64, I_XO = 16 * 32, I_G = 16 * 16 * 8, I_U = I_G, I_D = 16 * 4 * 32, I_XQ = 1024;
        constexpr int NITEMS = I_IN + I_OUT + I_XKV + I_XO + I_G + I_U + I_D + I_XQ;
        for (int it = gw; it < NITEMS; it += NGW) {
            int r = it;
            if (r < I_IN) { const int kb = r / 96, nb = r % 96; transpose_item(ARGP(w_in), WIN_LD, Win_t, DM, 64 * kb, 32 * nb, 32 * nb, ARGP(norm_mix), scr, lane); continue; } r -= I_IN;
            if (r < I_OUT) { const int kb = r / 32, nb = r % 32; const float* gn = (64 * kb < HW) ? ARGP(norm_fox) : (ARGP(norm_sb) - HW); transpose_item(ARGP(w_out), DM, Wout_t, DM, 64 * kb, 32 * nb, 32 * nb, gn, scr, lane); continue; } r -= I_OUT;
            if (r < I_XKV) { const int kb = r / 64, nb = r % 64; transpose_item(ARGP(w_xkv), 2 * DM, Wxkv_t, DM, 64 * kb, 32 * nb, 32 * nb, ARGP(norm_mem), scr, lane); continue; } r -= I_XKV;
            if (r < I_XO) { const int kb = r / 32, nb = r % 32; transpose_item(ARGP(w_xo), DM, Wxo_t, DM, 64 * kb, 32 * nb, 32 * nb, nullptr, scr, lane); continue; } r -= I_XO;
            if (r < I_G + I_U) { const int up = r >= I_G; const int q = up ? r - I_G : r; const int e = q / 128, kb = (q % 128) / 8, nb = q % 8; const int n0 = 32 * nb;
                const float* W = (up ? ARGP(w_up) : ARGP(w_gate)) + (size_t)e * DM * DFF;
                transpose_item8(W, DFF, (unsigned char*)Wgu_t + (size_t)e * 512 * DM, DM, 64 * kb, n0, 256 * (n0 / 128) + (n0 % 128) + (up ? 128 : 0), ARGP(norm_ffn), WGU_SCALE, scr, lane); continue; } r -= I_G + I_U;
            if (r < I_D) { const int e = r / 128, kb = (r % 128) / 32, nb = r % 32; transpose_item8(ARGP(w_down) + (size_t)e * DFF * DM, DM, (unsigned char*)Wd_t + (size_t)e * DM * DFF, DFF, 64 * kb, 32 * nb, 32 * nb, nullptr, WD_SCALE, scr, lane); continue; } r -= I_D;
            { const int k = r; const float gk = ARGP(norm_xattn)[k]; const f32x4* src = (const f32x4*)(ARGP(w_xq) + (size_t)k * DM) + lane; u32x2* dst = (u32x2*)(Wxq_n + (size_t)k * DM) + lane;
#pragma unroll
              for (int j = 0; j < 4; ++j) { const f32x4 v = src[64 * j] * gk; u32x2 w; w.x = cvt_pk_bf16(v[0], v[1]); w.y = cvt_pk_bf16(v[2], v[3]); dst[64 * j] = w; } }
        }
        __syncthreads();
        const float* xin = ARGP(x); const float* memin = ARGP(mem); const float* bfg = ARGP(b_forget);
        constexpr int TOT = M + MEMROWS;
#define P0_LOAD(vv, rw) do { if ((rw) < TOT) { const bool im_ = (rw) >= M; const f32x4* xr_ = (const f32x4*)((im_ ? memin : xin) + (size_t)(im_ ? (rw) - M : (rw)) * DM) + lane; \
        _Pragma("unroll") for (int j = 0; j < 4; ++j) vv[j] = __builtin_nontemporal_load(xr_ + 64 * j); } } while (0)
#define P0_ROW(vv, rw) do { const int row_ = (rw); const bool is_mem = row_ >= M; const int r = is_mem ? row_ - M : row_; float s = 0.f; \
        _Pragma("unroll") for (int j = 0; j < 4; ++j) s += (vv[j][0] * vv[j][0] + vv[j][1] * vv[j][1]) + (vv[j][2] * vv[j][2] + vv[j][3] * vv[j][3]); \
        const float rinv = rsqrtf(wave_sum(s) * (1.0f / DM) + EPS); \
        u32x2* o8 = (u32x2*)((is_mem ? MEMB : XB) + (size_t)r * DM) + lane; \
        _Pragma("unroll") for (int j = 0; j < 4; ++j) { u32x2 w; w.x = cvt_pk_bf16(vv[j][0], vv[j][1]); w.y = cvt_pk_bf16(vv[j][2], vv[j][3]); o8[64 * j] = w; } \
        if (is_mem) { if (lane == 0) RMEM[r] = rinv; } \
        else { float f[8]; \
            _Pragma("unroll") for (int jj = 0; jj < 8; ++jj) { float a = 0.f; \
                _Pragma("unroll") for (int j = 0; j < 4; ++j) { const f32x4 w4 = *(const LAS f32x4*)(wfT + jj * DM + 256 * j + 4 * lane); a += (vv[j][0] * w4[0] + vv[j][1] * w4[1]) + (vv[j][2] * w4[2] + vv[j][3] * w4[3]); } \
                f[jj] = wave_sum(a); } \
            if (lane == 0) RX[r] = rinv; \
            if (lane < 8) { float fl = 0.f; \
                _Pragma("unroll") for (int jj = 0; jj < 8; ++jj) fl = (lane == jj) ? f[jj] : fl; \
                fl = fl * rinv + bfg[lane]; \
                const float ls = fminf(fl, 0.f) - log1pf(expf(-fabsf(fl))); \
                LF[(size_t)r * 8 + lane] = ls * LOG2E; } } } while (0)
        f32x4 va[4], vb[4], vc[4];
        P0_LOAD(va, gw); P0_LOAD(vb, gw + NGW);
        for (int row = gw; row < TOT; row += 3 * NGW) {
            P0_LOAD(vc, row + 2 * NGW); P0_ROW(va, row);
            if (row + NGW < TOT) { P0_LOAD(va, row + 3 * NGW); P0_ROW(vb, row + NGW); }
            if (row + 2 * NGW < TOT) { P0_LOAD(vb, row + 4 * NGW); P0_ROW(vc, row + 2 * NGW); }
        }
#undef P0_LOAD
#undef P0_ROW
    }
    xcd_barrier(bar);
    if (PROBE_HI == 0) t_pb = __builtin_amdgcn_s_memrealtime();

    if (PROBE_LO == 1) t_pa = __builtin_amdgcn_s_memrealtime();
    if (PH(1))
    if (vcu < 32) {
        PHASE_PTRS
        const int b = vcu >> 2, h = (vcu & 3) * 2 + (wave >> 2), seg = wave & 3, s0 = seg * 2048 + lane * 32;
        const float* src = LF + ((size_t)b * SEQ + s0) * 8 + h;
        float p[32];
#pragma unroll
        for (int j = 0; j < 32; ++j) p[j] = src[j * 8];
#pragma unroll
        for (int j = 1; j < 32; ++j) p[j] += p[j - 1];
        float inc = p[31];
#pragma unroll
        for (int o = 1; o < 64; o <<= 1) { const float y = __shfl_up(inc, o); if (lane >= o) inc += y; }
        LAS float* tot = (LAS float*)(lds + EXTRA_OFF);
        if (lane == 63) tot[wave] = inc;
        __syncthreads();
        float off = inc - p[31];
        for (int q = 0; q < 3; ++q) if (q < seg) off += tot[(wave & 4) + q];
        float* dst = CC + ((size_t)b * NH + h) * SEQ + s0; bf16_t* kx = KX + (((size_t)b * NH + h) * SEQ + s0) * 8;
#pragma unroll
        for (int j = 0; j < 32; ++j) { const float x = off + p[j]; dst[j] = x;
            unsigned hm, lo; fox::split3(-x, hm, lo); u32x4 w; w.x = 0x3F803F80u; w.y = 0x3F80u | (hm << 16); w.z = (hm >> 16) | (lo << 16); w.w = 0u;
            *(u32x4*)(kx + j * 8) = w; }
        VM_WAIT(); __syncthreads();
    }
    if (PH(1))
    for (int rep_ = 0; rep_ < REPS(1); ++rep_)
    {
        PHASE_PTRS
        pg8::Gemm g{DM, DM, DM};
        SchedDense S{(const char*)XB, (const char*)Win_t, M / 256, NPROJ / 256, G, bx, (size_t)256 * DM * 2, (size_t)256 * DM * 2, 0, 2};
        LAS float* rst = (LAS float*)(lds + EXTRA_OFF);
#pragma unroll
        for (int q = 0; q < 8; ++q) { const int idx = tid + 512 * q, i = idx >> 8, r = idx & 255; int pm, pn; if (pg8::tile_order(i, G, bx, M / 256, NPROJ / 256, pm, pn)) rst[idx] = RX[pm * 256 + r]; }
        VM_WAIT(); __syncthreads();
        pg8::EpiBf16 E{QKV, HW, RX, QKV_STRIDE, C2, C2, ctl + CW_KN, rst, 1.f, false};
        pg8::gemm_phase<pg8::EpiBf16, SchedDense, true, false>(lds + RING_OFF, g, S, E);
    }
    xcd_barrier(bar);
    if (PROBE_HI == 1) t_pb = __builtin_amdgcn_s_memrealtime();

    if (PROBE_LO == 2) t_pa = __builtin_amdgcn_s_memrealtime();
    if (PH(2))
    {
        PHASE_PTRS
        const bf16_t* QA = QKV; const bf16_t* KA = QKV + QKV_STRIDE; const bf16_t* VA = QKV + 2 * QKV_STRIDE;
        const bf16_t* QBp = QKV + 3 * QKV_STRIDE; const bf16_t* KBp = QKV + 4 * QKV_STRIDE; const bf16_t* VBp = QKV + 5 * QKV_STRIDE;
        bf16_t* OA = OAB; bf16_t* OB = OAB + HW;
        LAS char* shm = (LAS char*)(lds + RING_OFF);
        { pg8::Gemm g{DM, DM, DM};
          SchedDense S2{(const char*)MEMB, (const char*)Wxkv_t, MEMROWS / 256, 2 * DM / 256, G, bx, (size_t)256 * DM * 2, (size_t)256 * DM * 2, 0, 0};
          pg8::EpiBf16 E2{KVM, 2 * DM, RMEM, 0, 1.f, 1.f, nullptr, nullptr, 1.f, false};
          pg8::gemm_phase<pg8::EpiBf16, SchedDense, true, false>(lds + RING_OFF, g, S2, E2);
          VM_WAIT(); __syncthreads(); }
        for (int rep = 0; rep < REP_FOX; ++rep)
        for (int i = 0; i < 8; ++i) { const int bh = (vcu >> 5) * 8 + i, x = vcu & 31, qb = (i & 1) ? 31 - x : x;
            const float kmax = sqrtf(__uint_as_float(ctl[CW_KN + bh * 2]) + __uint_as_float(ctl[CW_KN + bh * 2 + 1])) * 1.01f;
            const int nqb = ((i + 1) & 1) ? 31 - x : x;
            fox::fox_unit<8>(bh, qb, QA, KA, VA, OA, HS + (bh & 7), CC + (size_t)bh * SEQ, KX, kmax, shm, i > 0, i < 7 ? bh + 1 : -1, nqb); }
        { volatile LAS unsigned* qs = MISC + 16;
          unsigned nxt = 0u;
          if (tid == 0) qs[0] = __hip_atomic_fetch_add(ctl + CW_SBQ, 1u, __ATOMIC_RELAXED, __HIP_MEMORY_SCOPE_AGENT);
          __syncthreads();
          unsigned idx = qs[0];
          while (idx < (unsigned)(BATCH * NH * 32 * REP_SB)) {
              __syncthreads();
              if (tid == 0) nxt = __hip_atomic_fetch_add(ctl + CW_SBQ, 1u, __ATOMIC_RELAXED, __HIP_MEMORY_SCOPE_AGENT);
              const int un = (int)(idx % (unsigned)(BATCH * NH * 32)), bh = un >> 5, qb = un & 31;
              sbk::sb_unit(bh >> 3, bh & 7, qb, QBp, KBp, VBp, OB, HS + 8 + (bh & 7), shm);
              if (tid == 0) qs[0] = nxt;
              __syncthreads();
              idx = qs[0];
          } }
    }
    xcd_barrier(bar);
    if (PROBE_HI == 2) t_pb = __builtin_amdgcn_s_memrealtime();

    if (PROBE_LO == 4) t_pa = __builtin_amdgcn_s_memrealtime();
    if (PH(4))
    for (int rep_ = 0; rep_ < REPS(4); ++rep_)
    {
        PHASE_PTRS
        pg8::Gemm g{DM, DM, DM};
        SchedDense S{(const char*)OAB, (const char*)Wout_t, M / 256, DM / 256, G, bx, (size_t)256 * DM * 2, (size_t)256 * DM * 2, 0, 0};
        LAS f32x2* rab = (LAS f32x2*)(lds + EXTRA_OFF);
#pragma unroll
        for (int q = 0; q < 4; ++q) { const int idx = tid + 512 * q, i = idx >> 8, r = idx & 255; int pm, pn;
            if (pg8::tile_order(i, G, bx, M / 256, DM / 256, pm, pn)) { const f32x4* p = (const f32x4*)(HS + (size_t)(pm * 256 + r) * 16); const f32x4 a0 = p[0], a1 = p[1], b0 = p[2], b1 = p[3];
                const float ra = rsqrtf((((a0[0] + a0[1]) + (a0[2] + a0[3])) + ((a1[0] + a1[1]) + (a1[2] + a1[3]))) * (1.0f / HW) + EPS);
                const float rb = rsqrtf((((b0[0] + b0[1]) + (b0[2] + b0[3])) + ((b1[0] + b1[1]) + (b1[2] + b1[3]))) * (1.0f / HW) + EPS);
                rab[idx] = (f32x2){ra / rb, rb}; } }
        VM_WAIT(); __syncthreads();
        pg8::EpiOutProj E{XB, H1B, H1F8, SSQ, rab};
        pg8::gemm_phase<pg8::EpiOutProj, SchedDense, true, false>(lds + RING_OFF, g, S, E);
        pg8::Gemm g2{0, 0, 256};
        SchedGH SG{(const char*)KVM, (const char*)Wxq_n, (const char*)Wxo_t, G, bx};
        EpiGH EG{(unsigned char*)GT, (unsigned char*)HT};
        g2.lda = 2 * DM; g2.ldb = DM; SchedGHk<0> S0{SG}; pg8::gemm_phase<EpiGH, SchedGHk<0>, true, false>(lds + RING_OFF, g2, S0, EG);
        g2.lda = DM; g2.ldb = 2 * DM; SchedGHk<1> S1{SG}; pg8::gemm_phase<EpiGH, SchedGHk<1>, true, false>(lds + RING_OFF, g2, S1, EG);
    }
    xcd_barrier(bar);
    if (PROBE_HI == 4) t_pb = __builtin_amdgcn_s_memrealtime();

    if (PROBE_LO == 5) t_pa = __builtin_amdgcn_s_memrealtime();
    if (PH(5))
    for (int rep_ = 0; rep_ < REPS(5); ++rep_)
    {
        PHASE_PTRS
        pg8::Gemm g{DM, DM, DM};
        SchedDense S{(const char*)H1F8, (const char*)GT, M / 256, DM / 256, G, bx, (size_t)256 * DM, (size_t)256 * DM, (size_t)DM * DM, 0};
        LAS float* r1t = (LAS float*)(lds + EXTRA_OFF + 8192);
#pragma unroll
        for (int q = 0; q < 4; ++q) { const int idx = tid + 512 * q, i = idx >> 8, r = idx & 255; int pm, pn;
            if (pg8::tile_order(i, G, bx, M / 256, DM / 256, pm, pn)) { const f32x4* sp = (const f32x4*)(SSQ + (size_t)(pm * 256 + r) * 16); const f32x4 s0 = sp[0], s1 = sp[1], s2 = sp[2], s3 = sp[3];
                const float tot = ((s0[0] + s0[1]) + (s0[2] + s0[3])) + ((s1[0] + s1[1]) + (s1[2] + s1[3])) + ((s2[0] + s2[1]) + (s2[2] + s2[3])) + ((s3[0] + s3[1]) + (s3[2] + s3[3]));
                r1t[idx] = rsqrtf(tot * (1.0f / DM) + EPS) * XSC; } }
        VM_WAIT(); __syncthreads();
        pg8::EpiSoftmax E{XB, r1t, (LAS float*)(lds + EXTRA_OFF)};
        pg8::gemm_phase<pg8::EpiSoftmax, SchedDense, true, false, true>(lds + RING_OFF, g, S, E);
    }
    xcd_barrier(bar);
    if (PROBE_HI == 5) t_pb = __builtin_amdgcn_s_memrealtime();

    if (PROBE_LO == 6) t_pa = __builtin_amdgcn_s_memrealtime();
    if (PH(6))
    {
        PHASE_PTRS
        pg8::Gemm g{DM, DM, DM};
        SchedDense S{(const char*)XB, (const char*)HT, M / 256, DM / 256, G, bx, (size_t)256 * DM, (size_t)256 * DM, (size_t)DM * DM, 0};
        pg8::EpiResidBf16 E{H1B, H2F8, 1.0f / P_SCALE};
        pg8::gemm_phase<pg8::EpiResidBf16, SchedDense, true, false, true>(lds + RING_OFF, g, S, E);
    }
    xcd_barrier(bar);
    if (PROBE_HI == 6) t_pb = __builtin_amdgcn_s_memrealtime();

    if (PROBE_LO == 7) t_pa = __builtin_amdgcn_s_memrealtime();
    if (PH(7))
    {
        PHASE_PTRS
        LAS bf16_t* wBh = (LAS bf16_t*)(lds + RING_OFF); LAS bf16_t* wBl = wBh + 20 * DM;
        { const f32x4* wg4 = (const f32x4*)ARGP(w_rg); const f32x4* we4 = (const f32x4*)ARGP(w_re); const float* gf = ARGP(norm_ffn);
          f32x4 ga[2], ea[2][4]; float gk[2];
#pragma unroll
          for (int q = 0; q < 2; ++q) { const int k = tid + 512 * q; ga[q] = wg4[k]; gk[q] = gf[k];
#pragma unroll
              for (int c = 0; c < 4; ++c) ea[q][c] = we4[k * 4 + c]; }
#pragma unroll
          for (int q = 0; q < 2; ++q) { const int k = tid + 512 * q;
#pragma unroll
              for (int j = 0; j < 4; ++j) { { const float v = ga[q][j] * gk[q]; const unsigned hi_ = cvt_pk_bf16(v, 0.f) & 0xffffu; wBh[j * DM + k] = (bf16_t)hi_; wBl[j * DM + k] = (bf16_t)(cvt_pk_bf16(v - __uint_as_float(hi_ << 16), 0.f) & 0xffffu); }
#pragma unroll
                  for (int c = 0; c < 4; ++c) { const float v = ea[q][c][j] * gk[q]; const unsigned hi_ = cvt_pk_bf16(v, 0.f) & 0xffffu; const int col = 4 + 4 * c + j; wBh[col * DM + k] = (bf16_t)hi_; wBl[col * DM + k] = (bf16_t)(cvt_pk_bf16(v - __uint_as_float(hi_ << 16), 0.f) & 0xffffu); } } } }
        LAS int* dec_e = (LAS int*)(lds + RING_OFF + 81920); LAS float* dec_w = (LAS float*)(lds + RING_OFF + 81920 + 2048); LAS int* dec_r = (LAS int*)(lds + RING_OFF + 81920 + 4096);
        LAS int* hist = (LAS int*)(lds + RING_OFF + 81920 + 6144); LAS int* ebase = hist + 16; LAS float* dec_v = (LAS float*)(lds + RING_OFF + 81920 + 8192);
        if (tid < 16) hist[tid] = 0;
        __syncthreads();
        const float brg0 = ARGP(b_rg)[0], brg1 = ARGP(b_rg)[1], brg2 = ARGP(b_rg)[2], brg3 = ARGP(b_rg)[3]; const float* bre = ARGP(b_re);
        const int tok = lane & 31, half = lane >> 5, jcol = tok < 20 ? tok : 19;
        for (int it = 0; it * NGW < M / 32; ++it) {
            const int T = gw + it * NGW; const bool act = T < M / 32; const int r0 = act ? 32 * T : 0;
            const bf16_t* rowp = H1B + (size_t)(r0 + tok) * DM + 512 * half;
            const LAS bf16_t* wph = wBh + jcol * DM + 512 * half; const LAS bf16_t* wpl = wBl + jcol * DM + 512 * half;
            f32x16 ah0 = f32x16{}, ah1 = f32x16{}, al0 = f32x16{}, al1 = f32x16{}; float ssq = 0.f;
#pragma unroll 4
            for (int sidx = 0; sidx < 64; sidx += 2) {
                const u32x4 a0 = *(const u32x4*)(rowp + 8 * sidx), a1 = *(const u32x4*)(rowp + 8 * sidx + 8);
                const bf16x8 wh0 = *(const LAS bf16x8*)(wph + 8 * sidx), wl0 = *(const LAS bf16x8*)(wpl + 8 * sidx), wh1 = *(const LAS bf16x8*)(wph + 8 * sidx + 8), wl1 = *(const LAS bf16x8*)(wpl + 8 * sidx + 8);
                ah0 = MFMA32(wh0, __builtin_bit_cast(bf16x8, a0), ah0); al0 = MFMA32(wl0, __builtin_bit_cast(bf16x8, a0), al0);
                ah1 = MFMA32(wh1, __builtin_bit_cast(bf16x8, a1), ah1); al1 = MFMA32(wl1, __builtin_bit_cast(bf16x8, a1), al1);
                ssq += (bf16lo(a0.x) * bf16lo(a0.x) + bf16hi(a0.x) * bf16hi(a0.x)) + (bf16lo(a0.y) * bf16lo(a0.y) + bf16hi(a0.y) * bf16hi(a0.y)) + (bf16lo(a0.z) * bf16lo(a0.z) + bf16hi(a0.z) * bf16hi(a0.z)) + (bf16lo(a0.w) * bf16lo(a0.w) + bf16hi(a0.w) * bf16hi(a0.w));
                ssq += (bf16lo(a1.x) * bf16lo(a1.x) + bf16hi(a1.x) * bf16hi(a1.x)) + (bf16lo(a1.y) * bf16lo(a1.y) + bf16hi(a1.y) * bf16hi(a1.y)) + (bf16lo(a1.z) * bf16lo(a1.z) + bf16hi(a1.z) * bf16hi(a1.z)) + (bf16lo(a1.w) * bf16lo(a1.w) + bf16hi(a1.w) * bf16hi(a1.w));
            }
            const float rinv = rsqrtf((att::swap_lo(ssq) + att::swap_hi(ssq)) * (1.0f / DM) + EPS);
            float lg[20];
#pragma unroll
            for (int r = 0; r < 12; ++r) { const float c = (ah0[r] + ah1[r]) + (al0[r] + al1[r]); auto rr = __builtin_amdgcn_permlane32_swap(__float_as_uint(c), __float_as_uint(c), false, false);
                const int jl = (r & 3) + 8 * (r >> 2); lg[jl] = __uint_as_float(rr[0]) * rinv; if (r < 8) lg[jl + 4] = __uint_as_float(rr[1]) * rinv; }
            float g0 = lg[0] + brg0, g1 = lg[1] + brg1, g2 = lg[2] + brg2, g3 = lg[3] + brg3;
            int gi = 0; float gm = g0; if (g1 > gm) { gm = g1; gi = 1; } if (g2 > gm) { gm = g2; gi = 2; } if (g3 > gm) { gm = g3; gi = 3; }
            const float gval = 1.0f / (expf(g0 - gm) + expf(g1 - gm) + expf(g2 - gm) + expf(g3 - gm));
            float el[4];
#pragma unroll
            for (int j = 0; j < 4; ++j) { const float e0 = lg[4 + j], e1 = lg[8 + j], e2 = lg[12 + j], e3 = lg[16 + j]; el[j] = ((gi == 0) ? e0 : (gi == 1) ? e1 : (gi == 2) ? e2 : e3) + bre[gi * 4 + j]; }
            int i0 = 0; float m0 = el[0];
#pragma unroll
            for (int j = 1; j < 4; ++j) if (el[j] > m0) { m0 = el[j]; i0 = j; }
            int i1 = -1; float m1 = -3.0e38f;
#pragma unroll
            for (int j = 0; j < 4; ++j) if (j != i0 && el[j] > m1) { m1 = el[j]; i1 = j; }
            const float w0 = 1.0f / (1.0f + expf(m1 - m0)), w1 = 1.0f - w0;
            if (act) { const int e = gi * 4 + (half == 0 ? i0 : i1); const float w = gval * (half == 0 ? w0 : w1);
                const int idx = (wave * 32 + tok) * 2 + half; dec_e[idx] = e; dec_w[idx] = w; dec_v[idx] = rinv; dec_r[idx] = __hip_atomic_fetch_add(hist + e, 1, __ATOMIC_RELAXED, __HIP_MEMORY_SCOPE_WORKGROUP); }
            __syncthreads();
            if (tid < 16) { const int n = hist[tid]; ebase[tid] = n ? (int)__hip_atomic_fetch_add(ctl + CW_CNT + 64 * tid, (unsigned)n, __ATOMIC_RELAXED, __HIP_MEMORY_SCOPE_AGENT) : 0; }
            __syncthreads();
            if (act) { const int row = r0 + (lane >> 1), idx = wave * 64 + lane; const int e = dec_e[idx], pos = ebase[e] + dec_r[idx];
                LIST[(size_t)e * M + pos] = row; R2S[(size_t)e * M + pos] = dec_v[idx]; TOKSLOT[(size_t)row * 2 + (lane & 1)] = (e << 20) | pos; TOKW[(size_t)row * 2 + (lane & 1)] = dec_w[idx]; }
            __syncthreads();
            if (tid < 16) hist[tid] = 0;
            __syncthreads();
        }
    }
    xcd_barrier(bar);
    if (PROBE_HI == 7) t_pb = __builtin_amdgcn_s_memrealtime();

    if (PROBE_LO == 8) t_pa = __builtin_amdgcn_s_memrealtime();
    if (PH(8))
    for (int rep_ = 0; rep_ < REPS(8); ++rep_)
    {
        PHASE_PTRS
        pg8::Gemm g{DM, DM, DM};
        LAS int* tbl = (LAS int*)(lds + EXTRA_OFF + 8192); moe_table(tbl, ctl);
        SchedMoe S; S.A = (const char*)H2F8; S.W = (const char*)Wgu_t; S.list = LIST; S.tbl = tbl; S.G = G; S.c = bx; S.NPN = 2; S.w_exp = (size_t)512 * DM; S.w_tile = (size_t)256 * DM; S.a_tile = 0; S.ocol_w = 128;
        pg8::EpiSwiglu E{HID, R2S, LIST};
        pg8::gemm_phase<pg8::EpiSwiglu, SchedMoe, true, true, true>(lds + RING_OFF, g, S, E);
    }
    xcd_barrier(bar);
    if (PROBE_HI == 8) t_pb = __builtin_amdgcn_s_memrealtime();

    if (PROBE_LO == 9) t_pa = __builtin_amdgcn_s_memrealtime();
    if (PH(9))
    for (int rep_ = 0; rep_ < REPS(9); ++rep_)
    {
        PHASE_PTRS
        pg8::Gemm g{DFF, DFF, DFF};
        LAS int* tbl = (LAS int*)(lds + EXTRA_OFF + 8192);
        SchedMoe S; S.A = (const char*)HID; S.W = (const char*)Wd_t; S.list = LIST; S.tbl = tbl; S.G = G; S.c = bx; S.NPN = 4; S.w_exp = (size_t)DM * DFF; S.w_tile = (size_t)256 * DFF; S.a_tile = (size_t)256 * DFF; S.ocol_w = 256;
        pg8::EpiBf16 E{YB, DM, nullptr, 0, 1.f, 1.f, nullptr, nullptr, 1.0f / WD_SCALE, true};
        pg8::gemm_phase<pg8::EpiBf16, SchedMoe, true, false, true>(lds + RING_OFF, g, S, E);
    }
    xcd_barrier(bar);
    if (PROBE_HI == 9) t_pb = __builtin_amdgcn_s_memrealtime();

    if (PROBE_LO == 10) t_pa = __builtin_amdgcn_s_memrealtime();
    if (PH(10))
    {
        PHASE_PTRS
        const LAS int* tb = (const LAS int*)(lds + EXTRA_OFF + 8192);
        const f32x4* gp = (const f32x4*)ARGP(norm_final) + lane;
        int sl0 = 0, sl1 = 0; float sw0 = 0.f, sw1 = 0.f;
        unsigned ya_n[4], yb_n[4]; u32x2 hh_n[4]; float w0_n = 0.f, w1_n = 0.f;
#define P10_SLOTS(rw) do { sl0 = TOKSLOT[(size_t)(rw) * 2]; sl1 = TOKSLOT[(size_t)(rw) * 2 + 1]; sw0 = TOKW[(size_t)(rw) * 2]; sw1 = TOKW[(size_t)(rw) * 2 + 1]; } while (0)
#define P10_DATA(rw) do { const int r0_ = tb[sl0 >> 20] * 256 + (sl0 & 0xfffff), r1_ = tb[sl1 >> 20] * 256 + (sl1 & 0xfffff); w0_n = sw0; w1_n = sw1; \
        const unsigned* y0_ = (const unsigned*)((const unsigned char*)YB + (size_t)r0_ * DM) + lane; const unsigned* y1_ = (const unsigned*)((const unsigned char*)YB + (size_t)r1_ * DM) + lane; const u32x2* h_ = (const u32x2*)(H1B + (size_t)(rw) * DM) + lane; \
        _Pragma("unroll") for (int j = 0; j < 4; ++j) { ya_n[j] = y0_[64 * j]; yb_n[j] = y1_[64 * j]; hh_n[j] = h_[64 * j]; } } while (0)
        if (gw < M) { P10_SLOTS(gw); P10_DATA(gw); if (gw + NGW < M) P10_SLOTS(gw + NGW); }
        for (int row = gw; row < M; row += NGW) {
            unsigned ya[4], yb[4]; u32x2 hh[4]; const float w0 = w0_n, w1 = w1_n;
#pragma unroll
            for (int j = 0; j < 4; ++j) { ya[j] = ya_n[j]; yb[j] = yb_n[j]; hh[j] = hh_n[j]; }
            if (row + NGW < M) { P10_DATA(row + NGW); if (row + 2 * NGW < M) P10_SLOTS(row + 2 * NGW); }
            f32x4* hr = (f32x4*)(out + (size_t)row * DM) + lane;
            f32x4 v[4]; float s = 0.f;
#pragma unroll
            for (int j = 0; j < 4; ++j) { const u32x2 hx = hh[j]; f32x4 h = {bf16lo(hx.x), bf16hi(hx.x), bf16lo(hx.y), bf16hi(hx.y)};
                const f32x2 a01 = __builtin_amdgcn_cvt_pk_f32_fp8((int)ya[j], false), a23 = __builtin_amdgcn_cvt_pk_f32_fp8((int)ya[j], true), b01 = __builtin_amdgcn_cvt_pk_f32_fp8((int)yb[j], false), b23 = __builtin_amdgcn_cvt_pk_f32_fp8((int)yb[j], true);
                h[0] += w0 * a01[0] + w1 * b01[0]; h[1] += w0 * a01[1] + w1 * b01[1]; h[2] += w0 * a23[0] + w1 * b23[0]; h[3] += w0 * a23[1] + w1 * b23[1];
                v[j] = h; s += (h[0] * h[0] + h[1] * h[1]) + (h[2] * h[2] + h[3] * h[3]); }
            const float rinv = rsqrtf(wave_sum(s) * (1.0f / DM) + EPS);
#pragma unroll
            for (int j = 0; j < 4; ++j) __builtin_nontemporal_store(v[j] * rinv * gp[64 * j], hr + 64 * j);
        }
#undef P10_SLOTS
#undef P10_DATA
    }
    if (PROBE_LO >= 0) {
        if (PROBE_HI == 10) t_pb = __builtin_amdgcn_s_memrealtime();
        if (blockIdx.x == 0 && threadIdx.x == 0) { const unsigned long long t0 = __builtin_amdgcn_s_memrealtime(), span = 2 * (t_pb - t_pa);
            while (__builtin_amdgcn_s_memrealtime() - t0 < span) __builtin_amdgcn_s_sleep(8); }
    }
}

extern "C" void kernel_launch(void* const* d_in, const int* in_sizes, int n_in, void* d_out, int out_size, void* d_ws, size_t ws_size, hipStream_t stream) {
    static int grid = 0;
    if (grid == 0) {
        if (n_in != 22 || in_sizes[0] != M * DM || out_size != M * DM || ws_size < WS_END) { fprintf(stderr, "kernel_launch: unexpected shapes (n_in %d, in0 %d, out %d, ws %zu)\n", n_in, n_in > 0 ? in_sizes[0] : -1, out_size, ws_size); grid = -1; return; }
        int dev = 0, cus = 0, per_cu = 0;
        if (hipGetDevice(&dev) != hipSuccess || hipDeviceGetAttribute(&cus, hipDeviceAttributeMultiprocessorCount, dev) != hipSuccess) { grid = -1; return; }
        if (hipFuncSetAttribute((const void*)hymba_fwd, hipFuncAttributeMaxDynamicSharedMemorySize, LDS_BYTES) != hipSuccess) { fprintf(stderr, "kernel_launch: hipFuncSetAttribute failed\n"); grid = -1; return; }
        if (hipOccupancyMaxActiveBlocksPerMultiprocessor(&per_cu, (const void*)hymba_fwd, NWAVES * 64, LDS_BYTES) != hipSuccess || per_cu < 1) { fprintf(stderr, "kernel_launch: occupancy query reports %d\n", per_cu); }
        (void)hipGetLastError();
        grid = cus;
    }
    if (grid < 0) return;
    (void)hipMemsetAsync((char*)d_ws + WS_CTL, 0, CTL_ZERO_BYTES, stream);
    Args a{};
    const float** p = (const float**)&a;
    for (int i = 0; i < 22; ++i) p[i] = (const float*)d_in[i];
    a.out = (float*)d_out; a.ws = (unsigned char*)d_ws;
    hipLaunchKernelGGL(hymba_fwd, dim3(grid), dim3(NWAVES * 64), LDS_BYTES, stream, a);
}
```

```cpp
#include <hip/hip_runtime.h>
#include <hip/hip_bf16.h>
#include <cstdio>
#include <cstdint>

#define LAS __attribute__((address_space(3)))
#define GAS __attribute__((address_space(1)))
typedef unsigned short bf16_t;
typedef short bf16x8 __attribute__((ext_vector_type(8)));
typedef short s16x4 __attribute__((ext_vector_type(4)));
typedef float f32x4 __attribute__((ext_vector_type(4)));
typedef float f32x2 __attribute__((ext_vector_type(2)));
typedef float f32x16 __attribute__((ext_vector_type(16)));
typedef unsigned u32x4 __attribute__((ext_vector_type(4)));
typedef unsigned u32x2 __attribute__((ext_vector_type(2)));
typedef __bf16 bf16x2_t __attribute__((ext_vector_type(2)));

constexpr int BATCH = 8, SEQ = 8192, DM = 1024, M = BATCH * SEQ;
constexpr int NH = 8, HD = 64, HW = NH * HD;
constexpr int NPROJ = 3 * HW * 2;
constexpr int WIN_LD = NPROJ + NH;
constexpr int NMEM = 256, XH = 4, XD = 256, MEMROWS = BATCH * NMEM;
constexpr int NEXP = 16, DFF = 256;
constexpr float EPS = 1e-6f;
constexpr float LOG2E = 1.4426950408889634f;
constexpr float C2 = 0.125f * LOG2E;
constexpr float XSC = 0.0625f * LOG2E;
constexpr float P_SCALE = 128.0f;
constexpr float WGU_SCALE = 32.0f;
constexpr float WD_SCALE = 16.0f;
constexpr float SB_EXIT = -48.0f;

constexpr size_t MiB = 1u << 20;
constexpr size_t WS_CTL = 0, CTL_ZERO_BYTES = 128 * 1024;
constexpr size_t WS_WIN = 1 * MiB;
constexpr size_t WS_WOUT = 7 * MiB;
constexpr size_t WS_WXQ = 9 * MiB;
constexpr size_t WS_WXKV = 11 * MiB;
constexpr size_t WS_WXO = 15 * MiB;
constexpr size_t WS_WGU = 17 * MiB;
constexpr size_t WS_WD = 33 * MiB;
constexpr size_t WS_RX = 41 * MiB;
constexpr size_t WS_RMEM = WS_RX + 256 * 1024;
constexpr size_t WS_R2 = WS_RX + 512 * 1024;
constexpr size_t WS_LF = 42 * MiB;
constexpr size_t WS_C2 = 44 * MiB;
constexpr size_t WS_SSQ = 46 * MiB;
constexpr size_t WS_TOKSLOT = 50 * MiB;
constexpr size_t WS_TOKW = 51 * MiB;
constexpr size_t WS_LIST = 52 * MiB;
constexpr size_t WS_MEMB = 56 * MiB;
constexpr size_t WS_KVM = 60 * MiB;
constexpr size_t WS_GT = 68 * MiB;
constexpr size_t WS_HT = 84 * MiB;
constexpr size_t WS_KX = 100 * MiB;
constexpr size_t WS_HS = 108 * MiB;
constexpr size_t WS_XB = 128 * MiB;
constexpr size_t WS_QKV = 256 * MiB;
constexpr size_t WS_H1B = 256 * MiB, WS_U2B = 384 * MiB, WS_HID = 512 * MiB;
constexpr size_t WS_H1F8 = 384 * MiB, WS_H2F8 = 448 * MiB;
constexpr size_t WS_O = 640 * MiB;
constexpr size_t WS_Y = 704 * MiB;
constexpr size_t WS_END = 1024 * MiB;
constexpr size_t QKV_STRIDE = (size_t)M * HW;
constexpr int MAXTILES = M * 2 / 256 + NEXP;
static_assert(WS_Y + (size_t)MAXTILES * 256 * 1024 * 2 <= WS_END, "ws map");
static_assert(WS_HID + (size_t)MAXTILES * 256 * 256 * 2 <= WS_O, "ws map");
constexpr int CW_BAR = 4096;
constexpr int CW_SBQ = 20736;
constexpr int CW_KN = 20480;
constexpr int CW_CNT = 16384;

constexpr int RING_OFF = 0, RING_BYTES = 131072;
constexpr int EXTRA_OFF = 131072, EXTRA_BYTES = 16384;
constexpr int MISC_OFF = EXTRA_OFF + EXTRA_BYTES;
constexpr int LDS_BYTES = MISC_OFF + 1024;
constexpr int NWAVES = 8;
#ifndef PHASE_MASK
#define PHASE_MASK 0x7ff
#endif
#define PH(n) ((PHASE_MASK >> (n)) & 1)
#ifndef PROBE_LO
#define PROBE_LO -1
#endif
#ifndef PROBE_HI
#define PROBE_HI -1
#endif
#ifndef FOX_V2
#define FOX_V2 1
#endif
#ifndef REP_MASK
#define REP_MASK 0
#endif
#define REPS(n) (1 + ((REP_MASK >> (n)) & 1))
#ifndef REP_FOX
#define REP_FOX 1
#endif
#ifndef REP_SB
#define REP_SB 1
#endif

__device__ __forceinline__ unsigned cvt_pk_bf16(float lo, float hi) { f32x2 v = {lo, hi}; bf16x2_t b = __builtin_convertvector(v, bf16x2_t); return __builtin_bit_cast(unsigned, b); }
__device__ __forceinline__ unsigned cvt4_fp8(float a, float b, float c, float d) { int w = 0; w = __builtin_amdgcn_cvt_pk_fp8_f32(a, b, w, false); w = __builtin_amdgcn_cvt_pk_fp8_f32(c, d, w, true); return (unsigned)w; }
__device__ __forceinline__ float bf16lo(unsigned u) { return __uint_as_float(u << 16); }
__device__ __forceinline__ float bf16hi(unsigned u) { return __uint_as_float(u & 0xffff0000u); }
#define DPP_ADD(v, CTRL) v += __builtin_bit_cast(float, __builtin_amdgcn_update_dpp(0, __builtin_bit_cast(int, v), CTRL, 0xf, 0xf, true))
__device__ __forceinline__ float wave_sum(float v) {
    DPP_ADD(v, 0xB1); DPP_ADD(v, 0x4E); DPP_ADD(v, 0x141); DPP_ADD(v, 0x140);
    const int iv = __builtin_bit_cast(int, v);
    return (__builtin_bit_cast(float, __builtin_amdgcn_readlane(iv, 0)) + __builtin_bit_cast(float, __builtin_amdgcn_readlane(iv, 16))) +
           (__builtin_bit_cast(float, __builtin_amdgcn_readlane(iv, 32)) + __builtin_bit_cast(float, __builtin_amdgcn_readlane(iv, 48)));
}
#define LDS_WAIT() asm volatile("s_waitcnt lgkmcnt(0)" ::: "memory")
#define VM_WAIT() asm volatile("s_waitcnt vmcnt(0)" ::: "memory")

namespace pg8 {
constexpr int BM = 256, BK = 64, HALF = 128, HTB = HALF * BK * 2, STAGE_BYTES = 8 * HTB, NXCD = 8, WGM = 8;
__host__ __device__ __forceinline__ int lds_byte(int r, int c) { const int st = (r >> 4) * 2 + (c >> 5), rr = r & 15, cc = c & 31, ob = rr * 64 + cc * 2; return st * 1024 + (ob ^ (((ob >> 9) & 1) << 5)); }
__host__ __device__ __forceinline__ void stage_rc(int b, int& R, int& C) { const int st = b / 1024, sb = b % 1024, swz = sb ^ (((sb >> 9) & 1) << 5); R = (st >> 1) * 16 + swz / 64; C = (st & 1) * 32 + (swz % 64) / 2; }
__host__ __device__ __forceinline__ int perm32(int rho) { const int n = rho >> 4, i = rho & 15; return 8 * (i >> 2) + 4 * n + (i & 3); }

struct Unit { const char* a; const char* b; int orow, ocol, aux; const int* rows; int nvalid; int seq; };
struct Gemm { int lda, ldb, K; };

__device__ __forceinline__ bool tile_order(int i, int G, int c, int nM, int nN, int& pm, int& pn) {
    const int nwg = nM * nN; const long L = (long)i * G + c; if (L >= nwg) return false;
    int wgid = (int)L; { const int q = nwg / NXCD, r = nwg % NXCD, xcd = wgid % NXCD, off = wgid / NXCD; wgid = (xcd < r ? xcd * (q + 1) : r * (q + 1) + (xcd - r) * q) + off; }
    const int nig = WGM * nN, gid = wgid / nig, fm = gid * WGM, gsz = (nM - fm) < WGM ? (nM - fm) : WGM;
    pm = fm + ((wgid % nig) % gsz); pn = (wgid % nig) / gsz; return true;
}

typedef int v8i32 __attribute__((ext_vector_type(8)));
template <class Epi, class Sched, bool ALIGN_EPI, bool GATHER, bool FP8 = false>
__device__ __forceinline__ void gemm_phase(LAS unsigned char* lds, const Gemm g, const Sched& S, const Epi& E) {
    int tid = threadIdx.x; asm volatile("" : "+v"(tid));
    const int wid = __builtin_amdgcn_readfirstlane(tid >> 6), lane = tid & 63, wr = wid >> 2, wc = wid & 3, fr = lane & 15, fq = lane >> 4;
    constexpr int ESZ = FP8 ? 1 : 2;
    const int K = g.K, nt = K / (FP8 ? 2 * BK : BK);
    unsigned voffA[2], voffB[2]; int RA[2], CA[2];
#pragma unroll
    for (int i = 0; i < 2; ++i) { int R, C; stage_rc(tid * 16 + i * 8192, R, C); const int Rb = (R & ~31) + perm32(R & 31);
        RA[i] = R; CA[i] = C; voffA[i] = (unsigned)(R * g.lda * ESZ + C * 2); voffB[i] = (unsigned)(Rb * g.ldb * ESZ + C * 2); }
    const size_t kstep = (size_t)(BK * 2);
    const size_t hstepA = (size_t)HALF * g.lda * ESZ, hstepB = (size_t)HALF * g.ldb * ESZ;
    const unsigned ldsw = (unsigned)wid * 1024u;
    const int aoff = lds_byte(wr * 64 + fr, FP8 ? fq * 16 : fq * 8), boff = lds_byte(wc * 32 + fr, FP8 ? fq * 16 : fq * 8);
    constexpr int KOFF = FP8 ? 16 : 1024;
#define PG8_SA(b, h) (((b) * 2 + (h)) * HTB)
#define PG8_SB(b, h) ((4 + (b) * 2 + (h)) * HTB)
#define PG8_STAGE2(bufoff, gbase, v0, v1) do { \
        __builtin_amdgcn_global_load_lds((const unsigned*)((const char*)(gbase) + (v0)), (LAS unsigned*)(lds + (bufoff) + ldsw), 16, 0, 0); \
        __builtin_amdgcn_global_load_lds((const unsigned*)((const char*)(gbase) + (v1)), (LAS unsigned*)(lds + (bufoff) + ldsw + 8192), 16, 0, 0); } while (0)
#define PG8_STAGEB(bufoff, gbase) PG8_STAGE2(bufoff, gbase, voffB[0], voffB[1])
#define PG8_STAGEA(bufoff, kptr, h, NX) do { if constexpr (GATHER) { const unsigned v0_ = (NX) ? gvn[h][0] : gvc[h][0], v1_ = (NX) ? gvn[h][1] : gvc[h][1]; PG8_STAGE2(bufoff, kptr, v0_, v1_); } \
        else { PG8_STAGE2(bufoff, (kptr) + (h) * hstepA, voffA[0], voffA[1]); } } while (0)
#define PG8_LDA(dst, b, h) do { _Pragma("unroll") for (int m = 0; m < 4; ++m) _Pragma("unroll") for (int k = 0; k < 2; ++k) dst[m][k] = *(const LAS bf16x8*)(lds + PG8_SA(b, h) + aoff + m * 2048 + k * KOFF); } while (0)
#define PG8_LDB(dst, b, h) do { _Pragma("unroll") for (int n = 0; n < 2; ++n) _Pragma("unroll") for (int k = 0; k < 2; ++k) dst[n][k] = *(const LAS bf16x8*)(lds + PG8_SB(b, h) + boff + n * 2048 + k * KOFF); } while (0)
#define PG8_CAT(x) __builtin_shufflevector(__builtin_bit_cast(f32x4, (x)[0]), __builtin_bit_cast(f32x4, (x)[1]), 0, 1, 2, 3, 4, 5, 6, 7)
#define PG8_MMA(ai, bj, At, Bt) do { __builtin_amdgcn_s_setprio(1); _Pragma("unroll") for (int m = 0; m < 4; ++m) _Pragma("unroll") for (int n = 0; n < 2; ++n) { \
        if constexpr (FP8) { acc[ai][bj][m][n] = __builtin_amdgcn_mfma_scale_f32_16x16x128_f8f6f4(__builtin_bit_cast(v8i32, PG8_CAT(Bt[n])), __builtin_bit_cast(v8i32, PG8_CAT(At[m])), acc[ai][bj][m][n], 0, 0, 0, 0x7F7F7F7F, 0, 0x7F7F7F7F); } \
        else { _Pragma("unroll") for (int k = 0; k < 2; ++k) acc[ai][bj][m][n] = __builtin_amdgcn_mfma_f32_16x16x32_bf16(Bt[n][k], At[m][k], acc[ai][bj][m][n], 0, 0, 0); } } \
        _Pragma("unroll") for (int m = 0; m < 4; ++m) _Pragma("unroll") for (int n = 0; n < 2; ++n) asm volatile("" : "+v"(acc[ai][bj][m][n]));     \
        __builtin_amdgcn_s_setprio(0); } while (0)
#define PG8_WAIT_V(n) asm volatile("s_waitcnt vmcnt(" #n ")" ::: "memory")
#define PG8_WAIT_L(n) asm volatile("s_waitcnt lgkmcnt(" #n ")" ::: "memory")
#define PG8_BAR __builtin_amdgcn_s_barrier()
#define PG8_SCHED __builtin_amdgcn_sched_barrier(0)
#define PG8_GATHER_OFFS(dst, u) do { _Pragma("unroll") for (int h_ = 0; h_ < 2; ++h_) _Pragma("unroll") for (int i_ = 0; i_ < 2; ++i_) { const int r_ = h_ * HALF + RA[i_]; \
        const int idx_ = (u).rows[r_ < (u).nvalid ? r_ : 0]; dst[h_][i_] = (unsigned)(idx_ * g.lda * ESZ + CA[i_] * 2); } } while (0)
    Unit cur, nxt; int ui = 0;
    if (!S.next(0, cur)) return;
    cur.seq = 0;
    unsigned gvc[2][2] = {{0u, 0u}, {0u, 0u}}, gvn[2][2] = {{0u, 0u}, {0u, 0u}};
    if constexpr (GATHER) { PG8_GATHER_OFFS(gvc, cur); }
    f32x4 acc[2][2][4][2];
#pragma unroll
    for (int a = 0; a < 2; ++a)
#pragma unroll
        for (int b = 0; b < 2; ++b)
#pragma unroll
            for (int m = 0; m < 4; ++m)
#pragma unroll
                for (int n = 0; n < 2; ++n) acc[a][b][m][n] = (f32x4){0.f, 0.f, 0.f, 0.f};
    bf16x8 At[4][2], B0[2][2], B1[2][2];
    const char* cA = cur.a; const char* cB = cur.b;
    PG8_STAGEB(PG8_SB(0, 0), cB); PG8_STAGEB(PG8_SB(0, 1), cB + hstepB); PG8_STAGEA(PG8_SA(0, 0), cA, 0, false); PG8_STAGEA(PG8_SA(0, 1), cA, 1, false);
    if (wr == 1) PG8_BAR;
    PG8_WAIT_V(2); PG8_BAR;
    PG8_STAGEB(PG8_SB(1, 0), cB + kstep); PG8_STAGEA(PG8_SA(1, 0), cA + kstep, 0, false); PG8_STAGEB(PG8_SB(1, 1), cB + hstepB + kstep);
    PG8_WAIT_V(6); PG8_BAR;
    for (;;) {
        const bool has_next = S.next(ui + 1, nxt); nxt.seq = ui + 1;
        const char* nA = has_next ? nxt.a : cA; const char* nB = has_next ? nxt.b : cB;
        if constexpr (GATHER) { if (has_next) { PG8_GATHER_OFFS(gvn, nxt); } else { gvn[0][0] = gvc[0][0]; gvn[0][1] = gvc[0][1]; gvn[1][0] = gvc[1][0]; gvn[1][1] = gvc[1][1]; } }
#pragma unroll 1
        for (int t = 0; t < nt; t += 2) {
            const bool last = (t == nt - 2);
            const char* a1 = cA + (size_t)(t + 1) * kstep;
            const char* a2 = last ? nA : cA + (size_t)(t + 2) * kstep; const char* b2 = last ? nB : cB + (size_t)(t + 2) * kstep;
            const char* a3 = a2 + kstep; const char* b3 = b2 + kstep;
            PG8_LDB(B0, 0, 0); PG8_LDB(B1, 0, 1); PG8_SCHED; PG8_LDA(At, 0, 0); PG8_STAGEA(PG8_SA(1, 1), a1, 1, false);
            PG8_WAIT_V(8); PG8_WAIT_L(0); PG8_BAR; PG8_MMA(0, 0, At, B0); PG8_MMA(0, 1, At, B1); PG8_BAR; PG8_SCHED;
            PG8_LDA(At, 0, 1); PG8_STAGEB(PG8_SB(0, 0), b2); PG8_STAGEB(PG8_SB(0, 1), b2 + hstepB); PG8_STAGEA(PG8_SA(0, 0), a2, 0, last);
            PG8_WAIT_V(8); PG8_WAIT_L(0); PG8_BAR; PG8_MMA(1, 0, At, B0); PG8_MMA(1, 1, At, B1); PG8_BAR; PG8_SCHED;
            PG8_LDB(B0, 1, 0); PG8_LDB(B1, 1, 1); PG8_SCHED; PG8_LDA(At, 1, 0); PG8_STAGEA(PG8_SA(0, 1), a2, 1, last);
            PG8_WAIT_V(8); PG8_WAIT_L(0); PG8_BAR; PG8_MMA(0, 0, At, B0); PG8_MMA(0, 1, At, B1); PG8_BAR; PG8_SCHED;
            PG8_LDA(At, 1, 1); PG8_STAGEB(PG8_SB(1, 0), b3); PG8_STAGEB(PG8_SB(1, 1), b3 + hstepB); PG8_STAGEA(PG8_SA(1, 0), a3, 0, last);
            PG8_WAIT_V(8); PG8_WAIT_L(0); PG8_BAR; PG8_MMA(1, 0, At, B0); PG8_MMA(1, 1, At, B1); PG8_BAR; PG8_SCHED;
            if constexpr (Epi::HAS_MID) { if (t == (nt >> 1) - 2) { int fr3 = fr, fq3 = fq; asm volatile("" : "+v"(fr3), "+v"(fq3)); E.mid(acc, cur, wr, wc, fr3, fq3); } }
        }
        if constexpr (ALIGN_EPI) { if (wr == 0) PG8_BAR; }
        { int fr2 = fr, fq2 = fq; asm volatile("" : "+v"(fr2), "+v"(fq2));
          E(acc, cur, wr, wc, fr2, fq2); }
        if (!has_next) break;
#pragma unroll
        for (int a = 0; a < 2; ++a)
#pragma unroll
            for (int b = 0; b < 2; ++b)
#pragma unroll
                for (int m = 0; m < 4; ++m)
#pragma unroll
                    for (int n = 0; n < 2; ++n) acc[a][b][m][n] = (f32x4){0.f, 0.f, 0.f, 0.f};
        cur = nxt; cA = nA; cB = nB; ++ui;
        if constexpr (GATHER) { gvc[0][0] = gvn[0][0]; gvc[0][1] = gvn[0][1]; gvc[1][0] = gvn[1][0]; gvc[1][1] = gvn[1][1]; }
        if constexpr (ALIGN_EPI) { if (wr == 1) PG8_BAR; }
    }
    PG8_WAIT_V(0);
    if constexpr (!ALIGN_EPI) { if (wr == 0) PG8_BAR; }
    PG8_BAR;
#undef PG8_SA
#undef PG8_SB
#undef PG8_STAGE2
#undef PG8_STAGEA
#undef PG8_STAGEB
#undef PG8_LDA
#undef PG8_LDB
#undef PG8_MMA
#undef PG8_CAT
#undef PG8_WAIT_V
#undef PG8_WAIT_L
#undef PG8_BAR
#undef PG8_SCHED
#undef PG8_GATHER_OFFS
}

#define EPI_ROW(u, ai, m) ((u).orow + (ai) * HALF + wr * 64 + (m) * 16 + fr)
#define EPI_COL(u, bj) ((u).ocol + (bj) * HALF + wc * 32 + 8 * fq)
struct EpiBf16 {
    static constexpr bool HAS_MID = false;
    bf16_t* O; int ldc; const float* rs; size_t stride; float sc0, sc3;
    unsigned* kn;
    const LAS float* rst;
    float mul;
    bool out8;
    __device__ __forceinline__ void operator()(const f32x4 (&acc)[2][2][4][2], const Unit& u, int wr, int wc, int fr, int fq) const {
        bf16_t* base = O + (size_t)u.aux * stride;
        const float sc = ((u.aux == 0) ? sc0 : ((u.aux == 3) ? sc3 : 1.f)) * mul;
        float nmax[2] = {0.f, 0.f}; const bool dokn = kn && u.aux == 1;
#pragma unroll
        for (int ai = 0; ai < 2; ++ai)
#pragma unroll
            for (int m = 0; m < 4; ++m) { const int row = EPI_ROW(u, ai, m); const float s = (rst ? rst[u.seq * 256 + ai * HALF + wr * 64 + m * 16 + fr] : (rs ? rs[row] : 1.f)) * sc;
#pragma unroll
                for (int bj = 0; bj < 2; ++bj) { const f32x4 v0 = acc[ai][bj][m][0] * s, v1 = acc[ai][bj][m][1] * s;
                    if (out8) { u32x2 w8; w8.x = cvt4_fp8(v0[0], v0[1], v0[2], v0[3]); w8.y = cvt4_fp8(v1[0], v1[1], v1[2], v1[3]); *(u32x2*)((unsigned char*)base + (size_t)row * ldc + EPI_COL(u, bj)) = w8; }
                    else { u32x4 w; w.x = cvt_pk_bf16(v0[0], v0[1]); w.y = cvt_pk_bf16(v0[2], v0[3]); w.z = cvt_pk_bf16(v1[0], v1[1]); w.w = cvt_pk_bf16(v1[2], v1[3]);
                    __builtin_nontemporal_store(w, (u32x4*)(base + (size_t)row * ldc + EPI_COL(u, bj))); }
                    if (dokn) { float q = (v0[0] * v0[0] + v0[1] * v0[1]) + (v0[2] * v0[2] + v0[3] * v0[3]) + (v1[0] * v1[0] + v1[1] * v1[1]) + (v1[2] * v1[2] + v1[3] * v1[3]);
                        q += __shfl_xor(q, 16); q += __shfl_xor(q, 32); nmax[bj] = fmaxf(nmax[bj], q); } } }
        if (dokn) {
#pragma unroll
            for (int bj = 0; bj < 2; ++bj) { float q = nmax[bj]; q = fmaxf(q, __shfl_xor(q, 1)); q = fmaxf(q, __shfl_xor(q, 2)); q = fmaxf(q, __shfl_xor(q, 4)); q = fmaxf(q, __shfl_xor(q, 8));
                const int head = ((u.ocol + bj * HALF) >> 6) + (wc >> 1), bt = u.orow / SEQ;
                if ((fr | fq) == 0) atomicMax(kn + ((bt * NH + head) * 2 + (wc & 1)), __float_as_uint(q)); }
        }
    }
};
struct EpiResid {
    static constexpr bool HAS_MID = false;
    const float* res; float* out; bf16_t* hb; float* ssq;
    __device__ __forceinline__ void operator()(const f32x4 (&acc)[2][2][4][2], const Unit& u, int wr, int wc, int fr, int fq) const {
#pragma unroll
        for (int ai = 0; ai < 2; ++ai)
#pragma unroll
            for (int m = 0; m < 4; ++m) { const int row = EPI_ROW(u, ai, m); float q = 0.f;
#pragma unroll
                for (int bj = 0; bj < 2; ++bj) { const size_t off = (size_t)row * DM + EPI_COL(u, bj);
                    const f32x4 r0 = *(const f32x4*)(res + off), r1 = *(const f32x4*)(res + off + 4);
                    const f32x4 v0 = acc[ai][bj][m][0] + r0, v1 = acc[ai][bj][m][1] + r1;
                    *(f32x4*)(out + off) = v0; *(f32x4*)(out + off + 4) = v1;
                    q += (v0[0] * v0[0] + v0[1] * v0[1]) + (v0[2] * v0[2] + v0[3] * v0[3]) + (v1[0] * v1[0] + v1[1] * v1[1]) + (v1[2] * v1[2] + v1[3] * v1[3]);
                    if (hb) { u32x4 w; w.x = cvt_pk_bf16(v0[0], v0[1]); w.y = cvt_pk_bf16(v0[2], v0[3]); w.z = cvt_pk_bf16(v1[0], v1[1]); w.w = cvt_pk_bf16(v1[2], v1[3]); *(u32x4*)(hb + off) = w; } }
                if (ssq) { q += __shfl_xor(q, 16); q += __shfl_xor(q, 32); if (fq == 0) ssq[(size_t)row * 16 + (u.ocol >> 8) * 4 + wc] = q; } }
    }
};
struct EpiOutProj {
    static constexpr bool HAS_MID = true;
    const bf16_t* xb; bf16_t* hb; unsigned char* h8; float* ssq; const LAS f32x2* rab;
    __device__ __forceinline__ void mid(f32x4 (&acc)[2][2][4][2], const Unit& u, int wr, int wc, int fr, int fq) const {
#pragma unroll
        for (int ai = 0; ai < 2; ++ai)
#pragma unroll
            for (int m = 0; m < 4; ++m) { const float f = rab[u.seq * 256 + ai * HALF + wr * 64 + m * 16 + fr].x;
#pragma unroll
                for (int bj = 0; bj < 2; ++bj) { acc[ai][bj][m][0] *= f; acc[ai][bj][m][1] *= f; } }
    }
    __device__ __forceinline__ void operator()(const f32x4 (&acc)[2][2][4][2], const Unit& u, int wr, int wc, int fr, int fq) const {
        u32x4 xres[2][4][2];
#pragma unroll
        for (int ai = 0; ai < 2; ++ai)
#pragma unroll
            for (int m = 0; m < 4; ++m)
#pragma unroll
                for (int bj = 0; bj < 2; ++bj) xres[ai][m][bj] = *(const u32x4*)(xb + (size_t)EPI_ROW(u, ai, m) * DM + EPI_COL(u, bj));
        asm volatile("" ::: "memory");
#pragma unroll
        for (int ai = 0; ai < 2; ++ai)
#pragma unroll
            for (int m = 0; m < 4; ++m) { const int row = EPI_ROW(u, ai, m); const float rb = rab[u.seq * 256 + ai * HALF + wr * 64 + m * 16 + fr].y; float q = 0.f;
#pragma unroll
                for (int bj = 0; bj < 2; ++bj) { const size_t off = (size_t)row * DM + EPI_COL(u, bj);
                    const u32x4 xr = xres[ai][m][bj];
                    f32x4 v0 = acc[ai][bj][m][0] * rb, v1 = acc[ai][bj][m][1] * rb;
                    v0[0] += bf16lo(xr.x); v0[1] += bf16hi(xr.x); v0[2] += bf16lo(xr.y); v0[3] += bf16hi(xr.y); v1[0] += bf16lo(xr.z); v1[1] += bf16hi(xr.z); v1[2] += bf16lo(xr.w); v1[3] += bf16hi(xr.w);
                    q += (v0[0] * v0[0] + v0[1] * v0[1]) + (v0[2] * v0[2] + v0[3] * v0[3]) + (v1[0] * v1[0] + v1[1] * v1[1]) + (v1[2] * v1[2] + v1[3] * v1[3]);
                    u32x4 w; w.x = cvt_pk_bf16(v0[0], v0[1]); w.y = cvt_pk_bf16(v0[2], v0[3]); w.z = cvt_pk_bf16(v1[0], v1[1]); w.w = cvt_pk_bf16(v1[2], v1[3]); *(u32x4*)(hb + off) = w;
                    { u32x2 w8; w8.x = cvt4_fp8(v0[0], v0[1], v0[2], v0[3]); w8.y = cvt4_fp8(v1[0], v1[1], v1[2], v1[3]); *(u32x2*)(h8 + off) = w8; } }
                q += __shfl_xor(q, 16); q += __shfl_xor(q, 32); if (fq == 0) ssq[(size_t)row * 16 + (u.ocol >> 8) * 4 + wc] = q; }
    }
};
struct EpiResidBf16 {
    static constexpr bool HAS_MID = false;
    bf16_t* hb; unsigned char* h8; float mul;
    __device__ __forceinline__ void operator()(const f32x4 (&acc)[2][2][4][2], const Unit& u, int wr, int wc, int fr, int fq) const {
#pragma unroll
        for (int ai = 0; ai < 2; ++ai) {
        u32x4 xres[4][2];
#pragma unroll
            for (int m = 0; m < 4; ++m)
#pragma unroll
                for (int bj = 0; bj < 2; ++bj) xres[m][bj] = *(const u32x4*)(hb + (size_t)EPI_ROW(u, ai, m) * DM + EPI_COL(u, bj));
        asm volatile("" ::: "memory");
#pragma unroll
            for (int m = 0; m < 4; ++m) { const int row = EPI_ROW(u, ai, m);
#pragma unroll
                for (int bj = 0; bj < 2; ++bj) { const size_t off = (size_t)row * DM + EPI_COL(u, bj);
                    const u32x4 xr = xres[m][bj];
                    f32x4 v0 = acc[ai][bj][m][0] * mul, v1 = acc[ai][bj][m][1] * mul;
                    v0[0] += bf16lo(xr.x); v0[1] += bf16hi(xr.x); v0[2] += bf16lo(xr.y); v0[3] += bf16hi(xr.y); v1[0] += bf16lo(xr.z); v1[1] += bf16hi(xr.z); v1[2] += bf16lo(xr.w); v1[3] += bf16hi(xr.w);
                    u32x4 w; w.x = cvt_pk_bf16(v0[0], v0[1]); w.y = cvt_pk_bf16(v0[2], v0[3]); w.z = cvt_pk_bf16(v1[0], v1[1]); w.w = cvt_pk_bf16(v1[2], v1[3]); *(u32x4*)(hb + off) = w;
                    if (h8) { u32x2 w8; w8.x = cvt4_fp8(v0[0], v0[1], v0[2], v0[3]); w8.y = cvt4_fp8(v1[0], v1[1], v1[2], v1[3]); *(u32x2*)(h8 + off) = w8; } } }
        asm volatile("" ::: "memory"); }
    }
};
struct EpiSoftmax {
    static constexpr bool HAS_MID = false;
    bf16_t* P; const LAS float* r1t; LAS float* red;
    __device__ __forceinline__ void operator()(f32x4 (&acc)[2][2][4][2], const Unit& u, int wr, int wc, int fr, int fq) const {
#pragma unroll
        for (int ai = 0; ai < 2; ++ai)
#pragma unroll
            for (int m = 0; m < 4; ++m) { const float r1 = r1t[u.seq * 256 + ai * HALF + wr * 64 + m * 16 + fr]; float a = -3.0e38f;
#pragma unroll
                for (int bj = 0; bj < 2; ++bj)
#pragma unroll
                    for (int n = 0; n < 2; ++n) { f32x4 v = acc[ai][bj][m][n] * r1; acc[ai][bj][m][n] = v; a = fmaxf(a, fmaxf(fmaxf(v[0], v[1]), fmaxf(v[2], v[3]))); }
                a = fmaxf(a, __shfl_xor(a, 16)); a = fmaxf(a, __shfl_xor(a, 32));
                if (fq == 0) red[(ai * HALF + wr * 64 + m * 16 + fr) * 4 + wc] = a; asm volatile("" ::: "memory"); }
        LDS_WAIT(); __builtin_amdgcn_s_barrier(); asm volatile("" ::: "memory");
#pragma unroll
        for (int ai = 0; ai < 2; ++ai)
#pragma unroll
            for (int m = 0; m < 4; ++m) { const int rl = ai * HALF + wr * 64 + m * 16 + fr; const f32x4 mm = *(const LAS f32x4*)(red + rl * 4);
                const float a = fmaxf(fmaxf(mm[0], mm[1]), fmaxf(mm[2], mm[3])); float s = 0.f;
#pragma unroll
                for (int bj = 0; bj < 2; ++bj)
#pragma unroll
                    for (int n = 0; n < 2; ++n) { f32x4 v = acc[ai][bj][m][n];
                        v[0] = __builtin_amdgcn_exp2f(v[0] - a); v[1] = __builtin_amdgcn_exp2f(v[1] - a); v[2] = __builtin_amdgcn_exp2f(v[2] - a); v[3] = __builtin_amdgcn_exp2f(v[3] - a);
                        acc[ai][bj][m][n] = v; s += (v[0] + v[1]) + (v[2] + v[3]); }
                s += __shfl_xor(s, 16); s += __shfl_xor(s, 32);
                if (fq == 0) red[1024 + rl * 4 + wc] = s; }
        LDS_WAIT(); __builtin_amdgcn_s_barrier(); asm volatile("" ::: "memory");
#pragma unroll
        for (int ai = 0; ai < 2; ++ai)
#pragma unroll
            for (int m = 0; m < 4; ++m) { const int rl = ai * HALF + wr * 64 + m * 16 + fr; const int row = u.orow + rl; const f32x4 ss = *(const LAS f32x4*)(red + 1024 + rl * 4);
                const float inv = P_SCALE / ((ss[0] + ss[1]) + (ss[2] + ss[3]));
#pragma unroll
                for (int bj = 0; bj < 2; ++bj) { const f32x4 v0 = acc[ai][bj][m][0] * inv, v1 = acc[ai][bj][m][1] * inv;
                    u32x2 w8; w8.x = cvt4_fp8(v0[0], v0[1], v0[2], v0[3]); w8.y = cvt4_fp8(v1[0], v1[1], v1[2], v1[3]);
                    *(u32x2*)((unsigned char*)P + (size_t)row * DM + EPI_COL(u, bj)) = w8; } }
    }
};
struct EpiSwiglu {
    static constexpr bool HAS_MID = false;
    bf16_t* Hd; const float* r2s; const int* listbase;
    __device__ __forceinline__ void operator()(const f32x4 (&acc)[2][2][4][2], const Unit& u, int wr, int wc, int fr, int fq) const {
#pragma unroll
        for (int ai = 0; ai < 2; ++ai)
#pragma unroll
            for (int m = 0; m < 4; ++m) { const int rl = ai * HALF + wr * 64 + m * 16 + fr, row = u.orow + rl; const float rs = r2s[(u.rows - listbase) + (rl < u.nvalid ? rl : 0)] * (1.0f / WGU_SCALE); float h[8];
#pragma unroll
                for (int n = 0; n < 2; ++n)
#pragma unroll
                    for (int e = 0; e < 4; ++e) { const float gt = acc[ai][0][m][n][e] * rs, up = acc[ai][1][m][n][e] * rs;
                        h[n * 4 + e] = gt * __builtin_amdgcn_rcpf(1.0f + __builtin_amdgcn_exp2f(-gt * LOG2E)) * up; }
                u32x2 w; w.x = cvt4_fp8(h[0], h[1], h[2], h[3]); w.y = cvt4_fp8(h[4], h[5], h[6], h[7]);
                *(u32x2*)((unsigned char*)Hd + (size_t)row * DFF + u.ocol + wc * 32 + 8 * fq) = w; }
    }
};
}

namespace att {
constexpr int QB = 256, KVBLK = 64, PITCH = HW, OPITCH = DM;
constexpr int SLOTB = 8192, LDS_K = 0, LDS_V = 2 * SLOTB, LDS_WS = 4 * SLOTB, LDS_OST = LDS_WS + NWAVES * 256, LDS_FLAG = LDS_OST + NWAVES * 4096, LDS_END = LDS_FLAG + 64;
static_assert(LDS_END <= RING_BYTES, "attention LDS");
__device__ __forceinline__ int crow(int r, int hi) { return (r & 3) + 8 * (r >> 2) + 4 * hi; }
__device__ __forceinline__ void glds16(const void* gsrc, unsigned lds_dst) { unsigned keep;
    asm volatile("s_mov_b32 %0, m0\n\ts_mov_b32 m0, %2\n\ts_nop 0\n\tglobal_load_lds_dwordx4 %1, off\n\ts_mov_b32 m0, %0" : "=&s"(keep) : "v"(gsrc), "s"(lds_dst) : "memory"); }
__device__ __forceinline__ void glds16s(const void* sbase, unsigned voff, unsigned lds_dst) { unsigned keep;
    asm volatile("s_mov_b32 %0, m0\n\ts_mov_b32 m0, %3\n\ts_nop 0\n\tglobal_load_lds_dwordx4 %1, %2\n\ts_mov_b32 m0, %0" : "=&s"(keep) : "v"(voff), "s"(sbase), "s"(lds_dst) : "memory"); }
#define ATT_WAIT_BAR0() asm volatile("s_waitcnt vmcnt(0) lgkmcnt(0)\n\ts_barrier" ::: "memory")
#define MFMA32(a, b, c) __builtin_amdgcn_mfma_f32_32x32x16_bf16(a, b, c, 0, 0, 0)
__device__ __forceinline__ void store_row_ssq(u32x4 v, float* dst, int ch) {
    float q = (bf16lo(v.x) * bf16lo(v.x) + bf16hi(v.x) * bf16hi(v.x)) + (bf16lo(v.y) * bf16lo(v.y) + bf16hi(v.y) * bf16hi(v.y)) + (bf16lo(v.z) * bf16lo(v.z) + bf16hi(v.z) * bf16hi(v.z)) + (bf16lo(v.w) * bf16lo(v.w) + bf16hi(v.w) * bf16hi(v.w));
    q += __shfl_xor(q, 1); q += __shfl_xor(q, 2); q += __shfl_xor(q, 4);
    if (ch == 0) *dst = q;
}
__device__ __forceinline__ void qkt(f32x16& p0, f32x16& p1, const LAS char* Kslot, const bf16x8* qr, const f32x16& cin, int r32, int hi) {
    const LAS char* kb = Kslot + hi * 1024 + r32 * 16;
#pragma unroll
    for (int d0 = 0; d0 < 4; ++d0) {
        const bf16x8 b0 = *(const LAS bf16x8*)(kb + d0 * 2048);
        const bf16x8 b1 = *(const LAS bf16x8*)(kb + d0 * 2048 + 512);
        if (d0 == 0) { p0 = MFMA32(b0, qr[0], cin); p1 = MFMA32(b1, qr[0], cin); }
        else { p0 = MFMA32(b0, qr[d0], p0); p1 = MFMA32(b1, qr[d0], p1); } }
}
__device__ __forceinline__ void pv(f32x16* o, int vb, bf16x8 pa0, bf16x8 pa1, bf16x8 pa2, bf16x8 pa3) {
#pragma unroll
    for (int d0 = 0; d0 < 2; ++d0) { s16x4 lo[4], hi[4];
#pragma unroll
        for (int ks = 0; ks < 4; ++ks) {
            asm volatile("ds_read_b64_tr_b16 %0,%1 offset:%c2" : "=&v"(lo[ks]) : "v"(vb), "i"(d0 * 4096 + ks * 1024) : "memory");
            asm volatile("ds_read_b64_tr_b16 %0,%1 offset:%c2" : "=&v"(hi[ks]) : "v"(vb), "i"(d0 * 4096 + ks * 1024 + 512) : "memory"); }
        asm volatile("s_waitcnt lgkmcnt(0)" ::: "memory"); __builtin_amdgcn_sched_barrier(0);
#define PK(k) (bf16x8){lo[k][0], lo[k][1], lo[k][2], lo[k][3], hi[k][0], hi[k][1], hi[k][2], hi[k][3]}
        o[d0] = MFMA32(pa0, PK(0), o[d0]); o[d0] = MFMA32(pa1, PK(1), o[d0]); o[d0] = MFMA32(pa2, PK(2), o[d0]); o[d0] = MFMA32(pa3, PK(3), o[d0]);
#undef PK
    }
}
__device__ __forceinline__ float swap_lo(float x) { auto rr = __builtin_amdgcn_permlane32_swap(__float_as_uint(x), __float_as_uint(x), false, false); return __uint_as_float(rr[0]); }
__device__ __forceinline__ float swap_hi(float x) { auto rr = __builtin_amdgcn_permlane32_swap(__float_as_uint(x), __float_as_uint(x), false, false); return __uint_as_float(rr[1]); }

template <int MODE> __device__ __forceinline__ void attn_unit(int b, int h, int qb, const bf16_t* Q, const bf16_t* K, const bf16_t* V, bf16_t* O, float* hs, const float* cb, LAS char* shm) {
    int tid = threadIdx.x; asm volatile("" : "+v"(tid)); const int lane = tid & 63, r32 = lane & 31, hi = lane >> 5; const int wid = __builtin_amdgcn_readfirstlane(tid >> 6);
    const long rowbase = (long)b * SEQ; const int q0 = qb * QB;
    const bf16_t* Qw = Q + (rowbase + q0 + wid * 32) * PITCH + h * HD;
    const bf16_t* Kh = K + rowbase * PITCH + h * HD; const bf16_t* Vh = V + rowbase * PITCH + h * HD;
    const unsigned lds0 = (unsigned)(uintptr_t)shm;
    LAS float* wsf = (LAS float*)(shm + LDS_WS) + wid * 64;
    LAS unsigned* flags = (LAS unsigned*)(shm + LDS_FLAG);
    const bf16_t* ksrc = Kh + (long)lane * PITCH + wid * 8;
    const bf16_t* vsrc = Vh + (long)(16 * (wid & 3) + (lane >> 2)) * PITCH + (wid >> 2) * 32 + (lane & 3) * 8;
    const unsigned kdst = lds0 + LDS_K + wid * 1024, vdst = lds0 + LDS_V + wid * 1024;
#define DMA_KV(t, slot) do { glds16(ksrc + (long)(t) * KVBLK * PITCH, (unsigned)__builtin_amdgcn_readfirstlane(kdst + (slot))); glds16(vsrc + (long)(t) * KVBLK * PITCH, (unsigned)__builtin_amdgcn_readfirstlane(vdst + (slot))); } while (0)
    const int vb0 = (int)(lds0 + LDS_V) + ((lane >> 4) & 1) * 32 + (lane & 3) * 8 + (4 * hi + ((lane & 15) >> 2)) * 64;
    const int NT = (q0 + QB) / KVBLK;
    DMA_KV(NT - 1, 0);
    bf16x8 qr[4];
#pragma unroll
    for (int d0 = 0; d0 < 4; ++d0) qr[d0] = *(const bf16x8*)(Qw + (long)r32 * PITCH + d0 * 16 + hi * 8);
    f32x16 o[2]; o[0] = f32x16{}; o[1] = f32x16{};
    const int qrel = wid * 32 + r32;
    float m_run = -1.0e30f, l_run = 0.f, R = 0.f, ct = 0.f;
    if (MODE == 0) ct = cb[q0 + qrel];
    bf16x8 TD0, TD1, TONE;
#pragma unroll
    for (int j = 0; j < 8; ++j) { const int kvl = 8 * (j >> 2) + 4 * hi + (j & 3); TD0[j] = (kvl >= r32) ? (short)0x3F80 : (short)0; TD1[j] = (16 + kvl >= r32) ? (short)0x3F80 : (short)0; TONE[j] = (short)0x3F80; }
    f32x16 zero16 = f32x16{};
    for (int i = 0; i < NT; ++i) {
        const int t = NT - 1 - i, slot = (i & 1) * SLOTB;
        ATT_WAIT_BAR0();
        if (MODE == 1 && i > 0) {
            const LAS unsigned* fl = flags + ((i - 1) & 1) * 8; unsigned all = 1u;
#pragma unroll
            for (int w = 0; w < 8; ++w) all &= fl[w];
            if (__builtin_amdgcn_readfirstlane(all)) break;
        }
        if (t > 0) DMA_KV(t - 1, slot ^ SLOTB);
        const int jb = t - (NT - 4);
        const bool active = !(jb >= 0 && 2 * jb > wid);
        bool wave_done = false;
        if (MODE == 1) wave_done = __all(R < SB_EXIT);
        if (active && !(MODE == 1 && wave_done)) {
            f32x16 p0, p1;
            qkt(p0, p1, shm + LDS_K + slot, qr, zero16, r32, hi);
            if (MODE == 0) {
                const float* cbt = cb + t * KVBLK + 4 * hi;
#pragma unroll
                for (int g = 0; g < 4; ++g) { const f32x4 c0 = *(const f32x4*)(cbt + 8 * g), c1 = *(const f32x4*)(cbt + 32 + 8 * g);
#pragma unroll
                    for (int e = 0; e < 4; ++e) { p0[4 * g + e] += ct - c0[e]; p1[4 * g + e] += ct - c1[e]; } }
                if (jb >= 0) {
#pragma unroll
                    for (int r = 0; r < 16; ++r) { const int kv = 64 * jb + crow(r, hi); if (kv > qrel) p0[r] = -1.0e30f; if (kv + 32 > qrel) p1[r] = -1.0e30f; } }
                float a = fmaxf(p0[0], p1[0]);
#pragma unroll
                for (int r = 1; r < 16; ++r) a = fmaxf(a, fmaxf(p0[r], p1[r]));
                a = fmaxf(swap_lo(a), swap_hi(a));
                const float m_new = fmaxf(m_run, a), alpha = __builtin_amdgcn_exp2f(m_run - m_new); m_run = m_new;
                float s = 0.f;
#pragma unroll
                for (int r = 0; r < 16; ++r) { p0[r] = __builtin_amdgcn_exp2f(p0[r] - m_new); p1[r] = __builtin_amdgcn_exp2f(p1[r] - m_new); s += p0[r] + p1[r]; }
                l_run = l_run * alpha + s;
                if (hi == 0) wsf[r32] = alpha;
                LDS_WAIT();
#pragma unroll
                for (int r = 0; r < 16; ++r) { const float f = wsf[crow(r, hi)]; o[0][r] *= f; o[1][r] *= f; }
                LDS_WAIT();
            } else {
                if (jb >= 0) {
#pragma unroll
                    for (int r = 0; r < 16; ++r) { const int kv = 64 * jb + crow(r, hi); if (kv >= qrel) p0[r] = -1.0e30f; if (kv + 32 >= qrel) p1[r] = -1.0e30f; } }
                f32x16 l0, l1;
#pragma unroll
                for (int r = 0; r < 16; ++r) {
                    l0[r] = -(fmaxf(p0[r], 0.f) + __builtin_amdgcn_logf(1.0f + __builtin_amdgcn_exp2f(-fabsf(p0[r]))));
                    l1[r] = -(fmaxf(p1[r], 0.f) + __builtin_amdgcn_logf(1.0f + __builtin_amdgcn_exp2f(-fabsf(p1[r])))); }
                u32x4 lw0 = {cvt_pk_bf16(l0[0], l0[1]), cvt_pk_bf16(l0[2], l0[3]), cvt_pk_bf16(l0[4], l0[5]), cvt_pk_bf16(l0[6], l0[7])};
                u32x4 lw1 = {cvt_pk_bf16(l0[8], l0[9]), cvt_pk_bf16(l0[10], l0[11]), cvt_pk_bf16(l0[12], l0[13]), cvt_pk_bf16(l0[14], l0[15])};
                u32x4 lw2 = {cvt_pk_bf16(l1[0], l1[1]), cvt_pk_bf16(l1[2], l1[3]), cvt_pk_bf16(l1[4], l1[5]), cvt_pk_bf16(l1[6], l1[7])};
                u32x4 lw3 = {cvt_pk_bf16(l1[8], l1[9]), cvt_pk_bf16(l1[10], l1[11]), cvt_pk_bf16(l1[12], l1[13]), cvt_pk_bf16(l1[14], l1[15])};
                f32x16 rt;
#pragma unroll
                for (int r = 0; r < 16; ++r) rt[r] = R;
                f32x16 t0 = MFMA32(TD0, __builtin_bit_cast(bf16x8, lw0), rt); t0 = MFMA32(TD1, __builtin_bit_cast(bf16x8, lw1), t0);
                t0 = MFMA32(TONE, __builtin_bit_cast(bf16x8, lw2), t0); t0 = MFMA32(TONE, __builtin_bit_cast(bf16x8, lw3), t0);
                f32x16 t1 = MFMA32(TD0, __builtin_bit_cast(bf16x8, lw2), rt); t1 = MFMA32(TD1, __builtin_bit_cast(bf16x8, lw3), t1);
#pragma unroll
                for (int r = 0; r < 16; ++r) { p0[r] = __builtin_amdgcn_exp2f(p0[r] + t0[r]); p1[r] = __builtin_amdgcn_exp2f(p1[r] + t1[r]); }
                R = swap_lo(t0[0]);
            }
            u32x4 pw0 = {cvt_pk_bf16(p0[0], p0[1]), cvt_pk_bf16(p0[2], p0[3]), cvt_pk_bf16(p0[4], p0[5]), cvt_pk_bf16(p0[6], p0[7])};
            u32x4 pw1 = {cvt_pk_bf16(p0[8], p0[9]), cvt_pk_bf16(p0[10], p0[11]), cvt_pk_bf16(p0[12], p0[13]), cvt_pk_bf16(p0[14], p0[15])};
            u32x4 pw2 = {cvt_pk_bf16(p1[0], p1[1]), cvt_pk_bf16(p1[2], p1[3]), cvt_pk_bf16(p1[4], p1[5]), cvt_pk_bf16(p1[6], p1[7])};
            u32x4 pw3 = {cvt_pk_bf16(p1[8], p1[9]), cvt_pk_bf16(p1[10], p1[11]), cvt_pk_bf16(p1[12], p1[13]), cvt_pk_bf16(p1[14], p1[15])};
            pv(o, vb0 + slot, __builtin_bit_cast(bf16x8, pw0), __builtin_bit_cast(bf16x8, pw1), __builtin_bit_cast(bf16x8, pw2), __builtin_bit_cast(bf16x8, pw3));
        }
        if (MODE == 1) { const bool dn = __all(R < SB_EXIT); if (lane == 0) flags[(i & 1) * 8 + wid] = dn ? 1u : 0u; }
    }
    float linv = 1.f;
    if (MODE == 0) { const float lt = swap_lo(l_run) + swap_hi(l_run); linv = 1.0f / lt; }
    if (hi == 0) wsf[32 + r32] = linv;
    LDS_WAIT();
    bf16_t* Ow = O + (rowbase + q0 + wid * 32) * OPITCH + h * HD;
    { LAS bf16_t* stg = (LAS bf16_t*)(shm + LDS_OST) + wid * 2048;
#pragma unroll
      for (int r = 0; r < 16; ++r) { const int orow = crow(r, hi); const float f = wsf[32 + orow];
#pragma unroll
        for (int d0 = 0; d0 < 2; ++d0) { const unsigned pk = cvt_pk_bf16(o[d0][r] * f, 0.f); stg[orow * 64 + d0 * 32 + r32] = (bf16_t)(pk & 0xffffu); } }
      LDS_WAIT();
#pragma unroll
      for (int i = 0; i < 4; ++i) { const int row = i * 8 + (lane >> 3), ch = lane & 7; const u32x4 v = *(const LAS u32x4*)(stg + row * 64 + ch * 8); *(u32x4*)(Ow + (long)row * OPITCH + ch * 8) = v;
        store_row_ssq(v, hs + (rowbase + q0 + wid * 32 + row) * 16, ch); } }
    asm volatile("s_waitcnt vmcnt(0) lgkmcnt(0)\n\ts_barrier" ::: "memory");
#undef DMA_KV
}
}


namespace fox {
constexpr int QB = 256, KVBLK = 64, PITCH = HW, OPITCH = DM;
constexpr int NSLOT = 3, SLOTB = 9216;
constexpr int LDS_K = 0, LDS_V = NSLOT * SLOTB, LDS_WS = 2 * NSLOT * SLOTB, LDS_OST = LDS_WS + NWAVES * 256, LDS_CL = LDS_OST + NWAVES * 4096, LDS_VOTE = LDS_CL + 512, LDS_END = LDS_VOTE + 32;
static_assert(LDS_END <= RING_BYTES, "fox LDS");
constexpr float WIN_T = 48.0f;
constexpr float FLOOR = -256.0f;
using att::crow; using att::glds16; using att::glds16s;
typedef __attribute__((address_space(3))) const char* lds_cptr;
typedef short v4i16_t __attribute__((ext_vector_type(4)));
#define SBAR() __builtin_amdgcn_sched_barrier(0)
#define WAIT_BAR(N) asm volatile("s_waitcnt vmcnt(" #N ") lgkmcnt(0)\n\ts_barrier" ::: "memory")
__device__ __forceinline__ s16x4 vtr(lds_cptr p) { return __builtin_bit_cast(s16x4, __builtin_amdgcn_ds_read_tr16_b64_v4i16((__attribute__((address_space(3))) v4i16_t*)p)); }
__device__ __forceinline__ void kload2(bf16x8* kf, lds_cptr kp, int j) { kf[2 * j] = *(const LAS bf16x8*)(kp + j * 2048); kf[2 * j + 1] = *(const LAS bf16x8*)(kp + j * 2048 + 512); }
__device__ __forceinline__ void cmask(f32x16& p0, f32x16& p1, int jb, int qrel, int hi) {
    const float NEG = -INFINITY; const int kb = 64 * jb + 4 * hi;
#pragma unroll
    for (int r = 0; r < 16; ++r) { const int kv = kb + (r & 3) + 8 * (r >> 2); if (kv > qrel) p0[r] = NEG; if (kv + 32 > qrel) p1[r] = NEG; }
}
__device__ __forceinline__ void split3(float x, unsigned& hm, unsigned& lo) {
    const unsigned h = cvt_pk_bf16(x, 0.f) & 0xffffu; const float r1 = x - __uint_as_float(h << 16);
    const unsigned m = cvt_pk_bf16(r1, 0.f) & 0xffffu; const float r2 = r1 - __uint_as_float(m << 16);
    hm = h | (m << 16); lo = cvt_pk_bf16(r2, 0.f) & 0xffffu;
}
__device__ __forceinline__ bf16x8 qx_build(float a, int hi) {
    unsigned hm, lo; split3(a, hm, lo);
    u32x4 w; w.x = hm; w.y = lo | 0x3F800000u; w.z = 0x3F803F80u; w.w = 0u;
    if (hi) { w.x = 0u; w.y = 0u; w.z = 0u; }
    return __builtin_bit_cast(bf16x8, w);
}

template <int THRL> __device__ __forceinline__ void fox_unit(int bh, int qb, const bf16_t* Q, const bf16_t* K, const bf16_t* V, bf16_t* O, float* hs, const float* cb, const bf16_t* KXall, float kmax, LAS char* shm, bool pre, int nbh, int nqb) {
    const bf16_t* KXh = KXall + (size_t)bh * SEQ * 8;
    int tid = threadIdx.x; asm volatile("" : "+v"(tid)); const int lane = tid & 63, r32 = lane & 31, hi = lane >> 5; const int wid = __builtin_amdgcn_readfirstlane(tid >> 6);
    const int b = bh >> 3, h = bh & 7; const long rowbase = (long)b * SEQ; const int q0 = qb * QB;
    const bf16_t* Qw = Q + (rowbase + q0 + wid * 32) * PITCH + h * HD;
    const bf16_t* Kh = K + rowbase * PITCH + h * HD; const bf16_t* Vh = V + rowbase * PITCH + h * HD;
    const unsigned lds0 = (unsigned)(uintptr_t)shm;
    LAS float* wsf = (LAS float*)(shm + LDS_WS) + wid * 64;
    const int NT = (q0 + QB) / KVBLK;
    int NTe = NT;
    LAS float* clt = (LAS float*)(shm + LDS_CL); LAS unsigned* votes = (LAS unsigned*)(shm + LDS_VOTE);
    const float clv = (tid < NT) ? cb[64 * tid + 63] : 0.f;
    const unsigned koff = (unsigned)(lane * PITCH + wid * 8) * 2u, voff = (unsigned)((16 * (wid & 3) + (lane >> 2)) * PITCH + (wid >> 2) * 32 + (lane & 3) * 8) * 2u, xoff = (unsigned)lane * 16u;
    const unsigned kdst = lds0 + LDS_K + wid * 1024, vdst = lds0 + LDS_V + wid * 1024, xdst = lds0 + LDS_K + 8192;
    const bool xl = (lane >> 3) == wid;
#define DMA_KX(Kb, KXb, NTv, p, slot) do { glds16s((Kb) + (long)((NTv) - 1 - (p)) * KVBLK * PITCH, koff, (unsigned)__builtin_amdgcn_readfirstlane(kdst + (slot))); \
        if (xl) glds16s((KXb) + (long)((NTv) - 1 - (p)) * KVBLK * 8, xoff, (unsigned)__builtin_amdgcn_readfirstlane(xdst + (slot))); } while (0)
#define DMA_VX(Vb, NTv, p, slot) glds16s((Vb) + (long)((NTv) - 1 - (p)) * KVBLK * PITCH, voff, (unsigned)__builtin_amdgcn_readfirstlane(vdst + (slot)))
#define DMA_K(p, slot) DMA_KX(Kh, KXh, NT, p, slot)
#define DMA_V(p, slot) DMA_VX(Vh, NT, p, slot)
    bf16x8 kf[10];
    const lds_cptr shm3 = (lds_cptr)shm; const lds_cptr kp0 = shm3 + LDS_K + hi * 1024 + r32 * 16; const lds_cptr kx0 = shm3 + LDS_K + 8192 + r32 * 16;
    const lds_cptr vp0 = shm3 + LDS_V + ((lane >> 4) & 1) * 32 + (lane & 3) * 8 + (4 * hi + ((lane & 15) >> 2)) * 64;
    if (!pre) { DMA_K(0, 0); DMA_V(0, 0); DMA_K(1, SLOTB); }
    bf16x8 qr[4];
#pragma unroll
    for (int d0 = 0; d0 < 4; ++d0) qr[d0] = *(const bf16x8*)(Qw + (long)r32 * PITCH + d0 * 16 + hi * 8);
    const int qrel = wid * 32 + r32;
    const float ct = cb[q0 + qrel];
    float mhat = 0.f, l_reg = 0.f; f32x16 o[2]; o[0] = f32x16{}; o[1] = f32x16{};
    bf16x8 qx = qx_build(ct, hi);
    const f32x16 z16 = f32x16{};
#define CMASK(P0, P1, p) do { const int jb_ = 3 - (p); if (jb_ >= 0) cmask(P0, P1, jb_, qrel, hi); } while (0)
    bool resc = false;
#define RESC() do { if (resc) { asm volatile("s_waitcnt lgkmcnt(0)" ::: "memory"); \
      _Pragma("unroll") for (int d_ = 0; d_ < 2; ++d_) _Pragma("unroll") for (int r = 0; r < 16; ++r) o[d_][r] *= wsf[crow(r, hi)]; } } while (0)
    f32x16 pA0, pA1, pB0, pB1;
    int sl_prev = 0, sl_cur = 0, sl_next = SLOTB;
#define ROT() do { sl_prev = sl_cur; sl_cur = sl_next; sl_next = (sl_next == (NSLOT - 1) * SLOTB) ? 0 : sl_next + SLOTB; } while (0)
    if (!pre) { DMA_K(2, 2 * SLOTB); }
    if (pre) { WAIT_BAR(0); } else WAIT_BAR(5);
    if (tid < NT) clt[tid] = clv;
    float qkb;
    { float q2 = 0.f;
#pragma unroll
      for (int d0 = 0; d0 < 4; ++d0)
#pragma unroll
          for (int j = 0; j < 8; ++j) { const float e = __uint_as_float(((unsigned)(unsigned short)qr[d0][j]) << 16); q2 += e * e; }
      q2 = att::swap_lo(q2) + att::swap_hi(q2); qkb = sqrtf(q2) * kmax + ct + WIN_T; }
    { const LAS char* kb = (const LAS char*)shm + LDS_K + hi * 1024 + r32 * 16; const LAS char* kxb = (const LAS char*)shm + LDS_K + 8192 + r32 * 16;
      pA0 = MFMA32(*(const LAS bf16x8*)(kxb), qx, z16); pA1 = MFMA32(*(const LAS bf16x8*)(kxb + 512), qx, z16);
#pragma unroll
      for (int d0 = 0; d0 < 4; ++d0) { pA0 = MFMA32(*(const LAS bf16x8*)(kb + d0 * 2048), qr[d0], pA0); pA1 = MFMA32(*(const LAS bf16x8*)(kb + d0 * 2048 + 512), qr[d0], pA1); } }
    asm volatile("s_nop 15\n\ts_nop 7" : "+v"(pA0), "+v"(pA1)); CMASK(pA0, pA1, 0);
    { float a = fmaxf(pA0[0], pA1[0]);
#pragma unroll
      for (int r = 1; r < 16; ++r) a = fmaxf(a, fmaxf(pA0[r], pA1[r]));
      a = fmaxf(att::swap_lo(a), att::swap_hi(a));
      const float dl = fmaxf(a, FLOOR); mhat = dl;
#pragma unroll
      for (int r = 0; r < 16; ++r) { pA0[r] = __builtin_amdgcn_exp2f(pA0[r] - dl); pA1[r] = __builtin_amdgcn_exp2f(pA1[r] - dl); }
      qx = qx_build(ct - mhat, hi); asm volatile("" : "+v"(qx)); }
    WAIT_BAR(0);
    DMA_K(3, 0); DMA_V(1, SLOTB);
    ROT();
    kload2(kf, kp0 + sl_cur, 0); kload2(kf, kp0 + sl_cur, 1); kload2(kf, kp0 + sl_cur, 2); kload2(kf, kp0 + sl_cur, 3);
    kf[8] = *(const LAS bf16x8*)(kx0 + sl_cur); kf[9] = *(const LAS bf16x8*)(kx0 + sl_cur + 512);
    WAIT_BAR(3);
    s16x4 vlo[8], vhi[8]; u32x4 pw0, pw1, pw2, pw3;
#define PKW(P, B) cvt_pk_bf16(P[B], P[B + 1])
#define PAF(k) __builtin_bit_cast(bf16x8, pw##k)
#define VFR(i) (bf16x8){vlo[i][0], vlo[i][1], vlo[i][2], vlo[i][3], vhi[i][0], vhi[i][1], vhi[i][2], vhi[i][3]}
#define PIN(x) asm volatile("" : "+v"(x))
#define MX3(a, b, c) __builtin_fmaxf(__builtin_fmaxf((a), (b)), (c))
#define GAPA(MF, A0, A1, A2, A3, W0, W1, PW) do { MF; sacc += A0; sacc += A1; sacc += A2; sacc += A3; PIN(sacc); W0; W1; PIN(PW); SBAR(); } while (0)
#define EX(v) __builtin_amdgcn_exp2f(v)
#define GAPB(MF, X, B) do { MF; X[B] = EX(X[B]); X[B + 1] = EX(X[B + 1]); X[B + 2] = EX(X[B + 2]); X[B + 3] = EX(X[B + 3]); PIN(X); SBAR(); } while (0)
#define VRD(i) do { vlo[i] = vtr(vp_ + (((i) >> 2) * 4096 + ((i) & 3) * 1024)); vhi[i] = vtr(vp_ + (((i) >> 2) * 4096 + ((i) & 3) * 1024 + 512)); } while (0)
#define KRD(G, j) do { if (G) { kload2(kf, kp0 + sl_next, j); SBAR(); } } while (0)
#define KRDX(G) do { if (G) { kf[8] = *(const LAS bf16x8*)(kx0 + sl_next); kf[9] = *(const LAS bf16x8*)(kx0 + sl_next + 512); SBAR(); } } while (0)
#define STEP(C0, C1, P0, P1, t, GK, GV, GL) do { SBAR(); \
    const lds_cptr vp_ = vp0 + sl_prev; \
    C0 = MFMA32(kf[8], qx, z16); C1 = MFMA32(kf[9], qx, z16); SBAR(); \
    VRD(0); SBAR(); float sacc = (P0[0] + P0[1]); \
    GAPA(C0 = MFMA32(kf[0], qr[0], C0), P0[2], P0[3], P0[4], P0[5],     pw0[0] = PKW(P0, 0), pw0[1] = PKW(P0, 2), pw0); \
    VRD(4); SBAR(); GAPA(C1 = MFMA32(kf[1], qr[0], C1), P0[6], P0[7], P0[8], P0[9],     pw0[2] = PKW(P0, 4), pw0[3] = PKW(P0, 6), pw0); \
    VRD(1); SBAR(); GAPA(C0 = MFMA32(kf[2], qr[1], C0),   P0[10], P0[11], P0[12], P0[13], pw1[0] = PKW(P0, 8), pw1[1] = PKW(P0, 10), pw1); \
    VRD(5); SBAR(); GAPA(C1 = MFMA32(kf[3], qr[1], C1),   P0[14], P0[15], P1[0], P1[1],   pw1[2] = PKW(P0, 12), pw1[3] = PKW(P0, 14), pw1); \
    VRD(2); SBAR(); GAPA(C0 = MFMA32(kf[4], qr[2], C0),   P1[2], P1[3], P1[4], P1[5],     pw2[0] = PKW(P1, 0), pw2[1] = PKW(P1, 2), pw2); \
    VRD(6); SBAR(); GAPA(C1 = MFMA32(kf[5], qr[2], C1),   P1[6], P1[7], P1[8], P1[9],     pw2[2] = PKW(P1, 4), pw2[3] = PKW(P1, 6), pw2); \
    VRD(3); SBAR(); GAPA(C0 = MFMA32(kf[6], qr[3], C0),   P1[10], P1[11], P1[12], P1[13], pw3[0] = PKW(P1, 8), pw3[1] = PKW(P1, 10), pw3); \
    VRD(7); SBAR(); GAPA(C1 = MFMA32(kf[7], qr[3], C1),   P1[14], P1[15], 0.f, 0.f,       pw3[2] = PKW(P1, 12), pw3[3] = PKW(P1, 14), pw3); \
    l_reg += sacc; \
    if (GK) { DMA_K((t) + 3, sl_cur); } if (GV) { DMA_V((t) + 1, sl_next); } \
    CMASK(C0, C1, t); \
    { float a = MX3(C0[0], C0[1], C1[0]), b_ = MX3(C0[2], C0[3], C1[1]); a = MX3(a, C1[2], C1[3]); \
      _Pragma("unroll") for (int r = 4; r < 16; r += 4) { a = MX3(a, C0[r], C0[r + 1]); b_ = MX3(b_, C0[r + 2], C0[r + 3]); a = MX3(a, C1[r], C1[r + 1]); b_ = MX3(b_, C1[r + 2], C1[r + 3]); } \
      float rm = __builtin_fmaxf(a, b_); { auto rr = __builtin_amdgcn_permlane32_swap(__float_as_uint(rm), __float_as_uint(rm), false, false); rm = __builtin_fmaxf(__uint_as_float(rr[0]), __uint_as_float(rr[1])); } \
      resc = false; \
      if (__builtin_expect(__any(rm > (float)THRL), 0)) { const float dl = __builtin_fmaxf(rm, 0.f); mhat += dl; \
        _Pragma("unroll") for (int r = 0; r < 16; ++r) { C0[r] -= dl; C1[r] -= dl; } \
        qx = qx_build(ct - mhat, hi); asm volatile("" : "+v"(qx)); \
        const float f = __builtin_amdgcn_exp2f(-dl); l_reg *= f; if (hi == 0) wsf[r32] = f; resc = true; } } \
    SBAR(); \
    GAPB(o[0] = MFMA32(PAF(0), VFR(0), o[0]), C0, 0); \
    KRDX(GL); GAPB(o[1] = MFMA32(PAF(0), VFR(4), o[1]), C0, 4); \
    KRD(GL, 0); GAPB(o[0] = MFMA32(PAF(1), VFR(1), o[0]), C0, 8); \
    KRD(GL, 1); GAPB(o[1] = MFMA32(PAF(1), VFR(5), o[1]), C0, 12); \
    KRD(GL, 2); GAPB(o[0] = MFMA32(PAF(2), VFR(2), o[0]), C1, 0); \
    KRD(GL, 3); GAPB(o[1] = MFMA32(PAF(2), VFR(6), o[1]), C1, 4); \
    GAPB(o[0] = MFMA32(PAF(3), VFR(3), o[0]), C1, 8); \
    GAPB(o[1] = MFMA32(PAF(3), VFR(7), o[1]), C1, 12); \
    } while (0)
#define ENDW(tt) do { if ((tt) + 3 < NTe) { WAIT_BAR(3); } else if ((tt) + 2 < NTe) { WAIT_BAR(1); } else { WAIT_BAR(0); } } while (0)
#define VOTE(u) do { const int ts_ = NT - (u) - 3; bool ok_ = false; if (ts_ >= 0) { ok_ = __all((qkb - mhat) < clt[ts_]); } if (lane == 0) votes[wid] = ok_ ? 1u : 0u; } while (0)
#define TALLY(u) do { const u32x4 va_ = *(const LAS u32x4*)votes, vb_ = *(const LAS u32x4*)(votes + 4); \
        if (__builtin_amdgcn_readfirstlane((va_.x & va_.y & va_.z & va_.w & vb_.x & vb_.y & vb_.z & vb_.w) != 0u)) { if ((u) + 2 < NTe) { NTe = (u) + 2; WAIT_BAR(0); } } } while (0)
    int t = 1;
    for (; t + 1 < NTe && t < 5; t += 2) {
        STEP(pB0, pB1, pA0, pA1, t, (t + 3 < NTe), (t + 1 < NTe), (t + 1 < NTe));       ENDW(t);     RESC(); ROT();
        STEP(pA0, pA1, pB0, pB1, t + 1, (t + 4 < NTe), (t + 2 < NTe), (t + 2 < NTe));   VOTE(t + 1); ENDW(t + 1); TALLY(t + 1); RESC(); ROT();
    }
#undef CMASK
#define CMASK(P0, P1, p) do {} while (0)
    for (; t + 5 < NTe; t += 2) {
        STEP(pB0, pB1, pA0, pA1, t, true, true, true);       WAIT_BAR(3); RESC(); ROT();
        STEP(pA0, pA1, pB0, pB1, t + 1, true, true, true);   VOTE(t + 1); WAIT_BAR(3); TALLY(t + 1); RESC(); ROT();
    }
    for (; t + 1 < NTe; t += 2) {
        STEP(pB0, pB1, pA0, pA1, t, (t + 3 < NTe), (t + 1 < NTe), (t + 1 < NTe));       ENDW(t);     RESC(); ROT();
        STEP(pA0, pA1, pB0, pB1, t + 1, (t + 4 < NTe), (t + 2 < NTe), (t + 2 < NTe));   ENDW(t + 1); RESC(); ROT();
    }
#undef CMASK
#define CMASK(P0, P1, p) do { const int jb_ = 3 - (p); if (jb_ >= 0) cmask(P0, P1, jb_, qrel, hi); } while (0)
    STEP(pB0, pB1, pA0, pA1, NTe - 1, false, false, false); RESC();
    { float sacc = pB0[0] + pB0[1];
#pragma unroll
      for (int r = 2; r < 16; ++r) sacc += pB0[r];
#pragma unroll
      for (int r = 0; r < 16; ++r) sacc += pB1[r];
      l_reg += sacc;
      pw0 = (u32x4){PKW(pB0, 0), PKW(pB0, 2), PKW(pB0, 4), PKW(pB0, 6)}; pw1 = (u32x4){PKW(pB0, 8), PKW(pB0, 10), PKW(pB0, 12), PKW(pB0, 14)};
      pw2 = (u32x4){PKW(pB1, 0), PKW(pB1, 2), PKW(pB1, 4), PKW(pB1, 6)}; pw3 = (u32x4){PKW(pB1, 8), PKW(pB1, 10), PKW(pB1, 12), PKW(pB1, 14)};
      SBAR(); att::pv(o, (int)(unsigned)(uintptr_t)(vp0 + sl_cur), PAF(0), PAF(1), PAF(2), PAF(3)); }
    if (nbh >= 0) { asm volatile("s_waitcnt lgkmcnt(0)\n\ts_barrier" ::: "memory");
        const int NTn = (nqb * QB + QB) / KVBLK; const bf16_t* Kn = K + (long)(nbh >> 3) * SEQ * PITCH + (nbh & 7) * HD; const bf16_t* Vn = V + (long)(nbh >> 3) * SEQ * PITCH + (nbh & 7) * HD; const bf16_t* KXn = KXall + (size_t)nbh * SEQ * 8;
        DMA_KX(Kn, KXn, NTn, 0, 0); DMA_VX(Vn, NTn, 0, 0); DMA_KX(Kn, KXn, NTn, 1, SLOTB); DMA_KX(Kn, KXn, NTn, 2, 2 * SLOTB); }
    l_reg = att::swap_lo(l_reg) + att::swap_hi(l_reg);
    if (hi == 0) wsf[32 + r32] = l_reg; asm volatile("s_waitcnt lgkmcnt(0)" ::: "memory");
    float rli[16];
#pragma unroll
    for (int r = 0; r < 16; ++r) rli[r] = __builtin_amdgcn_rcpf(wsf[32 + crow(r, hi)]);
    bf16_t* Ow = O + (rowbase + q0 + wid * 32) * OPITCH + h * HD;
    { LAS bf16_t* stg = (LAS bf16_t*)(shm + LDS_OST) + wid * 2048;
#pragma unroll
      for (int r = 0; r < 16; ++r) { const int orow = crow(r, hi);
#pragma unroll
        for (int d0 = 0; d0 < 2; ++d0) stg[orow * 64 + d0 * 32 + r32] = (bf16_t)(cvt_pk_bf16(o[d0][r] * rli[r], 0.f) & 0xffffu); }
      asm volatile("s_waitcnt lgkmcnt(0)" ::: "memory");
#pragma unroll
      for (int i = 0; i < 4; ++i) { const int row = i * 8 + (lane >> 3), ch = lane & 7; const u32x4 v = *(const LAS u32x4*)(stg + row * 64 + ch * 8); *(u32x4*)(Ow + (long)row * OPITCH + ch * 8) = v;
        att::store_row_ssq(v, hs + (rowbase + q0 + wid * 32 + row) * 16, ch); } }
    asm volatile("s_waitcnt lgkmcnt(0)\n\ts_barrier" ::: "memory");
#undef DMA_K
#undef DMA_V
#undef DMA_KX
#undef DMA_VX
#undef CMASK
#undef RESC
#undef ROT
#undef PKW
#undef PAF
#undef VFR
#undef PIN
#undef MX3
#undef GAPA
#undef GAPB
#undef EX
#undef VRD
#undef KRD
#undef KRDX
#undef STEP
#undef ENDW
#undef VOTE
#undef TALLY
}
#undef SBAR
#undef WAIT_BAR
}


namespace sbk {
constexpr int QB = 256, KVBLK = 64, PITCH = HW, OPITCH = DM, NBURST = 6, SLOTB = 8192;
constexpr int LDS_K = 0, LDS_V = NBURST * SLOTB, LDS_FLAG = 2 * NBURST * SLOTB, LDS_END = LDS_FLAG + 128;
static_assert(LDS_END <= RING_BYTES, "sb LDS");
using att::crow; using att::glds16s; using att::qkt; using att::pv; using att::swap_lo;
__device__ __forceinline__ void sb_tile(const LAS char* Kslot, int vb, const bf16x8* qr, bf16x8 TD0, bf16x8 TD1, bf16x8 TONE, int jb, int qrel, int r32, int hi, float& R, f32x16* o) {
    f32x16 p0, p1; const f32x16 z16 = f32x16{};
    qkt(p0, p1, Kslot, qr, z16, r32, hi);
    if (jb >= 0) {
#pragma unroll
        for (int r = 0; r < 16; ++r) { const int kv = 64 * jb + crow(r, hi); if (kv >= qrel) p0[r] = -1.0e30f; if (kv + 32 >= qrel) p1[r] = -1.0e30f; } }
    f32x16 l0, l1;
#pragma unroll
    for (int r = 0; r < 16; ++r) {
        l0[r] = -(fmaxf(p0[r], 0.f) + __builtin_amdgcn_logf(1.0f + __builtin_amdgcn_exp2f(-fabsf(p0[r]))));
        l1[r] = -(fmaxf(p1[r], 0.f) + __builtin_amdgcn_logf(1.0f + __builtin_amdgcn_exp2f(-fabsf(p1[r])))); }
    u32x4 lw0 = {cvt_pk_bf16(l0[0], l0[1]), cvt_pk_bf16(l0[2], l0[3]), cvt_pk_bf16(l0[4], l0[5]), cvt_pk_bf16(l0[6], l0[7])};
    u32x4 lw1 = {cvt_pk_bf16(l0[8], l0[9]), cvt_pk_bf16(l0[10], l0[11]), cvt_pk_bf16(l0[12], l0[13]), cvt_pk_bf16(l0[14], l0[15])};
    u32x4 lw2 = {cvt_pk_bf16(l1[0], l1[1]), cvt_pk_bf16(l1[2], l1[3]), cvt_pk_bf16(l1[4], l1[5]), cvt_pk_bf16(l1[6], l1[7])};
    u32x4 lw3 = {cvt_pk_bf16(l1[8], l1[9]), cvt_pk_bf16(l1[10], l1[11]), cvt_pk_bf16(l1[12], l1[13]), cvt_pk_bf16(l1[14], l1[15])};
    f32x16 rt;
#pragma unroll
    for (int r = 0; r < 16; ++r) rt[r] = R;
    f32x16 t0 = MFMA32(TD0, __builtin_bit_cast(bf16x8, lw0), rt); t0 = MFMA32(TD1, __builtin_bit_cast(bf16x8, lw1), t0);
    t0 = MFMA32(TONE, __builtin_bit_cast(bf16x8, lw2), t0); t0 = MFMA32(TONE, __builtin_bit_cast(bf16x8, lw3), t0);
    f32x16 t1 = MFMA32(TD0, __builtin_bit_cast(bf16x8, lw2), rt); t1 = MFMA32(TD1, __builtin_bit_cast(bf16x8, lw3), t1);
#pragma unroll
    for (int r = 0; r < 16; ++r) { p0[r] = __builtin_amdgcn_exp2f(p0[r] + t0[r]); p1[r] = __builtin_amdgcn_exp2f(p1[r] + t1[r]); }
    R = swap_lo(t0[0]);
    u32x4 pw0 = {cvt_pk_bf16(p0[0], p0[1]), cvt_pk_bf16(p0[2], p0[3]), cvt_pk_bf16(p0[4], p0[5]), cvt_pk_bf16(p0[6], p0[7])};
    u32x4 pw1 = {cvt_pk_bf16(p0[8], p0[9]), cvt_pk_bf16(p0[10], p0[11]), cvt_pk_bf16(p0[12], p0[13]), cvt_pk_bf16(p0[14], p0[15])};
    u32x4 pw2 = {cvt_pk_bf16(p1[0], p1[1]), cvt_pk_bf16(p1[2], p1[3]), cvt_pk_bf16(p1[4], p1[5]), cvt_pk_bf16(p1[6], p1[7])};
    u32x4 pw3 = {cvt_pk_bf16(p1[8], p1[9]), cvt_pk_bf16(p1[10], p1[11]), cvt_pk_bf16(p1[12], p1[13]), cvt_pk_bf16(p1[14], p1[15])};
    pv(o, vb, __builtin_bit_cast(bf16x8, pw0), __builtin_bit_cast(bf16x8, pw1), __builtin_bit_cast(bf16x8, pw2), __builtin_bit_cast(bf16x8, pw3));
}
#define SB_WAITBAR(N) asm volatile("s_waitcnt vmcnt(" #N ") lgkmcnt(0)\n\ts_barrier" ::: "memory")
__device__ __forceinline__ void sb_unit(int b, int h, int qb, const bf16_t* Q, const bf16_t* K, const bf16_t* V, bf16_t* O, float* hs, LAS char* shm) {
    int tid = threadIdx.x; asm volatile("" : "+v"(tid)); const int lane = tid & 63, r32 = lane & 31, hi = lane >> 5; const int wid = __builtin_amdgcn_readfirstlane(tid >> 6);
    const long rowbase = (long)b * SEQ; const int q0 = qb * QB;
    const bf16_t* Qw = Q + (rowbase + q0 + wid * 32) * PITCH + h * HD;
    const bf16_t* Kh = K + rowbase * PITCH + h * HD; const bf16_t* Vh = V + rowbase * PITCH + h * HD;
    const unsigned lds0 = (unsigned)(uintptr_t)shm;
    LAS unsigned* flags = (LAS unsigned*)(shm + LDS_FLAG);
    const unsigned koff = (unsigned)(lane * PITCH + wid * 8) * 2u, voff = (unsigned)((16 * (wid & 3) + (lane >> 2)) * PITCH + (wid >> 2) * 32 + (lane & 3) * 8) * 2u;
    const unsigned kdst = lds0 + LDS_K + wid * 1024, vdst = lds0 + LDS_V + wid * 1024;
#define SB_DMA(p, slot) do { glds16s(Kh + (long)(NT - 1 - (p)) * KVBLK * PITCH, koff, (unsigned)__builtin_amdgcn_readfirstlane(kdst + (slot) * SLOTB)); \
        glds16s(Vh + (long)(NT - 1 - (p)) * KVBLK * PITCH, voff, (unsigned)__builtin_amdgcn_readfirstlane(vdst + (slot) * SLOTB)); } while (0)
    const int vb0 = (int)(lds0 + LDS_V) + ((lane >> 4) & 1) * 32 + (lane & 3) * 8 + (4 * hi + ((lane & 15) >> 2)) * 64;
    const int NT = (q0 + QB) / KVBLK, NB = NT < NBURST ? NT : NBURST;
    for (int p = 0; p < NB; ++p) SB_DMA(p, p);
    bf16x8 qr[4];
#pragma unroll
    for (int d0 = 0; d0 < 4; ++d0) qr[d0] = *(const bf16x8*)(Qw + (long)r32 * PITCH + d0 * 16 + hi * 8);
    f32x16 o[2]; o[0] = f32x16{}; o[1] = f32x16{};
    const int qrel = wid * 32 + r32;
    float R = 0.f;
    bf16x8 TD0, TD1, TONE;
#pragma unroll
    for (int j = 0; j < 8; ++j) { const int kvl = 8 * (j >> 2) + 4 * hi + (j & 3); TD0[j] = (kvl >= r32) ? (short)0x3F80 : (short)0; TD1[j] = (16 + kvl >= r32) ? (short)0x3F80 : (short)0; TONE[j] = (short)0x3F80; }
    if (NB > 4) { SB_WAITBAR(4); } else { SB_WAITBAR(0); }
    bool mid_done = (NB <= 4);
    int p = 3 - (wid >> 1);
    for (; p < NB; ++p) {
        if (p >= 4 && !mid_done) { SB_WAITBAR(0); mid_done = true; }
        sb_tile(shm + LDS_K + p * SLOTB, vb0 + p * SLOTB, qr, TD0, TD1, TONE, 3 - p, qrel, r32, hi, R, o);
        if (__all(R < SB_EXIT)) { ++p; break; }
    }
    if (!mid_done) { SB_WAITBAR(0); }
    { const bool dn = __all(R < SB_EXIT) || (p >= NT); if (lane == 0) flags[wid] = dn ? 1u : 0u; }
    SB_WAITBAR(0);
    bool alldone;
    { const u32x4 fa = *(const LAS u32x4*)flags, fb = *(const LAS u32x4*)(flags + 4); alldone = __builtin_amdgcn_readfirstlane((fa.x & fa.y & fa.z & fa.w & fb.x & fb.y & fb.z & fb.w) != 0u); }
    if (!alldone && NB < NT) {
        SB_DMA(NB, 0);
        for (int i = 0; NB + i < NT; ++i) {
            const int pp = NB + i, sl = i & 1;
            SB_WAITBAR(0);
            if (i > 0) { const LAS unsigned* fl = flags + 8 + ((i - 1) & 1) * 8; const u32x4 fa = *(const LAS u32x4*)fl, fb = *(const LAS u32x4*)(fl + 4);
                if (__builtin_amdgcn_readfirstlane((fa.x & fa.y & fa.z & fa.w & fb.x & fb.y & fb.z & fb.w) != 0u)) break; }
            if (pp + 1 < NT) SB_DMA(pp + 1, sl ^ 1);
            if (!__all(R < SB_EXIT)) sb_tile(shm + LDS_K + sl * SLOTB, vb0 + sl * SLOTB, qr, TD0, TD1, TONE, -1, qrel, r32, hi, R, o);
            { const bool dn = __all(R < SB_EXIT); if (lane == 0) flags[8 + (i & 1) * 8 + wid] = dn ? 1u : 0u; }
        }
        SB_WAITBAR(0);
    }
    bf16_t* Ow = O + (rowbase + q0 + wid * 32) * OPITCH + h * HD;
    { LAS bf16_t* stg = (LAS bf16_t*)(shm + LDS_K) + wid * 2048;
#pragma unroll
      for (int r = 0; r < 16; ++r) { const int orow = crow(r, hi);
#pragma unroll
        for (int d0 = 0; d0 < 2; ++d0) stg[orow * 64 + d0 * 32 + r32] = (bf16_t)(cvt_pk_bf16(o[d0][r], 0.f) & 0xffffu); }
      LDS_WAIT();
#pragma unroll
      for (int i = 0; i < 4; ++i) { const int row = i * 8 + (lane >> 3), ch = lane & 7; const u32x4 v = *(const LAS u32x4*)(stg + row * 64 + ch * 8); *(u32x4*)(Ow + (long)row * OPITCH + ch * 8) = v;
        att::store_row_ssq(v, hs + (rowbase + q0 + wid * 32 + row) * 16, ch); } }
    asm volatile("s_waitcnt vmcnt(0) lgkmcnt(0)\n\ts_barrier" ::: "memory");
#undef SB_DMA
}
#undef SB_WAITBAR
}

#define XB_TMO      128
#define XB_XCNT(j)  (256  + 64 * (j))
#define XB_XSUB(j)  (1280 + 64 * (j))
#define XB_XGEN(j)  (2304 + 64 * (j))
#define XB_TOP      3328
#define XB_TOPGEN   3392
#define XCD_BAR_WORDS 3456
#define XB_SPIN_CAP (1u << 18)
__device__ __forceinline__ unsigned xb_ld(unsigned* p)              { return __hip_atomic_load(p, __ATOMIC_RELAXED, __HIP_MEMORY_SCOPE_AGENT); }
__device__ __forceinline__ unsigned xb_add(unsigned* p, unsigned v) { return __hip_atomic_fetch_add(p, v, __ATOMIC_RELAXED, __HIP_MEMORY_SCOPE_AGENT); }
__device__ __forceinline__ unsigned xb_xcc_id() { return (unsigned)__builtin_amdgcn_s_getreg((3 << 11) | 20) & 0xFu; }
#define XB_SPIN(cond, bar) do { unsigned _sp = 0; while (cond) { __builtin_amdgcn_s_sleep(1); \
    if ((++_sp & 255u) == 0u) { if (xb_ld(&(bar)[XB_TMO])) break; if (_sp > XB_SPIN_CAP) { atomicAdd(&(bar)[XB_TMO], 1u); break; } } } } while (0)
struct XcdBarrier { unsigned* bar; unsigned x; volatile LAS unsigned* st; };
__device__ __forceinline__ XcdBarrier xcd_barrier_post(unsigned* bar, volatile LAS unsigned* st) {
    XcdBarrier b; b.bar = bar; b.x = xb_xcc_id(); b.st = st;
    if (threadIdx.x == 0) (void)xb_add(&bar[XB_XCNT(b.x)], 1u);
    return b;
}
__device__ __forceinline__ void xcd_barrier_complete(unsigned* bar, unsigned x, unsigned& nloc, unsigned& nx) {
    const unsigned G = gridDim.x * gridDim.y * gridDim.z;
    unsigned sum, cnt, mine, sp = 0u;
    for (;;) {
        sum = 0u; cnt = 0u; mine = 0u;
#pragma unroll
        for (unsigned j = 0; j < 16; ++j) { const unsigned c = xb_ld(&bar[XB_XCNT(j)]); sum += c; cnt += (c > 0u) ? 1u : 0u; mine = (j == x) ? c : mine; }
        if (sum == G) break;
        __builtin_amdgcn_s_sleep(1);
        if ((++sp & 255u) == 0u) { if (xb_ld(&bar[XB_TMO])) break; if (sp > XB_SPIN_CAP) { atomicAdd(&bar[XB_TMO], 1u); break; } }
    }
    nloc = mine > 0u ? mine : 1u; nx = cnt > 0u ? cnt : 1u;
}
__device__ __forceinline__ void xcd_barrier(const XcdBarrier& b) {
    asm volatile("s_waitcnt vmcnt(0)" ::: "memory");
    __syncthreads();
    if (threadIdx.x == 0) {
        unsigned* bar = b.bar;
        __builtin_amdgcn_s_waitcnt(0);
        unsigned nloc = b.st[0], nx = b.st[1];
        if (nloc == 0u) { xcd_barrier_complete(bar, b.x, nloc, nx); b.st[0] = nloc; b.st[1] = nx; }
        const unsigned old = xb_add(&bar[XB_XSUB(b.x)], 1u);
        const unsigned gen = old / nloc;
        if (old + 1u == (gen + 1u) * nloc) {
            __builtin_amdgcn_fence(__ATOMIC_RELEASE, "agent");
            asm volatile("s_waitcnt vmcnt(0)" ::: "memory");
            const unsigned og = xb_add(&bar[XB_TOP], 1u);
            const unsigned tg = og / nx;
            if (og + 1u == (tg + 1u) * nx) xb_add(&bar[XB_TOPGEN], 1u);
            else XB_SPIN(xb_ld(&bar[XB_TOPGEN]) == tg, bar);
            __builtin_amdgcn_fence(__ATOMIC_ACQUIRE, "agent");
            xb_add(&bar[XB_XGEN(b.x)], 1u);
            asm volatile("s_waitcnt vmcnt(0)" ::: "memory");
        } else {
            XB_SPIN(xb_ld(&bar[XB_XGEN(b.x)]) == gen, bar);
            __builtin_amdgcn_fence(__ATOMIC_ACQUIRE, "agent");
            asm volatile("s_waitcnt vmcnt(0)" ::: "memory");
        }
    }
    __syncthreads();
}

__device__ __forceinline__ const void* ldp(const volatile LAS unsigned* tab, int i) {
    const unsigned lo = __builtin_amdgcn_readfirstlane(tab[2 * i]), hi = __builtin_amdgcn_readfirstlane(tab[2 * i + 1]);
    return (const void*)(const GAS void*)(((unsigned long long)hi << 32) | lo);
}
struct Args {
    const float* x; const float* mem; const float* norm_mix; const float* w_in; const float* b_forget; const float* norm_fox; const float* norm_sb; const float* w_out;
    const float* norm_xattn; const float* norm_mem; const float* w_xq; const float* w_xkv; const float* w_xo; const float* norm_ffn;
    const float* w_rg; const float* b_rg; const float* w_re; const float* b_re; const float* w_gate; const float* w_up; const float* w_down; const float* norm_final;
    float* out; unsigned char* ws;
};

__device__ __forceinline__ void transpose_item(const float* W, int ldw, bf16_t* WT, int ldo, int k0, int n0, int dst_row0, const float* gain, LAS float* scr, int lane) {
    float tv[32], tg[32];
#pragma unroll
    for (int i = 0; i < 32; ++i) { const int kk = 2 * i + (lane >> 5); tv[i] = W[(size_t)(k0 + kk) * ldw + n0 + (lane & 31)]; tg[i] = gain ? gain[k0 + kk] : 1.f; }
#pragma unroll
    for (int i = 0; i < 32; ++i) { const int kk = 2 * i + (lane >> 5); scr[kk * 33 + (lane & 31)] = tv[i] * tg[i]; }
    LDS_WAIT(); asm volatile("" ::: "memory");
    const int c = lane & 7;
#pragma unroll
    for (int j = 0; j < 4; ++j) { const int n = (lane >> 3) + 8 * j; const LAS float* s = scr + (8 * c) * 33 + n;
        u32x4 o; o.x = cvt_pk_bf16(s[0 * 33], s[1 * 33]); o.y = cvt_pk_bf16(s[2 * 33], s[3 * 33]); o.z = cvt_pk_bf16(s[4 * 33], s[5 * 33]); o.w = cvt_pk_bf16(s[6 * 33], s[7 * 33]);
        *(u32x4*)(WT + (size_t)(dst_row0 + n) * ldo + k0 + 8 * c) = o; }
    LDS_WAIT(); asm volatile("" ::: "memory");
}

__device__ __forceinline__ void transpose_item8(const float* W, int ldw, unsigned char* WT, int ldo, int k0, int n0, int dst_row0, const float* gain, float scale, LAS float* scr, int lane) {
    float tv[32], tg[32];
#pragma unroll
    for (int i = 0; i < 32; ++i) { const int kk = 2 * i + (lane >> 5); tv[i] = W[(size_t)(k0 + kk) * ldw + n0 + (lane & 31)]; tg[i] = gain ? gain[k0 + kk] : 1.f; }
#pragma unroll
    for (int i = 0; i < 32; ++i) { const int kk = 2 * i + (lane >> 5); scr[kk * 33 + (lane & 31)] = tv[i] * tg[i] * scale; }
    LDS_WAIT(); asm volatile("" ::: "memory");
    const int c = lane & 7;
#pragma unroll
    for (int j = 0; j < 4; ++j) { const int n = (lane >> 3) + 8 * j; const LAS float* s = scr + (8 * c) * 33 + n;
        u32x2 o; o.x = cvt4_fp8(s[0 * 33], s[1 * 33], s[2 * 33], s[3 * 33]); o.y = cvt4_fp8(s[4 * 33], s[5 * 33], s[6 * 33], s[7 * 33]);
        *(u32x2*)(WT + (size_t)(dst_row0 + n) * ldo + k0 + 8 * c) = o; }
    LDS_WAIT(); asm volatile("" ::: "memory");
}

struct SchedDense {
    const char* A; const char* Bt; int nM, nN, G, c; size_t a_tile, b_tile, b_batch; int split_tiles;
    __device__ __forceinline__ bool next(int i, pg8::Unit& u) const {
        int pm, pn; if (!pg8::tile_order(i, G, c, nM, nN, pm, pn)) return false;
        u.a = A + (size_t)pm * a_tile; u.b = Bt + (size_t)pn * b_tile + (size_t)(pm >> 5) * b_batch; u.orow = pm * 256;
        if (split_tiles) { u.aux = pn / split_tiles; u.ocol = (pn % split_tiles) * 256; } else { u.aux = 1; u.ocol = pn * 256; }
        u.rows = nullptr; u.nvalid = 256; return true;
    }
};
struct SchedGH {
    const char* KVm; const char* Wxq; const char* Wxo; int G, c;
    __device__ __forceinline__ bool next(int i, pg8::Unit& u) const {
        const int L = i * G + c; if (L >= 256) return false;
        const int kind = L >> 7, r = L & 127, bh = r >> 2, j = r & 3, b = bh >> 2, h = bh & 3;
        if (kind == 0) { u.a = KVm + ((size_t)(b * 256) * 2048 + h * 256) * 2; u.b = Wxq + ((size_t)(256 * j) * 1024 + h * 256) * 2; u.orow = b * 1024 + h * 256; u.ocol = 256 * j; u.aux = 1; }
        else { u.a = Wxo + ((size_t)(256 * j) * 1024 + h * 256) * 2; u.b = KVm + ((size_t)(b * 256) * 2048 + 1024 + h * 256) * 2; u.orow = b * 1024 + 256 * j; u.ocol = h * 256; u.aux = 2; }
        u.rows = nullptr; u.nvalid = 256; return true;
    }
};
template <int KIND> struct SchedGHk { SchedGH s; __device__ __forceinline__ bool next(int i, pg8::Unit& u) const { const int c2 = (s.G >= 256) ? s.c - 128 * KIND : s.c; if (c2 < 0) return false; const int L = i * s.G + c2; if (L >= 128) return false; SchedGH t = s; t.G = 1; t.c = 0; return t.next(128 * KIND + L, u); } };
struct EpiGH { static constexpr bool HAS_MID = false; unsigned char* GTp; unsigned char* HTp;
    __device__ __forceinline__ void operator()(const f32x4 (&acc)[2][2][4][2], const pg8::Unit& u, int wr, int wc, int fr, int fq) const {
        unsigned char* base = u.aux == 1 ? GTp : HTp;
#pragma unroll
        for (int ai = 0; ai < 2; ++ai)
#pragma unroll
            for (int m = 0; m < 4; ++m) { const int row = u.orow + ai * pg8::HALF + wr * 64 + m * 16 + fr;
#pragma unroll
                for (int bj = 0; bj < 2; ++bj) { const f32x4 v0 = acc[ai][bj][m][0], v1 = acc[ai][bj][m][1];
                    u32x2 w8; w8.x = cvt4_fp8(v0[0], v0[1], v0[2], v0[3]); w8.y = cvt4_fp8(v1[0], v1[1], v1[2], v1[3]);
                    *(u32x2*)(base + (size_t)row * DM + u.ocol + bj * pg8::HALF + wc * 32 + 8 * fq) = w8; } }
    } };
struct SchedMoe {
    const char* A; const char* W; const int* list; const LAS int* tbl; int G, c, NPN; size_t w_exp, w_tile, a_tile; int ocol_w;
    __device__ __forceinline__ bool next(int i, pg8::Unit& u) const {
        const int L = i * G + c; const int tl = L / NPN, pn = L % NPN;
        if (tl >= __builtin_amdgcn_readfirstlane(tbl[16])) return false;
        int e = 0;
#pragma unroll 1
        for (int x = 1; x < NEXP; ++x) { if (tl >= __builtin_amdgcn_readfirstlane(tbl[x])) e = x; }
        const int j = tl - __builtin_amdgcn_readfirstlane(tbl[e]), n = __builtin_amdgcn_readfirstlane(tbl[32 + e]) - 256 * j;
        u.a = A + (size_t)tl * a_tile; u.b = W + (size_t)e * w_exp + (size_t)pn * w_tile; u.orow = tl * 256; u.ocol = pn * ocol_w; u.aux = 1;
        u.rows = list + (size_t)e * M + 256 * j; u.nvalid = n < 256 ? n : 256; return true;
    }
};
__device__ __forceinline__ void moe_table(LAS int* tbl, const unsigned* ctl) {
    if (threadIdx.x == 0) { int base = 0; for (int e = 0; e < NEXP; ++e) { const int n = (int)ctl[CW_CNT + 64 * e]; tbl[e] = base; tbl[32 + e] = n; base += (n + 255) >> 8; } tbl[16] = base; }
    __syncthreads();
}

__global__ void __launch_bounds__(NWAVES * 64, 2) hymba_fwd(Args args) {
    extern __shared__ __attribute__((aligned(16))) unsigned char lds_raw[];
    LAS unsigned char* lds = (LAS unsigned char*)lds_raw;
    volatile LAS unsigned* MISC = (volatile LAS unsigned*)(lds + MISC_OFF);
    const int tid0 = threadIdx.x; const int wave = __builtin_amdgcn_readfirstlane(tid0 >> 6);
    const int G = gridDim.x; const int bx = blockIdx.x; const int vcu = (G % 8 == 0) ? (bx % 8) * (G / 8) + bx / 8 : bx;
    volatile LAS unsigned* ATAB = (volatile LAS unsigned*)(lds + MISC_OFF + 512);
    for (int u = tid0; u < 256; u += NWAVES * 64) ((LAS unsigned*)(lds + MISC_OFF))[u] = 0u;
    __syncthreads();
    if (tid0 == 0) { const float* const* ap = (const float* const*)&args;
#pragma unroll
        for (int i = 0; i < 24; ++i) { const unsigned long long v = (unsigned long long)ap[i]; ATAB[2 * i] = (unsigned)v; ATAB[2 * i + 1] = (unsigned)(v >> 32); } }
    __syncthreads();
#define ARGP(name) ((const float*)ldp(ATAB, (int)(offsetof(Args, name) / 8)))
#define PHASE_PTRS \
    int tid = threadIdx.x; asm volatile("" : "+v"(tid)); const int lane = tid & 63; (void)lane; \
    unsigned char* const ws = (unsigned char*)ldp(ATAB, 23); float* const out = (float*)ldp(ATAB, 22); unsigned* const ctl = (unsigned*)(ws + WS_CTL); (void)out; (void)ctl; \
    bf16_t* const Win_t = (bf16_t*)(ws + WS_WIN); bf16_t* const Wout_t = (bf16_t*)(ws + WS_WOUT); bf16_t* const Wxq_n = (bf16_t*)(ws + WS_WXQ); bf16_t* const Wxkv_t = (bf16_t*)(ws + WS_WXKV); \
    bf16_t* const Wxo_t = (bf16_t*)(ws + WS_WXO); bf16_t* const Wgu_t = (bf16_t*)(ws + WS_WGU); bf16_t* const Wd_t = (bf16_t*)(ws + WS_WD); \
    float* const RX = (float*)(ws + WS_RX); float* const RMEM = (float*)(ws + WS_RMEM); float* const LF = (float*)(ws + WS_LF); float* const CC = (float*)(ws + WS_C2); float* const SSQ = (float*)(ws + WS_SSQ); \
    int* const TOKSLOT = (int*)(ws + WS_TOKSLOT); float* const TOKW = (float*)(ws + WS_TOKW); int* const LIST = (int*)(ws + WS_LIST); \
    bf16_t* const MEMB = (bf16_t*)(ws + WS_MEMB); bf16_t* const KVM = (bf16_t*)(ws + WS_KVM); bf16_t* const GT = (bf16_t*)(ws + WS_GT); bf16_t* const HT = (bf16_t*)(ws + WS_HT); \
    bf16_t* const XB = (bf16_t*)(ws + WS_XB); bf16_t* const QKV = (bf16_t*)(ws + WS_QKV); bf16_t* const H1B = (bf16_t*)(ws + WS_H1B); bf16_t* const U2B = (bf16_t*)(ws + WS_U2B); bf16_t* const HID = (bf16_t*)(ws + WS_HID); \
    bf16_t* const OAB = (bf16_t*)(ws + WS_O); bf16_t* const YB = (bf16_t*)(ws + WS_Y); bf16_t* const KX = (bf16_t*)(ws + WS_KX); (void)KX; float* const HS = (float*)(ws + WS_HS); (void)HS; float* const R2S = (float*)(ws + WS_SSQ); (void)R2S; unsigned char* const H1F8 = ws + WS_H1F8; (void)H1F8; unsigned char* const H2F8 = ws + WS_H2F8; (void)H2F8; \
    (void)Win_t; (void)Wout_t; (void)Wxq_n; (void)Wxkv_t; (void)Wxo_t; (void)Wgu_t; (void)Wd_t; (void)RX; (void)RMEM; (void)LF; (void)CC; (void)SSQ; (void)TOKSLOT; (void)TOKW; (void)LIST; \
    (void)MEMB; (void)KVM; (void)GT; (void)HT; (void)XB; (void)QKV; (void)H1B; (void)U2B; (void)HID; (void)OAB; (void)YB;
    XcdBarrier bar;
    { unsigned char* const ws0 = (unsigned char*)ldp(ATAB, 23); bar = xcd_barrier_post((unsigned*)(ws0 + WS_CTL) + CW_BAR, MISC + 8); }
    const int gw = vcu * NWAVES + wave, NGW = G * NWAVES;
    unsigned long long t_pa = 0, t_pb = 0; (void)t_pa; (void)t_pb;


    if (PROBE_LO == 0) t_pa = __builtin_amdgcn_s_memrealtime();
    if (PH(0))
    for (int rep_ = 0; rep_ < REPS(0); ++rep_)
    {
        PHASE_PTRS
        LAS float* wfT = (LAS float*)(lds + RING_OFF);
        LAS float* scr = (LAS float*)(lds + RING_OFF + 32768 + wave * 8448);
        { const float* win = ARGP(w_in); const float* gmix = ARGP(norm_mix);
          f32x4 fa[2], fb[2]; float gk[2];
#pragma unroll
          for (int q = 0; q < 2; ++q) { const int k = tid + 512 * q; gk[q] = gmix[k]; fa[q] = *(const f32x4*)(win + (size_t)k * WIN_LD + NPROJ); fb[q] = *(const f32x4*)(win + (size_t)k * WIN_LD + NPROJ + 4); }
#pragma unroll
          for (int q = 0; q < 2; ++q) { const int k = tid + 512 * q;
#pragma unroll
              for (int j = 0; j < 4; ++j) { wfT[j * DM + k] = fa[q][j] * gk[q]; wfT[(4 + j) * DM + k] = fb[q][j] * gk[q]; } } }
        constexpr int I_IN = 16 * 96, I_OUT = 16 * 32, I_XKV = 16 * 64, I_XO = 16 * 32, I_G = 16 * 16 * 8, I_U = I_G, I_D = 16 * 4 * 32, I_XQ = 1024;
        constexpr int NITEMS = I_IN + I_OUT + I_XKV + I_XO + I_G + I_U + I_D + I_XQ;
        for (int it = gw; it < NITEMS; it += NGW) {
            int r = it;
            if (r < I_IN) { const int kb = r / 96, nb = r % 96; transpose_item(ARGP(w_in), WIN_LD, Win_t, DM, 64 * kb, 32 * nb, 32 * nb, ARGP(norm_mix), scr, lane); continue; } r -= I_IN;
            if (r < I_OUT) { const int kb = r / 32, nb = r % 32; const float* gn = (64 * kb < HW) ? ARGP(norm_fox) : (ARGP(norm_sb) - HW); transpose_item(ARGP(w_out), DM, Wout_t, DM, 64 * kb, 32 * nb, 32 * nb, gn, scr, lane); continue; } r -= I_OUT;
            if (r < I_XKV) { const int kb = r / 64, nb = r % 64; transpose_item(ARGP(w_xkv), 2 * DM, Wxkv_t, DM, 64 * kb, 32 * nb, 32 * nb, ARGP(norm_mem), scr, lane); continue; } r -= I_XKV;
            if (r < I_XO) { const int kb = r / 32, nb = r % 32; transpose_item(ARGP(w_xo), DM, Wxo_t, DM, 64 * kb, 32 * nb, 32 * nb, nullptr, scr, lane); continue; } r -= I_XO;
            if (r < I_G + I_U) { const int up = r >= I_G; const int q = up ? r - I_G : r; const int e = q / 128, kb = (q % 128) / 8, nb = q % 8; const int n0 = 32 * nb;
                const float* W = (up ? ARGP(w_up) : ARGP(w_gate)) + (size_t)e * DM * DFF;
                transpose_item8(W, DFF, (unsigned char*)Wgu_t + (size_t)e * 512 * DM, DM, 64 * kb, n0, 256 * (n0 / 128) + (n0 % 128) + (up ? 128 : 0), ARGP(norm_ffn), WGU_SCALE, scr, lane); continue; } r -= I_G + I_U;
            if (r < I_D) { const int e = r / 128, kb = (r % 128) / 32, nb = r % 32; transpose_item8(ARGP(w_down) + (size_t)e * DFF * DM, DM, (unsigned char*)Wd_t + (size_t)e * DM * DFF, DFF, 64 * kb, 32 * nb, 32 * nb, nullptr, WD_SCALE, scr, lane); continue; } r -= I_D;
            { const int k = r; const float gk = ARGP(norm_xattn)[k]; const f32x4* src = (const f32x4*)(ARGP(w_xq) + (size_t)k * DM) + lane; u32x2* dst = (u32x2*)(Wxq_n + (size_t)k * DM) + lane;
#pragma unroll
              for (int j = 0; j < 4; ++j) { const f32x4 v = src[64 * j] * gk; u32x2 w; w.x = cvt_pk_bf16(v[0], v[1]); w.y = cvt_pk_bf16(v[2], v[3]); dst[64 * j] = w; } }
        }
        __syncthreads();
        const float* xin = ARGP(x); const float* memin = ARGP(mem); const float* bfg = ARGP(b_forget);
        constexpr int TOT = M + MEMROWS;
#define P0_LOAD(vv, rw) do { if ((rw) < TOT) { const bool im_ = (rw) >= M; const f32x4* xr_ = (const f32x4*)((im_ ? memin : xin) + (size_t)(im_ ? (rw) - M : (rw)) * DM) + lane; \
        _Pragma("unroll") for (int j = 0; j < 4; ++j) vv[j] = __builtin_nontemporal_load(xr_ + 64 * j); } } while (0)
#define P0_ROW(vv, rw) do { const int row_ = (rw); const bool is_mem = row_ >= M; const int r = is_mem ? row_ - M : row_; float s = 0.f; \
        _Pragma("unroll") for (int j = 0; j < 4; ++j) s += (vv[j][0] * vv[j][0] + vv[j][1] * vv[j][1]) + (vv[j][2] * vv[j][2] + vv[j][3] * vv[j][3]); \
        const float rinv = rsqrtf(wave_sum(s) * (1.0f / DM) + EPS); \
        u32x2* o8 = (u32x2*)((is_mem ? MEMB : XB) + (size_t)r * DM) + lane; \
        _Pragma("unroll") for (int j = 0; j < 4; ++j) { u32x2 w; w.x = cvt_pk_bf16(vv[j][0], vv[j][1]); w.y = cvt_pk_bf16(vv[j][2], vv[j][3]); o8[64 * j] = w; } \
        if (is_mem) { if (lane == 0) RMEM[r] = rinv; } \
        else { float f[8]; \
            _Pragma("unroll") for (int jj = 0; jj < 8; ++jj) { float a = 0.f; \
                _Pragma("unroll") for (int j = 0; j < 4; ++j) { const f32x4 w4 = *(const LAS f32x4*)(wfT + jj * DM + 256 * j + 4 * lane); a += (vv[j][0] * w4[0] + vv[j][1] * w4[1]) + (vv[j][2] * w4[2] + vv[j][3] * w4[3]); } \
                f[jj] = wave_sum(a); } \
            if (lane == 0) RX[r] = rinv; \
            if (lane < 8) { float fl = 0.f; \
                _Pragma("unroll") for (int jj = 0; jj < 8; ++jj) fl = (lane == jj) ? f[jj] : fl; \
                fl = fl * rinv + bfg[lane]; \
                const float ls = fminf(fl, 0.f) - log1pf(expf(-fabsf(fl))); \
                LF[(size_t)r * 8 + lane] = ls * LOG2E; } } } while (0)
        f32x4 va[4], vb[4], vc[4];
        P0_LOAD(va, gw); P0_LOAD(vb, gw + NGW);
        for (int row = gw; row < TOT; row += 3 * NGW) {
            P0_LOAD(vc, row + 2 * NGW); P0_ROW(va, row);
            if (row + NGW < TOT) { P0_LOAD(va, row + 3 * NGW); P0_ROW(vb, row + NGW); }
            if (row + 2 * NGW < TOT) { P0_LOAD(vb, row + 4 * NGW); P0_ROW(vc, row + 2 * NGW); }
        }
#undef P0_LOAD
#undef P0_ROW
    }
    xcd_barrier(bar);
    if (PROBE_HI == 0) t_pb = __builtin_amdgcn_s_memrealtime();

    if (PROBE_LO == 1) t_pa = __builtin_amdgcn_s_memrealtime();
    if (PH(1))
    if (vcu < 32) {
        PHASE_PTRS
        const int b = vcu >> 2, h = (vcu & 3) * 2 + (wave >> 2), seg = wave & 3, s0 = seg * 2048 + lane * 32;
        const float* src = LF + ((size_t)b * SEQ + s0) * 8 + h;
        float p[32];
#pragma unroll
        for (int j = 0; j < 32; ++j) p[j] = src[j * 8];
#pragma unroll
        for (int j = 1; j < 32; ++j) p[j] += p[j - 1];
        float inc = p[31];
#pragma unroll
        for (int o = 1; o < 64; o <<= 1) { const float y = __shfl_up(inc, o); if (lane >= o) inc += y; }
        LAS float* tot = (LAS float*)(lds + EXTRA_OFF);
        if (lane == 63) tot[wave] = inc;
        __syncthreads();
        float off = inc - p[31];
        for (int q = 0; q < 3; ++q) if (q < seg) off += tot[(wave & 4) + q];
        float* dst = CC + ((size_t)b * NH + h) * SEQ + s0; bf16_t* kx = KX + (((size_t)b * NH + h) * SEQ + s0) * 8;
#pragma unroll
        for (int j = 0; j < 32; ++j) { const float x = off + p[j]; dst[j] = x;
            unsigned hm, lo; fox::split3(-x, hm, lo); u32x4 w; w.x = 0x3F803F80u; w.y = 0x3F80u | (hm << 16); w.z = (hm >> 16) | (lo << 16); w.w = 0u;
            *(u32x4*)(kx + j * 8) = w; }
        VM_WAIT(); __syncthreads();
    }
    if (PH(1))
    for (int rep_ = 0; rep_ < REPS(1); ++rep_)
    {
        PHASE_PTRS
        pg8::Gemm g{DM, DM, DM};
        SchedDense S{(const char*)XB, (const char*)Win_t, M / 256, NPROJ / 256, G, bx, (size_t)256 * DM * 2, (size_t)256 * DM * 2, 0, 2};
        LAS float* rst = (LAS float*)(lds + EXTRA_OFF);
#pragma unroll
        for (int q = 0; q < 8; ++q) { const int idx = tid + 512 * q, i = idx >> 8, r = idx & 255; int pm, pn; if (pg8::tile_order(i, G, bx, M / 256, NPROJ / 256, pm, pn)) rst[idx] = RX[pm * 256 + r]; }
        VM_WAIT(); __syncthreads();
        pg8::EpiBf16 E{QKV, HW, RX, QKV_STRIDE, C2, C2, ctl + CW_KN, rst, 1.f, false};
        pg8::gemm_phase<pg8::EpiBf16, SchedDense, true, false>(lds + RING_OFF, g, S, E);
    }
    xcd_barrier(bar);
    if (PROBE_HI == 1) t_pb = __builtin_amdgcn_s_memrealtime();

    if (PROBE_LO == 2) t_pa = __builtin_amdgcn_s_memrealtime();
    if (PH(2))
    {
        PHASE_PTRS
        const bf16_t* QA = QKV; const bf16_t* KA = QKV + QKV_STRIDE; const bf16_t* VA = QKV + 2 * QKV_STRIDE;
        const bf16_t* QBp = QKV + 3 * QKV_STRIDE; const bf16_t* KBp = QKV + 4 * QKV_STRIDE; const bf16_t* VBp = QKV + 5 * QKV_STRIDE;
        bf16_t* OA = OAB; bf16_t* OB = OAB + HW;
        LAS char* shm = (LAS char*)(lds + RING_OFF);
        { pg8::Gemm g{DM, DM, DM};
          SchedDense S2{(const char*)MEMB, (const char*)Wxkv_t, MEMROWS / 256, 2 * DM / 256, G, bx, (size_t)256 * DM * 2, (size_t)256 * DM * 2, 0, 0};
          pg8::EpiBf16 E2{KVM, 2 * DM, RMEM, 0, 1.f, 1.f, nullptr, nullptr, 1.f, false};
          pg8::gemm_phase<pg8::EpiBf16, SchedDense, true, false>(lds + RING_OFF, g, S2, E2);
          VM_WAIT(); __syncthreads(); }
        for (int rep = 0; rep < REP_FOX; ++rep)
        for (int i = 0; i < 8; ++i) { const int bh = (vcu >> 5) * 8 + i, x = vcu & 31, qb = (i & 1) ? 31 - x : x;
            const float kmax = sqrtf(__uint_as_float(ctl[CW_KN + bh * 2]) + __uint_as_float(ctl[CW_KN + bh * 2 + 1])) * 1.01f;
            const int nqb = ((i + 1) & 1) ? 31 - x : x;
            fox::fox_unit<8>(bh, qb, QA, KA, VA, OA, HS + (bh & 7), CC + (size_t)bh * SEQ, KX, kmax, shm, i > 0, i < 7 ? bh + 1 : -1, nqb); }
        { volatile LAS unsigned* qs = MISC + 16;
          unsigned nxt = 0u;
          if (tid == 0) qs[0] = __hip_atomic_fetch_add(ctl + CW_SBQ, 1u, __ATOMIC_RELAXED, __HIP_MEMORY_SCOPE_AGENT);
          __syncthreads();
          unsigned idx = qs[0];
          while (idx < (unsigned)(BATCH * NH * 32 * REP_SB)) {
              __syncthreads();
              if (tid == 0) nxt = __hip_atomic_fetch_add(ctl + CW_SBQ, 1u, __ATOMIC_RELAXED, __HIP_MEMORY_SCOPE_AGENT);
              const int un = (int)(idx % (unsigned)(BATCH * NH * 32)), bh = un >> 5, qb = un & 31;
              sbk::sb_unit(bh >> 3, bh & 7, qb, QBp, KBp, VBp, OB, HS + 8 + (bh & 7), shm);
              if (tid == 0) qs[0] = nxt;
              __syncthreads();
              idx = qs[0];
          } }
    }
    xcd_barrier(bar);
    if (PROBE_HI == 2) t_pb = __builtin_amdgcn_s_memrealtime();

    if (PROBE_LO == 4) t_pa = __builtin_amdgcn_s_memrealtime();
    if (PH(4))
    for (int rep_ = 0; rep_ < REPS(4); ++rep_)
    {
        PHASE_PTRS
        pg8::Gemm g{DM, DM, DM};
        SchedDense S{(const char*)OAB, (const char*)Wout_t, M / 256, DM / 256, G, bx, (size_t)256 * DM * 2, (size_t)256 * DM * 2, 0, 0};
        LAS f32x2* rab = (LAS f32x2*)(lds + EXTRA_OFF);
#pragma unroll
        for (int q = 0; q < 4; ++q) { const int idx = tid + 512 * q, i = idx >> 8, r = idx & 255; int pm, pn;
            if (pg8::tile_order(i, G, bx, M / 256, DM / 256, pm, pn)) { const f32x4* p = (const f32x4*)(HS + (size_t)(pm * 256 + r) * 16); const f32x4 a0 = p[0], a1 = p[1], b0 = p[2], b1 = p[3];
                const float ra = rsqrtf((((a0[0] + a0[1]) + (a0[2] + a0[3])) + ((a1[0] + a1[1]) + (a1[2] + a1[3]))) * (1.0f / HW) + EPS);
                const float rb = rsqrtf((((b0[0] + b0[1]) + (b0[2] + b0[3])) + ((b1[0] + b1[1]) + (b1[2] + b1[3]))) * (1.0f / HW) + EPS);
                rab[idx] = (f32x2){ra / rb, rb}; } }
        VM_WAIT(); __syncthreads();
        pg8::EpiOutProj E{XB, H1B, H1F8, SSQ, rab};
        pg8::gemm_phase<pg8::EpiOutProj, SchedDense, true, false>(lds + RING_OFF, g, S, E);
        pg8::Gemm g2{0, 0, 256};
        SchedGH SG{(const char*)KVM, (const char*)Wxq_n, (const char*)Wxo_t, G, bx};
        EpiGH EG{(unsigned char*)GT, (unsigned char*)HT};
        g2.lda = 2 * DM; g2.ldb = DM; SchedGHk<0> S0{SG}; pg8::gemm_phase<EpiGH, SchedGHk<0>, true, false>(lds + RING_OFF, g2, S0, EG);
        g2.lda = DM; g2.ldb = 2 * DM; SchedGHk<1> S1{SG}; pg8::gemm_phase<EpiGH, SchedGHk<1>, true, false>(lds + RING_OFF, g2, S1, EG);
    }
    xcd_barrier(bar);
    if (PROBE_HI == 4) t_pb = __builtin_amdgcn_s_memrealtime();

    if (PROBE_LO == 5) t_pa = __builtin_amdgcn_s_memrealtime();
    if (PH(5))
    for (int rep_ = 0; rep_ < REPS(5); ++rep_)
    {
        PHASE_PTRS
        pg8::Gemm g{DM, DM, DM};
        SchedDense S{(const char*)H1F8, (const char*)GT, M / 256, DM / 256, G, bx, (size_t)256 * DM, (size_t)256 * DM, (size_t)DM * DM, 0};
        LAS float* r1t = (LAS float*)(lds + EXTRA_OFF + 8192);
#pragma unroll
        for (int q = 0; q < 4; ++q) { const int idx = tid + 512 * q, i = idx >> 8, r = idx & 255; int pm, pn;
            if (pg8::tile_order(i, G, bx, M / 256, DM / 256, pm, pn)) { const f32x4* sp = (const f32x4*)(SSQ + (size_t)(pm * 256 + r) * 16); const f32x4 s0 = sp[0], s1 = sp[1], s2 = sp[2], s3 = sp[3];
                const float tot = ((s0[0] + s0[1]) + (s0[2] + s0[3])) + ((s1[0] + s1[1]) + (s1[2] + s1[3])) + ((s2[0] + s2[1]) + (s2[2] + s2[3])) + ((s3[0] + s3[1]) + (s3[2] + s3[3]));
                r1t[idx] = rsqrtf(tot * (1.0f / DM) + EPS) * XSC; } }
        VM_WAIT(); __syncthreads();
        pg8::EpiSoftmax E{XB, r1t, (LAS float*)(lds + EXTRA_OFF)};
        pg8::gemm_phase<pg8::EpiSoftmax, SchedDense, true, false, true>(lds + RING_OFF, g, S, E);
    }
    xcd_barrier(bar);
    if (PROBE_HI == 5) t_pb = __builtin_amdgcn_s_memrealtime();

    if (PROBE_LO == 6) t_pa = __builtin_amdgcn_s_memrealtime();
    if (PH(6))
    {
        PHASE_PTRS
        pg8::Gemm g{DM, DM, DM};
        SchedDense S{(const char*)XB, (const char*)HT, M / 256, DM / 256, G, bx, (size_t)256 * DM, (size_t)256 * DM, (size_t)DM * DM, 0};
        pg8::EpiResidBf16 E{H1B, H2F8, 1.0f / P_SCALE};
        pg8::gemm_phase<pg8::EpiResidBf16, SchedDense, true, false, true>(lds + RING_OFF, g, S, E);
    }
    xcd_barrier(bar);
    if (PROBE_HI == 6) t_pb = __builtin_amdgcn_s_memrealtime();

    if (PROBE_LO == 7) t_pa = __builtin_amdgcn_s_memrealtime();
    if (PH(7))
    {
        PHASE_PTRS
        LAS bf16_t* wBh = (LAS bf16_t*)(lds + RING_OFF); LAS bf16_t* wBl = wBh + 20 * DM;
        { const f32x4* wg4 = (const f32x4*)ARGP(w_rg); const f32x4* we4 = (const f32x4*)ARGP(w_re); const float* gf = ARGP(norm_ffn);
          f32x4 ga[2], ea[2][4]; float gk[2];
#pragma unroll
          for (int q = 0; q < 2; ++q) { const int k = tid + 512 * q; ga[q] = wg4[k]; gk[q] = gf[k];
#pragma unroll
              for (int c = 0; c < 4; ++c) ea[q][c] = we4[k * 4 + c]; }
#pragma unroll
          for (int q = 0; q < 2; ++q) { const int k = tid + 512 * q;
#pragma unroll
              for (int j = 0; j < 4; ++j) { { const float v = ga[q][j] * gk[q]; const unsigned hi_ = cvt_pk_bf16(v, 0.f) & 0xffffu; wBh[j * DM + k] = (bf16_t)hi_; wBl[j * DM + k] = (bf16_t)(cvt_pk_bf16(v - __uint_as_float(hi_ << 16), 0.f) & 0xffffu); }
#pragma unroll
                  for (int c = 0; c < 4; ++c) { const float v = ea[q][c][j] * gk[q]; const unsigned hi_ = cvt_pk_bf16(v, 0.f) & 0xffffu; const int col = 4 + 4 * c + j; wBh[col * DM + k] = (bf16_t)hi_; wBl[col * DM + k] = (bf16_t)(cvt_pk_bf16(v - __uint_as_float(hi_ << 16), 0.f) & 0xffffu); } } } }
        LAS int* dec_e = (LAS int*)(lds + RING_OFF + 81920); LAS float* dec_w = (LAS float*)(lds + RING_OFF + 81920 + 2048); LAS int* dec_r = (LAS int*)(lds + RING_OFF + 81920 + 4096);
        LAS int* hist = (LAS int*)(lds + RING_OFF + 81920 + 6144); LAS int* ebase = hist + 16; LAS float* dec_v = (LAS float*)(lds + RING_OFF + 81920 + 8192);
        if (tid < 16) hist[tid] = 0;
        __syncthreads();
        const float brg0 = ARGP(b_rg)[0], brg1 = ARGP(b_rg)[1], brg2 = ARGP(b_rg)[2], brg3 = ARGP(b_rg)[3]; const float* bre = ARGP(b_re);
        const int tok = lane & 31, half = lane >> 5, jcol = tok < 20 ? tok : 19;
        for (int it = 0; it * NGW < M / 32; ++it) {
            const int T = gw + it * NGW; const bool act = T < M / 32; const int r0 = act ? 32 * T : 0;
            const bf16_t* rowp = H1B + (size_t)(r0 + tok) * DM + 512 * half;
            const LAS bf16_t* wph = wBh + jcol * DM + 512 * half; const LAS bf16_t* wpl = wBl + jcol * DM + 512 * half;
            f32x16 ah0 = f32x16{}, ah1 = f32x16{}, al0 = f32x16{}, al1 = f32x16{}; float ssq = 0.f;
#pragma unroll 4
            for (int sidx = 0; sidx < 64; sidx += 2) {
                const u32x4 a0 = *(const u32x4*)(rowp + 8 * sidx), a1 = *(const u32x4*)(rowp + 8 * sidx + 8);
                const bf16x8 wh0 = *(const LAS bf16x8*)(wph + 8 * sidx), wl0 = *(const LAS bf16x8*)(wpl + 8 * sidx), wh1 = *(const LAS bf16x8*)(wph + 8 * sidx + 8), wl1 = *(const LAS bf16x8*)(wpl + 8 * sidx + 8);
                ah0 = MFMA32(wh0, __builtin_bit_cast(bf16x8, a0), ah0); al0 = MFMA32(wl0, __builtin_bit_cast(bf16x8, a0), al0);
                ah1 = MFMA32(wh1, __builtin_bit_cast(bf16x8, a1), ah1); al1 = MFMA32(wl1, __builtin_bit_cast(bf16x8, a1), al1);
                ssq += (bf16lo(a0.x) * bf16lo(a0.x) + bf16hi(a0.x) * bf16hi(a0.x)) + (bf16lo(a0.y) * bf16lo(a0.y) + bf16hi(a0.y) * bf16hi(a0.y)) + (bf16lo(a0.z) * bf16lo(a0.z) + bf16hi(a0.z) * bf16hi(a0.z)) + (bf16lo(a0.w) * bf16lo(a0.w) + bf16hi(a0.w) * bf16hi(a0.w));
                ssq += (bf16lo(a1.x) * bf16lo(a1.x) + bf16hi(a1.x) * bf16hi(a1.x)) + (bf16lo(a1.y) * bf16lo(a1.y) + bf16hi(a1.y) * bf16hi(a1.y)) + (bf16lo(a1.z) * bf16lo(a1.z) + bf16hi(a1.z) * bf16hi(a1.z)) + (bf16lo(a1.w) * bf16lo(a1.w) + bf16hi(a1.w) * bf16hi(a1.w));
            }
            const float rinv = rsqrtf((att::swap_lo(ssq) + att::swap_hi(ssq)) * (1.0f / DM) + EPS);
            float lg[20];
#pragma unroll
            for (int r = 0; r < 12; ++r) { const float c = (ah0[r] + ah1[r]) + (al0[r] + al1[r]); auto rr = __builtin_amdgcn_permlane32_swap(__float_as_uint(c), __float_as_uint(c), false, false);
                const int jl = (r & 3) + 8 * (r >> 2); lg[jl] = __uint_as_float(rr[0]) * rinv; if (r < 8) lg[jl + 4] = __uint_as_float(rr[1]) * rinv; }
            float g0 = lg[0] + brg0, g1 = lg[1] + brg1, g2 = lg[2] + brg2, g3 = lg[3] + brg3;
            int gi = 0; float gm = g0; if (g1 > gm) { gm = g1; gi = 1; } if (g2 > gm) { gm = g2; gi = 2; } if (g3 > gm) { gm = g3; gi = 3; }
            const float gval = 1.0f / (expf(g0 - gm) + expf(g1 - gm) + expf(g2 - gm) + expf(g3 - gm));
            float el[4];
#pragma unroll
            for (int j = 0; j < 4; ++j) { const float e0 = lg[4 + j], e1 = lg[8 + j], e2 = lg[12 + j], e3 = lg[16 + j]; el[j] = ((gi == 0) ? e0 : (gi == 1) ? e1 : (gi == 2) ? e2 : e3) + bre[gi * 4 + j]; }
            int i0 = 0; float m0 = el[0];
#pragma unroll
            for (int j = 1; j < 4; ++j) if (el[j] > m0) { m0 = el[j]; i0 = j; }
            int i1 = -1; float m1 = -3.0e38f;
#pragma unroll
            for (int j = 0; j < 4; ++j) if (j != i0 && el[j] > m1) { m1 = el[j]; i1 = j; }
            const float w0 = 1.0f / (1.0f + expf(m1 - m0)), w1 = 1.0f - w0;
            if (act) { const int e = gi * 4 + (half == 0 ? i0 : i1); const float w = gval * (half == 0 ? w0 : w1);
                const int idx = (wave * 32 + tok) * 2 + half; dec_e[idx] = e; dec_w[idx] = w; dec_v[idx] = rinv; dec_r[idx] = __hip_atomic_fetch_add(hist + e, 1, __ATOMIC_RELAXED, __HIP_MEMORY_SCOPE_WORKGROUP); }
            __syncthreads();
            if (tid < 16) { const int n = hist[tid]; ebase[tid] = n ? (int)__hip_atomic_fetch_add(ctl + CW_CNT + 64 * tid, (unsigned)n, __ATOMIC_RELAXED, __HIP_MEMORY_SCOPE_AGENT) : 0; }
            __syncthreads();
            if (act) { const int row = r0 + (lane >> 1), idx = wave * 64 + lane; const int e = dec_e[idx], pos = ebase[e] + dec_r[idx];
                LIST[(size_t)e * M + pos] = row; R2S[(size_t)e * M + pos] = dec_v[idx]; TOKSLOT[(size_t)row * 2 + (lane & 1)] = (e << 20) | pos; TOKW[(size_t)row * 2 + (lane & 1)] = dec_w[idx]; }
            __syncthreads();
            if (tid < 16) hist[tid] = 0;
            __syncthreads();
        }
    }
    xcd_barrier(bar);
    if (PROBE_HI == 7) t_pb = __builtin_amdgcn_s_memrealtime();

    if (PROBE_LO == 8) t_pa = __builtin_amdgcn_s_memrealtime();
    if (PH(8))
    for (int rep_ = 0; rep_ < REPS(8); ++rep_)
    {
        PHASE_PTRS
        pg8::Gemm g{DM, DM, DM};
        LAS int* tbl = (LAS int*)(lds + EXTRA_OFF + 8192); moe_table(tbl, ctl);
        SchedMoe S; S.A = (const char*)H2F8; S.W = (const char*)Wgu_t; S.list = LIST; S.tbl = tbl; S.G = G; S.c = bx; S.NPN = 2; S.w_exp = (size_t)512 * DM; S.w_tile = (size_t)256 * DM; S.a_tile = 0; S.ocol_w = 128;
        pg8::EpiSwiglu E{HID, R2S, LIST};
        pg8::gemm_phase<pg8::EpiSwiglu, SchedMoe, true, true, true>(lds + RING_OFF, g, S, E);
    }
    xcd_barrier(bar);
    if (PROBE_HI == 8) t_pb = __builtin_amdgcn_s_memrealtime();

    if (PROBE_LO == 9) t_pa = __builtin_amdgcn_s_memrealtime();
    if (PH(9))
    for (int rep_ = 0; rep_ < REPS(9); ++rep_)
    {
        PHASE_PTRS
        pg8::Gemm g{DFF, DFF, DFF};
        LAS int* tbl = (LAS int*)(lds + EXTRA_OFF + 8192);
        SchedMoe S; S.A = (const char*)HID; S.W = (const char*)Wd_t; S.list = LIST; S.tbl = tbl; S.G = G; S.c = bx; S.NPN = 4; S.w_exp = (size_t)DM * DFF; S.w_tile = (size_t)256 * DFF; S.a_tile = (size_t)256 * DFF; S.ocol_w = 256;
        pg8::EpiBf16 E{YB, DM, nullptr, 0, 1.f, 1.f, nullptr, nullptr, 1.0f / WD_SCALE, true};
        pg8::gemm_phase<pg8::EpiBf16, SchedMoe, true, false, true>(lds + RING_OFF, g, S, E);
    }
    xcd_barrier(bar);
    if (PROBE_HI == 9) t_pb = __builtin_amdgcn_s_memrealtime();

    if (PROBE_LO == 10) t_pa = __builtin_amdgcn_s_memrealtime();
    if (PH(10))
    {
        PHASE_PTRS
        const LAS int* tb = (const LAS int*)(lds + EXTRA_OFF + 8192);
        const f32x4* gp = (const f32x4*)ARGP(norm_final) + lane;
        int sl0 = 0, sl1 = 0; float sw0 = 0.f, sw1 = 0.f;
        unsigned ya_n[4], yb_n[4]; u32x2 hh_n[4]; float w0_n = 0.f, w1_n = 0.f;
#define P10_SLOTS(rw) do { sl0 = TOKSLOT[(size_t)(rw) * 2]; sl1 = TOKSLOT[(size_t)(rw) * 2 + 1]; sw0 = TOKW[(size_t)(rw) * 2]; sw1 = TOKW[(size_t)(rw) * 2 + 1]; } while (0)
#define P10_DATA(rw) do { const int r0_ = tb[sl0 >> 20] * 256 + (sl0 & 0xfffff), r1_ = tb[sl1 >> 20] * 256 + (sl1 & 0xfffff); w0_n = sw0; w1_n = sw1; \
        const unsigned* y0_ = (const unsigned*)((const unsigned char*)YB + (size_t)r0_ * DM) + lane; const unsigned* y1_ = (const unsigned*)((const unsigned char*)YB + (size_t)r1_ * DM) + lane; const u32x2* h_ = (const u32x2*)(H1B + (size_t)(rw) * DM) + lane; \
        _Pragma("unroll") for (int j = 0; j < 4; ++j) { ya_n[j] = y0_[64 * j]; yb_n[j] = y1_[64 * j]; hh_n[j] = h_[64 * j]; } } while (0)
        if (gw < M) { P10_SLOTS(gw); P10_DATA(gw); if (gw + NGW < M) P10_SLOTS(gw + NGW); }
        for (int row = gw; row < M; row += NGW) {
            unsigned ya[4], yb[4]; u32x2 hh[4]; const float w0 = w0_n, w1 = w1_n;
#pragma unroll
            for (int j = 0; j < 4; ++j) { ya[j] = ya_n[j]; yb[j] = yb_n[j]; hh[j] = hh_n[j]; }
            if (row + NGW < M) { P10_DATA(row + NGW); if (row + 2 * NGW < M) P10_SLOTS(row + 2 * NGW); }
            f32x4* hr = (f32x4*)(out + (size_t)row * DM) + lane;
            f32x4 v[4]; float s = 0.f;
#pragma unroll
            for (int j = 0; j < 4; ++j) { const u32x2 hx = hh[j]; f32x4 h = {bf16lo(hx.x), bf16hi(hx.x), bf16lo(hx.y), bf16hi(hx.y)};
                const f32x2 a01 = __builtin_amdgcn_cvt_pk_f32_fp8((int)ya[j], false), a23 = __builtin_amdgcn_cvt_pk_f32_fp8((int)ya[j], true), b01 = __builtin_amdgcn_cvt_pk_f32_fp8((int)yb[j], false), b23 = __builtin_amdgcn_cvt_pk_f32_fp8((int)yb[j], true);
                h[0] += w0 * a01[0] + w1 * b01[0]; h[1] += w0 * a01[1] + w1 * b01[1]; h[2] += w0 * a23[0] + w1 * b23[0]; h[3] += w0 * a23[1] + w1 * b23[1];
                v[j] = h; s += (h[0] * h[0] + h[1] * h[1]) + (h[2] * h[2] + h[3] * h[3]); }
            const float rinv = rsqrtf(wave_sum(s) * (1.0f / DM) + EPS);
#pragma unroll
            for (int j = 0; j < 4; ++j) __builtin_nontemporal_store(v[j] * rinv * gp[64 * j], hr + 64 * j);
        }
#undef P10_SLOTS
#undef P10_DATA
    }
    if (PROBE_LO >= 0) {
        if (PROBE_HI == 10) t_pb = __builtin_amdgcn_s_memrealtime();
        if (blockIdx.x == 0 && threadIdx.x == 0) { const unsigned long long t0 = __builtin_amdgcn_s_memrealtime(), span = 2 * (t_pb - t_pa);
            while (__builtin_amdgcn_s_memrealtime() - t0 < span) __builtin_amdgcn_s_sleep(8); }
    }
}

extern "C" void kernel_launch(void* const* d_in, const int* in_sizes, int n_in, void* d_out, int out_size, void* d_ws, size_t ws_size, hipStream_t stream) {
    static int grid = 0;
    if (grid == 0) {
        if (n_in != 22 || in_sizes[0] != M * DM || out_size != M * DM || ws_size < WS_END) { fprintf(stderr, "kernel_launch: unexpected shapes (n_in %d, in0 %d, out %d, ws %zu)\n", n_in, n_in > 0 ? in_sizes[0] : -1, out_size, ws_size); grid = -1; return; }
        int dev = 0, cus = 0, per_cu = 0;
        if (hipGetDevice(&dev) != hipSuccess || hipDeviceGetAttribute(&cus, hipDeviceAttributeMultiprocessorCount, dev) != hipSuccess) { grid = -1; return; }
        if (hipFuncSetAttribute((const void*)hymba_fwd, hipFuncAttributeMaxDynamicSharedMemorySize, LDS_BYTES) != hipSuccess) { fprintf(stderr, "kernel_launch: hipFuncSetAttribute failed\n"); grid = -1; return; }
        if (hipOccupancyMaxActiveBlocksPerMultiprocessor(&per_cu, (const void*)hymba_fwd, NWAVES * 64, LDS_BYTES) != hipSuccess || per_cu < 1) { fprintf(stderr, "kernel_launch: occupancy query reports %d\n", per_cu); }
        (void)hipGetLastError();
        grid = cus;
    }
    if (grid < 0) return;
    (void)hipMemsetAsync((char*)d_ws + WS_CTL, 0, CTL_ZERO_BYTES, stream);
    Args a{};
    const float** p = (const float**)&a;
    for (int i = 0; i < 22; ++i) p[i] = (const float*)d_in[i];
    a.out = (float*)d_out; a.ws = (unsigned char*)d_ws;
    hipLaunchKernelGGL(hymba_fwd, dim3(grid), dim3(NWAVES * 64), LDS_BYTES, stream, a);
}
```

```cpp
#include <hip/hip_runtime.h>
#include <hip/hip_bf16.h>
#include <cstdio>
#include <cstdint>

#define LAS __attribute__((address_space(3)))
#define GAS __attribute__((address_space(1)))
typedef unsigned short bf16_t;
typedef short bf16x8 __attribute__((ext_vector_type(8)));
typedef short s16x4 __attribute__((ext_vector_type(4)));
typedef float f32x4 __attribute__((ext_vector_type(4)));
typedef float f32x2 __attribute__((ext_vector_type(2)));
typedef float f32x16 __attribute__((ext_vector_type(16)));
typedef unsigned u32x4 __attribute__((ext_vector_type(4)));
typedef unsigned u32x2 __attribute__((ext_vector_type(2)));
typedef __bf16 bf16x2_t __attribute__((ext_vector_type(2)));

constexpr int BATCH = 8, SEQ = 8192, DM = 1024, M = BATCH * SEQ;
constexpr int NH = 8, HD = 64, HW = NH * HD;
constexpr int NPROJ = 3 * HW * 2;
constexpr int WIN_LD = NPROJ + NH;
constexpr int NMEM = 256, XH = 4, XD = 256, MEMROWS = BATCH * NMEM;
constexpr int NEXP = 16, DFF = 256;
constexpr float EPS = 1e-6f;
constexpr float LOG2E = 1.4426950408889634f;
constexpr float C2 = 0.125f * LOG2E;
constexpr float XSC = 0.0625f * LOG2E;
constexpr float P_SCALE = 128.0f;
constexpr float WGU_SCALE = 32.0f;
constexpr float WD_SCALE = 16.0f;
constexpr float SB_EXIT = -48.0f;

constexpr size_t MiB = 1u << 20;
constexpr size_t WS_CTL = 0, CTL_ZERO_BYTES = 128 * 1024;
constexpr size_t WS_WIN = 1 * MiB;
constexpr size_t WS_WOUT = 7 * MiB;
constexpr size_t WS_WXQ = 9 * MiB;
constexpr size_t WS_WXKV = 11 * MiB;
constexpr size_t WS_WXO = 15 * MiB;
constexpr size_t WS_WGU = 17 * MiB;
constexpr size_t WS_WD = 33 * MiB;
constexpr size_t WS_RX = 41 * MiB;
constexpr size_t WS_RMEM = WS_RX + 256 * 1024;
constexpr size_t WS_R2 = WS_RX + 512 * 1024;
constexpr size_t WS_LF = 42 * MiB;
constexpr size_t WS_C2 = 44 * MiB;
constexpr size_t WS_SSQ = 46 * MiB;
constexpr size_t WS_TOKSLOT = 50 * MiB;
constexpr size_t WS_TOKW = 51 * MiB;
constexpr size_t WS_LIST = 52 * MiB;
constexpr size_t WS_MEMB = 56 * MiB;
constexpr size_t WS_KVM = 60 * MiB;
constexpr size_t WS_GT = 68 * MiB;
constexpr size_t WS_HT = 84 * MiB;
constexpr size_t WS_KX = 100 * MiB;
constexpr size_t WS_HS = 108 * MiB;
constexpr size_t WS_XB = 128 * MiB;
constexpr size_t WS_QKV = 256 * MiB;
constexpr size_t WS_H1B = 256 * MiB, WS_U2B = 384 * MiB, WS_HID = 512 * MiB;
constexpr size_t WS_H1F8 = 384 * MiB, WS_H2F8 = 448 * MiB;
constexpr size_t WS_O = 640 * MiB;
constexpr size_t WS_Y = 704 * MiB;
constexpr size_t WS_END = 1024 * MiB;
constexpr size_t QKV_STRIDE = (size_t)M * HW;
constexpr int MAXTILES = M * 2 / 256 + NEXP;
static_assert(WS_Y + (size_t)MAXTILES * 256 * 1024 * 2 <= WS_END, "ws map");
static_assert(WS_HID + (size_t)MAXTILES * 256 * 256 * 2 <= WS_O, "ws map");
constexpr int CW_BAR = 4096;
constexpr int CW_SBQ = 20736;
constexpr int CW_KN = 20480;
constexpr int CW_CNT = 16384;

constexpr int RING_OFF = 0, RING_BYTES = 131072;
constexpr int EXTRA_OFF = 131072, EXTRA_BYTES = 16384;
constexpr int MISC_OFF = EXTRA_OFF + EXTRA_BYTES;
constexpr int LDS_BYTES = MISC_OFF + 1024;
constexpr int NWAVES = 8;
#ifndef PHASE_MASK
#define PHASE_MASK 0x7ff
#endif
#define PH(n) ((PHASE_MASK >> (n)) & 1)
#ifndef PROBE_LO
#define PROBE_LO -1
#endif
#ifndef PROBE_HI
#define PROBE_HI -1
#endif
#ifndef FOX_V2
#define FOX_V2 1
#endif
#ifndef REP_MASK
#define REP_MASK 0
#endif
#define REPS(n) (1 + ((REP_MASK >> (n)) & 1))
#ifndef REP_FOX
#define REP_FOX 1
#endif
#ifndef REP_SB
#define REP_SB 1
#endif

__device__ __forceinline__ unsigned cvt_pk_bf16(float lo, float hi) { f32x2 v = {lo, hi}; bf16x2_t b = __builtin_convertvector(v, bf16x2_t); return __builtin_bit_cast(unsigned, b); }
__device__ __forceinline__ unsigned cvt4_fp8(float a, float b, float c, float d) { int w = 0; w = __builtin_amdgcn_cvt_pk_fp8_f32(a, b, w, false); w = __builtin_amdgcn_cvt_pk_fp8_f32(c, d, w, true); return (unsigned)w; }
__device__ __forceinline__ float bf16lo(unsigned u) { return __uint_as_float(u << 16); }
__device__ __forceinline__ float bf16hi(unsigned u) { return __uint_as_float(u & 0xffff0000u); }
#define DPP_ADD(v, CTRL) v += __builtin_bit_cast(float, __builtin_amdgcn_update_dpp(0, __builtin_bit_cast(int, v), CTRL, 0xf, 0xf, true))
__device__ __forceinline__ float wave_sum(float v) {
    DPP_ADD(v, 0xB1); DPP_ADD(v, 0x4E); DPP_ADD(v, 0x141); DPP_ADD(v, 0x140);
    const int iv = __builtin_bit_cast(int, v);
    return (__builtin_bit_cast(float, __builtin_amdgcn_readlane(iv, 0)) + __builtin_bit_cast(float, __builtin_amdgcn_readlane(iv, 16))) +
           (__builtin_bit_cast(float, __builtin_amdgcn_readlane(iv, 32)) + __builtin_bit_cast(float, __builtin_amdgcn_readlane(iv, 48)));
}
#define LDS_WAIT() asm volatile("s_waitcnt lgkmcnt(0)" ::: "memory")
#define VM_WAIT() asm volatile("s_waitcnt vmcnt(0)" ::: "memory")

namespace pg8 {
constexpr int BM = 256, BK = 64, HALF = 128, HTB = HALF * BK * 2, STAGE_BYTES = 8 * HTB, NXCD = 8, WGM = 8;
__host__ __device__ __forceinline__ int lds_byte(int r, int c) { const int st = (r >> 4) * 2 + (c >> 5), rr = r & 15, cc = c & 31, ob = rr * 64 + cc * 2; return st * 1024 + (ob ^ (((ob >> 9) & 1) << 5)); }
__host__ __device__ __forceinline__ void stage_rc(int b, int& R, int& C) { const int st = b / 1024, sb = b % 1024, swz = sb ^ (((sb >> 9) & 1) << 5); R = (st >> 1) * 16 + swz / 64; C = (st & 1) * 32 + (swz % 64) / 2; }
__host__ __device__ __forceinline__ int perm32(int rho) { const int n = rho >> 4, i = rho & 15; return 8 * (i >> 2) + 4 * n + (i & 3); }

struct Unit { const char* a; const char* b; int orow, ocol, aux; const int* rows; int nvalid; int seq; };
struct Gemm { int lda, ldb, K; };

__device__ __forceinline__ bool tile_order(int i, int G, int c, int nM, int nN, int& pm, int& pn) {
    const int nwg = nM * nN; const long L = (long)i * G + c; if (L >= nwg) return false;
    int wgid = (int)L; { const int q = nwg / NXCD, r = nwg % NXCD, xcd = wgid % NXCD, off = wgid / NXCD; wgid = (xcd < r ? xcd * (q + 1) : r * (q + 1) + (xcd - r) * q) + off; }
    const int nig = WGM * nN, gid = wgid / nig, fm = gid * WGM, gsz = (nM - fm) < WGM ? (nM - fm) : WGM;
    pm = fm + ((wgid % nig) % gsz); pn = (wgid % nig) / gsz; return true;
}

typedef int v8i32 __attribute__((ext_vector_type(8)));
template <class Epi, class Sched, bool ALIGN_EPI, bool GATHER, bool FP8 = false>
__device__ __forceinline__ void gemm_phase(LAS unsigned char* lds, const Gemm g, const Sched& S, const Epi& E) {
    int tid = threadIdx.x; asm volatile("" : "+v"(tid));
    const int wid = __builtin_amdgcn_readfirstlane(tid >> 6), lane = tid & 63, wr = wid >> 2, wc = wid & 3, fr = lane & 15, fq = lane >> 4;
    constexpr int ESZ = FP8 ? 1 : 2;
    const int K = g.K, nt = K / (FP8 ? 2 * BK : BK);
    unsigned voffA[2], voffB[2]; int RA[2], CA[2];
#pragma unroll
    for (int i = 0; i < 2; ++i) { int R, C; stage_rc(tid * 16 + i * 8192, R, C); const int Rb = (R & ~31) + perm32(R & 31);
        RA[i] = R; CA[i] = C; voffA[i] = (unsigned)(R * g.lda * ESZ + C * 2); voffB[i] = (unsigned)(Rb * g.ldb * ESZ + C * 2); }
    const size_t kstep = (size_t)(BK * 2);
    const size_t hstepA = (size_t)HALF * g.lda * ESZ, hstepB = (size_t)HALF * g.ldb * ESZ;
    const unsigned ldsw = (unsigned)wid * 1024u;
    const int aoff = lds_byte(wr * 64 + fr, FP8 ? fq * 16 : fq * 8), boff = lds_byte(wc * 32 + fr, FP8 ? fq * 16 : fq * 8);
    constexpr int KOFF = FP8 ? 16 : 1024;
#define PG8_SA(b, h) (((b) * 2 + (h)) * HTB)
#define PG8_SB(b, h) ((4 + (b) * 2 + (h)) * HTB)
#define PG8_STAGE2(bufoff, gbase, v0, v1) do { \
        __builtin_amdgcn_global_load_lds((const unsigned*)((const char*)(gbase) + (v0)), (LAS unsigned*)(lds + (bufoff) + ldsw), 16, 0, 0); \
        __builtin_amdgcn_global_load_lds((const unsigned*)((const char*)(gbase) + (v1)), (LAS unsigned*)(lds + (bufoff) + ldsw + 8192), 16, 0, 0); } while (0)
#define PG8_STAGEB(bufoff, gbase) PG8_STAGE2(bufoff, gbase, voffB[0], voffB[1])
#define PG8_STAGEA(bufoff, kptr, h, NX) do { if constexpr (GATHER) { const unsigned v0_ = (NX) ? gvn[h][0] : gvc[h][0], v1_ = (NX) ? gvn[h][1] : gvc[h][1]; PG8_STAGE2(bufoff, kptr, v0_, v1_); } \
        else { PG8_STAGE2(bufoff, (kptr) + (h) * hstepA, voffA[0], voffA[1]); } } while (0)
#define PG8_LDA(dst, b, h) do { _Pragma("unroll") for (int m = 0; m < 4; ++m) _Pragma("unroll") for (int k = 0; k < 2; ++k) dst[m][k] = *(const LAS bf16x8*)(lds + PG8_SA(b, h) + aoff + m * 2048 + k * KOFF); } while (0)
#define PG8_LDB(dst, b, h) do { _Pragma("unroll") for (int n = 0; n < 2; ++n) _Pragma("unroll") for (int k = 0; k < 2; ++k) dst[n][k] = *(const LAS bf16x8*)(lds + PG8_SB(b, h) + boff + n * 2048 + k * KOFF); } while (0)
#define PG8_CAT(x) __builtin_shufflevector(__builtin_bit_cast(f32x4, (x)[0]), __builtin_bit_cast(f32x4, (x)[1]), 0, 1, 2, 3, 4, 5, 6, 7)
#define PG8_MMA(ai, bj, At, Bt) do { __builtin_amdgcn_s_setprio(1); _Pragma("unroll") for (int m = 0; m < 4; ++m) _Pragma("unroll") for (int n = 0; n < 2; ++n) { \
        if constexpr (FP8) { acc[ai][bj][m][n] = __builtin_amdgcn_mfma_scale_f32_16x16x128_f8f6f4(__builtin_bit_cast(v8i32, PG8_CAT(Bt[n])), __builtin_bit_cast(v8i32, PG8_CAT(At[m])), acc[ai][bj][m][n], 0, 0, 0, 0x7F7F7F7F, 0, 0x7F7F7F7F); } \
        else { _Pragma("unroll") for (int k = 0; k < 2; ++k) acc[ai][bj][m][n] = __builtin_amdgcn_mfma_f32_16x16x32_bf16(Bt[n][k], At[m][k], acc[ai][bj][m][n], 0, 0, 0); } } \
        _Pragma("unroll") for (int m = 0; m < 4; ++m) _Pragma("unroll") for (int n = 0; n < 2; ++n) asm volatile("" : "+v"(acc[ai][bj][m][n]));     \
        __builtin_amdgcn_s_setprio(0); } while (0)
#define PG8_WAIT_V(n) asm volatile("s_waitcnt vmcnt(" #n ")" ::: "memory")
#define PG8_WAIT_L(n) asm volatile("s_waitcnt lgkmcnt(" #n ")" ::: "memory")
#define PG8_BAR __builtin_amdgcn_s_barrier()
#define PG8_SCHED __builtin_amdgcn_sched_barrier(0)
#define PG8_GATHER_OFFS(dst, u) do { _Pragma("unroll") for (int h_ = 0; h_ < 2; ++h_) _Pragma("unroll") for (int i_ = 0; i_ < 2; ++i_) { const int r_ = h_ * HALF + RA[i_]; \
        const int idx_ = (u).rows[r_ < (u).nvalid ? r_ : 0]; dst[h_][i_] = (unsigned)(idx_ * g.lda * ESZ + CA[i_] * 2); } } while (0)
    Unit cur, nxt; int ui = 0;
    if (!S.next(0, cur)) return;
    cur.seq = 0;
    unsigned gvc[2][2] = {{0u, 0u}, {0u, 0u}}, gvn[2][2] = {{0u, 0u}, {0u, 0u}};
    if constexpr (GATHER) { PG8_GATHER_OFFS(gvc, cur); }
    f32x4 acc[2][2][4][2];
#pragma unroll
    for (int a = 0; a < 2; ++a)
#pragma unroll
        for (int b = 0; b < 2; ++b)
#pragma unroll
            for (int m = 0; m < 4; ++m)
#pragma unroll
                for (int n = 0; n < 2; ++n) acc[a][b][m][n] = (f32x4){0.f, 0.f, 0.f, 0.f};
    bf16x8 At[4][2], B0[2][2], B1[2][2];
    const char* cA = cur.a; const char* cB = cur.b;
    PG8_STAGEB(PG8_SB(0, 0), cB); PG8_STAGEB(PG8_SB(0, 1), cB + hstepB); PG8_STAGEA(PG8_SA(0, 0), cA, 0, false); PG8_STAGEA(PG8_SA(0, 1), cA, 1, false);
    if (wr == 1) PG8_BAR;
    PG8_WAIT_V(2); PG8_BAR;
    PG8_STAGEB(PG8_SB(1, 0), cB + kstep); PG8_STAGEA(PG8_SA(1, 0), cA + kstep, 0, false); PG8_STAGEB(PG8_SB(1, 1), cB + hstepB + kstep);
    PG8_WAIT_V(6); PG8_BAR;
    for (;;) {
        const bool has_next = S.next(ui + 1, nxt); nxt.seq = ui + 1;
        const char* nA = has_next ? nxt.a : cA; const char* nB = has_next ? nxt.b : cB;
        if constexpr (GATHER) { if (has_next) { PG8_GATHER_OFFS(gvn, nxt); } else { gvn[0][0] = gvc[0][0]; gvn[0][1] = gvc[0][1]; gvn[1][0] = gvc[1][0]; gvn[1][1] = gvc[1][1]; } }
#pragma unroll 1
        for (int t = 0; t < nt; t += 2) {
            const bool last = (t == nt - 2);
            const char* a1 = cA + (size_t)(t + 1) * kstep;
            const char* a2 = last ? nA : cA + (size_t)(t + 2) * kstep; const char* b2 = last ? nB : cB + (size_t)(t + 2) * kstep;
            const char* a3 = a2 + kstep; const char* b3 = b2 + kstep;
            PG8_LDB(B0, 0, 0); PG8_LDB(B1, 0, 1); PG8_SCHED; PG8_LDA(At, 0, 0); PG8_STAGEA(PG8_SA(1, 1), a1, 1, false);
            PG8_WAIT_V(8); PG8_WAIT_L(0); PG8_BAR; PG8_MMA(0, 0, At, B0); PG8_MMA(0, 1, At, B1); PG8_BAR; PG8_SCHED;
            PG8_LDA(At, 0, 1); PG8_STAGEB(PG8_SB(0, 0), b2); PG8_STAGEB(PG8_SB(0, 1), b2 + hstepB); PG8_STAGEA(PG8_SA(0, 0), a2, 0, last);
            PG8_WAIT_V(8); PG8_WAIT_L(0); PG8_BAR; PG8_MMA(1, 0, At, B0); PG8_MMA(1, 1, At, B1); PG8_BAR; PG8_SCHED;
            PG8_LDB(B0, 1, 0); PG8_LDB(B1, 1, 1); PG8_SCHED; PG8_LDA(At, 1, 0); PG8_STAGEA(PG8_SA(0, 1), a2, 1, last);
            PG8_WAIT_V(8); PG8_WAIT_L(0); PG8_BAR; PG8_MMA(0, 0, At, B0); PG8_MMA(0, 1, At, B1); PG8_BAR; PG8_SCHED;
            PG8_LDA(At, 1, 1); PG8_STAGEB(PG8_SB(1, 0), b3); PG8_STAGEB(PG8_SB(1, 1), b3 + hstepB); PG8_STAGEA(PG8_SA(1, 0), a3, 0, last);
            PG8_WAIT_V(8); PG8_WAIT_L(0); PG8_BAR; PG8_MMA(1, 0, At, B0); PG8_MMA(1, 1, At, B1); PG8_BAR; PG8_SCHED;
            if constexpr (Epi::HAS_MID) { if (t == (nt >> 1) - 2) { int fr3 = fr, fq3 = fq; asm volatile("" : "+v"(fr3), "+v"(fq3)); E.mid(acc, cur, wr, wc, fr3, fq3); } }
        }
        if constexpr (ALIGN_EPI) { if (wr == 0) PG8_BAR; }
        { int fr2 = fr, fq2 = fq; asm volatile("" : "+v"(fr2), "+v"(fq2));
          E(acc, cur, wr, wc, fr2, fq2); }
        if (!has_next) break;
#pragma unroll
        for (int a = 0; a < 2; ++a)
#pragma unroll
            for (int b = 0; b < 2; ++b)
#pragma unroll
                for (int m = 0; m < 4; ++m)
#pragma unroll
                    for (int n = 0; n < 2; ++n) acc[a][b][m][n] = (f32x4){0.f, 0.f, 0.f, 0.f};
        cur = nxt; cA = nA; cB = nB; ++ui;
        if constexpr (GATHER) { gvc[0][0] = gvn[0][0]; gvc[0][1] = gvn[0][1]; gvc[1][0] = gvn[1][0]; gvc[1][1] = gvn[1][1]; }
        if constexpr (ALIGN_EPI) { if (wr == 1) PG8_BAR; }
    }
    PG8_WAIT_V(0);
    if constexpr (!ALIGN_EPI) { if (wr == 0) PG8_BAR; }
    PG8_BAR;
#undef PG8_SA
#undef PG8_SB
#undef PG8_STAGE2
#undef PG8_STAGEA
#undef PG8_STAGEB
#undef PG8_LDA
#undef PG8_LDB
#undef PG8_MMA
#undef PG8_CAT
#undef PG8_WAIT_V
#undef PG8_WAIT_L
#undef PG8_BAR
#undef PG8_SCHED
#undef PG8_GATHER_OFFS
}

#define EPI_ROW(u, ai, m) ((u).orow + (ai) * HALF + wr * 64 + (m) * 16 + fr)
#define EPI_COL(u, bj) ((u).ocol + (bj) * HALF + wc * 32 + 8 * fq)
struct EpiBf16 {
    static constexpr bool HAS_MID = false;
    bf16_t* O; int ldc; const float* rs; size_t stride; float sc0, sc3;
    unsigned* kn;
    const LAS float* rst;
    float mul;
    bool out8;
    __device__ __forceinline__ void operator()(const f32x4 (&acc)[2][2][4][2], const Unit& u, int wr, int wc, int fr, int fq) const {
        bf16_t* base = O + (size_t)u.aux * stride;
        const float sc = ((u.aux == 0) ? sc0 : ((u.aux == 3) ? sc3 : 1.f)) * mul;
        float nmax[2] = {0.f, 0.f}; const bool dokn = kn && u.aux == 1;
#pragma unroll
        for (int ai = 0; ai < 2; ++ai)
#pragma unroll
            for (int m = 0; m < 4; ++m) { const int row = EPI_ROW(u, ai, m); const float s = (rst ? rst[u.seq * 256 + ai * HALF + wr * 64 + m * 16 + fr] : (rs ? rs[row] : 1.f)) * sc;
#pragma unroll
                for (int bj = 0; bj < 2; ++bj) { const f32x4 v0 = acc[ai][bj][m][0] * s, v1 = acc[ai][bj][m][1] * s;
                    if (out8) { u32x2 w8; w8.x = cvt4_fp8(v0[0], v0[1], v0[2], v0[3]); w8.y = cvt4_fp8(v1[0], v1[1], v1[2], v1[3]); *(u32x2*)((unsigned char*)base + (size_t)row * ldc + EPI_COL(u, bj)) = w8; }
                    else { u32x4 w; w.x = cvt_pk_bf16(v0[0], v0[1]); w.y = cvt_pk_bf16(v0[2], v0[3]); w.z = cvt_pk_bf16(v1[0], v1[1]); w.w = cvt_pk_bf16(v1[2], v1[3]);
                    __builtin_nontemporal_store(w, (u32x4*)(base + (size_t)row * ldc + EPI_COL(u, bj))); }
                    if (dokn) { float q = (v0[0] * v0[0] + v0[1] * v0[1]) + (v0[2] * v0[2] + v0[3] * v0[3]) + (v1[0] * v1[0] + v1[1] * v1[1]) + (v1[2] * v1[2] + v1[3] * v1[3]);
                        q += __shfl_xor(q, 16); q += __shfl_xor(q, 32); nmax[bj] = fmaxf(nmax[bj], q); } } }
        if (dokn) {
#pragma unroll
            for (int bj = 0; bj < 2; ++bj) { float q = nmax[bj]; q = fmaxf(q, __shfl_xor(q, 1)); q = fmaxf(q, __shfl_xor(q, 2)); q = fmaxf(q, __shfl_xor(q, 4)); q = fmaxf(q, __shfl_xor(q, 8));
                const int head = ((u.ocol + bj * HALF) >> 6) + (wc >> 1), bt = u.orow / SEQ;
                if ((fr | fq) == 0) atomicMax(kn + ((bt * NH + head) * 2 + (wc & 1)), __float_as_uint(q)); }
        }
    }
};
struct EpiResid {
    static constexpr bool HAS_MID = false;
    const float* res; float* out; bf16_t* hb; float* ssq;
    __device__ __forceinline__ void operator()(const f32x4 (&acc)[2][2][4][2], const Unit& u, int wr, int wc, int fr, int fq) const {
#pragma unroll
        for (int ai = 0; ai < 2; ++ai)
#pragma unroll
            for (int m = 0; m < 4; ++m) { const int row = EPI_ROW(u, ai, m); float q = 0.f;
#pragma unroll
                for (int bj = 0; bj < 2; ++bj) { const size_t off = (size_t)row * DM + EPI_COL(u, bj);
                    const f32x4 r0 = *(const f32x4*)(res + off), r1 = *(const f32x4*)(res + off + 4);
                    const f32x4 v0 = acc[ai][bj][m][0] + r0, v1 = acc[ai][bj][m][1] + r1;
                    *(f32x4*)(out + off) = v0; *(f32x4*)(out + off + 4) = v1;
                    q += (v0[0] * v0[0] + v0[1] * v0[1]) + (v0[2] * v0[2] + v0[3] * v0[3]) + (v1[0] * v1[0] + v1[1] * v1[1]) + (v1[2] * v1[2] + v1[3] * v1[3]);
                    if (hb) { u32x4 w; w.x = cvt_pk_bf16(v0[0], v0[1]); w.y = cvt_pk_bf16(v0[2], v0[3]); w.z = cvt_pk_bf16(v1[0], v1[1]); w.w = cvt_pk_bf16(v1[2], v1[3]); *(u32x4*)(hb + off) = w; } }
                if (ssq) { q += __shfl_xor(q, 16); q += __shfl_xor(q, 32); if (fq == 0) ssq[(size_t)row * 16 + (u.ocol >> 8) * 4 + wc] = q; } }
    }
};
struct EpiOutProj {
    static constexpr bool HAS_MID = true;
    const bf16_t* xb; bf16_t* hb; unsigned char* h8; float* ssq; const LAS f32x2* rab;
    __device__ __forceinline__ void mid(f32x4 (&acc)[2][2][4][2], const Unit& u, int wr, int wc, int fr, int fq) const {
#pragma unroll
        for (int ai = 0; ai < 2; ++ai)
#pragma unroll
            for (int m = 0; m < 4; ++m) { const float f = rab[u.seq * 256 + ai * HALF + wr * 64 + m * 16 + fr].x;
#pragma unroll
                for (int bj = 0; bj < 2; ++bj) { acc[ai][bj][m][0] *= f; acc[ai][bj][m][1] *= f; } }
    }
    __device__ __forceinline__ void operator()(const f32x4 (&acc)[2][2][4][2], const Unit& u, int wr, int wc, int fr, int fq) const {
        u32x4 xres[2][4][2];
#pragma unroll
        for (int ai = 0; ai < 2; ++ai)
#pragma unroll
            for (int m = 0; m < 4; ++m)
#pragma unroll
                for (int bj = 0; bj < 2; ++bj) xres[ai][m][bj] = __builtin_nontemporal_load((const u32x4*)(xb + (size_t)EPI_ROW(u, ai, m) * DM + EPI_COL(u, bj)));
        asm volatile("" ::: "memory");
#pragma unroll
        for (int ai = 0; ai < 2; ++ai)
#pragma unroll
            for (int m = 0; m < 4; ++m) { const int row = EPI_ROW(u, ai, m); const float rb = rab[u.seq * 256 + ai * HALF + wr * 64 + m * 16 + fr].y; float q = 0.f;
#pragma unroll
                for (int bj = 0; bj < 2; ++bj) { const size_t off = (size_t)row * DM + EPI_COL(u, bj);
                    const u32x4 xr = xres[ai][m][bj];
                    f32x4 v0 = acc[ai][bj][m][0] * rb, v1 = acc[ai][bj][m][1] * rb;
                    v0[0] += bf16lo(xr.x); v0[1] += bf16hi(xr.x); v0[2] += bf16lo(xr.y); v0[3] += bf16hi(xr.y); v1[0] += bf16lo(xr.z); v1[1] += bf16hi(xr.z); v1[2] += bf16lo(xr.w); v1[3] += bf16hi(xr.w);
                    q += (v0[0] * v0[0] + v0[1] * v0[1]) + (v0[2] * v0[2] + v0[3] * v0[3]) + (v1[0] * v1[0] + v1[1] * v1[1]) + (v1[2] * v1[2] + v1[3] * v1[3]);
                    u32x4 w; w.x = cvt_pk_bf16(v0[0], v0[1]); w.y = cvt_pk_bf16(v0[2], v0[3]); w.z = cvt_pk_bf16(v1[0], v1[1]); w.w = cvt_pk_bf16(v1[2], v1[3]); *(u32x4*)(hb + off) = w;
                    { u32x2 w8; w8.x = cvt4_fp8(v0[0], v0[1], v0[2], v0[3]); w8.y = cvt4_fp8(v1[0], v1[1], v1[2], v1[3]); *(u32x2*)(h8 + off) = w8; } }
                q += __shfl_xor(q, 16); q += __shfl_xor(q, 32); if (fq == 0) ssq[(size_t)row * 16 + (u.ocol >> 8) * 4 + wc] = q; }
    }
};
struct EpiResidBf16 {
    static constexpr bool HAS_MID = false;
    bf16_t* hb; unsigned char* h8; float mul;
    __device__ __forceinline__ void operator()(const f32x4 (&acc)[2][2][4][2], const Unit& u, int wr, int wc, int fr, int fq) const {
#pragma unroll
        for (int ai = 0; ai < 2; ++ai) {
        u32x4 xres[4][2];
#pragma unroll
            for (int m = 0; m < 4; ++m)
#pragma unroll
                for (int bj = 0; bj < 2; ++bj) xres[m][bj] = *(const u32x4*)(hb + (size_t)EPI_ROW(u, ai, m) * DM + EPI_COL(u, bj));
        asm volatile("" ::: "memory");
#pragma unroll
            for (int m = 0; m < 4; ++m) { const int row = EPI_ROW(u, ai, m);
#pragma unroll
                for (int bj = 0; bj < 2; ++bj) { const size_t off = (size_t)row * DM + EPI_COL(u, bj);
                    const u32x4 xr = xres[m][bj];
                    f32x4 v0 = acc[ai][bj][m][0] * mul, v1 = acc[ai][bj][m][1] * mul;
                    v0[0] += bf16lo(xr.x); v0[1] += bf16hi(xr.x); v0[2] += bf16lo(xr.y); v0[3] += bf16hi(xr.y); v1[0] += bf16lo(xr.z); v1[1] += bf16hi(xr.z); v1[2] += bf16lo(xr.w); v1[3] += bf16hi(xr.w);
                    u32x4 w; w.x = cvt_pk_bf16(v0[0], v0[1]); w.y = cvt_pk_bf16(v0[2], v0[3]); w.z = cvt_pk_bf16(v1[0], v1[1]); w.w = cvt_pk_bf16(v1[2], v1[3]); *(u32x4*)(hb + off) = w;
                    if (h8) { u32x2 w8; w8.x = cvt4_fp8(v0[0], v0[1], v0[2], v0[3]); w8.y = cvt4_fp8(v1[0], v1[1], v1[2], v1[3]); *(u32x2*)(h8 + off) = w8; } } }
        asm volatile("" ::: "memory"); }
    }
};
struct EpiSoftmax {
    static constexpr bool HAS_MID = false;
    bf16_t* P; const LAS float* r1t; LAS float* red;
    __device__ __forceinline__ void operator()(f32x4 (&acc)[2][2][4][2], const Unit& u, int wr, int wc, int fr, int fq) const {
#pragma unroll
        for (int ai = 0; ai < 2; ++ai)
#pragma unroll
            for (int m = 0; m < 4; ++m) { const float r1 = r1t[u.seq * 256 + ai * HALF + wr * 64 + m * 16 + fr]; float a = -3.0e38f;
#pragma unroll
                for (int bj = 0; bj < 2; ++bj)
#pragma unroll
                    for (int n = 0; n < 2; ++n) { f32x4 v = acc[ai][bj][m][n] * r1; acc[ai][bj][m][n] = v; a = fmaxf(a, fmaxf(fmaxf(v[0], v[1]), fmaxf(v[2], v[3]))); }
                a = fmaxf(a, __shfl_xor(a, 16)); a = fmaxf(a, __shfl_xor(a, 32));
                if (fq == 0) red[(ai * HALF + wr * 64 + m * 16 + fr) * 4 + wc] = a; asm volatile("" ::: "memory"); }
        LDS_WAIT(); __builtin_amdgcn_s_barrier(); asm volatile("" ::: "memory");
#pragma unroll
        for (int ai = 0; ai < 2; ++ai)
#pragma unroll
            for (int m = 0; m < 4; ++m) { const int rl = ai * HALF + wr * 64 + m * 16 + fr; const f32x4 mm = *(const LAS f32x4*)(red + rl * 4);
                const float a = fmaxf(fmaxf(mm[0], mm[1]), fmaxf(mm[2], mm[3])); float s = 0.f;
#pragma unroll
                for (int bj = 0; bj < 2; ++bj)
#pragma unroll
                    for (int n = 0; n < 2; ++n) { f32x4 v = acc[ai][bj][m][n];
                        v[0] = __builtin_amdgcn_exp2f(v[0] - a); v[1] = __builtin_amdgcn_exp2f(v[1] - a); v[2] = __builtin_amdgcn_exp2f(v[2] - a); v[3] = __builtin_amdgcn_exp2f(v[3] - a);
                        acc[ai][bj][m][n] = v; s += (v[0] + v[1]) + (v[2] + v[3]); }
                s += __shfl_xor(s, 16); s += __shfl_xor(s, 32);
                if (fq == 0) red[1024 + rl * 4 + wc] = s; }
        LDS_WAIT(); __builtin_amdgcn_s_barrier(); asm volatile("" ::: "memory");
#pragma unroll
        for (int ai = 0; ai < 2; ++ai)
#pragma unroll
            for (int m = 0; m < 4; ++m) { const int rl = ai * HALF + wr * 64 + m * 16 + fr; const int row = u.orow + rl; const f32x4 ss = *(const LAS f32x4*)(red + 1024 + rl * 4);
                const float inv = P_SCALE / ((ss[0] + ss[1]) + (ss[2] + ss[3]));
#pragma unroll
                for (int bj = 0; bj < 2; ++bj) { const f32x4 v0 = acc[ai][bj][m][0] * inv, v1 = acc[ai][bj][m][1] * inv;
                    u32x2 w8; w8.x = cvt4_fp8(v0[0], v0[1], v0[2], v0[3]); w8.y = cvt4_fp8(v1[0], v1[1], v1[2], v1[3]);
                    *(u32x2*)((unsigned char*)P + (size_t)row * DM + EPI_COL(u, bj)) = w8; } }
    }
};
struct EpiSwiglu {
    static constexpr bool HAS_MID = false;
    bf16_t* Hd; const float* r2s; const int* listbase;
    __device__ __forceinline__ void operator()(const f32x4 (&acc)[2][2][4][2], const Unit& u, int wr, int wc, int fr, int fq) const {
#pragma unroll
        for (int ai = 0; ai < 2; ++ai)
#pragma unroll
            for (int m = 0; m < 4; ++m) { const int rl = ai * HALF + wr * 64 + m * 16 + fr, row = u.orow + rl; const float rs = r2s[(u.rows - listbase) + (rl < u.nvalid ? rl : 0)] * (1.0f / WGU_SCALE); float h[8];
#pragma unroll
                for (int n = 0; n < 2; ++n)
#pragma unroll
                    for (int e = 0; e < 4; ++e) { const float gt = acc[ai][0][m][n][e] * rs, up = acc[ai][1][m][n][e] * rs;
                        h[n * 4 + e] = gt * __builtin_amdgcn_rcpf(1.0f + __builtin_amdgcn_exp2f(-gt * LOG2E)) * up; }
                u32x2 w; w.x = cvt4_fp8(h[0], h[1], h[2], h[3]); w.y = cvt4_fp8(h[4], h[5], h[6], h[7]);
                *(u32x2*)((unsigned char*)Hd + (size_t)row * DFF + u.ocol + wc * 32 + 8 * fq) = w; }
    }
};
}

namespace att {
constexpr int QB = 256, KVBLK = 64, PITCH = HW, OPITCH = DM;
constexpr int SLOTB = 8192, LDS_K = 0, LDS_V = 2 * SLOTB, LDS_WS = 4 * SLOTB, LDS_OST = LDS_WS + NWAVES * 256, LDS_FLAG = LDS_OST + NWAVES * 4096, LDS_END = LDS_FLAG + 64;
static_assert(LDS_END <= RING_BYTES, "attention LDS");
__device__ __forceinline__ int crow(int r, int hi) { return (r & 3) + 8 * (r >> 2) + 4 * hi; }
__device__ __forceinline__ void glds16(const void* gsrc, unsigned lds_dst) { unsigned keep;
    asm volatile("s_mov_b32 %0, m0\n\ts_mov_b32 m0, %2\n\ts_nop 0\n\tglobal_load_lds_dwordx4 %1, off\n\ts_mov_b32 m0, %0" : "=&s"(keep) : "v"(gsrc), "s"(lds_dst) : "memory"); }
__device__ __forceinline__ void glds16s(const void* sbase, unsigned voff, unsigned lds_dst) { unsigned keep;
    asm volatile("s_mov_b32 %0, m0\n\ts_mov_b32 m0, %3\n\ts_nop 0\n\tglobal_load_lds_dwordx4 %1, %2\n\ts_mov_b32 m0, %0" : "=&s"(keep) : "v"(voff), "s"(sbase), "s"(lds_dst) : "memory"); }
#define ATT_WAIT_BAR0() asm volatile("s_waitcnt vmcnt(0) lgkmcnt(0)\n\ts_barrier" ::: "memory")
#define MFMA32(a, b, c) __builtin_amdgcn_mfma_f32_32x32x16_bf16(a, b, c, 0, 0, 0)
__device__ __forceinline__ void store_row_ssq(u32x4 v, float* dst, int ch) {
    float q = (bf16lo(v.x) * bf16lo(v.x) + bf16hi(v.x) * bf16hi(v.x)) + (bf16lo(v.y) * bf16lo(v.y) + bf16hi(v.y) * bf16hi(v.y)) + (bf16lo(v.z) * bf16lo(v.z) + bf16hi(v.z) * bf16hi(v.z)) + (bf16lo(v.w) * bf16lo(v.w) + bf16hi(v.w) * bf16hi(v.w));
    q += __shfl_xor(q, 1); q += __shfl_xor(q, 2); q += __shfl_xor(q, 4);
    if (ch == 0) *dst = q;
}
__device__ __forceinline__ void qkt(f32x16& p0, f32x16& p1, const LAS char* Kslot, const bf16x8* qr, const f32x16& cin, int r32, int hi) {
    const LAS char* kb = Kslot + hi * 1024 + r32 * 16;
#pragma unroll
    for (int d0 = 0; d0 < 4; ++d0) {
        const bf16x8 b0 = *(const LAS bf16x8*)(kb + d0 * 2048);
        const bf16x8 b1 = *(const LAS bf16x8*)(kb + d0 * 2048 + 512);
        if (d0 == 0) { p0 = MFMA32(b0, qr[0], cin); p1 = MFMA32(b1, qr[0], cin); }
        else { p0 = MFMA32(b0, qr[d0], p0); p1 = MFMA32(b1, qr[d0], p1); } }
}
__device__ __forceinline__ void pv(f32x16* o, int vb, bf16x8 pa0, bf16x8 pa1, bf16x8 pa2, bf16x8 pa3) {
#pragma unroll
    for (int d0 = 0; d0 < 2; ++d0) { s16x4 lo[4], hi[4];
#pragma unroll
        for (int ks = 0; ks < 4; ++ks) {
            asm volatile("ds_read_b64_tr_b16 %0,%1 offset:%c2" : "=&v"(lo[ks]) : "v"(vb), "i"(d0 * 4096 + ks * 1024) : "memory");
            asm volatile("ds_read_b64_tr_b16 %0,%1 offset:%c2" : "=&v"(hi[ks]) : "v"(vb), "i"(d0 * 4096 + ks * 1024 + 512) : "memory"); }
        asm volatile("s_waitcnt lgkmcnt(0)" ::: "memory"); __builtin_amdgcn_sched_barrier(0);
#define PK(k) (bf16x8){lo[k][0], lo[k][1], lo[k][2], lo[k][3], hi[k][0], hi[k][1], hi[k][2], hi[k][3]}
        o[d0] = MFMA32(pa0, PK(0), o[d0]); o[d0] = MFMA32(pa1, PK(1), o[d0]); o[d0] = MFMA32(pa2, PK(2), o[d0]); o[d0] = MFMA32(pa3, PK(3), o[d0]);
#undef PK
    }
}
__device__ __forceinline__ float swap_lo(float x) { auto rr = __builtin_amdgcn_permlane32_swap(__float_as_uint(x), __float_as_uint(x), false, false); return __uint_as_float(rr[0]); }
__device__ __forceinline__ float swap_hi(float x) { auto rr = __builtin_amdgcn_permlane32_swap(__float_as_uint(x), __float_as_uint(x), false, false); return __uint_as_float(rr[1]); }

template <int MODE> __device__ __forceinline__ void attn_unit(int b, int h, int qb, const bf16_t* Q, const bf16_t* K, const bf16_t* V, bf16_t* O, float* hs, const float* cb, LAS char* shm) {
    int tid = threadIdx.x; asm volatile("" : "+v"(tid)); const int lane = tid & 63, r32 = lane & 31, hi = lane >> 5; const int wid = __builtin_amdgcn_readfirstlane(tid >> 6);
    const long rowbase = (long)b * SEQ; const int q0 = qb * QB;
    const bf16_t* Qw = Q + (rowbase + q0 + wid * 32) * PITCH + h * HD;
    const bf16_t* Kh = K + rowbase * PITCH + h * HD; const bf16_t* Vh = V + rowbase * PITCH + h * HD;
    const unsigned lds0 = (unsigned)(uintptr_t)shm;
    LAS float* wsf = (LAS float*)(shm + LDS_WS) + wid * 64;
    LAS unsigned* flags = (LAS unsigned*)(shm + LDS_FLAG);
    const bf16_t* ksrc = Kh + (long)lane * PITCH + wid * 8;
    const bf16_t* vsrc = Vh + (long)(16 * (wid & 3) + (lane >> 2)) * PITCH + (wid >> 2) * 32 + (lane & 3) * 8;
    const unsigned kdst = lds0 + LDS_K + wid * 1024, vdst = lds0 + LDS_V + wid * 1024;
#define DMA_KV(t, slot) do { glds16(ksrc + (long)(t) * KVBLK * PITCH, (unsigned)__builtin_amdgcn_readfirstlane(kdst + (slot))); glds16(vsrc + (long)(t) * KVBLK * PITCH, (unsigned)__builtin_amdgcn_readfirstlane(vdst + (slot))); } while (0)
    const int vb0 = (int)(lds0 + LDS_V) + ((lane >> 4) & 1) * 32 + (lane & 3) * 8 + (4 * hi + ((lane & 15) >> 2)) * 64;
    const int NT = (q0 + QB) / KVBLK;
    DMA_KV(NT - 1, 0);
    bf16x8 qr[4];
#pragma unroll
    for (int d0 = 0; d0 < 4; ++d0) qr[d0] = *(const bf16x8*)(Qw + (long)r32 * PITCH + d0 * 16 + hi * 8);
    f32x16 o[2]; o[0] = f32x16{}; o[1] = f32x16{};
    const int qrel = wid * 32 + r32;
    float m_run = -1.0e30f, l_run = 0.f, R = 0.f, ct = 0.f;
    if (MODE == 0) ct = cb[q0 + qrel];
    bf16x8 TD0, TD1, TONE;
#pragma unroll
    for (int j = 0; j < 8; ++j) { const int kvl = 8 * (j >> 2) + 4 * hi + (j & 3); TD0[j] = (kvl >= r32) ? (short)0x3F80 : (short)0; TD1[j] = (16 + kvl >= r32) ? (short)0x3F80 : (short)0; TONE[j] = (short)0x3F80; }
    f32x16 zero16 = f32x16{};
    for (int i = 0; i < NT; ++i) {
        const int t = NT - 1 - i, slot = (i & 1) * SLOTB;
        ATT_WAIT_BAR0();
        if (MODE == 1 && i > 0) {
            const LAS unsigned* fl = flags + ((i - 1) & 1) * 8; unsigned all = 1u;
#pragma unroll
            for (int w = 0; w < 8; ++w) all &= fl[w];
            if (__builtin_amdgcn_readfirstlane(all)) break;
        }
        if (t > 0) DMA_KV(t - 1, slot ^ SLOTB);
        const int jb = t - (NT - 4);
        const bool active = !(jb >= 0 && 2 * jb > wid);
        bool wave_done = false;
        if (MODE == 1) wave_done = __all(R < SB_EXIT);
        if (active && !(MODE == 1 && wave_done)) {
            f32x16 p0, p1;
            qkt(p0, p1, shm + LDS_K + slot, qr, zero16, r32, hi);
            if (MODE == 0) {
                const float* cbt = cb + t * KVBLK + 4 * hi;
#pragma unroll
                for (int g = 0; g < 4; ++g) { const f32x4 c0 = *(const f32x4*)(cbt + 8 * g), c1 = *(const f32x4*)(cbt + 32 + 8 * g);
#pragma unroll
                    for (int e = 0; e < 4; ++e) { p0[4 * g + e] += ct - c0[e]; p1[4 * g + e] += ct - c1[e]; } }
                if (jb >= 0) {
#pragma unroll
                    for (int r = 0; r < 16; ++r) { const int kv = 64 * jb + crow(r, hi); if (kv > qrel) p0[r] = -1.0e30f; if (kv + 32 > qrel) p1[r] = -1.0e30f; } }
                float a = fmaxf(p0[0], p1[0]);
#pragma unroll
                for (int r = 1; r < 16; ++r) a = fmaxf(a, fmaxf(p0[r], p1[r]));
                a = fmaxf(swap_lo(a), swap_hi(a));
                const float m_new = fmaxf(m_run, a), alpha = __builtin_amdgcn_exp2f(m_run - m_new); m_run = m_new;
                float s = 0.f;
#pragma unroll
                for (int r = 0; r < 16; ++r) { p0[r] = __builtin_amdgcn_exp2f(p0[r] - m_new); p1[r] = __builtin_amdgcn_exp2f(p1[r] - m_new); s += p0[r] + p1[r]; }
                l_run = l_run * alpha + s;
                if (hi == 0) wsf[r32] = alpha;
                LDS_WAIT();
#pragma unroll
                for (int r = 0; r < 16; ++r) { const float f = wsf[crow(r, hi)]; o[0][r] *= f; o[1][r] *= f; }
                LDS_WAIT();
            } else {
                if (jb >= 0) {
#pragma unroll
                    for (int r = 0; r < 16; ++r) { const int kv = 64 * jb + crow(r, hi); if (kv >= qrel) p0[r] = -1.0e30f; if (kv + 32 >= qrel) p1[r] = -1.0e30f; } }
                f32x16 l0, l1;
#pragma unroll
                for (int r = 0; r < 16; ++r) {
                    l0[r] = -(fmaxf(p0[r], 0.f) + __builtin_amdgcn_logf(1.0f + __builtin_amdgcn_exp2f(-fabsf(p0[r]))));
                    l1[r] = -(fmaxf(p1[r], 0.f) + __builtin_amdgcn_logf(1.0f + __builtin_amdgcn_exp2f(-fabsf(p1[r])))); }
                u32x4 lw0 = {cvt_pk_bf16(l0[0], l0[1]), cvt_pk_bf16(l0[2], l0[3]), cvt_pk_bf16(l0[4], l0[5]), cvt_pk_bf16(l0[6], l0[7])};
                u32x4 lw1 = {cvt_pk_bf16(l0[8], l0[9]), cvt_pk_bf16(l0[10], l0[11]), cvt_pk_bf16(l0[12], l0[13]), cvt_pk_bf16(l0[14], l0[15])};
                u32x4 lw2 = {cvt_pk_bf16(l1[0], l1[1]), cvt_pk_bf16(l1[2], l1[3]), cvt_pk_bf16(l1[4], l1[5]), cvt_pk_bf16(l1[6], l1[7])};
                u32x4 lw3 = {cvt_pk_bf16(l1[8], l1[9]), cvt_pk_bf16(l1[10], l1[11]), cvt_pk_bf16(l1[12], l1[13]), cvt_pk_bf16(l1[14], l1[15])};
                f32x16 rt;
#pragma unroll
                for (int r = 0; r < 16; ++r) rt[r] = R;
                f32x16 t0 = MFMA32(TD0, __builtin_bit_cast(bf16x8, lw0), rt); t0 = MFMA32(TD1, __builtin_bit_cast(bf16x8, lw1), t0);
                t0 = MFMA32(TONE, __builtin_bit_cast(bf16x8, lw2), t0); t0 = MFMA32(TONE, __builtin_bit_cast(bf16x8, lw3), t0);
                f32x16 t1 = MFMA32(TD0, __builtin_bit_cast(bf16x8, lw2), rt); t1 = MFMA32(TD1, __builtin_bit_cast(bf16x8, lw3), t1);
#pragma unroll
                for (int r = 0; r < 16; ++r) { p0[r] = __builtin_amdgcn_exp2f(p0[r] + t0[r]); p1[r] = __builtin_amdgcn_exp2f(p1[r] + t1[r]); }
                R = swap_lo(t0[0]);
            }
            u32x4 pw0 = {cvt_pk_bf16(p0[0], p0[1]), cvt_pk_bf16(p0[2], p0[3]), cvt_pk_bf16(p0[4], p0[5]), cvt_pk_bf16(p0[6], p0[7])};
            u32x4 pw1 = {cvt_pk_bf16(p0[8], p0[9]), cvt_pk_bf16(p0[10], p0[11]), cvt_pk_bf16(p0[12], p0[13]), cvt_pk_bf16(p0[14], p0[15])};
            u32x4 pw2 = {cvt_pk_bf16(p1[0], p1[1]), cvt_pk_bf16(p1[2], p1[3]), cvt_pk_bf16(p1[4], p1[5]), cvt_pk_bf16(p1[6], p1[7])};
            u32x4 pw3 = {cvt_pk_bf16(p1[8], p1[9]), cvt_pk_bf16(p1[10], p1[11]), cvt_pk_bf16(p1[12], p1[13]), cvt_pk_bf16(p1[14], p1[15])};
            pv(o, vb0 + slot, __builtin_bit_cast(bf16x8, pw0), __builtin_bit_cast(bf16x8, pw1), __builtin_bit_cast(bf16x8, pw2), __builtin_bit_cast(bf16x8, pw3));
        }
        if (MODE == 1) { const bool dn = __all(R < SB_EXIT); if (lane == 0) flags[(i & 1) * 8 + wid] = dn ? 1u : 0u; }
    }
    float linv = 1.f;
    if (MODE == 0) { const float lt = swap_lo(l_run) + swap_hi(l_run); linv = 1.0f / lt; }
    if (hi == 0) wsf[32 + r32] = linv;
    LDS_WAIT();
    bf16_t* Ow = O + (rowbase + q0 + wid * 32) * OPITCH + h * HD;
    { LAS bf16_t* stg = (LAS bf16_t*)(shm + LDS_OST) + wid * 2048;
#pragma unroll
      for (int r = 0; r < 16; ++r) { const int orow = crow(r, hi); const float f = wsf[32 + orow];
#pragma unroll
        for (int d0 = 0; d0 < 2; ++d0) { const unsigned pk = cvt_pk_bf16(o[d0][r] * f, 0.f); stg[orow * 64 + d0 * 32 + r32] = (bf16_t)(pk & 0xffffu); } }
      LDS_WAIT();
#pragma unroll
      for (int i = 0; i < 4; ++i) { const int row = i * 8 + (lane >> 3), ch = lane & 7; const u32x4 v = *(const LAS u32x4*)(stg + row * 64 + ch * 8); *(u32x4*)(Ow + (long)row * OPITCH + ch * 8) = v;
        store_row_ssq(v, hs + (rowbase + q0 + wid * 32 + row) * 16, ch); } }
    asm volatile("s_waitcnt vmcnt(0) lgkmcnt(0)\n\ts_barrier" ::: "memory");
#undef DMA_KV
}
}


namespace fox {
constexpr int QB = 256, KVBLK = 64, PITCH = HW, OPITCH = DM;
constexpr int NSLOT = 3, SLOTB = 9216;
constexpr int LDS_K = 0, LDS_V = NSLOT * SLOTB, LDS_WS = 2 * NSLOT * SLOTB, LDS_OST = LDS_WS + NWAVES * 256, LDS_CL = LDS_OST + NWAVES * 4096, LDS_VOTE = LDS_CL + 512, LDS_END = LDS_VOTE + 32;
static_assert(LDS_END <= RING_BYTES, "fox LDS");
constexpr float WIN_T = 48.0f;
constexpr float FLOOR = -256.0f;
using att::crow; using att::glds16; using att::glds16s;
typedef __attribute__((address_space(3))) const char* lds_cptr;
typedef short v4i16_t __attribute__((ext_vector_type(4)));
#define SBAR() __builtin_amdgcn_sched_barrier(0)
#define WAIT_BAR(N) asm volatile("s_waitcnt vmcnt(" #N ") lgkmcnt(0)\n\ts_barrier" ::: "memory")
__device__ __forceinline__ s16x4 vtr(lds_cptr p) { return __builtin_bit_cast(s16x4, __builtin_amdgcn_ds_read_tr16_b64_v4i16((__attribute__((address_space(3))) v4i16_t*)p)); }
__device__ __forceinline__ void kload2(bf16x8* kf, lds_cptr kp, int j) { kf[2 * j] = *(const LAS bf16x8*)(kp + j * 2048); kf[2 * j + 1] = *(const LAS bf16x8*)(kp + j * 2048 + 512); }
__device__ __forceinline__ void cmask(f32x16& p0, f32x16& p1, int jb, int qrel, int hi) {
    const float NEG = -INFINITY; const int kb = 64 * jb + 4 * hi;
#pragma unroll
    for (int r = 0; r < 16; ++r) { const int kv = kb + (r & 3) + 8 * (r >> 2); if (kv > qrel) p0[r] = NEG; if (kv + 32 > qrel) p1[r] = NEG; }
}
__device__ __forceinline__ void split3(float x, unsigned& hm, unsigned& lo) {
    const unsigned h = cvt_pk_bf16(x, 0.f) & 0xffffu; const float r1 = x - __uint_as_float(h << 16);
    const unsigned m = cvt_pk_bf16(r1, 0.f) & 0xffffu; const float r2 = r1 - __uint_as_float(m << 16);
    hm = h | (m << 16); lo = cvt_pk_bf16(r2, 0.f) & 0xffffu;
}
__device__ __forceinline__ bf16x8 qx_build(float a, int hi) {
    unsigned hm, lo; split3(a, hm, lo);
    u32x4 w; w.x = hm; w.y = lo | 0x3F800000u; w.z = 0x3F803F80u; w.w = 0u;
    if (hi) { w.x = 0u; w.y = 0u; w.z = 0u; }
    return __builtin_bit_cast(bf16x8, w);
}

template <int THRL> __device__ __forceinline__ void fox_unit(int bh, int qb, const bf16_t* Q, const bf16_t* K, const bf16_t* V, bf16_t* O, float* hs, const float* cb, const bf16_t* KXall, float kmax, LAS char* shm, bool pre, int nbh, int nqb) {
    const bf16_t* KXh = KXall + (size_t)bh * SEQ * 8;
    int tid = threadIdx.x; asm volatile("" : "+v"(tid)); const int lane = tid & 63, r32 = lane & 31, hi = lane >> 5; const int wid = __builtin_amdgcn_readfirstlane(tid >> 6);
    const int b = bh >> 3, h = bh & 7; const long rowbase = (long)b * SEQ; const int q0 = qb * QB;
    const bf16_t* Qw = Q + (rowbase + q0 + wid * 32) * PITCH + h * HD;
    const bf16_t* Kh = K + rowbase * PITCH + h * HD; const bf16_t* Vh = V + rowbase * PITCH + h * HD;
    const unsigned lds0 = (unsigned)(uintptr_t)shm;
    LAS float* wsf = (LAS float*)(shm + LDS_WS) + wid * 64;
    const int NT = (q0 + QB) / KVBLK;
    int NTe = NT;
    LAS float* clt = (LAS float*)(shm + LDS_CL); LAS unsigned* votes = (LAS unsigned*)(shm + LDS_VOTE);
    const float clv = (tid < NT) ? cb[64 * tid + 63] : 0.f;
    const unsigned koff = (unsigned)(lane * PITCH + wid * 8) * 2u, voff = (unsigned)((16 * (wid & 3) + (lane >> 2)) * PITCH + (wid >> 2) * 32 + (lane & 3) * 8) * 2u, xoff = (unsigned)lane * 16u;
    const unsigned kdst = lds0 + LDS_K + wid * 1024, vdst = lds0 + LDS_V + wid * 1024, xdst = lds0 + LDS_K + 8192;
    const bool xl = (lane >> 3) == wid;
#define DMA_KX(Kb, KXb, NTv, p, slot) do { glds16s((Kb) + (long)((NTv) - 1 - (p)) * KVBLK * PITCH, koff, (unsigned)__builtin_amdgcn_readfirstlane(kdst + (slot))); \
        if (xl) glds16s((KXb) + (long)((NTv) - 1 - (p)) * KVBLK * 8, xoff, (unsigned)__builtin_amdgcn_readfirstlane(xdst + (slot))); } while (0)
#define DMA_VX(Vb, NTv, p, slot) glds16s((Vb) + (long)((NTv) - 1 - (p)) * KVBLK * PITCH, voff, (unsigned)__builtin_amdgcn_readfirstlane(vdst + (slot)))
#define DMA_K(p, slot) DMA_KX(Kh, KXh, NT, p, slot)
#define DMA_V(p, slot) DMA_VX(Vh, NT, p, slot)
    bf16x8 kf[10];
    const lds_cptr shm3 = (lds_cptr)shm; const lds_cptr kp0 = shm3 + LDS_K + hi * 1024 + r32 * 16; const lds_cptr kx0 = shm3 + LDS_K + 8192 + r32 * 16;
    const lds_cptr vp0 = shm3 + LDS_V + ((lane >> 4) & 1) * 32 + (lane & 3) * 8 + (4 * hi + ((lane & 15) >> 2)) * 64;
    if (!pre) { DMA_K(0, 0); DMA_V(0, 0); DMA_K(1, SLOTB); }
    bf16x8 qr[4];
#pragma unroll
    for (int d0 = 0; d0 < 4; ++d0) qr[d0] = *(const bf16x8*)(Qw + (long)r32 * PITCH + d0 * 16 + hi * 8);
    const int qrel = wid * 32 + r32;
    const float ct = cb[q0 + qrel];
    float mhat = 0.f, l_reg = 0.f; f32x16 o[2]; o[0] = f32x16{}; o[1] = f32x16{};
    bf16x8 qx = qx_build(ct, hi);
    const f32x16 z16 = f32x16{};
#define CMASK(P0, P1, p) do { const int jb_ = 3 - (p); if (jb_ >= 0) cmask(P0, P1, jb_, qrel, hi); } while (0)
    bool resc = false;
#define RESC() do { if (resc) { asm volatile("s_waitcnt lgkmcnt(0)" ::: "memory"); \
      _Pragma("unroll") for (int d_ = 0; d_ < 2; ++d_) _Pragma("unroll") for (int r = 0; r < 16; ++r) o[d_][r] *= wsf[crow(r, hi)]; } } while (0)
    f32x16 pA0, pA1, pB0, pB1;
    int sl_prev = 0, sl_cur = 0, sl_next = SLOTB;
#define ROT() do { sl_prev = sl_cur; sl_cur = sl_next; sl_next = (sl_next == (NSLOT - 1) * SLOTB) ? 0 : sl_next + SLOTB; } while (0)
    if (!pre) { DMA_K(2, 2 * SLOTB); }
    if (pre) { WAIT_BAR(0); } else WAIT_BAR(5);
    if (tid < NT) clt[tid] = clv;
    float qkb;
    { float q2 = 0.f;
#pragma unroll
      for (int d0 = 0; d0 < 4; ++d0)
#pragma unroll
          for (int j = 0; j < 8; ++j) { const float e = __uint_as_float(((unsigned)(unsigned short)qr[d0][j]) << 16); q2 += e * e; }
      q2 = att::swap_lo(q2) + att::swap_hi(q2); qkb = sqrtf(q2) * kmax + ct + WIN_T; }
    { const LAS char* kb = (const LAS char*)shm + LDS_K + hi * 1024 + r32 * 16; const LAS char* kxb = (const LAS char*)shm + LDS_K + 8192 + r32 * 16;
      pA0 = MFMA32(*(const LAS bf16x8*)(kxb), qx, z16); pA1 = MFMA32(*(const LAS bf16x8*)(kxb + 512), qx, z16);
#pragma unroll
      for (int d0 = 0; d0 < 4; ++d0) { pA0 = MFMA32(*(const LAS bf16x8*)(kb + d0 * 2048), qr[d0], pA0); pA1 = MFMA32(*(const LAS bf16x8*)(kb + d0 * 2048 + 512), qr[d0], pA1); } }
    asm volatile("s_nop 15\n\ts_nop 7" : "+v"(pA0), "+v"(pA1)); CMASK(pA0, pA1, 0);
    { float a = fmaxf(pA0[0], pA1[0]);
#pragma unroll
      for (int r = 1; r < 16; ++r) a = fmaxf(a, fmaxf(pA0[r], pA1[r]));
      a = fmaxf(att::swap_lo(a), att::swap_hi(a));
      const float dl = fmaxf(a, FLOOR); mhat = dl;
#pragma unroll
      for (int r = 0; r < 16; ++r) { pA0[r] = __builtin_amdgcn_exp2f(pA0[r] - dl); pA1[r] = __builtin_amdgcn_exp2f(pA1[r] - dl); }
      qx = qx_build(ct - mhat, hi); asm volatile("" : "+v"(qx)); }
    WAIT_BAR(0);
    DMA_K(3, 0); DMA_V(1, SLOTB);
    ROT();
    kload2(kf, kp0 + sl_cur, 0); kload2(kf, kp0 + sl_cur, 1); kload2(kf, kp0 + sl_cur, 2); kload2(kf, kp0 + sl_cur, 3);
    kf[8] = *(const LAS bf16x8*)(kx0 + sl_cur); kf[9] = *(const LAS bf16x8*)(kx0 + sl_cur + 512);
    WAIT_BAR(3);
    s16x4 vlo[8], vhi[8]; u32x4 pw0, pw1, pw2, pw3;
#define PKW(P, B) cvt_pk_bf16(P[B], P[B + 1])
#define PAF(k) __builtin_bit_cast(bf16x8, pw##k)
#define VFR(i) (bf16x8){vlo[i][0], vlo[i][1], vlo[i][2], vlo[i][3], vhi[i][0], vhi[i][1], vhi[i][2], vhi[i][3]}
#define PIN(x) asm volatile("" : "+v"(x))
#define MX3(a, b, c) __builtin_fmaxf(__builtin_fmaxf((a), (b)), (c))
#define GAPA(MF, A0, A1, A2, A3, W0, W1, PW) do { MF; sacc += A0; sacc += A1; sacc += A2; sacc += A3; PIN(sacc); W0; W1; PIN(PW); SBAR(); } while (0)
#define EX(v) __builtin_amdgcn_exp2f(v)
#define GAPB(MF, X, B) do { MF; X[B] = EX(X[B]); X[B + 1] = EX(X[B + 1]); X[B + 2] = EX(X[B + 2]); X[B + 3] = EX(X[B + 3]); PIN(X); SBAR(); } while (0)
#define VRD(i) do { vlo[i] = vtr(vp_ + (((i) >> 2) * 4096 + ((i) & 3) * 1024)); vhi[i] = vtr(vp_ + (((i) >> 2) * 4096 + ((i) & 3) * 1024 + 512)); } while (0)
#define KRD(G, j) do { if (G) { kload2(kf, kp0 + sl_next, j); SBAR(); } } while (0)
#define KRDX(G) do { if (G) { kf[8] = *(const LAS bf16x8*)(kx0 + sl_next); kf[9] = *(const LAS bf16x8*)(kx0 + sl_next + 512); SBAR(); } } while (0)
#define STEP(C0, C1, P0, P1, t, GK, GV, GL) do { SBAR(); \
    const lds_cptr vp_ = vp0 + sl_prev; \
    C0 = MFMA32(kf[8], qx, z16); C1 = MFMA32(kf[9], qx, z16); SBAR(); \
    VRD(0); SBAR(); float sacc = (P0[0] + P0[1]); \
    GAPA(C0 = MFMA32(kf[0], qr[0], C0), P0[2], P0[3], P0[4], P0[5],     pw0[0] = PKW(P0, 0), pw0[1] = PKW(P0, 2), pw0); \
    VRD(4); SBAR(); GAPA(C1 = MFMA32(kf[1], qr[0], C1), P0[6], P0[7], P0[8], P0[9],     pw0[2] = PKW(P0, 4), pw0[3] = PKW(P0, 6), pw0); \
    VRD(1); SBAR(); GAPA(C0 = MFMA32(kf[2], qr[1], C0),   P0[10], P0[11], P0[12], P0[13], pw1[0] = PKW(P0, 8), pw1[1] = PKW(P0, 10), pw1); \
    VRD(5); SBAR(); GAPA(C1 = MFMA32(kf[3], qr[1], C1),   P0[14], P0[15], P1[0], P1[1],   pw1[2] = PKW(P0, 12), pw1[3] = PKW(P0, 14), pw1); \
    VRD(2); SBAR(); GAPA(C0 = MFMA32(kf[4], qr[2], C0),   P1[2], P1[3], P1[4], P1[5],     pw2[0] = PKW(P1, 0), pw2[1] = PKW(P1, 2), pw2); \
    VRD(6); SBAR(); GAPA(C1 = MFMA32(kf[5], qr[2], C1),   P1[6], P1[7], P1[8], P1[9],     pw2[2] = PKW(P1, 4), pw2[3] = PKW(P1, 6), pw2); \
    VRD(3); SBAR(); GAPA(C0 = MFMA32(kf[6], qr[3], C0),   P1[10], P1[11], P1[12], P1[13], pw3[0] = PKW(P1, 8), pw3[1] = PKW(P1, 10), pw3); \
    VRD(7); SBAR(); GAPA(C1 = MFMA32(kf[7], qr[3], C1),   P1[14], P1[15], 0.f, 0.f,       pw3[2] = PKW(P1, 12), pw3[3] = PKW(P1, 14), pw3); \
    l_reg += sacc; \
    if (GK) { DMA_K((t) + 3, sl_cur); } if (GV) { DMA_V((t) + 1, sl_next); } \
    CMASK(C0, C1, t); \
    { float a = MX3(C0[0], C0[1], C1[0]), b_ = MX3(C0[2], C0[3], C1[1]); a = MX3(a, C1[2], C1[3]); \
      _Pragma("unroll") for (int r = 4; r < 16; r += 4) { a = MX3(a, C0[r], C0[r + 1]); b_ = MX3(b_, C0[r + 2], C0[r + 3]); a = MX3(a, C1[r], C1[r + 1]); b_ = MX3(b_, C1[r + 2], C1[r + 3]); } \
      float rm = __builtin_fmaxf(a, b_); { auto rr = __builtin_amdgcn_permlane32_swap(__float_as_uint(rm), __float_as_uint(rm), false, false); rm = __builtin_fmaxf(__uint_as_float(rr[0]), __uint_as_float(rr[1])); } \
      resc = false; \
      if (__builtin_expect(__any(rm > (float)THRL), 0)) { const float dl = __builtin_fmaxf(rm, 0.f); mhat += dl; \
        _Pragma("unroll") for (int r = 0; r < 16; ++r) { C0[r] -= dl; C1[r] -= dl; } \
        qx = qx_build(ct - mhat, hi); asm volatile("" : "+v"(qx)); \
        const float f = __builtin_amdgcn_exp2f(-dl); l_reg *= f; if (hi == 0) wsf[r32] = f; resc = true; } } \
    SBAR(); \
    GAPB(o[0] = MFMA32(PAF(0), VFR(0), o[0]), C0, 0); \
    KRDX(GL); GAPB(o[1] = MFMA32(PAF(0), VFR(4), o[1]), C0, 4); \
    KRD(GL, 0); GAPB(o[0] = MFMA32(PAF(1), VFR(1), o[0]), C0, 8); \
    KRD(GL, 1); GAPB(o[1] = MFMA32(PAF(1), VFR(5), o[1]), C0, 12); \
    KRD(GL, 2); GAPB(o[0] = MFMA32(PAF(2), VFR(2), o[0]), C1, 0); \
    KRD(GL, 3); GAPB(o[1] = MFMA32(PAF(2), VFR(6), o[1]), C1, 4); \
    GAPB(o[0] = MFMA32(PAF(3), VFR(3), o[0]), C1, 8); \
    GAPB(o[1] = MFMA32(PAF(3), VFR(7), o[1]), C1, 12); \
    } while (0)
#define ENDW(tt) do { if ((tt) + 3 < NTe) { WAIT_BAR(3); } else if ((tt) + 2 < NTe) { WAIT_BAR(1); } else { WAIT_BAR(0); } } while (0)
#define VOTE(u) do { const int ts_ = NT - (u) - 3; bool ok_ = false; if (ts_ >= 0) { ok_ = __all((qkb - mhat) < clt[ts_]); } if (lane == 0) votes[wid] = ok_ ? 1u : 0u; } while (0)
#define TALLY(u) do { const u32x4 va_ = *(const LAS u32x4*)votes, vb_ = *(const LAS u32x4*)(votes + 4); \
        if (__builtin_amdgcn_readfirstlane((va_.x & va_.y & va_.z & va_.w & vb_.x & vb_.y & vb_.z & vb_.w) != 0u)) { if ((u) + 2 < NTe) { NTe = (u) + 2; WAIT_BAR(0); } } } while (0)
    int t = 1;
    for (; t + 1 < NTe && t < 5; t += 2) {
        STEP(pB0, pB1, pA0, pA1, t, (t + 3 < NTe), (t + 1 < NTe), (t + 1 < NTe));       ENDW(t);     RESC(); ROT();
        STEP(pA0, pA1, pB0, pB1, t + 1, (t + 4 < NTe), (t + 2 < NTe), (t + 2 < NTe));   VOTE(t + 1); ENDW(t + 1); TALLY(t + 1); RESC(); ROT();
    }
#undef CMASK
#define CMASK(P0, P1, p) do {} while (0)
    for (; t + 5 < NTe; t += 2) {
        STEP(pB0, pB1, pA0, pA1, t, true, true, true);       WAIT_BAR(3); RESC(); ROT();
        STEP(pA0, pA1, pB0, pB1, t + 1, true, true, true);   VOTE(t + 1); WAIT_BAR(3); TALLY(t + 1); RESC(); ROT();
    }
    for (; t + 1 < NTe; t += 2) {
        STEP(pB0, pB1, pA0, pA1, t, (t + 3 < NTe), (t + 1 < NTe), (t + 1 < NTe));       ENDW(t);     RESC(); ROT();
        STEP(pA0, pA1, pB0, pB1, t + 1, (t + 4 < NTe), (t + 2 < NTe), (t + 2 < NTe));   ENDW(t + 1); RESC(); ROT();
    }
#undef CMASK
#define CMASK(P0, P1, p) do { const int jb_ = 3 - (p); if (jb_ >= 0) cmask(P0, P1, jb_, qrel, hi); } while (0)
    STEP(pB0, pB1, pA0, pA1, NTe - 1, false, false, false); RESC();
    { float sacc = pB0[0] + pB0[1];
#pragma unroll
      for (int r = 2; r < 16; ++r) sacc += pB0[r];
#pragma unroll
      for (int r = 0; r < 16; ++r) sacc += pB1[r];
      l_reg += sacc;
      pw0 = (u32x4){PKW(pB0, 0), PKW(pB0, 2), PKW(pB0, 4), PKW(pB0, 6)}; pw1 = (u32x4){PKW(pB0, 8), PKW(pB0, 10), PKW(pB0, 12), PKW(pB0, 14)};
      pw2 = (u32x4){PKW(pB1, 0), PKW(pB1, 2), PKW(pB1, 4), PKW(pB1, 6)}; pw3 = (u32x4){PKW(pB1, 8), PKW(pB1, 10), PKW(pB1, 12), PKW(pB1, 14)};
      SBAR(); att::pv(o, (int)(unsigned)(uintptr_t)(vp0 + sl_cur), PAF(0), PAF(1), PAF(2), PAF(3)); }
    if (nbh >= 0) { asm volatile("s_waitcnt lgkmcnt(0)\n\ts_barrier" ::: "memory");
        const int NTn = (nqb * QB + QB) / KVBLK; const bf16_t* Kn = K + (long)(nbh >> 3) * SEQ * PITCH + (nbh & 7) * HD; const bf16_t* Vn = V + (long)(nbh >> 3) * SEQ * PITCH + (nbh & 7) * HD; const bf16_t* KXn = KXall + (size_t)nbh * SEQ * 8;
        DMA_KX(Kn, KXn, NTn, 0, 0); DMA_VX(Vn, NTn, 0, 0); DMA_KX(Kn, KXn, NTn, 1, SLOTB); DMA_KX(Kn, KXn, NTn, 2, 2 * SLOTB); }
    l_reg = att::swap_lo(l_reg) + att::swap_hi(l_reg);
    if (hi == 0) wsf[32 + r32] = l_reg; asm volatile("s_waitcnt lgkmcnt(0)" ::: "memory");
    float rli[16];
#pragma unroll
    for (int r = 0; r < 16; ++r) rli[r] = __builtin_amdgcn_rcpf(wsf[32 + crow(r, hi)]);
    bf16_t* Ow = O + (rowbase + q0 + wid * 32) * OPITCH + h * HD;
    { LAS bf16_t* stg = (LAS bf16_t*)(shm + LDS_OST) + wid * 2048;
#pragma unroll
      for (int r = 0; r < 16; ++r) { const int orow = crow(r, hi);
#pragma unroll
        for (int d0 = 0; d0 < 2; ++d0) stg[orow * 64 + d0 * 32 + r32] = (bf16_t)(cvt_pk_bf16(o[d0][r] * rli[r], 0.f) & 0xffffu); }
      asm volatile("s_waitcnt lgkmcnt(0)" ::: "memory");
#pragma unroll
      for (int i = 0; i < 4; ++i) { const int row = i * 8 + (lane >> 3), ch = lane & 7; const u32x4 v = *(const LAS u32x4*)(stg + row * 64 + ch * 8); *(u32x4*)(Ow + (long)row * OPITCH + ch * 8) = v;
        att::store_row_ssq(v, hs + (rowbase + q0 + wid * 32 + row) * 16, ch); } }
    asm volatile("s_waitcnt lgkmcnt(0)\n\ts_barrier" ::: "memory");
#undef DMA_K
#undef DMA_V
#undef DMA_KX
#undef DMA_VX
#undef CMASK
#undef RESC
#undef ROT
#undef PKW
#undef PAF
#undef VFR
#undef PIN
#undef MX3
#undef GAPA
#undef GAPB
#undef EX
#undef VRD
#undef KRD
#undef KRDX
#undef STEP
#undef ENDW
#undef VOTE
#undef TALLY
}
#undef SBAR
#undef WAIT_BAR
}


namespace sbk {
constexpr int QB = 256, KVBLK = 64, PITCH = HW, OPITCH = DM, NBURST = 6, SLOTB = 8192;
constexpr int LDS_K = 0, LDS_V = NBURST * SLOTB, LDS_FLAG = 2 * NBURST * SLOTB, LDS_END = LDS_FLAG + 128;
static_assert(LDS_END <= RING_BYTES, "sb LDS");
using att::crow; using att::glds16s; using att::qkt; using att::pv; using att::swap_lo;
__device__ __forceinline__ void sb_tile(const LAS char* Kslot, int vb, const bf16x8* qr, bf16x8 TD0, bf16x8 TD1, bf16x8 TONE, int jb, int qrel, int r32, int hi, float& R, f32x16* o) {
    f32x16 p0, p1; const f32x16 z16 = f32x16{};
    qkt(p0, p1, Kslot, qr, z16, r32, hi);
    if (jb >= 0) {
#pragma unroll
        for (int r = 0; r < 16; ++r) { const int kv = 64 * jb + crow(r, hi); if (kv >= qrel) p0[r] = -1.0e30f; if (kv + 32 >= qrel) p1[r] = -1.0e30f; } }
    f32x16 l0, l1;
#pragma unroll
    for (int r = 0; r < 16; ++r) {
        l0[r] = -(fmaxf(p0[r], 0.f) + __builtin_amdgcn_logf(1.0f + __builtin_amdgcn_exp2f(-fabsf(p0[r]))));
        l1[r] = -(fmaxf(p1[r], 0.f) + __builtin_amdgcn_logf(1.0f + __builtin_amdgcn_exp2f(-fabsf(p1[r])))); }
    u32x4 lw0 = {cvt_pk_bf16(l0[0], l0[1]), cvt_pk_bf16(l0[2], l0[3]), cvt_pk_bf16(l0[4], l0[5]), cvt_pk_bf16(l0[6], l0[7])};
    u32x4 lw1 = {cvt_pk_bf16(l0[8], l0[9]), cvt_pk_bf16(l0[10], l0[11]), cvt_pk_bf16(l0[12], l0[13]), cvt_pk_bf16(l0[14], l0[15])};
    u32x4 lw2 = {cvt_pk_bf16(l1[0], l1[1]), cvt_pk_bf16(l1[2], l1[3]), cvt_pk_bf16(l1[4], l1[5]), cvt_pk_bf16(l1[6], l1[7])};
    u32x4 lw3 = {cvt_pk_bf16(l1[8], l1[9]), cvt_pk_bf16(l1[10], l1[11]), cvt_pk_bf16(l1[12], l1[13]), cvt_pk_bf16(l1[14], l1[15])};
    f32x16 rt;
#pragma unroll
    for (int r = 0; r < 16; ++r) rt[r] = R;
    f32x16 t0 = MFMA32(TD0, __builtin_bit_cast(bf16x8, lw0), rt); t0 = MFMA32(TD1, __builtin_bit_cast(bf16x8, lw1), t0);
    t0 = MFMA32(TONE, __builtin_bit_cast(bf16x8, lw2), t0); t0 = MFMA32(TONE, __builtin_bit_cast(bf16x8, lw3), t0);
    f32x16 t1 = MFMA32(TD0, __builtin_bit_cast(bf16x8, lw2), rt); t1 = MFMA32(TD1, __builtin_bit_cast(bf16x8, lw3), t1);
#pragma unroll
    for (int r = 0; r < 16; ++r) { p0[r] = __builtin_amdgcn_exp2f(p0[r] + t0[r]); p1[r] = __builtin_amdgcn_exp2f(p1[r] + t1[r]); }
    R = swap_lo(t0[0]);
    u32x4 pw0 = {cvt_pk_bf16(p0[0], p0[1]), cvt_pk_bf16(p0[2], p0[3]), cvt_pk_bf16(p0[4], p0[5]), cvt_pk_bf16(p0[6], p0[7])};
    u32x4 pw1 = {cvt_pk_bf16(p0[8], p0[9]), cvt_pk_bf16(p0[10], p0[11]), cvt_pk_bf16(p0[12], p0[13]), cvt_pk_bf16(p0[14], p0[15])};
    u32x4 pw2 = {cvt_pk_bf16(p1[0], p1[1]), cvt_pk_bf16(p1[2], p1[3]), cvt_pk_bf16(p1[4], p1[5]), cvt_pk_bf16(p1[6], p1[7])};
    u32x4 pw3 = {cvt_pk_bf16(p1[8], p1[9]), cvt_pk_bf16(p1[10], p1[11]), cvt_pk_bf16(p1[12], p1[13]), cvt_pk_bf16(p1[14], p1[15])};
    pv(o, vb, __builtin_bit_cast(bf16x8, pw0), __builtin_bit_cast(bf16x8, pw1), __builtin_bit_cast(bf16x8, pw2), __builtin_bit_cast(bf16x8, pw3));
}
#define SB_WAITBAR(N) asm volatile("s_waitcnt vmcnt(" #N ") lgkmcnt(0)\n\ts_barrier" ::: "memory")
__device__ __forceinline__ void sb_unit(int b, int h, int qb, const bf16_t* Q, const bf16_t* K, const bf16_t* V, bf16_t* O, float* hs, LAS char* shm) {
    int tid = threadIdx.x; asm volatile("" : "+v"(tid)); const int lane = tid & 63, r32 = lane & 31, hi = lane >> 5; const int wid = __builtin_amdgcn_readfirstlane(tid >> 6);
    const long rowbase = (long)b * SEQ; const int q0 = qb * QB;
    const bf16_t* Qw = Q + (rowbase + q0 + wid * 32) * PITCH + h * HD;
    const bf16_t* Kh = K + rowbase * PITCH + h * HD; const bf16_t* Vh = V + rowbase * PITCH + h * HD;
    const unsigned lds0 = (unsigned)(uintptr_t)shm;
    LAS unsigned* flags = (LAS unsigned*)(shm + LDS_FLAG);
    const unsigned koff = (unsigned)(lane * PITCH + wid * 8) * 2u, voff = (unsigned)((16 * (wid & 3) + (lane >> 2)) * PITCH + (wid >> 2) * 32 + (lane & 3) * 8) * 2u;
    const unsigned kdst = lds0 + LDS_K + wid * 1024, vdst = lds0 + LDS_V + wid * 1024;
#define SB_DMA(p, slot) do { glds16s(Kh + (long)(NT - 1 - (p)) * KVBLK * PITCH, koff, (unsigned)__builtin_amdgcn_readfirstlane(kdst + (slot) * SLOTB)); \
        glds16s(Vh + (long)(NT - 1 - (p)) * KVBLK * PITCH, voff, (unsigned)__builtin_amdgcn_readfirstlane(vdst + (slot) * SLOTB)); } while (0)
    const int vb0 = (int)(lds0 + LDS_V) + ((lane >> 4) & 1) * 32 + (lane & 3) * 8 + (4 * hi + ((lane & 15) >> 2)) * 64;
    const int NT = (q0 + QB) / KVBLK, NB = NT < NBURST ? NT : NBURST;
    for (int p = 0; p < NB; ++p) SB_DMA(p, p);
    bf16x8 qr[4];
#pragma unroll
    for (int d0 = 0; d0 < 4; ++d0) qr[d0] = *(const bf16x8*)(Qw + (long)r32 * PITCH + d0 * 16 + hi * 8);
    f32x16 o[2]; o[0] = f32x16{}; o[1] = f32x16{};
    const int qrel = wid * 32 + r32;
    float R = 0.f;
    bf16x8 TD0, TD1, TONE;
#pragma unroll
    for (int j = 0; j < 8; ++j) { const int kvl = 8 * (j >> 2) + 4 * hi + (j & 3); TD0[j] = (kvl >= r32) ? (short)0x3F80 : (short)0; TD1[j] = (16 + kvl >= r32) ? (short)0x3F80 : (short)0; TONE[j] = (short)0x3F80; }
    if (NB > 4) { SB_WAITBAR(4); } else { SB_WAITBAR(0); }
    bool mid_done = (NB <= 4);
    int p = 3 - (wid >> 1);
    for (; p < NB; ++p) {
        if (p >= 4 && !mid_done) { SB_WAITBAR(0); mid_done = true; }
        sb_tile(shm + LDS_K + p * SLOTB, vb0 + p * SLOTB, qr, TD0, TD1, TONE, 3 - p, qrel, r32, hi, R, o);
        if (__all(R < SB_EXIT)) { ++p; break; }
    }
    if (!mid_done) { SB_WAITBAR(0); }
    { const bool dn = __all(R < SB_EXIT) || (p >= NT); if (lane == 0) flags[wid] = dn ? 1u : 0u; }
    SB_WAITBAR(0);
    bool alldone;
    { const u32x4 fa = *(const LAS u32x4*)flags, fb = *(const LAS u32x4*)(flags + 4); alldone = __builtin_amdgcn_readfirstlane((fa.x & fa.y & fa.z & fa.w & fb.x & fb.y & fb.z & fb.w) != 0u); }
    if (!alldone && NB < NT) {
        SB_DMA(NB, 0);
        for (int i = 0; NB + i < NT; ++i) {
            const int pp = NB + i, sl = i & 1;
            SB_WAITBAR(0);
            if (i > 0) { const LAS unsigned* fl = flags + 8 + ((i - 1) & 1) * 8; const u32x4 fa = *(const LAS u32x4*)fl, fb = *(const LAS u32x4*)(fl + 4);
                if (__builtin_amdgcn_readfirstlane((fa.x & fa.y & fa.z & fa.w & fb.x & fb.y & fb.z & fb.w) != 0u)) break; }
            if (pp + 1 < NT) SB_DMA(pp + 1, sl ^ 1);
            if (!__all(R < SB_EXIT)) sb_tile(shm + LDS_K + sl * SLOTB, vb0 + sl * SLOTB, qr, TD0, TD1, TONE, -1, qrel, r32, hi, R, o);
            { const bool dn = __all(R < SB_EXIT); if (lane == 0) flags[8 + (i & 1) * 8 + wid] = dn ? 1u : 0u; }
        }
        SB_WAITBAR(0);
    }
    bf16_t* Ow = O + (rowbase + q0 + wid * 32) * OPITCH + h * HD;
    { LAS bf16_t* stg = (LAS bf16_t*)(shm + LDS_K) + wid * 2048;
#pragma unroll
      for (int r = 0; r < 16; ++r) { const int orow = crow(r, hi);
#pragma unroll
        for (int d0 = 0; d0 < 2; ++d0) stg[orow * 64 + d0 * 32 + r32] = (bf16_t)(cvt_pk_bf16(o[d0][r], 0.f) & 0xffffu); }
      LDS_WAIT();
#pragma unroll
      for (int i = 0; i < 4; ++i) { const int row = i * 8 + (lane >> 3), ch = lane & 7; const u32x4 v = *(const LAS u32x4*)(stg + row * 64 + ch * 8); *(u32x4*)(Ow + (long)row * OPITCH + ch * 8) = v;
        att::store_row_ssq(v, hs + (rowbase + q0 + wid * 32 + row) * 16, ch); } }
    asm volatile("s_waitcnt vmcnt(0) lgkmcnt(0)\n\ts_barrier" ::: "memory");
#undef SB_DMA
}
#undef SB_WAITBAR
}

#define XB_TMO      128
#define XB_XCNT(j)  (256  + 64 * (j))
#define XB_XSUB(j)  (1280 + 64 * (j))
#define XB_XGEN(j)  (2304 + 64 * (j))
#define XB_TOP      3328
#define XB_TOPGEN   3392
#define XCD_BAR_WORDS 3456
#define XB_SPIN_CAP (1u << 18)
__device__ __forceinline__ unsigned xb_ld(unsigned* p)              { return __hip_atomic_load(p, __ATOMIC_RELAXED, __HIP_MEMORY_SCOPE_AGENT); }
__device__ __forceinline__ unsigned xb_add(unsigned* p, unsigned v) { return __hip_atomic_fetch_add(p, v, __ATOMIC_RELAXED, __HIP_MEMORY_SCOPE_AGENT); }
__device__ __forceinline__ unsigned xb_xcc_id() { return (unsigned)__builtin_amdgcn_s_getreg((3 << 11) | 20) & 0xFu; }
#define XB_SPIN(cond, bar) do { unsigned _sp = 0; while (cond) { __builtin_amdgcn_s_sleep(1); \
    if ((++_sp & 255u) == 0u) { if (xb_ld(&(bar)[XB_TMO])) break; if (_sp > XB_SPIN_CAP) { atomicAdd(&(bar)[XB_TMO], 1u); break; } } } } while (0)
struct XcdBarrier { unsigned* bar; unsigned x; volatile LAS unsigned* st; };
__device__ __forceinline__ XcdBarrier xcd_barrier_post(unsigned* bar, volatile LAS unsigned* st) {
    XcdBarrier b; b.bar = bar; b.x = xb_xcc_id(); b.st = st;
    if (threadIdx.x == 0) (void)xb_add(&bar[XB_XCNT(b.x)], 1u);
    return b;
}
__device__ __forceinline__ void xcd_barrier_complete(unsigned* bar, unsigned x, unsigned& nloc, unsigned& nx) {
    const unsigned G = gridDim.x * gridDim.y * gridDim.z;
    unsigned sum, cnt, mine, sp = 0u;
    for (;;) {
        sum = 0u; cnt = 0u; mine = 0u;
#pragma unroll
        for (unsigned j = 0; j < 16; ++j) { const unsigned c = xb_ld(&bar[XB_XCNT(j)]); sum += c; cnt += (c > 0u) ? 1u : 0u; mine = (j == x) ? c : mine; }
        if (sum == G) break;
        __builtin_amdgcn_s_sleep(1);
        if ((++sp & 255u) == 0u) { if (xb_ld(&bar[XB_TMO])) break; if (sp > XB_SPIN_CAP) { atomicAdd(&bar[XB_TMO], 1u); break; } }
    }
    nloc = mine > 0u ? mine : 1u; nx = cnt > 0u ? cnt : 1u;
}
__device__ __forceinline__ void xcd_barrier(const XcdBarrier& b) {
    asm volatile("s_waitcnt vmcnt(0)" ::: "memory");
    __syncthreads();
    if (threadIdx.x == 0) {
        unsigned* bar = b.bar;
        __builtin_amdgcn_s_waitcnt(0);
        unsigned nloc = b.st[0], nx = b.st[1];
        if (nloc == 0u) { xcd_barrier_complete(bar, b.x, nloc, nx); b.st[0] = nloc; b.st[1] = nx; }
        const unsigned old = xb_add(&bar[XB_XSUB(b.x)], 1u);
        const unsigned gen = old / nloc;
        if (old + 1u == (gen + 1u) * nloc) {
            __builtin_amdgcn_fence(__ATOMIC_RELEASE, "agent");
            asm volatile("s_waitcnt vmcnt(0)" ::: "memory");
            const unsigned og = xb_add(&bar[XB_TOP], 1u);
            const unsigned tg = og / nx;
            if (og + 1u == (tg + 1u) * nx) xb_add(&bar[XB_TOPGEN], 1u);
            else XB_SPIN(xb_ld(&bar[XB_TOPGEN]) == tg, bar);
            __builtin_amdgcn_fence(__ATOMIC_ACQUIRE, "agent");
            xb_add(&bar[XB_XGEN(b.x)], 1u);
            asm volatile("s_waitcnt vmcnt(0)" ::: "memory");
        } else {
            XB_SPIN(xb_ld(&bar[XB_XGEN(b.x)]) == gen, bar);
            __builtin_amdgcn_fence(__ATOMIC_ACQUIRE, "agent");
            asm volatile("s_waitcnt vmcnt(0)" ::: "memory");
        }
    }
    __syncthreads();
}

__device__ __forceinline__ const void* ldp(const volatile LAS unsigned* tab, int i) {
    const unsigned lo = __builtin_amdgcn_readfirstlane(tab[2 * i]), hi = __builtin_amdgcn_readfirstlane(tab[2 * i + 1]);
    return (const void*)(const GAS void*)(((unsigned long long)hi << 32) | lo);
}
struct Args {
    const float* x; const float* mem; const float* norm_mix; const float* w_in; const float* b_forget; const float* norm_fox; const float* norm_sb; const float* w_out;
    const float* norm_xattn; const float* norm_mem; const float* w_xq; const float* w_xkv; const float* w_xo; const float* norm_ffn;
    const float* w_rg; const float* b_rg; const float* w_re; const float* b_re; const float* w_gate; const float* w_up; const float* w_down; const float* norm_final;
    float* out; unsigned char* ws;
};

__device__ __forceinline__ void transpose_item(const float* W, int ldw, bf16_t* WT, int ldo, int k0, int n0, int dst_row0, const float* gain, LAS float* scr, int lane) {
    float tv[32], tg[32];
#pragma unroll
    for (int i = 0; i < 32; ++i) { const int kk = 2 * i + (lane >> 5); tv[i] = __builtin_nontemporal_load(W + (size_t)(k0 + kk) * ldw + n0 + (lane & 31)); tg[i] = gain ? gain[k0 + kk] : 1.f; }
#pragma unroll
    for (int i = 0; i < 32; ++i) { const int kk = 2 * i + (lane >> 5); scr[kk * 33 + (lane & 31)] = tv[i] * tg[i]; }
    LDS_WAIT(); asm volatile("" ::: "memory");
    const int c = lane & 7;
#pragma unroll
    for (int j = 0; j < 4; ++j) { const int n = (lane >> 3) + 8 * j; const LAS float* s = scr + (8 * c) * 33 + n;
        u32x4 o; o.x = cvt_pk_bf16(s[0 * 33], s[1 * 33]); o.y = cvt_pk_bf16(s[2 * 33], s[3 * 33]); o.z = cvt_pk_bf16(s[4 * 33], s[5 * 33]); o.w = cvt_pk_bf16(s[6 * 33], s[7 * 33]);
        *(u32x4*)(WT + (size_t)(dst_row0 + n) * ldo + k0 + 8 * c) = o; }
    LDS_WAIT(); asm volatile("" ::: "memory");
}

__device__ __forceinline__ void transpose_item8(const float* W, int ldw, unsigned char* WT, int ldo, int k0, int n0, int dst_row0, const float* gain, float scale, LAS float* scr, int lane) {
    float tv[32], tg[32];
#pragma unroll
    for (int i = 0; i < 32; ++i) { const int kk = 2 * i + (lane >> 5); tv[i] = __builtin_nontemporal_load(W + (size_t)(k0 + kk) * ldw + n0 + (lane & 31)); tg[i] = gain ? gain[k0 + kk] : 1.f; }
#pragma unroll
    for (int i = 0; i < 32; ++i) { const int kk = 2 * i + (lane >> 5); scr[kk * 33 + (lane & 31)] = tv[i] * tg[i] * scale; }
    LDS_WAIT(); asm volatile("" ::: "memory");
    const int c = lane & 7;
#pragma unroll
    for (int j = 0; j < 4; ++j) { const int n = (lane >> 3) + 8 * j; const LAS float* s = scr + (8 * c) * 33 + n;
        u32x2 o; o.x = cvt4_fp8(s[0 * 33], s[1 * 33], s[2 * 33], s[3 * 33]); o.y = cvt4_fp8(s[4 * 33], s[5 * 33], s[6 * 33], s[7 * 33]);
        *(u32x2*)(WT + (size_t)(dst_row0 + n) * ldo + k0 + 8 * c) = o; }
    LDS_WAIT(); asm volatile("" ::: "memory");
}

struct SchedDense {
    const char* A; const char* Bt; int nM, nN, G, c; size_t a_tile, b_tile, b_batch; int split_tiles;
    __device__ __forceinline__ bool next(int i, pg8::Unit& u) const {
        int pm, pn; if (!pg8::tile_order(i, G, c, nM, nN, pm, pn)) return false;
        u.a = A + (size_t)pm * a_tile; u.b = Bt + (size_t)pn * b_tile + (size_t)(pm >> 5) * b_batch; u.orow = pm * 256;
        if (split_tiles) { u.aux = pn / split_tiles; u.ocol = (pn % split_tiles) * 256; } else { u.aux = 1; u.ocol = pn * 256; }
        u.rows = nullptr; u.nvalid = 256; return true;
    }
};
struct SchedGH {
    const char* KVm; const char* Wxq; const char* Wxo; int G, c;
    __device__ __forceinline__ bool next(int i, pg8::Unit& u) const {
        const int L = i * G + c; if (L >= 256) return false;
        const int kind = L >> 7, r = L & 127, bh = r >> 2, j = r & 3, b = bh >> 2, h = bh & 3;
        if (kind == 0) { u.a = KVm + ((size_t)(b * 256) * 2048 + h * 256) * 2; u.b = Wxq + ((size_t)(256 * j) * 1024 + h * 256) * 2; u.orow = b * 1024 + h * 256; u.ocol = 256 * j; u.aux = 1; }
        else { u.a = Wxo + ((size_t)(256 * j) * 1024 + h * 256) * 2; u.b = KVm + ((size_t)(b * 256) * 2048 + 1024 + h * 256) * 2; u.orow = b * 1024 + 256 * j; u.ocol = h * 256; u.aux = 2; }
        u.rows = nullptr; u.nvalid = 256; return true;
    }
};
template <int KIND> struct SchedGHk { SchedGH s; __device__ __forceinline__ bool next(int i, pg8::Unit& u) const { const int c2 = (s.G >= 256) ? s.c - 128 * KIND : s.c; if (c2 < 0) return false; const int L = i * s.G + c2; if (L >= 128) return false; SchedGH t = s; t.G = 1; t.c = 0; return t.next(128 * KIND + L, u); } };
struct EpiGH { static constexpr bool HAS_MID = false; unsigned char* GTp; unsigned char* HTp;
    __device__ __forceinline__ void operator()(const f32x4 (&acc)[2][2][4][2], const pg8::Unit& u, int wr, int wc, int fr, int fq) const {
        unsigned char* base = u.aux == 1 ? GTp : HTp;
#pragma unroll
        for (int ai = 0; ai < 2; ++ai)
#pragma unroll
            for (int m = 0; m < 4; ++m) { const int row = u.orow + ai * pg8::HALF + wr * 64 + m * 16 + fr;
#pragma unroll
                for (int bj = 0; bj < 2; ++bj) { const f32x4 v0 = acc[ai][bj][m][0], v1 = acc[ai][bj][m][1];
                    u32x2 w8; w8.x = cvt4_fp8(v0[0], v0[1], v0[2], v0[3]); w8.y = cvt4_fp8(v1[0], v1[1], v1[2], v1[3]);
                    *(u32x2*)(base + (size_t)row * DM + u.ocol + bj * pg8::HALF + wc * 32 + 8 * fq) = w8; } }
    } };
struct SchedMoe {
    const char* A; const char* W; const int* list; const LAS int* tbl; int G, c, NPN; size_t w_exp, w_tile, a_tile; int ocol_w;
    __device__ __forceinline__ bool next(int i, pg8::Unit& u) const {
        const int L = i * G + c; const int tl = L / NPN, pn = L % NPN;
        if (tl >= __builtin_amdgcn_readfirstlane(tbl[16])) return false;
        int e = 0;
#pragma unroll 1
        for (int x = 1; x < NEXP; ++x) { if (tl >= __builtin_amdgcn_readfirstlane(tbl[x])) e = x; }
        const int j = tl - __builtin_amdgcn_readfirstlane(tbl[e]), n = __builtin_amdgcn_readfirstlane(tbl[32 + e]) - 256 * j;
        u.a = A + (size_t)tl * a_tile; u.b = W + (size_t)e * w_exp + (size_t)pn * w_tile; u.orow = tl * 256; u.ocol = pn * ocol_w; u.aux = 1;
        u.rows = list + (size_t)e * M + 256 * j; u.nvalid = n < 256 ? n : 256; return true;
    }
};
__device__ __forceinline__ void moe_table(LAS int* tbl, const unsigned* ctl) {
    if (threadIdx.x == 0) { int base = 0; for (int e = 0; e < NEXP; ++e) { const int n = (int)ctl[CW_CNT + 64 * e]; tbl[e] = base; tbl[32 + e] = n; base += (n + 255) >> 8; } tbl[16] = base; }
    __syncthreads();
}

__global__ void __launch_bounds__(NWAVES * 64, 2) hymba_fwd(Args args) {
    extern __shared__ __attribute__((aligned(16))) unsigned char lds_raw[];
    LAS unsigned char* lds = (LAS unsigned char*)lds_raw;
    volatile LAS unsigned* MISC = (volatile LAS unsigned*)(lds + MISC_OFF);
    const int tid0 = threadIdx.x; const int wave = __builtin_amdgcn_readfirstlane(tid0 >> 6);
    const int G = gridDim.x; const int bx = blockIdx.x; const int vcu = (G % 8 == 0) ? (bx % 8) * (G / 8) + bx / 8 : bx;
    volatile LAS unsigned* ATAB = (volatile LAS unsigned*)(lds + MISC_OFF + 512);
    for (int u = tid0; u < 256; u += NWAVES * 64) ((LAS unsigned*)(lds + MISC_OFF))[u] = 0u;
    __syncthreads();
    if (tid0 == 0) { const float* const* ap = (const float* const*)&args;
#pragma unroll
        for (int i = 0; i < 24; ++i) { const unsigned long long v = (unsigned long long)ap[i]; ATAB[2 * i] = (unsigned)v; ATAB[2 * i + 1] = (unsigned)(v >> 32); } }
    __syncthreads();
#define ARGP(name) ((const float*)ldp(ATAB, (int)(offsetof(Args, name) / 8)))
#define PHASE_PTRS \
    int tid = threadIdx.x; asm volatile("" : "+v"(tid)); const int lane = tid & 63; (void)lane; \
    unsigned char* const ws = (unsigned char*)ldp(ATAB, 23); float* const out = (float*)ldp(ATAB, 22); unsigned* const ctl = (unsigned*)(ws + WS_CTL); (void)out; (void)ctl; \
    bf16_t* const Win_t = (bf16_t*)(ws + WS_WIN); bf16_t* const Wout_t = (bf16_t*)(ws + WS_WOUT); bf16_t* const Wxq_n = (bf16_t*)(ws + WS_WXQ); bf16_t* const Wxkv_t = (bf16_t*)(ws + WS_WXKV); \
    bf16_t* const Wxo_t = (bf16_t*)(ws + WS_WXO); bf16_t* const Wgu_t = (bf16_t*)(ws + WS_WGU); bf16_t* const Wd_t = (bf16_t*)(ws + WS_WD); \
    float* const RX = (float*)(ws + WS_RX); float* const RMEM = (float*)(ws + WS_RMEM); float* const LF = (float*)(ws + WS_LF); float* const CC = (float*)(ws + WS_C2); float* const SSQ = (float*)(ws + WS_SSQ); \
    int* const TOKSLOT = (int*)(ws + WS_TOKSLOT); float* const TOKW = (float*)(ws + WS_TOKW); int* const LIST = (int*)(ws + WS_LIST); \
    bf16_t* const MEMB = (bf16_t*)(ws + WS_MEMB); bf16_t* const KVM = (bf16_t*)(ws + WS_KVM); bf16_t* const GT = (bf16_t*)(ws + WS_GT); bf16_t* const HT = (bf16_t*)(ws + WS_HT); \
    bf16_t* const XB = (bf16_t*)(ws + WS_XB); bf16_t* const QKV = (bf16_t*)(ws + WS_QKV); bf16_t* const H1B = (bf16_t*)(ws + WS_H1B); bf16_t* const U2B = (bf16_t*)(ws + WS_U2B); bf16_t* const HID = (bf16_t*)(ws + WS_HID); \
    bf16_t* const OAB = (bf16_t*)(ws + WS_O); bf16_t* const YB = (bf16_t*)(ws + WS_Y); bf16_t* const KX = (bf16_t*)(ws + WS_KX); (void)KX; float* const HS = (float*)(ws + WS_HS); (void)HS; float* const R2S = (float*)(ws + WS_SSQ); (void)R2S; unsigned char* const H1F8 = ws + WS_H1F8; (void)H1F8; unsigned char* const H2F8 = ws + WS_H2F8; (void)H2F8; \
    (void)Win_t; (void)Wout_t; (void)Wxq_n; (void)Wxkv_t; (void)Wxo_t; (void)Wgu_t; (void)Wd_t; (void)RX; (void)RMEM; (void)LF; (void)CC; (void)SSQ; (void)TOKSLOT; (void)TOKW; (void)LIST; \
    (void)MEMB; (void)KVM; (void)GT; (void)HT; (void)XB; (void)QKV; (void)H1B; (void)U2B; (void)HID; (void)OAB; (void)YB;
    XcdBarrier bar;
    { unsigned char* const ws0 = (unsigned char*)ldp(ATAB, 23); bar = xcd_barrier_post((unsigned*)(ws0 + WS_CTL) + CW_BAR, MISC + 8); }
    const int gw = vcu * NWAVES + wave, NGW = G * NWAVES;
    unsigned long long t_pa = 0, t_pb = 0; (void)t_pa; (void)t_pb;


    if (PROBE_LO == 0) t_pa = __builtin_amdgcn_s_memrealtime();
    if (PH(0))
    for (int rep_ = 0; rep_ < REPS(0); ++rep_)
    {
        PHASE_PTRS
        LAS float* wfT = (LAS float*)(lds + RING_OFF);
        LAS float* scr = (LAS float*)(lds + RING_OFF + 32768 + wave * 8448);
        { const float* win = ARGP(w_in); const float* gmix = ARGP(norm_mix);
          f32x4 fa[2], fb[2]; float gk[2];
#pragma unroll
          for (int q = 0; q < 2; ++q) { const int k = tid + 512 * q; gk[q] = gmix[k]; fa[q] = *(const f32x4*)(win + (size_t)k * WIN_LD + NPROJ); fb[q] = *(const f32x4*)(win + (size_t)k * WIN_LD + NPROJ + 4); }
#pragma unroll
          for (int q = 0; q < 2; ++q) { const int k = tid + 512 * q;
#pragma unroll
              for (int j = 0; j < 4; ++j) { wfT[j * DM + k] = fa[q][j] * gk[q]; wfT[(4 + j) * DM + k] = fb[q][j] * gk[q]; } } }
        constexpr int I_IN = 16 * 96, I_OUT = 16 * 32, I_XKV = 16 * 64, I_XO = 16 * 32, I_G = 16 * 16 * 8, I_U = I_G, I_D = 16 * 4 * 32, I_XQ = 1024;
        constexpr int NITEMS = I_IN + I_OUT + I_XKV + I_XO + I_G + I_U + I_D + I_XQ;
        for (int it = gw; it < NITEMS; it += NGW) {
            int r = it;
            if (r < I_IN) { const int kb = r / 96, nb = r % 96; transpose_item(ARGP(w_in), WIN_LD, Win_t, DM, 64 * kb, 32 * nb, 32 * nb, ARGP(norm_mix), scr, lane); continue; } r -= I_IN;
            if (r < I_OUT) { const int kb = r / 32, nb = r % 32; const float* gn = (64 * kb < HW) ? ARGP(norm_fox) : (ARGP(norm_sb) - HW); transpose_item(ARGP(w_out), DM, Wout_t, DM, 64 * kb, 32 * nb, 32 * nb, gn, scr, lane); continue; } r -= I_OUT;
            if (r < I_XKV) { const int kb = r / 64, nb = r % 64; transpose_item(ARGP(w_xkv), 2 * DM, Wxkv_t, DM, 64 * kb, 32 * nb, 32 * nb, ARGP(norm_mem), scr, lane); continue; } r -= I_XKV;
            if (r < I_XO) { const int kb = r / 32, nb = r % 32; transpose_item(ARGP(w_xo), DM, Wxo_t, DM, 64 * kb, 32 * nb, 32 * nb, nullptr, scr, lane); continue; } r -= I_XO;
            if (r < I_G + I_U) { const int up = r >= I_G; const int q = up ? r - I_G : r; const int e = q / 128, kb = (q % 128) / 8, nb = q % 8; const int n0 = 32 * nb;
                const float* W = (up ? ARGP(w_up) : ARGP(w_gate)) + (size_t)e * DM * DFF;
                transpose_item8(W, DFF, (unsigned char*)Wgu_t + (size_t)e * 512 * DM, DM, 64 * kb, n0, 256 * (n0 / 128) + (n0 % 128) + (up ? 128 : 0), ARGP(norm_ffn), WGU_SCALE, scr, lane); continue; } r -= I_G + I_U;
            if (r < I_D) { const int e = r / 128, kb = (r % 128) / 32, nb = r % 32; transpose_item8(ARGP(w_down) + (size_t)e * DFF * DM, DM, (unsigned char*)Wd_t + (size_t)e * DM * DFF, DFF, 64 * kb, 32 * nb, 32 * nb, nullptr, WD_SCALE, scr, lane); continue; } r -= I_D;
            { const int k = r; const float gk = ARGP(norm_xattn)[k]; const f32x4* src = (const f32x4*)(ARGP(w_xq) + (size_t)k * DM) + lane; u32x2* dst = (u32x2*)(Wxq_n + (size_t)k * DM) + lane;
#pragma unroll
              for (int j = 0; j < 4; ++j) { const f32x4 v = src[64 * j] * gk; u32x2 w; w.x = cvt_pk_bf16(v[0], v[1]); w.y = cvt_pk_bf16(v[2], v[3]); dst[64 * j] = w; } }
        }
        __syncthreads();
        const float* xin = ARGP(x); const float* memin = ARGP(mem); const float* bfg = ARGP(b_forget);
        constexpr int TOT = M + MEMROWS;
#define P0_LOAD(vv, rw) do { if ((rw) < TOT) { const bool im_ = (rw) >= M; const f32x4* xr_ = (const f32x4*)((im_ ? memin : xin) + (size_t)(im_ ? (rw) - M : (rw)) * DM) + lane; \
        _Pragma("unroll") for (int j = 0; j < 4; ++j) vv[j] = __builtin_nontemporal_load(xr_ + 64 * j); } } while (0)
#define P0_ROW(vv, rw) do { const int row_ = (rw); const bool is_mem = row_ >= M; const int r = is_mem ? row_ - M : row_; float s = 0.f; \
        _Pragma("unroll") for (int j = 0; j < 4; ++j) s += (vv[j][0] * vv[j][0] + vv[j][1] * vv[j][1]) + (vv[j][2] * vv[j][2] + vv[j][3] * vv[j][3]); \
        const float rinv = rsqrtf(wave_sum(s) * (1.0f / DM) + EPS); \
        u32x2* o8 = (u32x2*)((is_mem ? MEMB : XB) + (size_t)r * DM) + lane; \
        _Pragma("unroll") for (int j = 0; j < 4; ++j) { u32x2 w; w.x = cvt_pk_bf16(vv[j][0], vv[j][1]); w.y = cvt_pk_bf16(vv[j][2], vv[j][3]); o8[64 * j] = w; } \
        if (is_mem) { if (lane == 0) RMEM[r] = rinv; } \
        else { float f[8]; \
            _Pragma("unroll") for (int jj = 0; jj < 8; ++jj) { float a = 0.f; \
                _Pragma("unroll") for (int j = 0; j < 4; ++j) { const f32x4 w4 = *(const LAS f32x4*)(wfT + jj * DM + 256 * j + 4 * lane); a += (vv[j][0] * w4[0] + vv[j][1] * w4[1]) + (vv[j][2] * w4[2] + vv[j][3] * w4[3]); } \
                f[jj] = wave_sum(a); } \
            if (lane == 0) RX[r] = rinv; \
            if (lane < 8) { float fl = 0.f; \
                _Pragma("unroll") for (int jj = 0; jj < 8; ++jj) fl = (lane == jj) ? f[jj] : fl; \
                fl = fl * rinv + bfg[lane]; \
                const float ls = fminf(fl, 0.f) - log1pf(expf(-fabsf(fl))); \
                LF[(size_t)r * 8 + lane] = ls * LOG2E; } } } while (0)
        f32x4 va[4], vb[4], vc[4];
        P0_LOAD(va, gw); P0_LOAD(vb, gw + NGW);
        for (int row = gw; row < TOT; row += 3 * NGW) {
            P0_LOAD(vc, row + 2 * NGW); P0_ROW(va, row);
            if (row + NGW < TOT) { P0_LOAD(va, row + 3 * NGW); P0_ROW(vb, row + NGW); }
            if (row + 2 * NGW < TOT) { P0_LOAD(vb, row + 4 * NGW); P0_ROW(vc, row + 2 * NGW); }
        }
#undef P0_LOAD
#undef P0_ROW
    }
    xcd_barrier(bar);
    if (PROBE_HI == 0) t_pb = __builtin_amdgcn_s_memrealtime();

    if (PROBE_LO == 1) t_pa = __builtin_amdgcn_s_memrealtime();
    if (PH(1))
    if (vcu < 32) {
        PHASE_PTRS
        const int b = vcu >> 2, h = (vcu & 3) * 2 + (wave >> 2), seg = wave & 3, s0 = seg * 2048 + lane * 32;
        const float* src = LF + ((size_t)b * SEQ + s0) * 8 + h;
        float p[32];
#pragma unroll
        for (int j = 0; j < 32; ++j) p[j] = src[j * 8];
#pragma unroll
        for (int j = 1; j < 32; ++j) p[j] += p[j - 1];
        float inc = p[31];
#pragma unroll
        for (int o = 1; o < 64; o <<= 1) { const float y = __shfl_up(inc, o); if (lane >= o) inc += y; }
        LAS float* tot = (LAS float*)(lds + EXTRA_OFF);
        if (lane == 63) tot[wave] = inc;
        __syncthreads();
        float off = inc - p[31];
        for (int q = 0; q < 3; ++q) if (q < seg) off += tot[(wave & 4) + q];
        float* dst = CC + ((size_t)b * NH + h) * SEQ + s0; bf16_t* kx = KX + (((size_t)b * NH + h) * SEQ + s0) * 8;
#pragma unroll
        for (int j = 0; j < 32; ++j) { const float x = off + p[j]; dst[j] = x;
            unsigned hm, lo; fox::split3(-x, hm, lo); u32x4 w; w.x = 0x3F803F80u; w.y = 0x3F80u | (hm << 16); w.z = (hm >> 16) | (lo << 16); w.w = 0u;
            *(u32x4*)(kx + j * 8) = w; }
        VM_WAIT(); __syncthreads();
    }
    if (PH(1))
    for (int rep_ = 0; rep_ < REPS(1); ++rep_)
    {
        PHASE_PTRS
        pg8::Gemm g{DM, DM, DM};
        SchedDense S{(const char*)XB, (const char*)Win_t, M / 256, NPROJ / 256, G, bx, (size_t)256 * DM * 2, (size_t)256 * DM * 2, 0, 2};
        LAS float* rst = (LAS float*)(lds + EXTRA_OFF);
#pragma unroll
        for (int q = 0; q < 8; ++q) { const int idx = tid + 512 * q, i = idx >> 8, r = idx & 255; int pm, pn; if (pg8::tile_order(i, G, bx, M / 256, NPROJ / 256, pm, pn)) rst[idx] = RX[pm * 256 + r]; }
        VM_WAIT(); __syncthreads();
        pg8::EpiBf16 E{QKV, HW, RX, QKV_STRIDE, C2, C2, ctl + CW_KN, rst, 1.f, false};
        pg8::gemm_phase<pg8::EpiBf16, SchedDense, true, false>(lds + RING_OFF, g, S, E);
    }
    xcd_barrier(bar);
    if (PROBE_HI == 1) t_pb = __builtin_amdgcn_s_memrealtime();

    if (PROBE_LO == 2) t_pa = __builtin_amdgcn_s_memrealtime();
    if (PH(2))
    {
        PHASE_PTRS
        const bf16_t* QA = QKV; const bf16_t* KA = QKV + QKV_STRIDE; const bf16_t* VA = QKV + 2 * QKV_STRIDE;
        const bf16_t* QBp = QKV + 3 * QKV_STRIDE; const bf16_t* KBp = QKV + 4 * QKV_STRIDE; const bf16_t* VBp = QKV + 5 * QKV_STRIDE;
        bf16_t* OA = OAB; bf16_t* OB = OAB + HW;
        LAS char* shm = (LAS char*)(lds + RING_OFF);
        { pg8::Gemm g{DM, DM, DM};
          SchedDense S2{(const char*)MEMB, (const char*)Wxkv_t, MEMROWS / 256, 2 * DM / 256, G, bx, (size_t)256 * DM * 2, (size_t)256 * DM * 2, 0, 0};
          pg8::EpiBf16 E2{KVM, 2 * DM, RMEM, 0, 1.f, 1.f, nullptr, nullptr, 1.f, false};
          pg8::gemm_phase<pg8::EpiBf16, SchedDense, true, false>(lds + RING_OFF, g, S2, E2);
          VM_WAIT(); __syncthreads(); }
        for (int rep = 0; rep < REP_FOX; ++rep)
        for (int i = 0; i < 8; ++i) { const int bh = (vcu >> 5) * 8 + i, x = vcu & 31, qb = (i & 1) ? 31 - x : x;
            const float kmax = sqrtf(__uint_as_float(ctl[CW_KN + bh * 2]) + __uint_as_float(ctl[CW_KN + bh * 2 + 1])) * 1.01f;
            const int nqb = ((i + 1) & 1) ? 31 - x : x;
            fox::fox_unit<8>(bh, qb, QA, KA, VA, OA, HS + (bh & 7), CC + (size_t)bh * SEQ, KX, kmax, shm, i > 0, i < 7 ? bh + 1 : -1, nqb); }
        { volatile LAS unsigned* qs = MISC + 16;
          unsigned nxt = 0u;
          if (tid == 0) qs[0] = __hip_atomic_fetch_add(ctl + CW_SBQ, 1u, __ATOMIC_RELAXED, __HIP_MEMORY_SCOPE_AGENT);
          __syncthreads();
          unsigned idx = qs[0];
          while (idx < (unsigned)(BATCH * NH * 32 * REP_SB)) {
              __syncthreads();
              if (tid == 0) nxt = __hip_atomic_fetch_add(ctl + CW_SBQ, 1u, __ATOMIC_RELAXED, __HIP_MEMORY_SCOPE_AGENT);
              const int un = (int)(idx % (unsigned)(BATCH * NH * 32)), bh = un >> 5, qb = un & 31;
              sbk::sb_unit(bh >> 3, bh & 7, qb, QBp, KBp, VBp, OB, HS + 8 + (bh & 7), shm);
              if (tid == 0) qs[0] = nxt;
              __syncthreads();
              idx = qs[0];
          } }
    }
    xcd_barrier(bar);
    if (PROBE_HI == 2) t_pb = __builtin_amdgcn_s_memrealtime();

    if (PROBE_LO == 4) t_pa = __builtin_amdgcn_s_memrealtime();
    if (PH(4))
    for (int rep_ = 0; rep_ < REPS(4); ++rep_)
    {
        PHASE_PTRS
        pg8::Gemm g{DM, DM, DM};
        SchedDense S{(const char*)OAB, (const char*)Wout_t, M / 256, DM / 256, G, bx, (size_t)256 * DM * 2, (size_t)256 * DM * 2, 0, 0};
        LAS f32x2* rab = (LAS f32x2*)(lds + EXTRA_OFF);
#pragma unroll
        for (int q = 0; q < 4; ++q) { const int idx = tid + 512 * q, i = idx >> 8, r = idx & 255; int pm, pn;
            if (pg8::tile_order(i, G, bx, M / 256, DM / 256, pm, pn)) { const f32x4* p = (const f32x4*)(HS + (size_t)(pm * 256 + r) * 16); const f32x4 a0 = p[0], a1 = p[1], b0 = p[2], b1 = p[3];
                const float ra = rsqrtf((((a0[0] + a0[1]) + (a0[2] + a0[3])) + ((a1[0] + a1[1]) + (a1[2] + a1[3]))) * (1.0f / HW) + EPS);
                const float rb = rsqrtf((((b0[0] + b0[1]) + (b0[2] + b0[3])) + ((b1[0] + b1[1]) + (b1[2] + b1[3]))) * (1.0f / HW) + EPS);
                rab[idx] = (f32x2){ra / rb, rb}; } }
        VM_WAIT(); __syncthreads();
        pg8::EpiOutProj E{XB, H1B, H1F8, SSQ, rab};
        pg8::gemm_phase<pg8::EpiOutProj, SchedDense, true, false>(lds + RING_OFF, g, S, E);
        pg8::Gemm g2{0, 0, 256};
        SchedGH SG{(const char*)KVM, (const char*)Wxq_n, (const char*)Wxo_t, G, bx};
        EpiGH EG{(unsigned char*)GT, (unsigned char*)HT};
        g2.lda = 2 * DM; g2.ldb = DM; SchedGHk<0> S0{SG}; pg8::gemm_phase<EpiGH, SchedGHk<0>, true, false>(lds + RING_OFF, g2, S0, EG);
        g2.lda = DM; g2.ldb = 2 * DM; SchedGHk<1> S1{SG}; pg8::gemm_phase<EpiGH, SchedGHk<1>, true, false>(lds + RING_OFF, g2, S1, EG);
    }
    xcd_barrier(bar);
    if (PROBE_HI == 4) t_pb = __builtin_amdgcn_s_memrealtime();

    if (PROBE_LO == 5) t_pa = __builtin_amdgcn_s_memrealtime();
    if (PH(5))
    for (int rep_ = 0; rep_ < REPS(5); ++rep_)
    {
        PHASE_PTRS
        pg8::Gemm g{DM, DM, DM};
        SchedDense S{(const char*)H1F8, (const char*)GT, M / 256, DM / 256, G, bx, (size_t)256 * DM, (size_t)256 * DM, (size_t)DM * DM, 0};
        LAS float* r1t = (LAS float*)(lds + EXTRA_OFF + 8192);
#pragma unroll
        for (int q = 0; q < 4; ++q) { const int idx = tid + 512 * q, i = idx >> 8, r = idx & 255; int pm, pn;
            if (pg8::tile_order(i, G, bx, M / 256, DM / 256, pm, pn)) { const f32x4* sp = (const f32x4*)(SSQ + (size_t)(pm * 256 + r) * 16); const f32x4 s0 = sp[0], s1 = sp[1], s2 = sp[2], s3 = sp[3];
                const float tot = ((s0[0] + s0[1]) + (s0[2] + s0[3])) + ((s1[0] + s1[1]) + (s1[2] + s1[3])) + ((s2[0] + s2[1]) + (s2[2] + s2[3])) + ((s3[0] + s3[1]) + (s3[2] + s3[3]));
                r1t[idx] = rsqrtf(tot * (1.0f / DM) + EPS) * XSC; } }
        VM_WAIT(); __syncthreads();
        pg8::EpiSoftmax E{XB, r1t, (LAS float*)(lds + EXTRA_OFF)};
        pg8::gemm_phase<pg8::EpiSoftmax, SchedDense, true, false, true>(lds + RING_OFF, g, S, E);
    }
    xcd_barrier(bar);
    if (PROBE_HI == 5) t_pb = __builtin_amdgcn_s_memrealtime();

    if (PROBE_LO == 6) t_pa = __builtin_amdgcn_s_memrealtime();
    if (PH(6))
    {
        PHASE_PTRS
        pg8::Gemm g{DM, DM, DM};
        SchedDense S{(const char*)XB, (const char*)HT, M / 256, DM / 256, G, bx, (size_t)256 * DM, (size_t)256 * DM, (size_t)DM * DM, 0};
        pg8::EpiResidBf16 E{H1B, H2F8, 1.0f / P_SCALE};
        pg8::gemm_phase<pg8::EpiResidBf16, SchedDense, true, false, true>(lds + RING_OFF, g, S, E);
    }
    xcd_barrier(bar);
    if (PROBE_HI == 6) t_pb = __builtin_amdgcn_s_memrealtime();

    if (PROBE_LO == 7) t_pa = __builtin_amdgcn_s_memrealtime();
    if (PH(7))
    {
        PHASE_PTRS
        LAS bf16_t* wBh = (LAS bf16_t*)(lds + RING_OFF); LAS bf16_t* wBl = wBh + 20 * DM;
        { const f32x4* wg4 = (const f32x4*)ARGP(w_rg); const f32x4* we4 = (const f32x4*)ARGP(w_re); const float* gf = ARGP(norm_ffn);
          f32x4 ga[2], ea[2][4]; float gk[2];
#pragma unroll
          for (int q = 0; q < 2; ++q) { const int k = tid + 512 * q; ga[q] = wg4[k]; gk[q] = gf[k];
#pragma unroll
              for (int c = 0; c < 4; ++c) ea[q][c] = we4[k * 4 + c]; }
#pragma unroll
          for (int q = 0; q < 2; ++q) { const int k = tid + 512 * q;
#pragma unroll
              for (int j = 0; j < 4; ++j) { { const float v = ga[q][j] * gk[q]; const unsigned hi_ = cvt_pk_bf16(v, 0.f) & 0xffffu; wBh[j * DM + k] = (bf16_t)hi_; wBl[j * DM + k] = (bf16_t)(cvt_pk_bf16(v - __uint_as_float(hi_ << 16), 0.f) & 0xffffu); }
#pragma unroll
                  for (int c = 0; c < 4; ++c) { const float v = ea[q][c][j] * gk[q]; const unsigned hi_ = cvt_pk_bf16(v, 0.f) & 0xffffu; const int col = 4 + 4 * c + j; wBh[col * DM + k] = (bf16_t)hi_; wBl[col * DM + k] = (bf16_t)(cvt_pk_bf16(v - __uint_as_float(hi_ << 16), 0.f) & 0xffffu); } } } }
        LAS int* dec_e = (LAS int*)(lds + RING_OFF + 81920); LAS float* dec_w = (LAS float*)(lds + RING_OFF + 81920 + 2048); LAS int* dec_r = (LAS int*)(lds + RING_OFF + 81920 + 4096);
        LAS int* hist = (LAS int*)(lds + RING_OFF + 81920 + 6144); LAS int* ebase = hist + 16; LAS float* dec_v = (LAS float*)(lds + RING_OFF + 81920 + 8192);
        if (tid < 16) hist[tid] = 0;
        __syncthreads();
        const float brg0 = ARGP(b_rg)[0], brg1 = ARGP(b_rg)[1], brg2 = ARGP(b_rg)[2], brg3 = ARGP(b_rg)[3]; const float* bre = ARGP(b_re);
        const int tok = lane & 31, half = lane >> 5, jcol = tok < 20 ? tok : 19;
        for (int it = 0; it * NGW < M / 32; ++it) {
            const int T = gw + it * NGW; const bool act = T < M / 32; const int r0 = act ? 32 * T : 0;
            const bf16_t* rowp = H1B + (size_t)(r0 + tok) * DM + 512 * half;
            const LAS bf16_t* wph = wBh + jcol * DM + 512 * half; const LAS bf16_t* wpl = wBl + jcol * DM + 512 * half;
            f32x16 ah0 = f32x16{}, ah1 = f32x16{}, al0 = f32x16{}, al1 = f32x16{}; float ssq = 0.f;
#pragma unroll 4
            for (int sidx = 0; sidx < 64; sidx += 2) {
                const u32x4 a0 = *(const u32x4*)(rowp + 8 * sidx), a1 = *(const u32x4*)(rowp + 8 * sidx + 8);
                const bf16x8 wh0 = *(const LAS bf16x8*)(wph + 8 * sidx), wl0 = *(const LAS bf16x8*)(wpl + 8 * sidx), wh1 = *(const LAS bf16x8*)(wph + 8 * sidx + 8), wl1 = *(const LAS bf16x8*)(wpl + 8 * sidx + 8);
                ah0 = MFMA32(wh0, __builtin_bit_cast(bf16x8, a0), ah0); al0 = MFMA32(wl0, __builtin_bit_cast(bf16x8, a0), al0);
                ah1 = MFMA32(wh1, __builtin_bit_cast(bf16x8, a1), ah1); al1 = MFMA32(wl1, __builtin_bit_cast(bf16x8, a1), al1);
                ssq += (bf16lo(a0.x) * bf16lo(a0.x) + bf16hi(a0.x) * bf16hi(a0.x)) + (bf16lo(a0.y) * bf16lo(a0.y) + bf16hi(a0.y) * bf16hi(a0.y)) + (bf16lo(a0.z) * bf16lo(a0.z) + bf16hi(a0.z) * bf16hi(a0.z)) + (bf16lo(a0.w) * bf16lo(a0.w) + bf16hi(a0.w) * bf16hi(a0.w));
                ssq += (bf16lo(a1.x) * bf16lo(a1.x) + bf16hi(a1.x) * bf16hi(a1.x)) + (bf16lo(a1.y) * bf16lo(a1.y) + bf16hi(a1.y) * bf16hi(a1.y)) + (bf16lo(a1.z) * bf16lo(a1.z) + bf16hi(a1.z) * bf16hi(a1.z)) + (bf16lo(a1.w) * bf16lo(a1.w) + bf16hi(a1.w) * bf16hi(a1.w));
            }
            const float rinv = rsqrtf((att::swap_lo(ssq) + att::swap_hi(ssq)) * (1.0f / DM) + EPS);
            float lg[20];
#pragma unroll
            for (int r = 0; r < 12; ++r) { const float c = (ah0[r] + ah1[r]) + (al0[r] + al1[r]); auto rr = __builtin_amdgcn_permlane32_swap(__float_as_uint(c), __float_as_uint(c), false, false);
                const int jl = (r & 3) + 8 * (r >> 2); lg[jl] = __uint_as_float(rr[0]) * rinv; if (r < 8) lg[jl + 4] = __uint_as_float(rr[1]) * rinv; }
            float g0 = lg[0] + brg0, g1 = lg[1] + brg1, g2 = lg[2] + brg2, g3 = lg[3] + brg3;
            int gi = 0; float gm = g0; if (g1 > gm) { gm = g1; gi = 1; } if (g2 > gm) { gm = g2; gi = 2; } if (g3 > gm) { gm = g3; gi = 3; }
            const float gval = 1.0f / (expf(g0 - gm) + expf(g1 - gm) + expf(g2 - gm) + expf(g3 - gm));
            float el[4];
#pragma unroll
            for (int j = 0; j < 4; ++j) { const float e0 = lg[4 + j], e1 = lg[8 + j], e2 = lg[12 + j], e3 = lg[16 + j]; el[j] = ((gi == 0) ? e0 : (gi == 1) ? e1 : (gi == 2) ? e2 : e3) + bre[gi * 4 + j]; }
            int i0 = 0; float m0 = el[0];
#pragma unroll
            for (int j = 1; j < 4; ++j) if (el[j] > m0) { m0 = el[j]; i0 = j; }
            int i1 = -1; float m1 = -3.0e38f;
#pragma unroll
            for (int j = 0; j < 4; ++j) if (j != i0 && el[j] > m1) { m1 = el[j]; i1 = j; }
            const float w0 = 1.0f / (1.0f + expf(m1 - m0)), w1 = 1.0f - w0;
            if (act) { const int e = gi * 4 + (half == 0 ? i0 : i1); const float w = gval * (half == 0 ? w0 : w1);
                const int idx = (wave * 32 + tok) * 2 + half; dec_e[idx] = e; dec_w[idx] = w; dec_v[idx] = rinv; dec_r[idx] = __hip_atomic_fetch_add(hist + e, 1, __ATOMIC_RELAXED, __HIP_MEMORY_SCOPE_WORKGROUP); }
            __syncthreads();
            if (tid < 16) { const int n = hist[tid]; ebase[tid] = n ? (int)__hip_atomic_fetch_add(ctl + CW_CNT + 64 * tid, (unsigned)n, __ATOMIC_RELAXED, __HIP_MEMORY_SCOPE_AGENT) : 0; }
            __syncthreads();
            if (act) { const int row = r0 + (lane >> 1), idx = wave * 64 + lane; const int e = dec_e[idx], pos = ebase[e] + dec_r[idx];
                LIST[(size_t)e * M + pos] = row; R2S[(size_t)e * M + pos] = dec_v[idx]; TOKSLOT[(size_t)row * 2 + (lane & 1)] = (e << 20) | pos; TOKW[(size_t)row * 2 + (lane & 1)] = dec_w[idx]; }
            __syncthreads();
            if (tid < 16) hist[tid] = 0;
            __syncthreads();
        }
    }
    xcd_barrier(bar);
    if (PROBE_HI == 7) t_pb = __builtin_amdgcn_s_memrealtime();

    if (PROBE_LO == 8) t_pa = __builtin_amdgcn_s_memrealtime();
    if (PH(8))
    for (int rep_ = 0; rep_ < REPS(8); ++rep_)
    {
        PHASE_PTRS
        pg8::Gemm g{DM, DM, DM};
        LAS int* tbl = (LAS int*)(lds + EXTRA_OFF + 8192); moe_table(tbl, ctl);
        SchedMoe S; S.A = (const char*)H2F8; S.W = (const char*)Wgu_t; S.list = LIST; S.tbl = tbl; S.G = G; S.c = bx; S.NPN = 2; S.w_exp = (size_t)512 * DM; S.w_tile = (size_t)256 * DM; S.a_tile = 0; S.ocol_w = 128;
        pg8::EpiSwiglu E{HID, R2S, LIST};
        pg8::gemm_phase<pg8::EpiSwiglu, SchedMoe, true, true, true>(lds + RING_OFF, g, S, E);
    }
    xcd_barrier(bar);
    if (PROBE_HI == 8) t_pb = __builtin_amdgcn_s_memrealtime();

    if (PROBE_LO == 9) t_pa = __builtin_amdgcn_s_memrealtime();
    if (PH(9))
    for (int rep_ = 0; rep_ < REPS(9); ++rep_)
    {
        PHASE_PTRS
        pg8::Gemm g{DFF, DFF, DFF};
        LAS int* tbl = (LAS int*)(lds + EXTRA_OFF + 8192);
        SchedMoe S; S.A = (const char*)HID; S.W = (const char*)Wd_t; S.list = LIST; S.tbl = tbl; S.G = G; S.c = bx; S.NPN = 4; S.w_exp = (size_t)DM * DFF; S.w_tile = (size_t)256 * DFF; S.a_tile = (size_t)256 * DFF; S.ocol_w = 256;
        pg8::EpiBf16 E{YB, DM, nullptr, 0, 1.f, 1.f, nullptr, nullptr, 1.0f / WD_SCALE, true};
        pg8::gemm_phase<pg8::EpiBf16, SchedMoe, true, false, true>(lds + RING_OFF, g, S, E);
    }
    xcd_barrier(bar);
    if (PROBE_HI == 9) t_pb = __builtin_amdgcn_s_memrealtime();

    if (PROBE_LO == 10) t_pa = __builtin_amdgcn_s_memrealtime();
    if (PH(10))
    {
        PHASE_PTRS
        const LAS int* tb = (const LAS int*)(lds + EXTRA_OFF + 8192);
        const f32x4* gp = (const f32x4*)ARGP(norm_final) + lane;
        int sl0 = 0, sl1 = 0; float sw0 = 0.f, sw1 = 0.f;
        unsigned ya_n[4], yb_n[4]; u32x2 hh_n[4]; float w0_n = 0.f, w1_n = 0.f;
#define P10_SLOTS(rw) do { sl0 = TOKSLOT[(size_t)(rw) * 2]; sl1 = TOKSLOT[(size_t)(rw) * 2 + 1]; sw0 = TOKW[(size_t)(rw) * 2]; sw1 = TOKW[(size_t)(rw) * 2 + 1]; } while (0)
#define P10_DATA(rw) do { const int r0_ = tb[sl0 >> 20] * 256 + (sl0 & 0xfffff), r1_ = tb[sl1 >> 20] * 256 + (sl1 & 0xfffff); w0_n = sw0; w1_n = sw1; \
        const unsigned* y0_ = (const unsigned*)((const unsigned char*)YB + (size_t)r0_ * DM) + lane; const unsigned* y1_ = (const unsigned*)((const unsigned char*)YB + (size_t)r1_ * DM) + lane; const u32x2* h_ = (const u32x2*)(H1B + (size_t)(rw) * DM) + lane; \
        _Pragma("unroll") for (int j = 0; j < 4; ++j) { ya_n[j] = y0_[64 * j]; yb_n[j] = y1_[64 * j]; hh_n[j] = h_[64 * j]; } } while (0)
        if (gw < M) { P10_SLOTS(gw); P10_DATA(gw); if (gw + NGW < M) P10_SLOTS(gw + NGW); }
        for (int row = gw; row < M; row += NGW) {
            unsigned ya[4], yb[4]; u32x2 hh[4]; const float w0 = w0_n, w1 = w1_n;
#pragma unroll
            for (int j = 0; j < 4; ++j) { ya[j] = ya_n[j]; yb[j] = yb_n[j]; hh[j] = hh_n[j]; }
            if (row + NGW < M) { P10_DATA(row + NGW); if (row + 2 * NGW < M) P10_SLOTS(row + 2 * NGW); }
            f32x4* hr = (f32x4*)(out + (size_t)row * DM) + lane;
            f32x4 v[4]; float s = 0.f;
#pragma unroll
            for (int j = 0; j < 4; ++j) { const u32x2 hx = hh[j]; f32x4 h = {bf16lo(hx.x), bf16hi(hx.x), bf16lo(hx.y), bf16hi(hx.y)};
                const f32x2 a01 = __builtin_amdgcn_cvt_pk_f32_fp8((int)ya[j], false), a23 = __builtin_amdgcn_cvt_pk_f32_fp8((int)ya[j], true), b01 = __builtin_amdgcn_cvt_pk_f32_fp8((int)yb[j], false), b23 = __builtin_amdgcn_cvt_pk_f32_fp8((int)yb[j], true);
                h[0] += w0 * a01[0] + w1 * b01[0]; h[1] += w0 * a01[1] + w1 * b01[1]; h[2] += w0 * a23[0] + w1 * b23[0]; h[3] += w0 * a23[1] + w1 * b23[1];
                v[j] = h; s += (h[0] * h[0] + h[1] * h[1]) + (h[2] * h[2] + h[3] * h[3]); }
            const float rinv = rsqrtf(wave_sum(s) * (1.0f / DM) + EPS);
#pragma unroll
            for (int j = 0; j < 4; ++j) __builtin_nontemporal_store(v[j] * rinv * gp[64 * j], hr + 64 * j);
        }
#undef P10_SLOTS
#undef P10_DATA
    }
    if (PROBE_LO >= 0) {
        if (PROBE_HI == 10) t_pb = __builtin_amdgcn_s_memrealtime();
        if (blockIdx.x == 0 && threadIdx.x == 0) { const unsigned long long t0 = __builtin_amdgcn_s_memrealtime(), span = 2 * (t_pb - t_pa);
            while (__builtin_amdgcn_s_memrealtime() - t0 < span) __builtin_amdgcn_s_sleep(8); }
    }
}

extern "C" void kernel_launch(void* const* d_in, const int* in_sizes, int n_in, void* d_out, int out_size, void* d_ws, size_t ws_size, hipStream_t stream) {
    static int grid = 0;
    if (grid == 0) {
        if (n_in != 22 || in_sizes[0] != M * DM || out_size != M * DM || ws_size < WS_END) { fprintf(stderr, "kernel_launch: unexpected shapes (n_in %d, in0 %d, out %d, ws %zu)\n", n_in, n_in > 0 ? in_sizes[0] : -1, out_size, ws_size); grid = -1; return; }
        int dev = 0, cus = 0, per_cu = 0;
        if (hipGetDevice(&dev) != hipSuccess || hipDeviceGetAttribute(&cus, hipDeviceAttributeMultiprocessorCount, dev) != hipSuccess) { grid = -1; return; }
        if (hipFuncSetAttribute((const void*)hymba_fwd, hipFuncAttributeMaxDynamicSharedMemorySize, LDS_BYTES) != hipSuccess) { fprintf(stderr, "kernel_launch: hipFuncSetAttribute failed\n"); grid = -1; return; }
        if (hipOccupancyMaxActiveBlocksPerMultiprocessor(&per_cu, (const void*)hymba_fwd, NWAVES * 64, LDS_BYTES) != hipSuccess || per_cu < 1) { fprintf(stderr, "kernel_launch: occupancy query reports %d\n", per_cu); }
        (void)hipGetLastError();
        grid = cus;
    }
    if (grid < 0) return;
    (void)hipMemsetAsync((char*)d_ws + WS_CTL, 0, CTL_ZERO_BYTES, stream);
    Args a{};
    const float** p = (const float**)&a;
    for (int i = 0; i < 22; ++i) p[i] = (const float*)d_in[i];
    a.out = (float*)d_out; a.ws = (unsigned char*)d_ws;
    hipLaunchKernelGGL(hymba_fwd, dim3(grid), dim3(NWAVES * 64), LDS_BYTES, stream, a);
}
```

```cpp
#include <hip/hip_runtime.h>
#include <hip/hip_bf16.h>
#include <cstdio>
#include <cstdint>

#define LAS __attribute__((address_space(3)))
#define GAS __attribute__((address_space(1)))
typedef unsigned short bf16_t;
typedef short bf16x8 __attribute__((ext_vector_type(8)));
typedef short s16x4 __attribute__((ext_vector_type(4)));
typedef float f32x4 __attribute__((ext_vector_type(4)));
typedef float f32x2 __attribute__((ext_vector_type(2)));
typedef float f32x16 __attribute__((ext_vector_type(16)));
typedef unsigned u32x4 __attribute__((ext_vector_type(4)));
typedef unsigned u32x2 __attribute__((ext_vector_type(2)));
typedef __bf16 bf16x2_t __attribute__((ext_vector_type(2)));

constexpr int BATCH = 8, SEQ = 8192, DM = 1024, M = BATCH * SEQ;
constexpr int NH = 8, HD = 64, HW = NH * HD;
constexpr int NPROJ = 3 * HW * 2;
constexpr int WIN_LD = NPROJ + NH;
constexpr int NMEM = 256, XH = 4, XD = 256, MEMROWS = BATCH * NMEM;
constexpr int NEXP = 16, DFF = 256;
constexpr float EPS = 1e-6f;
constexpr float LOG2E = 1.4426950408889634f;
constexpr float C2 = 0.125f * LOG2E;
constexpr float XSC = 0.0625f * LOG2E;
constexpr float P_SCALE = 128.0f;
constexpr float WGU_SCALE = 32.0f;
constexpr float WD_SCALE = 16.0f;
constexpr float SB_EXIT = -48.0f;

constexpr size_t MiB = 1u << 20;
constexpr size_t WS_CTL = 0, CTL_ZERO_BYTES = 128 * 1024;
constexpr size_t WS_WIN = 1 * MiB;
constexpr size_t WS_WOUT = 7 * MiB;
constexpr size_t WS_WXQ = 9 * MiB;
constexpr size_t WS_WXKV = 11 * MiB;
constexpr size_t WS_WXO = 15 * MiB;
constexpr size_t WS_WGU = 17 * MiB;
constexpr size_t WS_WD = 33 * MiB;
constexpr size_t WS_RX = 41 * MiB;
constexpr size_t WS_RMEM = WS_RX + 256 * 1024;
constexpr size_t WS_R2 = WS_RX + 512 * 1024;
constexpr size_t WS_LF = 42 * MiB;
constexpr size_t WS_C2 = 44 * MiB;
constexpr size_t WS_SSQ = 46 * MiB;
constexpr size_t WS_TOKSLOT = 50 * MiB;
constexpr size_t WS_TOKW = 51 * MiB;
constexpr size_t WS_LIST = 52 * MiB;
constexpr size_t WS_MEMB = 56 * MiB;
constexpr size_t WS_KVM = 60 * MiB;
constexpr size_t WS_GT = 68 * MiB;
constexpr size_t WS_HT = 84 * MiB;
constexpr size_t WS_KX = 100 * MiB;
constexpr size_t WS_HS = 108 * MiB;
constexpr size_t WS_XB = 128 * MiB;
constexpr size_t WS_QKV = 256 * MiB;
constexpr size_t WS_H1B = 256 * MiB, WS_U2B = 384 * MiB, WS_HID = 512 * MiB;
constexpr size_t WS_H1F8 = 384 * MiB, WS_H2F8 = 448 * MiB;
constexpr size_t WS_O = 640 * MiB;
constexpr size_t WS_Y = 704 * MiB;
constexpr size_t WS_END = 1024 * MiB;
constexpr size_t QKV_STRIDE = (size_t)M * HW;
constexpr int MAXTILES = M * 2 / 256 + NEXP;
static_assert(WS_Y + (size_t)MAXTILES * 256 * 1024 * 2 <= WS_END, "ws map");
static_assert(WS_HID + (size_t)MAXTILES * 256 * 256 * 2 <= WS_O, "ws map");
constexpr int CW_BAR = 4096;
constexpr int CW_SBQ = 20736;
constexpr int CW_KN = 20480;
constexpr int CW_CNT = 16384;

constexpr int RING_OFF = 0, RING_BYTES = 131072;
constexpr int EXTRA_OFF = 131072, EXTRA_BYTES = 16384;
constexpr int MISC_OFF = EXTRA_OFF + EXTRA_BYTES;
constexpr int LDS_BYTES = MISC_OFF + 1024;
constexpr int NWAVES = 8;
#ifndef PHASE_MASK
#define PHASE_MASK 0x7ff
#endif
#define PH(n) ((PHASE_MASK >> (n)) & 1)
#ifndef PROBE_LO
#define PROBE_LO -1
#endif
#ifndef PROBE_HI
#define PROBE_HI -1
#endif
#ifndef REP_MASK
#define REP_MASK 0
#endif
#define REPS(n) (1 + ((REP_MASK >> (n)) & 1))
#ifndef REP_FOX
#define REP_FOX 1
#endif
#ifndef REP_SB
#define REP_SB 1
#endif

__device__ __forceinline__ unsigned cvt_pk_bf16(float lo, float hi) { f32x2 v = {lo, hi}; bf16x2_t b = __builtin_convertvector(v, bf16x2_t); return __builtin_bit_cast(unsigned, b); }
__device__ __forceinline__ unsigned cvt4_fp8(float a, float b, float c, float d) { int w = 0; w = __builtin_amdgcn_cvt_pk_fp8_f32(a, b, w, false); w = __builtin_amdgcn_cvt_pk_fp8_f32(c, d, w, true); return (unsigned)w; }
__device__ __forceinline__ float bf16lo(unsigned u) { return __uint_as_float(u << 16); }
__device__ __forceinline__ float bf16hi(unsigned u) { return __uint_as_float(u & 0xffff0000u); }
#define DPP_ADD(v, CTRL) v += __builtin_bit_cast(float, __builtin_amdgcn_update_dpp(0, __builtin_bit_cast(int, v), CTRL, 0xf, 0xf, true))
__device__ __forceinline__ float wave_sum(float v) {
    DPP_ADD(v, 0xB1); DPP_ADD(v, 0x4E); DPP_ADD(v, 0x141); DPP_ADD(v, 0x140);
    const int iv = __builtin_bit_cast(int, v);
    return (__builtin_bit_cast(float, __builtin_amdgcn_readlane(iv, 0)) + __builtin_bit_cast(float, __builtin_amdgcn_readlane(iv, 16))) +
           (__builtin_bit_cast(float, __builtin_amdgcn_readlane(iv, 32)) + __builtin_bit_cast(float, __builtin_amdgcn_readlane(iv, 48)));
}
#define LDS_WAIT() asm volatile("s_waitcnt lgkmcnt(0)" ::: "memory")
#define VM_WAIT() asm volatile("s_waitcnt vmcnt(0)" ::: "memory")

namespace pg8 {
constexpr int BM = 256, BK = 64, HALF = 128, HTB = HALF * BK * 2, STAGE_BYTES = 8 * HTB, NXCD = 8, WGM = 8;
__host__ __device__ __forceinline__ int lds_byte(int r, int c) { const int st = (r >> 4) * 2 + (c >> 5), rr = r & 15, cc = c & 31, ob = rr * 64 + cc * 2; return st * 1024 + (ob ^ (((ob >> 9) & 1) << 5)); }
__host__ __device__ __forceinline__ void stage_rc(int b, int& R, int& C) { const int st = b / 1024, sb = b % 1024, swz = sb ^ (((sb >> 9) & 1) << 5); R = (st >> 1) * 16 + swz / 64; C = (st & 1) * 32 + (swz % 64) / 2; }
__host__ __device__ __forceinline__ int perm32(int rho) { const int n = rho >> 4, i = rho & 15; return 8 * (i >> 2) + 4 * n + (i & 3); }

struct Unit { const char* a; const char* b; int orow, ocol, aux; const int* rows; int nvalid; int seq; };
struct Gemm { int lda, ldb, K; };

__device__ __forceinline__ bool tile_order(int i, int G, int c, int nM, int nN, int& pm, int& pn) {
    const int nwg = nM * nN; const long L = (long)i * G + c; if (L >= nwg) return false;
    int wgid = (int)L; { const int q = nwg / NXCD, r = nwg % NXCD, xcd = wgid % NXCD, off = wgid / NXCD; wgid = (xcd < r ? xcd * (q + 1) : r * (q + 1) + (xcd - r) * q) + off; }
    const int nig = WGM * nN, gid = wgid / nig, fm = gid * WGM, gsz = (nM - fm) < WGM ? (nM - fm) : WGM;
    pm = fm + ((wgid % nig) % gsz); pn = (wgid % nig) / gsz; return true;
}

typedef int v8i32 __attribute__((ext_vector_type(8)));
template <class Epi, class Sched, bool ALIGN_EPI, bool GATHER, bool FP8 = false>
__device__ __forceinline__ void gemm_phase(LAS unsigned char* lds, const Gemm g, const Sched& S, const Epi& E) {
    int tid = threadIdx.x; asm volatile("" : "+v"(tid));
    const int wid = __builtin_amdgcn_readfirstlane(tid >> 6), lane = tid & 63, wr = wid >> 2, wc = wid & 3, fr = lane & 15, fq = lane >> 4;
    constexpr int ESZ = FP8 ? 1 : 2;
    const int K = g.K, nt = K / (FP8 ? 2 * BK : BK);
    unsigned voffA[2], voffB[2]; int RA[2], CA[2];
#pragma unroll
    for (int i = 0; i < 2; ++i) { int R, C; stage_rc(tid * 16 + i * 8192, R, C); const int Rb = (R & ~31) + perm32(R & 31);
        RA[i] = R; CA[i] = C; voffA[i] = (unsigned)(R * g.lda * ESZ + C * 2); voffB[i] = (unsigned)(Rb * g.ldb * ESZ + C * 2); }
    const size_t kstep = (size_t)(BK * 2);
    const size_t hstepA = (size_t)HALF * g.lda * ESZ, hstepB = (size_t)HALF * g.ldb * ESZ;
    const unsigned ldsw = (unsigned)wid * 1024u;
    const int aoff = lds_byte(wr * 64 + fr, FP8 ? fq * 16 : fq * 8), boff = lds_byte(wc * 32 + fr, FP8 ? fq * 16 : fq * 8);
    constexpr int KOFF = FP8 ? 16 : 1024;
#define PG8_SA(b, h) (((b) * 2 + (h)) * HTB)
#define PG8_SB(b, h) ((4 + (b) * 2 + (h)) * HTB)
#define PG8_STAGE2(bufoff, gbase, v0, v1) do { \
        __builtin_amdgcn_global_load_lds((const unsigned*)((const char*)(gbase) + (v0)), (LAS unsigned*)(lds + (bufoff) + ldsw), 16, 0, 0); \
        __builtin_amdgcn_global_load_lds((const unsigned*)((const char*)(gbase) + (v1)), (LAS unsigned*)(lds + (bufoff) + ldsw + 8192), 16, 0, 0); } while (0)
#define PG8_STAGEB(bufoff, gbase) PG8_STAGE2(bufoff, gbase, voffB[0], voffB[1])
#define PG8_STAGEA(bufoff, kptr, h, NX) do { if constexpr (GATHER) { const unsigned v0_ = (NX) ? gvn[h][0] : gvc[h][0], v1_ = (NX) ? gvn[h][1] : gvc[h][1]; PG8_STAGE2(bufoff, kptr, v0_, v1_); } \
        else { PG8_STAGE2(bufoff, (kptr) + (h) * hstepA, voffA[0], voffA[1]); } } while (0)
#define PG8_LDA(dst, b, h) do { _Pragma("unroll") for (int m = 0; m < 4; ++m) _Pragma("unroll") for (int k = 0; k < 2; ++k) dst[m][k] = *(const LAS bf16x8*)(lds + PG8_SA(b, h) + aoff + m * 2048 + k * KOFF); } while (0)
#define PG8_LDB(dst, b, h) do { _Pragma("unroll") for (int n = 0; n < 2; ++n) _Pragma("unroll") for (int k = 0; k < 2; ++k) dst[n][k] = *(const LAS bf16x8*)(lds + PG8_SB(b, h) + boff + n * 2048 + k * KOFF); } while (0)
#define PG8_CAT(x) __builtin_shufflevector(__builtin_bit_cast(f32x4, (x)[0]), __builtin_bit_cast(f32x4, (x)[1]), 0, 1, 2, 3, 4, 5, 6, 7)
#define PG8_MMA(ai, bj, At, Bt) do { __builtin_amdgcn_s_setprio(1); _Pragma("unroll") for (int m = 0; m < 4; ++m) _Pragma("unroll") for (int n = 0; n < 2; ++n) { \
        if constexpr (FP8) { acc[ai][bj][m][n] = __builtin_amdgcn_mfma_scale_f32_16x16x128_f8f6f4(__builtin_bit_cast(v8i32, PG8_CAT(Bt[n])), __builtin_bit_cast(v8i32, PG8_CAT(At[m])), acc[ai][bj][m][n], 0, 0, 0, 0x7F7F7F7F, 0, 0x7F7F7F7F); } \
        else { _Pragma("unroll") for (int k = 0; k < 2; ++k) acc[ai][bj][m][n] = __builtin_amdgcn_mfma_f32_16x16x32_bf16(Bt[n][k], At[m][k], acc[ai][bj][m][n], 0, 0, 0); } } \
        _Pragma("unroll") for (int m = 0; m < 4; ++m) _Pragma("unroll") for (int n = 0; n < 2; ++n) asm volatile("" : "+v"(acc[ai][bj][m][n]));     \
        __builtin_amdgcn_s_setprio(0); } while (0)
#define PG8_WAIT_V(n) asm volatile("s_waitcnt vmcnt(" #n ")" ::: "memory")
#define PG8_WAIT_L(n) asm volatile("s_waitcnt lgkmcnt(" #n ")" ::: "memory")
#define PG8_BAR __builtin_amdgcn_s_barrier()
#define PG8_SCHED __builtin_amdgcn_sched_barrier(0)
#define PG8_GATHER_OFFS(dst, u) do { _Pragma("unroll") for (int h_ = 0; h_ < 2; ++h_) _Pragma("unroll") for (int i_ = 0; i_ < 2; ++i_) { const int r_ = h_ * HALF + RA[i_]; \
        const int idx_ = (u).rows[r_ < (u).nvalid ? r_ : 0]; dst[h_][i_] = (unsigned)(idx_ * g.lda * ESZ + CA[i_] * 2); } } while (0)
    Unit cur, nxt; int ui = 0;
    if (!S.next(0, cur)) return;
    cur.seq = 0;
    unsigned gvc[2][2] = {{0u, 0u}, {0u, 0u}}, gvn[2][2] = {{0u, 0u}, {0u, 0u}};
    if constexpr (GATHER) { PG8_GATHER_OFFS(gvc, cur); }
    f32x4 acc[2][2][4][2];
#pragma unroll
    for (int a = 0; a < 2; ++a)
#pragma unroll
        for (int b = 0; b < 2; ++b)
#pragma unroll
            for (int m = 0; m < 4; ++m)
#pragma unroll
                for (int n = 0; n < 2; ++n) acc[a][b][m][n] = (f32x4){0.f, 0.f, 0.f, 0.f};
    bf16x8 At[4][2], B0[2][2], B1[2][2];
    const char* cA = cur.a; const char* cB = cur.b;
    PG8_STAGEB(PG8_SB(0, 0), cB); PG8_STAGEB(PG8_SB(0, 1), cB + hstepB); PG8_STAGEA(PG8_SA(0, 0), cA, 0, false); PG8_STAGEA(PG8_SA(0, 1), cA, 1, false);
    if (wr == 1) PG8_BAR;
    PG8_WAIT_V(2); PG8_BAR;
    PG8_STAGEB(PG8_SB(1, 0), cB + kstep); PG8_STAGEA(PG8_SA(1, 0), cA + kstep, 0, false); PG8_STAGEB(PG8_SB(1, 1), cB + hstepB + kstep);
    PG8_WAIT_V(6); PG8_BAR;
    for (;;) {
        const bool has_next = S.next(ui + 1, nxt); nxt.seq = ui + 1;
        const char* nA = has_next ? nxt.a : cA; const char* nB = has_next ? nxt.b : cB;
        if constexpr (GATHER) { if (has_next) { PG8_GATHER_OFFS(gvn, nxt); } else { gvn[0][0] = gvc[0][0]; gvn[0][1] = gvc[0][1]; gvn[1][0] = gvc[1][0]; gvn[1][1] = gvc[1][1]; } }
#pragma unroll 1
        for (int t = 0; t < nt; t += 2) {
            const bool last = (t == nt - 2);
            const char* a1 = cA + (size_t)(t + 1) * kstep;
            const char* a2 = last ? nA : cA + (size_t)(t + 2) * kstep; const char* b2 = last ? nB : cB + (size_t)(t + 2) * kstep;
            const char* a3 = a2 + kstep; const char* b3 = b2 + kstep;
            PG8_LDB(B0, 0, 0); PG8_LDB(B1, 0, 1); PG8_SCHED; PG8_LDA(At, 0, 0); PG8_STAGEA(PG8_SA(1, 1), a1, 1, false);
            PG8_WAIT_V(8); PG8_WAIT_L(0); PG8_BAR; PG8_MMA(0, 0, At, B0); PG8_MMA(0, 1, At, B1); PG8_BAR; PG8_SCHED;
            PG8_LDA(At, 0, 1); PG8_STAGEB(PG8_SB(0, 0), b2); PG8_STAGEB(PG8_SB(0, 1), b2 + hstepB); PG8_STAGEA(PG8_SA(0, 0), a2, 0, last);
            PG8_WAIT_V(8); PG8_WAIT_L(0); PG8_BAR; PG8_MMA(1, 0, At, B0); PG8_MMA(1, 1, At, B1); PG8_BAR; PG8_SCHED;
            PG8_LDB(B0, 1, 0); PG8_LDB(B1, 1, 1); PG8_SCHED; PG8_LDA(At, 1, 0); PG8_STAGEA(PG8_SA(0, 1), a2, 1, last);
            PG8_WAIT_V(8); PG8_WAIT_L(0); PG8_BAR; PG8_MMA(0, 0, At, B0); PG8_MMA(0, 1, At, B1); PG8_BAR; PG8_SCHED;
            PG8_LDA(At, 1, 1); PG8_STAGEB(PG8_SB(1, 0), b3); PG8_STAGEB(PG8_SB(1, 1), b3 + hstepB); PG8_STAGEA(PG8_SA(1, 0), a3, 0, last);
            PG8_WAIT_V(8); PG8_WAIT_L(0); PG8_BAR; PG8_MMA(1, 0, At, B0); PG8_MMA(1, 1, At, B1); PG8_BAR; PG8_SCHED;
            if constexpr (Epi::HAS_MID) { if (t == (nt >> 1) - 2) { int fr3 = fr, fq3 = fq; asm volatile("" : "+v"(fr3), "+v"(fq3)); E.mid(acc, cur, wr, wc, fr3, fq3); } }
        }
        if constexpr (ALIGN_EPI) { if (wr == 0) PG8_BAR; }
        { int fr2 = fr, fq2 = fq; asm volatile("" : "+v"(fr2), "+v"(fq2));
          E(acc, cur, wr, wc, fr2, fq2); }
        if (!has_next) break;
#pragma unroll
        for (int a = 0; a < 2; ++a)
#pragma unroll
            for (int b = 0; b < 2; ++b)
#pragma unroll
                for (int m = 0; m < 4; ++m)
#pragma unroll
                    for (int n = 0; n < 2; ++n) acc[a][b][m][n] = (f32x4){0.f, 0.f, 0.f, 0.f};
        cur = nxt; cA = nA; cB = nB; ++ui;
        if constexpr (GATHER) { gvc[0][0] = gvn[0][0]; gvc[0][1] = gvn[0][1]; gvc[1][0] = gvn[1][0]; gvc[1][1] = gvn[1][1]; }
        if constexpr (ALIGN_EPI) { if (wr == 1) PG8_BAR; }
    }
    PG8_WAIT_V(0);
    if constexpr (!ALIGN_EPI) { if (wr == 0) PG8_BAR; }
    PG8_BAR;
#undef PG8_SA
#undef PG8_SB
#undef PG8_STAGE2
#undef PG8_STAGEA
#undef PG8_STAGEB
#undef PG8_LDA
#undef PG8_LDB
#undef PG8_MMA
#undef PG8_CAT
#undef PG8_WAIT_V
#undef PG8_WAIT_L
#undef PG8_BAR
#undef PG8_SCHED
#undef PG8_GATHER_OFFS
}

#define EPI_ROW(u, ai, m) ((u).orow + (ai) * HALF + wr * 64 + (m) * 16 + fr)
#define EPI_COL(u, bj) ((u).ocol + (bj) * HALF + wc * 32 + 8 * fq)
struct EpiBf16 {
    static constexpr bool HAS_MID = false;
    bf16_t* O; int ldc; const float* rs; size_t stride; float sc0, sc3;
    unsigned* kn;
    const LAS float* rst;
    float mul;
    __device__ __forceinline__ void operator()(const f32x4 (&acc)[2][2][4][2], const Unit& u, int wr, int wc, int fr, int fq) const {
        bf16_t* base = O + (size_t)u.aux * stride;
        const float sc = ((u.aux == 0) ? sc0 : ((u.aux == 3) ? sc3 : 1.f)) * mul;
        float nmax[2] = {0.f, 0.f}; const bool dokn = kn && u.aux == 1;
#pragma unroll
        for (int ai = 0; ai < 2; ++ai)
#pragma unroll
            for (int m = 0; m < 4; ++m) { const int row = EPI_ROW(u, ai, m); const float s = (rst ? rst[u.seq * 256 + ai * HALF + wr * 64 + m * 16 + fr] : (rs ? rs[row] : 1.f)) * sc;
#pragma unroll
                for (int bj = 0; bj < 2; ++bj) { const f32x4 v0 = acc[ai][bj][m][0] * s, v1 = acc[ai][bj][m][1] * s;
                    { u32x4 w; w.x = cvt_pk_bf16(v0[0], v0[1]); w.y = cvt_pk_bf16(v0[2], v0[3]); w.z = cvt_pk_bf16(v1[0], v1[1]); w.w = cvt_pk_bf16(v1[2], v1[3]);
                    __builtin_nontemporal_store(w, (u32x4*)(base + (size_t)row * ldc + EPI_COL(u, bj))); }
                    if (dokn) { float q = (v0[0] * v0[0] + v0[1] * v0[1]) + (v0[2] * v0[2] + v0[3] * v0[3]) + (v1[0] * v1[0] + v1[1] * v1[1]) + (v1[2] * v1[2] + v1[3] * v1[3]);
                        q += __shfl_xor(q, 16); q += __shfl_xor(q, 32); nmax[bj] = fmaxf(nmax[bj], q); } } }
        if (dokn) {
#pragma unroll
            for (int bj = 0; bj < 2; ++bj) { float q = nmax[bj]; q = fmaxf(q, __shfl_xor(q, 1)); q = fmaxf(q, __shfl_xor(q, 2)); q = fmaxf(q, __shfl_xor(q, 4)); q = fmaxf(q, __shfl_xor(q, 8));
                const int head = ((u.ocol + bj * HALF) >> 6) + (wc >> 1), bt = u.orow / SEQ;
                if ((fr | fq) == 0) atomicMax(kn + ((bt * NH + head) * 2 + (wc & 1)), __float_as_uint(q)); }
        }
    }
};
struct EpiY8 {
    static constexpr bool HAS_MID = false;
    unsigned char* Y; float mul;
    __device__ __forceinline__ void operator()(const f32x4 (&acc)[2][2][4][2], const Unit& u, int wr, int wc, int fr, int fq) const {
#pragma unroll
        for (int ai = 0; ai < 2; ++ai)
#pragma unroll
            for (int m = 0; m < 4; ++m) { const int row = EPI_ROW(u, ai, m);
#pragma unroll
                for (int bj = 0; bj < 2; ++bj) { const f32x4 v0 = acc[ai][bj][m][0] * mul, v1 = acc[ai][bj][m][1] * mul;
                    u32x2 w8; w8.x = cvt4_fp8(v0[0], v0[1], v0[2], v0[3]); w8.y = cvt4_fp8(v1[0], v1[1], v1[2], v1[3]); *(u32x2*)(Y + (size_t)row * DM + EPI_COL(u, bj)) = w8; } }
    }
};
struct EpiOutProj {
    static constexpr bool HAS_MID = true;
    const bf16_t* xb; bf16_t* hb; unsigned char* h8; float* ssq; const LAS f32x2* rab;
    __device__ __forceinline__ void mid(f32x4 (&acc)[2][2][4][2], const Unit& u, int wr, int wc, int fr, int fq) const {
#pragma unroll
        for (int ai = 0; ai < 2; ++ai)
#pragma unroll
            for (int m = 0; m < 4; ++m) { const float f = rab[u.seq * 256 + ai * HALF + wr * 64 + m * 16 + fr].x;
#pragma unroll
                for (int bj = 0; bj < 2; ++bj) { acc[ai][bj][m][0] *= f; acc[ai][bj][m][1] *= f; } }
    }
    __device__ __forceinline__ void operator()(const f32x4 (&acc)[2][2][4][2], const Unit& u, int wr, int wc, int fr, int fq) const {
#pragma unroll
        for (int ai = 0; ai < 2; ++ai)
#pragma unroll
            for (int m = 0; m < 4; ++m) { const int row = EPI_ROW(u, ai, m); const float rb = rab[u.seq * 256 + ai * HALF + wr * 64 + m * 16 + fr].y; float q = 0.f;
#pragma unroll
                for (int bj = 0; bj < 2; ++bj) { const size_t off = (size_t)row * DM + EPI_COL(u, bj);
                    const u32x4 xr = __builtin_nontemporal_load((const u32x4*)(xb + off));
                    f32x4 v0 = acc[ai][bj][m][0] * rb, v1 = acc[ai][bj][m][1] * rb;
                    v0[0] += bf16lo(xr.x); v0[1] += bf16hi(xr.x); v0[2] += bf16lo(xr.y); v0[3] += bf16hi(xr.y); v1[0] += bf16lo(xr.z); v1[1] += bf16hi(xr.z); v1[2] += bf16lo(xr.w); v1[3] += bf16hi(xr.w);
                    q += (v0[0] * v0[0] + v0[1] * v0[1]) + (v0[2] * v0[2] + v0[3] * v0[3]) + (v1[0] * v1[0] + v1[1] * v1[1]) + (v1[2] * v1[2] + v1[3] * v1[3]);
                    u32x4 w; w.x = cvt_pk_bf16(v0[0], v0[1]); w.y = cvt_pk_bf16(v0[2], v0[3]); w.z = cvt_pk_bf16(v1[0], v1[1]); w.w = cvt_pk_bf16(v1[2], v1[3]); *(u32x4*)(hb + off) = w;
                    { u32x2 w8; w8.x = cvt4_fp8(v0[0], v0[1], v0[2], v0[3]); w8.y = cvt4_fp8(v1[0], v1[1], v1[2], v1[3]); *(u32x2*)(h8 + off) = w8; } }
                q += __shfl_xor(q, 16); q += __shfl_xor(q, 32); if (fq == 0) ssq[(size_t)row * 16 + (u.ocol >> 8) * 4 + wc] = q; }
    }
};
struct EpiResidBf16 {
    static constexpr bool HAS_MID = false;
    bf16_t* hb; unsigned char* h8; float mul;
    __device__ __forceinline__ void operator()(const f32x4 (&acc)[2][2][4][2], const Unit& u, int wr, int wc, int fr, int fq) const {
#pragma unroll
        for (int ai = 0; ai < 2; ++ai) {
        u32x4 xres[4][2];
#pragma unroll
            for (int m = 0; m < 4; ++m)
#pragma unroll
                for (int bj = 0; bj < 2; ++bj) xres[m][bj] = *(const u32x4*)(hb + (size_t)EPI_ROW(u, ai, m) * DM + EPI_COL(u, bj));
        asm volatile("" ::: "memory");
#pragma unroll
            for (int m = 0; m < 4; ++m) { const int row = EPI_ROW(u, ai, m);
#pragma unroll
                for (int bj = 0; bj < 2; ++bj) { const size_t off = (size_t)row * DM + EPI_COL(u, bj);
                    const u32x4 xr = xres[m][bj];
                    f32x4 v0 = acc[ai][bj][m][0] * mul, v1 = acc[ai][bj][m][1] * mul;
                    v0[0] += bf16lo(xr.x); v0[1] += bf16hi(xr.x); v0[2] += bf16lo(xr.y); v0[3] += bf16hi(xr.y); v1[0] += bf16lo(xr.z); v1[1] += bf16hi(xr.z); v1[2] += bf16lo(xr.w); v1[3] += bf16hi(xr.w);
                    u32x4 w; w.x = cvt_pk_bf16(v0[0], v0[1]); w.y = cvt_pk_bf16(v0[2], v0[3]); w.z = cvt_pk_bf16(v1[0], v1[1]); w.w = cvt_pk_bf16(v1[2], v1[3]); *(u32x4*)(hb + off) = w;
                    if (h8) { u32x2 w8; w8.x = cvt4_fp8(v0[0], v0[1], v0[2], v0[3]); w8.y = cvt4_fp8(v1[0], v1[1], v1[2], v1[3]); *(u32x2*)(h8 + off) = w8; } } }
        asm volatile("" ::: "memory"); }
    }
};
struct EpiSoftmax {
    static constexpr bool HAS_MID = false;
    bf16_t* P; const LAS float* r1t; LAS float* red;
    __device__ __forceinline__ void operator()(f32x4 (&acc)[2][2][4][2], const Unit& u, int wr, int wc, int fr, int fq) const {
#pragma unroll
        for (int ai = 0; ai < 2; ++ai)
#pragma unroll
            for (int m = 0; m < 4; ++m) { const float r1 = r1t[u.seq * 256 + ai * HALF + wr * 64 + m * 16 + fr]; float a = -3.0e38f;
#pragma unroll
                for (int bj = 0; bj < 2; ++bj)
#pragma unroll
                    for (int n = 0; n < 2; ++n) { f32x4 v = acc[ai][bj][m][n] * r1; acc[ai][bj][m][n] = v; a = fmaxf(a, fmaxf(fmaxf(v[0], v[1]), fmaxf(v[2], v[3]))); }
                a = fmaxf(a, __shfl_xor(a, 16)); a = fmaxf(a, __shfl_xor(a, 32));
                if (fq == 0) red[(ai * HALF + wr * 64 + m * 16 + fr) * 4 + wc] = a; asm volatile("" ::: "memory"); }
        LDS_WAIT(); __builtin_amdgcn_s_barrier(); asm volatile("" ::: "memory");
#pragma unroll
        for (int ai = 0; ai < 2; ++ai)
#pragma unroll
            for (int m = 0; m < 4; ++m) { const int rl = ai * HALF + wr * 64 + m * 16 + fr; const f32x4 mm = *(const LAS f32x4*)(red + rl * 4);
                const float a = fmaxf(fmaxf(mm[0], mm[1]), fmaxf(mm[2], mm[3])); float s = 0.f;
#pragma unroll
                for (int bj = 0; bj < 2; ++bj)
#pragma unroll
                    for (int n = 0; n < 2; ++n) { f32x4 v = acc[ai][bj][m][n];
                        v[0] = __builtin_amdgcn_exp2f(v[0] - a); v[1] = __builtin_amdgcn_exp2f(v[1] - a); v[2] = __builtin_amdgcn_exp2f(v[2] - a); v[3] = __builtin_amdgcn_exp2f(v[3] - a);
                        acc[ai][bj][m][n] = v; s += (v[0] + v[1]) + (v[2] + v[3]); }
                s += __shfl_xor(s, 16); s += __shfl_xor(s, 32);
                if (fq == 0) red[1024 + rl * 4 + wc] = s; }
        LDS_WAIT(); __builtin_amdgcn_s_barrier(); asm volatile("" ::: "memory");
#pragma unroll
        for (int ai = 0; ai < 2; ++ai)
#pragma unroll
            for (int m = 0; m < 4; ++m) { const int rl = ai * HALF + wr * 64 + m * 16 + fr; const int row = u.orow + rl; const f32x4 ss = *(const LAS f32x4*)(red + 1024 + rl * 4);
                const float inv = P_SCALE / ((ss[0] + ss[1]) + (ss[2] + ss[3]));
#pragma unroll
                for (int bj = 0; bj < 2; ++bj) { const f32x4 v0 = acc[ai][bj][m][0] * inv, v1 = acc[ai][bj][m][1] * inv;
                    u32x2 w8; w8.x = cvt4_fp8(v0[0], v0[1], v0[2], v0[3]); w8.y = cvt4_fp8(v1[0], v1[1], v1[2], v1[3]);
                    *(u32x2*)((unsigned char*)P + (size_t)row * DM + EPI_COL(u, bj)) = w8; } }
    }
};
struct EpiSwiglu {
    static constexpr bool HAS_MID = false;
    bf16_t* Hd; const float* r2s; const int* listbase;
    __device__ __forceinline__ void operator()(const f32x4 (&acc)[2][2][4][2], const Unit& u, int wr, int wc, int fr, int fq) const {
#pragma unroll
        for (int ai = 0; ai < 2; ++ai)
#pragma unroll
            for (int m = 0; m < 4; ++m) { const int rl = ai * HALF + wr * 64 + m * 16 + fr, row = u.orow + rl; const float rs = r2s[(u.rows - listbase) + (rl < u.nvalid ? rl : 0)] * (1.0f / WGU_SCALE); float h[8];
#pragma unroll
                for (int n = 0; n < 2; ++n)
#pragma unroll
                    for (int e = 0; e < 4; ++e) { const float gt = acc[ai][0][m][n][e] * rs, up = acc[ai][1][m][n][e] * rs;
                        h[n * 4 + e] = gt * __builtin_amdgcn_rcpf(1.0f + __builtin_amdgcn_exp2f(-gt * LOG2E)) * up; }
                u32x2 w; w.x = cvt4_fp8(h[0], h[1], h[2], h[3]); w.y = cvt4_fp8(h[4], h[5], h[6], h[7]);
                *(u32x2*)((unsigned char*)Hd + (size_t)row * DFF + u.ocol + wc * 32 + 8 * fq) = w; }
    }
};
}

namespace att {
constexpr int QB = 256, KVBLK = 64, PITCH = HW, OPITCH = DM;
constexpr int SLOTB = 8192, LDS_K = 0, LDS_V = 2 * SLOTB, LDS_WS = 4 * SLOTB, LDS_OST = LDS_WS + NWAVES * 256, LDS_FLAG = LDS_OST + NWAVES * 4096, LDS_END = LDS_FLAG + 64;
static_assert(LDS_END <= RING_BYTES, "attention LDS");
__device__ __forceinline__ int crow(int r, int hi) { return (r & 3) + 8 * (r >> 2) + 4 * hi; }
__device__ __forceinline__ void glds16(const void* gsrc, unsigned lds_dst) { unsigned keep;
    asm volatile("s_mov_b32 %0, m0\n\ts_mov_b32 m0, %2\n\ts_nop 0\n\tglobal_load_lds_dwordx4 %1, off\n\ts_mov_b32 m0, %0" : "=&s"(keep) : "v"(gsrc), "s"(lds_dst) : "memory"); }
__device__ __forceinline__ void glds16s(const void* sbase, unsigned voff, unsigned lds_dst) { unsigned keep;
    asm volatile("s_mov_b32 %0, m0\n\ts_mov_b32 m0, %3\n\ts_nop 0\n\tglobal_load_lds_dwordx4 %1, %2\n\ts_mov_b32 m0, %0" : "=&s"(keep) : "v"(voff), "s"(sbase), "s"(lds_dst) : "memory"); }
#define ATT_WAIT_BAR0() asm volatile("s_waitcnt vmcnt(0) lgkmcnt(0)\n\ts_barrier" ::: "memory")
#define MFMA32(a, b, c) __builtin_amdgcn_mfma_f32_32x32x16_bf16(a, b, c, 0, 0, 0)
__device__ __forceinline__ void store_row_ssq(u32x4 v, float* dst, int ch) {
    float q = (bf16lo(v.x) * bf16lo(v.x) + bf16hi(v.x) * bf16hi(v.x)) + (bf16lo(v.y) * bf16lo(v.y) + bf16hi(v.y) * bf16hi(v.y)) + (bf16lo(v.z) * bf16lo(v.z) + bf16hi(v.z) * bf16hi(v.z)) + (bf16lo(v.w) * bf16lo(v.w) + bf16hi(v.w) * bf16hi(v.w));
    q += __shfl_xor(q, 1); q += __shfl_xor(q, 2); q += __shfl_xor(q, 4);
    if (ch == 0) *dst = q;
}
__device__ __forceinline__ void qkt(f32x16& p0, f32x16& p1, const LAS char* Kslot, const bf16x8* qr, const f32x16& cin, int r32, int hi) {
    const LAS char* kb = Kslot + hi * 1024 + r32 * 16;
#pragma unroll
    for (int d0 = 0; d0 < 4; ++d0) {
        const bf16x8 b0 = *(const LAS bf16x8*)(kb + d0 * 2048);
        const bf16x8 b1 = *(const LAS bf16x8*)(kb + d0 * 2048 + 512);
        if (d0 == 0) { p0 = MFMA32(b0, qr[0], cin); p1 = MFMA32(b1, qr[0], cin); }
        else { p0 = MFMA32(b0, qr[d0], p0); p1 = MFMA32(b1, qr[d0], p1); } }
}
__device__ __forceinline__ void pv(f32x16* o, int vb, bf16x8 pa0, bf16x8 pa1, bf16x8 pa2, bf16x8 pa3) {
#pragma unroll
    for (int d0 = 0; d0 < 2; ++d0) { s16x4 lo[4], hi[4];
#pragma unroll
        for (int ks = 0; ks < 4; ++ks) {
            asm volatile("ds_read_b64_tr_b16 %0,%1 offset:%c2" : "=&v"(lo[ks]) : "v"(vb), "i"(d0 * 4096 + ks * 1024) : "memory");
            asm volatile("ds_read_b64_tr_b16 %0,%1 offset:%c2" : "=&v"(hi[ks]) : "v"(vb), "i"(d0 * 4096 + ks * 1024 + 512) : "memory"); }
        asm volatile("s_waitcnt lgkmcnt(0)" ::: "memory"); __builtin_amdgcn_sched_barrier(0);
#define PK(k) (bf16x8){lo[k][0], lo[k][1], lo[k][2], lo[k][3], hi[k][0], hi[k][1], hi[k][2], hi[k][3]}
        o[d0] = MFMA32(pa0, PK(0), o[d0]); o[d0] = MFMA32(pa1, PK(1), o[d0]); o[d0] = MFMA32(pa2, PK(2), o[d0]); o[d0] = MFMA32(pa3, PK(3), o[d0]);
#undef PK
    }
}
__device__ __forceinline__ float swap_lo(float x) { auto rr = __builtin_amdgcn_permlane32_swap(__float_as_uint(x), __float_as_uint(x), false, false); return __uint_as_float(rr[0]); }
__device__ __forceinline__ float swap_hi(float x) { auto rr = __builtin_amdgcn_permlane32_swap(__float_as_uint(x), __float_as_uint(x), false, false); return __uint_as_float(rr[1]); }

}


namespace fox {
constexpr int QB = 256, KVBLK = 64, PITCH = HW, OPITCH = DM;
constexpr int NSLOT = 3, SLOTB = 9216;
constexpr int LDS_K = 0, LDS_V = NSLOT * SLOTB, LDS_WS = 2 * NSLOT * SLOTB, LDS_OST = LDS_WS + NWAVES * 256, LDS_CL = LDS_OST + NWAVES * 4096, LDS_VOTE = LDS_CL + 512, LDS_END = LDS_VOTE + 32;
static_assert(LDS_END <= RING_BYTES, "fox LDS");
constexpr float WIN_T = 48.0f;
constexpr float FLOOR = -256.0f;
using att::crow; using att::glds16; using att::glds16s;
typedef __attribute__((address_space(3))) const char* lds_cptr;
typedef short v4i16_t __attribute__((ext_vector_type(4)));
#define SBAR() __builtin_amdgcn_sched_barrier(0)
#define WAIT_BAR(N) asm volatile("s_waitcnt vmcnt(" #N ") lgkmcnt(0)\n\ts_barrier" ::: "memory")
__device__ __forceinline__ s16x4 vtr(lds_cptr p) { return __builtin_bit_cast(s16x4, __builtin_amdgcn_ds_read_tr16_b64_v4i16((__attribute__((address_space(3))) v4i16_t*)p)); }
__device__ __forceinline__ void kload2(bf16x8* kf, lds_cptr kp, int j) { kf[2 * j] = *(const LAS bf16x8*)(kp + j * 2048); kf[2 * j + 1] = *(const LAS bf16x8*)(kp + j * 2048 + 512); }
__device__ __forceinline__ void cmask(f32x16& p0, f32x16& p1, int jb, int qrel, int hi) {
    const float NEG = -INFINITY; const int kb = 64 * jb + 4 * hi;
#pragma unroll
    for (int r = 0; r < 16; ++r) { const int kv = kb + (r & 3) + 8 * (r >> 2); if (kv > qrel) p0[r] = NEG; if (kv + 32 > qrel) p1[r] = NEG; }
}
__device__ __forceinline__ void split3(float x, unsigned& hm, unsigned& lo) {
    const unsigned h = cvt_pk_bf16(x, 0.f) & 0xffffu; const float r1 = x - __uint_as_float(h << 16);
    const unsigned m = cvt_pk_bf16(r1, 0.f) & 0xffffu; const float r2 = r1 - __uint_as_float(m << 16);
    hm = h | (m << 16); lo = cvt_pk_bf16(r2, 0.f) & 0xffffu;
}
__device__ __forceinline__ bf16x8 qx_build(float a, int hi) {
    unsigned hm, lo; split3(a, hm, lo);
    u32x4 w; w.x = hm; w.y = lo | 0x3F800000u; w.z = 0x3F803F80u; w.w = 0u;
    if (hi) { w.x = 0u; w.y = 0u; w.z = 0u; }
    return __builtin_bit_cast(bf16x8, w);
}

template <int THRL> __device__ __forceinline__ void fox_unit(int bh, int qb, const bf16_t* Q, const bf16_t* K, const bf16_t* V, bf16_t* O, float* hs, const float* cb, const bf16_t* KXall, float kmax, LAS char* shm, bool pre, int nbh, int nqb) {
    const bf16_t* KXh = KXall + (size_t)bh * SEQ * 8;
    int tid = threadIdx.x; asm volatile("" : "+v"(tid)); const int lane = tid & 63, r32 = lane & 31, hi = lane >> 5; const int wid = __builtin_amdgcn_readfirstlane(tid >> 6);
    const int b = bh >> 3, h = bh & 7; const long rowbase = (long)b * SEQ; const int q0 = qb * QB;
    const bf16_t* Qw = Q + (rowbase + q0 + wid * 32) * PITCH + h * HD;
    const bf16_t* Kh = K + rowbase * PITCH + h * HD; const bf16_t* Vh = V + rowbase * PITCH + h * HD;
    const unsigned lds0 = (unsigned)(uintptr_t)shm;
    LAS float* wsf = (LAS float*)(shm + LDS_WS) + wid * 64;
    const int NT = (q0 + QB) / KVBLK;
    int NTe = NT;
    LAS float* clt = (LAS float*)(shm + LDS_CL); LAS unsigned* votes = (LAS unsigned*)(shm + LDS_VOTE);
    const float clv = (tid < NT) ? cb[64 * tid + 63] : 0.f;
    const unsigned koff = (unsigned)(lane * PITCH + wid * 8) * 2u, voff = (unsigned)((16 * (wid & 3) + (lane >> 2)) * PITCH + (wid >> 2) * 32 + (lane & 3) * 8) * 2u, xoff = (unsigned)lane * 16u;
    const unsigned kdst = lds0 + LDS_K + wid * 1024, vdst = lds0 + LDS_V + wid * 1024, xdst = lds0 + LDS_K + 8192;
    const bool xl = (lane >> 3) == wid;
#define DMA_KX(Kb, KXb, NTv, p, slot) do { glds16s((Kb) + (long)((NTv) - 1 - (p)) * KVBLK * PITCH, koff, (unsigned)__builtin_amdgcn_readfirstlane(kdst + (slot))); \
        if (xl) glds16s((KXb) + (long)((NTv) - 1 - (p)) * KVBLK * 8, xoff, (unsigned)__builtin_amdgcn_readfirstlane(xdst + (slot))); } while (0)
#define DMA_VX(Vb, NTv, p, slot) glds16s((Vb) + (long)((NTv) - 1 - (p)) * KVBLK * PITCH, voff, (unsigned)__builtin_amdgcn_readfirstlane(vdst + (slot)))
#define DMA_K(p, slot) DMA_KX(Kh, KXh, NT, p, slot)
#define DMA_V(p, slot) DMA_VX(Vh, NT, p, slot)
    bf16x8 kf[10];
    const lds_cptr shm3 = (lds_cptr)shm; const lds_cptr kp0 = shm3 + LDS_K + hi * 1024 + r32 * 16; const lds_cptr kx0 = shm3 + LDS_K + 8192 + r32 * 16;
    const lds_cptr vp0 = shm3 + LDS_V + ((lane >> 4) & 1) * 32 + (lane & 3) * 8 + (4 * hi + ((lane & 15) >> 2)) * 64;
    if (!pre) { DMA_K(0, 0); DMA_V(0, 0); DMA_K(1, SLOTB); }
    bf16x8 qr[4];
#pragma unroll
    for (int d0 = 0; d0 < 4; ++d0) qr[d0] = *(const bf16x8*)(Qw + (long)r32 * PITCH + d0 * 16 + hi * 8);
    const int qrel = wid * 32 + r32;
    const float ct = cb[q0 + qrel];
    float mhat = 0.f, l_reg = 0.f; f32x16 o[2]; o[0] = f32x16{}; o[1] = f32x16{};
    bf16x8 qx = qx_build(ct, hi);
    const f32x16 z16 = f32x16{};
#define CMASK(P0, P1, p) do { const int jb_ = 3 - (p); if (jb_ >= 0) cmask(P0, P1, jb_, qrel, hi); } while (0)
    bool resc = false;
#define RESC() do { if (resc) { asm volatile("s_waitcnt lgkmcnt(0)" ::: "memory"); \
      _Pragma("unroll") for (int d_ = 0; d_ < 2; ++d_) _Pragma("unroll") for (int r = 0; r < 16; ++r) o[d_][r] *= wsf[crow(r, hi)]; } } while (0)
    f32x16 pA0, pA1, pB0, pB1;
    int sl_prev = 0, sl_cur = 0, sl_next = SLOTB;
#define ROT() do { sl_prev = sl_cur; sl_cur = sl_next; sl_next = (sl_next == (NSLOT - 1) * SLOTB) ? 0 : sl_next + SLOTB; } while (0)
    if (!pre) { DMA_K(2, 2 * SLOTB); }
    if (pre) { WAIT_BAR(0); } else WAIT_BAR(5);
    if (tid < NT) clt[tid] = clv;
    float qkb;
    { float q2 = 0.f;
#pragma unroll
      for (int d0 = 0; d0 < 4; ++d0)
#pragma unroll
          for (int j = 0; j < 8; ++j) { const float e = __uint_as_float(((unsigned)(unsigned short)qr[d0][j]) << 16); q2 += e * e; }
      q2 = att::swap_lo(q2) + att::swap_hi(q2); qkb = sqrtf(q2) * kmax + ct + WIN_T; }
    { const LAS char* kb = (const LAS char*)shm + LDS_K + hi * 1024 + r32 * 16; const LAS char* kxb = (const LAS char*)shm + LDS_K + 8192 + r32 * 16;
      pA0 = MFMA32(*(const LAS bf16x8*)(kxb), qx, z16); pA1 = MFMA32(*(const LAS bf16x8*)(kxb + 512), qx, z16);
#pragma unroll
      for (int d0 = 0; d0 < 4; ++d0) { pA0 = MFMA32(*(const LAS bf16x8*)(kb + d0 * 2048), qr[d0], pA0); pA1 = MFMA32(*(const LAS bf16x8*)(kb + d0 * 2048 + 512), qr[d0], pA1); } }
    asm volatile("s_nop 15\n\ts_nop 7" : "+v"(pA0), "+v"(pA1)); CMASK(pA0, pA1, 0);
    { float a = fmaxf(pA0[0], pA1[0]);
#pragma unroll
      for (int r = 1; r < 16; ++r) a = fmaxf(a, fmaxf(pA0[r], pA1[r]));
      a = fmaxf(att::swap_lo(a), att::swap_hi(a));
      const float dl = fmaxf(a, FLOOR); mhat = dl;
#pragma unroll
      for (int r = 0; r < 16; ++r) { pA0[r] = __builtin_amdgcn_exp2f(pA0[r] - dl); pA1[r] = __builtin_amdgcn_exp2f(pA1[r] - dl); }
      qx = qx_build(ct - mhat, hi); asm volatile("" : "+v"(qx)); }
    WAIT_BAR(0);
    DMA_K(3, 0); DMA_V(1, SLOTB);
    ROT();
    kload2(kf, kp0 + sl_cur, 0); kload2(kf, kp0 + sl_cur, 1); kload2(kf, kp0 + sl_cur, 2); kload2(kf, kp0 + sl_cur, 3);
    kf[8] = *(const LAS bf16x8*)(kx0 + sl_cur); kf[9] = *(const LAS bf16x8*)(kx0 + sl_cur + 512);
    WAIT_BAR(3);
    s16x4 vlo[8], vhi[8]; u32x4 pw0, pw1, pw2, pw3;
#define PKW(P, B) cvt_pk_bf16(P[B], P[B + 1])
#define PAF(k) __builtin_bit_cast(bf16x8, pw##k)
#define VFR(i) (bf16x8){vlo[i][0], vlo[i][1], vlo[i][2], vlo[i][3], vhi[i][0], vhi[i][1], vhi[i][2], vhi[i][3]}
#define PIN(x) asm volatile("" : "+v"(x))
#define MX3(a, b, c) __builtin_fmaxf(__builtin_fmaxf((a), (b)), (c))
#define GAPA(MF, A0, A1, A2, A3, W0, W1, PW) do { MF; sacc += A0; sacc += A1; sacc += A2; sacc += A3; PIN(sacc); W0; W1; PIN(PW); SBAR(); } while (0)
#define EX(v) __builtin_amdgcn_exp2f(v)
#define GAPB(MF, X, B) do { MF; X[B] = EX(X[B]); X[B + 1] = EX(X[B + 1]); X[B + 2] = EX(X[B + 2]); X[B + 3] = EX(X[B + 3]); PIN(X); SBAR(); } while (0)
#define VRD(i) do { vlo[i] = vtr(vp_ + (((i) >> 2) * 4096 + ((i) & 3) * 1024)); vhi[i] = vtr(vp_ + (((i) >> 2) * 4096 + ((i) & 3) * 1024 + 512)); } while (0)
#define KRD(G, j) do { if (G) { kload2(kf, kp0 + sl_next, j); SBAR(); } } while (0)
#define KRDX(G) do { if (G) { kf[8] = *(const LAS bf16x8*)(kx0 + sl_next); kf[9] = *(const LAS bf16x8*)(kx0 + sl_next + 512); SBAR(); } } while (0)
#define STEP(C0, C1, P0, P1, t, GK, GV, GL) do { SBAR(); \
    const lds_cptr vp_ = vp0 + sl_prev; \
    C0 = MFMA32(kf[8], qx, z16); C1 = MFMA32(kf[9], qx, z16); SBAR(); \
    VRD(0); SBAR(); float sacc = (P0[0] + P0[1]); \
    GAPA(C0 = MFMA32(kf[0], qr[0], C0), P0[2], P0[3], P0[4], P0[5],     pw0[0] = PKW(P0, 0), pw0[1] = PKW(P0, 2), pw0); \
    VRD(4); SBAR(); GAPA(C1 = MFMA32(kf[1], qr[0], C1), P0[6], P0[7], P0[8], P0[9],     pw0[2] = PKW(P0, 4), pw0[3] = PKW(P0, 6), pw0); \
    VRD(1); SBAR(); GAPA(C0 = MFMA32(kf[2], qr[1], C0),   P0[10], P0[11], P0[12], P0[13], pw1[0] = PKW(P0, 8), pw1[1] = PKW(P0, 10), pw1); \
    VRD(5); SBAR(); GAPA(C1 = MFMA32(kf[3], qr[1], C1),   P0[14], P0[15], P1[0], P1[1],   pw1[2] = PKW(P0, 12), pw1[3] = PKW(P0, 14), pw1); \
    VRD(2); SBAR(); GAPA(C0 = MFMA32(kf[4], qr[2], C0),   P1[2], P1[3], P1[4], P1[5],     pw2[0] = PKW(P1, 0), pw2[1] = PKW(P1, 2), pw2); \
    VRD(6); SBAR(); GAPA(C1 = MFMA32(kf[5], qr[2], C1),   P1[6], P1[7], P1[8], P1[9],     pw2[2] = PKW(P1, 4), pw2[3] = PKW(P1, 6), pw2); \
    VRD(3); SBAR(); GAPA(C0 = MFMA32(kf[6], qr[3], C0),   P1[10], P1[11], P1[12], P1[13], pw3[0] = PKW(P1, 8), pw3[1] = PKW(P1, 10), pw3); \
    VRD(7); SBAR(); GAPA(C1 = MFMA32(kf[7], qr[3], C1),   P1[14], P1[15], 0.f, 0.f,       pw3[2] = PKW(P1, 12), pw3[3] = PKW(P1, 14), pw3); \
    l_reg += sacc; \
    if (GK) { DMA_K((t) + 3, sl_cur); } if (GV) { DMA_V((t) + 1, sl_next); } \
    CMASK(C0, C1, t); \
    { float a = MX3(C0[0], C0[1], C1[0]), b_ = MX3(C0[2], C0[3], C1[1]); a = MX3(a, C1[2], C1[3]); \
      _Pragma("unroll") for (int r = 4; r < 16; r += 4) { a = MX3(a, C0[r], C0[r + 1]); b_ = MX3(b_, C0[r + 2], C0[r + 3]); a = MX3(a, C1[r], C1[r + 1]); b_ = MX3(b_, C1[r + 2], C1[r + 3]); } \
      float rm = __builtin_fmaxf(a, b_); { auto rr = __builtin_amdgcn_permlane32_swap(__float_as_uint(rm), __float_as_uint(rm), false, false); rm = __builtin_fmaxf(__uint_as_float(rr[0]), __uint_as_float(rr[1])); } \
      resc = false; \
      if (__builtin_expect(__any(rm > (float)THRL), 0)) { const float dl = __builtin_fmaxf(rm, 0.f); mhat += dl; \
        _Pragma("unroll") for (int r = 0; r < 16; ++r) { C0[r] -= dl; C1[r] -= dl; } \
        qx = qx_build(ct - mhat, hi); asm volatile("" : "+v"(qx)); \
        const float f = __builtin_amdgcn_exp2f(-dl); l_reg *= f; if (hi == 0) wsf[r32] = f; resc = true; } } \
    SBAR(); \
    GAPB(o[0] = MFMA32(PAF(0), VFR(0), o[0]), C0, 0); \
    KRDX(GL); GAPB(o[1] = MFMA32(PAF(0), VFR(4), o[1]), C0, 4); \
    KRD(GL, 0); GAPB(o[0] = MFMA32(PAF(1), VFR(1), o[0]), C0, 8); \
    KRD(GL, 1); GAPB(o[1] = MFMA32(PAF(1), VFR(5), o[1]), C0, 12); \
    KRD(GL, 2); GAPB(o[0] = MFMA32(PAF(2), VFR(2), o[0]), C1, 0); \
    KRD(GL, 3); GAPB(o[1] = MFMA32(PAF(2), VFR(6), o[1]), C1, 4); \
    GAPB(o[0] = MFMA32(PAF(3), VFR(3), o[0]), C1, 8); \
    GAPB(o[1] = MFMA32(PAF(3), VFR(7), o[1]), C1, 12); \
    } while (0)
#define ENDW(tt) do { if ((tt) + 3 < NTe) { WAIT_BAR(3); } else if ((tt) + 2 < NTe) { WAIT_BAR(1); } else { WAIT_BAR(0); } } while (0)
#define VOTE(u) do { const int ts_ = NT - (u) - 3; bool ok_ = false; if (ts_ >= 0) { ok_ = __all((qkb - mhat) < clt[ts_]); } if (lane == 0) votes[wid] = ok_ ? 1u : 0u; } while (0)
#define TALLY(u) do { const u32x4 va_ = *(const LAS u32x4*)votes, vb_ = *(const LAS u32x4*)(votes + 4); \
        if (__builtin_amdgcn_readfirstlane((va_.x & va_.y & va_.z & va_.w & vb_.x & vb_.y & vb_.z & vb_.w) != 0u)) { if ((u) + 2 < NTe) { NTe = (u) + 2; WAIT_BAR(0); } } } while (0)
    int t = 1;
    for (; t + 1 < NTe && t < 5; t += 2) {
        STEP(pB0, pB1, pA0, pA1, t, (t + 3 < NTe), (t + 1 < NTe), (t + 1 < NTe));       ENDW(t);     RESC(); ROT();
        STEP(pA0, pA1, pB0, pB1, t + 1, (t + 4 < NTe), (t + 2 < NTe), (t + 2 < NTe));   VOTE(t + 1); ENDW(t + 1); TALLY(t + 1); RESC(); ROT();
    }
#undef CMASK
#define CMASK(P0, P1, p) do {} while (0)
    for (; t + 5 < NTe; t += 2) {
        STEP(pB0, pB1, pA0, pA1, t, true, true, true);       WAIT_BAR(3); RESC(); ROT();
        STEP(pA0, pA1, pB0, pB1, t + 1, true, true, true);   VOTE(t + 1); WAIT_BAR(3); TALLY(t + 1); RESC(); ROT();
    }
    for (; t + 1 < NTe; t += 2) {
        STEP(pB0, pB1, pA0, pA1, t, (t + 3 < NTe), (t + 1 < NTe), (t + 1 < NTe));       ENDW(t);     RESC(); ROT();
        STEP(pA0, pA1, pB0, pB1, t + 1, (t + 4 < NTe), (t + 2 < NTe), (t + 2 < NTe));   ENDW(t + 1); RESC(); ROT();
    }
#undef CMASK
#define CMASK(P0, P1, p) do { const int jb_ = 3 - (p); if (jb_ >= 0) cmask(P0, P1, jb_, qrel, hi); } while (0)
    STEP(pB0, pB1, pA0, pA1, NTe - 1, false, false, false); RESC();
    { float sacc = pB0[0] + pB0[1];
#pragma unroll
      for (int r = 2; r < 16; ++r) sacc += pB0[r];
#pragma unroll
      for (int r = 0; r < 16; ++r) sacc += pB1[r];
      l_reg += sacc;
      pw0 = (u32x4){PKW(pB0, 0), PKW(pB0, 2), PKW(pB0, 4), PKW(pB0, 6)}; pw1 = (u32x4){PKW(pB0, 8), PKW(pB0, 10), PKW(pB0, 12), PKW(pB0, 14)};
      pw2 = (u32x4){PKW(pB1, 0), PKW(pB1, 2), PKW(pB1, 4), PKW(pB1, 6)}; pw3 = (u32x4){PKW(pB1, 8), PKW(pB1, 10), PKW(pB1, 12), PKW(pB1, 14)};
      SBAR(); att::pv(o, (int)(unsigned)(uintptr_t)(vp0 + sl_cur), PAF(0), PAF(1), PAF(2), PAF(3)); }
    if (nbh >= 0) { asm volatile("s_waitcnt lgkmcnt(0)\n\ts_barrier" ::: "memory");
        const int NTn = (nqb * QB + QB) / KVBLK; const bf16_t* Kn = K + (long)(nbh >> 3) * SEQ * PITCH + (nbh & 7) * HD; const bf16_t* Vn = V + (long)(nbh >> 3) * SEQ * PITCH + (nbh & 7) * HD; const bf16_t* KXn = KXall + (size_t)nbh * SEQ * 8;
        DMA_KX(Kn, KXn, NTn, 0, 0); DMA_VX(Vn, NTn, 0, 0); DMA_KX(Kn, KXn, NTn, 1, SLOTB); DMA_KX(Kn, KXn, NTn, 2, 2 * SLOTB); }
    l_reg = att::swap_lo(l_reg) + att::swap_hi(l_reg);
    if (hi == 0) wsf[32 + r32] = l_reg; asm volatile("s_waitcnt lgkmcnt(0)" ::: "memory");
    float rli[16];
#pragma unroll
    for (int r = 0; r < 16; ++r) rli[r] = __builtin_amdgcn_rcpf(wsf[32 + crow(r, hi)]);
    bf16_t* Ow = O + (rowbase + q0 + wid * 32) * OPITCH + h * HD;
    { LAS bf16_t* stg = (LAS bf16_t*)(shm + LDS_OST) + wid * 2048;
#pragma unroll
      for (int r = 0; r < 16; ++r) { const int orow = crow(r, hi);
#pragma unroll
        for (int d0 = 0; d0 < 2; ++d0) stg[orow * 64 + d0 * 32 + r32] = (bf16_t)(cvt_pk_bf16(o[d0][r] * rli[r], 0.f) & 0xffffu); }
      asm volatile("s_waitcnt lgkmcnt(0)" ::: "memory");
#pragma unroll
      for (int i = 0; i < 4; ++i) { const int row = i * 8 + (lane >> 3), ch = lane & 7; const u32x4 v = *(const LAS u32x4*)(stg + row * 64 + ch * 8); *(u32x4*)(Ow + (long)row * OPITCH + ch * 8) = v;
        att::store_row_ssq(v, hs + (rowbase + q0 + wid * 32 + row) * 16, ch); } }
    asm volatile("s_waitcnt lgkmcnt(0)\n\ts_barrier" ::: "memory");
#undef DMA_K
#undef DMA_V
#undef DMA_KX
#undef DMA_VX
#undef CMASK
#undef RESC
#undef ROT
#undef PKW
#undef PAF
#undef VFR
#undef PIN
#undef MX3
#undef GAPA
#undef GAPB
#undef EX
#undef VRD
#undef KRD
#undef KRDX
#undef STEP
#undef ENDW
#undef VOTE
#undef TALLY
}
#undef SBAR
#undef WAIT_BAR
}


namespace sbk {
constexpr int QB = 256, KVBLK = 64, PITCH = HW, OPITCH = DM, NBURST = 6, SLOTB = 8192;
constexpr int LDS_K = 0, LDS_V = NBURST * SLOTB, LDS_FLAG = 2 * NBURST * SLOTB, LDS_END = LDS_FLAG + 128;
static_assert(LDS_END <= RING_BYTES, "sb LDS");
using att::crow; using att::glds16s; using att::qkt; using att::pv; using att::swap_lo;
__device__ __forceinline__ void sb_tile(const LAS char* Kslot, int vb, const bf16x8* qr, bf16x8 TD0, bf16x8 TD1, bf16x8 TONE, int jb, int qrel, int r32, int hi, float& R, f32x16* o) {
    f32x16 p0, p1; const f32x16 z16 = f32x16{};
    qkt(p0, p1, Kslot, qr, z16, r32, hi);
    if (jb >= 0) {
#pragma unroll
        for (int r = 0; r < 16; ++r) { const int kv = 64 * jb + crow(r, hi); if (kv >= qrel) p0[r] = -1.0e30f; if (kv + 32 >= qrel) p1[r] = -1.0e30f; } }
    f32x16 l0, l1;
#pragma unroll
    for (int r = 0; r < 16; ++r) {
        l0[r] = -(fmaxf(p0[r], 0.f) + __builtin_amdgcn_logf(1.0f + __builtin_amdgcn_exp2f(-fabsf(p0[r]))));
        l1[r] = -(fmaxf(p1[r], 0.f) + __builtin_amdgcn_logf(1.0f + __builtin_amdgcn_exp2f(-fabsf(p1[r])))); }
    u32x4 lw0 = {cvt_pk_bf16(l0[0], l0[1]), cvt_pk_bf16(l0[2], l0[3]), cvt_pk_bf16(l0[4], l0[5]), cvt_pk_bf16(l0[6], l0[7])};
    u32x4 lw1 = {cvt_pk_bf16(l0[8], l0[9]), cvt_pk_bf16(l0[10], l0[11]), cvt_pk_bf16(l0[12], l0[13]), cvt_pk_bf16(l0[14], l0[15])};
    u32x4 lw2 = {cvt_pk_bf16(l1[0], l1[1]), cvt_pk_bf16(l1[2], l1[3]), cvt_pk_bf16(l1[4], l1[5]), cvt_pk_bf16(l1[6], l1[7])};
    u32x4 lw3 = {cvt_pk_bf16(l1[8], l1[9]), cvt_pk_bf16(l1[10], l1[11]), cvt_pk_bf16(l1[12], l1[13]), cvt_pk_bf16(l1[14], l1[15])};
    f32x16 rt;
#pragma unroll
    for (int r = 0; r < 16; ++r) rt[r] = R;
    f32x16 t0 = MFMA32(TD0, __builtin_bit_cast(bf16x8, lw0), rt); t0 = MFMA32(TD1, __builtin_bit_cast(bf16x8, lw1), t0);
    t0 = MFMA32(TONE, __builtin_bit_cast(bf16x8, lw2), t0); t0 = MFMA32(TONE, __builtin_bit_cast(bf16x8, lw3), t0);
    f32x16 t1 = MFMA32(TD0, __builtin_bit_cast(bf16x8, lw2), rt); t1 = MFMA32(TD1, __builtin_bit_cast(bf16x8, lw3), t1);
#pragma unroll
    for (int r = 0; r < 16; ++r) { p0[r] = __builtin_amdgcn_exp2f(p0[r] + t0[r]); p1[r] = __builtin_amdgcn_exp2f(p1[r] + t1[r]); }
    R = swap_lo(t0[0]);
    u32x4 pw0 = {cvt_pk_bf16(p0[0], p0[1]), cvt_pk_bf16(p0[2], p0[3]), cvt_pk_bf16(p0[4], p0[5]), cvt_pk_bf16(p0[6], p0[7])};
    u32x4 pw1 = {cvt_pk_bf16(p0[8], p0[9]), cvt_pk_bf16(p0[10], p0[11]), cvt_pk_bf16(p0[12], p0[13]), cvt_pk_bf16(p0[14], p0[15])};
    u32x4 pw2 = {cvt_pk_bf16(p1[0], p1[1]), cvt_pk_bf16(p1[2], p1[3]), cvt_pk_bf16(p1[4], p1[5]), cvt_pk_bf16(p1[6], p1[7])};
    u32x4 pw3 = {cvt_pk_bf16(p1[8], p1[9]), cvt_pk_bf16(p1[10], p1[11]), cvt_pk_bf16(p1[12], p1[13]), cvt_pk_bf16(p1[14], p1[15])};
    pv(o, vb, __builtin_bit_cast(bf16x8, pw0), __builtin_bit_cast(bf16x8, pw1), __builtin_bit_cast(bf16x8, pw2), __builtin_bit_cast(bf16x8, pw3));
}
#define SB_WAITBAR(N) asm volatile("s_waitcnt vmcnt(" #N ") lgkmcnt(0)\n\ts_barrier" ::: "memory")
__device__ __forceinline__ void sb_unit(int b, int h, int qb, const bf16_t* Q, const bf16_t* K, const bf16_t* V, bf16_t* O, float* hs, LAS char* shm) {
    int tid = threadIdx.x; asm volatile("" : "+v"(tid)); const int lane = tid & 63, r32 = lane & 31, hi = lane >> 5; const int wid = __builtin_amdgcn_readfirstlane(tid >> 6);
    const long rowbase = (long)b * SEQ; const int q0 = qb * QB;
    const bf16_t* Qw = Q + (rowbase + q0 + wid * 32) * PITCH + h * HD;
    const bf16_t* Kh = K + rowbase * PITCH + h * HD; const bf16_t* Vh = V + rowbase * PITCH + h * HD;
    const unsigned lds0 = (unsigned)(uintptr_t)shm;
    LAS unsigned* flags = (LAS unsigned*)(shm + LDS_FLAG);
    const unsigned koff = (unsigned)(lane * PITCH + wid * 8) * 2u, voff = (unsigned)((16 * (wid & 3) + (lane >> 2)) * PITCH + (wid >> 2) * 32 + (lane & 3) * 8) * 2u;
    const unsigned kdst = lds0 + LDS_K + wid * 1024, vdst = lds0 + LDS_V + wid * 1024;
#define SB_DMA(p, slot) do { glds16s(Kh + (long)(NT - 1 - (p)) * KVBLK * PITCH, koff, (unsigned)__builtin_amdgcn_readfirstlane(kdst + (slot) * SLOTB)); \
        glds16s(Vh + (long)(NT - 1 - (p)) * KVBLK * PITCH, voff, (unsigned)__builtin_amdgcn_readfirstlane(vdst + (slot) * SLOTB)); } while (0)
    const int vb0 = (int)(lds0 + LDS_V) + ((lane >> 4) & 1) * 32 + (lane & 3) * 8 + (4 * hi + ((lane & 15) >> 2)) * 64;
    const int NT = (q0 + QB) / KVBLK, NB = NT < NBURST ? NT : NBURST;
    for (int p = 0; p < NB; ++p) SB_DMA(p, p);
    bf16x8 qr[4];
#pragma unroll
    for (int d0 = 0; d0 < 4; ++d0) qr[d0] = *(const bf16x8*)(Qw + (long)r32 * PITCH + d0 * 16 + hi * 8);
    f32x16 o[2]; o[0] = f32x16{}; o[1] = f32x16{};
    const int qrel = wid * 32 + r32;
    float R = 0.f;
    bf16x8 TD0, TD1, TONE;
#pragma unroll
    for (int j = 0; j < 8; ++j) { const int kvl = 8 * (j >> 2) + 4 * hi + (j & 3); TD0[j] = (kvl >= r32) ? (short)0x3F80 : (short)0; TD1[j] = (16 + kvl >= r32) ? (short)0x3F80 : (short)0; TONE[j] = (short)0x3F80; }
    if (NB > 4) { SB_WAITBAR(4); } else { SB_WAITBAR(0); }
    bool mid_done = (NB <= 4);
    int p = 3 - (wid >> 1);
    for (; p < NB; ++p) {
        if (p >= 4 && !mid_done) { SB_WAITBAR(0); mid_done = true; }
        sb_tile(shm + LDS_K + p * SLOTB, vb0 + p * SLOTB, qr, TD0, TD1, TONE, 3 - p, qrel, r32, hi, R, o);
        if (__all(R < SB_EXIT)) { ++p; break; }
    }
    if (!mid_done) { SB_WAITBAR(0); }
    { const bool dn = __all(R < SB_EXIT) || (p >= NT); if (lane == 0) flags[wid] = dn ? 1u : 0u; }
    SB_WAITBAR(0);
    bool alldone;
    { const u32x4 fa = *(const LAS u32x4*)flags, fb = *(const LAS u32x4*)(flags + 4); alldone = __builtin_amdgcn_readfirstlane((fa.x & fa.y & fa.z & fa.w & fb.x & fb.y & fb.z & fb.w) != 0u); }
    if (!alldone && NB < NT) {
        SB_DMA(NB, 0);
        for (int i = 0; NB + i < NT; ++i) {
            const int pp = NB + i, sl = i & 1;
            SB_WAITBAR(0);
            if (i > 0) { const LAS unsigned* fl = flags + 8 + ((i - 1) & 1) * 8; const u32x4 fa = *(const LAS u32x4*)fl, fb = *(const LAS u32x4*)(fl + 4);
                if (__builtin_amdgcn_readfirstlane((fa.x & fa.y & fa.z & fa.w & fb.x & fb.y & fb.z & fb.w) != 0u)) break; }
            if (pp + 1 < NT) SB_DMA(pp + 1, sl ^ 1);
            if (!__all(R < SB_EXIT)) sb_tile(shm + LDS_K + sl * SLOTB, vb0 + sl * SLOTB, qr, TD0, TD1, TONE, -1, qrel, r32, hi, R, o);
            { const bool dn = __all(R < SB_EXIT); if (lane == 0) flags[8 + (i & 1) * 8 + wid] = dn ? 1u : 0u; }
        }
        SB_WAITBAR(0);
    }
    bf16_t* Ow = O + (rowbase + q0 + wid * 32) * OPITCH + h * HD;
    { LAS bf16_t* stg = (LAS bf16_t*)(shm + LDS_K) + wid * 2048;
#pragma unroll
      for (int r = 0; r < 16; ++r) { const int orow = crow(r, hi);
#pragma unroll
        for (int d0 = 0; d0 < 2; ++d0) stg[orow * 64 + d0 * 32 + r32] = (bf16_t)(cvt_pk_bf16(o[d0][r], 0.f) & 0xffffu); }
      LDS_WAIT();
#pragma unroll
      for (int i = 0; i < 4; ++i) { const int row = i * 8 + (lane >> 3), ch = lane & 7; const u32x4 v = *(const LAS u32x4*)(stg + row * 64 + ch * 8); *(u32x4*)(Ow + (long)row * OPITCH + ch * 8) = v;
        att::store_row_ssq(v, hs + (rowbase + q0 + wid * 32 + row) * 16, ch); } }
    asm volatile("s_waitcnt vmcnt(0) lgkmcnt(0)\n\ts_barrier" ::: "memory");
#undef SB_DMA
}
#undef SB_WAITBAR
}

#define XB_TMO      128
#define XB_XCNT(j)  (256  + 64 * (j))
#define XB_XSUB(j)  (1280 + 64 * (j))
#define XB_XGEN(j)  (2304 + 64 * (j))
#define XB_TOP      3328
#define XB_TOPGEN   3392
#define XCD_BAR_WORDS 3456
#define XB_SPIN_CAP (1u << 18)
__device__ __forceinline__ unsigned xb_ld(unsigned* p)              { return __hip_atomic_load(p, __ATOMIC_RELAXED, __HIP_MEMORY_SCOPE_AGENT); }
__device__ __forceinline__ unsigned xb_add(unsigned* p, unsigned v) { return __hip_atomic_fetch_add(p, v, __ATOMIC_RELAXED, __HIP_MEMORY_SCOPE_AGENT); }
__device__ __forceinline__ unsigned xb_xcc_id() { return (unsigned)__builtin_amdgcn_s_getreg((3 << 11) | 20) & 0xFu; }
#define XB_SPIN(cond, bar) do { unsigned _sp = 0; while (cond) { __builtin_amdgcn_s_sleep(1); \
    if ((++_sp & 255u) == 0u) { if (xb_ld(&(bar)[XB_TMO])) break; if (_sp > XB_SPIN_CAP) { atomicAdd(&(bar)[XB_TMO], 1u); break; } } } } while (0)
struct XcdBarrier { unsigned* bar; unsigned x; volatile LAS unsigned* st; };
__device__ __forceinline__ XcdBarrier xcd_barrier_post(unsigned* bar, volatile LAS unsigned* st) {
    XcdBarrier b; b.bar = bar; b.x = xb_xcc_id(); b.st = st;
    if (threadIdx.x == 0) (void)xb_add(&bar[XB_XCNT(b.x)], 1u);
    return b;
}
__device__ __forceinline__ void xcd_barrier_complete(unsigned* bar, unsigned x, unsigned& nloc, unsigned& nx) {
    const unsigned G = gridDim.x * gridDim.y * gridDim.z;
    unsigned sum, cnt, mine, sp = 0u;
    for (;;) {
        sum = 0u; cnt = 0u; mine = 0u;
#pragma unroll
        for (unsigned j = 0; j < 16; ++j) { const unsigned c = xb_ld(&bar[XB_XCNT(j)]); sum += c; cnt += (c > 0u) ? 1u : 0u; mine = (j == x) ? c : mine; }
        if (sum == G) break;
        __builtin_amdgcn_s_sleep(1);
        if ((++sp & 255u) == 0u) { if (xb_ld(&bar[XB_TMO])) break; if (sp > XB_SPIN_CAP) { atomicAdd(&bar[XB_TMO], 1u); break; } }
    }
    nloc = mine > 0u ? mine : 1u; nx = cnt > 0u ? cnt : 1u;
}
__device__ __forceinline__ void xcd_barrier(const XcdBarrier& b) {
    asm volatile("s_waitcnt vmcnt(0)" ::: "memory");
    __syncthreads();
    if (threadIdx.x == 0) {
        unsigned* bar = b.bar;
        __builtin_amdgcn_s_waitcnt(0);
        unsigned nloc = b.st[0], nx = b.st[1];
        if (nloc == 0u) { xcd_barrier_complete(bar, b.x, nloc, nx); b.st[0] = nloc; b.st[1] = nx; }
        const unsigned old = xb_add(&bar[XB_XSUB(b.x)], 1u);
        const unsigned gen = old / nloc;
        if (old + 1u == (gen + 1u) * nloc) {
            __builtin_amdgcn_fence(__ATOMIC_RELEASE, "agent");
            asm volatile("s_waitcnt vmcnt(0)" ::: "memory");
            const unsigned og = xb_add(&bar[XB_TOP], 1u);
            const unsigned tg = og / nx;
            if (og + 1u == (tg + 1u) * nx) xb_add(&bar[XB_TOPGEN], 1u);
            else XB_SPIN(xb_ld(&bar[XB_TOPGEN]) == tg, bar);
            __builtin_amdgcn_fence(__ATOMIC_ACQUIRE, "agent");
            xb_add(&bar[XB_XGEN(b.x)], 1u);
            asm volatile("s_waitcnt vmcnt(0)" ::: "memory");
        } else {
            XB_SPIN(xb_ld(&bar[XB_XGEN(b.x)]) == gen, bar);
            __builtin_amdgcn_fence(__ATOMIC_ACQUIRE, "agent");
            asm volatile("s_waitcnt vmcnt(0)" ::: "memory");
        }
    }
    __syncthreads();
}

__device__ __forceinline__ const void* ldp(const volatile LAS unsigned* tab, int i) {
    const unsigned lo = __builtin_amdgcn_readfirstlane(tab[2 * i]), hi = __builtin_amdgcn_readfirstlane(tab[2 * i + 1]);
    return (const void*)(const GAS void*)(((unsigned long long)hi << 32) | lo);
}
struct Args {
    const float* x; const float* mem; const float* norm_mix; const float* w_in; const float* b_forget; const float* norm_fox; const float* norm_sb; const float* w_out;
    const float* norm_xattn; const float* norm_mem; const float* w_xq; const float* w_xkv; const float* w_xo; const float* norm_ffn;
    const float* w_rg; const float* b_rg; const float* w_re; const float* b_re; const float* w_gate; const float* w_up; const float* w_down; const float* norm_final;
    float* out; unsigned char* ws;
};

__device__ __forceinline__ void transpose_item(const float* W, int ldw, bf16_t* WT, int ldo, int k0, int n0, int dst_row0, const float* gain, LAS float* scr, int lane) {
    float tv[32], tg[32];
#pragma unroll
    for (int i = 0; i < 32; ++i) { const int kk = 2 * i + (lane >> 5); tv[i] = __builtin_nontemporal_load(W + (size_t)(k0 + kk) * ldw + n0 + (lane & 31)); tg[i] = gain ? gain[k0 + kk] : 1.f; }
#pragma unroll
    for (int i = 0; i < 32; ++i) { const int kk = 2 * i + (lane >> 5); scr[kk * 33 + (lane & 31)] = tv[i] * tg[i]; }
    LDS_WAIT(); asm volatile("" ::: "memory");
    const int c = lane & 7;
#pragma unroll
    for (int j = 0; j < 4; ++j) { const int n = (lane >> 3) + 8 * j; const LAS float* s = scr + (8 * c) * 33 + n;
        u32x4 o; o.x = cvt_pk_bf16(s[0 * 33], s[1 * 33]); o.y = cvt_pk_bf16(s[2 * 33], s[3 * 33]); o.z = cvt_pk_bf16(s[4 * 33], s[5 * 33]); o.w = cvt_pk_bf16(s[6 * 33], s[7 * 33]);
        *(u32x4*)(WT + (size_t)(dst_row0 + n) * ldo + k0 + 8 * c) = o; }
    LDS_WAIT(); asm volatile("" ::: "memory");
}

__device__ __forceinline__ void transpose_item8(const float* W, int ldw, unsigned char* WT, int ldo, int k0, int n0, int dst_row0, const float* gain, float scale, LAS float* scr, int lane) {
    float tv[32], tg[32];
#pragma unroll
    for (int i = 0; i < 32; ++i) { const int kk = 2 * i + (lane >> 5); tv[i] = __builtin_nontemporal_load(W + (size_t)(k0 + kk) * ldw + n0 + (lane & 31)); tg[i] = gain ? gain[k0 + kk] : 1.f; }
#pragma unroll
    for (int i = 0; i < 32; ++i) { const int kk = 2 * i + (lane >> 5); scr[kk * 33 + (lane & 31)] = tv[i] * tg[i] * scale; }
    LDS_WAIT(); asm volatile("" ::: "memory");
    const int c = lane & 7;
#pragma unroll
    for (int j = 0; j < 4; ++j) { const int n = (lane >> 3) + 8 * j; const LAS float* s = scr + (8 * c) * 33 + n;
        u32x2 o; o.x = cvt4_fp8(s[0 * 33], s[1 * 33], s[2 * 33], s[3 * 33]); o.y = cvt4_fp8(s[4 * 33], s[5 * 33], s[6 * 33], s[7 * 33]);
        *(u32x2*)(WT + (size_t)(dst_row0 + n) * ldo + k0 + 8 * c) = o; }
    LDS_WAIT(); asm volatile("" ::: "memory");
}

struct SchedDense {
    const char* A; const char* Bt; int nM, nN, G, c; size_t a_tile, b_tile, b_batch; int split_tiles;
    __device__ __forceinline__ bool next(int i, pg8::Unit& u) const {
        int pm, pn; if (!pg8::tile_order(i, G, c, nM, nN, pm, pn)) return false;
        u.a = A + (size_t)pm * a_tile; u.b = Bt + (size_t)pn * b_tile + (size_t)(pm >> 5) * b_batch; u.orow = pm * 256;
        if (split_tiles) { u.aux = pn / split_tiles; u.ocol = (pn % split_tiles) * 256; } else { u.aux = 1; u.ocol = pn * 256; }
        u.rows = nullptr; u.nvalid = 256; return true;
    }
};
struct SchedGH {
    const char* KVm; const char* Wxq; const char* Wxo; int G, c;
    __device__ __forceinline__ bool next(int i, pg8::Unit& u) const {
        const int L = i * G + c; if (L >= 256) return false;
        const int kind = L >> 7, r = L & 127, bh = r >> 2, j = r & 3, b = bh >> 2, h = bh & 3;
        if (kind == 0) { u.a = KVm + ((size_t)(b * 256) * 2048 + h * 256) * 2; u.b = Wxq + ((size_t)(256 * j) * 1024 + h * 256) * 2; u.orow = b * 1024 + h * 256; u.ocol = 256 * j; u.aux = 1; }
        else { u.a = Wxo + ((size_t)(256 * j) * 1024 + h * 256) * 2; u.b = KVm + ((size_t)(b * 256) * 2048 + 1024 + h * 256) * 2; u.orow = b * 1024 + 256 * j; u.ocol = h * 256; u.aux = 2; }
        u.rows = nullptr; u.nvalid = 256; return true;
    }
};
template <int KIND> struct SchedGHk { SchedGH s; __device__ __forceinline__ bool next(int i, pg8::Unit& u) const { const int c2 = (s.G >= 256) ? s.c - 128 * KIND : s.c; if (c2 < 0) return false; const int L = i * s.G + c2; if (L >= 128) return false; SchedGH t = s; t.G = 1; t.c = 0; return t.next(128 * KIND + L, u); } };
struct EpiGH { static constexpr bool HAS_MID = false; unsigned char* GTp; unsigned char* HTp;
    __device__ __forceinline__ void operator()(const f32x4 (&acc)[2][2][4][2], const pg8::Unit& u, int wr, int wc, int fr, int fq) const {
        unsigned char* base = u.aux == 1 ? GTp : HTp;
#pragma unroll
        for (int ai = 0; ai < 2; ++ai)
#pragma unroll
            for (int m = 0; m < 4; ++m) { const int row = u.orow + ai * pg8::HALF + wr * 64 + m * 16 + fr;
#pragma unroll
                for (int bj = 0; bj < 2; ++bj) { const f32x4 v0 = acc[ai][bj][m][0], v1 = acc[ai][bj][m][1];
                    u32x2 w8; w8.x = cvt4_fp8(v0[0], v0[1], v0[2], v0[3]); w8.y = cvt4_fp8(v1[0], v1[1], v1[2], v1[3]);
                    *(u32x2*)(base + (size_t)row * DM + u.ocol + bj * pg8::HALF + wc * 32 + 8 * fq) = w8; } }
    } };
struct SchedMoe {
    const char* A; const char* W; const int* list; const LAS int* tbl; int G, c, NPN; size_t w_exp, w_tile, a_tile; int ocol_w;
    __device__ __forceinline__ bool next(int i, pg8::Unit& u) const {
        const int L = i * G + c; const int tl = L / NPN, pn = L % NPN;
        if (tl >= __builtin_amdgcn_readfirstlane(tbl[16])) return false;
        int e = 0;
#pragma unroll 1
        for (int x = 1; x < NEXP; ++x) { if (tl >= __builtin_amdgcn_readfirstlane(tbl[x])) e = x; }
        const int j = tl - __builtin_amdgcn_readfirstlane(tbl[e]), n = __builtin_amdgcn_readfirstlane(tbl[32 + e]) - 256 * j;
        u.a = A + (size_t)tl * a_tile; u.b = W + (size_t)e * w_exp + (size_t)pn * w_tile; u.orow = tl * 256; u.ocol = pn * ocol_w; u.aux = 1;
        u.rows = list + (size_t)e * M + 256 * j; u.nvalid = n < 256 ? n : 256; return true;
    }
};
__device__ __forceinline__ void moe_table(LAS int* tbl, const unsigned* ctl) {
    if (threadIdx.x == 0) { int base = 0; for (int e = 0; e < NEXP; ++e) { const int n = (int)ctl[CW_CNT + 64 * e]; tbl[e] = base; tbl[32 + e] = n; base += (n + 255) >> 8; } tbl[16] = base; }
    __syncthreads();
}

__global__ void __launch_bounds__(NWAVES * 64, 2) hymba_fwd(Args args) {
    extern __shared__ __attribute__((aligned(16))) unsigned char lds_raw[];
    LAS unsigned char* lds = (LAS unsigned char*)lds_raw;
    volatile LAS unsigned* MISC = (volatile LAS unsigned*)(lds + MISC_OFF);
    const int tid0 = threadIdx.x; const int wave = __builtin_amdgcn_readfirstlane(tid0 >> 6);
    const int G = gridDim.x; const int bx = blockIdx.x; const int vcu = (G % 8 == 0) ? (bx % 8) * (G / 8) + bx / 8 : bx;
    volatile LAS unsigned* ATAB = (volatile LAS unsigned*)(lds + MISC_OFF + 512);
    for (int u = tid0; u < 256; u += NWAVES * 64) ((LAS unsigned*)(lds + MISC_OFF))[u] = 0u;
    __syncthreads();
    if (tid0 == 0) { const float* const* ap = (const float* const*)&args;
#pragma unroll
        for (int i = 0; i < 24; ++i) { const unsigned long long v = (unsigned long long)ap[i]; ATAB[2 * i] = (unsigned)v; ATAB[2 * i + 1] = (unsigned)(v >> 32); } }
    __syncthreads();
#define ARGP(name) ((const float*)ldp(ATAB, (int)(offsetof(Args, name) / 8)))
#define PHASE_PTRS \
    int tid = threadIdx.x; asm volatile("" : "+v"(tid)); const int lane = tid & 63; (void)lane; \
    unsigned char* const ws = (unsigned char*)ldp(ATAB, 23); float* const out = (float*)ldp(ATAB, 22); unsigned* const ctl = (unsigned*)(ws + WS_CTL); (void)out; (void)ctl; \
    bf16_t* const Win_t = (bf16_t*)(ws + WS_WIN); bf16_t* const Wout_t = (bf16_t*)(ws + WS_WOUT); bf16_t* const Wxq_n = (bf16_t*)(ws + WS_WXQ); bf16_t* const Wxkv_t = (bf16_t*)(ws + WS_WXKV); \
    bf16_t* const Wxo_t = (bf16_t*)(ws + WS_WXO); bf16_t* const Wgu_t = (bf16_t*)(ws + WS_WGU); bf16_t* const Wd_t = (bf16_t*)(ws + WS_WD); \
    float* const RX = (float*)(ws + WS_RX); float* const RMEM = (float*)(ws + WS_RMEM); float* const LF = (float*)(ws + WS_LF); float* const CC = (float*)(ws + WS_C2); float* const SSQ = (float*)(ws + WS_SSQ); \
    int* const TOKSLOT = (int*)(ws + WS_TOKSLOT); float* const TOKW = (float*)(ws + WS_TOKW); int* const LIST = (int*)(ws + WS_LIST); \
    bf16_t* const MEMB = (bf16_t*)(ws + WS_MEMB); bf16_t* const KVM = (bf16_t*)(ws + WS_KVM); bf16_t* const GT = (bf16_t*)(ws + WS_GT); bf16_t* const HT = (bf16_t*)(ws + WS_HT); \
    bf16_t* const XB = (bf16_t*)(ws + WS_XB); bf16_t* const QKV = (bf16_t*)(ws + WS_QKV); bf16_t* const H1B = (bf16_t*)(ws + WS_H1B); bf16_t* const U2B = (bf16_t*)(ws + WS_U2B); bf16_t* const HID = (bf16_t*)(ws + WS_HID); \
    bf16_t* const OAB = (bf16_t*)(ws + WS_O); bf16_t* const YB = (bf16_t*)(ws + WS_Y); bf16_t* const KX = (bf16_t*)(ws + WS_KX); (void)KX; float* const HS = (float*)(ws + WS_HS); (void)HS; float* const R2S = (float*)(ws + WS_SSQ); (void)R2S; unsigned char* const H1F8 = ws + WS_H1F8; (void)H1F8; unsigned char* const H2F8 = ws + WS_H2F8; (void)H2F8; \
    (void)Win_t; (void)Wout_t; (void)Wxq_n; (void)Wxkv_t; (void)Wxo_t; (void)Wgu_t; (void)Wd_t; (void)RX; (void)RMEM; (void)LF; (void)CC; (void)SSQ; (void)TOKSLOT; (void)TOKW; (void)LIST; \
    (void)MEMB; (void)KVM; (void)GT; (void)HT; (void)XB; (void)QKV; (void)H1B; (void)U2B; (void)HID; (void)OAB; (void)YB;
    XcdBarrier bar;
    { unsigned char* const ws0 = (unsigned char*)ldp(ATAB, 23); bar = xcd_barrier_post((unsigned*)(ws0 + WS_CTL) + CW_BAR, MISC + 8); }
    const int gw = vcu * NWAVES + wave, NGW = G * NWAVES;
    unsigned long long t_pa = 0, t_pb = 0; (void)t_pa; (void)t_pb;


    if (PROBE_LO == 0) t_pa = __builtin_amdgcn_s_memrealtime();
    if (PH(0))
    for (int rep_ = 0; rep_ < REPS(0); ++rep_)
    {
        PHASE_PTRS
        LAS float* wfT = (LAS float*)(lds + RING_OFF);
        LAS float* scr = (LAS float*)(lds + RING_OFF + 32768 + wave * 8448);
        { const float* win = ARGP(w_in); const float* gmix = ARGP(norm_mix);
          f32x4 fa[2], fb[2]; float gk[2];
#pragma unroll
          for (int q = 0; q < 2; ++q) { const int k = tid + 512 * q; gk[q] = gmix[k]; fa[q] = *(const f32x4*)(win + (size_t)k * WIN_LD + NPROJ); fb[q] = *(const f32x4*)(win + (size_t)k * WIN_LD + NPROJ + 4); }
#pragma unroll
          for (int q = 0; q < 2; ++q) { const int k = tid + 512 * q;
#pragma unroll
              for (int j = 0; j < 4; ++j) { wfT[j * DM + k] = fa[q][j] * gk[q]; wfT[(4 + j) * DM + k] = fb[q][j] * gk[q]; } } }
        constexpr int I_IN = 16 * 96, I_OUT = 16 * 32, I_XKV = 16 * 64, I_XO = 16 * 32, I_G = 16 * 16 * 8, I_U = I_G, I_D = 16 * 4 * 32, I_XQ = 1024;
        constexpr int NITEMS = I_IN + I_OUT + I_XKV + I_XO + I_G + I_U + I_D + I_XQ;
        for (int it = gw; it < NITEMS; it += NGW) {
            int r = it;
            if (r < I_IN) { const int kb = r / 96, nb = r % 96; transpose_item(ARGP(w_in), WIN_LD, Win_t, DM, 64 * kb, 32 * nb, 32 * nb, ARGP(norm_mix), scr, lane); continue; } r -= I_IN;
            if (r < I_OUT) { const int kb = r / 32, nb = r % 32; const float* gn = (64 * kb < HW) ? ARGP(norm_fox) : (ARGP(norm_sb) - HW); transpose_item(ARGP(w_out), DM, Wout_t, DM, 64 * kb, 32 * nb, 32 * nb, gn, scr, lane); continue; } r -= I_OUT;
            if (r < I_XKV) { const int kb = r / 64, nb = r % 64; transpose_item(ARGP(w_xkv), 2 * DM, Wxkv_t, DM, 64 * kb, 32 * nb, 32 * nb, ARGP(norm_mem), scr, lane); continue; } r -= I_XKV;
            if (r < I_XO) { const int kb = r / 32, nb = r % 32; transpose_item(ARGP(w_xo), DM, Wxo_t, DM, 64 * kb, 32 * nb, 32 * nb, nullptr, scr, lane); continue; } r -= I_XO;
            if (r < I_G + I_U) { const int up = r >= I_G; const int q = up ? r - I_G : r; const int e = q / 128, kb = (q % 128) / 8, nb = q % 8; const int n0 = 32 * nb;
                const float* W = (up ? ARGP(w_up) : ARGP(w_gate)) + (size_t)e * DM * DFF;
                transpose_item8(W, DFF, (unsigned char*)Wgu_t + (size_t)e * 512 * DM, DM, 64 * kb, n0, 256 * (n0 / 128) + (n0 % 128) + (up ? 128 : 0), ARGP(norm_ffn), WGU_SCALE, scr, lane); continue; } r -= I_G + I_U;
            if (r < I_D) { const int e = r / 128, kb = (r % 128) / 32, nb = r % 32; transpose_item8(ARGP(w_down) + (size_t)e * DFF * DM, DM, (unsigned char*)Wd_t + (size_t)e * DM * DFF, DFF, 64 * kb, 32 * nb, 32 * nb, nullptr, WD_SCALE, scr, lane); continue; } r -= I_D;
            { const int k = r; const float gk = ARGP(norm_xattn)[k]; const f32x4* src = (const f32x4*)(ARGP(w_xq) + (size_t)k * DM) + lane; u32x2* dst = (u32x2*)(Wxq_n + (size_t)k * DM) + lane;
#pragma unroll
              for (int j = 0; j < 4; ++j) { const f32x4 v = src[64 * j] * gk; u32x2 w; w.x = cvt_pk_bf16(v[0], v[1]); w.y = cvt_pk_bf16(v[2], v[3]); dst[64 * j] = w; } }
        }
        __syncthreads();
        const float* xin = ARGP(x); const float* memin = ARGP(mem); const float* bfg = ARGP(b_forget);
        constexpr int TOT = M + MEMROWS;
#define P0_LOAD(vv, rw) do { if ((rw) < TOT) { const bool im_ = (rw) >= M; const f32x4* xr_ = (const f32x4*)((im_ ? memin : xin) + (size_t)(im_ ? (rw) - M : (rw)) * DM) + lane; \
        _Pragma("unroll") for (int j = 0; j < 4; ++j) vv[j] = __builtin_nontemporal_load(xr_ + 64 * j); } } while (0)
#define P0_ROW(vv, rw) do { const int row_ = (rw); const bool is_mem = row_ >= M; const int r = is_mem ? row_ - M : row_; float s = 0.f; \
        _Pragma("unroll") for (int j = 0; j < 4; ++j) s += (vv[j][0] * vv[j][0] + vv[j][1] * vv[j][1]) + (vv[j][2] * vv[j][2] + vv[j][3] * vv[j][3]); \
        const float rinv = rsqrtf(wave_sum(s) * (1.0f / DM) + EPS); \
        u32x2* o8 = (u32x2*)((is_mem ? MEMB : XB) + (size_t)r * DM) + lane; \
        _Pragma("unroll") for (int j = 0; j < 4; ++j) { u32x2 w; w.x = cvt_pk_bf16(vv[j][0], vv[j][1]); w.y = cvt_pk_bf16(vv[j][2], vv[j][3]); o8[64 * j] = w; } \
        if (is_mem) { if (lane == 0) RMEM[r] = rinv; } \
        else { float f[8]; \
            _Pragma("unroll") for (int jj = 0; jj < 8; ++jj) { float a = 0.f; \
                _Pragma("unroll") for (int j = 0; j < 4; ++j) { const f32x4 w4 = *(const LAS f32x4*)(wfT + jj * DM + 256 * j + 4 * lane); a += (vv[j][0] * w4[0] + vv[j][1] * w4[1]) + (vv[j][2] * w4[2] + vv[j][3] * w4[3]); } \
                f[jj] = wave_sum(a); } \
            if (lane == 0) RX[r] = rinv; \
            if (lane < 8) { float fl = 0.f; \
                _Pragma("unroll") for (int jj = 0; jj < 8; ++jj) fl = (lane == jj) ? f[jj] : fl; \
                fl = fl * rinv + bfg[lane]; \
                const float ls = fminf(fl, 0.f) - log1pf(expf(-fabsf(fl))); \
                LF[(size_t)r * 8 + lane] = ls * LOG2E; } } } while (0)
        f32x4 va[4], vb[4], vc[4];
        P0_LOAD(va, gw); P0_LOAD(vb, gw + NGW);
        for (int row = gw; row < TOT; row += 3 * NGW) {
            P0_LOAD(vc, row + 2 * NGW); P0_ROW(va, row);
            if (row + NGW < TOT) { P0_LOAD(va, row + 3 * NGW); P0_ROW(vb, row + NGW); }
            if (row + 2 * NGW < TOT) { P0_LOAD(vb, row + 4 * NGW); P0_ROW(vc, row + 2 * NGW); }
        }
#undef P0_LOAD
#undef P0_ROW
    }
    xcd_barrier(bar);
    if (PROBE_HI == 0) t_pb = __builtin_amdgcn_s_memrealtime();

    if (PROBE_LO == 1) t_pa = __builtin_amdgcn_s_memrealtime();
    if (PH(1))
    if (vcu < 32) {
        PHASE_PTRS
        const int b = vcu >> 2, h = (vcu & 3) * 2 + (wave >> 2), seg = wave & 3, s0 = seg * 2048 + lane * 32;
        const float* src = LF + ((size_t)b * SEQ + s0) * 8 + h;
        float p[32];
#pragma unroll
        for (int j = 0; j < 32; ++j) p[j] = src[j * 8];
#pragma unroll
        for (int j = 1; j < 32; ++j) p[j] += p[j - 1];
        float inc = p[31];
#pragma unroll
        for (int o = 1; o < 64; o <<= 1) { const float y = __shfl_up(inc, o); if (lane >= o) inc += y; }
        LAS float* tot = (LAS float*)(lds + EXTRA_OFF);
        if (lane == 63) tot[wave] = inc;
        __syncthreads();
        float off = inc - p[31];
        for (int q = 0; q < 3; ++q) if (q < seg) off += tot[(wave & 4) + q];
        float* dst = CC + ((size_t)b * NH + h) * SEQ + s0; bf16_t* kx = KX + (((size_t)b * NH + h) * SEQ + s0) * 8;
#pragma unroll
        for (int j = 0; j < 32; ++j) { const float x = off + p[j]; dst[j] = x;
            unsigned hm, lo; fox::split3(-x, hm, lo); u32x4 w; w.x = 0x3F803F80u; w.y = 0x3F80u | (hm << 16); w.z = (hm >> 16) | (lo << 16); w.w = 0u;
            *(u32x4*)(kx + j * 8) = w; }
        VM_WAIT(); __syncthreads();
    }
    if (PH(1))
    for (int rep_ = 0; rep_ < REPS(1); ++rep_)
    {
        PHASE_PTRS
        pg8::Gemm g{DM, DM, DM};
        SchedDense S{(const char*)XB, (const char*)Win_t, M / 256, NPROJ / 256, G, bx, (size_t)256 * DM * 2, (size_t)256 * DM * 2, 0, 2};
        LAS float* rst = (LAS float*)(lds + EXTRA_OFF);
#pragma unroll
        for (int q = 0; q < 8; ++q) { const int idx = tid + 512 * q, i = idx >> 8, r = idx & 255; int pm, pn; if (pg8::tile_order(i, G, bx, M / 256, NPROJ / 256, pm, pn)) rst[idx] = RX[pm * 256 + r]; }
        VM_WAIT(); __syncthreads();
        pg8::EpiBf16 E{QKV, HW, RX, QKV_STRIDE, C2, C2, ctl + CW_KN, rst, 1.f};
        pg8::gemm_phase<pg8::EpiBf16, SchedDense, true, false>(lds + RING_OFF, g, S, E);
    }
    xcd_barrier(bar);
    if (PROBE_HI == 1) t_pb = __builtin_amdgcn_s_memrealtime();

    if (PROBE_LO == 2) t_pa = __builtin_amdgcn_s_memrealtime();
    if (PH(2))
    {
        PHASE_PTRS
        const bf16_t* QA = QKV; const bf16_t* KA = QKV + QKV_STRIDE; const bf16_t* VA = QKV + 2 * QKV_STRIDE;
        const bf16_t* QBp = QKV + 3 * QKV_STRIDE; const bf16_t* KBp = QKV + 4 * QKV_STRIDE; const bf16_t* VBp = QKV + 5 * QKV_STRIDE;
        bf16_t* OA = OAB; bf16_t* OB = OAB + HW;
        LAS char* shm = (LAS char*)(lds + RING_OFF);
        { pg8::Gemm g{DM, DM, DM};
          SchedDense S2{(const char*)MEMB, (const char*)Wxkv_t, MEMROWS / 256, 2 * DM / 256, G, bx, (size_t)256 * DM * 2, (size_t)256 * DM * 2, 0, 0};
          pg8::EpiBf16 E2{KVM, 2 * DM, RMEM, 0, 1.f, 1.f, nullptr, nullptr, 1.f};
          pg8::gemm_phase<pg8::EpiBf16, SchedDense, true, false>(lds + RING_OFF, g, S2, E2);
          VM_WAIT(); __syncthreads(); }
        for (int rep = 0; rep < REP_FOX; ++rep)
        for (int i = 0; i < 8; ++i) { const int bh = (vcu >> 5) * 8 + i, x = vcu & 31, qb = (i & 1) ? 31 - x : x;
            const float kmax = sqrtf(__uint_as_float(ctl[CW_KN + bh * 2]) + __uint_as_float(ctl[CW_KN + bh * 2 + 1])) * 1.01f;
            const int nqb = ((i + 1) & 1) ? 31 - x : x;
            fox::fox_unit<8>(bh, qb, QA, KA, VA, OA, HS + (bh & 7), CC + (size_t)bh * SEQ, KX, kmax, shm, i > 0, i < 7 ? bh + 1 : -1, nqb); }
        { volatile LAS unsigned* qs = MISC + 16;
          unsigned nxt = 0u;
          if (tid == 0) qs[0] = __hip_atomic_fetch_add(ctl + CW_SBQ, 1u, __ATOMIC_RELAXED, __HIP_MEMORY_SCOPE_AGENT);
          __syncthreads();
          unsigned idx = qs[0];
          while (idx < (unsigned)(BATCH * NH * 32 * REP_SB)) {
              __syncthreads();
              if (tid == 0) nxt = __hip_atomic_fetch_add(ctl + CW_SBQ, 1u, __ATOMIC_RELAXED, __HIP_MEMORY_SCOPE_AGENT);
              const int un = (int)(idx % (unsigned)(BATCH * NH * 32)), bh = un >> 5, qb = un & 31;
              sbk::sb_unit(bh >> 3, bh & 7, qb, QBp, KBp, VBp, OB, HS + 8 + (bh & 7), shm);
              if (tid == 0) qs[0] = nxt;
              __syncthreads();
              idx = qs[0];
          } }
    }
    xcd_barrier(bar);
    if (PROBE_HI == 2) t_pb = __builtin_amdgcn_s_memrealtime();

    if (PROBE_LO == 4) t_pa = __builtin_amdgcn_s_memrealtime();
    if (PH(4))
    for (int rep_ = 0; rep_ < REPS(4); ++rep_)
    {
        PHASE_PTRS
        pg8::Gemm g{DM, DM, DM};
        SchedDense S{(const char*)OAB, (const char*)Wout_t, M / 256, DM / 256, G, bx, (size_t)256 * DM * 2, (size_t)256 * DM * 2, 0, 0};
        LAS f32x2* rab = (LAS f32x2*)(lds + EXTRA_OFF);
#pragma unroll
        for (int q = 0; q < 4; ++q) { const int idx = tid + 512 * q, i = idx >> 8, r = idx & 255; int pm, pn;
            if (pg8::tile_order(i, G, bx, M / 256, DM / 256, pm, pn)) { const f32x4* p = (const f32x4*)(HS + (size_t)(pm * 256 + r) * 16); const f32x4 a0 = p[0], a1 = p[1], b0 = p[2], b1 = p[3];
                const float ra = rsqrtf((((a0[0] + a0[1]) + (a0[2] + a0[3])) + ((a1[0] + a1[1]) + (a1[2] + a1[3]))) * (1.0f / HW) + EPS);
                const float rb = rsqrtf((((b0[0] + b0[1]) + (b0[2] + b0[3])) + ((b1[0] + b1[1]) + (b1[2] + b1[3]))) * (1.0f / HW) + EPS);
                rab[idx] = (f32x2){ra / rb, rb}; } }
        VM_WAIT(); __syncthreads();
        pg8::EpiOutProj E{XB, H1B, H1F8, SSQ, rab};
        pg8::gemm_phase<pg8::EpiOutProj, SchedDense, true, false>(lds + RING_OFF, g, S, E);
        pg8::Gemm g2{0, 0, 256};
        SchedGH SG{(const char*)KVM, (const char*)Wxq_n, (const char*)Wxo_t, G, bx};
        EpiGH EG{(unsigned char*)GT, (unsigned char*)HT};
        g2.lda = 2 * DM; g2.ldb = DM; SchedGHk<0> S0{SG}; pg8::gemm_phase<EpiGH, SchedGHk<0>, true, false>(lds + RING_OFF, g2, S0, EG);
        g2.lda = DM; g2.ldb = 2 * DM; SchedGHk<1> S1{SG}; pg8::gemm_phase<EpiGH, SchedGHk<1>, true, false>(lds + RING_OFF, g2, S1, EG);
    }
    xcd_barrier(bar);
    if (PROBE_HI == 4) t_pb = __builtin_amdgcn_s_memrealtime();

    if (PROBE_LO == 5) t_pa = __builtin_amdgcn_s_memrealtime();
    if (PH(5))
    for (int rep_ = 0; rep_ < REPS(5); ++rep_)
    {
        PHASE_PTRS
        pg8::Gemm g{DM, DM, DM};
        SchedDense S{(const char*)H1F8, (const char*)GT, M / 256, DM / 256, G, bx, (size_t)256 * DM, (size_t)256 * DM, (size_t)DM * DM, 0};
        LAS float* r1t = (LAS float*)(lds + EXTRA_OFF + 8192);
#pragma unroll
        for (int q = 0; q < 4; ++q) { const int idx = tid + 512 * q, i = idx >> 8, r = idx & 255; int pm, pn;
            if (pg8::tile_order(i, G, bx, M / 256, DM / 256, pm, pn)) { const f32x4* sp = (const f32x4*)(SSQ + (size_t)(pm * 256 + r) * 16); const f32x4 s0 = sp[0], s1 = sp[1], s2 = sp[2], s3 = sp[3];
                const float tot = ((s0[0] + s0[1]) + (s0[2] + s0[3])) + ((s1[0] + s1[1]) + (s1[2] + s1[3])) + ((s2[0] + s2[1]) + (s2[2] + s2[3])) + ((s3[0] + s3[1]) + (s3[2] + s3[3]));
                r1t[idx] = rsqrtf(tot * (1.0f / DM) + EPS) * XSC; } }
        VM_WAIT(); __syncthreads();
        pg8::EpiSoftmax E{XB, r1t, (LAS float*)(lds + EXTRA_OFF)};
        pg8::gemm_phase<pg8::EpiSoftmax, SchedDense, true, false, true>(lds + RING_OFF, g, S, E);
    }
    xcd_barrier(bar);
    if (PROBE_HI == 5) t_pb = __builtin_amdgcn_s_memrealtime();

    if (PROBE_LO == 6) t_pa = __builtin_amdgcn_s_memrealtime();
    if (PH(6))
    {
        PHASE_PTRS
        pg8::Gemm g{DM, DM, DM};
        SchedDense S{(const char*)XB, (const char*)HT, M / 256, DM / 256, G, bx, (size_t)256 * DM, (size_t)256 * DM, (size_t)DM * DM, 0};
        pg8::EpiResidBf16 E{H1B, H2F8, 1.0f / P_SCALE};
        pg8::gemm_phase<pg8::EpiResidBf16, SchedDense, true, false, true>(lds + RING_OFF, g, S, E);
    }
    xcd_barrier(bar);
    if (PROBE_HI == 6) t_pb = __builtin_amdgcn_s_memrealtime();

    if (PROBE_LO == 7) t_pa = __builtin_amdgcn_s_memrealtime();
    if (PH(7))
    {
        PHASE_PTRS
        LAS bf16_t* wBh = (LAS bf16_t*)(lds + RING_OFF); LAS bf16_t* wBl = wBh + 20 * DM;
        { const f32x4* wg4 = (const f32x4*)ARGP(w_rg); const f32x4* we4 = (const f32x4*)ARGP(w_re); const float* gf = ARGP(norm_ffn);
          f32x4 ga[2], ea[2][4]; float gk[2];
#pragma unroll
          for (int q = 0; q < 2; ++q) { const int k = tid + 512 * q; ga[q] = wg4[k]; gk[q] = gf[k];
#pragma unroll
              for (int c = 0; c < 4; ++c) ea[q][c] = we4[k * 4 + c]; }
#pragma unroll
          for (int q = 0; q < 2; ++q) { const int k = tid + 512 * q;
#pragma unroll
              for (int j = 0; j < 4; ++j) { { const float v = ga[q][j] * gk[q]; const unsigned hi_ = cvt_pk_bf16(v, 0.f) & 0xffffu; wBh[j * DM + k] = (bf16_t)hi_; wBl[j * DM + k] = (bf16_t)(cvt_pk_bf16(v - __uint_as_float(hi_ << 16), 0.f) & 0xffffu); }
#pragma unroll
                  for (int c = 0; c < 4; ++c) { const float v = ea[q][c][j] * gk[q]; const unsigned hi_ = cvt_pk_bf16(v, 0.f) & 0xffffu; const int col = 4 + 4 * c + j; wBh[col * DM + k] = (bf16_t)hi_; wBl[col * DM + k] = (bf16_t)(cvt_pk_bf16(v - __uint_as_float(hi_ << 16), 0.f) & 0xffffu); } } } }
        LAS int* dec_e = (LAS int*)(lds + RING_OFF + 81920); LAS float* dec_w = (LAS float*)(lds + RING_OFF + 81920 + 2048); LAS int* dec_r = (LAS int*)(lds + RING_OFF + 81920 + 4096);
        LAS int* hist = (LAS int*)(lds + RING_OFF + 81920 + 6144); LAS int* ebase = hist + 16; LAS float* dec_v = (LAS float*)(lds + RING_OFF + 81920 + 8192);
        if (tid < 16) hist[tid] = 0;
        __syncthreads();
        const float brg0 = ARGP(b_rg)[0], brg1 = ARGP(b_rg)[1], brg2 = ARGP(b_rg)[2], brg3 = ARGP(b_rg)[3]; const float* bre = ARGP(b_re);
        const int tok = lane & 31, half = lane >> 5, jcol = tok < 20 ? tok : 19;
        for (int it = 0; it * NGW < M / 32; ++it) {
            const int T = gw + it * NGW; const bool act = T < M / 32; const int r0 = act ? 32 * T : 0;
            const bf16_t* rowp = H1B + (size_t)(r0 + tok) * DM + 512 * half;
            const LAS bf16_t* wph = wBh + jcol * DM + 512 * half; const LAS bf16_t* wpl = wBl + jcol * DM + 512 * half;
            f32x16 ah0 = f32x16{}, ah1 = f32x16{}, al0 = f32x16{}, al1 = f32x16{}; float ssq = 0.f;
#pragma unroll 4
            for (int sidx = 0; sidx < 64; sidx += 2) {
                const u32x4 a0 = *(const u32x4*)(rowp + 8 * sidx), a1 = *(const u32x4*)(rowp + 8 * sidx + 8);
                const bf16x8 wh0 = *(const LAS bf16x8*)(wph + 8 * sidx), wl0 = *(const LAS bf16x8*)(wpl + 8 * sidx), wh1 = *(const LAS bf16x8*)(wph + 8 * sidx + 8), wl1 = *(const LAS bf16x8*)(wpl + 8 * sidx + 8);
                ah0 = MFMA32(wh0, __builtin_bit_cast(bf16x8, a0), ah0); al0 = MFMA32(wl0, __builtin_bit_cast(bf16x8, a0), al0);
                ah1 = MFMA32(wh1, __builtin_bit_cast(bf16x8, a1), ah1); al1 = MFMA32(wl1, __builtin_bit_cast(bf16x8, a1), al1);
                ssq += (bf16lo(a0.x) * bf16lo(a0.x) + bf16hi(a0.x) * bf16hi(a0.x)) + (bf16lo(a0.y) * bf16lo(a0.y) + bf16hi(a0.y) * bf16hi(a0.y)) + (bf16lo(a0.z) * bf16lo(a0.z) + bf16hi(a0.z) * bf16hi(a0.z)) + (bf16lo(a0.w) * bf16lo(a0.w) + bf16hi(a0.w) * bf16hi(a0.w));
                ssq += (bf16lo(a1.x) * bf16lo(a1.x) + bf16hi(a1.x) * bf16hi(a1.x)) + (bf16lo(a1.y) * bf16lo(a1.y) + bf16hi(a1.y) * bf16hi(a1.y)) + (bf16lo(a1.z) * bf16lo(a1.z) + bf16hi(a1.z) * bf16hi(a1.z)) + (bf16lo(a1.w) * bf16lo(a1.w) + bf16hi(a1.w) * bf16hi(a1.w));
            }
            const float rinv = rsqrtf((att::swap_lo(ssq) + att::swap_hi(ssq)) * (1.0f / DM) + EPS);
            float lg[20];
#pragma unroll
            for (int r = 0; r < 12; ++r) { const float c = (ah0[r] + ah1[r]) + (al0[r] + al1[r]); auto rr = __builtin_amdgcn_permlane32_swap(__float_as_uint(c), __float_as_uint(c), false, false);
                const int jl = (r & 3) + 8 * (r >> 2); lg[jl] = __uint_as_float(rr[0]) * rinv; if (r < 8) lg[jl + 4] = __uint_as_float(rr[1]) * rinv; }
            float g0 = lg[0] + brg0, g1 = lg[1] + brg1, g2 = lg[2] + brg2, g3 = lg[3] + brg3;
            int gi = 0; float gm = g0; if (g1 > gm) { gm = g1; gi = 1; } if (g2 > gm) { gm = g2; gi = 2; } if (g3 > gm) { gm = g3; gi = 3; }
            const float gval = 1.0f / (expf(g0 - gm) + expf(g1 - gm) + expf(g2 - gm) + expf(g3 - gm));
            float el[4];
#pragma unroll
            for (int j = 0; j < 4; ++j) { const float e0 = lg[4 + j], e1 = lg[8 + j], e2 = lg[12 + j], e3 = lg[16 + j]; el[j] = ((gi == 0) ? e0 : (gi == 1) ? e1 : (gi == 2) ? e2 : e3) + bre[gi * 4 + j]; }
            int i0 = 0; float m0 = el[0];
#pragma unroll
            for (int j = 1; j < 4; ++j) if (el[j] > m0) { m0 = el[j]; i0 = j; }
            int i1 = -1; float m1 = -3.0e38f;
#pragma unroll
            for (int j = 0; j < 4; ++j) if (j != i0 && el[j] > m1) { m1 = el[j]; i1 = j; }
            const float w0 = 1.0f / (1.0f + expf(m1 - m0)), w1 = 1.0f - w0;
            if (act) { const int e = gi * 4 + (half == 0 ? i0 : i1); const float w = gval * (half == 0 ? w0 : w1);
                const int idx = (wave * 32 + tok) * 2 + half; dec_e[idx] = e; dec_w[idx] = w; dec_v[idx] = rinv; dec_r[idx] = __hip_atomic_fetch_add(hist + e, 1, __ATOMIC_RELAXED, __HIP_MEMORY_SCOPE_WORKGROUP); }
            __syncthreads();
            if (tid < 16) { const int n = hist[tid]; ebase[tid] = n ? (int)__hip_atomic_fetch_add(ctl + CW_CNT + 64 * tid, (unsigned)n, __ATOMIC_RELAXED, __HIP_MEMORY_SCOPE_AGENT) : 0; }
            __syncthreads();
            if (act) { const int row = r0 + (lane >> 1), idx = wave * 64 + lane; const int e = dec_e[idx], pos = ebase[e] + dec_r[idx];
                LIST[(size_t)e * M + pos] = row; R2S[(size_t)e * M + pos] = dec_v[idx]; TOKSLOT[(size_t)row * 2 + (lane & 1)] = (e << 20) | pos; TOKW[(size_t)row * 2 + (lane & 1)] = dec_w[idx]; }
            __syncthreads();
            if (tid < 16) hist[tid] = 0;
            __syncthreads();
        }
    }
    xcd_barrier(bar);
    if (PROBE_HI == 7) t_pb = __builtin_amdgcn_s_memrealtime();

    if (PROBE_LO == 8) t_pa = __builtin_amdgcn_s_memrealtime();
    if (PH(8))
    for (int rep_ = 0; rep_ < REPS(8); ++rep_)
    {
        PHASE_PTRS
        pg8::Gemm g{DM, DM, DM};
        LAS int* tbl = (LAS int*)(lds + EXTRA_OFF + 8192); moe_table(tbl, ctl);
        SchedMoe S; S.A = (const char*)H2F8; S.W = (const char*)Wgu_t; S.list = LIST; S.tbl = tbl; S.G = G; S.c = bx; S.NPN = 2; S.w_exp = (size_t)512 * DM; S.w_tile = (size_t)256 * DM; S.a_tile = 0; S.ocol_w = 128;
        pg8::EpiSwiglu E{HID, R2S, LIST};
        pg8::gemm_phase<pg8::EpiSwiglu, SchedMoe, true, true, true>(lds + RING_OFF, g, S, E);
    }
    xcd_barrier(bar);
    if (PROBE_HI == 8) t_pb = __builtin_amdgcn_s_memrealtime();

    if (PROBE_LO == 9) t_pa = __builtin_amdgcn_s_memrealtime();
    if (PH(9))
    for (int rep_ = 0; rep_ < REPS(9); ++rep_)
    {
        PHASE_PTRS
        pg8::Gemm g{DFF, DFF, DFF};
        LAS int* tbl = (LAS int*)(lds + EXTRA_OFF + 8192);
        SchedMoe S; S.A = (const char*)HID; S.W = (const char*)Wd_t; S.list = LIST; S.tbl = tbl; S.G = G; S.c = bx; S.NPN = 4; S.w_exp = (size_t)DM * DFF; S.w_tile = (size_t)256 * DFF; S.a_tile = (size_t)256 * DFF; S.ocol_w = 256;
        pg8::EpiY8 E{(unsigned char*)YB, 1.0f / WD_SCALE};
        pg8::gemm_phase<pg8::EpiY8, SchedMoe, true, false, true>(lds + RING_OFF, g, S, E);
    }
    xcd_barrier(bar);
    if (PROBE_HI == 9) t_pb = __builtin_amdgcn_s_memrealtime();

    if (PROBE_LO == 10) t_pa = __builtin_amdgcn_s_memrealtime();
    if (PH(10))
    {
        PHASE_PTRS
        const LAS int* tb = (const LAS int*)(lds + EXTRA_OFF + 8192);
        const f32x4* gp = (const f32x4*)ARGP(norm_final) + lane;
        int sl0 = 0, sl1 = 0; float sw0 = 0.f, sw1 = 0.f;
        unsigned ya_n[4], yb_n[4]; u32x2 hh_n[4]; float w0_n = 0.f, w1_n = 0.f;
#define P10_SLOTS(rw) do { sl0 = TOKSLOT[(size_t)(rw) * 2]; sl1 = TOKSLOT[(size_t)(rw) * 2 + 1]; sw0 = TOKW[(size_t)(rw) * 2]; sw1 = TOKW[(size_t)(rw) * 2 + 1]; } while (0)
#define P10_DATA(rw) do { const int r0_ = tb[sl0 >> 20] * 256 + (sl0 & 0xfffff), r1_ = tb[sl1 >> 20] * 256 + (sl1 & 0xfffff); w0_n = sw0; w1_n = sw1; \
        const unsigned* y0_ = (const unsigned*)((const unsigned char*)YB + (size_t)r0_ * DM) + lane; const unsigned* y1_ = (const unsigned*)((const unsigned char*)YB + (size_t)r1_ * DM) + lane; const u32x2* h_ = (const u32x2*)(H1B + (size_t)(rw) * DM) + lane; \
        _Pragma("unroll") for (int j = 0; j < 4; ++j) { ya_n[j] = y0_[64 * j]; yb_n[j] = y1_[64 * j]; hh_n[j] = h_[64 * j]; } } while (0)
        if (gw < M) { P10_SLOTS(gw); P10_DATA(gw); if (gw + NGW < M) P10_SLOTS(gw + NGW); }
        for (int row = gw; row < M; row += NGW) {
            unsigned ya[4], yb[4]; u32x2 hh[4]; const float w0 = w0_n, w1 = w1_n;
#pragma unroll
            for (int j = 0; j < 4; ++j) { ya[j] = ya_n[j]; yb[j] = yb_n[j]; hh[j] = hh_n[j]; }
            if (row + NGW < M) { P10_DATA(row + NGW); if (row + 2 * NGW < M) P10_SLOTS(row + 2 * NGW); }
            f32x4* hr = (f32x4*)(out + (size_t)row * DM) + lane;
            f32x4 v[4]; float s = 0.f;
#pragma unroll
            for (int j = 0; j < 4; ++j) { const u32x2 hx = hh[j]; f32x4 h = {bf16lo(hx.x), bf16hi(hx.x), bf16lo(hx.y), bf16hi(hx.y)};
                const f32x2 a01 = __builtin_amdgcn_cvt_pk_f32_fp8((int)ya[j], false), a23 = __builtin_amdgcn_cvt_pk_f32_fp8((int)ya[j], true), b01 = __builtin_amdgcn_cvt_pk_f32_fp8((int)yb[j], false), b23 = __builtin_amdgcn_cvt_pk_f32_fp8((int)yb[j], true);
                h[0] += w0 * a01[0] + w1 * b01[0]; h[1] += w0 * a01[1] + w1 * b01[1]; h[2] += w0 * a23[0] + w1 * b23[0]; h[3] += w0 * a23[1] + w1 * b23[1];
                v[j] = h; s += (h[0] * h[0] + h[1] * h[1]) + (h[2] * h[2] + h[3] * h[3]); }
            const float rinv = rsqrtf(wave_sum(s) * (1.0f / DM) + EPS);
#pragma unroll
            for (int j = 0; j < 4; ++j) __builtin_nontemporal_store(v[j] * rinv * gp[64 * j], hr + 64 * j);
        }
#undef P10_SLOTS
#undef P10_DATA
    }
    if (PROBE_LO >= 0) {
        if (PROBE_HI == 10) t_pb = __builtin_amdgcn_s_memrealtime();
        if (blockIdx.x == 0 && threadIdx.x == 0) { const unsigned long long t0 = __builtin_amdgcn_s_memrealtime(), span = 2 * (t_pb - t_pa);
            while (__builtin_amdgcn_s_memrealtime() - t0 < span) __builtin_amdgcn_s_sleep(8); }
    }
}

extern "C" void kernel_launch(void* const* d_in, const int* in_sizes, int n_in, void* d_out, int out_size, void* d_ws, size_t ws_size, hipStream_t stream) {
    static int grid = 0;
    if (grid == 0) {
        if (n_in != 22 || in_sizes[0] != M * DM || out_size != M * DM || ws_size < WS_END) { fprintf(stderr, "kernel_launch: unexpected shapes (n_in %d, in0 %d, out %d, ws %zu)\n", n_in, n_in > 0 ? in_sizes[0] : -1, out_size, ws_size); grid = -1; return; }
        int dev = 0, cus = 0, per_cu = 0;
        if (hipGetDevice(&dev) != hipSuccess || hipDeviceGetAttribute(&cus, hipDeviceAttributeMultiprocessorCount, dev) != hipSuccess) { grid = -1; return; }
        if (hipFuncSetAttribute((const void*)hymba_fwd, hipFuncAttributeMaxDynamicSharedMemorySize, LDS_BYTES) != hipSuccess) { fprintf(stderr, "kernel_launch: hipFuncSetAttribute failed\n"); grid = -1; return; }
        if (hipOccupancyMaxActiveBlocksPerMultiprocessor(&per_cu, (const void*)hymba_fwd, NWAVES * 64, LDS_BYTES) != hipSuccess || per_cu < 1) { fprintf(stderr, "kernel_launch: occupancy query reports %d\n", per_cu); }
        (void)hipGetLastError();
        grid = cus;
    }
    if (grid < 0) return;
    (void)hipMemsetAsync((char*)d_ws + WS_CTL, 0, CTL_ZERO_BYTES, stream);
    Args a{};
    const float** p = (const float**)&a;
    for (int i = 0; i < 22; ++i) p[i] = (const float*)d_in[i];
    a.out = (float*)d_out; a.ws = (unsigned char*)d_ws;
    hipLaunchKernelGGL(hymba_fwd, dim3(grid), dim3(NWAVES * 64), LDS_BYTES, stream, a);
}
```

```cpp
#include <hip/hip_runtime.h>
#include <hip/hip_bf16.h>
#include <cstdio>
#include <cstdint>

#define LAS __attribute__((address_space(3)))
#define GAS __attribute__((address_space(1)))
typedef unsigned short bf16_t;
typedef short bf16x8 __attribute__((ext_vector_type(8)));
typedef short s16x4 __attribute__((ext_vector_type(4)));
typedef float f32x4 __attribute__((ext_vector_type(4)));
typedef float f32x2 __attribute__((ext_vector_type(2)));
typedef float f32x16 __attribute__((ext_vector_type(16)));
typedef unsigned u32x4 __attribute__((ext_vector_type(4)));
typedef unsigned u32x2 __attribute__((ext_vector_type(2)));
typedef __bf16 bf16x2_t __attribute__((ext_vector_type(2)));

constexpr int BATCH = 8, SEQ = 8192, DM = 1024, M = BATCH * SEQ;
constexpr int NH = 8, HD = 64, HW = NH * HD;
constexpr int NPROJ = 3 * HW * 2;
constexpr int WIN_LD = NPROJ + NH;
constexpr int NMEM = 256, XH = 4, XD = 256, MEMROWS = BATCH * NMEM;
constexpr int NEXP = 16, DFF = 256;
constexpr float EPS = 1e-6f;
constexpr float LOG2E = 1.4426950408889634f;
constexpr float C2 = 0.125f * LOG2E;
constexpr float XSC = 0.0625f * LOG2E;
constexpr float P_SCALE = 128.0f;
constexpr float WGU_SCALE = 32.0f;
constexpr float WD_SCALE = 16.0f;
constexpr float SB_EXIT = -48.0f;

constexpr size_t MiB = 1u << 20;
constexpr size_t WS_CTL = 0, CTL_ZERO_BYTES = 128 * 1024;
constexpr size_t WS_WIN = 1 * MiB;
constexpr size_t WS_WOUT = 7 * MiB;
constexpr size_t WS_WXQ = 9 * MiB;
constexpr size_t WS_WXKV = 11 * MiB;
constexpr size_t WS_WXO = 15 * MiB;
constexpr size_t WS_WGU = 17 * MiB;
constexpr size_t WS_WD = 33 * MiB;
constexpr size_t WS_RX = 41 * MiB;
constexpr size_t WS_RMEM = WS_RX + 256 * 1024;
constexpr size_t WS_R2 = WS_RX + 512 * 1024;
constexpr size_t WS_LF = 42 * MiB;
constexpr size_t WS_C2 = 44 * MiB;
constexpr size_t WS_SSQ = 46 * MiB;
constexpr size_t WS_TOKSLOT = 50 * MiB;
constexpr size_t WS_TOKW = 51 * MiB;
constexpr size_t WS_LIST = 52 * MiB;
constexpr size_t WS_MEMB = 56 * MiB;
constexpr size_t WS_KVM = 60 * MiB;
constexpr size_t WS_GT = 68 * MiB;
constexpr size_t WS_HT = 84 * MiB;
constexpr size_t WS_KX = 100 * MiB;
constexpr size_t WS_HS = 108 * MiB;
constexpr size_t WS_XB = 128 * MiB;
constexpr size_t WS_QKV = 256 * MiB;
constexpr size_t WS_H1B = 256 * MiB, WS_U2B = 384 * MiB, WS_HID = 512 * MiB;
constexpr size_t WS_H1F8 = 384 * MiB, WS_H2F8 = 448 * MiB;
constexpr size_t WS_O = 640 * MiB;
constexpr size_t WS_Y = 704 * MiB;
constexpr size_t WS_END = 1024 * MiB;
constexpr size_t QKV_STRIDE = (size_t)M * HW;
constexpr int MAXTILES = M * 2 / 256 + NEXP;
static_assert(WS_Y + (size_t)MAXTILES * 256 * 1024 * 2 <= WS_END, "ws map");
static_assert(WS_HID + (size_t)MAXTILES * 256 * 256 * 2 <= WS_O, "ws map");
constexpr int CW_BAR = 4096;
constexpr int CW_SBQ = 20736;
constexpr int CW_KN = 20480;
constexpr int CW_CNT = 16384;

constexpr int RING_OFF = 0, RING_BYTES = 131072;
constexpr int EXTRA_OFF = 131072, EXTRA_BYTES = 16384;
constexpr int MISC_OFF = EXTRA_OFF + EXTRA_BYTES;
constexpr int LDS_BYTES = MISC_OFF + 1024;
constexpr int NWAVES = 8;
#ifndef PHASE_MASK
#define PHASE_MASK 0x7ff
#endif
#define PH(n) ((PHASE_MASK >> (n)) & 1)
#ifndef PROBE_LO
#define PROBE_LO -1
#endif
#ifndef PROBE_HI
#define PROBE_HI -1
#endif
#ifndef REP_MASK
#define REP_MASK 0
#endif
#define REPS(n) (1 + ((REP_MASK >> (n)) & 1))
#ifndef REP_FOX
#define REP_FOX 1
#endif
#ifndef REP_SB
#define REP_SB 1
#endif

__device__ __forceinline__ unsigned cvt_pk_bf16(float lo, float hi) { f32x2 v = {lo, hi}; bf16x2_t b = __builtin_convertvector(v, bf16x2_t); return __builtin_bit_cast(unsigned, b); }
__device__ __forceinline__ unsigned cvt4_fp8(float a, float b, float c, float d) { int w = 0; w = __builtin_amdgcn_cvt_pk_fp8_f32(a, b, w, false); w = __builtin_amdgcn_cvt_pk_fp8_f32(c, d, w, true); return (unsigned)w; }
__device__ __forceinline__ u32x4 widen16(u32x2 a, u32x2 b) {
    const auto r0 = __builtin_amdgcn_permlane16_swap(a.x, b.x, false, false); const auto r1 = __builtin_amdgcn_permlane16_swap(a.y, b.y, false, false);
    return (u32x4){r0[0], r1[0], r0[1], r1[1]};
}
__device__ __forceinline__ float bf16lo(unsigned u) { return __uint_as_float(u << 16); }
__device__ __forceinline__ float bf16hi(unsigned u) { return __uint_as_float(u & 0xffff0000u); }
#define DPP_ADD(v, CTRL) v += __builtin_bit_cast(float, __builtin_amdgcn_update_dpp(0, __builtin_bit_cast(int, v), CTRL, 0xf, 0xf, true))
__device__ __forceinline__ float wave_sum(float v) {
    DPP_ADD(v, 0xB1); DPP_ADD(v, 0x4E); DPP_ADD(v, 0x141); DPP_ADD(v, 0x140);
    const int iv = __builtin_bit_cast(int, v);
    return (__builtin_bit_cast(float, __builtin_amdgcn_readlane(iv, 0)) + __builtin_bit_cast(float, __builtin_amdgcn_readlane(iv, 16))) +
           (__builtin_bit_cast(float, __builtin_amdgcn_readlane(iv, 32)) + __builtin_bit_cast(float, __builtin_amdgcn_readlane(iv, 48)));
}
#define LDS_WAIT() asm volatile("s_waitcnt lgkmcnt(0)" ::: "memory")
#define VM_WAIT() asm volatile("s_waitcnt vmcnt(0)" ::: "memory")

namespace pg8 {
constexpr int BM = 256, BK = 64, HALF = 128, HTB = HALF * BK * 2, STAGE_BYTES = 8 * HTB, NXCD = 8, WGM = 8;
__host__ __device__ __forceinline__ int lds_byte(int r, int c) { const int st = (r >> 4) * 2 + (c >> 5), rr = r & 15, cc = c & 31, ob = rr * 64 + cc * 2; return st * 1024 + (ob ^ (((ob >> 9) & 1) << 5)); }
__host__ __device__ __forceinline__ void stage_rc(int b, int& R, int& C) { const int st = b / 1024, sb = b % 1024, swz = sb ^ (((sb >> 9) & 1) << 5); R = (st >> 1) * 16 + swz / 64; C = (st & 1) * 32 + (swz % 64) / 2; }
__host__ __device__ __forceinline__ int perm32(int rho) { const int n = rho >> 4, i = rho & 15; return 8 * (i >> 2) + 4 * n + (i & 3); }

struct Unit { const char* a; const char* b; int orow, ocol, aux; const int* rows; int nvalid; int seq; };
struct Gemm { int lda, ldb, K; };

__device__ __forceinline__ bool tile_order(int i, int G, int c, int nM, int nN, int& pm, int& pn) {
    const int nwg = nM * nN; const long L = (long)i * G + c; if (L >= nwg) return false;
    int wgid = (int)L; { const int q = nwg / NXCD, r = nwg % NXCD, xcd = wgid % NXCD, off = wgid / NXCD; wgid = (xcd < r ? xcd * (q + 1) : r * (q + 1) + (xcd - r) * q) + off; }
    const int nig = WGM * nN, gid = wgid / nig, fm = gid * WGM, gsz = (nM - fm) < WGM ? (nM - fm) : WGM;
    pm = fm + ((wgid % nig) % gsz); pn = (wgid % nig) / gsz; return true;
}

typedef int v8i32 __attribute__((ext_vector_type(8)));
template <class Epi, class Sched, bool ALIGN_EPI, bool GATHER, bool FP8 = false>
__device__ __forceinline__ void gemm_phase(LAS unsigned char* lds, const Gemm g, const Sched& S, const Epi& E) {
    int tid = threadIdx.x; asm volatile("" : "+v"(tid));
    const int wid = __builtin_amdgcn_readfirstlane(tid >> 6), lane = tid & 63, wr = wid >> 2, wc = wid & 3, fr = lane & 15, fq = lane >> 4;
    constexpr int ESZ = FP8 ? 1 : 2;
    const int K = g.K, nt = K / (FP8 ? 2 * BK : BK);
    unsigned voffA[2], voffB[2]; int RA[2], CA[2];
#pragma unroll
    for (int i = 0; i < 2; ++i) { int R, C; stage_rc(tid * 16 + i * 8192, R, C); const int Rb = (R & ~31) + perm32(R & 31);
        RA[i] = R; CA[i] = C; voffA[i] = (unsigned)(R * g.lda * ESZ + C * 2); voffB[i] = (unsigned)(Rb * g.ldb * ESZ + C * 2); }
    const size_t kstep = (size_t)(BK * 2);
    const size_t hstepA = (size_t)HALF * g.lda * ESZ, hstepB = (size_t)HALF * g.ldb * ESZ;
    const unsigned ldsw = (unsigned)wid * 1024u;
    const int aoff = lds_byte(wr * 64 + fr, FP8 ? fq * 16 : fq * 8), boff = lds_byte(wc * 32 + fr, FP8 ? fq * 16 : fq * 8);
    constexpr int KOFF = FP8 ? 16 : 1024;
#define PG8_SA(b, h) (((b) * 2 + (h)) * HTB)
#define PG8_SB(b, h) ((4 + (b) * 2 + (h)) * HTB)
#define PG8_STAGE2(bufoff, gbase, v0, v1) do { \
        __builtin_amdgcn_global_load_lds((const unsigned*)((const char*)(gbase) + (v0)), (LAS unsigned*)(lds + (bufoff) + ldsw), 16, 0, 0); \
        __builtin_amdgcn_global_load_lds((const unsigned*)((const char*)(gbase) + (v1)), (LAS unsigned*)(lds + (bufoff) + ldsw + 8192), 16, 0, 0); } while (0)
#define PG8_STAGEB(bufoff, gbase) PG8_STAGE2(bufoff, gbase, voffB[0], voffB[1])
#define PG8_STAGEA(bufoff, kptr, h, NX) do { if constexpr (GATHER) { const unsigned v0_ = (NX) ? gvn[h][0] : gvc[h][0], v1_ = (NX) ? gvn[h][1] : gvc[h][1]; PG8_STAGE2(bufoff, kptr, v0_, v1_); } \
        else { PG8_STAGE2(bufoff, (kptr) + (h) * hstepA, voffA[0], voffA[1]); } } while (0)
#define PG8_LDA(dst, b, h) do { _Pragma("unroll") for (int m = 0; m < 4; ++m) _Pragma("unroll") for (int k = 0; k < 2; ++k) dst[m][k] = *(const LAS bf16x8*)(lds + PG8_SA(b, h) + aoff + m * 2048 + k * KOFF); } while (0)
#define PG8_LDB(dst, b, h) do { _Pragma("unroll") for (int n = 0; n < 2; ++n) _Pragma("unroll") for (int k = 0; k < 2; ++k) dst[n][k] = *(const LAS bf16x8*)(lds + PG8_SB(b, h) + boff + n * 2048 + k * KOFF); } while (0)
#define PG8_CAT(x) __builtin_shufflevector(__builtin_bit_cast(f32x4, (x)[0]), __builtin_bit_cast(f32x4, (x)[1]), 0, 1, 2, 3, 4, 5, 6, 7)
#define PG8_MMA(ai, bj, At, Bt) do { __builtin_amdgcn_s_setprio(1); _Pragma("unroll") for (int m = 0; m < 4; ++m) _Pragma("unroll") for (int n = 0; n < 2; ++n) { \
        if constexpr (FP8) { acc[ai][bj][m][n] = __builtin_amdgcn_mfma_scale_f32_16x16x128_f8f6f4(__builtin_bit_cast(v8i32, PG8_CAT(Bt[n])), __builtin_bit_cast(v8i32, PG8_CAT(At[m])), acc[ai][bj][m][n], 0, 0, 0, 0x7F7F7F7F, 0, 0x7F7F7F7F); } \
        else { _Pragma("unroll") for (int k = 0; k < 2; ++k) acc[ai][bj][m][n] = __builtin_amdgcn_mfma_f32_16x16x32_bf16(Bt[n][k], At[m][k], acc[ai][bj][m][n], 0, 0, 0); } } \
        _Pragma("unroll") for (int m = 0; m < 4; ++m) _Pragma("unroll") for (int n = 0; n < 2; ++n) asm volatile("" : "+v"(acc[ai][bj][m][n]));     \
        __builtin_amdgcn_s_setprio(0); } while (0)
#define PG8_WAIT_V(n) asm volatile("s_waitcnt vmcnt(" #n ")" ::: "memory")
#define PG8_WAIT_L(n) asm volatile("s_waitcnt lgkmcnt(" #n ")" ::: "memory")
#define PG8_BAR __builtin_amdgcn_s_barrier()
#define PG8_SCHED __builtin_amdgcn_sched_barrier(0)
#define PG8_GATHER_OFFS(dst, u) do { _Pragma("unroll") for (int h_ = 0; h_ < 2; ++h_) _Pragma("unroll") for (int i_ = 0; i_ < 2; ++i_) { const int r_ = h_ * HALF + RA[i_]; \
        const int idx_ = (u).rows[r_ < (u).nvalid ? r_ : 0]; dst[h_][i_] = (unsigned)(idx_ * g.lda * ESZ + CA[i_] * 2); } } while (0)
    Unit cur, nxt; int ui = 0;
    if (!S.next(0, cur)) return;
    cur.seq = 0;
    unsigned gvc[2][2] = {{0u, 0u}, {0u, 0u}}, gvn[2][2] = {{0u, 0u}, {0u, 0u}};
    if constexpr (GATHER) { PG8_GATHER_OFFS(gvc, cur); }
    f32x4 acc[2][2][4][2];
#pragma unroll
    for (int a = 0; a < 2; ++a)
#pragma unroll
        for (int b = 0; b < 2; ++b)
#pragma unroll
            for (int m = 0; m < 4; ++m)
#pragma unroll
                for (int n = 0; n < 2; ++n) acc[a][b][m][n] = (f32x4){0.f, 0.f, 0.f, 0.f};
    bf16x8 At[4][2], B0[2][2], B1[2][2];
    const char* cA = cur.a; const char* cB = cur.b;
    PG8_STAGEB(PG8_SB(0, 0), cB); PG8_STAGEB(PG8_SB(0, 1), cB + hstepB); PG8_STAGEA(PG8_SA(0, 0), cA, 0, false); PG8_STAGEA(PG8_SA(0, 1), cA, 1, false);
    if (wr == 1) PG8_BAR;
    PG8_WAIT_V(2); PG8_BAR;
    PG8_STAGEB(PG8_SB(1, 0), cB + kstep); PG8_STAGEA(PG8_SA(1, 0), cA + kstep, 0, false); PG8_STAGEB(PG8_SB(1, 1), cB + hstepB + kstep);
    PG8_WAIT_V(6); PG8_BAR;
    for (;;) {
        const bool has_next = S.next(ui + 1, nxt); nxt.seq = ui + 1;
        const char* nA = has_next ? nxt.a : cA; const char* nB = has_next ? nxt.b : cB;
        if constexpr (GATHER) { if (has_next) { PG8_GATHER_OFFS(gvn, nxt); } else { gvn[0][0] = gvc[0][0]; gvn[0][1] = gvc[0][1]; gvn[1][0] = gvc[1][0]; gvn[1][1] = gvc[1][1]; } }
#pragma unroll 1
        for (int t = 0; t < nt; t += 2) {
            const bool last = (t == nt - 2);
            const char* a1 = cA + (size_t)(t + 1) * kstep;
            const char* a2 = last ? nA : cA + (size_t)(t + 2) * kstep; const char* b2 = last ? nB : cB + (size_t)(t + 2) * kstep;
            const char* a3 = a2 + kstep; const char* b3 = b2 + kstep;
            PG8_LDB(B0, 0, 0); PG8_LDB(B1, 0, 1); PG8_SCHED; PG8_LDA(At, 0, 0); PG8_STAGEA(PG8_SA(1, 1), a1, 1, false);
            PG8_WAIT_V(8); PG8_WAIT_L(0); PG8_BAR; PG8_MMA(0, 0, At, B0); PG8_MMA(0, 1, At, B1); PG8_BAR; PG8_SCHED;
            PG8_LDA(At, 0, 1); PG8_STAGEB(PG8_SB(0, 0), b2); PG8_STAGEB(PG8_SB(0, 1), b2 + hstepB); PG8_STAGEA(PG8_SA(0, 0), a2, 0, last);
            PG8_WAIT_V(8); PG8_WAIT_L(0); PG8_BAR; PG8_MMA(1, 0, At, B0); PG8_MMA(1, 1, At, B1); PG8_BAR; PG8_SCHED;
            PG8_LDB(B0, 1, 0); PG8_LDB(B1, 1, 1); PG8_SCHED; PG8_LDA(At, 1, 0); PG8_STAGEA(PG8_SA(0, 1), a2, 1, last);
            PG8_WAIT_V(8); PG8_WAIT_L(0); PG8_BAR; PG8_MMA(0, 0, At, B0); PG8_MMA(0, 1, At, B1); PG8_BAR; PG8_SCHED;
            PG8_LDA(At, 1, 1); PG8_STAGEB(PG8_SB(1, 0), b3); PG8_STAGEB(PG8_SB(1, 1), b3 + hstepB); PG8_STAGEA(PG8_SA(1, 0), a3, 0, last);
            PG8_WAIT_V(8); PG8_WAIT_L(0); PG8_BAR; PG8_MMA(1, 0, At, B0); PG8_MMA(1, 1, At, B1); PG8_BAR; PG8_SCHED;
            if constexpr (Epi::HAS_MID) { if (t == (nt >> 1) - 2) { int fr3 = fr, fq3 = fq; asm volatile("" : "+v"(fr3), "+v"(fq3)); E.mid(acc, cur, wr, wc, fr3, fq3); } }
        }
        if constexpr (ALIGN_EPI) { if (wr == 0) PG8_BAR; }
        { int fr2 = fr, fq2 = fq; asm volatile("" : "+v"(fr2), "+v"(fq2));
          E(acc, cur, wr, wc, fr2, fq2); }
        if (!has_next) break;
#pragma unroll
        for (int a = 0; a < 2; ++a)
#pragma unroll
            for (int b = 0; b < 2; ++b)
#pragma unroll
                for (int m = 0; m < 4; ++m)
#pragma unroll
                    for (int n = 0; n < 2; ++n) acc[a][b][m][n] = (f32x4){0.f, 0.f, 0.f, 0.f};
        cur = nxt; cA = nA; cB = nB; ++ui;
        if constexpr (GATHER) { gvc[0][0] = gvn[0][0]; gvc[0][1] = gvn[0][1]; gvc[1][0] = gvn[1][0]; gvc[1][1] = gvn[1][1]; }
        if constexpr (ALIGN_EPI) { if (wr == 1) PG8_BAR; }
    }
    PG8_WAIT_V(0);
    if constexpr (!ALIGN_EPI) { if (wr == 0) PG8_BAR; }
    PG8_BAR;
#undef PG8_SA
#undef PG8_SB
#undef PG8_STAGE2
#undef PG8_STAGEA
#undef PG8_STAGEB
#undef PG8_LDA
#undef PG8_LDB
#undef PG8_MMA
#undef PG8_CAT
#undef PG8_WAIT_V
#undef PG8_WAIT_L
#undef PG8_BAR
#undef PG8_SCHED
#undef PG8_GATHER_OFFS
}

#define EPI_ROW(u, ai, m) ((u).orow + (ai) * HALF + wr * 64 + (m) * 16 + fr)
#define EPI_COL(u, bj) ((u).ocol + (bj) * HALF + wc * 32 + 8 * fq)
struct EpiBf16 {
    static constexpr bool HAS_MID = false;
    bf16_t* O; int ldc; const float* rs; size_t stride; float sc0, sc3;
    unsigned* kn;
    const LAS float* rst;
    float mul;
    __device__ __forceinline__ void operator()(const f32x4 (&acc)[2][2][4][2], const Unit& u, int wr, int wc, int fr, int fq) const {
        bf16_t* base = O + (size_t)u.aux * stride;
        const float sc = ((u.aux == 0) ? sc0 : ((u.aux == 3) ? sc3 : 1.f)) * mul;
        float nmax[2] = {0.f, 0.f}; const bool dokn = kn && u.aux == 1;
#pragma unroll
        for (int ai = 0; ai < 2; ++ai)
#pragma unroll
            for (int m = 0; m < 4; ++m) { const int row = EPI_ROW(u, ai, m); const float s = (rst ? rst[u.seq * 256 + ai * HALF + wr * 64 + m * 16 + fr] : (rs ? rs[row] : 1.f)) * sc;
#pragma unroll
                for (int bj = 0; bj < 2; ++bj) { const f32x4 v0 = acc[ai][bj][m][0] * s, v1 = acc[ai][bj][m][1] * s;
                    { u32x4 w; w.x = cvt_pk_bf16(v0[0], v0[1]); w.y = cvt_pk_bf16(v0[2], v0[3]); w.z = cvt_pk_bf16(v1[0], v1[1]); w.w = cvt_pk_bf16(v1[2], v1[3]);
                    __builtin_nontemporal_store(w, (u32x4*)(base + (size_t)row * ldc + EPI_COL(u, bj))); }
                    if (dokn) { float q = (v0[0] * v0[0] + v0[1] * v0[1]) + (v0[2] * v0[2] + v0[3] * v0[3]) + (v1[0] * v1[0] + v1[1] * v1[1]) + (v1[2] * v1[2] + v1[3] * v1[3]);
                        q += __shfl_xor(q, 16); q += __shfl_xor(q, 32); nmax[bj] = fmaxf(nmax[bj], q); } } }
        if (dokn) {
#pragma unroll
            for (int bj = 0; bj < 2; ++bj) { float q = nmax[bj]; q = fmaxf(q, __shfl_xor(q, 1)); q = fmaxf(q, __shfl_xor(q, 2)); q = fmaxf(q, __shfl_xor(q, 4)); q = fmaxf(q, __shfl_xor(q, 8));
                const int head = ((u.ocol + bj * HALF) >> 6) + (wc >> 1), bt = u.orow / SEQ;
                if ((fr | fq) == 0) atomicMax(kn + ((bt * NH + head) * 2 + (wc & 1)), __float_as_uint(q)); }
        }
    }
};
struct EpiY8 {
    static constexpr bool HAS_MID = false;
    unsigned char* Y; float mul;
    __device__ __forceinline__ void operator()(const f32x4 (&acc)[2][2][4][2], const Unit& u, int wr, int wc, int fr, int fq) const {
#pragma unroll
        for (int ai = 0; ai < 2; ++ai)
#pragma unroll
            for (int m = 0; m < 4; m += 2) { const int row = EPI_ROW(u, ai, m) + 16 * (fq & 1);
#pragma unroll
                for (int bj = 0; bj < 2; ++bj) { u32x2 w8[2];
#pragma unroll
                    for (int mm = 0; mm < 2; ++mm) { const f32x4 v0 = acc[ai][bj][m + mm][0] * mul, v1 = acc[ai][bj][m + mm][1] * mul; w8[mm].x = cvt4_fp8(v0[0], v0[1], v0[2], v0[3]); w8[mm].y = cvt4_fp8(v1[0], v1[1], v1[2], v1[3]); }
                    *(u32x4*)(Y + (size_t)row * DM + (u.ocol + bj * HALF + wc * 32 + 8 * (fq & ~1))) = widen16(w8[0], w8[1]); } }
    }
};
struct EpiOutProj {
    static constexpr bool HAS_MID = true;
    const bf16_t* xb; bf16_t* hb; unsigned char* h8; float* ssq; const LAS f32x2* rab;
    __device__ __forceinline__ void mid(f32x4 (&acc)[2][2][4][2], const Unit& u, int wr, int wc, int fr, int fq) const {
#pragma unroll
        for (int ai = 0; ai < 2; ++ai)
#pragma unroll
            for (int m = 0; m < 4; ++m) { const float f = rab[u.seq * 256 + ai * HALF + wr * 64 + m * 16 + fr].x;
#pragma unroll
                for (int bj = 0; bj < 2; ++bj) { acc[ai][bj][m][0] *= f; acc[ai][bj][m][1] *= f; } }
    }
    __device__ __forceinline__ void operator()(const f32x4 (&acc)[2][2][4][2], const Unit& u, int wr, int wc, int fr, int fq) const {
#pragma unroll
        for (int ai = 0; ai < 2; ++ai)
#pragma unroll
            for (int m = 0; m < 4; ++m) { const int row = EPI_ROW(u, ai, m); const float rb = rab[u.seq * 256 + ai * HALF + wr * 64 + m * 16 + fr].y; float q = 0.f;
#pragma unroll
                for (int bj = 0; bj < 2; ++bj) { const size_t off = (size_t)row * DM + EPI_COL(u, bj);
                    const u32x4 xr = __builtin_nontemporal_load((const u32x4*)(xb + off));
                    f32x4 v0 = acc[ai][bj][m][0] * rb, v1 = acc[ai][bj][m][1] * rb;
                    v0[0] += bf16lo(xr.x); v0[1] += bf16hi(xr.x); v0[2] += bf16lo(xr.y); v0[3] += bf16hi(xr.y); v1[0] += bf16lo(xr.z); v1[1] += bf16hi(xr.z); v1[2] += bf16lo(xr.w); v1[3] += bf16hi(xr.w);
                    q += (v0[0] * v0[0] + v0[1] * v0[1]) + (v0[2] * v0[2] + v0[3] * v0[3]) + (v1[0] * v1[0] + v1[1] * v1[1]) + (v1[2] * v1[2] + v1[3] * v1[3]);
                    u32x4 w; w.x = cvt_pk_bf16(v0[0], v0[1]); w.y = cvt_pk_bf16(v0[2], v0[3]); w.z = cvt_pk_bf16(v1[0], v1[1]); w.w = cvt_pk_bf16(v1[2], v1[3]); *(u32x4*)(hb + off) = w;
                    { u32x2 w8; w8.x = cvt4_fp8(v0[0], v0[1], v0[2], v0[3]); w8.y = cvt4_fp8(v1[0], v1[1], v1[2], v1[3]); *(u32x2*)(h8 + off) = w8; } }
                q += __shfl_xor(q, 16); q += __shfl_xor(q, 32); if (fq == 0) ssq[(size_t)row * 16 + (u.ocol >> 8) * 4 + wc] = q; }
    }
};
struct EpiResidBf16 {
    static constexpr bool HAS_MID = false;
    bf16_t* hb; unsigned char* h8; float mul;
    __device__ __forceinline__ void operator()(const f32x4 (&acc)[2][2][4][2], const Unit& u, int wr, int wc, int fr, int fq) const {
#pragma unroll
        for (int ai = 0; ai < 2; ++ai) {
        u32x4 xres[4][2];
#pragma unroll
            for (int m = 0; m < 4; ++m)
#pragma unroll
                for (int bj = 0; bj < 2; ++bj) xres[m][bj] = *(const u32x4*)(hb + (size_t)EPI_ROW(u, ai, m) * DM + EPI_COL(u, bj));
        asm volatile("" ::: "memory");
#pragma unroll
            for (int m = 0; m < 4; ++m) { const int row = EPI_ROW(u, ai, m);
#pragma unroll
                for (int bj = 0; bj < 2; ++bj) { const size_t off = (size_t)row * DM + EPI_COL(u, bj);
                    const u32x4 xr = xres[m][bj];
                    f32x4 v0 = acc[ai][bj][m][0] * mul, v1 = acc[ai][bj][m][1] * mul;
                    v0[0] += bf16lo(xr.x); v0[1] += bf16hi(xr.x); v0[2] += bf16lo(xr.y); v0[3] += bf16hi(xr.y); v1[0] += bf16lo(xr.z); v1[1] += bf16hi(xr.z); v1[2] += bf16lo(xr.w); v1[3] += bf16hi(xr.w);
                    u32x4 w; w.x = cvt_pk_bf16(v0[0], v0[1]); w.y = cvt_pk_bf16(v0[2], v0[3]); w.z = cvt_pk_bf16(v1[0], v1[1]); w.w = cvt_pk_bf16(v1[2], v1[3]); *(u32x4*)(hb + off) = w;
                    if (h8) { u32x2 w8; w8.x = cvt4_fp8(v0[0], v0[1], v0[2], v0[3]); w8.y = cvt4_fp8(v1[0], v1[1], v1[2], v1[3]); *(u32x2*)(h8 + off) = w8; } } }
        asm volatile("" ::: "memory"); }
    }
};
struct EpiSoftmax {
    static constexpr bool HAS_MID = false;
    bf16_t* P; const LAS float* r1t; LAS float* red;
    __device__ __forceinline__ void operator()(f32x4 (&acc)[2][2][4][2], const Unit& u, int wr, int wc, int fr, int fq) const {
#pragma unroll
        for (int ai = 0; ai < 2; ++ai)
#pragma unroll
            for (int m = 0; m < 4; ++m) { const float r1 = r1t[u.seq * 256 + ai * HALF + wr * 64 + m * 16 + fr]; float a = -3.0e38f;
#pragma unroll
                for (int bj = 0; bj < 2; ++bj)
#pragma unroll
                    for (int n = 0; n < 2; ++n) { f32x4 v = acc[ai][bj][m][n] * r1; acc[ai][bj][m][n] = v; a = fmaxf(a, fmaxf(fmaxf(v[0], v[1]), fmaxf(v[2], v[3]))); }
                a = fmaxf(a, __shfl_xor(a, 16)); a = fmaxf(a, __shfl_xor(a, 32));
                if (fq == 0) red[(ai * HALF + wr * 64 + m * 16 + fr) * 4 + wc] = a; asm volatile("" ::: "memory"); }
        LDS_WAIT(); __builtin_amdgcn_s_barrier(); asm volatile("" ::: "memory");
#pragma unroll
        for (int ai = 0; ai < 2; ++ai)
#pragma unroll
            for (int m = 0; m < 4; ++m) { const int rl = ai * HALF + wr * 64 + m * 16 + fr; const f32x4 mm = *(const LAS f32x4*)(red + rl * 4);
                const float a = fmaxf(fmaxf(mm[0], mm[1]), fmaxf(mm[2], mm[3])); float s = 0.f;
#pragma unroll
                for (int bj = 0; bj < 2; ++bj)
#pragma unroll
                    for (int n = 0; n < 2; ++n) { f32x4 v = acc[ai][bj][m][n];
                        v[0] = __builtin_amdgcn_exp2f(v[0] - a); v[1] = __builtin_amdgcn_exp2f(v[1] - a); v[2] = __builtin_amdgcn_exp2f(v[2] - a); v[3] = __builtin_amdgcn_exp2f(v[3] - a);
                        acc[ai][bj][m][n] = v; s += (v[0] + v[1]) + (v[2] + v[3]); }
                s += __shfl_xor(s, 16); s += __shfl_xor(s, 32);
                if (fq == 0) red[1024 + rl * 4 + wc] = s; }
        LDS_WAIT(); __builtin_amdgcn_s_barrier(); asm volatile("" ::: "memory");
#pragma unroll
        for (int ai = 0; ai < 2; ++ai)
#pragma unroll
            for (int m = 0; m < 4; m += 2) { u32x2 w8[2][2];
#pragma unroll
                for (int mm = 0; mm < 2; ++mm) { const int rl = ai * HALF + wr * 64 + (m + mm) * 16 + fr; const f32x4 ss = *(const LAS f32x4*)(red + 1024 + rl * 4);
                    const float inv = P_SCALE / ((ss[0] + ss[1]) + (ss[2] + ss[3]));
#pragma unroll
                    for (int bj = 0; bj < 2; ++bj) { const f32x4 v0 = acc[ai][bj][m + mm][0] * inv, v1 = acc[ai][bj][m + mm][1] * inv;
                        w8[mm][bj].x = cvt4_fp8(v0[0], v0[1], v0[2], v0[3]); w8[mm][bj].y = cvt4_fp8(v1[0], v1[1], v1[2], v1[3]); } }
                const int row = EPI_ROW(u, ai, m) + 16 * (fq & 1);
#pragma unroll
                for (int bj = 0; bj < 2; ++bj) *(u32x4*)((unsigned char*)P + (size_t)row * DM + (u.ocol + bj * HALF + wc * 32 + 8 * (fq & ~1))) = widen16(w8[0][bj], w8[1][bj]); }
    }
};
struct EpiSwiglu {
    static constexpr bool HAS_MID = false;
    bf16_t* Hd; const float* r2s; const int* listbase;
    __device__ __forceinline__ void operator()(const f32x4 (&acc)[2][2][4][2], const Unit& u, int wr, int wc, int fr, int fq) const {
#pragma unroll
        for (int ai = 0; ai < 2; ++ai)
#pragma unroll
            for (int m = 0; m < 4; m += 2) { u32x2 w8[2];
#pragma unroll
                for (int mm = 0; mm < 2; ++mm) { const int rl = ai * HALF + wr * 64 + (m + mm) * 16 + fr; const float rs = r2s[(u.rows - listbase) + (rl < u.nvalid ? rl : 0)] * (1.0f / WGU_SCALE); float h[8];
#pragma unroll
                    for (int n = 0; n < 2; ++n)
#pragma unroll
                        for (int e = 0; e < 4; ++e) { const float gt = acc[ai][0][m + mm][n][e] * rs, up = acc[ai][1][m + mm][n][e] * rs;
                            h[n * 4 + e] = gt * __builtin_amdgcn_rcpf(1.0f + __builtin_amdgcn_exp2f(-gt * LOG2E)) * up; }
                    w8[mm].x = cvt4_fp8(h[0], h[1], h[2], h[3]); w8[mm].y = cvt4_fp8(h[4], h[5], h[6], h[7]); }
                const int row = EPI_ROW(u, ai, m) + 16 * (fq & 1);
                *(u32x4*)((unsigned char*)Hd + (size_t)row * DFF + u.ocol + wc * 32 + 8 * (fq & ~1)) = widen16(w8[0], w8[1]); }
    }
};
}

namespace att {
constexpr int QB = 256, KVBLK = 64, PITCH = HW, OPITCH = DM;
constexpr int SLOTB = 8192, LDS_K = 0, LDS_V = 2 * SLOTB, LDS_WS = 4 * SLOTB, LDS_OST = LDS_WS + NWAVES * 256, LDS_FLAG = LDS_OST + NWAVES * 4096, LDS_END = LDS_FLAG + 64;
static_assert(LDS_END <= RING_BYTES, "attention LDS");
__device__ __forceinline__ int crow(int r, int hi) { return (r & 3) + 8 * (r >> 2) + 4 * hi; }
__device__ __forceinline__ void glds16(const void* gsrc, unsigned lds_dst) { unsigned keep;
    asm volatile("s_mov_b32 %0, m0\n\ts_mov_b32 m0, %2\n\ts_nop 0\n\tglobal_load_lds_dwordx4 %1, off\n\ts_mov_b32 m0, %0" : "=&s"(keep) : "v"(gsrc), "s"(lds_dst) : "memory"); }
__device__ __forceinline__ void glds16s(const void* sbase, unsigned voff, unsigned lds_dst) { unsigned keep;
    asm volatile("s_mov_b32 %0, m0\n\ts_mov_b32 m0, %3\n\ts_nop 0\n\tglobal_load_lds_dwordx4 %1, %2\n\ts_mov_b32 m0, %0" : "=&s"(keep) : "v"(voff), "s"(sbase), "s"(lds_dst) : "memory"); }
#define ATT_WAIT_BAR0() asm volatile("s_waitcnt vmcnt(0) lgkmcnt(0)\n\ts_barrier" ::: "memory")
#define MFMA32(a, b, c) __builtin_amdgcn_mfma_f32_32x32x16_bf16(a, b, c, 0, 0, 0)
__device__ __forceinline__ void store_row_ssq(u32x4 v, float* dst, int ch) {
    float q = (bf16lo(v.x) * bf16lo(v.x) + bf16hi(v.x) * bf16hi(v.x)) + (bf16lo(v.y) * bf16lo(v.y) + bf16hi(v.y) * bf16hi(v.y)) + (bf16lo(v.z) * bf16lo(v.z) + bf16hi(v.z) * bf16hi(v.z)) + (bf16lo(v.w) * bf16lo(v.w) + bf16hi(v.w) * bf16hi(v.w));
    q += __shfl_xor(q, 1); q += __shfl_xor(q, 2); q += __shfl_xor(q, 4);
    if (ch == 0) *dst = q;
}
__device__ __forceinline__ void qkt(f32x16& p0, f32x16& p1, const LAS char* Kslot, const bf16x8* qr, const f32x16& cin, int r32, int hi) {
    const LAS char* kb = Kslot + hi * 1024 + r32 * 16;
#pragma unroll
    for (int d0 = 0; d0 < 4; ++d0) {
        const bf16x8 b0 = *(const LAS bf16x8*)(kb + d0 * 2048);
        const bf16x8 b1 = *(const LAS bf16x8*)(kb + d0 * 2048 + 512);
        if (d0 == 0) { p0 = MFMA32(b0, qr[0], cin); p1 = MFMA32(b1, qr[0], cin); }
        else { p0 = MFMA32(b0, qr[d0], p0); p1 = MFMA32(b1, qr[d0], p1); } }
}
__device__ __forceinline__ void pv(f32x16* o, int vb, bf16x8 pa0, bf16x8 pa1, bf16x8 pa2, bf16x8 pa3) {
#pragma unroll
    for (int d0 = 0; d0 < 2; ++d0) { s16x4 lo[4], hi[4];
#pragma unroll
        for (int ks = 0; ks < 4; ++ks) {
            asm volatile("ds_read_b64_tr_b16 %0,%1 offset:%c2" : "=&v"(lo[ks]) : "v"(vb), "i"(d0 * 4096 + ks * 1024) : "memory");
            asm volatile("ds_read_b64_tr_b16 %0,%1 offset:%c2" : "=&v"(hi[ks]) : "v"(vb), "i"(d0 * 4096 + ks * 1024 + 512) : "memory"); }
        asm volatile("s_waitcnt lgkmcnt(0)" ::: "memory"); __builtin_amdgcn_sched_barrier(0);
#define PK(k) (bf16x8){lo[k][0], lo[k][1], lo[k][2], lo[k][3], hi[k][0], hi[k][1], hi[k][2], hi[k][3]}
        o[d0] = MFMA32(pa0, PK(0), o[d0]); o[d0] = MFMA32(pa1, PK(1), o[d0]); o[d0] = MFMA32(pa2, PK(2), o[d0]); o[d0] = MFMA32(pa3, PK(3), o[d0]);
#undef PK
    }
}
__device__ __forceinline__ float swap_lo(float x) { auto rr = __builtin_amdgcn_permlane32_swap(__float_as_uint(x), __float_as_uint(x), false, false); return __uint_as_float(rr[0]); }
__device__ __forceinline__ float swap_hi(float x) { auto rr = __builtin_amdgcn_permlane32_swap(__float_as_uint(x), __float_as_uint(x), false, false); return __uint_as_float(rr[1]); }

}


namespace fox {
constexpr int QB = 256, KVBLK = 64, PITCH = HW, OPITCH = DM;
constexpr int NSLOT = 3, SLOTB = 9216;
constexpr int LDS_K = 0, LDS_V = NSLOT * SLOTB, LDS_WS = 2 * NSLOT * SLOTB, LDS_OST = LDS_WS + NWAVES * 256, LDS_CL = LDS_OST + NWAVES * 4096, LDS_VOTE = LDS_CL + 512, LDS_END = LDS_VOTE + 32;
static_assert(LDS_END <= RING_BYTES, "fox LDS");
constexpr float WIN_T = 48.0f;
constexpr float FLOOR = -256.0f;
using att::crow; using att::glds16; using att::glds16s;
typedef __attribute__((address_space(3))) const char* lds_cptr;
typedef short v4i16_t __attribute__((ext_vector_type(4)));
#define SBAR() __builtin_amdgcn_sched_barrier(0)
#define WAIT_BAR(N) asm volatile("s_waitcnt vmcnt(" #N ") lgkmcnt(0)\n\ts_barrier" ::: "memory")
__device__ __forceinline__ s16x4 vtr(lds_cptr p) { return __builtin_bit_cast(s16x4, __builtin_amdgcn_ds_read_tr16_b64_v4i16((__attribute__((address_space(3))) v4i16_t*)p)); }
__device__ __forceinline__ void kload2(bf16x8* kf, lds_cptr kp, int j) { kf[2 * j] = *(const LAS bf16x8*)(kp + j * 2048); kf[2 * j + 1] = *(const LAS bf16x8*)(kp + j * 2048 + 512); }
__device__ __forceinline__ void cmask(f32x16& p0, f32x16& p1, int jb, int qrel, int hi) {
    const float NEG = -INFINITY; const int kb = 64 * jb + 4 * hi;
#pragma unroll
    for (int r = 0; r < 16; ++r) { const int kv = kb + (r & 3) + 8 * (r >> 2); if (kv > qrel) p0[r] = NEG; if (kv + 32 > qrel) p1[r] = NEG; }
}
__device__ __forceinline__ void split3(float x, unsigned& hm, unsigned& lo) {
    const unsigned h = cvt_pk_bf16(x, 0.f) & 0xffffu; const float r1 = x - __uint_as_float(h << 16);
    const unsigned m = cvt_pk_bf16(r1, 0.f) & 0xffffu; const float r2 = r1 - __uint_as_float(m << 16);
    hm = h | (m << 16); lo = cvt_pk_bf16(r2, 0.f) & 0xffffu;
}
__device__ __forceinline__ bf16x8 qx_build(float a, int hi) {
    unsigned hm, lo; split3(a, hm, lo);
    u32x4 w; w.x = hm; w.y = lo | 0x3F800000u; w.z = 0x3F803F80u; w.w = 0u;
    if (hi) { w.x = 0u; w.y = 0u; w.z = 0u; }
    return __builtin_bit_cast(bf16x8, w);
}

template <int THRL> __device__ __forceinline__ void fox_unit(int bh, int qb, const bf16_t* Q, const bf16_t* K, const bf16_t* V, bf16_t* O, float* hs, const float* cb, const bf16_t* KXall, float kmax, LAS char* shm, bool pre, int nbh, int nqb) {
    const bf16_t* KXh = KXall + (size_t)bh * SEQ * 8;
    int tid = threadIdx.x; asm volatile("" : "+v"(tid)); const int lane = tid & 63, r32 = lane & 31, hi = lane >> 5; const int wid = __builtin_amdgcn_readfirstlane(tid >> 6);
    const int b = bh >> 3, h = bh & 7; const long rowbase = (long)b * SEQ; const int q0 = qb * QB;
    const bf16_t* Qw = Q + (rowbase + q0 + wid * 32) * PITCH + h * HD;
    const bf16_t* Kh = K + rowbase * PITCH + h * HD; const bf16_t* Vh = V + rowbase * PITCH + h * HD;
    const unsigned lds0 = (unsigned)(uintptr_t)shm;
    LAS float* wsf = (LAS float*)(shm + LDS_WS) + wid * 64;
    const int NT = (q0 + QB) / KVBLK;
    int NTe = NT;
    LAS float* clt = (LAS float*)(shm + LDS_CL); LAS unsigned* votes = (LAS unsigned*)(shm + LDS_VOTE);
    const float clv = (tid < NT) ? cb[64 * tid + 63] : 0.f;
    const unsigned koff = (unsigned)(lane * PITCH + wid * 8) * 2u, voff = (unsigned)((16 * (wid & 3) + (lane >> 2)) * PITCH + (wid >> 2) * 32 + (lane & 3) * 8) * 2u, xoff = (unsigned)lane * 16u;
    const unsigned kdst = lds0 + LDS_K + wid * 1024, vdst = lds0 + LDS_V + wid * 1024, xdst = lds0 + LDS_K + 8192;
    const bool xl = (lane >> 3) == wid;
#define DMA_KX(Kb, KXb, NTv, p, slot) do { glds16s((Kb) + (long)((NTv) - 1 - (p)) * KVBLK * PITCH, koff, (unsigned)__builtin_amdgcn_readfirstlane(kdst + (slot))); \
        if (xl) glds16s((KXb) + (long)((NTv) - 1 - (p)) * KVBLK * 8, xoff, (unsigned)__builtin_amdgcn_readfirstlane(xdst + (slot))); } while (0)
#define DMA_VX(Vb, NTv, p, slot) glds16s((Vb) + (long)((NTv) - 1 - (p)) * KVBLK * PITCH, voff, (unsigned)__builtin_amdgcn_readfirstlane(vdst + (slot)))
#define DMA_K(p, slot) DMA_KX(Kh, KXh, NT, p, slot)
#define DMA_V(p, slot) DMA_VX(Vh, NT, p, slot)
    bf16x8 kf[10];
    const lds_cptr shm3 = (lds_cptr)shm; const lds_cptr kp0 = shm3 + LDS_K + hi * 1024 + r32 * 16; const lds_cptr kx0 = shm3 + LDS_K + 8192 + r32 * 16;
    const lds_cptr vp0 = shm3 + LDS_V + ((lane >> 4) & 1) * 32 + (lane & 3) * 8 + (4 * hi + ((lane & 15) >> 2)) * 64;
    if (!pre) { DMA_K(0, 0); DMA_V(0, 0); DMA_K(1, SLOTB); }
    bf16x8 qr[4];
#pragma unroll
    for (int d0 = 0; d0 < 4; ++d0) qr[d0] = *(const bf16x8*)(Qw + (long)r32 * PITCH + d0 * 16 + hi * 8);
    const int qrel = wid * 32 + r32;
    const float ct = cb[q0 + qrel];
    float mhat = 0.f, l_reg = 0.f; f32x16 o[2]; o[0] = f32x16{}; o[1] = f32x16{};
    bf16x8 qx = qx_build(ct, hi);
    const f32x16 z16 = f32x16{};
#define CMASK(P0, P1, p) do { const int jb_ = 3 - (p); if (jb_ >= 0) cmask(P0, P1, jb_, qrel, hi); } while (0)
    bool resc = false;
#define RESC() do { if (resc) { asm volatile("s_waitcnt lgkmcnt(0)" ::: "memory"); \
      _Pragma("unroll") for (int d_ = 0; d_ < 2; ++d_) _Pragma("unroll") for (int r = 0; r < 16; ++r) o[d_][r] *= wsf[crow(r, hi)]; } } while (0)
    f32x16 pA0, pA1, pB0, pB1;
    int sl_prev = 0, sl_cur = 0, sl_next = SLOTB;
#define ROT() do { sl_prev = sl_cur; sl_cur = sl_next; sl_next = (sl_next == (NSLOT - 1) * SLOTB) ? 0 : sl_next + SLOTB; } while (0)
    if (!pre) { DMA_K(2, 2 * SLOTB); }
    if (pre) { WAIT_BAR(0); } else WAIT_BAR(5);
    if (tid < NT) clt[tid] = clv;
    float qkb;
    { float q2 = 0.f;
#pragma unroll
      for (int d0 = 0; d0 < 4; ++d0)
#pragma unroll
          for (int j = 0; j < 8; ++j) { const float e = __uint_as_float(((unsigned)(unsigned short)qr[d0][j]) << 16); q2 += e * e; }
      q2 = att::swap_lo(q2) + att::swap_hi(q2); qkb = sqrtf(q2) * kmax + ct + WIN_T; }
    { const LAS char* kb = (const LAS char*)shm + LDS_K + hi * 1024 + r32 * 16; const LAS char* kxb = (const LAS char*)shm + LDS_K + 8192 + r32 * 16;
      pA0 = MFMA32(*(const LAS bf16x8*)(kxb), qx, z16); pA1 = MFMA32(*(const LAS bf16x8*)(kxb + 512), qx, z16);
#pragma unroll
      for (int d0 = 0; d0 < 4; ++d0) { pA0 = MFMA32(*(const LAS bf16x8*)(kb + d0 * 2048), qr[d0], pA0); pA1 = MFMA32(*(const LAS bf16x8*)(kb + d0 * 2048 + 512), qr[d0], pA1); } }
    asm volatile("s_nop 15\n\ts_nop 7" : "+v"(pA0), "+v"(pA1)); CMASK(pA0, pA1, 0);
    { float a = fmaxf(pA0[0], pA1[0]);
#pragma unroll
      for (int r = 1; r < 16; ++r) a = fmaxf(a, fmaxf(pA0[r], pA1[r]));
      a = fmaxf(att::swap_lo(a), att::swap_hi(a));
      const float dl = fmaxf(a, FLOOR); mhat = dl;
#pragma unroll
      for (int r = 0; r < 16; ++r) { pA0[r] = __builtin_amdgcn_exp2f(pA0[r] - dl); pA1[r] = __builtin_amdgcn_exp2f(pA1[r] - dl); }
      qx = qx_build(ct - mhat, hi); asm volatile("" : "+v"(qx)); }
    WAIT_BAR(0);
    DMA_K(3, 0); DMA_V(1, SLOTB);
    ROT();
    kload2(kf, kp0 + sl_cur, 0); kload2(kf, kp0 + sl_cur, 1); kload2(kf, kp0 + sl_cur, 2); kload2(kf, kp0 + sl_cur, 3);
    kf[8] = *(const LAS bf16x8*)(kx0 + sl_cur); kf[9] = *(const LAS bf16x8*)(kx0 + sl_cur + 512);
    WAIT_BAR(3);
    s16x4 vlo[8], vhi[8]; u32x4 pw0, pw1, pw2, pw3;
#define PKW(P, B) cvt_pk_bf16(P[B], P[B + 1])
#define PAF(k) __builtin_bit_cast(bf16x8, pw##k)
#define VFR(i) (bf16x8){vlo[i][0], vlo[i][1], vlo[i][2], vlo[i][3], vhi[i][0], vhi[i][1], vhi[i][2], vhi[i][3]}
#define PIN(x) asm volatile("" : "+v"(x))
#define MX3(a, b, c) __builtin_fmaxf(__builtin_fmaxf((a), (b)), (c))
#define GAPA(MF, A0, A1, A2, A3, W0, W1, PW) do { MF; sacc += A0; sacc += A1; sacc += A2; sacc += A3; PIN(sacc); W0; W1; PIN(PW); SBAR(); } while (0)
#define EX(v) __builtin_amdgcn_exp2f(v)
#define GAPB(MF, X, B) do { MF; X[B] = EX(X[B]); X[B + 1] = EX(X[B + 1]); X[B + 2] = EX(X[B + 2]); X[B + 3] = EX(X[B + 3]); PIN(X); SBAR(); } while (0)
#define VRD(i) do { vlo[i] = vtr(vp_ + (((i) >> 2) * 4096 + ((i) & 3) * 1024)); vhi[i] = vtr(vp_ + (((i) >> 2) * 4096 + ((i) & 3) * 1024 + 512)); } while (0)
#define KRD(G, j) do { if (G) { kload2(kf, kp0 + sl_next, j); SBAR(); } } while (0)
#define KRDX(G) do { if (G) { kf[8] = *(const LAS bf16x8*)(kx0 + sl_next); kf[9] = *(const LAS bf16x8*)(kx0 + sl_next + 512); SBAR(); } } while (0)
#define STEP(C0, C1, P0, P1, t, GK, GV, GL) do { SBAR(); \
    const lds_cptr vp_ = vp0 + sl_prev; \
    C0 = MFMA32(kf[8], qx, z16); C1 = MFMA32(kf[9], qx, z16); SBAR(); \
    VRD(0); SBAR(); float sacc = (P0[0] + P0[1]); \
    GAPA(C0 = MFMA32(kf[0], qr[0], C0), P0[2], P0[3], P0[4], P0[5],     pw0[0] = PKW(P0, 0), pw0[1] = PKW(P0, 2), pw0); \
    VRD(4); SBAR(); GAPA(C1 = MFMA32(kf[1], qr[0], C1), P0[6], P0[7], P0[8], P0[9],     pw0[2] = PKW(P0, 4), pw0[3] = PKW(P0, 6), pw0); \
    VRD(1); SBAR(); GAPA(C0 = MFMA32(kf[2], qr[1], C0),   P0[10], P0[11], P0[12], P0[13], pw1[0] = PKW(P0, 8), pw1[1] = PKW(P0, 10), pw1); \
    VRD(5); SBAR(); GAPA(C1 = MFMA32(kf[3], qr[1], C1),   P0[14], P0[15], P1[0], P1[1],   pw1[2] = PKW(P0, 12), pw1[3] = PKW(P0, 14), pw1); \
    VRD(2); SBAR(); GAPA(C0 = MFMA32(kf[4], qr[2], C0),   P1[2], P1[3], P1[4], P1[5],     pw2[0] = PKW(P1, 0), pw2[1] = PKW(P1, 2), pw2); \
    VRD(6); SBAR(); GAPA(C1 = MFMA32(kf[5], qr[2], C1),   P1[6], P1[7], P1[8], P1[9],     pw2[2] = PKW(P1, 4), pw2[3] = PKW(P1, 6), pw2); \
    VRD(3); SBAR(); GAPA(C0 = MFMA32(kf[6], qr[3], C0),   P1[10], P1[11], P1[12], P1[13], pw3[0] = PKW(P1, 8), pw3[1] = PKW(P1, 10), pw3); \
    VRD(7); SBAR(); GAPA(C1 = MFMA32(kf[7], qr[3], C1),   P1[14], P1[15], 0.f, 0.f,       pw3[2] = PKW(P1, 12), pw3[3] = PKW(P1, 14), pw3); \
    l_reg += sacc; \
    if (GK) { DMA_K((t) + 3, sl_cur); } if (GV) { DMA_V((t) + 1, sl_next); } \
    CMASK(C0, C1, t); \
    { float a = MX3(C0[0], C0[1], C1[0]), b_ = MX3(C0[2], C0[3], C1[1]); a = MX3(a, C1[2], C1[3]); \
      _Pragma("unroll") for (int r = 4; r < 16; r += 4) { a = MX3(a, C0[r], C0[r + 1]); b_ = MX3(b_, C0[r + 2], C0[r + 3]); a = MX3(a, C1[r], C1[r + 1]); b_ = MX3(b_, C1[r + 2], C1[r + 3]); } \
      float rm = __builtin_fmaxf(a, b_); { auto rr = __builtin_amdgcn_permlane32_swap(__float_as_uint(rm), __float_as_uint(rm), false, false); rm = __builtin_fmaxf(__uint_as_float(rr[0]), __uint_as_float(rr[1])); } \
      resc = false; \
      if (__builtin_expect(__any(rm > (float)THRL), 0)) { const float dl = __builtin_fmaxf(rm, 0.f); mhat += dl; \
        _Pragma("unroll") for (int r = 0; r < 16; ++r) { C0[r] -= dl; C1[r] -= dl; } \
        qx = qx_build(ct - mhat, hi); asm volatile("" : "+v"(qx)); \
        const float f = __builtin_amdgcn_exp2f(-dl); l_reg *= f; if (hi == 0) wsf[r32] = f; resc = true; } } \
    SBAR(); \
    GAPB(o[0] = MFMA32(PAF(0), VFR(0), o[0]), C0, 0); \
    KRDX(GL); GAPB(o[1] = MFMA32(PAF(0), VFR(4), o[1]), C0, 4); \
    KRD(GL, 0); GAPB(o[0] = MFMA32(PAF(1), VFR(1), o[0]), C0, 8); \
    KRD(GL, 1); GAPB(o[1] = MFMA32(PAF(1), VFR(5), o[1]), C0, 12); \
    KRD(GL, 2); GAPB(o[0] = MFMA32(PAF(2), VFR(2), o[0]), C1, 0); \
    KRD(GL, 3); GAPB(o[1] = MFMA32(PAF(2), VFR(6), o[1]), C1, 4); \
    GAPB(o[0] = MFMA32(PAF(3), VFR(3), o[0]), C1, 8); \
    GAPB(o[1] = MFMA32(PAF(3), VFR(7), o[1]), C1, 12); \
    } while (0)
#define ENDW(tt) do { if ((tt) + 3 < NTe) { WAIT_BAR(3); } else if ((tt) + 2 < NTe) { WAIT_BAR(1); } else { WAIT_BAR(0); } } while (0)
#define VOTE(u) do { const int ts_ = NT - (u) - 3; bool ok_ = false; if (ts_ >= 0) { ok_ = __all((qkb - mhat) < clt[ts_]); } if (lane == 0) votes[wid] = ok_ ? 1u : 0u; } while (0)
#define TALLY(u) do { const u32x4 va_ = *(const LAS u32x4*)votes, vb_ = *(const LAS u32x4*)(votes + 4); \
        if (__builtin_amdgcn_readfirstlane((va_.x & va_.y & va_.z & va_.w & vb_.x & vb_.y & vb_.z & vb_.w) != 0u)) { if ((u) + 2 < NTe) { NTe = (u) + 2; WAIT_BAR(0); } } } while (0)
    int t = 1;
    for (; t + 1 < NTe && t < 5; t += 2) {
        STEP(pB0, pB1, pA0, pA1, t, (t + 3 < NTe), (t + 1 < NTe), (t + 1 < NTe));       ENDW(t);     RESC(); ROT();
        STEP(pA0, pA1, pB0, pB1, t + 1, (t + 4 < NTe), (t + 2 < NTe), (t + 2 < NTe));   VOTE(t + 1); ENDW(t + 1); TALLY(t + 1); RESC(); ROT();
    }
#undef CMASK
#define CMASK(P0, P1, p) do {} while (0)
    for (; t + 5 < NTe; t += 2) {
        STEP(pB0, pB1, pA0, pA1, t, true, true, true);       WAIT_BAR(3); RESC(); ROT();
        STEP(pA0, pA1, pB0, pB1, t + 1, true, true, true);   VOTE(t + 1); WAIT_BAR(3); TALLY(t + 1); RESC(); ROT();
    }
    for (; t + 1 < NTe; t += 2) {
        STEP(pB0, pB1, pA0, pA1, t, (t + 3 < NTe), (t + 1 < NTe), (t + 1 < NTe));       ENDW(t);     RESC(); ROT();
        STEP(pA0, pA1, pB0, pB1, t + 1, (t + 4 < NTe), (t + 2 < NTe), (t + 2 < NTe));   ENDW(t + 1); RESC(); ROT();
    }
#undef CMASK
#define CMASK(P0, P1, p) do { const int jb_ = 3 - (p); if (jb_ >= 0) cmask(P0, P1, jb_, qrel, hi); } while (0)
    STEP(pB0, pB1, pA0, pA1, NTe - 1, false, false, false); RESC();
    { float sacc = pB0[0] + pB0[1];
#pragma unroll
      for (int r = 2; r < 16; ++r) sacc += pB0[r];
#pragma unroll
      for (int r = 0; r < 16; ++r) sacc += pB1[r];
      l_reg += sacc;
      pw0 = (u32x4){PKW(pB0, 0), PKW(pB0, 2), PKW(pB0, 4), PKW(pB0, 6)}; pw1 = (u32x4){PKW(pB0, 8), PKW(pB0, 10), PKW(pB0, 12), PKW(pB0, 14)};
      pw2 = (u32x4){PKW(pB1, 0), PKW(pB1, 2), PKW(pB1, 4), PKW(pB1, 6)}; pw3 = (u32x4){PKW(pB1, 8), PKW(pB1, 10), PKW(pB1, 12), PKW(pB1, 14)};
      SBAR(); att::pv(o, (int)(unsigned)(uintptr_t)(vp0 + sl_cur), PAF(0), PAF(1), PAF(2), PAF(3)); }
    if (nbh >= 0) { asm volatile("s_waitcnt lgkmcnt(0)\n\ts_barrier" ::: "memory");
        const int NTn = (nqb * QB + QB) / KVBLK; const bf16_t* Kn = K + (long)(nbh >> 3) * SEQ * PITCH + (nbh & 7) * HD; const bf16_t* Vn = V + (long)(nbh >> 3) * SEQ * PITCH + (nbh & 7) * HD; const bf16_t* KXn = KXall + (size_t)nbh * SEQ * 8;
        DMA_KX(Kn, KXn, NTn, 0, 0); DMA_VX(Vn, NTn, 0, 0); DMA_KX(Kn, KXn, NTn, 1, SLOTB); DMA_KX(Kn, KXn, NTn, 2, 2 * SLOTB); }
    l_reg = att::swap_lo(l_reg) + att::swap_hi(l_reg);
    if (hi == 0) wsf[32 + r32] = l_reg; asm volatile("s_waitcnt lgkmcnt(0)" ::: "memory");
    float rli[16];
#pragma unroll
    for (int r = 0; r < 16; ++r) rli[r] = __builtin_amdgcn_rcpf(wsf[32 + crow(r, hi)]);
    bf16_t* Ow = O + (rowbase + q0 + wid * 32) * OPITCH + h * HD;
    { LAS bf16_t* stg = (LAS bf16_t*)(shm + LDS_OST) + wid * 2048;
#pragma unroll
      for (int r = 0; r < 16; ++r) { const int orow = crow(r, hi);
#pragma unroll
        for (int d0 = 0; d0 < 2; ++d0) stg[orow * 64 + d0 * 32 + r32] = (bf16_t)(cvt_pk_bf16(o[d0][r] * rli[r], 0.f) & 0xffffu); }
      asm volatile("s_waitcnt lgkmcnt(0)" ::: "memory");
#pragma unroll
      for (int i = 0; i < 4; ++i) { const int row = i * 8 + (lane >> 3), ch = lane & 7; const u32x4 v = *(const LAS u32x4*)(stg + row * 64 + ch * 8); *(u32x4*)(Ow + (long)row * OPITCH + ch * 8) = v;
        att::store_row_ssq(v, hs + (rowbase + q0 + wid * 32 + row) * 16, ch); } }
    asm volatile("s_waitcnt lgkmcnt(0)\n\ts_barrier" ::: "memory");
#undef DMA_K
#undef DMA_V
#undef DMA_KX
#undef DMA_VX
#undef CMASK
#undef RESC
#undef ROT
#undef PKW
#undef PAF
#undef VFR
#undef PIN
#undef MX3
#undef GAPA
#undef GAPB
#undef EX
#undef VRD
#undef KRD
#undef KRDX
#undef STEP
#undef ENDW
#undef VOTE
#undef TALLY
}
#undef SBAR
#undef WAIT_BAR
}


namespace sbk {
constexpr int QB = 256, KVBLK = 64, PITCH = HW, OPITCH = DM, NBURST = 6, SLOTB = 8192;
constexpr int LDS_K = 0, LDS_V = NBURST * SLOTB, LDS_FLAG = 2 * NBURST * SLOTB, LDS_END = LDS_FLAG + 128;
static_assert(LDS_END <= RING_BYTES, "sb LDS");
using att::crow; using att::glds16s; using att::qkt; using att::pv; using att::swap_lo;
__device__ __forceinline__ void sb_tile(const LAS char* Kslot, int vb, const bf16x8* qr, bf16x8 TD0, bf16x8 TD1, bf16x8 TONE, int jb, int qrel, int r32, int hi, float& R, f32x16* o) {
    f32x16 p0, p1; const f32x16 z16 = f32x16{};
    qkt(p0, p1, Kslot, qr, z16, r32, hi);
    if (jb >= 0) {
#pragma unroll
        for (int r = 0; r < 16; ++r) { const int kv = 64 * jb + crow(r, hi); if (kv >= qrel) p0[r] = -1.0e30f; if (kv + 32 >= qrel) p1[r] = -1.0e30f; } }
    f32x16 l0, l1;
#pragma unroll
    for (int r = 0; r < 16; ++r) {
        l0[r] = -(fmaxf(p0[r], 0.f) + __builtin_amdgcn_logf(1.0f + __builtin_amdgcn_exp2f(-fabsf(p0[r]))));
        l1[r] = -(fmaxf(p1[r], 0.f) + __builtin_amdgcn_logf(1.0f + __builtin_amdgcn_exp2f(-fabsf(p1[r])))); }
    u32x4 lw0 = {cvt_pk_bf16(l0[0], l0[1]), cvt_pk_bf16(l0[2], l0[3]), cvt_pk_bf16(l0[4], l0[5]), cvt_pk_bf16(l0[6], l0[7])};
    u32x4 lw1 = {cvt_pk_bf16(l0[8], l0[9]), cvt_pk_bf16(l0[10], l0[11]), cvt_pk_bf16(l0[12], l0[13]), cvt_pk_bf16(l0[14], l0[15])};
    u32x4 lw2 = {cvt_pk_bf16(l1[0], l1[1]), cvt_pk_bf16(l1[2], l1[3]), cvt_pk_bf16(l1[4], l1[5]), cvt_pk_bf16(l1[6], l1[7])};
    u32x4 lw3 = {cvt_pk_bf16(l1[8], l1[9]), cvt_pk_bf16(l1[10], l1[11]), cvt_pk_bf16(l1[12], l1[13]), cvt_pk_bf16(l1[14], l1[15])};
    f32x16 rt;
#pragma unroll
    for (int r = 0; r < 16; ++r) rt[r] = R;
    f32x16 t0 = MFMA32(TD0, __builtin_bit_cast(bf16x8, lw0), rt); t0 = MFMA32(TD1, __builtin_bit_cast(bf16x8, lw1), t0);
    t0 = MFMA32(TONE, __builtin_bit_cast(bf16x8, lw2), t0); t0 = MFMA32(TONE, __builtin_bit_cast(bf16x8, lw3), t0);
    f32x16 t1 = MFMA32(TD0, __builtin_bit_cast(bf16x8, lw2), rt); t1 = MFMA32(TD1, __builtin_bit_cast(bf16x8, lw3), t1);
#pragma unroll
    for (int r = 0; r < 16; ++r) { p0[r] = __builtin_amdgcn_exp2f(p0[r] + t0[r]); p1[r] = __builtin_amdgcn_exp2f(p1[r] + t1[r]); }
    R = swap_lo(t0[0]);
    u32x4 pw0 = {cvt_pk_bf16(p0[0], p0[1]), cvt_pk_bf16(p0[2], p0[3]), cvt_pk_bf16(p0[4], p0[5]), cvt_pk_bf16(p0[6], p0[7])};
    u32x4 pw1 = {cvt_pk_bf16(p0[8], p0[9]), cvt_pk_bf16(p0[10], p0[11]), cvt_pk_bf16(p0[12], p0[13]), cvt_pk_bf16(p0[14], p0[15])};
    u32x4 pw2 = {cvt_pk_bf16(p1[0], p1[1]), cvt_pk_bf16(p1[2], p1[3]), cvt_pk_bf16(p1[4], p1[5]), cvt_pk_bf16(p1[6], p1[7])};
    u32x4 pw3 = {cvt_pk_bf16(p1[8], p1[9]), cvt_pk_bf16(p1[10], p1[11]), cvt_pk_bf16(p1[12], p1[13]), cvt_pk_bf16(p1[14], p1[15])};
    pv(o, vb, __builtin_bit_cast(bf16x8, pw0), __builtin_bit_cast(bf16x8, pw1), __builtin_bit_cast(bf16x8, pw2), __builtin_bit_cast(bf16x8, pw3));
}
#define SB_WAITBAR(N) asm volatile("s_waitcnt vmcnt(" #N ") lgkmcnt(0)\n\ts_barrier" ::: "memory")
__device__ __forceinline__ void sb_unit(int b, int h, int qb, const bf16_t* Q, const bf16_t* K, const bf16_t* V, bf16_t* O, float* hs, LAS char* shm) {
    int tid = threadIdx.x; asm volatile("" : "+v"(tid)); const int lane = tid & 63, r32 = lane & 31, hi = lane >> 5; const int wid = __builtin_amdgcn_readfirstlane(tid >> 6);
    const long rowbase = (long)b * SEQ; const int q0 = qb * QB;
    const bf16_t* Qw = Q + (rowbase + q0 + wid * 32) * PITCH + h * HD;
    const bf16_t* Kh = K + rowbase * PITCH + h * HD; const bf16_t* Vh = V + rowbase * PITCH + h * HD;
    const unsigned lds0 = (unsigned)(uintptr_t)shm;
    LAS unsigned* flags = (LAS unsigned*)(shm + LDS_FLAG);
    const unsigned koff = (unsigned)(lane * PITCH + wid * 8) * 2u, voff = (unsigned)((16 * (wid & 3) + (lane >> 2)) * PITCH + (wid >> 2) * 32 + (lane & 3) * 8) * 2u;
    const unsigned kdst = lds0 + LDS_K + wid * 1024, vdst = lds0 + LDS_V + wid * 1024;
#define SB_DMA(p, slot) do { glds16s(Kh + (long)(NT - 1 - (p)) * KVBLK * PITCH, koff, (unsigned)__builtin_amdgcn_readfirstlane(kdst + (slot) * SLOTB)); \
        glds16s(Vh + (long)(NT - 1 - (p)) * KVBLK * PITCH, voff, (unsigned)__builtin_amdgcn_readfirstlane(vdst + (slot) * SLOTB)); } while (0)
    const int vb0 = (int)(lds0 + LDS_V) + ((lane >> 4) & 1) * 32 + (lane & 3) * 8 + (4 * hi + ((lane & 15) >> 2)) * 64;
    const int NT = (q0 + QB) / KVBLK, NB = NT < NBURST ? NT : NBURST;
    for (int p = 0; p < NB; ++p) SB_DMA(p, p);
    bf16x8 qr[4];
#pragma unroll
    for (int d0 = 0; d0 < 4; ++d0) qr[d0] = *(const bf16x8*)(Qw + (long)r32 * PITCH + d0 * 16 + hi * 8);
    f32x16 o[2]; o[0] = f32x16{}; o[1] = f32x16{};
    const int qrel = wid * 32 + r32;
    float R = 0.f;
    bf16x8 TD0, TD1, TONE;
#pragma unroll
    for (int j = 0; j < 8; ++j) { const int kvl = 8 * (j >> 2) + 4 * hi + (j & 3); TD0[j] = (kvl >= r32) ? (short)0x3F80 : (short)0; TD1[j] = (16 + kvl >= r32) ? (short)0x3F80 : (short)0; TONE[j] = (short)0x3F80; }
    if (NB > 4) { SB_WAITBAR(4); } else { SB_WAITBAR(0); }
    bool mid_done = (NB <= 4);
    int p = 3 - (wid >> 1);
    for (; p < NB; ++p) {
        if (p >= 4 && !mid_done) { SB_WAITBAR(0); mid_done = true; }
        sb_tile(shm + LDS_K + p * SLOTB, vb0 + p * SLOTB, qr, TD0, TD1, TONE, 3 - p, qrel, r32, hi, R, o);
        if (__all(R < SB_EXIT)) { ++p; break; }
    }
    if (!mid_done) { SB_WAITBAR(0); }
    { const bool dn = __all(R < SB_EXIT) || (p >= NT); if (lane == 0) flags[wid] = dn ? 1u : 0u; }
    SB_WAITBAR(0);
    bool alldone;
    { const u32x4 fa = *(const LAS u32x4*)flags, fb = *(const LAS u32x4*)(flags + 4); alldone = __builtin_amdgcn_readfirstlane((fa.x & fa.y & fa.z & fa.w & fb.x & fb.y & fb.z & fb.w) != 0u); }
    if (!alldone && NB < NT) {
        SB_DMA(NB, 0);
        for (int i = 0; NB + i < NT; ++i) {
            const int pp = NB + i, sl = i & 1;
            SB_WAITBAR(0);
            if (i > 0) { const LAS unsigned* fl = flags + 8 + ((i - 1) & 1) * 8; const u32x4 fa = *(const LAS u32x4*)fl, fb = *(const LAS u32x4*)(fl + 4);
                if (__builtin_amdgcn_readfirstlane((fa.x & fa.y & fa.z & fa.w & fb.x & fb.y & fb.z & fb.w) != 0u)) break; }
            if (pp + 1 < NT) SB_DMA(pp + 1, sl ^ 1);
            if (!__all(R < SB_EXIT)) sb_tile(shm + LDS_K + sl * SLOTB, vb0 + sl * SLOTB, qr, TD0, TD1, TONE, -1, qrel, r32, hi, R, o);
            { const bool dn = __all(R < SB_EXIT); if (lane == 0) flags[8 + (i & 1) * 8 + wid] = dn ? 1u : 0u; }
        }
        SB_WAITBAR(0);
    }
    bf16_t* Ow = O + (rowbase + q0 + wid * 32) * OPITCH + h * HD;
    { LAS bf16_t* stg = (LAS bf16_t*)(shm + LDS_K) + wid * 2048;
#pragma unroll
      for (int r = 0; r < 16; ++r) { const int orow = crow(r, hi);
#pragma unroll
        for (int d0 = 0; d0 < 2; ++d0) stg[orow * 64 + d0 * 32 + r32] = (bf16_t)(cvt_pk_bf16(o[d0][r], 0.f) & 0xffffu); }
      LDS_WAIT();
#pragma unroll
      for (int i = 0; i < 4; ++i) { const int row = i * 8 + (lane >> 3), ch = lane & 7; const u32x4 v = *(const LAS u32x4*)(stg + row * 64 + ch * 8); *(u32x4*)(Ow + (long)row * OPITCH + ch * 8) = v;
        att::store_row_ssq(v, hs + (rowbase + q0 + wid * 32 + row) * 16, ch); } }
    asm volatile("s_waitcnt vmcnt(0) lgkmcnt(0)\n\ts_barrier" ::: "memory");
#undef SB_DMA
}
#undef SB_WAITBAR
}

#define XB_TMO      128
#define XB_XCNT(j)  (256  + 64 * (j))
#define XB_XSUB(j)  (1280 + 64 * (j))
#define XB_XGEN(j)  (2304 + 64 * (j))
#define XB_TOP      3328
#define XB_TOPGEN   3392
#define XCD_BAR_WORDS 3456
#define XB_SPIN_CAP (1u << 18)
__device__ __forceinline__ unsigned xb_ld(unsigned* p)              { return __hip_atomic_load(p, __ATOMIC_RELAXED, __HIP_MEMORY_SCOPE_AGENT); }
__device__ __forceinline__ unsigned xb_add(unsigned* p, unsigned v) { return __hip_atomic_fetch_add(p, v, __ATOMIC_RELAXED, __HIP_MEMORY_SCOPE_AGENT); }
__device__ __forceinline__ unsigned xb_xcc_id() { return (unsigned)__builtin_amdgcn_s_getreg((3 << 11) | 20) & 0xFu; }
#define XB_SPIN(cond, bar) do { unsigned _sp = 0; while (cond) { __builtin_amdgcn_s_sleep(1); \
    if ((++_sp & 255u) == 0u) { if (xb_ld(&(bar)[XB_TMO])) break; if (_sp > XB_SPIN_CAP) { atomicAdd(&(bar)[XB_TMO], 1u); break; } } } } while (0)
struct XcdBarrier { unsigned* bar; unsigned x; volatile LAS unsigned* st; };
__device__ __forceinline__ XcdBarrier xcd_barrier_post(unsigned* bar, volatile LAS unsigned* st) {
    XcdBarrier b; b.bar = bar; b.x = xb_xcc_id(); b.st = st;
    if (threadIdx.x == 0) (void)xb_add(&bar[XB_XCNT(b.x)], 1u);
    return b;
}
__device__ __forceinline__ void xcd_barrier_complete(unsigned* bar, unsigned x, unsigned& nloc, unsigned& nx) {
    const unsigned G = gridDim.x * gridDim.y * gridDim.z;
    unsigned sum, cnt, mine, sp = 0u;
    for (;;) {
        sum = 0u; cnt = 0u; mine = 0u;
#pragma unroll
        for (unsigned j = 0; j < 16; ++j) { const unsigned c = xb_ld(&bar[XB_XCNT(j)]); sum += c; cnt += (c > 0u) ? 1u : 0u; mine = (j == x) ? c : mine; }
        if (sum == G) break;
        __builtin_amdgcn_s_sleep(1);
        if ((++sp & 255u) == 0u) { if (xb_ld(&bar[XB_TMO])) break; if (sp > XB_SPIN_CAP) { atomicAdd(&bar[XB_TMO], 1u); break; } }
    }
    nloc = mine > 0u ? mine : 1u; nx = cnt > 0u ? cnt : 1u;
}
__device__ __forceinline__ void xcd_barrier(const XcdBarrier& b) {
    asm volatile("s_waitcnt vmcnt(0)" ::: "memory");
    __syncthreads();
    if (threadIdx.x == 0) {
        unsigned* bar = b.bar;
        __builtin_amdgcn_s_waitcnt(0);
        unsigned nloc = b.st[0], nx = b.st[1];
        if (nloc == 0u) { xcd_barrier_complete(bar, b.x, nloc, nx); b.st[0] = nloc; b.st[1] = nx; }
        const unsigned old = xb_add(&bar[XB_XSUB(b.x)], 1u);
        const unsigned gen = old / nloc;
        if (old + 1u == (gen + 1u) * nloc) {
            __builtin_amdgcn_fence(__ATOMIC_RELEASE, "agent");
            asm volatile("s_waitcnt vmcnt(0)" ::: "memory");
            const unsigned og = xb_add(&bar[XB_TOP], 1u);
            const unsigned tg = og / nx;
            if (og + 1u == (tg + 1u) * nx) xb_add(&bar[XB_TOPGEN], 1u);
            else XB_SPIN(xb_ld(&bar[XB_TOPGEN]) == tg, bar);
            __builtin_amdgcn_fence(__ATOMIC_ACQUIRE, "agent");
            xb_add(&bar[XB_XGEN(b.x)], 1u);
            asm volatile("s_waitcnt vmcnt(0)" ::: "memory");
        } else {
            XB_SPIN(xb_ld(&bar[XB_XGEN(b.x)]) == gen, bar);
            __builtin_amdgcn_fence(__ATOMIC_ACQUIRE, "agent");
            asm volatile("s_waitcnt vmcnt(0)" ::: "memory");
        }
    }
    __syncthreads();
}

__device__ __forceinline__ const void* ldp(const volatile LAS unsigned* tab, int i) {
    const unsigned lo = __builtin_amdgcn_readfirstlane(tab[2 * i]), hi = __builtin_amdgcn_readfirstlane(tab[2 * i + 1]);
    return (const void*)(const GAS void*)(((unsigned long long)hi << 32) | lo);
}
struct Args {
    const float* x; const float* mem; const float* norm_mix; const float* w_in; const float* b_forget; const float* norm_fox; const float* norm_sb; const float* w_out;
    const float* norm_xattn; const float* norm_mem; const float* w_xq; const float* w_xkv; const float* w_xo; const float* norm_ffn;
    const float* w_rg; const float* b_rg; const float* w_re; const float* b_re; const float* w_gate; const float* w_up; const float* w_down; const float* norm_final;
    float* out; unsigned char* ws;
};

__device__ __forceinline__ void transpose_item(const float* W, int ldw, bf16_t* WT, int ldo, int k0, int n0, int dst_row0, const float* gain, LAS float* scr, int lane) {
    float tv[32], tg[32];
#pragma unroll
    for (int i = 0; i < 32; ++i) { const int kk = 2 * i + (lane >> 5); tv[i] = __builtin_nontemporal_load(W + (size_t)(k0 + kk) * ldw + n0 + (lane & 31)); tg[i] = gain ? gain[k0 + kk] : 1.f; }
#pragma unroll
    for (int i = 0; i < 32; ++i) { const int kk = 2 * i + (lane >> 5); scr[kk * 33 + (lane & 31)] = tv[i] * tg[i]; }
    LDS_WAIT(); asm volatile("" ::: "memory");
    const int c = lane & 7;
#pragma unroll
    for (int j = 0; j < 4; ++j) { const int n = (lane >> 3) + 8 * j; const LAS float* s = scr + (8 * c) * 33 + n;
        u32x4 o; o.x = cvt_pk_bf16(s[0 * 33], s[1 * 33]); o.y = cvt_pk_bf16(s[2 * 33], s[3 * 33]); o.z = cvt_pk_bf16(s[4 * 33], s[5 * 33]); o.w = cvt_pk_bf16(s[6 * 33], s[7 * 33]);
        *(u32x4*)(WT + (size_t)(dst_row0 + n) * ldo + k0 + 8 * c) = o; }
    LDS_WAIT(); asm volatile("" ::: "memory");
}

__device__ __forceinline__ void transpose_item8(const float* W, int ldw, unsigned char* WT, int ldo, int k0, int n0, int dst_row0, const float* gain, float scale, LAS float* scr, int lane) {
    float tv[32], tg[32];
#pragma unroll
    for (int i = 0; i < 32; ++i) { const int kk = 2 * i + (lane >> 5); tv[i] = __builtin_nontemporal_load(W + (size_t)(k0 + kk) * ldw + n0 + (lane & 31)); tg[i] = gain ? gain[k0 + kk] : 1.f; }
#pragma unroll
    for (int i = 0; i < 32; ++i) { const int kk = 2 * i + (lane >> 5); scr[kk * 33 + (lane & 31)] = tv[i] * tg[i] * scale; }
    LDS_WAIT(); asm volatile("" ::: "memory");
    const int c = lane & 7;
#pragma unroll
    for (int j = 0; j < 4; ++j) { const int n = (lane >> 3) + 8 * j; const LAS float* s = scr + (8 * c) * 33 + n;
        u32x2 o; o.x = cvt4_fp8(s[0 * 33], s[1 * 33], s[2 * 33], s[3 * 33]); o.y = cvt4_fp8(s[4 * 33], s[5 * 33], s[6 * 33], s[7 * 33]);
        *(u32x2*)(WT + (size_t)(dst_row0 + n) * ldo + k0 + 8 * c) = o; }
    LDS_WAIT(); asm volatile("" ::: "memory");
}

struct SchedDense {
    const char* A; const char* Bt; int nM, nN, G, c; size_t a_tile, b_tile, b_batch; int split_tiles;
    __device__ __forceinline__ bool next(int i, pg8::Unit& u) const {
        int pm, pn; if (!pg8::tile_order(i, G, c, nM, nN, pm, pn)) return false;
        u.a = A + (size_t)pm * a_tile; u.b = Bt + (size_t)pn * b_tile + (size_t)(pm >> 5) * b_batch; u.orow = pm * 256;
        if (split_tiles) { u.aux = pn / split_tiles; u.ocol = (pn % split_tiles) * 256; } else { u.aux = 1; u.ocol = pn * 256; }
        u.rows = nullptr; u.nvalid = 256; return true;
    }
};
struct SchedGH {
    const char* KVm; const char* Wxq; const char* Wxo; int G, c;
    __device__ __forceinline__ bool next(int i, pg8::Unit& u) const {
        const int L = i * G + c; if (L >= 256) return false;
        const int kind = L >> 7, r = L & 127, bh = r >> 2, j = r & 3, b = bh >> 2, h = bh & 3;
        if (kind == 0) { u.a = KVm + ((size_t)(b * 256) * 2048 + h * 256) * 2; u.b = Wxq + ((size_t)(256 * j) * 1024 + h * 256) * 2; u.orow = b * 1024 + h * 256; u.ocol = 256 * j; u.aux = 1; }
        else { u.a = Wxo + ((size_t)(256 * j) * 1024 + h * 256) * 2; u.b = KVm + ((size_t)(b * 256) * 2048 + 1024 + h * 256) * 2; u.orow = b * 1024 + 256 * j; u.ocol = h * 256; u.aux = 2; }
        u.rows = nullptr; u.nvalid = 256; return true;
    }
};
template <int KIND> struct SchedGHk { SchedGH s; __device__ __forceinline__ bool next(int i, pg8::Unit& u) const { const int c2 = (s.G >= 256) ? s.c - 128 * KIND : s.c; if (c2 < 0) return false; const int L = i * s.G + c2; if (L >= 128) return false; SchedGH t = s; t.G = 1; t.c = 0; return t.next(128 * KIND + L, u); } };
struct EpiGH { static constexpr bool HAS_MID = false; unsigned char* GTp; unsigned char* HTp;
    __device__ __forceinline__ void operator()(const f32x4 (&acc)[2][2][4][2], const pg8::Unit& u, int wr, int wc, int fr, int fq) const {
        unsigned char* base = u.aux == 1 ? GTp : HTp;
#pragma unroll
        for (int ai = 0; ai < 2; ++ai)
#pragma unroll
            for (int m = 0; m < 4; m += 2) { const int row = u.orow + ai * pg8::HALF + wr * 64 + m * 16 + fr + 16 * (fq & 1);
#pragma unroll
                for (int bj = 0; bj < 2; ++bj) { u32x2 w8[2];
#pragma unroll
                    for (int mm = 0; mm < 2; ++mm) { const f32x4 v0 = acc[ai][bj][m + mm][0], v1 = acc[ai][bj][m + mm][1]; w8[mm].x = cvt4_fp8(v0[0], v0[1], v0[2], v0[3]); w8[mm].y = cvt4_fp8(v1[0], v1[1], v1[2], v1[3]); }
                    *(u32x4*)(base + (size_t)row * DM + u.ocol + bj * pg8::HALF + wc * 32 + 8 * (fq & ~1)) = widen16(w8[0], w8[1]); } }
    } };
struct SchedMoe {
    const char* A; const char* W; const int* list; const LAS int* tbl; int G, c, NPN; size_t w_exp, w_tile, a_tile; int ocol_w;
    __device__ __forceinline__ bool next(int i, pg8::Unit& u) const {
        const int L = i * G + c; const int tl = L / NPN, pn = L % NPN;
        if (tl >= __builtin_amdgcn_readfirstlane(tbl[16])) return false;
        int e = 0;
#pragma unroll 1
        for (int x = 1; x < NEXP; ++x) { if (tl >= __builtin_amdgcn_readfirstlane(tbl[x])) e = x; }
        const int j = tl - __builtin_amdgcn_readfirstlane(tbl[e]), n = __builtin_amdgcn_readfirstlane(tbl[32 + e]) - 256 * j;
        u.a = A + (size_t)tl * a_tile; u.b = W + (size_t)e * w_exp + (size_t)pn * w_tile; u.orow = tl * 256; u.ocol = pn * ocol_w; u.aux = 1;
        u.rows = list + (size_t)e * M + 256 * j; u.nvalid = n < 256 ? n : 256; return true;
    }
};
__device__ __forceinline__ void moe_table(LAS int* tbl, const unsigned* ctl) {
    if (threadIdx.x == 0) { int base = 0; for (int e = 0; e < NEXP; ++e) { const int n = (int)ctl[CW_CNT + 64 * e]; tbl[e] = base; tbl[32 + e] = n; base += (n + 255) >> 8; } tbl[16] = base; }
    __syncthreads();
}

__global__ void __launch_bounds__(NWAVES * 64, 2) hymba_fwd(Args args) {
    extern __shared__ __attribute__((aligned(16))) unsigned char lds_raw[];
    LAS unsigned char* lds = (LAS unsigned char*)lds_raw;
    volatile LAS unsigned* MISC = (volatile LAS unsigned*)(lds + MISC_OFF);
    const int tid0 = threadIdx.x; const int wave = __builtin_amdgcn_readfirstlane(tid0 >> 6);
    const int G = gridDim.x; const int bx = blockIdx.x; const int vcu = (G % 8 == 0) ? (bx % 8) * (G / 8) + bx / 8 : bx;
    volatile LAS unsigned* ATAB = (volatile LAS unsigned*)(lds + MISC_OFF + 512);
    for (int u = tid0; u < 256; u += NWAVES * 64) ((LAS unsigned*)(lds + MISC_OFF))[u] = 0u;
    __syncthreads();
    if (tid0 == 0) { const float* const* ap = (const float* const*)&args;
#pragma unroll
        for (int i = 0; i < 24; ++i) { const unsigned long long v = (unsigned long long)ap[i]; ATAB[2 * i] = (unsigned)v; ATAB[2 * i + 1] = (unsigned)(v >> 32); } }
    __syncthreads();
#define ARGP(name) ((const float*)ldp(ATAB, (int)(offsetof(Args, name) / 8)))
#define PHASE_PTRS \
    int tid = threadIdx.x; asm volatile("" : "+v"(tid)); const int lane = tid & 63; (void)lane; \
    unsigned char* const ws = (unsigned char*)ldp(ATAB, 23); float* const out = (float*)ldp(ATAB, 22); unsigned* const ctl = (unsigned*)(ws + WS_CTL); (void)out; (void)ctl; \
    bf16_t* const Win_t = (bf16_t*)(ws + WS_WIN); bf16_t* const Wout_t = (bf16_t*)(ws + WS_WOUT); bf16_t* const Wxq_n = (bf16_t*)(ws + WS_WXQ); bf16_t* const Wxkv_t = (bf16_t*)(ws + WS_WXKV); \
    bf16_t* const Wxo_t = (bf16_t*)(ws + WS_WXO); bf16_t* const Wgu_t = (bf16_t*)(ws + WS_WGU); bf16_t* const Wd_t = (bf16_t*)(ws + WS_WD); \
    float* const RX = (float*)(ws + WS_RX); float* const RMEM = (float*)(ws + WS_RMEM); float* const LF = (float*)(ws + WS_LF); float* const CC = (float*)(ws + WS_C2); float* const SSQ = (float*)(ws + WS_SSQ); \
    int* const TOKSLOT = (int*)(ws + WS_TOKSLOT); float* const TOKW = (float*)(ws + WS_TOKW); int* const LIST = (int*)(ws + WS_LIST); \
    bf16_t* const MEMB = (bf16_t*)(ws + WS_MEMB); bf16_t* const KVM = (bf16_t*)(ws + WS_KVM); bf16_t* const GT = (bf16_t*)(ws + WS_GT); bf16_t* const HT = (bf16_t*)(ws + WS_HT); \
    bf16_t* const XB = (bf16_t*)(ws + WS_XB); bf16_t* const QKV = (bf16_t*)(ws + WS_QKV); bf16_t* const H1B = (bf16_t*)(ws + WS_H1B); bf16_t* const U2B = (bf16_t*)(ws + WS_U2B); bf16_t* const HID = (bf16_t*)(ws + WS_HID); \
    bf16_t* const OAB = (bf16_t*)(ws + WS_O); bf16_t* const YB = (bf16_t*)(ws + WS_Y); bf16_t* const KX = (bf16_t*)(ws + WS_KX); (void)KX; float* const HS = (float*)(ws + WS_HS); (void)HS; float* const R2S = (float*)(ws + WS_SSQ); (void)R2S; unsigned char* const H1F8 = ws + WS_H1F8; (void)H1F8; unsigned char* const H2F8 = ws + WS_H2F8; (void)H2F8; \
    (void)Win_t; (void)Wout_t; (void)Wxq_n; (void)Wxkv_t; (void)Wxo_t; (void)Wgu_t; (void)Wd_t; (void)RX; (void)RMEM; (void)LF; (void)CC; (void)SSQ; (void)TOKSLOT; (void)TOKW; (void)LIST; \
    (void)MEMB; (void)KVM; (void)GT; (void)HT; (void)XB; (void)QKV; (void)H1B; (void)U2B; (void)HID; (void)OAB; (void)YB;
    XcdBarrier bar;
    { unsigned char* const ws0 = (unsigned char*)ldp(ATAB, 23); bar = xcd_barrier_post((unsigned*)(ws0 + WS_CTL) + CW_BAR, MISC + 8); }
    const int gw = vcu * NWAVES + wave, NGW = G * NWAVES;
    unsigned long long t_pa = 0, t_pb = 0; (void)t_pa; (void)t_pb;


    if (PROBE_LO == 0) t_pa = __builtin_amdgcn_s_memrealtime();
    if (PH(0))
    for (int rep_ = 0; rep_ < REPS(0); ++rep_)
    {
        PHASE_PTRS
        LAS float* wfT = (LAS float*)(lds + RING_OFF);
        LAS float* scr = (LAS float*)(lds + RING_OFF + 32768 + wave * 8448);
        { const float* win = ARGP(w_in); const float* gmix = ARGP(norm_mix);
          f32x4 fa[2], fb[2]; float gk[2];
#pragma unroll
          for (int q = 0; q < 2; ++q) { const int k = tid + 512 * q; gk[q] = gmix[k]; fa[q] = *(const f32x4*)(win + (size_t)k * WIN_LD + NPROJ); fb[q] = *(const f32x4*)(win + (size_t)k * WIN_LD + NPROJ + 4); }
#pragma unroll
          for (int q = 0; q < 2; ++q) { const int k = tid + 512 * q;
#pragma unroll
              for (int j = 0; j < 4; ++j) { wfT[j * DM + k] = fa[q][j] * gk[q]; wfT[(4 + j) * DM + k] = fb[q][j] * gk[q]; } } }
        constexpr int I_IN = 16 * 96, I_OUT = 16 * 32, I_XKV = 16 * 64, I_XO = 16 * 32, I_G = 16 * 16 * 8, I_U = I_G, I_D = 16 * 4 * 32, I_XQ = 1024;
        constexpr int NITEMS = I_IN + I_OUT + I_XKV + I_XO + I_G + I_U + I_D + I_XQ;
        for (int it = gw; it < NITEMS; it += NGW) {
            int r = it;
            if (r < I_IN) { const int kb = r / 96, nb = r % 96; transpose_item(ARGP(w_in), WIN_LD, Win_t, DM, 64 * kb, 32 * nb, 32 * nb, ARGP(norm_mix), scr, lane); continue; } r -= I_IN;
            if (r < I_OUT) { const int kb = r / 32, nb = r % 32; const float* gn = (64 * kb < HW) ? ARGP(norm_fox) : (ARGP(norm_sb) - HW); transpose_item(ARGP(w_out), DM, Wout_t, DM, 64 * kb, 32 * nb, 32 * nb, gn, scr, lane); continue; } r -= I_OUT;
            if (r < I_XKV) { const int kb = r / 64, nb = r % 64; transpose_item(ARGP(w_xkv), 2 * DM, Wxkv_t, DM, 64 * kb, 32 * nb, 32 * nb, ARGP(norm_mem), scr, lane); continue; } r -= I_XKV;
            if (r < I_XO) { const int kb = r / 32, nb = r % 32; transpose_item(ARGP(w_xo), DM, Wxo_t, DM, 64 * kb, 32 * nb, 32 * nb, nullptr, scr, lane); continue; } r -= I_XO;
            if (r < I_G + I_U) { const int up = r >= I_G; const int q = up ? r - I_G : r; const int e = q / 128, kb = (q % 128) / 8, nb = q % 8; const int n0 = 32 * nb;
                const float* W = (up ? ARGP(w_up) : ARGP(w_gate)) + (size_t)e * DM * DFF;
                transpose_item8(W, DFF, (unsigned char*)Wgu_t + (size_t)e * 512 * DM, DM, 64 * kb, n0, 256 * (n0 / 128) + (n0 % 128) + (up ? 128 : 0), ARGP(norm_ffn), WGU_SCALE, scr, lane); continue; } r -= I_G + I_U;
            if (r < I_D) { const int e = r / 128, kb = (r % 128) / 32, nb = r % 32; transpose_item8(ARGP(w_down) + (size_t)e * DFF * DM, DM, (unsigned char*)Wd_t + (size_t)e * DM * DFF, DFF, 64 * kb, 32 * nb, 32 * nb, nullptr, WD_SCALE, scr, lane); continue; } r -= I_D;
            { const int k = r; const float gk = ARGP(norm_xattn)[k]; const f32x4* src = (const f32x4*)(ARGP(w_xq) + (size_t)k * DM) + lane; u32x2* dst = (u32x2*)(Wxq_n + (size_t)k * DM) + lane;
#pragma unroll
              for (int j = 0; j < 4; ++j) { const f32x4 v = src[64 * j] * gk; u32x2 w; w.x = cvt_pk_bf16(v[0], v[1]); w.y = cvt_pk_bf16(v[2], v[3]); dst[64 * j] = w; } }
        }
        __syncthreads();
        const float* xin = ARGP(x); const float* memin = ARGP(mem); const float* bfg = ARGP(b_forget);
        constexpr int TOT = M + MEMROWS;
#define P0_LOAD(vv, rw) do { if ((rw) < TOT) { const bool im_ = (rw) >= M; const f32x4* xr_ = (const f32x4*)((im_ ? memin : xin) + (size_t)(im_ ? (rw) - M : (rw)) * DM) + lane; \
        _Pragma("unroll") for (int j = 0; j < 4; ++j) vv[j] = __builtin_nontemporal_load(xr_ + 64 * j); } } while (0)
#define P0_ROW(vv, rw) do { const int row_ = (rw); const bool is_mem = row_ >= M; const int r = is_mem ? row_ - M : row_; float s = 0.f; \
        _Pragma("unroll") for (int j = 0; j < 4; ++j) s += (vv[j][0] * vv[j][0] + vv[j][1] * vv[j][1]) + (vv[j][2] * vv[j][2] + vv[j][3] * vv[j][3]); \
        const float rinv = rsqrtf(wave_sum(s) * (1.0f / DM) + EPS); \
        u32x2* o8 = (u32x2*)((is_mem ? MEMB : XB) + (size_t)r * DM) + lane; \
        _Pragma("unroll") for (int j = 0; j < 4; ++j) { u32x2 w; w.x = cvt_pk_bf16(vv[j][0], vv[j][1]); w.y = cvt_pk_bf16(vv[j][2], vv[j][3]); o8[64 * j] = w; } \
        if (is_mem) { if (lane == 0) RMEM[r] = rinv; } \
        else { float f[8]; \
            _Pragma("unroll") for (int jj = 0; jj < 8; ++jj) { float a = 0.f; \
                _Pragma("unroll") for (int j = 0; j < 4; ++j) { const f32x4 w4 = *(const LAS f32x4*)(wfT + jj * DM + 256 * j + 4 * lane); a += (vv[j][0] * w4[0] + vv[j][1] * w4[1]) + (vv[j][2] * w4[2] + vv[j][3] * w4[3]); } \
                f[jj] = wave_sum(a); } \
            if (lane == 0) RX[r] = rinv; \
            if (lane < 8) { float fl = 0.f; \
                _Pragma("unroll") for (int jj = 0; jj < 8; ++jj) fl = (lane == jj) ? f[jj] : fl; \
                fl = fl * rinv + bfg[lane]; \
                const float ls = fminf(fl, 0.f) - log1pf(expf(-fabsf(fl))); \
                LF[(size_t)r * 8 + lane] = ls * LOG2E; } } } while (0)
        f32x4 va[4], vb[4], vc[4];
        P0_LOAD(va, gw); P0_LOAD(vb, gw + NGW);
        for (int row = gw; row < TOT; row += 3 * NGW) {
            P0_LOAD(vc, row + 2 * NGW); P0_ROW(va, row);
            if (row + NGW < TOT) { P0_LOAD(va, row + 3 * NGW); P0_ROW(vb, row + NGW); }
            if (row + 2 * NGW < TOT) { P0_LOAD(vb, row + 4 * NGW); P0_ROW(vc, row + 2 * NGW); }
        }
#undef P0_LOAD
#undef P0_ROW
    }
    xcd_barrier(bar);
    if (PROBE_HI == 0) t_pb = __builtin_amdgcn_s_memrealtime();

    if (PROBE_LO == 1) t_pa = __builtin_amdgcn_s_memrealtime();
    if (PH(1))
    if (vcu < 32) {
        PHASE_PTRS
        const int b = vcu >> 2, h = (vcu & 3) * 2 + (wave >> 2), seg = wave & 3, s0 = seg * 2048 + lane * 32;
        const float* src = LF + ((size_t)b * SEQ + s0) * 8 + h;
        float p[32];
#pragma unroll
        for (int j = 0; j < 32; ++j) p[j] = src[j * 8];
#pragma unroll
        for (int j = 1; j < 32; ++j) p[j] += p[j - 1];
        float inc = p[31];
#pragma unroll
        for (int o = 1; o < 64; o <<= 1) { const float y = __shfl_up(inc, o); if (lane >= o) inc += y; }
        LAS float* tot = (LAS float*)(lds + EXTRA_OFF);
        if (lane == 63) tot[wave] = inc;
        __syncthreads();
        float off = inc - p[31];
        for (int q = 0; q < 3; ++q) if (q < seg) off += tot[(wave & 4) + q];
        float* dst = CC + ((size_t)b * NH + h) * SEQ + s0; bf16_t* kx = KX + (((size_t)b * NH + h) * SEQ + s0) * 8;
#pragma unroll
        for (int j = 0; j < 32; ++j) { const float x = off + p[j]; dst[j] = x;
            unsigned hm, lo; fox::split3(-x, hm, lo); u32x4 w; w.x = 0x3F803F80u; w.y = 0x3F80u | (hm << 16); w.z = (hm >> 16) | (lo << 16); w.w = 0u;
            *(u32x4*)(kx + j * 8) = w; }
        VM_WAIT(); __syncthreads();
    }
    if (PH(1))
    for (int rep_ = 0; rep_ < REPS(1); ++rep_)
    {
        PHASE_PTRS
        pg8::Gemm g{DM, DM, DM};
        SchedDense S{(const char*)XB, (const char*)Win_t, M / 256, NPROJ / 256, G, bx, (size_t)256 * DM * 2, (size_t)256 * DM * 2, 0, 2};
        LAS float* rst = (LAS float*)(lds + EXTRA_OFF);
#pragma unroll
        for (int q = 0; q < 8; ++q) { const int idx = tid + 512 * q, i = idx >> 8, r = idx & 255; int pm, pn; if (pg8::tile_order(i, G, bx, M / 256, NPROJ / 256, pm, pn)) rst[idx] = RX[pm * 256 + r]; }
        VM_WAIT(); __syncthreads();
        pg8::EpiBf16 E{QKV, HW, RX, QKV_STRIDE, C2, C2, ctl + CW_KN, rst, 1.f};
        pg8::gemm_phase<pg8::EpiBf16, SchedDense, true, false>(lds + RING_OFF, g, S, E);
    }
    xcd_barrier(bar);
    if (PROBE_HI == 1) t_pb = __builtin_amdgcn_s_memrealtime();

    if (PROBE_LO == 2) t_pa = __builtin_amdgcn_s_memrealtime();
    if (PH(2))
    {
        PHASE_PTRS
        const bf16_t* QA = QKV; const bf16_t* KA = QKV + QKV_STRIDE; const bf16_t* VA = QKV + 2 * QKV_STRIDE;
        const bf16_t* QBp = QKV + 3 * QKV_STRIDE; const bf16_t* KBp = QKV + 4 * QKV_STRIDE; const bf16_t* VBp = QKV + 5 * QKV_STRIDE;
        bf16_t* OA = OAB; bf16_t* OB = OAB + HW;
        LAS char* shm = (LAS char*)(lds + RING_OFF);
        { pg8::Gemm g{DM, DM, DM};
          SchedDense S2{(const char*)MEMB, (const char*)Wxkv_t, MEMROWS / 256, 2 * DM / 256, G, bx, (size_t)256 * DM * 2, (size_t)256 * DM * 2, 0, 0};
          pg8::EpiBf16 E2{KVM, 2 * DM, RMEM, 0, 1.f, 1.f, nullptr, nullptr, 1.f};
          pg8::gemm_phase<pg8::EpiBf16, SchedDense, true, false>(lds + RING_OFF, g, S2, E2);
          VM_WAIT(); __syncthreads(); }
        for (int rep = 0; rep < REP_FOX; ++rep)
        for (int i = 0; i < 8; ++i) { const int bh = (vcu >> 5) * 8 + i, x = vcu & 31, qb = (i & 1) ? 31 - x : x;
            const float kmax = sqrtf(__uint_as_float(ctl[CW_KN + bh * 2]) + __uint_as_float(ctl[CW_KN + bh * 2 + 1])) * 1.01f;
            const int nqb = ((i + 1) & 1) ? 31 - x : x;
            fox::fox_unit<8>(bh, qb, QA, KA, VA, OA, HS + (bh & 7), CC + (size_t)bh * SEQ, KX, kmax, shm, i > 0, i < 7 ? bh + 1 : -1, nqb); }
        { volatile LAS unsigned* qs = MISC + 16;
          unsigned nxt = 0u;
          if (tid == 0) qs[0] = __hip_atomic_fetch_add(ctl + CW_SBQ, 1u, __ATOMIC_RELAXED, __HIP_MEMORY_SCOPE_AGENT);
          __syncthreads();
          unsigned idx = qs[0];
          while (idx < (unsigned)(BATCH * NH * 32 * REP_SB)) {
              __syncthreads();
              if (tid == 0) nxt = __hip_atomic_fetch_add(ctl + CW_SBQ, 1u, __ATOMIC_RELAXED, __HIP_MEMORY_SCOPE_AGENT);
              const int un = (int)(idx % (unsigned)(BATCH * NH * 32)), bh = un >> 5, qb = un & 31;
              sbk::sb_unit(bh >> 3, bh & 7, qb, QBp, KBp, VBp, OB, HS + 8 + (bh & 7), shm);
              if (tid == 0) qs[0] = nxt;
              __syncthreads();
              idx = qs[0];
          } }
    }
    xcd_barrier(bar);
    if (PROBE_HI == 2) t_pb = __builtin_amdgcn_s_memrealtime();

    if (PROBE_LO == 4) t_pa = __builtin_amdgcn_s_memrealtime();
    if (PH(4))
    for (int rep_ = 0; rep_ < REPS(4); ++rep_)
    {
        PHASE_PTRS
        pg8::Gemm g{DM, DM, DM};
        SchedDense S{(const char*)OAB, (const char*)Wout_t, M / 256, DM / 256, G, bx, (size_t)256 * DM * 2, (size_t)256 * DM * 2, 0, 0};
        LAS f32x2* rab = (LAS f32x2*)(lds + EXTRA_OFF);
#pragma unroll
        for (int q = 0; q < 4; ++q) { const int idx = tid + 512 * q, i = idx >> 8, r = idx & 255; int pm, pn;
            if (pg8::tile_order(i, G, bx, M / 256, DM / 256, pm, pn)) { const f32x4* p = (const f32x4*)(HS + (size_t)(pm * 256 + r) * 16); const f32x4 a0 = p[0], a1 = p[1], b0 = p[2], b1 = p[3];
                const float ra = rsqrtf((((a0[0] + a0[1]) + (a0[2] + a0[3])) + ((a1[0] + a1[1]) + (a1[2] + a1[3]))) * (1.0f / HW) + EPS);
                const float rb = rsqrtf((((b0[0] + b0[1]) + (b0[2] + b0[3])) + ((b1[0] + b1[1]) + (b1[2] + b1[3]))) * (1.0f / HW) + EPS);
                rab[idx] = (f32x2){ra / rb, rb}; } }
        VM_WAIT(); __syncthreads();
        pg8::EpiOutProj E{XB, H1B, H1F8, SSQ, rab};
        pg8::gemm_phase<pg8::EpiOutProj, SchedDense, true, false>(lds + RING_OFF, g, S, E);
        pg8::Gemm g2{0, 0, 256};
        SchedGH SG{(const char*)KVM, (const char*)Wxq_n, (const char*)Wxo_t, G, bx};
        EpiGH EG{(unsigned char*)GT, (unsigned char*)HT};
        g2.lda = 2 * DM; g2.ldb = DM; SchedGHk<0> S0{SG}; pg8::gemm_phase<EpiGH, SchedGHk<0>, true, false>(lds + RING_OFF, g2, S0, EG);
        g2.lda = DM; g2.ldb = 2 * DM; SchedGHk<1> S1{SG}; pg8::gemm_phase<EpiGH, SchedGHk<1>, true, false>(lds + RING_OFF, g2, S1, EG);
    }
    xcd_barrier(bar);
    if (PROBE_HI == 4) t_pb = __builtin_amdgcn_s_memrealtime();

    if (PROBE_LO == 5) t_pa = __builtin_amdgcn_s_memrealtime();
    if (PH(5))
    for (int rep_ = 0; rep_ < REPS(5); ++rep_)
    {
        PHASE_PTRS
        pg8::Gemm g{DM, DM, DM};
        SchedDense S{(const char*)H1F8, (const char*)GT, M / 256, DM / 256, G, bx, (size_t)256 * DM, (size_t)256 * DM, (size_t)DM * DM, 0};
        LAS float* r1t = (LAS float*)(lds + EXTRA_OFF + 8192);
#pragma unroll
        for (int q = 0; q < 4; ++q) { const int idx = tid + 512 * q, i = idx >> 8, r = idx & 255; int pm, pn;
            if (pg8::tile_order(i, G, bx, M / 256, DM / 256, pm, pn)) { const f32x4* sp = (const f32x4*)(SSQ + (size_t)(pm * 256 + r) * 16); const f32x4 s0 = sp[0], s1 = sp[1], s2 = sp[2], s3 = sp[3];
                const float tot = ((s0[0] + s0[1]) + (s0[2] + s0[3])) + ((s1[0] + s1[1]) + (s1[2] + s1[3])) + ((s2[0] + s2[1]) + (s2[2] + s2[3])) + ((s3[0] + s3[1]) + (s3[2] + s3[3]));
                r1t[idx] = rsqrtf(tot * (1.0f / DM) + EPS) * XSC; } }
        VM_WAIT(); __syncthreads();
        pg8::EpiSoftmax E{XB, r1t, (LAS float*)(lds + EXTRA_OFF)};
        pg8::gemm_phase<pg8::EpiSoftmax, SchedDense, true, false, true>(lds + RING_OFF, g, S, E);
    }
    xcd_barrier(bar);
    if (PROBE_HI == 5) t_pb = __builtin_amdgcn_s_memrealtime();

    if (PROBE_LO == 6) t_pa = __builtin_amdgcn_s_memrealtime();
    if (PH(6))
    {
        PHASE_PTRS
        pg8::Gemm g{DM, DM, DM};
        SchedDense S{(const char*)XB, (const char*)HT, M / 256, DM / 256, G, bx, (size_t)256 * DM, (size_t)256 * DM, (size_t)DM * DM, 0};
        pg8::EpiResidBf16 E{H1B, H2F8, 1.0f / P_SCALE};
        pg8::gemm_phase<pg8::EpiResidBf16, SchedDense, true, false, true>(lds + RING_OFF, g, S, E);
    }
    xcd_barrier(bar);
    if (PROBE_HI == 6) t_pb = __builtin_amdgcn_s_memrealtime();

    if (PROBE_LO == 7) t_pa = __builtin_amdgcn_s_memrealtime();
    if (PH(7))
    {
        PHASE_PTRS
        LAS bf16_t* wBh = (LAS bf16_t*)(lds + RING_OFF); LAS bf16_t* wBl = wBh + 20 * DM;
        { const f32x4* wg4 = (const f32x4*)ARGP(w_rg); const f32x4* we4 = (const f32x4*)ARGP(w_re); const float* gf = ARGP(norm_ffn);
          f32x4 ga[2], ea[2][4]; float gk[2];
#pragma unroll
          for (int q = 0; q < 2; ++q) { const int k = tid + 512 * q; ga[q] = wg4[k]; gk[q] = gf[k];
#pragma unroll
              for (int c = 0; c < 4; ++c) ea[q][c] = we4[k * 4 + c]; }
#pragma unroll
          for (int q = 0; q < 2; ++q) { const int k = tid + 512 * q;
#pragma unroll
              for (int j = 0; j < 4; ++j) { { const float v = ga[q][j] * gk[q]; const unsigned hi_ = cvt_pk_bf16(v, 0.f) & 0xffffu; wBh[j * DM + k] = (bf16_t)hi_; wBl[j * DM + k] = (bf16_t)(cvt_pk_bf16(v - __uint_as_float(hi_ << 16), 0.f) & 0xffffu); }
#pragma unroll
                  for (int c = 0; c < 4; ++c) { const float v = ea[q][c][j] * gk[q]; const unsigned hi_ = cvt_pk_bf16(v, 0.f) & 0xffffu; const int col = 4 + 4 * c + j; wBh[col * DM + k] = (bf16_t)hi_; wBl[col * DM + k] = (bf16_t)(cvt_pk_bf16(v - __uint_as_float(hi_ << 16), 0.f) & 0xffffu); } } } }
        LAS int* dec_e = (LAS int*)(lds + RING_OFF + 81920); LAS float* dec_w = (LAS float*)(lds + RING_OFF + 81920 + 2048); LAS int* dec_r = (LAS int*)(lds + RING_OFF + 81920 + 4096);
        LAS int* hist = (LAS int*)(lds + RING_OFF + 81920 + 6144); LAS int* ebase = hist + 16; LAS float* dec_v = (LAS float*)(lds + RING_OFF + 81920 + 8192);
        if (tid < 16) hist[tid] = 0;
        __syncthreads();
        const float brg0 = ARGP(b_rg)[0], brg1 = ARGP(b_rg)[1], brg2 = ARGP(b_rg)[2], brg3 = ARGP(b_rg)[3]; const float* bre = ARGP(b_re);
        const int tok = lane & 31, half = lane >> 5, jcol = tok < 20 ? tok : 19;
        for (int it = 0; it * NGW < M / 32; ++it) {
            const int T = gw + it * NGW; const bool act = T < M / 32; const int r0 = act ? 32 * T : 0;
            const bf16_t* rowp = H1B + (size_t)(r0 + tok) * DM + 512 * half;
            const LAS bf16_t* wph = wBh + jcol * DM + 512 * half; const LAS bf16_t* wpl = wBl + jcol * DM + 512 * half;
            f32x16 ah0 = f32x16{}, ah1 = f32x16{}, al0 = f32x16{}, al1 = f32x16{}; float ssq = 0.f;
#pragma unroll 4
            for (int sidx = 0; sidx < 64; sidx += 2) {
                const u32x4 a0 = *(const u32x4*)(rowp + 8 * sidx), a1 = *(const u32x4*)(rowp + 8 * sidx + 8);
                const bf16x8 wh0 = *(const LAS bf16x8*)(wph + 8 * sidx), wl0 = *(const LAS bf16x8*)(wpl + 8 * sidx), wh1 = *(const LAS bf16x8*)(wph + 8 * sidx + 8), wl1 = *(const LAS bf16x8*)(wpl + 8 * sidx + 8);
                ah0 = MFMA32(wh0, __builtin_bit_cast(bf16x8, a0), ah0); al0 = MFMA32(wl0, __builtin_bit_cast(bf16x8, a0), al0);
                ah1 = MFMA32(wh1, __builtin_bit_cast(bf16x8, a1), ah1); al1 = MFMA32(wl1, __builtin_bit_cast(bf16x8, a1), al1);
                ssq += (bf16lo(a0.x) * bf16lo(a0.x) + bf16hi(a0.x) * bf16hi(a0.x)) + (bf16lo(a0.y) * bf16lo(a0.y) + bf16hi(a0.y) * bf16hi(a0.y)) + (bf16lo(a0.z) * bf16lo(a0.z) + bf16hi(a0.z) * bf16hi(a0.z)) + (bf16lo(a0.w) * bf16lo(a0.w) + bf16hi(a0.w) * bf16hi(a0.w));
                ssq += (bf16lo(a1.x) * bf16lo(a1.x) + bf16hi(a1.x) * bf16hi(a1.x)) + (bf16lo(a1.y) * bf16lo(a1.y) + bf16hi(a1.y) * bf16hi(a1.y)) + (bf16lo(a1.z) * bf16lo(a1.z) + bf16hi(a1.z) * bf16hi(a1.z)) + (bf16lo(a1.w) * bf16lo(a1.w) + bf16hi(a1.w) * bf16hi(a1.w));
            }
            const float rinv = rsqrtf((att::swap_lo(ssq) + att::swap_hi(ssq)) * (1.0f / DM) + EPS);
            float lg[20];
#pragma unroll
            for (int r = 0; r < 12; ++r) { const float c = (ah0[r] + ah1[r]) + (al0[r] + al1[r]); auto rr = __builtin_amdgcn_permlane32_swap(__float_as_uint(c), __float_as_uint(c), false, false);
                const int jl = (r & 3) + 8 * (r >> 2); lg[jl] = __uint_as_float(rr[0]) * rinv; if (r < 8) lg[jl + 4] = __uint_as_float(rr[1]) * rinv; }
            float g0 = lg[0] + brg0, g1 = lg[1] + brg1, g2 = lg[2] + brg2, g3 = lg[3] + brg3;
            int gi = 0; float gm = g0; if (g1 > gm) { gm = g1; gi = 1; } if (g2 > gm) { gm = g2; gi = 2; } if (g3 > gm) { gm = g3; gi = 3; }
            const float gval = 1.0f / (expf(g0 - gm) + expf(g1 - gm) + expf(g2 - gm) + expf(g3 - gm));
            float el[4];
#pragma unroll
            for (int j = 0; j < 4; ++j) { const float e0 = lg[4 + j], e1 = lg[8 + j], e2 = lg[12 + j], e3 = lg[16 + j]; el[j] = ((gi == 0) ? e0 : (gi == 1) ? e1 : (gi == 2) ? e2 : e3) + bre[gi * 4 + j]; }
            int i0 = 0; float m0 = el[0];
#pragma unroll
            for (int j = 1; j < 4; ++j) if (el[j] > m0) { m0 = el[j]; i0 = j; }
            int i1 = -1; float m1 = -3.0e38f;
#pragma unroll
            for (int j = 0; j < 4; ++j) if (j != i0 && el[j] > m1) { m1 = el[j]; i1 = j; }
            const float w0 = 1.0f / (1.0f + expf(m1 - m0)), w1 = 1.0f - w0;
            if (act) { const int e = gi * 4 + (half == 0 ? i0 : i1); const float w = gval * (half == 0 ? w0 : w1);
                const int idx = (wave * 32 + tok) * 2 + half; dec_e[idx] = e; dec_w[idx] = w; dec_v[idx] = rinv; dec_r[idx] = __hip_atomic_fetch_add(hist + e, 1, __ATOMIC_RELAXED, __HIP_MEMORY_SCOPE_WORKGROUP); }
            __syncthreads();
            if (tid < 16) { const int n = hist[tid]; ebase[tid] = n ? (int)__hip_atomic_fetch_add(ctl + CW_CNT + 64 * tid, (unsigned)n, __ATOMIC_RELAXED, __HIP_MEMORY_SCOPE_AGENT) : 0; }
            __syncthreads();
            if (act) { const int row = r0 + (lane >> 1), idx = wave * 64 + lane; const int e = dec_e[idx], pos = ebase[e] + dec_r[idx];
                LIST[(size_t)e * M + pos] = row; R2S[(size_t)e * M + pos] = dec_v[idx]; TOKSLOT[(size_t)row * 2 + (lane & 1)] = (e << 20) | pos; TOKW[(size_t)row * 2 + (lane & 1)] = dec_w[idx]; }
            __syncthreads();
            if (tid < 16) hist[tid] = 0;
            __syncthreads();
        }
    }
    xcd_barrier(bar);
    if (PROBE_HI == 7) t_pb = __builtin_amdgcn_s_memrealtime();

    if (PROBE_LO == 8) t_pa = __builtin_amdgcn_s_memrealtime();
    if (PH(8))
    for (int rep_ = 0; rep_ < REPS(8); ++rep_)
    {
        PHASE_PTRS
        pg8::Gemm g{DM, DM, DM};
        LAS int* tbl = (LAS int*)(lds + EXTRA_OFF + 8192); moe_table(tbl, ctl);
        SchedMoe S; S.A = (const char*)H2F8; S.W = (const char*)Wgu_t; S.list = LIST; S.tbl = tbl; S.G = G; S.c = bx; S.NPN = 2; S.w_exp = (size_t)512 * DM; S.w_tile = (size_t)256 * DM; S.a_tile = 0; S.ocol_w = 128;
        pg8::EpiSwiglu E{HID, R2S, LIST};
        pg8::gemm_phase<pg8::EpiSwiglu, SchedMoe, true, true, true>(lds + RING_OFF, g, S, E);
    }
    xcd_barrier(bar);
    if (PROBE_HI == 8) t_pb = __builtin_amdgcn_s_memrealtime();

    if (PROBE_LO == 9) t_pa = __builtin_amdgcn_s_memrealtime();
    if (PH(9))
    for (int rep_ = 0; rep_ < REPS(9); ++rep_)
    {
        PHASE_PTRS
        pg8::Gemm g{DFF, DFF, DFF};
        LAS int* tbl = (LAS int*)(lds + EXTRA_OFF + 8192);
        SchedMoe S; S.A = (const char*)HID; S.W = (const char*)Wd_t; S.list = LIST; S.tbl = tbl; S.G = G; S.c = bx; S.NPN = 4; S.w_exp = (size_t)DM * DFF; S.w_tile = (size_t)256 * DFF; S.a_tile = (size_t)256 * DFF; S.ocol_w = 256;
        pg8::EpiY8 E{(unsigned char*)YB, 1.0f / WD_SCALE};
        pg8::gemm_phase<pg8::EpiY8, SchedMoe, true, false, true>(lds + RING_OFF, g, S, E);
    }
    xcd_barrier(bar);
    if (PROBE_HI == 9) t_pb = __builtin_amdgcn_s_memrealtime();

    if (PROBE_LO == 10) t_pa = __builtin_amdgcn_s_memrealtime();
    if (PH(10))
    {
        PHASE_PTRS
        const LAS int* tb = (const LAS int*)(lds + EXTRA_OFF + 8192);
        const f32x4* gp = (const f32x4*)ARGP(norm_final) + lane;
        int sl0 = 0, sl1 = 0; float sw0 = 0.f, sw1 = 0.f;
        unsigned ya_n[4], yb_n[4]; u32x2 hh_n[4]; float w0_n = 0.f, w1_n = 0.f;
#define P10_SLOTS(rw) do { sl0 = TOKSLOT[(size_t)(rw) * 2]; sl1 = TOKSLOT[(size_t)(rw) * 2 + 1]; sw0 = TOKW[(size_t)(rw) * 2]; sw1 = TOKW[(size_t)(rw) * 2 + 1]; } while (0)
#define P10_DATA(rw) do { const int r0_ = tb[sl0 >> 20] * 256 + (sl0 & 0xfffff), r1_ = tb[sl1 >> 20] * 256 + (sl1 & 0xfffff); w0_n = sw0; w1_n = sw1; \
        const unsigned* y0_ = (const unsigned*)((const unsigned char*)YB + (size_t)r0_ * DM) + lane; const unsigned* y1_ = (const unsigned*)((const unsigned char*)YB + (size_t)r1_ * DM) + lane; const u32x2* h_ = (const u32x2*)(H1B + (size_t)(rw) * DM) + lane; \
        _Pragma("unroll") for (int j = 0; j < 4; ++j) { ya_n[j] = y0_[64 * j]; yb_n[j] = y1_[64 * j]; hh_n[j] = h_[64 * j]; } } while (0)
        if (gw < M) { P10_SLOTS(gw); P10_DATA(gw); if (gw + NGW < M) P10_SLOTS(gw + NGW); }
        for (int row = gw; row < M; row += NGW) {
            unsigned ya[4], yb[4]; u32x2 hh[4]; const float w0 = w0_n, w1 = w1_n;
#pragma unroll
            for (int j = 0; j < 4; ++j) { ya[j] = ya_n[j]; yb[j] = yb_n[j]; hh[j] = hh_n[j]; }
            if (row + NGW < M) { P10_DATA(row + NGW); if (row + 2 * NGW < M) P10_SLOTS(row + 2 * NGW); }
            f32x4* hr = (f32x4*)(out + (size_t)row * DM) + lane;
            f32x4 v[4]; float s = 0.f;
#pragma unroll
            for (int j = 0; j < 4; ++j) { const u32x2 hx = hh[j]; f32x4 h = {bf16lo(hx.x), bf16hi(hx.x), bf16lo(hx.y), bf16hi(hx.y)};
                const f32x2 a01 = __builtin_amdgcn_cvt_pk_f32_fp8((int)ya[j], false), a23 = __builtin_amdgcn_cvt_pk_f32_fp8((int)ya[j], true), b01 = __builtin_amdgcn_cvt_pk_f32_fp8((int)yb[j], false), b23 = __builtin_amdgcn_cvt_pk_f32_fp8((int)yb[j], true);
                h[0] += w0 * a01[0] + w1 * b01[0]; h[1] += w0 * a01[1] + w1 * b01[1]; h[2] += w0 * a23[0] + w1 * b23[0]; h[3] += w0 * a23[1] + w1 * b23[1];
                v[j] = h; s += (h[0] * h[0] + h[1] * h[1]) + (h[2] * h[2] + h[3] * h[3]); }
            const float rinv = rsqrtf(wave_sum(s) * (1.0f / DM) + EPS);
#pragma unroll
            for (int j = 0; j < 4; ++j) __builtin_nontemporal_store(v[j] * rinv * gp[64 * j], hr + 64 * j);
        }
#undef P10_SLOTS
#undef P10_DATA
    }
    if (PROBE_LO >= 0) {
        if (PROBE_HI == 10) t_pb = __builtin_amdgcn_s_memrealtime();
        if (blockIdx.x == 0 && threadIdx.x == 0) { const unsigned long long t0 = __builtin_amdgcn_s_memrealtime(), span = 2 * (t_pb - t_pa);
            while (__builtin_amdgcn_s_memrealtime() - t0 < span) __builtin_amdgcn_s_sleep(8); }
    }
}

extern "C" void kernel_launch(void* const* d_in, const int* in_sizes, int n_in, void* d_out, int out_size, void* d_ws, size_t ws_size, hipStream_t stream) {
    static int grid = 0;
    if (grid == 0) {
        if (n_in != 22 || in_sizes[0] != M * DM || out_size != M * DM || ws_size < WS_END) { fprintf(stderr, "kernel_launch: unexpected shapes (n_in %d, in0 %d, out %d, ws %zu)\n", n_in, n_in > 0 ? in_sizes[0] : -1, out_size, ws_size); grid = -1; return; }
        int dev = 0, cus = 0, per_cu = 0;
        if (hipGetDevice(&dev) != hipSuccess || hipDeviceGetAttribute(&cus, hipDeviceAttributeMultiprocessorCount, dev) != hipSuccess) { grid = -1; return; }
        if (hipFuncSetAttribute((const void*)hymba_fwd, hipFuncAttributeMaxDynamicSharedMemorySize, LDS_BYTES) != hipSuccess) { fprintf(stderr, "kernel_launch: hipFuncSetAttribute failed\n"); grid = -1; return; }
        if (hipOccupancyMaxActiveBlocksPerMultiprocessor(&per_cu, (const void*)hymba_fwd, NWAVES * 64, LDS_BYTES) != hipSuccess || per_cu < 1) { fprintf(stderr, "kernel_launch: occupancy query reports %d\n", per_cu); }
        (void)hipGetLastError();
        grid = cus;
    }
    if (grid < 0) return;
    (void)hipMemsetAsync((char*)d_ws + WS_CTL, 0, CTL_ZERO_BYTES, stream);
    Args a{};
    const float** p = (const float**)&a;
    for (int i = 0; i < 22; ++i) p[i] = (const float*)d_in[i];
    a.out = (float*)d_out; a.ws = (unsigned char*)d_ws;
    hipLaunchKernelGGL(hymba_fwd, dim3(grid), dim3(NWAVES * 64), LDS_BYTES, stream, a);
}
```

```cpp
#include <hip/hip_runtime.h>
#include <hip/hip_bf16.h>
#include <cstdio>
#include <cstdint>

#define LAS __attribute__((address_space(3)))
#define GAS __attribute__((address_space(1)))
typedef unsigned short bf16_t;
typedef short bf16x8 __attribute__((ext_vector_type(8)));
typedef short s16x4 __attribute__((ext_vector_type(4)));
typedef float f32x4 __attribute__((ext_vector_type(4)));
typedef float f32x2 __attribute__((ext_vector_type(2)));
typedef float f32x16 __attribute__((ext_vector_type(16)));
typedef unsigned u32x4 __attribute__((ext_vector_type(4)));
typedef unsigned u32x2 __attribute__((ext_vector_type(2)));
typedef __bf16 bf16x2_t __attribute__((ext_vector_type(2)));

constexpr int BATCH = 8, SEQ = 8192, DM = 1024, M = BATCH * SEQ;
constexpr int NH = 8, HD = 64, HW = NH * HD;
constexpr int NPROJ = 3 * HW * 2;
constexpr int WIN_LD = NPROJ + NH;
constexpr int NMEM = 256, XH = 4, XD = 256, MEMROWS = BATCH * NMEM;
constexpr int NEXP = 16, DFF = 256;
constexpr float EPS = 1e-6f;
constexpr float LOG2E = 1.4426950408889634f;
constexpr float C2 = 0.125f * LOG2E;
constexpr float XSC = 0.0625f * LOG2E;
constexpr float P_SCALE = 128.0f;
constexpr float WGU_SCALE = 32.0f;
constexpr float WD_SCALE = 16.0f;
constexpr float SB_EXIT = -48.0f;

constexpr size_t MiB = 1u << 20;
constexpr size_t WS_CTL = 0, CTL_ZERO_BYTES = 128 * 1024;
constexpr size_t WS_WIN = 1 * MiB;
constexpr size_t WS_WOUT = 7 * MiB;
constexpr size_t WS_WXQ = 9 * MiB;
constexpr size_t WS_WXKV = 11 * MiB;
constexpr size_t WS_WXO = 15 * MiB;
constexpr size_t WS_WGU = 17 * MiB;
constexpr size_t WS_WD = 33 * MiB;
constexpr size_t WS_RX = 41 * MiB;
constexpr size_t WS_RMEM = WS_RX + 256 * 1024;
constexpr size_t WS_R2 = WS_RX + 512 * 1024;
constexpr size_t WS_LF = 42 * MiB;
constexpr size_t WS_C2 = 44 * MiB;
constexpr size_t WS_SSQ = 46 * MiB;
constexpr size_t WS_TOKSLOT = 50 * MiB;
constexpr size_t WS_TOKW = 51 * MiB;
constexpr size_t WS_LIST = 52 * MiB;
constexpr size_t WS_MEMB = 56 * MiB;
constexpr size_t WS_KVM = 60 * MiB;
constexpr size_t WS_GT = 68 * MiB;
constexpr size_t WS_HT = 84 * MiB;
constexpr size_t WS_KX = 100 * MiB;
constexpr size_t WS_HS = 108 * MiB;
constexpr size_t WS_XB = 128 * MiB;
constexpr size_t WS_QKV = 256 * MiB;
constexpr size_t WS_H1B = 256 * MiB, WS_U2B = 384 * MiB, WS_HID = 512 * MiB;
constexpr size_t WS_H1F8 = 384 * MiB, WS_H2F8 = 448 * MiB;
constexpr size_t WS_O = 640 * MiB;
constexpr size_t WS_Y = 704 * MiB;
constexpr size_t WS_END = 1024 * MiB;
constexpr size_t QKV_STRIDE = (size_t)M * HW;
constexpr int MAXTILES = M * 2 / 256 + NEXP;
static_assert(WS_Y + (size_t)MAXTILES * 256 * 1024 * 2 <= WS_END, "ws map");
static_assert(WS_HID + (size_t)MAXTILES * 256 * 256 * 2 <= WS_O, "ws map");
constexpr int CW_BAR = 4096;
constexpr int CW_SBQ = 20736;
constexpr int CW_KN = 20480;
constexpr int CW_CNT = 16384;

constexpr int RING_OFF = 0, RING_BYTES = 131072;
constexpr int EXTRA_OFF = 131072, EXTRA_BYTES = 16384;
constexpr int MISC_OFF = EXTRA_OFF + EXTRA_BYTES;
constexpr int LDS_BYTES = MISC_OFF + 1024;
constexpr int NWAVES = 8;
#ifndef PHASE_MASK
#define PHASE_MASK 0x7ff
#endif
#define PH(n) ((PHASE_MASK >> (n)) & 1)
#ifndef PROBE_LO
#define PROBE_LO -1
#endif
#ifndef PROBE_HI
#define PROBE_HI -1
#endif
#ifndef REP_MASK
#define REP_MASK 0
#endif
#define REPS(n) (1 + ((REP_MASK >> (n)) & 1))
#ifndef REP_FOX
#define REP_FOX 1
#endif
#ifndef REP_SB
#define REP_SB 1
#endif

__device__ __forceinline__ unsigned cvt_pk_bf16(float lo, float hi) { f32x2 v = {lo, hi}; bf16x2_t b = __builtin_convertvector(v, bf16x2_t); return __builtin_bit_cast(unsigned, b); }
__device__ __forceinline__ unsigned cvt4_fp8(float a, float b, float c, float d) { int w = 0; w = __builtin_amdgcn_cvt_pk_fp8_f32(a, b, w, false); w = __builtin_amdgcn_cvt_pk_fp8_f32(c, d, w, true); return (unsigned)w; }
__device__ __forceinline__ u32x4 widen16(u32x2 a, u32x2 b) {
    const auto r0 = __builtin_amdgcn_permlane16_swap(a.x, b.x, false, false); const auto r1 = __builtin_amdgcn_permlane16_swap(a.y, b.y, false, false);
    return (u32x4){r0[0], r1[0], r0[1], r1[1]};
}
__device__ __forceinline__ float bf16lo(unsigned u) { return __uint_as_float(u << 16); }
__device__ __forceinline__ float bf16hi(unsigned u) { return __uint_as_float(u & 0xffff0000u); }
#define DPP_ADD(v, CTRL) v += __builtin_bit_cast(float, __builtin_amdgcn_update_dpp(0, __builtin_bit_cast(int, v), CTRL, 0xf, 0xf, true))
__device__ __forceinline__ float wave_sum(float v) {
    DPP_ADD(v, 0xB1); DPP_ADD(v, 0x4E); DPP_ADD(v, 0x141); DPP_ADD(v, 0x140);
    const int iv = __builtin_bit_cast(int, v);
    return (__builtin_bit_cast(float, __builtin_amdgcn_readlane(iv, 0)) + __builtin_bit_cast(float, __builtin_amdgcn_readlane(iv, 16))) +
           (__builtin_bit_cast(float, __builtin_amdgcn_readlane(iv, 32)) + __builtin_bit_cast(float, __builtin_amdgcn_readlane(iv, 48)));
}
#define LDS_WAIT() asm volatile("s_waitcnt lgkmcnt(0)" ::: "memory")
#define VM_WAIT() asm volatile("s_waitcnt vmcnt(0)" ::: "memory")

namespace pg8 {
constexpr int BM = 256, BK = 64, HALF = 128, HTB = HALF * BK * 2, STAGE_BYTES = 8 * HTB, NXCD = 8, WGM = 8;
__host__ __device__ __forceinline__ int lds_byte(int r, int c) { const int st = (r >> 4) * 2 + (c >> 5), rr = r & 15, cc = c & 31, ob = rr * 64 + cc * 2; return st * 1024 + (ob ^ (((ob >> 9) & 1) << 5)); }
__host__ __device__ __forceinline__ void stage_rc(int b, int& R, int& C) { const int st = b / 1024, sb = b % 1024, swz = sb ^ (((sb >> 9) & 1) << 5); R = (st >> 1) * 16 + swz / 64; C = (st & 1) * 32 + (swz % 64) / 2; }
__host__ __device__ __forceinline__ int perm32(int rho) { const int n = rho >> 4, i = rho & 15; return 8 * (i >> 2) + 4 * n + (i & 3); }

struct Unit { const char* a; const char* b; int orow, ocol, aux; const int* rows; int nvalid; int seq; };
struct Gemm { int lda, ldb, K; };

__device__ __forceinline__ bool tile_order(int i, int G, int c, int nM, int nN, int& pm, int& pn) {
    const int nwg = nM * nN; const long L = (long)i * G + c; if (L >= nwg) return false;
    int wgid = (int)L; { const int q = nwg / NXCD, r = nwg % NXCD, xcd = wgid % NXCD, off = wgid / NXCD; wgid = (xcd < r ? xcd * (q + 1) : r * (q + 1) + (xcd - r) * q) + off; }
    const int nig = WGM * nN, gid = wgid / nig, fm = gid * WGM, gsz = (nM - fm) < WGM ? (nM - fm) : WGM;
    pm = fm + ((wgid % nig) % gsz); pn = (wgid % nig) / gsz; return true;
}

typedef int v8i32 __attribute__((ext_vector_type(8)));
template <class Epi, class Sched, bool ALIGN_EPI, bool GATHER, bool FP8 = false>
__device__ __forceinline__ void gemm_phase(LAS unsigned char* lds, const Gemm g, const Sched& S, const Epi& E) {
    int tid = threadIdx.x; asm volatile("" : "+v"(tid));
    const int wid = __builtin_amdgcn_readfirstlane(tid >> 6), lane = tid & 63, wr = wid >> 2, wc = wid & 3, fr = lane & 15, fq = lane >> 4;
    constexpr int ESZ = FP8 ? 1 : 2;
    const int K = g.K, nt = K / (FP8 ? 2 * BK : BK);
    unsigned voffA[2], voffB[2]; int RA[2], CA[2];
#pragma unroll
    for (int i = 0; i < 2; ++i) { int R, C; stage_rc(tid * 16 + i * 8192, R, C); const int Rb = (R & ~31) + perm32(R & 31);
        RA[i] = R; CA[i] = C; voffA[i] = (unsigned)(R * g.lda * ESZ + C * 2); voffB[i] = (unsigned)(Rb * g.ldb * ESZ + C * 2); }
    const size_t kstep = (size_t)(BK * 2);
    const size_t hstepA = (size_t)HALF * g.lda * ESZ, hstepB = (size_t)HALF * g.ldb * ESZ;
    const unsigned ldsw = (unsigned)wid * 1024u;
    const int aoff = lds_byte(wr * 64 + fr, FP8 ? fq * 16 : fq * 8), boff = lds_byte(wc * 32 + fr, FP8 ? fq * 16 : fq * 8);
    constexpr int KOFF = FP8 ? 16 : 1024;
#define PG8_SA(b, h) (((b) * 2 + (h)) * HTB)
#define PG8_SB(b, h) ((4 + (b) * 2 + (h)) * HTB)
#define PG8_STAGE2(bufoff, gbase, v0, v1) do { \
        __builtin_amdgcn_global_load_lds((const unsigned*)((const char*)(gbase) + (v0)), (LAS unsigned*)(lds + (bufoff) + ldsw), 16, 0, 0); \
        __builtin_amdgcn_global_load_lds((const unsigned*)((const char*)(gbase) + (v1)), (LAS unsigned*)(lds + (bufoff) + ldsw + 8192), 16, 0, 0); } while (0)
#define PG8_STAGEB(bufoff, gbase) PG8_STAGE2(bufoff, gbase, voffB[0], voffB[1])
#define PG8_STAGEA(bufoff, kptr, h, NX) do { if constexpr (GATHER) { const unsigned v0_ = (NX) ? gvn[h][0] : gvc[h][0], v1_ = (NX) ? gvn[h][1] : gvc[h][1]; PG8_STAGE2(bufoff, kptr, v0_, v1_); } \
        else { PG8_STAGE2(bufoff, (kptr) + (h) * hstepA, voffA[0], voffA[1]); } } while (0)
#define PG8_LDA(dst, b, h) do { _Pragma("unroll") for (int m = 0; m < 4; ++m) _Pragma("unroll") for (int k = 0; k < 2; ++k) dst[m][k] = *(const LAS bf16x8*)(lds + PG8_SA(b, h) + aoff + m * 2048 + k * KOFF); } while (0)
#define PG8_LDB(dst, b, h) do { _Pragma("unroll") for (int n = 0; n < 2; ++n) _Pragma("unroll") for (int k = 0; k < 2; ++k) dst[n][k] = *(const LAS bf16x8*)(lds + PG8_SB(b, h) + boff + n * 2048 + k * KOFF); } while (0)
#define PG8_CAT(x) __builtin_shufflevector(__builtin_bit_cast(f32x4, (x)[0]), __builtin_bit_cast(f32x4, (x)[1]), 0, 1, 2, 3, 4, 5, 6, 7)
#define PG8_MMA(ai, bj, At, Bt) do { __builtin_amdgcn_s_setprio(1); _Pragma("unroll") for (int m = 0; m < 4; ++m) _Pragma("unroll") for (int n = 0; n < 2; ++n) { \
        if constexpr (FP8) { acc[ai][bj][m][n] = __builtin_amdgcn_mfma_scale_f32_16x16x128_f8f6f4(__builtin_bit_cast(v8i32, PG8_CAT(Bt[n])), __builtin_bit_cast(v8i32, PG8_CAT(At[m])), acc[ai][bj][m][n], 0, 0, 0, 0x7F7F7F7F, 0, 0x7F7F7F7F); } \
        else { _Pragma("unroll") for (int k = 0; k < 2; ++k) acc[ai][bj][m][n] = __builtin_amdgcn_mfma_f32_16x16x32_bf16(Bt[n][k], At[m][k], acc[ai][bj][m][n], 0, 0, 0); } } \
        _Pragma("unroll") for (int m = 0; m < 4; ++m) _Pragma("unroll") for (int n = 0; n < 2; ++n) asm volatile("" : "+v"(acc[ai][bj][m][n]));     \
        __builtin_amdgcn_s_setprio(0); } while (0)
#define PG8_WAIT_V(n) asm volatile("s_waitcnt vmcnt(" #n ")" ::: "memory")
#define PG8_WAIT_L(n) asm volatile("s_waitcnt lgkmcnt(" #n ")" ::: "memory")
#define PG8_BAR __builtin_amdgcn_s_barrier()
#define PG8_SCHED __builtin_amdgcn_sched_barrier(0)
#define PG8_GATHER_OFFS(dst, u) do { _Pragma("unroll") for (int h_ = 0; h_ < 2; ++h_) _Pragma("unroll") for (int i_ = 0; i_ < 2; ++i_) { const int r_ = h_ * HALF + RA[i_]; \
        const int idx_ = (u).rows[r_ < (u).nvalid ? r_ : 0]; dst[h_][i_] = (unsigned)(idx_ * g.lda * ESZ + CA[i_] * 2); } } while (0)
    Unit cur, nxt; int ui = 0;
    if (!S.next(0, cur)) return;
    cur.seq = 0;
    unsigned gvc[2][2] = {{0u, 0u}, {0u, 0u}}, gvn[2][2] = {{0u, 0u}, {0u, 0u}};
    if constexpr (GATHER) { PG8_GATHER_OFFS(gvc, cur); }
    f32x4 acc[2][2][4][2];
#pragma unroll
    for (int a = 0; a < 2; ++a)
#pragma unroll
        for (int b = 0; b < 2; ++b)
#pragma unroll
            for (int m = 0; m < 4; ++m)
#pragma unroll
                for (int n = 0; n < 2; ++n) acc[a][b][m][n] = (f32x4){0.f, 0.f, 0.f, 0.f};
    bf16x8 At[4][2], B0[2][2], B1[2][2];
    const char* cA = cur.a; const char* cB = cur.b;
    PG8_STAGEB(PG8_SB(0, 0), cB); PG8_STAGEB(PG8_SB(0, 1), cB + hstepB); PG8_STAGEA(PG8_SA(0, 0), cA, 0, false); PG8_STAGEA(PG8_SA(0, 1), cA, 1, false);
    if (wr == 1) PG8_BAR;
    PG8_WAIT_V(2); PG8_BAR;
    PG8_STAGEB(PG8_SB(1, 0), cB + kstep); PG8_STAGEA(PG8_SA(1, 0), cA + kstep, 0, false); PG8_STAGEB(PG8_SB(1, 1), cB + hstepB + kstep);
    PG8_WAIT_V(6); PG8_BAR;
    for (;;) {
        const bool has_next = S.next(ui + 1, nxt); nxt.seq = ui + 1;
        const char* nA = has_next ? nxt.a : cA; const char* nB = has_next ? nxt.b : cB;
        if constexpr (GATHER) { if (has_next) { PG8_GATHER_OFFS(gvn, nxt); } else { gvn[0][0] = gvc[0][0]; gvn[0][1] = gvc[0][1]; gvn[1][0] = gvc[1][0]; gvn[1][1] = gvc[1][1]; } }
#pragma unroll 1
        for (int t = 0; t < nt; t += 2) {
            const bool last = (t == nt - 2);
            const char* a1 = cA + (size_t)(t + 1) * kstep;
            const char* a2 = last ? nA : cA + (size_t)(t + 2) * kstep; const char* b2 = last ? nB : cB + (size_t)(t + 2) * kstep;
            const char* a3 = a2 + kstep; const char* b3 = b2 + kstep;
            PG8_LDB(B0, 0, 0); PG8_LDB(B1, 0, 1); PG8_SCHED; PG8_LDA(At, 0, 0); PG8_STAGEA(PG8_SA(1, 1), a1, 1, false);
            PG8_WAIT_V(8); PG8_WAIT_L(0); PG8_BAR; PG8_MMA(0, 0, At, B0); PG8_MMA(0, 1, At, B1); PG8_BAR; PG8_SCHED;
            PG8_LDA(At, 0, 1); PG8_STAGEB(PG8_SB(0, 0), b2); PG8_STAGEB(PG8_SB(0, 1), b2 + hstepB); PG8_STAGEA(PG8_SA(0, 0), a2, 0, last);
            PG8_WAIT_V(8); PG8_WAIT_L(0); PG8_BAR; PG8_MMA(1, 0, At, B0); PG8_MMA(1, 1, At, B1); PG8_BAR; PG8_SCHED;
            PG8_LDB(B0, 1, 0); PG8_LDB(B1, 1, 1); PG8_SCHED; PG8_LDA(At, 1, 0); PG8_STAGEA(PG8_SA(0, 1), a2, 1, last);
            PG8_WAIT_V(8); PG8_WAIT_L(0); PG8_BAR; PG8_MMA(0, 0, At, B0); PG8_MMA(0, 1, At, B1); PG8_BAR; PG8_SCHED;
            PG8_LDA(At, 1, 1); PG8_STAGEB(PG8_SB(1, 0), b3); PG8_STAGEB(PG8_SB(1, 1), b3 + hstepB); PG8_STAGEA(PG8_SA(1, 0), a3, 0, last);
            PG8_WAIT_V(8); PG8_WAIT_L(0); PG8_BAR; PG8_MMA(1, 0, At, B0); PG8_MMA(1, 1, At, B1); PG8_BAR; PG8_SCHED;
            if constexpr (Epi::HAS_MID) { if (t == (nt >> 1) - 2) { int fr3 = fr, fq3 = fq; asm volatile("" : "+v"(fr3), "+v"(fq3)); E.mid(acc, cur, wr, wc, fr3, fq3); } }
        }
        if constexpr (ALIGN_EPI) { if (wr == 0) PG8_BAR; }
        { int fr2 = fr, fq2 = fq; asm volatile("" : "+v"(fr2), "+v"(fq2));
          E(acc, cur, wr, wc, fr2, fq2); }
        if (!has_next) break;
#pragma unroll
        for (int a = 0; a < 2; ++a)
#pragma unroll
            for (int b = 0; b < 2; ++b)
#pragma unroll
                for (int m = 0; m < 4; ++m)
#pragma unroll
                    for (int n = 0; n < 2; ++n) acc[a][b][m][n] = (f32x4){0.f, 0.f, 0.f, 0.f};
        cur = nxt; cA = nA; cB = nB; ++ui;
        if constexpr (GATHER) { gvc[0][0] = gvn[0][0]; gvc[0][1] = gvn[0][1]; gvc[1][0] = gvn[1][0]; gvc[1][1] = gvn[1][1]; }
        if constexpr (ALIGN_EPI) { if (wr == 1) PG8_BAR; }
    }
    PG8_WAIT_V(0);
    if constexpr (!ALIGN_EPI) { if (wr == 0) PG8_BAR; }
    PG8_BAR;
#undef PG8_SA
#undef PG8_SB
#undef PG8_STAGE2
#undef PG8_STAGEA
#undef PG8_STAGEB
#undef PG8_LDA
#undef PG8_LDB
#undef PG8_MMA
#undef PG8_CAT
#undef PG8_WAIT_V
#undef PG8_WAIT_L
#undef PG8_BAR
#undef PG8_SCHED
#undef PG8_GATHER_OFFS
}

#define EPI_ROW(u, ai, m) ((u).orow + (ai) * HALF + wr * 64 + (m) * 16 + fr)
#define EPI_COL(u, bj) ((u).ocol + (bj) * HALF + wc * 32 + 8 * fq)
struct EpiBf16 {
    static constexpr bool HAS_MID = false;
    bf16_t* O; int ldc; const float* rs; size_t stride; float sc0, sc3;
    unsigned* kn;
    const LAS float* rst;
    float mul;
    __device__ __forceinline__ void operator()(const f32x4 (&acc)[2][2][4][2], const Unit& u, int wr, int wc, int fr, int fq) const {
        bf16_t* base = O + (size_t)u.aux * stride;
        const float sc = ((u.aux == 0) ? sc0 : ((u.aux == 3) ? sc3 : 1.f)) * mul;
        float nmax[2] = {0.f, 0.f}; const bool dokn = kn && u.aux == 1;
#pragma unroll
        for (int ai = 0; ai < 2; ++ai)
#pragma unroll
            for (int m = 0; m < 4; ++m) { const int row = EPI_ROW(u, ai, m); const float s = (rst ? rst[u.seq * 256 + ai * HALF + wr * 64 + m * 16 + fr] : (rs ? rs[row] : 1.f)) * sc;
#pragma unroll
                for (int bj = 0; bj < 2; ++bj) { const f32x4 v0 = acc[ai][bj][m][0] * s, v1 = acc[ai][bj][m][1] * s;
                    { u32x4 w; w.x = cvt_pk_bf16(v0[0], v0[1]); w.y = cvt_pk_bf16(v0[2], v0[3]); w.z = cvt_pk_bf16(v1[0], v1[1]); w.w = cvt_pk_bf16(v1[2], v1[3]);
                    __builtin_nontemporal_store(w, (u32x4*)(base + (size_t)row * ldc + EPI_COL(u, bj))); }
                    if (dokn) { float q = (v0[0] * v0[0] + v0[1] * v0[1]) + (v0[2] * v0[2] + v0[3] * v0[3]) + (v1[0] * v1[0] + v1[1] * v1[1]) + (v1[2] * v1[2] + v1[3] * v1[3]);
                        q += __shfl_xor(q, 16); q += __shfl_xor(q, 32); nmax[bj] = fmaxf(nmax[bj], q); } } }
        if (dokn) {
#pragma unroll
            for (int bj = 0; bj < 2; ++bj) { float q = nmax[bj]; q = fmaxf(q, __shfl_xor(q, 1)); q = fmaxf(q, __shfl_xor(q, 2)); q = fmaxf(q, __shfl_xor(q, 4)); q = fmaxf(q, __shfl_xor(q, 8));
                const int head = ((u.ocol + bj * HALF) >> 6) + (wc >> 1), bt = u.orow / SEQ;
                if ((fr | fq) == 0) atomicMax(kn + ((bt * NH + head) * 2 + (wc & 1)), __float_as_uint(q)); }
        }
    }
};
struct EpiY8 {
    static constexpr bool HAS_MID = false;
    unsigned char* Y; float mul;
    __device__ __forceinline__ void operator()(const f32x4 (&acc)[2][2][4][2], const Unit& u, int wr, int wc, int fr, int fq) const {
#pragma unroll
        for (int ai = 0; ai < 2; ++ai)
#pragma unroll
            for (int m = 0; m < 4; m += 2) { const int row = EPI_ROW(u, ai, m) + 16 * (fq & 1);
#pragma unroll
                for (int bj = 0; bj < 2; ++bj) { u32x2 w8[2];
#pragma unroll
                    for (int mm = 0; mm < 2; ++mm) { const f32x4 v0 = acc[ai][bj][m + mm][0] * mul, v1 = acc[ai][bj][m + mm][1] * mul; w8[mm].x = cvt4_fp8(v0[0], v0[1], v0[2], v0[3]); w8[mm].y = cvt4_fp8(v1[0], v1[1], v1[2], v1[3]); }
                    *(u32x4*)(Y + (size_t)row * DM + (u.ocol + bj * HALF + wc * 32 + 8 * (fq & ~1))) = widen16(w8[0], w8[1]); } }
    }
};
struct EpiOutProj {
    static constexpr bool HAS_MID = true;
    const bf16_t* xb; bf16_t* hb; unsigned char* h8; float* ssq; const LAS f32x2* rab;
    __device__ __forceinline__ void mid(f32x4 (&acc)[2][2][4][2], const Unit& u, int wr, int wc, int fr, int fq) const {
#pragma unroll
        for (int ai = 0; ai < 2; ++ai)
#pragma unroll
            for (int m = 0; m < 4; ++m) { const float f = rab[u.seq * 256 + ai * HALF + wr * 64 + m * 16 + fr].x;
#pragma unroll
                for (int bj = 0; bj < 2; ++bj) { acc[ai][bj][m][0] *= f; acc[ai][bj][m][1] *= f; } }
    }
    __device__ __forceinline__ void operator()(const f32x4 (&acc)[2][2][4][2], const Unit& u, int wr, int wc, int fr, int fq) const {
#pragma unroll
        for (int ai = 0; ai < 2; ++ai)
#pragma unroll
            for (int m2 = 0; m2 < 4; m2 += 2) { u32x2 w8[2][2];
#pragma unroll
              for (int mm = 0; mm < 2; ++mm) { const int m = m2 + mm; const int row = EPI_ROW(u, ai, m); const float rb = rab[u.seq * 256 + ai * HALF + wr * 64 + m * 16 + fr].y; float q = 0.f;
#pragma unroll
                for (int bj = 0; bj < 2; ++bj) { const size_t off = (size_t)row * DM + EPI_COL(u, bj);
                    const u32x4 xr = __builtin_nontemporal_load((const u32x4*)(xb + off));
                    f32x4 v0 = acc[ai][bj][m][0] * rb, v1 = acc[ai][bj][m][1] * rb;
                    v0[0] += bf16lo(xr.x); v0[1] += bf16hi(xr.x); v0[2] += bf16lo(xr.y); v0[3] += bf16hi(xr.y); v1[0] += bf16lo(xr.z); v1[1] += bf16hi(xr.z); v1[2] += bf16lo(xr.w); v1[3] += bf16hi(xr.w);
                    q += (v0[0] * v0[0] + v0[1] * v0[1]) + (v0[2] * v0[2] + v0[3] * v0[3]) + (v1[0] * v1[0] + v1[1] * v1[1]) + (v1[2] * v1[2] + v1[3] * v1[3]);
                    u32x4 w; w.x = cvt_pk_bf16(v0[0], v0[1]); w.y = cvt_pk_bf16(v0[2], v0[3]); w.z = cvt_pk_bf16(v1[0], v1[1]); w.w = cvt_pk_bf16(v1[2], v1[3]); *(u32x4*)(hb + off) = w;
                    w8[mm][bj].x = cvt4_fp8(v0[0], v0[1], v0[2], v0[3]); w8[mm][bj].y = cvt4_fp8(v1[0], v1[1], v1[2], v1[3]); }
                q += __shfl_xor(q, 16); q += __shfl_xor(q, 32); if (fq == 0) ssq[(size_t)row * 16 + (u.ocol >> 8) * 4 + wc] = q; }
              const int rowp = EPI_ROW(u, ai, m2) + 16 * (fq & 1);
#pragma unroll
              for (int bj = 0; bj < 2; ++bj) *(u32x4*)(h8 + (size_t)rowp * DM + (u.ocol + bj * HALF + wc * 32 + 8 * (fq & ~1))) = widen16(w8[0][bj], w8[1][bj]); }
    }
};
struct EpiResidBf16 {
    static constexpr bool HAS_MID = false;
    bf16_t* hb; unsigned char* h8; float mul;
    __device__ __forceinline__ void operator()(const f32x4 (&acc)[2][2][4][2], const Unit& u, int wr, int wc, int fr, int fq) const {
#pragma unroll
        for (int ai = 0; ai < 2; ++ai) {
        u32x4 xres[4][2];
#pragma unroll
            for (int m = 0; m < 4; ++m)
#pragma unroll
                for (int bj = 0; bj < 2; ++bj) xres[m][bj] = *(const u32x4*)(hb + (size_t)EPI_ROW(u, ai, m) * DM + EPI_COL(u, bj));
        asm volatile("" ::: "memory");
#pragma unroll
            for (int m2 = 0; m2 < 4; m2 += 2) { u32x2 w8[2][2];
#pragma unroll
              for (int mm = 0; mm < 2; ++mm) { const int m = m2 + mm; const int row = EPI_ROW(u, ai, m);
#pragma unroll
                for (int bj = 0; bj < 2; ++bj) { const size_t off = (size_t)row * DM + EPI_COL(u, bj);
                    const u32x4 xr = xres[m][bj];
                    f32x4 v0 = acc[ai][bj][m][0] * mul, v1 = acc[ai][bj][m][1] * mul;
                    v0[0] += bf16lo(xr.x); v0[1] += bf16hi(xr.x); v0[2] += bf16lo(xr.y); v0[3] += bf16hi(xr.y); v1[0] += bf16lo(xr.z); v1[1] += bf16hi(xr.z); v1[2] += bf16lo(xr.w); v1[3] += bf16hi(xr.w);
                    u32x4 w; w.x = cvt_pk_bf16(v0[0], v0[1]); w.y = cvt_pk_bf16(v0[2], v0[3]); w.z = cvt_pk_bf16(v1[0], v1[1]); w.w = cvt_pk_bf16(v1[2], v1[3]); *(u32x4*)(hb + off) = w;
                    w8[mm][bj].x = cvt4_fp8(v0[0], v0[1], v0[2], v0[3]); w8[mm][bj].y = cvt4_fp8(v1[0], v1[1], v1[2], v1[3]); } }
              if (h8) { const int rowp = EPI_ROW(u, ai, m2) + 16 * (fq & 1);
#pragma unroll
                  for (int bj = 0; bj < 2; ++bj) *(u32x4*)(h8 + (size_t)rowp * DM + (u.ocol + bj * HALF + wc * 32 + 8 * (fq & ~1))) = widen16(w8[0][bj], w8[1][bj]); } }
        asm volatile("" ::: "memory"); }
    }
};
struct EpiSoftmax {
    static constexpr bool HAS_MID = false;
    bf16_t* P; const LAS float* r1t; LAS float* red;
    __device__ __forceinline__ void operator()(f32x4 (&acc)[2][2][4][2], const Unit& u, int wr, int wc, int fr, int fq) const {
#pragma unroll
        for (int ai = 0; ai < 2; ++ai)
#pragma unroll
            for (int m = 0; m < 4; ++m) { const float r1 = r1t[u.seq * 256 + ai * HALF + wr * 64 + m * 16 + fr]; float a = -3.0e38f;
#pragma unroll
                for (int bj = 0; bj < 2; ++bj)
#pragma unroll
                    for (int n = 0; n < 2; ++n) { f32x4 v = acc[ai][bj][m][n] * r1; acc[ai][bj][m][n] = v; a = fmaxf(a, fmaxf(fmaxf(v[0], v[1]), fmaxf(v[2], v[3]))); }
                a = fmaxf(a, __shfl_xor(a, 16)); a = fmaxf(a, __shfl_xor(a, 32));
                if (fq == 0) red[(ai * HALF + wr * 64 + m * 16 + fr) * 4 + wc] = a; asm volatile("" ::: "memory"); }
        LDS_WAIT(); __builtin_amdgcn_s_barrier(); asm volatile("" ::: "memory");
#pragma unroll
        for (int ai = 0; ai < 2; ++ai)
#pragma unroll
            for (int m = 0; m < 4; ++m) { const int rl = ai * HALF + wr * 64 + m * 16 + fr; const f32x4 mm = *(const LAS f32x4*)(red + rl * 4);
                const float a = fmaxf(fmaxf(mm[0], mm[1]), fmaxf(mm[2], mm[3])); float s = 0.f;
#pragma unroll
                for (int bj = 0; bj < 2; ++bj)
#pragma unroll
                    for (int n = 0; n < 2; ++n) { f32x4 v = acc[ai][bj][m][n];
                        v[0] = __builtin_amdgcn_exp2f(v[0] - a); v[1] = __builtin_amdgcn_exp2f(v[1] - a); v[2] = __builtin_amdgcn_exp2f(v[2] - a); v[3] = __builtin_amdgcn_exp2f(v[3] - a);
                        acc[ai][bj][m][n] = v; s += (v[0] + v[1]) + (v[2] + v[3]); }
                s += __shfl_xor(s, 16); s += __shfl_xor(s, 32);
                if (fq == 0) red[1024 + rl * 4 + wc] = s; }
        LDS_WAIT(); __builtin_amdgcn_s_barrier(); asm volatile("" ::: "memory");
#pragma unroll
        for (int ai = 0; ai < 2; ++ai)
#pragma unroll
            for (int m = 0; m < 4; m += 2) { u32x2 w8[2][2];
#pragma unroll
                for (int mm = 0; mm < 2; ++mm) { const int rl = ai * HALF + wr * 64 + (m + mm) * 16 + fr; const f32x4 ss = *(const LAS f32x4*)(red + 1024 + rl * 4);
                    const float inv = P_SCALE / ((ss[0] + ss[1]) + (ss[2] + ss[3]));
#pragma unroll
                    for (int bj = 0; bj < 2; ++bj) { const f32x4 v0 = acc[ai][bj][m + mm][0] * inv, v1 = acc[ai][bj][m + mm][1] * inv;
                        w8[mm][bj].x = cvt4_fp8(v0[0], v0[1], v0[2], v0[3]); w8[mm][bj].y = cvt4_fp8(v1[0], v1[1], v1[2], v1[3]); } }
                const int row = EPI_ROW(u, ai, m) + 16 * (fq & 1);
#pragma unroll
                for (int bj = 0; bj < 2; ++bj) *(u32x4*)((unsigned char*)P + (size_t)row * DM + (u.ocol + bj * HALF + wc * 32 + 8 * (fq & ~1))) = widen16(w8[0][bj], w8[1][bj]); }
    }
};
struct EpiSwiglu {
    static constexpr bool HAS_MID = false;
    bf16_t* Hd; const float* r2s; const int* listbase;
    __device__ __forceinline__ void operator()(const f32x4 (&acc)[2][2][4][2], const Unit& u, int wr, int wc, int fr, int fq) const {
#pragma unroll
        for (int ai = 0; ai < 2; ++ai)
#pragma unroll
            for (int m = 0; m < 4; m += 2) { u32x2 w8[2];
#pragma unroll
                for (int mm = 0; mm < 2; ++mm) { const int rl = ai * HALF + wr * 64 + (m + mm) * 16 + fr; const float rs = r2s[(u.rows - listbase) + (rl < u.nvalid ? rl : 0)] * (1.0f / WGU_SCALE); float h[8];
#pragma unroll
                    for (int n = 0; n < 2; ++n)
#pragma unroll
                        for (int e = 0; e < 4; ++e) { const float gt = acc[ai][0][m + mm][n][e] * rs, up = acc[ai][1][m + mm][n][e] * rs;
                            h[n * 4 + e] = gt * __builtin_amdgcn_rcpf(1.0f + __builtin_amdgcn_exp2f(-gt * LOG2E)) * up; }
                    w8[mm].x = cvt4_fp8(h[0], h[1], h[2], h[3]); w8[mm].y = cvt4_fp8(h[4], h[5], h[6], h[7]); }
                const int row = EPI_ROW(u, ai, m) + 16 * (fq & 1);
                *(u32x4*)((unsigned char*)Hd + (size_t)row * DFF + u.ocol + wc * 32 + 8 * (fq & ~1)) = widen16(w8[0], w8[1]); }
    }
};
}

namespace att {
constexpr int QB = 256, KVBLK = 64, PITCH = HW, OPITCH = DM;
constexpr int SLOTB = 8192, LDS_K = 0, LDS_V = 2 * SLOTB, LDS_WS = 4 * SLOTB, LDS_OST = LDS_WS + NWAVES * 256, LDS_FLAG = LDS_OST + NWAVES * 4096, LDS_END = LDS_FLAG + 64;
static_assert(LDS_END <= RING_BYTES, "attention LDS");
__device__ __forceinline__ int crow(int r, int hi) { return (r & 3) + 8 * (r >> 2) + 4 * hi; }
__device__ __forceinline__ void glds16(const void* gsrc, unsigned lds_dst) { unsigned keep;
    asm volatile("s_mov_b32 %0, m0\n\ts_mov_b32 m0, %2\n\ts_nop 0\n\tglobal_load_lds_dwordx4 %1, off\n\ts_mov_b32 m0, %0" : "=&s"(keep) : "v"(gsrc), "s"(lds_dst) : "memory"); }
__device__ __forceinline__ void glds16s(const void* sbase, unsigned voff, unsigned lds_dst) { unsigned keep;
    asm volatile("s_mov_b32 %0, m0\n\ts_mov_b32 m0, %3\n\ts_nop 0\n\tglobal_load_lds_dwordx4 %1, %2\n\ts_mov_b32 m0, %0" : "=&s"(keep) : "v"(voff), "s"(sbase), "s"(lds_dst) : "memory"); }
#define ATT_WAIT_BAR0() asm volatile("s_waitcnt vmcnt(0) lgkmcnt(0)\n\ts_barrier" ::: "memory")
#define MFMA32(a, b, c) __builtin_amdgcn_mfma_f32_32x32x16_bf16(a, b, c, 0, 0, 0)
__device__ __forceinline__ void store_row_ssq(u32x4 v, float* dst, int ch) {
    float q = (bf16lo(v.x) * bf16lo(v.x) + bf16hi(v.x) * bf16hi(v.x)) + (bf16lo(v.y) * bf16lo(v.y) + bf16hi(v.y) * bf16hi(v.y)) + (bf16lo(v.z) * bf16lo(v.z) + bf16hi(v.z) * bf16hi(v.z)) + (bf16lo(v.w) * bf16lo(v.w) + bf16hi(v.w) * bf16hi(v.w));
    q += __shfl_xor(q, 1); q += __shfl_xor(q, 2); q += __shfl_xor(q, 4);
    if (ch == 0) *dst = q;
}
__device__ __forceinline__ void qkt(f32x16& p0, f32x16& p1, const LAS char* Kslot, const bf16x8* qr, const f32x16& cin, int r32, int hi) {
    const LAS char* kb = Kslot + hi * 1024 + r32 * 16;
#pragma unroll
    for (int d0 = 0; d0 < 4; ++d0) {
        const bf16x8 b0 = *(const LAS bf16x8*)(kb + d0 * 2048);
        const bf16x8 b1 = *(const LAS bf16x8*)(kb + d0 * 2048 + 512);
        if (d0 == 0) { p0 = MFMA32(b0, qr[0], cin); p1 = MFMA32(b1, qr[0], cin); }
        else { p0 = MFMA32(b0, qr[d0], p0); p1 = MFMA32(b1, qr[d0], p1); } }
}
__device__ __forceinline__ void pv(f32x16* o, int vb, bf16x8 pa0, bf16x8 pa1, bf16x8 pa2, bf16x8 pa3) {
#pragma unroll
    for (int d0 = 0; d0 < 2; ++d0) { s16x4 lo[4], hi[4];
#pragma unroll
        for (int ks = 0; ks < 4; ++ks) {
            asm volatile("ds_read_b64_tr_b16 %0,%1 offset:%c2" : "=&v"(lo[ks]) : "v"(vb), "i"(d0 * 4096 + ks * 1024) : "memory");
            asm volatile("ds_read_b64_tr_b16 %0,%1 offset:%c2" : "=&v"(hi[ks]) : "v"(vb), "i"(d0 * 4096 + ks * 1024 + 512) : "memory"); }
        asm volatile("s_waitcnt lgkmcnt(0)" ::: "memory"); __builtin_amdgcn_sched_barrier(0);
#define PK(k) (bf16x8){lo[k][0], lo[k][1], lo[k][2], lo[k][3], hi[k][0], hi[k][1], hi[k][2], hi[k][3]}
        o[d0] = MFMA32(pa0, PK(0), o[d0]); o[d0] = MFMA32(pa1, PK(1), o[d0]); o[d0] = MFMA32(pa2, PK(2), o[d0]); o[d0] = MFMA32(pa3, PK(3), o[d0]);
#undef PK
    }
}
__device__ __forceinline__ float swap_lo(float x) { auto rr = __builtin_amdgcn_permlane32_swap(__float_as_uint(x), __float_as_uint(x), false, false); return __uint_as_float(rr[0]); }
__device__ __forceinline__ float swap_hi(float x) { auto rr = __builtin_amdgcn_permlane32_swap(__float_as_uint(x), __float_as_uint(x), false, false); return __uint_as_float(rr[1]); }

}


namespace fox {
constexpr int QB = 256, KVBLK = 64, PITCH = HW, OPITCH = DM;
constexpr int NSLOT = 3, SLOTB = 9216;
constexpr int LDS_K = 0, LDS_V = NSLOT * SLOTB, LDS_WS = 2 * NSLOT * SLOTB, LDS_OST = LDS_WS + NWAVES * 256, LDS_CL = LDS_OST + NWAVES * 4096, LDS_VOTE = LDS_CL + 512, LDS_END = LDS_VOTE + 32;
static_assert(LDS_END <= RING_BYTES, "fox LDS");
constexpr float WIN_T = 48.0f;
constexpr float FLOOR = -256.0f;
using att::crow; using att::glds16; using att::glds16s;
typedef __attribute__((address_space(3))) const char* lds_cptr;
typedef short v4i16_t __attribute__((ext_vector_type(4)));
#define SBAR() __builtin_amdgcn_sched_barrier(0)
#define WAIT_BAR(N) asm volatile("s_waitcnt vmcnt(" #N ") lgkmcnt(0)\n\ts_barrier" ::: "memory")
__device__ __forceinline__ s16x4 vtr(lds_cptr p) { return __builtin_bit_cast(s16x4, __builtin_amdgcn_ds_read_tr16_b64_v4i16((__attribute__((address_space(3))) v4i16_t*)p)); }
__device__ __forceinline__ void kload2(bf16x8* kf, lds_cptr kp, int j) { kf[2 * j] = *(const LAS bf16x8*)(kp + j * 2048); kf[2 * j + 1] = *(const LAS bf16x8*)(kp + j * 2048 + 512); }
__device__ __forceinline__ void cmask(f32x16& p0, f32x16& p1, int jb, int qrel, int hi) {
    const float NEG = -INFINITY; const int kb = 64 * jb + 4 * hi;
#pragma unroll
    for (int r = 0; r < 16; ++r) { const int kv = kb + (r & 3) + 8 * (r >> 2); if (kv > qrel) p0[r] = NEG; if (kv + 32 > qrel) p1[r] = NEG; }
}
__device__ __forceinline__ void split3(float x, unsigned& hm, unsigned& lo) {
    const unsigned h = cvt_pk_bf16(x, 0.f) & 0xffffu; const float r1 = x - __uint_as_float(h << 16);
    const unsigned m = cvt_pk_bf16(r1, 0.f) & 0xffffu; const float r2 = r1 - __uint_as_float(m << 16);
    hm = h | (m << 16); lo = cvt_pk_bf16(r2, 0.f) & 0xffffu;
}
__device__ __forceinline__ bf16x8 qx_build(float a, int hi) {
    unsigned hm, lo; split3(a, hm, lo);
    u32x4 w; w.x = hm; w.y = lo | 0x3F800000u; w.z = 0x3F803F80u; w.w = 0u;
    if (hi) { w.x = 0u; w.y = 0u; w.z = 0u; }
    return __builtin_bit_cast(bf16x8, w);
}

template <int THRL> __device__ __forceinline__ void fox_unit(int bh, int qb, const bf16_t* Q, const bf16_t* K, const bf16_t* V, bf16_t* O, float* hs, const float* cb, const bf16_t* KXall, float kmax, LAS char* shm, bool pre, int nbh, int nqb) {
    const bf16_t* KXh = KXall + (size_t)bh * SEQ * 8;
    int tid = threadIdx.x; asm volatile("" : "+v"(tid)); const int lane = tid & 63, r32 = lane & 31, hi = lane >> 5; const int wid = __builtin_amdgcn_readfirstlane(tid >> 6);
    const int b = bh >> 3, h = bh & 7; const long rowbase = (long)b * SEQ; const int q0 = qb * QB;
    const bf16_t* Qw = Q + (rowbase + q0 + wid * 32) * PITCH + h * HD;
    const bf16_t* Kh = K + rowbase * PITCH + h * HD; const bf16_t* Vh = V + rowbase * PITCH + h * HD;
    const unsigned lds0 = (unsigned)(uintptr_t)shm;
    LAS float* wsf = (LAS float*)(shm + LDS_WS) + wid * 64;
    const int NT = (q0 + QB) / KVBLK;
    int NTe = NT;
    LAS float* clt = (LAS float*)(shm + LDS_CL); LAS unsigned* votes = (LAS unsigned*)(shm + LDS_VOTE);
    const float clv = (tid < NT) ? cb[64 * tid + 63] : 0.f;
    const unsigned koff = (unsigned)(lane * PITCH + wid * 8) * 2u, voff = (unsigned)((16 * (wid & 3) + (lane >> 2)) * PITCH + (wid >> 2) * 32 + (lane & 3) * 8) * 2u, xoff = (unsigned)lane * 16u;
    const unsigned kdst = lds0 + LDS_K + wid * 1024, vdst = lds0 + LDS_V + wid * 1024, xdst = lds0 + LDS_K + 8192;
    const bool xl = (lane >> 3) == wid;
#define DMA_KX(Kb, KXb, NTv, p, slot) do { glds16s((Kb) + (long)((NTv) - 1 - (p)) * KVBLK * PITCH, koff, (unsigned)__builtin_amdgcn_readfirstlane(kdst + (slot))); \
        if (xl) glds16s((KXb) + (long)((NTv) - 1 - (p)) * KVBLK * 8, xoff, (unsigned)__builtin_amdgcn_readfirstlane(xdst + (slot))); } while (0)
#define DMA_VX(Vb, NTv, p, slot) glds16s((Vb) + (long)((NTv) - 1 - (p)) * KVBLK * PITCH, voff, (unsigned)__builtin_amdgcn_readfirstlane(vdst + (slot)))
#define DMA_K(p, slot) DMA_KX(Kh, KXh, NT, p, slot)
#define DMA_V(p, slot) DMA_VX(Vh, NT, p, slot)
    bf16x8 kf[10];
    const lds_cptr shm3 = (lds_cptr)shm; const lds_cptr kp0 = shm3 + LDS_K + hi * 1024 + r32 * 16; const lds_cptr kx0 = shm3 + LDS_K + 8192 + r32 * 16;
    const lds_cptr vp0 = shm3 + LDS_V + ((lane >> 4) & 1) * 32 + (lane & 3) * 8 + (4 * hi + ((lane & 15) >> 2)) * 64;
    if (!pre) { DMA_K(0, 0); DMA_V(0, 0); DMA_K(1, SLOTB); }
    bf16x8 qr[4];
#pragma unroll
    for (int d0 = 0; d0 < 4; ++d0) qr[d0] = *(const bf16x8*)(Qw + (long)r32 * PITCH + d0 * 16 + hi * 8);
    const int qrel = wid * 32 + r32;
    const float ct = cb[q0 + qrel];
    float mhat = 0.f, l_reg = 0.f; f32x16 o[2]; o[0] = f32x16{}; o[1] = f32x16{};
    bf16x8 qx = qx_build(ct, hi);
    const f32x16 z16 = f32x16{};
#define CMASK(P0, P1, p) do { const int jb_ = 3 - (p); if (jb_ >= 0) cmask(P0, P1, jb_, qrel, hi); } while (0)
    bool resc = false;
#define RESC() do { if (resc) { asm volatile("s_waitcnt lgkmcnt(0)" ::: "memory"); \
      _Pragma("unroll") for (int d_ = 0; d_ < 2; ++d_) _Pragma("unroll") for (int r = 0; r < 16; ++r) o[d_][r] *= wsf[crow(r, hi)]; } } while (0)
    f32x16 pA0, pA1, pB0, pB1;
    int sl_prev = 0, sl_cur = 0, sl_next = SLOTB;
#define ROT() do { sl_prev = sl_cur; sl_cur = sl_next; sl_next = (sl_next == (NSLOT - 1) * SLOTB) ? 0 : sl_next + SLOTB; } while (0)
    if (!pre) { DMA_K(2, 2 * SLOTB); }
    if (pre) { WAIT_BAR(0); } else WAIT_BAR(5);
    if (tid < NT) clt[tid] = clv;
    float qkb;
    { float q2 = 0.f;
#pragma unroll
      for (int d0 = 0; d0 < 4; ++d0)
#pragma unroll
          for (int j = 0; j < 8; ++j) { const float e = __uint_as_float(((unsigned)(unsigned short)qr[d0][j]) << 16); q2 += e * e; }
      q2 = att::swap_lo(q2) + att::swap_hi(q2); qkb = sqrtf(q2) * kmax + ct + WIN_T; }
    { const LAS char* kb = (const LAS char*)shm + LDS_K + hi * 1024 + r32 * 16; const LAS char* kxb = (const LAS char*)shm + LDS_K + 8192 + r32 * 16;
      pA0 = MFMA32(*(const LAS bf16x8*)(kxb), qx, z16); pA1 = MFMA32(*(const LAS bf16x8*)(kxb + 512), qx, z16);
#pragma unroll
      for (int d0 = 0; d0 < 4; ++d0) { pA0 = MFMA32(*(const LAS bf16x8*)(kb + d0 * 2048), qr[d0], pA0); pA1 = MFMA32(*(const LAS bf16x8*)(kb + d0 * 2048 + 512), qr[d0], pA1); } }
    asm volatile("s_nop 15\n\ts_nop 7" : "+v"(pA0), "+v"(pA1)); CMASK(pA0, pA1, 0);
    { float a = fmaxf(pA0[0], pA1[0]);
#pragma unroll
      for (int r = 1; r < 16; ++r) a = fmaxf(a, fmaxf(pA0[r], pA1[r]));
      a = fmaxf(att::swap_lo(a), att::swap_hi(a));
      const float dl = fmaxf(a, FLOOR); mhat = dl;
#pragma unroll
      for (int r = 0; r < 16; ++r) { pA0[r] = __builtin_amdgcn_exp2f(pA0[r] - dl); pA1[r] = __builtin_amdgcn_exp2f(pA1[r] - dl); }
      qx = qx_build(ct - mhat, hi); asm volatile("" : "+v"(qx)); }
    WAIT_BAR(0);
    DMA_K(3, 0); DMA_V(1, SLOTB);
    ROT();
    kload2(kf, kp0 + sl_cur, 0); kload2(kf, kp0 + sl_cur, 1); kload2(kf, kp0 + sl_cur, 2); kload2(kf, kp0 + sl_cur, 3);
    kf[8] = *(const LAS bf16x8*)(kx0 + sl_cur); kf[9] = *(const LAS bf16x8*)(kx0 + sl_cur + 512);
    WAIT_BAR(3);
    s16x4 vlo[8], vhi[8]; u32x4 pw0, pw1, pw2, pw3;
#define PKW(P, B) cvt_pk_bf16(P[B], P[B + 1])
#define PAF(k) __builtin_bit_cast(bf16x8, pw##k)
#define VFR(i) (bf16x8){vlo[i][0], vlo[i][1], vlo[i][2], vlo[i][3], vhi[i][0], vhi[i][1], vhi[i][2], vhi[i][3]}
#define PIN(x) asm volatile("" : "+v"(x))
#define MX3(a, b, c) __builtin_fmaxf(__builtin_fmaxf((a), (b)), (c))
#define GAPA(MF, A0, A1, A2, A3, W0, W1, PW) do { MF; sacc += A0; sacc += A1; sacc += A2; sacc += A3; PIN(sacc); W0; W1; PIN(PW); SBAR(); } while (0)
#define EX(v) __builtin_amdgcn_exp2f(v)
#define GAPB(MF, X, B) do { MF; X[B] = EX(X[B]); X[B + 1] = EX(X[B + 1]); X[B + 2] = EX(X[B + 2]); X[B + 3] = EX(X[B + 3]); PIN(X); SBAR(); } while (0)
#define VRD(i) do { vlo[i] = vtr(vp_ + (((i) >> 2) * 4096 + ((i) & 3) * 1024)); vhi[i] = vtr(vp_ + (((i) >> 2) * 4096 + ((i) & 3) * 1024 + 512)); } while (0)
#define KRD(G, j) do { if (G) { kload2(kf, kp0 + sl_next, j); SBAR(); } } while (0)
#define KRDX(G) do { if (G) { kf[8] = *(const LAS bf16x8*)(kx0 + sl_next); kf[9] = *(const LAS bf16x8*)(kx0 + sl_next + 512); SBAR(); } } while (0)
#define STEP(C0, C1, P0, P1, t, GK, GV, GL) do { SBAR(); \
    const lds_cptr vp_ = vp0 + sl_prev; \
    C0 = MFMA32(kf[8], qx, z16); C1 = MFMA32(kf[9], qx, z16); SBAR(); \
    VRD(0); SBAR(); float sacc = (P0[0] + P0[1]); \
    GAPA(C0 = MFMA32(kf[0], qr[0], C0), P0[2], P0[3], P0[4], P0[5],     pw0[0] = PKW(P0, 0), pw0[1] = PKW(P0, 2), pw0); \
    VRD(4); SBAR(); GAPA(C1 = MFMA32(kf[1], qr[0], C1), P0[6], P0[7], P0[8], P0[9],     pw0[2] = PKW(P0, 4), pw0[3] = PKW(P0, 6), pw0); \
    VRD(1); SBAR(); GAPA(C0 = MFMA32(kf[2], qr[1], C0),   P0[10], P0[11], P0[12], P0[13], pw1[0] = PKW(P0, 8), pw1[1] = PKW(P0, 10), pw1); \
    VRD(5); SBAR(); GAPA(C1 = MFMA32(kf[3], qr[1], C1),   P0[14], P0[15], P1[0], P1[1],   pw1[2] = PKW(P0, 12), pw1[3] = PKW(P0, 14), pw1); \
    VRD(2); SBAR(); GAPA(C0 = MFMA32(kf[4], qr[2], C0),   P1[2], P1[3], P1[4], P1[5],     pw2[0] = PKW(P1, 0), pw2[1] = PKW(P1, 2), pw2); \
    VRD(6); SBAR(); GAPA(C1 = MFMA32(kf[5], qr[2], C1),   P1[6], P1[7], P1[8], P1[9],     pw2[2] = PKW(P1, 4), pw2[3] = PKW(P1, 6), pw2); \
    VRD(3); SBAR(); GAPA(C0 = MFMA32(kf[6], qr[3], C0),   P1[10], P1[11], P1[12], P1[13], pw3[0] = PKW(P1, 8), pw3[1] = PKW(P1, 10), pw3); \
    VRD(7); SBAR(); GAPA(C1 = MFMA32(kf[7], qr[3], C1),   P1[14], P1[15], 0.f, 0.f,       pw3[2] = PKW(P1, 12), pw3[3] = PKW(P1, 14), pw3); \
    l_reg += sacc; \
    if (GK) { DMA_K((t) + 3, sl_cur); } if (GV) { DMA_V((t) + 1, sl_next); } \
    CMASK(C0, C1, t); \
    { float a = MX3(C0[0], C0[1], C1[0]), b_ = MX3(C0[2], C0[3], C1[1]); a = MX3(a, C1[2], C1[3]); \
      _Pragma("unroll") for (int r = 4; r < 16; r += 4) { a = MX3(a, C0[r], C0[r + 1]); b_ = MX3(b_, C0[r + 2], C0[r + 3]); a = MX3(a, C1[r], C1[r + 1]); b_ = MX3(b_, C1[r + 2], C1[r + 3]); } \
      float rm = __builtin_fmaxf(a, b_); { auto rr = __builtin_amdgcn_permlane32_swap(__float_as_uint(rm), __float_as_uint(rm), false, false); rm = __builtin_fmaxf(__uint_as_float(rr[0]), __uint_as_float(rr[1])); } \
      resc = false; \
      if (__builtin_expect(__any(rm > (float)THRL), 0)) { const float dl = __builtin_fmaxf(rm, 0.f); mhat += dl; \
        _Pragma("unroll") for (int r = 0; r < 16; ++r) { C0[r] -= dl; C1[r] -= dl; } \
        qx = qx_build(ct - mhat, hi); asm volatile("" : "+v"(qx)); \
        const float f = __builtin_amdgcn_exp2f(-dl); l_reg *= f; if (hi == 0) wsf[r32] = f; resc = true; } } \
    SBAR(); \
    GAPB(o[0] = MFMA32(PAF(0), VFR(0), o[0]), C0, 0); \
    KRDX(GL); GAPB(o[1] = MFMA32(PAF(0), VFR(4), o[1]), C0, 4); \
    KRD(GL, 0); GAPB(o[0] = MFMA32(PAF(1), VFR(1), o[0]), C0, 8); \
    KRD(GL, 1); GAPB(o[1] = MFMA32(PAF(1), VFR(5), o[1]), C0, 12); \
    KRD(GL, 2); GAPB(o[0] = MFMA32(PAF(2), VFR(2), o[0]), C1, 0); \
    KRD(GL, 3); GAPB(o[1] = MFMA32(PAF(2), VFR(6), o[1]), C1, 4); \
    GAPB(o[0] = MFMA32(PAF(3), VFR(3), o[0]), C1, 8); \
    GAPB(o[1] = MFMA32(PAF(3), VFR(7), o[1]), C1, 12); \
    } while (0)
#define ENDW(tt) do { if ((tt) + 3 < NTe) { WAIT_BAR(3); } else if ((tt) + 2 < NTe) { WAIT_BAR(1); } else { WAIT_BAR(0); } } while (0)
#define VOTE(u) do { const int ts_ = NT - (u) - 3; bool ok_ = false; if (ts_ >= 0) { ok_ = __all((qkb - mhat) < clt[ts_]); } if (lane == 0) votes[wid] = ok_ ? 1u : 0u; } while (0)
#define TALLY(u) do { const u32x4 va_ = *(const LAS u32x4*)votes, vb_ = *(const LAS u32x4*)(votes + 4); \
        if (__builtin_amdgcn_readfirstlane((va_.x & va_.y & va_.z & va_.w & vb_.x & vb_.y & vb_.z & vb_.w) != 0u)) { if ((u) + 2 < NTe) { NTe = (u) + 2; WAIT_BAR(0); } } } while (0)
    int t = 1;
    for (; t + 1 < NTe && t < 5; t += 2) {
        STEP(pB0, pB1, pA0, pA1, t, (t + 3 < NTe), (t + 1 < NTe), (t + 1 < NTe));       ENDW(t);     RESC(); ROT();
        STEP(pA0, pA1, pB0, pB1, t + 1, (t + 4 < NTe), (t + 2 < NTe), (t + 2 < NTe));   VOTE(t + 1); ENDW(t + 1); TALLY(t + 1); RESC(); ROT();
    }
#undef CMASK
#define CMASK(P0, P1, p) do {} while (0)
    for (; t + 5 < NTe; t += 2) {
        STEP(pB0, pB1, pA0, pA1, t, true, true, true);       WAIT_BAR(3); RESC(); ROT();
        STEP(pA0, pA1, pB0, pB1, t + 1, true, true, true);   VOTE(t + 1); WAIT_BAR(3); TALLY(t + 1); RESC(); ROT();
    }
    for (; t + 1 < NTe; t += 2) {
        STEP(pB0, pB1, pA0, pA1, t, (t + 3 < NTe), (t + 1 < NTe), (t + 1 < NTe));       ENDW(t);     RESC(); ROT();
        STEP(pA0, pA1, pB0, pB1, t + 1, (t + 4 < NTe), (t + 2 < NTe), (t + 2 < NTe));   ENDW(t + 1); RESC(); ROT();
    }
#undef CMASK
#define CMASK(P0, P1, p) do { const int jb_ = 3 - (p); if (jb_ >= 0) cmask(P0, P1, jb_, qrel, hi); } while (0)
    STEP(pB0, pB1, pA0, pA1, NTe - 1, false, false, false); RESC();
    { float sacc = pB0[0] + pB0[1];
#pragma unroll
      for (int r = 2; r < 16; ++r) sacc += pB0[r];
#pragma unroll
      for (int r = 0; r < 16; ++r) sacc += pB1[r];
      l_reg += sacc;
      pw0 = (u32x4){PKW(pB0, 0), PKW(pB0, 2), PKW(pB0, 4), PKW(pB0, 6)}; pw1 = (u32x4){PKW(pB0, 8), PKW(pB0, 10), PKW(pB0, 12), PKW(pB0, 14)};
      pw2 = (u32x4){PKW(pB1, 0), PKW(pB1, 2), PKW(pB1, 4), PKW(pB1, 6)}; pw3 = (u32x4){PKW(pB1, 8), PKW(pB1, 10), PKW(pB1, 12), PKW(pB1, 14)};
      SBAR(); att::pv(o, (int)(unsigned)(uintptr_t)(vp0 + sl_cur), PAF(0), PAF(1), PAF(2), PAF(3)); }
    if (nbh >= 0) { asm volatile("s_waitcnt lgkmcnt(0)\n\ts_barrier" ::: "memory");
        const int NTn = (nqb * QB + QB) / KVBLK; const bf16_t* Kn = K + (long)(nbh >> 3) * SEQ * PITCH + (nbh & 7) * HD; const bf16_t* Vn = V + (long)(nbh >> 3) * SEQ * PITCH + (nbh & 7) * HD; const bf16_t* KXn = KXall + (size_t)nbh * SEQ * 8;
        DMA_KX(Kn, KXn, NTn, 0, 0); DMA_VX(Vn, NTn, 0, 0); DMA_KX(Kn, KXn, NTn, 1, SLOTB); DMA_KX(Kn, KXn, NTn, 2, 2 * SLOTB); }
    l_reg = att::swap_lo(l_reg) + att::swap_hi(l_reg);
    if (hi == 0) wsf[32 + r32] = l_reg; asm volatile("s_waitcnt lgkmcnt(0)" ::: "memory");
    float rli[16];
#pragma unroll
    for (int r = 0; r < 16; ++r) rli[r] = __builtin_amdgcn_rcpf(wsf[32 + crow(r, hi)]);
    bf16_t* Ow = O + (rowbase + q0 + wid * 32) * OPITCH + h * HD;
    { LAS bf16_t* stg = (LAS bf16_t*)(shm + LDS_OST) + wid * 2048;
#pragma unroll
      for (int r = 0; r < 16; ++r) { const int orow = crow(r, hi);
#pragma unroll
        for (int d0 = 0; d0 < 2; ++d0) stg[orow * 64 + d0 * 32 + r32] = (bf16_t)(cvt_pk_bf16(o[d0][r] * rli[r], 0.f) & 0xffffu); }
      asm volatile("s_waitcnt lgkmcnt(0)" ::: "memory");
#pragma unroll
      for (int i = 0; i < 4; ++i) { const int row = i * 8 + (lane >> 3), ch = lane & 7; const u32x4 v = *(const LAS u32x4*)(stg + row * 64 + ch * 8); *(u32x4*)(Ow + (long)row * OPITCH + ch * 8) = v;
        att::store_row_ssq(v, hs + (rowbase + q0 + wid * 32 + row) * 16, ch); } }
    asm volatile("s_waitcnt lgkmcnt(0)\n\ts_barrier" ::: "memory");
#undef DMA_K
#undef DMA_V
#undef DMA_KX
#undef DMA_VX
#undef CMASK
#undef RESC
#undef ROT
#undef PKW
#undef PAF
#undef VFR
#undef PIN
#undef MX3
#undef GAPA
#undef GAPB
#undef EX
#undef VRD
#undef KRD
#undef KRDX
#undef STEP
#undef ENDW
#undef VOTE
#undef TALLY
}
#undef SBAR
#undef WAIT_BAR
}


namespace sbk {
constexpr int QB = 256, KVBLK = 64, PITCH = HW, OPITCH = DM, NBURST = 6, SLOTB = 8192;
constexpr int LDS_K = 0, LDS_V = NBURST * SLOTB, LDS_FLAG = 2 * NBURST * SLOTB, LDS_END = LDS_FLAG + 128;
static_assert(LDS_END <= RING_BYTES, "sb LDS");
using att::crow; using att::glds16s; using att::qkt; using att::pv; using att::swap_lo;
__device__ __forceinline__ void sb_tile(const LAS char* Kslot, int vb, const bf16x8* qr, bf16x8 TD0, bf16x8 TD1, bf16x8 TONE, int jb, int qrel, int r32, int hi, float& R, f32x16* o) {
    f32x16 p0, p1; const f32x16 z16 = f32x16{};
    qkt(p0, p1, Kslot, qr, z16, r32, hi);
    if (jb >= 0) {
#pragma unroll
        for (int r = 0; r < 16; ++r) { const int kv = 64 * jb + crow(r, hi); if (kv >= qrel) p0[r] = -1.0e30f; if (kv + 32 >= qrel) p1[r] = -1.0e30f; } }
    f32x16 l0, l1;
#pragma unroll
    for (int r = 0; r < 16; ++r) {
        l0[r] = -(fmaxf(p0[r], 0.f) + __builtin_amdgcn_logf(1.0f + __builtin_amdgcn_exp2f(-fabsf(p0[r]))));
        l1[r] = -(fmaxf(p1[r], 0.f) + __builtin_amdgcn_logf(1.0f + __builtin_amdgcn_exp2f(-fabsf(p1[r])))); }
    u32x4 lw0 = {cvt_pk_bf16(l0[0], l0[1]), cvt_pk_bf16(l0[2], l0[3]), cvt_pk_bf16(l0[4], l0[5]), cvt_pk_bf16(l0[6], l0[7])};
    u32x4 lw1 = {cvt_pk_bf16(l0[8], l0[9]), cvt_pk_bf16(l0[10], l0[11]), cvt_pk_bf16(l0[12], l0[13]), cvt_pk_bf16(l0[14], l0[15])};
    u32x4 lw2 = {cvt_pk_bf16(l1[0], l1[1]), cvt_pk_bf16(l1[2], l1[3]), cvt_pk_bf16(l1[4], l1[5]), cvt_pk_bf16(l1[6], l1[7])};
    u32x4 lw3 = {cvt_pk_bf16(l1[8], l1[9]), cvt_pk_bf16(l1[10], l1[11]), cvt_pk_bf16(l1[12], l1[13]), cvt_pk_bf16(l1[14], l1[15])};
    f32x16 rt;
#pragma unroll
    for (int r = 0; r < 16; ++r) rt[r] = R;
    f32x16 t0 = MFMA32(TD0, __builtin_bit_cast(bf16x8, lw0), rt); t0 = MFMA32(TD1, __builtin_bit_cast(bf16x8, lw1), t0);
    t0 = MFMA32(TONE, __builtin_bit_cast(bf16x8, lw2), t0); t0 = MFMA32(TONE, __builtin_bit_cast(bf16x8, lw3), t0);
    f32x16 t1 = MFMA32(TD0, __builtin_bit_cast(bf16x8, lw2), rt); t1 = MFMA32(TD1, __builtin_bit_cast(bf16x8, lw3), t1);
#pragma unroll
    for (int r = 0; r < 16; ++r) { p0[r] = __builtin_amdgcn_exp2f(p0[r] + t0[r]); p1[r] = __builtin_amdgcn_exp2f(p1[r] + t1[r]); }
    R = swap_lo(t0[0]);
    u32x4 pw0 = {cvt_pk_bf16(p0[0], p0[1]), cvt_pk_bf16(p0[2], p0[3]), cvt_pk_bf16(p0[4], p0[5]), cvt_pk_bf16(p0[6], p0[7])};
    u32x4 pw1 = {cvt_pk_bf16(p0[8], p0[9]), cvt_pk_bf16(p0[10], p0[11]), cvt_pk_bf16(p0[12], p0[13]), cvt_pk_bf16(p0[14], p0[15])};
    u32x4 pw2 = {cvt_pk_bf16(p1[0], p1[1]), cvt_pk_bf16(p1[2], p1[3]), cvt_pk_bf16(p1[4], p1[5]), cvt_pk_bf16(p1[6], p1[7])};
    u32x4 pw3 = {cvt_pk_bf16(p1[8], p1[9]), cvt_pk_bf16(p1[10], p1[11]), cvt_pk_bf16(p1[12], p1[13]), cvt_pk_bf16(p1[14], p1[15])};
    pv(o, vb, __builtin_bit_cast(bf16x8, pw0), __builtin_bit_cast(bf16x8, pw1), __builtin_bit_cast(bf16x8, pw2), __builtin_bit_cast(bf16x8, pw3));
}
#define SB_WAITBAR(N) asm volatile("s_waitcnt vmcnt(" #N ") lgkmcnt(0)\n\ts_barrier" ::: "memory")
__device__ __forceinline__ void sb_unit(int b, int h, int qb, const bf16_t* Q, const bf16_t* K, const bf16_t* V, bf16_t* O, float* hs, LAS char* shm) {
    int tid = threadIdx.x; asm volatile("" : "+v"(tid)); const int lane = tid & 63, r32 = lane & 31, hi = lane >> 5; const int wid = __builtin_amdgcn_readfirstlane(tid >> 6);
    const long rowbase = (long)b * SEQ; const int q0 = qb * QB;
    const bf16_t* Qw = Q + (rowbase + q0 + wid * 32) * PITCH + h * HD;
    const bf16_t* Kh = K + rowbase * PITCH + h * HD; const bf16_t* Vh = V + rowbase * PITCH + h * HD;
    const unsigned lds0 = (unsigned)(uintptr_t)shm;
    LAS unsigned* flags = (LAS unsigned*)(shm + LDS_FLAG);
    const unsigned koff = (unsigned)(lane * PITCH + wid * 8) * 2u, voff = (unsigned)((16 * (wid & 3) + (lane >> 2)) * PITCH + (wid >> 2) * 32 + (lane & 3) * 8) * 2u;
    const unsigned kdst = lds0 + LDS_K + wid * 1024, vdst = lds0 + LDS_V + wid * 1024;
#define SB_DMA(p, slot) do { glds16s(Kh + (long)(NT - 1 - (p)) * KVBLK * PITCH, koff, (unsigned)__builtin_amdgcn_readfirstlane(kdst + (slot) * SLOTB)); \
        glds16s(Vh + (long)(NT - 1 - (p)) * KVBLK * PITCH, voff, (unsigned)__builtin_amdgcn_readfirstlane(vdst + (slot) * SLOTB)); } while (0)
    const int vb0 = (int)(lds0 + LDS_V) + ((lane >> 4) & 1) * 32 + (lane & 3) * 8 + (4 * hi + ((lane & 15) >> 2)) * 64;
    const int NT = (q0 + QB) / KVBLK, NB = NT < NBURST ? NT : NBURST;
    for (int p = 0; p < NB; ++p) SB_DMA(p, p);
    bf16x8 qr[4];
#pragma unroll
    for (int d0 = 0; d0 < 4; ++d0) qr[d0] = *(const bf16x8*)(Qw + (long)r32 * PITCH + d0 * 16 + hi * 8);
    f32x16 o[2]; o[0] = f32x16{}; o[1] = f32x16{};
    const int qrel = wid * 32 + r32;
    float R = 0.f;
    bf16x8 TD0, TD1, TONE;
#pragma unroll
    for (int j = 0; j < 8; ++j) { const int kvl = 8 * (j >> 2) + 4 * hi + (j & 3); TD0[j] = (kvl >= r32) ? (short)0x3F80 : (short)0; TD1[j] = (16 + kvl >= r32) ? (short)0x3F80 : (short)0; TONE[j] = (short)0x3F80; }
    if (NB > 4) { SB_WAITBAR(4); } else { SB_WAITBAR(0); }
    bool mid_done = (NB <= 4);
    int p = 3 - (wid >> 1);
    for (; p < NB; ++p) {
        if (p >= 4 && !mid_done) { SB_WAITBAR(0); mid_done = true; }
        sb_tile(shm + LDS_K + p * SLOTB, vb0 + p * SLOTB, qr, TD0, TD1, TONE, 3 - p, qrel, r32, hi, R, o);
        if (__all(R < SB_EXIT)) { ++p; break; }
    }
    if (!mid_done) { SB_WAITBAR(0); }
    { const bool dn = __all(R < SB_EXIT) || (p >= NT); if (lane == 0) flags[wid] = dn ? 1u : 0u; }
    SB_WAITBAR(0);
    bool alldone;
    { const u32x4 fa = *(const LAS u32x4*)flags, fb = *(const LAS u32x4*)(flags + 4); alldone = __builtin_amdgcn_readfirstlane((fa.x & fa.y & fa.z & fa.w & fb.x & fb.y & fb.z & fb.w) != 0u); }
    if (!alldone && NB < NT) {
        SB_DMA(NB, 0);
        for (int i = 0; NB + i < NT; ++i) {
            const int pp = NB + i, sl = i & 1;
            SB_WAITBAR(0);
            if (i > 0) { const LAS unsigned* fl = flags + 8 + ((i - 1) & 1) * 8; const u32x4 fa = *(const LAS u32x4*)fl, fb = *(const LAS u32x4*)(fl + 4);
                if (__builtin_amdgcn_readfirstlane((fa.x & fa.y & fa.z & fa.w & fb.x & fb.y & fb.z & fb.w) != 0u)) break; }
            if (pp + 1 < NT) SB_DMA(pp + 1, sl ^ 1);
            if (!__all(R < SB_EXIT)) sb_tile(shm + LDS_K + sl * SLOTB, vb0 + sl * SLOTB, qr, TD0, TD1, TONE, -1, qrel, r32, hi, R, o);
            { const bool dn = __all(R < SB_EXIT); if (lane == 0) flags[8 + (i & 1) * 8 + wid] = dn ? 1u : 0u; }
        }
        SB_WAITBAR(0);
    }
    bf16_t* Ow = O + (rowbase + q0 + wid * 32) * OPITCH + h * HD;
    { LAS bf16_t* stg = (LAS bf16_t*)(shm + LDS_K) + wid * 2048;
#pragma unroll
      for (int r = 0; r < 16; ++r) { const int orow = crow(r, hi);
#pragma unroll
        for (int d0 = 0; d0 < 2; ++d0) stg[orow * 64 + d0 * 32 + r32] = (bf16_t)(cvt_pk_bf16(o[d0][r], 0.f) & 0xffffu); }
      LDS_WAIT();
#pragma unroll
      for (int i = 0; i < 4; ++i) { const int row = i * 8 + (lane >> 3), ch = lane & 7; const u32x4 v = *(const LAS u32x4*)(stg + row * 64 + ch * 8); *(u32x4*)(Ow + (long)row * OPITCH + ch * 8) = v;
        att::store_row_ssq(v, hs + (rowbase + q0 + wid * 32 + row) * 16, ch); } }
    asm volatile("s_waitcnt vmcnt(0) lgkmcnt(0)\n\ts_barrier" ::: "memory");
#undef SB_DMA
}
#undef SB_WAITBAR
}

#define XB_TMO      128
#define XB_XCNT(j)  (256  + 64 * (j))
#define XB_XSUB(j)  (1280 + 64 * (j))
#define XB_XGEN(j)  (2304 + 64 * (j))
#define XB_TOP      3328
#define XB_TOPGEN   3392
#define XCD_BAR_WORDS 3456
#define XB_SPIN_CAP (1u << 18)
__device__ __forceinline__ unsigned xb_ld(unsigned* p)              { return __hip_atomic_load(p, __ATOMIC_RELAXED, __HIP_MEMORY_SCOPE_AGENT); }
__device__ __forceinline__ unsigned xb_add(unsigned* p, unsigned v) { return __hip_atomic_fetch_add(p, v, __ATOMIC_RELAXED, __HIP_MEMORY_SCOPE_AGENT); }
__device__ __forceinline__ unsigned xb_xcc_id() { return (unsigned)__builtin_amdgcn_s_getreg((3 << 11) | 20) & 0xFu; }
#define XB_SPIN(cond, bar) do { unsigned _sp = 0; while (cond) { __builtin_amdgcn_s_sleep(1); \
    if ((++_sp & 255u) == 0u) { if (xb_ld(&(bar)[XB_TMO])) break; if (_sp > XB_SPIN_CAP) { atomicAdd(&(bar)[XB_TMO], 1u); break; } } } } while (0)
struct XcdBarrier { unsigned* bar; unsigned x; volatile LAS unsigned* st; };
__device__ __forceinline__ XcdBarrier xcd_barrier_post(unsigned* bar, volatile LAS unsigned* st) {
    XcdBarrier b; b.bar = bar; b.x = xb_xcc_id(); b.st = st;
    if (threadIdx.x == 0) (void)xb_add(&bar[XB_XCNT(b.x)], 1u);
    return b;
}
__device__ __forceinline__ void xcd_barrier_complete(unsigned* bar, unsigned x, unsigned& nloc, unsigned& nx) {
    const unsigned G = gridDim.x * gridDim.y * gridDim.z;
    unsigned sum, cnt, mine, sp = 0u;
    for (;;) {
        sum = 0u; cnt = 0u; mine = 0u;
#pragma unroll
        for (unsigned j = 0; j < 16; ++j) { const unsigned c = xb_ld(&bar[XB_XCNT(j)]); sum += c; cnt += (c > 0u) ? 1u : 0u; mine = (j == x) ? c : mine; }
        if (sum == G) break;
        __builtin_amdgcn_s_sleep(1);
        if ((++sp & 255u) == 0u) { if (xb_ld(&bar[XB_TMO])) break; if (sp > XB_SPIN_CAP) { atomicAdd(&bar[XB_TMO], 1u); break; } }
    }
    nloc = mine > 0u ? mine : 1u; nx = cnt > 0u ? cnt : 1u;
}
__device__ __forceinline__ void xcd_barrier(const XcdBarrier& b) {
    asm volatile("s_waitcnt vmcnt(0)" ::: "memory");
    __syncthreads();
    if (threadIdx.x == 0) {
        unsigned* bar = b.bar;
        __builtin_amdgcn_s_waitcnt(0);
        unsigned nloc = b.st[0], nx = b.st[1];
        if (nloc == 0u) { xcd_barrier_complete(bar, b.x, nloc, nx); b.st[0] = nloc; b.st[1] = nx; }
        const unsigned old = xb_add(&bar[XB_XSUB(b.x)], 1u);
        const unsigned gen = old / nloc;
        if (old + 1u == (gen + 1u) * nloc) {
            __builtin_amdgcn_fence(__ATOMIC_RELEASE, "agent");
            asm volatile("s_waitcnt vmcnt(0)" ::: "memory");
            const unsigned og = xb_add(&bar[XB_TOP], 1u);
            const unsigned tg = og / nx;
            if (og + 1u == (tg + 1u) * nx) xb_add(&bar[XB_TOPGEN], 1u);
            else XB_SPIN(xb_ld(&bar[XB_TOPGEN]) == tg, bar);
            __builtin_amdgcn_fence(__ATOMIC_ACQUIRE, "agent");
            xb_add(&bar[XB_XGEN(b.x)], 1u);
            asm volatile("s_waitcnt vmcnt(0)" ::: "memory");
        } else {
            XB_SPIN(xb_ld(&bar[XB_XGEN(b.x)]) == gen, bar);
            __builtin_amdgcn_fence(__ATOMIC_ACQUIRE, "agent");
            asm volatile("s_waitcnt vmcnt(0)" ::: "memory");
        }
    }
    __syncthreads();
}

__device__ __forceinline__ const void* ldp(const volatile LAS unsigned* tab, int i) {
    const unsigned lo = __builtin_amdgcn_readfirstlane(tab[2 * i]), hi = __builtin_amdgcn_readfirstlane(tab[2 * i + 1]);
    return (const void*)(const GAS void*)(((unsigned long long)hi << 32) | lo);
}
struct Args {
    const float* x; const float* mem; const float* norm_mix; const float* w_in; const float* b_forget; const float* norm_fox; const float* norm_sb; const float* w_out;
    const float* norm_xattn; const float* norm_mem; const float* w_xq; const float* w_xkv; const float* w_xo; const float* norm_ffn;
    const float* w_rg; const float* b_rg; const float* w_re; const float* b_re; const float* w_gate; const float* w_up; const float* w_down; const float* norm_final;
    float* out; unsigned char* ws;
};

__device__ __forceinline__ void transpose_item(const float* W, int ldw, bf16_t* WT, int ldo, int k0, int n0, int dst_row0, const float* gain, LAS float* scr, int lane) {
    float tv[32], tg[32];
#pragma unroll
    for (int i = 0; i < 32; ++i) { const int kk = 2 * i + (lane >> 5); tv[i] = __builtin_nontemporal_load(W + (size_t)(k0 + kk) * ldw + n0 + (lane & 31)); tg[i] = gain ? gain[k0 + kk] : 1.f; }
#pragma unroll
    for (int i = 0; i < 32; ++i) { const int kk = 2 * i + (lane >> 5); scr[kk * 33 + (lane & 31)] = tv[i] * tg[i]; }
    LDS_WAIT(); asm volatile("" ::: "memory");
    const int c = lane & 7;
#pragma unroll
    for (int j = 0; j < 4; ++j) { const int n = (lane >> 3) + 8 * j; const LAS float* s = scr + (8 * c) * 33 + n;
        u32x4 o; o.x = cvt_pk_bf16(s[0 * 33], s[1 * 33]); o.y = cvt_pk_bf16(s[2 * 33], s[3 * 33]); o.z = cvt_pk_bf16(s[4 * 33], s[5 * 33]); o.w = cvt_pk_bf16(s[6 * 33], s[7 * 33]);
        *(u32x4*)(WT + (size_t)(dst_row0 + n) * ldo + k0 + 8 * c) = o; }
    LDS_WAIT(); asm volatile("" ::: "memory");
}

__device__ __forceinline__ void transpose_item8(const float* W, int ldw, unsigned char* WT, int ldo, int k0, int n0, int dst_row0, const float* gain, float scale, LAS float* scr, int lane) {
    float tv[32], tg[32];
#pragma unroll
    for (int i = 0; i < 32; ++i) { const int kk = 2 * i + (lane >> 5); tv[i] = __builtin_nontemporal_load(W + (size_t)(k0 + kk) * ldw + n0 + (lane & 31)); tg[i] = gain ? gain[k0 + kk] : 1.f; }
#pragma unroll
    for (int i = 0; i < 32; ++i) { const int kk = 2 * i + (lane >> 5); scr[kk * 33 + (lane & 31)] = tv[i] * tg[i] * scale; }
    LDS_WAIT(); asm volatile("" ::: "memory");
    const int c = lane & 7;
#pragma unroll
    for (int j = 0; j < 4; ++j) { const int n = (lane >> 3) + 8 * j; const LAS float* s = scr + (8 * c) * 33 + n;
        u32x2 o; o.x = cvt4_fp8(s[0 * 33], s[1 * 33], s[2 * 33], s[3 * 33]); o.y = cvt4_fp8(s[4 * 33], s[5 * 33], s[6 * 33], s[7 * 33]);
        *(u32x2*)(WT + (size_t)(dst_row0 + n) * ldo + k0 + 8 * c) = o; }
    LDS_WAIT(); asm volatile("" ::: "memory");
}

struct SchedDense {
    const char* A; const char* Bt; int nM, nN, G, c; size_t a_tile, b_tile, b_batch; int split_tiles;
    __device__ __forceinline__ bool next(int i, pg8::Unit& u) const {
        int pm, pn; if (!pg8::tile_order(i, G, c, nM, nN, pm, pn)) return false;
        u.a = A + (size_t)pm * a_tile; u.b = Bt + (size_t)pn * b_tile + (size_t)(pm >> 5) * b_batch; u.orow = pm * 256;
        if (split_tiles) { u.aux = pn / split_tiles; u.ocol = (pn % split_tiles) * 256; } else { u.aux = 1; u.ocol = pn * 256; }
        u.rows = nullptr; u.nvalid = 256; return true;
    }
};
struct SchedGH {
    const char* KVm; const char* Wxq; const char* Wxo; int G, c;
    __device__ __forceinline__ bool next(int i, pg8::Unit& u) const {
        const int L = i * G + c; if (L >= 256) return false;
        const int kind = L >> 7, r = L & 127, bh = r >> 2, j = r & 3, b = bh >> 2, h = bh & 3;
        if (kind == 0) { u.a = KVm + ((size_t)(b * 256) * 2048 + h * 256) * 2; u.b = Wxq + ((size_t)(256 * j) * 1024 + h * 256) * 2; u.orow = b * 1024 + h * 256; u.ocol = 256 * j; u.aux = 1; }
        else { u.a = Wxo + ((size_t)(256 * j) * 1024 + h * 256) * 2; u.b = KVm + ((size_t)(b * 256) * 2048 + 1024 + h * 256) * 2; u.orow = b * 1024 + 256 * j; u.ocol = h * 256; u.aux = 2; }
        u.rows = nullptr; u.nvalid = 256; return true;
    }
};
template <int KIND> struct SchedGHk { SchedGH s; __device__ __forceinline__ bool next(int i, pg8::Unit& u) const { const int c2 = (s.G >= 256) ? s.c - 128 * KIND : s.c; if (c2 < 0) return false; const int L = i * s.G + c2; if (L >= 128) return false; SchedGH t = s; t.G = 1; t.c = 0; return t.next(128 * KIND + L, u); } };
struct EpiGH { static constexpr bool HAS_MID = false; unsigned char* GTp; unsigned char* HTp;
    __device__ __forceinline__ void operator()(const f32x4 (&acc)[2][2][4][2], const pg8::Unit& u, int wr, int wc, int fr, int fq) const {
        unsigned char* base = u.aux == 1 ? GTp : HTp;
#pragma unroll
        for (int ai = 0; ai < 2; ++ai)
#pragma unroll
            for (int m = 0; m < 4; m += 2) { const int row = u.orow + ai * pg8::HALF + wr * 64 + m * 16 + fr + 16 * (fq & 1);
#pragma unroll
                for (int bj = 0; bj < 2; ++bj) { u32x2 w8[2];
#pragma unroll
                    for (int mm = 0; mm < 2; ++mm) { const f32x4 v0 = acc[ai][bj][m + mm][0], v1 = acc[ai][bj][m + mm][1]; w8[mm].x = cvt4_fp8(v0[0], v0[1], v0[2], v0[3]); w8[mm].y = cvt4_fp8(v1[0], v1[1], v1[2], v1[3]); }
                    *(u32x4*)(base + (size_t)row * DM + u.ocol + bj * pg8::HALF + wc * 32 + 8 * (fq & ~1)) = widen16(w8[0], w8[1]); } }
    } };
struct SchedMoe {
    const char* A; const char* W; const int* list; const LAS int* tbl; int G, c, NPN; size_t w_exp, w_tile, a_tile; int ocol_w;
    __device__ __forceinline__ bool next(int i, pg8::Unit& u) const {
        const int L = i * G + c; const int tl = L / NPN, pn = L % NPN;
        if (tl >= __builtin_amdgcn_readfirstlane(tbl[16])) return false;
        int e = 0;
#pragma unroll 1
        for (int x = 1; x < NEXP; ++x) { if (tl >= __builtin_amdgcn_readfirstlane(tbl[x])) e = x; }
        const int j = tl - __builtin_amdgcn_readfirstlane(tbl[e]), n = __builtin_amdgcn_readfirstlane(tbl[32 + e]) - 256 * j;
        u.a = A + (size_t)tl * a_tile; u.b = W + (size_t)e * w_exp + (size_t)pn * w_tile; u.orow = tl * 256; u.ocol = pn * ocol_w; u.aux = 1;
        u.rows = list + (size_t)e * M + 256 * j; u.nvalid = n < 256 ? n : 256; return true;
    }
};
__device__ __forceinline__ void moe_table(LAS int* tbl, const unsigned* ctl) {
    if (threadIdx.x == 0) { int base = 0; for (int e = 0; e < NEXP; ++e) { const int n = (int)ctl[CW_CNT + 64 * e]; tbl[e] = base; tbl[32 + e] = n; base += (n + 255) >> 8; } tbl[16] = base; }
    __syncthreads();
}

__global__ void __launch_bounds__(NWAVES * 64, 2) hymba_fwd(Args args) {
    extern __shared__ __attribute__((aligned(16))) unsigned char lds_raw[];
    LAS unsigned char* lds = (LAS unsigned char*)lds_raw;
    volatile LAS unsigned* MISC = (volatile LAS unsigned*)(lds + MISC_OFF);
    const int tid0 = threadIdx.x; const int wave = __builtin_amdgcn_readfirstlane(tid0 >> 6);
    const int G = gridDim.x; const int bx = blockIdx.x; const int vcu = (G % 8 == 0) ? (bx % 8) * (G / 8) + bx / 8 : bx;
    volatile LAS unsigned* ATAB = (volatile LAS unsigned*)(lds + MISC_OFF + 512);
    for (int u = tid0; u < 256; u += NWAVES * 64) ((LAS unsigned*)(lds + MISC_OFF))[u] = 0u;
    __syncthreads();
    if (tid0 == 0) { const float* const* ap = (const float* const*)&args;
#pragma unroll
        for (int i = 0; i < 24; ++i) { const unsigned long long v = (unsigned long long)ap[i]; ATAB[2 * i] = (unsigned)v; ATAB[2 * i + 1] = (unsigned)(v >> 32); } }
    __syncthreads();
#define ARGP(name) ((const float*)ldp(ATAB, (int)(offsetof(Args, name) / 8)))
#define PHASE_PTRS \
    int tid = threadIdx.x; asm volatile("" : "+v"(tid)); const int lane = tid & 63; (void)lane; \
    unsigned char* const ws = (unsigned char*)ldp(ATAB, 23); float* const out = (float*)ldp(ATAB, 22); unsigned* const ctl = (unsigned*)(ws + WS_CTL); (void)out; (void)ctl; \
    bf16_t* const Win_t = (bf16_t*)(ws + WS_WIN); bf16_t* const Wout_t = (bf16_t*)(ws + WS_WOUT); bf16_t* const Wxq_n = (bf16_t*)(ws + WS_WXQ); bf16_t* const Wxkv_t = (bf16_t*)(ws + WS_WXKV); \
    bf16_t* const Wxo_t = (bf16_t*)(ws + WS_WXO); bf16_t* const Wgu_t = (bf16_t*)(ws + WS_WGU); bf16_t* const Wd_t = (bf16_t*)(ws + WS_WD); \
    float* const RX = (float*)(ws + WS_RX); float* const RMEM = (float*)(ws + WS_RMEM); float* const LF = (float*)(ws + WS_LF); float* const CC = (float*)(ws + WS_C2); float* const SSQ = (float*)(ws + WS_SSQ); \
    int* const TOKSLOT = (int*)(ws + WS_TOKSLOT); float* const TOKW = (float*)(ws + WS_TOKW); int* const LIST = (int*)(ws + WS_LIST); \
    bf16_t* const MEMB = (bf16_t*)(ws + WS_MEMB); bf16_t* const KVM = (bf16_t*)(ws + WS_KVM); bf16_t* const GT = (bf16_t*)(ws + WS_GT); bf16_t* const HT = (bf16_t*)(ws + WS_HT); \
    bf16_t* const XB = (bf16_t*)(ws + WS_XB); bf16_t* const QKV = (bf16_t*)(ws + WS_QKV); bf16_t* const H1B = (bf16_t*)(ws + WS_H1B); bf16_t* const U2B = (bf16_t*)(ws + WS_U2B); bf16_t* const HID = (bf16_t*)(ws + WS_HID); \
    bf16_t* const OAB = (bf16_t*)(ws + WS_O); bf16_t* const YB = (bf16_t*)(ws + WS_Y); bf16_t* const KX = (bf16_t*)(ws + WS_KX); (void)KX; float* const HS = (float*)(ws + WS_HS); (void)HS; float* const R2S = (float*)(ws + WS_SSQ); (void)R2S; unsigned char* const H1F8 = ws + WS_H1F8; (void)H1F8; unsigned char* const H2F8 = ws + WS_H2F8; (void)H2F8; \
    (void)Win_t; (void)Wout_t; (void)Wxq_n; (void)Wxkv_t; (void)Wxo_t; (void)Wgu_t; (void)Wd_t; (void)RX; (void)RMEM; (void)LF; (void)CC; (void)SSQ; (void)TOKSLOT; (void)TOKW; (void)LIST; \
    (void)MEMB; (void)KVM; (void)GT; (void)HT; (void)XB; (void)QKV; (void)H1B; (void)U2B; (void)HID; (void)OAB; (void)YB;
    XcdBarrier bar;
    { unsigned char* const ws0 = (unsigned char*)ldp(ATAB, 23); bar = xcd_barrier_post((unsigned*)(ws0 + WS_CTL) + CW_BAR, MISC + 8); }
    const int gw = vcu * NWAVES + wave, NGW = G * NWAVES;
    unsigned long long t_pa = 0, t_pb = 0; (void)t_pa; (void)t_pb;


    if (PROBE_LO == 0) t_pa = __builtin_amdgcn_s_memrealtime();
    if (PH(0))
    for (int rep_ = 0; rep_ < REPS(0); ++rep_)
    {
        PHASE_PTRS
        LAS float* wfT = (LAS float*)(lds + RING_OFF);
        LAS float* scr = (LAS float*)(lds + RING_OFF + 32768 + wave * 8448);
        { const float* win = ARGP(w_in); const float* gmix = ARGP(norm_mix);
          f32x4 fa[2], fb[2]; float gk[2];
#pragma unroll
          for (int q = 0; q < 2; ++q) { const int k = tid + 512 * q; gk[q] = gmix[k]; fa[q] = *(const f32x4*)(win + (size_t)k * WIN_LD + NPROJ); fb[q] = *(const f32x4*)(win + (size_t)k * WIN_LD + NPROJ + 4); }
#pragma unroll
          for (int q = 0; q < 2; ++q) { const int k = tid + 512 * q;
#pragma unroll
              for (int j = 0; j < 4; ++j) { wfT[j * DM + k] = fa[q][j] * gk[q]; wfT[(4 + j) * DM + k] = fb[q][j] * gk[q]; } } }
        constexpr int I_IN = 16 * 96, I_OUT = 16 * 32, I_XKV = 16 * 64, I_XO = 16 * 32, I_G = 16 * 16 * 8, I_U = I_G, I_D = 16 * 4 * 32, I_XQ = 1024;
        constexpr int NITEMS = I_IN + I_OUT + I_XKV + I_XO + I_G + I_U + I_D + I_XQ;
        for (int it = gw; it < NITEMS; it += NGW) {
            int r = it;
            if (r < I_IN) { const int kb = r / 96, nb = r % 96; transpose_item(ARGP(w_in), WIN_LD, Win_t, DM, 64 * kb, 32 * nb, 32 * nb, ARGP(norm_mix), scr, lane); continue; } r -= I_IN;
            if (r < I_OUT) { const int kb = r / 32, nb = r % 32; const float* gn = (64 * kb < HW) ? ARGP(norm_fox) : (ARGP(norm_sb) - HW); transpose_item(ARGP(w_out), DM, Wout_t, DM, 64 * kb, 32 * nb, 32 * nb, gn, scr, lane); continue; } r -= I_OUT;
            if (r < I_XKV) { const int kb = r / 64, nb = r % 64; transpose_item(ARGP(w_xkv), 2 * DM, Wxkv_t, DM, 64 * kb, 32 * nb, 32 * nb, ARGP(norm_mem), scr, lane); continue; } r -= I_XKV;
            if (r < I_XO) { const int kb = r / 32, nb = r % 32; transpose_item(ARGP(w_xo), DM, Wxo_t, DM, 64 * kb, 32 * nb, 32 * nb, nullptr, scr, lane); continue; } r -= I_XO;
            if (r < I_G + I_U) { const int up = r >= I_G; const int q = up ? r - I_G : r; const int e = q / 128, kb = (q % 128) / 8, nb = q % 8; const int n0 = 32 * nb;
                const float* W = (up ? ARGP(w_up) : ARGP(w_gate)) + (size_t)e * DM * DFF;
                transpose_item8(W, DFF, (unsigned char*)Wgu_t + (size_t)e * 512 * DM, DM, 64 * kb, n0, 256 * (n0 / 128) + (n0 % 128) + (up ? 128 : 0), ARGP(norm_ffn), WGU_SCALE, scr, lane); continue; } r -= I_G + I_U;
            if (r < I_D) { const int e = r / 128, kb = (r % 128) / 32, nb = r % 32; transpose_item8(ARGP(w_down) + (size_t)e * DFF * DM, DM, (unsigned char*)Wd_t + (size_t)e * DM * DFF, DFF, 64 * kb, 32 * nb, 32 * nb, nullptr, WD_SCALE, scr, lane); continue; } r -= I_D;
            { const int k = r; const float gk = ARGP(norm_xattn)[k]; const f32x4* src = (const f32x4*)(ARGP(w_xq) + (size_t)k * DM) + lane; u32x2* dst = (u32x2*)(Wxq_n + (size_t)k * DM) + lane;
#pragma unroll
              for (int j = 0; j < 4; ++j) { const f32x4 v = src[64 * j] * gk; u32x2 w; w.x = cvt_pk_bf16(v[0], v[1]); w.y = cvt_pk_bf16(v[2], v[3]); dst[64 * j] = w; } }
        }
        __syncthreads();
        const float* xin = ARGP(x); const float* memin = ARGP(mem); const float* bfg = ARGP(b_forget);
        constexpr int TOT = M + MEMROWS;
#define P0_LOAD(vv, rw) do { if ((rw) < TOT) { const bool im_ = (rw) >= M; const f32x4* xr_ = (const f32x4*)((im_ ? memin : xin) + (size_t)(im_ ? (rw) - M : (rw)) * DM) + lane; \
        _Pragma("unroll") for (int j = 0; j < 4; ++j) vv[j] = __builtin_nontemporal_load(xr_ + 64 * j); } } while (0)
#define P0_ROW(vv, rw) do { const int row_ = (rw); const bool is_mem = row_ >= M; const int r = is_mem ? row_ - M : row_; float s = 0.f; \
        _Pragma("unroll") for (int j = 0; j < 4; ++j) s += (vv[j][0] * vv[j][0] + vv[j][1] * vv[j][1]) + (vv[j][2] * vv[j][2] + vv[j][3] * vv[j][3]); \
        const float rinv = rsqrtf(wave_sum(s) * (1.0f / DM) + EPS); \
        u32x2* o8 = (u32x2*)((is_mem ? MEMB : XB) + (size_t)r * DM) + lane; \
        _Pragma("unroll") for (int j = 0; j < 4; ++j) { u32x2 w; w.x = cvt_pk_bf16(vv[j][0], vv[j][1]); w.y = cvt_pk_bf16(vv[j][2], vv[j][3]); o8[64 * j] = w; } \
        if (is_mem) { if (lane == 0) RMEM[r] = rinv; } \
        else { float f[8]; \
            _Pragma("unroll") for (int jj = 0; jj < 8; ++jj) { float a = 0.f; \
                _Pragma("unroll") for (int j = 0; j < 4; ++j) { const f32x4 w4 = *(const LAS f32x4*)(wfT + jj * DM + 256 * j + 4 * lane); a += (vv[j][0] * w4[0] + vv[j][1] * w4[1]) + (vv[j][2] * w4[2] + vv[j][3] * w4[3]); } \
                f[jj] = wave_sum(a); } \
            if (lane == 0) RX[r] = rinv; \
            if (lane < 8) { float fl = 0.f; \
                _Pragma("unroll") for (int jj = 0; jj < 8; ++jj) fl = (lane == jj) ? f[jj] : fl; \
                fl = fl * rinv + bfg[lane]; \
                const float ls = fminf(fl, 0.f) - log1pf(expf(-fabsf(fl))); \
                LF[(size_t)r * 8 + lane] = ls * LOG2E; } } } while (0)
        f32x4 va[4], vb[4], vc[4];
        P0_LOAD(va, gw); P0_LOAD(vb, gw + NGW);
        for (int row = gw; row < TOT; row += 3 * NGW) {
            P0_LOAD(vc, row + 2 * NGW); P0_ROW(va, row);
            if (row + NGW < TOT) { P0_LOAD(va, row + 3 * NGW); P0_ROW(vb, row + NGW); }
            if (row + 2 * NGW < TOT) { P0_LOAD(vb, row + 4 * NGW); P0_ROW(vc, row + 2 * NGW); }
        }
#undef P0_LOAD
#undef P0_ROW
    }
    xcd_barrier(bar);
    if (PROBE_HI == 0) t_pb = __builtin_amdgcn_s_memrealtime();

    if (PROBE_LO == 1) t_pa = __builtin_amdgcn_s_memrealtime();
    if (PH(1))
    if (vcu < 32) {
        PHASE_PTRS
        const int b = vcu >> 2, h = (vcu & 3) * 2 + (wave >> 2), seg = wave & 3, s0 = seg * 2048 + lane * 32;
        const float* src = LF + ((size_t)b * SEQ + s0) * 8 + h;
        float p[32];
#pragma unroll
        for (int j = 0; j < 32; ++j) p[j] = src[j * 8];
#pragma unroll
        for (int j = 1; j < 32; ++j) p[j] += p[j - 1];
        float inc = p[31];
#pragma unroll
        for (int o = 1; o < 64; o <<= 1) { const float y = __shfl_up(inc, o); if (lane >= o) inc += y; }
        LAS float* tot = (LAS float*)(lds + EXTRA_OFF);
        if (lane == 63) tot[wave] = inc;
        __syncthreads();
        float off = inc - p[31];
        for (int q = 0; q < 3; ++q) if (q < seg) off += tot[(wave & 4) + q];
        float* dst = CC + ((size_t)b * NH + h) * SEQ + s0; bf16_t* kx = KX + (((size_t)b * NH + h) * SEQ + s0) * 8;
#pragma unroll
        for (int j = 0; j < 32; ++j) { const float x = off + p[j]; dst[j] = x;
            unsigned hm, lo; fox::split3(-x, hm, lo); u32x4 w; w.x = 0x3F803F80u; w.y = 0x3F80u | (hm << 16); w.z = (hm >> 16) | (lo << 16); w.w = 0u;
            *(u32x4*)(kx + j * 8) = w; }
        VM_WAIT(); __syncthreads();
    }
    if (PH(1))
    for (int rep_ = 0; rep_ < REPS(1); ++rep_)
    {
        PHASE_PTRS
        pg8::Gemm g{DM, DM, DM};
        SchedDense S{(const char*)XB, (const char*)Win_t, M / 256, NPROJ / 256, G, bx, (size_t)256 * DM * 2, (size_t)256 * DM * 2, 0, 2};
        LAS float* rst = (LAS float*)(lds + EXTRA_OFF);
#pragma unroll
        for (int q = 0; q < 8; ++q) { const int idx = tid + 512 * q, i = idx >> 8, r = idx & 255; int pm, pn; if (pg8::tile_order(i, G, bx, M / 256, NPROJ / 256, pm, pn)) rst[idx] = RX[pm * 256 + r]; }
        VM_WAIT(); __syncthreads();
        pg8::EpiBf16 E{QKV, HW, RX, QKV_STRIDE, C2, C2, ctl + CW_KN, rst, 1.f};
        pg8::gemm_phase<pg8::EpiBf16, SchedDense, true, false>(lds + RING_OFF, g, S, E);
    }
    xcd_barrier(bar);
    if (PROBE_HI == 1) t_pb = __builtin_amdgcn_s_memrealtime();

    if (PROBE_LO == 2) t_pa = __builtin_amdgcn_s_memrealtime();
    if (PH(2))
    {
        PHASE_PTRS
        const bf16_t* QA = QKV; const bf16_t* KA = QKV + QKV_STRIDE; const bf16_t* VA = QKV + 2 * QKV_STRIDE;
        const bf16_t* QBp = QKV + 3 * QKV_STRIDE; const bf16_t* KBp = QKV + 4 * QKV_STRIDE; const bf16_t* VBp = QKV + 5 * QKV_STRIDE;
        bf16_t* OA = OAB; bf16_t* OB = OAB + HW;
        LAS char* shm = (LAS char*)(lds + RING_OFF);
        { pg8::Gemm g{DM, DM, DM};
          SchedDense S2{(const char*)MEMB, (const char*)Wxkv_t, MEMROWS / 256, 2 * DM / 256, G, bx, (size_t)256 * DM * 2, (size_t)256 * DM * 2, 0, 0};
          pg8::EpiBf16 E2{KVM, 2 * DM, RMEM, 0, 1.f, 1.f, nullptr, nullptr, 1.f};
          pg8::gemm_phase<pg8::EpiBf16, SchedDense, true, false>(lds + RING_OFF, g, S2, E2);
          VM_WAIT(); __syncthreads(); }
        for (int rep = 0; rep < REP_FOX; ++rep)
        for (int i = 0; i < 8; ++i) { const int bh = (vcu >> 5) * 8 + i, x = vcu & 31, qb = (i & 1) ? 31 - x : x;
            const float kmax = sqrtf(__uint_as_float(ctl[CW_KN + bh * 2]) + __uint_as_float(ctl[CW_KN + bh * 2 + 1])) * 1.01f;
            const int nqb = ((i + 1) & 1) ? 31 - x : x;
            fox::fox_unit<8>(bh, qb, QA, KA, VA, OA, HS + (bh & 7), CC + (size_t)bh * SEQ, KX, kmax, shm, i > 0, i < 7 ? bh + 1 : -1, nqb); }
        { volatile LAS unsigned* qs = MISC + 16;
          unsigned nxt = 0u;
          if (tid == 0) qs[0] = __hip_atomic_fetch_add(ctl + CW_SBQ, 1u, __ATOMIC_RELAXED, __HIP_MEMORY_SCOPE_AGENT);
          __syncthreads();
          unsigned idx = qs[0];
          while (idx < (unsigned)(BATCH * NH * 32 * REP_SB)) {
              __syncthreads();
              if (tid == 0) nxt = __hip_atomic_fetch_add(ctl + CW_SBQ, 1u, __ATOMIC_RELAXED, __HIP_MEMORY_SCOPE_AGENT);
              const int un = (int)(idx % (unsigned)(BATCH * NH * 32)), bh = un >> 5, qb = un & 31;
              sbk::sb_unit(bh >> 3, bh & 7, qb, QBp, KBp, VBp, OB, HS + 8 + (bh & 7), shm);
              if (tid == 0) qs[0] = nxt;
              __syncthreads();
              idx = qs[0];
          } }
    }
    xcd_barrier(bar);
    if (PROBE_HI == 2) t_pb = __builtin_amdgcn_s_memrealtime();

    if (PROBE_LO == 4) t_pa = __builtin_amdgcn_s_memrealtime();
    if (PH(4))
    for (int rep_ = 0; rep_ < REPS(4); ++rep_)
    {
        PHASE_PTRS
        pg8::Gemm g{DM, DM, DM};
        SchedDense S{(const char*)OAB, (const char*)Wout_t, M / 256, DM / 256, G, bx, (size_t)256 * DM * 2, (size_t)256 * DM * 2, 0, 0};
        LAS f32x2* rab = (LAS f32x2*)(lds + EXTRA_OFF);
#pragma unroll
        for (int q = 0; q < 4; ++q) { const int idx = tid + 512 * q, i = idx >> 8, r = idx & 255; int pm, pn;
            if (pg8::tile_order(i, G, bx, M / 256, DM / 256, pm, pn)) { const f32x4* p = (const f32x4*)(HS + (size_t)(pm * 256 + r) * 16); const f32x4 a0 = p[0], a1 = p[1], b0 = p[2], b1 = p[3];
                const float ra = rsqrtf((((a0[0] + a0[1]) + (a0[2] + a0[3])) + ((a1[0] + a1[1]) + (a1[2] + a1[3]))) * (1.0f / HW) + EPS);
                const float rb = rsqrtf((((b0[0] + b0[1]) + (b0[2] + b0[3])) + ((b1[0] + b1[1]) + (b1[2] + b1[3]))) * (1.0f / HW) + EPS);
                rab[idx] = (f32x2){ra / rb, rb}; } }
        VM_WAIT(); __syncthreads();
        pg8::EpiOutProj E{XB, H1B, H1F8, SSQ, rab};
        pg8::gemm_phase<pg8::EpiOutProj, SchedDense, true, false>(lds + RING_OFF, g, S, E);
        pg8::Gemm g2{0, 0, 256};
        SchedGH SG{(const char*)KVM, (const char*)Wxq_n, (const char*)Wxo_t, G, bx};
        EpiGH EG{(unsigned char*)GT, (unsigned char*)HT};
        g2.lda = 2 * DM; g2.ldb = DM; SchedGHk<0> S0{SG}; pg8::gemm_phase<EpiGH, SchedGHk<0>, true, false>(lds + RING_OFF, g2, S0, EG);
        g2.lda = DM; g2.ldb = 2 * DM; SchedGHk<1> S1{SG}; pg8::gemm_phase<EpiGH, SchedGHk<1>, true, false>(lds + RING_OFF, g2, S1, EG);
    }
    xcd_barrier(bar);
    if (PROBE_HI == 4) t_pb = __builtin_amdgcn_s_memrealtime();

    if (PROBE_LO == 5) t_pa = __builtin_amdgcn_s_memrealtime();
    if (PH(5))
    for (int rep_ = 0; rep_ < REPS(5); ++rep_)
    {
        PHASE_PTRS
        pg8::Gemm g{DM, DM, DM};
        SchedDense S{(const char*)H1F8, (const char*)GT, M / 256, DM / 256, G, bx, (size_t)256 * DM, (size_t)256 * DM, (size_t)DM * DM, 0};
        LAS float* r1t = (LAS float*)(lds + EXTRA_OFF + 8192);
#pragma unroll
        for (int q = 0; q < 4; ++q) { const int idx = tid + 512 * q, i = idx >> 8, r = idx & 255; int pm, pn;
            if (pg8::tile_order(i, G, bx, M / 256, DM / 256, pm, pn)) { const f32x4* sp = (const f32x4*)(SSQ + (size_t)(pm * 256 + r) * 16); const f32x4 s0 = sp[0], s1 = sp[1], s2 = sp[2], s3 = sp[3];
                const float tot = ((s0[0] + s0[1]) + (s0[2] + s0[3])) + ((s1[0] + s1[1]) + (s1[2] + s1[3])) + ((s2[0] + s2[1]) + (s2[2] + s2[3])) + ((s3[0] + s3[1]) + (s3[2] + s3[3]));
                r1t[idx] = rsqrtf(tot * (1.0f / DM) + EPS) * XSC; } }
        VM_WAIT(); __syncthreads();
        pg8::EpiSoftmax E{XB, r1t, (LAS float*)(lds + EXTRA_OFF)};
        pg8::gemm_phase<pg8::EpiSoftmax, SchedDense, true, false, true>(lds + RING_OFF, g, S, E);
    }
    xcd_barrier(bar);
    if (PROBE_HI == 5) t_pb = __builtin_amdgcn_s_memrealtime();

    if (PROBE_LO == 6) t_pa = __builtin_amdgcn_s_memrealtime();
    if (PH(6))
    {
        PHASE_PTRS
        pg8::Gemm g{DM, DM, DM};
        SchedDense S{(const char*)XB, (const char*)HT, M / 256, DM / 256, G, bx, (size_t)256 * DM, (size_t)256 * DM, (size_t)DM * DM, 0};
        pg8::EpiResidBf16 E{H1B, H2F8, 1.0f / P_SCALE};
        pg8::gemm_phase<pg8::EpiResidBf16, SchedDense, true, false, true>(lds + RING_OFF, g, S, E);
    }
    xcd_barrier(bar);
    if (PROBE_HI == 6) t_pb = __builtin_amdgcn_s_memrealtime();

    if (PROBE_LO == 7) t_pa = __builtin_amdgcn_s_memrealtime();
    if (PH(7))
    {
        PHASE_PTRS
        LAS bf16_t* wBh = (LAS bf16_t*)(lds + RING_OFF); LAS bf16_t* wBl = wBh + 20 * DM;
        { const f32x4* wg4 = (const f32x4*)ARGP(w_rg); const f32x4* we4 = (const f32x4*)ARGP(w_re); const float* gf = ARGP(norm_ffn);
          f32x4 ga[2], ea[2][4]; float gk[2];
#pragma unroll
          for (int q = 0; q < 2; ++q) { const int k = tid + 512 * q; ga[q] = wg4[k]; gk[q] = gf[k];
#pragma unroll
              for (int c = 0; c < 4; ++c) ea[q][c] = we4[k * 4 + c]; }
#pragma unroll
          for (int q = 0; q < 2; ++q) { const int k = tid + 512 * q;
#pragma unroll
              for (int j = 0; j < 4; ++j) { { const float v = ga[q][j] * gk[q]; const unsigned hi_ = cvt_pk_bf16(v, 0.f) & 0xffffu; wBh[j * DM + k] = (bf16_t)hi_; wBl[j * DM + k] = (bf16_t)(cvt_pk_bf16(v - __uint_as_float(hi_ << 16), 0.f) & 0xffffu); }
#pragma unroll
                  for (int c = 0; c < 4; ++c) { const float v = ea[q][c][j] * gk[q]; const unsigned hi_ = cvt_pk_bf16(v, 0.f) & 0xffffu; const int col = 4 + 4 * c + j; wBh[col * DM + k] = (bf16_t)hi_; wBl[col * DM + k] = (bf16_t)(cvt_pk_bf16(v - __uint_as_float(hi_ << 16), 0.f) & 0xffffu); } } } }
        LAS int* dec_e = (LAS int*)(lds + RING_OFF + 81920); LAS float* dec_w = (LAS float*)(lds + RING_OFF + 81920 + 2048); LAS int* dec_r = (LAS int*)(lds + RING_OFF + 81920 + 4096);
        LAS int* hist = (LAS int*)(lds + RING_OFF + 81920 + 6144); LAS int* ebase = hist + 16; LAS float* dec_v = (LAS float*)(lds + RING_OFF + 81920 + 8192);
        if (tid < 16) hist[tid] = 0;
        __syncthreads();
        const float brg0 = ARGP(b_rg)[0], brg1 = ARGP(b_rg)[1], brg2 = ARGP(b_rg)[2], brg3 = ARGP(b_rg)[3]; const float* bre = ARGP(b_re);
        const int tok = lane & 31, half = lane >> 5, jcol = tok < 20 ? tok : 19;
        for (int it = 0; it * NGW < M / 32; ++it) {
            const int T = gw + it * NGW; const bool act = T < M / 32; const int r0 = act ? 32 * T : 0;
            const bf16_t* rowp = H1B + (size_t)(r0 + tok) * DM + 512 * half;
            const LAS bf16_t* wph = wBh + jcol * DM + 512 * half; const LAS bf16_t* wpl = wBl + jcol * DM + 512 * half;
            f32x16 ah0 = f32x16{}, ah1 = f32x16{}, al0 = f32x16{}, al1 = f32x16{}; float ssq = 0.f;
#pragma unroll 4
            for (int sidx = 0; sidx < 64; sidx += 2) {
                const u32x4 a0 = *(const u32x4*)(rowp + 8 * sidx), a1 = *(const u32x4*)(rowp + 8 * sidx + 8);
                const bf16x8 wh0 = *(const LAS bf16x8*)(wph + 8 * sidx), wl0 = *(const LAS bf16x8*)(wpl + 8 * sidx), wh1 = *(const LAS bf16x8*)(wph + 8 * sidx + 8), wl1 = *(const LAS bf16x8*)(wpl + 8 * sidx + 8);
                ah0 = MFMA32(wh0, __builtin_bit_cast(bf16x8, a0), ah0); al0 = MFMA32(wl0, __builtin_bit_cast(bf16x8, a0), al0);
                ah1 = MFMA32(wh1, __builtin_bit_cast(bf16x8, a1), ah1); al1 = MFMA32(wl1, __builtin_bit_cast(bf16x8, a1), al1);
                ssq += (bf16lo(a0.x) * bf16lo(a0.x) + bf16hi(a0.x) * bf16hi(a0.x)) + (bf16lo(a0.y) * bf16lo(a0.y) + bf16hi(a0.y) * bf16hi(a0.y)) + (bf16lo(a0.z) * bf16lo(a0.z) + bf16hi(a0.z) * bf16hi(a0.z)) + (bf16lo(a0.w) * bf16lo(a0.w) + bf16hi(a0.w) * bf16hi(a0.w));
                ssq += (bf16lo(a1.x) * bf16lo(a1.x) + bf16hi(a1.x) * bf16hi(a1.x)) + (bf16lo(a1.y) * bf16lo(a1.y) + bf16hi(a1.y) * bf16hi(a1.y)) + (bf16lo(a1.z) * bf16lo(a1.z) + bf16hi(a1.z) * bf16hi(a1.z)) + (bf16lo(a1.w) * bf16lo(a1.w) + bf16hi(a1.w) * bf16hi(a1.w));
            }
            const float rinv = rsqrtf((att::swap_lo(ssq) + att::swap_hi(ssq)) * (1.0f / DM) + EPS);
            float lg[20];
#pragma unroll
            for (int r = 0; r < 12; ++r) { const float c = (ah0[r] + ah1[r]) + (al0[r] + al1[r]); auto rr = __builtin_amdgcn_permlane32_swap(__float_as_uint(c), __float_as_uint(c), false, false);
                const int jl = (r & 3) + 8 * (r >> 2); lg[jl] = __uint_as_float(rr[0]) * rinv; if (r < 8) lg[jl + 4] = __uint_as_float(rr[1]) * rinv; }
            float g0 = lg[0] + brg0, g1 = lg[1] + brg1, g2 = lg[2] + brg2, g3 = lg[3] + brg3;
            int gi = 0; float gm = g0; if (g1 > gm) { gm = g1; gi = 1; } if (g2 > gm) { gm = g2; gi = 2; } if (g3 > gm) { gm = g3; gi = 3; }
            const float gval = 1.0f / (expf(g0 - gm) + expf(g1 - gm) + expf(g2 - gm) + expf(g3 - gm));
            float el[4];
#pragma unroll
            for (int j = 0; j < 4; ++j) { const float e0 = lg[4 + j], e1 = lg[8 + j], e2 = lg[12 + j], e3 = lg[16 + j]; el[j] = ((gi == 0) ? e0 : (gi == 1) ? e1 : (gi == 2) ? e2 : e3) + bre[gi * 4 + j]; }
            int i0 = 0; float m0 = el[0];
#pragma unroll
            for (int j = 1; j < 4; ++j) if (el[j] > m0) { m0 = el[j]; i0 = j; }
            int i1 = -1; float m1 = -3.0e38f;
#pragma unroll
            for (int j = 0; j < 4; ++j) if (j != i0 && el[j] > m1) { m1 = el[j]; i1 = j; }
            const float w0 = 1.0f / (1.0f + expf(m1 - m0)), w1 = 1.0f - w0;
            if (act) { const int e = gi * 4 + (half == 0 ? i0 : i1); const float w = gval * (half == 0 ? w0 : w1);
                const int idx = (wave * 32 + tok) * 2 + half; dec_e[idx] = e; dec_w[idx] = w; dec_v[idx] = rinv; dec_r[idx] = __hip_atomic_fetch_add(hist + e, 1, __ATOMIC_RELAXED, __HIP_MEMORY_SCOPE_WORKGROUP); }
            __syncthreads();
            if (tid < 16) { const int n = hist[tid]; ebase[tid] = n ? (int)__hip_atomic_fetch_add(ctl + CW_CNT + 64 * tid, (unsigned)n, __ATOMIC_RELAXED, __HIP_MEMORY_SCOPE_AGENT) : 0; }
            __syncthreads();
            if (act) { const int row = r0 + (lane >> 1), idx = wave * 64 + lane; const int e = dec_e[idx], pos = ebase[e] + dec_r[idx];
                LIST[(size_t)e * M + pos] = row; R2S[(size_t)e * M + pos] = dec_v[idx]; TOKSLOT[(size_t)row * 2 + (lane & 1)] = (e << 20) | pos; TOKW[(size_t)row * 2 + (lane & 1)] = dec_w[idx]; }
            __syncthreads();
            if (tid < 16) hist[tid] = 0;
            __syncthreads();
        }
    }
    xcd_barrier(bar);
    if (PROBE_HI == 7) t_pb = __builtin_amdgcn_s_memrealtime();

    if (PROBE_LO == 8) t_pa = __builtin_amdgcn_s_memrealtime();
    if (PH(8))
    for (int rep_ = 0; rep_ < REPS(8); ++rep_)
    {
        PHASE_PTRS
        pg8::Gemm g{DM, DM, DM};
        LAS int* tbl = (LAS int*)(lds + EXTRA_OFF + 8192); moe_table(tbl, ctl);
        SchedMoe S; S.A = (const char*)H2F8; S.W = (const char*)Wgu_t; S.list = LIST; S.tbl = tbl; S.G = G; S.c = bx; S.NPN = 2; S.w_exp = (size_t)512 * DM; S.w_tile = (size_t)256 * DM; S.a_tile = 0; S.ocol_w = 128;
        pg8::EpiSwiglu E{HID, R2S, LIST};
        pg8::gemm_phase<pg8::EpiSwiglu, SchedMoe, true, true, true>(lds + RING_OFF, g, S, E);
    }
    xcd_barrier(bar);
    if (PROBE_HI == 8) t_pb = __builtin_amdgcn_s_memrealtime();

    if (PROBE_LO == 9) t_pa = __builtin_amdgcn_s_memrealtime();
    if (PH(9))
    for (int rep_ = 0; rep_ < REPS(9); ++rep_)
    {
        PHASE_PTRS
        pg8::Gemm g{DFF, DFF, DFF};
        LAS int* tbl = (LAS int*)(lds + EXTRA_OFF + 8192);
        SchedMoe S; S.A = (const char*)HID; S.W = (const char*)Wd_t; S.list = LIST; S.tbl = tbl; S.G = G; S.c = bx; S.NPN = 4; S.w_exp = (size_t)DM * DFF; S.w_tile = (size_t)256 * DFF; S.a_tile = (size_t)256 * DFF; S.ocol_w = 256;
        pg8::EpiY8 E{(unsigned char*)YB, 1.0f / WD_SCALE};
        pg8::gemm_phase<pg8::EpiY8, SchedMoe, true, false, true>(lds + RING_OFF, g, S, E);
    }
    xcd_barrier(bar);
    if (PROBE_HI == 9) t_pb = __builtin_amdgcn_s_memrealtime();

    if (PROBE_LO == 10) t_pa = __builtin_amdgcn_s_memrealtime();
    if (PH(10))
    {
        PHASE_PTRS
        const LAS int* tb = (const LAS int*)(lds + EXTRA_OFF + 8192);
        const f32x4* gp = (const f32x4*)ARGP(norm_final) + lane;
        int sl0 = 0, sl1 = 0; float sw0 = 0.f, sw1 = 0.f;
        unsigned ya_n[4], yb_n[4]; u32x2 hh_n[4]; float w0_n = 0.f, w1_n = 0.f;
#define P10_SLOTS(rw) do { sl0 = TOKSLOT[(size_t)(rw) * 2]; sl1 = TOKSLOT[(size_t)(rw) * 2 + 1]; sw0 = TOKW[(size_t)(rw) * 2]; sw1 = TOKW[(size_t)(rw) * 2 + 1]; } while (0)
#define P10_DATA(rw) do { const int r0_ = tb[sl0 >> 20] * 256 + (sl0 & 0xfffff), r1_ = tb[sl1 >> 20] * 256 + (sl1 & 0xfffff); w0_n = sw0; w1_n = sw1; \
        const unsigned* y0_ = (const unsigned*)((const unsigned char*)YB + (size_t)r0_ * DM) + lane; const unsigned* y1_ = (const unsigned*)((const unsigned char*)YB + (size_t)r1_ * DM) + lane; const u32x2* h_ = (const u32x2*)(H1B + (size_t)(rw) * DM) + lane; \
        _Pragma("unroll") for (int j = 0; j < 4; ++j) { ya_n[j] = y0_[64 * j]; yb_n[j] = y1_[64 * j]; hh_n[j] = h_[64 * j]; } } while (0)
        if (gw < M) { P10_SLOTS(gw); P10_DATA(gw); if (gw + NGW < M) P10_SLOTS(gw + NGW); }
        for (int row = gw; row < M; row += NGW) {
            unsigned ya[4], yb[4]; u32x2 hh[4]; const float w0 = w0_n, w1 = w1_n;
#pragma unroll
            for (int j = 0; j < 4; ++j) { ya[j] = ya_n[j]; yb[j] = yb_n[j]; hh[j] = hh_n[j]; }
            if (row + NGW < M) { P10_DATA(row + NGW); if (row + 2 * NGW < M) P10_SLOTS(row + 2 * NGW); }
            f32x4* hr = (f32x4*)(out + (size_t)row * DM) + lane;
            f32x4 v[4]; float s = 0.f;
#pragma unroll
            for (int j = 0; j < 4; ++j) { const u32x2 hx = hh[j]; f32x4 h = {bf16lo(hx.x), bf16hi(hx.x), bf16lo(hx.y), bf16hi(hx.y)};
                const f32x2 a01 = __builtin_amdgcn_cvt_pk_f32_fp8((int)ya[j], false), a23 = __builtin_amdgcn_cvt_pk_f32_fp8((int)ya[j], true), b01 = __builtin_amdgcn_cvt_pk_f32_fp8((int)yb[j], false), b23 = __builtin_amdgcn_cvt_pk_f32_fp8((int)yb[j], true);
                h[0] += w0 * a01[0] + w1 * b01[0]; h[1] += w0 * a01[1] + w1 * b01[1]; h[2] += w0 * a23[0] + w1 * b23[0]; h[3] += w0 * a23[1] + w1 * b23[1];
                v[j] = h; s += (h[0] * h[0] + h[1] * h[1]) + (h[2] * h[2] + h[3] * h[3]); }
            const float rinv = rsqrtf(wave_sum(s) * (1.0f / DM) + EPS);
#pragma unroll
            for (int j = 0; j < 4; ++j) __builtin_nontemporal_store(v[j] * rinv * gp[64 * j], hr + 64 * j);
        }
#undef P10_SLOTS
#undef P10_DATA
    }
    if (PROBE_LO >= 0) {
        if (PROBE_HI == 10) t_pb = __builtin_amdgcn_s_memrealtime();
        if (blockIdx.x == 0 && threadIdx.x == 0) { const unsigned long long t0 = __builtin_amdgcn_s_memrealtime(), span = 2 * (t_pb - t_pa);
            while (__builtin_amdgcn_s_memrealtime() - t0 < span) __builtin_amdgcn_s_sleep(8); }
    }
}

extern "C" void kernel_launch(void* const* d_in, const int* in_sizes, int n_in, void* d_out, int out_size, void* d_ws, size_t ws_size, hipStream_t stream) {
    static int grid = 0;
    if (grid == 0) {
        if (n_in != 22 || in_sizes[0] != M * DM || out_size != M * DM || ws_size < WS_END) { fprintf(stderr, "kernel_launch: unexpected shapes (n_in %d, in0 %d, out %d, ws %zu)\n", n_in, n_in > 0 ? in_sizes[0] : -1, out_size, ws_size); grid = -1; return; }
        int dev = 0, cus = 0, per_cu = 0;
        if (hipGetDevice(&dev) != hipSuccess || hipDeviceGetAttribute(&cus, hipDeviceAttributeMultiprocessorCount, dev) != hipSuccess) { grid = -1; return; }
        if (hipFuncSetAttribute((const void*)hymba_fwd, hipFuncAttributeMaxDynamicSharedMemorySize, LDS_BYTES) != hipSuccess) { fprintf(stderr, "kernel_launch: hipFuncSetAttribute failed\n"); grid = -1; return; }
        if (hipOccupancyMaxActiveBlocksPerMultiprocessor(&per_cu, (const void*)hymba_fwd, NWAVES * 64, LDS_BYTES) != hipSuccess || per_cu < 1) { fprintf(stderr, "kernel_launch: occupancy query reports %d\n", per_cu); }
        (void)hipGetLastError();
        grid = cus;
    }
    if (grid < 0) return;
    (void)hipMemsetAsync((char*)d_ws + WS_CTL, 0, CTL_ZERO_BYTES, stream);
    Args a{};
    const float** p = (const float**)&a;
    for (int i = 0; i < 22; ++i) p[i] = (const float*)d_in[i];
    a.out = (float*)d_out; a.ws = (unsigned char*)d_ws;
    hipLaunchKernelGGL(hymba_fwd, dim3(grid), dim3(NWAVES * 64), LDS_BYTES, stream, a);
}
```

```cpp
#include <hip/hip_runtime.h>
#include <hip/hip_bf16.h>
#include <cstdio>
#include <cstdint>

#define LAS __attribute__((address_space(3)))
#define GAS __attribute__((address_space(1)))
typedef unsigned short bf16_t;
typedef short bf16x8 __attribute__((ext_vector_type(8)));
typedef short s16x4 __attribute__((ext_vector_type(4)));
typedef float f32x4 __attribute__((ext_vector_type(4)));
typedef float f32x2 __attribute__((ext_vector_type(2)));
typedef float f32x16 __attribute__((ext_vector_type(16)));
typedef unsigned u32x4 __attribute__((ext_vector_type(4)));
typedef unsigned u32x2 __attribute__((ext_vector_type(2)));
typedef __bf16 bf16x2_t __attribute__((ext_vector_type(2)));

constexpr int BATCH = 8, SEQ = 8192, DM = 1024, M = BATCH * SEQ;
constexpr int NH = 8, HD = 64, HW = NH * HD;
constexpr int NPROJ = 3 * HW * 2;
constexpr int WIN_LD = NPROJ + NH;
constexpr int NMEM = 256, XH = 4, XD = 256, MEMROWS = BATCH * NMEM;
constexpr int NEXP = 16, DFF = 256;
constexpr float EPS = 1e-6f;
constexpr float LOG2E = 1.4426950408889634f;
constexpr float C2 = 0.125f * LOG2E;
constexpr float XSC = 0.0625f * LOG2E;
constexpr float P_SCALE = 128.0f;
constexpr float WGU_SCALE = 32.0f;
constexpr float WD_SCALE = 16.0f;
constexpr float SB_EXIT = -48.0f;

constexpr size_t MiB = 1u << 20;
constexpr size_t WS_CTL = 0, CTL_ZERO_BYTES = 128 * 1024;
constexpr size_t WS_WIN = 1 * MiB;
constexpr size_t WS_WOUT = 7 * MiB;
constexpr size_t WS_WXQ = 9 * MiB;
constexpr size_t WS_WXKV = 11 * MiB;
constexpr size_t WS_WXO = 15 * MiB;
constexpr size_t WS_WGU = 17 * MiB;
constexpr size_t WS_WD = 33 * MiB;
constexpr size_t WS_RX = 41 * MiB;
constexpr size_t WS_RMEM = WS_RX + 256 * 1024;
constexpr size_t WS_R2 = WS_RX + 512 * 1024;
constexpr size_t WS_LF = 42 * MiB;
constexpr size_t WS_C2 = 44 * MiB;
constexpr size_t WS_SSQ = 46 * MiB;
constexpr size_t WS_TOKSLOT = 50 * MiB;
constexpr size_t WS_TOKW = 51 * MiB;
constexpr size_t WS_LIST = 52 * MiB;
constexpr size_t WS_MEMB = 56 * MiB;
constexpr size_t WS_KVM = 60 * MiB;
constexpr size_t WS_GT = 68 * MiB;
constexpr size_t WS_HT = 84 * MiB;
constexpr size_t WS_KX = 100 * MiB;
constexpr size_t WS_HS = 108 * MiB;
constexpr size_t WS_XB = 128 * MiB;
constexpr size_t WS_QKV = 256 * MiB;
constexpr size_t WS_H1B = 256 * MiB, WS_U2B = 384 * MiB, WS_HID = 512 * MiB;
constexpr size_t WS_H1F8 = 384 * MiB, WS_H2F8 = 448 * MiB;
constexpr size_t WS_O = 640 * MiB;
constexpr size_t WS_Y = 704 * MiB;
constexpr size_t WS_END = 1024 * MiB;
constexpr size_t QKV_STRIDE = (size_t)M * HW;
constexpr int MAXTILES = M * 2 / 256 + NEXP;
static_assert(WS_Y + (size_t)MAXTILES * 256 * 1024 * 2 <= WS_END, "ws map");
static_assert(WS_HID + (size_t)MAXTILES * 256 * 256 * 2 <= WS_O, "ws map");
constexpr int CW_BAR = 4096;
constexpr int CW_SBQ = 20736;
constexpr int CW_KN = 20480;
constexpr int CW_CNT = 16384;

constexpr int RING_OFF = 0, RING_BYTES = 131072;
constexpr int EXTRA_OFF = 131072, EXTRA_BYTES = 16384;
constexpr int MISC_OFF = EXTRA_OFF + EXTRA_BYTES;
constexpr int LDS_BYTES = MISC_OFF + 1024;
constexpr int NWAVES = 8;
#ifndef PHASE_MASK
#define PHASE_MASK 0x7ff
#endif
#define PH(n) ((PHASE_MASK >> (n)) & 1)
#ifndef PROBE_LO
#define PROBE_LO -1
#endif
#ifndef PROBE_HI
#define PROBE_HI -1
#endif
#ifndef REP_MASK
#define REP_MASK 0
#endif
#define REPS(n) (1 + ((REP_MASK >> (n)) & 1))
#ifndef REP_FOX
#define REP_FOX 1
#endif
#ifndef REP_SB
#define REP_SB 1
#endif

__device__ __forceinline__ unsigned cvt_pk_bf16(float lo, float hi) { f32x2 v = {lo, hi}; bf16x2_t b = __builtin_convertvector(v, bf16x2_t); return __builtin_bit_cast(unsigned, b); }
__device__ __forceinline__ unsigned cvt4_fp8(float a, float b, float c, float d) { int w = 0; w = __builtin_amdgcn_cvt_pk_fp8_f32(a, b, w, false); w = __builtin_amdgcn_cvt_pk_fp8_f32(c, d, w, true); return (unsigned)w; }
__device__ __forceinline__ u32x4 widen16(u32x2 a, u32x2 b) {
    const auto r0 = __builtin_amdgcn_permlane16_swap(a.x, b.x, false, false); const auto r1 = __builtin_amdgcn_permlane16_swap(a.y, b.y, false, false);
    return (u32x4){r0[0], r1[0], r0[1], r1[1]};
}
__device__ __forceinline__ float bf16lo(unsigned u) { return __uint_as_float(u << 16); }
__device__ __forceinline__ float bf16hi(unsigned u) { return __uint_as_float(u & 0xffff0000u); }
#define DPP_ADD(v, CTRL) v += __builtin_bit_cast(float, __builtin_amdgcn_update_dpp(0, __builtin_bit_cast(int, v), CTRL, 0xf, 0xf, true))
__device__ __forceinline__ float wave_sum(float v) {
    DPP_ADD(v, 0xB1); DPP_ADD(v, 0x4E); DPP_ADD(v, 0x141); DPP_ADD(v, 0x140);
    const int iv = __builtin_bit_cast(int, v);
    return (__builtin_bit_cast(float, __builtin_amdgcn_readlane(iv, 0)) + __builtin_bit_cast(float, __builtin_amdgcn_readlane(iv, 16))) +
           (__builtin_bit_cast(float, __builtin_amdgcn_readlane(iv, 32)) + __builtin_bit_cast(float, __builtin_amdgcn_readlane(iv, 48)));
}
#define LDS_WAIT() asm volatile("s_waitcnt lgkmcnt(0)" ::: "memory")
#define VM_WAIT() asm volatile("s_waitcnt vmcnt(0)" ::: "memory")

namespace pg8 {
constexpr int BM = 256, BK = 64, HALF = 128, HTB = HALF * BK * 2, STAGE_BYTES = 8 * HTB, NXCD = 8, WGM = 8;
__host__ __device__ __forceinline__ int lds_byte(int r, int c) { const int st = (r >> 4) * 2 + (c >> 5), rr = r & 15, cc = c & 31, ob = rr * 64 + cc * 2; return st * 1024 + (ob ^ (((ob >> 9) & 1) << 5)); }
__host__ __device__ __forceinline__ void stage_rc(int b, int& R, int& C) { const int st = b / 1024, sb = b % 1024, swz = sb ^ (((sb >> 9) & 1) << 5); R = (st >> 1) * 16 + swz / 64; C = (st & 1) * 32 + (swz % 64) / 2; }
__host__ __device__ __forceinline__ int perm32(int rho) { const int n = rho >> 4, i = rho & 15; return 8 * (i >> 2) + 4 * n + (i & 3); }

struct Unit { const char* a; const char* b; int orow, ocol, aux; const int* rows; int nvalid; int seq; };
struct Gemm { int lda, ldb, K; };

__device__ __forceinline__ bool tile_order(int i, int G, int c, int nM, int nN, int& pm, int& pn) {
    const int nwg = nM * nN; const long L = (long)i * G + c; if (L >= nwg) return false;
    int wgid = (int)L; { const int q = nwg / NXCD, r = nwg % NXCD, xcd = wgid % NXCD, off = wgid / NXCD; wgid = (xcd < r ? xcd * (q + 1) : r * (q + 1) + (xcd - r) * q) + off; }
    const int nig = WGM * nN, gid = wgid / nig, fm = gid * WGM, gsz = (nM - fm) < WGM ? (nM - fm) : WGM;
    pm = fm + ((wgid % nig) % gsz); pn = (wgid % nig) / gsz; return true;
}

typedef int v8i32 __attribute__((ext_vector_type(8)));
template <class Epi, class Sched, bool ALIGN_EPI, bool GATHER, bool FP8 = false>
__device__ __forceinline__ void gemm_phase(LAS unsigned char* lds, const Gemm g, const Sched& S, const Epi& E) {
    int tid = threadIdx.x; asm volatile("" : "+v"(tid));
    const int wid = __builtin_amdgcn_readfirstlane(tid >> 6), lane = tid & 63, wr = wid >> 2, wc = wid & 3, fr = lane & 15, fq = lane >> 4;
    constexpr int ESZ = FP8 ? 1 : 2;
    const int K = g.K, nt = K / (FP8 ? 2 * BK : BK);
    unsigned voffA[2], voffB[2]; int RA[2], CA[2];
#pragma unroll
    for (int i = 0; i < 2; ++i) { int R, C; stage_rc(tid * 16 + i * 8192, R, C); const int Rb = (R & ~31) + perm32(R & 31);
        RA[i] = R; CA[i] = C; voffA[i] = (unsigned)(R * g.lda * ESZ + C * 2); voffB[i] = (unsigned)(Rb * g.ldb * ESZ + C * 2); }
    const size_t kstep = (size_t)(BK * 2);
    const size_t hstepA = (size_t)HALF * g.lda * ESZ, hstepB = (size_t)HALF * g.ldb * ESZ;
    const unsigned ldsw = (unsigned)wid * 1024u;
    const int aoff = lds_byte(wr * 64 + fr, FP8 ? fq * 16 : fq * 8), boff = lds_byte(wc * 32 + fr, FP8 ? fq * 16 : fq * 8);
    constexpr int KOFF = FP8 ? 16 : 1024;
#define PG8_SA(b, h) (((b) * 2 + (h)) * HTB)
#define PG8_SB(b, h) ((4 + (b) * 2 + (h)) * HTB)
#define PG8_STAGE2(bufoff, gbase, v0, v1) do { \
        __builtin_amdgcn_global_load_lds((const unsigned*)((const char*)(gbase) + (v0)), (LAS unsigned*)(lds + (bufoff) + ldsw), 16, 0, 0); \
        __builtin_amdgcn_global_load_lds((const unsigned*)((const char*)(gbase) + (v1)), (LAS unsigned*)(lds + (bufoff) + ldsw + 8192), 16, 0, 0); } while (0)
#define PG8_STAGEB(bufoff, gbase) PG8_STAGE2(bufoff, gbase, voffB[0], voffB[1])
#define PG8_STAGEA(bufoff, kptr, h, NX) do { if constexpr (GATHER) { const unsigned v0_ = (NX) ? gvn[h][0] : gvc[h][0], v1_ = (NX) ? gvn[h][1] : gvc[h][1]; PG8_STAGE2(bufoff, kptr, v0_, v1_); } \
        else { PG8_STAGE2(bufoff, (kptr) + (h) * hstepA, voffA[0], voffA[1]); } } while (0)
#define PG8_LDA(dst, b, h) do { _Pragma("unroll") for (int m = 0; m < 4; ++m) _Pragma("unroll") for (int k = 0; k < 2; ++k) dst[m][k] = *(const LAS bf16x8*)(lds + PG8_SA(b, h) + aoff + m * 2048 + k * KOFF); } while (0)
#define PG8_LDB(dst, b, h) do { _Pragma("unroll") for (int n = 0; n < 2; ++n) _Pragma("unroll") for (int k = 0; k < 2; ++k) dst[n][k] = *(const LAS bf16x8*)(lds + PG8_SB(b, h) + boff + n * 2048 + k * KOFF); } while (0)
#define PG8_CAT(x) __builtin_shufflevector(__builtin_bit_cast(f32x4, (x)[0]), __builtin_bit_cast(f32x4, (x)[1]), 0, 1, 2, 3, 4, 5, 6, 7)
#define PG8_MMA(ai, bj, At, Bt) do { __builtin_amdgcn_s_setprio(1); _Pragma("unroll") for (int m = 0; m < 4; ++m) _Pragma("unroll") for (int n = 0; n < 2; ++n) { \
        if constexpr (FP8) { acc[ai][bj][m][n] = __builtin_amdgcn_mfma_scale_f32_16x16x128_f8f6f4(__builtin_bit_cast(v8i32, PG8_CAT(Bt[n])), __builtin_bit_cast(v8i32, PG8_CAT(At[m])), acc[ai][bj][m][n], 0, 0, 0, 0x7F7F7F7F, 0, 0x7F7F7F7F); } \
        else { _Pragma("unroll") for (int k = 0; k < 2; ++k) acc[ai][bj][m][n] = __builtin_amdgcn_mfma_f32_16x16x32_bf16(Bt[n][k], At[m][k], acc[ai][bj][m][n], 0, 0, 0); } } \
        _Pragma("unroll") for (int m = 0; m < 4; ++m) _Pragma("unroll") for (int n = 0; n < 2; ++n) asm volatile("" : "+v"(acc[ai][bj][m][n]));     \
        __builtin_amdgcn_s_setprio(0); } while (0)
#define PG8_WAIT_V(n) asm volatile("s_waitcnt vmcnt(" #n ")" ::: "memory")
#define PG8_WAIT_L(n) asm volatile("s_waitcnt lgkmcnt(" #n ")" ::: "memory")
#define PG8_BAR __builtin_amdgcn_s_barrier()
#define PG8_SCHED __builtin_amdgcn_sched_barrier(0)
#define PG8_GATHER_OFFS(dst, u) do { _Pragma("unroll") for (int h_ = 0; h_ < 2; ++h_) _Pragma("unroll") for (int i_ = 0; i_ < 2; ++i_) { const int r_ = h_ * HALF + RA[i_]; \
        const int idx_ = (u).rows[r_ < (u).nvalid ? r_ : 0]; dst[h_][i_] = (unsigned)(idx_ * g.lda * ESZ + CA[i_] * 2); } } while (0)
    Unit cur, nxt; int ui = 0;
    if (!S.next(0, cur)) return;
    cur.seq = 0;
    unsigned gvc[2][2] = {{0u, 0u}, {0u, 0u}}, gvn[2][2] = {{0u, 0u}, {0u, 0u}};
    if constexpr (GATHER) { PG8_GATHER_OFFS(gvc, cur); }
    f32x4 acc[2][2][4][2];
#pragma unroll
    for (int a = 0; a < 2; ++a)
#pragma unroll
        for (int b = 0; b < 2; ++b)
#pragma unroll
            for (int m = 0; m < 4; ++m)
#pragma unroll
                for (int n = 0; n < 2; ++n) acc[a][b][m][n] = (f32x4){0.f, 0.f, 0.f, 0.f};
    bf16x8 At[4][2], B0[2][2], B1[2][2];
    const char* cA = cur.a; const char* cB = cur.b;
    PG8_STAGEB(PG8_SB(0, 0), cB); PG8_STAGEB(PG8_SB(0, 1), cB + hstepB); PG8_STAGEA(PG8_SA(0, 0), cA, 0, false); PG8_STAGEA(PG8_SA(0, 1), cA, 1, false);
    if (wr == 1) PG8_BAR;
    PG8_WAIT_V(2); PG8_BAR;
    PG8_STAGEB(PG8_SB(1, 0), cB + kstep); PG8_STAGEA(PG8_SA(1, 0), cA + kstep, 0, false); PG8_STAGEB(PG8_SB(1, 1), cB + hstepB + kstep);
    PG8_WAIT_V(6); PG8_BAR;
    for (;;) {
        const bool has_next = S.next(ui + 1, nxt); nxt.seq = ui + 1;
        const char* nA = has_next ? nxt.a : cA; const char* nB = has_next ? nxt.b : cB;
        if constexpr (GATHER) { if (has_next) { PG8_GATHER_OFFS(gvn, nxt); } else { gvn[0][0] = gvc[0][0]; gvn[0][1] = gvc[0][1]; gvn[1][0] = gvc[1][0]; gvn[1][1] = gvc[1][1]; } }
#pragma unroll 1
        for (int t = 0; t < nt; t += 2) {
            const bool last = (t == nt - 2);
            const char* a1 = cA + (size_t)(t + 1) * kstep;
            const char* a2 = last ? nA : cA + (size_t)(t + 2) * kstep; const char* b2 = last ? nB : cB + (size_t)(t + 2) * kstep;
            const char* a3 = a2 + kstep; const char* b3 = b2 + kstep;
            PG8_LDB(B0, 0, 0); PG8_LDB(B1, 0, 1); PG8_SCHED; PG8_LDA(At, 0, 0); PG8_STAGEA(PG8_SA(1, 1), a1, 1, false);
            PG8_WAIT_V(8); PG8_WAIT_L(0); PG8_BAR; PG8_MMA(0, 0, At, B0); PG8_MMA(0, 1, At, B1); PG8_BAR; PG8_SCHED;
            PG8_LDA(At, 0, 1); PG8_STAGEB(PG8_SB(0, 0), b2); PG8_STAGEB(PG8_SB(0, 1), b2 + hstepB); PG8_STAGEA(PG8_SA(0, 0), a2, 0, last);
            PG8_WAIT_V(8); PG8_WAIT_L(0); PG8_BAR; PG8_MMA(1, 0, At, B0); PG8_MMA(1, 1, At, B1); PG8_BAR; PG8_SCHED;
            PG8_LDB(B0, 1, 0); PG8_LDB(B1, 1, 1); PG8_SCHED; PG8_LDA(At, 1, 0); PG8_STAGEA(PG8_SA(0, 1), a2, 1, last);
            PG8_WAIT_V(8); PG8_WAIT_L(0); PG8_BAR; PG8_MMA(0, 0, At, B0); PG8_MMA(0, 1, At, B1); PG8_BAR; PG8_SCHED;
            PG8_LDA(At, 1, 1); PG8_STAGEB(PG8_SB(1, 0), b3); PG8_STAGEB(PG8_SB(1, 1), b3 + hstepB); PG8_STAGEA(PG8_SA(1, 0), a3, 0, last);
            PG8_WAIT_V(8); PG8_WAIT_L(0); PG8_BAR; PG8_MMA(1, 0, At, B0); PG8_MMA(1, 1, At, B1); PG8_BAR; PG8_SCHED;
            if constexpr (Epi::HAS_MID) { if (t == (nt >> 1) - 2) { int fr3 = fr, fq3 = fq; asm volatile("" : "+v"(fr3), "+v"(fq3)); E.mid(acc, cur, wr, wc, fr3, fq3); } }
        }
        if constexpr (ALIGN_EPI) { if (wr == 0) PG8_BAR; }
        { int fr2 = fr, fq2 = fq; asm volatile("" : "+v"(fr2), "+v"(fq2));
          E(acc, cur, wr, wc, fr2, fq2); }
        if (!has_next) break;
#pragma unroll
        for (int a = 0; a < 2; ++a)
#pragma unroll
            for (int b = 0; b < 2; ++b)
#pragma unroll
                for (int m = 0; m < 4; ++m)
#pragma unroll
                    for (int n = 0; n < 2; ++n) acc[a][b][m][n] = (f32x4){0.f, 0.f, 0.f, 0.f};
        cur = nxt; cA = nA; cB = nB; ++ui;
        if constexpr (GATHER) { gvc[0][0] = gvn[0][0]; gvc[0][1] = gvn[0][1]; gvc[1][0] = gvn[1][0]; gvc[1][1] = gvn[1][1]; }
        if constexpr (ALIGN_EPI) { if (wr == 1) PG8_BAR; }
    }
    PG8_WAIT_V(0);
    if constexpr (!ALIGN_EPI) { if (wr == 0) PG8_BAR; }
    PG8_BAR;
#undef PG8_SA
#undef PG8_SB
#undef PG8_STAGE2
#undef PG8_STAGEA
#undef PG8_STAGEB
#undef PG8_LDA
#undef PG8_LDB
#undef PG8_MMA
#undef PG8_CAT
#undef PG8_WAIT_V
#undef PG8_WAIT_L
#undef PG8_BAR
#undef PG8_SCHED
#undef PG8_GATHER_OFFS
}

#define EPI_ROW(u, ai, m) ((u).orow + (ai) * HALF + wr * 64 + (m) * 16 + fr)
#define EPI_COL(u, bj) ((u).ocol + (bj) * HALF + wc * 32 + 8 * fq)
struct EpiBf16 {
    static constexpr bool HAS_MID = false;
    bf16_t* O; int ldc; const float* rs; size_t stride; float sc0, sc3;
    unsigned* kn;
    const LAS float* rst;
    float mul;
    __device__ __forceinline__ void operator()(const f32x4 (&acc)[2][2][4][2], const Unit& u, int wr, int wc, int fr, int fq) const {
        bf16_t* base = O + (size_t)u.aux * stride;
        const float sc = ((u.aux == 0) ? sc0 : ((u.aux == 3) ? sc3 : 1.f)) * mul;
        float nmax[2] = {0.f, 0.f}; const bool dokn = kn && u.aux == 1;
#pragma unroll
        for (int ai = 0; ai < 2; ++ai)
#pragma unroll
            for (int m = 0; m < 4; ++m) { const int row = EPI_ROW(u, ai, m); const float s = (rst ? rst[u.seq * 256 + ai * HALF + wr * 64 + m * 16 + fr] : (rs ? rs[row] : 1.f)) * sc;
#pragma unroll
                for (int bj = 0; bj < 2; ++bj) { const f32x4 v0 = acc[ai][bj][m][0] * s, v1 = acc[ai][bj][m][1] * s;
                    { u32x4 w; w.x = cvt_pk_bf16(v0[0], v0[1]); w.y = cvt_pk_bf16(v0[2], v0[3]); w.z = cvt_pk_bf16(v1[0], v1[1]); w.w = cvt_pk_bf16(v1[2], v1[3]);
                    __builtin_nontemporal_store(w, (u32x4*)(base + (size_t)row * ldc + EPI_COL(u, bj))); }
                    if (dokn) { float q = (v0[0] * v0[0] + v0[1] * v0[1]) + (v0[2] * v0[2] + v0[3] * v0[3]) + (v1[0] * v1[0] + v1[1] * v1[1]) + (v1[2] * v1[2] + v1[3] * v1[3]);
                        q += __shfl_xor(q, 16); q += __shfl_xor(q, 32); nmax[bj] = fmaxf(nmax[bj], q); } } }
        if (dokn) {
#pragma unroll
            for (int bj = 0; bj < 2; ++bj) { float q = nmax[bj]; q = fmaxf(q, __shfl_xor(q, 1)); q = fmaxf(q, __shfl_xor(q, 2)); q = fmaxf(q, __shfl_xor(q, 4)); q = fmaxf(q, __shfl_xor(q, 8));
                const int head = ((u.ocol + bj * HALF) >> 6) + (wc >> 1), bt = u.orow / SEQ;
                if ((fr | fq) == 0) atomicMax(kn + ((bt * NH + head) * 2 + (wc & 1)), __float_as_uint(q)); }
        }
    }
};
struct EpiY8 {
    static constexpr bool HAS_MID = false;
    unsigned char* Y; float mul;
    __device__ __forceinline__ void operator()(const f32x4 (&acc)[2][2][4][2], const Unit& u, int wr, int wc, int fr, int fq) const {
#pragma unroll
        for (int ai = 0; ai < 2; ++ai)
#pragma unroll
            for (int m = 0; m < 4; m += 2) { const int row = EPI_ROW(u, ai, m) + 16 * (fq & 1);
#pragma unroll
                for (int bj = 0; bj < 2; ++bj) { u32x2 w8[2];
#pragma unroll
                    for (int mm = 0; mm < 2; ++mm) { const f32x4 v0 = acc[ai][bj][m + mm][0] * mul, v1 = acc[ai][bj][m + mm][1] * mul; w8[mm].x = cvt4_fp8(v0[0], v0[1], v0[2], v0[3]); w8[mm].y = cvt4_fp8(v1[0], v1[1], v1[2], v1[3]); }
                    *(u32x4*)(Y + (size_t)row * DM + (u.ocol + bj * HALF + wc * 32 + 8 * (fq & ~1))) = widen16(w8[0], w8[1]); } }
    }
};
struct EpiOutProj {
    static constexpr bool HAS_MID = true;
    const bf16_t* xb; bf16_t* hb; unsigned char* h8; float* ssq; const LAS f32x2* rab;
    __device__ __forceinline__ void mid(f32x4 (&acc)[2][2][4][2], const Unit& u, int wr, int wc, int fr, int fq) const {
#pragma unroll
        for (int ai = 0; ai < 2; ++ai)
#pragma unroll
            for (int m = 0; m < 4; ++m) { const float f = rab[u.seq * 256 + ai * HALF + wr * 64 + m * 16 + fr].x;
#pragma unroll
                for (int bj = 0; bj < 2; ++bj) { acc[ai][bj][m][0] *= f; acc[ai][bj][m][1] *= f; } }
    }
    __device__ __forceinline__ void operator()(const f32x4 (&acc)[2][2][4][2], const Unit& u, int wr, int wc, int fr, int fq) const {
#pragma unroll
        for (int ai = 0; ai < 2; ++ai)
#pragma unroll
            for (int m2 = 0; m2 < 4; m2 += 2) { u32x2 w8[2][2];
#pragma unroll
              for (int mm = 0; mm < 2; ++mm) { const int m = m2 + mm; const int row = EPI_ROW(u, ai, m); const float rb = rab[u.seq * 256 + ai * HALF + wr * 64 + m * 16 + fr].y; float q = 0.f;
#pragma unroll
                for (int bj = 0; bj < 2; ++bj) { const size_t off = (size_t)row * DM + EPI_COL(u, bj);
                    const u32x4 xr = __builtin_nontemporal_load((const u32x4*)(xb + off));
                    f32x4 v0 = acc[ai][bj][m][0] * rb, v1 = acc[ai][bj][m][1] * rb;
                    v0[0] += bf16lo(xr.x); v0[1] += bf16hi(xr.x); v0[2] += bf16lo(xr.y); v0[3] += bf16hi(xr.y); v1[0] += bf16lo(xr.z); v1[1] += bf16hi(xr.z); v1[2] += bf16lo(xr.w); v1[3] += bf16hi(xr.w);
                    q += (v0[0] * v0[0] + v0[1] * v0[1]) + (v0[2] * v0[2] + v0[3] * v0[3]) + (v1[0] * v1[0] + v1[1] * v1[1]) + (v1[2] * v1[2] + v1[3] * v1[3]);
                    u32x4 w; w.x = cvt_pk_bf16(v0[0], v0[1]); w.y = cvt_pk_bf16(v0[2], v0[3]); w.z = cvt_pk_bf16(v1[0], v1[1]); w.w = cvt_pk_bf16(v1[2], v1[3]); *(u32x4*)(hb + off) = w;
                    w8[mm][bj].x = cvt4_fp8(v0[0], v0[1], v0[2], v0[3]); w8[mm][bj].y = cvt4_fp8(v1[0], v1[1], v1[2], v1[3]); }
                q += __shfl_xor(q, 16); q += __shfl_xor(q, 32); if (fq == 0) ssq[(size_t)row * 16 + (u.ocol >> 8) * 4 + wc] = q; }
              const int rowp = EPI_ROW(u, ai, m2) + 16 * (fq & 1);
#pragma unroll
              for (int bj = 0; bj < 2; ++bj) *(u32x4*)(h8 + (size_t)rowp * DM + (u.ocol + bj * HALF + wc * 32 + 8 * (fq & ~1))) = widen16(w8[0][bj], w8[1][bj]); }
    }
};
struct EpiResidBf16 {
    static constexpr bool HAS_MID = false;
    bf16_t* hb; unsigned char* h8; float mul;
    __device__ __forceinline__ void operator()(const f32x4 (&acc)[2][2][4][2], const Unit& u, int wr, int wc, int fr, int fq) const {
#pragma unroll
        for (int ai = 0; ai < 2; ++ai) {
        u32x4 xres[4][2];
#pragma unroll
            for (int m = 0; m < 4; ++m)
#pragma unroll
                for (int bj = 0; bj < 2; ++bj) xres[m][bj] = *(const u32x4*)(hb + (size_t)EPI_ROW(u, ai, m) * DM + EPI_COL(u, bj));
        asm volatile("" ::: "memory");
#pragma unroll
            for (int m2 = 0; m2 < 4; m2 += 2) { u32x2 w8[2][2];
#pragma unroll
              for (int mm = 0; mm < 2; ++mm) { const int m = m2 + mm; const int row = EPI_ROW(u, ai, m);
#pragma unroll
                for (int bj = 0; bj < 2; ++bj) { const size_t off = (size_t)row * DM + EPI_COL(u, bj);
                    const u32x4 xr = xres[m][bj];
                    f32x4 v0 = acc[ai][bj][m][0] * mul, v1 = acc[ai][bj][m][1] * mul;
                    v0[0] += bf16lo(xr.x); v0[1] += bf16hi(xr.x); v0[2] += bf16lo(xr.y); v0[3] += bf16hi(xr.y); v1[0] += bf16lo(xr.z); v1[1] += bf16hi(xr.z); v1[2] += bf16lo(xr.w); v1[3] += bf16hi(xr.w);
                    u32x4 w; w.x = cvt_pk_bf16(v0[0], v0[1]); w.y = cvt_pk_bf16(v0[2], v0[3]); w.z = cvt_pk_bf16(v1[0], v1[1]); w.w = cvt_pk_bf16(v1[2], v1[3]); *(u32x4*)(hb + off) = w;
                    w8[mm][bj].x = cvt4_fp8(v0[0], v0[1], v0[2], v0[3]); w8[mm][bj].y = cvt4_fp8(v1[0], v1[1], v1[2], v1[3]); } }
              if (h8) { const int rowp = EPI_ROW(u, ai, m2) + 16 * (fq & 1);
#pragma unroll
                  for (int bj = 0; bj < 2; ++bj) *(u32x4*)(h8 + (size_t)rowp * DM + (u.ocol + bj * HALF + wc * 32 + 8 * (fq & ~1))) = widen16(w8[0][bj], w8[1][bj]); } }
        asm volatile("" ::: "memory"); }
    }
};
struct EpiSoftmax {
    static constexpr bool HAS_MID = false;
    bf16_t* P; const LAS float* r1t; LAS float* red;
    __device__ __forceinline__ void operator()(f32x4 (&acc)[2][2][4][2], const Unit& u, int wr, int wc, int fr, int fq) const {
#pragma unroll
        for (int ai = 0; ai < 2; ++ai)
#pragma unroll
            for (int m = 0; m < 4; ++m) { const float r1 = r1t[u.seq * 256 + ai * HALF + wr * 64 + m * 16 + fr]; float a = -3.0e38f;
#pragma unroll
                for (int bj = 0; bj < 2; ++bj)
#pragma unroll
                    for (int n = 0; n < 2; ++n) { f32x4 v = acc[ai][bj][m][n] * r1; acc[ai][bj][m][n] = v; a = fmaxf(a, fmaxf(fmaxf(v[0], v[1]), fmaxf(v[2], v[3]))); }
                a = fmaxf(a, __shfl_xor(a, 16)); a = fmaxf(a, __shfl_xor(a, 32));
                if (fq == 0) red[(ai * HALF + wr * 64 + m * 16 + fr) * 4 + wc] = a; asm volatile("" ::: "memory"); }
        LDS_WAIT(); __builtin_amdgcn_s_barrier(); asm volatile("" ::: "memory");
#pragma unroll
        for (int ai = 0; ai < 2; ++ai)
#pragma unroll
            for (int m = 0; m < 4; ++m) { const int rl = ai * HALF + wr * 64 + m * 16 + fr; const f32x4 mm = *(const LAS f32x4*)(red + rl * 4);
                const float a = fmaxf(fmaxf(mm[0], mm[1]), fmaxf(mm[2], mm[3])); float s = 0.f;
#pragma unroll
                for (int bj = 0; bj < 2; ++bj)
#pragma unroll
                    for (int n = 0; n < 2; ++n) { f32x4 v = acc[ai][bj][m][n];
                        v[0] = __builtin_amdgcn_exp2f(v[0] - a); v[1] = __builtin_amdgcn_exp2f(v[1] - a); v[2] = __builtin_amdgcn_exp2f(v[2] - a); v[3] = __builtin_amdgcn_exp2f(v[3] - a);
                        acc[ai][bj][m][n] = v; s += (v[0] + v[1]) + (v[2] + v[3]); }
                s += __shfl_xor(s, 16); s += __shfl_xor(s, 32);
                if (fq == 0) red[1024 + rl * 4 + wc] = s; }
        LDS_WAIT(); __builtin_amdgcn_s_barrier(); asm volatile("" ::: "memory");
#pragma unroll
        for (int ai = 0; ai < 2; ++ai)
#pragma unroll
            for (int m = 0; m < 4; m += 2) { u32x2 w8[2][2];
#pragma unroll
                for (int mm = 0; mm < 2; ++mm) { const int rl = ai * HALF + wr * 64 + (m + mm) * 16 + fr; const f32x4 ss = *(const LAS f32x4*)(red + 1024 + rl * 4);
                    const float inv = P_SCALE / ((ss[0] + ss[1]) + (ss[2] + ss[3]));
#pragma unroll
                    for (int bj = 0; bj < 2; ++bj) { const f32x4 v0 = acc[ai][bj][m + mm][0] * inv, v1 = acc[ai][bj][m + mm][1] * inv;
                        w8[mm][bj].x = cvt4_fp8(v0[0], v0[1], v0[2], v0[3]); w8[mm][bj].y = cvt4_fp8(v1[0], v1[1], v1[2], v1[3]); } }
                const int row = EPI_ROW(u, ai, m) + 16 * (fq & 1);
#pragma unroll
                for (int bj = 0; bj < 2; ++bj) *(u32x4*)((unsigned char*)P + (size_t)row * DM + (u.ocol + bj * HALF + wc * 32 + 8 * (fq & ~1))) = widen16(w8[0][bj], w8[1][bj]); }
    }
};
struct EpiSwiglu {
    static constexpr bool HAS_MID = false;
    bf16_t* Hd; const float* r2s; const int* listbase;
    __device__ __forceinline__ void operator()(const f32x4 (&acc)[2][2][4][2], const Unit& u, int wr, int wc, int fr, int fq) const {
#pragma unroll
        for (int ai = 0; ai < 2; ++ai)
#pragma unroll
            for (int m = 0; m < 4; m += 2) { u32x2 w8[2];
#pragma unroll
                for (int mm = 0; mm < 2; ++mm) { const int rl = ai * HALF + wr * 64 + (m + mm) * 16 + fr; const float rs = r2s[(u.rows - listbase) + (rl < u.nvalid ? rl : 0)] * (1.0f / WGU_SCALE); float h[8];
#pragma unroll
                    for (int n = 0; n < 2; ++n)
#pragma unroll
                        for (int e = 0; e < 4; ++e) { const float gt = acc[ai][0][m + mm][n][e] * rs, up = acc[ai][1][m + mm][n][e] * rs;
                            h[n * 4 + e] = gt * __builtin_amdgcn_rcpf(1.0f + __builtin_amdgcn_exp2f(-gt * LOG2E)) * up; }
                    w8[mm].x = cvt4_fp8(h[0], h[1], h[2], h[3]); w8[mm].y = cvt4_fp8(h[4], h[5], h[6], h[7]); }
                const int row = EPI_ROW(u, ai, m) + 16 * (fq & 1);
                *(u32x4*)((unsigned char*)Hd + (size_t)row * DFF + u.ocol + wc * 32 + 8 * (fq & ~1)) = widen16(w8[0], w8[1]); }
    }
};
}

namespace att {
constexpr int QB = 256, KVBLK = 64, PITCH = HW, OPITCH = DM;
constexpr int SLOTB = 8192, LDS_K = 0, LDS_V = 2 * SLOTB, LDS_WS = 4 * SLOTB, LDS_OST = LDS_WS + NWAVES * 256, LDS_FLAG = LDS_OST + NWAVES * 4096, LDS_END = LDS_FLAG + 64;
static_assert(LDS_END <= RING_BYTES, "attention LDS");
__device__ __forceinline__ int crow(int r, int hi) { return (r & 3) + 8 * (r >> 2) + 4 * hi; }
__device__ __forceinline__ void glds16(const void* gsrc, unsigned lds_dst) { unsigned keep;
    asm volatile("s_mov_b32 %0, m0\n\ts_mov_b32 m0, %2\n\ts_nop 0\n\tglobal_load_lds_dwordx4 %1, off\n\ts_mov_b32 m0, %0" : "=&s"(keep) : "v"(gsrc), "s"(lds_dst) : "memory"); }
__device__ __forceinline__ void glds16s(const void* sbase, unsigned voff, unsigned lds_dst) { unsigned keep;
    asm volatile("s_mov_b32 %0, m0\n\ts_mov_b32 m0, %3\n\ts_nop 0\n\tglobal_load_lds_dwordx4 %1, %2\n\ts_mov_b32 m0, %0" : "=&s"(keep) : "v"(voff), "s"(sbase), "s"(lds_dst) : "memory"); }
#define ATT_WAIT_BAR0() asm volatile("s_waitcnt vmcnt(0) lgkmcnt(0)\n\ts_barrier" ::: "memory")
#define MFMA32(a, b, c) __builtin_amdgcn_mfma_f32_32x32x16_bf16(a, b, c, 0, 0, 0)
__device__ __forceinline__ void store_row_ssq(u32x4 v, float* dst, int ch) {
    float q = (bf16lo(v.x) * bf16lo(v.x) + bf16hi(v.x) * bf16hi(v.x)) + (bf16lo(v.y) * bf16lo(v.y) + bf16hi(v.y) * bf16hi(v.y)) + (bf16lo(v.z) * bf16lo(v.z) + bf16hi(v.z) * bf16hi(v.z)) + (bf16lo(v.w) * bf16lo(v.w) + bf16hi(v.w) * bf16hi(v.w));
    q += __shfl_xor(q, 1); q += __shfl_xor(q, 2); q += __shfl_xor(q, 4);
    if (ch == 0) *dst = q;
}
__device__ __forceinline__ void qkt(f32x16& p0, f32x16& p1, const LAS char* Kslot, const bf16x8* qr, const f32x16& cin, int r32, int hi) {
    const LAS char* kb = Kslot + hi * 1024 + r32 * 16;
#pragma unroll
    for (int d0 = 0; d0 < 4; ++d0) {
        const bf16x8 b0 = *(const LAS bf16x8*)(kb + d0 * 2048);
        const bf16x8 b1 = *(const LAS bf16x8*)(kb + d0 * 2048 + 512);
        if (d0 == 0) { p0 = MFMA32(b0, qr[0], cin); p1 = MFMA32(b1, qr[0], cin); }
        else { p0 = MFMA32(b0, qr[d0], p0); p1 = MFMA32(b1, qr[d0], p1); } }
}
__device__ __forceinline__ void pv(f32x16* o, int vb, bf16x8 pa0, bf16x8 pa1, bf16x8 pa2, bf16x8 pa3) {
#pragma unroll
    for (int d0 = 0; d0 < 2; ++d0) { s16x4 lo[4], hi[4];
#pragma unroll
        for (int ks = 0; ks < 4; ++ks) {
            asm volatile("ds_read_b64_tr_b16 %0,%1 offset:%c2" : "=&v"(lo[ks]) : "v"(vb), "i"(d0 * 4096 + ks * 1024) : "memory");
            asm volatile("ds_read_b64_tr_b16 %0,%1 offset:%c2" : "=&v"(hi[ks]) : "v"(vb), "i"(d0 * 4096 + ks * 1024 + 512) : "memory"); }
        asm volatile("s_waitcnt lgkmcnt(0)" ::: "memory"); __builtin_amdgcn_sched_barrier(0);
#define PK(k) (bf16x8){lo[k][0], lo[k][1], lo[k][2], lo[k][3], hi[k][0], hi[k][1], hi[k][2], hi[k][3]}
        o[d0] = MFMA32(pa0, PK(0), o[d0]); o[d0] = MFMA32(pa1, PK(1), o[d0]); o[d0] = MFMA32(pa2, PK(2), o[d0]); o[d0] = MFMA32(pa3, PK(3), o[d0]);
#undef PK
    }
}
__device__ __forceinline__ float swap_lo(float x) { auto rr = __builtin_amdgcn_permlane32_swap(__float_as_uint(x), __float_as_uint(x), false, false); return __uint_as_float(rr[0]); }
__device__ __forceinline__ float swap_hi(float x) { auto rr = __builtin_amdgcn_permlane32_swap(__float_as_uint(x), __float_as_uint(x), false, false); return __uint_as_float(rr[1]); }

}


namespace fox {
constexpr int QB = 256, KVBLK = 64, PITCH = HW, OPITCH = DM;
constexpr int NSLOT = 3, SLOTB = 9216;
constexpr int LDS_K = 0, LDS_V = NSLOT * SLOTB, LDS_WS = 2 * NSLOT * SLOTB, LDS_OST = LDS_WS + NWAVES * 256, LDS_CL = LDS_OST + NWAVES * 4096, LDS_VOTE = LDS_CL + 512, LDS_END = LDS_VOTE + 32;
static_assert(LDS_END <= RING_BYTES, "fox LDS");
constexpr float WIN_T = 48.0f;
constexpr float FLOOR = -256.0f;
using att::crow; using att::glds16; using att::glds16s;
typedef __attribute__((address_space(3))) const char* lds_cptr;
typedef short v4i16_t __attribute__((ext_vector_type(4)));
#define SBAR() __builtin_amdgcn_sched_barrier(0)
#define WAIT_BAR(N) asm volatile("s_waitcnt vmcnt(" #N ") lgkmcnt(0)\n\ts_barrier" ::: "memory")
__device__ __forceinline__ s16x4 vtr(lds_cptr p) { return __builtin_bit_cast(s16x4, __builtin_amdgcn_ds_read_tr16_b64_v4i16((__attribute__((address_space(3))) v4i16_t*)p)); }
__device__ __forceinline__ void kload2(bf16x8* kf, lds_cptr kp, int j) { kf[2 * j] = *(const LAS bf16x8*)(kp + j * 2048); kf[2 * j + 1] = *(const LAS bf16x8*)(kp + j * 2048 + 512); }
__device__ __forceinline__ void cmask(f32x16& p0, f32x16& p1, int jb, int qrel, int hi) {
    const float NEG = -INFINITY; const int kb = 64 * jb + 4 * hi;
#pragma unroll
    for (int r = 0; r < 16; ++r) { const int kv = kb + (r & 3) + 8 * (r >> 2); if (kv > qrel) p0[r] = NEG; if (kv + 32 > qrel) p1[r] = NEG; }
}
__device__ __forceinline__ void split3(float x, unsigned& hm, unsigned& lo) {
    const unsigned h = cvt_pk_bf16(x, 0.f) & 0xffffu; const float r1 = x - __uint_as_float(h << 16);
    const unsigned m = cvt_pk_bf16(r1, 0.f) & 0xffffu; const float r2 = r1 - __uint_as_float(m << 16);
    hm = h | (m << 16); lo = cvt_pk_bf16(r2, 0.f) & 0xffffu;
}
__device__ __forceinline__ bf16x8 qx_build(float a, int hi) {
    unsigned hm, lo; split3(a, hm, lo);
    u32x4 w; w.x = hm; w.y = lo | 0x3F800000u; w.z = 0x3F803F80u; w.w = 0u;
    if (hi) { w.x = 0u; w.y = 0u; w.z = 0u; }
    return __builtin_bit_cast(bf16x8, w);
}

template <int THRL> __device__ __forceinline__ void fox_unit(int bh, int qb, const bf16_t* Q, const bf16_t* K, const bf16_t* V, bf16_t* O, float* hs, const float* cb, const bf16_t* KXall, float kmax, LAS char* shm, bool pre, int nbh, int nqb) {
    const bf16_t* KXh = KXall + (size_t)bh * SEQ * 8;
    int tid = threadIdx.x; asm volatile("" : "+v"(tid)); const int lane = tid & 63, r32 = lane & 31, hi = lane >> 5; const int wid = __builtin_amdgcn_readfirstlane(tid >> 6);
    const int b = bh >> 3, h = bh & 7; const long rowbase = (long)b * SEQ; const int q0 = qb * QB;
    const bf16_t* Qw = Q + (rowbase + q0 + wid * 32) * PITCH + h * HD;
    const bf16_t* Kh = K + rowbase * PITCH + h * HD; const bf16_t* Vh = V + rowbase * PITCH + h * HD;
    const unsigned lds0 = (unsigned)(uintptr_t)shm;
    LAS float* wsf = (LAS float*)(shm + LDS_WS) + wid * 64;
    const int NT = (q0 + QB) / KVBLK;
    int NTe = NT;
    LAS float* clt = (LAS float*)(shm + LDS_CL); LAS unsigned* votes = (LAS unsigned*)(shm + LDS_VOTE);
    const float clv = (tid < NT) ? cb[64 * tid + 63] : 0.f;
    const unsigned koff = (unsigned)(lane * PITCH + wid * 8) * 2u, voff = (unsigned)((16 * (wid & 3) + (lane >> 2)) * PITCH + (wid >> 2) * 32 + (lane & 3) * 8) * 2u, xoff = (unsigned)lane * 16u;
    const unsigned kdst = lds0 + LDS_K + wid * 1024, vdst = lds0 + LDS_V + wid * 1024, xdst = lds0 + LDS_K + 8192;
    const bool xl = (lane >> 3) == wid;
#define DMA_KX(Kb, KXb, NTv, p, slot) do { glds16s((Kb) + (long)((NTv) - 1 - (p)) * KVBLK * PITCH, koff, (unsigned)__builtin_amdgcn_readfirstlane(kdst + (slot))); \
        if (xl) glds16s((KXb) + (long)((NTv) - 1 - (p)) * KVBLK * 8, xoff, (unsigned)__builtin_amdgcn_readfirstlane(xdst + (slot))); } while (0)
#define DMA_VX(Vb, NTv, p, slot) glds16s((Vb) + (long)((NTv) - 1 - (p)) * KVBLK * PITCH, voff, (unsigned)__builtin_amdgcn_readfirstlane(vdst + (slot)))
#define DMA_K(p, slot) DMA_KX(Kh, KXh, NT, p, slot)
#define DMA_V(p, slot) DMA_VX(Vh, NT, p, slot)
    bf16x8 kf[10];
    const lds_cptr shm3 = (lds_cptr)shm; const lds_cptr kp0 = shm3 + LDS_K + hi * 1024 + r32 * 16; const lds_cptr kx0 = shm3 + LDS_K + 8192 + r32 * 16;
    const lds_cptr vp0 = shm3 + LDS_V + ((lane >> 4) & 1) * 32 + (lane & 3) * 8 + (4 * hi + ((lane & 15) >> 2)) * 64;
    if (!pre) { DMA_K(0, 0); DMA_V(0, 0); DMA_K(1, SLOTB); }
    bf16x8 qr[4];
#pragma unroll
    for (int d0 = 0; d0 < 4; ++d0) qr[d0] = *(const bf16x8*)(Qw + (long)r32 * PITCH + d0 * 16 + hi * 8);
    const int qrel = wid * 32 + r32;
    const float ct = cb[q0 + qrel];
    float mhat = 0.f, l_reg = 0.f; f32x16 o[2]; o[0] = f32x16{}; o[1] = f32x16{};
    bf16x8 qx = qx_build(ct, hi);
    const f32x16 z16 = f32x16{};
#define CMASK(P0, P1, p) do { const int jb_ = 3 - (p); if (jb_ >= 0) cmask(P0, P1, jb_, qrel, hi); } while (0)
    bool resc = false;
#define RESC() do { if (resc) { asm volatile("s_waitcnt lgkmcnt(0)" ::: "memory"); \
      _Pragma("unroll") for (int d_ = 0; d_ < 2; ++d_) _Pragma("unroll") for (int r = 0; r < 16; ++r) o[d_][r] *= wsf[crow(r, hi)]; } } while (0)
    f32x16 pA0, pA1, pB0, pB1;
    int sl_prev = 0, sl_cur = 0, sl_next = SLOTB;
#define ROT() do { sl_prev = sl_cur; sl_cur = sl_next; sl_next = (sl_next == (NSLOT - 1) * SLOTB) ? 0 : sl_next + SLOTB; } while (0)
    if (!pre) { DMA_K(2, 2 * SLOTB); }
    if (pre) { WAIT_BAR(0); } else WAIT_BAR(5);
    if (tid < NT) clt[tid] = clv;
    float qkb;
    { float q2 = 0.f;
#pragma unroll
      for (int d0 = 0; d0 < 4; ++d0)
#pragma unroll
          for (int j = 0; j < 8; ++j) { const float e = __uint_as_float(((unsigned)(unsigned short)qr[d0][j]) << 16); q2 += e * e; }
      q2 = att::swap_lo(q2) + att::swap_hi(q2); qkb = sqrtf(q2) * kmax + ct + WIN_T; }
    { const LAS char* kb = (const LAS char*)shm + LDS_K + hi * 1024 + r32 * 16; const LAS char* kxb = (const LAS char*)shm + LDS_K + 8192 + r32 * 16;
      pA0 = MFMA32(*(const LAS bf16x8*)(kxb), qx, z16); pA1 = MFMA32(*(const LAS bf16x8*)(kxb + 512), qx, z16);
#pragma unroll
      for (int d0 = 0; d0 < 4; ++d0) { pA0 = MFMA32(*(const LAS bf16x8*)(kb + d0 * 2048), qr[d0], pA0); pA1 = MFMA32(*(const LAS bf16x8*)(kb + d0 * 2048 + 512), qr[d0], pA1); } }
    asm volatile("s_nop 15\n\ts_nop 7" : "+v"(pA0), "+v"(pA1)); CMASK(pA0, pA1, 0);
    { float a = fmaxf(pA0[0], pA1[0]);
#pragma unroll
      for (int r = 1; r < 16; ++r) a = fmaxf(a, fmaxf(pA0[r], pA1[r]));
      a = fmaxf(att::swap_lo(a), att::swap_hi(a));
      const float dl = fmaxf(a, FLOOR); mhat = dl;
#pragma unroll
      for (int r = 0; r < 16; ++r) { pA0[r] = __builtin_amdgcn_exp2f(pA0[r] - dl); pA1[r] = __builtin_amdgcn_exp2f(pA1[r] - dl); }
      qx = qx_build(ct - mhat, hi); asm volatile("" : "+v"(qx)); }
    WAIT_BAR(0);
    DMA_K(3, 0); DMA_V(1, SLOTB);
    ROT();
    kload2(kf, kp0 + sl_cur, 0); kload2(kf, kp0 + sl_cur, 1); kload2(kf, kp0 + sl_cur, 2); kload2(kf, kp0 + sl_cur, 3);
    kf[8] = *(const LAS bf16x8*)(kx0 + sl_cur); kf[9] = *(const LAS bf16x8*)(kx0 + sl_cur + 512);
    WAIT_BAR(3);
    s16x4 vlo[8], vhi[8]; u32x4 pw0, pw1, pw2, pw3;
#define PKW(P, B) cvt_pk_bf16(P[B], P[B + 1])
#define PAF(k) __builtin_bit_cast(bf16x8, pw##k)
#define VFR(i) (bf16x8){vlo[i][0], vlo[i][1], vlo[i][2], vlo[i][3], vhi[i][0], vhi[i][1], vhi[i][2], vhi[i][3]}
#define PIN(x) asm volatile("" : "+v"(x))
#define MX3(a, b, c) __builtin_fmaxf(__builtin_fmaxf((a), (b)), (c))
#define GAPA(MF, A0, A1, A2, A3, W0, W1, PW) do { MF; sacc += A0; sacc += A1; sacc += A2; sacc += A3; PIN(sacc); W0; W1; PIN(PW); SBAR(); } while (0)
#define EX(v) __builtin_amdgcn_exp2f(v)
#define GAPB(MF, X, B) do { MF; X[B] = EX(X[B]); X[B + 1] = EX(X[B + 1]); X[B + 2] = EX(X[B + 2]); X[B + 3] = EX(X[B + 3]); PIN(X); SBAR(); } while (0)
#define VRD(i) do { vlo[i] = vtr(vp_ + (((i) >> 2) * 4096 + ((i) & 3) * 1024)); vhi[i] = vtr(vp_ + (((i) >> 2) * 4096 + ((i) & 3) * 1024 + 512)); } while (0)
#define KRD(G, j) do { if (G) { kload2(kf, kp0 + sl_next, j); SBAR(); } } while (0)
#define KRDX(G) do { if (G) { kf[8] = *(const LAS bf16x8*)(kx0 + sl_next); kf[9] = *(const LAS bf16x8*)(kx0 + sl_next + 512); SBAR(); } } while (0)
#define STEP(C0, C1, P0, P1, t, GK, GV, GL) do { SBAR(); \
    const lds_cptr vp_ = vp0 + sl_prev; \
    C0 = MFMA32(kf[8], qx, z16); C1 = MFMA32(kf[9], qx, z16); SBAR(); \
    VRD(0); SBAR(); float sacc = (P0[0] + P0[1]); \
    GAPA(C0 = MFMA32(kf[0], qr[0], C0), P0[2], P0[3], P0[4], P0[5],     pw0[0] = PKW(P0, 0), pw0[1] = PKW(P0, 2), pw0); \
    VRD(4); SBAR(); GAPA(C1 = MFMA32(kf[1], qr[0], C1), P0[6], P0[7], P0[8], P0[9],     pw0[2] = PKW(P0, 4), pw0[3] = PKW(P0, 6), pw0); \
    VRD(1); SBAR(); GAPA(C0 = MFMA32(kf[2], qr[1], C0),   P0[10], P0[11], P0[12], P0[13], pw1[0] = PKW(P0, 8), pw1[1] = PKW(P0, 10), pw1); \
    VRD(5); SBAR(); GAPA(C1 = MFMA32(kf[3], qr[1], C1),   P0[14], P0[15], P1[0], P1[1],   pw1[2] = PKW(P0, 12), pw1[3] = PKW(P0, 14), pw1); \
    VRD(2); SBAR(); GAPA(C0 = MFMA32(kf[4], qr[2], C0),   P1[2], P1[3], P1[4], P1[5],     pw2[0] = PKW(P1, 0), pw2[1] = PKW(P1, 2), pw2); \
    VRD(6); SBAR(); GAPA(C1 = MFMA32(kf[5], qr[2], C1),   P1[6], P1[7], P1[8], P1[9],     pw2[2] = PKW(P1, 4), pw2[3] = PKW(P1, 6), pw2); \
    VRD(3); SBAR(); GAPA(C0 = MFMA32(kf[6], qr[3], C0),   P1[10], P1[11], P1[12], P1[13], pw3[0] = PKW(P1, 8), pw3[1] = PKW(P1, 10), pw3); \
    VRD(7); SBAR(); GAPA(C1 = MFMA32(kf[7], qr[3], C1),   P1[14], P1[15], 0.f, 0.f,       pw3[2] = PKW(P1, 12), pw3[3] = PKW(P1, 14), pw3); \
    l_reg += sacc; \
    if (GK) { DMA_K((t) + 3, sl_cur); } if (GV) { DMA_V((t) + 1, sl_next); } \
    CMASK(C0, C1, t); \
    { float a = MX3(C0[0], C0[1], C1[0]), b_ = MX3(C0[2], C0[3], C1[1]); a = MX3(a, C1[2], C1[3]); \
      _Pragma("unroll") for (int r = 4; r < 16; r += 4) { a = MX3(a, C0[r], C0[r + 1]); b_ = MX3(b_, C0[r + 2], C0[r + 3]); a = MX3(a, C1[r], C1[r + 1]); b_ = MX3(b_, C1[r + 2], C1[r + 3]); } \
      float rm = __builtin_fmaxf(a, b_); { auto rr = __builtin_amdgcn_permlane32_swap(__float_as_uint(rm), __float_as_uint(rm), false, false); rm = __builtin_fmaxf(__uint_as_float(rr[0]), __uint_as_float(rr[1])); } \
      resc = false; \
      if (__builtin_expect(__any(rm > (float)THRL), 0)) { const float dl = __builtin_fmaxf(rm, 0.f); mhat += dl; \
        _Pragma("unroll") for (int r = 0; r < 16; ++r) { C0[r] -= dl; C1[r] -= dl; } \
        qx = qx_build(ct - mhat, hi); asm volatile("" : "+v"(qx)); \
        const float f = __builtin_amdgcn_exp2f(-dl); l_reg *= f; if (hi == 0) wsf[r32] = f; resc = true; } } \
    SBAR(); \
    GAPB(o[0] = MFMA32(PAF(0), VFR(0), o[0]), C0, 0); \
    KRDX(GL); GAPB(o[1] = MFMA32(PAF(0), VFR(4), o[1]), C0, 4); \
    KRD(GL, 0); GAPB(o[0] = MFMA32(PAF(1), VFR(1), o[0]), C0, 8); \
    KRD(GL, 1); GAPB(o[1] = MFMA32(PAF(1), VFR(5), o[1]), C0, 12); \
    KRD(GL, 2); GAPB(o[0] = MFMA32(PAF(2), VFR(2), o[0]), C1, 0); \
    KRD(GL, 3); GAPB(o[1] = MFMA32(PAF(2), VFR(6), o[1]), C1, 4); \
    GAPB(o[0] = MFMA32(PAF(3), VFR(3), o[0]), C1, 8); \
    GAPB(o[1] = MFMA32(PAF(3), VFR(7), o[1]), C1, 12); \
    } while (0)
#define ENDW(tt) do { if ((tt) + 3 < NTe) { WAIT_BAR(3); } else if ((tt) + 2 < NTe) { WAIT_BAR(1); } else { WAIT_BAR(0); } } while (0)
#define VOTE(u) do { const int ts_ = NT - (u) - 3; bool ok_ = false; if (ts_ >= 0) { ok_ = __all((qkb - mhat) < clt[ts_]); } if (lane == 0) votes[wid] = ok_ ? 1u : 0u; } while (0)
#define TALLY(u) do { const u32x4 va_ = *(const LAS u32x4*)votes, vb_ = *(const LAS u32x4*)(votes + 4); \
        if (__builtin_amdgcn_readfirstlane((va_.x & va_.y & va_.z & va_.w & vb_.x & vb_.y & vb_.z & vb_.w) != 0u)) { if ((u) + 2 < NTe) { NTe = (u) + 2; WAIT_BAR(0); } } } while (0)
    int t = 1;
    for (; t + 1 < NTe && t < 5; t += 2) {
        STEP(pB0, pB1, pA0, pA1, t, (t + 3 < NTe), (t + 1 < NTe), (t + 1 < NTe));       ENDW(t);     RESC(); ROT();
        STEP(pA0, pA1, pB0, pB1, t + 1, (t + 4 < NTe), (t + 2 < NTe), (t + 2 < NTe));   VOTE(t + 1); ENDW(t + 1); TALLY(t + 1); RESC(); ROT();
    }
#undef CMASK
#define CMASK(P0, P1, p) do {} while (0)
    for (; t + 5 < NTe; t += 2) {
        STEP(pB0, pB1, pA0, pA1, t, true, true, true);       WAIT_BAR(3); RESC(); ROT();
        STEP(pA0, pA1, pB0, pB1, t + 1, true, true, true);   VOTE(t + 1); WAIT_BAR(3); TALLY(t + 1); RESC(); ROT();
    }
    for (; t + 1 < NTe; t += 2) {
        STEP(pB0, pB1, pA0, pA1, t, (t + 3 < NTe), (t + 1 < NTe), (t + 1 < NTe));       ENDW(t);     RESC(); ROT();
        STEP(pA0, pA1, pB0, pB1, t + 1, (t + 4 < NTe), (t + 2 < NTe), (t + 2 < NTe));   ENDW(t + 1); RESC(); ROT();
    }
#undef CMASK
#define CMASK(P0, P1, p) do { const int jb_ = 3 - (p); if (jb_ >= 0) cmask(P0, P1, jb_, qrel, hi); } while (0)
    STEP(pB0, pB1, pA0, pA1, NTe - 1, false, false, false); RESC();
    { float sacc = pB0[0] + pB0[1];
#pragma unroll
      for (int r = 2; r < 16; ++r) sacc += pB0[r];
#pragma unroll
      for (int r = 0; r < 16; ++r) sacc += pB1[r];
      l_reg += sacc;
      pw0 = (u32x4){PKW(pB0, 0), PKW(pB0, 2), PKW(pB0, 4), PKW(pB0, 6)}; pw1 = (u32x4){PKW(pB0, 8), PKW(pB0, 10), PKW(pB0, 12), PKW(pB0, 14)};
      pw2 = (u32x4){PKW(pB1, 0), PKW(pB1, 2), PKW(pB1, 4), PKW(pB1, 6)}; pw3 = (u32x4){PKW(pB1, 8), PKW(pB1, 10), PKW(pB1, 12), PKW(pB1, 14)};
      SBAR(); att::pv(o, (int)(unsigned)(uintptr_t)(vp0 + sl_cur), PAF(0), PAF(1), PAF(2), PAF(3)); }
    if (nbh >= 0) { asm volatile("s_waitcnt lgkmcnt(0)\n\ts_barrier" ::: "memory");
        const int NTn = (nqb * QB + QB) / KVBLK; const bf16_t* Kn = K + (long)(nbh >> 3) * SEQ * PITCH + (nbh & 7) * HD; const bf16_t* Vn = V + (long)(nbh >> 3) * SEQ * PITCH + (nbh & 7) * HD; const bf16_t* KXn = KXall + (size_t)nbh * SEQ * 8;
        DMA_KX(Kn, KXn, NTn, 0, 0); DMA_VX(Vn, NTn, 0, 0); DMA_KX(Kn, KXn, NTn, 1, SLOTB); DMA_KX(Kn, KXn, NTn, 2, 2 * SLOTB); }
    l_reg = att::swap_lo(l_reg) + att::swap_hi(l_reg);
    if (hi == 0) wsf[32 + r32] = l_reg; asm volatile("s_waitcnt lgkmcnt(0)" ::: "memory");
    float rli[16];
#pragma unroll
    for (int r = 0; r < 16; ++r) rli[r] = __builtin_amdgcn_rcpf(wsf[32 + crow(r, hi)]);
    bf16_t* Ow = O + (rowbase + q0 + wid * 32) * OPITCH + h * HD;
    { LAS bf16_t* stg = (LAS bf16_t*)(shm + LDS_OST) + wid * 2048;
#pragma unroll
      for (int r = 0; r < 16; ++r) { const int orow = crow(r, hi);
#pragma unroll
        for (int d0 = 0; d0 < 2; ++d0) stg[orow * 64 + d0 * 32 + r32] = (bf16_t)(cvt_pk_bf16(o[d0][r] * rli[r], 0.f) & 0xffffu); }
      asm volatile("s_waitcnt lgkmcnt(0)" ::: "memory");
#pragma unroll
      for (int i = 0; i < 4; ++i) { const int row = i * 8 + (lane >> 3), ch = lane & 7; const u32x4 v = *(const LAS u32x4*)(stg + row * 64 + ch * 8); *(u32x4*)(Ow + (long)row * OPITCH + ch * 8) = v;
        att::store_row_ssq(v, hs + (rowbase + q0 + wid * 32 + row) * 16, ch); } }
    asm volatile("s_waitcnt lgkmcnt(0)\n\ts_barrier" ::: "memory");
#undef DMA_K
#undef DMA_V
#undef DMA_KX
#undef DMA_VX
#undef CMASK
#undef RESC
#undef ROT
#undef PKW
#undef PAF
#undef VFR
#undef PIN
#undef MX3
#undef GAPA
#undef GAPB
#undef EX
#undef VRD
#undef KRD
#undef KRDX
#undef STEP
#undef ENDW
#undef VOTE
#undef TALLY
}
#undef SBAR
#undef WAIT_BAR
}


namespace sbk {
constexpr int QB = 256, KVBLK = 64, PITCH = HW, OPITCH = DM, NBURST = 6, SLOTB = 8192;
constexpr int LDS_K = 0, LDS_V = NBURST * SLOTB, LDS_FLAG = 2 * NBURST * SLOTB, LDS_END = LDS_FLAG + 128;
static_assert(LDS_END <= RING_BYTES, "sb LDS");
using att::crow; using att::glds16s; using att::qkt; using att::pv; using att::swap_lo;
__device__ __forceinline__ void sb_tile(const LAS char* Kslot, int vb, const bf16x8* qr, bf16x8 TD0, bf16x8 TD1, bf16x8 TONE, int jb, int qrel, int r32, int hi, float& R, f32x16* o) {
    f32x16 p0, p1; const f32x16 z16 = f32x16{};
    qkt(p0, p1, Kslot, qr, z16, r32, hi);
    if (jb >= 0) {
#pragma unroll
        for (int r = 0; r < 16; ++r) { const int kv = 64 * jb + crow(r, hi); if (kv >= qrel) p0[r] = -1.0e30f; if (kv + 32 >= qrel) p1[r] = -1.0e30f; } }
    f32x16 l0, l1;
#pragma unroll
    for (int r = 0; r < 16; ++r) {
        l0[r] = -(fmaxf(p0[r], 0.f) + __builtin_amdgcn_logf(1.0f + __builtin_amdgcn_exp2f(-fabsf(p0[r]))));
        l1[r] = -(fmaxf(p1[r], 0.f) + __builtin_amdgcn_logf(1.0f + __builtin_amdgcn_exp2f(-fabsf(p1[r])))); }
    u32x4 lw0 = {cvt_pk_bf16(l0[0], l0[1]), cvt_pk_bf16(l0[2], l0[3]), cvt_pk_bf16(l0[4], l0[5]), cvt_pk_bf16(l0[6], l0[7])};
    u32x4 lw1 = {cvt_pk_bf16(l0[8], l0[9]), cvt_pk_bf16(l0[10], l0[11]), cvt_pk_bf16(l0[12], l0[13]), cvt_pk_bf16(l0[14], l0[15])};
    u32x4 lw2 = {cvt_pk_bf16(l1[0], l1[1]), cvt_pk_bf16(l1[2], l1[3]), cvt_pk_bf16(l1[4], l1[5]), cvt_pk_bf16(l1[6], l1[7])};
    u32x4 lw3 = {cvt_pk_bf16(l1[8], l1[9]), cvt_pk_bf16(l1[10], l1[11]), cvt_pk_bf16(l1[12], l1[13]), cvt_pk_bf16(l1[14], l1[15])};
    f32x16 rt;
#pragma unroll
    for (int r = 0; r < 16; ++r) rt[r] = R;
    f32x16 t0 = MFMA32(TD0, __builtin_bit_cast(bf16x8, lw0), rt); t0 = MFMA32(TD1, __builtin_bit_cast(bf16x8, lw1), t0);
    t0 = MFMA32(TONE, __builtin_bit_cast(bf16x8, lw2), t0); t0 = MFMA32(TONE, __builtin_bit_cast(bf16x8, lw3), t0);
    f32x16 t1 = MFMA32(TD0, __builtin_bit_cast(bf16x8, lw2), rt); t1 = MFMA32(TD1, __builtin_bit_cast(bf16x8, lw3), t1);
#pragma unroll
    for (int r = 0; r < 16; ++r) { p0[r] = __builtin_amdgcn_exp2f(p0[r] + t0[r]); p1[r] = __builtin_amdgcn_exp2f(p1[r] + t1[r]); }
    R = swap_lo(t0[0]);
    u32x4 pw0 = {cvt_pk_bf16(p0[0], p0[1]), cvt_pk_bf16(p0[2], p0[3]), cvt_pk_bf16(p0[4], p0[5]), cvt_pk_bf16(p0[6], p0[7])};
    u32x4 pw1 = {cvt_pk_bf16(p0[8], p0[9]), cvt_pk_bf16(p0[10], p0[11]), cvt_pk_bf16(p0[12], p0[13]), cvt_pk_bf16(p0[14], p0[15])};
    u32x4 pw2 = {cvt_pk_bf16(p1[0], p1[1]), cvt_pk_bf16(p1[2], p1[3]), cvt_pk_bf16(p1[4], p1[5]), cvt_pk_bf16(p1[6], p1[7])};
    u32x4 pw3 = {cvt_pk_bf16(p1[8], p1[9]), cvt_pk_bf16(p1[10], p1[11]), cvt_pk_bf16(p1[12], p1[13]), cvt_pk_bf16(p1[14], p1[15])};
    pv(o, vb, __builtin_bit_cast(bf16x8, pw0), __builtin_bit_cast(bf16x8, pw1), __builtin_bit_cast(bf16x8, pw2), __builtin_bit_cast(bf16x8, pw3));
}
#define SB_WAITBAR(N) asm volatile("s_waitcnt vmcnt(" #N ") lgkmcnt(0)\n\ts_barrier" ::: "memory")
__device__ __forceinline__ void sb_unit(int b, int h, int qb, const bf16_t* Q, const bf16_t* K, const bf16_t* V, bf16_t* O, float* hs, LAS char* shm) {
    int tid = threadIdx.x; asm volatile("" : "+v"(tid)); const int lane = tid & 63, r32 = lane & 31, hi = lane >> 5; const int wid = __builtin_amdgcn_readfirstlane(tid >> 6);
    const long rowbase = (long)b * SEQ; const int q0 = qb * QB;
    const bf16_t* Qw = Q + (rowbase + q0 + wid * 32) * PITCH + h * HD;
    const bf16_t* Kh = K + rowbase * PITCH + h * HD; const bf16_t* Vh = V + rowbase * PITCH + h * HD;
    const unsigned lds0 = (unsigned)(uintptr_t)shm;
    LAS unsigned* flags = (LAS unsigned*)(shm + LDS_FLAG);
    const unsigned koff = (unsigned)(lane * PITCH + wid * 8) * 2u, voff = (unsigned)((16 * (wid & 3) + (lane >> 2)) * PITCH + (wid >> 2) * 32 + (lane & 3) * 8) * 2u;
    const unsigned kdst = lds0 + LDS_K + wid * 1024, vdst = lds0 + LDS_V + wid * 1024;
#define SB_DMA(p, slot) do { glds16s(Kh + (long)(NT - 1 - (p)) * KVBLK * PITCH, koff, (unsigned)__builtin_amdgcn_readfirstlane(kdst + (slot) * SLOTB)); \
        glds16s(Vh + (long)(NT - 1 - (p)) * KVBLK * PITCH, voff, (unsigned)__builtin_amdgcn_readfirstlane(vdst + (slot) * SLOTB)); } while (0)
    const int vb0 = (int)(lds0 + LDS_V) + ((lane >> 4) & 1) * 32 + (lane & 3) * 8 + (4 * hi + ((lane & 15) >> 2)) * 64;
    const int NT = (q0 + QB) / KVBLK, NB = NT < NBURST ? NT : NBURST;
    for (int p = 0; p < NB; ++p) SB_DMA(p, p);
    bf16x8 qr[4];
#pragma unroll
    for (int d0 = 0; d0 < 4; ++d0) qr[d0] = *(const bf16x8*)(Qw + (long)r32 * PITCH + d0 * 16 + hi * 8);
    f32x16 o[2]; o[0] = f32x16{}; o[1] = f32x16{};
    const int qrel = wid * 32 + r32;
    float R = 0.f;
    bf16x8 TD0, TD1, TONE;
#pragma unroll
    for (int j = 0; j < 8; ++j) { const int kvl = 8 * (j >> 2) + 4 * hi + (j & 3); TD0[j] = (kvl >= r32) ? (short)0x3F80 : (short)0; TD1[j] = (16 + kvl >= r32) ? (short)0x3F80 : (short)0; TONE[j] = (short)0x3F80; }
    if (NB > 4) { SB_WAITBAR(4); } else { SB_WAITBAR(0); }
    bool mid_done = (NB <= 4);
    int p = 3 - (wid >> 1);
    for (; p < NB; ++p) {
        if (p >= 4 && !mid_done) { SB_WAITBAR(0); mid_done = true; }
        sb_tile(shm + LDS_K + p * SLOTB, vb0 + p * SLOTB, qr, TD0, TD1, TONE, 3 - p, qrel, r32, hi, R, o);
        if (__all(R < SB_EXIT)) { ++p; break; }
    }
    if (!mid_done) { SB_WAITBAR(0); }
    { const bool dn = __all(R < SB_EXIT) || (p >= NT); if (lane == 0) flags[wid] = dn ? 1u : 0u; }
    SB_WAITBAR(0);
    bool alldone;
    { const u32x4 fa = *(const LAS u32x4*)flags, fb = *(const LAS u32x4*)(flags + 4); alldone = __builtin_amdgcn_readfirstlane((fa.x & fa.y & fa.z & fa.w & fb.x & fb.y & fb.z & fb.w) != 0u); }
    if (!alldone && NB < NT) {
        SB_DMA(NB, 0);
        for (int i = 0; NB + i < NT; ++i) {
            const int pp = NB + i, sl = i & 1;
            SB_WAITBAR(0);
            if (i > 0) { const LAS unsigned* fl = flags + 8 + ((i - 1) & 1) * 8; const u32x4 fa = *(const LAS u32x4*)fl, fb = *(const LAS u32x4*)(fl + 4);
                if (__builtin_amdgcn_readfirstlane((fa.x & fa.y & fa.z & fa.w & fb.x & fb.y & fb.z & fb.w) != 0u)) break; }
            if (pp + 1 < NT) SB_DMA(pp + 1, sl ^ 1);
            if (!__all(R < SB_EXIT)) sb_tile(shm + LDS_K + sl * SLOTB, vb0 + sl * SLOTB, qr, TD0, TD1, TONE, -1, qrel, r32, hi, R, o);
            { const bool dn = __all(R < SB_EXIT); if (lane == 0) flags[8 + (i & 1) * 8 + wid] = dn ? 1u : 0u; }
        }
        SB_WAITBAR(0);
    }
    bf16_t* Ow = O + (rowbase + q0 + wid * 32) * OPITCH + h * HD;
    { LAS bf16_t* stg = (LAS bf16_t*)(shm + LDS_K) + wid * 2048;
#pragma unroll
      for (int r = 0; r < 16; ++r) { const int orow = crow(r, hi);
#pragma unroll
        for (int d0 = 0; d0 < 2; ++d0) stg[orow * 64 + d0 * 32 + r32] = (bf16_t)(cvt_pk_bf16(o[d0][r], 0.f) & 0xffffu); }
      LDS_WAIT();
#pragma unroll
      for (int i = 0; i < 4; ++i) { const int row = i * 8 + (lane >> 3), ch = lane & 7; const u32x4 v = *(const LAS u32x4*)(stg + row * 64 + ch * 8); *(u32x4*)(Ow + (long)row * OPITCH + ch * 8) = v;
        att::store_row_ssq(v, hs + (rowbase + q0 + wid * 32 + row) * 16, ch); } }
    asm volatile("s_waitcnt vmcnt(0) lgkmcnt(0)\n\ts_barrier" ::: "memory");
#undef SB_DMA
}
#undef SB_WAITBAR
}

#define XB_TMO      128
#define XB_XCNT(j)  (256  + 64 * (j))
#define XB_XSUB(j)  (1280 + 64 * (j))
#define XB_XGEN(j)  (2304 + 64 * (j))
#define XB_TOP      3328
#define XB_TOPGEN   3392
#define XCD_BAR_WORDS 3456
#define XB_SPIN_CAP (1u << 18)
__device__ __forceinline__ unsigned xb_ld(unsigned* p)              { return __hip_atomic_load(p, __ATOMIC_RELAXED, __HIP_MEMORY_SCOPE_AGENT); }
__device__ __forceinline__ unsigned xb_add(unsigned* p, unsigned v) { return __hip_atomic_fetch_add(p, v, __ATOMIC_RELAXED, __HIP_MEMORY_SCOPE_AGENT); }
__device__ __forceinline__ unsigned xb_xcc_id() { return (unsigned)__builtin_amdgcn_s_getreg((3 << 11) | 20) & 0xFu; }
#define XB_SPIN(cond, bar) do { unsigned _sp = 0; while (cond) { __builtin_amdgcn_s_sleep(1); \
    if ((++_sp & 255u) == 0u) { if (xb_ld(&(bar)[XB_TMO])) break; if (_sp > XB_SPIN_CAP) { atomicAdd(&(bar)[XB_TMO], 1u); break; } } } } while (0)
struct XcdBarrier { unsigned* bar; unsigned x; volatile LAS unsigned* st; };
__device__ __forceinline__ XcdBarrier xcd_barrier_post(unsigned* bar, volatile LAS unsigned* st) {
    XcdBarrier b; b.bar = bar; b.x = xb_xcc_id(); b.st = st;
    if (threadIdx.x == 0) (void)xb_add(&bar[XB_XCNT(b.x)], 1u);
    return b;
}
__device__ __forceinline__ void xcd_barrier_complete(unsigned* bar, unsigned x, unsigned& nloc, unsigned& nx) {
    const unsigned G = gridDim.x * gridDim.y * gridDim.z;
    unsigned sum, cnt, mine, sp = 0u;
    for (;;) {
        sum = 0u; cnt = 0u; mine = 0u;
#pragma unroll
        for (unsigned j = 0; j < 16; ++j) { const unsigned c = xb_ld(&bar[XB_XCNT(j)]); sum += c; cnt += (c > 0u) ? 1u : 0u; mine = (j == x) ? c : mine; }
        if (sum == G) break;
        __builtin_amdgcn_s_sleep(1);
        if ((++sp & 255u) == 0u) { if (xb_ld(&bar[XB_TMO])) break; if (sp > XB_SPIN_CAP) { atomicAdd(&bar[XB_TMO], 1u); break; } }
    }
    nloc = mine > 0u ? mine : 1u; nx = cnt > 0u ? cnt : 1u;
}
__device__ __forceinline__ void xcd_barrier(const XcdBarrier& b) {
    asm volatile("s_waitcnt vmcnt(0)" ::: "memory");
    __syncthreads();
    if (threadIdx.x == 0) {
        unsigned* bar = b.bar;
        __builtin_amdgcn_s_waitcnt(0);
        unsigned nloc = b.st[0], nx = b.st[1];
        if (nloc == 0u) { xcd_barrier_complete(bar, b.x, nloc, nx); b.st[0] = nloc; b.st[1] = nx; }
        const unsigned old = xb_add(&bar[XB_XSUB(b.x)], 1u);
        const unsigned gen = old / nloc;
        if (old + 1u == (gen + 1u) * nloc) {
            __builtin_amdgcn_fence(__ATOMIC_RELEASE, "agent");
            asm volatile("s_waitcnt vmcnt(0)" ::: "memory");
            const unsigned og = xb_add(&bar[XB_TOP], 1u);
            const unsigned tg = og / nx;
            if (og + 1u == (tg + 1u) * nx) xb_add(&bar[XB_TOPGEN], 1u);
            else XB_SPIN(xb_ld(&bar[XB_TOPGEN]) == tg, bar);
            __builtin_amdgcn_fence(__ATOMIC_ACQUIRE, "agent");
            xb_add(&bar[XB_XGEN(b.x)], 1u);
            asm volatile("s_waitcnt vmcnt(0)" ::: "memory");
        } else {
            XB_SPIN(xb_ld(&bar[XB_XGEN(b.x)]) == gen, bar);
            __builtin_amdgcn_fence(__ATOMIC_ACQUIRE, "agent");
            asm volatile("s_waitcnt vmcnt(0)" ::: "memory");
        }
    }
    __syncthreads();
}

__device__ __forceinline__ const void* ldp(const volatile LAS unsigned* tab, int i) {
    const unsigned lo = __builtin_amdgcn_readfirstlane(tab[2 * i]), hi = __builtin_amdgcn_readfirstlane(tab[2 * i + 1]);
    return (const void*)(const GAS void*)(((unsigned long long)hi << 32) | lo);
}
struct Args {
    const float* x; const float* mem; const float* norm_mix; const float* w_in; const float* b_forget; const float* norm_fox; const float* norm_sb; const float* w_out;
    const float* norm_xattn; const float* norm_mem; const float* w_xq; const float* w_xkv; const float* w_xo; const float* norm_ffn;
    const float* w_rg; const float* b_rg; const float* w_re; const float* b_re; const float* w_gate; const float* w_up; const float* w_down; const float* norm_final;
    float* out; unsigned char* ws;
};

__device__ __forceinline__ void transpose_item(const float* W, int ldw, bf16_t* WT, int ldo, int k0, int n0, int dst_row0, const float* gain, LAS float* scr, int lane) {
    float tv[32], tg[32];
#pragma unroll
    for (int i = 0; i < 32; ++i) { const int kk = 2 * i + (lane >> 5); tv[i] = __builtin_nontemporal_load(W + (size_t)(k0 + kk) * ldw + n0 + (lane & 31)); tg[i] = gain ? gain[k0 + kk] : 1.f; }
#pragma unroll
    for (int i = 0; i < 32; ++i) { const int kk = 2 * i + (lane >> 5); scr[kk * 33 + (lane & 31)] = tv[i] * tg[i]; }
    LDS_WAIT(); asm volatile("" ::: "memory");
    const int c = lane & 7;
#pragma unroll
    for (int j = 0; j < 4; ++j) { const int n = (lane >> 3) + 8 * j; const LAS float* s = scr + (8 * c) * 33 + n;
        u32x4 o; o.x = cvt_pk_bf16(s[0 * 33], s[1 * 33]); o.y = cvt_pk_bf16(s[2 * 33], s[3 * 33]); o.z = cvt_pk_bf16(s[4 * 33], s[5 * 33]); o.w = cvt_pk_bf16(s[6 * 33], s[7 * 33]);
        *(u32x4*)(WT + (size_t)(dst_row0 + n) * ldo + k0 + 8 * c) = o; }
    LDS_WAIT(); asm volatile("" ::: "memory");
}

__device__ __forceinline__ void transpose_item8(const float* W, int ldw, unsigned char* WT, int ldo, int k0, int n0, int dst_row0, const float* gain, float scale, LAS float* scr, int lane) {
    float tv[32], tg[32];
#pragma unroll
    for (int i = 0; i < 32; ++i) { const int kk = 2 * i + (lane >> 5); tv[i] = __builtin_nontemporal_load(W + (size_t)(k0 + kk) * ldw + n0 + (lane & 31)); tg[i] = gain ? gain[k0 + kk] : 1.f; }
#pragma unroll
    for (int i = 0; i < 32; ++i) { const int kk = 2 * i + (lane >> 5); scr[kk * 33 + (lane & 31)] = tv[i] * tg[i] * scale; }
    LDS_WAIT(); asm volatile("" ::: "memory");
    const int c = lane & 7;
#pragma unroll
    for (int j = 0; j < 4; ++j) { const int n = (lane >> 3) + 8 * j; const LAS float* s = scr + (8 * c) * 33 + n;
        u32x2 o; o.x = cvt4_fp8(s[0 * 33], s[1 * 33], s[2 * 33], s[3 * 33]); o.y = cvt4_fp8(s[4 * 33], s[5 * 33], s[6 * 33], s[7 * 33]);
        *(u32x2*)(WT + (size_t)(dst_row0 + n) * ldo + k0 + 8 * c) = o; }
    LDS_WAIT(); asm volatile("" ::: "memory");
}

struct SchedDense {
    const char* A; const char* Bt; int nM, nN, G, c; size_t a_tile, b_tile, b_batch; int split_tiles;
    __device__ __forceinline__ bool next(int i, pg8::Unit& u) const {
        int pm, pn; if (!pg8::tile_order(i, G, c, nM, nN, pm, pn)) return false;
        u.a = A + (size_t)pm * a_tile; u.b = Bt + (size_t)pn * b_tile + (size_t)(pm >> 5) * b_batch; u.orow = pm * 256;
        if (split_tiles) { u.aux = pn / split_tiles; u.ocol = (pn % split_tiles) * 256; } else { u.aux = 1; u.ocol = pn * 256; }
        u.rows = nullptr; u.nvalid = 256; return true;
    }
};
struct SchedGH {
    const char* KVm; const char* Wxq; const char* Wxo; int G, c;
    __device__ __forceinline__ bool next(int i, pg8::Unit& u) const {
        const int L = i * G + c; if (L >= 256) return false;
        const int kind = L >> 7, r = L & 127, bh = r >> 2, j = r & 3, b = bh >> 2, h = bh & 3;
        if (kind == 0) { u.a = KVm + ((size_t)(b * 256) * 2048 + h * 256) * 2; u.b = Wxq + ((size_t)(256 * j) * 1024 + h * 256) * 2; u.orow = b * 1024 + h * 256; u.ocol = 256 * j; u.aux = 1; }
        else { u.a = Wxo + ((size_t)(256 * j) * 1024 + h * 256) * 2; u.b = KVm + ((size_t)(b * 256) * 2048 + 1024 + h * 256) * 2; u.orow = b * 1024 + 256 * j; u.ocol = h * 256; u.aux = 2; }
        u.rows = nullptr; u.nvalid = 256; return true;
    }
};
template <int KIND> struct SchedGHk { SchedGH s; __device__ __forceinline__ bool next(int i, pg8::Unit& u) const { const int c2 = (s.G >= 256) ? s.c - 128 * KIND : s.c; if (c2 < 0) return false; const int L = i * s.G + c2; if (L >= 128) return false; SchedGH t = s; t.G = 1; t.c = 0; return t.next(128 * KIND + L, u); } };
struct EpiGH { static constexpr bool HAS_MID = false; unsigned char* GTp; unsigned char* HTp;
    __device__ __forceinline__ void operator()(const f32x4 (&acc)[2][2][4][2], const pg8::Unit& u, int wr, int wc, int fr, int fq) const {
        unsigned char* base = u.aux == 1 ? GTp : HTp;
#pragma unroll
        for (int ai = 0; ai < 2; ++ai)
#pragma unroll
            for (int m = 0; m < 4; m += 2) { const int row = u.orow + ai * pg8::HALF + wr * 64 + m * 16 + fr + 16 * (fq & 1);
#pragma unroll
                for (int bj = 0; bj < 2; ++bj) { u32x2 w8[2];
#pragma unroll
                    for (int mm = 0; mm < 2; ++mm) { const f32x4 v0 = acc[ai][bj][m + mm][0], v1 = acc[ai][bj][m + mm][1]; w8[mm].x = cvt4_fp8(v0[0], v0[1], v0[2], v0[3]); w8[mm].y = cvt4_fp8(v1[0], v1[1], v1[2], v1[3]); }
                    *(u32x4*)(base + (size_t)row * DM + u.ocol + bj * pg8::HALF + wc * 32 + 8 * (fq & ~1)) = widen16(w8[0], w8[1]); } }
    } };
struct SchedMoe {
    const char* A; const char* W; const int* list; const LAS int* tbl; int G, c, NPN; size_t w_exp, w_tile, a_tile; int ocol_w;
    __device__ __forceinline__ bool next(int i, pg8::Unit& u) const {
        const int L = i * G + c; const int tl = L / NPN, pn = L % NPN;
        if (tl >= __builtin_amdgcn_readfirstlane(tbl[16])) return false;
        const int e = __builtin_amdgcn_readfirstlane(tbl[64 + tl]);
        const int j = tl - __builtin_amdgcn_readfirstlane(tbl[e]), n = __builtin_amdgcn_readfirstlane(tbl[32 + e]) - 256 * j;
        u.a = A + (size_t)tl * a_tile; u.b = W + (size_t)e * w_exp + (size_t)pn * w_tile; u.orow = tl * 256; u.ocol = pn * ocol_w; u.aux = 1;
        u.rows = list + (size_t)e * M + 256 * j; u.nvalid = n < 256 ? n : 256; return true;
    }
};
__device__ __forceinline__ void moe_table(LAS int* tbl, const unsigned* ctl) {
    if (threadIdx.x == 0) { int base = 0; for (int e = 0; e < NEXP; ++e) { const int n = (int)ctl[CW_CNT + 64 * e]; tbl[e] = base; tbl[32 + e] = n; base += (n + 255) >> 8; } tbl[16] = base; }
    __syncthreads();
    for (int tl = threadIdx.x; tl < tbl[16]; tl += NWAVES * 64) { int e = 0;
#pragma unroll
        for (int x = 1; x < NEXP; ++x) if (tl >= tbl[x]) e = x;
        tbl[64 + tl] = e; }
    __syncthreads();
}

__global__ void __launch_bounds__(NWAVES * 64, 2) hymba_fwd(Args args) {
    extern __shared__ __attribute__((aligned(16))) unsigned char lds_raw[];
    LAS unsigned char* lds = (LAS unsigned char*)lds_raw;
    volatile LAS unsigned* MISC = (volatile LAS unsigned*)(lds + MISC_OFF);
    const int tid0 = threadIdx.x; const int wave = __builtin_amdgcn_readfirstlane(tid0 >> 6);
    const int G = gridDim.x; const int bx = blockIdx.x; const int vcu = (G % 8 == 0) ? (bx % 8) * (G / 8) + bx / 8 : bx;
    volatile LAS unsigned* ATAB = (volatile LAS unsigned*)(lds + MISC_OFF + 512);
    for (int u = tid0; u < 256; u += NWAVES * 64) ((LAS unsigned*)(lds + MISC_OFF))[u] = 0u;
    __syncthreads();
    if (tid0 == 0) { const float* const* ap = (const float* const*)&args;
#pragma unroll
        for (int i = 0; i < 24; ++i) { const unsigned long long v = (unsigned long long)ap[i]; ATAB[2 * i] = (unsigned)v; ATAB[2 * i + 1] = (unsigned)(v >> 32); } }
    __syncthreads();
#define ARGP(name) ((const float*)ldp(ATAB, (int)(offsetof(Args, name) / 8)))
#define PHASE_PTRS \
    int tid = threadIdx.x; asm volatile("" : "+v"(tid)); const int lane = tid & 63; (void)lane; \
    unsigned char* const ws = (unsigned char*)ldp(ATAB, 23); float* const out = (float*)ldp(ATAB, 22); unsigned* const ctl = (unsigned*)(ws + WS_CTL); (void)out; (void)ctl; \
    bf16_t* const Win_t = (bf16_t*)(ws + WS_WIN); bf16_t* const Wout_t = (bf16_t*)(ws + WS_WOUT); bf16_t* const Wxq_n = (bf16_t*)(ws + WS_WXQ); bf16_t* const Wxkv_t = (bf16_t*)(ws + WS_WXKV); \
    bf16_t* const Wxo_t = (bf16_t*)(ws + WS_WXO); bf16_t* const Wgu_t = (bf16_t*)(ws + WS_WGU); bf16_t* const Wd_t = (bf16_t*)(ws + WS_WD); \
    float* const RX = (float*)(ws + WS_RX); float* const RMEM = (float*)(ws + WS_RMEM); float* const LF = (float*)(ws + WS_LF); float* const CC = (float*)(ws + WS_C2); float* const SSQ = (float*)(ws + WS_SSQ); \
    int* const TOKSLOT = (int*)(ws + WS_TOKSLOT); float* const TOKW = (float*)(ws + WS_TOKW); int* const LIST = (int*)(ws + WS_LIST); \
    bf16_t* const MEMB = (bf16_t*)(ws + WS_MEMB); bf16_t* const KVM = (bf16_t*)(ws + WS_KVM); bf16_t* const GT = (bf16_t*)(ws + WS_GT); bf16_t* const HT = (bf16_t*)(ws + WS_HT); \
    bf16_t* const XB = (bf16_t*)(ws + WS_XB); bf16_t* const QKV = (bf16_t*)(ws + WS_QKV); bf16_t* const H1B = (bf16_t*)(ws + WS_H1B); bf16_t* const U2B = (bf16_t*)(ws + WS_U2B); bf16_t* const HID = (bf16_t*)(ws + WS_HID); \
    bf16_t* const OAB = (bf16_t*)(ws + WS_O); bf16_t* const YB = (bf16_t*)(ws + WS_Y); bf16_t* const KX = (bf16_t*)(ws + WS_KX); (void)KX; float* const HS = (float*)(ws + WS_HS); (void)HS; float* const R2S = (float*)(ws + WS_SSQ); (void)R2S; unsigned char* const H1F8 = ws + WS_H1F8; (void)H1F8; unsigned char* const H2F8 = ws + WS_H2F8; (void)H2F8; \
    (void)Win_t; (void)Wout_t; (void)Wxq_n; (void)Wxkv_t; (void)Wxo_t; (void)Wgu_t; (void)Wd_t; (void)RX; (void)RMEM; (void)LF; (void)CC; (void)SSQ; (void)TOKSLOT; (void)TOKW; (void)LIST; \
    (void)MEMB; (void)KVM; (void)GT; (void)HT; (void)XB; (void)QKV; (void)H1B; (void)U2B; (void)HID; (void)OAB; (void)YB;
    XcdBarrier bar;
    { unsigned char* const ws0 = (unsigned char*)ldp(ATAB, 23); bar = xcd_barrier_post((unsigned*)(ws0 + WS_CTL) + CW_BAR, MISC + 8); }
    const int gw = vcu * NWAVES + wave, NGW = G * NWAVES;
    unsigned long long t_pa = 0, t_pb = 0; (void)t_pa; (void)t_pb;


    if (PROBE_LO == 0) t_pa = __builtin_amdgcn_s_memrealtime();
    if (PH(0))
    for (int rep_ = 0; rep_ < REPS(0); ++rep_)
    {
        PHASE_PTRS
        LAS float* wfT = (LAS float*)(lds + RING_OFF);
        LAS float* scr = (LAS float*)(lds + RING_OFF + 32768 + wave * 8448);
        { const float* win = ARGP(w_in); const float* gmix = ARGP(norm_mix);
          f32x4 fa[2], fb[2]; float gk[2];
#pragma unroll
          for (int q = 0; q < 2; ++q) { const int k = tid + 512 * q; gk[q] = gmix[k]; fa[q] = *(const f32x4*)(win + (size_t)k * WIN_LD + NPROJ); fb[q] = *(const f32x4*)(win + (size_t)k * WIN_LD + NPROJ + 4); }
#pragma unroll
          for (int q = 0; q < 2; ++q) { const int k = tid + 512 * q;
#pragma unroll
              for (int j = 0; j < 4; ++j) { wfT[j * DM + k] = fa[q][j] * gk[q]; wfT[(4 + j) * DM + k] = fb[q][j] * gk[q]; } } }
        constexpr int I_IN = 16 * 96, I_OUT = 16 * 32, I_XKV = 16 * 64, I_XO = 16 * 32, I_G = 16 * 16 * 8, I_U = I_G, I_D = 16 * 4 * 32, I_XQ = 1024;
        constexpr int NITEMS = I_IN + I_OUT + I_XKV + I_XO + I_G + I_U + I_D + I_XQ;
        for (int it = gw; it < NITEMS; it += NGW) {
            int r = it;
            if (r < I_IN) { const int kb = r / 96, nb = r % 96; transpose_item(ARGP(w_in), WIN_LD, Win_t, DM, 64 * kb, 32 * nb, 32 * nb, ARGP(norm_mix), scr, lane); continue; } r -= I_IN;
            if (r < I_OUT) { const int kb = r / 32, nb = r % 32; const float* gn = (64 * kb < HW) ? ARGP(norm_fox) : (ARGP(norm_sb) - HW); transpose_item(ARGP(w_out), DM, Wout_t, DM, 64 * kb, 32 * nb, 32 * nb, gn, scr, lane); continue; } r -= I_OUT;
            if (r < I_XKV) { const int kb = r / 64, nb = r % 64; transpose_item(ARGP(w_xkv), 2 * DM, Wxkv_t, DM, 64 * kb, 32 * nb, 32 * nb, ARGP(norm_mem), scr, lane); continue; } r -= I_XKV;
            if (r < I_XO) { const int kb = r / 32, nb = r % 32; transpose_item(ARGP(w_xo), DM, Wxo_t, DM, 64 * kb, 32 * nb, 32 * nb, nullptr, scr, lane); continue; } r -= I_XO;
            if (r < I_G + I_U) { const int up = r >= I_G; const int q = up ? r - I_G : r; const int e = q / 128, kb = (q % 128) / 8, nb = q % 8; const int n0 = 32 * nb;
                const float* W = (up ? ARGP(w_up) : ARGP(w_gate)) + (size_t)e * DM * DFF;
                transpose_item8(W, DFF, (unsigned char*)Wgu_t + (size_t)e * 512 * DM, DM, 64 * kb, n0, 256 * (n0 / 128) + (n0 % 128) + (up ? 128 : 0), ARGP(norm_ffn), WGU_SCALE, scr, lane); continue; } r -= I_G + I_U;
            if (r < I_D) { const int e = r / 128, kb = (r % 128) / 32, nb = r % 32; transpose_item8(ARGP(w_down) + (size_t)e * DFF * DM, DM, (unsigned char*)Wd_t + (size_t)e * DM * DFF, DFF, 64 * kb, 32 * nb, 32 * nb, nullptr, WD_SCALE, scr, lane); continue; } r -= I_D;
            { const int k = r; const float gk = ARGP(norm_xattn)[k]; const f32x4* src = (const f32x4*)(ARGP(w_xq) + (size_t)k * DM) + lane; u32x2* dst = (u32x2*)(Wxq_n + (size_t)k * DM) + lane;
#pragma unroll
              for (int j = 0; j < 4; ++j) { const f32x4 v = src[64 * j] * gk; u32x2 w; w.x = cvt_pk_bf16(v[0], v[1]); w.y = cvt_pk_bf16(v[2], v[3]); dst[64 * j] = w; } }
        }
        __syncthreads();
        const float* xin = ARGP(x); const float* memin = ARGP(mem); const float* bfg = ARGP(b_forget);
        constexpr int TOT = M + MEMROWS;
#define P0_LOAD(vv, rw) do { if ((rw) < TOT) { const bool im_ = (rw) >= M; const f32x4* xr_ = (const f32x4*)((im_ ? memin : xin) + (size_t)(im_ ? (rw) - M : (rw)) * DM) + lane; \
        _Pragma("unroll") for (int j = 0; j < 4; ++j) vv[j] = __builtin_nontemporal_load(xr_ + 64 * j); } } while (0)
#define P0_ROW(vv, rw) do { const int row_ = (rw); const bool is_mem = row_ >= M; const int r = is_mem ? row_ - M : row_; float s = 0.f; \
        _Pragma("unroll") for (int j = 0; j < 4; ++j) s += (vv[j][0] * vv[j][0] + vv[j][1] * vv[j][1]) + (vv[j][2] * vv[j][2] + vv[j][3] * vv[j][3]); \
        const float rinv = rsqrtf(wave_sum(s) * (1.0f / DM) + EPS); \
        u32x2* o8 = (u32x2*)((is_mem ? MEMB : XB) + (size_t)r * DM) + lane; \
        _Pragma("unroll") for (int j = 0; j < 4; ++j) { u32x2 w; w.x = cvt_pk_bf16(vv[j][0], vv[j][1]); w.y = cvt_pk_bf16(vv[j][2], vv[j][3]); o8[64 * j] = w; } \
        if (is_mem) { if (lane == 0) RMEM[r] = rinv; } \
        else { float f[8]; \
            _Pragma("unroll") for (int jj = 0; jj < 8; ++jj) { float a = 0.f; \
                _Pragma("unroll") for (int j = 0; j < 4; ++j) { const f32x4 w4 = *(const LAS f32x4*)(wfT + jj * DM + 256 * j + 4 * lane); a += (vv[j][0] * w4[0] + vv[j][1] * w4[1]) + (vv[j][2] * w4[2] + vv[j][3] * w4[3]); } \
                f[jj] = wave_sum(a); } \
            if (lane == 0) RX[r] = rinv; \
            if (lane < 8) { float fl = 0.f; \
                _Pragma("unroll") for (int jj = 0; jj < 8; ++jj) fl = (lane == jj) ? f[jj] : fl; \
                fl = fl * rinv + bfg[lane]; \
                const float ls = fminf(fl, 0.f) - log1pf(expf(-fabsf(fl))); \
                LF[(size_t)r * 8 + lane] = ls * LOG2E; } } } while (0)
        f32x4 va[4], vb[4], vc[4];
        P0_LOAD(va, gw); P0_LOAD(vb, gw + NGW);
        for (int row = gw; row < TOT; row += 3 * NGW) {
            P0_LOAD(vc, row + 2 * NGW); P0_ROW(va, row);
            if (row + NGW < TOT) { P0_LOAD(va, row + 3 * NGW); P0_ROW(vb, row + NGW); }
            if (row + 2 * NGW < TOT) { P0_LOAD(vb, row + 4 * NGW); P0_ROW(vc, row + 2 * NGW); }
        }
#undef P0_LOAD
#undef P0_ROW
    }
    xcd_barrier(bar);
    if (PROBE_HI == 0) t_pb = __builtin_amdgcn_s_memrealtime();

    if (PROBE_LO == 1) t_pa = __builtin_amdgcn_s_memrealtime();
    if (PH(1))
    if (vcu < 32) {
        PHASE_PTRS
        const int b = vcu >> 2, h = (vcu & 3) * 2 + (wave >> 2), seg = wave & 3, s0 = seg * 2048 + lane * 32;
        const float* src = LF + ((size_t)b * SEQ + s0) * 8 + h;
        float p[32];
#pragma unroll
        for (int j = 0; j < 32; ++j) p[j] = src[j * 8];
#pragma unroll
        for (int j = 1; j < 32; ++j) p[j] += p[j - 1];
        float inc = p[31];
#pragma unroll
        for (int o = 1; o < 64; o <<= 1) { const float y = __shfl_up(inc, o); if (lane >= o) inc += y; }
        LAS float* tot = (LAS float*)(lds + EXTRA_OFF);
        if (lane == 63) tot[wave] = inc;
        __syncthreads();
        float off = inc - p[31];
        for (int q = 0; q < 3; ++q) if (q < seg) off += tot[(wave & 4) + q];
        float* dst = CC + ((size_t)b * NH + h) * SEQ + s0; bf16_t* kx = KX + (((size_t)b * NH + h) * SEQ + s0) * 8;
#pragma unroll
        for (int j = 0; j < 32; ++j) { const float x = off + p[j]; dst[j] = x;
            unsigned hm, lo; fox::split3(-x, hm, lo); u32x4 w; w.x = 0x3F803F80u; w.y = 0x3F80u | (hm << 16); w.z = (hm >> 16) | (lo << 16); w.w = 0u;
            *(u32x4*)(kx + j * 8) = w; }
        VM_WAIT(); __syncthreads();
    }
    if (PH(1))
    for (int rep_ = 0; rep_ < REPS(1); ++rep_)
    {
        PHASE_PTRS
        pg8::Gemm g{DM, DM, DM};
        SchedDense S{(const char*)XB, (const char*)Win_t, M / 256, NPROJ / 256, G, bx, (size_t)256 * DM * 2, (size_t)256 * DM * 2, 0, 2};
        LAS float* rst = (LAS float*)(lds + EXTRA_OFF);
#pragma unroll
        for (int q = 0; q < 8; ++q) { const int idx = tid + 512 * q, i = idx >> 8, r = idx & 255; int pm, pn; if (pg8::tile_order(i, G, bx, M / 256, NPROJ / 256, pm, pn)) rst[idx] = RX[pm * 256 + r]; }
        VM_WAIT(); __syncthreads();
        pg8::EpiBf16 E{QKV, HW, RX, QKV_STRIDE, C2, C2, ctl + CW_KN, rst, 1.f};
        pg8::gemm_phase<pg8::EpiBf16, SchedDense, true, false>(lds + RING_OFF, g, S, E);
    }
    xcd_barrier(bar);
    if (PROBE_HI == 1) t_pb = __builtin_amdgcn_s_memrealtime();

    if (PROBE_LO == 2) t_pa = __builtin_amdgcn_s_memrealtime();
    if (PH(2))
    {
        PHASE_PTRS
        const bf16_t* QA = QKV; const bf16_t* KA = QKV + QKV_STRIDE; const bf16_t* VA = QKV + 2 * QKV_STRIDE;
        const bf16_t* QBp = QKV + 3 * QKV_STRIDE; const bf16_t* KBp = QKV + 4 * QKV_STRIDE; const bf16_t* VBp = QKV + 5 * QKV_STRIDE;
        bf16_t* OA = OAB; bf16_t* OB = OAB + HW;
        LAS char* shm = (LAS char*)(lds + RING_OFF);
        { pg8::Gemm g{DM, DM, DM};
          SchedDense S2{(const char*)MEMB, (const char*)Wxkv_t, MEMROWS / 256, 2 * DM / 256, G, bx, (size_t)256 * DM * 2, (size_t)256 * DM * 2, 0, 0};
          pg8::EpiBf16 E2{KVM, 2 * DM, RMEM, 0, 1.f, 1.f, nullptr, nullptr, 1.f};
          pg8::gemm_phase<pg8::EpiBf16, SchedDense, true, false>(lds + RING_OFF, g, S2, E2);
          VM_WAIT(); __syncthreads(); }
        for (int rep = 0; rep < REP_FOX; ++rep)
        for (int i = 0; i < 8; ++i) { const int bh = (vcu >> 5) * 8 + i, x = vcu & 31, qb = (i & 1) ? 31 - x : x;
            const float kmax = sqrtf(__uint_as_float(ctl[CW_KN + bh * 2]) + __uint_as_float(ctl[CW_KN + bh * 2 + 1])) * 1.01f;
            const int nqb = ((i + 1) & 1) ? 31 - x : x;
            fox::fox_unit<8>(bh, qb, QA, KA, VA, OA, HS + (bh & 7), CC + (size_t)bh * SEQ, KX, kmax, shm, i > 0, i < 7 ? bh + 1 : -1, nqb); }
        { volatile LAS unsigned* qs = MISC + 16;
          unsigned nxt = 0u;
          if (tid == 0) qs[0] = __hip_atomic_fetch_add(ctl + CW_SBQ, 1u, __ATOMIC_RELAXED, __HIP_MEMORY_SCOPE_AGENT);
          __syncthreads();
          unsigned idx = qs[0];
          while (idx < (unsigned)(BATCH * NH * 32 * REP_SB)) {
              __syncthreads();
              if (tid == 0) nxt = __hip_atomic_fetch_add(ctl + CW_SBQ, 1u, __ATOMIC_RELAXED, __HIP_MEMORY_SCOPE_AGENT);
              const int un = (int)(idx % (unsigned)(BATCH * NH * 32)), bh = un >> 5, qb = un & 31;
              sbk::sb_unit(bh >> 3, bh & 7, qb, QBp, KBp, VBp, OB, HS + 8 + (bh & 7), shm);
              if (tid == 0) qs[0] = nxt;
              __syncthreads();
              idx = qs[0];
          } }
    }
    xcd_barrier(bar);
    if (PROBE_HI == 2) t_pb = __builtin_amdgcn_s_memrealtime();

    if (PROBE_LO == 4) t_pa = __builtin_amdgcn_s_memrealtime();
    if (PH(4))
    for (int rep_ = 0; rep_ < REPS(4); ++rep_)
    {
        PHASE_PTRS
        pg8::Gemm g{DM, DM, DM};
        SchedDense S{(const char*)OAB, (const char*)Wout_t, M / 256, DM / 256, G, bx, (size_t)256 * DM * 2, (size_t)256 * DM * 2, 0, 0};
        LAS f32x2* rab = (LAS f32x2*)(lds + EXTRA_OFF);
#pragma unroll
        for (int q = 0; q < 4; ++q) { const int idx = tid + 512 * q, i = idx >> 8, r = idx & 255; int pm, pn;
            if (pg8::tile_order(i, G, bx, M / 256, DM / 256, pm, pn)) { const f32x4* p = (const f32x4*)(HS + (size_t)(pm * 256 + r) * 16); const f32x4 a0 = p[0], a1 = p[1], b0 = p[2], b1 = p[3];
                const float ra = rsqrtf((((a0[0] + a0[1]) + (a0[2] + a0[3])) + ((a1[0] + a1[1]) + (a1[2] + a1[3]))) * (1.0f / HW) + EPS);
                const float rb = rsqrtf((((b0[0] + b0[1]) + (b0[2] + b0[3])) + ((b1[0] + b1[1]) + (b1[2] + b1[3]))) * (1.0f / HW) + EPS);
                rab[idx] = (f32x2){ra / rb, rb}; } }
        VM_WAIT(); __syncthreads();
        pg8::EpiOutProj E{XB, H1B, H1F8, SSQ, rab};
        pg8::gemm_phase<pg8::EpiOutProj, SchedDense, true, false>(lds + RING_OFF, g, S, E);
        pg8::Gemm g2{0, 0, 256};
        SchedGH SG{(const char*)KVM, (const char*)Wxq_n, (const char*)Wxo_t, G, bx};
        EpiGH EG{(unsigned char*)GT, (unsigned char*)HT};
        g2.lda = 2 * DM; g2.ldb = DM; SchedGHk<0> S0{SG}; pg8::gemm_phase<EpiGH, SchedGHk<0>, true, false>(lds + RING_OFF, g2, S0, EG);
        g2.lda = DM; g2.ldb = 2 * DM; SchedGHk<1> S1{SG}; pg8::gemm_phase<EpiGH, SchedGHk<1>, true, false>(lds + RING_OFF, g2, S1, EG);
    }
    xcd_barrier(bar);
    if (PROBE_HI == 4) t_pb = __builtin_amdgcn_s_memrealtime();

    if (PROBE_LO == 5) t_pa = __builtin_amdgcn_s_memrealtime();
    if (PH(5))
    for (int rep_ = 0; rep_ < REPS(5); ++rep_)
    {
        PHASE_PTRS
        pg8::Gemm g{DM, DM, DM};
        SchedDense S{(const char*)H1F8, (const char*)GT, M / 256, DM / 256, G, bx, (size_t)256 * DM, (size_t)256 * DM, (size_t)DM * DM, 0};
        LAS float* r1t = (LAS float*)(lds + EXTRA_OFF + 8192);
#pragma unroll
        for (int q = 0; q < 4; ++q) { const int idx = tid + 512 * q, i = idx >> 8, r = idx & 255; int pm, pn;
            if (pg8::tile_order(i, G, bx, M / 256, DM / 256, pm, pn)) { const f32x4* sp = (const f32x4*)(SSQ + (size_t)(pm * 256 + r) * 16); const f32x4 s0 = sp[0], s1 = sp[1], s2 = sp[2], s3 = sp[3];
                const float tot = ((s0[0] + s0[1]) + (s0[2] + s0[3])) + ((s1[0] + s1[1]) + (s1[2] + s1[3])) + ((s2[0] + s2[1]) + (s2[2] + s2[3])) + ((s3[0] + s3[1]) + (s3[2] + s3[3]));
                r1t[idx] = rsqrtf(tot * (1.0f / DM) + EPS) * XSC; } }
        VM_WAIT(); __syncthreads();
        pg8::EpiSoftmax E{XB, r1t, (LAS float*)(lds + EXTRA_OFF)};
        pg8::gemm_phase<pg8::EpiSoftmax, SchedDense, true, false, true>(lds + RING_OFF, g, S, E);
    }
    xcd_barrier(bar);
    if (PROBE_HI == 5) t_pb = __builtin_amdgcn_s_memrealtime();

    if (PROBE_LO == 6) t_pa = __builtin_amdgcn_s_memrealtime();
    if (PH(6))
    {
        PHASE_PTRS
        pg8::Gemm g{DM, DM, DM};
        SchedDense S{(const char*)XB, (const char*)HT, M / 256, DM / 256, G, bx, (size_t)256 * DM, (size_t)256 * DM, (size_t)DM * DM, 0};
        pg8::EpiResidBf16 E{H1B, H2F8, 1.0f / P_SCALE};
        pg8::gemm_phase<pg8::EpiResidBf16, SchedDense, true, false, true>(lds + RING_OFF, g, S, E);
    }
    xcd_barrier(bar);
    if (PROBE_HI == 6) t_pb = __builtin_amdgcn_s_memrealtime();

    if (PROBE_LO == 7) t_pa = __builtin_amdgcn_s_memrealtime();
    if (PH(7))
    {
        PHASE_PTRS
        LAS bf16_t* wBh = (LAS bf16_t*)(lds + RING_OFF); LAS bf16_t* wBl = wBh + 20 * DM;
        { const f32x4* wg4 = (const f32x4*)ARGP(w_rg); const f32x4* we4 = (const f32x4*)ARGP(w_re); const float* gf = ARGP(norm_ffn);
          f32x4 ga[2], ea[2][4]; float gk[2];
#pragma unroll
          for (int q = 0; q < 2; ++q) { const int k = tid + 512 * q; ga[q] = wg4[k]; gk[q] = gf[k];
#pragma unroll
              for (int c = 0; c < 4; ++c) ea[q][c] = we4[k * 4 + c]; }
#pragma unroll
          for (int q = 0; q < 2; ++q) { const int k = tid + 512 * q;
#pragma unroll
              for (int j = 0; j < 4; ++j) { { const float v = ga[q][j] * gk[q]; const unsigned hi_ = cvt_pk_bf16(v, 0.f) & 0xffffu; wBh[j * DM + k] = (bf16_t)hi_; wBl[j * DM + k] = (bf16_t)(cvt_pk_bf16(v - __uint_as_float(hi_ << 16), 0.f) & 0xffffu); }
#pragma unroll
                  for (int c = 0; c < 4; ++c) { const float v = ea[q][c][j] * gk[q]; const unsigned hi_ = cvt_pk_bf16(v, 0.f) & 0xffffu; const int col = 4 + 4 * c + j; wBh[col * DM + k] = (bf16_t)hi_; wBl[col * DM + k] = (bf16_t)(cvt_pk_bf16(v - __uint_as_float(hi_ << 16), 0.f) & 0xffffu); } } } }
        LAS int* dec_e = (LAS int*)(lds + RING_OFF + 81920); LAS float* dec_w = (LAS float*)(lds + RING_OFF + 81920 + 2048); LAS int* dec_r = (LAS int*)(lds + RING_OFF + 81920 + 4096);
        LAS int* hist = (LAS int*)(lds + RING_OFF + 81920 + 6144); LAS int* ebase = hist + 16; LAS float* dec_v = (LAS float*)(lds + RING_OFF + 81920 + 8192);
        if (tid < 16) hist[tid] = 0;
        __syncthreads();
        const float brg0 = ARGP(b_rg)[0], brg1 = ARGP(b_rg)[1], brg2 = ARGP(b_rg)[2], brg3 = ARGP(b_rg)[3]; const float* bre = ARGP(b_re);
        const int tok = lane & 31, half = lane >> 5, jcol = tok < 20 ? tok : 19;
        for (int it = 0; it * NGW < M / 32; ++it) {
            const int T = gw + it * NGW; const bool act = T < M / 32; const int r0 = act ? 32 * T : 0;
            const bf16_t* rowp = H1B + (size_t)(r0 + tok) * DM + 512 * half;
            const LAS bf16_t* wph = wBh + jcol * DM + 512 * half; const LAS bf16_t* wpl = wBl + jcol * DM + 512 * half;
            f32x16 ah0 = f32x16{}, ah1 = f32x16{}, al0 = f32x16{}, al1 = f32x16{}; float ssq = 0.f;
#pragma unroll 4
            for (int sidx = 0; sidx < 64; sidx += 2) {
                const u32x4 a0 = *(const u32x4*)(rowp + 8 * sidx), a1 = *(const u32x4*)(rowp + 8 * sidx + 8);
                const bf16x8 wh0 = *(const LAS bf16x8*)(wph + 8 * sidx), wl0 = *(const LAS bf16x8*)(wpl + 8 * sidx), wh1 = *(const LAS bf16x8*)(wph + 8 * sidx + 8), wl1 = *(const LAS bf16x8*)(wpl + 8 * sidx + 8);
                ah0 = MFMA32(wh0, __builtin_bit_cast(bf16x8, a0), ah0); al0 = MFMA32(wl0, __builtin_bit_cast(bf16x8, a0), al0);
                ah1 = MFMA32(wh1, __builtin_bit_cast(bf16x8, a1), ah1); al1 = MFMA32(wl1, __builtin_bit_cast(bf16x8, a1), al1);
                ssq += (bf16lo(a0.x) * bf16lo(a0.x) + bf16hi(a0.x) * bf16hi(a0.x)) + (bf16lo(a0.y) * bf16lo(a0.y) + bf16hi(a0.y) * bf16hi(a0.y)) + (bf16lo(a0.z) * bf16lo(a0.z) + bf16hi(a0.z) * bf16hi(a0.z)) + (bf16lo(a0.w) * bf16lo(a0.w) + bf16hi(a0.w) * bf16hi(a0.w));
                ssq += (bf16lo(a1.x) * bf16lo(a1.x) + bf16hi(a1.x) * bf16hi(a1.x)) + (bf16lo(a1.y) * bf16lo(a1.y) + bf16hi(a1.y) * bf16hi(a1.y)) + (bf16lo(a1.z) * bf16lo(a1.z) + bf16hi(a1.z) * bf16hi(a1.z)) + (bf16lo(a1.w) * bf16lo(a1.w) + bf16hi(a1.w) * bf16hi(a1.w));
            }
            const float rinv = rsqrtf((att::swap_lo(ssq) + att::swap_hi(ssq)) * (1.0f / DM) + EPS);
            float lg[20];
#pragma unroll
            for (int r = 0; r < 12; ++r) { const float c = (ah0[r] + ah1[r]) + (al0[r] + al1[r]); auto rr = __builtin_amdgcn_permlane32_swap(__float_as_uint(c), __float_as_uint(c), false, false);
                const int jl = (r & 3) + 8 * (r >> 2); lg[jl] = __uint_as_float(rr[0]) * rinv; if (r < 8) lg[jl + 4] = __uint_as_float(rr[1]) * rinv; }
            float g0 = lg[0] + brg0, g1 = lg[1] + brg1, g2 = lg[2] + brg2, g3 = lg[3] + brg3;
            int gi = 0; float gm = g0; if (g1 > gm) { gm = g1; gi = 1; } if (g2 > gm) { gm = g2; gi = 2; } if (g3 > gm) { gm = g3; gi = 3; }
            const float gval = 1.0f / (expf(g0 - gm) + expf(g1 - gm) + expf(g2 - gm) + expf(g3 - gm));
            float el[4];
#pragma unroll
            for (int j = 0; j < 4; ++j) { const float e0 = lg[4 + j], e1 = lg[8 + j], e2 = lg[12 + j], e3 = lg[16 + j]; el[j] = ((gi == 0) ? e0 : (gi == 1) ? e1 : (gi == 2) ? e2 : e3) + bre[gi * 4 + j]; }
            int i0 = 0; float m0 = el[0];
#pragma unroll
            for (int j = 1; j < 4; ++j) if (el[j] > m0) { m0 = el[j]; i0 = j; }
            int i1 = -1; float m1 = -3.0e38f;
#pragma unroll
            for (int j = 0; j < 4; ++j) if (j != i0 && el[j] > m1) { m1 = el[j]; i1 = j; }
            const float w0 = 1.0f / (1.0f + expf(m1 - m0)), w1 = 1.0f - w0;
            if (act) { const int e = gi * 4 + (half == 0 ? i0 : i1); const float w = gval * (half == 0 ? w0 : w1);
                const int idx = (wave * 32 + tok) * 2 + half; dec_e[idx] = e; dec_w[idx] = w; dec_v[idx] = rinv; dec_r[idx] = __hip_atomic_fetch_add(hist + e, 1, __ATOMIC_RELAXED, __HIP_MEMORY_SCOPE_WORKGROUP); }
            __syncthreads();
            if (tid < 16) { const int n = hist[tid]; ebase[tid] = n ? (int)__hip_atomic_fetch_add(ctl + CW_CNT + 64 * tid, (unsigned)n, __ATOMIC_RELAXED, __HIP_MEMORY_SCOPE_AGENT) : 0; }
            __syncthreads();
            if (act) { const int row = r0 + (lane >> 1), idx = wave * 64 + lane; const int e = dec_e[idx], pos = ebase[e] + dec_r[idx];
                LIST[(size_t)e * M + pos] = row; R2S[(size_t)e * M + pos] = dec_v[idx]; TOKSLOT[(size_t)row * 2 + (lane & 1)] = (e << 20) | pos; TOKW[(size_t)row * 2 + (lane & 1)] = dec_w[idx]; }
            __syncthreads();
            if (tid < 16) hist[tid] = 0;
            __syncthreads();
        }
    }
    xcd_barrier(bar);
    if (PROBE_HI == 7) t_pb = __builtin_amdgcn_s_memrealtime();

    if (PROBE_LO == 8) t_pa = __builtin_amdgcn_s_memrealtime();
    if (PH(8))
    for (int rep_ = 0; rep_ < REPS(8); ++rep_)
    {
        PHASE_PTRS
        pg8::Gemm g{DM, DM, DM};
        LAS int* tbl = (LAS int*)(lds + EXTRA_OFF + 8192); moe_table(tbl, ctl);
        SchedMoe S; S.A = (const char*)H2F8; S.W = (const char*)Wgu_t; S.list = LIST; S.tbl = tbl; S.G = G; S.c = bx; S.NPN = 2; S.w_exp = (size_t)512 * DM; S.w_tile = (size_t)256 * DM; S.a_tile = 0; S.ocol_w = 128;
        pg8::EpiSwiglu E{HID, R2S, LIST};
        pg8::gemm_phase<pg8::EpiSwiglu, SchedMoe, true, true, true>(lds + RING_OFF, g, S, E);
    }
    xcd_barrier(bar);
    if (PROBE_HI == 8) t_pb = __builtin_amdgcn_s_memrealtime();

    if (PROBE_LO == 9) t_pa = __builtin_amdgcn_s_memrealtime();
    if (PH(9))
    for (int rep_ = 0; rep_ < REPS(9); ++rep_)
    {
        PHASE_PTRS
        pg8::Gemm g{DFF, DFF, DFF};
        LAS int* tbl = (LAS int*)(lds + EXTRA_OFF + 8192);
        SchedMoe S; S.A = (const char*)HID; S.W = (const char*)Wd_t; S.list = LIST; S.tbl = tbl; S.G = G; S.c = bx; S.NPN = 4; S.w_exp = (size_t)DM * DFF; S.w_tile = (size_t)256 * DFF; S.a_tile = (size_t)256 * DFF; S.ocol_w = 256;
        pg8::EpiY8 E{(unsigned char*)YB, 1.0f / WD_SCALE};
        pg8::gemm_phase<pg8::EpiY8, SchedMoe, true, false, true>(lds + RING_OFF, g, S, E);
    }
    xcd_barrier(bar);
    if (PROBE_HI == 9) t_pb = __builtin_amdgcn_s_memrealtime();

    if (PROBE_LO == 10) t_pa = __builtin_amdgcn_s_memrealtime();
    if (PH(10))
    {
        PHASE_PTRS
        const LAS int* tb = (const LAS int*)(lds + EXTRA_OFF + 8192);
        const f32x4* gp = (const f32x4*)ARGP(norm_final) + lane;
        int sl0 = 0, sl1 = 0; float sw0 = 0.f, sw1 = 0.f;
        unsigned ya_n[4], yb_n[4]; u32x2 hh_n[4]; float w0_n = 0.f, w1_n = 0.f;
#define P10_SLOTS(rw) do { sl0 = TOKSLOT[(size_t)(rw) * 2]; sl1 = TOKSLOT[(size_t)(rw) * 2 + 1]; sw0 = TOKW[(size_t)(rw) * 2]; sw1 = TOKW[(size_t)(rw) * 2 + 1]; } while (0)
#define P10_DATA(rw) do { const int r0_ = tb[sl0 >> 20] * 256 + (sl0 & 0xfffff), r1_ = tb[sl1 >> 20] * 256 + (sl1 & 0xfffff); w0_n = sw0; w1_n = sw1; \
        const unsigned* y0_ = (const unsigned*)((const unsigned char*)YB + (size_t)r0_ * DM) + lane; const unsigned* y1_ = (const unsigned*)((const unsigned char*)YB + (size_t)r1_ * DM) + lane; const u32x2* h_ = (const u32x2*)(H1B + (size_t)(rw) * DM) + lane; \
        _Pragma("unroll") for (int j = 0; j < 4; ++j) { ya_n[j] = y0_[64 * j]; yb_n[j] = y1_[64 * j]; hh_n[j] = h_[64 * j]; } } while (0)
        if (gw < M) { P10_SLOTS(gw); P10_DATA(gw); if (gw + NGW < M) P10_SLOTS(gw + NGW); }
        for (int row = gw; row < M; row += NGW) {
            unsigned ya[4], yb[4]; u32x2 hh[4]; const float w0 = w0_n, w1 = w1_n;
#pragma unroll
            for (int j = 0; j < 4; ++j) { ya[j] = ya_n[j]; yb[j] = yb_n[j]; hh[j] = hh_n[j]; }
            if (row + NGW < M) { P10_DATA(row + NGW); if (row + 2 * NGW < M) P10_SLOTS(row + 2 * NGW); }
            f32x4* hr = (f32x4*)(out + (size_t)row * DM) + lane;
            f32x4 v[4]; float s = 0.f;
#pragma unroll
            for (int j = 0; j < 4; ++j) { const u32x2 hx = hh[j]; f32x4 h = {bf16lo(hx.x), bf16hi(hx.x), bf16lo(hx.y), bf16hi(hx.y)};
                const f32x2 a01 = __builtin_amdgcn_cvt_pk_f32_fp8((int)ya[j], false), a23 = __builtin_amdgcn_cvt_pk_f32_fp8((int)ya[j], true), b01 = __builtin_amdgcn_cvt_pk_f32_fp8((int)yb[j], false), b23 = __builtin_amdgcn_cvt_pk_f32_fp8((int)yb[j], true);
                h[0] += w0 * a01[0] + w1 * b01[0]; h[1] += w0 * a01[1] + w1 * b01[1]; h[2] += w0 * a23[0] + w1 * b23[0]; h[3] += w0 * a23[1] + w1 * b23[1];
                v[j] = h; s += (h[0] * h[0] + h[1] * h[1]) + (h[2] * h[2] + h[3] * h[3]); }
            const float rinv = rsqrtf(wave_sum(s) * (1.0f / DM) + EPS);
#pragma unroll
            for (int j = 0; j < 4; ++j) __builtin_nontemporal_store(v[j] * rinv * gp[64 * j], hr + 64 * j);
        }
#undef P10_SLOTS
#undef P10_DATA
    }
    if (PROBE_LO >= 0) {
        if (PROBE_HI == 10) t_pb = __builtin_amdgcn_s_memrealtime();
        if (blockIdx.x == 0 && threadIdx.x == 0) { const unsigned long long t0 = __builtin_amdgcn_s_memrealtime(), span = 2 * (t_pb - t_pa);
            while (__builtin_amdgcn_s_memrealtime() - t0 < span) __builtin_amdgcn_s_sleep(8); }
    }
}

extern "C" void kernel_launch(void* const* d_in, const int* in_sizes, int n_in, void* d_out, int out_size, void* d_ws, size_t ws_size, hipStream_t stream) {
    static int grid = 0;
    if (grid == 0) {
        if (n_in != 22 || in_sizes[0] != M * DM || out_size != M * DM || ws_size < WS_END) { fprintf(stderr, "kernel_launch: unexpected shapes (n_in %d, in0 %d, out %d, ws %zu)\n", n_in, n_in > 0 ? in_sizes[0] : -1, out_size, ws_size); grid = -1; return; }
        int dev = 0, cus = 0, per_cu = 0;
        if (hipGetDevice(&dev) != hipSuccess || hipDeviceGetAttribute(&cus, hipDeviceAttributeMultiprocessorCount, dev) != hipSuccess) { grid = -1; return; }
        if (hipFuncSetAttribute((const void*)hymba_fwd, hipFuncAttributeMaxDynamicSharedMemorySize, LDS_BYTES) != hipSuccess) { fprintf(stderr, "kernel_launch: hipFuncSetAttribute failed\n"); grid = -1; return; }
        if (hipOccupancyMaxActiveBlocksPerMultiprocessor(&per_cu, (const void*)hymba_fwd, NWAVES * 64, LDS_BYTES) != hipSuccess || per_cu < 1) { fprintf(stderr, "kernel_launch: occupancy query reports %d\n", per_cu); }
        (void)hipGetLastError();
        grid = cus;
    }
    if (grid < 0) return;
    (void)hipMemsetAsync((char*)d_ws + WS_CTL, 0, CTL_ZERO_BYTES, stream);
    Args a{};
    const float** p = (const float**)&a;
    for (int i = 0; i < 22; ++i) p[i] = (const float*)d_in[i];
    a.out = (float*)d_out; a.ws = (unsigned char*)d_ws;
    hipLaunchKernelGGL(hymba_fwd, dim3(grid), dim3(NWAVES * 64), LDS_BYTES, stream, a);
}
```

```cpp
#include <hip/hip_runtime.h>
#include <hip/hip_bf16.h>
#include <cstdio>
#include <cstdint>

#define LAS __attribute__((address_space(3)))
#define GAS __attribute__((address_space(1)))
typedef unsigned short bf16_t;
typedef short bf16x8 __attribute__((ext_vector_type(8)));
typedef short s16x4 __attribute__((ext_vector_type(4)));
typedef float f32x4 __attribute__((ext_vector_type(4)));
typedef float f32x2 __attribute__((ext_vector_type(2)));
typedef float f32x16 __attribute__((ext_vector_type(16)));
typedef unsigned u32x4 __attribute__((ext_vector_type(4)));
typedef unsigned u32x2 __attribute__((ext_vector_type(2)));
typedef __bf16 bf16x2_t __attribute__((ext_vector_type(2)));

constexpr int BATCH = 8, SEQ = 8192, DM = 1024, M = BATCH * SEQ;
constexpr int NH = 8, HD = 64, HW = NH * HD;
constexpr int NPROJ = 3 * HW * 2;
constexpr int WIN_LD = NPROJ + NH;
constexpr int NMEM = 256, XH = 4, XD = 256, MEMROWS = BATCH * NMEM;
constexpr int NEXP = 16, DFF = 256;
constexpr float EPS = 1e-6f;
constexpr float LOG2E = 1.4426950408889634f;
constexpr float C2 = 0.125f * LOG2E;
constexpr float XSC = 0.0625f * LOG2E;
constexpr float P_SCALE = 128.0f;
constexpr float WGU_SCALE = 32.0f;
constexpr float WD_SCALE = 16.0f;
constexpr float SB_EXIT = -40.0f;

constexpr size_t MiB = 1u << 20;
constexpr size_t WS_CTL = 0, CTL_ZERO_BYTES = 128 * 1024;
constexpr size_t WS_WIN = 1 * MiB;
constexpr size_t WS_WOUT = 7 * MiB;
constexpr size_t WS_WXQ = 9 * MiB;
constexpr size_t WS_WXKV = 11 * MiB;
constexpr size_t WS_WXO = 15 * MiB;
constexpr size_t WS_WGU = 17 * MiB;
constexpr size_t WS_WD = 33 * MiB;
constexpr size_t WS_RX = 41 * MiB;
constexpr size_t WS_RMEM = WS_RX + 256 * 1024;
constexpr size_t WS_R2 = WS_RX + 512 * 1024;
constexpr size_t WS_LF = 42 * MiB;
constexpr size_t WS_C2 = 44 * MiB;
constexpr size_t WS_SSQ = 46 * MiB;
constexpr size_t WS_TOKSLOT = 50 * MiB;
constexpr size_t WS_TOKW = 51 * MiB;
constexpr size_t WS_LIST = 52 * MiB;
constexpr size_t WS_MEMB = 56 * MiB;
constexpr size_t WS_KVM = 60 * MiB;
constexpr size_t WS_GT = 68 * MiB;
constexpr size_t WS_HT = 84 * MiB;
constexpr size_t WS_KX = 100 * MiB;
constexpr size_t WS_HS = 108 * MiB;
constexpr size_t WS_XB = 128 * MiB;
constexpr size_t WS_QKV = 256 * MiB;
constexpr size_t WS_H1B = 256 * MiB, WS_U2B = 384 * MiB, WS_HID = 512 * MiB;
constexpr size_t WS_H1F8 = 384 * MiB, WS_H2F8 = 448 * MiB;
constexpr size_t WS_O = 640 * MiB;
constexpr size_t WS_Y = 704 * MiB;
constexpr size_t WS_END = 1024 * MiB;
constexpr size_t QKV_STRIDE = (size_t)M * HW;
constexpr int MAXTILES = M * 2 / 256 + NEXP;
static_assert(WS_Y + (size_t)MAXTILES * 256 * 1024 * 2 <= WS_END, "ws map");
static_assert(WS_HID + (size_t)MAXTILES * 256 * 256 * 2 <= WS_O, "ws map");
constexpr int CW_BAR = 4096;
constexpr int CW_SBQ = 20736;
constexpr int CW_KN = 20480;
constexpr int CW_CNT = 16384;

constexpr int RING_OFF = 0, RING_BYTES = 131072;
constexpr int EXTRA_OFF = 131072, EXTRA_BYTES = 16384;
constexpr int MISC_OFF = EXTRA_OFF + EXTRA_BYTES;
constexpr int LDS_BYTES = MISC_OFF + 1024;
constexpr int NWAVES = 8;
#ifndef PHASE_MASK
#define PHASE_MASK 0x7ff
#endif
#define PH(n) ((PHASE_MASK >> (n)) & 1)
#ifndef PROBE_LO
#define PROBE_LO -1
#endif
#ifndef PROBE_HI
#define PROBE_HI -1
#endif
#ifndef REP_MASK
#define REP_MASK 0
#endif
#define REPS(n) (1 + ((REP_MASK >> (n)) & 1))
#ifndef REP_FOX
#define REP_FOX 1
#endif
#ifndef REP_SB
#define REP_SB 1
#endif

__device__ __forceinline__ unsigned cvt_pk_bf16(float lo, float hi) { f32x2 v = {lo, hi}; bf16x2_t b = __builtin_convertvector(v, bf16x2_t); return __builtin_bit_cast(unsigned, b); }
__device__ __forceinline__ unsigned cvt4_fp8(float a, float b, float c, float d) { int w = 0; w = __builtin_amdgcn_cvt_pk_fp8_f32(a, b, w, false); w = __builtin_amdgcn_cvt_pk_fp8_f32(c, d, w, true); return (unsigned)w; }
__device__ __forceinline__ u32x4 widen16(u32x2 a, u32x2 b) {
    const auto r0 = __builtin_amdgcn_permlane16_swap(a.x, b.x, false, false); const auto r1 = __builtin_amdgcn_permlane16_swap(a.y, b.y, false, false);
    return (u32x4){r0[0], r1[0], r0[1], r1[1]};
}
__device__ __forceinline__ float bf16lo(unsigned u) { return __uint_as_float(u << 16); }
__device__ __forceinline__ float bf16hi(unsigned u) { return __uint_as_float(u & 0xffff0000u); }
#define DPP_ADD(v, CTRL) v += __builtin_bit_cast(float, __builtin_amdgcn_update_dpp(0, __builtin_bit_cast(int, v), CTRL, 0xf, 0xf, true))
#define DPP_MOV(v, CTRL) __builtin_bit_cast(float, __builtin_amdgcn_update_dpp(0, __builtin_bit_cast(int, (v)), CTRL, 0xf, 0xf, true))
__device__ __forceinline__ float wave_sum(float v) {
    DPP_ADD(v, 0xB1); DPP_ADD(v, 0x4E); DPP_ADD(v, 0x141); DPP_ADD(v, 0x140);
    const int iv = __builtin_bit_cast(int, v);
    return (__builtin_bit_cast(float, __builtin_amdgcn_readlane(iv, 0)) + __builtin_bit_cast(float, __builtin_amdgcn_readlane(iv, 16))) +
           (__builtin_bit_cast(float, __builtin_amdgcn_readlane(iv, 32)) + __builtin_bit_cast(float, __builtin_amdgcn_readlane(iv, 48)));
}
#define LDS_WAIT() asm volatile("s_waitcnt lgkmcnt(0)" ::: "memory")
#define VM_WAIT() asm volatile("s_waitcnt vmcnt(0)" ::: "memory")

namespace pg8 {
constexpr int BM = 256, BK = 64, HALF = 128, HTB = HALF * BK * 2, STAGE_BYTES = 8 * HTB, NXCD = 8, WGM = 8;
__host__ __device__ __forceinline__ int lds_byte(int r, int c) { const int st = (r >> 4) * 2 + (c >> 5), rr = r & 15, cc = c & 31, ob = rr * 64 + cc * 2; return st * 1024 + (ob ^ (((ob >> 9) & 1) << 5)); }
__host__ __device__ __forceinline__ void stage_rc(int b, int& R, int& C) { const int st = b / 1024, sb = b % 1024, swz = sb ^ (((sb >> 9) & 1) << 5); R = (st >> 1) * 16 + swz / 64; C = (st & 1) * 32 + (swz % 64) / 2; }
__host__ __device__ __forceinline__ int perm32(int rho) { const int n = rho >> 4, i = rho & 15; return 8 * (i >> 2) + 4 * n + (i & 3); }

struct Unit { const char* a; const char* b; int orow, ocol, aux; const int* rows; int nvalid; int seq; };
struct Gemm { int lda, ldb, K; };

__device__ __forceinline__ bool tile_order(int i, int G, int c, int nM, int nN, int& pm, int& pn) {
    const int nwg = nM * nN; const long L = (long)i * G + c; if (L >= nwg) return false;
    int wgid = (int)L; { const int q = nwg / NXCD, r = nwg % NXCD, xcd = wgid % NXCD, off = wgid / NXCD; wgid = (xcd < r ? xcd * (q + 1) : r * (q + 1) + (xcd - r) * q) + off; }
    const int nig = WGM * nN, gid = wgid / nig, fm = gid * WGM, gsz = (nM - fm) < WGM ? (nM - fm) : WGM;
    pm = fm + ((wgid % nig) % gsz); pn = (wgid % nig) / gsz; return true;
}

typedef int v8i32 __attribute__((ext_vector_type(8)));
template <class Epi, class Sched, bool ALIGN_EPI, bool GATHER, bool FP8 = false>
__device__ __forceinline__ void gemm_phase(LAS unsigned char* lds, const Gemm g, const Sched& S, const Epi& E) {
    int tid = threadIdx.x; asm volatile("" : "+v"(tid));
    const int wid = __builtin_amdgcn_readfirstlane(tid >> 6), lane = tid & 63, wr = wid >> 2, wc = wid & 3, fr = lane & 15, fq = lane >> 4;
    constexpr int ESZ = FP8 ? 1 : 2;
    const int K = g.K, nt = K / (FP8 ? 2 * BK : BK);
    unsigned voffA[2], voffB[2]; int RA[2], CA[2];
#pragma unroll
    for (int i = 0; i < 2; ++i) { int R, C; stage_rc(tid * 16 + i * 8192, R, C); const int Rb = (R & ~31) + perm32(R & 31);
        RA[i] = R; CA[i] = C; voffA[i] = (unsigned)(R * g.lda * ESZ + C * 2); voffB[i] = (unsigned)(Rb * g.ldb * ESZ + C * 2); }
    const size_t kstep = (size_t)(BK * 2);
    const size_t hstepA = (size_t)HALF * g.lda * ESZ, hstepB = (size_t)HALF * g.ldb * ESZ;
    const unsigned ldsw = (unsigned)wid * 1024u; const unsigned ldsu = (unsigned)(uintptr_t)lds;
    const int aoff = lds_byte(wr * 64 + fr, FP8 ? fq * 16 : fq * 8), boff = lds_byte(wc * 32 + fr, FP8 ? fq * 16 : fq * 8);
    constexpr int KOFF = FP8 ? 16 : 1024;
#define PG8_SA(b, h) (((b) * 2 + (h)) * HTB)
#define PG8_SB(b, h) ((4 + (b) * 2 + (h)) * HTB)
#define PG8_GLDS(sbase, voff, ldsdst) asm volatile("s_mov_b32 m0, %2\n\ts_nop 0\n\tglobal_load_lds_dwordx4 %0, %1" :: "v"(voff), "s"(sbase), "s"(ldsdst) : "memory", "m0")
#define PG8_STAGE2(bufoff, gbase, v0, v1) do { const unsigned ld_ = (unsigned)__builtin_amdgcn_readfirstlane((int)(ldsu + (unsigned)(bufoff) + ldsw)); \
        PG8_GLDS((const char*)(gbase), (v0), ld_); PG8_GLDS((const char*)(gbase), (v1), ld_ + 8192u); } while (0)
#define PG8_STAGEB(bufoff, gbase) PG8_STAGE2(bufoff, gbase, voffB[0], voffB[1])
#define PG8_STAGEA(bufoff, kptr, h, NX) do { if constexpr (GATHER) { const unsigned v0_ = (NX) ? gvn[h][0] : gvc[h][0], v1_ = (NX) ? gvn[h][1] : gvc[h][1]; PG8_STAGE2(bufoff, kptr, v0_, v1_); } \
        else { PG8_STAGE2(bufoff, (kptr) + (h) * hstepA, voffA[0], voffA[1]); } } while (0)
#define PG8_LDA(dst, b, h) do { _Pragma("unroll") for (int m = 0; m < 4; ++m) _Pragma("unroll") for (int k = 0; k < 2; ++k) dst[m][k] = *(const LAS bf16x8*)(lds + PG8_SA(b, h) + aoff + m * 2048 + k * KOFF); } while (0)
#define PG8_LDB(dst, b, h) do { _Pragma("unroll") for (int n = 0; n < 2; ++n) _Pragma("unroll") for (int k = 0; k < 2; ++k) dst[n][k] = *(const LAS bf16x8*)(lds + PG8_SB(b, h) + boff + n * 2048 + k * KOFF); } while (0)
#define PG8_CAT(x) __builtin_shufflevector(__builtin_bit_cast(f32x4, (x)[0]), __builtin_bit_cast(f32x4, (x)[1]), 0, 1, 2, 3, 4, 5, 6, 7)
#define PG8_MMA(ai, bj, At, Bt) do { __builtin_amdgcn_s_setprio(1); _Pragma("unroll") for (int m = 0; m < 4; ++m) _Pragma("unroll") for (int n = 0; n < 2; ++n) { \
        if constexpr (FP8) { acc[ai][bj][m][n] = __builtin_amdgcn_mfma_scale_f32_16x16x128_f8f6f4(__builtin_bit_cast(v8i32, PG8_CAT(Bt[n])), __builtin_bit_cast(v8i32, PG8_CAT(At[m])), acc[ai][bj][m][n], 0, 0, 0, 0x7F7F7F7F, 0, 0x7F7F7F7F); } \
        else { _Pragma("unroll") for (int k = 0; k < 2; ++k) acc[ai][bj][m][n] = __builtin_amdgcn_mfma_f32_16x16x32_bf16(Bt[n][k], At[m][k], acc[ai][bj][m][n], 0, 0, 0); } } \
        _Pragma("unroll") for (int m = 0; m < 4; ++m) _Pragma("unroll") for (int n = 0; n < 2; ++n) asm volatile("" : "+v"(acc[ai][bj][m][n]));     \
        __builtin_amdgcn_s_setprio(0); } while (0)
#define PG8_WAIT_V(n) asm volatile("s_waitcnt vmcnt(" #n ")" ::: "memory")
#define PG8_WAIT_L(n) asm volatile("s_waitcnt lgkmcnt(" #n ")" ::: "memory")
#define PG8_BAR __builtin_amdgcn_s_barrier()
#define PG8_SCHED __builtin_amdgcn_sched_barrier(0)
#define PG8_GATHER_OFFS(dst, u) do { _Pragma("unroll") for (int h_ = 0; h_ < 2; ++h_) _Pragma("unroll") for (int i_ = 0; i_ < 2; ++i_) { const int r_ = h_ * HALF + RA[i_]; \
        const int idx_ = (u).rows[r_ < (u).nvalid ? r_ : 0]; dst[h_][i_] = (unsigned)(idx_ * g.lda * ESZ + CA[i_] * 2); } } while (0)
    Unit cur, nxt; int ui = 0;
    if (!S.next(0, cur)) return;
    cur.seq = 0;
    unsigned gvc[2][2] = {{0u, 0u}, {0u, 0u}}, gvn[2][2] = {{0u, 0u}, {0u, 0u}};
    if constexpr (GATHER) { PG8_GATHER_OFFS(gvc, cur); }
    f32x4 acc[2][2][4][2];
#pragma unroll
    for (int a = 0; a < 2; ++a)
#pragma unroll
        for (int b = 0; b < 2; ++b)
#pragma unroll
            for (int m = 0; m < 4; ++m)
#pragma unroll
                for (int n = 0; n < 2; ++n) acc[a][b][m][n] = (f32x4){0.f, 0.f, 0.f, 0.f};
    bf16x8 At[4][2], B0[2][2], B1[2][2];
    const char* cA = cur.a; const char* cB = cur.b;
    PG8_STAGEB(PG8_SB(0, 0), cB); PG8_STAGEB(PG8_SB(0, 1), cB + hstepB); PG8_STAGEA(PG8_SA(0, 0), cA, 0, false); PG8_STAGEA(PG8_SA(0, 1), cA, 1, false);
    if (wr == 1) PG8_BAR;
    PG8_WAIT_V(2); PG8_BAR;
    PG8_STAGEB(PG8_SB(1, 0), cB + kstep); PG8_STAGEA(PG8_SA(1, 0), cA + kstep, 0, false); PG8_STAGEB(PG8_SB(1, 1), cB + hstepB + kstep);
    PG8_WAIT_V(6); PG8_BAR;
    for (;;) {
        const bool has_next = S.next(ui + 1, nxt); nxt.seq = ui + 1;
        const char* nA = has_next ? nxt.a : cA; const char* nB = has_next ? nxt.b : cB;
        if constexpr (GATHER) { if (has_next) { PG8_GATHER_OFFS(gvn, nxt); } else { gvn[0][0] = gvc[0][0]; gvn[0][1] = gvc[0][1]; gvn[1][0] = gvc[1][0]; gvn[1][1] = gvc[1][1]; } }
#pragma unroll 1
        for (int t = 0; t < nt; t += 2) {
            const bool last = (t == nt - 2);
            const char* a1 = cA + (size_t)(t + 1) * kstep;
            const char* a2 = last ? nA : cA + (size_t)(t + 2) * kstep; const char* b2 = last ? nB : cB + (size_t)(t + 2) * kstep;
            const char* a3 = a2 + kstep; const char* b3 = b2 + kstep;
            PG8_LDB(B0, 0, 0); PG8_LDB(B1, 0, 1); PG8_SCHED; PG8_LDA(At, 0, 0); PG8_STAGEA(PG8_SA(1, 1), a1, 1, false);
            PG8_WAIT_V(8); PG8_WAIT_L(0); PG8_BAR; PG8_MMA(0, 0, At, B0); PG8_MMA(0, 1, At, B1); PG8_BAR; PG8_SCHED;
            PG8_LDA(At, 0, 1); PG8_STAGEB(PG8_SB(0, 0), b2); PG8_STAGEB(PG8_SB(0, 1), b2 + hstepB); PG8_STAGEA(PG8_SA(0, 0), a2, 0, last);
            PG8_WAIT_V(8); PG8_WAIT_L(0); PG8_BAR; PG8_MMA(1, 0, At, B0); PG8_MMA(1, 1, At, B1); PG8_BAR; PG8_SCHED;
            PG8_LDB(B0, 1, 0); PG8_LDB(B1, 1, 1); PG8_SCHED; PG8_LDA(At, 1, 0); PG8_STAGEA(PG8_SA(0, 1), a2, 1, last);
            PG8_WAIT_V(8); PG8_WAIT_L(0); PG8_BAR; PG8_MMA(0, 0, At, B0); PG8_MMA(0, 1, At, B1); PG8_BAR; PG8_SCHED;
            PG8_LDA(At, 1, 1); PG8_STAGEB(PG8_SB(1, 0), b3); PG8_STAGEB(PG8_SB(1, 1), b3 + hstepB); PG8_STAGEA(PG8_SA(1, 0), a3, 0, last);
            PG8_WAIT_V(8); PG8_WAIT_L(0); PG8_BAR; PG8_MMA(1, 0, At, B0); PG8_MMA(1, 1, At, B1); PG8_BAR; PG8_SCHED;
            if constexpr (Epi::HAS_MID) { if (t == (nt >> 1) - 2) { int fr3 = fr, fq3 = fq; asm volatile("" : "+v"(fr3), "+v"(fq3)); E.mid(acc, cur, wr, wc, fr3, fq3); } }
        }
        if constexpr (ALIGN_EPI) { if (wr == 0) PG8_BAR; }
        { int fr2 = fr, fq2 = fq; asm volatile("" : "+v"(fr2), "+v"(fq2));
          E(acc, cur, wr, wc, fr2, fq2); }
        if (!has_next) break;
#pragma unroll
        for (int a = 0; a < 2; ++a)
#pragma unroll
            for (int b = 0; b < 2; ++b)
#pragma unroll
                for (int m = 0; m < 4; ++m)
#pragma unroll
                    for (int n = 0; n < 2; ++n) acc[a][b][m][n] = (f32x4){0.f, 0.f, 0.f, 0.f};
        cur = nxt; cA = nA; cB = nB; ++ui;
        if constexpr (GATHER) { gvc[0][0] = gvn[0][0]; gvc[0][1] = gvn[0][1]; gvc[1][0] = gvn[1][0]; gvc[1][1] = gvn[1][1]; }
        if constexpr (ALIGN_EPI) { if (wr == 1) PG8_BAR; }
    }
    PG8_WAIT_V(0);
    if constexpr (!ALIGN_EPI) { if (wr == 0) PG8_BAR; }
    PG8_BAR;
#undef PG8_SA
#undef PG8_SB
#undef PG8_STAGE2
#undef PG8_GLDS
#undef PG8_STAGEA
#undef PG8_STAGEB
#undef PG8_LDA
#undef PG8_LDB
#undef PG8_MMA
#undef PG8_CAT
#undef PG8_WAIT_V
#undef PG8_WAIT_L
#undef PG8_BAR
#undef PG8_SCHED
#undef PG8_GATHER_OFFS
}

#define EPI_ROW(u, ai, m) ((u).orow + (ai) * HALF + wr * 64 + (m) * 16 + fr)
#define EPI_COL(u, bj) ((u).ocol + (bj) * HALF + wc * 32 + 8 * fq)
struct EpiBf16 {
    static constexpr bool HAS_MID = false;
    bf16_t* O; int ldc; const float* rs; size_t stride; float sc0, sc3;
    unsigned* kn;
    const LAS float* rst;
    float mul;
    __device__ __forceinline__ void operator()(const f32x4 (&acc)[2][2][4][2], const Unit& u, int wr, int wc, int fr, int fq) const {
        bf16_t* base = O + (size_t)u.aux * stride;
        const float sc = ((u.aux == 0) ? sc0 : ((u.aux == 3) ? sc3 : 1.f)) * mul;
        float nmax[2] = {0.f, 0.f}; const bool dokn = kn && u.aux == 1;
#pragma unroll
        for (int ai = 0; ai < 2; ++ai)
#pragma unroll
            for (int m = 0; m < 4; ++m) { const int row = EPI_ROW(u, ai, m); const float s = (rst ? rst[u.seq * 256 + ai * HALF + wr * 64 + m * 16 + fr] : (rs ? rs[row] : 1.f)) * sc;
#pragma unroll
                for (int bj = 0; bj < 2; ++bj) { const f32x4 v0 = acc[ai][bj][m][0] * s, v1 = acc[ai][bj][m][1] * s;
                    { u32x4 w; w.x = cvt_pk_bf16(v0[0], v0[1]); w.y = cvt_pk_bf16(v0[2], v0[3]); w.z = cvt_pk_bf16(v1[0], v1[1]); w.w = cvt_pk_bf16(v1[2], v1[3]);
                    __builtin_nontemporal_store(w, (u32x4*)(base + (size_t)row * ldc + EPI_COL(u, bj))); }
                    if (dokn) { float q = (v0[0] * v0[0] + v0[1] * v0[1]) + (v0[2] * v0[2] + v0[3] * v0[3]) + (v1[0] * v1[0] + v1[1] * v1[1]) + (v1[2] * v1[2] + v1[3] * v1[3]);
                        q += __shfl_xor(q, 16); q += __shfl_xor(q, 32); nmax[bj] = fmaxf(nmax[bj], q); } } }
        if (dokn) {
#pragma unroll
            for (int bj = 0; bj < 2; ++bj) { float q = nmax[bj]; q = fmaxf(q, __shfl_xor(q, 1)); q = fmaxf(q, __shfl_xor(q, 2)); q = fmaxf(q, __shfl_xor(q, 4)); q = fmaxf(q, __shfl_xor(q, 8));
                const int head = ((u.ocol + bj * HALF) >> 6) + (wc >> 1), bt = u.orow / SEQ;
                if ((fr | fq) == 0) atomicMax(kn + ((bt * NH + head) * 2 + (wc & 1)), __float_as_uint(q)); }
        }
    }
};
struct EpiY8 {
    static constexpr bool HAS_MID = false;
    unsigned char* Y; float mul;
    __device__ __forceinline__ void operator()(const f32x4 (&acc)[2][2][4][2], const Unit& u, int wr, int wc, int fr, int fq) const {
#pragma unroll
        for (int ai = 0; ai < 2; ++ai)
#pragma unroll
            for (int m = 0; m < 4; m += 2) { const int row = EPI_ROW(u, ai, m) + 16 * (fq & 1);
#pragma unroll
                for (int bj = 0; bj < 2; ++bj) { u32x2 w8[2];
#pragma unroll
                    for (int mm = 0; mm < 2; ++mm) { const f32x4 v0 = acc[ai][bj][m + mm][0] * mul, v1 = acc[ai][bj][m + mm][1] * mul; w8[mm].x = cvt4_fp8(v0[0], v0[1], v0[2], v0[3]); w8[mm].y = cvt4_fp8(v1[0], v1[1], v1[2], v1[3]); }
                    *(u32x4*)(Y + (size_t)row * DM + (u.ocol + bj * HALF + wc * 32 + 8 * (fq & ~1))) = widen16(w8[0], w8[1]); } }
    }
};
struct EpiOutProj {
    static constexpr bool HAS_MID = true;
    const bf16_t* xb; bf16_t* hb; unsigned char* h8; float* ssq; const LAS f32x2* rab;
    __device__ __forceinline__ void mid(f32x4 (&acc)[2][2][4][2], const Unit& u, int wr, int wc, int fr, int fq) const {
#pragma unroll
        for (int ai = 0; ai < 2; ++ai)
#pragma unroll
            for (int m = 0; m < 4; ++m) { const float f = rab[u.seq * 256 + ai * HALF + wr * 64 + m * 16 + fr].x;
#pragma unroll
                for (int bj = 0; bj < 2; ++bj) { acc[ai][bj][m][0] *= f; acc[ai][bj][m][1] *= f; } }
    }
    __device__ __forceinline__ void operator()(const f32x4 (&acc)[2][2][4][2], const Unit& u, int wr, int wc, int fr, int fq) const {
#pragma unroll
        for (int ai = 0; ai < 2; ++ai) {
        u32x4 xres[4][2];
#pragma unroll
            for (int m = 0; m < 4; ++m)
#pragma unroll
                for (int bj = 0; bj < 2; ++bj) xres[m][bj] = __builtin_nontemporal_load((const u32x4*)(xb + (size_t)EPI_ROW(u, ai, m) * DM + EPI_COL(u, bj)));
        asm volatile("" ::: "memory");
#pragma unroll
            for (int m2 = 0; m2 < 4; m2 += 2) { u32x2 w8[2][2];
#pragma unroll
              for (int mm = 0; mm < 2; ++mm) { const int m = m2 + mm; const int row = EPI_ROW(u, ai, m); const float rb = rab[u.seq * 256 + ai * HALF + wr * 64 + m * 16 + fr].y; float q = 0.f;
#pragma unroll
                for (int bj = 0; bj < 2; ++bj) { const size_t off = (size_t)row * DM + EPI_COL(u, bj);
                    const u32x4 xr = xres[m][bj];
                    f32x4 v0 = acc[ai][bj][m][0] * rb, v1 = acc[ai][bj][m][1] * rb;
                    v0[0] += bf16lo(xr.x); v0[1] += bf16hi(xr.x); v0[2] += bf16lo(xr.y); v0[3] += bf16hi(xr.y); v1[0] += bf16lo(xr.z); v1[1] += bf16hi(xr.z); v1[2] += bf16lo(xr.w); v1[3] += bf16hi(xr.w);
                    q += (v0[0] * v0[0] + v0[1] * v0[1]) + (v0[2] * v0[2] + v0[3] * v0[3]) + (v1[0] * v1[0] + v1[1] * v1[1]) + (v1[2] * v1[2] + v1[3] * v1[3]);
                    u32x4 w; w.x = cvt_pk_bf16(v0[0], v0[1]); w.y = cvt_pk_bf16(v0[2], v0[3]); w.z = cvt_pk_bf16(v1[0], v1[1]); w.w = cvt_pk_bf16(v1[2], v1[3]); __builtin_nontemporal_store(w, (u32x4*)(hb + off));
                    w8[mm][bj].x = cvt4_fp8(v0[0], v0[1], v0[2], v0[3]); w8[mm][bj].y = cvt4_fp8(v1[0], v1[1], v1[2], v1[3]); }
                q += __shfl_xor(q, 16); q += __shfl_xor(q, 32); if (fq == 0) ssq[(size_t)row * 16 + (u.ocol >> 8) * 4 + wc] = q; }
              const int rowp = EPI_ROW(u, ai, m2) + 16 * (fq & 1);
#pragma unroll
              for (int bj = 0; bj < 2; ++bj) *(u32x4*)(h8 + (size_t)rowp * DM + (u.ocol + bj * HALF + wc * 32 + 8 * (fq & ~1))) = widen16(w8[0][bj], w8[1][bj]); }
        asm volatile("" ::: "memory"); }
    }
};
struct EpiResidBf16 {
    static constexpr bool HAS_MID = false;
    bf16_t* hb; unsigned char* h8; float mul;
    __device__ __forceinline__ void operator()(const f32x4 (&acc)[2][2][4][2], const Unit& u, int wr, int wc, int fr, int fq) const {
#pragma unroll
        for (int ai = 0; ai < 2; ++ai) {
        u32x4 xres[4][2];
#pragma unroll
            for (int m = 0; m < 4; ++m)
#pragma unroll
                for (int bj = 0; bj < 2; ++bj) xres[m][bj] = *(const u32x4*)(hb + (size_t)EPI_ROW(u, ai, m) * DM + EPI_COL(u, bj));
        asm volatile("" ::: "memory");
#pragma unroll
            for (int m2 = 0; m2 < 4; m2 += 2) { u32x2 w8[2][2];
#pragma unroll
              for (int mm = 0; mm < 2; ++mm) { const int m = m2 + mm; const int row = EPI_ROW(u, ai, m);
#pragma unroll
                for (int bj = 0; bj < 2; ++bj) { const size_t off = (size_t)row * DM + EPI_COL(u, bj);
                    const u32x4 xr = xres[m][bj];
                    f32x4 v0 = acc[ai][bj][m][0] * mul, v1 = acc[ai][bj][m][1] * mul;
                    v0[0] += bf16lo(xr.x); v0[1] += bf16hi(xr.x); v0[2] += bf16lo(xr.y); v0[3] += bf16hi(xr.y); v1[0] += bf16lo(xr.z); v1[1] += bf16hi(xr.z); v1[2] += bf16lo(xr.w); v1[3] += bf16hi(xr.w);
                    u32x4 w; w.x = cvt_pk_bf16(v0[0], v0[1]); w.y = cvt_pk_bf16(v0[2], v0[3]); w.z = cvt_pk_bf16(v1[0], v1[1]); w.w = cvt_pk_bf16(v1[2], v1[3]); *(u32x4*)(hb + off) = w;
                    w8[mm][bj].x = cvt4_fp8(v0[0], v0[1], v0[2], v0[3]); w8[mm][bj].y = cvt4_fp8(v1[0], v1[1], v1[2], v1[3]); } }
              if (h8) { const int rowp = EPI_ROW(u, ai, m2) + 16 * (fq & 1);
#pragma unroll
                  for (int bj = 0; bj < 2; ++bj) *(u32x4*)(h8 + (size_t)rowp * DM + (u.ocol + bj * HALF + wc * 32 + 8 * (fq & ~1))) = widen16(w8[0][bj], w8[1][bj]); } }
        asm volatile("" ::: "memory"); }
    }
};
struct EpiSoftmax {
    static constexpr bool HAS_MID = false;
    bf16_t* P; const LAS float* r1t; LAS float* red;
    __device__ __forceinline__ void operator()(f32x4 (&acc)[2][2][4][2], const Unit& u, int wr, int wc, int fr, int fq) const {
#pragma unroll
        for (int ai = 0; ai < 2; ++ai)
#pragma unroll
            for (int m = 0; m < 4; ++m) { const float r1 = r1t[u.seq * 256 + ai * HALF + wr * 64 + m * 16 + fr]; float a = -3.0e38f;
#pragma unroll
                for (int bj = 0; bj < 2; ++bj)
#pragma unroll
                    for (int n = 0; n < 2; ++n) { f32x4 v = acc[ai][bj][m][n] * r1; acc[ai][bj][m][n] = v; a = fmaxf(a, fmaxf(fmaxf(v[0], v[1]), fmaxf(v[2], v[3]))); }
                a = fmaxf(a, __shfl_xor(a, 16)); a = fmaxf(a, __shfl_xor(a, 32));
                if (fq == 0) red[(ai * HALF + wr * 64 + m * 16 + fr) * 4 + wc] = a; asm volatile("" ::: "memory"); }
        LDS_WAIT(); __builtin_amdgcn_s_barrier(); asm volatile("" ::: "memory");
#pragma unroll
        for (int ai = 0; ai < 2; ++ai)
#pragma unroll
            for (int m = 0; m < 4; ++m) { const int rl = ai * HALF + wr * 64 + m * 16 + fr; const f32x4 mm = *(const LAS f32x4*)(red + rl * 4);
                const float a = fmaxf(fmaxf(mm[0], mm[1]), fmaxf(mm[2], mm[3])); float s = 0.f;
#pragma unroll
                for (int bj = 0; bj < 2; ++bj)
#pragma unroll
                    for (int n = 0; n < 2; ++n) { f32x4 v = acc[ai][bj][m][n];
                        v[0] = __builtin_amdgcn_exp2f(v[0] - a); v[1] = __builtin_amdgcn_exp2f(v[1] - a); v[2] = __builtin_amdgcn_exp2f(v[2] - a); v[3] = __builtin_amdgcn_exp2f(v[3] - a);
                        acc[ai][bj][m][n] = v; s += (v[0] + v[1]) + (v[2] + v[3]); }
                s += __shfl_xor(s, 16); s += __shfl_xor(s, 32);
                if (fq == 0) red[1024 + rl * 4 + wc] = s; }
        LDS_WAIT(); __builtin_amdgcn_s_barrier(); asm volatile("" ::: "memory");
#pragma unroll
        for (int ai = 0; ai < 2; ++ai)
#pragma unroll
            for (int m = 0; m < 4; m += 2) { u32x2 w8[2][2];
#pragma unroll
                for (int mm = 0; mm < 2; ++mm) { const int rl = ai * HALF + wr * 64 + (m + mm) * 16 + fr; const f32x4 ss = *(const LAS f32x4*)(red + 1024 + rl * 4);
                    const float inv = P_SCALE / ((ss[0] + ss[1]) + (ss[2] + ss[3]));
#pragma unroll
                    for (int bj = 0; bj < 2; ++bj) { const f32x4 v0 = acc[ai][bj][m + mm][0] * inv, v1 = acc[ai][bj][m + mm][1] * inv;
                        w8[mm][bj].x = cvt4_fp8(v0[0], v0[1], v0[2], v0[3]); w8[mm][bj].y = cvt4_fp8(v1[0], v1[1], v1[2], v1[3]); } }
                const int row = EPI_ROW(u, ai, m) + 16 * (fq & 1);
#pragma unroll
                for (int bj = 0; bj < 2; ++bj) *(u32x4*)((unsigned char*)P + (size_t)row * DM + (u.ocol + bj * HALF + wc * 32 + 8 * (fq & ~1))) = widen16(w8[0][bj], w8[1][bj]); }
    }
};
struct EpiSwiglu {
    static constexpr bool HAS_MID = false;
    bf16_t* Hd; const float* r2s; const int* listbase;
    __device__ __forceinline__ void operator()(const f32x4 (&acc)[2][2][4][2], const Unit& u, int wr, int wc, int fr, int fq) const {
        float rsv[2][4];
#pragma unroll
        for (int ai = 0; ai < 2; ++ai)
#pragma unroll
            for (int m = 0; m < 4; ++m) { const int rl = ai * HALF + wr * 64 + m * 16 + fr; rsv[ai][m] = r2s[(u.rows - listbase) + (rl < u.nvalid ? rl : 0)]; }
        asm volatile("" ::: "memory");
#pragma unroll
        for (int ai = 0; ai < 2; ++ai)
#pragma unroll
            for (int m = 0; m < 4; m += 2) { u32x2 w8[2];
#pragma unroll
                for (int mm = 0; mm < 2; ++mm) { const float rs = rsv[ai][m + mm] * (1.0f / WGU_SCALE); float h[8];
#pragma unroll
                    for (int n = 0; n < 2; ++n)
#pragma unroll
                        for (int e = 0; e < 4; ++e) { const float gt = acc[ai][0][m + mm][n][e] * rs, up = acc[ai][1][m + mm][n][e] * rs;
                            h[n * 4 + e] = gt * __builtin_amdgcn_rcpf(1.0f + __builtin_amdgcn_exp2f(-gt * LOG2E)) * up; }
                    w8[mm].x = cvt4_fp8(h[0], h[1], h[2], h[3]); w8[mm].y = cvt4_fp8(h[4], h[5], h[6], h[7]); }
                const int row = EPI_ROW(u, ai, m) + 16 * (fq & 1);
                *(u32x4*)((unsigned char*)Hd + (size_t)row * DFF + u.ocol + wc * 32 + 8 * (fq & ~1)) = widen16(w8[0], w8[1]); }
    }
};
}

namespace att {
constexpr int QB = 256, KVBLK = 64, PITCH = HW, OPITCH = DM;
constexpr int SLOTB = 8192, LDS_K = 0, LDS_V = 2 * SLOTB, LDS_WS = 4 * SLOTB, LDS_OST = LDS_WS + NWAVES * 256, LDS_FLAG = LDS_OST + NWAVES * 4096, LDS_END = LDS_FLAG + 64;
static_assert(LDS_END <= RING_BYTES, "attention LDS");
__device__ __forceinline__ int crow(int r, int hi) { return (r & 3) + 8 * (r >> 2) + 4 * hi; }
__device__ __forceinline__ void glds16(const void* gsrc, unsigned lds_dst) { unsigned keep;
    asm volatile("s_mov_b32 %0, m0\n\ts_mov_b32 m0, %2\n\ts_nop 0\n\tglobal_load_lds_dwordx4 %1, off\n\ts_mov_b32 m0, %0" : "=&s"(keep) : "v"(gsrc), "s"(lds_dst) : "memory"); }
__device__ __forceinline__ void glds16s(const void* sbase, unsigned voff, unsigned lds_dst) { unsigned keep;
    asm volatile("s_mov_b32 %0, m0\n\ts_mov_b32 m0, %3\n\ts_nop 0\n\tglobal_load_lds_dwordx4 %1, %2\n\ts_mov_b32 m0, %0" : "=&s"(keep) : "v"(voff), "s"(sbase), "s"(lds_dst) : "memory"); }
#define ATT_WAIT_BAR0() asm volatile("s_waitcnt vmcnt(0) lgkmcnt(0)\n\ts_barrier" ::: "memory")
#define MFMA32(a, b, c) __builtin_amdgcn_mfma_f32_32x32x16_bf16(a, b, c, 0, 0, 0)
__device__ __forceinline__ void store_row_ssq(u32x4 v, float* dst, int ch) {
    float q = (bf16lo(v.x) * bf16lo(v.x) + bf16hi(v.x) * bf16hi(v.x)) + (bf16lo(v.y) * bf16lo(v.y) + bf16hi(v.y) * bf16hi(v.y)) + (bf16lo(v.z) * bf16lo(v.z) + bf16hi(v.z) * bf16hi(v.z)) + (bf16lo(v.w) * bf16lo(v.w) + bf16hi(v.w) * bf16hi(v.w));
    q += __shfl_xor(q, 1); q += __shfl_xor(q, 2); q += __shfl_xor(q, 4);
    if (ch == 0) *dst = q;
}
__device__ __forceinline__ void qkt(f32x16& p0, f32x16& p1, const LAS char* Kslot, const bf16x8* qr, const f32x16& cin, int r32, int hi) {
    const LAS char* kb = Kslot + hi * 1024 + r32 * 16;
#pragma unroll
    for (int d0 = 0; d0 < 4; ++d0) {
        const bf16x8 b0 = *(const LAS bf16x8*)(kb + d0 * 2048);
        const bf16x8 b1 = *(const LAS bf16x8*)(kb + d0 * 2048 + 512);
        if (d0 == 0) { p0 = MFMA32(b0, qr[0], cin); p1 = MFMA32(b1, qr[0], cin); }
        else { p0 = MFMA32(b0, qr[d0], p0); p1 = MFMA32(b1, qr[d0], p1); } }
}
__device__ __forceinline__ void pv(f32x16* o, int vb, bf16x8 pa0, bf16x8 pa1, bf16x8 pa2, bf16x8 pa3) {
#pragma unroll
    for (int d0 = 0; d0 < 2; ++d0) { s16x4 lo[4], hi[4];
#pragma unroll
        for (int ks = 0; ks < 4; ++ks) {
            asm volatile("ds_read_b64_tr_b16 %0,%1 offset:%c2" : "=&v"(lo[ks]) : "v"(vb), "i"(d0 * 4096 + ks * 1024) : "memory");
            asm volatile("ds_read_b64_tr_b16 %0,%1 offset:%c2" : "=&v"(hi[ks]) : "v"(vb), "i"(d0 * 4096 + ks * 1024 + 512) : "memory"); }
        asm volatile("s_waitcnt lgkmcnt(0)" ::: "memory"); __builtin_amdgcn_sched_barrier(0);
#define PK(k) (bf16x8){lo[k][0], lo[k][1], lo[k][2], lo[k][3], hi[k][0], hi[k][1], hi[k][2], hi[k][3]}
        o[d0] = MFMA32(pa0, PK(0), o[d0]); o[d0] = MFMA32(pa1, PK(1), o[d0]); o[d0] = MFMA32(pa2, PK(2), o[d0]); o[d0] = MFMA32(pa3, PK(3), o[d0]);
#undef PK
    }
}
__device__ __forceinline__ float swap_lo(float x) { auto rr = __builtin_amdgcn_permlane32_swap(__float_as_uint(x), __float_as_uint(x), false, false); return __uint_as_float(rr[0]); }
__device__ __forceinline__ float swap_hi(float x) { auto rr = __builtin_amdgcn_permlane32_swap(__float_as_uint(x), __float_as_uint(x), false, false); return __uint_as_float(rr[1]); }

}


namespace fox {
constexpr int QB = 256, KVBLK = 64, PITCH = HW, OPITCH = DM;
constexpr int NSLOT = 3, SLOTB = 9216;
constexpr int LDS_K = 0, LDS_V = NSLOT * SLOTB, LDS_WS = 2 * NSLOT * SLOTB, LDS_OST = LDS_WS + NWAVES * 256, LDS_CL = LDS_OST + NWAVES * 4096, LDS_VOTE = LDS_CL + 512, LDS_END = LDS_VOTE + 32;
static_assert(LDS_END <= RING_BYTES, "fox LDS");
constexpr float WIN_T = 40.0f;
constexpr float FLOOR = -256.0f;
using att::crow; using att::glds16; using att::glds16s;
typedef __attribute__((address_space(3))) const char* lds_cptr;
typedef short v4i16_t __attribute__((ext_vector_type(4)));
#define SBAR() __builtin_amdgcn_sched_barrier(0)
#define WAIT_BAR(N) asm volatile("s_waitcnt vmcnt(" #N ") lgkmcnt(0)\n\ts_barrier" ::: "memory")
__device__ __forceinline__ s16x4 vtr(lds_cptr p) { return __builtin_bit_cast(s16x4, __builtin_amdgcn_ds_read_tr16_b64_v4i16((__attribute__((address_space(3))) v4i16_t*)p)); }
__device__ __forceinline__ void kload2(bf16x8* kf, lds_cptr kp, int j) { kf[2 * j] = *(const LAS bf16x8*)(kp + j * 2048); kf[2 * j + 1] = *(const LAS bf16x8*)(kp + j * 2048 + 512); }
__device__ __forceinline__ void cmask(f32x16& p0, f32x16& p1, int jb, int qrel, int hi) {
    const float NEG = -INFINITY; const int kb = 64 * jb + 4 * hi;
#pragma unroll
    for (int r = 0; r < 16; ++r) { const int kv = kb + (r & 3) + 8 * (r >> 2); if (kv > qrel) p0[r] = NEG; if (kv + 32 > qrel) p1[r] = NEG; }
}
__device__ __forceinline__ void split3(float x, unsigned& hm, unsigned& lo) {
    const unsigned h = cvt_pk_bf16(x, 0.f) & 0xffffu; const float r1 = x - __uint_as_float(h << 16);
    const unsigned m = cvt_pk_bf16(r1, 0.f) & 0xffffu; const float r2 = r1 - __uint_as_float(m << 16);
    hm = h | (m << 16); lo = cvt_pk_bf16(r2, 0.f) & 0xffffu;
}
__device__ __forceinline__ bf16x8 qx_build(float a, int hi) {
    unsigned hm, lo; split3(a, hm, lo);
    u32x4 w; w.x = hm; w.y = lo | 0x3F800000u; w.z = 0x3F803F80u; w.w = 0u;
    if (hi) { w.x = 0u; w.y = 0u; w.z = 0u; }
    return __builtin_bit_cast(bf16x8, w);
}

template <int THRL> __device__ __forceinline__ void fox_unit(int bh, int qb, const bf16_t* Q, const bf16_t* K, const bf16_t* V, bf16_t* O, float* hs, const float* cb, const bf16_t* KXall, float kmax, LAS char* shm, bool pre, int nbh, int nqb) {
    const bf16_t* KXh = KXall + (size_t)bh * SEQ * 8;
    int tid = threadIdx.x; asm volatile("" : "+v"(tid)); const int lane = tid & 63, r32 = lane & 31, hi = lane >> 5; const int wid = __builtin_amdgcn_readfirstlane(tid >> 6);
    const int b = bh >> 3, h = bh & 7; const long rowbase = (long)b * SEQ; const int q0 = qb * QB;
    const bf16_t* Qw = Q + (rowbase + q0 + wid * 32) * PITCH + h * HD;
    const bf16_t* Kh = K + rowbase * PITCH + h * HD; const bf16_t* Vh = V + rowbase * PITCH + h * HD;
    const unsigned lds0 = (unsigned)(uintptr_t)shm;
    LAS float* wsf = (LAS float*)(shm + LDS_WS) + wid * 64;
    const int NT = (q0 + QB) / KVBLK;
    int NTe = NT;
    LAS float* clt = (LAS float*)(shm + LDS_CL); LAS unsigned* votes = (LAS unsigned*)(shm + LDS_VOTE);
    const float clv = (tid < NT) ? cb[64 * tid + 63] : 0.f;
    const unsigned koff = (unsigned)(lane * PITCH + wid * 8) * 2u, voff = (unsigned)((16 * (wid & 3) + (lane >> 2)) * PITCH + (wid >> 2) * 32 + (lane & 3) * 8) * 2u, xoff = (unsigned)lane * 16u;
    const unsigned kdst = lds0 + LDS_K + wid * 1024, vdst = lds0 + LDS_V + wid * 1024, xdst = lds0 + LDS_K + 8192;
    const bool xl = (lane >> 3) == wid;
#define DMA_KX(Kb, KXb, NTv, p, slot) do { glds16s((Kb) + (long)((NTv) - 1 - (p)) * KVBLK * PITCH, koff, (unsigned)__builtin_amdgcn_readfirstlane(kdst + (slot))); \
        if (xl) glds16s((KXb) + (long)((NTv) - 1 - (p)) * KVBLK * 8, xoff, (unsigned)__builtin_amdgcn_readfirstlane(xdst + (slot))); } while (0)
#define DMA_VX(Vb, NTv, p, slot) glds16s((Vb) + (long)((NTv) - 1 - (p)) * KVBLK * PITCH, voff, (unsigned)__builtin_amdgcn_readfirstlane(vdst + (slot)))
#define DMA_K(p, slot) DMA_KX(Kh, KXh, NT, p, slot)
#define DMA_V(p, slot) DMA_VX(Vh, NT, p, slot)
    bf16x8 kf[10];
    const lds_cptr shm3 = (lds_cptr)shm; const lds_cptr kp0 = shm3 + LDS_K + hi * 1024 + r32 * 16; const lds_cptr kx0 = shm3 + LDS_K + 8192 + r32 * 16;
    const lds_cptr vp0 = shm3 + LDS_V + ((lane >> 4) & 1) * 32 + (lane & 3) * 8 + (4 * hi + ((lane & 15) >> 2)) * 64;
    if (!pre) { DMA_K(0, 0); DMA_V(0, 0); DMA_K(1, SLOTB); }
    bf16x8 qr[4];
#pragma unroll
    for (int d0 = 0; d0 < 4; ++d0) qr[d0] = *(const bf16x8*)(Qw + (long)r32 * PITCH + d0 * 16 + hi * 8);
    const int qrel = wid * 32 + r32;
    const float ct = cb[q0 + qrel];
    float mhat = 0.f, l_reg = 0.f; f32x16 o[2]; o[0] = f32x16{}; o[1] = f32x16{};
    bf16x8 qx = qx_build(ct, hi);
    const f32x16 z16 = f32x16{};
#define CMASK(P0, P1, p) do { const int jb_ = 3 - (p); if (jb_ >= 0) cmask(P0, P1, jb_, qrel, hi); } while (0)
    bool resc = false;
#define RESC() do { if (resc) { asm volatile("s_waitcnt lgkmcnt(0)" ::: "memory"); \
      _Pragma("unroll") for (int d_ = 0; d_ < 2; ++d_) _Pragma("unroll") for (int r = 0; r < 16; ++r) o[d_][r] *= wsf[crow(r, hi)]; } } while (0)
    f32x16 pA0, pA1, pB0, pB1;
    int sl_prev = 0, sl_cur = 0, sl_next = SLOTB;
#define ROT() do { sl_prev = sl_cur; sl_cur = sl_next; sl_next = (sl_next == (NSLOT - 1) * SLOTB) ? 0 : sl_next + SLOTB; } while (0)
    if (!pre) { DMA_K(2, 2 * SLOTB); }
    if (pre) { WAIT_BAR(0); } else WAIT_BAR(5);
    if (tid < NT) clt[tid] = clv;
    float qkb;
    { float q2 = 0.f;
#pragma unroll
      for (int d0 = 0; d0 < 4; ++d0)
#pragma unroll
          for (int j = 0; j < 8; ++j) { const float e = __uint_as_float(((unsigned)(unsigned short)qr[d0][j]) << 16); q2 += e * e; }
      q2 = att::swap_lo(q2) + att::swap_hi(q2); qkb = sqrtf(q2) * kmax + ct + WIN_T; }
    { const LAS char* kb = (const LAS char*)shm + LDS_K + hi * 1024 + r32 * 16; const LAS char* kxb = (const LAS char*)shm + LDS_K + 8192 + r32 * 16;
      pA0 = MFMA32(*(const LAS bf16x8*)(kxb), qx, z16); pA1 = MFMA32(*(const LAS bf16x8*)(kxb + 512), qx, z16);
#pragma unroll
      for (int d0 = 0; d0 < 4; ++d0) { pA0 = MFMA32(*(const LAS bf16x8*)(kb + d0 * 2048), qr[d0], pA0); pA1 = MFMA32(*(const LAS bf16x8*)(kb + d0 * 2048 + 512), qr[d0], pA1); } }
    asm volatile("s_nop 15\n\ts_nop 7" : "+v"(pA0), "+v"(pA1)); CMASK(pA0, pA1, 0);
    { float a = fmaxf(pA0[0], pA1[0]);
#pragma unroll
      for (int r = 1; r < 16; ++r) a = fmaxf(a, fmaxf(pA0[r], pA1[r]));
      a = fmaxf(att::swap_lo(a), att::swap_hi(a));
      const float dl = fmaxf(a, FLOOR); mhat = dl;
#pragma unroll
      for (int r = 0; r < 16; ++r) { pA0[r] = __builtin_amdgcn_exp2f(pA0[r] - dl); pA1[r] = __builtin_amdgcn_exp2f(pA1[r] - dl); }
      qx = qx_build(ct - mhat, hi); asm volatile("" : "+v"(qx)); }
    WAIT_BAR(0);
    DMA_K(3, 0); DMA_V(1, SLOTB);
    ROT();
    kload2(kf, kp0 + sl_cur, 0); kload2(kf, kp0 + sl_cur, 1); kload2(kf, kp0 + sl_cur, 2); kload2(kf, kp0 + sl_cur, 3);
    kf[8] = *(const LAS bf16x8*)(kx0 + sl_cur); kf[9] = *(const LAS bf16x8*)(kx0 + sl_cur + 512);
    WAIT_BAR(3);
    s16x4 vlo[8], vhi[8]; u32x4 pw0, pw1, pw2, pw3;
#define PKW(P, B) cvt_pk_bf16(P[B], P[B + 1])
#define PAF(k) __builtin_bit_cast(bf16x8, pw##k)
#define VFR(i) (bf16x8){vlo[i][0], vlo[i][1], vlo[i][2], vlo[i][3], vhi[i][0], vhi[i][1], vhi[i][2], vhi[i][3]}
#define PIN(x) asm volatile("" : "+v"(x))
#define MX3(a, b, c) __builtin_fmaxf(__builtin_fmaxf((a), (b)), (c))
#define GAPA(MF, A0, A1, A2, A3, W0, W1, PW) do { MF; sacc += A0; sacc += A1; sacc += A2; sacc += A3; PIN(sacc); W0; W1; PIN(PW); SBAR(); } while (0)
#define EX(v) __builtin_amdgcn_exp2f(v)
#define GAPB(MF, X, B) do { MF; X[B] = EX(X[B]); X[B + 1] = EX(X[B + 1]); X[B + 2] = EX(X[B + 2]); X[B + 3] = EX(X[B + 3]); PIN(X); SBAR(); } while (0)
#define VRD(i) do { vlo[i] = vtr(vp_ + (((i) >> 2) * 4096 + ((i) & 3) * 1024)); vhi[i] = vtr(vp_ + (((i) >> 2) * 4096 + ((i) & 3) * 1024 + 512)); } while (0)
#define KRD(G, j) do { if (G) { kload2(kf, kp0 + sl_next, j); SBAR(); } } while (0)
#define KRDX(G) do { if (G) { kf[8] = *(const LAS bf16x8*)(kx0 + sl_next); kf[9] = *(const LAS bf16x8*)(kx0 + sl_next + 512); SBAR(); } } while (0)
#define STEP(C0, C1, P0, P1, t, GK, GV, GL) do { SBAR(); \
    const lds_cptr vp_ = vp0 + sl_prev; \
    C0 = MFMA32(kf[8], qx, z16); C1 = MFMA32(kf[9], qx, z16); SBAR(); \
    VRD(0); SBAR(); float sacc = (P0[0] + P0[1]); \
    GAPA(C0 = MFMA32(kf[0], qr[0], C0), P0[2], P0[3], P0[4], P0[5],     pw0[0] = PKW(P0, 0), pw0[1] = PKW(P0, 2), pw0); \
    VRD(4); SBAR(); GAPA(C1 = MFMA32(kf[1], qr[0], C1), P0[6], P0[7], P0[8], P0[9],     pw0[2] = PKW(P0, 4), pw0[3] = PKW(P0, 6), pw0); \
    VRD(1); SBAR(); GAPA(C0 = MFMA32(kf[2], qr[1], C0),   P0[10], P0[11], P0[12], P0[13], pw1[0] = PKW(P0, 8), pw1[1] = PKW(P0, 10), pw1); \
    VRD(5); SBAR(); GAPA(C1 = MFMA32(kf[3], qr[1], C1),   P0[14], P0[15], P1[0], P1[1],   pw1[2] = PKW(P0, 12), pw1[3] = PKW(P0, 14), pw1); \
    VRD(2); SBAR(); GAPA(C0 = MFMA32(kf[4], qr[2], C0),   P1[2], P1[3], P1[4], P1[5],     pw2[0] = PKW(P1, 0), pw2[1] = PKW(P1, 2), pw2); \
    VRD(6); SBAR(); GAPA(C1 = MFMA32(kf[5], qr[2], C1),   P1[6], P1[7], P1[8], P1[9],     pw2[2] = PKW(P1, 4), pw2[3] = PKW(P1, 6), pw2); \
    VRD(3); SBAR(); GAPA(C0 = MFMA32(kf[6], qr[3], C0),   P1[10], P1[11], P1[12], P1[13], pw3[0] = PKW(P1, 8), pw3[1] = PKW(P1, 10), pw3); \
    VRD(7); SBAR(); GAPA(C1 = MFMA32(kf[7], qr[3], C1),   P1[14], P1[15], 0.f, 0.f,       pw3[2] = PKW(P1, 12), pw3[3] = PKW(P1, 14), pw3); \
    l_reg += sacc; \
    if (GK) { DMA_K((t) + 3, sl_cur); } if (GV) { DMA_V((t) + 1, sl_next); } \
    CMASK(C0, C1, t); \
    { float a = MX3(C0[0], C0[1], C1[0]), b_ = MX3(C0[2], C0[3], C1[1]); a = MX3(a, C1[2], C1[3]); \
      _Pragma("unroll") for (int r = 4; r < 16; r += 4) { a = MX3(a, C0[r], C0[r + 1]); b_ = MX3(b_, C0[r + 2], C0[r + 3]); a = MX3(a, C1[r], C1[r + 1]); b_ = MX3(b_, C1[r + 2], C1[r + 3]); } \
      float rm = __builtin_fmaxf(a, b_); { auto rr = __builtin_amdgcn_permlane32_swap(__float_as_uint(rm), __float_as_uint(rm), false, false); rm = __builtin_fmaxf(__uint_as_float(rr[0]), __uint_as_float(rr[1])); } \
      resc = false; \
      if (__builtin_expect(__any(rm > (float)THRL), 0)) { const float dl = __builtin_fmaxf(rm, 0.f); mhat += dl; \
        _Pragma("unroll") for (int r = 0; r < 16; ++r) { C0[r] -= dl; C1[r] -= dl; } \
        qx = qx_build(ct - mhat, hi); asm volatile("" : "+v"(qx)); \
        const float f = __builtin_amdgcn_exp2f(-dl); l_reg *= f; if (hi == 0) wsf[r32] = f; resc = true; } } \
    SBAR(); \
    GAPB(o[0] = MFMA32(PAF(0), VFR(0), o[0]), C0, 0); \
    KRDX(GL); GAPB(o[1] = MFMA32(PAF(0), VFR(4), o[1]), C0, 4); \
    KRD(GL, 0); GAPB(o[0] = MFMA32(PAF(1), VFR(1), o[0]), C0, 8); \
    KRD(GL, 1); GAPB(o[1] = MFMA32(PAF(1), VFR(5), o[1]), C0, 12); \
    KRD(GL, 2); GAPB(o[0] = MFMA32(PAF(2), VFR(2), o[0]), C1, 0); \
    KRD(GL, 3); GAPB(o[1] = MFMA32(PAF(2), VFR(6), o[1]), C1, 4); \
    GAPB(o[0] = MFMA32(PAF(3), VFR(3), o[0]), C1, 8); \
    GAPB(o[1] = MFMA32(PAF(3), VFR(7), o[1]), C1, 12); \
    } while (0)
#define ENDW(tt) do { if ((tt) + 3 < NTe) { WAIT_BAR(3); } else if ((tt) + 2 < NTe) { WAIT_BAR(1); } else { WAIT_BAR(0); } } while (0)
#define VOTE(u) do { const int ts_ = NT - (u) - 3; bool ok_ = false; if (ts_ >= 0) { ok_ = __all((qkb - mhat) < clt[ts_]); } if (lane == 0) votes[wid] = ok_ ? 1u : 0u; } while (0)
#define TALLY(u) do { const u32x4 va_ = *(const LAS u32x4*)votes, vb_ = *(const LAS u32x4*)(votes + 4); \
        if (__builtin_amdgcn_readfirstlane((va_.x & va_.y & va_.z & va_.w & vb_.x & vb_.y & vb_.z & vb_.w) != 0u)) { if ((u) + 2 < NTe) { NTe = (u) + 2; WAIT_BAR(0); } } } while (0)
    int t = 1;
    for (; t + 1 < NTe && t < 5; t += 2) {
        STEP(pB0, pB1, pA0, pA1, t, (t + 3 < NTe), (t + 1 < NTe), (t + 1 < NTe));       ENDW(t);     RESC(); ROT();
        STEP(pA0, pA1, pB0, pB1, t + 1, (t + 4 < NTe), (t + 2 < NTe), (t + 2 < NTe));   VOTE(t + 1); ENDW(t + 1); TALLY(t + 1); RESC(); ROT();
    }
#undef CMASK
#define CMASK(P0, P1, p) do {} while (0)
    for (; t + 5 < NTe; t += 2) {
        STEP(pB0, pB1, pA0, pA1, t, true, true, true);       WAIT_BAR(3); RESC(); ROT();
        STEP(pA0, pA1, pB0, pB1, t + 1, true, true, true);   VOTE(t + 1); WAIT_BAR(3); TALLY(t + 1); RESC(); ROT();
    }
    for (; t + 1 < NTe; t += 2) {
        STEP(pB0, pB1, pA0, pA1, t, (t + 3 < NTe), (t + 1 < NTe), (t + 1 < NTe));       ENDW(t);     RESC(); ROT();
        STEP(pA0, pA1, pB0, pB1, t + 1, (t + 4 < NTe), (t + 2 < NTe), (t + 2 < NTe));   ENDW(t + 1); RESC(); ROT();
    }
#undef CMASK
#define CMASK(P0, P1, p) do { const int jb_ = 3 - (p); if (jb_ >= 0) cmask(P0, P1, jb_, qrel, hi); } while (0)
    STEP(pB0, pB1, pA0, pA1, NTe - 1, false, false, false); RESC();
    { float sacc = pB0[0] + pB0[1];
#pragma unroll
      for (int r = 2; r < 16; ++r) sacc += pB0[r];
#pragma unroll
      for (int r = 0; r < 16; ++r) sacc += pB1[r];
      l_reg += sacc;
      pw0 = (u32x4){PKW(pB0, 0), PKW(pB0, 2), PKW(pB0, 4), PKW(pB0, 6)}; pw1 = (u32x4){PKW(pB0, 8), PKW(pB0, 10), PKW(pB0, 12), PKW(pB0, 14)};
      pw2 = (u32x4){PKW(pB1, 0), PKW(pB1, 2), PKW(pB1, 4), PKW(pB1, 6)}; pw3 = (u32x4){PKW(pB1, 8), PKW(pB1, 10), PKW(pB1, 12), PKW(pB1, 14)};
      SBAR(); att::pv(o, (int)(unsigned)(uintptr_t)(vp0 + sl_cur), PAF(0), PAF(1), PAF(2), PAF(3)); }
    if (nbh >= 0) { asm volatile("s_waitcnt lgkmcnt(0)\n\ts_barrier" ::: "memory");
        const int NTn = (nqb * QB + QB) / KVBLK; const bf16_t* Kn = K + (long)(nbh >> 3) * SEQ * PITCH + (nbh & 7) * HD; const bf16_t* Vn = V + (long)(nbh >> 3) * SEQ * PITCH + (nbh & 7) * HD; const bf16_t* KXn = KXall + (size_t)nbh * SEQ * 8;
        DMA_KX(Kn, KXn, NTn, 0, 0); DMA_VX(Vn, NTn, 0, 0); DMA_KX(Kn, KXn, NTn, 1, SLOTB); DMA_KX(Kn, KXn, NTn, 2, 2 * SLOTB); }
    l_reg = att::swap_lo(l_reg) + att::swap_hi(l_reg);
    if (hi == 0) wsf[32 + r32] = l_reg; asm volatile("s_waitcnt lgkmcnt(0)" ::: "memory");
    float rli[16];
#pragma unroll
    for (int r = 0; r < 16; ++r) rli[r] = __builtin_amdgcn_rcpf(wsf[32 + crow(r, hi)]);
    bf16_t* Ow = O + (rowbase + q0 + wid * 32) * OPITCH + h * HD;
    { LAS bf16_t* stg = (LAS bf16_t*)(shm + LDS_OST) + wid * 2048;
#pragma unroll
      for (int r = 0; r < 16; ++r) { const int orow = crow(r, hi);
#pragma unroll
        for (int d0 = 0; d0 < 2; ++d0) stg[orow * 64 + d0 * 32 + r32] = (bf16_t)(cvt_pk_bf16(o[d0][r] * rli[r], 0.f) & 0xffffu); }
      asm volatile("s_waitcnt lgkmcnt(0)" ::: "memory");
#pragma unroll
      for (int i = 0; i < 4; ++i) { const int row = i * 8 + (lane >> 3), ch = lane & 7; const u32x4 v = *(const LAS u32x4*)(stg + row * 64 + ch * 8); *(u32x4*)(Ow + (long)row * OPITCH + ch * 8) = v;
        att::store_row_ssq(v, hs + (rowbase + q0 + wid * 32 + row) * 16, ch); } }
    asm volatile("s_waitcnt lgkmcnt(0)\n\ts_barrier" ::: "memory");
#undef DMA_K
#undef DMA_V
#undef DMA_KX
#undef DMA_VX
#undef CMASK
#undef RESC
#undef ROT
#undef PKW
#undef PAF
#undef VFR
#undef PIN
#undef MX3
#undef GAPA
#undef GAPB
#undef EX
#undef VRD
#undef KRD
#undef KRDX
#undef STEP
#undef ENDW
#undef VOTE
#undef TALLY
}
#undef SBAR
#undef WAIT_BAR
}


namespace sbk {
constexpr int QB = 256, KVBLK = 64, PITCH = HW, OPITCH = DM, NBURST = 6, SLOTB = 8192;
constexpr int LDS_K = 0, LDS_V = NBURST * SLOTB, LDS_FLAG = 2 * NBURST * SLOTB, LDS_END = LDS_FLAG + 128;
static_assert(LDS_END <= RING_BYTES, "sb LDS");
using att::crow; using att::glds16s; using att::qkt; using att::pv; using att::swap_lo;
__device__ __forceinline__ void sb_tile(const LAS char* Kslot, int vb, const bf16x8* qr, bf16x8 TD0, bf16x8 TD1, bf16x8 TONE, int jb, int qrel, int r32, int hi, float& R, f32x16* o) {
    f32x16 p0, p1; const f32x16 z16 = f32x16{};
    qkt(p0, p1, Kslot, qr, z16, r32, hi);
    if (jb >= 0) {
#pragma unroll
        for (int r = 0; r < 16; ++r) { const int kv = 64 * jb + crow(r, hi); if (kv >= qrel) p0[r] = -1.0e30f; if (kv + 32 >= qrel) p1[r] = -1.0e30f; } }
    f32x16 l0, l1;
#pragma unroll
    for (int r = 0; r < 16; ++r) {
        l0[r] = -(fmaxf(p0[r], 0.f) + __builtin_amdgcn_logf(1.0f + __builtin_amdgcn_exp2f(-fabsf(p0[r]))));
        l1[r] = -(fmaxf(p1[r], 0.f) + __builtin_amdgcn_logf(1.0f + __builtin_amdgcn_exp2f(-fabsf(p1[r])))); }
    u32x4 lw0 = {cvt_pk_bf16(l0[0], l0[1]), cvt_pk_bf16(l0[2], l0[3]), cvt_pk_bf16(l0[4], l0[5]), cvt_pk_bf16(l0[6], l0[7])};
    u32x4 lw1 = {cvt_pk_bf16(l0[8], l0[9]), cvt_pk_bf16(l0[10], l0[11]), cvt_pk_bf16(l0[12], l0[13]), cvt_pk_bf16(l0[14], l0[15])};
    u32x4 lw2 = {cvt_pk_bf16(l1[0], l1[1]), cvt_pk_bf16(l1[2], l1[3]), cvt_pk_bf16(l1[4], l1[5]), cvt_pk_bf16(l1[6], l1[7])};
    u32x4 lw3 = {cvt_pk_bf16(l1[8], l1[9]), cvt_pk_bf16(l1[10], l1[11]), cvt_pk_bf16(l1[12], l1[13]), cvt_pk_bf16(l1[14], l1[15])};
    f32x16 rt;
#pragma unroll
    for (int r = 0; r < 16; ++r) rt[r] = R;
    f32x16 t0 = MFMA32(TD0, __builtin_bit_cast(bf16x8, lw0), rt); t0 = MFMA32(TD1, __builtin_bit_cast(bf16x8, lw1), t0);
    t0 = MFMA32(TONE, __builtin_bit_cast(bf16x8, lw2), t0); t0 = MFMA32(TONE, __builtin_bit_cast(bf16x8, lw3), t0);
    f32x16 t1 = MFMA32(TD0, __builtin_bit_cast(bf16x8, lw2), rt); t1 = MFMA32(TD1, __builtin_bit_cast(bf16x8, lw3), t1);
#pragma unroll
    for (int r = 0; r < 16; ++r) { p0[r] = __builtin_amdgcn_exp2f(p0[r] + t0[r]); p1[r] = __builtin_amdgcn_exp2f(p1[r] + t1[r]); }
    R = swap_lo(t0[0]);
    u32x4 pw0 = {cvt_pk_bf16(p0[0], p0[1]), cvt_pk_bf16(p0[2], p0[3]), cvt_pk_bf16(p0[4], p0[5]), cvt_pk_bf16(p0[6], p0[7])};
    u32x4 pw1 = {cvt_pk_bf16(p0[8], p0[9]), cvt_pk_bf16(p0[10], p0[11]), cvt_pk_bf16(p0[12], p0[13]), cvt_pk_bf16(p0[14], p0[15])};
    u32x4 pw2 = {cvt_pk_bf16(p1[0], p1[1]), cvt_pk_bf16(p1[2], p1[3]), cvt_pk_bf16(p1[4], p1[5]), cvt_pk_bf16(p1[6], p1[7])};
    u32x4 pw3 = {cvt_pk_bf16(p1[8], p1[9]), cvt_pk_bf16(p1[10], p1[11]), cvt_pk_bf16(p1[12], p1[13]), cvt_pk_bf16(p1[14], p1[15])};
    pv(o, vb, __builtin_bit_cast(bf16x8, pw0), __builtin_bit_cast(bf16x8, pw1), __builtin_bit_cast(bf16x8, pw2), __builtin_bit_cast(bf16x8, pw3));
}
#define SB_WAITBAR(N) asm volatile("s_waitcnt vmcnt(" #N ") lgkmcnt(0)\n\ts_barrier" ::: "memory")
__device__ __forceinline__ void sb_unit(int b, int h, int qb, const bf16_t* Q, const bf16_t* K, const bf16_t* V, bf16_t* O, float* hs, LAS char* shm) {
    int tid = threadIdx.x; asm volatile("" : "+v"(tid)); const int lane = tid & 63, r32 = lane & 31, hi = lane >> 5; const int wid = __builtin_amdgcn_readfirstlane(tid >> 6);
    const long rowbase = (long)b * SEQ; const int q0 = qb * QB;
    const bf16_t* Qw = Q + (rowbase + q0 + wid * 32) * PITCH + h * HD;
    const bf16_t* Kh = K + rowbase * PITCH + h * HD; const bf16_t* Vh = V + rowbase * PITCH + h * HD;
    const unsigned lds0 = (unsigned)(uintptr_t)shm;
    LAS unsigned* flags = (LAS unsigned*)(shm + LDS_FLAG);
    const unsigned koff = (unsigned)(lane * PITCH + wid * 8) * 2u, voff = (unsigned)((16 * (wid & 3) + (lane >> 2)) * PITCH + (wid >> 2) * 32 + (lane & 3) * 8) * 2u;
    const unsigned kdst = lds0 + LDS_K + wid * 1024, vdst = lds0 + LDS_V + wid * 1024;
#define SB_DMA(p, slot) do { glds16s(Kh + (long)(NT - 1 - (p)) * KVBLK * PITCH, koff, (unsigned)__builtin_amdgcn_readfirstlane(kdst + (slot) * SLOTB)); \
        glds16s(Vh + (long)(NT - 1 - (p)) * KVBLK * PITCH, voff, (unsigned)__builtin_amdgcn_readfirstlane(vdst + (slot) * SLOTB)); } while (0)
    const int vb0 = (int)(lds0 + LDS_V) + ((lane >> 4) & 1) * 32 + (lane & 3) * 8 + (4 * hi + ((lane & 15) >> 2)) * 64;
    const int NT = (q0 + QB) / KVBLK, NB = NT < NBURST ? NT : NBURST;
    for (int p = 0; p < NB; ++p) SB_DMA(p, p);
    bf16x8 qr[4];
#pragma unroll
    for (int d0 = 0; d0 < 4; ++d0) qr[d0] = *(const bf16x8*)(Qw + (long)r32 * PITCH + d0 * 16 + hi * 8);
    f32x16 o[2]; o[0] = f32x16{}; o[1] = f32x16{};
    const int qrel = wid * 32 + r32;
    float R = 0.f;
    bf16x8 TD0, TD1, TONE;
#pragma unroll
    for (int j = 0; j < 8; ++j) { const int kvl = 8 * (j >> 2) + 4 * hi + (j & 3); TD0[j] = (kvl >= r32) ? (short)0x3F80 : (short)0; TD1[j] = (16 + kvl >= r32) ? (short)0x3F80 : (short)0; TONE[j] = (short)0x3F80; }
    if (NB > 4) { SB_WAITBAR(4); } else { SB_WAITBAR(0); }
    bool mid_done = (NB <= 4);
    int p = 3 - (wid >> 1);
    for (; p < NB; ++p) {
        if (p >= 4 && !mid_done) { SB_WAITBAR(0); mid_done = true; }
        sb_tile(shm + LDS_K + p * SLOTB, vb0 + p * SLOTB, qr, TD0, TD1, TONE, 3 - p, qrel, r32, hi, R, o);
        if (__all(R < SB_EXIT)) { ++p; break; }
    }
    if (!mid_done) { SB_WAITBAR(0); }
    { const bool dn = __all(R < SB_EXIT) || (p >= NT); if (lane == 0) flags[wid] = dn ? 1u : 0u; }
    SB_WAITBAR(0);
    bool alldone;
    { const u32x4 fa = *(const LAS u32x4*)flags, fb = *(const LAS u32x4*)(flags + 4); alldone = __builtin_amdgcn_readfirstlane((fa.x & fa.y & fa.z & fa.w & fb.x & fb.y & fb.z & fb.w) != 0u); }
    if (!alldone && NB < NT) {
        SB_DMA(NB, 0);
        for (int i = 0; NB + i < NT; ++i) {
            const int pp = NB + i, sl = i & 1;
            SB_WAITBAR(0);
            if (i > 0) { const LAS unsigned* fl = flags + 8 + ((i - 1) & 1) * 8; const u32x4 fa = *(const LAS u32x4*)fl, fb = *(const LAS u32x4*)(fl + 4);
                if (__builtin_amdgcn_readfirstlane((fa.x & fa.y & fa.z & fa.w & fb.x & fb.y & fb.z & fb.w) != 0u)) break; }
            if (pp + 1 < NT) SB_DMA(pp + 1, sl ^ 1);
            if (!__all(R < SB_EXIT)) sb_tile(shm + LDS_K + sl * SLOTB, vb0 + sl * SLOTB, qr, TD0, TD1, TONE, -1, qrel, r32, hi, R, o);
            { const bool dn = __all(R < SB_EXIT); if (lane == 0) flags[8 + (i & 1) * 8 + wid] = dn ? 1u : 0u; }
        }
        SB_WAITBAR(0);
    }
    bf16_t* Ow = O + (rowbase + q0 + wid * 32) * OPITCH + h * HD;
    { LAS bf16_t* stg = (LAS bf16_t*)(shm + LDS_K) + wid * 2048;
#pragma unroll
      for (int r = 0; r < 16; ++r) { const int orow = crow(r, hi);
#pragma unroll
        for (int d0 = 0; d0 < 2; ++d0) stg[orow * 64 + d0 * 32 + r32] = (bf16_t)(cvt_pk_bf16(o[d0][r], 0.f) & 0xffffu); }
      LDS_WAIT();
#pragma unroll
      for (int i = 0; i < 4; ++i) { const int row = i * 8 + (lane >> 3), ch = lane & 7; const u32x4 v = *(const LAS u32x4*)(stg + row * 64 + ch * 8); *(u32x4*)(Ow + (long)row * OPITCH + ch * 8) = v;
        att::store_row_ssq(v, hs + (rowbase + q0 + wid * 32 + row) * 16, ch); } }
    asm volatile("s_waitcnt vmcnt(0) lgkmcnt(0)\n\ts_barrier" ::: "memory");
#undef SB_DMA
}
#undef SB_WAITBAR
}


namespace sbw {
constexpr int KVBLK = 64, PITCH = HW, OPITCH = DM, WAVE_LDS = 16384, VSLOT = 8192;
static_assert(NWAVES * WAVE_LDS <= RING_BYTES, "sbw LDS");
using att::crow; using att::glds16s; using att::pv; using att::swap_lo;
__device__ __forceinline__ void tile_pass(f32x16& p0, f32x16& p1, float& R, f32x16* o, int vb, bf16x8 TD0, bf16x8 TD1, bf16x8 TONE, bool wait_v) {
    const f32x16 z16 = f32x16{};
    f32x16 l0, l1;
#pragma unroll
    for (int r = 0; r < 16; ++r) {
        l0[r] = -(fmaxf(p0[r], 0.f) + __builtin_amdgcn_logf(1.0f + __builtin_amdgcn_exp2f(-fabsf(p0[r]))));
        l1[r] = -(fmaxf(p1[r], 0.f) + __builtin_amdgcn_logf(1.0f + __builtin_amdgcn_exp2f(-fabsf(p1[r])))); }
    u32x4 lw0 = {cvt_pk_bf16(l0[0], l0[1]), cvt_pk_bf16(l0[2], l0[3]), cvt_pk_bf16(l0[4], l0[5]), cvt_pk_bf16(l0[6], l0[7])};
    u32x4 lw1 = {cvt_pk_bf16(l0[8], l0[9]), cvt_pk_bf16(l0[10], l0[11]), cvt_pk_bf16(l0[12], l0[13]), cvt_pk_bf16(l0[14], l0[15])};
    u32x4 lw2 = {cvt_pk_bf16(l1[0], l1[1]), cvt_pk_bf16(l1[2], l1[3]), cvt_pk_bf16(l1[4], l1[5]), cvt_pk_bf16(l1[6], l1[7])};
    u32x4 lw3 = {cvt_pk_bf16(l1[8], l1[9]), cvt_pk_bf16(l1[10], l1[11]), cvt_pk_bf16(l1[12], l1[13]), cvt_pk_bf16(l1[14], l1[15])};
    f32x16 t0 = MFMA32(TD0, __builtin_bit_cast(bf16x8, lw0), z16); t0 = MFMA32(TD1, __builtin_bit_cast(bf16x8, lw1), t0);
    t0 = MFMA32(TONE, __builtin_bit_cast(bf16x8, lw2), t0); t0 = MFMA32(TONE, __builtin_bit_cast(bf16x8, lw3), t0);
    f32x16 t1 = MFMA32(TD0, __builtin_bit_cast(bf16x8, lw2), z16); t1 = MFMA32(TD1, __builtin_bit_cast(bf16x8, lw3), t1);
#pragma unroll
    for (int r = 0; r < 16; ++r) { p0[r] = __builtin_amdgcn_exp2f((p0[r] + R) + t0[r]); p1[r] = __builtin_amdgcn_exp2f((p1[r] + R) + t1[r]); }
    R += swap_lo(t0[0]);
    u32x4 pw0 = {cvt_pk_bf16(p0[0], p0[1]), cvt_pk_bf16(p0[2], p0[3]), cvt_pk_bf16(p0[4], p0[5]), cvt_pk_bf16(p0[6], p0[7])};
    u32x4 pw1 = {cvt_pk_bf16(p0[8], p0[9]), cvt_pk_bf16(p0[10], p0[11]), cvt_pk_bf16(p0[12], p0[13]), cvt_pk_bf16(p0[14], p0[15])};
    u32x4 pw2 = {cvt_pk_bf16(p1[0], p1[1]), cvt_pk_bf16(p1[2], p1[3]), cvt_pk_bf16(p1[4], p1[5]), cvt_pk_bf16(p1[6], p1[7])};
    u32x4 pw3 = {cvt_pk_bf16(p1[8], p1[9]), cvt_pk_bf16(p1[10], p1[11]), cvt_pk_bf16(p1[12], p1[13]), cvt_pk_bf16(p1[14], p1[15])};
    if (wait_v) asm volatile("s_waitcnt vmcnt(0)" ::: "memory");
    pv(o, vb, __builtin_bit_cast(bf16x8, pw0), __builtin_bit_cast(bf16x8, pw1), __builtin_bit_cast(bf16x8, pw2), __builtin_bit_cast(bf16x8, pw3));
}
__device__ __forceinline__ void sbw_unit(int u, const bf16_t* Q, const bf16_t* K, const bf16_t* V, bf16_t* O, float* hsb, LAS char* wshm, int lane) {
    const int r32 = lane & 31, hi = lane >> 5;
    const int bh = u >> 7, qw = u & 127, b = bh >> 3, h = bh & 7;
    const long rowbase = (long)b * SEQ; const int q0 = qw * 64, td = qw;
    const bf16_t* Qw = Q + (rowbase + q0) * PITCH + h * HD;
    const bf16_t* Kh = K + rowbase * PITCH + h * HD; const bf16_t* Vh = V + rowbase * PITCH + h * HD;
    const unsigned lds0 = (unsigned)(uintptr_t)wshm;
    const int row16 = lane >> 2, pos = lane & 3;
    const unsigned voffV = (unsigned)(row16 * PITCH + pos * 8) * 2u;
    const unsigned voffK = (unsigned)(row16 * PITCH + (pos ^ ((row16 >> 2) & 3)) * 8) * 2u;
    const int vb0 = (int)lds0 + VSLOT + ((lane >> 4) & 1) * 32 + (lane & 3) * 8 + (4 * hi + ((lane & 15) >> 2)) * 64;
    const LAS char* kb = (const LAS char*)wshm + (r32 >> 4) * 1024 + (r32 & 15) * 64;
    const int kx0 = ((0 | hi) ^ ((r32 >> 2) & 3)) * 16, kx1 = ((2 | hi) ^ ((r32 >> 2) & 3)) * 16;
#define SBW_DMA(base, t, voff, slotoff) do { const bf16_t* vt_ = (base) + (long)(t) * KVBLK * PITCH; _Pragma("unroll") for (int c_ = 0; c_ < 8; ++c_) \
        glds16s(vt_ + (c_ & 3) * 16 * PITCH + (c_ >> 2) * 32, voff, (unsigned)__builtin_amdgcn_readfirstlane(lds0 + (slotoff) + c_ * 1024)); } while (0)
#define SBW_KFR() do { _Pragma("unroll") for (int d0_ = 0; d0_ < 4; ++d0_) { const LAS char* a_ = kb + (d0_ >> 1) * 4096 + ((d0_ & 1) ? kx1 : kx0); \
        kf[2 * d0_] = *(const LAS bf16x8*)a_; kf[2 * d0_ + 1] = *(const LAS bf16x8*)(a_ + 2048); } } while (0)
#define SBW_QKT(qf) do { SBW_KFR(); p0 = MFMA32(kf[0], qf[0], z16); p1 = MFMA32(kf[1], qf[0], z16); \
        _Pragma("unroll") for (int d0_ = 1; d0_ < 4; ++d0_) { p0 = MFMA32(kf[2 * d0_], qf[d0_], p0); p1 = MFMA32(kf[2 * d0_ + 1], qf[d0_], p1); } } while (0)
    SBW_DMA(Kh, td, voffK, 0); SBW_DMA(Vh, td, voffV, VSLOT);
    bf16x8 qa[4], qb[4];
#pragma unroll
    for (int d0 = 0; d0 < 4; ++d0) { qa[d0] = *(const bf16x8*)(Qw + (long)r32 * PITCH + d0 * 16 + hi * 8); qb[d0] = *(const bf16x8*)(Qw + (long)(32 + r32) * PITCH + d0 * 16 + hi * 8); }
    bf16x8 TD0, TD1, TONE;
#pragma unroll
    for (int j = 0; j < 8; ++j) { const int kvl = 8 * (j >> 2) + 4 * hi + (j & 3); TD0[j] = (kvl >= r32) ? (short)0x3F80 : (short)0; TD1[j] = (16 + kvl >= r32) ? (short)0x3F80 : (short)0; TONE[j] = (short)0x3F80; }
    f32x16 oa[2], ob[2]; oa[0] = f32x16{}; oa[1] = f32x16{}; ob[0] = f32x16{}; ob[1] = f32x16{};
    float RA = 0.f, RB = 0.f;
    const f32x16 z16 = f32x16{};
    int t = td;
    for (;;) {
        const bool first = (t == td), more = t > 0;
        bf16x8 kf[8]; f32x16 p0, p1;
        asm volatile("s_waitcnt vmcnt(8)" ::: "memory");
        SBW_QKT(qa);
        if (first) {
#pragma unroll
            for (int r = 0; r < 16; ++r) { if (crow(r, hi) >= r32) p0[r] = -1.0e30f; p1[r] = -1.0e30f; } }
        tile_pass(p0, p1, RA, oa, vb0, TD0, TD1, TONE, true);
        SBW_QKT(qb);
        if (more) { asm volatile("s_waitcnt lgkmcnt(0)" ::: "memory"); SBW_DMA(Kh, t - 1, voffK, 0); }
        if (first) {
#pragma unroll
            for (int r = 0; r < 16; ++r) { if (crow(r, hi) >= r32) p1[r] = -1.0e30f; } }
        tile_pass(p0, p1, RB, ob, vb0, TD0, TD1, TONE, false);
        if (!more || (__all(RA < SB_EXIT) && __all(RB < SB_EXIT))) break;
        asm volatile("s_waitcnt lgkmcnt(0)" ::: "memory"); SBW_DMA(Vh, t - 1, voffV, VSLOT);
        --t;
    }
    bf16_t* Ow = O + (rowbase + q0) * OPITCH + h * HD;
    { LAS bf16_t* stg = (LAS bf16_t*)(wshm + VSLOT);
      asm volatile("s_waitcnt lgkmcnt(0)" ::: "memory");
#pragma unroll
      for (int r = 0; r < 16; ++r) { const int orow = crow(r, hi);
#pragma unroll
        for (int d0 = 0; d0 < 2; ++d0) { stg[orow * 64 + d0 * 32 + r32] = (bf16_t)(cvt_pk_bf16(oa[d0][r], 0.f) & 0xffffu); stg[(32 + orow) * 64 + d0 * 32 + r32] = (bf16_t)(cvt_pk_bf16(ob[d0][r], 0.f) & 0xffffu); } }
      LDS_WAIT();
#pragma unroll
      for (int i = 0; i < 8; ++i) { const int row = i * 8 + (lane >> 3), ch = lane & 7; const u32x4 v = *(const LAS u32x4*)(stg + row * 64 + ch * 8); *(u32x4*)(Ow + (long)row * OPITCH + ch * 8) = v;
        att::store_row_ssq(v, hsb + (rowbase + q0 + row) * 16 + h, ch); } }
    LDS_WAIT();
#undef SBW_DMA
#undef SBW_KFR
#undef SBW_QKT
}
}

#define XB_TMO      128
#define XB_XCNT(j)  (256  + 64 * (j))
#define XB_XSUB(j)  (1280 + 64 * (j))
#define XB_XGEN(j)  (2304 + 64 * (j))
#define XB_TOP      3328
#define XB_TOPGEN   3392
#define XCD_BAR_WORDS 3456
#define XB_SPIN_CAP (1u << 18)
__device__ __forceinline__ unsigned xb_ld(unsigned* p)              { return __hip_atomic_load(p, __ATOMIC_RELAXED, __HIP_MEMORY_SCOPE_AGENT); }
__device__ __forceinline__ unsigned xb_add(unsigned* p, unsigned v) { return __hip_atomic_fetch_add(p, v, __ATOMIC_RELAXED, __HIP_MEMORY_SCOPE_AGENT); }
__device__ __forceinline__ unsigned xb_xcc_id() { return (unsigned)__builtin_amdgcn_s_getreg((3 << 11) | 20) & 0xFu; }
#define XB_SPIN(cond, bar) do { unsigned _sp = 0; while (cond) { __builtin_amdgcn_s_sleep(1); \
    if ((++_sp & 255u) == 0u) { if (xb_ld(&(bar)[XB_TMO])) break; if (_sp > XB_SPIN_CAP) { atomicAdd(&(bar)[XB_TMO], 1u); break; } } } } while (0)
struct XcdBarrier { unsigned* bar; unsigned x; volatile LAS unsigned* st; };
__device__ __forceinline__ XcdBarrier xcd_barrier_post(unsigned* bar, volatile LAS unsigned* st) {
    XcdBarrier b; b.bar = bar; b.x = xb_xcc_id(); b.st = st;
    if (threadIdx.x == 0) (void)xb_add(&bar[XB_XCNT(b.x)], 1u);
    return b;
}
__device__ __forceinline__ void xcd_barrier_complete(unsigned* bar, unsigned x, unsigned& nloc, unsigned& nx) {
    const unsigned G = gridDim.x * gridDim.y * gridDim.z;
    unsigned sum, cnt, mine, sp = 0u;
    for (;;) {
        sum = 0u; cnt = 0u; mine = 0u;
#pragma unroll
        for (unsigned j = 0; j < 16; ++j) { const unsigned c = xb_ld(&bar[XB_XCNT(j)]); sum += c; cnt += (c > 0u) ? 1u : 0u; mine = (j == x) ? c : mine; }
        if (sum == G) break;
        __builtin_amdgcn_s_sleep(1);
        if ((++sp & 255u) == 0u) { if (xb_ld(&bar[XB_TMO])) break; if (sp > XB_SPIN_CAP) { atomicAdd(&bar[XB_TMO], 1u); break; } }
    }
    nloc = mine > 0u ? mine : 1u; nx = cnt > 0u ? cnt : 1u;
}
__device__ __forceinline__ void xcd_barrier(const XcdBarrier& b) {
    asm volatile("s_waitcnt vmcnt(0)" ::: "memory");
    __syncthreads();
    if (threadIdx.x == 0) {
        unsigned* bar = b.bar;
        __builtin_amdgcn_s_waitcnt(0);
        unsigned nloc = b.st[0], nx = b.st[1];
        if (nloc == 0u) { xcd_barrier_complete(bar, b.x, nloc, nx); b.st[0] = nloc; b.st[1] = nx; }
        const unsigned old = xb_add(&bar[XB_XSUB(b.x)], 1u);
        const unsigned gen = old / nloc;
        if (old + 1u == (gen + 1u) * nloc) {
            __builtin_amdgcn_fence(__ATOMIC_RELEASE, "agent");
            asm volatile("s_waitcnt vmcnt(0)" ::: "memory");
            const unsigned og = xb_add(&bar[XB_TOP], 1u);
            const unsigned tg = og / nx;
            if (og + 1u == (tg + 1u) * nx) xb_add(&bar[XB_TOPGEN], 1u);
            else XB_SPIN(xb_ld(&bar[XB_TOPGEN]) == tg, bar);
            __builtin_amdgcn_fence(__ATOMIC_ACQUIRE, "agent");
            xb_add(&bar[XB_XGEN(b.x)], 1u);
            asm volatile("s_waitcnt vmcnt(0)" ::: "memory");
        } else {
            XB_SPIN(xb_ld(&bar[XB_XGEN(b.x)]) == gen, bar);
            __builtin_amdgcn_fence(__ATOMIC_ACQUIRE, "agent");
            asm volatile("s_waitcnt vmcnt(0)" ::: "memory");
        }
    }
    __syncthreads();
}

__device__ __forceinline__ const void* ldp(const volatile LAS unsigned* tab, int i) {
    const unsigned lo = __builtin_amdgcn_readfirstlane(tab[2 * i]), hi = __builtin_amdgcn_readfirstlane(tab[2 * i + 1]);
    return (const void*)(const GAS void*)(((unsigned long long)hi << 32) | lo);
}
struct Args {
    const float* x; const float* mem; const float* norm_mix; const float* w_in; const float* b_forget; const float* norm_fox; const float* norm_sb; const float* w_out;
    const float* norm_xattn; const float* norm_mem; const float* w_xq; const float* w_xkv; const float* w_xo; const float* norm_ffn;
    const float* w_rg; const float* b_rg; const float* w_re; const float* b_re; const float* w_gate; const float* w_up; const float* w_down; const float* norm_final;
    float* out; unsigned char* ws;
};

__device__ __forceinline__ void transpose_item(const float* W, int ldw, bf16_t* WT, int ldo, int k0, int n0, int dst_row0, const float* gain, LAS float* scr, int lane) {
    float tv[32], tg[32];
#pragma unroll
    for (int i = 0; i < 32; ++i) { const int kk = 2 * i + (lane >> 5); tv[i] = __builtin_nontemporal_load(W + (size_t)(k0 + kk) * ldw + n0 + (lane & 31)); tg[i] = gain ? gain[k0 + kk] : 1.f; }
#pragma unroll
    for (int i = 0; i < 32; ++i) { const int kk = 2 * i + (lane >> 5); scr[kk * 33 + (lane & 31)] = tv[i] * tg[i]; }
    LDS_WAIT(); asm volatile("" ::: "memory");
    const int c = lane & 7;
#pragma unroll
    for (int j = 0; j < 4; ++j) { const int n = (lane >> 3) + 8 * j; const LAS float* s = scr + (8 * c) * 33 + n;
        u32x4 o; o.x = cvt_pk_bf16(s[0 * 33], s[1 * 33]); o.y = cvt_pk_bf16(s[2 * 33], s[3 * 33]); o.z = cvt_pk_bf16(s[4 * 33], s[5 * 33]); o.w = cvt_pk_bf16(s[6 * 33], s[7 * 33]);
        *(u32x4*)(WT + (size_t)(dst_row0 + n) * ldo + k0 + 8 * c) = o; }
    LDS_WAIT(); asm volatile("" ::: "memory");
}

__device__ __forceinline__ void transpose_item8(const float* W, int ldw, unsigned char* WT, int ldo, int k0, int n0, int dst_row0, const float* gain, float scale, LAS float* scr, int lane) {
    float tv[32], tg[32];
#pragma unroll
    for (int i = 0; i < 32; ++i) { const int kk = 2 * i + (lane >> 5); tv[i] = __builtin_nontemporal_load(W + (size_t)(k0 + kk) * ldw + n0 + (lane & 31)); tg[i] = gain ? gain[k0 + kk] : 1.f; }
#pragma unroll
    for (int i = 0; i < 32; ++i) { const int kk = 2 * i + (lane >> 5); scr[kk * 33 + (lane & 31)] = tv[i] * tg[i] * scale; }
    LDS_WAIT(); asm volatile("" ::: "memory");
    const int c = lane & 7;
#pragma unroll
    for (int j = 0; j < 4; ++j) { const int n = (lane >> 3) + 8 * j; const LAS float* s = scr + (8 * c) * 33 + n;
        u32x2 o; o.x = cvt4_fp8(s[0 * 33], s[1 * 33], s[2 * 33], s[3 * 33]); o.y = cvt4_fp8(s[4 * 33], s[5 * 33], s[6 * 33], s[7 * 33]);
        *(u32x2*)(WT + (size_t)(dst_row0 + n) * ldo + k0 + 8 * c) = o; }
    LDS_WAIT(); asm volatile("" ::: "memory");
}

struct SchedDense {
    const char* A; const char* Bt; int nM, nN, G, c; size_t a_tile, b_tile, b_batch; int split_tiles;
    __device__ __forceinline__ bool next(int i, pg8::Unit& u) const {
        int pm, pn; if (!pg8::tile_order(i, G, c, nM, nN, pm, pn)) return false;
        u.a = A + (size_t)pm * a_tile; u.b = Bt + (size_t)pn * b_tile + (size_t)(pm >> 5) * b_batch; u.orow = pm * 256;
        if (split_tiles) { u.aux = pn / split_tiles; u.ocol = (pn % split_tiles) * 256; } else { u.aux = 1; u.ocol = pn * 256; }
        u.rows = nullptr; u.nvalid = 256; return true;
    }
};
struct SchedGH {
    const char* KVm; const char* Wxq; const char* Wxo; int G, c;
    __device__ __forceinline__ bool next(int i, pg8::Unit& u) const {
        const int L = i * G + c; if (L >= 256) return false;
        const int kind = L >> 7, r = L & 127, bh = r >> 2, j = r & 3, b = bh >> 2, h = bh & 3;
        if (kind == 0) { u.a = KVm + ((size_t)(b * 256) * 2048 + h * 256) * 2; u.b = Wxq + ((size_t)(256 * j) * 1024 + h * 256) * 2; u.orow = b * 1024 + h * 256; u.ocol = 256 * j; u.aux = 1; }
        else { u.a = Wxo + ((size_t)(256 * j) * 1024 + h * 256) * 2; u.b = KVm + ((size_t)(b * 256) * 2048 + 1024 + h * 256) * 2; u.orow = b * 1024 + 256 * j; u.ocol = h * 256; u.aux = 2; }
        u.rows = nullptr; u.nvalid = 256; return true;
    }
};
template <int KIND> struct SchedGHk { SchedGH s; __device__ __forceinline__ bool next(int i, pg8::Unit& u) const { const int c2 = (s.G >= 256) ? s.c - 128 * KIND : s.c; if (c2 < 0) return false; const int L = i * s.G + c2; if (L >= 128) return false; SchedGH t = s; t.G = 1; t.c = 0; return t.next(128 * KIND + L, u); } };
struct EpiGH { static constexpr bool HAS_MID = false; unsigned char* GTp; unsigned char* HTp;
    __device__ __forceinline__ void operator()(const f32x4 (&acc)[2][2][4][2], const pg8::Unit& u, int wr, int wc, int fr, int fq) const {
        unsigned char* base = u.aux == 1 ? GTp : HTp;
#pragma unroll
        for (int ai = 0; ai < 2; ++ai)
#pragma unroll
            for (int m = 0; m < 4; m += 2) { const int row = u.orow + ai * pg8::HALF + wr * 64 + m * 16 + fr + 16 * (fq & 1);
#pragma unroll
                for (int bj = 0; bj < 2; ++bj) { u32x2 w8[2];
#pragma unroll
                    for (int mm = 0; mm < 2; ++mm) { const f32x4 v0 = acc[ai][bj][m + mm][0], v1 = acc[ai][bj][m + mm][1]; w8[mm].x = cvt4_fp8(v0[0], v0[1], v0[2], v0[3]); w8[mm].y = cvt4_fp8(v1[0], v1[1], v1[2], v1[3]); }
                    *(u32x4*)(base + (size_t)row * DM + u.ocol + bj * pg8::HALF + wc * 32 + 8 * (fq & ~1)) = widen16(w8[0], w8[1]); } }
    } };
struct SchedMoe {
    const char* A; const char* W; const int* list; const LAS int* tbl; int G, c, NPN; size_t w_exp, w_tile, a_tile; int ocol_w;
    __device__ __forceinline__ bool next(int i, pg8::Unit& u) const {
        int tl, pn;
        if ((G & 7) == 0) { const int uu = i * (G >> 3) + (c >> 3); tl = (uu / NPN) * 8 + (c & 7); pn = uu % NPN; }
        else { const int L = i * G + c; tl = L / NPN; pn = L % NPN; }
        if (tl >= __builtin_amdgcn_readfirstlane(tbl[16])) return false;
        const int e = __builtin_amdgcn_readfirstlane(tbl[64 + tl]);
        const int j = tl - __builtin_amdgcn_readfirstlane(tbl[e]), n = __builtin_amdgcn_readfirstlane(tbl[32 + e]) - 256 * j;
        u.a = A + (size_t)tl * a_tile; u.b = W + (size_t)e * w_exp + (size_t)pn * w_tile; u.orow = tl * 256; u.ocol = pn * ocol_w; u.aux = 1;
        u.rows = list + (size_t)e * M + 256 * j; u.nvalid = n < 256 ? n : 256; return true;
    }
};
__device__ __forceinline__ void moe_table(LAS int* tbl, const unsigned* ctl) {
    if (threadIdx.x == 0) { int base = 0; for (int e = 0; e < NEXP; ++e) { const int n = (int)ctl[CW_CNT + 64 * e]; tbl[e] = base; tbl[32 + e] = n; base += (n + 255) >> 8; } tbl[16] = base; }
    __syncthreads();
    for (int tl = threadIdx.x; tl < tbl[16]; tl += NWAVES * 64) { int e = 0;
#pragma unroll
        for (int x = 1; x < NEXP; ++x) if (tl >= tbl[x]) e = x;
        tbl[64 + tl] = e; }
    __syncthreads();
}

__global__ void __launch_bounds__(NWAVES * 64, 2) hymba_fwd(Args args) {
    extern __shared__ __attribute__((aligned(16))) unsigned char lds_raw[];
    LAS unsigned char* lds = (LAS unsigned char*)lds_raw;
    volatile LAS unsigned* MISC = (volatile LAS unsigned*)(lds + MISC_OFF);
    const int tid0 = threadIdx.x; const int wave = __builtin_amdgcn_readfirstlane(tid0 >> 6);
    const int G = gridDim.x; const int bx = blockIdx.x; const int vcu = (G % 8 == 0) ? (bx % 8) * (G / 8) + bx / 8 : bx;
    volatile LAS unsigned* ATAB = (volatile LAS unsigned*)(lds + MISC_OFF + 512);
    for (int u = tid0; u < 256; u += NWAVES * 64) ((LAS unsigned*)(lds + MISC_OFF))[u] = 0u;
    __syncthreads();
    if (tid0 == 0) { const float* const* ap = (const float* const*)&args;
#pragma unroll
        for (int i = 0; i < 24; ++i) { const unsigned long long v = (unsigned long long)ap[i]; ATAB[2 * i] = (unsigned)v; ATAB[2 * i + 1] = (unsigned)(v >> 32); } }
    __syncthreads();
#define ARGP(name) ((const float*)ldp(ATAB, (int)(offsetof(Args, name) / 8)))
#define PHASE_PTRS \
    int tid = threadIdx.x; asm volatile("" : "+v"(tid)); const int lane = tid & 63; (void)lane; \
    unsigned char* const ws = (unsigned char*)ldp(ATAB, 23); float* const out = (float*)ldp(ATAB, 22); unsigned* const ctl = (unsigned*)(ws + WS_CTL); (void)out; (void)ctl; \
    bf16_t* const Win_t = (bf16_t*)(ws + WS_WIN); bf16_t* const Wout_t = (bf16_t*)(ws + WS_WOUT); bf16_t* const Wxq_n = (bf16_t*)(ws + WS_WXQ); bf16_t* const Wxkv_t = (bf16_t*)(ws + WS_WXKV); \
    bf16_t* const Wxo_t = (bf16_t*)(ws + WS_WXO); bf16_t* const Wgu_t = (bf16_t*)(ws + WS_WGU); bf16_t* const Wd_t = (bf16_t*)(ws + WS_WD); \
    float* const RX = (float*)(ws + WS_RX); float* const RMEM = (float*)(ws + WS_RMEM); float* const LF = (float*)(ws + WS_LF); float* const CC = (float*)(ws + WS_C2); float* const SSQ = (float*)(ws + WS_SSQ); \
    int* const TOKSLOT = (int*)(ws + WS_TOKSLOT); float* const TOKW = (float*)(ws + WS_TOKW); int* const LIST = (int*)(ws + WS_LIST); \
    bf16_t* const MEMB = (bf16_t*)(ws + WS_MEMB); bf16_t* const KVM = (bf16_t*)(ws + WS_KVM); bf16_t* const GT = (bf16_t*)(ws + WS_GT); bf16_t* const HT = (bf16_t*)(ws + WS_HT); \
    bf16_t* const XB = (bf16_t*)(ws + WS_XB); bf16_t* const QKV = (bf16_t*)(ws + WS_QKV); bf16_t* const H1B = (bf16_t*)(ws + WS_H1B); bf16_t* const U2B = (bf16_t*)(ws + WS_U2B); bf16_t* const HID = (bf16_t*)(ws + WS_HID); \
    bf16_t* const OAB = (bf16_t*)(ws + WS_O); bf16_t* const YB = (bf16_t*)(ws + WS_Y); bf16_t* const KX = (bf16_t*)(ws + WS_KX); (void)KX; float* const HS = (float*)(ws + WS_HS); (void)HS; float* const R2S = (float*)(ws + WS_SSQ); (void)R2S; unsigned char* const H1F8 = ws + WS_H1F8; (void)H1F8; unsigned char* const H2F8 = ws + WS_H2F8; (void)H2F8; \
    (void)Win_t; (void)Wout_t; (void)Wxq_n; (void)Wxkv_t; (void)Wxo_t; (void)Wgu_t; (void)Wd_t; (void)RX; (void)RMEM; (void)LF; (void)CC; (void)SSQ; (void)TOKSLOT; (void)TOKW; (void)LIST; \
    (void)MEMB; (void)KVM; (void)GT; (void)HT; (void)XB; (void)QKV; (void)H1B; (void)U2B; (void)HID; (void)OAB; (void)YB;
    XcdBarrier bar;
    { unsigned char* const ws0 = (unsigned char*)ldp(ATAB, 23); bar = xcd_barrier_post((unsigned*)(ws0 + WS_CTL) + CW_BAR, MISC + 8); }
    const int gw = vcu * NWAVES + wave, NGW = G * NWAVES;
    unsigned long long t_pa = 0, t_pb = 0; (void)t_pa; (void)t_pb;


    if (PROBE_LO == 0) t_pa = __builtin_amdgcn_s_memrealtime();
    if (PH(0))
    for (int rep_ = 0; rep_ < REPS(0); ++rep_)
    {
        PHASE_PTRS
        LAS float* wfT = (LAS float*)(lds + RING_OFF);
        LAS float* scr = (LAS float*)(lds + RING_OFF + 32768 + wave * 8448);
        { const float* win = ARGP(w_in); const float* gmix = ARGP(norm_mix);
          f32x4 fa[2], fb[2]; float gk[2];
#pragma unroll
          for (int q = 0; q < 2; ++q) { const int k = tid + 512 * q; gk[q] = gmix[k]; fa[q] = *(const f32x4*)(win + (size_t)k * WIN_LD + NPROJ); fb[q] = *(const f32x4*)(win + (size_t)k * WIN_LD + NPROJ + 4); }
#pragma unroll
          for (int q = 0; q < 2; ++q) { const int k = tid + 512 * q;
#pragma unroll
              for (int j = 0; j < 4; ++j) { wfT[j * DM + k] = fa[q][j] * gk[q]; wfT[(4 + j) * DM + k] = fb[q][j] * gk[q]; } } }
        constexpr int I_IN = 16 * 96, I_OUT = 16 * 32, I_XKV = 16 * 64, I_XO = 16 * 32, I_G = 16 * 16 * 8, I_U = I_G, I_D = 16 * 4 * 32, I_XQ = 1024;
        constexpr int NITEMS = I_IN + I_OUT + I_XKV + I_XO + I_G + I_U + I_D + I_XQ;
        for (int it = gw; it < NITEMS; it += NGW) {
            int r = it;
            if (r < I_IN) { const int kb = r / 96, nb = r % 96; transpose_item(ARGP(w_in), WIN_LD, Win_t, DM, 64 * kb, 32 * nb, 32 * nb, ARGP(norm_mix), scr, lane); continue; } r -= I_IN;
            if (r < I_OUT) { const int kb = r / 32, nb = r % 32; const float* gn = (64 * kb < HW) ? ARGP(norm_fox) : (ARGP(norm_sb) - HW); transpose_item(ARGP(w_out), DM, Wout_t, DM, 64 * kb, 32 * nb, 32 * nb, gn, scr, lane); continue; } r -= I_OUT;
            if (r < I_XKV) { const int kb = r / 64, nb = r % 64; transpose_item(ARGP(w_xkv), 2 * DM, Wxkv_t, DM, 64 * kb, 32 * nb, 32 * nb, ARGP(norm_mem), scr, lane); continue; } r -= I_XKV;
            if (r < I_XO) { const int kb = r / 32, nb = r % 32; transpose_item(ARGP(w_xo), DM, Wxo_t, DM, 64 * kb, 32 * nb, 32 * nb, nullptr, scr, lane); continue; } r -= I_XO;
            if (r < I_G + I_U) { const int up = r >= I_G; const int q = up ? r - I_G : r; const int e = q / 128, kb = (q % 128) / 8, nb = q % 8; const int n0 = 32 * nb;
                const float* W = (up ? ARGP(w_up) : ARGP(w_gate)) + (size_t)e * DM * DFF;
                transpose_item8(W, DFF, (unsigned char*)Wgu_t + (size_t)e * 512 * DM, DM, 64 * kb, n0, 256 * (n0 / 128) + (n0 % 128) + (up ? 128 : 0), ARGP(norm_ffn), WGU_SCALE, scr, lane); continue; } r -= I_G + I_U;
            if (r < I_D) { const int e = r / 128, kb = (r % 128) / 32, nb = r % 32; transpose_item8(ARGP(w_down) + (size_t)e * DFF * DM, DM, (unsigned char*)Wd_t + (size_t)e * DM * DFF, DFF, 64 * kb, 32 * nb, 32 * nb, nullptr, WD_SCALE, scr, lane); continue; } r -= I_D;
            { const int k = r; const float gk = ARGP(norm_xattn)[k]; const f32x4* src = (const f32x4*)(ARGP(w_xq) + (size_t)k * DM) + lane; u32x2* dst = (u32x2*)(Wxq_n + (size_t)k * DM) + lane;
              f32x4 vq[4];
#pragma unroll
              for (int j = 0; j < 4; ++j) vq[j] = src[64 * j];
#pragma unroll
              for (int j = 0; j < 4; ++j) { const f32x4 v = vq[j] * gk; u32x2 w; w.x = cvt_pk_bf16(v[0], v[1]); w.y = cvt_pk_bf16(v[2], v[3]); dst[64 * j] = w; } }
        }
        __syncthreads();
        const float* xin = ARGP(x); const float* memin = ARGP(mem); const float* bfg = ARGP(b_forget);
        constexpr int TOT = M + MEMROWS;
#define P0_LOAD(vv, rw) do { if ((rw) < TOT) { const bool im_ = (rw) >= M; const f32x4* xr_ = (const f32x4*)((im_ ? memin : xin) + (size_t)(im_ ? (rw) - M : (rw)) * DM) + lane; \
        _Pragma("unroll") for (int j = 0; j < 4; ++j) vv[j] = __builtin_nontemporal_load(xr_ + 64 * j); } } while (0)
#define P0_SSQ(vv, s) do { _Pragma("unroll") for (int j = 0; j < 4; ++j) s += (vv[j][0] * vv[j][0] + vv[j][1] * vv[j][1]) + (vv[j][2] * vv[j][2] + vv[j][3] * vv[j][3]); } while (0)
#define P0_STORE(vv, dstp) do { u32x2* o8 = (u32x2*)(dstp) + lane; \
        _Pragma("unroll") for (int j = 0; j < 4; ++j) { u32x2 w; w.x = cvt_pk_bf16(vv[j][0], vv[j][1]); w.y = cvt_pk_bf16(vv[j][2], vv[j][3]); o8[64 * j] = w; } } while (0)
#define P0_BFLY(f, fl) do { const bool pb0 = (lane & 1) != 0, pb1 = (lane & 2) != 0, pb2 = (lane & 4) != 0; float c4[4], d2[2]; \
        _Pragma("unroll") for (int i = 0; i < 4; ++i) { const float keep = pb0 ? f[i + 4] : f[i], send = pb0 ? f[i] : f[i + 4]; c4[i] = keep + DPP_MOV(send, 0xB1); } \
        _Pragma("unroll") for (int i = 0; i < 2; ++i) { const float keep = pb1 ? c4[i + 2] : c4[i], send = pb1 ? c4[i] : c4[i + 2]; d2[i] = keep + DPP_MOV(send, 0x4E); } \
        { const float keep = pb2 ? d2[1] : d2[0], send = pb2 ? d2[0] : d2[1]; const float up = DPP_MOV(send, 0x104), dn = DPP_MOV(send, 0x114); fl = keep + (pb2 ? dn : up); } \
        fl += DPP_MOV(fl, 0x128); \
        { auto t_ = __builtin_amdgcn_permlane16_swap(__float_as_uint(fl), __float_as_uint(fl), false, false); fl = __uint_as_float(t_[0]) + __uint_as_float(t_[1]); } \
        fl = att::swap_lo(fl) + att::swap_hi(fl); } while (0)
#define P0_LFOUT(fl, rinv, r) do { const int hd = 4 * (lane & 1) + (lane & 2) + ((lane >> 2) & 1); const float fv = (fl) * (rinv) + bfg[hd]; \
        const float ls = fminf(fv, 0.f) - log1pf(expf(-fabsf(fv))); \
        LF[((size_t)((r) >> 13) * 8 + hd) * SEQ + ((r) & (SEQ - 1))] = ls * LOG2E; } while (0)
#define P0_ROW(vv, rw) do { const int row_ = (rw); const bool is_mem = row_ >= M; const int r = is_mem ? row_ - M : row_; float s = 0.f; P0_SSQ(vv, s); \
        const float rinv = rsqrtf(wave_sum(s) * (1.0f / DM) + EPS); \
        P0_STORE(vv, (is_mem ? MEMB : XB) + (size_t)r * DM); \
        if (is_mem) { if (lane == 0) RMEM[r] = rinv; } \
        else { float f[8]; \
            _Pragma("unroll") for (int jj = 0; jj < 8; ++jj) { float a = 0.f; \
                _Pragma("unroll") for (int j = 0; j < 4; ++j) { const f32x4 w4 = *(const LAS f32x4*)(wfT + jj * DM + 256 * j + 4 * lane); a += (vv[j][0] * w4[0] + vv[j][1] * w4[1]) + (vv[j][2] * w4[2] + vv[j][3] * w4[3]); } \
                f[jj] = a; } \
            float fl; P0_BFLY(f, fl); \
            if (lane == 0) RX[r] = rinv; \
            if (lane < 8) P0_LFOUT(fl, rinv, r); } } while (0)
#define P0_ROW2(vA, rA, vB, rB) do { float sA = 0.f, sB = 0.f; P0_SSQ(vA, sA); P0_SSQ(vB, sB); \
        const float rinvA = rsqrtf(wave_sum(sA) * (1.0f / DM) + EPS), rinvB = rsqrtf(wave_sum(sB) * (1.0f / DM) + EPS); \
        P0_STORE(vA, XB + (size_t)(rA) * DM); P0_STORE(vB, XB + (size_t)(rB) * DM); \
        float fA[8], fB[8]; \
        _Pragma("unroll") for (int jj = 0; jj < 8; ++jj) { float aA = 0.f, aB = 0.f; \
            _Pragma("unroll") for (int j = 0; j < 4; ++j) { const f32x4 w4 = *(const LAS f32x4*)(wfT + jj * DM + 256 * j + 4 * lane); \
                aA += (vA[j][0] * w4[0] + vA[j][1] * w4[1]) + (vA[j][2] * w4[2] + vA[j][3] * w4[3]); aB += (vB[j][0] * w4[0] + vB[j][1] * w4[1]) + (vB[j][2] * w4[2] + vB[j][3] * w4[3]); } \
            fA[jj] = aA; fB[jj] = aB; } \
        float flA, flB; P0_BFLY(fA, flA); P0_BFLY(fB, flB); \
        if (lane == 0) { RX[rA] = rinvA; RX[rB] = rinvB; } \
        if (lane < 8) { P0_LFOUT(flA, rinvA, rA); P0_LFOUT(flB, rinvB, rB); } } while (0)
#define P0_PAIR(vA, rA, vB, rB) do { if ((rB) < M) { P0_ROW2(vA, rA, vB, rB); } else { if ((rA) < TOT) P0_ROW(vA, rA); if ((rB) < TOT) P0_ROW(vB, rB); } } while (0)
        f32x4 va[4], vb[4], vc[4], vd[4];
        P0_LOAD(va, gw); P0_LOAD(vb, gw + NGW);
        for (int row = gw; row < TOT; row += 4 * NGW) {
            P0_LOAD(vc, row + 2 * NGW); P0_LOAD(vd, row + 3 * NGW);
            P0_PAIR(va, row, vb, row + NGW);
            if (row + 2 * NGW < TOT) { P0_LOAD(va, row + 4 * NGW); P0_LOAD(vb, row + 5 * NGW); P0_PAIR(vc, row + 2 * NGW, vd, row + 3 * NGW); }
        }
#undef P0_SSQ
#undef P0_STORE
#undef P0_BFLY
#undef P0_LFOUT
#undef P0_ROW2
#undef P0_PAIR
#undef P0_LOAD
#undef P0_ROW
    }
    xcd_barrier(bar);
    if (PROBE_HI == 0) t_pb = __builtin_amdgcn_s_memrealtime();

    if (PROBE_LO == 1) t_pa = __builtin_amdgcn_s_memrealtime();
    const bool cs_first = ((bx >> 3) & 1) != 0;
    auto p1_cumsum = [&]()
    {
        PHASE_PTRS
        for (int bhq = vcu; bhq < 256; bhq += G) {
        const int bh = bhq >> 2, seg = bhq & 3, s0 = seg * 2048 + wave * 256 + lane * 4;
        const float* src = LF + (size_t)bh * SEQ;
        const f32x4 v = *(const f32x4*)(src + s0);
        float e = 0.f;
        for (int q = 0; q < seg; ++q) { const f32x4 w = *(const f32x4*)(src + q * 2048 + wave * 256 + lane * 4); e += (w[0] + w[1]) + (w[2] + w[3]); }
        const float p0 = v[0], p1 = p0 + v[1], p2 = p1 + v[2], p3 = p2 + v[3];
        float inc = p3;
#pragma unroll
        for (int o = 1; o < 64; o <<= 1) { const float y = __shfl_up(inc, o); if (lane >= o) inc += y; }
        const float es = wave_sum(e);
        LAS float* tot = (LAS float*)(lds + EXTRA_OFF);
        if (lane == 63) tot[wave] = inc;
        if (lane == 0) tot[8 + wave] = es;
        __syncthreads();
        float off = inc - p3;
        for (int q = 0; q < 8; ++q) { off += tot[8 + q]; if (q < wave) off += tot[q]; }
        {
            const f32x4 c = {off + p0, off + p1, off + p2, off + p3};
            *(f32x4*)(CC + (size_t)bh * SEQ + s0) = c;
            bf16_t* kx = KX + ((size_t)bh * SEQ + s0) * 8;
#pragma unroll
            for (int j = 0; j < 4; ++j) { unsigned hm, lo; fox::split3(-c[j], hm, lo); u32x4 w; w.x = 0x3F803F80u; w.y = 0x3F80u | (hm << 16); w.z = (hm >> 16) | (lo << 16); w.w = 0u;
                *(u32x4*)(kx + j * 8) = w; } }
        VM_WAIT(); __syncthreads();
        }
    };
    if (PH(1) && cs_first) p1_cumsum();
    if (PH(1))
    for (int rep_ = 0; rep_ < REPS(1); ++rep_)
    {
        PHASE_PTRS
        pg8::Gemm g{DM, DM, DM};
        SchedDense S{(const char*)XB, (const char*)Win_t, M / 256, NPROJ / 256, G, bx, (size_t)256 * DM * 2, (size_t)256 * DM * 2, 0, 2};
        LAS float* rst = (LAS float*)(lds + EXTRA_OFF);
#pragma unroll
        for (int q = 0; q < 8; ++q) { const int idx = tid + 512 * q, i = idx >> 8, r = idx & 255; int pm, pn; if (pg8::tile_order(i, G, bx, M / 256, NPROJ / 256, pm, pn)) rst[idx] = RX[pm * 256 + r]; }
        VM_WAIT(); __syncthreads();
        pg8::EpiBf16 E{QKV, HW, RX, QKV_STRIDE, C2, C2, ctl + CW_KN, rst, 1.f};
        pg8::gemm_phase<pg8::EpiBf16, SchedDense, true, false>(lds + RING_OFF, g, S, E);
    }
    if (PH(1) && !cs_first) { __syncthreads(); p1_cumsum(); }
    xcd_barrier(bar);
    if (PROBE_HI == 1) t_pb = __builtin_amdgcn_s_memrealtime();

    if (PROBE_LO == 2) t_pa = __builtin_amdgcn_s_memrealtime();
    if (PH(2))
    {
        PHASE_PTRS
        const bf16_t* QA = QKV; const bf16_t* KA = QKV + QKV_STRIDE; const bf16_t* VA = QKV + 2 * QKV_STRIDE;
        const bf16_t* QBp = QKV + 3 * QKV_STRIDE; const bf16_t* KBp = QKV + 4 * QKV_STRIDE; const bf16_t* VBp = QKV + 5 * QKV_STRIDE;
        bf16_t* OA = OAB; bf16_t* OB = OAB + HW;
        LAS char* shm = (LAS char*)(lds + RING_OFF);
        { pg8::Gemm g{DM, DM, DM};
          SchedDense S2{(const char*)MEMB, (const char*)Wxkv_t, MEMROWS / 256, 2 * DM / 256, G, bx, (size_t)256 * DM * 2, (size_t)256 * DM * 2, 0, 0};
          pg8::EpiBf16 E2{KVM, 2 * DM, RMEM, 0, 1.f, 1.f, nullptr, nullptr, 1.f};
          pg8::gemm_phase<pg8::EpiBf16, SchedDense, true, false>(lds + RING_OFF, g, S2, E2);
          VM_WAIT(); __syncthreads(); }
        for (int rep = 0; rep < REP_FOX; ++rep)
        for (int i = 0; i < 8; ++i) { const int bh = (vcu >> 5) * 8 + i, x = vcu & 31, qb = (i & 1) ? 31 - x : x;
            const float kmax = sqrtf(__uint_as_float(ctl[CW_KN + bh * 2]) + __uint_as_float(ctl[CW_KN + bh * 2 + 1])) * 1.01f;
            const int nqb = ((i + 1) & 1) ? 31 - x : x;
            fox::fox_unit<8>(bh, qb, QA, KA, VA, OA, HS + (bh & 7), CC + (size_t)bh * SEQ, KX, kmax, shm, i > 0, i < 7 ? bh + 1 : -1, nqb); }
        __syncthreads();
        { LAS char* wshm = shm + wave * sbw::WAVE_LDS;
          constexpr unsigned NQ = NH * 128;
          const unsigned xq = bar.x & 7u;
          unsigned* qh = ctl + CW_SBQ;
          unsigned qi = 0u, qsel = xq, raw = 0u;
          if (lane == 0) raw = __hip_atomic_fetch_add(qh + 64 * qsel, 1u, __ATOMIC_RELAXED, __HIP_MEMORY_SCOPE_AGENT);
          unsigned idx = (unsigned)__builtin_amdgcn_readfirstlane((int)raw);
          for (;;) {
              while (idx >= NQ && qi < 7u) { ++qi; qsel = (xq + qi) & 7u;
                  if (lane == 0) raw = __hip_atomic_fetch_add(qh + 64 * qsel, 1u, __ATOMIC_RELAXED, __HIP_MEMORY_SCOPE_AGENT);
                  idx = (unsigned)__builtin_amdgcn_readfirstlane((int)raw); }
              if (idx >= NQ) break;
              if (lane == 0) raw = __hip_atomic_fetch_add(qh + 64 * qsel, 1u, __ATOMIC_RELAXED, __HIP_MEMORY_SCOPE_AGENT);
              sbw::sbw_unit((int)(qsel * NQ + idx), QBp, KBp, VBp, OB, HS + 8, wshm, lane);
              idx = (unsigned)__builtin_amdgcn_readfirstlane((int)raw);
          } }
    }
    xcd_barrier(bar);
    if (PROBE_HI == 2) t_pb = __builtin_amdgcn_s_memrealtime();

    if (PROBE_LO == 4) t_pa = __builtin_amdgcn_s_memrealtime();
    if (PH(4))
    for (int rep_ = 0; rep_ < REPS(4); ++rep_)
    {
        PHASE_PTRS
        const bool gh_first = ((bx >> 3) & 1) != 0;
#define P4_GH() do { pg8::Gemm g2{0, 0, 256}; SchedGH SG{(const char*)KVM, (const char*)Wxq_n, (const char*)Wxo_t, G, bx}; EpiGH EG{(unsigned char*)GT, (unsigned char*)HT}; \
        g2.lda = 2 * DM; g2.ldb = DM; SchedGHk<0> S0{SG}; pg8::gemm_phase<EpiGH, SchedGHk<0>, true, false>(lds + RING_OFF, g2, S0, EG); \
        g2.lda = DM; g2.ldb = 2 * DM; SchedGHk<1> S1{SG}; pg8::gemm_phase<EpiGH, SchedGHk<1>, true, false>(lds + RING_OFF, g2, S1, EG); } while (0)
        if (gh_first) { P4_GH(); }
        pg8::Gemm g{DM, DM, DM};
        SchedDense S{(const char*)OAB, (const char*)Wout_t, M / 256, DM / 256, G, bx, (size_t)256 * DM * 2, (size_t)256 * DM * 2, 0, 0};
        LAS f32x2* rab = (LAS f32x2*)(lds + EXTRA_OFF);
#pragma unroll
        for (int q = 0; q < 4; ++q) { const int idx = tid + 512 * q, i = idx >> 8, r = idx & 255; int pm, pn;
            if (pg8::tile_order(i, G, bx, M / 256, DM / 256, pm, pn)) { const f32x4* p = (const f32x4*)(HS + (size_t)(pm * 256 + r) * 16); const f32x4 a0 = p[0], a1 = p[1], b0 = p[2], b1 = p[3];
                const float ra = rsqrtf((((a0[0] + a0[1]) + (a0[2] + a0[3])) + ((a1[0] + a1[1]) + (a1[2] + a1[3]))) * (1.0f / HW) + EPS);
                const float rb = rsqrtf((((b0[0] + b0[1]) + (b0[2] + b0[3])) + ((b1[0] + b1[1]) + (b1[2] + b1[3]))) * (1.0f / HW) + EPS);
                rab[idx] = (f32x2){ra / rb, rb}; } }
        VM_WAIT(); __syncthreads();
        pg8::EpiOutProj E{XB, H1B, H1F8, SSQ, rab};
        pg8::gemm_phase<pg8::EpiOutProj, SchedDense, true, false>(lds + RING_OFF, g, S, E);
        if (!gh_first) { P4_GH(); }
#undef P4_GH
    }
    xcd_barrier(bar);
    if (PROBE_HI == 4) t_pb = __builtin_amdgcn_s_memrealtime();

    if (PROBE_LO == 5) t_pa = __builtin_amdgcn_s_memrealtime();
    if (PH(5))
    for (int rep_ = 0; rep_ < REPS(5); ++rep_)
    {
        PHASE_PTRS
        pg8::Gemm g{DM, DM, DM};
        SchedDense S{(const char*)H1F8, (const char*)GT, M / 256, DM / 256, G, bx, (size_t)256 * DM, (size_t)256 * DM, (size_t)DM * DM, 0};
        LAS float* r1t = (LAS float*)(lds + EXTRA_OFF + 8192);
#pragma unroll
        for (int q = 0; q < 4; ++q) { const int idx = tid + 512 * q, i = idx >> 8, r = idx & 255; int pm, pn;
            if (pg8::tile_order(i, G, bx, M / 256, DM / 256, pm, pn)) { const f32x4* sp = (const f32x4*)(SSQ + (size_t)(pm * 256 + r) * 16); const f32x4 s0 = sp[0], s1 = sp[1], s2 = sp[2], s3 = sp[3];
                const float tot = ((s0[0] + s0[1]) + (s0[2] + s0[3])) + ((s1[0] + s1[1]) + (s1[2] + s1[3])) + ((s2[0] + s2[1]) + (s2[2] + s2[3])) + ((s3[0] + s3[1]) + (s3[2] + s3[3]));
                r1t[idx] = rsqrtf(tot * (1.0f / DM) + EPS) * XSC; } }
        VM_WAIT(); __syncthreads();
        pg8::EpiSoftmax E{XB, r1t, (LAS float*)(lds + EXTRA_OFF)};
        pg8::gemm_phase<pg8::EpiSoftmax, SchedDense, true, false, true>(lds + RING_OFF, g, S, E);
    }
    xcd_barrier(bar);
    if (PROBE_HI == 5) t_pb = __builtin_amdgcn_s_memrealtime();

    if (PROBE_LO == 6) t_pa = __builtin_amdgcn_s_memrealtime();
    if (PH(6))
    {
        PHASE_PTRS
        pg8::Gemm g{DM, DM, DM};
        SchedDense S{(const char*)XB, (const char*)HT, M / 256, DM / 256, G, bx, (size_t)256 * DM, (size_t)256 * DM, (size_t)DM * DM, 0};
        pg8::EpiResidBf16 E{H1B, H2F8, 1.0f / P_SCALE};
        pg8::gemm_phase<pg8::EpiResidBf16, SchedDense, true, false, true>(lds + RING_OFF, g, S, E);
    }
    xcd_barrier(bar);
    if (PROBE_HI == 6) t_pb = __builtin_amdgcn_s_memrealtime();

    if (PROBE_LO == 7) t_pa = __builtin_amdgcn_s_memrealtime();
    if (PH(7))
    {
        PHASE_PTRS
        LAS bf16_t* wBh = (LAS bf16_t*)(lds + RING_OFF); LAS bf16_t* wBl = wBh + 20 * DM;
        { const f32x4* wg4 = (const f32x4*)ARGP(w_rg); const f32x4* we4 = (const f32x4*)ARGP(w_re); const float* gf = ARGP(norm_ffn);
          f32x4 ga[2], ea[2][4]; float gk[2];
#pragma unroll
          for (int q = 0; q < 2; ++q) { const int k = tid + 512 * q; ga[q] = wg4[k]; gk[q] = gf[k];
#pragma unroll
              for (int c = 0; c < 4; ++c) ea[q][c] = we4[k * 4 + c]; }
#pragma unroll
          for (int q = 0; q < 2; ++q) { const int k = tid + 512 * q;
#pragma unroll
              for (int j = 0; j < 4; ++j) { { const float v = ga[q][j] * gk[q]; const unsigned hi_ = cvt_pk_bf16(v, 0.f) & 0xffffu; wBh[j * DM + k] = (bf16_t)hi_; wBl[j * DM + k] = (bf16_t)(cvt_pk_bf16(v - __uint_as_float(hi_ << 16), 0.f) & 0xffffu); }
#pragma unroll
                  for (int c = 0; c < 4; ++c) { const float v = ea[q][c][j] * gk[q]; const unsigned hi_ = cvt_pk_bf16(v, 0.f) & 0xffffu; const int col = 4 + 4 * c + j; wBh[col * DM + k] = (bf16_t)hi_; wBl[col * DM + k] = (bf16_t)(cvt_pk_bf16(v - __uint_as_float(hi_ << 16), 0.f) & 0xffffu); } } } }
        LAS int* dec_e = (LAS int*)(lds + RING_OFF + 81920); LAS float* dec_w = (LAS float*)(lds + RING_OFF + 81920 + 2048); LAS int* dec_r = (LAS int*)(lds + RING_OFF + 81920 + 4096);
        LAS int* hist = (LAS int*)(lds + RING_OFF + 81920 + 6144); LAS int* ebase = hist + 16; LAS float* dec_v = (LAS float*)(lds + RING_OFF + 81920 + 8192);
        if (tid < 16) hist[tid] = 0;
        __syncthreads();
        const float brg0 = ARGP(b_rg)[0], brg1 = ARGP(b_rg)[1], brg2 = ARGP(b_rg)[2], brg3 = ARGP(b_rg)[3]; const float* bre = ARGP(b_re);
        const int tok = lane & 31, half = lane >> 5, jcol = tok < 20 ? tok : 19;
        for (int it = 0; it * NGW < M / 32; ++it) {
            const int T = gw + it * NGW; const bool act = T < M / 32; const int r0 = act ? 32 * T : 0;
            const bf16_t* rowp = H1B + (size_t)(r0 + tok) * DM + 512 * half;
            const LAS bf16_t* wph = wBh + jcol * DM + 512 * half; const LAS bf16_t* wpl = wBl + jcol * DM + 512 * half;
            f32x16 ah0 = f32x16{}, ah1 = f32x16{}, al0 = f32x16{}, al1 = f32x16{}; float ssq = 0.f;
            u32x4 ag[2][8];
#define P7_LOADG(g, S) do { _Pragma("unroll") for (int q = 0; q < 4; ++q) { ag[S][2 * q] = *(const u32x4*)(rowp + 16 * (4 * (g) + q)); ag[S][2 * q + 1] = *(const u32x4*)(rowp + 16 * (4 * (g) + q) + 8); } } while (0)
#define P7_COMPG(g, S) do { _Pragma("unroll") for (int q = 0; q < 4; ++q) { const int sidx = 2 * (4 * (g) + q); const u32x4 a0 = ag[S][2 * q], a1 = ag[S][2 * q + 1]; \
                const bf16x8 wh0 = *(const LAS bf16x8*)(wph + 8 * sidx), wl0 = *(const LAS bf16x8*)(wpl + 8 * sidx), wh1 = *(const LAS bf16x8*)(wph + 8 * sidx + 8), wl1 = *(const LAS bf16x8*)(wpl + 8 * sidx + 8); \
                ah0 = MFMA32(wh0, __builtin_bit_cast(bf16x8, a0), ah0); al0 = MFMA32(wl0, __builtin_bit_cast(bf16x8, a0), al0); \
                ah1 = MFMA32(wh1, __builtin_bit_cast(bf16x8, a1), ah1); al1 = MFMA32(wl1, __builtin_bit_cast(bf16x8, a1), al1); \
                ssq += (bf16lo(a0.x) * bf16lo(a0.x) + bf16hi(a0.x) * bf16hi(a0.x)) + (bf16lo(a0.y) * bf16lo(a0.y) + bf16hi(a0.y) * bf16hi(a0.y)) + (bf16lo(a0.z) * bf16lo(a0.z) + bf16hi(a0.z) * bf16hi(a0.z)) + (bf16lo(a0.w) * bf16lo(a0.w) + bf16hi(a0.w) * bf16hi(a0.w)); \
                ssq += (bf16lo(a1.x) * bf16lo(a1.x) + bf16hi(a1.x) * bf16hi(a1.x)) + (bf16lo(a1.y) * bf16lo(a1.y) + bf16hi(a1.y) * bf16hi(a1.y)) + (bf16lo(a1.z) * bf16lo(a1.z) + bf16hi(a1.z) * bf16hi(a1.z)) + (bf16lo(a1.w) * bf16lo(a1.w) + bf16hi(a1.w) * bf16hi(a1.w)); } \
                asm volatile("" ::: "memory"); } while (0)
            P7_LOADG(0, 0);
            P7_LOADG(1, 1); P7_COMPG(0, 0); P7_LOADG(2, 0); P7_COMPG(1, 1); P7_LOADG(3, 1); P7_COMPG(2, 0); P7_LOADG(4, 0); P7_COMPG(3, 1);
            P7_LOADG(5, 1); P7_COMPG(4, 0); P7_LOADG(6, 0); P7_COMPG(5, 1); P7_LOADG(7, 1); P7_COMPG(6, 0); P7_COMPG(7, 1);
#undef P7_LOADG
#undef P7_COMPG
            const float rinv = rsqrtf((att::swap_lo(ssq) + att::swap_hi(ssq)) * (1.0f / DM) + EPS);
            float lg[20];
#pragma unroll
            for (int r = 0; r < 12; ++r) { const float c = (ah0[r] + ah1[r]) + (al0[r] + al1[r]); auto rr = __builtin_amdgcn_permlane32_swap(__float_as_uint(c), __float_as_uint(c), false, false);
                const int jl = (r & 3) + 8 * (r >> 2); lg[jl] = __uint_as_float(rr[0]) * rinv; if (r < 8) lg[jl + 4] = __uint_as_float(rr[1]) * rinv; }
            float g0 = lg[0] + brg0, g1 = lg[1] + brg1, g2 = lg[2] + brg2, g3 = lg[3] + brg3;
            int gi = 0; float gm = g0; if (g1 > gm) { gm = g1; gi = 1; } if (g2 > gm) { gm = g2; gi = 2; } if (g3 > gm) { gm = g3; gi = 3; }
            const float gval = 1.0f / (expf(g0 - gm) + expf(g1 - gm) + expf(g2 - gm) + expf(g3 - gm));
            float el[4];
            const f32x4 breq = *(const f32x4*)(bre + gi * 4);
#pragma unroll
            for (int j = 0; j < 4; ++j) { const float e0 = lg[4 + j], e1 = lg[8 + j], e2 = lg[12 + j], e3 = lg[16 + j]; el[j] = ((gi == 0) ? e0 : (gi == 1) ? e1 : (gi == 2) ? e2 : e3) + breq[j]; }
            int i0 = 0; float m0 = el[0];
#pragma unroll
            for (int j = 1; j < 4; ++j) if (el[j] > m0) { m0 = el[j]; i0 = j; }
            int i1 = -1; float m1 = -3.0e38f;
#pragma unroll
            for (int j = 0; j < 4; ++j) if (j != i0 && el[j] > m1) { m1 = el[j]; i1 = j; }
            const float w0 = 1.0f / (1.0f + expf(m1 - m0)), w1 = 1.0f - w0;
            if (act) { const int e = gi * 4 + (half == 0 ? i0 : i1); const float w = gval * (half == 0 ? w0 : w1);
                const int idx = (wave * 32 + tok) * 2 + half; dec_e[idx] = e; dec_w[idx] = w; dec_v[idx] = rinv; dec_r[idx] = __hip_atomic_fetch_add(hist + e, 1, __ATOMIC_RELAXED, __HIP_MEMORY_SCOPE_WORKGROUP); }
            __syncthreads();
            if (tid < 16) { const int n = hist[tid]; ebase[tid] = n ? (int)__hip_atomic_fetch_add(ctl + CW_CNT + 64 * tid, (unsigned)n, __ATOMIC_RELAXED, __HIP_MEMORY_SCOPE_AGENT) : 0; }
            __syncthreads();
            if (act) { const int row = r0 + (lane >> 1), idx = wave * 64 + lane; const int e = dec_e[idx], pos = ebase[e] + dec_r[idx];
                LIST[(size_t)e * M + pos] = row; R2S[(size_t)e * M + pos] = dec_v[idx]; TOKSLOT[(size_t)row * 2 + (lane & 1)] = (e << 20) | pos; TOKW[(size_t)row * 2 + (lane & 1)] = dec_w[idx]; }
            __syncthreads();
            if (tid < 16) hist[tid] = 0;
            __syncthreads();
        }
    }
    xcd_barrier(bar);
    if (PROBE_HI == 7) t_pb = __builtin_amdgcn_s_memrealtime();

    if (PROBE_LO == 8) t_pa = __builtin_amdgcn_s_memrealtime();
    if (PH(8))
    for (int rep_ = 0; rep_ < REPS(8); ++rep_)
    {
        PHASE_PTRS
        pg8::Gemm g{DM, DM, DM};
        LAS int* tbl = (LAS int*)(lds + EXTRA_OFF + 8192); moe_table(tbl, ctl);
        SchedMoe S; S.A = (const char*)H2F8; S.W = (const char*)Wgu_t; S.list = LIST; S.tbl = tbl; S.G = G; S.c = bx; S.NPN = 2; S.w_exp = (size_t)512 * DM; S.w_tile = (size_t)256 * DM; S.a_tile = 0; S.ocol_w = 128;
        pg8::EpiSwiglu E{HID, R2S, LIST};
        pg8::gemm_phase<pg8::EpiSwiglu, SchedMoe, true, true, true>(lds + RING_OFF, g, S, E);
    }
    xcd_barrier(bar);
    if (PROBE_HI == 8) t_pb = __builtin_amdgcn_s_memrealtime();

    if (PROBE_LO == 9) t_pa = __builtin_amdgcn_s_memrealtime();
    if (PH(9))
    for (int rep_ = 0; rep_ < REPS(9); ++rep_)
    {
        PHASE_PTRS
        pg8::Gemm g{DFF, DFF, DFF};
        LAS int* tbl = (LAS int*)(lds + EXTRA_OFF + 8192);
        SchedMoe S; S.A = (const char*)HID; S.W = (const char*)Wd_t; S.list = LIST; S.tbl = tbl; S.G = G; S.c = bx; S.NPN = 4; S.w_exp = (size_t)DM * DFF; S.w_tile = (size_t)256 * DFF; S.a_tile = (size_t)256 * DFF; S.ocol_w = 256;
        pg8::EpiY8 E{(unsigned char*)YB, 1.0f / WD_SCALE};
        pg8::gemm_phase<pg8::EpiY8, SchedMoe, true, false, true>(lds + RING_OFF, g, S, E);
    }
    xcd_barrier(bar);
    if (PROBE_HI == 9) t_pb = __builtin_amdgcn_s_memrealtime();

    if (PROBE_LO == 10) t_pa = __builtin_amdgcn_s_memrealtime();
    if (PH(10))
    {
        PHASE_PTRS
        const LAS int* tb = (const LAS int*)(lds + EXTRA_OFF + 8192);
        f32x4 gfin[4];
        { const f32x4* gp = (const f32x4*)ARGP(norm_final) + lane;
#pragma unroll
          for (int j = 0; j < 4; ++j) gfin[j] = gp[64 * j]; }
        int sl0 = 0, sl1 = 0; float sw0 = 0.f, sw1 = 0.f;
        unsigned ya_n[4], yb_n[4]; u32x2 hh_n[4]; float w0_n = 0.f, w1_n = 0.f;
#define P10_SLOTS(rw) do { sl0 = TOKSLOT[(size_t)(rw) * 2]; sl1 = TOKSLOT[(size_t)(rw) * 2 + 1]; sw0 = TOKW[(size_t)(rw) * 2]; sw1 = TOKW[(size_t)(rw) * 2 + 1]; } while (0)
#define P10_DATA(rw) do { const int r0_ = tb[sl0 >> 20] * 256 + (sl0 & 0xfffff), r1_ = tb[sl1 >> 20] * 256 + (sl1 & 0xfffff); w0_n = sw0; w1_n = sw1; \
        const unsigned* y0_ = (const unsigned*)((const unsigned char*)YB + (size_t)r0_ * DM) + lane; const unsigned* y1_ = (const unsigned*)((const unsigned char*)YB + (size_t)r1_ * DM) + lane; const u32x2* h_ = (const u32x2*)(H1B + (size_t)(rw) * DM) + lane; \
        _Pragma("unroll") for (int j = 0; j < 4; ++j) { ya_n[j] = __builtin_nontemporal_load(y0_ + 64 * j); yb_n[j] = __builtin_nontemporal_load(y1_ + 64 * j); hh_n[j] = __builtin_nontemporal_load(h_ + 64 * j); } } while (0)
        if (gw < M) { P10_SLOTS(gw); P10_DATA(gw); if (gw + NGW < M) P10_SLOTS(gw + NGW); }
        for (int row = gw; row < M; row += NGW) {
            unsigned ya[4], yb[4]; u32x2 hh[4]; const float w0 = w0_n, w1 = w1_n;
#pragma unroll
            for (int j = 0; j < 4; ++j) { ya[j] = ya_n[j]; yb[j] = yb_n[j]; hh[j] = hh_n[j]; }
            if (row + NGW < M) { P10_DATA(row + NGW); if (row + 2 * NGW < M) P10_SLOTS(row + 2 * NGW); }
            f32x4* hr = (f32x4*)(out + (size_t)row * DM) + lane;
            f32x4 v[4]; float s = 0.f;
#pragma unroll
            for (int j = 0; j < 4; ++j) { const u32x2 hx = hh[j]; f32x4 h = {bf16lo(hx.x), bf16hi(hx.x), bf16lo(hx.y), bf16hi(hx.y)};
                const f32x2 a01 = __builtin_amdgcn_cvt_pk_f32_fp8((int)ya[j], false), a23 = __builtin_amdgcn_cvt_pk_f32_fp8((int)ya[j], true), b01 = __builtin_amdgcn_cvt_pk_f32_fp8((int)yb[j], false), b23 = __builtin_amdgcn_cvt_pk_f32_fp8((int)yb[j], true);
                h[0] += w0 * a01[0] + w1 * b01[0]; h[1] += w0 * a01[1] + w1 * b01[1]; h[2] += w0 * a23[0] + w1 * b23[0]; h[3] += w0 * a23[1] + w1 * b23[1];
                v[j] = h; s += (h[0] * h[0] + h[1] * h[1]) + (h[2] * h[2] + h[3] * h[3]); }
            const float rinv = rsqrtf(wave_sum(s) * (1.0f / DM) + EPS);
#pragma unroll
            for (int j = 0; j < 4; ++j) __builtin_nontemporal_store(v[j] * rinv * gfin[j], hr + 64 * j);
        }
#undef P10_SLOTS
#undef P10_DATA
    }
    if (PROBE_LO >= 0) {
        if (PROBE_HI == 10) t_pb = __builtin_amdgcn_s_memrealtime();
        if (blockIdx.x == 0 && threadIdx.x == 0) { const unsigned long long t0 = __builtin_amdgcn_s_memrealtime(), span = 2 * (t_pb - t_pa);
            while (__builtin_amdgcn_s_memrealtime() - t0 < span) __builtin_amdgcn_s_sleep(8); }
    }
}

extern "C" void kernel_launch(void* const* d_in, const int* in_sizes, int n_in, void* d_out, int out_size, void* d_ws, size_t ws_size, hipStream_t stream) {
    static int grid = 0;
    if (grid == 0) {
        if (n_in != 22 || in_sizes[0] != M * DM || out_size != M * DM || ws_size < WS_END) { fprintf(stderr, "kernel_launch: unexpected shapes (n_in %d, in0 %d, out %d, ws %zu)\n", n_in, n_in > 0 ? in_sizes[0] : -1, out_size, ws_size); grid = -1; return; }
        int dev = 0, cus = 0, per_cu = 0;
        if (hipGetDevice(&dev) != hipSuccess || hipDeviceGetAttribute(&cus, hipDeviceAttributeMultiprocessorCount, dev) != hipSuccess) { grid = -1; return; }
        if (hipFuncSetAttribute((const void*)hymba_fwd, hipFuncAttributeMaxDynamicSharedMemorySize, LDS_BYTES) != hipSuccess) { fprintf(stderr, "kernel_launch: hipFuncSetAttribute failed\n"); grid = -1; return; }
        if (hipOccupancyMaxActiveBlocksPerMultiprocessor(&per_cu, (const void*)hymba_fwd, NWAVES * 64, LDS_BYTES) != hipSuccess || per_cu < 1) { fprintf(stderr, "kernel_launch: occupancy query reports %d\n", per_cu); }
        (void)hipGetLastError();
        grid = cus;
    }
    if (grid < 0) return;
    (void)hipMemsetAsync((char*)d_ws + WS_CTL, 0, CTL_ZERO_BYTES, stream);
    Args a{};
    const float** p = (const float**)&a;
    for (int i = 0; i < 22; ++i) p[i] = (const float*)d_in[i];
    a.out = (float*)d_out; a.ws = (unsigned char*)d_ws;
    hipLaunchKernelGGL(hymba_fwd, dim3(grid), dim3(NWAVES * 64), LDS_BYTES, stream, a);
}
```
